# Optimizing an MI355X kernel written in HIP

```python
import jax, jax.numpy as jnp
from jax import lax
import numpy as np

D_MODEL = 1024
BATCH = 2
SEQ = 8192
DEPTH = 4

N_A = DEPTH // 2
N_B = DEPTH - N_A
N_VRES = max(N_A - 1, 0)
HEAD_DIM = 64
N_HEADS = D_MODEL // HEAD_DIM
D_FF = 4 * D_MODEL
DECAY_LORA = 64
AAA_LORA = 64
MV_LORA = 32
GATE_LORA = 160
Q_BLOCK = 128
N_MOD = 6
NORM_EPS = 1e-6
GN_EPS = 64e-5
L2_EPS = 1e-12

kernel_name = 'yoco_rwkv7_fox_hybrid'


def rms_norm(x, g):
    xf = x.astype(jnp.float32)
    y = xf * lax.rsqrt(jnp.mean(xf * xf, axis=-1, keepdims=True) + NORM_EPS)
    return (y * g.astype(jnp.float32)).astype(x.dtype)


def modulate(h, shift, scale):
    return h * (1.0 + scale) + shift


def token_shift(x):
    return jnp.pad(x, ((0, 0), (1, 0), (0, 0)))[:, :-1, :]


def split_heads(t):
    return t.reshape(t.shape[0], t.shape[1], N_HEADS, HEAD_DIM)


def wkv7_scan(r, decay, k, v, a_vec, b_vec):
    bsz = r.shape[0]
    xs = tuple(jnp.moveaxis(t.astype(jnp.float32), 1, 0) for t in (r, decay, k, v, a_vec, b_vec))

    def step(S, inp):
        r_t, w_t, k_t, v_t, a_t, b_t = inp
        sa = jnp.einsum('bhvk,bhk->bhv', S, a_t)
        S = S * w_t[:, :, None, :] + sa[..., :, None] * b_t[..., None, :] + v_t[..., :, None] * k_t[..., None, :]
        y = jnp.einsum('bhvk,bhk->bhv', S, r_t)
        return S, y

    S0 = jnp.zeros((bsz, N_HEADS, HEAD_DIM, HEAD_DIM), jnp.float32)
    _, ys = lax.scan(step, S0, xs)
    return jnp.moveaxis(ys, 0, 1)


def rwkv7_time_mix(h, v_first, vres, mu, wr, wk, wv, wo, w0, w1, w2, a0, a1, a2,
                   g1, g2, k_k, k_a, r_k, ln_w, ln_b):
    bsz, T, _ = h.shape
    xx = token_shift(h) - h
    xr, xw, xk, xv, xa, xg = (h + xx * mu[j] for j in range(6))
    r = xr @ wr
    w_log = -jax.nn.softplus(-(w0 + jnp.tanh(xw @ w1) @ w2)) - 0.5
    k = xk @ wk
    v = xv @ wv
    if vres is None:
        v_first = v
    else:
        v0, v1, v2 = vres
        v = v + (v_first - v) * jax.nn.sigmoid(v0 + (xv @ v1) @ v2)
    a = jax.nn.sigmoid(a0 + (xa @ a1) @ a2)
    g = jax.nn.sigmoid(xg @ g1) @ g2
    kk = split_heads(k * k_k).astype(jnp.float32)
    kk = kk / jnp.maximum(jnp.sqrt(jnp.sum(kk * kk, axis=-1, keepdims=True)), L2_EPS)
    k = k * (1.0 + (a - 1.0) * k_a)
    decay = jnp.exp(-jnp.exp(w_log.astype(jnp.float32)))
    rh, kh, vh = split_heads(r), split_heads(k), split_heads(v)
    ah = split_heads(a).astype(jnp.float32)
    y = wkv7_scan(rh, split_heads(decay), kh, vh, -kk, kk * ah)
    mean = jnp.mean(y, axis=-1, keepdims=True)
    var = jnp.mean(jnp.square(y - mean), axis=-1, keepdims=True)
    y = ((y - mean) * lax.rsqrt(var + GN_EPS)).reshape(bsz, T, D_MODEL)
    y = y * ln_w.astype(jnp.float32) + ln_b.astype(jnp.float32)
    bonus = jnp.sum((rh * kh * r_k).astype(jnp.float32), axis=-1, keepdims=True) * vh.astype(jnp.float32)
    y = (y + bonus.reshape(bsz, T, D_MODEL)).astype(h.dtype)
    return (y * g) @ wo, v_first


def shared_kv(x, shift, scale, norm_g, w_kv, f_bias, k_gain):
    h = modulate(rms_norm(x, norm_g), shift, scale)
    kvf = h @ w_kv
    k = kvf[..., :D_MODEL]
    v = kvf[..., D_MODEL:2 * D_MODEL]
    f_logit = kvf[..., 2 * D_MODEL:]
    k = rms_norm(split_heads(k), k_gain)
    log_f = jax.nn.log_sigmoid(f_logit.astype(jnp.float32) + f_bias.astype(jnp.float32))
    F = jnp.cumsum(log_f, axis=1)
    return (k.transpose(0, 2, 1, 3), split_heads(v).transpose(0, 2, 1, 3).astype(jnp.float32),
            F.transpose(0, 2, 1))


def forgetting_attention(h, k, v, F, w_qg, q_gain, w_o):
    bsz, T, _ = h.shape
    qg = h @ w_qg
    q, gate = qg[..., :D_MODEL], qg[..., D_MODEL:]
    q = rms_norm(split_heads(q), q_gain).transpose(0, 2, 1, 3)
    sm_scale = HEAD_DIM ** -0.5
    kpos = jnp.arange(T)

    def block(start):
        qb = lax.dynamic_slice_in_dim(q, start, Q_BLOCK, axis=2)
        Fq = lax.dynamic_slice_in_dim(F, start, Q_BLOCK, axis=2)
        s = jnp.einsum('bhqd,bhkd->bhqk', qb, k).astype(jnp.float32) * sm_scale
        s = s + Fq[..., :, None] - F[..., None, :]
        qpos = start + jnp.arange(Q_BLOCK)
        s = jnp.where(kpos[None, :] <= qpos[:, None], s, -jnp.inf)
        p = jax.nn.softmax(s, axis=-1)
        return jnp.einsum('bhqk,bhkd->bhqd', p, v)

    starts = jnp.arange(T // Q_BLOCK) * Q_BLOCK
    o = lax.map(block, starts)
    o = o.transpose(1, 0, 3, 2, 4).reshape(bsz, T, D_MODEL).astype(h.dtype)
    return (o * jax.nn.sigmoid(gate)) @ w_o


def sq_relu_mlp(h, w_up, w_down):
    return jnp.square(jax.nn.relu(h @ w_up)) @ w_down


def setup_inputs(seed: int = 0) -> dict:
    key = jax.random.key(seed)
    keys = iter(jax.random.split(key, 48))
    f32 = jnp.float32

    def nrm(shape, scale):
        return jax.random.normal(next(keys), shape, f32) * scale

    def unif(shape, lo, hi):
        return jax.random.uniform(next(keys), shape, f32, lo, hi)

    D = D_MODEL
    return {
        'x': nrm((BATCH, SEQ, D), 1.0),
        'c': nrm((BATCH, D), 1.0),
        'mod_w': nrm((DEPTH, D, N_MOD * D), 0.2 * D ** -0.5),
        'mod_b': nrm((DEPTH, N_MOD * D), 0.01),
        'norm_mix_g': 1.0 + nrm((DEPTH, D), 0.02),
        'norm_mlp_g': 1.0 + nrm((DEPTH, D), 0.02),
        'mlp_up': nrm((DEPTH, D, D_FF), D ** -0.5),
        'mlp_down': nrm((DEPTH, D_FF, D), D_FF ** -0.5),
        'rw_mu': unif((N_A, 6, D), 0.0, 1.0),
        'rw_wr': nrm((N_A, D, D), D ** -0.5),
        'rw_wk': nrm((N_A, D, D), D ** -0.5),
        'rw_wv': nrm((N_A, D, D), D ** -0.5),
        'rw_wo': nrm((N_A, D, D), D ** -0.5),
        'rw_w0': unif((N_A, D), -6.0, 0.0),
        'rw_w1': nrm((N_A, D, DECAY_LORA), D ** -0.5),
        'rw_w2': nrm((N_A, DECAY_LORA, D), 0.1 * DECAY_LORA ** -0.5),
        'rw_a0': nrm((N_A, D), 0.1),
        'rw_a1': nrm((N_A, D, AAA_LORA), D ** -0.5),
        'rw_a2': nrm((N_A, AAA_LORA, D), 0.1 * AAA_LORA ** -0.5),
        'rw_g1': nrm((N_A, D, GATE_LORA), D ** -0.5),
        'rw_g2': nrm((N_A, GATE_LORA, D), GATE_LORA ** -0.5),
        'rw_kk': 0.85 + nrm((N_A, D), 0.02),
        'rw_ka': 1.0 + nrm((N_A, D), 0.02),
        'rw_rk': nrm((N_A, N_HEADS, HEAD_DIM), 0.1),
        'rw_lnw': 1.0 + nrm((N_A, D), 0.02),
        'rw_lnb': nrm((N_A, D), 0.01),
        'rw_v0': 1.0 + nrm((N_VRES, D), 0.02),
        'rw_v1': nrm((N_VRES, D, MV_LORA), D ** -0.5),
        'rw_v2': nrm((N_VRES, MV_LORA, D), 0.1 * MV_LORA ** -0.5),
        'kv_norm_g': 1.0 + nrm((D,), 0.02),
        'kv_mod_w': nrm((D, 2 * D), 0.2 * D ** -0.5),
        'kv_mod_b': nrm((2 * D,), 0.01),
        'kv_w': nrm((D, 2 * D + N_HEADS), D ** -0.5),
        'kv_fb': unif((N_HEADS,), 1.0, 5.0),
        'kv_kg': 1.0 + nrm((HEAD_DIM,), 0.02),
        'fx_wqg': nrm((N_B, D, 2 * D), D ** -0.5),
        'fx_qg': 1.0 + nrm((N_B, HEAD_DIM), 0.02),
        'fx_wo': nrm((N_B, D, D), D ** -0.5),
        'final_g': 1.0 + nrm((D,), 0.02),
    }


def reference(x, c, mod_w, mod_b, norm_mix_g, norm_mlp_g, mlp_up, mlp_down,
              rw_mu, rw_wr, rw_wk, rw_wv, rw_wo, rw_w0, rw_w1, rw_w2, rw_a0, rw_a1, rw_a2,
              rw_g1, rw_g2, rw_kk, rw_ka, rw_rk, rw_lnw, rw_lnb, rw_v0, rw_v1, rw_v2,
              kv_norm_g, kv_mod_w, kv_mod_b, kv_w, kv_fb, kv_kg,
              fx_wqg, fx_qg, fx_wo, final_g):
    c_act = jax.nn.silu(c)
    v_first = None
    k_sh = v_sh = F_sh = None
    for i in range(DEPTH):
        mod = (c_act @ mod_w[i] + mod_b[i])[:, None, :]
        sh1, sc1, gt1, sh2, sc2, gt2 = jnp.split(mod, N_MOD, axis=-1)
        if i == N_A:
            kvm = (c_act @ kv_mod_w + kv_mod_b)[:, None, :]
            kv_shift, kv_scale = jnp.split(kvm, 2, axis=-1)
            k_sh, v_sh, F_sh = shared_kv(x, kv_shift, kv_scale, kv_norm_g, kv_w, kv_fb, kv_kg)
        h = modulate(rms_norm(x, norm_mix_g[i]), sh1, sc1)
        if i < N_A:
            vres = None if i == 0 else (rw_v0[i - 1], rw_v1[i - 1], rw_v2[i - 1])
            y, v_first = rwkv7_time_mix(h, v_first, vres, rw_mu[i], rw_wr[i], rw_wk[i], rw_wv[i], rw_wo[i],
                                        rw_w0[i], rw_w1[i], rw_w2[i], rw_a0[i], rw_a1[i], rw_a2[i],
                                        rw_g1[i], rw_g2[i], rw_kk[i], rw_ka[i], rw_rk[i],
                                        rw_lnw[i], rw_lnb[i])
        else:
            j = i - N_A
            y = forgetting_attention(h, k_sh, v_sh, F_sh, fx_wqg[j], fx_qg[j], fx_wo[j])
        x = x + (1.0 + gt1) * y
        h = modulate(rms_norm(x, norm_mlp_g[i]), sh2, sc2)
        x = x + (1.0 + gt2) * sq_relu_mlp(h, mlp_up[i], mlp_down[i])
    return rms_norm(x, final_g)
```

```cpp
#include <hip/hip_runtime.h>
#include <hip/hip_cooperative_groups.h>
#include <hip/hip_bf16.h>
#include <cstdio>
#include <cstdint>
#include <cmath>
namespace cg = cooperative_groups;
#ifndef MK_ONE_LAUNCH
#define MK_ONE_LAUNCH 1
#endif
namespace pg8 {
#define PG8_LAS __attribute__((address_space(3)))
typedef unsigned short bf16_t;
typedef short bf16x8 __attribute__((ext_vector_type(8)));
typedef float f32x4 __attribute__((ext_vector_type(4)));
typedef unsigned u32x4 __attribute__((ext_vector_type(4)));
constexpr int BM = 256, BK = 64, HALF = 128, HTB = HALF * BK * 2  , STAGE_BYTES = 8 * HTB, NXCD = 8, WGM = 8;

__host__ __device__ __forceinline__ int lds_byte(int r, int c) { const int st = (r >> 4) * 2 + (c >> 5), rr = r & 15, cc = c & 31, ob = rr * 64 + cc * 2; return st * 1024 + (ob ^ (((ob >> 9) & 1) << 5)); }
__host__ __device__ __forceinline__ void stage_rc(int b, int& R, int& C) { const int st = b / 1024, sb = b % 1024, swz = sb ^ (((sb >> 9) & 1) << 5); R = (st >> 1) * 16 + swz / 64; C = (st & 1) * 32 + (swz % 64) / 2; }
__host__ __device__ __forceinline__ int perm32(int rho) { const int n = rho >> 4, i = rho & 15; return 8 * (i >> 2) + 4 * n + (i & 3); }

struct Unit { int pm, pn; };
struct Gemm { const bf16_t* A; const bf16_t* Bt; int M, N, K, lda, ldb; };

struct StaticOrder {
    int nM, nN, nwg, G, c;
    __host__ __device__ void init(int M, int N, int G_, int c_) { nM = M / BM; nN = N / BM; nwg = nM * nN; G = G_; c = c_; }
    __host__ __device__ bool next(int i, Unit& u) const {
        const long L = (long)i * G + c; if (L >= nwg) return false;
        int wgid = (int)L; { const int q = nwg / NXCD, r = nwg % NXCD, xcd = wgid % NXCD, off = wgid / NXCD; wgid = (xcd < r ? xcd * (q + 1) : r * (q + 1) + (xcd - r) * q) + off; }
        const int nig = WGM * nN, gid = wgid / nig, fm = gid * WGM, gsz = (nM - fm) < WGM ? (nM - fm) : WGM;
        u.pm = fm + ((wgid % nig) % gsz); u.pn = (wgid % nig) / gsz; return true;
    }
    __device__ __forceinline__ void a_ready(const Unit&) const {}
    __device__ __forceinline__ void done(const Unit&) const {}
};

typedef float f32x2 __attribute__((ext_vector_type(2)));
typedef __bf16 bf16x2_t __attribute__((ext_vector_type(2)));
__device__ __forceinline__ unsigned pkbf(float lo, float hi) { f32x2 v = {lo, hi}; bf16x2_t b = __builtin_convertvector(v, bf16x2_t); return __builtin_bit_cast(unsigned, b); }
__device__ __forceinline__ float bflo(unsigned w) { return __uint_as_float(w << 16); }
__device__ __forceinline__ float bfhi(unsigned w) { return __uint_as_float(w & 0xffff0000u); }
__device__ __forceinline__ float sigm(float x) { return 1.0f / (1.0f + __expf(-x)); }
template <class Fn> struct Epi8 {
    static constexpr bool PERM = true, AFTER_DRAIN = false; Fn f;
    __device__ __forceinline__ void operator()(const f32x4 (&acc)[2][2][4][2], const Unit& u, int wr, int wc, int fr, int fq) const {
        const int row0 = u.pm * BM + wr * 64 + fr, col0 = u.pn * BM + wc * 32 + 8 * fq;
#pragma unroll
        for (int ai = 0; ai < 2; ++ai)
#pragma unroll
            for (int m = 0; m < 4; ++m)
#pragma unroll
                for (int bj = 0; bj < 2; ++bj) { f(row0 + ai * HALF + m * 16, col0 + bj * HALF, acc[ai][bj][m][0], acc[ai][bj][m][1]); asm volatile("" ::: "memory"); }
    }
};
__device__ __forceinline__ void st8bf(bf16_t* p, f32x4 v0, f32x4 v1) { u32x4 w; w.x = pkbf(v0[0], v0[1]); w.y = pkbf(v0[2], v0[3]); w.z = pkbf(v1[0], v1[1]); w.w = pkbf(v1[2], v1[3]); *(u32x4*)p = w; }
struct FnP1 { bf16_t* O;
    __device__ __forceinline__ void operator()(int row, int col, f32x4 v0, f32x4 v1) const {
        if (col >= 3072) {
            if (col < 3136) {
#pragma unroll
                for (int j = 0; j < 4; ++j) { v0[j] = 1.0f - 2.0f / (__expf(2.0f * v0[j]) + 1.0f); v1[j] = 1.0f - 2.0f / (__expf(2.0f * v1[j]) + 1.0f); } }
            else if (col >= 3232 && col < 3392) {
#pragma unroll
                for (int j = 0; j < 4; ++j) { v0[j] = sigm(v0[j]); v1[j] = sigm(v1[j]); } }
        }
        st8bf(O + (size_t)row * 3584 + col, v0, v1); } };
struct FnP2 { bf16_t* O; const float* bias;
    __device__ __forceinline__ void operator()(int row, int col, f32x4 v0, f32x4 v1) const {
        const f32x4 b0 = *(const f32x4*)(bias + col), b1 = *(const f32x4*)(bias + col + 4);
        const float sc = col < 1024 ? -0.60653065971f : 1.0f;
#pragma unroll
        for (int j = 0; j < 4; ++j) { v0[j] = sc * sigm(v0[j] + b0[j]); v1[j] = sc * sigm(v1[j] + b1[j]); }
        st8bf(O + (size_t)row * 3072 + col, v0, v1); } };
struct FnGate { bf16_t* Y; int ld;
    __device__ __forceinline__ void operator()(int row, int col, f32x4 v0, f32x4 v1) const {
        bf16_t* p = Y + (size_t)row * ld + col; const u32x4 y = *(const u32x4*)p;
        v0[0] *= bflo(y.x); v0[1] *= bfhi(y.x); v0[2] *= bflo(y.y); v0[3] *= bfhi(y.y); v1[0] *= bflo(y.z); v1[1] *= bfhi(y.z); v1[2] *= bflo(y.w); v1[3] *= bfhi(y.w);
        st8bf(p, v0, v1); } };
struct FnRes { const float* xin; float* xout; const float* gate;
    __device__ __forceinline__ void operator()(int row, int col, f32x4 v0, f32x4 v1) const {
        const float* gp = gate + (row >> 13) * 6144 + col; const f32x4 g0 = *(const f32x4*)gp, g1 = *(const f32x4*)(gp + 4);
        const size_t off = (size_t)row * 1024 + col; const f32x4 x0 = *(const f32x4*)(xin + off), x1 = *(const f32x4*)(xin + off + 4);
        *(f32x4*)(xout + off) = x0 + (g0 + 1.0f) * v0; *(f32x4*)(xout + off + 4) = x1 + (g1 + 1.0f) * v1; } };
struct FnUp { bf16_t* O;
    __device__ __forceinline__ void operator()(int row, int col, f32x4 v0, f32x4 v1) const {
#pragma unroll
        for (int j = 0; j < 4; ++j) { const float a = fmaxf(v0[j], 0.f), b = fmaxf(v1[j], 0.f); v0[j] = a * a; v1[j] = b * b; }
        st8bf(O + (size_t)row * 4096 + col, v0, v1); } };
struct FnKv { bf16_t* O; float* FL;
    __device__ __forceinline__ void operator()(int row, int col, f32x4 v0, f32x4 v1) const {
        if (col < 2048) st8bf(O + (size_t)row * 2048 + col, v0, v1);
        else if (col < 2064) { float* p = FL + (size_t)row * 16 + (col - 2048); *(f32x4*)p = v0; *(f32x4*)(p + 4) = v1; } } };
struct FnQg { bf16_t* Q; bf16_t* G;
    __device__ __forceinline__ void operator()(int row, int col, f32x4 v0, f32x4 v1) const {
        if (col < 1024) st8bf(Q + (size_t)row * 1024 + col, v0, v1);
        else {
#pragma unroll
            for (int j = 0; j < 4; ++j) { v0[j] = sigm(v0[j]); v1[j] = sigm(v1[j]); }
            st8bf(G + (size_t)row * 1024 + (col - 1024), v0, v1); } } };
template <class Epi, class Sched, bool ALIGN_EPI = false, bool SP2 = false>
__device__ __forceinline__ void gemm_phase(PG8_LAS unsigned char* lds, const Gemm g, const Sched& S, const Epi& E) {
    int tid_l = threadIdx.x; asm volatile("" : "+v"(tid_l));
    const int tid = tid_l, wid = __builtin_amdgcn_readfirstlane(tid >> 6), lane = tid & 63, wr = wid >> 2, wc = wid & 3, fr = lane & 15, fq = lane >> 4;
    const int K = g.K, nt = K / BK;
    unsigned voffA[2], voffB[2];
#pragma unroll
    for (int i = 0; i < 2; ++i) { int R, C; stage_rc(tid * 16 + i * 8192, R, C); const int Rb = Epi::PERM ? ((R & ~31) + perm32(R & 31)) : R;
        voffA[i] = (unsigned)(R * g.lda + C) * 2u; voffB[i] = (unsigned)(Rb * g.ldb + C) * 2u; }
    const size_t kstep = (size_t)(BK * 2);
    const size_t hstepA = (size_t)HALF * g.lda * 2, hstepB = (size_t)HALF * g.ldb * 2;
    const size_t tstepA = 2 * hstepA, tstepB = 2 * hstepB;
    const unsigned ldsw = (unsigned)wid * 1024u;
    const int aoff = lds_byte(wr * 64 + fr, fq * 8), boff = lds_byte(wc * 32 + fr, fq * 8);
#define PG8_SA(b, h) (((b) * 2 + (h)) * HTB)
#define PG8_SB(b, h) ((4 + (b) * 2 + (h)) * HTB)
#define PG8_STAGE(bufoff, gbase, voff) do { _Pragma("unroll") for (int _i = 0; _i < 2; ++_i) \
        __builtin_amdgcn_global_load_lds((const unsigned*)((const char*)(gbase) + (voff)[_i]), (PG8_LAS unsigned*)(lds + (bufoff) + ldsw + _i * 8192), 16, 0, 0); } while (0)
#define PG8_LDA(dst, b, h) do { _Pragma("unroll") for (int m = 0; m < 4; ++m) _Pragma("unroll") for (int k = 0; k < 2; ++k) dst[m][k] = *(const PG8_LAS bf16x8*)(lds + PG8_SA(b, h) + aoff + m * 2048 + k * 1024); } while (0)
#define PG8_LDB(dst, b, h) do { _Pragma("unroll") for (int n = 0; n < 2; ++n) _Pragma("unroll") for (int k = 0; k < 2; ++k) dst[n][k] = *(const PG8_LAS bf16x8*)(lds + PG8_SB(b, h) + boff + n * 2048 + k * 1024); } while (0)
#define PG8_MMA(ai, bj, At, Bt) do { __builtin_amdgcn_s_setprio(1); _Pragma("unroll") for (int m = 0; m < 4; ++m) _Pragma("unroll") for (int n = 0; n < 2; ++n) _Pragma("unroll") for (int k = 0; k < 2; ++k) \
        acc[ai][bj][m][n] = __builtin_amdgcn_mfma_f32_16x16x32_bf16(Bt[n][k], At[m][k], acc[ai][bj][m][n], 0, 0, 0); __builtin_amdgcn_s_setprio(0); } while (0)
#define PG8_WAIT_V(n) asm volatile("s_waitcnt vmcnt(" #n ")" ::: "memory")
#define PG8_WAIT_L(n) asm volatile("s_waitcnt lgkmcnt(" #n ")" ::: "memory")
#define PG8_BAR __builtin_amdgcn_s_barrier()
#define PG8_SCHED __builtin_amdgcn_sched_barrier(0)
    Unit cur, nxt; int ui = 0;
    if (!S.next(0, cur)) return;
    f32x4 acc[2][2][4][2];
#pragma unroll
    for (int a = 0; a < 2; ++a)
#pragma unroll
        for (int b = 0; b < 2; ++b)
#pragma unroll
            for (int m = 0; m < 4; ++m)
#pragma unroll
                for (int n = 0; n < 2; ++n) acc[a][b][m][n] = (f32x4){0.f, 0.f, 0.f, 0.f};
    bf16x8 At[4][2], B0[2][2], B1[2][2];
    const char* cA = (const char*)g.A + (size_t)cur.pm * tstepA; const char* cB = (const char*)g.Bt + (size_t)cur.pn * tstepB;
    S.a_ready(cur);
    if constexpr (SP2) {
        PG8_STAGE(PG8_SB(0, 0), cB, voffB); PG8_STAGE(PG8_SB(0, 1), cB + hstepB, voffB); PG8_STAGE(PG8_SA(0, 0), cA, voffA); PG8_STAGE(PG8_SA(0, 1), cA + hstepA, voffA);
        if (wr == 1) PG8_BAR;
        PG8_WAIT_V(2); PG8_BAR;
        PG8_STAGE(PG8_SB(1, 0), cB + kstep, voffB); PG8_STAGE(PG8_SA(1, 0), cA + kstep, voffA); PG8_STAGE(PG8_SB(1, 1), cB + hstepB + kstep, voffB);
        PG8_WAIT_V(6); PG8_BAR;
    } else {
        PG8_STAGE(PG8_SB(0, 0), cB, voffB); PG8_STAGE(PG8_SA(0, 0), cA, voffA); PG8_STAGE(PG8_SB(0, 1), cB + hstepB, voffB); PG8_STAGE(PG8_SA(0, 1), cA + hstepA, voffA);
        if (wr == 1) PG8_BAR;
        PG8_WAIT_V(4); PG8_BAR;
        PG8_STAGE(PG8_SB(1, 0), cB + kstep, voffB); PG8_STAGE(PG8_SA(1, 0), cA + kstep, voffA); PG8_STAGE(PG8_SB(1, 1), cB + hstepB + kstep, voffB);
        PG8_WAIT_V(6); PG8_BAR;
    }
    for (;;) {
        const bool has_next = S.next(ui + 1, nxt);
        const char* nA = has_next ? (const char*)g.A + (size_t)nxt.pm * tstepA : cA; const char* nB = has_next ? (const char*)g.Bt + (size_t)nxt.pn * tstepB : cB;
        for (int t = 0; t < nt; t += 2) {
            const bool last = (t == nt - 2);
            const char* a1 = cA + (size_t)(t + 1) * kstep;
            const char* a2 = last ? nA : cA + (size_t)(t + 2) * kstep; const char* b2 = last ? nB : cB + (size_t)(t + 2) * kstep;
            const char* a3 = a2 + kstep; const char* b3 = b2 + kstep;
            if (last && has_next) S.a_ready(nxt);
            if constexpr (SP2) {
            PG8_LDB(B0, 0, 0); PG8_LDB(B1, 0, 1); PG8_SCHED; PG8_LDA(At, 0, 0); PG8_STAGE(PG8_SA(1, 1), a1 + hstepA, voffA);
            PG8_WAIT_V(8); PG8_WAIT_L(0); PG8_BAR; PG8_MMA(0, 0, At, B0); PG8_MMA(0, 1, At, B1); PG8_BAR; PG8_SCHED;
            PG8_LDA(At, 0, 1); PG8_STAGE(PG8_SB(0, 0), b2, voffB); PG8_STAGE(PG8_SB(0, 1), b2 + hstepB, voffB); PG8_STAGE(PG8_SA(0, 0), a2, voffA);
            PG8_WAIT_V(8); PG8_WAIT_L(0); PG8_BAR; PG8_MMA(1, 0, At, B0); PG8_MMA(1, 1, At, B1); PG8_BAR; PG8_SCHED;
            PG8_LDB(B0, 1, 0); PG8_LDB(B1, 1, 1); PG8_SCHED; PG8_LDA(At, 1, 0); PG8_STAGE(PG8_SA(0, 1), a2 + hstepA, voffA);
            PG8_WAIT_V(8); PG8_WAIT_L(0); PG8_BAR; PG8_MMA(0, 0, At, B0); PG8_MMA(0, 1, At, B1); PG8_BAR; PG8_SCHED;
            PG8_LDA(At, 1, 1); PG8_STAGE(PG8_SB(1, 0), b3, voffB); PG8_STAGE(PG8_SB(1, 1), b3 + hstepB, voffB); PG8_STAGE(PG8_SA(1, 0), a3, voffA);
            PG8_WAIT_V(8); PG8_WAIT_L(0); PG8_BAR; PG8_MMA(1, 0, At, B0); PG8_MMA(1, 1, At, B1); PG8_BAR; PG8_SCHED;
            } else {
            PG8_LDB(B0, 0, 0); PG8_SCHED; PG8_LDA(At, 0, 0); PG8_STAGE(PG8_SA(1, 1), a1 + hstepA, voffA);
            PG8_WAIT_L(8); PG8_BAR; PG8_WAIT_L(0); PG8_MMA(0, 0, At, B0); PG8_BAR; PG8_SCHED;
            PG8_LDB(B1, 0, 1); PG8_STAGE(PG8_SB(0, 0), b2, voffB);
            PG8_BAR; PG8_WAIT_L(0); PG8_MMA(0, 1, At, B1); PG8_BAR;
            PG8_LDA(At, 0, 1); PG8_STAGE(PG8_SA(0, 0), a2, voffA);
            PG8_BAR; PG8_WAIT_L(0); PG8_MMA(1, 0, At, B0); PG8_BAR; PG8_SCHED;
            PG8_STAGE(PG8_SB(0, 1), b2 + hstepB, voffB);
            PG8_WAIT_V(6); PG8_BAR; PG8_MMA(1, 1, At, B1); PG8_BAR;
            PG8_LDB(B0, 1, 0); PG8_SCHED; PG8_LDA(At, 1, 0); PG8_STAGE(PG8_SA(0, 1), a2 + hstepA, voffA);
            PG8_WAIT_L(8); PG8_BAR; PG8_WAIT_L(0); PG8_MMA(0, 0, At, B0); PG8_BAR; PG8_SCHED;
            PG8_LDB(B1, 1, 1); PG8_STAGE(PG8_SB(1, 0), b3, voffB);
            PG8_BAR; PG8_WAIT_L(0); PG8_MMA(0, 1, At, B1); PG8_BAR;
            PG8_LDA(At, 1, 1); PG8_STAGE(PG8_SA(1, 0), a3, voffA);
            PG8_BAR; PG8_WAIT_L(0); PG8_MMA(1, 0, At, B0); PG8_BAR; PG8_SCHED;
            PG8_STAGE(PG8_SB(1, 1), b3 + hstepB, voffB);
            PG8_WAIT_V(6); PG8_BAR; PG8_MMA(1, 1, At, B1); PG8_BAR;
            }
        }
        if constexpr (ALIGN_EPI) { if (wr == 0) PG8_BAR; }
        if constexpr (!Epi::AFTER_DRAIN) { E(acc, cur, wr, wc, fr, fq); S.done(cur); }
        if (!has_next) break;
#pragma unroll
        for (int a = 0; a < 2; ++a)
#pragma unroll
            for (int b = 0; b < 2; ++b)
#pragma unroll
                for (int m = 0; m < 4; ++m)
#pragma unroll
                    for (int n = 0; n < 2; ++n) acc[a][b][m][n] = (f32x4){0.f, 0.f, 0.f, 0.f};
        cur = nxt; cA = nA; cB = nB; ++ui;
        if constexpr (ALIGN_EPI) { if (wr == 1) PG8_BAR; }
    }
    PG8_WAIT_V(0);
    if constexpr (!ALIGN_EPI) { if (wr == 0) PG8_BAR; }
    PG8_BAR;
    if constexpr (Epi::AFTER_DRAIN) { E.fused(acc, cur, wr, wc, fr, fq, lds, wid, lane); S.done(cur); }
#undef PG8_SA
#undef PG8_SB
#undef PG8_STAGE
#undef PG8_LDA
#undef PG8_LDB
#undef PG8_MMA
#undef PG8_WAIT_V
#undef PG8_WAIT_L
#undef PG8_BAR
#undef PG8_SCHED
}
}
#include <hip/hip_bf16.h>
#include <cmath>
namespace attn_body {
using bf16=__hip_bfloat16;
using bf16x8=__attribute__((ext_vector_type(8)))short;
using s16x4=__attribute__((ext_vector_type(4)))short;
using f32x16=__attribute__((ext_vector_type(16)))float;
using u32x4=__attribute__((ext_vector_type(4)))unsigned;
constexpr int BATCH=2,NHEAD=16,SEQ=8192,D=64,DM=NHEAD*D;
constexpr int NW=8,QBLK=32,QB=QBLK*NW,KVBLK=64,NQB=SEQ/QB;
constexpr int ATTN_PITCH=DM, ATTN_UNIT_ROWS=QB;
__device__ __forceinline__ int crow(int r,int hi){return (r&3)+8*(r>>2)+4*hi;}
#define SBAR() __builtin_amdgcn_sched_barrier(0)
__device__ __forceinline__ void cmask(f32x16&p0,f32x16&p1,int jb,int qrel,int hi){
  const float NEG=-INFINITY; int kb=64*jb+4*hi;
  #pragma unroll
  for(int r=0;r<16;++r){int kv=kb+(r&3)+8*(r>>2); if(kv>qrel)p0[r]=NEG; if(kv+32>qrel)p1[r]=NEG;}
}

constexpr int NSLOT=3, SLOTB=9216;
constexpr int LDS_K=0, LDS_V=NSLOT*SLOTB, LDS_WS=2*NSLOT*SLOTB, LDS_OST=LDS_WS+NW*64*4, LDS_BYTES=LDS_OST+NW*4096;
constexpr float C2=0.125f*1.4426950408889634f;
__device__ __forceinline__ void glds16(const void*gsrc,unsigned lds_dst){unsigned keep;
  asm volatile("s_mov_b32 %0, m0\n\ts_mov_b32 m0, %2\n\ts_nop 0\n\tglobal_load_lds_dwordx4 %1, off\n\ts_mov_b32 m0, %0":"=&s"(keep):"v"(gsrc),"s"(lds_dst):"memory");}
__device__ __forceinline__ float max3f(float a,float b,float c){float r;asm("v_max3_f32 %0, %1, %2, %3":"=v"(r):"v"(a),"v"(b),"v"(c));return r;}
__device__ __forceinline__ float max2f(float a,float b){float r;asm("v_max_f32_e32 %0, %1, %2":"=v"(r):"v"(a),"v"(b));return r;}
__device__ __forceinline__ float fadd_s(float a,float b){float r;asm("v_add_f32_e32 %0, %1, %2":"=v"(r):"v"(a),"v"(b));return r;}
__device__ __forceinline__ float fsub_s(float a,float b){float r;asm("v_sub_f32_e32 %0, %1, %2":"=v"(r):"v"(a),"v"(b));return r;}
typedef float f32x2_t __attribute__((ext_vector_type(2))); typedef __bf16 bf16x2_t __attribute__((ext_vector_type(2)));
__device__ __forceinline__ unsigned cvtpk_s(float lo,float hi){f32x2_t v={lo,hi};bf16x2_t b=__builtin_convertvector(v,bf16x2_t);return __builtin_bit_cast(unsigned,b);}
#define WAIT_BAR(N) asm volatile("s_waitcnt vmcnt(" #N ") lgkmcnt(0)\n\ts_barrier":::"memory")
#define WAIT_BARW() do{ if(wid==0){WAIT_BAR(3);} else {WAIT_BAR(2);} }while(0)

__device__ __forceinline__ void qkt(f32x16&p0,f32x16&p1,const char*Kslot,const bf16x8*qr,const bf16x8 qe,const f32x16&negm,int r32,int hi){
  const char*kb=Kslot+hi*1024+r32*16;
  #pragma unroll
  for(int d0=0;d0<4;++d0){
    const bf16x8 b0=*reinterpret_cast<const bf16x8*>(kb+d0*2048);
    const bf16x8 b1=*reinterpret_cast<const bf16x8*>(kb+d0*2048+512);
    if(d0==0){p0=__builtin_amdgcn_mfma_f32_32x32x16_bf16(b0,qr[0],negm,0,0,0);p1=__builtin_amdgcn_mfma_f32_32x32x16_bf16(b1,qr[0],negm,0,0,0);}
    else{p0=__builtin_amdgcn_mfma_f32_32x32x16_bf16(b0,qr[d0],p0,0,0,0);p1=__builtin_amdgcn_mfma_f32_32x32x16_bf16(b1,qr[d0],p1,0,0,0);}}
  { const char*ke=Kslot+8192+r32*16; const bf16x8 e0=*reinterpret_cast<const bf16x8*>(ke),e1=*reinterpret_cast<const bf16x8*>(ke+512);
    p0=__builtin_amdgcn_mfma_f32_32x32x16_bf16(e0,qe,p0,0,0,0);p1=__builtin_amdgcn_mfma_f32_32x32x16_bf16(e1,qe,p1,0,0,0);}
}
typedef __attribute__((address_space(3))) const char* lds_cptr;
typedef short v4i16_t __attribute__((ext_vector_type(4)));
__device__ __forceinline__ void kload8(bf16x8*kf,lds_cptr kp){
  kf[0]=*(const __attribute__((address_space(3))) bf16x8*)(kp);      kf[1]=*(const __attribute__((address_space(3))) bf16x8*)(kp+512);
  kf[2]=*(const __attribute__((address_space(3))) bf16x8*)(kp+2048); kf[3]=*(const __attribute__((address_space(3))) bf16x8*)(kp+2560);
  kf[4]=*(const __attribute__((address_space(3))) bf16x8*)(kp+4096); kf[5]=*(const __attribute__((address_space(3))) bf16x8*)(kp+4608);
  kf[6]=*(const __attribute__((address_space(3))) bf16x8*)(kp+6144); kf[7]=*(const __attribute__((address_space(3))) bf16x8*)(kp+6656);
}
__device__ __forceinline__ void kload2(bf16x8*kf,lds_cptr kp,int j){ kf[2*j]=*(const __attribute__((address_space(3))) bf16x8*)(kp+j*2048); kf[2*j+1]=*(const __attribute__((address_space(3))) bf16x8*)(kp+j*2048+512); }
__device__ __forceinline__ s16x4 vtr(lds_cptr p){ return __builtin_bit_cast(s16x4,__builtin_amdgcn_ds_read_tr16_b64_v4i16((__attribute__((address_space(3))) v4i16_t*)p)); }
__device__ __forceinline__ float rowmax(const f32x16&p0,const f32x16&p1){
  float a=max3f(p0[0],p0[1],p1[0]),b=max3f(p0[2],p0[3],p1[1]);a=max3f(a,p1[2],p1[3]);
  #pragma unroll
  for(int r=4;r<16;r+=4){a=max3f(a,p0[r],p0[r+1]);b=max3f(b,p0[r+2],p0[r+3]);a=max3f(a,p1[r],p1[r+1]);b=max3f(b,p1[r+2],p1[r+3]);}
  const float m=max2f(a,b);
  auto rr=__builtin_amdgcn_permlane32_swap(__float_as_uint(m),__float_as_uint(m),false,false);
  return max2f(__uint_as_float(rr[0]),__uint_as_float(rr[1]));
}
__device__ __forceinline__ void pv(f32x16*o,int vb,bf16x8 pa0,bf16x8 pa1,bf16x8 pa2,bf16x8 pa3){
  #pragma unroll
  for(int d0=0;d0<2;++d0){s16x4 lo[4],hi[4];
    #pragma unroll
    for(int ks=0;ks<4;++ks){
      asm volatile("ds_read_b64_tr_b16 %0,%1 offset:%c2":"=&v"(lo[ks]):"v"(vb),"i"(d0*4096+ks*1024):"memory");
      asm volatile("ds_read_b64_tr_b16 %0,%1 offset:%c2":"=&v"(hi[ks]):"v"(vb),"i"(d0*4096+ks*1024+512):"memory");}
    asm volatile("s_waitcnt lgkmcnt(0)":::"memory");SBAR();
    #define PK(k) (bf16x8){lo[k][0],lo[k][1],lo[k][2],lo[k][3],hi[k][0],hi[k][1],hi[k][2],hi[k][3]}
    o[d0]=__builtin_amdgcn_mfma_f32_32x32x16_bf16(pa0,PK(0),o[d0],0,0,0);
    o[d0]=__builtin_amdgcn_mfma_f32_32x32x16_bf16(pa1,PK(1),o[d0],0,0,0);
    o[d0]=__builtin_amdgcn_mfma_f32_32x32x16_bf16(pa2,PK(2),o[d0],0,0,0);
    o[d0]=__builtin_amdgcn_mfma_f32_32x32x16_bf16(pa3,PK(3),o[d0],0,0,0);
    #undef PK
  }
}

#ifndef ATTN_STORE16
#define ATTN_STORE16(p,v) (*(u32x4*)(p)=(v))
#endif
template<int THRL> __device__ __forceinline__ void attn_unit(int b,int h,int qb,const bf16*Q,const bf16*__restrict__ K,const bf16*__restrict__ V,bf16*O,const bf16*__restrict__ GT,const unsigned char*__restrict__ G3,const float*__restrict__ qgain,char*shm){
  int tid_l=threadIdx.x; asm volatile("":"+v"(tid_l)); const int tid=tid_l,lane=tid&63,r32=lane&31,hi=lane>>5; const int wid=__builtin_amdgcn_readfirstlane(tid>>6);
  const long rowbase=(long)b*SEQ; const int q0=qb*QB;
  const bf16*Qw=Q+(rowbase+q0+wid*QBLK)*DM+h*D;
  const bf16*Kh=K+rowbase*DM+h*D,*Vh=V+rowbase*DM+h*D;
  const unsigned lds0=(unsigned)(uintptr_t)shm;
  float*wsf=(float*)(shm+LDS_WS)+wid*64;
  const bf16*ksrc=Kh+(long)lane*DM+wid*8;
  const bf16*vsrc=Vh+(long)(16*(wid&3)+(lane>>2))*DM+(wid>>2)*32+(lane&3)*8;
  const unsigned kdst=lds0+LDS_K+wid*1024, vdst=lds0+LDS_V+wid*1024, gdst=lds0+LDS_K+8192;
  const unsigned char*gsrc=G3+((long)(b*NHEAD+h)*SEQ+lane)*16;
  #define DMA_K(t,slot) do{ if(wid==0)glds16(gsrc+(long)(t)*KVBLK*16,(unsigned)__builtin_amdgcn_readfirstlane(gdst+(slot))); glds16(ksrc+(long)(t)*KVBLK*DM,(unsigned)__builtin_amdgcn_readfirstlane(kdst+(slot))); }while(0)
  #define DMA_V(t,slot) glds16(vsrc+(long)(t)*KVBLK*DM,(unsigned)__builtin_amdgcn_readfirstlane(vdst+(slot)))
  const int vb0=(int)(lds0+LDS_V)+((lane>>4)&1)*32+(lane&3)*8+(4*hi+((lane&15)>>2))*64;
  const char*Kbase=shm+LDS_K; bf16x8 kf[10];
  const lds_cptr shm3=(lds_cptr)shm; const lds_cptr kp0=shm3+LDS_K+hi*1024+r32*16; const lds_cptr kpe=shm3+LDS_K+8192+r32*16; const lds_cptr vp0=shm3+LDS_V+((lane>>4)&1)*32+(lane&3)*8+(4*hi+((lane&15)>>2))*64;
  const int NT=(q0+QB)/KVBLK;
  DMA_K(0,0);DMA_V(0,0);DMA_K(1,SLOTB);
  bf16x8 qr[4]; float fq2; bf16x8 qe;
  { bf16x8 qraw[4];
    #pragma unroll
    for(int d0=0;d0<4;++d0)qraw[d0]=*reinterpret_cast<const bf16x8*>(&Qw[(long)r32*DM+d0*16+hi*8]);
    const u32x4 ge=*reinterpret_cast<const u32x4*>(G3+((long)(b*NHEAD+h)*SEQ+q0+wid*QBLK+r32)*16);
    fq2=-(__uint_as_float(ge[0]<<16)+__uint_as_float(ge[0]&0xffff0000u)+__uint_as_float(ge[1]<<16));
    float ss=0.f;
    #pragma unroll
    for(int d0=0;d0<4;++d0)
      #pragma unroll
      for(int j=0;j<8;++j){const float x=__uint_as_float(((unsigned)(unsigned short)qraw[d0][j])<<16);ss+=x*x;}
    {auto rr=__builtin_amdgcn_permlane32_swap(__float_as_uint(ss),__float_as_uint(ss),false,false);ss=__uint_as_float(rr[0])+__uint_as_float(rr[1]);}
    const float qs=C2/sqrtf(ss*(1.0f/64.0f)+1e-6f);
    #pragma unroll
    for(int d0=0;d0<4;++d0){ u32x4 w;
      #pragma unroll
      for(int j=0;j<8;j+=2){const float x0=__uint_as_float(((unsigned)(unsigned short)qraw[d0][j])<<16),x1=__uint_as_float(((unsigned)(unsigned short)qraw[d0][j+1])<<16);
        w[j>>1]=cvtpk_s(x0*qs*qgain[d0*16+hi*8+j],x1*qs*qgain[d0*16+hi*8+j+1]);}
      qr[d0]=__builtin_bit_cast(bf16x8,w);}
    const unsigned one2=hi?0u:0x3f803f80u, one1=hi?0u:0x00003f80u; qe=__builtin_bit_cast(bf16x8,(u32x4){one2,one1,0u,0u}); }
  float mhat=0.f,l_reg=0.f;f32x16 o[2];o[0]=f32x16{};o[1]=f32x16{};f32x16 negm;
  #pragma unroll
  for(int r=0;r<16;++r)negm[r]=fq2;
  asm volatile("":"+v"(negm));
  const int qrel=wid*QBLK+r32;
  #define CMASK(P0,P1,t) do{int jb_=(t)-(NT-4); if(jb_>=0)cmask(P0,P1,jb_,qrel,hi);}while(0)
  bool resc=false;
  #define START(P0,P1) do{ const float rm=rowmax(P0,P1); resc=false; \
    { const float dl=rm; mhat=fadd_s(mhat,dl); \
      _Pragma("unroll") for(int r=0;r<16;++r){P0[r]=fsub_s(P0[r],dl);P1[r]=fsub_s(P1[r],dl);} \
      _Pragma("unroll") for(int r=0;r<16;++r)negm[r]=fq2-mhat; asm volatile("":"+v"(negm)); } \
    _Pragma("unroll") for(int r=0;r<16;++r)P0[r]=__builtin_amdgcn_exp2f(P0[r]); }while(0)
  #define RESC() do{ if(resc){ asm volatile("s_waitcnt lgkmcnt(0)":::"memory"); \
      _Pragma("unroll") for(int d_=0;d_<2;++d_) _Pragma("unroll") for(int r=0;r<16;++r)o[d_][r]*=wsf[crow(r,hi)]; } }while(0)
  f32x16 pA0,pA1,pB0,pB1;
  int sl_prev=0,sl_cur=0,sl_next=SLOTB;
  #define ROT() do{sl_prev=sl_cur;sl_cur=sl_next;sl_next=(sl_next==(NSLOT-1)*SLOTB)?0:sl_next+SLOTB;}while(0)
  DMA_K(2,2*SLOTB);
  WAIT_BAR(3);
  qkt(pA0,pA1,Kbase,qr,qe,negm,r32,hi);asm volatile("s_nop 15\n\ts_nop 7":"+v"(pA0),"+v"(pA1));CMASK(pA0,pA1,0);
  START(pA0,pA1);
  _Pragma("unroll") for(int r=0;r<16;++r)pA1[r]=__builtin_amdgcn_exp2f(pA1[r]);
  WAIT_BAR(0);
  DMA_K(3,0);DMA_V(1,SLOTB);
  ROT();
  kload8(kf,kp0+sl_cur);
  kf[8]=*(const __attribute__((address_space(3))) bf16x8*)(kpe+sl_cur); kf[9]=*(const __attribute__((address_space(3))) bf16x8*)(kpe+sl_cur+512);
  WAIT_BARW();
  s16x4 vlo[8],vhi[8]; u32x4 pw0,pw1,pw2,pw3;
  #define PKW(P,B) cvtpk_s(P[B],P[B+1])
  #define PAF(k) __builtin_bit_cast(bf16x8,pw##k)
  #define VFR(i) (bf16x8){vlo[i][0],vlo[i][1],vlo[i][2],vlo[i][3],vhi[i][0],vhi[i][1],vhi[i][2],vhi[i][3]}
  #define PIN(x) asm volatile("":"+v"(x))
  #define MX3(a,b,c) __builtin_fmaxf(__builtin_fmaxf((a),(b)),(c))
  #define GAPA(MF,A0,A1,A2,A3,W0,W1,PW) do{ MF; sacc+=A0; sacc+=A1; sacc+=A2; sacc+=A3; PIN(sacc); W0; W1; PIN(PW); SBAR(); }while(0)
  #define EX(v) __builtin_amdgcn_exp2f(v)
  #define GAPB(MF,X,B) do{ MF; X[B]=EX(X[B]); X[B+1]=EX(X[B+1]); X[B+2]=EX(X[B+2]); X[B+3]=EX(X[B+3]); PIN(X); SBAR(); }while(0)
  #define VRD(i) do{ vlo[i]=vtr(vp_+(((i)>>2)*4096+((i)&3)*1024)); vhi[i]=vtr(vp_+(((i)>>2)*4096+((i)&3)*1024+512)); }while(0)
  #define KRD(G,j) do{ if(G){ kload2(kf,kp0+sl_next,j); SBAR(); } }while(0)
  #define STEP(C0,C1,P0,P1,t,GK,GV,GL) do{ SBAR(); \
    const lds_cptr vp_=vp0+sl_prev; \
    VRD(0); SBAR(); float sacc=(P0[0]+P0[1]); \
    GAPA(C0=__builtin_amdgcn_mfma_f32_32x32x16_bf16(kf[0],qr[0],negm,0,0,0), P0[2],P0[3],P0[4],P0[5],     pw0[0]=PKW(P0,0), pw0[1]=PKW(P0,2), pw0); \
    VRD(4); SBAR(); GAPA(C1=__builtin_amdgcn_mfma_f32_32x32x16_bf16(kf[1],qr[0],negm,0,0,0), P0[6],P0[7],P0[8],P0[9],     pw0[2]=PKW(P0,4), pw0[3]=PKW(P0,6), pw0); \
    VRD(1); SBAR(); GAPA(C0=__builtin_amdgcn_mfma_f32_32x32x16_bf16(kf[2],qr[1],C0,0,0,0),   P0[10],P0[11],P0[12],P0[13], pw1[0]=PKW(P0,8), pw1[1]=PKW(P0,10), pw1); \
    VRD(5); SBAR(); GAPA(C1=__builtin_amdgcn_mfma_f32_32x32x16_bf16(kf[3],qr[1],C1,0,0,0),   P0[14],P0[15],P1[0],P1[1],   pw1[2]=PKW(P0,12),pw1[3]=PKW(P0,14), pw1); \
    VRD(2); SBAR(); GAPA(C0=__builtin_amdgcn_mfma_f32_32x32x16_bf16(kf[4],qr[2],C0,0,0,0),   P1[2],P1[3],P1[4],P1[5],     pw2[0]=PKW(P1,0), pw2[1]=PKW(P1,2), pw2); \
    VRD(6); SBAR(); GAPA(C1=__builtin_amdgcn_mfma_f32_32x32x16_bf16(kf[5],qr[2],C1,0,0,0),   P1[6],P1[7],P1[8],P1[9],     pw2[2]=PKW(P1,4), pw2[3]=PKW(P1,6), pw2); \
    VRD(3); SBAR(); GAPA(C0=__builtin_amdgcn_mfma_f32_32x32x16_bf16(kf[6],qr[3],C0,0,0,0),   P1[10],P1[11],P1[12],P1[13], pw3[0]=PKW(P1,8), pw3[1]=PKW(P1,10), pw3); \
    VRD(7); SBAR(); GAPA(C1=__builtin_amdgcn_mfma_f32_32x32x16_bf16(kf[7],qr[3],C1,0,0,0),   P1[14],P1[15],0.f,0.f,       pw3[2]=PKW(P1,12),pw3[3]=PKW(P1,14), pw3); \
    C0=__builtin_amdgcn_mfma_f32_32x32x16_bf16(kf[8],qe,C0,0,0,0); C1=__builtin_amdgcn_mfma_f32_32x32x16_bf16(kf[9],qe,C1,0,0,0); \
    l_reg+=sacc; \
    if(GK){DMA_K((t)+3,sl_cur);} if(GV){DMA_V((t)+1,sl_next);} \
    CMASK(C0,C1,t); \
    { float a=MX3(C0[0],C0[1],C1[0]),b=MX3(C0[2],C0[3],C1[1]); a=MX3(a,C1[2],C1[3]); \
      _Pragma("unroll") for(int r=4;r<16;r+=4){a=MX3(a,C0[r],C0[r+1]);b=MX3(b,C0[r+2],C0[r+3]);a=MX3(a,C1[r],C1[r+1]);b=MX3(b,C1[r+2],C1[r+3]);} \
      float rm=__builtin_fmaxf(a,b); { auto rr=__builtin_amdgcn_permlane32_swap(__float_as_uint(rm),__float_as_uint(rm),false,false); rm=__builtin_fmaxf(__uint_as_float(rr[0]),__uint_as_float(rr[1])); } \
      resc=false; \
      if(__builtin_expect(__any(rm>(float)THRL),0)){ const float dl=__builtin_fmaxf(rm,0.f); mhat+=dl; \
        _Pragma("unroll") for(int r=0;r<16;++r){C0[r]-=dl;C1[r]-=dl;} \
        _Pragma("unroll") for(int r=0;r<16;++r)negm[r]=fq2-mhat; asm volatile("":"+v"(negm)); \
        const float f=__builtin_amdgcn_exp2f(-dl); l_reg*=f; if(hi==0)wsf[r32]=f; resc=true; } } \
    SBAR(); \
    GAPB(o[0]=__builtin_amdgcn_mfma_f32_32x32x16_bf16(PAF(0),VFR(0),o[0],0,0,0), C0,0); \
    GAPB(o[1]=__builtin_amdgcn_mfma_f32_32x32x16_bf16(PAF(0),VFR(4),o[1],0,0,0), C0,4); \
    KRD(GL,0); GAPB(o[0]=__builtin_amdgcn_mfma_f32_32x32x16_bf16(PAF(1),VFR(1),o[0],0,0,0), C0,8); \
    KRD(GL,1); GAPB(o[1]=__builtin_amdgcn_mfma_f32_32x32x16_bf16(PAF(1),VFR(5),o[1],0,0,0), C0,12); \
    KRD(GL,2); GAPB(o[0]=__builtin_amdgcn_mfma_f32_32x32x16_bf16(PAF(2),VFR(2),o[0],0,0,0), C1,0); \
    KRD(GL,3); GAPB(o[1]=__builtin_amdgcn_mfma_f32_32x32x16_bf16(PAF(2),VFR(6),o[1],0,0,0), C1,4); \
    if(GL){ kf[8]=*(const __attribute__((address_space(3))) bf16x8*)(kpe+sl_next); kf[9]=*(const __attribute__((address_space(3))) bf16x8*)(kpe+sl_next+512); SBAR(); } \
    GAPB(o[0]=__builtin_amdgcn_mfma_f32_32x32x16_bf16(PAF(3),VFR(3),o[0],0,0,0), C1,8); \
    GAPB(o[1]=__builtin_amdgcn_mfma_f32_32x32x16_bf16(PAF(3),VFR(7),o[1],0,0,0), C1,12); \
    }while(0)
  int t=1;
  #undef CMASK
  #define CMASK(P0,P1,t) do{}while(0)
  for(;t+5<NT;t+=2){
    STEP(pB0,pB1,pA0,pA1,t,true,true,true);     WAIT_BARW(); RESC(); ROT();
    STEP(pA0,pA1,pB0,pB1,t+1,true,true,true);   WAIT_BARW(); RESC(); ROT();
  }
  #undef CMASK
  #define CMASK(P0,P1,t) do{int jb_=(t)-(NT-4); if(jb_>=0)cmask(P0,P1,jb_,qrel,hi);}while(0)
  #define ENDW(tt) do{ if((tt)+3<NT){WAIT_BARW();} else if((tt)+2<NT){WAIT_BAR(1);} else {WAIT_BAR(0);} }while(0)
  for(;t+1<NT;t+=2){
    STEP(pB0,pB1,pA0,pA1,t,(t+3<NT),(t+1<NT),(t+1<NT));       ENDW(t);   RESC(); ROT();
    STEP(pA0,pA1,pB0,pB1,t+1,(t+4<NT),(t+2<NT),(t+2<NT));     ENDW(t+1); RESC(); ROT();
  }
  STEP(pB0,pB1,pA0,pA1,NT-1,false,false,false); RESC();
  { float sacc=pB0[0]+pB0[1]; _Pragma("unroll") for(int r=2;r<16;++r)sacc+=pB0[r]; _Pragma("unroll") for(int r=0;r<16;++r)sacc+=pB1[r]; l_reg+=sacc;
    pw0=(u32x4){PKW(pB0,0),PKW(pB0,2),PKW(pB0,4),PKW(pB0,6)};pw1=(u32x4){PKW(pB0,8),PKW(pB0,10),PKW(pB0,12),PKW(pB0,14)};pw2=(u32x4){PKW(pB1,0),PKW(pB1,2),PKW(pB1,4),PKW(pB1,6)};pw3=(u32x4){PKW(pB1,8),PKW(pB1,10),PKW(pB1,12),PKW(pB1,14)};
    SBAR(); pv(o,vb0+sl_cur,PAF(0),PAF(1),PAF(2),PAF(3)); }
  #undef PKW
  #undef PAF
  #undef VFR
  #undef PIN
  #undef MX3
  #undef GAPA
  #undef GAPB
  #undef EX
  #undef VRD
  #undef KRD
  #undef STEP
  #undef ENDW
  {auto rr=__builtin_amdgcn_permlane32_swap(__float_as_uint(l_reg),__float_as_uint(l_reg),false,false);l_reg=__uint_as_float(rr[0])+__uint_as_float(rr[1]);}
  if(hi==0)wsf[32+r32]=l_reg;asm volatile("s_waitcnt lgkmcnt(0)":::"memory");
  float rli[16];
  #pragma unroll
  for(int r=0;r<16;++r)rli[r]=__builtin_amdgcn_rcpf(wsf[32+crow(r,hi)]);
  bf16*Ow=O+(rowbase+q0+wid*QBLK)*DM+h*D;
  { bf16*stg=(bf16*)(shm+LDS_OST)+wid*2048;
    #pragma unroll
    for(int r=0;r<16;++r){const int orow=crow(r,hi);
      #pragma unroll
      for(int d0=0;d0<2;++d0)stg[orow*64+d0*32+r32]=__float2bfloat16(o[d0][r]*rli[r]);}
    asm volatile("s_waitcnt lgkmcnt(0)":::"memory");
    const bf16*Gw=GT+(rowbase+q0+wid*QBLK)*DM+h*D;
    #pragma unroll
    for(int i=0;i<4;++i){const int row=i*8+(lane>>3),ch=lane&7; u32x4 v=*(const u32x4*)(stg+row*64+ch*8); const u32x4 gg=*(const u32x4*)(Gw+(long)row*DM+ch*8);
      #pragma unroll
      for(int j=0;j<4;++j){ v[j]=cvtpk_s(__uint_as_float(v[j]<<16)*__uint_as_float(gg[j]<<16),__uint_as_float(v[j]&0xffff0000u)*__uint_as_float(gg[j]&0xffff0000u)); }
      ATTN_STORE16(Ow+(long)row*DM+ch*8,v);} }
  asm volatile("s_waitcnt lgkmcnt(0)\n\ts_barrier":::"memory");
  #undef DMA_K
  #undef DMA_V
  #undef CMASK
  #undef START
  #undef RESC
  #undef ROT
}
constexpr int ATTN_LDS_BYTES=LDS_BYTES;
struct AttnTensors { const bf16* Q; const bf16* K; const bf16* V; bf16* O; const bf16* GT; const unsigned char* G3; const float* qgain; };
struct AttnUnit { int bh; int qb; };
struct StaticOrder {
  int vcu;
  __device__ __forceinline__ explicit StaticOrder(int grid,int block):vcu((block%8)*(grid/8)+block/8){}
  __device__ __forceinline__ bool next(int i,AttnUnit&u)const{ if(i>=4)return false; const int s=vcu&7; u.bh=vcu>>3; u.qb=(i==0)?s:(i==1)?15-s:(i==2)?16+s:31-s; return true; }
  __device__ __forceinline__ void a_ready(const AttnUnit&)const{}
  __device__ __forceinline__ void done(const AttnUnit&)const{}
};
template<class Sched,int THRL=8> __device__ __forceinline__ void attn_phase(char*lds,const AttnTensors&T,const Sched&S){
  AttnUnit u;
  for(int i=0;S.next(i,u);++i){ S.a_ready(u); attn_unit<THRL>(u.bh/NHEAD,u.bh%NHEAD,u.qb,T.Q,T.K,T.V,T.O,T.GT,T.G3,T.qgain,lds); S.done(u); }
}
#undef SBAR
#undef WAIT_BAR
#undef WAIT_BARW
}
constexpr int NWAVES = 8;
constexpr int BATCH = 2, T = 8192, D = 1024, H = 16, HD = 64, FF = 4096, M = BATCH * T;
constexpr int N1 = 3584, K1 = 2048, NP2 = 3072;
constexpr size_t MiB = 1u << 20;
constexpr size_t WS_MOD = 0;
constexpr size_t WS_W1 = 1 * MiB;
constexpr size_t WS_W2A = 29 * MiB;
constexpr size_t WS_W2G = 32 * MiB;
constexpr size_t WS_WO = 33 * MiB;
constexpr size_t WS_WKV = 37 * MiB;
constexpr size_t WS_WQG = 42 * MiB;
constexpr size_t WS_WO2 = 50 * MiB;
constexpr size_t WS_WUP = 54 * MiB, WS_WDN = 62 * MiB;
constexpr size_t WS_G3 = 70 * MiB;
constexpr size_t WS_FL = 74 * MiB;
constexpr size_t WS_H2 = 76 * MiB;
constexpr size_t WS_P1 = 140 * MiB;
constexpr size_t WS_P2 = 252 * MiB;
constexpr size_t WS_VF = 348 * MiB;
constexpr size_t WS_HB = 140 * MiB;
constexpr size_t WS_KVRAW = 140 * MiB, WS_QB = 204 * MiB, WS_GT = 236 * MiB, WS_VS = 316 * MiB, WS_KS = 348 * MiB;
constexpr size_t WS_END = 380 * MiB;
constexpr int LDS_BYTES = 147456;

#define GAS __attribute__((address_space(1)))
#define LAS __attribute__((address_space(3)))
typedef unsigned short bf16;
typedef unsigned v4u __attribute__((ext_vector_type(4)));
typedef unsigned v2u __attribute__((ext_vector_type(2)));
typedef float f32x4 __attribute__((ext_vector_type(4)));
using pg8::pkbf; using pg8::bflo; using pg8::bfhi; using pg8::sigm;

struct Args { const float* in[39]; float* out; unsigned char* ws; int ph_lo, ph_hi; };

struct Frame { LAS unsigned char* lds; int tid, lane, wave, vcu, G, bx; unsigned char* ws; float* out; const float* const* in; };

__device__ __forceinline__ void tr_item(const float* W, int ldw, int Nvalid, bf16* WT, int ldt, int row_off, int col_off, const float* mu, LAS float* scr, int item, int lane) {
    const int nblk = (Nvalid + 31) / 32, kb = item / nblk, nb = item % nblk, k0 = 64 * kb, n0 = 32 * nb;
#pragma unroll 8
    for (int i = 0; i < 32; ++i) { const int kk = 2 * i + (lane >> 5), n = n0 + (lane & 31); scr[kk * 33 + (lane & 31)] = n < Nvalid ? W[(size_t)(k0 + kk) * ldw + n] : 0.f; }
    asm volatile("s_waitcnt lgkmcnt(0)" ::: "memory");
    const int c = lane & 7;
    float s0[8], s1[8];
#pragma unroll
    for (int q = 0; q < 8; ++q) { const float m = mu ? mu[k0 + 8 * c + q] : 0.f; s0[q] = 1.f - m; s1[q] = m; }
#pragma unroll
    for (int j = 0; j < 4; ++j) { const int n = (lane >> 3) + 8 * j; const LAS float* s = scr + (8 * c) * 33 + n;
        float v[8];
#pragma unroll
        for (int q = 0; q < 8; ++q) v[q] = s[q * 33];
        v4u o; o.x = pkbf(v[0] * s0[0], v[1] * s0[1]); o.y = pkbf(v[2] * s0[2], v[3] * s0[3]); o.z = pkbf(v[4] * s0[4], v[5] * s0[5]); o.w = pkbf(v[6] * s0[6], v[7] * s0[7]);
        bf16* dst = WT + (size_t)(row_off + n0 + n) * ldt + col_off + k0 + 8 * c;
        *(v4u*)dst = o;
        if (mu) { v4u p; p.x = pkbf(v[0] * s1[0], v[1] * s1[1]); p.y = pkbf(v[2] * s1[2], v[3] * s1[3]); p.z = pkbf(v[4] * s1[4], v[5] * s1[5]); p.w = pkbf(v[6] * s1[6], v[7] * s1[7]); *(v4u*)(dst + 1024) = p; } }
    asm volatile("s_waitcnt lgkmcnt(0)" ::: "memory");
}
__device__ __forceinline__ float dpp_f(float x, const int ctrl_sel) {
    switch (ctrl_sel) {
        case 0: return __builtin_bit_cast(float, __builtin_amdgcn_update_dpp(0, __builtin_bit_cast(int, x), 0xB1, 0xf, 0xf, false));
        case 1: return __builtin_bit_cast(float, __builtin_amdgcn_update_dpp(0, __builtin_bit_cast(int, x), 0x4E, 0xf, 0xf, false));
        case 2: return __builtin_bit_cast(float, __builtin_amdgcn_update_dpp(0, __builtin_bit_cast(int, x), 0x141, 0xf, 0xf, false));
        default: return __builtin_bit_cast(float, __builtin_amdgcn_update_dpp(0, __builtin_bit_cast(int, x), 0x140, 0xf, 0xf, false));
    }
}
__device__ __forceinline__ float sum4(float x) { x += dpp_f(x, 0); x += dpp_f(x, 1); return x; }
__device__ __forceinline__ float sum8(float x) { x = sum4(x); x += dpp_f(x, 2); return x; }
__device__ __forceinline__ float sum16(float x) { x = sum8(x); x += dpp_f(x, 3); return x; }
__device__ __forceinline__ float wave_sum(float v) {
    v = sum16(v);
    { auto rr = __builtin_amdgcn_permlane16_swap(__float_as_uint(v), __float_as_uint(v), false, false); v = __uint_as_float(rr[0]) + __uint_as_float(rr[1]); }
    { auto rr = __builtin_amdgcn_permlane32_swap(__float_as_uint(v), __float_as_uint(v), false, false); v = __uint_as_float(rr[0]) + __uint_as_float(rr[1]); }
    return v;
}
__device__ __forceinline__ void norm_row(const float* xrow, const float* g, const float* sh, const float* sc, int lane, f32x4 (&v)[4]) {
    float s = 0.f;
#pragma unroll
    for (int j = 0; j < 4; ++j) { v[j] = *((const f32x4*)xrow + lane + 64 * j); s += (v[j].x * v[j].x + v[j].y * v[j].y) + (v[j].z * v[j].z + v[j].w * v[j].w); }
    const float rstd = 1.0f / sqrtf(wave_sum(s) * (1.f / D) + 1e-6f);
#pragma unroll
    for (int j = 0; j < 4; ++j) { const f32x4 gg = *((const f32x4*)g + lane + 64 * j);
        f32x4 a = {1.f, 1.f, 1.f, 1.f}, b = {0.f, 0.f, 0.f, 0.f}; if (sc) { a = *((const f32x4*)sc + lane + 64 * j) + 1.0f; b = *((const f32x4*)sh + lane + 64 * j); }
        v[j] = (v[j] * rstd * gg) * a + b; }
}
__device__ __forceinline__ void st_row_bf16(bf16* orow, int lane, const f32x4 (&v)[4]) {
#pragma unroll
    for (int j = 0; j < 4; ++j) { v2u w; w.x = pkbf(v[j].x, v[j].y); w.y = pkbf(v[j].z, v[j].w); *((v2u*)orow + lane + 64 * j) = w; }
}
__device__ __forceinline__ void p0_mod(Frame& F) {
    LAS float* ca = (LAS float*)F.lds; LAS float* red = (LAS float*)(F.lds + 8192);
    const float* cin = F.in[1];
    for (int i = F.tid; i < 2048; i += 512) { const float c = cin[i]; ca[i] = c / (1.0f + __expf(-c)); }
    __syncthreads();
    float* MOD = (float*)(F.ws + WS_MOD); float* MODKV = MOD + 4 * 2 * 6144;
    for (int item = F.bx; item < 208; item += F.G) {
        const int col = item * 128; const float* W; const float* bias; int ldw, cw; float* dst0; float* dst1;
        if (col < 24576) { const int l = col / 6144; cw = col % 6144; W = F.in[2] + (size_t)l * 1024 * 6144; ldw = 6144; bias = F.in[3] + l * 6144; dst0 = MOD + (l * 2 + 0) * 6144 + cw; dst1 = MOD + (l * 2 + 1) * 6144 + cw; }
        else { cw = col - 24576; W = F.in[30]; ldw = 2048; bias = F.in[31]; dst0 = MODKV + cw; dst1 = MODKV + 2048 + cw; }
        const int c4 = F.tid & 31, ks = F.tid >> 5;
        f32x4 a0 = {0.f, 0.f, 0.f, 0.f}, a1 = {0.f, 0.f, 0.f, 0.f};
#pragma unroll 8
        for (int k = ks * 64; k < ks * 64 + 64; ++k) { const f32x4 w = *(const f32x4*)(W + (size_t)k * ldw + cw + c4 * 4); a0 += w * ca[k]; a1 += w * ca[1024 + k]; }
        *(LAS f32x4*)(red + (ks * 32 + c4) * 8) = a0; *(LAS f32x4*)(red + (ks * 32 + c4) * 8 + 4) = a1;
        __syncthreads();
        if (F.tid < 256) { const int b = F.tid >> 7, c = F.tid & 127; float s = 0.f;
#pragma unroll
            for (int q = 0; q < 16; ++q) s += red[(q * 32 + (c >> 2)) * 8 + b * 4 + (c & 3)];
            (b ? dst1 : dst0)[c] = s + bias[cw + c]; }
        __syncthreads();
    }
}
__device__ __forceinline__ void p0_weights(Frame& F) {
    LAS float* scr = (LAS float*)(F.lds + 16384 + F.wave * 16384);
    const int gw = F.vcu * NWAVES + F.wave, NGW = F.G * NWAVES;
    bf16* W1 = (bf16*)(F.ws + WS_W1); bf16* WO = (bf16*)(F.ws + WS_WO); bf16* WKV = (bf16*)(F.ws + WS_WKV); bf16* WQG = (bf16*)(F.ws + WS_WQG); bf16* WO2 = (bf16*)(F.ws + WS_WO2);
    const float* mu = F.in[8];
    constexpr int PL = 512 * 3 + 32 + 32 + 16 + 80 + 512;
    constexpr int NIT = 2 * PL + 512 + 512 + 16 + 2 * (1024 + 512);
    for (int it = gw; it < NIT; it += NGW) {
        int r = it;
        if (r < 2 * PL) { const int i = r / PL; r -= i * PL; bf16* w1 = W1 + (size_t)i * N1 * K1; const float* m6 = mu + i * 6 * 1024;
            if (r < 512) { tr_item(F.in[9] + (size_t)i * D * D, D, D, w1, K1, 0, 0, m6 + 0 * 1024, scr, r, F.lane); continue; } r -= 512;
            if (r < 512) { tr_item(F.in[10] + (size_t)i * D * D, D, D, w1, K1, 1024, 0, m6 + 2 * 1024, scr, r, F.lane); continue; } r -= 512;
            if (r < 512) { tr_item(F.in[11] + (size_t)i * D * D, D, D, w1, K1, 2048, 0, m6 + 3 * 1024, scr, r, F.lane); continue; } r -= 512;
            if (r < 32) { tr_item(F.in[14] + (size_t)i * D * 64, 64, 64, w1, K1, 3072, 0, m6 + 1 * 1024, scr, r, F.lane); continue; } r -= 32;
            if (r < 32) { tr_item(F.in[17] + (size_t)i * D * 64, 64, 64, w1, K1, 3136, 0, m6 + 4 * 1024, scr, r, F.lane); continue; } r -= 32;
            if (r < 16) { if (i == 1) tr_item(F.in[27], 32, 32, w1, K1, 3200, 0, m6 + 3 * 1024, scr, r, F.lane); continue; } r -= 16;
            if (r < 80) { tr_item(F.in[19] + (size_t)i * D * 160, 160, 160, w1, K1, 3232, 0, m6 + 5 * 1024, scr, r, F.lane); continue; } r -= 80;
            tr_item(F.in[12] + (size_t)i * D * D, D, D, WO + (size_t)i * D * D, D, 0, 0, nullptr, scr, r, F.lane); continue; }
        r -= 2 * PL;
        if (r < 512) { tr_item(F.in[32], 2064, 1024, WKV, D, 0, 0, nullptr, scr, r, F.lane); continue; } r -= 512;
        if (r < 512) { tr_item(F.in[32] + 1024, 2064, 1024, WKV, D, 1024, 0, nullptr, scr, r, F.lane); continue; } r -= 512;
        if (r < 16) { tr_item(F.in[32] + 2048, 2064, 16, WKV, D, 2048, 0, nullptr, scr, r, F.lane); continue; } r -= 16;
        { const int j = r / 1536; r -= j * 1536;
          if (r < 1024) tr_item(F.in[35] + (size_t)j * D * 2048, 2048, 2048, WQG + (size_t)j * 2048 * D, D, 0, 0, nullptr, scr, r, F.lane);
          else tr_item(F.in[37] + (size_t)j * D * D, D, D, WO2 + (size_t)j * D * D, D, 0, 0, nullptr, scr, r - 1024, F.lane); }
    }
    const int gt = F.bx * 512 + F.tid, NT = F.G * 512; const v4u z = {0u, 0u, 0u, 0u};
    for (int e = gt; e < 135168; e += NT) {
        int r = e; bf16* p;
        if (r < 98304) { const int i = r / 49152; r -= i * 49152; p = W1 + (size_t)i * N1 * K1 + (size_t)3392 * K1 + (size_t)r * 8; }
        else if (r < 98304 + 8192) { r -= 98304; p = W1 + (size_t)3200 * K1 + (size_t)r * 8; }
        else { r -= 98304 + 8192; p = WKV + (size_t)2080 * D + (size_t)r * 8; }
        *(v4u*)p = z; }
    { float* B2 = (float*)(F.ws + WS_MOD) + 53248;
      for (int e = gt; e < 2 * 3072; e += NT) { const int i = e / 3072, n = e % 3072, grp = n >> 10, c = n & 1023;
          B2[e] = grp == 0 ? F.in[13][i * D + c] : (grp == 1 ? F.in[16][i * D + c] : (i == 1 ? F.in[26][c] : 0.f)); } }
    bf16* W2A = (bf16*)(F.ws + WS_W2A); bf16* W2G = (bf16*)(F.ws + WS_W2G);
    for (int e = gt; e < 2 * 1048576; e += NT) {
        const int i = e >> 20; int r = e & 1048575;
        if (r < 786432) { const int k = r / 3072, n = r % 3072, grp = n >> 10, c = n & 1023; float v = 0.f;
            if (grp == 0) { if (k < 64) v = F.in[15][((size_t)i * 64 + k) * 1024 + c]; }
            else if (grp == 1) { if (k >= 64 && k < 128) v = F.in[18][((size_t)i * 64 + (k - 64)) * 1024 + c]; }
            else { if (i == 1 && k >= 128 && k < 160) v = F.in[28][(size_t)(k - 128) * 1024 + c]; }
            W2A[(size_t)i * 3072 * 256 + (size_t)n * 256 + k] = (bf16)(pkbf(v, 0.f) & 0xffffu); }
        else { r -= 786432; const int k = r >> 10, n = r & 1023; const float v = k < 160 ? F.in[20][((size_t)i * 160 + k) * 1024 + n] : 0.f;
            W2G[(size_t)i * 1024 * 256 + (size_t)n * 256 + k] = (bf16)(pkbf(v, 0.f) & 0xffffu); }
    }
}
__device__ __forceinline__ void mlp_weights(Frame& F, int L) {
    LAS float* scr = (LAS float*)(F.lds + F.wave * 16384);
    const int gw = F.vcu * NWAVES + F.wave, NGW = F.G * NWAVES;
    bf16* WUP = (bf16*)(F.ws + WS_WUP); bf16* WDN = (bf16*)(F.ws + WS_WDN);
    for (int it = gw; it < 4096; it += NGW) {
        if (it < 2048) tr_item(F.in[6] + (size_t)L * D * FF, FF, FF, WUP, D, 0, 0, nullptr, scr, it, F.lane);
        else tr_item(F.in[7] + (size_t)L * FF * D, D, D, WDN, FF, 0, 0, nullptr, scr, it - 2048, F.lane);
    }
}
__device__ __forceinline__ void norm_phase(Frame& F, const float* xin, const float* g, const float* sh, const float* sc, int bstride, int mode, bf16* dst) {
    const int gw = F.vcu * NWAVES + F.wave, NGW = F.G * NWAVES;
    for (int m = gw; m < M; m += NGW) {
        const int b = m >> 13; f32x4 v[4];
        norm_row(xin + (size_t)m * D, g, sh ? sh + b * bstride : nullptr, sc ? sc + b * bstride : nullptr, F.lane, v);
        if (mode == 0) {
            st_row_bf16(dst + (size_t)m * 2048, F.lane, v);
            if ((m & 8191) != 8191) st_row_bf16(dst + (size_t)(m + 1) * 2048 + 1024, F.lane, v);
            if ((m & 8191) == 0) { const v2u z = {0u, 0u};
#pragma unroll
                for (int j = 0; j < 4; ++j) *((v2u*)(dst + (size_t)m * 2048 + 1024) + F.lane + 64 * j) = z; }
        } else st_row_bf16(dst + (size_t)m * 1024, F.lane, v);
    }
}
__device__ __forceinline__ void final_norm_phase(Frame& F) {
    const int gw = F.vcu * NWAVES + F.wave, NGW = F.G * NWAVES;
    for (int m = gw; m < M; m += NGW) { f32x4 v[4]; norm_row(F.out + (size_t)m * D, F.in[38], nullptr, nullptr, F.lane, v);
#pragma unroll
        for (int j = 0; j < 4; ++j) *((f32x4*)(F.out + (size_t)m * D) + F.lane + 64 * j) = v[j]; }
}
constexpr int SC_C = 32, SC_NC = T / SC_C;
constexpr int SC_W = 0, SC_A = 8192, SC_B = 16384, SC_K = 24576, SC_R = 32768, SC_V = 40960, SC_Y = 41984, SC_BUF = 43008;
__device__ __forceinline__ void scan_phase(Frame& F, int L) {
    const bf16* P1 = (const bf16*)(F.ws + WS_P1); const bf16* P2 = (const bf16*)(F.ws + WS_P2); const bf16* VF = (const bf16*)(F.ws + WS_VF); float* Y = (float*)(F.ws + WS_H2);
    const float* kkw = F.in[21] + L * D; const float* kaw = F.in[22] + L * D;
    const int tid = F.tid, lane = F.lane, wave = F.wave;
    for (int item = F.bx; item < 256; item += F.G) {
        const int bh = (item & 7) + 8 * (item >> 6), rg = (item >> 3) & 7, b = bh >> 4, h = bh & 15;
        const size_t m0 = (size_t)b * T;
        const int hidx = tid - 128, htt = (hidx >> 3) & 31, hc8 = hidx & 7;
        const int vtt = lane >> 1, vr4 = (lane & 1) * 4;
        float ckk[8], cka[8];
        v4u lr = {0u,0u,0u,0u}, lk = {0u,0u,0u,0u}, lw = {0u,0u,0u,0u}, la = {0u,0u,0u,0u}; v2u lv = {0u,0u}, lvm = {0u,0u}, lvf = {0u,0u};
        if (wave >= 2 && wave < 6) {
#pragma unroll
            for (int j = 0; j < 8; ++j) { ckk[j] = kkw[h * 64 + hc8 * 8 + j]; cka[j] = kaw[h * 64 + hc8 * 8 + j]; } }
#define SC_LOAD(c) do { \
        if (wave >= 2 && wave < 6) { const size_t m = m0 + (size_t)(c) * SC_C + htt; const bf16* p1 = P1 + m * N1 + h * 64 + hc8 * 8; const bf16* p2 = P2 + m * NP2 + h * 64 + hc8 * 8; \
            lr = *(const v4u*)p1; lk = *(const v4u*)(p1 + 1024); lw = *(const v4u*)p2; la = *(const v4u*)(p2 + 1024); } \
        else if (wave == 6) { const size_t m = m0 + (size_t)(c) * SC_C + vtt; const int cc = h * 64 + rg * 8 + vr4; \
            lv = *(const v2u*)(P1 + m * N1 + 2048 + cc); if (L == 1) { lvm = *(const v2u*)(P2 + m * NP2 + 2048 + cc); lvf = *(const v2u*)(VF + m * D + cc); } } } while (0)
#define SC_PREP(buf) do { LAS unsigned char* B_ = F.lds + (buf) * SC_BUF; \
        if (wave >= 2 && wave < 6) { float kr[8], av[8], wn[8], rv[8]; \
            kr[0] = bflo(lk.x); kr[1] = bfhi(lk.x); kr[2] = bflo(lk.y); kr[3] = bfhi(lk.y); kr[4] = bflo(lk.z); kr[5] = bfhi(lk.z); kr[6] = bflo(lk.w); kr[7] = bfhi(lk.w); \
            av[0] = bflo(la.x); av[1] = bfhi(la.x); av[2] = bflo(la.y); av[3] = bfhi(la.y); av[4] = bflo(la.z); av[5] = bfhi(la.z); av[6] = bflo(la.w); av[7] = bfhi(la.w); \
            wn[0] = bflo(lw.x); wn[1] = bfhi(lw.x); wn[2] = bflo(lw.y); wn[3] = bfhi(lw.y); wn[4] = bflo(lw.z); wn[5] = bfhi(lw.z); wn[6] = bflo(lw.w); wn[7] = bfhi(lw.w); \
            rv[0] = bflo(lr.x); rv[1] = bfhi(lr.x); rv[2] = bflo(lr.y); rv[3] = bfhi(lr.y); rv[4] = bflo(lr.z); rv[5] = bfhi(lr.z); rv[6] = bflo(lr.w); rv[7] = bfhi(lr.w); \
            float kv_[8], ss = 0.f; \
            _Pragma("unroll") for (int j = 0; j < 8; ++j) { kv_[j] = kr[j] * ckk[j]; ss += kv_[j] * kv_[j]; } \
            ss = sum8(ss); const float inv = 1.0f / fmaxf(sqrtf(ss), 1e-12f); \
            float oa[8], ob[8], ok[8], ow[8]; \
            _Pragma("unroll") for (int j = 0; j < 8; ++j) { const float kk = kv_[j] * inv; oa[j] = -kk; ob[j] = kk * av[j]; ok[j] = kr[j] * (1.0f + (av[j] - 1.0f) * cka[j]); ow[j] = __expf(wn[j]); } \
            const int o_ = (htt * 64 + hc8 * 8) * 4; \
            *(LAS f32x4*)(B_ + SC_W + o_) = (f32x4){ow[0], ow[1], ow[2], ow[3]}; *(LAS f32x4*)(B_ + SC_W + o_ + 16) = (f32x4){ow[4], ow[5], ow[6], ow[7]}; \
            *(LAS f32x4*)(B_ + SC_A + o_) = (f32x4){oa[0], oa[1], oa[2], oa[3]}; *(LAS f32x4*)(B_ + SC_A + o_ + 16) = (f32x4){oa[4], oa[5], oa[6], oa[7]}; \
            *(LAS f32x4*)(B_ + SC_B + o_) = (f32x4){ob[0], ob[1], ob[2], ob[3]}; *(LAS f32x4*)(B_ + SC_B + o_ + 16) = (f32x4){ob[4], ob[5], ob[6], ob[7]}; \
            *(LAS f32x4*)(B_ + SC_K + o_) = (f32x4){ok[0], ok[1], ok[2], ok[3]}; *(LAS f32x4*)(B_ + SC_K + o_ + 16) = (f32x4){ok[4], ok[5], ok[6], ok[7]}; \
            *(LAS f32x4*)(B_ + SC_R + o_) = (f32x4){rv[0], rv[1], rv[2], rv[3]}; *(LAS f32x4*)(B_ + SC_R + o_ + 16) = (f32x4){rv[4], rv[5], rv[6], rv[7]}; } \
        else if (wave == 6) { float v_[4] = {bflo(lv.x), bfhi(lv.x), bflo(lv.y), bfhi(lv.y)}; \
            if (L == 1) { const float f_[4] = {bflo(lvf.x), bfhi(lvf.x), bflo(lvf.y), bfhi(lvf.y)}, g_[4] = {bflo(lvm.x), bfhi(lvm.x), bflo(lvm.y), bfhi(lvm.y)}; \
                _Pragma("unroll") for (int j = 0; j < 4; ++j) v_[j] = v_[j] + (f_[j] - v_[j]) * g_[j]; } \
            *(LAS f32x4*)(B_ + SC_V + (vtt * 8 + vr4) * 4) = (f32x4){v_[0], v_[1], v_[2], v_[3]}; } } while (0)
        SC_LOAD(0); SC_PREP(0); SC_LOAD(1);
        __syncthreads();
        f32x4 S = {0.f, 0.f, 0.f, 0.f};
        const int rl = lane >> 4, kq = lane & 15, rowi = (wave & 1) * 4 + rl;
        for (int c = 0; c < SC_NC; ++c) {
            const int buf = c & 1;
            if (wave < 2) {
                const LAS unsigned char* Bc = F.lds + buf * SC_BUF;
                const LAS f32x4* pw = (const LAS f32x4*)(Bc + SC_W) + kq; const LAS f32x4* pa = (const LAS f32x4*)(Bc + SC_A) + kq; const LAS f32x4* pb = (const LAS f32x4*)(Bc + SC_B) + kq;
                const LAS f32x4* pk = (const LAS f32x4*)(Bc + SC_K) + kq; const LAS f32x4* pr = (const LAS f32x4*)(Bc + SC_R) + kq;
                const LAS float* pv = (const LAS float*)(Bc + SC_V) + rowi; LAS float* py = (LAS float*)(Bc + SC_Y) + rowi;
#pragma unroll 8
                for (int tt = 0; tt < SC_C; ++tt) {
                    const f32x4 w4 = pw[tt * 16], a4 = pa[tt * 16], b4 = pb[tt * 16], k4 = pk[tt * 16], r4 = pr[tt * 16]; const float vv = pv[tt * 8];
                    float sa = (S.x * a4.x + S.y * a4.y) + (S.z * a4.z + S.w * a4.w);
                    const f32x4 tv = S * w4 + k4 * vv;
                    sa = sum16(sa);
                    S = tv + b4 * sa;
                    float y = (S.x * r4.x + S.y * r4.y) + (S.z * r4.z + S.w * r4.w);
                    y = sum16(y);
                    if (kq == 0) py[tt * 8] = y;
                }
            } else {
                if (c + 1 < SC_NC) SC_PREP(buf ^ 1);
                if (c + 2 < SC_NC) SC_LOAD(c + 2);
                if (wave == 7 && c > 0) { const f32x4 yv = *(const LAS f32x4*)(F.lds + (buf ^ 1) * SC_BUF + SC_Y + (vtt * 8 + vr4) * 4);
                    *(f32x4*)(Y + (m0 + (size_t)(c - 1) * SC_C + vtt) * D + h * 64 + rg * 8 + vr4) = yv; }
            }
            __syncthreads();
        }
        if (wave == 7) { const f32x4 yv = *(const LAS f32x4*)(F.lds + ((SC_NC - 1) & 1) * SC_BUF + SC_Y + (vtt * 8 + vr4) * 4);
            *(f32x4*)(Y + (m0 + (size_t)(SC_NC - 1) * SC_C + vtt) * D + h * 64 + rg * 8 + vr4) = yv; }
        __syncthreads();
#undef SC_LOAD
#undef SC_PREP
    }
}
__device__ __forceinline__ void post_phase(Frame& F, int L) {
    const bf16* P1 = (const bf16*)(F.ws + WS_P1); const bf16* P2 = (const bf16*)(F.ws + WS_P2); bf16* VF = (bf16*)(F.ws + WS_VF); float* Y = (float*)(F.ws + WS_H2);
    const int gw = F.vcu * NWAVES + F.wave, NGW = F.G * NWAVES, lane = F.lane, c0 = lane * 16;
    const float* kaw = F.in[22] + L * D + c0; const float* rkw = F.in[23] + L * D + c0; const float* lnw = F.in[24] + L * D + c0; const float* lnb = F.in[25] + L * D + c0;
    for (int m = gw; m < M; m += NGW) {
        float y[16], r[16], k[16], v[16], a[16];
        const float* yp = Y + (size_t)m * D + c0;
#pragma unroll
        for (int q = 0; q < 4; ++q) { const f32x4 t = *(const f32x4*)(yp + 4 * q); y[4 * q] = t.x; y[4 * q + 1] = t.y; y[4 * q + 2] = t.z; y[4 * q + 3] = t.w; }
        const bf16* p1 = P1 + (size_t)m * N1 + c0; const bf16* p2 = P2 + (size_t)m * NP2 + c0;
        v4u rv[2], kv[2], vv[2], av[2];
#pragma unroll
        for (int q = 0; q < 2; ++q) { rv[q] = *(const v4u*)(p1 + 8 * q); kv[q] = *(const v4u*)(p1 + 1024 + 8 * q); vv[q] = *(const v4u*)(p1 + 2048 + 8 * q); av[q] = *(const v4u*)(p2 + 1024 + 8 * q); }
#pragma unroll
        for (int q = 0; q < 2; ++q)
#pragma unroll
            for (int j = 0; j < 4; ++j) { r[8 * q + 2 * j] = bflo(rv[q][j]); r[8 * q + 2 * j + 1] = bfhi(rv[q][j]); k[8 * q + 2 * j] = bflo(kv[q][j]); k[8 * q + 2 * j + 1] = bfhi(kv[q][j]);
                v[8 * q + 2 * j] = bflo(vv[q][j]); v[8 * q + 2 * j + 1] = bfhi(vv[q][j]); a[8 * q + 2 * j] = bflo(av[q][j]); a[8 * q + 2 * j + 1] = bfhi(av[q][j]); }
        if (L == 0) { *(v4u*)(VF + (size_t)m * D + c0) = vv[0]; *(v4u*)(VF + (size_t)m * D + c0 + 8) = vv[1]; }
        else { v4u fv[2], gv[2];
#pragma unroll
            for (int q = 0; q < 2; ++q) { fv[q] = *(const v4u*)(VF + (size_t)m * D + c0 + 8 * q); gv[q] = *(const v4u*)(p2 + 2048 + 8 * q); }
#pragma unroll
            for (int q = 0; q < 2; ++q)
#pragma unroll
                for (int j = 0; j < 4; ++j) { const float f0 = bflo(fv[q][j]), f1 = bfhi(fv[q][j]), g0 = bflo(gv[q][j]), g1 = bfhi(gv[q][j]);
                    v[8 * q + 2 * j] += (f0 - v[8 * q + 2 * j]) * g0; v[8 * q + 2 * j + 1] += (f1 - v[8 * q + 2 * j + 1]) * g1; } }
        float s = 0.f, bd = 0.f;
#pragma unroll
        for (int j = 0; j < 16; ++j) { s += y[j]; const float k2 = k[j] * (1.0f + (a[j] - 1.0f) * kaw[j]); bd += r[j] * k2 * rkw[j]; }
        s = sum4(s); bd = sum4(bd);
        const float mean = s * (1.0f / 64.0f); float q2 = 0.f;
#pragma unroll
        for (int j = 0; j < 16; ++j) { const float d = y[j] - mean; q2 += d * d; }
        q2 = sum4(q2);
        const float rstd = 1.0f / sqrtf(q2 * (1.0f / 64.0f) + 64e-5f);
        float o[16];
#pragma unroll
        for (int j = 0; j < 16; ++j) o[j] = (y[j] - mean) * rstd * lnw[j] + lnb[j] + bd * v[j];
        bf16* yn = (bf16*)(Y + (size_t)m * D) + c0;
        v4u w0, w1; w0.x = pkbf(o[0], o[1]); w0.y = pkbf(o[2], o[3]); w0.z = pkbf(o[4], o[5]); w0.w = pkbf(o[6], o[7]); w1.x = pkbf(o[8], o[9]); w1.y = pkbf(o[10], o[11]); w1.z = pkbf(o[12], o[13]); w1.w = pkbf(o[14], o[15]);
        *(v4u*)yn = w0; *(v4u*)(yn + 8) = w1;
    }
}
__device__ __forceinline__ void kvpost_phase(Frame& F) {
    const bf16* KV = (const bf16*)(F.ws + WS_KVRAW); bf16* KS = (bf16*)(F.ws + WS_KS); bf16* VS = (bf16*)(F.ws + WS_VS);
    const int gw = F.vcu * NWAVES + F.wave, NGW = F.G * NWAVES, lane = F.lane, c0 = lane * 16;
    const float* kg = F.in[34] + (c0 & 63);
    for (int m = gw; m < M; m += NGW) {
        const bf16* p = KV + (size_t)m * 2048 + c0; v4u kv[2], vv[2];
#pragma unroll
        for (int q = 0; q < 2; ++q) { kv[q] = *(const v4u*)(p + 8 * q); vv[q] = *(const v4u*)(p + 1024 + 8 * q); }
        float k[16], ss = 0.f;
#pragma unroll
        for (int q = 0; q < 2; ++q)
#pragma unroll
            for (int j = 0; j < 4; ++j) { k[8 * q + 2 * j] = bflo(kv[q][j]); k[8 * q + 2 * j + 1] = bfhi(kv[q][j]); }
#pragma unroll
        for (int j = 0; j < 16; ++j) ss += k[j] * k[j];
        ss = sum4(ss); const float rs = 1.0f / sqrtf(ss * (1.0f / 64.0f) + 1e-6f);
        v4u w0, w1;
        w0.x = pkbf(k[0] * rs * kg[0], k[1] * rs * kg[1]); w0.y = pkbf(k[2] * rs * kg[2], k[3] * rs * kg[3]); w0.z = pkbf(k[4] * rs * kg[4], k[5] * rs * kg[5]); w0.w = pkbf(k[6] * rs * kg[6], k[7] * rs * kg[7]);
        w1.x = pkbf(k[8] * rs * kg[8], k[9] * rs * kg[9]); w1.y = pkbf(k[10] * rs * kg[10], k[11] * rs * kg[11]); w1.z = pkbf(k[12] * rs * kg[12], k[13] * rs * kg[13]); w1.w = pkbf(k[14] * rs * kg[14], k[15] * rs * kg[15]);
        *(v4u*)(KS + (size_t)m * D + c0) = w0; *(v4u*)(KS + (size_t)m * D + c0 + 8) = w1;
        *(v4u*)(VS + (size_t)m * D + c0) = vv[0]; *(v4u*)(VS + (size_t)m * D + c0 + 8) = vv[1];
    }
    if (gw < 32) {
        const int bh = gw, b = bh >> 4, h = bh & 15; const float* FL = (const float*)(F.ws + WS_FL); const float fb = F.in[33][h]; v4u* G3 = (v4u*)(F.ws + WS_G3) + (size_t)bh * T;
        float carry = 0.f;
        for (int c = 0; c < T / 64; ++c) {
            const int t = c * 64 + lane; const float x = FL[((size_t)b * T + t) * 16 + h] + fb;
            float lf = -(fmaxf(-x, 0.f) + log1pf(__expf(-fabsf(x))));
#pragma unroll
            for (int o = 1; o < 64; o <<= 1) { const float n = __int_as_float(__builtin_amdgcn_ds_bpermute((lane - o) << 2, __float_as_int(lf))); if (lane >= o) lf += n; }
            const float Fv = carry + lf; carry = __int_as_float(__builtin_amdgcn_readlane(__float_as_int(Fv), 63));
            const float gv = -Fv * 1.4426950408889634f;
            const unsigned hi = pkbf(gv, 0.f) & 0xffffu; const float r1 = gv - __uint_as_float(hi << 16);
            const unsigned mid = pkbf(r1, 0.f) & 0xffffu; const float r2 = r1 - __uint_as_float(mid << 16);
            const unsigned lo = pkbf(r2, 0.f) & 0xffffu;
            G3[t] = (v4u){hi | (mid << 16), lo, 0u, 0u};
        }
    }
}
#define GEMM_CALL(FN, Aptr, Bptr, Nn, Kk, LDA, LDB, ...) do { pg8::Gemm g_{(const pg8::bf16_t*)(Aptr), (const pg8::bf16_t*)(Bptr), M, (Nn), (Kk), (LDA), (LDB)}; pg8::StaticOrder S_; S_.init(M, (Nn), F.G, F.bx); \
    pg8::Epi8<pg8::FN> E_{{__VA_ARGS__}}; pg8::gemm_phase<pg8::Epi8<pg8::FN>, pg8::StaticOrder, true, true>(F.lds, g_, S_, E_); } while (0)
constexpr int N_PHASES = 42;
__global__ void __launch_bounds__(NWAVES * 64, 2) yoco_fwd(Args args) {
    extern __shared__ __attribute__((aligned(16))) unsigned char lds[];
    cg::grid_group grid = cg::this_grid();
    Frame F;
    F.lds = (LAS unsigned char*)lds; F.tid = threadIdx.x; F.lane = F.tid & 63; F.wave = __builtin_amdgcn_readfirstlane(F.tid >> 6);
    F.G = gridDim.x; F.bx = blockIdx.x; F.vcu = F.bx;
    F.ws = args.ws; F.out = args.out; F.in = args.in;
    unsigned char* ws = args.ws;
    const int lo = args.ph_lo, hi = args.ph_hi; const bool one = (hi - lo) > 1;
#define LAUNDER() do { int t_ = threadIdx.x; asm volatile("" : "+v"(t_)); F.tid = t_; F.lane = t_ & 63; F.wave = __builtin_amdgcn_readfirstlane(t_ >> 6); \
        int z_ = 0; asm volatile("" : "+v"(z_)); z_ = __builtin_amdgcn_readfirstlane(z_); ws = args.ws + z_; F.ws = ws; F.in = args.in + z_; F.out = args.out + z_; F.bx = (int)blockIdx.x + z_; F.G = (int)gridDim.x + z_; F.vcu = (F.G % 8 == 0) ? (F.bx % 8) * (F.G / 8) + F.bx / 8 : F.bx; } while (0)
#define IN(k) (lo <= (k) && (k) < hi)
#define SEAM() do { if (one) grid.sync(); } while (0)
#define MOD_ ((float*)(ws + WS_MOD))
#define MODKV_ (MOD_ + 4 * 2 * 6144)
#define H2_ ((bf16*)(ws + WS_H2))
#define XN_ ((bf16*)(ws + WS_H2))
#define XNKV_ ((bf16*)(ws + WS_H2 + 32 * MiB))
#define P1_ ((bf16*)(ws + WS_P1))
#define P2_ ((bf16*)(ws + WS_P2))
#define HB_ ((bf16*)(ws + WS_HB))
#define QB_ ((bf16*)(ws + WS_QB))
#define GT_ ((bf16*)(ws + WS_GT))
#define XIN1_ ((L == 0) ? F.in[0] : (const float*)F.out)
#define MODL_ (MOD_ + L * 2 * 6144)

    if (IN(0)) { LAUNDER(); p0_mod(F); p0_weights(F); SEAM(); }
    { constexpr int L = 0;
        const int pb = 1 + L * 10;
        if (L < 2) {
            if (IN(pb + 0)) { LAUNDER(); norm_phase(F, XIN1_, F.in[4] + L * D, MODL_, MODL_ + 1024, 6144, 0, H2_); SEAM(); }
            if (IN(pb + 1)) { LAUNDER(); GEMM_CALL(FnP1, H2_, ws + WS_W1 + (size_t)L * N1 * K1 * 2, N1, K1, K1, K1, P1_); SEAM(); }
            if (IN(pb + 2)) { LAUNDER(); GEMM_CALL(FnP2, P1_ + 3072, ws + WS_W2A + (size_t)L * 3072 * 256 * 2, NP2, 256, N1, 256, P2_, MOD_ + 53248 + L * 3072); SEAM(); }
            if (IN(pb + 3)) { LAUNDER(); scan_phase(F, L); SEAM(); }
            if (IN(pb + 4)) { LAUNDER(); post_phase(F, L); SEAM(); }
            if (IN(pb + 5)) { LAUNDER(); GEMM_CALL(FnGate, P1_ + 3232, ws + WS_W2G + (size_t)L * 1024 * 256 * 2, D, 256, N1, 256, H2_, 2048); SEAM(); }
            if (IN(pb + 6)) { LAUNDER(); GEMM_CALL(FnRes, H2_, ws + WS_WO + (size_t)L * D * D * 2, D, D, 2048, D, XIN1_, F.out, MODL_ + 2 * 1024); SEAM(); }
        } else {
            const int j = L - 2;
            if (IN(pb + 0)) { LAUNDER(); norm_phase(F, F.out, F.in[4] + L * D, MODL_, MODL_ + 1024, 6144, 1, XN_);
                if (L == 2) norm_phase(F, F.out, F.in[29], MODKV_, MODKV_ + 1024, 2048, 1, XNKV_);
                SEAM(); }
            if (IN(pb + 1)) { LAUNDER();
                if (L == 2) GEMM_CALL(FnKv, XNKV_, ws + WS_WKV, 2304, D, D, D, (bf16*)(ws + WS_KVRAW), (float*)(ws + WS_FL));
                LAUNDER();
                GEMM_CALL(FnQg, XN_, ws + WS_WQG + (size_t)j * 2048 * D * 2, 2048, D, D, D, QB_, GT_); SEAM(); }
            if (IN(pb + 2) && L == 2) { LAUNDER(); kvpost_phase(F); SEAM(); }
            if (IN(pb + 3)) { LAUNDER();
                const attn_body::AttnTensors AT{(const attn_body::bf16*)QB_, (const attn_body::bf16*)(ws + WS_KS), (const attn_body::bf16*)(ws + WS_VS), (attn_body::bf16*)QB_, (const attn_body::bf16*)GT_, (const unsigned char*)(ws + WS_G3), F.in[36] + j * 64};
                const attn_body::StaticOrder S((int)F.G, F.bx);
                attn_body::attn_phase<attn_body::StaticOrder>((char*)lds, AT, S);
                SEAM(); }
            if (IN(pb + 6)) { LAUNDER(); GEMM_CALL(FnRes, QB_, ws + WS_WO2 + (size_t)j * D * D * 2, D, D, D, D, (const float*)F.out, F.out, MODL_ + 2 * 1024); SEAM(); }
        }
        if (IN(pb + 7)) { LAUNDER(); mlp_weights(F, L); norm_phase(F, F.out, F.in[5] + L * D, MODL_ + 3 * 1024, MODL_ + 4 * 1024, 6144, 1, XN_); SEAM(); }
        if (IN(pb + 8)) { LAUNDER(); GEMM_CALL(FnUp, XN_, ws + WS_WUP, FF, D, D, D, HB_); SEAM(); }
        if (IN(pb + 9)) { LAUNDER(); GEMM_CALL(FnRes, HB_, ws + WS_WDN, D, FF, FF, FF, (const float*)F.out, F.out, MODL_ + 5 * 1024); SEAM(); }
        }
    { constexpr int L = 1;
        const int pb = 1 + L * 10;
        if (L < 2) {
            if (IN(pb + 0)) { LAUNDER(); norm_phase(F, XIN1_, F.in[4] + L * D, MODL_, MODL_ + 1024, 6144, 0, H2_); SEAM(); }
            if (IN(pb + 1)) { LAUNDER(); GEMM_CALL(FnP1, H2_, ws + WS_W1 + (size_t)L * N1 * K1 * 2, N1, K1, K1, K1, P1_); SEAM(); }
            if (IN(pb + 2)) { LAUNDER(); GEMM_CALL(FnP2, P1_ + 3072, ws + WS_W2A + (size_t)L * 3072 * 256 * 2, NP2, 256, N1, 256, P2_, MOD_ + 53248 + L * 3072); SEAM(); }
            if (IN(pb + 3)) { LAUNDER(); scan_phase(F, L); SEAM(); }
            if (IN(pb + 4)) { LAUNDER(); post_phase(F, L); SEAM(); }
            if (IN(pb + 5)) { LAUNDER(); GEMM_CALL(FnGate, P1_ + 3232, ws + WS_W2G + (size_t)L * 1024 * 256 * 2, D, 256, N1, 256, H2_, 2048); SEAM(); }
            if (IN(pb + 6)) { LAUNDER(); GEMM_CALL(FnRes, H2_, ws + WS_WO + (size_t)L * D * D * 2, D, D, 2048, D, XIN1_, F.out, MODL_ + 2 * 1024); SEAM(); }
        } else {
            const int j = L - 2;
            if (IN(pb + 0)) { LAUNDER(); norm_phase(F, F.out, F.in[4] + L * D, MODL_, MODL_ + 1024, 6144, 1, XN_);
                if (L == 2) norm_phase(F, F.out, F.in[29], MODKV_, MODKV_ + 1024, 2048, 1, XNKV_);
                SEAM(); }
            if (IN(pb + 1)) { LAUNDER();
                if (L == 2) GEMM_CALL(FnKv, XNKV_, ws + WS_WKV, 2304, D, D, D, (bf16*)(ws + WS_KVRAW), (float*)(ws + WS_FL));
                LAUNDER();
                GEMM_CALL(FnQg, XN_, ws + WS_WQG + (size_t)j * 2048 * D * 2, 2048, D, D, D, QB_, GT_); SEAM(); }
            if (IN(pb + 2) && L == 2) { LAUNDER(); kvpost_phase(F); SEAM(); }
            if (IN(pb + 3)) { LAUNDER();
                const attn_body::AttnTensors AT{(const attn_body::bf16*)QB_, (const attn_body::bf16*)(ws + WS_KS), (const attn_body::bf16*)(ws + WS_VS), (attn_body::bf16*)QB_, (const attn_body::bf16*)GT_, (const unsigned char*)(ws + WS_G3), F.in[36] + j * 64};
                const attn_body::StaticOrder S((int)F.G, F.bx);
                attn_body::attn_phase<attn_body::StaticOrder>((char*)lds, AT, S);
                SEAM(); }
            if (IN(pb + 6)) { LAUNDER(); GEMM_CALL(FnRes, QB_, ws + WS_WO2 + (size_t)j * D * D * 2, D, D, D, D, (const float*)F.out, F.out, MODL_ + 2 * 1024); SEAM(); }
        }
        if (IN(pb + 7)) { LAUNDER(); mlp_weights(F, L); norm_phase(F, F.out, F.in[5] + L * D, MODL_ + 3 * 1024, MODL_ + 4 * 1024, 6144, 1, XN_); SEAM(); }
        if (IN(pb + 8)) { LAUNDER(); GEMM_CALL(FnUp, XN_, ws + WS_WUP, FF, D, D, D, HB_); SEAM(); }
        if (IN(pb + 9)) { LAUNDER(); GEMM_CALL(FnRes, HB_, ws + WS_WDN, D, FF, FF, FF, (const float*)F.out, F.out, MODL_ + 5 * 1024); SEAM(); }
        }
    { constexpr int L = 2;
        const int pb = 1 + L * 10;
        if (L < 2) {
            if (IN(pb + 0)) { LAUNDER(); norm_phase(F, XIN1_, F.in[4] + L * D, MODL_, MODL_ + 1024, 6144, 0, H2_); SEAM(); }
            if (IN(pb + 1)) { LAUNDER(); GEMM_CALL(FnP1, H2_, ws + WS_W1 + (size_t)L * N1 * K1 * 2, N1, K1, K1, K1, P1_); SEAM(); }
            if (IN(pb + 2)) { LAUNDER(); GEMM_CALL(FnP2, P1_ + 3072, ws + WS_W2A + (size_t)L * 3072 * 256 * 2, NP2, 256, N1, 256, P2_, MOD_ + 53248 + L * 3072); SEAM(); }
            if (IN(pb + 3)) { LAUNDER(); scan_phase(F, L); SEAM(); }
            if (IN(pb + 4)) { LAUNDER(); post_phase(F, L); SEAM(); }
            if (IN(pb + 5)) { LAUNDER(); GEMM_CALL(FnGate, P1_ + 3232, ws + WS_W2G + (size_t)L * 1024 * 256 * 2, D, 256, N1, 256, H2_, 2048); SEAM(); }
            if (IN(pb + 6)) { LAUNDER(); GEMM_CALL(FnRes, H2_, ws + WS_WO + (size_t)L * D * D * 2, D, D, 2048, D, XIN1_, F.out, MODL_ + 2 * 1024); SEAM(); }
        } else {
            const int j = L - 2;
            if (IN(pb + 0)) { LAUNDER(); norm_phase(F, F.out, F.in[4] + L * D, MODL_, MODL_ + 1024, 6144, 1, XN_);
                if (L == 2) norm_phase(F, F.out, F.in[29], MODKV_, MODKV_ + 1024, 2048, 1, XNKV_);
                SEAM(); }
            if (IN(pb + 1)) { LAUNDER();
                if (L == 2) GEMM_CALL(FnKv, XNKV_, ws + WS_WKV, 2304, D, D, D, (bf16*)(ws + WS_KVRAW), (float*)(ws + WS_FL));
                LAUNDER();
                GEMM_CALL(FnQg, XN_, ws + WS_WQG + (size_t)j * 2048 * D * 2, 2048, D, D, D, QB_, GT_); SEAM(); }
            if (IN(pb + 2) && L == 2) { LAUNDER(); kvpost_phase(F); SEAM(); }
            if (IN(pb + 3)) { LAUNDER();
                const attn_body::AttnTensors AT{(const attn_body::bf16*)QB_, (const attn_body::bf16*)(ws + WS_KS), (const attn_body::bf16*)(ws + WS_VS), (attn_body::bf16*)QB_, (const attn_body::bf16*)GT_, (const unsigned char*)(ws + WS_G3), F.in[36] + j * 64};
                const attn_body::StaticOrder S((int)F.G, F.bx);
                attn_body::attn_phase<attn_body::StaticOrder>((char*)lds, AT, S);
                SEAM(); }
            if (IN(pb + 6)) { LAUNDER(); GEMM_CALL(FnRes, QB_, ws + WS_WO2 + (size_t)j * D * D * 2, D, D, D, D, (const float*)F.out, F.out, MODL_ + 2 * 1024); SEAM(); }
        }
        if (IN(pb + 7)) { LAUNDER(); mlp_weights(F, L); norm_phase(F, F.out, F.in[5] + L * D, MODL_ + 3 * 1024, MODL_ + 4 * 1024, 6144, 1, XN_); SEAM(); }
        if (IN(pb + 8)) { LAUNDER(); GEMM_CALL(FnUp, XN_, ws + WS_WUP, FF, D, D, D, HB_); SEAM(); }
        if (IN(pb + 9)) { LAUNDER(); GEMM_CALL(FnRes, HB_, ws + WS_WDN, D, FF, FF, FF, (const float*)F.out, F.out, MODL_ + 5 * 1024); SEAM(); }
        }
    { constexpr int L = 3;
        const int pb = 1 + L * 10;
        if (L < 2) {
            if (IN(pb + 0)) { LAUNDER(); norm_phase(F, XIN1_, F.in[4] + L * D, MODL_, MODL_ + 1024, 6144, 0, H2_); SEAM(); }
            if (IN(pb + 1)) { LAUNDER(); GEMM_CALL(FnP1, H2_, ws + WS_W1 + (size_t)L * N1 * K1 * 2, N1, K1, K1, K1, P1_); SEAM(); }
            if (IN(pb + 2)) { LAUNDER(); GEMM_CALL(FnP2, P1_ + 3072, ws + WS_W2A + (size_t)L * 3072 * 256 * 2, NP2, 256, N1, 256, P2_, MOD_ + 53248 + L * 3072); SEAM(); }
            if (IN(pb + 3)) { LAUNDER(); scan_phase(F, L); SEAM(); }
            if (IN(pb + 4)) { LAUNDER(); post_phase(F, L); SEAM(); }
            if (IN(pb + 5)) { LAUNDER(); GEMM_CALL(FnGate, P1_ + 3232, ws + WS_W2G + (size_t)L * 1024 * 256 * 2, D, 256, N1, 256, H2_, 2048); SEAM(); }
            if (IN(pb + 6)) { LAUNDER(); GEMM_CALL(FnRes, H2_, ws + WS_WO + (size_t)L * D * D * 2, D, D, 2048, D, XIN1_, F.out, MODL_ + 2 * 1024); SEAM(); }
        } else {
            const int j = L - 2;
            if (IN(pb + 0)) { LAUNDER(); norm_phase(F, F.out, F.in[4] + L * D, MODL_, MODL_ + 1024, 6144, 1, XN_);
                if (L == 2) norm_phase(F, F.out, F.in[29], MODKV_, MODKV_ + 1024, 2048, 1, XNKV_);
                SEAM(); }
            if (IN(pb + 1)) { LAUNDER();
                if (L == 2) GEMM_CALL(FnKv, XNKV_, ws + WS_WKV, 2304, D, D, D, (bf16*)(ws + WS_KVRAW), (float*)(ws + WS_FL));
                LAUNDER();
                GEMM_CALL(FnQg, XN_, ws + WS_WQG + (size_t)j * 2048 * D * 2, 2048, D, D, D, QB_, GT_); SEAM(); }
            if (IN(pb + 2) && L == 2) { LAUNDER(); kvpost_phase(F); SEAM(); }
            if (IN(pb + 3)) { LAUNDER();
                const attn_body::AttnTensors AT{(const attn_body::bf16*)QB_, (const attn_body::bf16*)(ws + WS_KS), (const attn_body::bf16*)(ws + WS_VS), (attn_body::bf16*)QB_, (const attn_body::bf16*)GT_, (const unsigned char*)(ws + WS_G3), F.in[36] + j * 64};
                const attn_body::StaticOrder S((int)F.G, F.bx);
                attn_body::attn_phase<attn_body::StaticOrder>((char*)lds, AT, S);
                SEAM(); }
            if (IN(pb + 6)) { LAUNDER(); GEMM_CALL(FnRes, QB_, ws + WS_WO2 + (size_t)j * D * D * 2, D, D, D, D, (const float*)F.out, F.out, MODL_ + 2 * 1024); SEAM(); }
        }
        if (IN(pb + 7)) { LAUNDER(); mlp_weights(F, L); norm_phase(F, F.out, F.in[5] + L * D, MODL_ + 3 * 1024, MODL_ + 4 * 1024, 6144, 1, XN_); SEAM(); }
        if (IN(pb + 8)) { LAUNDER(); GEMM_CALL(FnUp, XN_, ws + WS_WUP, FF, D, D, D, HB_); SEAM(); }
        if (IN(pb + 9)) { LAUNDER(); GEMM_CALL(FnRes, HB_, ws + WS_WDN, D, FF, FF, FF, (const float*)F.out, F.out, MODL_ + 5 * 1024); SEAM(); }
        }
    if (IN(41)) { LAUNDER(); final_norm_phase(F); }
#undef IN
#undef SEAM
}
static bool phase_exists(int ph) {
    if (ph == 0 || ph == 41) return true;
    const int L = (ph - 1) / 10, s = (ph - 1) % 10;
    if (L < 2) return true;
    if (s == 4 || s == 5) return false;
    if (s == 2) return L == 2;
    return true;
}
extern "C" void kernel_launch(void* const* d_in, const int* in_sizes, int n_in, void* d_out, int out_size, void* d_ws, size_t ws_size, hipStream_t stream) {
    static int grid = 0;
    if (grid == 0) {
        if (n_in != 39 || in_sizes[0] != M * D || out_size != M * D || ws_size < WS_END) { fprintf(stderr, "kernel_launch: shape/workspace mismatch: n_in %d in0 %d out %d ws %zu (need %zu)\n", n_in, n_in > 0 ? in_sizes[0] : -1, out_size, ws_size, (size_t)WS_END); grid = -1; return; }
        int dev = 0, cus = 0, per_cu = 0;
        if (hipGetDevice(&dev) != hipSuccess || hipDeviceGetAttribute(&cus, hipDeviceAttributeMultiprocessorCount, dev) != hipSuccess) { fprintf(stderr, "kernel_launch: device query failed\n"); grid = -1; return; }
        if (hipFuncSetAttribute((const void*)yoco_fwd, hipFuncAttributeMaxDynamicSharedMemorySize, LDS_BYTES) != hipSuccess) { fprintf(stderr, "kernel_launch: hipFuncSetAttribute failed\n"); grid = -1; return; }
        if (hipOccupancyMaxActiveBlocksPerMultiprocessor(&per_cu, (const void*)yoco_fwd, NWAVES * 64, LDS_BYTES) != hipSuccess || per_cu < 1) { fprintf(stderr, "kernel_launch: occupancy query says %d blocks/CU\n", per_cu); per_cu = 1; }
        (void)hipGetLastError();
        grid = cus * per_cu;
        if (grid != 256) { fprintf(stderr, "kernel_launch: resident capacity %d workgroups; this kernel's static schedules want 256 (using 256)\n", grid); if (grid > 256) grid = 256; }
    }
    if (grid < 0) return;
    Args a{};
    for (int i = 0; i < 39; ++i) a.in[i] = (const float*)d_in[i];
    a.out = (float*)d_out; a.ws = (unsigned char*)d_ws;
#if MK_ONE_LAUNCH
    a.ph_lo = 0; a.ph_hi = N_PHASES;
    void* params[] = {&a};
    const hipError_t le = hipLaunchCooperativeKernel((const void*)yoco_fwd, dim3(grid), dim3(NWAVES * 64), params, LDS_BYTES, stream);
    if (le != hipSuccess) fprintf(stderr, "kernel_launch: cooperative launch failed: %s (grid %d)\n", hipGetErrorName(le), grid);
#else
    for (int ph = 0; ph < N_PHASES; ++ph) { if (!phase_exists(ph)) continue; a.ph_lo = ph; a.ph_hi = ph + 1;
        hipLaunchKernelGGL(yoco_fwd, dim3(grid), dim3(NWAVES * 64), LDS_BYTES, stream, a);
        const hipError_t le = hipPeekAtLastError(); if (le != hipSuccess) { fprintf(stderr, "kernel_launch: launch of phase %d failed: %s\n", ph, hipGetErrorName(le)); break; } }
#endif
}
```

```cpp
#include <hip/hip_runtime.h>
#include <hip/hip_cooperative_groups.h>
#include <hip/hip_bf16.h>
#include <cstdio>
#include <cstdint>
#include <cmath>
namespace cg = cooperative_groups;
#ifndef MK_ONE_LAUNCH
#define MK_ONE_LAUNCH 1
#endif
namespace pg8 {
#define PG8_LAS __attribute__((address_space(3)))
typedef unsigned short bf16_t;
typedef short bf16x8 __attribute__((ext_vector_type(8)));
typedef float f32x4 __attribute__((ext_vector_type(4)));
typedef unsigned u32x4 __attribute__((ext_vector_type(4)));
constexpr int BM = 256, BK = 64, HALF = 128, HTB = HALF * BK * 2  , STAGE_BYTES = 8 * HTB, NXCD = 8, WGM = 8;

__host__ __device__ __forceinline__ int lds_byte(int r, int c) { const int st = (r >> 4) * 2 + (c >> 5), rr = r & 15, cc = c & 31, ob = rr * 64 + cc * 2; return st * 1024 + (ob ^ (((ob >> 9) & 1) << 5)); }
__host__ __device__ __forceinline__ void stage_rc(int b, int& R, int& C) { const int st = b / 1024, sb = b % 1024, swz = sb ^ (((sb >> 9) & 1) << 5); R = (st >> 1) * 16 + swz / 64; C = (st & 1) * 32 + (swz % 64) / 2; }
__host__ __device__ __forceinline__ int perm32(int rho) { const int n = rho >> 4, i = rho & 15; return 8 * (i >> 2) + 4 * n + (i & 3); }

struct Unit { int pm, pn; };
struct Gemm { const bf16_t* A; const bf16_t* Bt; int M, N, K, lda, ldb; };

struct StaticOrder {
    int nM, nN, nwg, G, c;
    __host__ __device__ void init(int M, int N, int G_, int c_) { nM = M / BM; nN = N / BM; nwg = nM * nN; G = G_; c = c_; }
    __host__ __device__ bool next(int i, Unit& u) const {
        const long L = (long)i * G + c; if (L >= nwg) return false;
        int wgid = (int)L; { const int q = nwg / NXCD, r = nwg % NXCD, xcd = wgid % NXCD, off = wgid / NXCD; wgid = (xcd < r ? xcd * (q + 1) : r * (q + 1) + (xcd - r) * q) + off; }
        const int nig = WGM * nN, gid = wgid / nig, fm = gid * WGM, gsz = (nM - fm) < WGM ? (nM - fm) : WGM;
        u.pm = fm + ((wgid % nig) % gsz); u.pn = (wgid % nig) / gsz; return true;
    }
    __device__ __forceinline__ void a_ready(const Unit&) const {}
    __device__ __forceinline__ void done(const Unit&) const {}
};

typedef float f32x2 __attribute__((ext_vector_type(2)));
typedef __bf16 bf16x2_t __attribute__((ext_vector_type(2)));
__device__ __forceinline__ unsigned pkbf(float lo, float hi) { f32x2 v = {lo, hi}; bf16x2_t b = __builtin_convertvector(v, bf16x2_t); return __builtin_bit_cast(unsigned, b); }
__device__ __forceinline__ float bflo(unsigned w) { return __uint_as_float(w << 16); }
__device__ __forceinline__ float bfhi(unsigned w) { return __uint_as_float(w & 0xffff0000u); }
__device__ __forceinline__ float sigm(float x) { return 1.0f / (1.0f + __expf(-x)); }
template <class Fn> struct Epi8 {
    static constexpr bool PERM = true, AFTER_DRAIN = false; Fn f;
    __device__ __forceinline__ void operator()(const f32x4 (&acc)[2][2][4][2], const Unit& u, int wr, int wc, int fr, int fq) const {
        const int row0 = u.pm * BM + wr * 64 + fr, col0 = u.pn * BM + wc * 32 + 8 * fq;
#pragma unroll
        for (int ai = 0; ai < 2; ++ai)
#pragma unroll
            for (int m = 0; m < 4; ++m)
#pragma unroll
                for (int bj = 0; bj < 2; ++bj) { f(row0 + ai * HALF + m * 16, col0 + bj * HALF, acc[ai][bj][m][0], acc[ai][bj][m][1]); asm volatile("" ::: "memory"); }
    }
};
__device__ __forceinline__ void st8bf(bf16_t* p, f32x4 v0, f32x4 v1) { u32x4 w; w.x = pkbf(v0[0], v0[1]); w.y = pkbf(v0[2], v0[3]); w.z = pkbf(v1[0], v1[1]); w.w = pkbf(v1[2], v1[3]); *(u32x4*)p = w; }
struct FnP1 { bf16_t* O;
    __device__ __forceinline__ void operator()(int row, int col, f32x4 v0, f32x4 v1) const {
        if (col >= 3072) {
            if (col < 3136) {
#pragma unroll
                for (int j = 0; j < 4; ++j) { v0[j] = 1.0f - 2.0f / (__expf(2.0f * v0[j]) + 1.0f); v1[j] = 1.0f - 2.0f / (__expf(2.0f * v1[j]) + 1.0f); } }
            else if (col >= 3232 && col < 3392) {
#pragma unroll
                for (int j = 0; j < 4; ++j) { v0[j] = sigm(v0[j]); v1[j] = sigm(v1[j]); } }
        }
        st8bf(O + (size_t)row * 3584 + col, v0, v1); } };
struct FnP2 { bf16_t* O; const float* bias;
    __device__ __forceinline__ void operator()(int row, int col, f32x4 v0, f32x4 v1) const {
        const f32x4 b0 = *(const f32x4*)(bias + col), b1 = *(const f32x4*)(bias + col + 4);
        const float sc = col < 1024 ? -0.60653065971f : 1.0f;
#pragma unroll
        for (int j = 0; j < 4; ++j) { v0[j] = sc * sigm(v0[j] + b0[j]); v1[j] = sc * sigm(v1[j] + b1[j]); }
        st8bf(O + (size_t)row * 3072 + col, v0, v1); } };
struct FnGate { bf16_t* Y; int ld;
    __device__ __forceinline__ void operator()(int row, int col, f32x4 v0, f32x4 v1) const {
        bf16_t* p = Y + (size_t)row * ld + col; const u32x4 y = *(const u32x4*)p;
        v0[0] *= bflo(y.x); v0[1] *= bfhi(y.x); v0[2] *= bflo(y.y); v0[3] *= bfhi(y.y); v1[0] *= bflo(y.z); v1[1] *= bfhi(y.z); v1[2] *= bflo(y.w); v1[3] *= bfhi(y.w);
        st8bf(p, v0, v1); } };
struct FnRes { const float* xin; float* xout; const float* gate;
    __device__ __forceinline__ void operator()(int row, int col, f32x4 v0, f32x4 v1) const {
        const float* gp = gate + (row >> 13) * 6144 + col; const f32x4 g0 = *(const f32x4*)gp, g1 = *(const f32x4*)(gp + 4);
        const size_t off = (size_t)row * 1024 + col; const f32x4 x0 = *(const f32x4*)(xin + off), x1 = *(const f32x4*)(xin + off + 4);
        *(f32x4*)(xout + off) = x0 + (g0 + 1.0f) * v0; *(f32x4*)(xout + off + 4) = x1 + (g1 + 1.0f) * v1; } };
struct FnUp { bf16_t* O;
    __device__ __forceinline__ void operator()(int row, int col, f32x4 v0, f32x4 v1) const {
#pragma unroll
        for (int j = 0; j < 4; ++j) { const float a = fmaxf(v0[j], 0.f), b = fmaxf(v1[j], 0.f); v0[j] = a * a; v1[j] = b * b; }
        st8bf(O + (size_t)row * 4096 + col, v0, v1); } };
struct FnKv { bf16_t* O; float* FL;
    __device__ __forceinline__ void operator()(int row, int col, f32x4 v0, f32x4 v1) const {
        if (col < 2048) st8bf(O + (size_t)row * 2048 + col, v0, v1);
        else if (col < 2064) { float* p = FL + (size_t)row * 16 + (col - 2048); *(f32x4*)p = v0; *(f32x4*)(p + 4) = v1; } } };
struct FnQg { bf16_t* Q; bf16_t* G;
    __device__ __forceinline__ void operator()(int row, int col, f32x4 v0, f32x4 v1) const {
        if (col < 1024) st8bf(Q + (size_t)row * 1024 + col, v0, v1);
        else {
#pragma unroll
            for (int j = 0; j < 4; ++j) { v0[j] = sigm(v0[j]); v1[j] = sigm(v1[j]); }
            st8bf(G + (size_t)row * 1024 + (col - 1024), v0, v1); } } };
template <class Epi, class Sched, bool ALIGN_EPI = false, bool SP2 = false>
__device__ __forceinline__ void gemm_phase(PG8_LAS unsigned char* lds, const Gemm g, const Sched& S, const Epi& E, const int tid_in) {
    int tid_l = tid_in; asm volatile("" : "+v"(tid_l));
    const int tid = tid_l, wid = __builtin_amdgcn_readfirstlane(tid >> 6), lane = tid & 63, wr = wid >> 2, wc = wid & 3, fr = lane & 15, fq = lane >> 4;
    const int K = g.K, nt = K / BK;
    unsigned voffA[2], voffB[2];
#pragma unroll
    for (int i = 0; i < 2; ++i) { int R, C; stage_rc(tid * 16 + i * 8192, R, C); const int Rb = Epi::PERM ? ((R & ~31) + perm32(R & 31)) : R;
        voffA[i] = (unsigned)(R * g.lda + C) * 2u; voffB[i] = (unsigned)(Rb * g.ldb + C) * 2u; }
    const size_t kstep = (size_t)(BK * 2);
    const size_t hstepA = (size_t)HALF * g.lda * 2, hstepB = (size_t)HALF * g.ldb * 2;
    const size_t tstepA = 2 * hstepA, tstepB = 2 * hstepB;
    const unsigned ldsw = (unsigned)wid * 1024u;
    const int aoff = lds_byte(wr * 64 + fr, fq * 8), boff = lds_byte(wc * 32 + fr, fq * 8);
#define PG8_SA(b, h) (((b) * 2 + (h)) * HTB)
#define PG8_SB(b, h) ((4 + (b) * 2 + (h)) * HTB)
#define PG8_STAGE(bufoff, gbase, voff) do { _Pragma("unroll") for (int _i = 0; _i < 2; ++_i) \
        __builtin_amdgcn_global_load_lds((const unsigned*)((const char*)(gbase) + (voff)[_i]), (PG8_LAS unsigned*)(lds + (bufoff) + ldsw + _i * 8192), 16, 0, 0); } while (0)
#define PG8_LDA(dst, b, h) do { _Pragma("unroll") for (int m = 0; m < 4; ++m) _Pragma("unroll") for (int k = 0; k < 2; ++k) dst[m][k] = *(const PG8_LAS bf16x8*)(lds + PG8_SA(b, h) + aoff + m * 2048 + k * 1024); } while (0)
#define PG8_LDB(dst, b, h) do { _Pragma("unroll") for (int n = 0; n < 2; ++n) _Pragma("unroll") for (int k = 0; k < 2; ++k) dst[n][k] = *(const PG8_LAS bf16x8*)(lds + PG8_SB(b, h) + boff + n * 2048 + k * 1024); } while (0)
#define PG8_MMA(ai, bj, At, Bt) do { __builtin_amdgcn_s_setprio(1); _Pragma("unroll") for (int m = 0; m < 4; ++m) _Pragma("unroll") for (int n = 0; n < 2; ++n) _Pragma("unroll") for (int k = 0; k < 2; ++k) \
        acc[ai][bj][m][n] = __builtin_amdgcn_mfma_f32_16x16x32_bf16(Bt[n][k], At[m][k], acc[ai][bj][m][n], 0, 0, 0); __builtin_amdgcn_s_setprio(0); } while (0)
#define PG8_WAIT_V(n) asm volatile("s_waitcnt vmcnt(" #n ")" ::: "memory")
#define PG8_WAIT_L(n) asm volatile("s_waitcnt lgkmcnt(" #n ")" ::: "memory")
#define PG8_BAR __builtin_amdgcn_s_barrier()
#define PG8_SCHED __builtin_amdgcn_sched_barrier(0)
    Unit cur, nxt; int ui = 0;
    if (!S.next(0, cur)) return;
    f32x4 acc[2][2][4][2];
#pragma unroll
    for (int a = 0; a < 2; ++a)
#pragma unroll
        for (int b = 0; b < 2; ++b)
#pragma unroll
            for (int m = 0; m < 4; ++m)
#pragma unroll
                for (int n = 0; n < 2; ++n) acc[a][b][m][n] = (f32x4){0.f, 0.f, 0.f, 0.f};
    bf16x8 At[4][2], B0[2][2], B1[2][2];
    const char* cA = (const char*)g.A + (size_t)cur.pm * tstepA; const char* cB = (const char*)g.Bt + (size_t)cur.pn * tstepB;
    S.a_ready(cur);
    if constexpr (SP2) {
        PG8_STAGE(PG8_SB(0, 0), cB, voffB); PG8_STAGE(PG8_SB(0, 1), cB + hstepB, voffB); PG8_STAGE(PG8_SA(0, 0), cA, voffA); PG8_STAGE(PG8_SA(0, 1), cA + hstepA, voffA);
        if (wr == 1) PG8_BAR;
        PG8_WAIT_V(2); PG8_BAR;
        PG8_STAGE(PG8_SB(1, 0), cB + kstep, voffB); PG8_STAGE(PG8_SA(1, 0), cA + kstep, voffA); PG8_STAGE(PG8_SB(1, 1), cB + hstepB + kstep, voffB);
        PG8_WAIT_V(6); PG8_BAR;
    } else {
        PG8_STAGE(PG8_SB(0, 0), cB, voffB); PG8_STAGE(PG8_SA(0, 0), cA, voffA); PG8_STAGE(PG8_SB(0, 1), cB + hstepB, voffB); PG8_STAGE(PG8_SA(0, 1), cA + hstepA, voffA);
        if (wr == 1) PG8_BAR;
        PG8_WAIT_V(4); PG8_BAR;
        PG8_STAGE(PG8_SB(1, 0), cB + kstep, voffB); PG8_STAGE(PG8_SA(1, 0), cA + kstep, voffA); PG8_STAGE(PG8_SB(1, 1), cB + hstepB + kstep, voffB);
        PG8_WAIT_V(6); PG8_BAR;
    }
    for (;;) {
        const bool has_next = S.next(ui + 1, nxt);
        const char* nA = has_next ? (const char*)g.A + (size_t)nxt.pm * tstepA : cA; const char* nB = has_next ? (const char*)g.Bt + (size_t)nxt.pn * tstepB : cB;
        for (int t = 0; t < nt; t += 2) {
            const bool last = (t == nt - 2);
            const char* a1 = cA + (size_t)(t + 1) * kstep;
            const char* a2 = last ? nA : cA + (size_t)(t + 2) * kstep; const char* b2 = last ? nB : cB + (size_t)(t + 2) * kstep;
            const char* a3 = a2 + kstep; const char* b3 = b2 + kstep;
            if (last && has_next) S.a_ready(nxt);
            if constexpr (SP2) {
            PG8_LDB(B0, 0, 0); PG8_LDB(B1, 0, 1); PG8_SCHED; PG8_LDA(At, 0, 0); PG8_STAGE(PG8_SA(1, 1), a1 + hstepA, voffA);
            PG8_WAIT_V(8); PG8_WAIT_L(0); PG8_BAR; PG8_MMA(0, 0, At, B0); PG8_MMA(0, 1, At, B1); PG8_BAR; PG8_SCHED;
            PG8_LDA(At, 0, 1); PG8_STAGE(PG8_SB(0, 0), b2, voffB); PG8_STAGE(PG8_SB(0, 1), b2 + hstepB, voffB); PG8_STAGE(PG8_SA(0, 0), a2, voffA);
            PG8_WAIT_V(8); PG8_WAIT_L(0); PG8_BAR; PG8_MMA(1, 0, At, B0); PG8_MMA(1, 1, At, B1); PG8_BAR; PG8_SCHED;
            PG8_LDB(B0, 1, 0); PG8_LDB(B1, 1, 1); PG8_SCHED; PG8_LDA(At, 1, 0); PG8_STAGE(PG8_SA(0, 1), a2 + hstepA, voffA);
            PG8_WAIT_V(8); PG8_WAIT_L(0); PG8_BAR; PG8_MMA(0, 0, At, B0); PG8_MMA(0, 1, At, B1); PG8_BAR; PG8_SCHED;
            PG8_LDA(At, 1, 1); PG8_STAGE(PG8_SB(1, 0), b3, voffB); PG8_STAGE(PG8_SB(1, 1), b3 + hstepB, voffB); PG8_STAGE(PG8_SA(1, 0), a3, voffA);
            PG8_WAIT_V(8); PG8_WAIT_L(0); PG8_BAR; PG8_MMA(1, 0, At, B0); PG8_MMA(1, 1, At, B1); PG8_BAR; PG8_SCHED;
            } else {
            PG8_LDB(B0, 0, 0); PG8_SCHED; PG8_LDA(At, 0, 0); PG8_STAGE(PG8_SA(1, 1), a1 + hstepA, voffA);
            PG8_WAIT_L(8); PG8_BAR; PG8_WAIT_L(0); PG8_MMA(0, 0, At, B0); PG8_BAR; PG8_SCHED;
            PG8_LDB(B1, 0, 1); PG8_STAGE(PG8_SB(0, 0), b2, voffB);
            PG8_BAR; PG8_WAIT_L(0); PG8_MMA(0, 1, At, B1); PG8_BAR;
            PG8_LDA(At, 0, 1); PG8_STAGE(PG8_SA(0, 0), a2, voffA);
            PG8_BAR; PG8_WAIT_L(0); PG8_MMA(1, 0, At, B0); PG8_BAR; PG8_SCHED;
            PG8_STAGE(PG8_SB(0, 1), b2 + hstepB, voffB);
            PG8_WAIT_V(6); PG8_BAR; PG8_MMA(1, 1, At, B1); PG8_BAR;
            PG8_LDB(B0, 1, 0); PG8_SCHED; PG8_LDA(At, 1, 0); PG8_STAGE(PG8_SA(0, 1), a2 + hstepA, voffA);
            PG8_WAIT_L(8); PG8_BAR; PG8_WAIT_L(0); PG8_MMA(0, 0, At, B0); PG8_BAR; PG8_SCHED;
            PG8_LDB(B1, 1, 1); PG8_STAGE(PG8_SB(1, 0), b3, voffB);
            PG8_BAR; PG8_WAIT_L(0); PG8_MMA(0, 1, At, B1); PG8_BAR;
            PG8_LDA(At, 1, 1); PG8_STAGE(PG8_SA(1, 0), a3, voffA);
            PG8_BAR; PG8_WAIT_L(0); PG8_MMA(1, 0, At, B0); PG8_BAR; PG8_SCHED;
            PG8_STAGE(PG8_SB(1, 1), b3 + hstepB, voffB);
            PG8_WAIT_V(6); PG8_BAR; PG8_MMA(1, 1, At, B1); PG8_BAR;
            }
        }
        if constexpr (ALIGN_EPI) { if (wr == 0) PG8_BAR; }
        if constexpr (!Epi::AFTER_DRAIN) { E(acc, cur, wr, wc, fr, fq); S.done(cur); }
        if (!has_next) break;
#pragma unroll
        for (int a = 0; a < 2; ++a)
#pragma unroll
            for (int b = 0; b < 2; ++b)
#pragma unroll
                for (int m = 0; m < 4; ++m)
#pragma unroll
                    for (int n = 0; n < 2; ++n) acc[a][b][m][n] = (f32x4){0.f, 0.f, 0.f, 0.f};
        cur = nxt; cA = nA; cB = nB; ++ui;
        if constexpr (ALIGN_EPI) { if (wr == 1) PG8_BAR; }
    }
    PG8_WAIT_V(0);
    if constexpr (!ALIGN_EPI) { if (wr == 0) PG8_BAR; }
    PG8_BAR;
    if constexpr (Epi::AFTER_DRAIN) { E.fused(acc, cur, wr, wc, fr, fq, lds, wid, lane); S.done(cur); }
#undef PG8_SA
#undef PG8_SB
#undef PG8_STAGE
#undef PG8_LDA
#undef PG8_LDB
#undef PG8_MMA
#undef PG8_WAIT_V
#undef PG8_WAIT_L
#undef PG8_BAR
#undef PG8_SCHED
}
}
#include <hip/hip_bf16.h>
#include <cmath>
namespace attn_body {
using bf16=__hip_bfloat16;
using bf16x8=__attribute__((ext_vector_type(8)))short;
using s16x4=__attribute__((ext_vector_type(4)))short;
using f32x16=__attribute__((ext_vector_type(16)))float;
using u32x4=__attribute__((ext_vector_type(4)))unsigned;
constexpr int BATCH=2,NHEAD=16,SEQ=8192,D=64,DM=NHEAD*D;
constexpr int NW=8,QBLK=32,QB=QBLK*NW,KVBLK=64,NQB=SEQ/QB;
constexpr int ATTN_PITCH=DM, ATTN_UNIT_ROWS=QB;
__device__ __forceinline__ int crow(int r,int hi){return (r&3)+8*(r>>2)+4*hi;}
#define SBAR() __builtin_amdgcn_sched_barrier(0)
__device__ __forceinline__ void cmask(f32x16&p0,f32x16&p1,int jb,int qrel,int hi){
  const float NEG=-INFINITY; int kb=64*jb+4*hi;
  #pragma unroll
  for(int r=0;r<16;++r){int kv=kb+(r&3)+8*(r>>2); if(kv>qrel)p0[r]=NEG; if(kv+32>qrel)p1[r]=NEG;}
}

constexpr int NSLOT=3, SLOTB=9216;
constexpr int LDS_K=0, LDS_V=NSLOT*SLOTB, LDS_WS=2*NSLOT*SLOTB, LDS_OST=LDS_WS+NW*64*4, LDS_BYTES=LDS_OST+NW*4096;
constexpr float C2=0.125f*1.4426950408889634f;
__device__ __forceinline__ void glds16(const void*gsrc,unsigned lds_dst){unsigned keep;
  asm volatile("s_mov_b32 %0, m0\n\ts_mov_b32 m0, %2\n\ts_nop 0\n\tglobal_load_lds_dwordx4 %1, off\n\ts_mov_b32 m0, %0":"=&s"(keep):"v"(gsrc),"s"(lds_dst):"memory");}
__device__ __forceinline__ float max3f(float a,float b,float c){float r;asm("v_max3_f32 %0, %1, %2, %3":"=v"(r):"v"(a),"v"(b),"v"(c));return r;}
__device__ __forceinline__ float max2f(float a,float b){float r;asm("v_max_f32_e32 %0, %1, %2":"=v"(r):"v"(a),"v"(b));return r;}
__device__ __forceinline__ float fadd_s(float a,float b){float r;asm("v_add_f32_e32 %0, %1, %2":"=v"(r):"v"(a),"v"(b));return r;}
__device__ __forceinline__ float fsub_s(float a,float b){float r;asm("v_sub_f32_e32 %0, %1, %2":"=v"(r):"v"(a),"v"(b));return r;}
typedef float f32x2_t __attribute__((ext_vector_type(2))); typedef __bf16 bf16x2_t __attribute__((ext_vector_type(2)));
__device__ __forceinline__ unsigned cvtpk_s(float lo,float hi){f32x2_t v={lo,hi};bf16x2_t b=__builtin_convertvector(v,bf16x2_t);return __builtin_bit_cast(unsigned,b);}
#define WAIT_BAR(N) asm volatile("s_waitcnt vmcnt(" #N ") lgkmcnt(0)\n\ts_barrier":::"memory")
#define WAIT_BARW() do{ if(wid==0){WAIT_BAR(3);} else {WAIT_BAR(2);} }while(0)

__device__ __forceinline__ void qkt(f32x16&p0,f32x16&p1,const char*Kslot,const bf16x8*qr,const bf16x8 qe,const f32x16&negm,int r32,int hi){
  const char*kb=Kslot+hi*1024+r32*16;
  #pragma unroll
  for(int d0=0;d0<4;++d0){
    const bf16x8 b0=*reinterpret_cast<const bf16x8*>(kb+d0*2048);
    const bf16x8 b1=*reinterpret_cast<const bf16x8*>(kb+d0*2048+512);
    if(d0==0){p0=__builtin_amdgcn_mfma_f32_32x32x16_bf16(b0,qr[0],negm,0,0,0);p1=__builtin_amdgcn_mfma_f32_32x32x16_bf16(b1,qr[0],negm,0,0,0);}
    else{p0=__builtin_amdgcn_mfma_f32_32x32x16_bf16(b0,qr[d0],p0,0,0,0);p1=__builtin_amdgcn_mfma_f32_32x32x16_bf16(b1,qr[d0],p1,0,0,0);}}
  { const char*ke=Kslot+8192+r32*16; const bf16x8 e0=*reinterpret_cast<const bf16x8*>(ke),e1=*reinterpret_cast<const bf16x8*>(ke+512);
    p0=__builtin_amdgcn_mfma_f32_32x32x16_bf16(e0,qe,p0,0,0,0);p1=__builtin_amdgcn_mfma_f32_32x32x16_bf16(e1,qe,p1,0,0,0);}
}
typedef __attribute__((address_space(3))) const char* lds_cptr;
typedef short v4i16_t __attribute__((ext_vector_type(4)));
__device__ __forceinline__ void kload8(bf16x8*kf,lds_cptr kp){
  kf[0]=*(const __attribute__((address_space(3))) bf16x8*)(kp);      kf[1]=*(const __attribute__((address_space(3))) bf16x8*)(kp+512);
  kf[2]=*(const __attribute__((address_space(3))) bf16x8*)(kp+2048); kf[3]=*(const __attribute__((address_space(3))) bf16x8*)(kp+2560);
  kf[4]=*(const __attribute__((address_space(3))) bf16x8*)(kp+4096); kf[5]=*(const __attribute__((address_space(3))) bf16x8*)(kp+4608);
  kf[6]=*(const __attribute__((address_space(3))) bf16x8*)(kp+6144); kf[7]=*(const __attribute__((address_space(3))) bf16x8*)(kp+6656);
}
__device__ __forceinline__ void kload2(bf16x8*kf,lds_cptr kp,int j){ kf[2*j]=*(const __attribute__((address_space(3))) bf16x8*)(kp+j*2048); kf[2*j+1]=*(const __attribute__((address_space(3))) bf16x8*)(kp+j*2048+512); }
__device__ __forceinline__ s16x4 vtr(lds_cptr p){ return __builtin_bit_cast(s16x4,__builtin_amdgcn_ds_read_tr16_b64_v4i16((__attribute__((address_space(3))) v4i16_t*)p)); }
__device__ __forceinline__ float rowmax(const f32x16&p0,const f32x16&p1){
  float a=max3f(p0[0],p0[1],p1[0]),b=max3f(p0[2],p0[3],p1[1]);a=max3f(a,p1[2],p1[3]);
  #pragma unroll
  for(int r=4;r<16;r+=4){a=max3f(a,p0[r],p0[r+1]);b=max3f(b,p0[r+2],p0[r+3]);a=max3f(a,p1[r],p1[r+1]);b=max3f(b,p1[r+2],p1[r+3]);}
  const float m=max2f(a,b);
  auto rr=__builtin_amdgcn_permlane32_swap(__float_as_uint(m),__float_as_uint(m),false,false);
  return max2f(__uint_as_float(rr[0]),__uint_as_float(rr[1]));
}
__device__ __forceinline__ void pv(f32x16*o,int vb,bf16x8 pa0,bf16x8 pa1,bf16x8 pa2,bf16x8 pa3){
  #pragma unroll
  for(int d0=0;d0<2;++d0){s16x4 lo[4],hi[4];
    #pragma unroll
    for(int ks=0;ks<4;++ks){
      asm volatile("ds_read_b64_tr_b16 %0,%1 offset:%c2":"=&v"(lo[ks]):"v"(vb),"i"(d0*4096+ks*1024):"memory");
      asm volatile("ds_read_b64_tr_b16 %0,%1 offset:%c2":"=&v"(hi[ks]):"v"(vb),"i"(d0*4096+ks*1024+512):"memory");}
    asm volatile("s_waitcnt lgkmcnt(0)":::"memory");SBAR();
    #define PK(k) (bf16x8){lo[k][0],lo[k][1],lo[k][2],lo[k][3],hi[k][0],hi[k][1],hi[k][2],hi[k][3]}
    o[d0]=__builtin_amdgcn_mfma_f32_32x32x16_bf16(pa0,PK(0),o[d0],0,0,0);
    o[d0]=__builtin_amdgcn_mfma_f32_32x32x16_bf16(pa1,PK(1),o[d0],0,0,0);
    o[d0]=__builtin_amdgcn_mfma_f32_32x32x16_bf16(pa2,PK(2),o[d0],0,0,0);
    o[d0]=__builtin_amdgcn_mfma_f32_32x32x16_bf16(pa3,PK(3),o[d0],0,0,0);
    #undef PK
  }
}

#ifndef ATTN_STORE16
#define ATTN_STORE16(p,v) (*(u32x4*)(p)=(v))
#endif
template<int THRL> __device__ __forceinline__ void attn_unit(int b,int h,int qb,const bf16*Q,const bf16*__restrict__ K,const bf16*__restrict__ V,bf16*O,const bf16*__restrict__ GT,const unsigned char*__restrict__ G3,const float*__restrict__ qgain,char*shm,const int tid_in){
  int tid_l=tid_in; asm volatile("":"+v"(tid_l)); const int tid=tid_l,lane=tid&63,r32=lane&31,hi=lane>>5; const int wid=__builtin_amdgcn_readfirstlane(tid>>6);
  const long rowbase=(long)b*SEQ; const int q0=qb*QB;
  const bf16*Qw=Q+(rowbase+q0+wid*QBLK)*DM+h*D;
  const bf16*Kh=K+rowbase*DM+h*D,*Vh=V+rowbase*DM+h*D;
  const unsigned lds0=(unsigned)(uintptr_t)shm;
  float*wsf=(float*)(shm+LDS_WS)+wid*64;
  const bf16*ksrc=Kh+(long)lane*DM+wid*8;
  const bf16*vsrc=Vh+(long)(16*(wid&3)+(lane>>2))*DM+(wid>>2)*32+(lane&3)*8;
  const unsigned kdst=lds0+LDS_K+wid*1024, vdst=lds0+LDS_V+wid*1024, gdst=lds0+LDS_K+8192;
  const unsigned char*gsrc=G3+((long)(b*NHEAD+h)*SEQ+lane)*16;
  #define DMA_K(t,slot) do{ if(wid==0)glds16(gsrc+(long)(t)*KVBLK*16,(unsigned)__builtin_amdgcn_readfirstlane(gdst+(slot))); glds16(ksrc+(long)(t)*KVBLK*DM,(unsigned)__builtin_amdgcn_readfirstlane(kdst+(slot))); }while(0)
  #define DMA_V(t,slot) glds16(vsrc+(long)(t)*KVBLK*DM,(unsigned)__builtin_amdgcn_readfirstlane(vdst+(slot)))
  const int vb0=(int)(lds0+LDS_V)+((lane>>4)&1)*32+(lane&3)*8+(4*hi+((lane&15)>>2))*64;
  const char*Kbase=shm+LDS_K; bf16x8 kf[10];
  const lds_cptr shm3=(lds_cptr)shm; const lds_cptr kp0=shm3+LDS_K+hi*1024+r32*16; const lds_cptr kpe=shm3+LDS_K+8192+r32*16; const lds_cptr vp0=shm3+LDS_V+((lane>>4)&1)*32+(lane&3)*8+(4*hi+((lane&15)>>2))*64;
  const int NT=(q0+QB)/KVBLK;
  DMA_K(0,0);DMA_V(0,0);DMA_K(1,SLOTB);
  bf16x8 qr[4]; float fq2; bf16x8 qe;
  { bf16x8 qraw[4];
    #pragma unroll
    for(int d0=0;d0<4;++d0)qraw[d0]=*reinterpret_cast<const bf16x8*>(&Qw[(long)r32*DM+d0*16+hi*8]);
    const u32x4 ge=*reinterpret_cast<const u32x4*>(G3+((long)(b*NHEAD+h)*SEQ+q0+wid*QBLK+r32)*16);
    fq2=-(__uint_as_float(ge[0]<<16)+__uint_as_float(ge[0]&0xffff0000u)+__uint_as_float(ge[1]<<16));
    float ss=0.f;
    #pragma unroll
    for(int d0=0;d0<4;++d0)
      #pragma unroll
      for(int j=0;j<8;++j){const float x=__uint_as_float(((unsigned)(unsigned short)qraw[d0][j])<<16);ss+=x*x;}
    {auto rr=__builtin_amdgcn_permlane32_swap(__float_as_uint(ss),__float_as_uint(ss),false,false);ss=__uint_as_float(rr[0])+__uint_as_float(rr[1]);}
    const float qs=C2/sqrtf(ss*(1.0f/64.0f)+1e-6f);
    #pragma unroll
    for(int d0=0;d0<4;++d0){ u32x4 w;
      #pragma unroll
      for(int j=0;j<8;j+=2){const float x0=__uint_as_float(((unsigned)(unsigned short)qraw[d0][j])<<16),x1=__uint_as_float(((unsigned)(unsigned short)qraw[d0][j+1])<<16);
        w[j>>1]=cvtpk_s(x0*qs*qgain[d0*16+hi*8+j],x1*qs*qgain[d0*16+hi*8+j+1]);}
      qr[d0]=__builtin_bit_cast(bf16x8,w);}
    const unsigned one2=hi?0u:0x3f803f80u, one1=hi?0u:0x00003f80u; qe=__builtin_bit_cast(bf16x8,(u32x4){one2,one1,0u,0u}); }
  float mhat=0.f,l_reg=0.f;f32x16 o[2];o[0]=f32x16{};o[1]=f32x16{};f32x16 negm;
  #pragma unroll
  for(int r=0;r<16;++r)negm[r]=fq2;
  asm volatile("":"+v"(negm));
  const int qrel=wid*QBLK+r32;
  #define CMASK(P0,P1,t) do{int jb_=(t)-(NT-4); if(jb_>=0)cmask(P0,P1,jb_,qrel,hi);}while(0)
  bool resc=false;
  #define START(P0,P1) do{ const float rm=rowmax(P0,P1); resc=false; \
    { const float dl=rm; mhat=fadd_s(mhat,dl); \
      _Pragma("unroll") for(int r=0;r<16;++r){P0[r]=fsub_s(P0[r],dl);P1[r]=fsub_s(P1[r],dl);} \
      _Pragma("unroll") for(int r=0;r<16;++r)negm[r]=fq2-mhat; asm volatile("":"+v"(negm)); } \
    _Pragma("unroll") for(int r=0;r<16;++r)P0[r]=__builtin_amdgcn_exp2f(P0[r]); }while(0)
  #define RESC() do{ if(resc){ asm volatile("s_waitcnt lgkmcnt(0)":::"memory"); \
      _Pragma("unroll") for(int d_=0;d_<2;++d_) _Pragma("unroll") for(int r=0;r<16;++r)o[d_][r]*=wsf[crow(r,hi)]; } }while(0)
  f32x16 pA0,pA1,pB0,pB1;
  int sl_prev=0,sl_cur=0,sl_next=SLOTB;
  #define ROT() do{sl_prev=sl_cur;sl_cur=sl_next;sl_next=(sl_next==(NSLOT-1)*SLOTB)?0:sl_next+SLOTB;}while(0)
  DMA_K(2,2*SLOTB);
  WAIT_BAR(3);
  qkt(pA0,pA1,Kbase,qr,qe,negm,r32,hi);asm volatile("s_nop 15\n\ts_nop 7":"+v"(pA0),"+v"(pA1));CMASK(pA0,pA1,0);
  START(pA0,pA1);
  _Pragma("unroll") for(int r=0;r<16;++r)pA1[r]=__builtin_amdgcn_exp2f(pA1[r]);
  WAIT_BAR(0);
  DMA_K(3,0);DMA_V(1,SLOTB);
  ROT();
  kload8(kf,kp0+sl_cur);
  kf[8]=*(const __attribute__((address_space(3))) bf16x8*)(kpe+sl_cur); kf[9]=*(const __attribute__((address_space(3))) bf16x8*)(kpe+sl_cur+512);
  WAIT_BARW();
  s16x4 vlo[8],vhi[8]; u32x4 pw0,pw1,pw2,pw3;
  #define PKW(P,B) cvtpk_s(P[B],P[B+1])
  #define PAF(k) __builtin_bit_cast(bf16x8,pw##k)
  #define VFR(i) (bf16x8){vlo[i][0],vlo[i][1],vlo[i][2],vlo[i][3],vhi[i][0],vhi[i][1],vhi[i][2],vhi[i][3]}
  #define PIN(x) asm volatile("":"+v"(x))
  #define MX3(a,b,c) __builtin_fmaxf(__builtin_fmaxf((a),(b)),(c))
  #define GAPA(MF,A0,A1,A2,A3,W0,W1,PW) do{ MF; sacc+=A0; sacc+=A1; sacc+=A2; sacc+=A3; PIN(sacc); W0; W1; PIN(PW); SBAR(); }while(0)
  #define EX(v) __builtin_amdgcn_exp2f(v)
  #define GAPB(MF,X,B) do{ MF; X[B]=EX(X[B]); X[B+1]=EX(X[B+1]); X[B+2]=EX(X[B+2]); X[B+3]=EX(X[B+3]); PIN(X); SBAR(); }while(0)
  #define VRD(i) do{ vlo[i]=vtr(vp_+(((i)>>2)*4096+((i)&3)*1024)); vhi[i]=vtr(vp_+(((i)>>2)*4096+((i)&3)*1024+512)); }while(0)
  #define KRD(G,j) do{ if(G){ kload2(kf,kp0+sl_next,j); SBAR(); } }while(0)
  #define STEP(C0,C1,P0,P1,t,GK,GV,GL) do{ SBAR(); \
    const lds_cptr vp_=vp0+sl_prev; \
    VRD(0); SBAR(); float sacc=(P0[0]+P0[1]); \
    GAPA(C0=__builtin_amdgcn_mfma_f32_32x32x16_bf16(kf[0],qr[0],negm,0,0,0), P0[2],P0[3],P0[4],P0[5],     pw0[0]=PKW(P0,0), pw0[1]=PKW(P0,2), pw0); \
    VRD(4); SBAR(); GAPA(C1=__builtin_amdgcn_mfma_f32_32x32x16_bf16(kf[1],qr[0],negm,0,0,0), P0[6],P0[7],P0[8],P0[9],     pw0[2]=PKW(P0,4), pw0[3]=PKW(P0,6), pw0); \
    VRD(1); SBAR(); GAPA(C0=__builtin_amdgcn_mfma_f32_32x32x16_bf16(kf[2],qr[1],C0,0,0,0),   P0[10],P0[11],P0[12],P0[13], pw1[0]=PKW(P0,8), pw1[1]=PKW(P0,10), pw1); \
    VRD(5); SBAR(); GAPA(C1=__builtin_amdgcn_mfma_f32_32x32x16_bf16(kf[3],qr[1],C1,0,0,0),   P0[14],P0[15],P1[0],P1[1],   pw1[2]=PKW(P0,12),pw1[3]=PKW(P0,14), pw1); \
    VRD(2); SBAR(); GAPA(C0=__builtin_amdgcn_mfma_f32_32x32x16_bf16(kf[4],qr[2],C0,0,0,0),   P1[2],P1[3],P1[4],P1[5],     pw2[0]=PKW(P1,0), pw2[1]=PKW(P1,2), pw2); \
    VRD(6); SBAR(); GAPA(C1=__builtin_amdgcn_mfma_f32_32x32x16_bf16(kf[5],qr[2],C1,0,0,0),   P1[6],P1[7],P1[8],P1[9],     pw2[2]=PKW(P1,4), pw2[3]=PKW(P1,6), pw2); \
    VRD(3); SBAR(); GAPA(C0=__builtin_amdgcn_mfma_f32_32x32x16_bf16(kf[6],qr[3],C0,0,0,0),   P1[10],P1[11],P1[12],P1[13], pw3[0]=PKW(P1,8), pw3[1]=PKW(P1,10), pw3); \
    VRD(7); SBAR(); GAPA(C1=__builtin_amdgcn_mfma_f32_32x32x16_bf16(kf[7],qr[3],C1,0,0,0),   P1[14],P1[15],0.f,0.f,       pw3[2]=PKW(P1,12),pw3[3]=PKW(P1,14), pw3); \
    C0=__builtin_amdgcn_mfma_f32_32x32x16_bf16(kf[8],qe,C0,0,0,0); C1=__builtin_amdgcn_mfma_f32_32x32x16_bf16(kf[9],qe,C1,0,0,0); \
    l_reg+=sacc; \
    if(GK){DMA_K((t)+3,sl_cur);} if(GV){DMA_V((t)+1,sl_next);} \
    CMASK(C0,C1,t); \
    { float a=MX3(C0[0],C0[1],C1[0]),b=MX3(C0[2],C0[3],C1[1]); a=MX3(a,C1[2],C1[3]); \
      _Pragma("unroll") for(int r=4;r<16;r+=4){a=MX3(a,C0[r],C0[r+1]);b=MX3(b,C0[r+2],C0[r+3]);a=MX3(a,C1[r],C1[r+1]);b=MX3(b,C1[r+2],C1[r+3]);} \
      float rm=__builtin_fmaxf(a,b); { auto rr=__builtin_amdgcn_permlane32_swap(__float_as_uint(rm),__float_as_uint(rm),false,false); rm=__builtin_fmaxf(__uint_as_float(rr[0]),__uint_as_float(rr[1])); } \
      resc=false; \
      if(__builtin_expect(__any(rm>(float)THRL),0)){ const float dl=__builtin_fmaxf(rm,0.f); mhat+=dl; \
        _Pragma("unroll") for(int r=0;r<16;++r){C0[r]-=dl;C1[r]-=dl;} \
        _Pragma("unroll") for(int r=0;r<16;++r)negm[r]=fq2-mhat; asm volatile("":"+v"(negm)); \
        const float f=__builtin_amdgcn_exp2f(-dl); l_reg*=f; if(hi==0)wsf[r32]=f; resc=true; } } \
    SBAR(); \
    GAPB(o[0]=__builtin_amdgcn_mfma_f32_32x32x16_bf16(PAF(0),VFR(0),o[0],0,0,0), C0,0); \
    GAPB(o[1]=__builtin_amdgcn_mfma_f32_32x32x16_bf16(PAF(0),VFR(4),o[1],0,0,0), C0,4); \
    KRD(GL,0); GAPB(o[0]=__builtin_amdgcn_mfma_f32_32x32x16_bf16(PAF(1),VFR(1),o[0],0,0,0), C0,8); \
    KRD(GL,1); GAPB(o[1]=__builtin_amdgcn_mfma_f32_32x32x16_bf16(PAF(1),VFR(5),o[1],0,0,0), C0,12); \
    KRD(GL,2); GAPB(o[0]=__builtin_amdgcn_mfma_f32_32x32x16_bf16(PAF(2),VFR(2),o[0],0,0,0), C1,0); \
    KRD(GL,3); GAPB(o[1]=__builtin_amdgcn_mfma_f32_32x32x16_bf16(PAF(2),VFR(6),o[1],0,0,0), C1,4); \
    if(GL){ kf[8]=*(const __attribute__((address_space(3))) bf16x8*)(kpe+sl_next); kf[9]=*(const __attribute__((address_space(3))) bf16x8*)(kpe+sl_next+512); SBAR(); } \
    GAPB(o[0]=__builtin_amdgcn_mfma_f32_32x32x16_bf16(PAF(3),VFR(3),o[0],0,0,0), C1,8); \
    GAPB(o[1]=__builtin_amdgcn_mfma_f32_32x32x16_bf16(PAF(3),VFR(7),o[1],0,0,0), C1,12); \
    }while(0)
  int t=1;
  #undef CMASK
  #define CMASK(P0,P1,t) do{}while(0)
  for(;t+5<NT;t+=2){
    STEP(pB0,pB1,pA0,pA1,t,true,true,true);     WAIT_BARW(); RESC(); ROT();
    STEP(pA0,pA1,pB0,pB1,t+1,true,true,true);   WAIT_BARW(); RESC(); ROT();
  }
  #undef CMASK
  #define CMASK(P0,P1,t) do{int jb_=(t)-(NT-4); if(jb_>=0)cmask(P0,P1,jb_,qrel,hi);}while(0)
  #define ENDW(tt) do{ if((tt)+3<NT){WAIT_BARW();} else if((tt)+2<NT){WAIT_BAR(1);} else {WAIT_BAR(0);} }while(0)
  for(;t+1<NT;t+=2){
    STEP(pB0,pB1,pA0,pA1,t,(t+3<NT),(t+1<NT),(t+1<NT));       ENDW(t);   RESC(); ROT();
    STEP(pA0,pA1,pB0,pB1,t+1,(t+4<NT),(t+2<NT),(t+2<NT));     ENDW(t+1); RESC(); ROT();
  }
  STEP(pB0,pB1,pA0,pA1,NT-1,false,false,false); RESC();
  { float sacc=pB0[0]+pB0[1]; _Pragma("unroll") for(int r=2;r<16;++r)sacc+=pB0[r]; _Pragma("unroll") for(int r=0;r<16;++r)sacc+=pB1[r]; l_reg+=sacc;
    pw0=(u32x4){PKW(pB0,0),PKW(pB0,2),PKW(pB0,4),PKW(pB0,6)};pw1=(u32x4){PKW(pB0,8),PKW(pB0,10),PKW(pB0,12),PKW(pB0,14)};pw2=(u32x4){PKW(pB1,0),PKW(pB1,2),PKW(pB1,4),PKW(pB1,6)};pw3=(u32x4){PKW(pB1,8),PKW(pB1,10),PKW(pB1,12),PKW(pB1,14)};
    SBAR(); pv(o,vb0+sl_cur,PAF(0),PAF(1),PAF(2),PAF(3)); }
  #undef PKW
  #undef PAF
  #undef VFR
  #undef PIN
  #undef MX3
  #undef GAPA
  #undef GAPB
  #undef EX
  #undef VRD
  #undef KRD
  #undef STEP
  #undef ENDW
  {auto rr=__builtin_amdgcn_permlane32_swap(__float_as_uint(l_reg),__float_as_uint(l_reg),false,false);l_reg=__uint_as_float(rr[0])+__uint_as_float(rr[1]);}
  if(hi==0)wsf[32+r32]=l_reg;asm volatile("s_waitcnt lgkmcnt(0)":::"memory");
  float rli[16];
  #pragma unroll
  for(int r=0;r<16;++r)rli[r]=__builtin_amdgcn_rcpf(wsf[32+crow(r,hi)]);
  bf16*Ow=O+(rowbase+q0+wid*QBLK)*DM+h*D;
  { bf16*stg=(bf16*)(shm+LDS_OST)+wid*2048;
    #pragma unroll
    for(int r=0;r<16;++r){const int orow=crow(r,hi);
      #pragma unroll
      for(int d0=0;d0<2;++d0)stg[orow*64+d0*32+r32]=__float2bfloat16(o[d0][r]*rli[r]);}
    asm volatile("s_waitcnt lgkmcnt(0)":::"memory");
    const bf16*Gw=GT+(rowbase+q0+wid*QBLK)*DM+h*D;
    #pragma unroll
    for(int i=0;i<4;++i){const int row=i*8+(lane>>3),ch=lane&7; u32x4 v=*(const u32x4*)(stg+row*64+ch*8); const u32x4 gg=*(const u32x4*)(Gw+(long)row*DM+ch*8);
      #pragma unroll
      for(int j=0;j<4;++j){ v[j]=cvtpk_s(__uint_as_float(v[j]<<16)*__uint_as_float(gg[j]<<16),__uint_as_float(v[j]&0xffff0000u)*__uint_as_float(gg[j]&0xffff0000u)); }
      ATTN_STORE16(Ow+(long)row*DM+ch*8,v);} }
  asm volatile("s_waitcnt lgkmcnt(0)\n\ts_barrier":::"memory");
  #undef DMA_K
  #undef DMA_V
  #undef CMASK
  #undef START
  #undef RESC
  #undef ROT
}
constexpr int ATTN_LDS_BYTES=LDS_BYTES;
struct AttnTensors { const bf16* Q; const bf16* K; const bf16* V; bf16* O; const bf16* GT; const unsigned char* G3; const float* qgain; };
struct AttnUnit { int bh; int qb; };
struct StaticOrder {
  int vcu;
  __device__ __forceinline__ explicit StaticOrder(int grid,int block):vcu((block%8)*(grid/8)+block/8){}
  __device__ __forceinline__ bool next(int i,AttnUnit&u)const{ if(i>=4)return false; const int s=vcu&7; u.bh=vcu>>3; u.qb=(i==0)?s:(i==1)?15-s:(i==2)?16+s:31-s; return true; }
  __device__ __forceinline__ void a_ready(const AttnUnit&)const{}
  __device__ __forceinline__ void done(const AttnUnit&)const{}
};
template<class Sched,int THRL=8> __device__ __forceinline__ void attn_phase(char*lds,const AttnTensors&T,const Sched&S,const int tid_in){
  AttnUnit u;
  for(int i=0;S.next(i,u);++i){ S.a_ready(u); attn_unit<THRL>(u.bh/NHEAD,u.bh%NHEAD,u.qb,T.Q,T.K,T.V,T.O,T.GT,T.G3,T.qgain,lds,tid_in); S.done(u); }
}
#undef SBAR
#undef WAIT_BAR
#undef WAIT_BARW
}
constexpr int NWAVES = 8;
constexpr int BATCH = 2, T = 8192, D = 1024, H = 16, HD = 64, FF = 4096, M = BATCH * T;
constexpr int N1 = 3584, K1 = 2048, NP2 = 3072;
constexpr size_t MiB = 1u << 20;
constexpr size_t WS_MOD = 0;
constexpr size_t WS_W1 = 1 * MiB;
constexpr size_t WS_W2A = 29 * MiB;
constexpr size_t WS_W2G = 32 * MiB;
constexpr size_t WS_WO = 33 * MiB;
constexpr size_t WS_WKV = 37 * MiB;
constexpr size_t WS_WQG = 42 * MiB;
constexpr size_t WS_WO2 = 50 * MiB;
constexpr size_t WS_WUP = 54 * MiB, WS_WDN = 62 * MiB;
constexpr size_t WS_G3 = 70 * MiB;
constexpr size_t WS_FL = 74 * MiB;
constexpr size_t WS_H2 = 76 * MiB;
constexpr size_t WS_P1 = 140 * MiB;
constexpr size_t WS_P2 = 252 * MiB;
constexpr size_t WS_VF = 348 * MiB;
constexpr size_t WS_HB = 140 * MiB;
constexpr size_t WS_KVRAW = 140 * MiB, WS_QB = 204 * MiB, WS_GT = 236 * MiB, WS_VS = 316 * MiB, WS_KS = 348 * MiB;
constexpr size_t WS_END = 380 * MiB;
constexpr int LDS_BYTES = 147456;

#define GAS __attribute__((address_space(1)))
#define LAS __attribute__((address_space(3)))
typedef unsigned short bf16;
typedef unsigned v4u __attribute__((ext_vector_type(4)));
typedef unsigned v2u __attribute__((ext_vector_type(2)));
typedef float f32x4 __attribute__((ext_vector_type(4)));
using pg8::pkbf; using pg8::bflo; using pg8::bfhi; using pg8::sigm;

struct Args { const float* in[39]; float* out; unsigned char* ws; int ph_lo, ph_hi; };

struct Frame { LAS unsigned char* lds; int tid, lane, wave, vcu, G, bx; unsigned char* ws; float* out; const float* const* in; };

__device__ __forceinline__ void tr_item(const float* W, int ldw, int Nvalid, bf16* WT, int ldt, int row_off, int col_off, const float* mu, LAS float* scr, int item, int lane) {
    const int nblk = (Nvalid + 31) / 32, kb = item / nblk, nb = item % nblk, k0 = 64 * kb, n0 = 32 * nb;
#pragma unroll 8
    for (int i = 0; i < 32; ++i) { const int kk = 2 * i + (lane >> 5), n = n0 + (lane & 31); scr[kk * 33 + (lane & 31)] = n < Nvalid ? W[(size_t)(k0 + kk) * ldw + n] : 0.f; }
    asm volatile("s_waitcnt lgkmcnt(0)" ::: "memory");
    const int c = lane & 7;
    float s0[8], s1[8];
#pragma unroll
    for (int q = 0; q < 8; ++q) { const float m = mu ? mu[k0 + 8 * c + q] : 0.f; s0[q] = 1.f - m; s1[q] = m; }
#pragma unroll
    for (int j = 0; j < 4; ++j) { const int n = (lane >> 3) + 8 * j; const LAS float* s = scr + (8 * c) * 33 + n;
        float v[8];
#pragma unroll
        for (int q = 0; q < 8; ++q) v[q] = s[q * 33];
        v4u o; o.x = pkbf(v[0] * s0[0], v[1] * s0[1]); o.y = pkbf(v[2] * s0[2], v[3] * s0[3]); o.z = pkbf(v[4] * s0[4], v[5] * s0[5]); o.w = pkbf(v[6] * s0[6], v[7] * s0[7]);
        bf16* dst = WT + (size_t)(row_off + n0 + n) * ldt + col_off + k0 + 8 * c;
        *(v4u*)dst = o;
        if (mu) { v4u p; p.x = pkbf(v[0] * s1[0], v[1] * s1[1]); p.y = pkbf(v[2] * s1[2], v[3] * s1[3]); p.z = pkbf(v[4] * s1[4], v[5] * s1[5]); p.w = pkbf(v[6] * s1[6], v[7] * s1[7]); *(v4u*)(dst + 1024) = p; } }
    asm volatile("s_waitcnt lgkmcnt(0)" ::: "memory");
}
__device__ __forceinline__ float dpp_f(float x, const int ctrl_sel) {
    switch (ctrl_sel) {
        case 0: return __builtin_bit_cast(float, __builtin_amdgcn_update_dpp(0, __builtin_bit_cast(int, x), 0xB1, 0xf, 0xf, false));
        case 1: return __builtin_bit_cast(float, __builtin_amdgcn_update_dpp(0, __builtin_bit_cast(int, x), 0x4E, 0xf, 0xf, false));
        case 2: return __builtin_bit_cast(float, __builtin_amdgcn_update_dpp(0, __builtin_bit_cast(int, x), 0x141, 0xf, 0xf, false));
        default: return __builtin_bit_cast(float, __builtin_amdgcn_update_dpp(0, __builtin_bit_cast(int, x), 0x140, 0xf, 0xf, false));
    }
}
__device__ __forceinline__ float sum4(float x) { x += dpp_f(x, 0); x += dpp_f(x, 1); return x; }
__device__ __forceinline__ float sum8(float x) { x = sum4(x); x += dpp_f(x, 2); return x; }
__device__ __forceinline__ float sum16(float x) { x = sum8(x); x += dpp_f(x, 3); return x; }
__device__ __forceinline__ float wave_sum(float v) {
    v = sum16(v);
    { auto rr = __builtin_amdgcn_permlane16_swap(__float_as_uint(v), __float_as_uint(v), false, false); v = __uint_as_float(rr[0]) + __uint_as_float(rr[1]); }
    { auto rr = __builtin_amdgcn_permlane32_swap(__float_as_uint(v), __float_as_uint(v), false, false); v = __uint_as_float(rr[0]) + __uint_as_float(rr[1]); }
    return v;
}
__device__ __forceinline__ void norm_row(const float* xrow, const float* g, const float* sh, const float* sc, int lane, f32x4 (&v)[4]) {
    float s = 0.f;
#pragma unroll
    for (int j = 0; j < 4; ++j) { v[j] = *((const f32x4*)xrow + lane + 64 * j); s += (v[j].x * v[j].x + v[j].y * v[j].y) + (v[j].z * v[j].z + v[j].w * v[j].w); }
    const float rstd = 1.0f / sqrtf(wave_sum(s) * (1.f / D) + 1e-6f);
#pragma unroll
    for (int j = 0; j < 4; ++j) { const f32x4 gg = *((const f32x4*)g + lane + 64 * j);
        f32x4 a = {1.f, 1.f, 1.f, 1.f}, b = {0.f, 0.f, 0.f, 0.f}; if (sc) { a = *((const f32x4*)sc + lane + 64 * j) + 1.0f; b = *((const f32x4*)sh + lane + 64 * j); }
        v[j] = (v[j] * rstd * gg) * a + b; }
}
__device__ __forceinline__ void st_row_bf16(bf16* orow, int lane, const f32x4 (&v)[4]) {
#pragma unroll
    for (int j = 0; j < 4; ++j) { v2u w; w.x = pkbf(v[j].x, v[j].y); w.y = pkbf(v[j].z, v[j].w); *((v2u*)orow + lane + 64 * j) = w; }
}
__device__ __forceinline__ void p0_mod(Frame& F) {
    LAS float* ca = (LAS float*)F.lds; LAS float* red = (LAS float*)(F.lds + 8192);
    const float* cin = F.in[1];
    for (int i = F.tid; i < 2048; i += 512) { const float c = cin[i]; ca[i] = c / (1.0f + __expf(-c)); }
    __syncthreads();
    float* MOD = (float*)(F.ws + WS_MOD); float* MODKV = MOD + 4 * 2 * 6144;
    for (int item = F.bx; item < 208; item += F.G) {
        const int col = item * 128; const float* W; const float* bias; int ldw, cw; float* dst0; float* dst1;
        if (col < 24576) { const int l = col / 6144; cw = col % 6144; W = F.in[2] + (size_t)l * 1024 * 6144; ldw = 6144; bias = F.in[3] + l * 6144; dst0 = MOD + (l * 2 + 0) * 6144 + cw; dst1 = MOD + (l * 2 + 1) * 6144 + cw; }
        else { cw = col - 24576; W = F.in[30]; ldw = 2048; bias = F.in[31]; dst0 = MODKV + cw; dst1 = MODKV + 2048 + cw; }
        const int c4 = F.tid & 31, ks = F.tid >> 5;
        f32x4 a0 = {0.f, 0.f, 0.f, 0.f}, a1 = {0.f, 0.f, 0.f, 0.f};
#pragma unroll 8
        for (int k = ks * 64; k < ks * 64 + 64; ++k) { const f32x4 w = *(const f32x4*)(W + (size_t)k * ldw + cw + c4 * 4); a0 += w * ca[k]; a1 += w * ca[1024 + k]; }
        *(LAS f32x4*)(red + (ks * 32 + c4) * 8) = a0; *(LAS f32x4*)(red + (ks * 32 + c4) * 8 + 4) = a1;
        __syncthreads();
        if (F.tid < 256) { const int b = F.tid >> 7, c = F.tid & 127; float s = 0.f;
#pragma unroll
            for (int q = 0; q < 16; ++q) s += red[(q * 32 + (c >> 2)) * 8 + b * 4 + (c & 3)];
            (b ? dst1 : dst0)[c] = s + bias[cw + c]; }
        __syncthreads();
    }
}
__device__ __forceinline__ void p0_weights(Frame& F) {
    LAS float* scr = (LAS float*)(F.lds + 16384 + F.wave * 16384);
    const int gw = F.vcu * NWAVES + F.wave, NGW = F.G * NWAVES;
    bf16* W1 = (bf16*)(F.ws + WS_W1); bf16* WO = (bf16*)(F.ws + WS_WO); bf16* WKV = (bf16*)(F.ws + WS_WKV); bf16* WQG = (bf16*)(F.ws + WS_WQG); bf16* WO2 = (bf16*)(F.ws + WS_WO2);
    const float* mu = F.in[8];
    constexpr int PL = 512 * 3 + 32 + 32 + 16 + 80 + 512;
    constexpr int NIT = 2 * PL + 512 + 512 + 16 + 2 * (1024 + 512);
    for (int it = gw; it < NIT; it += NGW) {
        int r = it;
        if (r < 2 * PL) { const int i = r / PL; r -= i * PL; bf16* w1 = W1 + (size_t)i * N1 * K1; const float* m6 = mu + i * 6 * 1024;
            if (r < 512) { tr_item(F.in[9] + (size_t)i * D * D, D, D, w1, K1, 0, 0, m6 + 0 * 1024, scr, r, F.lane); continue; } r -= 512;
            if (r < 512) { tr_item(F.in[10] + (size_t)i * D * D, D, D, w1, K1, 1024, 0, m6 + 2 * 1024, scr, r, F.lane); continue; } r -= 512;
            if (r < 512) { tr_item(F.in[11] + (size_t)i * D * D, D, D, w1, K1, 2048, 0, m6 + 3 * 1024, scr, r, F.lane); continue; } r -= 512;
            if (r < 32) { tr_item(F.in[14] + (size_t)i * D * 64, 64, 64, w1, K1, 3072, 0, m6 + 1 * 1024, scr, r, F.lane); continue; } r -= 32;
            if (r < 32) { tr_item(F.in[17] + (size_t)i * D * 64, 64, 64, w1, K1, 3136, 0, m6 + 4 * 1024, scr, r, F.lane); continue; } r -= 32;
            if (r < 16) { if (i == 1) tr_item(F.in[27], 32, 32, w1, K1, 3200, 0, m6 + 3 * 1024, scr, r, F.lane); continue; } r -= 16;
            if (r < 80) { tr_item(F.in[19] + (size_t)i * D * 160, 160, 160, w1, K1, 3232, 0, m6 + 5 * 1024, scr, r, F.lane); continue; } r -= 80;
            tr_item(F.in[12] + (size_t)i * D * D, D, D, WO + (size_t)i * D * D, D, 0, 0, nullptr, scr, r, F.lane); continue; }
        r -= 2 * PL;
        if (r < 512) { tr_item(F.in[32], 2064, 1024, WKV, D, 0, 0, nullptr, scr, r, F.lane); continue; } r -= 512;
        if (r < 512) { tr_item(F.in[32] + 1024, 2064, 1024, WKV, D, 1024, 0, nullptr, scr, r, F.lane); continue; } r -= 512;
        if (r < 16) { tr_item(F.in[32] + 2048, 2064, 16, WKV, D, 2048, 0, nullptr, scr, r, F.lane); continue; } r -= 16;
        { const int j = r / 1536; r -= j * 1536;
          if (r < 1024) tr_item(F.in[35] + (size_t)j * D * 2048, 2048, 2048, WQG + (size_t)j * 2048 * D, D, 0, 0, nullptr, scr, r, F.lane);
          else tr_item(F.in[37] + (size_t)j * D * D, D, D, WO2 + (size_t)j * D * D, D, 0, 0, nullptr, scr, r - 1024, F.lane); }
    }
    const int gt = F.bx * 512 + F.tid, NT = F.G * 512; const v4u z = {0u, 0u, 0u, 0u};
    for (int e = gt; e < 135168; e += NT) {
        int r = e; bf16* p;
        if (r < 98304) { const int i = r / 49152; r -= i * 49152; p = W1 + (size_t)i * N1 * K1 + (size_t)3392 * K1 + (size_t)r * 8; }
        else if (r < 98304 + 8192) { r -= 98304; p = W1 + (size_t)3200 * K1 + (size_t)r * 8; }
        else { r -= 98304 + 8192; p = WKV + (size_t)2080 * D + (size_t)r * 8; }
        *(v4u*)p = z; }
    { float* B2 = (float*)(F.ws + WS_MOD) + 53248;
      for (int e = gt; e < 2 * 3072; e += NT) { const int i = e / 3072, n = e % 3072, grp = n >> 10, c = n & 1023;
          B2[e] = grp == 0 ? F.in[13][i * D + c] : (grp == 1 ? F.in[16][i * D + c] : (i == 1 ? F.in[26][c] : 0.f)); } }
    bf16* W2A = (bf16*)(F.ws + WS_W2A); bf16* W2G = (bf16*)(F.ws + WS_W2G);
    for (int e = gt; e < 2 * 1048576; e += NT) {
        const int i = e >> 20; int r = e & 1048575;
        if (r < 786432) { const int k = r / 3072, n = r % 3072, grp = n >> 10, c = n & 1023; float v = 0.f;
            if (grp == 0) { if (k < 64) v = F.in[15][((size_t)i * 64 + k) * 1024 + c]; }
            else if (grp == 1) { if (k >= 64 && k < 128) v = F.in[18][((size_t)i * 64 + (k - 64)) * 1024 + c]; }
            else { if (i == 1 && k >= 128 && k < 160) v = F.in[28][(size_t)(k - 128) * 1024 + c]; }
            W2A[(size_t)i * 3072 * 256 + (size_t)n * 256 + k] = (bf16)(pkbf(v, 0.f) & 0xffffu); }
        else { r -= 786432; const int k = r >> 10, n = r & 1023; const float v = k < 160 ? F.in[20][((size_t)i * 160 + k) * 1024 + n] : 0.f;
            W2G[(size_t)i * 1024 * 256 + (size_t)n * 256 + k] = (bf16)(pkbf(v, 0.f) & 0xffffu); }
    }
}
__device__ __forceinline__ void mlp_weights(Frame& F, int L) {
    LAS float* scr = (LAS float*)(F.lds + F.wave * 16384);
    const int gw = F.vcu * NWAVES + F.wave, NGW = F.G * NWAVES;
    bf16* WUP = (bf16*)(F.ws + WS_WUP); bf16* WDN = (bf16*)(F.ws + WS_WDN);
    for (int it = gw; it < 4096; it += NGW) {
        if (it < 2048) tr_item(F.in[6] + (size_t)L * D * FF, FF, FF, WUP, D, 0, 0, nullptr, scr, it, F.lane);
        else tr_item(F.in[7] + (size_t)L * FF * D, D, D, WDN, FF, 0, 0, nullptr, scr, it - 2048, F.lane);
    }
}
__device__ __forceinline__ void norm_phase(Frame& F, const float* xin, const float* g, const float* sh, const float* sc, int bstride, int mode, bf16* dst) {
    const int gw = F.vcu * NWAVES + F.wave, NGW = F.G * NWAVES;
    for (int m = gw; m < M; m += NGW) {
        const int b = m >> 13; f32x4 v[4];
        norm_row(xin + (size_t)m * D, g, sh ? sh + b * bstride : nullptr, sc ? sc + b * bstride : nullptr, F.lane, v);
        if (mode == 0) {
            st_row_bf16(dst + (size_t)m * 2048, F.lane, v);
            if ((m & 8191) != 8191) st_row_bf16(dst + (size_t)(m + 1) * 2048 + 1024, F.lane, v);
            if ((m & 8191) == 0) { const v2u z = {0u, 0u};
#pragma unroll
                for (int j = 0; j < 4; ++j) *((v2u*)(dst + (size_t)m * 2048 + 1024) + F.lane + 64 * j) = z; }
        } else st_row_bf16(dst + (size_t)m * 1024, F.lane, v);
    }
}
__device__ __forceinline__ void final_norm_phase(Frame& F) {
    const int gw = F.vcu * NWAVES + F.wave, NGW = F.G * NWAVES;
    for (int m = gw; m < M; m += NGW) { f32x4 v[4]; norm_row(F.out + (size_t)m * D, F.in[38], nullptr, nullptr, F.lane, v);
#pragma unroll
        for (int j = 0; j < 4; ++j) *((f32x4*)(F.out + (size_t)m * D) + F.lane + 64 * j) = v[j]; }
}
constexpr int SC_C = 32, SC_NC = T / SC_C;
constexpr int SC_W = 0, SC_A = 8192, SC_B = 16384, SC_K = 24576, SC_R = 32768, SC_V = 40960, SC_Y = 41984, SC_BUF = 58368;
__device__ __forceinline__ void scan_phase(Frame& F, int L) {
    const bf16* P1 = (const bf16*)(F.ws + WS_P1); const bf16* P2 = (const bf16*)(F.ws + WS_P2); const bf16* VF = (const bf16*)(F.ws + WS_VF); float* Y = (float*)(F.ws + WS_H2);
    const float* kkw = F.in[21] + L * D; const float* kaw = F.in[22] + L * D;
    const int tid = F.tid, lane = F.lane, wave = F.wave;
    for (int item = F.bx; item < 256; item += F.G) {
        const int bh = (item & 7) + 8 * (item >> 6), rg = (item >> 3) & 7, b = bh >> 4, h = bh & 15;
        const size_t m0 = (size_t)b * T;
        const int hidx = tid - 128, htt = (hidx >> 3) & 31, hc8 = hidx & 7;
        const int vtt = lane >> 1, vr4 = (lane & 1) * 4;
        float ckk[8], cka[8];
        v4u lr = {0u,0u,0u,0u}, lk = {0u,0u,0u,0u}, lw = {0u,0u,0u,0u}, la = {0u,0u,0u,0u}; v2u lv = {0u,0u}, lvm = {0u,0u}, lvf = {0u,0u};
        if (wave >= 2 && wave < 6) {
#pragma unroll
            for (int j = 0; j < 8; ++j) { ckk[j] = kkw[h * 64 + hc8 * 8 + j]; cka[j] = kaw[h * 64 + hc8 * 8 + j]; } }
#define SC_LOAD(c) do { \
        if (wave >= 2 && wave < 6) { const size_t m = m0 + (size_t)(c) * SC_C + htt; const bf16* p1 = P1 + m * N1 + h * 64 + hc8 * 8; const bf16* p2 = P2 + m * NP2 + h * 64 + hc8 * 8; \
            lr = *(const v4u*)p1; lk = *(const v4u*)(p1 + 1024); lw = *(const v4u*)p2; la = *(const v4u*)(p2 + 1024); } \
        else if (wave == 6) { const size_t m = m0 + (size_t)(c) * SC_C + vtt; const int cc = h * 64 + rg * 8 + vr4; \
            lv = *(const v2u*)(P1 + m * N1 + 2048 + cc); if (L == 1) { lvm = *(const v2u*)(P2 + m * NP2 + 2048 + cc); lvf = *(const v2u*)(VF + m * D + cc); } } } while (0)
#define SC_PREP(buf) do { LAS unsigned char* B_ = F.lds + (buf) * SC_BUF; \
        if (wave >= 2 && wave < 6) { float kr[8], av[8], wn[8], rv[8]; \
            kr[0] = bflo(lk.x); kr[1] = bfhi(lk.x); kr[2] = bflo(lk.y); kr[3] = bfhi(lk.y); kr[4] = bflo(lk.z); kr[5] = bfhi(lk.z); kr[6] = bflo(lk.w); kr[7] = bfhi(lk.w); \
            av[0] = bflo(la.x); av[1] = bfhi(la.x); av[2] = bflo(la.y); av[3] = bfhi(la.y); av[4] = bflo(la.z); av[5] = bfhi(la.z); av[6] = bflo(la.w); av[7] = bfhi(la.w); \
            wn[0] = bflo(lw.x); wn[1] = bfhi(lw.x); wn[2] = bflo(lw.y); wn[3] = bfhi(lw.y); wn[4] = bflo(lw.z); wn[5] = bfhi(lw.z); wn[6] = bflo(lw.w); wn[7] = bfhi(lw.w); \
            rv[0] = bflo(lr.x); rv[1] = bfhi(lr.x); rv[2] = bflo(lr.y); rv[3] = bfhi(lr.y); rv[4] = bflo(lr.z); rv[5] = bfhi(lr.z); rv[6] = bflo(lr.w); rv[7] = bfhi(lr.w); \
            float kv_[8], ss = 0.f; \
            _Pragma("unroll") for (int j = 0; j < 8; ++j) { kv_[j] = kr[j] * ckk[j]; ss += kv_[j] * kv_[j]; } \
            ss = sum8(ss); const float inv = 1.0f / fmaxf(sqrtf(ss), 1e-12f); \
            float oa[8], ob[8], ok[8], ow[8]; \
            _Pragma("unroll") for (int j = 0; j < 8; ++j) { const float kk = kv_[j] * inv; oa[j] = -kk; ob[j] = kk * av[j]; ok[j] = kr[j] * (1.0f + (av[j] - 1.0f) * cka[j]); ow[j] = __expf(wn[j]); } \
            const int o_ = (htt * 64 + hc8 * 8) * 4; \
            *(LAS f32x4*)(B_ + SC_W + o_) = (f32x4){ow[0], ow[1], ow[2], ow[3]}; *(LAS f32x4*)(B_ + SC_W + o_ + 16) = (f32x4){ow[4], ow[5], ow[6], ow[7]}; \
            *(LAS f32x4*)(B_ + SC_A + o_) = (f32x4){oa[0], oa[1], oa[2], oa[3]}; *(LAS f32x4*)(B_ + SC_A + o_ + 16) = (f32x4){oa[4], oa[5], oa[6], oa[7]}; \
            *(LAS f32x4*)(B_ + SC_B + o_) = (f32x4){ob[0], ob[1], ob[2], ob[3]}; *(LAS f32x4*)(B_ + SC_B + o_ + 16) = (f32x4){ob[4], ob[5], ob[6], ob[7]}; \
            *(LAS f32x4*)(B_ + SC_K + o_) = (f32x4){ok[0], ok[1], ok[2], ok[3]}; *(LAS f32x4*)(B_ + SC_K + o_ + 16) = (f32x4){ok[4], ok[5], ok[6], ok[7]}; \
            *(LAS f32x4*)(B_ + SC_R + o_) = (f32x4){rv[0], rv[1], rv[2], rv[3]}; *(LAS f32x4*)(B_ + SC_R + o_ + 16) = (f32x4){rv[4], rv[5], rv[6], rv[7]}; } \
        else if (wave == 6) { float v_[4] = {bflo(lv.x), bfhi(lv.x), bflo(lv.y), bfhi(lv.y)}; \
            if (L == 1) { const float f_[4] = {bflo(lvf.x), bfhi(lvf.x), bflo(lvf.y), bfhi(lvf.y)}, g_[4] = {bflo(lvm.x), bfhi(lvm.x), bflo(lvm.y), bfhi(lvm.y)}; \
                _Pragma("unroll") for (int j = 0; j < 4; ++j) v_[j] = v_[j] + (f_[j] - v_[j]) * g_[j]; } \
            *(LAS f32x4*)(B_ + SC_V + (vtt * 8 + vr4) * 4) = (f32x4){v_[0], v_[1], v_[2], v_[3]}; } } while (0)
#define SC_YRED(bufi) f32x4 yv; do { const LAS f32x4* q_ = (const LAS f32x4*)(F.lds + (bufi) * SC_BUF + SC_Y) + (vtt * 8 + vr4) * 4; \
            _Pragma("unroll") for (int r_ = 0; r_ < 4; ++r_) { const f32x4 t0 = q_[r_ * 4], t1 = q_[r_ * 4 + 1], t2 = q_[r_ * 4 + 2], t3 = q_[r_ * 4 + 3]; const f32x4 t = (t0 + t1) + (t2 + t3); yv[r_] = (t.x + t.y) + (t.z + t.w); } } while (0)
        SC_LOAD(0); SC_PREP(0); SC_LOAD(1);
        __syncthreads();
        f32x4 S = {0.f, 0.f, 0.f, 0.f};
        const int rl = lane >> 4, kq = lane & 15, rowi = (wave & 1) * 4 + rl;
        for (int c = 0; c < SC_NC; ++c) {
            const int buf = c & 1;
            if (wave < 2) {
                const LAS unsigned char* Bc = F.lds + buf * SC_BUF;
                const LAS f32x4* pw = (const LAS f32x4*)(Bc + SC_W) + kq; const LAS f32x4* pa = (const LAS f32x4*)(Bc + SC_A) + kq; const LAS f32x4* pb = (const LAS f32x4*)(Bc + SC_B) + kq;
                const LAS f32x4* pk = (const LAS f32x4*)(Bc + SC_K) + kq; const LAS f32x4* pr = (const LAS f32x4*)(Bc + SC_R) + kq;
                const LAS float* pv = (const LAS float*)(Bc + SC_V) + rowi; LAS float* py = (LAS float*)(Bc + SC_Y) + rowi * 16 + kq;
                f32x4 cw[2], ca[2], cb[2], ck[2], cr[2]; float cv[2];
#pragma unroll
                for (int u = 0; u < 2; ++u) { cw[u] = pw[u * 16]; ca[u] = pa[u * 16]; cb[u] = pb[u * 16]; ck[u] = pk[u * 16]; cr[u] = pr[u * 16]; cv[u] = pv[u * 8]; }
#pragma unroll
                for (int g = 0; g < SC_C / 2; ++g) {
                    f32x4 nw[2], na[2], nb[2], nk[2], nr[2]; float nv[2];
                    if (g + 1 < SC_C / 2) {
#pragma unroll
                        for (int u = 0; u < 2; ++u) { const int tt = 2 * g + 2 + u; nw[u] = pw[tt * 16]; na[u] = pa[tt * 16]; nb[u] = pb[tt * 16]; nk[u] = pk[tt * 16]; nr[u] = pr[tt * 16]; nv[u] = pv[tt * 8]; }
                    }
                    float yp[2];
#pragma unroll
                    for (int u = 0; u < 2; ++u) {
                        float sa = (S.x * ca[u].x + S.y * ca[u].y) + (S.z * ca[u].z + S.w * ca[u].w);
                        const f32x4 tv = S * cw[u] + ck[u] * cv[u];
                        sa = sum16(sa);
                        S = tv + cb[u] * sa;
                        yp[u] = (S.x * cr[u].x + S.y * cr[u].y) + (S.z * cr[u].z + S.w * cr[u].w);
                    }
                    py[(2 * g) * 128] = yp[0]; py[(2 * g + 1) * 128] = yp[1];
                    if (g + 1 < SC_C / 2) {
#pragma unroll
                        for (int u = 0; u < 2; ++u) { cw[u] = nw[u]; ca[u] = na[u]; cb[u] = nb[u]; ck[u] = nk[u]; cr[u] = nr[u]; cv[u] = nv[u]; }
                    }
                }
            } else {
                if (c + 1 < SC_NC) SC_PREP(buf ^ 1);
                if (c + 2 < SC_NC) SC_LOAD(c + 2);
                if (wave == 7 && c > 0) { SC_YRED(buf ^ 1);
                    *(f32x4*)(Y + (m0 + (size_t)(c - 1) * SC_C + vtt) * D + h * 64 + rg * 8 + vr4) = yv; }
            }
            __syncthreads();
        }
        if (wave == 7) { SC_YRED((SC_NC - 1) & 1);
            *(f32x4*)(Y + (m0 + (size_t)(SC_NC - 1) * SC_C + vtt) * D + h * 64 + rg * 8 + vr4) = yv; }
        __syncthreads();
#undef SC_LOAD
#undef SC_PREP
#undef SC_YRED
    }
}
__device__ __forceinline__ void post_phase(Frame& F, int L) {
    const bf16* P1 = (const bf16*)(F.ws + WS_P1); const bf16* P2 = (const bf16*)(F.ws + WS_P2); bf16* VF = (bf16*)(F.ws + WS_VF); float* Y = (float*)(F.ws + WS_H2);
    const int gw = F.vcu * NWAVES + F.wave, NGW = F.G * NWAVES, lane = F.lane, c0 = lane * 16;
    const float* kaw = F.in[22] + L * D + c0; const float* rkw = F.in[23] + L * D + c0; const float* lnw = F.in[24] + L * D + c0; const float* lnb = F.in[25] + L * D + c0;
    for (int m = gw; m < M; m += NGW) {
        float y[16], r[16], k[16], v[16], a[16];
        const float* yp = Y + (size_t)m * D + c0;
#pragma unroll
        for (int q = 0; q < 4; ++q) { const f32x4 t = *(const f32x4*)(yp + 4 * q); y[4 * q] = t.x; y[4 * q + 1] = t.y; y[4 * q + 2] = t.z; y[4 * q + 3] = t.w; }
        const bf16* p1 = P1 + (size_t)m * N1 + c0; const bf16* p2 = P2 + (size_t)m * NP2 + c0;
        v4u rv[2], kv[2], vv[2], av[2];
#pragma unroll
        for (int q = 0; q < 2; ++q) { rv[q] = *(const v4u*)(p1 + 8 * q); kv[q] = *(const v4u*)(p1 + 1024 + 8 * q); vv[q] = *(const v4u*)(p1 + 2048 + 8 * q); av[q] = *(const v4u*)(p2 + 1024 + 8 * q); }
#pragma unroll
        for (int q = 0; q < 2; ++q)
#pragma unroll
            for (int j = 0; j < 4; ++j) { r[8 * q + 2 * j] = bflo(rv[q][j]); r[8 * q + 2 * j + 1] = bfhi(rv[q][j]); k[8 * q + 2 * j] = bflo(kv[q][j]); k[8 * q + 2 * j + 1] = bfhi(kv[q][j]);
                v[8 * q + 2 * j] = bflo(vv[q][j]); v[8 * q + 2 * j + 1] = bfhi(vv[q][j]); a[8 * q + 2 * j] = bflo(av[q][j]); a[8 * q + 2 * j + 1] = bfhi(av[q][j]); }
        if (L == 0) { *(v4u*)(VF + (size_t)m * D + c0) = vv[0]; *(v4u*)(VF + (size_t)m * D + c0 + 8) = vv[1]; }
        else { v4u fv[2], gv[2];
#pragma unroll
            for (int q = 0; q < 2; ++q) { fv[q] = *(const v4u*)(VF + (size_t)m * D + c0 + 8 * q); gv[q] = *(const v4u*)(p2 + 2048 + 8 * q); }
#pragma unroll
            for (int q = 0; q < 2; ++q)
#pragma unroll
                for (int j = 0; j < 4; ++j) { const float f0 = bflo(fv[q][j]), f1 = bfhi(fv[q][j]), g0 = bflo(gv[q][j]), g1 = bfhi(gv[q][j]);
                    v[8 * q + 2 * j] += (f0 - v[8 * q + 2 * j]) * g0; v[8 * q + 2 * j + 1] += (f1 - v[8 * q + 2 * j + 1]) * g1; } }
        float s = 0.f, bd = 0.f;
#pragma unroll
        for (int j = 0; j < 16; ++j) { s += y[j]; const float k2 = k[j] * (1.0f + (a[j] - 1.0f) * kaw[j]); bd += r[j] * k2 * rkw[j]; }
        s = sum4(s); bd = sum4(bd);
        const float mean = s * (1.0f / 64.0f); float q2 = 0.f;
#pragma unroll
        for (int j = 0; j < 16; ++j) { const float d = y[j] - mean; q2 += d * d; }
        q2 = sum4(q2);
        const float rstd = 1.0f / sqrtf(q2 * (1.0f / 64.0f) + 64e-5f);
        float o[16];
#pragma unroll
        for (int j = 0; j < 16; ++j) o[j] = (y[j] - mean) * rstd * lnw[j] + lnb[j] + bd * v[j];
        bf16* yn = (bf16*)(Y + (size_t)m * D) + c0;
        v4u w0, w1; w0.x = pkbf(o[0], o[1]); w0.y = pkbf(o[2], o[3]); w0.z = pkbf(o[4], o[5]); w0.w = pkbf(o[6], o[7]); w1.x = pkbf(o[8], o[9]); w1.y = pkbf(o[10], o[11]); w1.z = pkbf(o[12], o[13]); w1.w = pkbf(o[14], o[15]);
        *(v4u*)yn = w0; *(v4u*)(yn + 8) = w1;
    }
}
__device__ __forceinline__ void kvpost_phase(Frame& F) {
    const bf16* KV = (const bf16*)(F.ws + WS_KVRAW); bf16* KS = (bf16*)(F.ws + WS_KS); bf16* VS = (bf16*)(F.ws + WS_VS);
    const int gw = F.vcu * NWAVES + F.wave, NGW = F.G * NWAVES, lane = F.lane, c0 = lane * 16;
    const float* kg = F.in[34] + (c0 & 63);
    for (int m = gw; m < M; m += NGW) {
        const bf16* p = KV + (size_t)m * 2048 + c0; v4u kv[2], vv[2];
#pragma unroll
        for (int q = 0; q < 2; ++q) { kv[q] = *(const v4u*)(p + 8 * q); vv[q] = *(const v4u*)(p + 1024 + 8 * q); }
        float k[16], ss = 0.f;
#pragma unroll
        for (int q = 0; q < 2; ++q)
#pragma unroll
            for (int j = 0; j < 4; ++j) { k[8 * q + 2 * j] = bflo(kv[q][j]); k[8 * q + 2 * j + 1] = bfhi(kv[q][j]); }
#pragma unroll
        for (int j = 0; j < 16; ++j) ss += k[j] * k[j];
        ss = sum4(ss); const float rs = 1.0f / sqrtf(ss * (1.0f / 64.0f) + 1e-6f);
        v4u w0, w1;
        w0.x = pkbf(k[0] * rs * kg[0], k[1] * rs * kg[1]); w0.y = pkbf(k[2] * rs * kg[2], k[3] * rs * kg[3]); w0.z = pkbf(k[4] * rs * kg[4], k[5] * rs * kg[5]); w0.w = pkbf(k[6] * rs * kg[6], k[7] * rs * kg[7]);
        w1.x = pkbf(k[8] * rs * kg[8], k[9] * rs * kg[9]); w1.y = pkbf(k[10] * rs * kg[10], k[11] * rs * kg[11]); w1.z = pkbf(k[12] * rs * kg[12], k[13] * rs * kg[13]); w1.w = pkbf(k[14] * rs * kg[14], k[15] * rs * kg[15]);
        *(v4u*)(KS + (size_t)m * D + c0) = w0; *(v4u*)(KS + (size_t)m * D + c0 + 8) = w1;
        *(v4u*)(VS + (size_t)m * D + c0) = vv[0]; *(v4u*)(VS + (size_t)m * D + c0 + 8) = vv[1];
    }
    if (gw < 32) {
        const int bh = gw, b = bh >> 4, h = bh & 15; const float* FL = (const float*)(F.ws + WS_FL); const float fb = F.in[33][h]; v4u* G3 = (v4u*)(F.ws + WS_G3) + (size_t)bh * T;
        float carry = 0.f;
        for (int c = 0; c < T / 64; ++c) {
            const int t = c * 64 + lane; const float x = FL[((size_t)b * T + t) * 16 + h] + fb;
            float lf = -(fmaxf(-x, 0.f) + log1pf(__expf(-fabsf(x))));
#pragma unroll
            for (int o = 1; o < 64; o <<= 1) { const float n = __int_as_float(__builtin_amdgcn_ds_bpermute((lane - o) << 2, __float_as_int(lf))); if (lane >= o) lf += n; }
            const float Fv = carry + lf; carry = __int_as_float(__builtin_amdgcn_readlane(__float_as_int(Fv), 63));
            const float gv = -Fv * 1.4426950408889634f;
            const unsigned hi = pkbf(gv, 0.f) & 0xffffu; const float r1 = gv - __uint_as_float(hi << 16);
            const unsigned mid = pkbf(r1, 0.f) & 0xffffu; const float r2 = r1 - __uint_as_float(mid << 16);
            const unsigned lo = pkbf(r2, 0.f) & 0xffffu;
            G3[t] = (v4u){hi | (mid << 16), lo, 0u, 0u};
        }
    }
}
constexpr size_t WS_BAR = 512 * 1024, BAR_BYTES = 16384; constexpr int MISC_OFF = LDS_BYTES - 1024;
#define RLX_AGENT __ATOMIC_RELAXED, __HIP_MEMORY_SCOPE_AGENT
#define LDS_WAIT() asm volatile("s_waitcnt lgkmcnt(0)" ::: "memory")
#define VM_WAIT() asm volatile("s_waitcnt vmcnt(0)" ::: "memory")
__device__ __forceinline__ unsigned long long rt() { return __builtin_amdgcn_s_memrealtime(); }
__device__ __forceinline__ unsigned f2bf(float f) { unsigned u = __builtin_bit_cast(unsigned, f); return (u + 0x7fffu + ((u >> 16) & 1u)) >> 16; }
__device__ __forceinline__ unsigned pk2(float lo, float hi) { return f2bf(lo) | (f2bf(hi) << 16); }

#define XB_TMO      128
#define XB_XCNT(j)  (256  + 64 * (j))
#define XB_XSUB(j)  (1280 + 64 * (j))
#define XB_XGEN(j)  (2304 + 64 * (j))
#define XB_TOP      3328
#define XB_TOPGEN   3392
#define XCD_BAR_WORDS 3456
#define XB_SPIN_CAP (1u << 18)

__device__ __forceinline__ unsigned xb_ld(unsigned* p)              { return __hip_atomic_load(p, __ATOMIC_RELAXED, __HIP_MEMORY_SCOPE_AGENT); }
__device__ __forceinline__ unsigned xb_add(unsigned* p, unsigned v) { return __hip_atomic_fetch_add(p, v, __ATOMIC_RELAXED, __HIP_MEMORY_SCOPE_AGENT); }
__device__ __forceinline__ unsigned xb_xcc_id() { return (unsigned)__builtin_amdgcn_s_getreg((3 << 11) | 20) & 0xFu; }
#define XB_SPIN(cond, bar) do { unsigned _sp = 0; while (cond) { __builtin_amdgcn_s_sleep(1); \
    if ((++_sp & 255u) == 0u) { if (xb_ld(&(bar)[XB_TMO])) break; if (_sp > XB_SPIN_CAP) { atomicAdd(&(bar)[XB_TMO], 1u); break; } } } } while (0)

struct XcdBarrier {
    unsigned* bar; unsigned x;
    volatile LAS unsigned* st;
};

__device__ __forceinline__ XcdBarrier xcd_barrier_post(unsigned* bar, volatile LAS unsigned* st, const int tid) {
    XcdBarrier b; b.bar = bar; b.x = xb_xcc_id(); b.st = st;
    if (tid == 0) (void)xb_add(&bar[XB_XCNT(b.x)], 1u);
    return b;
}
__device__ __forceinline__ void xcd_barrier_complete(unsigned* bar, unsigned x, unsigned& nloc, unsigned& nx) {
    const unsigned G = gridDim.x * gridDim.y * gridDim.z;
    unsigned sum, cnt, mine, sp = 0u;
    for (;;) {
        sum = 0u; cnt = 0u; mine = 0u;
#pragma unroll
        for (unsigned j = 0; j < 16; ++j) { const unsigned c = xb_ld(&bar[XB_XCNT(j)]); sum += c; cnt += (c > 0u) ? 1u : 0u; mine = (j == x) ? c : mine; }
        if (sum == G) break;
        __builtin_amdgcn_s_sleep(1);
        if ((++sp & 255u) == 0u) { if (xb_ld(&bar[XB_TMO])) break; if (sp > XB_SPIN_CAP) { atomicAdd(&bar[XB_TMO], 1u); break; } }
    }
    nloc = mine > 0u ? mine : 1u; nx = cnt > 0u ? cnt : 1u;
}

__device__ __forceinline__ void xcd_barrier(const XcdBarrier& b, const int tid) {
    asm volatile("s_waitcnt vmcnt(0)" ::: "memory");
    __syncthreads();
    if (tid == 0) {
        unsigned* bar = b.bar;
        __builtin_amdgcn_s_waitcnt(0);
        unsigned nloc = b.st[0], nx = b.st[1];
        if (nloc == 0u) { xcd_barrier_complete(bar, b.x, nloc, nx); b.st[0] = nloc; b.st[1] = nx; }
        const unsigned old = xb_add(&bar[XB_XSUB(b.x)], 1u);
        const unsigned gen = old / nloc;
        if (old + 1u == (gen + 1u) * nloc) {
            __builtin_amdgcn_fence(__ATOMIC_RELEASE, "agent");
            asm volatile("s_waitcnt vmcnt(0)" ::: "memory");
            const unsigned og = xb_add(&bar[XB_TOP], 1u);
            const unsigned tg = og / nx;
            if (og + 1u == (tg + 1u) * nx) xb_add(&bar[XB_TOPGEN], 1u);
            else XB_SPIN(xb_ld(&bar[XB_TOPGEN]) == tg, bar);
            __builtin_amdgcn_fence(__ATOMIC_ACQUIRE, "agent");
            xb_add(&bar[XB_XGEN(b.x)], 1u);
            asm volatile("s_waitcnt vmcnt(0)" ::: "memory");
        } else {
            XB_SPIN(xb_ld(&bar[XB_XGEN(b.x)]) == gen, bar);
            __builtin_amdgcn_fence(__ATOMIC_ACQUIRE, "agent");
            asm volatile("s_waitcnt vmcnt(0)" ::: "memory");
        }
    }
    __syncthreads();
}
#define GEMM_CALL(FN, Aptr, Bptr, Nn, Kk, LDA, LDB, ...) do { pg8::Gemm g_{(const pg8::bf16_t*)(Aptr), (const pg8::bf16_t*)(Bptr), M, (Nn), (Kk), (LDA), (LDB)}; pg8::StaticOrder S_; S_.init(M, (Nn), F.G, F.bx); \
    pg8::Epi8<pg8::FN> E_{{__VA_ARGS__}}; pg8::gemm_phase<pg8::Epi8<pg8::FN>, pg8::StaticOrder, true, true>(F.lds, g_, S_, E_, F.tid); } while (0)
constexpr int N_PHASES = 42;
__global__ void __launch_bounds__(NWAVES * 64, 2) yoco_fwd(Args args) {
    extern __shared__ __attribute__((aligned(16))) unsigned char lds[];
    cg::grid_group grid = cg::this_grid();
    Frame F;
    const int wave_s = __builtin_amdgcn_readfirstlane((int)threadIdx.x >> 6);
    F.lds = (LAS unsigned char*)lds; F.tid = threadIdx.x; F.lane = F.tid & 63; F.wave = wave_s;
    F.G = gridDim.x; F.bx = blockIdx.x; F.vcu = F.bx;
    F.ws = args.ws; F.out = args.out; F.in = args.in;
    unsigned char* ws = args.ws;
    const int lo = args.ph_lo, hi = args.ph_hi; const bool one = (hi - lo) > 1;
#define LAUNDER() do { int t_ = wave_s * 64 + (int)__builtin_amdgcn_mbcnt_hi(~0u, __builtin_amdgcn_mbcnt_lo(~0u, 0u)); asm volatile("" : "+v"(t_)); F.tid = t_; F.lane = t_ & 63; F.wave = __builtin_amdgcn_readfirstlane(t_ >> 6); \
        int z_ = 0; asm volatile("" : "+v"(z_)); z_ = __builtin_amdgcn_readfirstlane(z_); ws = args.ws + z_; F.ws = ws; F.in = args.in + z_; F.out = args.out + z_; F.bx = (int)blockIdx.x + z_; F.G = (int)gridDim.x + z_; F.vcu = (F.G % 8 == 0) ? (F.bx % 8) * (F.G / 8) + F.bx / 8 : F.bx; } while (0)
#define IN(k) (lo <= (k) && (k) < hi)
#define SEAM() do { if (one) { unsigned zz_ = 0u; asm volatile("" : "+v"(zz_)); const int st_ = wave_s * 64 + (int)__builtin_amdgcn_mbcnt_hi(~0u, __builtin_amdgcn_mbcnt_lo(~0u, zz_)); xcd_barrier(xbar, st_); } } while (0)
#define MOD_ ((float*)(ws + WS_MOD))
#define MODKV_ (MOD_ + 4 * 2 * 6144)
#define H2_ ((bf16*)(ws + WS_H2))
#define XN_ ((bf16*)(ws + WS_H2))
#define XNKV_ ((bf16*)(ws + WS_H2 + 32 * MiB))
#define P1_ ((bf16*)(ws + WS_P1))
#define P2_ ((bf16*)(ws + WS_P2))
#define HB_ ((bf16*)(ws + WS_HB))
#define QB_ ((bf16*)(ws + WS_QB))
#define GT_ ((bf16*)(ws + WS_GT))
#define XIN1_ ((L == 0) ? F.in[0] : (const float*)F.out)
#define MODL_ (MOD_ + L * 2 * 6144)

    volatile LAS unsigned* MISC = (volatile LAS unsigned*)(F.lds + MISC_OFF);
    if (F.tid < 32) MISC[F.tid] = 0u;
    __syncthreads();
    XcdBarrier xbar; xbar.bar = (unsigned*)(args.ws + WS_BAR); xbar.x = 0; xbar.st = MISC + 8;
    if (one) xbar = xcd_barrier_post((unsigned*)(args.ws + WS_BAR), MISC + 8, F.tid);
    if (IN(0)) { LAUNDER(); p0_mod(F); p0_weights(F); if (one) grid.sync(); }
    { constexpr int L = 0;
        const int pb = 1 + L * 10;
        if (L < 2) {
            if (IN(pb + 0)) { LAUNDER(); norm_phase(F, XIN1_, F.in[4] + L * D, MODL_, MODL_ + 1024, 6144, 0, H2_); SEAM(); }
            if (IN(pb + 1)) { LAUNDER(); GEMM_CALL(FnP1, H2_, ws + WS_W1 + (size_t)L * N1 * K1 * 2, N1, K1, K1, K1, P1_); SEAM(); }
            if (IN(pb + 2)) { LAUNDER(); GEMM_CALL(FnP2, P1_ + 3072, ws + WS_W2A + (size_t)L * 3072 * 256 * 2, NP2, 256, N1, 256, P2_, MOD_ + 53248 + L * 3072); SEAM(); }
            if (IN(pb + 3)) { LAUNDER(); scan_phase(F, L); SEAM(); }
            if (IN(pb + 4)) { LAUNDER(); post_phase(F, L); SEAM(); }
            if (IN(pb + 5)) { LAUNDER(); GEMM_CALL(FnGate, P1_ + 3232, ws + WS_W2G + (size_t)L * 1024 * 256 * 2, D, 256, N1, 256, H2_, 2048); SEAM(); }
            if (IN(pb + 6)) { LAUNDER(); GEMM_CALL(FnRes, H2_, ws + WS_WO + (size_t)L * D * D * 2, D, D, 2048, D, XIN1_, F.out, MODL_ + 2 * 1024); SEAM(); }
        } else {
            const int j = L - 2;
            if (IN(pb + 0)) { LAUNDER(); norm_phase(F, F.out, F.in[4] + L * D, MODL_, MODL_ + 1024, 6144, 1, XN_);
                if (L == 2) norm_phase(F, F.out, F.in[29], MODKV_, MODKV_ + 1024, 2048, 1, XNKV_);
                SEAM(); }
            if (IN(pb + 1)) { LAUNDER();
                if (L == 2) GEMM_CALL(FnKv, XNKV_, ws + WS_WKV, 2304, D, D, D, (bf16*)(ws + WS_KVRAW), (float*)(ws + WS_FL));
                LAUNDER();
                GEMM_CALL(FnQg, XN_, ws + WS_WQG + (size_t)j * 2048 * D * 2, 2048, D, D, D, QB_, GT_); SEAM(); }
            if (IN(pb + 2) && L == 2) { LAUNDER(); kvpost_phase(F); SEAM(); }
            if (IN(pb + 3)) { LAUNDER();
                const attn_body::AttnTensors AT{(const attn_body::bf16*)QB_, (const attn_body::bf16*)(ws + WS_KS), (const attn_body::bf16*)(ws + WS_VS), (attn_body::bf16*)QB_, (const attn_body::bf16*)GT_, (const unsigned char*)(ws + WS_G3), F.in[36] + j * 64};
                const attn_body::StaticOrder S((int)F.G, F.bx);
                attn_body::attn_phase<attn_body::StaticOrder>((char*)lds, AT, S, F.tid);
                SEAM(); }
            if (IN(pb + 6)) { LAUNDER(); GEMM_CALL(FnRes, QB_, ws + WS_WO2 + (size_t)j * D * D * 2, D, D, D, D, (const float*)F.out, F.out, MODL_ + 2 * 1024); SEAM(); }
        }
        if (IN(pb + 7)) { LAUNDER(); mlp_weights(F, L); norm_phase(F, F.out, F.in[5] + L * D, MODL_ + 3 * 1024, MODL_ + 4 * 1024, 6144, 1, XN_); SEAM(); }
        if (IN(pb + 8)) { LAUNDER(); GEMM_CALL(FnUp, XN_, ws + WS_WUP, FF, D, D, D, HB_); SEAM(); }
        if (IN(pb + 9)) { LAUNDER(); GEMM_CALL(FnRes, HB_, ws + WS_WDN, D, FF, FF, FF, (const float*)F.out, F.out, MODL_ + 5 * 1024); SEAM(); }
        }
    { constexpr int L = 1;
        const int pb = 1 + L * 10;
        if (L < 2) {
            if (IN(pb + 0)) { LAUNDER(); norm_phase(F, XIN1_, F.in[4] + L * D, MODL_, MODL_ + 1024, 6144, 0, H2_); SEAM(); }
            if (IN(pb + 1)) { LAUNDER(); GEMM_CALL(FnP1, H2_, ws + WS_W1 + (size_t)L * N1 * K1 * 2, N1, K1, K1, K1, P1_); SEAM(); }
            if (IN(pb + 2)) { LAUNDER(); GEMM_CALL(FnP2, P1_ + 3072, ws + WS_W2A + (size_t)L * 3072 * 256 * 2, NP2, 256, N1, 256, P2_, MOD_ + 53248 + L * 3072); SEAM(); }
            if (IN(pb + 3)) { LAUNDER(); scan_phase(F, L); SEAM(); }
            if (IN(pb + 4)) { LAUNDER(); post_phase(F, L); SEAM(); }
            if (IN(pb + 5)) { LAUNDER(); GEMM_CALL(FnGate, P1_ + 3232, ws + WS_W2G + (size_t)L * 1024 * 256 * 2, D, 256, N1, 256, H2_, 2048); SEAM(); }
            if (IN(pb + 6)) { LAUNDER(); GEMM_CALL(FnRes, H2_, ws + WS_WO + (size_t)L * D * D * 2, D, D, 2048, D, XIN1_, F.out, MODL_ + 2 * 1024); SEAM(); }
        } else {
            const int j = L - 2;
            if (IN(pb + 0)) { LAUNDER(); norm_phase(F, F.out, F.in[4] + L * D, MODL_, MODL_ + 1024, 6144, 1, XN_);
                if (L == 2) norm_phase(F, F.out, F.in[29], MODKV_, MODKV_ + 1024, 2048, 1, XNKV_);
                SEAM(); }
            if (IN(pb + 1)) { LAUNDER();
                if (L == 2) GEMM_CALL(FnKv, XNKV_, ws + WS_WKV, 2304, D, D, D, (bf16*)(ws + WS_KVRAW), (float*)(ws + WS_FL));
                LAUNDER();
                GEMM_CALL(FnQg, XN_, ws + WS_WQG + (size_t)j * 2048 * D * 2, 2048, D, D, D, QB_, GT_); SEAM(); }
            if (IN(pb + 2) && L == 2) { LAUNDER(); kvpost_phase(F); SEAM(); }
            if (IN(pb + 3)) { LAUNDER();
                const attn_body::AttnTensors AT{(const attn_body::bf16*)QB_, (const attn_body::bf16*)(ws + WS_KS), (const attn_body::bf16*)(ws + WS_VS), (attn_body::bf16*)QB_, (const attn_body::bf16*)GT_, (const unsigned char*)(ws + WS_G3), F.in[36] + j * 64};
                const attn_body::StaticOrder S((int)F.G, F.bx);
                attn_body::attn_phase<attn_body::StaticOrder>((char*)lds, AT, S, F.tid);
                SEAM(); }
            if (IN(pb + 6)) { LAUNDER(); GEMM_CALL(FnRes, QB_, ws + WS_WO2 + (size_t)j * D * D * 2, D, D, D, D, (const float*)F.out, F.out, MODL_ + 2 * 1024); SEAM(); }
        }
        if (IN(pb + 7)) { LAUNDER(); mlp_weights(F, L); norm_phase(F, F.out, F.in[5] + L * D, MODL_ + 3 * 1024, MODL_ + 4 * 1024, 6144, 1, XN_); SEAM(); }
        if (IN(pb + 8)) { LAUNDER(); GEMM_CALL(FnUp, XN_, ws + WS_WUP, FF, D, D, D, HB_); SEAM(); }
        if (IN(pb + 9)) { LAUNDER(); GEMM_CALL(FnRes, HB_, ws + WS_WDN, D, FF, FF, FF, (const float*)F.out, F.out, MODL_ + 5 * 1024); SEAM(); }
        }
    { constexpr int L = 2;
        const int pb = 1 + L * 10;
        if (L < 2) {
            if (IN(pb + 0)) { LAUNDER(); norm_phase(F, XIN1_, F.in[4] + L * D, MODL_, MODL_ + 1024, 6144, 0, H2_); SEAM(); }
            if (IN(pb + 1)) { LAUNDER(); GEMM_CALL(FnP1, H2_, ws + WS_W1 + (size_t)L * N1 * K1 * 2, N1, K1, K1, K1, P1_); SEAM(); }
            if (IN(pb + 2)) { LAUNDER(); GEMM_CALL(FnP2, P1_ + 3072, ws + WS_W2A + (size_t)L * 3072 * 256 * 2, NP2, 256, N1, 256, P2_, MOD_ + 53248 + L * 3072); SEAM(); }
            if (IN(pb + 3)) { LAUNDER(); scan_phase(F, L); SEAM(); }
            if (IN(pb + 4)) { LAUNDER(); post_phase(F, L); SEAM(); }
            if (IN(pb + 5)) { LAUNDER(); GEMM_CALL(FnGate, P1_ + 3232, ws + WS_W2G + (size_t)L * 1024 * 256 * 2, D, 256, N1, 256, H2_, 2048); SEAM(); }
            if (IN(pb + 6)) { LAUNDER(); GEMM_CALL(FnRes, H2_, ws + WS_WO + (size_t)L * D * D * 2, D, D, 2048, D, XIN1_, F.out, MODL_ + 2 * 1024); SEAM(); }
        } else {
            const int j = L - 2;
            if (IN(pb + 0)) { LAUNDER(); norm_phase(F, F.out, F.in[4] + L * D, MODL_, MODL_ + 1024, 6144, 1, XN_);
                if (L == 2) norm_phase(F, F.out, F.in[29], MODKV_, MODKV_ + 1024, 2048, 1, XNKV_);
                SEAM(); }
            if (IN(pb + 1)) { LAUNDER();
                if (L == 2) GEMM_CALL(FnKv, XNKV_, ws + WS_WKV, 2304, D, D, D, (bf16*)(ws + WS_KVRAW), (float*)(ws + WS_FL));
                LAUNDER();
                GEMM_CALL(FnQg, XN_, ws + WS_WQG + (size_t)j * 2048 * D * 2, 2048, D, D, D, QB_, GT_); SEAM(); }
            if (IN(pb + 2) && L == 2) { LAUNDER(); kvpost_phase(F); SEAM(); }
            if (IN(pb + 3)) { LAUNDER();
                const attn_body::AttnTensors AT{(const attn_body::bf16*)QB_, (const attn_body::bf16*)(ws + WS_KS), (const attn_body::bf16*)(ws + WS_VS), (attn_body::bf16*)QB_, (const attn_body::bf16*)GT_, (const unsigned char*)(ws + WS_G3), F.in[36] + j * 64};
                const attn_body::StaticOrder S((int)F.G, F.bx);
                attn_body::attn_phase<attn_body::StaticOrder>((char*)lds, AT, S, F.tid);
                SEAM(); }
            if (IN(pb + 6)) { LAUNDER(); GEMM_CALL(FnRes, QB_, ws + WS_WO2 + (size_t)j * D * D * 2, D, D, D, D, (const float*)F.out, F.out, MODL_ + 2 * 1024); SEAM(); }
        }
        if (IN(pb + 7)) { LAUNDER(); mlp_weights(F, L); norm_phase(F, F.out, F.in[5] + L * D, MODL_ + 3 * 1024, MODL_ + 4 * 1024, 6144, 1, XN_); SEAM(); }
        if (IN(pb + 8)) { LAUNDER(); GEMM_CALL(FnUp, XN_, ws + WS_WUP, FF, D, D, D, HB_); SEAM(); }
        if (IN(pb + 9)) { LAUNDER(); GEMM_CALL(FnRes, HB_, ws + WS_WDN, D, FF, FF, FF, (const float*)F.out, F.out, MODL_ + 5 * 1024); SEAM(); }
        }
    { constexpr int L = 3;
        const int pb = 1 + L * 10;
        if (L < 2) {
            if (IN(pb + 0)) { LAUNDER(); norm_phase(F, XIN1_, F.in[4] + L * D, MODL_, MODL_ + 1024, 6144, 0, H2_); SEAM(); }
            if (IN(pb + 1)) { LAUNDER(); GEMM_CALL(FnP1, H2_, ws + WS_W1 + (size_t)L * N1 * K1 * 2, N1, K1, K1, K1, P1_); SEAM(); }
            if (IN(pb + 2)) { LAUNDER(); GEMM_CALL(FnP2, P1_ + 3072, ws + WS_W2A + (size_t)L * 3072 * 256 * 2, NP2, 256, N1, 256, P2_, MOD_ + 53248 + L * 3072); SEAM(); }
            if (IN(pb + 3)) { LAUNDER(); scan_phase(F, L); SEAM(); }
            if (IN(pb + 4)) { LAUNDER(); post_phase(F, L); SEAM(); }
            if (IN(pb + 5)) { LAUNDER(); GEMM_CALL(FnGate, P1_ + 3232, ws + WS_W2G + (size_t)L * 1024 * 256 * 2, D, 256, N1, 256, H2_, 2048); SEAM(); }
            if (IN(pb + 6)) { LAUNDER(); GEMM_CALL(FnRes, H2_, ws + WS_WO + (size_t)L * D * D * 2, D, D, 2048, D, XIN1_, F.out, MODL_ + 2 * 1024); SEAM(); }
        } else {
            const int j = L - 2;
            if (IN(pb + 0)) { LAUNDER(); norm_phase(F, F.out, F.in[4] + L * D, MODL_, MODL_ + 1024, 6144, 1, XN_);
                if (L == 2) norm_phase(F, F.out, F.in[29], MODKV_, MODKV_ + 1024, 2048, 1, XNKV_);
                SEAM(); }
            if (IN(pb + 1)) { LAUNDER();
                if (L == 2) GEMM_CALL(FnKv, XNKV_, ws + WS_WKV, 2304, D, D, D, (bf16*)(ws + WS_KVRAW), (float*)(ws + WS_FL));
                LAUNDER();
                GEMM_CALL(FnQg, XN_, ws + WS_WQG + (size_t)j * 2048 * D * 2, 2048, D, D, D, QB_, GT_); SEAM(); }
            if (IN(pb + 2) && L == 2) { LAUNDER(); kvpost_phase(F); SEAM(); }
            if (IN(pb + 3)) { LAUNDER();
                const attn_body::AttnTensors AT{(const attn_body::bf16*)QB_, (const attn_body::bf16*)(ws + WS_KS), (const attn_body::bf16*)(ws + WS_VS), (attn_body::bf16*)QB_, (const attn_body::bf16*)GT_, (const unsigned char*)(ws + WS_G3), F.in[36] + j * 64};
                const attn_body::StaticOrder S((int)F.G, F.bx);
                attn_body::attn_phase<attn_body::StaticOrder>((char*)lds, AT, S, F.tid);
                SEAM(); }
            if (IN(pb + 6)) { LAUNDER(); GEMM_CALL(FnRes, QB_, ws + WS_WO2 + (size_t)j * D * D * 2, D, D, D, D, (const float*)F.out, F.out, MODL_ + 2 * 1024); SEAM(); }
        }
        if (IN(pb + 7)) { LAUNDER(); mlp_weights(F, L); norm_phase(F, F.out, F.in[5] + L * D, MODL_ + 3 * 1024, MODL_ + 4 * 1024, 6144, 1, XN_); SEAM(); }
        if (IN(pb + 8)) { LAUNDER(); GEMM_CALL(FnUp, XN_, ws + WS_WUP, FF, D, D, D, HB_); SEAM(); }
        if (IN(pb + 9)) { LAUNDER(); GEMM_CALL(FnRes, HB_, ws + WS_WDN, D, FF, FF, FF, (const float*)F.out, F.out, MODL_ + 5 * 1024); SEAM(); }
        }
    if (IN(41)) { LAUNDER(); final_norm_phase(F); }
#undef IN
#undef SEAM
}
static bool phase_exists(int ph) {
    if (ph == 0 || ph == 41) return true;
    const int L = (ph - 1) / 10, s = (ph - 1) % 10;
    if (L < 2) return true;
    if (s == 4 || s == 5) return false;
    if (s == 2) return L == 2;
    return true;
}
extern "C" void kernel_launch(void* const* d_in, const int* in_sizes, int n_in, void* d_out, int out_size, void* d_ws, size_t ws_size, hipStream_t stream) {
    static int grid = 0;
    if (grid == 0) {
        if (n_in != 39 || in_sizes[0] != M * D || out_size != M * D || ws_size < WS_END) { fprintf(stderr, "kernel_launch: shape/workspace mismatch: n_in %d in0 %d out %d ws %zu (need %zu)\n", n_in, n_in > 0 ? in_sizes[0] : -1, out_size, ws_size, (size_t)WS_END); grid = -1; return; }
        int dev = 0, cus = 0, per_cu = 0;
        if (hipGetDevice(&dev) != hipSuccess || hipDeviceGetAttribute(&cus, hipDeviceAttributeMultiprocessorCount, dev) != hipSuccess) { fprintf(stderr, "kernel_launch: device query failed\n"); grid = -1; return; }
        if (hipFuncSetAttribute((const void*)yoco_fwd, hipFuncAttributeMaxDynamicSharedMemorySize, LDS_BYTES) != hipSuccess) { fprintf(stderr, "kernel_launch: hipFuncSetAttribute failed\n"); grid = -1; return; }
        if (hipOccupancyMaxActiveBlocksPerMultiprocessor(&per_cu, (const void*)yoco_fwd, NWAVES * 64, LDS_BYTES) != hipSuccess || per_cu < 1) { fprintf(stderr, "kernel_launch: occupancy query says %d blocks/CU\n", per_cu); per_cu = 1; }
        (void)hipGetLastError();
        grid = cus * per_cu;
        if (grid != 256) { fprintf(stderr, "kernel_launch: resident capacity %d workgroups; this kernel's static schedules want 256 (using 256)\n", grid); if (grid > 256) grid = 256; }
    }
    if (grid < 0) return;
    if (hipMemsetAsync((char*)d_ws + WS_BAR, 0, BAR_BYTES, stream) != hipSuccess) { fprintf(stderr, "kernel_launch: memset of barrier words failed\n"); return; }
    Args a{};
    for (int i = 0; i < 39; ++i) a.in[i] = (const float*)d_in[i];
    a.out = (float*)d_out; a.ws = (unsigned char*)d_ws;
#if MK_ONE_LAUNCH
    a.ph_lo = 0; a.ph_hi = N_PHASES;
    void* params[] = {&a};
    const hipError_t le = hipLaunchCooperativeKernel((const void*)yoco_fwd, dim3(grid), dim3(NWAVES * 64), params, LDS_BYTES, stream);
    if (le != hipSuccess) fprintf(stderr, "kernel_launch: cooperative launch failed: %s (grid %d)\n", hipGetErrorName(le), grid);
#else
    for (int ph = 0; ph < N_PHASES; ++ph) { if (!phase_exists(ph)) continue; a.ph_lo = ph; a.ph_hi = ph + 1;
        hipLaunchKernelGGL(yoco_fwd, dim3(grid), dim3(NWAVES * 64), LDS_BYTES, stream, a);
        const hipError_t le = hipPeekAtLastError(); if (le != hipSuccess) { fprintf(stderr, "kernel_launch: launch of phase %d failed: %s\n", ph, hipGetErrorName(le)); break; } }
#endif
}
```

```cpp
#include <hip/hip_runtime.h>
#include <hip/hip_cooperative_groups.h>
#include <hip/hip_bf16.h>
#include <cstdio>
#include <cstdint>
#include <cmath>
namespace cg = cooperative_groups;
#ifndef MK_ONE_LAUNCH
#define MK_ONE_LAUNCH 1
#endif
namespace pg8 {
#define PG8_LAS __attribute__((address_space(3)))
typedef unsigned short bf16_t;
typedef short bf16x8 __attribute__((ext_vector_type(8)));
typedef float f32x4 __attribute__((ext_vector_type(4)));
typedef unsigned u32x4 __attribute__((ext_vector_type(4)));
constexpr int BM = 256, BK = 64, HALF = 128, HTB = HALF * BK * 2  , STAGE_BYTES = 8 * HTB, NXCD = 8, WGM = 8;

__host__ __device__ __forceinline__ int lds_byte(int r, int c) { const int st = (r >> 4) * 2 + (c >> 5), rr = r & 15, cc = c & 31, ob = rr * 64 + cc * 2; return st * 1024 + (ob ^ (((ob >> 9) & 1) << 5)); }
__host__ __device__ __forceinline__ void stage_rc(int b, int& R, int& C) { const int st = b / 1024, sb = b % 1024, swz = sb ^ (((sb >> 9) & 1) << 5); R = (st >> 1) * 16 + swz / 64; C = (st & 1) * 32 + (swz % 64) / 2; }
__host__ __device__ __forceinline__ int perm32(int rho) { const int n = rho >> 4, i = rho & 15; return 8 * (i >> 2) + 4 * n + (i & 3); }

struct Unit { int pm, pn; };
struct Gemm { const bf16_t* A; const bf16_t* Bt; int M, N, K, lda, ldb; };

struct StaticOrder {
    int nM, nN, nwg, G, c;
    __host__ __device__ void init(int M, int N, int G_, int c_) { nM = M / BM; nN = N / BM; nwg = nM * nN; G = G_; c = c_; }
    __host__ __device__ bool next(int i, Unit& u) const {
        const long L = (long)i * G + c; if (L >= nwg) return false;
        int wgid = (int)L; { const int q = nwg / NXCD, r = nwg % NXCD, xcd = wgid % NXCD, off = wgid / NXCD; wgid = (xcd < r ? xcd * (q + 1) : r * (q + 1) + (xcd - r) * q) + off; }
        const int nig = WGM * nN, gid = wgid / nig, fm = gid * WGM, gsz = (nM - fm) < WGM ? (nM - fm) : WGM;
        u.pm = fm + ((wgid % nig) % gsz); u.pn = (wgid % nig) / gsz; return true;
    }
    __device__ __forceinline__ void a_ready(const Unit&) const {}
    __device__ __forceinline__ void done(const Unit&) const {}
};

typedef float f32x2 __attribute__((ext_vector_type(2)));
typedef __bf16 bf16x2_t __attribute__((ext_vector_type(2)));
__device__ __forceinline__ unsigned pkbf(float lo, float hi) { f32x2 v = {lo, hi}; bf16x2_t b = __builtin_convertvector(v, bf16x2_t); return __builtin_bit_cast(unsigned, b); }
__device__ __forceinline__ float bflo(unsigned w) { return __uint_as_float(w << 16); }
__device__ __forceinline__ float bfhi(unsigned w) { return __uint_as_float(w & 0xffff0000u); }
__device__ __forceinline__ float sigm(float x) { return 1.0f / (1.0f + __expf(-x)); }
template <class Fn> struct Epi8 {
    static constexpr bool PERM = true, AFTER_DRAIN = false; Fn f;
    __device__ __forceinline__ void operator()(const f32x4 (&acc)[2][2][4][2], const Unit& u, int wr, int wc, int fr, int fq) const {
        const int row0 = u.pm * BM + wr * 64 + fr, col0 = u.pn * BM + wc * 32 + 8 * fq;
#pragma unroll
        for (int ai = 0; ai < 2; ++ai)
#pragma unroll
            for (int m = 0; m < 4; ++m)
#pragma unroll
                for (int bj = 0; bj < 2; ++bj) { f(row0 + ai * HALF + m * 16, col0 + bj * HALF, acc[ai][bj][m][0], acc[ai][bj][m][1]); asm volatile("" ::: "memory"); }
    }
};
__device__ __forceinline__ void st8bf(bf16_t* p, f32x4 v0, f32x4 v1) { u32x4 w; w.x = pkbf(v0[0], v0[1]); w.y = pkbf(v0[2], v0[3]); w.z = pkbf(v1[0], v1[1]); w.w = pkbf(v1[2], v1[3]); *(u32x4*)p = w; }
struct FnP1 { bf16_t* O;
    __device__ __forceinline__ void operator()(int row, int col, f32x4 v0, f32x4 v1) const {
        if (col >= 3072) {
            if (col < 3136) {
#pragma unroll
                for (int j = 0; j < 4; ++j) { v0[j] = 1.0f - 2.0f / (__expf(2.0f * v0[j]) + 1.0f); v1[j] = 1.0f - 2.0f / (__expf(2.0f * v1[j]) + 1.0f); } }
            else if (col >= 3232 && col < 3392) {
#pragma unroll
                for (int j = 0; j < 4; ++j) { v0[j] = sigm(v0[j]); v1[j] = sigm(v1[j]); } }
        }
        st8bf(O + (size_t)row * 3584 + col, v0, v1); } };
struct FnP2 { bf16_t* O; const float* bias;
    __device__ __forceinline__ void operator()(int row, int col, f32x4 v0, f32x4 v1) const {
        const f32x4 b0 = *(const f32x4*)(bias + col), b1 = *(const f32x4*)(bias + col + 4);
        const float sc = col < 1024 ? -0.60653065971f : 1.0f;
#pragma unroll
        for (int j = 0; j < 4; ++j) { v0[j] = sc * sigm(v0[j] + b0[j]); v1[j] = sc * sigm(v1[j] + b1[j]); }
        st8bf(O + (size_t)row * 3072 + col, v0, v1); } };
struct FnGate { bf16_t* Y; int ld;
    __device__ __forceinline__ void operator()(int row, int col, f32x4 v0, f32x4 v1) const {
        bf16_t* p = Y + (size_t)row * ld + col; const u32x4 y = *(const u32x4*)p;
        v0[0] *= bflo(y.x); v0[1] *= bfhi(y.x); v0[2] *= bflo(y.y); v0[3] *= bfhi(y.y); v1[0] *= bflo(y.z); v1[1] *= bfhi(y.z); v1[2] *= bflo(y.w); v1[3] *= bfhi(y.w);
        st8bf(p, v0, v1); } };
struct FnRes { const float* xin; float* xout; const float* gate;
    __device__ __forceinline__ void operator()(int row, int col, f32x4 v0, f32x4 v1) const {
        const float* gp = gate + (row >> 13) * 6144 + col; const f32x4 g0 = *(const f32x4*)gp, g1 = *(const f32x4*)(gp + 4);
        const size_t off = (size_t)row * 1024 + col; const f32x4 x0 = *(const f32x4*)(xin + off), x1 = *(const f32x4*)(xin + off + 4);
        *(f32x4*)(xout + off) = x0 + (g0 + 1.0f) * v0; *(f32x4*)(xout + off + 4) = x1 + (g1 + 1.0f) * v1; } };
struct FnUp { bf16_t* O;
    __device__ __forceinline__ void operator()(int row, int col, f32x4 v0, f32x4 v1) const {
#pragma unroll
        for (int j = 0; j < 4; ++j) { const float a = fmaxf(v0[j], 0.f), b = fmaxf(v1[j], 0.f); v0[j] = a * a; v1[j] = b * b; }
        st8bf(O + (size_t)row * 4096 + col, v0, v1); } };
struct FnKv { bf16_t* O; float* FL;
    __device__ __forceinline__ void operator()(int row, int col, f32x4 v0, f32x4 v1) const {
        if (col < 2048) st8bf(O + (size_t)row * 2048 + col, v0, v1);
        else if (col < 2064) { float* p = FL + (size_t)row * 16 + (col - 2048); *(f32x4*)p = v0; *(f32x4*)(p + 4) = v1; } } };
struct FnQg { bf16_t* Q; bf16_t* G;
    __device__ __forceinline__ void operator()(int row, int col, f32x4 v0, f32x4 v1) const {
        if (col < 1024) st8bf(Q + (size_t)row * 1024 + col, v0, v1);
        else {
#pragma unroll
            for (int j = 0; j < 4; ++j) { v0[j] = sigm(v0[j]); v1[j] = sigm(v1[j]); }
            st8bf(G + (size_t)row * 1024 + (col - 1024), v0, v1); } } };
template <class Epi, class Sched, bool ALIGN_EPI = false, bool SP2 = false>
__device__ __forceinline__ void gemm_phase(PG8_LAS unsigned char* lds, const Gemm g, const Sched& S, const Epi& E, const int tid_in) {
    int tid_l = tid_in; asm volatile("" : "+v"(tid_l));
    const int tid = tid_l, wid = __builtin_amdgcn_readfirstlane(tid >> 6), lane = tid & 63, wr = wid >> 2, wc = wid & 3, fr = lane & 15, fq = lane >> 4;
    const int K = g.K, nt = K / BK;
    unsigned voffA[2], voffB[2];
#pragma unroll
    for (int i = 0; i < 2; ++i) { int R, C; stage_rc(tid * 16 + i * 8192, R, C); const int Rb = Epi::PERM ? ((R & ~31) + perm32(R & 31)) : R;
        voffA[i] = (unsigned)(R * g.lda + C) * 2u; voffB[i] = (unsigned)(Rb * g.ldb + C) * 2u; }
    const size_t kstep = (size_t)(BK * 2);
    const size_t hstepA = (size_t)HALF * g.lda * 2, hstepB = (size_t)HALF * g.ldb * 2;
    const size_t tstepA = 2 * hstepA, tstepB = 2 * hstepB;
    const unsigned ldsw = (unsigned)wid * 1024u;
    const int aoff = lds_byte(wr * 64 + fr, fq * 8), boff = lds_byte(wc * 32 + fr, fq * 8);
#define PG8_SA(b, h) (((b) * 2 + (h)) * HTB)
#define PG8_SB(b, h) ((4 + (b) * 2 + (h)) * HTB)
#define PG8_STAGE(bufoff, gbase, voff) do { _Pragma("unroll") for (int _i = 0; _i < 2; ++_i) \
        __builtin_amdgcn_global_load_lds((const unsigned*)((const char*)(gbase) + (voff)[_i]), (PG8_LAS unsigned*)(lds + (bufoff) + ldsw + _i * 8192), 16, 0, 0); } while (0)
#define PG8_LDA(dst, b, h) do { _Pragma("unroll") for (int m = 0; m < 4; ++m) _Pragma("unroll") for (int k = 0; k < 2; ++k) dst[m][k] = *(const PG8_LAS bf16x8*)(lds + PG8_SA(b, h) + aoff + m * 2048 + k * 1024); } while (0)
#define PG8_LDB(dst, b, h) do { _Pragma("unroll") for (int n = 0; n < 2; ++n) _Pragma("unroll") for (int k = 0; k < 2; ++k) dst[n][k] = *(const PG8_LAS bf16x8*)(lds + PG8_SB(b, h) + boff + n * 2048 + k * 1024); } while (0)
#define PG8_MMA(ai, bj, At, Bt) do { __builtin_amdgcn_s_setprio(1); _Pragma("unroll") for (int m = 0; m < 4; ++m) _Pragma("unroll") for (int n = 0; n < 2; ++n) _Pragma("unroll") for (int k = 0; k < 2; ++k) \
        acc[ai][bj][m][n] = __builtin_amdgcn_mfma_f32_16x16x32_bf16(Bt[n][k], At[m][k], acc[ai][bj][m][n], 0, 0, 0); __builtin_amdgcn_s_setprio(0); } while (0)
#define PG8_WAIT_V(n) asm volatile("s_waitcnt vmcnt(" #n ")" ::: "memory")
#define PG8_WAIT_L(n) asm volatile("s_waitcnt lgkmcnt(" #n ")" ::: "memory")
#define PG8_BAR __builtin_amdgcn_s_barrier()
#define PG8_SCHED __builtin_amdgcn_sched_barrier(0)
    Unit cur, nxt; int ui = 0;
    if (!S.next(0, cur)) return;
    f32x4 acc[2][2][4][2];
#pragma unroll
    for (int a = 0; a < 2; ++a)
#pragma unroll
        for (int b = 0; b < 2; ++b)
#pragma unroll
            for (int m = 0; m < 4; ++m)
#pragma unroll
                for (int n = 0; n < 2; ++n) acc[a][b][m][n] = (f32x4){0.f, 0.f, 0.f, 0.f};
    bf16x8 At[4][2], B0[2][2], B1[2][2];
    const char* cA = (const char*)g.A + (size_t)cur.pm * tstepA; const char* cB = (const char*)g.Bt + (size_t)cur.pn * tstepB;
    S.a_ready(cur);
    if constexpr (SP2) {
        PG8_STAGE(PG8_SB(0, 0), cB, voffB); PG8_STAGE(PG8_SB(0, 1), cB + hstepB, voffB); PG8_STAGE(PG8_SA(0, 0), cA, voffA); PG8_STAGE(PG8_SA(0, 1), cA + hstepA, voffA);
        if (wr == 1) PG8_BAR;
        PG8_WAIT_V(2); PG8_BAR;
        PG8_STAGE(PG8_SB(1, 0), cB + kstep, voffB); PG8_STAGE(PG8_SA(1, 0), cA + kstep, voffA); PG8_STAGE(PG8_SB(1, 1), cB + hstepB + kstep, voffB);
        PG8_WAIT_V(6); PG8_BAR;
    } else {
        PG8_STAGE(PG8_SB(0, 0), cB, voffB); PG8_STAGE(PG8_SA(0, 0), cA, voffA); PG8_STAGE(PG8_SB(0, 1), cB + hstepB, voffB); PG8_STAGE(PG8_SA(0, 1), cA + hstepA, voffA);
        if (wr == 1) PG8_BAR;
        PG8_WAIT_V(4); PG8_BAR;
        PG8_STAGE(PG8_SB(1, 0), cB + kstep, voffB); PG8_STAGE(PG8_SA(1, 0), cA + kstep, voffA); PG8_STAGE(PG8_SB(1, 1), cB + hstepB + kstep, voffB);
        PG8_WAIT_V(6); PG8_BAR;
    }
    for (;;) {
        const bool has_next = S.next(ui + 1, nxt);
        const char* nA = has_next ? (const char*)g.A + (size_t)nxt.pm * tstepA : cA; const char* nB = has_next ? (const char*)g.Bt + (size_t)nxt.pn * tstepB : cB;
        for (int t = 0; t < nt; t += 2) {
            const bool last = (t == nt - 2);
            const char* a1 = cA + (size_t)(t + 1) * kstep;
            const char* a2 = last ? nA : cA + (size_t)(t + 2) * kstep; const char* b2 = last ? nB : cB + (size_t)(t + 2) * kstep;
            const char* a3 = a2 + kstep; const char* b3 = b2 + kstep;
            if (last && has_next) S.a_ready(nxt);
            if constexpr (SP2) {
            PG8_LDB(B0, 0, 0); PG8_LDB(B1, 0, 1); PG8_SCHED; PG8_LDA(At, 0, 0); PG8_STAGE(PG8_SA(1, 1), a1 + hstepA, voffA);
            PG8_WAIT_V(8); PG8_WAIT_L(0); PG8_BAR; PG8_MMA(0, 0, At, B0); PG8_MMA(0, 1, At, B1); PG8_BAR; PG8_SCHED;
            PG8_LDA(At, 0, 1); PG8_STAGE(PG8_SB(0, 0), b2, voffB); PG8_STAGE(PG8_SB(0, 1), b2 + hstepB, voffB); PG8_STAGE(PG8_SA(0, 0), a2, voffA);
            PG8_WAIT_V(8); PG8_WAIT_L(0); PG8_BAR; PG8_MMA(1, 0, At, B0); PG8_MMA(1, 1, At, B1); PG8_BAR; PG8_SCHED;
            PG8_LDB(B0, 1, 0); PG8_LDB(B1, 1, 1); PG8_SCHED; PG8_LDA(At, 1, 0); PG8_STAGE(PG8_SA(0, 1), a2 + hstepA, voffA);
            PG8_WAIT_V(8); PG8_WAIT_L(0); PG8_BAR; PG8_MMA(0, 0, At, B0); PG8_MMA(0, 1, At, B1); PG8_BAR; PG8_SCHED;
            PG8_LDA(At, 1, 1); PG8_STAGE(PG8_SB(1, 0), b3, voffB); PG8_STAGE(PG8_SB(1, 1), b3 + hstepB, voffB); PG8_STAGE(PG8_SA(1, 0), a3, voffA);
            PG8_WAIT_V(8); PG8_WAIT_L(0); PG8_BAR; PG8_MMA(1, 0, At, B0); PG8_MMA(1, 1, At, B1); PG8_BAR; PG8_SCHED;
            } else {
            PG8_LDB(B0, 0, 0); PG8_SCHED; PG8_LDA(At, 0, 0); PG8_STAGE(PG8_SA(1, 1), a1 + hstepA, voffA);
            PG8_WAIT_L(8); PG8_BAR; PG8_WAIT_L(0); PG8_MMA(0, 0, At, B0); PG8_BAR; PG8_SCHED;
            PG8_LDB(B1, 0, 1); PG8_STAGE(PG8_SB(0, 0), b2, voffB);
            PG8_BAR; PG8_WAIT_L(0); PG8_MMA(0, 1, At, B1); PG8_BAR;
            PG8_LDA(At, 0, 1); PG8_STAGE(PG8_SA(0, 0), a2, voffA);
            PG8_BAR; PG8_WAIT_L(0); PG8_MMA(1, 0, At, B0); PG8_BAR; PG8_SCHED;
            PG8_STAGE(PG8_SB(0, 1), b2 + hstepB, voffB);
            PG8_WAIT_V(6); PG8_BAR; PG8_MMA(1, 1, At, B1); PG8_BAR;
            PG8_LDB(B0, 1, 0); PG8_SCHED; PG8_LDA(At, 1, 0); PG8_STAGE(PG8_SA(0, 1), a2 + hstepA, voffA);
            PG8_WAIT_L(8); PG8_BAR; PG8_WAIT_L(0); PG8_MMA(0, 0, At, B0); PG8_BAR; PG8_SCHED;
            PG8_LDB(B1, 1, 1); PG8_STAGE(PG8_SB(1, 0), b3, voffB);
            PG8_BAR; PG8_WAIT_L(0); PG8_MMA(0, 1, At, B1); PG8_BAR;
            PG8_LDA(At, 1, 1); PG8_STAGE(PG8_SA(1, 0), a3, voffA);
            PG8_BAR; PG8_WAIT_L(0); PG8_MMA(1, 0, At, B0); PG8_BAR; PG8_SCHED;
            PG8_STAGE(PG8_SB(1, 1), b3 + hstepB, voffB);
            PG8_WAIT_V(6); PG8_BAR; PG8_MMA(1, 1, At, B1); PG8_BAR;
            }
        }
        if constexpr (ALIGN_EPI) { if (wr == 0) PG8_BAR; }
        if constexpr (!Epi::AFTER_DRAIN) { E(acc, cur, wr, wc, fr, fq); S.done(cur); }
        if (!has_next) break;
#pragma unroll
        for (int a = 0; a < 2; ++a)
#pragma unroll
            for (int b = 0; b < 2; ++b)
#pragma unroll
                for (int m = 0; m < 4; ++m)
#pragma unroll
                    for (int n = 0; n < 2; ++n) acc[a][b][m][n] = (f32x4){0.f, 0.f, 0.f, 0.f};
        cur = nxt; cA = nA; cB = nB; ++ui;
        if constexpr (ALIGN_EPI) { if (wr == 1) PG8_BAR; }
    }
    PG8_WAIT_V(0);
    if constexpr (!ALIGN_EPI) { if (wr == 0) PG8_BAR; }
    PG8_BAR;
    if constexpr (Epi::AFTER_DRAIN) { E.fused(acc, cur, wr, wc, fr, fq, lds, wid, lane); S.done(cur); }
#undef PG8_SA
#undef PG8_SB
#undef PG8_STAGE
#undef PG8_LDA
#undef PG8_LDB
#undef PG8_MMA
#undef PG8_WAIT_V
#undef PG8_WAIT_L
#undef PG8_BAR
#undef PG8_SCHED
}
}
#include <hip/hip_bf16.h>
#include <cmath>
namespace attn_body {
using bf16=__hip_bfloat16;
using bf16x8=__attribute__((ext_vector_type(8)))short;
using s16x4=__attribute__((ext_vector_type(4)))short;
using f32x16=__attribute__((ext_vector_type(16)))float;
using u32x4=__attribute__((ext_vector_type(4)))unsigned;
constexpr int BATCH=2,NHEAD=16,SEQ=8192,D=64,DM=NHEAD*D;
constexpr int NW=8,QBLK=32,QB=QBLK*NW,KVBLK=64,NQB=SEQ/QB;
constexpr int ATTN_PITCH=DM, ATTN_UNIT_ROWS=QB;
__device__ __forceinline__ int crow(int r,int hi){return (r&3)+8*(r>>2)+4*hi;}
#define SBAR() __builtin_amdgcn_sched_barrier(0)
__device__ __forceinline__ void cmask(f32x16&p0,f32x16&p1,int jb,int qrel,int hi){
  const float NEG=-INFINITY; int kb=64*jb+4*hi;
  #pragma unroll
  for(int r=0;r<16;++r){int kv=kb+(r&3)+8*(r>>2); if(kv>qrel)p0[r]=NEG; if(kv+32>qrel)p1[r]=NEG;}
}

constexpr int NSLOT=3, SLOTB=9216;
constexpr int LDS_K=0, LDS_V=NSLOT*SLOTB, LDS_WS=2*NSLOT*SLOTB, LDS_OST=LDS_WS+NW*64*4, LDS_BYTES=LDS_OST+NW*4096;
constexpr float C2=0.125f*1.4426950408889634f;
__device__ __forceinline__ void glds16(const void*gsrc,unsigned lds_dst){unsigned keep;
  asm volatile("s_mov_b32 %0, m0\n\ts_mov_b32 m0, %2\n\ts_nop 0\n\tglobal_load_lds_dwordx4 %1, off\n\ts_mov_b32 m0, %0":"=&s"(keep):"v"(gsrc),"s"(lds_dst):"memory");}
__device__ __forceinline__ float max3f(float a,float b,float c){float r;asm("v_max3_f32 %0, %1, %2, %3":"=v"(r):"v"(a),"v"(b),"v"(c));return r;}
__device__ __forceinline__ float max2f(float a,float b){float r;asm("v_max_f32_e32 %0, %1, %2":"=v"(r):"v"(a),"v"(b));return r;}
__device__ __forceinline__ float fadd_s(float a,float b){float r;asm("v_add_f32_e32 %0, %1, %2":"=v"(r):"v"(a),"v"(b));return r;}
__device__ __forceinline__ float fsub_s(float a,float b){float r;asm("v_sub_f32_e32 %0, %1, %2":"=v"(r):"v"(a),"v"(b));return r;}
typedef float f32x2_t __attribute__((ext_vector_type(2))); typedef __bf16 bf16x2_t __attribute__((ext_vector_type(2)));
__device__ __forceinline__ unsigned cvtpk_s(float lo,float hi){f32x2_t v={lo,hi};bf16x2_t b=__builtin_convertvector(v,bf16x2_t);return __builtin_bit_cast(unsigned,b);}
#define WAIT_BAR(N) asm volatile("s_waitcnt vmcnt(" #N ") lgkmcnt(0)\n\ts_barrier":::"memory")
#define WAIT_BARW() do{ if(wid==0){WAIT_BAR(3);} else {WAIT_BAR(2);} }while(0)

__device__ __forceinline__ void qkt(f32x16&p0,f32x16&p1,const char*Kslot,const bf16x8*qr,const bf16x8 qe,const f32x16&negm,int r32,int hi){
  const char*kb=Kslot+hi*1024+r32*16;
  #pragma unroll
  for(int d0=0;d0<4;++d0){
    const bf16x8 b0=*reinterpret_cast<const bf16x8*>(kb+d0*2048);
    const bf16x8 b1=*reinterpret_cast<const bf16x8*>(kb+d0*2048+512);
    if(d0==0){p0=__builtin_amdgcn_mfma_f32_32x32x16_bf16(b0,qr[0],negm,0,0,0);p1=__builtin_amdgcn_mfma_f32_32x32x16_bf16(b1,qr[0],negm,0,0,0);}
    else{p0=__builtin_amdgcn_mfma_f32_32x32x16_bf16(b0,qr[d0],p0,0,0,0);p1=__builtin_amdgcn_mfma_f32_32x32x16_bf16(b1,qr[d0],p1,0,0,0);}}
  { const char*ke=Kslot+8192+r32*16; const bf16x8 e0=*reinterpret_cast<const bf16x8*>(ke),e1=*reinterpret_cast<const bf16x8*>(ke+512);
    p0=__builtin_amdgcn_mfma_f32_32x32x16_bf16(e0,qe,p0,0,0,0);p1=__builtin_amdgcn_mfma_f32_32x32x16_bf16(e1,qe,p1,0,0,0);}
}
typedef __attribute__((address_space(3))) const char* lds_cptr;
typedef short v4i16_t __attribute__((ext_vector_type(4)));
__device__ __forceinline__ void kload8(bf16x8*kf,lds_cptr kp){
  kf[0]=*(const __attribute__((address_space(3))) bf16x8*)(kp);      kf[1]=*(const __attribute__((address_space(3))) bf16x8*)(kp+512);
  kf[2]=*(const __attribute__((address_space(3))) bf16x8*)(kp+2048); kf[3]=*(const __attribute__((address_space(3))) bf16x8*)(kp+2560);
  kf[4]=*(const __attribute__((address_space(3))) bf16x8*)(kp+4096); kf[5]=*(const __attribute__((address_space(3))) bf16x8*)(kp+4608);
  kf[6]=*(const __attribute__((address_space(3))) bf16x8*)(kp+6144); kf[7]=*(const __attribute__((address_space(3))) bf16x8*)(kp+6656);
}
__device__ __forceinline__ void kload2(bf16x8*kf,lds_cptr kp,int j){ kf[2*j]=*(const __attribute__((address_space(3))) bf16x8*)(kp+j*2048); kf[2*j+1]=*(const __attribute__((address_space(3))) bf16x8*)(kp+j*2048+512); }
__device__ __forceinline__ s16x4 vtr(lds_cptr p){ return __builtin_bit_cast(s16x4,__builtin_amdgcn_ds_read_tr16_b64_v4i16((__attribute__((address_space(3))) v4i16_t*)p)); }
__device__ __forceinline__ float rowmax(const f32x16&p0,const f32x16&p1){
  float a=max3f(p0[0],p0[1],p1[0]),b=max3f(p0[2],p0[3],p1[1]);a=max3f(a,p1[2],p1[3]);
  #pragma unroll
  for(int r=4;r<16;r+=4){a=max3f(a,p0[r],p0[r+1]);b=max3f(b,p0[r+2],p0[r+3]);a=max3f(a,p1[r],p1[r+1]);b=max3f(b,p1[r+2],p1[r+3]);}
  const float m=max2f(a,b);
  auto rr=__builtin_amdgcn_permlane32_swap(__float_as_uint(m),__float_as_uint(m),false,false);
  return max2f(__uint_as_float(rr[0]),__uint_as_float(rr[1]));
}
__device__ __forceinline__ void pv(f32x16*o,int vb,bf16x8 pa0,bf16x8 pa1,bf16x8 pa2,bf16x8 pa3){
  #pragma unroll
  for(int d0=0;d0<2;++d0){s16x4 lo[4],hi[4];
    #pragma unroll
    for(int ks=0;ks<4;++ks){
      asm volatile("ds_read_b64_tr_b16 %0,%1 offset:%c2":"=&v"(lo[ks]):"v"(vb),"i"(d0*4096+ks*1024):"memory");
      asm volatile("ds_read_b64_tr_b16 %0,%1 offset:%c2":"=&v"(hi[ks]):"v"(vb),"i"(d0*4096+ks*1024+512):"memory");}
    asm volatile("s_waitcnt lgkmcnt(0)":::"memory");SBAR();
    #define PK(k) (bf16x8){lo[k][0],lo[k][1],lo[k][2],lo[k][3],hi[k][0],hi[k][1],hi[k][2],hi[k][3]}
    o[d0]=__builtin_amdgcn_mfma_f32_32x32x16_bf16(pa0,PK(0),o[d0],0,0,0);
    o[d0]=__builtin_amdgcn_mfma_f32_32x32x16_bf16(pa1,PK(1),o[d0],0,0,0);
    o[d0]=__builtin_amdgcn_mfma_f32_32x32x16_bf16(pa2,PK(2),o[d0],0,0,0);
    o[d0]=__builtin_amdgcn_mfma_f32_32x32x16_bf16(pa3,PK(3),o[d0],0,0,0);
    #undef PK
  }
}

#ifndef ATTN_STORE16
#define ATTN_STORE16(p,v) (*(u32x4*)(p)=(v))
#endif
template<int THRL> __device__ __forceinline__ void attn_unit(int b,int h,int qb,const bf16*Q,const bf16*__restrict__ K,const bf16*__restrict__ V,bf16*O,const bf16*__restrict__ GT,const unsigned char*__restrict__ G3,const float*__restrict__ qgain,const float kbound,char*shm,const int tid_in){
  int tid_l=tid_in; asm volatile("":"+v"(tid_l)); const int tid=tid_l,lane=tid&63,r32=lane&31,hi=lane>>5; const int wid=__builtin_amdgcn_readfirstlane(tid>>6);
  const long rowbase=(long)b*SEQ; const int q0=qb*QB;
  const bf16*Qw=Q+(rowbase+q0+wid*QBLK)*DM+h*D;
  const bf16*Kh=K+rowbase*DM+h*D,*Vh=V+rowbase*DM+h*D;
  const unsigned lds0=(unsigned)(uintptr_t)shm;
  float*wsf=(float*)(shm+LDS_WS)+wid*64;
  const bf16*ksrc=Kh+(long)lane*DM+wid*8;
  const bf16*vsrc=Vh+(long)(16*(wid&3)+(lane>>2))*DM+(wid>>2)*32+(lane&3)*8;
  const unsigned kdst=lds0+LDS_K+wid*1024, vdst=lds0+LDS_V+wid*1024, gdst=lds0+LDS_K+8192;
  const unsigned char*gsrc=G3+((long)(b*NHEAD+h)*SEQ+lane)*16;
  #define DMA_K(t,slot) do{ if(wid==0)glds16(gsrc+(long)(t)*KVBLK*16,(unsigned)__builtin_amdgcn_readfirstlane(gdst+(slot))); glds16(ksrc+(long)(t)*KVBLK*DM,(unsigned)__builtin_amdgcn_readfirstlane(kdst+(slot))); }while(0)
  #define DMA_V(t,slot) glds16(vsrc+(long)(t)*KVBLK*DM,(unsigned)__builtin_amdgcn_readfirstlane(vdst+(slot)))
  const int vb0=(int)(lds0+LDS_V)+((lane>>4)&1)*32+(lane&3)*8+(4*hi+((lane&15)>>2))*64;
  const char*Kbase=shm+LDS_K; bf16x8 kf[10];
  const lds_cptr shm3=(lds_cptr)shm; const lds_cptr kp0=shm3+LDS_K+hi*1024+r32*16; const lds_cptr kpe=shm3+LDS_K+8192+r32*16; const lds_cptr vp0=shm3+LDS_V+((lane>>4)&1)*32+(lane&3)*8+(4*hi+((lane&15)>>2))*64;
  const int NT=(q0+QB)/KVBLK;
  DMA_K(0,0);DMA_V(0,0);DMA_K(1,SLOTB);
  bf16x8 qr[4]; float fq2; bf16x8 qe; float ubound;
  { bf16x8 qraw[4];
    #pragma unroll
    for(int d0=0;d0<4;++d0)qraw[d0]=*reinterpret_cast<const bf16x8*>(&Qw[(long)r32*DM+d0*16+hi*8]);
    const u32x4 ge=*reinterpret_cast<const u32x4*>(G3+((long)(b*NHEAD+h)*SEQ+q0+wid*QBLK+r32)*16);
    fq2=-(__uint_as_float(ge[0]<<16)+__uint_as_float(ge[0]&0xffff0000u)+__uint_as_float(ge[1]<<16));
    float ss=0.f;
    #pragma unroll
    for(int d0=0;d0<4;++d0)
      #pragma unroll
      for(int j=0;j<8;++j){const float x=__uint_as_float(((unsigned)(unsigned short)qraw[d0][j])<<16);ss+=x*x;}
    {auto rr=__builtin_amdgcn_permlane32_swap(__float_as_uint(ss),__float_as_uint(ss),false,false);ss=__uint_as_float(rr[0])+__uint_as_float(rr[1]);}
    const float qs=C2/sqrtf(ss*(1.0f/64.0f)+1e-6f);
    float s2=0.f;
    #pragma unroll
    for(int d0=0;d0<4;++d0){ u32x4 w;
      #pragma unroll
      for(int j=0;j<8;j+=2){const float x0=__uint_as_float(((unsigned)(unsigned short)qraw[d0][j])<<16),x1=__uint_as_float(((unsigned)(unsigned short)qraw[d0][j+1])<<16);
        const float y0=x0*qs*qgain[d0*16+hi*8+j],y1=x1*qs*qgain[d0*16+hi*8+j+1]; s2+=y0*y0+y1*y1;
        w[j>>1]=cvtpk_s(y0,y1);}
      qr[d0]=__builtin_bit_cast(bf16x8,w);}
    {auto rr=__builtin_amdgcn_permlane32_swap(__float_as_uint(s2),__float_as_uint(s2),false,false);s2=__uint_as_float(rr[0])+__uint_as_float(rr[1]);}
    ubound=sqrtf(s2)*kbound;
    const unsigned one2=hi?0u:0x3f803f80u, one1=hi?0u:0x00003f80u; qe=__builtin_bit_cast(bf16x8,(u32x4){one2,one1,0u,0u}); }
  float mhat=ubound,l_reg=0.f;f32x16 o[2];o[0]=f32x16{};o[1]=f32x16{};f32x16 negm;
  #pragma unroll
  for(int r=0;r<16;++r)negm[r]=fq2-ubound;
  asm volatile("":"+v"(negm));
  const int qrel=wid*QBLK+r32;
  #define CMASK(P0,P1,t) do{int jb_=(t)-(NT-4); if(jb_>=0)cmask(P0,P1,jb_,qrel,hi);}while(0)
  bool resc=false;
  #define START(P0,P1) do{ const float rm=rowmax(P0,P1); resc=false; \
    { const float dl=fmaxf(rm,0.f); mhat=fadd_s(mhat,dl); \
      _Pragma("unroll") for(int r=0;r<16;++r){P0[r]=fsub_s(P0[r],dl);P1[r]=fsub_s(P1[r],dl);} \
      _Pragma("unroll") for(int r=0;r<16;++r)negm[r]=fq2-mhat; asm volatile("":"+v"(negm)); } \
    _Pragma("unroll") for(int r=0;r<16;++r)P0[r]=__builtin_amdgcn_exp2f(P0[r]); }while(0)
  #define RESC() do{ if(resc){ asm volatile("s_waitcnt lgkmcnt(0)":::"memory"); \
      _Pragma("unroll") for(int d_=0;d_<2;++d_) _Pragma("unroll") for(int r=0;r<16;++r)o[d_][r]*=wsf[crow(r,hi)]; } }while(0)
  f32x16 pA0,pA1,pB0,pB1;
  int sl_prev=0,sl_cur=0,sl_next=SLOTB;
  #define ROT() do{sl_prev=sl_cur;sl_cur=sl_next;sl_next=(sl_next==(NSLOT-1)*SLOTB)?0:sl_next+SLOTB;}while(0)
  DMA_K(2,2*SLOTB);
  WAIT_BAR(3);
  qkt(pA0,pA1,Kbase,qr,qe,negm,r32,hi);asm volatile("s_nop 15\n\ts_nop 7":"+v"(pA0),"+v"(pA1));CMASK(pA0,pA1,0);
  START(pA0,pA1);
  _Pragma("unroll") for(int r=0;r<16;++r)pA1[r]=__builtin_amdgcn_exp2f(pA1[r]);
  WAIT_BAR(0);
  DMA_K(3,0);DMA_V(1,SLOTB);
  ROT();
  kload8(kf,kp0+sl_cur);
  kf[8]=*(const __attribute__((address_space(3))) bf16x8*)(kpe+sl_cur); kf[9]=*(const __attribute__((address_space(3))) bf16x8*)(kpe+sl_cur+512);
  WAIT_BARW();
  s16x4 vlo[8],vhi[8]; u32x4 pw0,pw1,pw2,pw3;
  #define PKW(P,B) cvtpk_s(P[B],P[B+1])
  #define PAF(k) __builtin_bit_cast(bf16x8,pw##k)
  #define VFR(i) (bf16x8){vlo[i][0],vlo[i][1],vlo[i][2],vlo[i][3],vhi[i][0],vhi[i][1],vhi[i][2],vhi[i][3]}
  #define PIN(x) asm volatile("":"+v"(x))
  #define MX3(a,b,c) __builtin_fmaxf(__builtin_fmaxf((a),(b)),(c))
  #define GAPA(MF,A0,A1,A2,A3,W0,W1,PW) do{ MF; sacc+=A0; sacc+=A1; sacc+=A2; sacc+=A3; PIN(sacc); W0; W1; PIN(PW); SBAR(); }while(0)
  #define EX(v) __builtin_amdgcn_exp2f(v)
  #define GAPB(MF,X,B) do{ MF; X[B]=EX(X[B]); X[B+1]=EX(X[B+1]); X[B+2]=EX(X[B+2]); X[B+3]=EX(X[B+3]); PIN(X); SBAR(); }while(0)
  #define VRD(i) do{ vlo[i]=vtr(vp_+(((i)>>2)*4096+((i)&3)*1024)); vhi[i]=vtr(vp_+(((i)>>2)*4096+((i)&3)*1024+512)); }while(0)
  #define KRD(G,j) do{ if(G){ kload2(kf,kp0+sl_next,j); SBAR(); } }while(0)
  #define STEP(C0,C1,P0,P1,t,GK,GV,GL) do{ SBAR(); \
    const lds_cptr vp_=vp0+sl_prev; \
    VRD(0); SBAR(); float sacc=(P0[0]+P0[1]); \
    GAPA(C0=__builtin_amdgcn_mfma_f32_32x32x16_bf16(kf[0],qr[0],negm,0,0,0), P0[2],P0[3],P0[4],P0[5],     pw0[0]=PKW(P0,0), pw0[1]=PKW(P0,2), pw0); \
    VRD(4); SBAR(); GAPA(C1=__builtin_amdgcn_mfma_f32_32x32x16_bf16(kf[1],qr[0],negm,0,0,0), P0[6],P0[7],P0[8],P0[9],     pw0[2]=PKW(P0,4), pw0[3]=PKW(P0,6), pw0); \
    VRD(1); SBAR(); GAPA(C0=__builtin_amdgcn_mfma_f32_32x32x16_bf16(kf[2],qr[1],C0,0,0,0),   P0[10],P0[11],P0[12],P0[13], pw1[0]=PKW(P0,8), pw1[1]=PKW(P0,10), pw1); \
    VRD(5); SBAR(); GAPA(C1=__builtin_amdgcn_mfma_f32_32x32x16_bf16(kf[3],qr[1],C1,0,0,0),   P0[14],P0[15],P1[0],P1[1],   pw1[2]=PKW(P0,12),pw1[3]=PKW(P0,14), pw1); \
    VRD(2); SBAR(); GAPA(C0=__builtin_amdgcn_mfma_f32_32x32x16_bf16(kf[4],qr[2],C0,0,0,0),   P1[2],P1[3],P1[4],P1[5],     pw2[0]=PKW(P1,0), pw2[1]=PKW(P1,2), pw2); \
    VRD(6); SBAR(); GAPA(C1=__builtin_amdgcn_mfma_f32_32x32x16_bf16(kf[5],qr[2],C1,0,0,0),   P1[6],P1[7],P1[8],P1[9],     pw2[2]=PKW(P1,4), pw2[3]=PKW(P1,6), pw2); \
    VRD(3); SBAR(); GAPA(C0=__builtin_amdgcn_mfma_f32_32x32x16_bf16(kf[6],qr[3],C0,0,0,0),   P1[10],P1[11],P1[12],P1[13], pw3[0]=PKW(P1,8), pw3[1]=PKW(P1,10), pw3); \
    VRD(7); SBAR(); GAPA(C1=__builtin_amdgcn_mfma_f32_32x32x16_bf16(kf[7],qr[3],C1,0,0,0),   P1[14],P1[15],0.f,0.f,       pw3[2]=PKW(P1,12),pw3[3]=PKW(P1,14), pw3); \
    C0=__builtin_amdgcn_mfma_f32_32x32x16_bf16(kf[8],qe,C0,0,0,0); C1=__builtin_amdgcn_mfma_f32_32x32x16_bf16(kf[9],qe,C1,0,0,0); \
    l_reg+=sacc; \
    if(GK){DMA_K((t)+3,sl_cur);} if(GV){DMA_V((t)+1,sl_next);} \
    CMASK(C0,C1,t); \
    { float a=MX3(C0[0],C0[1],C1[0]),b=MX3(C0[2],C0[3],C1[1]); a=MX3(a,C1[2],C1[3]); \
      _Pragma("unroll") for(int r=4;r<16;r+=4){a=MX3(a,C0[r],C0[r+1]);b=MX3(b,C0[r+2],C0[r+3]);a=MX3(a,C1[r],C1[r+1]);b=MX3(b,C1[r+2],C1[r+3]);} \
      float rm=__builtin_fmaxf(a,b); { auto rr=__builtin_amdgcn_permlane32_swap(__float_as_uint(rm),__float_as_uint(rm),false,false); rm=__builtin_fmaxf(__uint_as_float(rr[0]),__uint_as_float(rr[1])); } \
      resc=false; \
      if(__builtin_expect(__any(rm>(float)THRL),0)){ const float dl=__builtin_fmaxf(rm,0.f); mhat+=dl; \
        _Pragma("unroll") for(int r=0;r<16;++r){C0[r]-=dl;C1[r]-=dl;} \
        _Pragma("unroll") for(int r=0;r<16;++r)negm[r]=fq2-mhat; asm volatile("":"+v"(negm)); \
        const float f=__builtin_amdgcn_exp2f(-dl); l_reg*=f; if(hi==0)wsf[r32]=f; resc=true; } } \
    SBAR(); \
    GAPB(o[0]=__builtin_amdgcn_mfma_f32_32x32x16_bf16(PAF(0),VFR(0),o[0],0,0,0), C0,0); \
    GAPB(o[1]=__builtin_amdgcn_mfma_f32_32x32x16_bf16(PAF(0),VFR(4),o[1],0,0,0), C0,4); \
    KRD(GL,0); GAPB(o[0]=__builtin_amdgcn_mfma_f32_32x32x16_bf16(PAF(1),VFR(1),o[0],0,0,0), C0,8); \
    KRD(GL,1); GAPB(o[1]=__builtin_amdgcn_mfma_f32_32x32x16_bf16(PAF(1),VFR(5),o[1],0,0,0), C0,12); \
    KRD(GL,2); GAPB(o[0]=__builtin_amdgcn_mfma_f32_32x32x16_bf16(PAF(2),VFR(2),o[0],0,0,0), C1,0); \
    KRD(GL,3); GAPB(o[1]=__builtin_amdgcn_mfma_f32_32x32x16_bf16(PAF(2),VFR(6),o[1],0,0,0), C1,4); \
    if(GL){ kf[8]=*(const __attribute__((address_space(3))) bf16x8*)(kpe+sl_next); kf[9]=*(const __attribute__((address_space(3))) bf16x8*)(kpe+sl_next+512); SBAR(); } \
    GAPB(o[0]=__builtin_amdgcn_mfma_f32_32x32x16_bf16(PAF(3),VFR(3),o[0],0,0,0), C1,8); \
    GAPB(o[1]=__builtin_amdgcn_mfma_f32_32x32x16_bf16(PAF(3),VFR(7),o[1],0,0,0), C1,12); \
    }while(0)
  int t=1;
  #undef CMASK
  #define CMASK(P0,P1,t) do{}while(0)
  for(;t+5<NT;t+=2){
    STEP(pB0,pB1,pA0,pA1,t,true,true,true);     WAIT_BARW(); RESC(); ROT();
    STEP(pA0,pA1,pB0,pB1,t+1,true,true,true);   WAIT_BARW(); RESC(); ROT();
  }
  #undef CMASK
  #define CMASK(P0,P1,t) do{int jb_=(t)-(NT-4); if(jb_>=0)cmask(P0,P1,jb_,qrel,hi);}while(0)
  #define ENDW(tt) do{ if((tt)+3<NT){WAIT_BARW();} else if((tt)+2<NT){WAIT_BAR(1);} else {WAIT_BAR(0);} }while(0)
  for(;t+1<NT;t+=2){
    STEP(pB0,pB1,pA0,pA1,t,(t+3<NT),(t+1<NT),(t+1<NT));       ENDW(t);   RESC(); ROT();
    STEP(pA0,pA1,pB0,pB1,t+1,(t+4<NT),(t+2<NT),(t+2<NT));     ENDW(t+1); RESC(); ROT();
  }
  STEP(pB0,pB1,pA0,pA1,NT-1,false,false,false); RESC();
  { float sacc=pB0[0]+pB0[1]; _Pragma("unroll") for(int r=2;r<16;++r)sacc+=pB0[r]; _Pragma("unroll") for(int r=0;r<16;++r)sacc+=pB1[r]; l_reg+=sacc;
    pw0=(u32x4){PKW(pB0,0),PKW(pB0,2),PKW(pB0,4),PKW(pB0,6)};pw1=(u32x4){PKW(pB0,8),PKW(pB0,10),PKW(pB0,12),PKW(pB0,14)};pw2=(u32x4){PKW(pB1,0),PKW(pB1,2),PKW(pB1,4),PKW(pB1,6)};pw3=(u32x4){PKW(pB1,8),PKW(pB1,10),PKW(pB1,12),PKW(pB1,14)};
    SBAR(); pv(o,vb0+sl_cur,PAF(0),PAF(1),PAF(2),PAF(3)); }
  #undef PKW
  #undef PAF
  #undef VFR
  #undef PIN
  #undef MX3
  #undef GAPA
  #undef GAPB
  #undef EX
  #undef VRD
  #undef KRD
  #undef STEP
  #undef ENDW
  {auto rr=__builtin_amdgcn_permlane32_swap(__float_as_uint(l_reg),__float_as_uint(l_reg),false,false);l_reg=__uint_as_float(rr[0])+__uint_as_float(rr[1]);}
  if(hi==0)wsf[32+r32]=l_reg;asm volatile("s_waitcnt lgkmcnt(0)":::"memory");
  float rli[16];
  #pragma unroll
  for(int r=0;r<16;++r)rli[r]=__builtin_amdgcn_rcpf(wsf[32+crow(r,hi)]);
  bf16*Ow=O+(rowbase+q0+wid*QBLK)*DM+h*D;
  { bf16*stg=(bf16*)(shm+LDS_OST)+wid*2048;
    #pragma unroll
    for(int r=0;r<16;++r){const int orow=crow(r,hi);
      #pragma unroll
      for(int d0=0;d0<2;++d0)stg[orow*64+d0*32+r32]=__float2bfloat16(o[d0][r]*rli[r]);}
    asm volatile("s_waitcnt lgkmcnt(0)":::"memory");
    const bf16*Gw=GT+(rowbase+q0+wid*QBLK)*DM+h*D;
    #pragma unroll
    for(int i=0;i<4;++i){const int row=i*8+(lane>>3),ch=lane&7; u32x4 v=*(const u32x4*)(stg+row*64+ch*8); const u32x4 gg=*(const u32x4*)(Gw+(long)row*DM+ch*8);
      #pragma unroll
      for(int j=0;j<4;++j){ v[j]=cvtpk_s(__uint_as_float(v[j]<<16)*__uint_as_float(gg[j]<<16),__uint_as_float(v[j]&0xffff0000u)*__uint_as_float(gg[j]&0xffff0000u)); }
      ATTN_STORE16(Ow+(long)row*DM+ch*8,v);} }
  asm volatile("s_waitcnt lgkmcnt(0)\n\ts_barrier":::"memory");
  #undef DMA_K
  #undef DMA_V
  #undef CMASK
  #undef START
  #undef RESC
  #undef ROT
}
constexpr int ATTN_LDS_BYTES=LDS_BYTES;
struct AttnTensors { const bf16* Q; const bf16* K; const bf16* V; bf16* O; const bf16* GT; const unsigned char* G3; const float* qgain; float kbound; };
struct AttnUnit { int bh; int qb; };
struct StaticOrder {
  int vcu;
  __device__ __forceinline__ explicit StaticOrder(int grid,int block):vcu((block%8)*(grid/8)+block/8){}
  __device__ __forceinline__ bool next(int i,AttnUnit&u)const{ if(i>=4)return false; const int s=vcu&7; u.bh=vcu>>3; u.qb=(i==0)?s:(i==1)?15-s:(i==2)?16+s:31-s; return true; }
  __device__ __forceinline__ void a_ready(const AttnUnit&)const{}
  __device__ __forceinline__ void done(const AttnUnit&)const{}
};
template<class Sched,int THRL=8> __device__ __forceinline__ void attn_phase(char*lds,const AttnTensors&T,const Sched&S,const int tid_in){
  AttnUnit u;
  for(int i=0;S.next(i,u);++i){ S.a_ready(u); attn_unit<THRL>(u.bh/NHEAD,u.bh%NHEAD,u.qb,T.Q,T.K,T.V,T.O,T.GT,T.G3,T.qgain,T.kbound,lds,tid_in); S.done(u); }
}
#undef SBAR
#undef WAIT_BAR
#undef WAIT_BARW
}
constexpr int NWAVES = 8;
constexpr int BATCH = 2, T = 8192, D = 1024, H = 16, HD = 64, FF = 4096, M = BATCH * T;
constexpr int N1 = 3584, K1 = 2048, NP2 = 3072;
constexpr size_t MiB = 1u << 20;
constexpr size_t WS_MOD = 0;
constexpr size_t WS_W1 = 1 * MiB;
constexpr size_t WS_W2A = 29 * MiB;
constexpr size_t WS_W2G = 32 * MiB;
constexpr size_t WS_WO = 33 * MiB;
constexpr size_t WS_WKV = 37 * MiB;
constexpr size_t WS_WQG = 42 * MiB;
constexpr size_t WS_WO2 = 50 * MiB;
constexpr size_t WS_WUP = 54 * MiB, WS_WDN = 62 * MiB;
constexpr size_t WS_G3 = 70 * MiB;
constexpr size_t WS_FL = 74 * MiB;
constexpr size_t WS_H2 = 76 * MiB;
constexpr size_t WS_P1 = 140 * MiB;
constexpr size_t WS_P2 = 252 * MiB;
constexpr size_t WS_VF = 348 * MiB;
constexpr size_t WS_HB = 140 * MiB;
constexpr size_t WS_KVRAW = 140 * MiB, WS_QB = 204 * MiB, WS_GT = 236 * MiB, WS_VS = 316 * MiB, WS_KS = 348 * MiB;
constexpr size_t WS_END = 380 * MiB;
constexpr int LDS_BYTES = 147456;

#define GAS __attribute__((address_space(1)))
#define LAS __attribute__((address_space(3)))
typedef unsigned short bf16;
typedef unsigned v4u __attribute__((ext_vector_type(4)));
typedef unsigned v2u __attribute__((ext_vector_type(2)));
typedef float f32x4 __attribute__((ext_vector_type(4)));
using pg8::pkbf; using pg8::bflo; using pg8::bfhi; using pg8::sigm;

struct Args { const float* in[39]; float* out; unsigned char* ws; int ph_lo, ph_hi; };

struct Frame { LAS unsigned char* lds; int tid, lane, wave, vcu, G, bx; unsigned char* ws; float* out; const float* const* in; };

__device__ __forceinline__ void tr_item(const float* W, int ldw, int Nvalid, bf16* WT, int ldt, int row_off, int col_off, const float* mu, LAS float* scr, int item, int lane) {
    const int nblk = (Nvalid + 31) / 32, kb = item / nblk, nb = item % nblk, k0 = 64 * kb, n0 = 32 * nb;
#pragma unroll 8
    for (int i = 0; i < 32; ++i) { const int kk = 2 * i + (lane >> 5), n = n0 + (lane & 31); scr[kk * 33 + (lane & 31)] = n < Nvalid ? W[(size_t)(k0 + kk) * ldw + n] : 0.f; }
    asm volatile("s_waitcnt lgkmcnt(0)" ::: "memory");
    const int c = lane & 7;
    float s0[8], s1[8];
#pragma unroll
    for (int q = 0; q < 8; ++q) { const float m = mu ? mu[k0 + 8 * c + q] : 0.f; s0[q] = 1.f - m; s1[q] = m; }
#pragma unroll
    for (int j = 0; j < 4; ++j) { const int n = (lane >> 3) + 8 * j; const LAS float* s = scr + (8 * c) * 33 + n;
        float v[8];
#pragma unroll
        for (int q = 0; q < 8; ++q) v[q] = s[q * 33];
        v4u o; o.x = pkbf(v[0] * s0[0], v[1] * s0[1]); o.y = pkbf(v[2] * s0[2], v[3] * s0[3]); o.z = pkbf(v[4] * s0[4], v[5] * s0[5]); o.w = pkbf(v[6] * s0[6], v[7] * s0[7]);
        bf16* dst = WT + (size_t)(row_off + n0 + n) * ldt + col_off + k0 + 8 * c;
        *(v4u*)dst = o;
        if (mu) { v4u p; p.x = pkbf(v[0] * s1[0], v[1] * s1[1]); p.y = pkbf(v[2] * s1[2], v[3] * s1[3]); p.z = pkbf(v[4] * s1[4], v[5] * s1[5]); p.w = pkbf(v[6] * s1[6], v[7] * s1[7]); *(v4u*)(dst + 1024) = p; } }
    asm volatile("s_waitcnt lgkmcnt(0)" ::: "memory");
}
__device__ __forceinline__ float dpp_f(float x, const int ctrl_sel) {
    switch (ctrl_sel) {
        case 0: return __builtin_bit_cast(float, __builtin_amdgcn_update_dpp(0, __builtin_bit_cast(int, x), 0xB1, 0xf, 0xf, false));
        case 1: return __builtin_bit_cast(float, __builtin_amdgcn_update_dpp(0, __builtin_bit_cast(int, x), 0x4E, 0xf, 0xf, false));
        case 2: return __builtin_bit_cast(float, __builtin_amdgcn_update_dpp(0, __builtin_bit_cast(int, x), 0x141, 0xf, 0xf, false));
        default: return __builtin_bit_cast(float, __builtin_amdgcn_update_dpp(0, __builtin_bit_cast(int, x), 0x140, 0xf, 0xf, false));
    }
}
__device__ __forceinline__ float sum4(float x) { x += dpp_f(x, 0); x += dpp_f(x, 1); return x; }
__device__ __forceinline__ float sum8(float x) { x = sum4(x); x += dpp_f(x, 2); return x; }
__device__ __forceinline__ float sum16(float x) { x = sum8(x); x += dpp_f(x, 3); return x; }
__device__ __forceinline__ float wave_sum(float v) {
    v = sum16(v);
    { auto rr = __builtin_amdgcn_permlane16_swap(__float_as_uint(v), __float_as_uint(v), false, false); v = __uint_as_float(rr[0]) + __uint_as_float(rr[1]); }
    { auto rr = __builtin_amdgcn_permlane32_swap(__float_as_uint(v), __float_as_uint(v), false, false); v = __uint_as_float(rr[0]) + __uint_as_float(rr[1]); }
    return v;
}
__device__ __forceinline__ void norm_row(const float* xrow, const float* g, const float* sh, const float* sc, int lane, f32x4 (&v)[4]) {
    float s = 0.f;
#pragma unroll
    for (int j = 0; j < 4; ++j) { v[j] = *((const f32x4*)xrow + lane + 64 * j); s += (v[j].x * v[j].x + v[j].y * v[j].y) + (v[j].z * v[j].z + v[j].w * v[j].w); }
    const float rstd = 1.0f / sqrtf(wave_sum(s) * (1.f / D) + 1e-6f);
#pragma unroll
    for (int j = 0; j < 4; ++j) { const f32x4 gg = *((const f32x4*)g + lane + 64 * j);
        f32x4 a = {1.f, 1.f, 1.f, 1.f}, b = {0.f, 0.f, 0.f, 0.f}; if (sc) { a = *((const f32x4*)sc + lane + 64 * j) + 1.0f; b = *((const f32x4*)sh + lane + 64 * j); }
        v[j] = (v[j] * rstd * gg) * a + b; }
}
__device__ __forceinline__ void st_row_bf16(bf16* orow, int lane, const f32x4 (&v)[4]) {
#pragma unroll
    for (int j = 0; j < 4; ++j) { v2u w; w.x = pkbf(v[j].x, v[j].y); w.y = pkbf(v[j].z, v[j].w); *((v2u*)orow + lane + 64 * j) = w; }
}
__device__ __forceinline__ void p0_mod(Frame& F) {
    LAS float* ca = (LAS float*)F.lds; LAS float* red = (LAS float*)(F.lds + 8192);
    const float* cin = F.in[1];
    for (int i = F.tid; i < 2048; i += 512) { const float c = cin[i]; ca[i] = c / (1.0f + __expf(-c)); }
    __syncthreads();
    float* MOD = (float*)(F.ws + WS_MOD); float* MODKV = MOD + 4 * 2 * 6144;
    for (int item = F.bx; item < 208; item += F.G) {
        const int col = item * 128; const float* W; const float* bias; int ldw, cw; float* dst0; float* dst1;
        if (col < 24576) { const int l = col / 6144; cw = col % 6144; W = F.in[2] + (size_t)l * 1024 * 6144; ldw = 6144; bias = F.in[3] + l * 6144; dst0 = MOD + (l * 2 + 0) * 6144 + cw; dst1 = MOD + (l * 2 + 1) * 6144 + cw; }
        else { cw = col - 24576; W = F.in[30]; ldw = 2048; bias = F.in[31]; dst0 = MODKV + cw; dst1 = MODKV + 2048 + cw; }
        const int c4 = F.tid & 31, ks = F.tid >> 5;
        f32x4 a0 = {0.f, 0.f, 0.f, 0.f}, a1 = {0.f, 0.f, 0.f, 0.f};
#pragma unroll 8
        for (int k = ks * 64; k < ks * 64 + 64; ++k) { const f32x4 w = *(const f32x4*)(W + (size_t)k * ldw + cw + c4 * 4); a0 += w * ca[k]; a1 += w * ca[1024 + k]; }
        *(LAS f32x4*)(red + (ks * 32 + c4) * 8) = a0; *(LAS f32x4*)(red + (ks * 32 + c4) * 8 + 4) = a1;
        __syncthreads();
        if (F.tid < 256) { const int b = F.tid >> 7, c = F.tid & 127; float s = 0.f;
#pragma unroll
            for (int q = 0; q < 16; ++q) s += red[(q * 32 + (c >> 2)) * 8 + b * 4 + (c & 3)];
            (b ? dst1 : dst0)[c] = s + bias[cw + c]; }
        __syncthreads();
    }
}
__device__ __forceinline__ void p0_weights(Frame& F) {
    LAS float* scr = (LAS float*)(F.lds + 16384 + F.wave * 16384);
    const int gw = F.vcu * NWAVES + F.wave, NGW = F.G * NWAVES;
    bf16* W1 = (bf16*)(F.ws + WS_W1); bf16* WO = (bf16*)(F.ws + WS_WO); bf16* WKV = (bf16*)(F.ws + WS_WKV); bf16* WQG = (bf16*)(F.ws + WS_WQG); bf16* WO2 = (bf16*)(F.ws + WS_WO2);
    const float* mu = F.in[8];
    constexpr int PL = 512 * 3 + 32 + 32 + 16 + 80 + 512;
    constexpr int NIT = 2 * PL + 512 + 512 + 16 + 2 * (1024 + 512);
    for (int it = gw; it < NIT; it += NGW) {
        int r = it;
        if (r < 2 * PL) { const int i = r / PL; r -= i * PL; bf16* w1 = W1 + (size_t)i * N1 * K1; const float* m6 = mu + i * 6 * 1024;
            if (r < 512) { tr_item(F.in[9] + (size_t)i * D * D, D, D, w1, K1, 0, 0, m6 + 0 * 1024, scr, r, F.lane); continue; } r -= 512;
            if (r < 512) { tr_item(F.in[10] + (size_t)i * D * D, D, D, w1, K1, 1024, 0, m6 + 2 * 1024, scr, r, F.lane); continue; } r -= 512;
            if (r < 512) { tr_item(F.in[11] + (size_t)i * D * D, D, D, w1, K1, 2048, 0, m6 + 3 * 1024, scr, r, F.lane); continue; } r -= 512;
            if (r < 32) { tr_item(F.in[14] + (size_t)i * D * 64, 64, 64, w1, K1, 3072, 0, m6 + 1 * 1024, scr, r, F.lane); continue; } r -= 32;
            if (r < 32) { tr_item(F.in[17] + (size_t)i * D * 64, 64, 64, w1, K1, 3136, 0, m6 + 4 * 1024, scr, r, F.lane); continue; } r -= 32;
            if (r < 16) { if (i == 1) tr_item(F.in[27], 32, 32, w1, K1, 3200, 0, m6 + 3 * 1024, scr, r, F.lane); continue; } r -= 16;
            if (r < 80) { tr_item(F.in[19] + (size_t)i * D * 160, 160, 160, w1, K1, 3232, 0, m6 + 5 * 1024, scr, r, F.lane); continue; } r -= 80;
            tr_item(F.in[12] + (size_t)i * D * D, D, D, WO + (size_t)i * D * D, D, 0, 0, nullptr, scr, r, F.lane); continue; }
        r -= 2 * PL;
        if (r < 512) { tr_item(F.in[32], 2064, 1024, WKV, D, 0, 0, nullptr, scr, r, F.lane); continue; } r -= 512;
        if (r < 512) { tr_item(F.in[32] + 1024, 2064, 1024, WKV, D, 1024, 0, nullptr, scr, r, F.lane); continue; } r -= 512;
        if (r < 16) { tr_item(F.in[32] + 2048, 2064, 16, WKV, D, 2048, 0, nullptr, scr, r, F.lane); continue; } r -= 16;
        { const int j = r / 1536; r -= j * 1536;
          if (r < 1024) tr_item(F.in[35] + (size_t)j * D * 2048, 2048, 2048, WQG + (size_t)j * 2048 * D, D, 0, 0, nullptr, scr, r, F.lane);
          else tr_item(F.in[37] + (size_t)j * D * D, D, D, WO2 + (size_t)j * D * D, D, 0, 0, nullptr, scr, r - 1024, F.lane); }
    }
    const int gt = F.bx * 512 + F.tid, NT = F.G * 512; const v4u z = {0u, 0u, 0u, 0u};
    for (int e = gt; e < 135168; e += NT) {
        int r = e; bf16* p;
        if (r < 98304) { const int i = r / 49152; r -= i * 49152; p = W1 + (size_t)i * N1 * K1 + (size_t)3392 * K1 + (size_t)r * 8; }
        else if (r < 98304 + 8192) { r -= 98304; p = W1 + (size_t)3200 * K1 + (size_t)r * 8; }
        else { r -= 98304 + 8192; p = WKV + (size_t)2080 * D + (size_t)r * 8; }
        *(v4u*)p = z; }
    { float* B2 = (float*)(F.ws + WS_MOD) + 53248;
      for (int e = gt; e < 2 * 3072; e += NT) { const int i = e / 3072, n = e % 3072, grp = n >> 10, c = n & 1023;
          B2[e] = grp == 0 ? F.in[13][i * D + c] : (grp == 1 ? F.in[16][i * D + c] : (i == 1 ? F.in[26][c] : 0.f)); } }
    bf16* W2A = (bf16*)(F.ws + WS_W2A); bf16* W2G = (bf16*)(F.ws + WS_W2G);
    for (int e = gt; e < 2 * 1048576; e += NT) {
        const int i = e >> 20; int r = e & 1048575;
        if (r < 786432) { const int k = r / 3072, n = r % 3072, grp = n >> 10, c = n & 1023; float v = 0.f;
            if (grp == 0) { if (k < 64) v = F.in[15][((size_t)i * 64 + k) * 1024 + c]; }
            else if (grp == 1) { if (k >= 64 && k < 128) v = F.in[18][((size_t)i * 64 + (k - 64)) * 1024 + c]; }
            else { if (i == 1 && k >= 128 && k < 160) v = F.in[28][(size_t)(k - 128) * 1024 + c]; }
            W2A[(size_t)i * 3072 * 256 + (size_t)n * 256 + k] = (bf16)(pkbf(v, 0.f) & 0xffffu); }
        else { r -= 786432; const int k = r >> 10, n = r & 1023; const float v = k < 160 ? F.in[20][((size_t)i * 160 + k) * 1024 + n] : 0.f;
            W2G[(size_t)i * 1024 * 256 + (size_t)n * 256 + k] = (bf16)(pkbf(v, 0.f) & 0xffffu); }
    }
}
__device__ __forceinline__ void mlp_weights(Frame& F, int L) {
    LAS float* scr = (LAS float*)(F.lds + F.wave * 16384);
    const int gw = F.vcu * NWAVES + F.wave, NGW = F.G * NWAVES;
    bf16* WUP = (bf16*)(F.ws + WS_WUP); bf16* WDN = (bf16*)(F.ws + WS_WDN);
    for (int it = gw; it < 4096; it += NGW) {
        if (it < 2048) tr_item(F.in[6] + (size_t)L * D * FF, FF, FF, WUP, D, 0, 0, nullptr, scr, it, F.lane);
        else tr_item(F.in[7] + (size_t)L * FF * D, D, D, WDN, FF, 0, 0, nullptr, scr, it - 2048, F.lane);
    }
}
__device__ __forceinline__ void norm_phase(Frame& F, const float* xin, const float* g, const float* sh, const float* sc, int bstride, int mode, bf16* dst) {
    const int gw = F.vcu * NWAVES + F.wave, NGW = F.G * NWAVES;
    for (int m = gw; m < M; m += NGW) {
        const int b = m >> 13; f32x4 v[4];
        norm_row(xin + (size_t)m * D, g, sh ? sh + b * bstride : nullptr, sc ? sc + b * bstride : nullptr, F.lane, v);
        if (mode == 0) {
            st_row_bf16(dst + (size_t)m * 2048, F.lane, v);
            if ((m & 8191) != 8191) st_row_bf16(dst + (size_t)(m + 1) * 2048 + 1024, F.lane, v);
            if ((m & 8191) == 0) { const v2u z = {0u, 0u};
#pragma unroll
                for (int j = 0; j < 4; ++j) *((v2u*)(dst + (size_t)m * 2048 + 1024) + F.lane + 64 * j) = z; }
        } else st_row_bf16(dst + (size_t)m * 1024, F.lane, v);
    }
}
__device__ __forceinline__ void final_norm_phase(Frame& F) {
    const int gw = F.vcu * NWAVES + F.wave, NGW = F.G * NWAVES;
    for (int m = gw; m < M; m += NGW) { f32x4 v[4]; norm_row(F.out + (size_t)m * D, F.in[38], nullptr, nullptr, F.lane, v);
#pragma unroll
        for (int j = 0; j < 4; ++j) *((f32x4*)(F.out + (size_t)m * D) + F.lane + 64 * j) = v[j]; }
}
#ifndef PROBE_SC
#define PROBE_SC 0
#endif
constexpr int SC_C = 32, SC_NC = T / SC_C;
constexpr int SC_VEC = 0, SC_SCAL = 36864, SC_V = 37120, SC_Y = 38144, SC_BUF = 54528;
__device__ __forceinline__ float dot4(const f32x4 s, const f32x4 a) { return fmaf(s.w, a.w, fmaf(s.z, a.z, fmaf(s.y, a.y, s.x * a.x))); }
__device__ __forceinline__ void scan_chunk(const LAS unsigned char* Bc, f32x4& S, const int kq, const int rowi) {
                const LAS f32x4* pvec = (const LAS f32x4*)(Bc + SC_VEC) + kq; const LAS f32x4* psc = (const LAS f32x4*)(Bc + SC_SCAL);
                const LAS float* pv = (const LAS float*)(Bc + SC_V) + rowi; LAS float* py = (LAS float*)(Bc + SC_Y) + rowi * 16 + kq;
                f32x4 cv[9], cs; float c0, c1;
#pragma unroll
                for (int j = 0; j < 9; ++j) cv[j] = pvec[j * 16];
                cs = psc[0]; c0 = pv[0]; c1 = pv[8];
#pragma unroll
                for (int p = 0; p < SC_C / 2; ++p) {
                    f32x4 nv[9], ns; float n0, n1;
                    if (p + 1 < SC_C / 2) {
#pragma unroll
                        for (int j = 0; j < 9; ++j) nv[j] = pvec[((p + 1) * 9 + j) * 16];
                        ns = psc[p + 1]; n0 = pv[(2 * p + 2) * 8]; n1 = pv[(2 * p + 3) * 8];
                    }
                    float p1 = dot4(S, cv[0]), p2 = dot4(S, cv[1]); const float p3 = dot4(S, cv[2]);
                    p1 += dpp_f(p1, 0); p2 += dpp_f(p2, 0);
                    p1 += dpp_f(p1, 1); p2 += dpp_f(p2, 1);
                    p1 += dpp_f(p1, 2); p2 += dpp_f(p2, 2);
                    p1 += dpp_f(p1, 3); p2 += dpp_f(p2, 3);
                    const float sa1 = fmaf(c0, cs.w, fmaf(p1, cs.z, p2));
                    const float y0 = p3 + ((kq == 0) ? fmaf(c0, cs.y, p1 * cs.x) : 0.f);
                    const f32x4 t0 = S * cv[3] + cv[4] * p1 + cv[5] * c0 + cv[7] * c1;
                    S = t0 + cv[6] * sa1;
                    const float y1 = dot4(S, cv[8]);
                    py[(2 * p) * 128] = y0; py[(2 * p + 1) * 128] = y1;
                    if (p + 1 < SC_C / 2) {
#pragma unroll
                        for (int j = 0; j < 9; ++j) cv[j] = nv[j];
                        cs = ns; c0 = n0; c1 = n1;
                    }
                }
}
__device__ __forceinline__ void scan_phase(Frame& F, int L) {
    const bf16* P1 = (const bf16*)(F.ws + WS_P1); const bf16* P2 = (const bf16*)(F.ws + WS_P2); const bf16* VF = (const bf16*)(F.ws + WS_VF); float* Y = (float*)(F.ws + WS_H2);
    const float* kkw = F.in[21] + L * D; const float* kaw = F.in[22] + L * D;
    const int lane = F.lane;
    int wave;
    { LAS unsigned* tb = (LAS unsigned*)(F.lds + LDS_BYTES - 2048);
      const unsigned simd = ((unsigned)__builtin_amdgcn_s_getreg((1 << 11) | (4 << 6) | 4)) & 3u;
      if (lane == 0) tb[F.wave] = simd;
      __syncthreads();
      unsigned sd[8];
#pragma unroll
      for (int w = 0; w < 8; ++w) sd[w] = tb[w];
      int B = 1;
#pragma unroll
      for (int w = 7; w >= 1; --w) if (sd[w] != sd[0]) B = w;
      int total_non = 0, non_before = 0, share_before = 0; bool my_share = false;
#pragma unroll
      for (int w = 1; w < 8; ++w) { const bool sh = (sd[w] == sd[0]) || (sd[w] == sd[B]); const bool other = (w != B);
          if (other && !sh) { ++total_non; if (w < F.wave) ++non_before; }
          if (other && sh && w < F.wave) ++share_before;
          if (w == F.wave) my_share = sh; }
      int role;
      if (F.wave == 0) role = 0; else if (F.wave == B) role = 1; else role = my_share ? (2 + total_non + share_before) : (2 + non_before);
      wave = __builtin_amdgcn_readfirstlane(role);
      __syncthreads(); }
    for (int item = F.bx; item < 256; item += F.G) {
        const int bh = (item & 7) + 8 * (item >> 6), rg = (item >> 3) & 7, b = bh >> 4, h = bh & 15;
        const size_t m0 = (size_t)b * T;
        const int hidx = (wave - 2) * 64 + lane, hp = (hidx >> 4) & 15, hc4 = hidx & 15;
        const int vtt = lane >> 1, vr4 = (lane & 1) * 4;
        float ckk[4], cka[4];
        v2u lr[2][2], lk[2][2], lw[2][2], la[2][2]; v2u lv[2], lvm[2], lvf[2];
#pragma unroll
        for (int q = 0; q < 2; ++q) { lv[q] = (v2u){0u,0u}; lvm[q] = (v2u){0u,0u}; lvf[q] = (v2u){0u,0u};
#pragma unroll
            for (int u = 0; u < 2; ++u) { lr[q][u] = (v2u){0u,0u}; lk[q][u] = (v2u){0u,0u}; lw[q][u] = (v2u){0u,0u}; la[q][u] = (v2u){0u,0u}; } }
        if (wave >= 2 && wave < 6) {
#pragma unroll
            for (int j = 0; j < 4; ++j) { ckk[j] = kkw[h * 64 + hc4 * 4 + j]; cka[j] = kaw[h * 64 + hc4 * 4 + j]; } }
#define SC_LOAD(c, Q) do { \
        if (wave >= 2 && wave < 6) { _Pragma("unroll") for (int u = 0; u < 2; ++u) { const size_t m = m0 + (size_t)(c) * SC_C + 2 * hp + u; const bf16* p1 = P1 + m * N1 + h * 64 + hc4 * 4; const bf16* p2 = P2 + m * NP2 + h * 64 + hc4 * 4; \
            lr[Q][u] = *(const v2u*)p1; lk[Q][u] = *(const v2u*)(p1 + 1024); lw[Q][u] = *(const v2u*)p2; la[Q][u] = *(const v2u*)(p2 + 1024); } } \
        else if (wave == 6) { const size_t m = m0 + (size_t)(c) * SC_C + vtt; const int cc = h * 64 + rg * 8 + vr4; \
            lv[Q] = *(const v2u*)(P1 + m * N1 + 2048 + cc); if (L == 1) { lvm[Q] = *(const v2u*)(P2 + m * NP2 + 2048 + cc); lvf[Q] = *(const v2u*)(VF + m * D + cc); } } } while (0)
#define SC_PREP(buf, Q) do { LAS unsigned char* B_ = F.lds + (buf) * SC_BUF; \
        if (wave >= 2 && wave < 6) { f32x4 an[2], bb[2], k2[2], ww[2], rr[2]; \
            _Pragma("unroll") for (int u = 0; u < 2; ++u) { \
                const float kr[4] = {bflo(lk[Q][u].x), bfhi(lk[Q][u].x), bflo(lk[Q][u].y), bfhi(lk[Q][u].y)}, av[4] = {bflo(la[Q][u].x), bfhi(la[Q][u].x), bflo(la[Q][u].y), bfhi(la[Q][u].y)}; \
                const float wn[4] = {bflo(lw[Q][u].x), bfhi(lw[Q][u].x), bflo(lw[Q][u].y), bfhi(lw[Q][u].y)}, rv[4] = {bflo(lr[Q][u].x), bfhi(lr[Q][u].x), bflo(lr[Q][u].y), bfhi(lr[Q][u].y)}; \
                float kv_[4], ss = 0.f; \
                _Pragma("unroll") for (int j = 0; j < 4; ++j) { kv_[j] = kr[j] * ckk[j]; ss += kv_[j] * kv_[j]; } \
                ss = sum16(ss); const float inv = 1.0f / fmaxf(sqrtf(ss), 1e-12f); \
                _Pragma("unroll") for (int j = 0; j < 4; ++j) { const float kk = kv_[j] * inv; an[u][j] = -kk; bb[u][j] = kk * av[j]; k2[u][j] = kr[j] * (1.0f + (av[j] - 1.0f) * cka[j]); ww[u][j] = __expf(wn[j]); rr[u][j] = rv[j]; } } \
            LAS f32x4* V_ = (LAS f32x4*)(B_ + SC_VEC) + (hp * 9) * 16 + hc4; \
            V_[0 * 16] = an[0]; V_[1 * 16] = ww[0] * an[1]; V_[2 * 16] = ww[0] * rr[0]; V_[3 * 16] = ww[0] * ww[1]; V_[4 * 16] = bb[0] * ww[1]; V_[5 * 16] = k2[0] * ww[1]; V_[6 * 16] = bb[1]; V_[7 * 16] = k2[1]; V_[8 * 16] = rr[1]; \
            float s0 = dot4(bb[0], rr[0]), s1 = dot4(k2[0], rr[0]), s2 = dot4(bb[0], an[1]), s3 = dot4(k2[0], an[1]); \
            s0 = sum16(s0); s1 = sum16(s1); s2 = sum16(s2); s3 = sum16(s3); \
            if (hc4 == 0) *(LAS f32x4*)(B_ + SC_SCAL + hp * 16) = (f32x4){s0, s1, s2, s3}; } \
        else if (wave == 6) { float v_[4] = {bflo(lv[Q].x), bfhi(lv[Q].x), bflo(lv[Q].y), bfhi(lv[Q].y)}; \
            if (L == 1) { const float f_[4] = {bflo(lvf[Q].x), bfhi(lvf[Q].x), bflo(lvf[Q].y), bfhi(lvf[Q].y)}, g_[4] = {bflo(lvm[Q].x), bfhi(lvm[Q].x), bflo(lvm[Q].y), bfhi(lvm[Q].y)}; \
                _Pragma("unroll") for (int j = 0; j < 4; ++j) v_[j] = v_[j] + (f_[j] - v_[j]) * g_[j]; } \
            *(LAS f32x4*)(B_ + SC_V + (vtt * 8 + vr4) * 4) = (f32x4){v_[0], v_[1], v_[2], v_[3]}; } } while (0)
#define SC_YRED(bufi) f32x4 yv; do { const LAS f32x4* q_ = (const LAS f32x4*)(F.lds + (bufi) * SC_BUF + SC_Y) + (vtt * 8 + vr4) * 4; \
            _Pragma("unroll") for (int r_ = 0; r_ < 4; ++r_) { const f32x4 t0 = q_[r_ * 4], t1 = q_[r_ * 4 + 1], t2 = q_[r_ * 4 + 2], t3 = q_[r_ * 4 + 3]; const f32x4 t = (t0 + t1) + (t2 + t3); yv[r_] = (t.x + t.y) + (t.z + t.w); } } while (0)
        SC_LOAD(0, 0); SC_PREP(0, 0); SC_LOAD(1, 1);
        __syncthreads();
        f32x4 S = {0.f, 0.f, 0.f, 0.f};
        const int rl = lane >> 4, kq = lane & 15, rowi = (wave & 1) * 4 + rl;
#define SC_ITER(c, QL, QP) do { const int buf = (c) & 1; \
            if (wave < 2) { if (PROBE_SC == 2) { f32x4 S2 = S; scan_chunk(F.lds + buf * SC_BUF, S2, kq, rowi); asm volatile("" :: "v"(S2) : "memory"); } scan_chunk(F.lds + buf * SC_BUF, S, kq, rowi); } \
            else { if ((c) + 2 < SC_NC) SC_LOAD((c) + 2, QL); \
                if ((c) + 1 < SC_NC) SC_PREP(buf ^ 1, QP); \
                if (PROBE_SC == 1 && (c) + 1 < SC_NC) { asm volatile("" ::: "memory"); SC_PREP(buf ^ 1, QP); } \
                if (wave == 7 && (c) > 0) { SC_YRED(buf ^ 1); *(f32x4*)(Y + (m0 + (size_t)((c) - 1) * SC_C + vtt) * D + h * 64 + rg * 8 + vr4) = yv; } } \
            asm volatile("s_waitcnt lgkmcnt(0)\n\ts_barrier" ::: "memory"); } while (0)
        for (int c = 0; c < SC_NC; c += 2) { SC_ITER(c, 0, 1); SC_ITER(c + 1, 1, 0); }
#undef SC_ITER
        if (wave == 7) { SC_YRED((SC_NC - 1) & 1);
            *(f32x4*)(Y + (m0 + (size_t)(SC_NC - 1) * SC_C + vtt) * D + h * 64 + rg * 8 + vr4) = yv; }
        __syncthreads();
#undef SC_LOAD
#undef SC_PREP
#undef SC_YRED
    }
}
__device__ __forceinline__ void post_phase(Frame& F, int L) {
    const bf16* P1 = (const bf16*)(F.ws + WS_P1); const bf16* P2 = (const bf16*)(F.ws + WS_P2); bf16* VF = (bf16*)(F.ws + WS_VF); float* Y = (float*)(F.ws + WS_H2);
    const int gw = F.vcu * NWAVES + F.wave, NGW = F.G * NWAVES, lane = F.lane, c0 = lane * 16;
    const float* kaw = F.in[22] + L * D + c0; const float* rkw = F.in[23] + L * D + c0; const float* lnw = F.in[24] + L * D + c0; const float* lnb = F.in[25] + L * D + c0;
    for (int m = gw; m < M; m += NGW) {
        float y[16], r[16], k[16], v[16], a[16];
        const float* yp = Y + (size_t)m * D + c0;
#pragma unroll
        for (int q = 0; q < 4; ++q) { const f32x4 t = *(const f32x4*)(yp + 4 * q); y[4 * q] = t.x; y[4 * q + 1] = t.y; y[4 * q + 2] = t.z; y[4 * q + 3] = t.w; }
        const bf16* p1 = P1 + (size_t)m * N1 + c0; const bf16* p2 = P2 + (size_t)m * NP2 + c0;
        v4u rv[2], kv[2], vv[2], av[2];
#pragma unroll
        for (int q = 0; q < 2; ++q) { rv[q] = *(const v4u*)(p1 + 8 * q); kv[q] = *(const v4u*)(p1 + 1024 + 8 * q); vv[q] = *(const v4u*)(p1 + 2048 + 8 * q); av[q] = *(const v4u*)(p2 + 1024 + 8 * q); }
#pragma unroll
        for (int q = 0; q < 2; ++q)
#pragma unroll
            for (int j = 0; j < 4; ++j) { r[8 * q + 2 * j] = bflo(rv[q][j]); r[8 * q + 2 * j + 1] = bfhi(rv[q][j]); k[8 * q + 2 * j] = bflo(kv[q][j]); k[8 * q + 2 * j + 1] = bfhi(kv[q][j]);
                v[8 * q + 2 * j] = bflo(vv[q][j]); v[8 * q + 2 * j + 1] = bfhi(vv[q][j]); a[8 * q + 2 * j] = bflo(av[q][j]); a[8 * q + 2 * j + 1] = bfhi(av[q][j]); }
        if (L == 0) { *(v4u*)(VF + (size_t)m * D + c0) = vv[0]; *(v4u*)(VF + (size_t)m * D + c0 + 8) = vv[1]; }
        else { v4u fv[2], gv[2];
#pragma unroll
            for (int q = 0; q < 2; ++q) { fv[q] = *(const v4u*)(VF + (size_t)m * D + c0 + 8 * q); gv[q] = *(const v4u*)(p2 + 2048 + 8 * q); }
#pragma unroll
            for (int q = 0; q < 2; ++q)
#pragma unroll
                for (int j = 0; j < 4; ++j) { const float f0 = bflo(fv[q][j]), f1 = bfhi(fv[q][j]), g0 = bflo(gv[q][j]), g1 = bfhi(gv[q][j]);
                    v[8 * q + 2 * j] += (f0 - v[8 * q + 2 * j]) * g0; v[8 * q + 2 * j + 1] += (f1 - v[8 * q + 2 * j + 1]) * g1; } }
        float s = 0.f, bd = 0.f;
#pragma unroll
        for (int j = 0; j < 16; ++j) { s += y[j]; const float k2 = k[j] * (1.0f + (a[j] - 1.0f) * kaw[j]); bd += r[j] * k2 * rkw[j]; }
        s = sum4(s); bd = sum4(bd);
        const float mean = s * (1.0f / 64.0f); float q2 = 0.f;
#pragma unroll
        for (int j = 0; j < 16; ++j) { const float d = y[j] - mean; q2 += d * d; }
        q2 = sum4(q2);
        const float rstd = 1.0f / sqrtf(q2 * (1.0f / 64.0f) + 64e-5f);
        float o[16];
#pragma unroll
        for (int j = 0; j < 16; ++j) o[j] = (y[j] - mean) * rstd * lnw[j] + lnb[j] + bd * v[j];
        bf16* yn = (bf16*)(Y + (size_t)m * D) + c0;
        v4u w0, w1; w0.x = pkbf(o[0], o[1]); w0.y = pkbf(o[2], o[3]); w0.z = pkbf(o[4], o[5]); w0.w = pkbf(o[6], o[7]); w1.x = pkbf(o[8], o[9]); w1.y = pkbf(o[10], o[11]); w1.z = pkbf(o[12], o[13]); w1.w = pkbf(o[14], o[15]);
        *(v4u*)yn = w0; *(v4u*)(yn + 8) = w1;
    }
}
__device__ __forceinline__ void kvpost_phase(Frame& F) {
    const bf16* KV = (const bf16*)(F.ws + WS_KVRAW); bf16* KS = (bf16*)(F.ws + WS_KS); bf16* VS = (bf16*)(F.ws + WS_VS);
    const int gw = F.vcu * NWAVES + F.wave, NGW = F.G * NWAVES, lane = F.lane, c0 = lane * 16;
    const float* kg = F.in[34] + (c0 & 63);
    for (int m = gw; m < M; m += NGW) {
        const bf16* p = KV + (size_t)m * 2048 + c0; v4u kv[2], vv[2];
#pragma unroll
        for (int q = 0; q < 2; ++q) { kv[q] = *(const v4u*)(p + 8 * q); vv[q] = *(const v4u*)(p + 1024 + 8 * q); }
        float k[16], ss = 0.f;
#pragma unroll
        for (int q = 0; q < 2; ++q)
#pragma unroll
            for (int j = 0; j < 4; ++j) { k[8 * q + 2 * j] = bflo(kv[q][j]); k[8 * q + 2 * j + 1] = bfhi(kv[q][j]); }
#pragma unroll
        for (int j = 0; j < 16; ++j) ss += k[j] * k[j];
        ss = sum4(ss); const float rs = 1.0f / sqrtf(ss * (1.0f / 64.0f) + 1e-6f);
        v4u w0, w1;
        w0.x = pkbf(k[0] * rs * kg[0], k[1] * rs * kg[1]); w0.y = pkbf(k[2] * rs * kg[2], k[3] * rs * kg[3]); w0.z = pkbf(k[4] * rs * kg[4], k[5] * rs * kg[5]); w0.w = pkbf(k[6] * rs * kg[6], k[7] * rs * kg[7]);
        w1.x = pkbf(k[8] * rs * kg[8], k[9] * rs * kg[9]); w1.y = pkbf(k[10] * rs * kg[10], k[11] * rs * kg[11]); w1.z = pkbf(k[12] * rs * kg[12], k[13] * rs * kg[13]); w1.w = pkbf(k[14] * rs * kg[14], k[15] * rs * kg[15]);
        *(v4u*)(KS + (size_t)m * D + c0) = w0; *(v4u*)(KS + (size_t)m * D + c0 + 8) = w1;
        *(v4u*)(VS + (size_t)m * D + c0) = vv[0]; *(v4u*)(VS + (size_t)m * D + c0 + 8) = vv[1];
    }
    if (gw < 32) {
        const int bh = gw, b = bh >> 4, h = bh & 15; const float* FL = (const float*)(F.ws + WS_FL) + ((size_t)b * T + (size_t)lane * 128) * 16 + h; const float fb = F.in[33][h];
        v4u* G3 = (v4u*)(F.ws + WS_G3) + (size_t)bh * T + (size_t)lane * 128;
        float tot = 0.f;
#pragma unroll 8
        for (int i = 0; i < 128; ++i) { const float x = FL[(size_t)i * 16] + fb; tot += -(fmaxf(-x, 0.f) + log1pf(__expf(-fabsf(x)))); }
        float inc = tot;
#pragma unroll
        for (int o = 1; o < 64; o <<= 1) { const float n = __int_as_float(__builtin_amdgcn_ds_bpermute((lane - o) << 2, __float_as_int(inc))); if (lane >= o) inc += n; }
        float run = inc - tot;
#pragma unroll 8
        for (int i = 0; i < 128; ++i) { const float x = FL[(size_t)i * 16] + fb; run += -(fmaxf(-x, 0.f) + log1pf(__expf(-fabsf(x))));
            const float gv = -run * 1.4426950408889634f;
            const unsigned hi = pkbf(gv, 0.f) & 0xffffu; const float r1 = gv - __uint_as_float(hi << 16);
            const unsigned mid = pkbf(r1, 0.f) & 0xffffu; const float r2 = r1 - __uint_as_float(mid << 16);
            const unsigned lo = pkbf(r2, 0.f) & 0xffffu;
            G3[i] = (v4u){hi | (mid << 16), lo, 0u, 0u}; }
    }
}
constexpr size_t WS_BAR = 512 * 1024, BAR_BYTES = 16384; constexpr int MISC_OFF = LDS_BYTES - 1024;
#define RLX_AGENT __ATOMIC_RELAXED, __HIP_MEMORY_SCOPE_AGENT
#define LDS_WAIT() asm volatile("s_waitcnt lgkmcnt(0)" ::: "memory")
#define VM_WAIT() asm volatile("s_waitcnt vmcnt(0)" ::: "memory")
__device__ __forceinline__ unsigned long long rt() { return __builtin_amdgcn_s_memrealtime(); }
__device__ __forceinline__ unsigned f2bf(float f) { unsigned u = __builtin_bit_cast(unsigned, f); return (u + 0x7fffu + ((u >> 16) & 1u)) >> 16; }
__device__ __forceinline__ unsigned pk2(float lo, float hi) { return f2bf(lo) | (f2bf(hi) << 16); }

#define XB_TMO      128
#define XB_XCNT(j)  (256  + 64 * (j))
#define XB_XSUB(j)  (1280 + 64 * (j))
#define XB_XGEN(j)  (2304 + 64 * (j))
#define XB_TOP      3328
#define XB_TOPGEN   3392
#define XCD_BAR_WORDS 3456
#define XB_SPIN_CAP (1u << 18)

__device__ __forceinline__ unsigned xb_ld(unsigned* p)              { return __hip_atomic_load(p, __ATOMIC_RELAXED, __HIP_MEMORY_SCOPE_AGENT); }
__device__ __forceinline__ unsigned xb_add(unsigned* p, unsigned v) { return __hip_atomic_fetch_add(p, v, __ATOMIC_RELAXED, __HIP_MEMORY_SCOPE_AGENT); }
__device__ __forceinline__ unsigned xb_xcc_id() { return (unsigned)__builtin_amdgcn_s_getreg((3 << 11) | 20) & 0xFu; }
#define XB_SPIN(cond, bar) do { unsigned _sp = 0; while (cond) { __builtin_amdgcn_s_sleep(1); \
    if ((++_sp & 255u) == 0u) { if (xb_ld(&(bar)[XB_TMO])) break; if (_sp > XB_SPIN_CAP) { atomicAdd(&(bar)[XB_TMO], 1u); break; } } } } while (0)

struct XcdBarrier {
    unsigned* bar; unsigned x;
    volatile LAS unsigned* st;
};

__device__ __forceinline__ XcdBarrier xcd_barrier_post(unsigned* bar, volatile LAS unsigned* st, const int tid) {
    XcdBarrier b; b.bar = bar; b.x = xb_xcc_id(); b.st = st;
    if (tid == 0) (void)xb_add(&bar[XB_XCNT(b.x)], 1u);
    return b;
}
__device__ __forceinline__ void xcd_barrier_complete(unsigned* bar, unsigned x, unsigned& nloc, unsigned& nx) {
    const unsigned G = gridDim.x * gridDim.y * gridDim.z;
    unsigned sum, cnt, mine, sp = 0u;
    for (;;) {
        sum = 0u; cnt = 0u; mine = 0u;
#pragma unroll
        for (unsigned j = 0; j < 16; ++j) { const unsigned c = xb_ld(&bar[XB_XCNT(j)]); sum += c; cnt += (c > 0u) ? 1u : 0u; mine = (j == x) ? c : mine; }
        if (sum == G) break;
        __builtin_amdgcn_s_sleep(1);
        if ((++sp & 255u) == 0u) { if (xb_ld(&bar[XB_TMO])) break; if (sp > XB_SPIN_CAP) { atomicAdd(&bar[XB_TMO], 1u); break; } }
    }
    nloc = mine > 0u ? mine : 1u; nx = cnt > 0u ? cnt : 1u;
}

__device__ __forceinline__ void xcd_barrier(const XcdBarrier& b, const int tid) {
    asm volatile("s_waitcnt vmcnt(0)" ::: "memory");
    __syncthreads();
    if (tid == 0) {
        unsigned* bar = b.bar;
        __builtin_amdgcn_s_waitcnt(0);
        unsigned nloc = b.st[0], nx = b.st[1];
        if (nloc == 0u) { xcd_barrier_complete(bar, b.x, nloc, nx); b.st[0] = nloc; b.st[1] = nx; }
        const unsigned old = xb_add(&bar[XB_XSUB(b.x)], 1u);
        const unsigned gen = old / nloc;
        if (old + 1u == (gen + 1u) * nloc) {
            __builtin_amdgcn_fence(__ATOMIC_RELEASE, "agent");
            asm volatile("s_waitcnt vmcnt(0)" ::: "memory");
            const unsigned og = xb_add(&bar[XB_TOP], 1u);
            const unsigned tg = og / nx;
            if (og + 1u == (tg + 1u) * nx) xb_add(&bar[XB_TOPGEN], 1u);
            else XB_SPIN(xb_ld(&bar[XB_TOPGEN]) == tg, bar);
            __builtin_amdgcn_fence(__ATOMIC_ACQUIRE, "agent");
            xb_add(&bar[XB_XGEN(b.x)], 1u);
            asm volatile("s_waitcnt vmcnt(0)" ::: "memory");
        } else {
            XB_SPIN(xb_ld(&bar[XB_XGEN(b.x)]) == gen, bar);
            __builtin_amdgcn_fence(__ATOMIC_ACQUIRE, "agent");
            asm volatile("s_waitcnt vmcnt(0)" ::: "memory");
        }
    }
    __syncthreads();
}
#define GEMM_CALL(FN, Aptr, Bptr, Nn, Kk, LDA, LDB, ...) do { pg8::Gemm g_{(const pg8::bf16_t*)(Aptr), (const pg8::bf16_t*)(Bptr), M, (Nn), (Kk), (LDA), (LDB)}; pg8::StaticOrder S_; S_.init(M, (Nn), F.G, F.bx); \
    pg8::Epi8<pg8::FN> E_{{__VA_ARGS__}}; pg8::gemm_phase<pg8::Epi8<pg8::FN>, pg8::StaticOrder, true, true>(F.lds, g_, S_, E_, F.tid); } while (0)
constexpr int N_PHASES = 42;
__global__ void __launch_bounds__(NWAVES * 64, 2) yoco_fwd(Args args) {
    extern __shared__ __attribute__((aligned(16))) unsigned char lds[];
    cg::grid_group grid = cg::this_grid();
    Frame F;
    const int wave_s = __builtin_amdgcn_readfirstlane((int)threadIdx.x >> 6);
    F.lds = (LAS unsigned char*)lds; F.tid = threadIdx.x; F.lane = F.tid & 63; F.wave = wave_s;
    F.G = gridDim.x; F.bx = blockIdx.x; F.vcu = F.bx;
    F.ws = args.ws; F.out = args.out; F.in = args.in;
    unsigned char* ws = args.ws;
    const int lo = args.ph_lo, hi = args.ph_hi; const bool one = (hi - lo) > 1;
#define LAUNDER() do { int t_ = wave_s * 64 + (int)__builtin_amdgcn_mbcnt_hi(~0u, __builtin_amdgcn_mbcnt_lo(~0u, 0u)); asm volatile("" : "+v"(t_)); F.tid = t_; F.lane = t_ & 63; F.wave = __builtin_amdgcn_readfirstlane(t_ >> 6); \
        int z_ = 0; asm volatile("" : "+v"(z_)); z_ = __builtin_amdgcn_readfirstlane(z_); ws = args.ws + z_; F.ws = ws; F.in = args.in + z_; F.out = args.out + z_; F.bx = (int)blockIdx.x + z_; F.G = (int)gridDim.x + z_; F.vcu = (F.G % 8 == 0) ? (F.bx % 8) * (F.G / 8) + F.bx / 8 : F.bx; } while (0)
#define IN(k) (lo <= (k) && (k) < hi)
#ifndef PROBE_BAR
#define PROBE_BAR 0
#endif
#ifndef PROBE_PH
#define PROBE_PH (-1)
#endif
#define PHASE(k) if (IN(k)) for (int rep_ = 0; rep_ < (((k) == PROBE_PH) ? 2 : 1); ++rep_)
#define SEAM() do { if (one) { unsigned zz_ = 0u; asm volatile("" : "+v"(zz_)); const int st_ = wave_s * 64 + (int)__builtin_amdgcn_mbcnt_hi(~0u, __builtin_amdgcn_mbcnt_lo(~0u, zz_)); xcd_barrier(xbar, st_); if (PROBE_BAR) xcd_barrier(xbar, st_); } } while (0)
#define MOD_ ((float*)(ws + WS_MOD))
#define MODKV_ (MOD_ + 4 * 2 * 6144)
#define H2_ ((bf16*)(ws + WS_H2))
#define XN_ ((bf16*)(ws + WS_H2))
#define XNKV_ ((bf16*)(ws + WS_H2 + 32 * MiB))
#define P1_ ((bf16*)(ws + WS_P1))
#define P2_ ((bf16*)(ws + WS_P2))
#define HB_ ((bf16*)(ws + WS_HB))
#define QB_ ((bf16*)(ws + WS_QB))
#define GT_ ((bf16*)(ws + WS_GT))
#define XIN1_ ((L == 0) ? F.in[0] : (const float*)F.out)
#define MODL_ (MOD_ + L * 2 * 6144)

    volatile LAS unsigned* MISC = (volatile LAS unsigned*)(F.lds + MISC_OFF);
    if (F.tid < 32) MISC[F.tid] = 0u;
    __syncthreads();
    XcdBarrier xbar; xbar.bar = (unsigned*)(args.ws + WS_BAR); xbar.x = 0; xbar.st = MISC + 8;
    if (one) xbar = xcd_barrier_post((unsigned*)(args.ws + WS_BAR), MISC + 8, F.tid);
    PHASE(0) { LAUNDER(); p0_mod(F); p0_weights(F); if (one) grid.sync(); }
    { constexpr int L = 0;
        const int pb = 1 + L * 10;
        if (L < 2) {
            PHASE(pb + 0) { LAUNDER(); norm_phase(F, XIN1_, F.in[4] + L * D, MODL_, MODL_ + 1024, 6144, 0, H2_); SEAM(); }
            PHASE(pb + 1) { LAUNDER(); GEMM_CALL(FnP1, H2_, ws + WS_W1 + (size_t)L * N1 * K1 * 2, N1, K1, K1, K1, P1_); SEAM(); }
            PHASE(pb + 2) { LAUNDER(); GEMM_CALL(FnP2, P1_ + 3072, ws + WS_W2A + (size_t)L * 3072 * 256 * 2, NP2, 256, N1, 256, P2_, MOD_ + 53248 + L * 3072); SEAM(); }
            PHASE(pb + 3) { LAUNDER(); scan_phase(F, L); SEAM(); }
            PHASE(pb + 4) { LAUNDER(); post_phase(F, L); SEAM(); }
            PHASE(pb + 5) { LAUNDER(); GEMM_CALL(FnGate, P1_ + 3232, ws + WS_W2G + (size_t)L * 1024 * 256 * 2, D, 256, N1, 256, H2_, 2048); SEAM(); }
            PHASE(pb + 6) { LAUNDER(); GEMM_CALL(FnRes, H2_, ws + WS_WO + (size_t)L * D * D * 2, D, D, 2048, D, XIN1_, F.out, MODL_ + 2 * 1024); SEAM(); }
        } else {
            const int j = L - 2;
            PHASE(pb + 0) { LAUNDER(); norm_phase(F, F.out, F.in[4] + L * D, MODL_, MODL_ + 1024, 6144, 1, XN_);
                if (L == 2) norm_phase(F, F.out, F.in[29], MODKV_, MODKV_ + 1024, 2048, 1, XNKV_);
                SEAM(); }
            PHASE(pb + 1) { LAUNDER();
                if (L == 2) GEMM_CALL(FnKv, XNKV_, ws + WS_WKV, 2304, D, D, D, (bf16*)(ws + WS_KVRAW), (float*)(ws + WS_FL));
                LAUNDER();
                GEMM_CALL(FnQg, XN_, ws + WS_WQG + (size_t)j * 2048 * D * 2, 2048, D, D, D, QB_, GT_); SEAM(); }
            if (L == 2) PHASE(pb + 2) { LAUNDER(); kvpost_phase(F); SEAM(); }
            PHASE(pb + 3) { LAUNDER();
                float kb_; { float g_ = fabsf(F.in[34][F.lane]); g_ = fmaxf(g_, dpp_f(g_, 0)); g_ = fmaxf(g_, dpp_f(g_, 1)); g_ = fmaxf(g_, dpp_f(g_, 2)); g_ = fmaxf(g_, dpp_f(g_, 3));
                  { auto rr = __builtin_amdgcn_permlane16_swap(__float_as_uint(g_), __float_as_uint(g_), false, false); g_ = fmaxf(__uint_as_float(rr[0]), __uint_as_float(rr[1])); }
                  { auto rr = __builtin_amdgcn_permlane32_swap(__float_as_uint(g_), __float_as_uint(g_), false, false); g_ = fmaxf(__uint_as_float(rr[0]), __uint_as_float(rr[1])); }
                  kb_ = 8.0f * 1.02f * g_; }
                const attn_body::AttnTensors AT{(const attn_body::bf16*)QB_, (const attn_body::bf16*)(ws + WS_KS), (const attn_body::bf16*)(ws + WS_VS), (attn_body::bf16*)((PROBE_PH == pb + 3 && rep_ == 0) ? (bf16*)(ws + WS_KVRAW) : QB_), (const attn_body::bf16*)GT_, (const unsigned char*)(ws + WS_G3), F.in[36] + j * 64, kb_};
                const attn_body::StaticOrder S((int)F.G, F.bx);
                attn_body::attn_phase<attn_body::StaticOrder>((char*)lds, AT, S, F.tid);
                SEAM(); }
            PHASE(pb + 6) { LAUNDER(); GEMM_CALL(FnRes, QB_, ws + WS_WO2 + (size_t)j * D * D * 2, D, D, D, D, (const float*)F.out, F.out, MODL_ + 2 * 1024); SEAM(); }
        }
        PHASE(pb + 7) { LAUNDER(); mlp_weights(F, L); norm_phase(F, F.out, F.in[5] + L * D, MODL_ + 3 * 1024, MODL_ + 4 * 1024, 6144, 1, XN_); SEAM(); }
        PHASE(pb + 8) { LAUNDER(); GEMM_CALL(FnUp, XN_, ws + WS_WUP, FF, D, D, D, HB_); SEAM(); }
        PHASE(pb + 9) { LAUNDER(); GEMM_CALL(FnRes, HB_, ws + WS_WDN, D, FF, FF, FF, (const float*)F.out, F.out, MODL_ + 5 * 1024); SEAM(); }
        }
    { constexpr int L = 1;
        const int pb = 1 + L * 10;
        if (L < 2) {
            PHASE(pb + 0) { LAUNDER(); norm_phase(F, XIN1_, F.in[4] + L * D, MODL_, MODL_ + 1024, 6144, 0, H2_); SEAM(); }
            PHASE(pb + 1) { LAUNDER(); GEMM_CALL(FnP1, H2_, ws + WS_W1 + (size_t)L * N1 * K1 * 2, N1, K1, K1, K1, P1_); SEAM(); }
            PHASE(pb + 2) { LAUNDER(); GEMM_CALL(FnP2, P1_ + 3072, ws + WS_W2A + (size_t)L * 3072 * 256 * 2, NP2, 256, N1, 256, P2_, MOD_ + 53248 + L * 3072); SEAM(); }
            PHASE(pb + 3) { LAUNDER(); scan_phase(F, L); SEAM(); }
            PHASE(pb + 4) { LAUNDER(); post_phase(F, L); SEAM(); }
            PHASE(pb + 5) { LAUNDER(); GEMM_CALL(FnGate, P1_ + 3232, ws + WS_W2G + (size_t)L * 1024 * 256 * 2, D, 256, N1, 256, H2_, 2048); SEAM(); }
            PHASE(pb + 6) { LAUNDER(); GEMM_CALL(FnRes, H2_, ws + WS_WO + (size_t)L * D * D * 2, D, D, 2048, D, XIN1_, F.out, MODL_ + 2 * 1024); SEAM(); }
        } else {
            const int j = L - 2;
            PHASE(pb + 0) { LAUNDER(); norm_phase(F, F.out, F.in[4] + L * D, MODL_, MODL_ + 1024, 6144, 1, XN_);
                if (L == 2) norm_phase(F, F.out, F.in[29], MODKV_, MODKV_ + 1024, 2048, 1, XNKV_);
                SEAM(); }
            PHASE(pb + 1) { LAUNDER();
                if (L == 2) GEMM_CALL(FnKv, XNKV_, ws + WS_WKV, 2304, D, D, D, (bf16*)(ws + WS_KVRAW), (float*)(ws + WS_FL));
                LAUNDER();
                GEMM_CALL(FnQg, XN_, ws + WS_WQG + (size_t)j * 2048 * D * 2, 2048, D, D, D, QB_, GT_); SEAM(); }
            if (L == 2) PHASE(pb + 2) { LAUNDER(); kvpost_phase(F); SEAM(); }
            PHASE(pb + 3) { LAUNDER();
                float kb_; { float g_ = fabsf(F.in[34][F.lane]); g_ = fmaxf(g_, dpp_f(g_, 0)); g_ = fmaxf(g_, dpp_f(g_, 1)); g_ = fmaxf(g_, dpp_f(g_, 2)); g_ = fmaxf(g_, dpp_f(g_, 3));
                  { auto rr = __builtin_amdgcn_permlane16_swap(__float_as_uint(g_), __float_as_uint(g_), false, false); g_ = fmaxf(__uint_as_float(rr[0]), __uint_as_float(rr[1])); }
                  { auto rr = __builtin_amdgcn_permlane32_swap(__float_as_uint(g_), __float_as_uint(g_), false, false); g_ = fmaxf(__uint_as_float(rr[0]), __uint_as_float(rr[1])); }
                  kb_ = 8.0f * 1.02f * g_; }
                const attn_body::AttnTensors AT{(const attn_body::bf16*)QB_, (const attn_body::bf16*)(ws + WS_KS), (const attn_body::bf16*)(ws + WS_VS), (attn_body::bf16*)((PROBE_PH == pb + 3 && rep_ == 0) ? (bf16*)(ws + WS_KVRAW) : QB_), (const attn_body::bf16*)GT_, (const unsigned char*)(ws + WS_G3), F.in[36] + j * 64, kb_};
                const attn_body::StaticOrder S((int)F.G, F.bx);
                attn_body::attn_phase<attn_body::StaticOrder>((char*)lds, AT, S, F.tid);
                SEAM(); }
            PHASE(pb + 6) { LAUNDER(); GEMM_CALL(FnRes, QB_, ws + WS_WO2 + (size_t)j * D * D * 2, D, D, D, D, (const float*)F.out, F.out, MODL_ + 2 * 1024); SEAM(); }
        }
        PHASE(pb + 7) { LAUNDER(); mlp_weights(F, L); norm_phase(F, F.out, F.in[5] + L * D, MODL_ + 3 * 1024, MODL_ + 4 * 1024, 6144, 1, XN_); SEAM(); }
        PHASE(pb + 8) { LAUNDER(); GEMM_CALL(FnUp, XN_, ws + WS_WUP, FF, D, D, D, HB_); SEAM(); }
        PHASE(pb + 9) { LAUNDER(); GEMM_CALL(FnRes, HB_, ws + WS_WDN, D, FF, FF, FF, (const float*)F.out, F.out, MODL_ + 5 * 1024); SEAM(); }
        }
    { constexpr int L = 2;
        const int pb = 1 + L * 10;
        if (L < 2) {
            PHASE(pb + 0) { LAUNDER(); norm_phase(F, XIN1_, F.in[4] + L * D, MODL_, MODL_ + 1024, 6144, 0, H2_); SEAM(); }
            PHASE(pb + 1) { LAUNDER(); GEMM_CALL(FnP1, H2_, ws + WS_W1 + (size_t)L * N1 * K1 * 2, N1, K1, K1, K1, P1_); SEAM(); }
            PHASE(pb + 2) { LAUNDER(); GEMM_CALL(FnP2, P1_ + 3072, ws + WS_W2A + (size_t)L * 3072 * 256 * 2, NP2, 256, N1, 256, P2_, MOD_ + 53248 + L * 3072); SEAM(); }
            PHASE(pb + 3) { LAUNDER(); scan_phase(F, L); SEAM(); }
            PHASE(pb + 4) { LAUNDER(); post_phase(F, L); SEAM(); }
            PHASE(pb + 5) { LAUNDER(); GEMM_CALL(FnGate, P1_ + 3232, ws + WS_W2G + (size_t)L * 1024 * 256 * 2, D, 256, N1, 256, H2_, 2048); SEAM(); }
            PHASE(pb + 6) { LAUNDER(); GEMM_CALL(FnRes, H2_, ws + WS_WO + (size_t)L * D * D * 2, D, D, 2048, D, XIN1_, F.out, MODL_ + 2 * 1024); SEAM(); }
        } else {
            const int j = L - 2;
            PHASE(pb + 0) { LAUNDER(); norm_phase(F, F.out, F.in[4] + L * D, MODL_, MODL_ + 1024, 6144, 1, XN_);
                if (L == 2) norm_phase(F, F.out, F.in[29], MODKV_, MODKV_ + 1024, 2048, 1, XNKV_);
                SEAM(); }
            PHASE(pb + 1) { LAUNDER();
                if (L == 2) GEMM_CALL(FnKv, XNKV_, ws + WS_WKV, 2304, D, D, D, (bf16*)(ws + WS_KVRAW), (float*)(ws + WS_FL));
                LAUNDER();
                GEMM_CALL(FnQg, XN_, ws + WS_WQG + (size_t)j * 2048 * D * 2, 2048, D, D, D, QB_, GT_); SEAM(); }
            if (L == 2) PHASE(pb + 2) { LAUNDER(); kvpost_phase(F); SEAM(); }
            PHASE(pb + 3) { LAUNDER();
                float kb_; { float g_ = fabsf(F.in[34][F.lane]); g_ = fmaxf(g_, dpp_f(g_, 0)); g_ = fmaxf(g_, dpp_f(g_, 1)); g_ = fmaxf(g_, dpp_f(g_, 2)); g_ = fmaxf(g_, dpp_f(g_, 3));
                  { auto rr = __builtin_amdgcn_permlane16_swap(__float_as_uint(g_), __float_as_uint(g_), false, false); g_ = fmaxf(__uint_as_float(rr[0]), __uint_as_float(rr[1])); }
                  { auto rr = __builtin_amdgcn_permlane32_swap(__float_as_uint(g_), __float_as_uint(g_), false, false); g_ = fmaxf(__uint_as_float(rr[0]), __uint_as_float(rr[1])); }
                  kb_ = 8.0f * 1.02f * g_; }
                const attn_body::AttnTensors AT{(const attn_body::bf16*)QB_, (const attn_body::bf16*)(ws + WS_KS), (const attn_body::bf16*)(ws + WS_VS), (attn_body::bf16*)((PROBE_PH == pb + 3 && rep_ == 0) ? (bf16*)(ws + WS_KVRAW) : QB_), (const attn_body::bf16*)GT_, (const unsigned char*)(ws + WS_G3), F.in[36] + j * 64, kb_};
                const attn_body::StaticOrder S((int)F.G, F.bx);
                attn_body::attn_phase<attn_body::StaticOrder>((char*)lds, AT, S, F.tid);
                SEAM(); }
            PHASE(pb + 6) { LAUNDER(); GEMM_CALL(FnRes, QB_, ws + WS_WO2 + (size_t)j * D * D * 2, D, D, D, D, (const float*)F.out, F.out, MODL_ + 2 * 1024); SEAM(); }
        }
        PHASE(pb + 7) { LAUNDER(); mlp_weights(F, L); norm_phase(F, F.out, F.in[5] + L * D, MODL_ + 3 * 1024, MODL_ + 4 * 1024, 6144, 1, XN_); SEAM(); }
        PHASE(pb + 8) { LAUNDER(); GEMM_CALL(FnUp, XN_, ws + WS_WUP, FF, D, D, D, HB_); SEAM(); }
        PHASE(pb + 9) { LAUNDER(); GEMM_CALL(FnRes, HB_, ws + WS_WDN, D, FF, FF, FF, (const float*)F.out, F.out, MODL_ + 5 * 1024); SEAM(); }
        }
    { constexpr int L = 3;
        const int pb = 1 + L * 10;
        if (L < 2) {
            PHASE(pb + 0) { LAUNDER(); norm_phase(F, XIN1_, F.in[4] + L * D, MODL_, MODL_ + 1024, 6144, 0, H2_); SEAM(); }
            PHASE(pb + 1) { LAUNDER(); GEMM_CALL(FnP1, H2_, ws + WS_W1 + (size_t)L * N1 * K1 * 2, N1, K1, K1, K1, P1_); SEAM(); }
            PHASE(pb + 2) { LAUNDER(); GEMM_CALL(FnP2, P1_ + 3072, ws + WS_W2A + (size_t)L * 3072 * 256 * 2, NP2, 256, N1, 256, P2_, MOD_ + 53248 + L * 3072); SEAM(); }
            PHASE(pb + 3) { LAUNDER(); scan_phase(F, L); SEAM(); }
            PHASE(pb + 4) { LAUNDER(); post_phase(F, L); SEAM(); }
            PHASE(pb + 5) { LAUNDER(); GEMM_CALL(FnGate, P1_ + 3232, ws + WS_W2G + (size_t)L * 1024 * 256 * 2, D, 256, N1, 256, H2_, 2048); SEAM(); }
            PHASE(pb + 6) { LAUNDER(); GEMM_CALL(FnRes, H2_, ws + WS_WO + (size_t)L * D * D * 2, D, D, 2048, D, XIN1_, F.out, MODL_ + 2 * 1024); SEAM(); }
        } else {
            const int j = L - 2;
            PHASE(pb + 0) { LAUNDER(); norm_phase(F, F.out, F.in[4] + L * D, MODL_, MODL_ + 1024, 6144, 1, XN_);
                if (L == 2) norm_phase(F, F.out, F.in[29], MODKV_, MODKV_ + 1024, 2048, 1, XNKV_);
                SEAM(); }
            PHASE(pb + 1) { LAUNDER();
                if (L == 2) GEMM_CALL(FnKv, XNKV_, ws + WS_WKV, 2304, D, D, D, (bf16*)(ws + WS_KVRAW), (float*)(ws + WS_FL));
                LAUNDER();
                GEMM_CALL(FnQg, XN_, ws + WS_WQG + (size_t)j * 2048 * D * 2, 2048, D, D, D, QB_, GT_); SEAM(); }
            if (L == 2) PHASE(pb + 2) { LAUNDER(); kvpost_phase(F); SEAM(); }
            PHASE(pb + 3) { LAUNDER();
                float kb_; { float g_ = fabsf(F.in[34][F.lane]); g_ = fmaxf(g_, dpp_f(g_, 0)); g_ = fmaxf(g_, dpp_f(g_, 1)); g_ = fmaxf(g_, dpp_f(g_, 2)); g_ = fmaxf(g_, dpp_f(g_, 3));
                  { auto rr = __builtin_amdgcn_permlane16_swap(__float_as_uint(g_), __float_as_uint(g_), false, false); g_ = fmaxf(__uint_as_float(rr[0]), __uint_as_float(rr[1])); }
                  { auto rr = __builtin_amdgcn_permlane32_swap(__float_as_uint(g_), __float_as_uint(g_), false, false); g_ = fmaxf(__uint_as_float(rr[0]), __uint_as_float(rr[1])); }
                  kb_ = 8.0f * 1.02f * g_; }
                const attn_body::AttnTensors AT{(const attn_body::bf16*)QB_, (const attn_body::bf16*)(ws + WS_KS), (const attn_body::bf16*)(ws + WS_VS), (attn_body::bf16*)((PROBE_PH == pb + 3 && rep_ == 0) ? (bf16*)(ws + WS_KVRAW) : QB_), (const attn_body::bf16*)GT_, (const unsigned char*)(ws + WS_G3), F.in[36] + j * 64, kb_};
                const attn_body::StaticOrder S((int)F.G, F.bx);
                attn_body::attn_phase<attn_body::StaticOrder>((char*)lds, AT, S, F.tid);
                SEAM(); }
            PHASE(pb + 6) { LAUNDER(); GEMM_CALL(FnRes, QB_, ws + WS_WO2 + (size_t)j * D * D * 2, D, D, D, D, (const float*)F.out, F.out, MODL_ + 2 * 1024); SEAM(); }
        }
        PHASE(pb + 7) { LAUNDER(); mlp_weights(F, L); norm_phase(F, F.out, F.in[5] + L * D, MODL_ + 3 * 1024, MODL_ + 4 * 1024, 6144, 1, XN_); SEAM(); }
        PHASE(pb + 8) { LAUNDER(); GEMM_CALL(FnUp, XN_, ws + WS_WUP, FF, D, D, D, HB_); SEAM(); }
        PHASE(pb + 9) { LAUNDER(); GEMM_CALL(FnRes, HB_, ws + WS_WDN, D, FF, FF, FF, (const float*)F.out, F.out, MODL_ + 5 * 1024); SEAM(); }
        }
    PHASE(41) { LAUNDER(); final_norm_phase(F); }
#undef IN
#undef SEAM
}
static bool phase_exists(int ph) {
    if (ph == 0 || ph == 41) return true;
    const int L = (ph - 1) / 10, s = (ph - 1) % 10;
    if (L < 2) return true;
    if (s == 4 || s == 5) return false;
    if (s == 2) return L == 2;
    return true;
}
extern "C" void kernel_launch(void* const* d_in, const int* in_sizes, int n_in, void* d_out, int out_size, void* d_ws, size_t ws_size, hipStream_t stream) {
    static int grid = 0;
    if (grid == 0) {
        if (n_in != 39 || in_sizes[0] != M * D || out_size != M * D || ws_size < WS_END) { fprintf(stderr, "kernel_launch: shape/workspace mismatch: n_in %d in0 %d out %d ws %zu (need %zu)\n", n_in, n_in > 0 ? in_sizes[0] : -1, out_size, ws_size, (size_t)WS_END); grid = -1; return; }
        int dev = 0, cus = 0, per_cu = 0;
        if (hipGetDevice(&dev) != hipSuccess || hipDeviceGetAttribute(&cus, hipDeviceAttributeMultiprocessorCount, dev) != hipSuccess) { fprintf(stderr, "kernel_launch: device query failed\n"); grid = -1; return; }
        if (hipFuncSetAttribute((const void*)yoco_fwd, hipFuncAttributeMaxDynamicSharedMemorySize, LDS_BYTES) != hipSuccess) { fprintf(stderr, "kernel_launch: hipFuncSetAttribute failed\n"); grid = -1; return; }
        if (hipOccupancyMaxActiveBlocksPerMultiprocessor(&per_cu, (const void*)yoco_fwd, NWAVES * 64, LDS_BYTES) != hipSuccess || per_cu < 1) { fprintf(stderr, "kernel_launch: occupancy query says %d blocks/CU\n", per_cu); per_cu = 1; }
        (void)hipGetLastError();
        grid = cus * per_cu;
        if (grid != 256) { fprintf(stderr, "kernel_launch: resident capacity %d workgroups; this kernel's static schedules want 256 (using 256)\n", grid); if (grid > 256) grid = 256; }
    }
    if (grid < 0) return;
    if (hipMemsetAsync((char*)d_ws + WS_BAR, 0, BAR_BYTES, stream) != hipSuccess) { fprintf(stderr, "kernel_launch: memset of barrier words failed\n"); return; }
    Args a{};
    for (int i = 0; i < 39; ++i) a.in[i] = (const float*)d_in[i];
    a.out = (float*)d_out; a.ws = (unsigned char*)d_ws;
#if MK_ONE_LAUNCH
    a.ph_lo = 0; a.ph_hi = N_PHASES;
    void* params[] = {&a};
    const hipError_t le = hipLaunchCooperativeKernel((const void*)yoco_fwd, dim3(grid), dim3(NWAVES * 64), params, LDS_BYTES, stream);
    if (le != hipSuccess) fprintf(stderr, "kernel_launch: cooperative launch failed: %s (grid %d)\n", hipGetErrorName(le), grid);
#else
    for (int ph = 0; ph < N_PHASES; ++ph) { if (!phase_exists(ph)) continue; a.ph_lo = ph; a.ph_hi = ph + 1;
        hipLaunchKernelGGL(yoco_fwd, dim3(grid), dim3(NWAVES * 64), LDS_BYTES, stream, a);
        const hipError_t le = hipPeekAtLastError(); if (le != hipSuccess) { fprintf(stderr, "kernel_launch: launch of phase %d failed: %s\n", ph, hipGetErrorName(le)); break; } }
#endif
}
```

```cpp
#include <hip/hip_runtime.h>
#include <hip/hip_cooperative_groups.h>
#include <hip/hip_bf16.h>
#include <cstdio>
#include <cstdint>
#include <cmath>
namespace cg = cooperative_groups;
#ifndef MK_ONE_LAUNCH
#define MK_ONE_LAUNCH 1
#endif
namespace pg8 {
#define PG8_LAS __attribute__((address_space(3)))
typedef unsigned short bf16_t;
typedef short bf16x8 __attribute__((ext_vector_type(8)));
typedef float f32x4 __attribute__((ext_vector_type(4)));
typedef unsigned u32x4 __attribute__((ext_vector_type(4)));
constexpr int BM = 256, BK = 64, HALF = 128, HTB = HALF * BK * 2  , STAGE_BYTES = 8 * HTB, NXCD = 8, WGM = 8;

__host__ __device__ __forceinline__ int lds_byte(int r, int c) { const int st = (r >> 4) * 2 + (c >> 5), rr = r & 15, cc = c & 31, ob = rr * 64 + cc * 2; return st * 1024 + (ob ^ (((ob >> 9) & 1) << 5)); }
__host__ __device__ __forceinline__ void stage_rc(int b, int& R, int& C) { const int st = b / 1024, sb = b % 1024, swz = sb ^ (((sb >> 9) & 1) << 5); R = (st >> 1) * 16 + swz / 64; C = (st & 1) * 32 + (swz % 64) / 2; }
__host__ __device__ __forceinline__ int perm32(int rho) { const int n = rho >> 4, i = rho & 15; return 8 * (i >> 2) + 4 * n + (i & 3); }

struct Unit { int pm, pn; };
struct Gemm { const bf16_t* A; const bf16_t* Bt; int M, N, K, lda, ldb; int agrp; size_t astep; };

struct SplitOrder {
    int c, nN;
    __host__ __device__ void init(int M, int N, int G_, int c_) { c = c_; nN = N / BM; (void)M; (void)G_; }
    __host__ __device__ bool next(int i, Unit& u) const { int idx; if (c < 128) { if (i >= 2) return false; idx = 2 * c + i; } else { if (i >= 4) return false; idx = 256 + 4 * (c - 128) + i; } u.pm = idx / nN; u.pn = idx % nN; return true; }
    __device__ __forceinline__ void a_ready(const Unit&) const {}
    __device__ __forceinline__ void done(const Unit&) const {}
};
struct StaticOrder {
    int nM, nN, nwg, G, c;
    __host__ __device__ void init(int M, int N, int G_, int c_) { nM = M / BM; nN = N / BM; nwg = nM * nN; G = G_; c = c_; }
    __host__ __device__ bool next(int i, Unit& u) const {
        const long L = (long)i * G + c; if (L >= nwg) return false;
        int wgid = (int)L; { const int q = nwg / NXCD, r = nwg % NXCD, xcd = wgid % NXCD, off = wgid / NXCD; wgid = (xcd < r ? xcd * (q + 1) : r * (q + 1) + (xcd - r) * q) + off; }
        const int nig = WGM * nN, gid = wgid / nig, fm = gid * WGM, gsz = (nM - fm) < WGM ? (nM - fm) : WGM;
        u.pm = fm + ((wgid % nig) % gsz); u.pn = (wgid % nig) / gsz; return true;
    }
    __device__ __forceinline__ void a_ready(const Unit&) const {}
    __device__ __forceinline__ void done(const Unit&) const {}
};

typedef float f32x2 __attribute__((ext_vector_type(2)));
typedef __bf16 bf16x2_t __attribute__((ext_vector_type(2)));
__device__ __forceinline__ unsigned pkbf(float lo, float hi) { f32x2 v = {lo, hi}; bf16x2_t b = __builtin_convertvector(v, bf16x2_t); return __builtin_bit_cast(unsigned, b); }
__device__ __forceinline__ float bflo(unsigned w) { return __uint_as_float(w << 16); }
__device__ __forceinline__ float bfhi(unsigned w) { return __uint_as_float(w & 0xffff0000u); }
__device__ __forceinline__ float sigm(float x) { return 1.0f / (1.0f + __expf(-x)); }
template <class Fn> struct Epi8 {
    static constexpr bool PERM = true, AFTER_DRAIN = false; Fn f;
    __device__ __forceinline__ void operator()(const f32x4 (&acc)[2][2][4][2], const Unit& u, int wr, int wc, int fr, int fq) const {
        const int row0 = u.pm * BM + wr * 64 + fr, col0 = u.pn * BM + wc * 32 + 8 * fq;
#pragma unroll
        for (int ai = 0; ai < 2; ++ai)
#pragma unroll
            for (int m = 0; m < 4; ++m)
#pragma unroll
                for (int bj = 0; bj < 2; ++bj) { f(row0 + ai * HALF + m * 16, col0 + bj * HALF, acc[ai][bj][m][0], acc[ai][bj][m][1]); asm volatile("" ::: "memory"); }
    }
};
__device__ __forceinline__ void st8bf(bf16_t* p, f32x4 v0, f32x4 v1) { u32x4 w; w.x = pkbf(v0[0], v0[1]); w.y = pkbf(v0[2], v0[3]); w.z = pkbf(v1[0], v1[1]); w.w = pkbf(v1[2], v1[3]); *(u32x4*)p = w; }
struct FnP1 { bf16_t* O; int coff;
    __device__ __forceinline__ void operator()(int row, int col, f32x4 v0, f32x4 v1) const {
        col += coff;
        if (col >= 3072) {
            if (col < 3136) {
#pragma unroll
                for (int j = 0; j < 4; ++j) { v0[j] = 1.0f - 2.0f / (__expf(2.0f * v0[j]) + 1.0f); v1[j] = 1.0f - 2.0f / (__expf(2.0f * v1[j]) + 1.0f); } }
            else if (col >= 3232 && col < 3392) {
#pragma unroll
                for (int j = 0; j < 4; ++j) { v0[j] = sigm(v0[j]); v1[j] = sigm(v1[j]); } }
        }
        st8bf(O + (size_t)row * 3584 + col, v0, v1); } };
struct FnP2 { bf16_t* O; const float* bias;
    __device__ __forceinline__ void operator()(int row, int col, f32x4 v0, f32x4 v1) const {
        const f32x4 b0 = *(const f32x4*)(bias + col), b1 = *(const f32x4*)(bias + col + 4);
        const float sc = col < 1024 ? -0.60653065971f : 1.0f;
#pragma unroll
        for (int j = 0; j < 4; ++j) { v0[j] = sc * sigm(v0[j] + b0[j]); v1[j] = sc * sigm(v1[j] + b1[j]); }
        st8bf(O + (size_t)row * 3072 + col, v0, v1); } };
struct FnGate { bf16_t* Y; int ld;
    __device__ __forceinline__ void operator()(int row, int col, f32x4 v0, f32x4 v1) const {
        bf16_t* p = Y + (size_t)row * ld + col; const u32x4 y = *(const u32x4*)p;
        v0[0] *= bflo(y.x); v0[1] *= bfhi(y.x); v0[2] *= bflo(y.y); v0[3] *= bfhi(y.y); v1[0] *= bflo(y.z); v1[1] *= bfhi(y.z); v1[2] *= bflo(y.w); v1[3] *= bfhi(y.w);
        st8bf(p, v0, v1); } };
struct FnRes { const float* xin; float* xout; const float* gate;
    __device__ __forceinline__ void operator()(int row, int col, f32x4 v0, f32x4 v1) const {
        const float* gp = gate + (row >> 13) * 6144 + col; const f32x4 g0 = *(const f32x4*)gp, g1 = *(const f32x4*)(gp + 4);
        const size_t off = (size_t)row * 1024 + col; const f32x4 x0 = *(const f32x4*)(xin + off), x1 = *(const f32x4*)(xin + off + 4);
        *(f32x4*)(xout + off) = x0 + (g0 + 1.0f) * v0; *(f32x4*)(xout + off + 4) = x1 + (g1 + 1.0f) * v1; } };
struct FnUp { bf16_t* O;
    __device__ __forceinline__ void operator()(int row, int col, f32x4 v0, f32x4 v1) const {
#pragma unroll
        for (int j = 0; j < 4; ++j) { const float a = fmaxf(v0[j], 0.f), b = fmaxf(v1[j], 0.f); v0[j] = a * a; v1[j] = b * b; }
        st8bf(O + (size_t)row * 4096 + col, v0, v1); } };
struct FnKv { bf16_t* O; float* FL;
    __device__ __forceinline__ void operator()(int row, int col, f32x4 v0, f32x4 v1) const {
        if (col < 2048) st8bf(O + (size_t)row * 2048 + col, v0, v1);
        else if (col < 2064) { float* p = FL + (size_t)row * 16 + (col - 2048); *(f32x4*)p = v0; *(f32x4*)(p + 4) = v1; } } };
struct FnQg { bf16_t* Q; bf16_t* G;
    __device__ __forceinline__ void operator()(int row, int col, f32x4 v0, f32x4 v1) const {
        if (col < 1024) st8bf(Q + (size_t)row * 1024 + col, v0, v1);
        else {
#pragma unroll
            for (int j = 0; j < 4; ++j) { v0[j] = sigm(v0[j]); v1[j] = sigm(v1[j]); }
            st8bf(G + (size_t)row * 1024 + (col - 1024), v0, v1); } } };
template <class Epi, class Sched, bool ALIGN_EPI = false, bool SP2 = false>
__device__ __forceinline__ void gemm_phase(PG8_LAS unsigned char* lds, const Gemm g, const Sched& S, const Epi& E, const int tid_in) {
    int tid_l = tid_in; asm volatile("" : "+v"(tid_l));
    const int tid = tid_l, wid = __builtin_amdgcn_readfirstlane(tid >> 6), lane = tid & 63, wr = wid >> 2, wc = wid & 3, fr = lane & 15, fq = lane >> 4;
    const int K = g.K, nt = K / BK;
    unsigned voffA[2], voffB[2];
#pragma unroll
    for (int i = 0; i < 2; ++i) { int R, C; stage_rc(tid * 16 + i * 8192, R, C); const int Rb = Epi::PERM ? ((R & ~31) + perm32(R & 31)) : R;
        voffA[i] = (unsigned)(R * g.lda + C) * 2u; voffB[i] = (unsigned)(Rb * g.ldb + C) * 2u; }
    const size_t kstep = (size_t)(BK * 2);
    const size_t hstepA = (size_t)HALF * g.lda * 2, hstepB = (size_t)HALF * g.ldb * 2;
    const size_t tstepA = 2 * hstepA, tstepB = 2 * hstepB;
    const unsigned ldsw = (unsigned)wid * 1024u;
    const int aoff = lds_byte(wr * 64 + fr, fq * 8), boff = lds_byte(wc * 32 + fr, fq * 8);
#define PG8_SA(b, h) (((b) * 2 + (h)) * HTB)
#define PG8_SB(b, h) ((4 + (b) * 2 + (h)) * HTB)
#define PG8_STAGE(bufoff, gbase, voff) do { _Pragma("unroll") for (int _i = 0; _i < 2; ++_i) \
        __builtin_amdgcn_global_load_lds((const unsigned*)((const char*)(gbase) + (voff)[_i]), (PG8_LAS unsigned*)(lds + (bufoff) + ldsw + _i * 8192), 16, 0, 0); } while (0)
#define PG8_LDA(dst, b, h) do { _Pragma("unroll") for (int m = 0; m < 4; ++m) _Pragma("unroll") for (int k = 0; k < 2; ++k) dst[m][k] = *(const PG8_LAS bf16x8*)(lds + PG8_SA(b, h) + aoff + m * 2048 + k * 1024); } while (0)
#define PG8_LDB(dst, b, h) do { _Pragma("unroll") for (int n = 0; n < 2; ++n) _Pragma("unroll") for (int k = 0; k < 2; ++k) dst[n][k] = *(const PG8_LAS bf16x8*)(lds + PG8_SB(b, h) + boff + n * 2048 + k * 1024); } while (0)
#define PG8_MMA(ai, bj, At, Bt) do { __builtin_amdgcn_s_setprio(1); _Pragma("unroll") for (int m = 0; m < 4; ++m) _Pragma("unroll") for (int n = 0; n < 2; ++n) _Pragma("unroll") for (int k = 0; k < 2; ++k) \
        acc[ai][bj][m][n] = __builtin_amdgcn_mfma_f32_16x16x32_bf16(Bt[n][k], At[m][k], acc[ai][bj][m][n], 0, 0, 0); __builtin_amdgcn_s_setprio(0); } while (0)
#define PG8_WAIT_V(n) asm volatile("s_waitcnt vmcnt(" #n ")" ::: "memory")
#define PG8_WAIT_L(n) asm volatile("s_waitcnt lgkmcnt(" #n ")" ::: "memory")
#define PG8_BAR __builtin_amdgcn_s_barrier()
#define PG8_SCHED __builtin_amdgcn_sched_barrier(0)
    Unit cur, nxt; int ui = 0;
    if (!S.next(0, cur)) return;
    f32x4 acc[2][2][4][2];
#pragma unroll
    for (int a = 0; a < 2; ++a)
#pragma unroll
        for (int b = 0; b < 2; ++b)
#pragma unroll
            for (int m = 0; m < 4; ++m)
#pragma unroll
                for (int n = 0; n < 2; ++n) acc[a][b][m][n] = (f32x4){0.f, 0.f, 0.f, 0.f};
    bf16x8 At[4][2], B0[2][2], B1[2][2];
    const char* cA = (const char*)g.A + (size_t)cur.pm * tstepA + (g.agrp ? (size_t)(cur.pn / g.agrp) * g.astep : (size_t)0); const char* cB = (const char*)g.Bt + (size_t)cur.pn * tstepB;
    S.a_ready(cur);
    if constexpr (SP2) {
        PG8_STAGE(PG8_SB(0, 0), cB, voffB); PG8_STAGE(PG8_SB(0, 1), cB + hstepB, voffB); PG8_STAGE(PG8_SA(0, 0), cA, voffA); PG8_STAGE(PG8_SA(0, 1), cA + hstepA, voffA);
        if (wr == 1) PG8_BAR;
        PG8_WAIT_V(2); PG8_BAR;
        PG8_STAGE(PG8_SB(1, 0), cB + kstep, voffB); PG8_STAGE(PG8_SA(1, 0), cA + kstep, voffA); PG8_STAGE(PG8_SB(1, 1), cB + hstepB + kstep, voffB);
        PG8_WAIT_V(6); PG8_BAR;
    } else {
        PG8_STAGE(PG8_SB(0, 0), cB, voffB); PG8_STAGE(PG8_SA(0, 0), cA, voffA); PG8_STAGE(PG8_SB(0, 1), cB + hstepB, voffB); PG8_STAGE(PG8_SA(0, 1), cA + hstepA, voffA);
        if (wr == 1) PG8_BAR;
        PG8_WAIT_V(4); PG8_BAR;
        PG8_STAGE(PG8_SB(1, 0), cB + kstep, voffB); PG8_STAGE(PG8_SA(1, 0), cA + kstep, voffA); PG8_STAGE(PG8_SB(1, 1), cB + hstepB + kstep, voffB);
        PG8_WAIT_V(6); PG8_BAR;
    }
    for (;;) {
        const bool has_next = S.next(ui + 1, nxt);
        const char* nA = has_next ? (const char*)g.A + (size_t)nxt.pm * tstepA + (g.agrp ? (size_t)(nxt.pn / g.agrp) * g.astep : (size_t)0) : cA; const char* nB = has_next ? (const char*)g.Bt + (size_t)nxt.pn * tstepB : cB;
        for (int t = 0; t < nt; t += 2) {
            const bool last = (t == nt - 2);
            const char* a1 = cA + (size_t)(t + 1) * kstep;
            const char* a2 = last ? nA : cA + (size_t)(t + 2) * kstep; const char* b2 = last ? nB : cB + (size_t)(t + 2) * kstep;
            const char* a3 = a2 + kstep; const char* b3 = b2 + kstep;
            if (last && has_next) S.a_ready(nxt);
            if constexpr (SP2) {
            PG8_LDB(B0, 0, 0); PG8_LDB(B1, 0, 1); PG8_SCHED; PG8_LDA(At, 0, 0); PG8_STAGE(PG8_SA(1, 1), a1 + hstepA, voffA);
            PG8_WAIT_V(8); PG8_WAIT_L(0); PG8_BAR; PG8_MMA(0, 0, At, B0); PG8_MMA(0, 1, At, B1); PG8_BAR; PG8_SCHED;
            PG8_LDA(At, 0, 1); PG8_STAGE(PG8_SB(0, 0), b2, voffB); PG8_STAGE(PG8_SB(0, 1), b2 + hstepB, voffB); PG8_STAGE(PG8_SA(0, 0), a2, voffA);
            PG8_WAIT_V(8); PG8_WAIT_L(0); PG8_BAR; PG8_MMA(1, 0, At, B0); PG8_MMA(1, 1, At, B1); PG8_BAR; PG8_SCHED;
            PG8_LDB(B0, 1, 0); PG8_LDB(B1, 1, 1); PG8_SCHED; PG8_LDA(At, 1, 0); PG8_STAGE(PG8_SA(0, 1), a2 + hstepA, voffA);
            PG8_WAIT_V(8); PG8_WAIT_L(0); PG8_BAR; PG8_MMA(0, 0, At, B0); PG8_MMA(0, 1, At, B1); PG8_BAR; PG8_SCHED;
            PG8_LDA(At, 1, 1); PG8_STAGE(PG8_SB(1, 0), b3, voffB); PG8_STAGE(PG8_SB(1, 1), b3 + hstepB, voffB); PG8_STAGE(PG8_SA(1, 0), a3, voffA);
            PG8_WAIT_V(8); PG8_WAIT_L(0); PG8_BAR; PG8_MMA(1, 0, At, B0); PG8_MMA(1, 1, At, B1); PG8_BAR; PG8_SCHED;
            } else {
            PG8_LDB(B0, 0, 0); PG8_SCHED; PG8_LDA(At, 0, 0); PG8_STAGE(PG8_SA(1, 1), a1 + hstepA, voffA);
            PG8_WAIT_L(8); PG8_BAR; PG8_WAIT_L(0); PG8_MMA(0, 0, At, B0); PG8_BAR; PG8_SCHED;
            PG8_LDB(B1, 0, 1); PG8_STAGE(PG8_SB(0, 0), b2, voffB);
            PG8_BAR; PG8_WAIT_L(0); PG8_MMA(0, 1, At, B1); PG8_BAR;
            PG8_LDA(At, 0, 1); PG8_STAGE(PG8_SA(0, 0), a2, voffA);
            PG8_BAR; PG8_WAIT_L(0); PG8_MMA(1, 0, At, B0); PG8_BAR; PG8_SCHED;
            PG8_STAGE(PG8_SB(0, 1), b2 + hstepB, voffB);
            PG8_WAIT_V(6); PG8_BAR; PG8_MMA(1, 1, At, B1); PG8_BAR;
            PG8_LDB(B0, 1, 0); PG8_SCHED; PG8_LDA(At, 1, 0); PG8_STAGE(PG8_SA(0, 1), a2 + hstepA, voffA);
            PG8_WAIT_L(8); PG8_BAR; PG8_WAIT_L(0); PG8_MMA(0, 0, At, B0); PG8_BAR; PG8_SCHED;
            PG8_LDB(B1, 1, 1); PG8_STAGE(PG8_SB(1, 0), b3, voffB);
            PG8_BAR; PG8_WAIT_L(0); PG8_MMA(0, 1, At, B1); PG8_BAR;
            PG8_LDA(At, 1, 1); PG8_STAGE(PG8_SA(1, 0), a3, voffA);
            PG8_BAR; PG8_WAIT_L(0); PG8_MMA(1, 0, At, B0); PG8_BAR; PG8_SCHED;
            PG8_STAGE(PG8_SB(1, 1), b3 + hstepB, voffB);
            PG8_WAIT_V(6); PG8_BAR; PG8_MMA(1, 1, At, B1); PG8_BAR;
            }
        }
        if constexpr (ALIGN_EPI) { if (wr == 0) PG8_BAR; }
        if constexpr (!Epi::AFTER_DRAIN) { E(acc, cur, wr, wc, fr, fq); S.done(cur); }
        if (!has_next) break;
#pragma unroll
        for (int a = 0; a < 2; ++a)
#pragma unroll
            for (int b = 0; b < 2; ++b)
#pragma unroll
                for (int m = 0; m < 4; ++m)
#pragma unroll
                    for (int n = 0; n < 2; ++n) acc[a][b][m][n] = (f32x4){0.f, 0.f, 0.f, 0.f};
        cur = nxt; cA = nA; cB = nB; ++ui;
        if constexpr (ALIGN_EPI) { if (wr == 1) PG8_BAR; }
    }
    PG8_WAIT_V(0);
    if constexpr (!ALIGN_EPI) { if (wr == 0) PG8_BAR; }
    PG8_BAR;
    if constexpr (Epi::AFTER_DRAIN) { E.fused(acc, cur, wr, wc, fr, fq, lds, wid, lane); S.done(cur); }
#undef PG8_SA
#undef PG8_SB
#undef PG8_STAGE
#undef PG8_LDA
#undef PG8_LDB
#undef PG8_MMA
#undef PG8_WAIT_V
#undef PG8_WAIT_L
#undef PG8_BAR
#undef PG8_SCHED
}
}
#include <hip/hip_bf16.h>
#include <cmath>
namespace attn_body {
using bf16=__hip_bfloat16;
using bf16x8=__attribute__((ext_vector_type(8)))short;
using s16x4=__attribute__((ext_vector_type(4)))short;
using f32x16=__attribute__((ext_vector_type(16)))float;
using u32x4=__attribute__((ext_vector_type(4)))unsigned;
constexpr int BATCH=2,NHEAD=16,SEQ=8192,D=64,DM=NHEAD*D;
constexpr int NW=8,QBLK=32,QB=QBLK*NW,KVBLK=64,NQB=SEQ/QB;
constexpr int ATTN_PITCH=DM, ATTN_UNIT_ROWS=QB;
__device__ __forceinline__ int crow(int r,int hi){return (r&3)+8*(r>>2)+4*hi;}
#define SBAR() __builtin_amdgcn_sched_barrier(0)
__device__ __forceinline__ void cmask(f32x16&p0,f32x16&p1,int jb,int qrel,int hi){
  const float NEG=-INFINITY; int kb=64*jb+4*hi;
  #pragma unroll
  for(int r=0;r<16;++r){int kv=kb+(r&3)+8*(r>>2); if(kv>qrel)p0[r]=NEG; if(kv+32>qrel)p1[r]=NEG;}
}

constexpr int NSLOT=3, SLOTB=9216;
constexpr int LDS_K=0, LDS_V=NSLOT*SLOTB, LDS_WS=2*NSLOT*SLOTB, LDS_OST=LDS_WS+NW*64*4, LDS_BYTES=LDS_OST+NW*4096;
constexpr float C2=0.125f*1.4426950408889634f;
__device__ __forceinline__ void glds16(const void*gsrc,unsigned lds_dst){unsigned keep;
  asm volatile("s_mov_b32 %0, m0\n\ts_mov_b32 m0, %2\n\ts_nop 0\n\tglobal_load_lds_dwordx4 %1, off\n\ts_mov_b32 m0, %0":"=&s"(keep):"v"(gsrc),"s"(lds_dst):"memory");}
__device__ __forceinline__ float max3f(float a,float b,float c){float r;asm("v_max3_f32 %0, %1, %2, %3":"=v"(r):"v"(a),"v"(b),"v"(c));return r;}
__device__ __forceinline__ float max2f(float a,float b){float r;asm("v_max_f32_e32 %0, %1, %2":"=v"(r):"v"(a),"v"(b));return r;}
__device__ __forceinline__ float fadd_s(float a,float b){float r;asm("v_add_f32_e32 %0, %1, %2":"=v"(r):"v"(a),"v"(b));return r;}
__device__ __forceinline__ float fsub_s(float a,float b){float r;asm("v_sub_f32_e32 %0, %1, %2":"=v"(r):"v"(a),"v"(b));return r;}
typedef float f32x2_t __attribute__((ext_vector_type(2))); typedef __bf16 bf16x2_t __attribute__((ext_vector_type(2)));
__device__ __forceinline__ unsigned cvtpk_s(float lo,float hi){f32x2_t v={lo,hi};bf16x2_t b=__builtin_convertvector(v,bf16x2_t);return __builtin_bit_cast(unsigned,b);}
#define WAIT_BAR(N) asm volatile("s_waitcnt vmcnt(" #N ") lgkmcnt(0)\n\ts_barrier":::"memory")
#define WAIT_BARW() do{ if(wid==0){WAIT_BAR(3);} else {WAIT_BAR(2);} }while(0)

__device__ __forceinline__ void qkt(f32x16&p0,f32x16&p1,const char*Kslot,const bf16x8*qr,const bf16x8 qe,const f32x16&negm,int r32,int hi){
  const char*kb=Kslot+hi*1024+r32*16;
  #pragma unroll
  for(int d0=0;d0<4;++d0){
    const bf16x8 b0=*reinterpret_cast<const bf16x8*>(kb+d0*2048);
    const bf16x8 b1=*reinterpret_cast<const bf16x8*>(kb+d0*2048+512);
    if(d0==0){p0=__builtin_amdgcn_mfma_f32_32x32x16_bf16(b0,qr[0],negm,0,0,0);p1=__builtin_amdgcn_mfma_f32_32x32x16_bf16(b1,qr[0],negm,0,0,0);}
    else{p0=__builtin_amdgcn_mfma_f32_32x32x16_bf16(b0,qr[d0],p0,0,0,0);p1=__builtin_amdgcn_mfma_f32_32x32x16_bf16(b1,qr[d0],p1,0,0,0);}}
  { const char*ke=Kslot+8192+r32*16; const bf16x8 e0=*reinterpret_cast<const bf16x8*>(ke),e1=*reinterpret_cast<const bf16x8*>(ke+512);
    p0=__builtin_amdgcn_mfma_f32_32x32x16_bf16(e0,qe,p0,0,0,0);p1=__builtin_amdgcn_mfma_f32_32x32x16_bf16(e1,qe,p1,0,0,0);}
}
typedef __attribute__((address_space(3))) const char* lds_cptr;
typedef short v4i16_t __attribute__((ext_vector_type(4)));
__device__ __forceinline__ void kload8(bf16x8*kf,lds_cptr kp){
  kf[0]=*(const __attribute__((address_space(3))) bf16x8*)(kp);      kf[1]=*(const __attribute__((address_space(3))) bf16x8*)(kp+512);
  kf[2]=*(const __attribute__((address_space(3))) bf16x8*)(kp+2048); kf[3]=*(const __attribute__((address_space(3))) bf16x8*)(kp+2560);
  kf[4]=*(const __attribute__((address_space(3))) bf16x8*)(kp+4096); kf[5]=*(const __attribute__((address_space(3))) bf16x8*)(kp+4608);
  kf[6]=*(const __attribute__((address_space(3))) bf16x8*)(kp+6144); kf[7]=*(const __attribute__((address_space(3))) bf16x8*)(kp+6656);
}
__device__ __forceinline__ void kload2(bf16x8*kf,lds_cptr kp,int j){ kf[2*j]=*(const __attribute__((address_space(3))) bf16x8*)(kp+j*2048); kf[2*j+1]=*(const __attribute__((address_space(3))) bf16x8*)(kp+j*2048+512); }
__device__ __forceinline__ s16x4 vtr(lds_cptr p){ return __builtin_bit_cast(s16x4,__builtin_amdgcn_ds_read_tr16_b64_v4i16((__attribute__((address_space(3))) v4i16_t*)p)); }
__device__ __forceinline__ float rowmax(const f32x16&p0,const f32x16&p1){
  float a=max3f(p0[0],p0[1],p1[0]),b=max3f(p0[2],p0[3],p1[1]);a=max3f(a,p1[2],p1[3]);
  #pragma unroll
  for(int r=4;r<16;r+=4){a=max3f(a,p0[r],p0[r+1]);b=max3f(b,p0[r+2],p0[r+3]);a=max3f(a,p1[r],p1[r+1]);b=max3f(b,p1[r+2],p1[r+3]);}
  const float m=max2f(a,b);
  auto rr=__builtin_amdgcn_permlane32_swap(__float_as_uint(m),__float_as_uint(m),false,false);
  return max2f(__uint_as_float(rr[0]),__uint_as_float(rr[1]));
}
__device__ __forceinline__ void pv(f32x16*o,int vb,bf16x8 pa0,bf16x8 pa1,bf16x8 pa2,bf16x8 pa3){
  #pragma unroll
  for(int d0=0;d0<2;++d0){s16x4 lo[4],hi[4];
    #pragma unroll
    for(int ks=0;ks<4;++ks){
      asm volatile("ds_read_b64_tr_b16 %0,%1 offset:%c2":"=&v"(lo[ks]):"v"(vb),"i"(d0*4096+ks*1024):"memory");
      asm volatile("ds_read_b64_tr_b16 %0,%1 offset:%c2":"=&v"(hi[ks]):"v"(vb),"i"(d0*4096+ks*1024+512):"memory");}
    asm volatile("s_waitcnt lgkmcnt(0)":::"memory");SBAR();
    #define PK(k) (bf16x8){lo[k][0],lo[k][1],lo[k][2],lo[k][3],hi[k][0],hi[k][1],hi[k][2],hi[k][3]}
    o[d0]=__builtin_amdgcn_mfma_f32_32x32x16_bf16(pa0,PK(0),o[d0],0,0,0);
    o[d0]=__builtin_amdgcn_mfma_f32_32x32x16_bf16(pa1,PK(1),o[d0],0,0,0);
    o[d0]=__builtin_amdgcn_mfma_f32_32x32x16_bf16(pa2,PK(2),o[d0],0,0,0);
    o[d0]=__builtin_amdgcn_mfma_f32_32x32x16_bf16(pa3,PK(3),o[d0],0,0,0);
    #undef PK
  }
}

#ifndef ATTN_STORE16
#define ATTN_STORE16(p,v) (*(u32x4*)(p)=(v))
#endif
template<int THRL> __device__ __forceinline__ void attn_unit(int b,int h,int qb,const bf16*Q,const bf16*__restrict__ K,const bf16*__restrict__ V,bf16*O,const bf16*__restrict__ GT,const unsigned char*__restrict__ G3,const float*__restrict__ qgain,const float kbound,char*shm,const int tid_in){
  int tid_l=tid_in; asm volatile("":"+v"(tid_l)); const int tid=tid_l,lane=tid&63,r32=lane&31,hi=lane>>5; const int wid=__builtin_amdgcn_readfirstlane(tid>>6);
  const long rowbase=(long)b*SEQ; const int q0=qb*QB;
  const bf16*Qw=Q+(rowbase+q0+wid*QBLK)*DM+h*D;
  const bf16*Kh=K+rowbase*DM+h*D,*Vh=V+rowbase*DM+h*D;
  const unsigned lds0=(unsigned)(uintptr_t)shm;
  float*wsf=(float*)(shm+LDS_WS)+wid*64;
  const bf16*ksrc=Kh+(long)lane*DM+wid*8;
  const bf16*vsrc=Vh+(long)(16*(wid&3)+(lane>>2))*DM+(wid>>2)*32+(lane&3)*8;
  const unsigned kdst=lds0+LDS_K+wid*1024, vdst=lds0+LDS_V+wid*1024, gdst=lds0+LDS_K+8192;
  const unsigned char*gsrc=G3+((long)(b*NHEAD+h)*SEQ+lane)*16;
  #define DMA_K(t,slot) do{ if(wid==0)glds16(gsrc+(long)(t)*KVBLK*16,(unsigned)__builtin_amdgcn_readfirstlane(gdst+(slot))); glds16(ksrc+(long)(t)*KVBLK*DM,(unsigned)__builtin_amdgcn_readfirstlane(kdst+(slot))); }while(0)
  #define DMA_V(t,slot) glds16(vsrc+(long)(t)*KVBLK*DM,(unsigned)__builtin_amdgcn_readfirstlane(vdst+(slot)))
  const int vb0=(int)(lds0+LDS_V)+((lane>>4)&1)*32+(lane&3)*8+(4*hi+((lane&15)>>2))*64;
  const char*Kbase=shm+LDS_K; bf16x8 kf[10];
  const lds_cptr shm3=(lds_cptr)shm; const lds_cptr kp0=shm3+LDS_K+hi*1024+r32*16; const lds_cptr kpe=shm3+LDS_K+8192+r32*16; const lds_cptr vp0=shm3+LDS_V+((lane>>4)&1)*32+(lane&3)*8+(4*hi+((lane&15)>>2))*64;
  const int NT=(q0+QB)/KVBLK;
  DMA_K(0,0);DMA_V(0,0);DMA_K(1,SLOTB);
  bf16x8 qr[4]; float fq2; bf16x8 qe; float ubound;
  { bf16x8 qraw[4];
    #pragma unroll
    for(int d0=0;d0<4;++d0)qraw[d0]=*reinterpret_cast<const bf16x8*>(&Qw[(long)r32*DM+d0*16+hi*8]);
    const u32x4 ge=*reinterpret_cast<const u32x4*>(G3+((long)(b*NHEAD+h)*SEQ+q0+wid*QBLK+r32)*16);
    fq2=-(__uint_as_float(ge[0]<<16)+__uint_as_float(ge[0]&0xffff0000u)+__uint_as_float(ge[1]<<16));
    float ss=0.f;
    #pragma unroll
    for(int d0=0;d0<4;++d0)
      #pragma unroll
      for(int j=0;j<8;++j){const float x=__uint_as_float(((unsigned)(unsigned short)qraw[d0][j])<<16);ss+=x*x;}
    {auto rr=__builtin_amdgcn_permlane32_swap(__float_as_uint(ss),__float_as_uint(ss),false,false);ss=__uint_as_float(rr[0])+__uint_as_float(rr[1]);}
    const float qs=C2/sqrtf(ss*(1.0f/64.0f)+1e-6f);
    float s2=0.f;
    #pragma unroll
    for(int d0=0;d0<4;++d0){ u32x4 w;
      #pragma unroll
      for(int j=0;j<8;j+=2){const float x0=__uint_as_float(((unsigned)(unsigned short)qraw[d0][j])<<16),x1=__uint_as_float(((unsigned)(unsigned short)qraw[d0][j+1])<<16);
        const float y0=x0*qs*qgain[d0*16+hi*8+j],y1=x1*qs*qgain[d0*16+hi*8+j+1]; s2+=y0*y0+y1*y1;
        w[j>>1]=cvtpk_s(y0,y1);}
      qr[d0]=__builtin_bit_cast(bf16x8,w);}
    {auto rr=__builtin_amdgcn_permlane32_swap(__float_as_uint(s2),__float_as_uint(s2),false,false);s2=__uint_as_float(rr[0])+__uint_as_float(rr[1]);}
    ubound=sqrtf(s2)*kbound;
    const unsigned one2=hi?0u:0x3f803f80u, one1=hi?0u:0x00003f80u; qe=__builtin_bit_cast(bf16x8,(u32x4){one2,one1,0u,0u}); }
  float mhat=ubound,l_reg=0.f;f32x16 o[2];o[0]=f32x16{};o[1]=f32x16{};f32x16 negm;
  #pragma unroll
  for(int r=0;r<16;++r)negm[r]=fq2-ubound;
  asm volatile("":"+v"(negm));
  const int qrel=wid*QBLK+r32;
  #define CMASK(P0,P1,t) do{int jb_=(t)-(NT-4); if(jb_>=0)cmask(P0,P1,jb_,qrel,hi);}while(0)
  bool resc=false;
  #define START(P0,P1) do{ const float rm=rowmax(P0,P1); resc=false; \
    { const float dl=fmaxf(rm,0.f); mhat=fadd_s(mhat,dl); \
      _Pragma("unroll") for(int r=0;r<16;++r){P0[r]=fsub_s(P0[r],dl);P1[r]=fsub_s(P1[r],dl);} \
      _Pragma("unroll") for(int r=0;r<16;++r)negm[r]=fq2-mhat; asm volatile("":"+v"(negm)); } \
    _Pragma("unroll") for(int r=0;r<16;++r)P0[r]=__builtin_amdgcn_exp2f(P0[r]); }while(0)
  #define RESC() do{ if(resc){ asm volatile("s_waitcnt lgkmcnt(0)":::"memory"); \
      _Pragma("unroll") for(int d_=0;d_<2;++d_) _Pragma("unroll") for(int r=0;r<16;++r)o[d_][r]*=wsf[crow(r,hi)]; } }while(0)
  f32x16 pA0,pA1,pB0,pB1;
  int sl_prev=0,sl_cur=0,sl_next=SLOTB;
  #define ROT() do{sl_prev=sl_cur;sl_cur=sl_next;sl_next=(sl_next==(NSLOT-1)*SLOTB)?0:sl_next+SLOTB;}while(0)
  DMA_K(2,2*SLOTB);
  WAIT_BAR(3);
  qkt(pA0,pA1,Kbase,qr,qe,negm,r32,hi);asm volatile("s_nop 15\n\ts_nop 7":"+v"(pA0),"+v"(pA1));CMASK(pA0,pA1,0);
  START(pA0,pA1);
  _Pragma("unroll") for(int r=0;r<16;++r)pA1[r]=__builtin_amdgcn_exp2f(pA1[r]);
  WAIT_BAR(0);
  DMA_K(3,0);DMA_V(1,SLOTB);
  ROT();
  kload8(kf,kp0+sl_cur);
  kf[8]=*(const __attribute__((address_space(3))) bf16x8*)(kpe+sl_cur); kf[9]=*(const __attribute__((address_space(3))) bf16x8*)(kpe+sl_cur+512);
  WAIT_BARW();
  s16x4 vlo[8],vhi[8]; u32x4 pw0,pw1,pw2,pw3;
  #define PKW(P,B) cvtpk_s(P[B],P[B+1])
  #define PAF(k) __builtin_bit_cast(bf16x8,pw##k)
  #define VFR(i) (bf16x8){vlo[i][0],vlo[i][1],vlo[i][2],vlo[i][3],vhi[i][0],vhi[i][1],vhi[i][2],vhi[i][3]}
  #define PIN(x) asm volatile("":"+v"(x))
  #define MX3(a,b,c) __builtin_fmaxf(__builtin_fmaxf((a),(b)),(c))
  #define GAPA(MF,A0,A1,A2,A3,W0,W1,PW) do{ MF; sacc+=A0; sacc+=A1; sacc+=A2; sacc+=A3; PIN(sacc); W0; W1; PIN(PW); SBAR(); }while(0)
  #define EX(v) __builtin_amdgcn_exp2f(v)
  #define GAPB(MF,X,B) do{ MF; X[B]=EX(X[B]); X[B+1]=EX(X[B+1]); X[B+2]=EX(X[B+2]); X[B+3]=EX(X[B+3]); PIN(X); SBAR(); }while(0)
  #define VRD(i) do{ vlo[i]=vtr(vp_+(((i)>>2)*4096+((i)&3)*1024)); vhi[i]=vtr(vp_+(((i)>>2)*4096+((i)&3)*1024+512)); }while(0)
  #define KRD(G,j) do{ if(G){ kload2(kf,kp0+sl_next,j); SBAR(); } }while(0)
  #define STEP(C0,C1,P0,P1,t,GK,GV,GL) do{ SBAR(); \
    const lds_cptr vp_=vp0+sl_prev; \
    VRD(0); SBAR(); float sacc=(P0[0]+P0[1]); \
    GAPA(C0=__builtin_amdgcn_mfma_f32_32x32x16_bf16(kf[0],qr[0],negm,0,0,0), P0[2],P0[3],P0[4],P0[5],     pw0[0]=PKW(P0,0), pw0[1]=PKW(P0,2), pw0); \
    VRD(4); SBAR(); GAPA(C1=__builtin_amdgcn_mfma_f32_32x32x16_bf16(kf[1],qr[0],negm,0,0,0), P0[6],P0[7],P0[8],P0[9],     pw0[2]=PKW(P0,4), pw0[3]=PKW(P0,6), pw0); \
    VRD(1); SBAR(); GAPA(C0=__builtin_amdgcn_mfma_f32_32x32x16_bf16(kf[2],qr[1],C0,0,0,0),   P0[10],P0[11],P0[12],P0[13], pw1[0]=PKW(P0,8), pw1[1]=PKW(P0,10), pw1); \
    VRD(5); SBAR(); GAPA(C1=__builtin_amdgcn_mfma_f32_32x32x16_bf16(kf[3],qr[1],C1,0,0,0),   P0[14],P0[15],P1[0],P1[1],   pw1[2]=PKW(P0,12),pw1[3]=PKW(P0,14), pw1); \
    VRD(2); SBAR(); GAPA(C0=__builtin_amdgcn_mfma_f32_32x32x16_bf16(kf[4],qr[2],C0,0,0,0),   P1[2],P1[3],P1[4],P1[5],     pw2[0]=PKW(P1,0), pw2[1]=PKW(P1,2), pw2); \
    VRD(6); SBAR(); GAPA(C1=__builtin_amdgcn_mfma_f32_32x32x16_bf16(kf[5],qr[2],C1,0,0,0),   P1[6],P1[7],P1[8],P1[9],     pw2[2]=PKW(P1,4), pw2[3]=PKW(P1,6), pw2); \
    VRD(3); SBAR(); GAPA(C0=__builtin_amdgcn_mfma_f32_32x32x16_bf16(kf[6],qr[3],C0,0,0,0),   P1[10],P1[11],P1[12],P1[13], pw3[0]=PKW(P1,8), pw3[1]=PKW(P1,10), pw3); \
    VRD(7); SBAR(); GAPA(C1=__builtin_amdgcn_mfma_f32_32x32x16_bf16(kf[7],qr[3],C1,0,0,0),   P1[14],P1[15],0.f,0.f,       pw3[2]=PKW(P1,12),pw3[3]=PKW(P1,14), pw3); \
    C0=__builtin_amdgcn_mfma_f32_32x32x16_bf16(kf[8],qe,C0,0,0,0); C1=__builtin_amdgcn_mfma_f32_32x32x16_bf16(kf[9],qe,C1,0,0,0); \
    l_reg+=sacc; \
    if(GK){DMA_K((t)+3,sl_cur);} if(GV){DMA_V((t)+1,sl_next);} \
    CMASK(C0,C1,t); \
    { float a=MX3(C0[0],C0[1],C1[0]),b=MX3(C0[2],C0[3],C1[1]); a=MX3(a,C1[2],C1[3]); \
      _Pragma("unroll") for(int r=4;r<16;r+=4){a=MX3(a,C0[r],C0[r+1]);b=MX3(b,C0[r+2],C0[r+3]);a=MX3(a,C1[r],C1[r+1]);b=MX3(b,C1[r+2],C1[r+3]);} \
      float rm=__builtin_fmaxf(a,b); { auto rr=__builtin_amdgcn_permlane32_swap(__float_as_uint(rm),__float_as_uint(rm),false,false); rm=__builtin_fmaxf(__uint_as_float(rr[0]),__uint_as_float(rr[1])); } \
      resc=false; \
      if(__builtin_expect(__any(rm>(float)THRL),0)){ const float dl=__builtin_fmaxf(rm,0.f); mhat+=dl; \
        _Pragma("unroll") for(int r=0;r<16;++r){C0[r]-=dl;C1[r]-=dl;} \
        _Pragma("unroll") for(int r=0;r<16;++r)negm[r]=fq2-mhat; asm volatile("":"+v"(negm)); \
        const float f=__builtin_amdgcn_exp2f(-dl); l_reg*=f; if(hi==0)wsf[r32]=f; resc=true; } } \
    SBAR(); \
    GAPB(o[0]=__builtin_amdgcn_mfma_f32_32x32x16_bf16(PAF(0),VFR(0),o[0],0,0,0), C0,0); \
    GAPB(o[1]=__builtin_amdgcn_mfma_f32_32x32x16_bf16(PAF(0),VFR(4),o[1],0,0,0), C0,4); \
    KRD(GL,0); GAPB(o[0]=__builtin_amdgcn_mfma_f32_32x32x16_bf16(PAF(1),VFR(1),o[0],0,0,0), C0,8); \
    KRD(GL,1); GAPB(o[1]=__builtin_amdgcn_mfma_f32_32x32x16_bf16(PAF(1),VFR(5),o[1],0,0,0), C0,12); \
    KRD(GL,2); GAPB(o[0]=__builtin_amdgcn_mfma_f32_32x32x16_bf16(PAF(2),VFR(2),o[0],0,0,0), C1,0); \
    KRD(GL,3); GAPB(o[1]=__builtin_amdgcn_mfma_f32_32x32x16_bf16(PAF(2),VFR(6),o[1],0,0,0), C1,4); \
    if(GL){ kf[8]=*(const __attribute__((address_space(3))) bf16x8*)(kpe+sl_next); kf[9]=*(const __attribute__((address_space(3))) bf16x8*)(kpe+sl_next+512); SBAR(); } \
    GAPB(o[0]=__builtin_amdgcn_mfma_f32_32x32x16_bf16(PAF(3),VFR(3),o[0],0,0,0), C1,8); \
    GAPB(o[1]=__builtin_amdgcn_mfma_f32_32x32x16_bf16(PAF(3),VFR(7),o[1],0,0,0), C1,12); \
    }while(0)
  int t=1;
  #undef CMASK
  #define CMASK(P0,P1,t) do{}while(0)
  for(;t+5<NT;t+=2){
    STEP(pB0,pB1,pA0,pA1,t,true,true,true);     WAIT_BARW(); RESC(); ROT();
    STEP(pA0,pA1,pB0,pB1,t+1,true,true,true);   WAIT_BARW(); RESC(); ROT();
  }
  #undef CMASK
  #define CMASK(P0,P1,t) do{int jb_=(t)-(NT-4); if(jb_>=0)cmask(P0,P1,jb_,qrel,hi);}while(0)
  #define ENDW(tt) do{ if((tt)+3<NT){WAIT_BARW();} else if((tt)+2<NT){WAIT_BAR(1);} else {WAIT_BAR(0);} }while(0)
  for(;t+1<NT;t+=2){
    STEP(pB0,pB1,pA0,pA1,t,(t+3<NT),(t+1<NT),(t+1<NT));       ENDW(t);   RESC(); ROT();
    STEP(pA0,pA1,pB0,pB1,t+1,(t+4<NT),(t+2<NT),(t+2<NT));     ENDW(t+1); RESC(); ROT();
  }
  STEP(pB0,pB1,pA0,pA1,NT-1,false,false,false); RESC();
  { float sacc=pB0[0]+pB0[1]; _Pragma("unroll") for(int r=2;r<16;++r)sacc+=pB0[r]; _Pragma("unroll") for(int r=0;r<16;++r)sacc+=pB1[r]; l_reg+=sacc;
    pw0=(u32x4){PKW(pB0,0),PKW(pB0,2),PKW(pB0,4),PKW(pB0,6)};pw1=(u32x4){PKW(pB0,8),PKW(pB0,10),PKW(pB0,12),PKW(pB0,14)};pw2=(u32x4){PKW(pB1,0),PKW(pB1,2),PKW(pB1,4),PKW(pB1,6)};pw3=(u32x4){PKW(pB1,8),PKW(pB1,10),PKW(pB1,12),PKW(pB1,14)};
    SBAR(); pv(o,vb0+sl_cur,PAF(0),PAF(1),PAF(2),PAF(3)); }
  #undef PKW
  #undef PAF
  #undef VFR
  #undef PIN
  #undef MX3
  #undef GAPA
  #undef GAPB
  #undef EX
  #undef VRD
  #undef KRD
  #undef STEP
  #undef ENDW
  {auto rr=__builtin_amdgcn_permlane32_swap(__float_as_uint(l_reg),__float_as_uint(l_reg),false,false);l_reg=__uint_as_float(rr[0])+__uint_as_float(rr[1]);}
  if(hi==0)wsf[32+r32]=l_reg;asm volatile("s_waitcnt lgkmcnt(0)":::"memory");
  float rli[16];
  #pragma unroll
  for(int r=0;r<16;++r)rli[r]=__builtin_amdgcn_rcpf(wsf[32+crow(r,hi)]);
  bf16*Ow=O+(rowbase+q0+wid*QBLK)*DM+h*D;
  { bf16*stg=(bf16*)(shm+LDS_OST)+wid*2048;
    #pragma unroll
    for(int r=0;r<16;++r){const int orow=crow(r,hi);
      #pragma unroll
      for(int d0=0;d0<2;++d0)stg[orow*64+d0*32+r32]=__float2bfloat16(o[d0][r]*rli[r]);}
    asm volatile("s_waitcnt lgkmcnt(0)":::"memory");
    const bf16*Gw=GT+(rowbase+q0+wid*QBLK)*DM+h*D;
    #pragma unroll
    for(int i=0;i<4;++i){const int row=i*8+(lane>>3),ch=lane&7; u32x4 v=*(const u32x4*)(stg+row*64+ch*8); const u32x4 gg=*(const u32x4*)(Gw+(long)row*DM+ch*8);
      #pragma unroll
      for(int j=0;j<4;++j){ v[j]=cvtpk_s(__uint_as_float(v[j]<<16)*__uint_as_float(gg[j]<<16),__uint_as_float(v[j]&0xffff0000u)*__uint_as_float(gg[j]&0xffff0000u)); }
      ATTN_STORE16(Ow+(long)row*DM+ch*8,v);} }
  asm volatile("s_waitcnt lgkmcnt(0)\n\ts_barrier":::"memory");
  #undef DMA_K
  #undef DMA_V
  #undef CMASK
  #undef START
  #undef RESC
  #undef ROT
}
constexpr int ATTN_LDS_BYTES=LDS_BYTES;
struct AttnTensors { const bf16* Q; const bf16* K; const bf16* V; bf16* O; const bf16* GT; const unsigned char* G3; const float* qgain; float kbound; };
struct AttnUnit { int bh; int qb; };
struct StaticOrder {
  int vcu;
  __device__ __forceinline__ explicit StaticOrder(int grid,int block):vcu((block%8)*(grid/8)+block/8){}
  __device__ __forceinline__ bool next(int i,AttnUnit&u)const{ if(i>=4)return false; const int s=vcu&7; u.bh=vcu>>3; u.qb=(i==0)?s:(i==1)?15-s:(i==2)?16+s:31-s; return true; }
  __device__ __forceinline__ void a_ready(const AttnUnit&)const{}
  __device__ __forceinline__ void done(const AttnUnit&)const{}
};
template<class Sched,int THRL=8> __device__ __forceinline__ void attn_phase(char*lds,const AttnTensors&T,const Sched&S,const int tid_in){
  AttnUnit u;
  for(int i=0;S.next(i,u);++i){ S.a_ready(u); attn_unit<THRL>(u.bh/NHEAD,u.bh%NHEAD,u.qb,T.Q,T.K,T.V,T.O,T.GT,T.G3,T.qgain,T.kbound,lds,tid_in); S.done(u); }
}
#undef SBAR
#undef WAIT_BAR
#undef WAIT_BARW
}
constexpr int NWAVES = 8;
constexpr int BATCH = 2, T = 8192, D = 1024, H = 16, HD = 64, FF = 4096, M = BATCH * T;
constexpr int N1 = 3584, K1 = 2048, NP2 = 3072;
constexpr size_t MiB = 1u << 20;
constexpr size_t WS_MOD = 0;
constexpr size_t WS_W1 = 1 * MiB;
constexpr size_t WS_W2A = 29 * MiB;
constexpr size_t WS_W2G = 32 * MiB;
constexpr size_t WS_WO = 33 * MiB;
constexpr size_t WS_WKV = 37 * MiB;
constexpr size_t WS_WQG = 42 * MiB;
constexpr size_t WS_WO2 = 50 * MiB;
constexpr size_t WS_WUP = 54 * MiB, WS_WDN = 62 * MiB;
constexpr size_t WS_G3 = 70 * MiB;
constexpr size_t WS_FL = 74 * MiB;
constexpr size_t WS_H2 = 76 * MiB;
constexpr size_t WS_P1 = 140 * MiB;
constexpr size_t WS_P2 = 252 * MiB;
constexpr size_t WS_VF = 348 * MiB;
constexpr size_t WS_HB = 140 * MiB;
constexpr size_t WS_KVRAW = 140 * MiB, WS_QB = 204 * MiB, WS_GT = 236 * MiB, WS_VS = 316 * MiB, WS_KS = 348 * MiB;
constexpr size_t WS_END = 380 * MiB;
constexpr int LDS_BYTES = 147456;

#define GAS __attribute__((address_space(1)))
#define LAS __attribute__((address_space(3)))
typedef unsigned short bf16;
typedef unsigned v4u __attribute__((ext_vector_type(4)));
typedef unsigned v2u __attribute__((ext_vector_type(2)));
typedef float f32x4 __attribute__((ext_vector_type(4)));
using pg8::pkbf; using pg8::bflo; using pg8::bfhi; using pg8::sigm;

struct Args { const float* in[39]; float* out; unsigned char* ws; int ph_lo, ph_hi; };

struct Frame { LAS unsigned char* lds; int tid, lane, wave, vcu, G, bx; unsigned char* ws; float* out; const float* const* in; };

__device__ __forceinline__ void tr_item(const float* W, int ldw, int Nvalid, bf16* WT, int ldt, int row_off, int col_off, const float* mu, LAS float* scr, int item, int lane) {
    const int nblk = (Nvalid + 31) / 32, kb = item / nblk, nb = item % nblk, k0 = 64 * kb, n0 = 32 * nb;
#pragma unroll 8
    for (int i = 0; i < 32; ++i) { const int kk = 2 * i + (lane >> 5), n = n0 + (lane & 31); scr[kk * 33 + (lane & 31)] = n < Nvalid ? W[(size_t)(k0 + kk) * ldw + n] : 0.f; }
    asm volatile("s_waitcnt lgkmcnt(0)" ::: "memory");
    const int c = lane & 7;
    float s0[8], s1[8];
#pragma unroll
    for (int q = 0; q < 8; ++q) { const float m = mu ? mu[k0 + 8 * c + q] : 0.f; s0[q] = 1.f - m; s1[q] = m; }
#pragma unroll
    for (int j = 0; j < 4; ++j) { const int n = (lane >> 3) + 8 * j; const LAS float* s = scr + (8 * c) * 33 + n;
        float v[8];
#pragma unroll
        for (int q = 0; q < 8; ++q) v[q] = s[q * 33];
        v4u o; o.x = pkbf(v[0] * s0[0], v[1] * s0[1]); o.y = pkbf(v[2] * s0[2], v[3] * s0[3]); o.z = pkbf(v[4] * s0[4], v[5] * s0[5]); o.w = pkbf(v[6] * s0[6], v[7] * s0[7]);
        bf16* dst = WT + (size_t)(row_off + n0 + n) * ldt + col_off + k0 + 8 * c;
        *(v4u*)dst = o;
        if (mu) { v4u p; p.x = pkbf(v[0] * s1[0], v[1] * s1[1]); p.y = pkbf(v[2] * s1[2], v[3] * s1[3]); p.z = pkbf(v[4] * s1[4], v[5] * s1[5]); p.w = pkbf(v[6] * s1[6], v[7] * s1[7]); *(v4u*)(dst + 1024) = p; } }
    asm volatile("s_waitcnt lgkmcnt(0)" ::: "memory");
}
__device__ __forceinline__ float dpp_f(float x, const int ctrl_sel) {
    switch (ctrl_sel) {
        case 0: return __builtin_bit_cast(float, __builtin_amdgcn_update_dpp(0, __builtin_bit_cast(int, x), 0xB1, 0xf, 0xf, false));
        case 1: return __builtin_bit_cast(float, __builtin_amdgcn_update_dpp(0, __builtin_bit_cast(int, x), 0x4E, 0xf, 0xf, false));
        case 2: return __builtin_bit_cast(float, __builtin_amdgcn_update_dpp(0, __builtin_bit_cast(int, x), 0x141, 0xf, 0xf, false));
        default: return __builtin_bit_cast(float, __builtin_amdgcn_update_dpp(0, __builtin_bit_cast(int, x), 0x140, 0xf, 0xf, false));
    }
}
__device__ __forceinline__ float sum4(float x) { x += dpp_f(x, 0); x += dpp_f(x, 1); return x; }
__device__ __forceinline__ float sum8(float x) { x = sum4(x); x += dpp_f(x, 2); return x; }
__device__ __forceinline__ float sum16(float x) { x = sum8(x); x += dpp_f(x, 3); return x; }
__device__ __forceinline__ float wave_sum(float v) {
    v = sum16(v);
    { auto rr = __builtin_amdgcn_permlane16_swap(__float_as_uint(v), __float_as_uint(v), false, false); v = __uint_as_float(rr[0]) + __uint_as_float(rr[1]); }
    { auto rr = __builtin_amdgcn_permlane32_swap(__float_as_uint(v), __float_as_uint(v), false, false); v = __uint_as_float(rr[0]) + __uint_as_float(rr[1]); }
    return v;
}
__device__ __forceinline__ void norm_row(const float* xrow, const float* g, const float* sh, const float* sc, int lane, f32x4 (&v)[4]) {
    float s = 0.f;
#pragma unroll
    for (int j = 0; j < 4; ++j) { v[j] = *((const f32x4*)xrow + lane + 64 * j); s += (v[j].x * v[j].x + v[j].y * v[j].y) + (v[j].z * v[j].z + v[j].w * v[j].w); }
    const float rstd = 1.0f / sqrtf(wave_sum(s) * (1.f / D) + 1e-6f);
#pragma unroll
    for (int j = 0; j < 4; ++j) { const f32x4 gg = *((const f32x4*)g + lane + 64 * j);
        f32x4 a = {1.f, 1.f, 1.f, 1.f}, b = {0.f, 0.f, 0.f, 0.f}; if (sc) { a = *((const f32x4*)sc + lane + 64 * j) + 1.0f; b = *((const f32x4*)sh + lane + 64 * j); }
        v[j] = (v[j] * rstd * gg) * a + b; }
}
__device__ __forceinline__ void st_row_bf16(bf16* orow, int lane, const f32x4 (&v)[4]) {
#pragma unroll
    for (int j = 0; j < 4; ++j) { v2u w; w.x = pkbf(v[j].x, v[j].y); w.y = pkbf(v[j].z, v[j].w); *((v2u*)orow + lane + 64 * j) = w; }
}
__device__ __forceinline__ void p0_mod(Frame& F) {
    LAS float* ca = (LAS float*)F.lds; LAS float* red = (LAS float*)(F.lds + 8192);
    const float* cin = F.in[1];
    for (int i = F.tid; i < 2048; i += 512) { const float c = cin[i]; ca[i] = c / (1.0f + __expf(-c)); }
    __syncthreads();
    float* MOD = (float*)(F.ws + WS_MOD); float* MODKV = MOD + 4 * 2 * 6144;
    for (int item = F.bx; item < 208; item += F.G) {
        const int col = item * 128; const float* W; const float* bias; int ldw, cw; float* dst0; float* dst1;
        if (col < 24576) { const int l = col / 6144; cw = col % 6144; W = F.in[2] + (size_t)l * 1024 * 6144; ldw = 6144; bias = F.in[3] + l * 6144; dst0 = MOD + (l * 2 + 0) * 6144 + cw; dst1 = MOD + (l * 2 + 1) * 6144 + cw; }
        else { cw = col - 24576; W = F.in[30]; ldw = 2048; bias = F.in[31]; dst0 = MODKV + cw; dst1 = MODKV + 2048 + cw; }
        const int c4 = F.tid & 31, ks = F.tid >> 5;
        f32x4 a0 = {0.f, 0.f, 0.f, 0.f}, a1 = {0.f, 0.f, 0.f, 0.f};
#pragma unroll 8
        for (int k = ks * 64; k < ks * 64 + 64; ++k) { const f32x4 w = *(const f32x4*)(W + (size_t)k * ldw + cw + c4 * 4); a0 += w * ca[k]; a1 += w * ca[1024 + k]; }
        *(LAS f32x4*)(red + (ks * 32 + c4) * 8) = a0; *(LAS f32x4*)(red + (ks * 32 + c4) * 8 + 4) = a1;
        __syncthreads();
        if (F.tid < 256) { const int b = F.tid >> 7, c = F.tid & 127; float s = 0.f;
#pragma unroll
            for (int q = 0; q < 16; ++q) s += red[(q * 32 + (c >> 2)) * 8 + b * 4 + (c & 3)];
            (b ? dst1 : dst0)[c] = s + bias[cw + c]; }
        __syncthreads();
    }
}
__device__ __forceinline__ void p0_weights(Frame& F) {
    LAS float* scr = (LAS float*)(F.lds + 16384 + F.wave * 16384);
    const int gw = F.vcu * NWAVES + F.wave, NGW = F.G * NWAVES;
    bf16* W1 = (bf16*)(F.ws + WS_W1); bf16* WO = (bf16*)(F.ws + WS_WO); bf16* WKV = (bf16*)(F.ws + WS_WKV); bf16* WQG = (bf16*)(F.ws + WS_WQG); bf16* WO2 = (bf16*)(F.ws + WS_WO2);
    const float* mu = F.in[8];
    constexpr int PL = 512 * 3 + 32 + 32 + 16 + 80 + 512;
    constexpr int NIT = 2 * PL + 512 + 512 + 16 + 2 * (1024 + 512);
    for (int it = gw; it < NIT; it += NGW) {
        int r = it;
        if (r < 2 * PL) { const int i = r / PL; r -= i * PL; bf16* w1 = W1 + (size_t)i * N1 * K1; const float* m6 = mu + i * 6 * 1024;
            bf16* wl = w1 + (size_t)3072 * 1024;
            if (r < 512) { tr_item(F.in[9] + (size_t)i * D * D, D, D, w1, D, 0, 0, nullptr, scr, r, F.lane); continue; } r -= 512;
            if (r < 512) { tr_item(F.in[10] + (size_t)i * D * D, D, D, w1, D, 1024, 0, nullptr, scr, r, F.lane); continue; } r -= 512;
            if (r < 512) { tr_item(F.in[11] + (size_t)i * D * D, D, D, w1, D, 2048, 0, nullptr, scr, r, F.lane); continue; } r -= 512;
            if (r < 32) { tr_item(F.in[14] + (size_t)i * D * 64, 64, 64, wl, K1, 0, 0, m6 + 1 * 1024, scr, r, F.lane); continue; } r -= 32;
            if (r < 32) { tr_item(F.in[17] + (size_t)i * D * 64, 64, 64, wl, K1, 64, 0, m6 + 4 * 1024, scr, r, F.lane); continue; } r -= 32;
            if (r < 16) { if (i == 1) tr_item(F.in[27], 32, 32, wl, K1, 128, 0, m6 + 3 * 1024, scr, r, F.lane); continue; } r -= 16;
            if (r < 80) { tr_item(F.in[19] + (size_t)i * D * 160, 160, 160, wl, K1, 160, 0, m6 + 5 * 1024, scr, r, F.lane); continue; } r -= 80;
            tr_item(F.in[12] + (size_t)i * D * D, D, D, WO + (size_t)i * D * D, D, 0, 0, nullptr, scr, r, F.lane); continue; }
        r -= 2 * PL;
        if (r < 512) { tr_item(F.in[32], 2064, 1024, WKV, D, 0, 0, nullptr, scr, r, F.lane); continue; } r -= 512;
        if (r < 512) { tr_item(F.in[32] + 1024, 2064, 1024, WKV, D, 1024, 0, nullptr, scr, r, F.lane); continue; } r -= 512;
        if (r < 16) { tr_item(F.in[32] + 2048, 2064, 16, WKV, D, 2048, 0, nullptr, scr, r, F.lane); continue; } r -= 16;
        { const int j = r / 1536; r -= j * 1536;
          if (r < 1024) tr_item(F.in[35] + (size_t)j * D * 2048, 2048, 2048, WQG + (size_t)j * 2048 * D, D, 0, 0, nullptr, scr, r, F.lane);
          else tr_item(F.in[37] + (size_t)j * D * D, D, D, WO2 + (size_t)j * D * D, D, 0, 0, nullptr, scr, r - 1024, F.lane); }
    }
    const int gt = F.bx * 512 + F.tid, NT = F.G * 512; const v4u z = {0u, 0u, 0u, 0u};
    for (int e = gt; e < 135168; e += NT) {
        int r = e; bf16* p;
        if (r < 98304) { const int i = r / 49152; r -= i * 49152; p = W1 + (size_t)i * N1 * K1 + (size_t)3072 * 1024 + (size_t)320 * K1 + (size_t)r * 8; }
        else if (r < 98304 + 8192) { r -= 98304; p = W1 + (size_t)3072 * 1024 + (size_t)128 * K1 + (size_t)r * 8; }
        else { r -= 98304 + 8192; p = WKV + (size_t)2080 * D + (size_t)r * 8; }
        *(v4u*)p = z; }
    { float* B2 = (float*)(F.ws + WS_MOD) + 53248;
      for (int e = gt; e < 2 * 3072; e += NT) { const int i = e / 3072, n = e % 3072, grp = n >> 10, c = n & 1023;
          B2[e] = grp == 0 ? F.in[13][i * D + c] : (grp == 1 ? F.in[16][i * D + c] : (i == 1 ? F.in[26][c] : 0.f)); } }
    bf16* W2A = (bf16*)(F.ws + WS_W2A); bf16* W2G = (bf16*)(F.ws + WS_W2G);
    for (int e = gt; e < 2 * 1048576; e += NT) {
        const int i = e >> 20; int r = e & 1048575;
        if (r < 786432) { const int k = r / 3072, n = r % 3072, grp = n >> 10, c = n & 1023; float v = 0.f;
            if (grp == 0) { if (k < 64) v = F.in[15][((size_t)i * 64 + k) * 1024 + c]; }
            else if (grp == 1) { if (k >= 64 && k < 128) v = F.in[18][((size_t)i * 64 + (k - 64)) * 1024 + c]; }
            else { if (i == 1 && k >= 128 && k < 160) v = F.in[28][(size_t)(k - 128) * 1024 + c]; }
            W2A[(size_t)i * 3072 * 256 + (size_t)n * 256 + k] = (bf16)(pkbf(v, 0.f) & 0xffffu); }
        else { r -= 786432; const int k = r >> 10, n = r & 1023; const float v = k < 160 ? F.in[20][((size_t)i * 160 + k) * 1024 + n] : 0.f;
            W2G[(size_t)i * 1024 * 256 + (size_t)n * 256 + k] = (bf16)(pkbf(v, 0.f) & 0xffffu); }
    }
}
__device__ __forceinline__ void mlp_weights(Frame& F, int L) {
    LAS float* scr = (LAS float*)(F.lds + F.wave * 16384);
    const int gw = F.vcu * NWAVES + F.wave, NGW = F.G * NWAVES;
    bf16* WUP = (bf16*)(F.ws + WS_WUP); bf16* WDN = (bf16*)(F.ws + WS_WDN);
    for (int it = gw; it < 4096; it += NGW) {
        if (it < 2048) tr_item(F.in[6] + (size_t)L * D * FF, FF, FF, WUP, D, 0, 0, nullptr, scr, it, F.lane);
        else tr_item(F.in[7] + (size_t)L * FF * D, D, D, WDN, FF, 0, 0, nullptr, scr, it - 2048, F.lane);
    }
}
__device__ __forceinline__ void norm_phase(Frame& F, const float* xin, const float* g, const float* sh, const float* sc, int bstride, int mode, bf16* dst) {
    const int gw = F.vcu * NWAVES + F.wave, NGW = F.G * NWAVES;
    for (int m = gw; m < M; m += NGW) {
        const int b = m >> 13; f32x4 v[4];
        norm_row(xin + (size_t)m * D, g, sh ? sh + b * bstride : nullptr, sc ? sc + b * bstride : nullptr, F.lane, v);
        if (mode == 0) {
            st_row_bf16(dst + (size_t)m * 2048, F.lane, v);
            if ((m & 8191) != 8191) st_row_bf16(dst + (size_t)(m + 1) * 2048 + 1024, F.lane, v);
            if ((m & 8191) == 0) { const v2u z = {0u, 0u};
#pragma unroll
                for (int j = 0; j < 4; ++j) *((v2u*)(dst + (size_t)m * 2048 + 1024) + F.lane + 64 * j) = z; }
        } else st_row_bf16(dst + (size_t)m * 1024, F.lane, v);
    }
}
__device__ __forceinline__ void norm_mix_phase(Frame& F, const float* xin, const float* g, const float* sh, const float* sc, const float* mu, bf16* H2p, bf16* XJ) {
    const int gw = F.vcu * NWAVES + F.wave, NGW = F.G * NWAVES, lane = F.lane;
    for (int base = gw * 8; base < M; base += NGW * 8) {
        const int b = base >> 13;
        f32x4 gg[4], aa[4], bb[4], m0[4], m1[4], m2[4];
#pragma unroll
        for (int j = 0; j < 4; ++j) { gg[j] = *((const f32x4*)g + lane + 64 * j); aa[j] = *((const f32x4*)(sc + b * 6144) + lane + 64 * j) + 1.0f; bb[j] = *((const f32x4*)(sh + b * 6144) + lane + 64 * j);
            m0[j] = *((const f32x4*)mu + lane + 64 * j); m1[j] = *((const f32x4*)(mu + 2048) + lane + 64 * j); m2[j] = *((const f32x4*)(mu + 3072) + lane + 64 * j); }
        const bool first = (base & 8191) == 0; const int r0 = first ? 0 : -1;
        f32x4 hp[4], xn[4];
#pragma unroll
        for (int j = 0; j < 4; ++j) { hp[j] = (f32x4){0.f, 0.f, 0.f, 0.f}; xn[j] = *((const f32x4*)(xin + (size_t)(base + r0) * D) + lane + 64 * j); }
#pragma unroll 1
        for (int r = r0; r < 8; ++r) { const int m = base + r; f32x4 v[4];
            float s = 0.f;
#pragma unroll
            for (int j = 0; j < 4; ++j) { v[j] = xn[j]; s += (v[j].x * v[j].x + v[j].y * v[j].y) + (v[j].z * v[j].z + v[j].w * v[j].w); }
            if (r + 1 < 8) {
#pragma unroll
                for (int j = 0; j < 4; ++j) xn[j] = *((const f32x4*)(xin + (size_t)(m + 1) * D) + lane + 64 * j); }
            const float rstd = 1.0f / sqrtf(wave_sum(s) * (1.f / D) + 1e-6f);
#pragma unroll
            for (int j = 0; j < 4; ++j) v[j] = (v[j] * rstd * gg[j]) * aa[j] + bb[j];
            if (r >= 0) {
                st_row_bf16(H2p + (size_t)m * 2048, lane, v); st_row_bf16(H2p + (size_t)m * 2048 + 1024, lane, hp);
                f32x4 x[4];
#pragma unroll
                for (int j = 0; j < 4; ++j) x[j] = v[j] + (hp[j] - v[j]) * m0[j];
                st_row_bf16(XJ + (size_t)m * D, lane, x);
#pragma unroll
                for (int j = 0; j < 4; ++j) x[j] = v[j] + (hp[j] - v[j]) * m1[j];
                st_row_bf16(XJ + (size_t)M * D + (size_t)m * D, lane, x);
#pragma unroll
                for (int j = 0; j < 4; ++j) x[j] = v[j] + (hp[j] - v[j]) * m2[j];
                st_row_bf16(XJ + (size_t)2 * M * D + (size_t)m * D, lane, x);
            }
#pragma unroll
            for (int j = 0; j < 4; ++j) hp[j] = v[j]; }
    }
}
__device__ __forceinline__ void final_norm_phase(Frame& F) {
    const int gw = F.vcu * NWAVES + F.wave, NGW = F.G * NWAVES;
    for (int m = gw; m < M; m += NGW) { f32x4 v[4]; norm_row(F.out + (size_t)m * D, F.in[38], nullptr, nullptr, F.lane, v);
#pragma unroll
        for (int j = 0; j < 4; ++j) *((f32x4*)(F.out + (size_t)m * D) + F.lane + 64 * j) = v[j]; }
}
#ifndef PROBE_SC
#define PROBE_SC 0
#endif
constexpr int SC_C = 32, SC_NC = T / SC_C;
constexpr int SC_VEC = 0, SC_SCAL = 36864, SC_V = 37120, SC_Y = 38144, SC_BUF = 54528;
typedef float f32x2s __attribute__((ext_vector_type(2)));
__device__ __forceinline__ float dot4(const f32x4 s, const f32x4 a) { f32x2s t = (f32x2s){s.x, s.y} * (f32x2s){a.x, a.y}; t = (f32x2s){s.z, s.w} * (f32x2s){a.z, a.w} + t; return t.x + t.y; }
__device__ __forceinline__ void scan_chunk(const LAS unsigned char* Bc, f32x4& S, const int kq, const int rowi) {
                const LAS f32x4* pvec = (const LAS f32x4*)(Bc + SC_VEC) + kq; const LAS f32x4* psc = (const LAS f32x4*)(Bc + SC_SCAL);
                const LAS float* pv = (const LAS float*)(Bc + SC_V) + rowi; LAS float* py = (LAS float*)(Bc + SC_Y) + rowi * 16 + kq;
                f32x4 cv[9], cs; float c0, c1;
#pragma unroll
                for (int j = 0; j < 9; ++j) cv[j] = pvec[j * 16];
                cs = psc[0]; c0 = pv[0]; c1 = pv[8];
#pragma unroll
                for (int p = 0; p < SC_C / 2; ++p) {
                    f32x4 nv[9], ns; float n0, n1;
                    if (p + 1 < SC_C / 2) {
#pragma unroll
                        for (int j = 0; j < 9; ++j) nv[j] = pvec[((p + 1) * 9 + j) * 16];
                        ns = psc[p + 1]; n0 = pv[(2 * p + 2) * 8]; n1 = pv[(2 * p + 3) * 8];
                    }
                    float p1 = dot4(S, cv[0]), p2 = dot4(S, cv[1]); const float p3 = dot4(S, cv[2]);
                    p1 += dpp_f(p1, 0); p2 += dpp_f(p2, 0);
                    p1 += dpp_f(p1, 1); p2 += dpp_f(p2, 1);
                    p1 += dpp_f(p1, 2); p2 += dpp_f(p2, 2);
                    p1 += dpp_f(p1, 3); p2 += dpp_f(p2, 3);
                    const float sa1 = fmaf(c0, cs.w, p2);
                    const float y0 = p3 + ((kq == 0) ? c0 * cs.y : 0.f);
                    const f32x4 t0 = S * cv[3] + cv[4] * p1 + cv[5] * c0 + cv[7] * c1;
                    S = t0 + cv[6] * sa1;
                    const float y1 = dot4(S, cv[8]);
                    py[(2 * p) * 128] = y0; py[(2 * p + 1) * 128] = y1;
                    if (p + 1 < SC_C / 2) {
#pragma unroll
                        for (int j = 0; j < 9; ++j) cv[j] = nv[j];
                        cs = ns; c0 = n0; c1 = n1;
                    }
                }
}
__device__ __forceinline__ void scan_phase(Frame& F, int L) {
    const bf16* P1 = (const bf16*)(F.ws + WS_P1); const bf16* P2 = (const bf16*)(F.ws + WS_P2); const bf16* VF = (const bf16*)(F.ws + WS_VF); float* Y = (float*)(F.ws + WS_H2);
    const float* kkw = F.in[21] + L * D; const float* kaw = F.in[22] + L * D;
    const int lane = F.lane;
    int wave;
    { LAS unsigned* tb = (LAS unsigned*)(F.lds + LDS_BYTES - 2048);
      const unsigned simd = ((unsigned)__builtin_amdgcn_s_getreg((1 << 11) | (4 << 6) | 4)) & 3u;
      if (lane == 0) tb[F.wave] = simd;
      __syncthreads();
      unsigned sd[8];
#pragma unroll
      for (int w = 0; w < 8; ++w) sd[w] = tb[w];
      int B = 1;
#pragma unroll
      for (int w = 7; w >= 1; --w) if (sd[w] != sd[0]) B = w;
      int total_non = 0, non_before = 0, share_before = 0; bool my_share = false;
#pragma unroll
      for (int w = 1; w < 8; ++w) { const bool sh = (sd[w] == sd[0]) || (sd[w] == sd[B]); const bool other = (w != B);
          if (other && !sh) { ++total_non; if (w < F.wave) ++non_before; }
          if (other && sh && w < F.wave) ++share_before;
          if (w == F.wave) my_share = sh; }
      int role;
      if (F.wave == 0) role = 0; else if (F.wave == B) role = 1; else role = my_share ? (2 + total_non + share_before) : (2 + non_before);
      wave = __builtin_amdgcn_readfirstlane(role);
      __syncthreads(); }
    for (int item = F.bx; item < 256; item += F.G) {
        const int bh = (item & 7) + 8 * (item >> 6), rg = (item >> 3) & 7, b = bh >> 4, h = bh & 15;
        const size_t m0 = (size_t)b * T;
        const int hidx = (wave - 2) * 64 + lane, hp = (hidx >> 4) & 15, hc4 = hidx & 15;
        const int vtt = lane >> 1, vr4 = (lane & 1) * 4;
        float ckk[4], cka[4];
        v2u lr[2][2], lk[2][2], lw[2][2], la[2][2]; v2u lv[2], lvm[2], lvf[2];
#pragma unroll
        for (int q = 0; q < 2; ++q) { lv[q] = (v2u){0u,0u}; lvm[q] = (v2u){0u,0u}; lvf[q] = (v2u){0u,0u};
#pragma unroll
            for (int u = 0; u < 2; ++u) { lr[q][u] = (v2u){0u,0u}; lk[q][u] = (v2u){0u,0u}; lw[q][u] = (v2u){0u,0u}; la[q][u] = (v2u){0u,0u}; } }
        if (wave >= 2 && wave < 6) {
#pragma unroll
            for (int j = 0; j < 4; ++j) { ckk[j] = kkw[h * 64 + hc4 * 4 + j]; cka[j] = kaw[h * 64 + hc4 * 4 + j]; } }
#define SC_LOAD(c, Q) do { \
        if (wave >= 2 && wave < 6) { _Pragma("unroll") for (int u = 0; u < 2; ++u) { const size_t m = m0 + (size_t)(c) * SC_C + 2 * hp + u; const bf16* p1 = P1 + m * N1 + h * 64 + hc4 * 4; const bf16* p2 = P2 + m * NP2 + h * 64 + hc4 * 4; \
            lr[Q][u] = *(const v2u*)p1; lk[Q][u] = *(const v2u*)(p1 + 1024); lw[Q][u] = *(const v2u*)p2; la[Q][u] = *(const v2u*)(p2 + 1024); } } \
        else if (wave == 6) { const size_t m = m0 + (size_t)(c) * SC_C + vtt; const int cc = h * 64 + rg * 8 + vr4; \
            lv[Q] = *(const v2u*)(P1 + m * N1 + 2048 + cc); if (L == 1) { lvm[Q] = *(const v2u*)(P2 + m * NP2 + 2048 + cc); lvf[Q] = *(const v2u*)(VF + m * D + cc); } } } while (0)
#define SC_PREP(buf, Q) do { LAS unsigned char* B_ = F.lds + (buf) * SC_BUF; \
        if (wave >= 2 && wave < 6) { f32x4 an[2], bb[2], k2[2], ww[2], rr[2]; \
            _Pragma("unroll") for (int u = 0; u < 2; ++u) { \
                const float kr[4] = {bflo(lk[Q][u].x), bfhi(lk[Q][u].x), bflo(lk[Q][u].y), bfhi(lk[Q][u].y)}, av[4] = {bflo(la[Q][u].x), bfhi(la[Q][u].x), bflo(la[Q][u].y), bfhi(la[Q][u].y)}; \
                const float wn[4] = {bflo(lw[Q][u].x), bfhi(lw[Q][u].x), bflo(lw[Q][u].y), bfhi(lw[Q][u].y)}, rv[4] = {bflo(lr[Q][u].x), bfhi(lr[Q][u].x), bflo(lr[Q][u].y), bfhi(lr[Q][u].y)}; \
                float kv_[4], ss = 0.f; \
                _Pragma("unroll") for (int j = 0; j < 4; ++j) { kv_[j] = kr[j] * ckk[j]; ss += kv_[j] * kv_[j]; } \
                ss = sum16(ss); const float inv = 1.0f / fmaxf(sqrtf(ss), 1e-12f); \
                _Pragma("unroll") for (int j = 0; j < 4; ++j) { const float kk = kv_[j] * inv; an[u][j] = -kk; bb[u][j] = kk * av[j]; k2[u][j] = kr[j] * (1.0f + (av[j] - 1.0f) * cka[j]); ww[u][j] = __expf(wn[j]); rr[u][j] = rv[j]; } } \
            LAS f32x4* V_ = (LAS f32x4*)(B_ + SC_VEC) + (hp * 9) * 16 + hc4; \
            float s0 = dot4(bb[0], rr[0]), s1 = dot4(k2[0], rr[0]), s2 = dot4(bb[0], an[1]), s3 = dot4(k2[0], an[1]); \
            s0 = sum16(s0); s1 = sum16(s1); s2 = sum16(s2); s3 = sum16(s3); \
            V_[0 * 16] = an[0]; V_[1 * 16] = ww[0] * an[1] + an[0] * s2; V_[2 * 16] = ww[0] * rr[0] + an[0] * s0; V_[3 * 16] = ww[0] * ww[1]; V_[4 * 16] = bb[0] * ww[1]; V_[5 * 16] = k2[0] * ww[1]; V_[6 * 16] = bb[1]; V_[7 * 16] = k2[1]; V_[8 * 16] = rr[1]; \
            if (hc4 == 0) *(LAS f32x4*)(B_ + SC_SCAL + hp * 16) = (f32x4){s0, s1, s2, s3}; } \
        else if (wave == 6) { float v_[4] = {bflo(lv[Q].x), bfhi(lv[Q].x), bflo(lv[Q].y), bfhi(lv[Q].y)}; \
            if (L == 1) { const float f_[4] = {bflo(lvf[Q].x), bfhi(lvf[Q].x), bflo(lvf[Q].y), bfhi(lvf[Q].y)}, g_[4] = {bflo(lvm[Q].x), bfhi(lvm[Q].x), bflo(lvm[Q].y), bfhi(lvm[Q].y)}; \
                _Pragma("unroll") for (int j = 0; j < 4; ++j) v_[j] = v_[j] + (f_[j] - v_[j]) * g_[j]; } \
            *(LAS f32x4*)(B_ + SC_V + (vtt * 8 + vr4) * 4) = (f32x4){v_[0], v_[1], v_[2], v_[3]}; } } while (0)
#define SC_YRED(bufi) f32x4 yv; do { const LAS f32x4* q_ = (const LAS f32x4*)(F.lds + (bufi) * SC_BUF + SC_Y) + (vtt * 8 + vr4) * 4; \
            _Pragma("unroll") for (int r_ = 0; r_ < 4; ++r_) { const f32x4 t0 = q_[r_ * 4], t1 = q_[r_ * 4 + 1], t2 = q_[r_ * 4 + 2], t3 = q_[r_ * 4 + 3]; const f32x4 t = (t0 + t1) + (t2 + t3); yv[r_] = (t.x + t.y) + (t.z + t.w); } } while (0)
        SC_LOAD(0, 0); SC_PREP(0, 0); SC_LOAD(1, 1);
        __syncthreads();
        f32x4 S = {0.f, 0.f, 0.f, 0.f};
        const int rl = lane >> 4, kq = lane & 15, rowi = (wave & 1) * 4 + rl;
#define SC_ITER(c, QL, QP) do { const int buf = (c) & 1; \
            if (wave < 2) { if (PROBE_SC == 2) { f32x4 S2 = S; scan_chunk(F.lds + buf * SC_BUF, S2, kq, rowi); asm volatile("" :: "v"(S2) : "memory"); } scan_chunk(F.lds + buf * SC_BUF, S, kq, rowi); } \
            else { if ((c) + 2 < SC_NC) SC_LOAD((c) + 2, QL); \
                if ((c) + 1 < SC_NC) SC_PREP(buf ^ 1, QP); \
                if (PROBE_SC == 1 && (c) + 1 < SC_NC) { asm volatile("" ::: "memory"); SC_PREP(buf ^ 1, QP); } \
                if (wave == 7 && (c) > 0) { SC_YRED(buf ^ 1); *(f32x4*)(Y + (m0 + (size_t)((c) - 1) * SC_C + vtt) * D + h * 64 + rg * 8 + vr4) = yv; } } \
            asm volatile("s_waitcnt lgkmcnt(0)\n\ts_barrier" ::: "memory"); } while (0)
        for (int c = 0; c < SC_NC; c += 2) { SC_ITER(c, 0, 1); SC_ITER(c + 1, 1, 0); }
#undef SC_ITER
        if (wave == 7) { SC_YRED((SC_NC - 1) & 1);
            *(f32x4*)(Y + (m0 + (size_t)(SC_NC - 1) * SC_C + vtt) * D + h * 64 + rg * 8 + vr4) = yv; }
        __syncthreads();
#undef SC_LOAD
#undef SC_PREP
#undef SC_YRED
    }
}
__device__ __forceinline__ void post_phase(Frame& F, int L) {
    const bf16* P1 = (const bf16*)(F.ws + WS_P1); const bf16* P2 = (const bf16*)(F.ws + WS_P2); bf16* VF = (bf16*)(F.ws + WS_VF); float* Y = (float*)(F.ws + WS_H2);
    const int gw = F.vcu * NWAVES + F.wave, NGW = F.G * NWAVES, lane = F.lane, c0 = lane * 16;
    const float* kaw = F.in[22] + L * D + c0; const float* rkw = F.in[23] + L * D + c0; const float* lnw = F.in[24] + L * D + c0; const float* lnb = F.in[25] + L * D + c0;
    for (int m = gw; m < M; m += NGW) {
        float y[16], r[16], k[16], v[16], a[16];
        const float* yp = Y + (size_t)m * D + c0;
#pragma unroll
        for (int q = 0; q < 4; ++q) { const f32x4 t = *(const f32x4*)(yp + 4 * q); y[4 * q] = t.x; y[4 * q + 1] = t.y; y[4 * q + 2] = t.z; y[4 * q + 3] = t.w; }
        const bf16* p1 = P1 + (size_t)m * N1 + c0; const bf16* p2 = P2 + (size_t)m * NP2 + c0;
        v4u rv[2], kv[2], vv[2], av[2];
#pragma unroll
        for (int q = 0; q < 2; ++q) { rv[q] = *(const v4u*)(p1 + 8 * q); kv[q] = *(const v4u*)(p1 + 1024 + 8 * q); vv[q] = *(const v4u*)(p1 + 2048 + 8 * q); av[q] = *(const v4u*)(p2 + 1024 + 8 * q); }
#pragma unroll
        for (int q = 0; q < 2; ++q)
#pragma unroll
            for (int j = 0; j < 4; ++j) { r[8 * q + 2 * j] = bflo(rv[q][j]); r[8 * q + 2 * j + 1] = bfhi(rv[q][j]); k[8 * q + 2 * j] = bflo(kv[q][j]); k[8 * q + 2 * j + 1] = bfhi(kv[q][j]);
                v[8 * q + 2 * j] = bflo(vv[q][j]); v[8 * q + 2 * j + 1] = bfhi(vv[q][j]); a[8 * q + 2 * j] = bflo(av[q][j]); a[8 * q + 2 * j + 1] = bfhi(av[q][j]); }
        if (L == 0) { *(v4u*)(VF + (size_t)m * D + c0) = vv[0]; *(v4u*)(VF + (size_t)m * D + c0 + 8) = vv[1]; }
        else { v4u fv[2], gv[2];
#pragma unroll
            for (int q = 0; q < 2; ++q) { fv[q] = *(const v4u*)(VF + (size_t)m * D + c0 + 8 * q); gv[q] = *(const v4u*)(p2 + 2048 + 8 * q); }
#pragma unroll
            for (int q = 0; q < 2; ++q)
#pragma unroll
                for (int j = 0; j < 4; ++j) { const float f0 = bflo(fv[q][j]), f1 = bfhi(fv[q][j]), g0 = bflo(gv[q][j]), g1 = bfhi(gv[q][j]);
                    v[8 * q + 2 * j] += (f0 - v[8 * q + 2 * j]) * g0; v[8 * q + 2 * j + 1] += (f1 - v[8 * q + 2 * j + 1]) * g1; } }
        float s = 0.f, bd = 0.f;
#pragma unroll
        for (int j = 0; j < 16; ++j) { s += y[j]; const float k2 = k[j] * (1.0f + (a[j] - 1.0f) * kaw[j]); bd += r[j] * k2 * rkw[j]; }
        s = sum4(s); bd = sum4(bd);
        const float mean = s * (1.0f / 64.0f); float q2 = 0.f;
#pragma unroll
        for (int j = 0; j < 16; ++j) { const float d = y[j] - mean; q2 += d * d; }
        q2 = sum4(q2);
        const float rstd = 1.0f / sqrtf(q2 * (1.0f / 64.0f) + 64e-5f);
        float o[16];
#pragma unroll
        for (int j = 0; j < 16; ++j) o[j] = (y[j] - mean) * rstd * lnw[j] + lnb[j] + bd * v[j];
        bf16* yn = (bf16*)(Y + (size_t)m * D) + c0;
        v4u w0, w1; w0.x = pkbf(o[0], o[1]); w0.y = pkbf(o[2], o[3]); w0.z = pkbf(o[4], o[5]); w0.w = pkbf(o[6], o[7]); w1.x = pkbf(o[8], o[9]); w1.y = pkbf(o[10], o[11]); w1.z = pkbf(o[12], o[13]); w1.w = pkbf(o[14], o[15]);
        *(v4u*)yn = w0; *(v4u*)(yn + 8) = w1;
    }
}
__device__ __forceinline__ void kvpost_phase(Frame& F) {
    const bf16* KV = (const bf16*)(F.ws + WS_KVRAW); bf16* KS = (bf16*)(F.ws + WS_KS); bf16* VS = (bf16*)(F.ws + WS_VS);
    const int gw = F.vcu * NWAVES + F.wave, NGW = F.G * NWAVES, lane = F.lane, c0 = lane * 16;
    const float* kg = F.in[34] + (c0 & 63);
    for (int m = gw; m < M; m += NGW) {
        const bf16* p = KV + (size_t)m * 2048 + c0; v4u kv[2], vv[2];
#pragma unroll
        for (int q = 0; q < 2; ++q) { kv[q] = *(const v4u*)(p + 8 * q); vv[q] = *(const v4u*)(p + 1024 + 8 * q); }
        float k[16], ss = 0.f;
#pragma unroll
        for (int q = 0; q < 2; ++q)
#pragma unroll
            for (int j = 0; j < 4; ++j) { k[8 * q + 2 * j] = bflo(kv[q][j]); k[8 * q + 2 * j + 1] = bfhi(kv[q][j]); }
#pragma unroll
        for (int j = 0; j < 16; ++j) ss += k[j] * k[j];
        ss = sum4(ss); const float rs = 1.0f / sqrtf(ss * (1.0f / 64.0f) + 1e-6f);
        v4u w0, w1;
        w0.x = pkbf(k[0] * rs * kg[0], k[1] * rs * kg[1]); w0.y = pkbf(k[2] * rs * kg[2], k[3] * rs * kg[3]); w0.z = pkbf(k[4] * rs * kg[4], k[5] * rs * kg[5]); w0.w = pkbf(k[6] * rs * kg[6], k[7] * rs * kg[7]);
        w1.x = pkbf(k[8] * rs * kg[8], k[9] * rs * kg[9]); w1.y = pkbf(k[10] * rs * kg[10], k[11] * rs * kg[11]); w1.z = pkbf(k[12] * rs * kg[12], k[13] * rs * kg[13]); w1.w = pkbf(k[14] * rs * kg[14], k[15] * rs * kg[15]);
        *(v4u*)(KS + (size_t)m * D + c0) = w0; *(v4u*)(KS + (size_t)m * D + c0 + 8) = w1;
        *(v4u*)(VS + (size_t)m * D + c0) = vv[0]; *(v4u*)(VS + (size_t)m * D + c0 + 8) = vv[1];
    }
    if (gw < 32) {
        const int bh = gw, b = bh >> 4, h = bh & 15; const float* FL = (const float*)(F.ws + WS_FL) + ((size_t)b * T + (size_t)lane * 128) * 16 + h; const float fb = F.in[33][h];
        v4u* G3 = (v4u*)(F.ws + WS_G3) + (size_t)bh * T + (size_t)lane * 128;
        float tot = 0.f;
#pragma unroll 8
        for (int i = 0; i < 128; ++i) { const float x = FL[(size_t)i * 16] + fb; tot += -(fmaxf(-x, 0.f) + log1pf(__expf(-fabsf(x)))); }
        float inc = tot;
#pragma unroll
        for (int o = 1; o < 64; o <<= 1) { const float n = __int_as_float(__builtin_amdgcn_ds_bpermute((lane - o) << 2, __float_as_int(inc))); if (lane >= o) inc += n; }
        float run = inc - tot;
#pragma unroll 8
        for (int i = 0; i < 128; ++i) { const float x = FL[(size_t)i * 16] + fb; run += -(fmaxf(-x, 0.f) + log1pf(__expf(-fabsf(x))));
            const float gv = -run * 1.4426950408889634f;
            const unsigned hi = pkbf(gv, 0.f) & 0xffffu; const float r1 = gv - __uint_as_float(hi << 16);
            const unsigned mid = pkbf(r1, 0.f) & 0xffffu; const float r2 = r1 - __uint_as_float(mid << 16);
            const unsigned lo = pkbf(r2, 0.f) & 0xffffu;
            G3[i] = (v4u){hi | (mid << 16), lo, 0u, 0u}; }
    }
}
constexpr size_t WS_BAR = 512 * 1024, BAR_BYTES = 16384; constexpr int MISC_OFF = LDS_BYTES - 1024;
#define RLX_AGENT __ATOMIC_RELAXED, __HIP_MEMORY_SCOPE_AGENT
#define LDS_WAIT() asm volatile("s_waitcnt lgkmcnt(0)" ::: "memory")
#define VM_WAIT() asm volatile("s_waitcnt vmcnt(0)" ::: "memory")
__device__ __forceinline__ unsigned long long rt() { return __builtin_amdgcn_s_memrealtime(); }
__device__ __forceinline__ unsigned f2bf(float f) { unsigned u = __builtin_bit_cast(unsigned, f); return (u + 0x7fffu + ((u >> 16) & 1u)) >> 16; }
__device__ __forceinline__ unsigned pk2(float lo, float hi) { return f2bf(lo) | (f2bf(hi) << 16); }

#define XB_TMO      128
#define XB_XCNT(j)  (256  + 64 * (j))
#define XB_XSUB(j)  (1280 + 64 * (j))
#define XB_XGEN(j)  (2304 + 64 * (j))
#define XB_TOP      3328
#define XB_TOPGEN   3392
#define XCD_BAR_WORDS 3456
#define XB_SPIN_CAP (1u << 18)

__device__ __forceinline__ unsigned xb_ld(unsigned* p)              { return __hip_atomic_load(p, __ATOMIC_RELAXED, __HIP_MEMORY_SCOPE_AGENT); }
__device__ __forceinline__ unsigned xb_add(unsigned* p, unsigned v) { return __hip_atomic_fetch_add(p, v, __ATOMIC_RELAXED, __HIP_MEMORY_SCOPE_AGENT); }
__device__ __forceinline__ unsigned xb_xcc_id() { return (unsigned)__builtin_amdgcn_s_getreg((3 << 11) | 20) & 0xFu; }
#define XB_SPIN(cond, bar) do { unsigned _sp = 0; while (cond) { __builtin_amdgcn_s_sleep(1); \
    if ((++_sp & 255u) == 0u) { if (xb_ld(&(bar)[XB_TMO])) break; if (_sp > XB_SPIN_CAP) { atomicAdd(&(bar)[XB_TMO], 1u); break; } } } } while (0)

struct XcdBarrier {
    unsigned* bar; unsigned x;
    volatile LAS unsigned* st;
};

__device__ __forceinline__ XcdBarrier xcd_barrier_post(unsigned* bar, volatile LAS unsigned* st, const int tid) {
    XcdBarrier b; b.bar = bar; b.x = xb_xcc_id(); b.st = st;
    if (tid == 0) (void)xb_add(&bar[XB_XCNT(b.x)], 1u);
    return b;
}
__device__ __forceinline__ void xcd_barrier_complete(unsigned* bar, unsigned x, unsigned& nloc, unsigned& nx) {
    const unsigned G = gridDim.x * gridDim.y * gridDim.z;
    unsigned sum, cnt, mine, sp = 0u;
    for (;;) {
        sum = 0u; cnt = 0u; mine = 0u;
#pragma unroll
        for (unsigned j = 0; j < 16; ++j) { const unsigned c = xb_ld(&bar[XB_XCNT(j)]); sum += c; cnt += (c > 0u) ? 1u : 0u; mine = (j == x) ? c : mine; }
        if (sum == G) break;
        __builtin_amdgcn_s_sleep(1);
        if ((++sp & 255u) == 0u) { if (xb_ld(&bar[XB_TMO])) break; if (sp > XB_SPIN_CAP) { atomicAdd(&bar[XB_TMO], 1u); break; } }
    }
    nloc = mine > 0u ? mine : 1u; nx = cnt > 0u ? cnt : 1u;
}

__device__ __forceinline__ void xcd_barrier(const XcdBarrier& b, const int tid) {
    asm volatile("s_waitcnt vmcnt(0)" ::: "memory");
    __syncthreads();
    if (tid == 0) {
        unsigned* bar = b.bar;
        __builtin_amdgcn_s_waitcnt(0);
        unsigned nloc = b.st[0], nx = b.st[1];
        if (nloc == 0u) { xcd_barrier_complete(bar, b.x, nloc, nx); b.st[0] = nloc; b.st[1] = nx; }
        const unsigned old = xb_add(&bar[XB_XSUB(b.x)], 1u);
        const unsigned gen = old / nloc;
        if (old + 1u == (gen + 1u) * nloc) {
            __builtin_amdgcn_fence(__ATOMIC_RELEASE, "agent");
            asm volatile("s_waitcnt vmcnt(0)" ::: "memory");
            const unsigned og = xb_add(&bar[XB_TOP], 1u);
            const unsigned tg = og / nx;
            if (og + 1u == (tg + 1u) * nx) xb_add(&bar[XB_TOPGEN], 1u);
            else XB_SPIN(xb_ld(&bar[XB_TOPGEN]) == tg, bar);
            __builtin_amdgcn_fence(__ATOMIC_ACQUIRE, "agent");
            xb_add(&bar[XB_XGEN(b.x)], 1u);
            asm volatile("s_waitcnt vmcnt(0)" ::: "memory");
        } else {
            XB_SPIN(xb_ld(&bar[XB_XGEN(b.x)]) == gen, bar);
            __builtin_amdgcn_fence(__ATOMIC_ACQUIRE, "agent");
            asm volatile("s_waitcnt vmcnt(0)" ::: "memory");
        }
    }
    __syncthreads();
}
#define GEMM_CALL(FN, Aptr, Bptr, Nn, Kk, LDA, LDB, ...) GEMM_CALL_G(FN, Aptr, Bptr, Nn, Kk, LDA, LDB, 0, 0, __VA_ARGS__)
#define GEMM_CALL_G(FN, Aptr, Bptr, Nn, Kk, LDA, LDB, AGRP, ASTEP, ...) GEMM_CALL_S(StaticOrder, FN, Aptr, Bptr, Nn, Kk, LDA, LDB, AGRP, ASTEP, __VA_ARGS__)
#define GEMM_CALL_S(ORD, FN, Aptr, Bptr, Nn, Kk, LDA, LDB, AGRP, ASTEP, ...) do { pg8::Gemm g_{(const pg8::bf16_t*)(Aptr), (const pg8::bf16_t*)(Bptr), M, (Nn), (Kk), (LDA), (LDB), (AGRP), (size_t)(ASTEP)}; pg8::ORD S_; S_.init(M, (Nn), F.G, F.bx); \
    pg8::Epi8<pg8::FN> E_{{__VA_ARGS__}}; pg8::gemm_phase<pg8::Epi8<pg8::FN>, pg8::ORD, true, true>(F.lds, g_, S_, E_, F.tid); } while (0)
constexpr int N_PHASES = 42;
__global__ void __launch_bounds__(NWAVES * 64, 2) yoco_fwd(Args args) {
    extern __shared__ __attribute__((aligned(16))) unsigned char lds[];
    cg::grid_group grid = cg::this_grid();
    Frame F;
    const int wave_s = __builtin_amdgcn_readfirstlane((int)threadIdx.x >> 6);
    F.lds = (LAS unsigned char*)lds; F.tid = threadIdx.x; F.lane = F.tid & 63; F.wave = wave_s;
    F.G = gridDim.x; F.bx = blockIdx.x; F.vcu = F.bx;
    F.ws = args.ws; F.out = args.out; F.in = args.in;
    unsigned char* ws = args.ws;
    const int lo = args.ph_lo, hi = args.ph_hi; const bool one = (hi - lo) > 1;
#define LAUNDER() do { int t_ = wave_s * 64 + (int)__builtin_amdgcn_mbcnt_hi(~0u, __builtin_amdgcn_mbcnt_lo(~0u, 0u)); asm volatile("" : "+v"(t_)); F.tid = t_; F.lane = t_ & 63; F.wave = __builtin_amdgcn_readfirstlane(t_ >> 6); \
        int z_ = 0; asm volatile("" : "+v"(z_)); z_ = __builtin_amdgcn_readfirstlane(z_); ws = args.ws + z_; F.ws = ws; F.in = args.in + z_; F.out = args.out + z_; F.bx = (int)blockIdx.x + z_; F.G = (int)gridDim.x + z_; F.vcu = (F.G % 8 == 0) ? (F.bx % 8) * (F.G / 8) + F.bx / 8 : F.bx; } while (0)
#define IN(k) (lo <= (k) && (k) < hi)
#ifndef PROBE_BAR
#define PROBE_BAR 0
#endif
#ifndef PROBE_PH
#define PROBE_PH (-1)
#endif
#define PHASE(k) if (IN(k)) for (int rep_ = 0; rep_ < (((k) == PROBE_PH) ? 2 : 1); ++rep_)
#define SEAM() do { if (one) { unsigned zz_ = 0u; asm volatile("" : "+v"(zz_)); const int st_ = wave_s * 64 + (int)__builtin_amdgcn_mbcnt_hi(~0u, __builtin_amdgcn_mbcnt_lo(~0u, zz_)); xcd_barrier(xbar, st_); if (PROBE_BAR) xcd_barrier(xbar, st_); } } while (0)
#define MOD_ ((float*)(ws + WS_MOD))
#define MODKV_ (MOD_ + 4 * 2 * 6144)
#define H2_ ((bf16*)(ws + WS_H2))
#define XN_ ((bf16*)(ws + WS_H2))
#define XNKV_ ((bf16*)(ws + WS_H2 + 32 * MiB))
#define P1_ ((bf16*)(ws + WS_P1))
#define P2_ ((bf16*)(ws + WS_P2))
#define HB_ ((bf16*)(ws + WS_HB))
#define QB_ ((bf16*)(ws + WS_QB))
#define GT_ ((bf16*)(ws + WS_GT))
#define XIN1_ ((L == 0) ? F.in[0] : (const float*)F.out)
#define MODL_ (MOD_ + L * 2 * 6144)

    volatile LAS unsigned* MISC = (volatile LAS unsigned*)(F.lds + MISC_OFF);
    if (F.tid < 32) MISC[F.tid] = 0u;
    __syncthreads();
    XcdBarrier xbar; xbar.bar = (unsigned*)(args.ws + WS_BAR); xbar.x = 0; xbar.st = MISC + 8;
    if (one) xbar = xcd_barrier_post((unsigned*)(args.ws + WS_BAR), MISC + 8, F.tid);
    PHASE(0) { LAUNDER(); p0_mod(F); p0_weights(F); if (one) grid.sync(); }
    { constexpr int L = 0;
        const int pb = 1 + L * 10;
        if (L < 2) {
            PHASE(pb + 0) { LAUNDER(); norm_mix_phase(F, XIN1_, F.in[4] + L * D, MODL_, MODL_ + 1024, F.in[8] + L * 6 * 1024, H2_, P2_); SEAM(); }
            PHASE(pb + 1) { LAUNDER(); GEMM_CALL(FnP1, H2_, ws + WS_W1 + (size_t)L * N1 * K1 * 2 + (size_t)3072 * 1024 * 2, 512, K1, K1, K1, P1_, 3072);
                LAUNDER();
                if (F.G == 256) GEMM_CALL_S(SplitOrder, FnP1, P2_, ws + WS_W1 + (size_t)L * N1 * K1 * 2, 3072, D, D, D, 4, (size_t)M * D * 2, P1_, 0);
                else GEMM_CALL_G(FnP1, P2_, ws + WS_W1 + (size_t)L * N1 * K1 * 2, 3072, D, D, D, 4, (size_t)M * D * 2, P1_, 0);
                SEAM(); }
            PHASE(pb + 2) { LAUNDER(); GEMM_CALL(FnP2, P1_ + 3072, ws + WS_W2A + (size_t)L * 3072 * 256 * 2, NP2, 256, N1, 256, P2_, MOD_ + 53248 + L * 3072); SEAM(); }
            PHASE(pb + 3) { LAUNDER(); scan_phase(F, L); SEAM(); }
            PHASE(pb + 4) { LAUNDER(); post_phase(F, L); SEAM(); }
            PHASE(pb + 5) { LAUNDER(); GEMM_CALL(FnGate, P1_ + 3232, ws + WS_W2G + (size_t)L * 1024 * 256 * 2, D, 256, N1, 256, H2_, 2048); SEAM(); }
            PHASE(pb + 6) { LAUNDER(); GEMM_CALL(FnRes, H2_, ws + WS_WO + (size_t)L * D * D * 2, D, D, 2048, D, XIN1_, F.out, MODL_ + 2 * 1024); SEAM(); }
        } else {
            const int j = L - 2;
            PHASE(pb + 0) { LAUNDER(); norm_phase(F, F.out, F.in[4] + L * D, MODL_, MODL_ + 1024, 6144, 1, XN_);
                if (L == 2) norm_phase(F, F.out, F.in[29], MODKV_, MODKV_ + 1024, 2048, 1, XNKV_);
                SEAM(); }
            PHASE(pb + 1) { LAUNDER();
                if (L == 2) GEMM_CALL(FnKv, XNKV_, ws + WS_WKV, 2304, D, D, D, (bf16*)(ws + WS_KVRAW), (float*)(ws + WS_FL));
                LAUNDER();
                GEMM_CALL(FnQg, XN_, ws + WS_WQG + (size_t)j * 2048 * D * 2, 2048, D, D, D, QB_, GT_); SEAM(); }
            if (L == 2) PHASE(pb + 2) { LAUNDER(); kvpost_phase(F); SEAM(); }
            PHASE(pb + 3) { LAUNDER();
                float kb_; { float g_ = fabsf(F.in[34][F.lane]); g_ = fmaxf(g_, dpp_f(g_, 0)); g_ = fmaxf(g_, dpp_f(g_, 1)); g_ = fmaxf(g_, dpp_f(g_, 2)); g_ = fmaxf(g_, dpp_f(g_, 3));
                  { auto rr = __builtin_amdgcn_permlane16_swap(__float_as_uint(g_), __float_as_uint(g_), false, false); g_ = fmaxf(__uint_as_float(rr[0]), __uint_as_float(rr[1])); }
                  { auto rr = __builtin_amdgcn_permlane32_swap(__float_as_uint(g_), __float_as_uint(g_), false, false); g_ = fmaxf(__uint_as_float(rr[0]), __uint_as_float(rr[1])); }
                  kb_ = 8.0f * 1.02f * g_; }
                const attn_body::AttnTensors AT{(const attn_body::bf16*)QB_, (const attn_body::bf16*)(ws + WS_KS), (const attn_body::bf16*)(ws + WS_VS), (attn_body::bf16*)((PROBE_PH == pb + 3 && rep_ == 0) ? (bf16*)(ws + WS_KVRAW) : QB_), (const attn_body::bf16*)GT_, (const unsigned char*)(ws + WS_G3), F.in[36] + j * 64, kb_};
                const attn_body::StaticOrder S((int)F.G, F.bx);
                attn_body::attn_phase<attn_body::StaticOrder>((char*)lds, AT, S, F.tid);
                SEAM(); }
            PHASE(pb + 6) { LAUNDER(); GEMM_CALL(FnRes, QB_, ws + WS_WO2 + (size_t)j * D * D * 2, D, D, D, D, (const float*)F.out, F.out, MODL_ + 2 * 1024); SEAM(); }
        }
        PHASE(pb + 7) { LAUNDER(); mlp_weights(F, L); norm_phase(F, F.out, F.in[5] + L * D, MODL_ + 3 * 1024, MODL_ + 4 * 1024, 6144, 1, XN_); SEAM(); }
        PHASE(pb + 8) { LAUNDER(); GEMM_CALL(FnUp, XN_, ws + WS_WUP, FF, D, D, D, HB_); SEAM(); }
        PHASE(pb + 9) { LAUNDER(); GEMM_CALL(FnRes, HB_, ws + WS_WDN, D, FF, FF, FF, (const float*)F.out, F.out, MODL_ + 5 * 1024); SEAM(); }
        }
    { constexpr int L = 1;
        const int pb = 1 + L * 10;
        if (L < 2) {
            PHASE(pb + 0) { LAUNDER(); norm_mix_phase(F, XIN1_, F.in[4] + L * D, MODL_, MODL_ + 1024, F.in[8] + L * 6 * 1024, H2_, P2_); SEAM(); }
            PHASE(pb + 1) { LAUNDER(); GEMM_CALL(FnP1, H2_, ws + WS_W1 + (size_t)L * N1 * K1 * 2 + (size_t)3072 * 1024 * 2, 512, K1, K1, K1, P1_, 3072);
                LAUNDER();
                if (F.G == 256) GEMM_CALL_S(SplitOrder, FnP1, P2_, ws + WS_W1 + (size_t)L * N1 * K1 * 2, 3072, D, D, D, 4, (size_t)M * D * 2, P1_, 0);
                else GEMM_CALL_G(FnP1, P2_, ws + WS_W1 + (size_t)L * N1 * K1 * 2, 3072, D, D, D, 4, (size_t)M * D * 2, P1_, 0);
                SEAM(); }
            PHASE(pb + 2) { LAUNDER(); GEMM_CALL(FnP2, P1_ + 3072, ws + WS_W2A + (size_t)L * 3072 * 256 * 2, NP2, 256, N1, 256, P2_, MOD_ + 53248 + L * 3072); SEAM(); }
            PHASE(pb + 3) { LAUNDER(); scan_phase(F, L); SEAM(); }
            PHASE(pb + 4) { LAUNDER(); post_phase(F, L); SEAM(); }
            PHASE(pb + 5) { LAUNDER(); GEMM_CALL(FnGate, P1_ + 3232, ws + WS_W2G + (size_t)L * 1024 * 256 * 2, D, 256, N1, 256, H2_, 2048); SEAM(); }
            PHASE(pb + 6) { LAUNDER(); GEMM_CALL(FnRes, H2_, ws + WS_WO + (size_t)L * D * D * 2, D, D, 2048, D, XIN1_, F.out, MODL_ + 2 * 1024); SEAM(); }
        } else {
            const int j = L - 2;
            PHASE(pb + 0) { LAUNDER(); norm_phase(F, F.out, F.in[4] + L * D, MODL_, MODL_ + 1024, 6144, 1, XN_);
                if (L == 2) norm_phase(F, F.out, F.in[29], MODKV_, MODKV_ + 1024, 2048, 1, XNKV_);
                SEAM(); }
            PHASE(pb + 1) { LAUNDER();
                if (L == 2) GEMM_CALL(FnKv, XNKV_, ws + WS_WKV, 2304, D, D, D, (bf16*)(ws + WS_KVRAW), (float*)(ws + WS_FL));
                LAUNDER();
                GEMM_CALL(FnQg, XN_, ws + WS_WQG + (size_t)j * 2048 * D * 2, 2048, D, D, D, QB_, GT_); SEAM(); }
            if (L == 2) PHASE(pb + 2) { LAUNDER(); kvpost_phase(F); SEAM(); }
            PHASE(pb + 3) { LAUNDER();
                float kb_; { float g_ = fabsf(F.in[34][F.lane]); g_ = fmaxf(g_, dpp_f(g_, 0)); g_ = fmaxf(g_, dpp_f(g_, 1)); g_ = fmaxf(g_, dpp_f(g_, 2)); g_ = fmaxf(g_, dpp_f(g_, 3));
                  { auto rr = __builtin_amdgcn_permlane16_swap(__float_as_uint(g_), __float_as_uint(g_), false, false); g_ = fmaxf(__uint_as_float(rr[0]), __uint_as_float(rr[1])); }
                  { auto rr = __builtin_amdgcn_permlane32_swap(__float_as_uint(g_), __float_as_uint(g_), false, false); g_ = fmaxf(__uint_as_float(rr[0]), __uint_as_float(rr[1])); }
                  kb_ = 8.0f * 1.02f * g_; }
                const attn_body::AttnTensors AT{(const attn_body::bf16*)QB_, (const attn_body::bf16*)(ws + WS_KS), (const attn_body::bf16*)(ws + WS_VS), (attn_body::bf16*)((PROBE_PH == pb + 3 && rep_ == 0) ? (bf16*)(ws + WS_KVRAW) : QB_), (const attn_body::bf16*)GT_, (const unsigned char*)(ws + WS_G3), F.in[36] + j * 64, kb_};
                const attn_body::StaticOrder S((int)F.G, F.bx);
                attn_body::attn_phase<attn_body::StaticOrder>((char*)lds, AT, S, F.tid);
                SEAM(); }
            PHASE(pb + 6) { LAUNDER(); GEMM_CALL(FnRes, QB_, ws + WS_WO2 + (size_t)j * D * D * 2, D, D, D, D, (const float*)F.out, F.out, MODL_ + 2 * 1024); SEAM(); }
        }
        PHASE(pb + 7) { LAUNDER(); mlp_weights(F, L); norm_phase(F, F.out, F.in[5] + L * D, MODL_ + 3 * 1024, MODL_ + 4 * 1024, 6144, 1, XN_); SEAM(); }
        PHASE(pb + 8) { LAUNDER(); GEMM_CALL(FnUp, XN_, ws + WS_WUP, FF, D, D, D, HB_); SEAM(); }
        PHASE(pb + 9) { LAUNDER(); GEMM_CALL(FnRes, HB_, ws + WS_WDN, D, FF, FF, FF, (const float*)F.out, F.out, MODL_ + 5 * 1024); SEAM(); }
        }
    { constexpr int L = 2;
        const int pb = 1 + L * 10;
        if (L < 2) {
            PHASE(pb + 0) { LAUNDER(); norm_mix_phase(F, XIN1_, F.in[4] + L * D, MODL_, MODL_ + 1024, F.in[8] + L * 6 * 1024, H2_, P2_); SEAM(); }
            PHASE(pb + 1) { LAUNDER(); GEMM_CALL(FnP1, H2_, ws + WS_W1 + (size_t)L * N1 * K1 * 2 + (size_t)3072 * 1024 * 2, 512, K1, K1, K1, P1_, 3072);
                LAUNDER();
                if (F.G == 256) GEMM_CALL_S(SplitOrder, FnP1, P2_, ws + WS_W1 + (size_t)L * N1 * K1 * 2, 3072, D, D, D, 4, (size_t)M * D * 2, P1_, 0);
                else GEMM_CALL_G(FnP1, P2_, ws + WS_W1 + (size_t)L * N1 * K1 * 2, 3072, D, D, D, 4, (size_t)M * D * 2, P1_, 0);
                SEAM(); }
            PHASE(pb + 2) { LAUNDER(); GEMM_CALL(FnP2, P1_ + 3072, ws + WS_W2A + (size_t)L * 3072 * 256 * 2, NP2, 256, N1, 256, P2_, MOD_ + 53248 + L * 3072); SEAM(); }
            PHASE(pb + 3) { LAUNDER(); scan_phase(F, L); SEAM(); }
            PHASE(pb + 4) { LAUNDER(); post_phase(F, L); SEAM(); }
            PHASE(pb + 5) { LAUNDER(); GEMM_CALL(FnGate, P1_ + 3232, ws + WS_W2G + (size_t)L * 1024 * 256 * 2, D, 256, N1, 256, H2_, 2048); SEAM(); }
            PHASE(pb + 6) { LAUNDER(); GEMM_CALL(FnRes, H2_, ws + WS_WO + (size_t)L * D * D * 2, D, D, 2048, D, XIN1_, F.out, MODL_ + 2 * 1024); SEAM(); }
        } else {
            const int j = L - 2;
            PHASE(pb + 0) { LAUNDER(); norm_phase(F, F.out, F.in[4] + L * D, MODL_, MODL_ + 1024, 6144, 1, XN_);
                if (L == 2) norm_phase(F, F.out, F.in[29], MODKV_, MODKV_ + 1024, 2048, 1, XNKV_);
                SEAM(); }
            PHASE(pb + 1) { LAUNDER();
                if (L == 2) GEMM_CALL(FnKv, XNKV_, ws + WS_WKV, 2304, D, D, D, (bf16*)(ws + WS_KVRAW), (float*)(ws + WS_FL));
                LAUNDER();
                GEMM_CALL(FnQg, XN_, ws + WS_WQG + (size_t)j * 2048 * D * 2, 2048, D, D, D, QB_, GT_); SEAM(); }
            if (L == 2) PHASE(pb + 2) { LAUNDER(); kvpost_phase(F); SEAM(); }
            PHASE(pb + 3) { LAUNDER();
                float kb_; { float g_ = fabsf(F.in[34][F.lane]); g_ = fmaxf(g_, dpp_f(g_, 0)); g_ = fmaxf(g_, dpp_f(g_, 1)); g_ = fmaxf(g_, dpp_f(g_, 2)); g_ = fmaxf(g_, dpp_f(g_, 3));
                  { auto rr = __builtin_amdgcn_permlane16_swap(__float_as_uint(g_), __float_as_uint(g_), false, false); g_ = fmaxf(__uint_as_float(rr[0]), __uint_as_float(rr[1])); }
                  { auto rr = __builtin_amdgcn_permlane32_swap(__float_as_uint(g_), __float_as_uint(g_), false, false); g_ = fmaxf(__uint_as_float(rr[0]), __uint_as_float(rr[1])); }
                  kb_ = 8.0f * 1.02f * g_; }
                const attn_body::AttnTensors AT{(const attn_body::bf16*)QB_, (const attn_body::bf16*)(ws + WS_KS), (const attn_body::bf16*)(ws + WS_VS), (attn_body::bf16*)((PROBE_PH == pb + 3 && rep_ == 0) ? (bf16*)(ws + WS_KVRAW) : QB_), (const attn_body::bf16*)GT_, (const unsigned char*)(ws + WS_G3), F.in[36] + j * 64, kb_};
                const attn_body::StaticOrder S((int)F.G, F.bx);
                attn_body::attn_phase<attn_body::StaticOrder>((char*)lds, AT, S, F.tid);
                SEAM(); }
            PHASE(pb + 6) { LAUNDER(); GEMM_CALL(FnRes, QB_, ws + WS_WO2 + (size_t)j * D * D * 2, D, D, D, D, (const float*)F.out, F.out, MODL_ + 2 * 1024); SEAM(); }
        }
        PHASE(pb + 7) { LAUNDER(); mlp_weights(F, L); norm_phase(F, F.out, F.in[5] + L * D, MODL_ + 3 * 1024, MODL_ + 4 * 1024, 6144, 1, XN_); SEAM(); }
        PHASE(pb + 8) { LAUNDER(); GEMM_CALL(FnUp, XN_, ws + WS_WUP, FF, D, D, D, HB_); SEAM(); }
        PHASE(pb + 9) { LAUNDER(); GEMM_CALL(FnRes, HB_, ws + WS_WDN, D, FF, FF, FF, (const float*)F.out, F.out, MODL_ + 5 * 1024); SEAM(); }
        }
    { constexpr int L = 3;
        const int pb = 1 + L * 10;
        if (L < 2) {
            PHASE(pb + 0) { LAUNDER(); norm_mix_phase(F, XIN1_, F.in[4] + L * D, MODL_, MODL_ + 1024, F.in[8] + L * 6 * 1024, H2_, P2_); SEAM(); }
            PHASE(pb + 1) { LAUNDER(); GEMM_CALL(FnP1, H2_, ws + WS_W1 + (size_t)L * N1 * K1 * 2 + (size_t)3072 * 1024 * 2, 512, K1, K1, K1, P1_, 3072);
                LAUNDER();
                if (F.G == 256) GEMM_CALL_S(SplitOrder, FnP1, P2_, ws + WS_W1 + (size_t)L * N1 * K1 * 2, 3072, D, D, D, 4, (size_t)M * D * 2, P1_, 0);
                else GEMM_CALL_G(FnP1, P2_, ws + WS_W1 + (size_t)L * N1 * K1 * 2, 3072, D, D, D, 4, (size_t)M * D * 2, P1_, 0);
                SEAM(); }
            PHASE(pb + 2) { LAUNDER(); GEMM_CALL(FnP2, P1_ + 3072, ws + WS_W2A + (size_t)L * 3072 * 256 * 2, NP2, 256, N1, 256, P2_, MOD_ + 53248 + L * 3072); SEAM(); }
            PHASE(pb + 3) { LAUNDER(); scan_phase(F, L); SEAM(); }
            PHASE(pb + 4) { LAUNDER(); post_phase(F, L); SEAM(); }
            PHASE(pb + 5) { LAUNDER(); GEMM_CALL(FnGate, P1_ + 3232, ws + WS_W2G + (size_t)L * 1024 * 256 * 2, D, 256, N1, 256, H2_, 2048); SEAM(); }
            PHASE(pb + 6) { LAUNDER(); GEMM_CALL(FnRes, H2_, ws + WS_WO + (size_t)L * D * D * 2, D, D, 2048, D, XIN1_, F.out, MODL_ + 2 * 1024); SEAM(); }
        } else {
            const int j = L - 2;
            PHASE(pb + 0) { LAUNDER(); norm_phase(F, F.out, F.in[4] + L * D, MODL_, MODL_ + 1024, 6144, 1, XN_);
                if (L == 2) norm_phase(F, F.out, F.in[29], MODKV_, MODKV_ + 1024, 2048, 1, XNKV_);
                SEAM(); }
            PHASE(pb + 1) { LAUNDER();
                if (L == 2) GEMM_CALL(FnKv, XNKV_, ws + WS_WKV, 2304, D, D, D, (bf16*)(ws + WS_KVRAW), (float*)(ws + WS_FL));
                LAUNDER();
                GEMM_CALL(FnQg, XN_, ws + WS_WQG + (size_t)j * 2048 * D * 2, 2048, D, D, D, QB_, GT_); SEAM(); }
            if (L == 2) PHASE(pb + 2) { LAUNDER(); kvpost_phase(F); SEAM(); }
            PHASE(pb + 3) { LAUNDER();
                float kb_; { float g_ = fabsf(F.in[34][F.lane]); g_ = fmaxf(g_, dpp_f(g_, 0)); g_ = fmaxf(g_, dpp_f(g_, 1)); g_ = fmaxf(g_, dpp_f(g_, 2)); g_ = fmaxf(g_, dpp_f(g_, 3));
                  { auto rr = __builtin_amdgcn_permlane16_swap(__float_as_uint(g_), __float_as_uint(g_), false, false); g_ = fmaxf(__uint_as_float(rr[0]), __uint_as_float(rr[1])); }
                  { auto rr = __builtin_amdgcn_permlane32_swap(__float_as_uint(g_), __float_as_uint(g_), false, false); g_ = fmaxf(__uint_as_float(rr[0]), __uint_as_float(rr[1])); }
                  kb_ = 8.0f * 1.02f * g_; }
                const attn_body::AttnTensors AT{(const attn_body::bf16*)QB_, (const attn_body::bf16*)(ws + WS_KS), (const attn_body::bf16*)(ws + WS_VS), (attn_body::bf16*)((PROBE_PH == pb + 3 && rep_ == 0) ? (bf16*)(ws + WS_KVRAW) : QB_), (const attn_body::bf16*)GT_, (const unsigned char*)(ws + WS_G3), F.in[36] + j * 64, kb_};
                const attn_body::StaticOrder S((int)F.G, F.bx);
                attn_body::attn_phase<attn_body::StaticOrder>((char*)lds, AT, S, F.tid);
                SEAM(); }
            PHASE(pb + 6) { LAUNDER(); GEMM_CALL(FnRes, QB_, ws + WS_WO2 + (size_t)j * D * D * 2, D, D, D, D, (const float*)F.out, F.out, MODL_ + 2 * 1024); SEAM(); }
        }
        PHASE(pb + 7) { LAUNDER(); mlp_weights(F, L); norm_phase(F, F.out, F.in[5] + L * D, MODL_ + 3 * 1024, MODL_ + 4 * 1024, 6144, 1, XN_); SEAM(); }
        PHASE(pb + 8) { LAUNDER(); GEMM_CALL(FnUp, XN_, ws + WS_WUP, FF, D, D, D, HB_); SEAM(); }
        PHASE(pb + 9) { LAUNDER(); GEMM_CALL(FnRes, HB_, ws + WS_WDN, D, FF, FF, FF, (const float*)F.out, F.out, MODL_ + 5 * 1024); SEAM(); }
        }
    PHASE(41) { LAUNDER(); final_norm_phase(F); }
#undef IN
#undef SEAM
}
static bool phase_exists(int ph) {
    if (ph == 0 || ph == 41) return true;
    const int L = (ph - 1) / 10, s = (ph - 1) % 10;
    if (L < 2) return true;
    if (s == 4 || s == 5) return false;
    if (s == 2) return L == 2;
    return true;
}
extern "C" void kernel_launch(void* const* d_in, const int* in_sizes, int n_in, void* d_out, int out_size, void* d_ws, size_t ws_size, hipStream_t stream) {
    static int grid = 0;
    if (grid == 0) {
        if (n_in != 39 || in_sizes[0] != M * D || out_size != M * D || ws_size < WS_END) { fprintf(stderr, "kernel_launch: shape/workspace mismatch: n_in %d in0 %d out %d ws %zu (need %zu)\n", n_in, n_in > 0 ? in_sizes[0] : -1, out_size, ws_size, (size_t)WS_END); grid = -1; return; }
        int dev = 0, cus = 0, per_cu = 0;
        if (hipGetDevice(&dev) != hipSuccess || hipDeviceGetAttribute(&cus, hipDeviceAttributeMultiprocessorCount, dev) != hipSuccess) { fprintf(stderr, "kernel_launch: device query failed\n"); grid = -1; return; }
        if (hipFuncSetAttribute((const void*)yoco_fwd, hipFuncAttributeMaxDynamicSharedMemorySize, LDS_BYTES) != hipSuccess) { fprintf(stderr, "kernel_launch: hipFuncSetAttribute failed\n"); grid = -1; return; }
        if (hipOccupancyMaxActiveBlocksPerMultiprocessor(&per_cu, (const void*)yoco_fwd, NWAVES * 64, LDS_BYTES) != hipSuccess || per_cu < 1) { fprintf(stderr, "kernel_launch: occupancy query says %d blocks/CU\n", per_cu); per_cu = 1; }
        (void)hipGetLastError();
        grid = cus * per_cu;
        if (grid != 256) { fprintf(stderr, "kernel_launch: resident capacity %d workgroups; this kernel's static schedules want 256 (using 256)\n", grid); if (grid > 256) grid = 256; }
    }
    if (grid < 0) return;
    if (hipMemsetAsync((char*)d_ws + WS_BAR, 0, BAR_BYTES, stream) != hipSuccess) { fprintf(stderr, "kernel_launch: memset of barrier words failed\n"); return; }
    Args a{};
    for (int i = 0; i < 39; ++i) a.in[i] = (const float*)d_in[i];
    a.out = (float*)d_out; a.ws = (unsigned char*)d_ws;
#if MK_ONE_LAUNCH
    a.ph_lo = 0; a.ph_hi = N_PHASES;
    void* params[] = {&a};
    const hipError_t le = hipLaunchCooperativeKernel((const void*)yoco_fwd, dim3(grid), dim3(NWAVES * 64), params, LDS_BYTES, stream);
    if (le != hipSuccess) fprintf(stderr, "kernel_launch: cooperative launch failed: %s (grid %d)\n", hipGetErrorName(le), grid);
#else
    for (int ph = 0; ph < N_PHASES; ++ph) { if (!phase_exists(ph)) continue; a.ph_lo = ph; a.ph_hi = ph + 1;
        hipLaunchKernelGGL(yoco_fwd, dim3(grid), dim3(NWAVES * 64), LDS_BYTES, stream, a);
        const hipError_t le = hipPeekAtLastError(); if (le != hipSuccess) { fprintf(stderr, "kernel_launch: launch of phase %d failed: %s\n", ph, hipGetErrorName(le)); break; } }
#endif
}
```

```cpp
#include <hip/hip_runtime.h>
#include <hip/hip_cooperative_groups.h>
#include <hip/hip_bf16.h>
#include <cstdio>
#include <cstdint>
#include <cmath>
namespace cg = cooperative_groups;
#ifndef MK_ONE_LAUNCH
#define MK_ONE_LAUNCH 1
#endif
namespace pg8 {
#define PG8_LAS __attribute__((address_space(3)))
typedef unsigned short bf16_t;
typedef short bf16x8 __attribute__((ext_vector_type(8)));
typedef float f32x4 __attribute__((ext_vector_type(4)));
typedef unsigned u32x4 __attribute__((ext_vector_type(4)));
constexpr int BM = 256, BK = 64, HALF = 128, HTB = HALF * BK * 2  , STAGE_BYTES = 8 * HTB, NXCD = 8, WGM = 8;

__host__ __device__ __forceinline__ int lds_byte(int r, int c) { const int st = (r >> 4) * 2 + (c >> 5), rr = r & 15, cc = c & 31, ob = rr * 64 + cc * 2; return st * 1024 + (ob ^ (((ob >> 9) & 1) << 5)); }
__host__ __device__ __forceinline__ void stage_rc(int b, int& R, int& C) { const int st = b / 1024, sb = b % 1024, swz = sb ^ (((sb >> 9) & 1) << 5); R = (st >> 1) * 16 + swz / 64; C = (st & 1) * 32 + (swz % 64) / 2; }
__host__ __device__ __forceinline__ int perm32(int rho) { const int n = rho >> 4, i = rho & 15; return 8 * (i >> 2) + 4 * n + (i & 3); }

struct Unit { int pm, pn; };
struct Gemm { const bf16_t* A; const bf16_t* Bt; int M, N, K, lda, ldb; int agrp; size_t astep; };

struct SplitOrder {
    int c, nN;
    __host__ __device__ void init(int M, int N, int G_, int c_) { c = c_; nN = N / BM; (void)M; (void)G_; }
    __host__ __device__ bool next(int i, Unit& u) const { int idx; if (c < 128) { if (i >= 2) return false; idx = 2 * c + i; } else { if (i >= 4) return false; idx = 256 + 4 * (c - 128) + i; } u.pm = idx / nN; u.pn = idx % nN; return true; }
    __device__ __forceinline__ void a_ready(const Unit&) const {}
    __device__ __forceinline__ void done(const Unit&) const {}
};
struct StaticOrder {
    int nM, nN, nwg, G, c;
    __host__ __device__ void init(int M, int N, int G_, int c_) { nM = M / BM; nN = N / BM; nwg = nM * nN; G = G_; c = c_; }
    __host__ __device__ bool next(int i, Unit& u) const {
        const long L = (long)i * G + c; if (L >= nwg) return false;
        int wgid = (int)L; { const int q = nwg / NXCD, r = nwg % NXCD, xcd = wgid % NXCD, off = wgid / NXCD; wgid = (xcd < r ? xcd * (q + 1) : r * (q + 1) + (xcd - r) * q) + off; }
        const int nig = WGM * nN, gid = wgid / nig, fm = gid * WGM, gsz = (nM - fm) < WGM ? (nM - fm) : WGM;
        u.pm = fm + ((wgid % nig) % gsz); u.pn = (wgid % nig) / gsz; return true;
    }
    __device__ __forceinline__ void a_ready(const Unit&) const {}
    __device__ __forceinline__ void done(const Unit&) const {}
};

typedef float f32x2 __attribute__((ext_vector_type(2)));
typedef __bf16 bf16x2_t __attribute__((ext_vector_type(2)));
__device__ __forceinline__ unsigned pkbf(float lo, float hi) { f32x2 v = {lo, hi}; bf16x2_t b = __builtin_convertvector(v, bf16x2_t); return __builtin_bit_cast(unsigned, b); }
__device__ __forceinline__ float bflo(unsigned w) { return __uint_as_float(w << 16); }
__device__ __forceinline__ float bfhi(unsigned w) { return __uint_as_float(w & 0xffff0000u); }
__device__ __forceinline__ float sigm(float x) { return 1.0f / (1.0f + __expf(-x)); }
template <class Fn> struct Epi8 {
    static constexpr bool PERM = true, AFTER_DRAIN = false; Fn f;
    __device__ __forceinline__ void operator()(const f32x4 (&acc)[2][2][4][2], const Unit& u, int wr, int wc, int fr, int fq) const {
        const int row0 = u.pm * BM + wr * 64 + fr, col0 = u.pn * BM + wc * 32 + 8 * fq;
#pragma unroll
        for (int ai = 0; ai < 2; ++ai)
#pragma unroll
            for (int m = 0; m < 4; ++m)
#pragma unroll
                for (int bj = 0; bj < 2; ++bj) { f(row0 + ai * HALF + m * 16, col0 + bj * HALF, acc[ai][bj][m][0], acc[ai][bj][m][1]); }
    }
};
__device__ __forceinline__ void st8bf(bf16_t* p, f32x4 v0, f32x4 v1) { u32x4 w; w.x = pkbf(v0[0], v0[1]); w.y = pkbf(v0[2], v0[3]); w.z = pkbf(v1[0], v1[1]); w.w = pkbf(v1[2], v1[3]); *(u32x4*)p = w; }
struct FnP1 { bf16_t* O; int coff;
    __device__ __forceinline__ void operator()(int row, int col, f32x4 v0, f32x4 v1) const {
        col += coff;
        if (col >= 3072) {
            if (col < 3136) {
#pragma unroll
                for (int j = 0; j < 4; ++j) { v0[j] = 1.0f - 2.0f / (__expf(2.0f * v0[j]) + 1.0f); v1[j] = 1.0f - 2.0f / (__expf(2.0f * v1[j]) + 1.0f); } }
            else if (col >= 3232 && col < 3392) {
#pragma unroll
                for (int j = 0; j < 4; ++j) { v0[j] = sigm(v0[j]); v1[j] = sigm(v1[j]); } }
        }
        st8bf(O + (size_t)row * 3584 + col, v0, v1); } };
struct FnP2 { bf16_t* O; const float* bias;
    __device__ __forceinline__ void operator()(int row, int col, f32x4 v0, f32x4 v1) const {
        const f32x4 b0 = *(const f32x4*)(bias + col), b1 = *(const f32x4*)(bias + col + 4);
        const float sc = col < 1024 ? -0.60653065971f : 1.0f;
#pragma unroll
        for (int j = 0; j < 4; ++j) { v0[j] = sc * sigm(v0[j] + b0[j]); v1[j] = sc * sigm(v1[j] + b1[j]); }
        st8bf(O + (size_t)row * 3072 + col, v0, v1); } };
struct FnGate { bf16_t* Y; int ld;
    __device__ __forceinline__ void operator()(int row, int col, f32x4 v0, f32x4 v1) const {
        bf16_t* p = Y + (size_t)row * ld + col; const u32x4 y = *(const u32x4*)p;
        v0[0] *= bflo(y.x); v0[1] *= bfhi(y.x); v0[2] *= bflo(y.y); v0[3] *= bfhi(y.y); v1[0] *= bflo(y.z); v1[1] *= bfhi(y.z); v1[2] *= bflo(y.w); v1[3] *= bfhi(y.w);
        st8bf(p, v0, v1); } };
struct FnRes { const float* xin; float* xout; const float* gate;
    __device__ __forceinline__ void operator()(int row, int col, f32x4 v0, f32x4 v1) const {
        const float* gp = gate + (row >> 13) * 6144 + col; const f32x4 g0 = *(const f32x4*)gp, g1 = *(const f32x4*)(gp + 4);
        const size_t off = (size_t)row * 1024 + col; const f32x4 x0 = *(const f32x4*)(xin + off), x1 = *(const f32x4*)(xin + off + 4);
        *(f32x4*)(xout + off) = x0 + (g0 + 1.0f) * v0; *(f32x4*)(xout + off + 4) = x1 + (g1 + 1.0f) * v1; } };
struct FnUp { bf16_t* O;
    __device__ __forceinline__ void operator()(int row, int col, f32x4 v0, f32x4 v1) const {
#pragma unroll
        for (int j = 0; j < 4; ++j) { const float a = fmaxf(v0[j], 0.f), b = fmaxf(v1[j], 0.f); v0[j] = a * a; v1[j] = b * b; }
        st8bf(O + (size_t)row * 4096 + col, v0, v1); } };
struct FnKv { bf16_t* O; float* FL;
    __device__ __forceinline__ void operator()(int row, int col, f32x4 v0, f32x4 v1) const {
        if (col < 2048) st8bf(O + (size_t)row * 2048 + col, v0, v1);
        else if (col < 2064) { float* p = FL + (size_t)row * 16 + (col - 2048); *(f32x4*)p = v0; *(f32x4*)(p + 4) = v1; } } };
struct FnQg { bf16_t* Q; bf16_t* G;
    __device__ __forceinline__ void operator()(int row, int col, f32x4 v0, f32x4 v1) const {
        if (col < 1024) st8bf(Q + (size_t)row * 1024 + col, v0, v1);
        else {
#pragma unroll
            for (int j = 0; j < 4; ++j) { v0[j] = sigm(v0[j]); v1[j] = sigm(v1[j]); }
            st8bf(G + (size_t)row * 1024 + (col - 1024), v0, v1); } } };
template <class Epi, class Sched, bool ALIGN_EPI = false, bool SP2 = false>
__device__ __forceinline__ void gemm_phase(PG8_LAS unsigned char* lds, const Gemm g, const Sched& S, const Epi& E, const int tid_in) {
    int tid_l = tid_in; asm volatile("" : "+v"(tid_l));
    const int tid = tid_l, wid = __builtin_amdgcn_readfirstlane(tid >> 6), lane = tid & 63, wr = wid >> 2, wc = wid & 3, fr = lane & 15, fq = lane >> 4;
    const int K = g.K, nt = K / BK;
    unsigned voffA[2], voffB[2];
#pragma unroll
    for (int i = 0; i < 2; ++i) { int R, C; stage_rc(tid * 16 + i * 8192, R, C); const int Rb = Epi::PERM ? ((R & ~31) + perm32(R & 31)) : R;
        voffA[i] = (unsigned)(R * g.lda + C) * 2u; voffB[i] = (unsigned)(Rb * g.ldb + C) * 2u; }
    const size_t kstep = (size_t)(BK * 2);
    const size_t hstepA = (size_t)HALF * g.lda * 2, hstepB = (size_t)HALF * g.ldb * 2;
    const size_t tstepA = 2 * hstepA, tstepB = 2 * hstepB;
    const unsigned ldsw = (unsigned)wid * 1024u;
    const int aoff = lds_byte(wr * 64 + fr, fq * 8), boff = lds_byte(wc * 32 + fr, fq * 8);
#define PG8_SA(b, h) (((b) * 2 + (h)) * HTB)
#define PG8_SB(b, h) ((4 + (b) * 2 + (h)) * HTB)
#define PG8_STAGE(bufoff, gbase, voff) do { _Pragma("unroll") for (int _i = 0; _i < 2; ++_i) \
        __builtin_amdgcn_global_load_lds((const unsigned*)((const char*)(gbase) + (voff)[_i]), (PG8_LAS unsigned*)(lds + (bufoff) + ldsw + _i * 8192), 16, 0, 0); } while (0)
#define PG8_LDA(dst, b, h) do { _Pragma("unroll") for (int m = 0; m < 4; ++m) _Pragma("unroll") for (int k = 0; k < 2; ++k) dst[m][k] = *(const PG8_LAS bf16x8*)(lds + PG8_SA(b, h) + aoff + m * 2048 + k * 1024); } while (0)
#define PG8_LDB(dst, b, h) do { _Pragma("unroll") for (int n = 0; n < 2; ++n) _Pragma("unroll") for (int k = 0; k < 2; ++k) dst[n][k] = *(const PG8_LAS bf16x8*)(lds + PG8_SB(b, h) + boff + n * 2048 + k * 1024); } while (0)
#define PG8_MMA(ai, bj, At, Bt) do { __builtin_amdgcn_s_setprio(1); _Pragma("unroll") for (int m = 0; m < 4; ++m) _Pragma("unroll") for (int n = 0; n < 2; ++n) _Pragma("unroll") for (int k = 0; k < 2; ++k) \
        acc[ai][bj][m][n] = __builtin_amdgcn_mfma_f32_16x16x32_bf16(Bt[n][k], At[m][k], acc[ai][bj][m][n], 0, 0, 0); __builtin_amdgcn_s_setprio(0); } while (0)
#define PG8_WAIT_V(n) asm volatile("s_waitcnt vmcnt(" #n ")" ::: "memory")
#define PG8_WAIT_L(n) asm volatile("s_waitcnt lgkmcnt(" #n ")" ::: "memory")
#define PG8_BAR __builtin_amdgcn_s_barrier()
#define PG8_SCHED __builtin_amdgcn_sched_barrier(0)
    Unit cur, nxt; int ui = 0;
    if (!S.next(0, cur)) return;
    f32x4 acc[2][2][4][2];
#pragma unroll
    for (int a = 0; a < 2; ++a)
#pragma unroll
        for (int b = 0; b < 2; ++b)
#pragma unroll
            for (int m = 0; m < 4; ++m)
#pragma unroll
                for (int n = 0; n < 2; ++n) acc[a][b][m][n] = (f32x4){0.f, 0.f, 0.f, 0.f};
    bf16x8 At[4][2], B0[2][2], B1[2][2];
    const char* cA = (const char*)g.A + (size_t)cur.pm * tstepA + (g.agrp ? (size_t)(cur.pn / g.agrp) * g.astep : (size_t)0); const char* cB = (const char*)g.Bt + (size_t)cur.pn * tstepB;
    S.a_ready(cur);
    if constexpr (SP2) {
        PG8_STAGE(PG8_SB(0, 0), cB, voffB); PG8_STAGE(PG8_SB(0, 1), cB + hstepB, voffB); PG8_STAGE(PG8_SA(0, 0), cA, voffA); PG8_STAGE(PG8_SA(0, 1), cA + hstepA, voffA);
        if (wr == 1) PG8_BAR;
        PG8_WAIT_V(2); PG8_BAR;
        PG8_STAGE(PG8_SB(1, 0), cB + kstep, voffB); PG8_STAGE(PG8_SA(1, 0), cA + kstep, voffA); PG8_STAGE(PG8_SB(1, 1), cB + hstepB + kstep, voffB);
        PG8_WAIT_V(6); PG8_BAR;
    } else {
        PG8_STAGE(PG8_SB(0, 0), cB, voffB); PG8_STAGE(PG8_SA(0, 0), cA, voffA); PG8_STAGE(PG8_SB(0, 1), cB + hstepB, voffB); PG8_STAGE(PG8_SA(0, 1), cA + hstepA, voffA);
        if (wr == 1) PG8_BAR;
        PG8_WAIT_V(4); PG8_BAR;
        PG8_STAGE(PG8_SB(1, 0), cB + kstep, voffB); PG8_STAGE(PG8_SA(1, 0), cA + kstep, voffA); PG8_STAGE(PG8_SB(1, 1), cB + hstepB + kstep, voffB);
        PG8_WAIT_V(6); PG8_BAR;
    }
    for (;;) {
        const bool has_next = S.next(ui + 1, nxt);
        const char* nA = has_next ? (const char*)g.A + (size_t)nxt.pm * tstepA + (g.agrp ? (size_t)(nxt.pn / g.agrp) * g.astep : (size_t)0) : cA; const char* nB = has_next ? (const char*)g.Bt + (size_t)nxt.pn * tstepB : cB;
        for (int t = 0; t < nt; t += 2) {
            const bool last = (t == nt - 2);
            const char* a1 = cA + (size_t)(t + 1) * kstep;
            const char* a2 = last ? nA : cA + (size_t)(t + 2) * kstep; const char* b2 = last ? nB : cB + (size_t)(t + 2) * kstep;
            const char* a3 = a2 + kstep; const char* b3 = b2 + kstep;
            if (last && has_next) S.a_ready(nxt);
            if constexpr (SP2) {
            PG8_LDB(B0, 0, 0); PG8_LDB(B1, 0, 1); PG8_SCHED; PG8_LDA(At, 0, 0); PG8_STAGE(PG8_SA(1, 1), a1 + hstepA, voffA);
            PG8_WAIT_V(8); PG8_WAIT_L(0); PG8_BAR; PG8_MMA(0, 0, At, B0); PG8_MMA(0, 1, At, B1); PG8_BAR; PG8_SCHED;
            PG8_LDA(At, 0, 1); PG8_STAGE(PG8_SB(0, 0), b2, voffB); PG8_STAGE(PG8_SB(0, 1), b2 + hstepB, voffB); PG8_STAGE(PG8_SA(0, 0), a2, voffA);
            PG8_WAIT_V(8); PG8_WAIT_L(0); PG8_BAR; PG8_MMA(1, 0, At, B0); PG8_MMA(1, 1, At, B1); PG8_BAR; PG8_SCHED;
            PG8_LDB(B0, 1, 0); PG8_LDB(B1, 1, 1); PG8_SCHED; PG8_LDA(At, 1, 0); PG8_STAGE(PG8_SA(0, 1), a2 + hstepA, voffA);
            PG8_WAIT_V(8); PG8_WAIT_L(0); PG8_BAR; PG8_MMA(0, 0, At, B0); PG8_MMA(0, 1, At, B1); PG8_BAR; PG8_SCHED;
            PG8_LDA(At, 1, 1); PG8_STAGE(PG8_SB(1, 0), b3, voffB); PG8_STAGE(PG8_SB(1, 1), b3 + hstepB, voffB); PG8_STAGE(PG8_SA(1, 0), a3, voffA);
            PG8_WAIT_V(8); PG8_WAIT_L(0); PG8_BAR; PG8_MMA(1, 0, At, B0); PG8_MMA(1, 1, At, B1); PG8_BAR; PG8_SCHED;
            } else {
            PG8_LDB(B0, 0, 0); PG8_SCHED; PG8_LDA(At, 0, 0); PG8_STAGE(PG8_SA(1, 1), a1 + hstepA, voffA);
            PG8_WAIT_L(8); PG8_BAR; PG8_WAIT_L(0); PG8_MMA(0, 0, At, B0); PG8_BAR; PG8_SCHED;
            PG8_LDB(B1, 0, 1); PG8_STAGE(PG8_SB(0, 0), b2, voffB);
            PG8_BAR; PG8_WAIT_L(0); PG8_MMA(0, 1, At, B1); PG8_BAR;
            PG8_LDA(At, 0, 1); PG8_STAGE(PG8_SA(0, 0), a2, voffA);
            PG8_BAR; PG8_WAIT_L(0); PG8_MMA(1, 0, At, B0); PG8_BAR; PG8_SCHED;
            PG8_STAGE(PG8_SB(0, 1), b2 + hstepB, voffB);
            PG8_WAIT_V(6); PG8_BAR; PG8_MMA(1, 1, At, B1); PG8_BAR;
            PG8_LDB(B0, 1, 0); PG8_SCHED; PG8_LDA(At, 1, 0); PG8_STAGE(PG8_SA(0, 1), a2 + hstepA, voffA);
            PG8_WAIT_L(8); PG8_BAR; PG8_WAIT_L(0); PG8_MMA(0, 0, At, B0); PG8_BAR; PG8_SCHED;
            PG8_LDB(B1, 1, 1); PG8_STAGE(PG8_SB(1, 0), b3, voffB);
            PG8_BAR; PG8_WAIT_L(0); PG8_MMA(0, 1, At, B1); PG8_BAR;
            PG8_LDA(At, 1, 1); PG8_STAGE(PG8_SA(1, 0), a3, voffA);
            PG8_BAR; PG8_WAIT_L(0); PG8_MMA(1, 0, At, B0); PG8_BAR; PG8_SCHED;
            PG8_STAGE(PG8_SB(1, 1), b3 + hstepB, voffB);
            PG8_WAIT_V(6); PG8_BAR; PG8_MMA(1, 1, At, B1); PG8_BAR;
            }
        }
        if constexpr (ALIGN_EPI) { if (wr == 0) PG8_BAR; }
        if constexpr (!Epi::AFTER_DRAIN) { E(acc, cur, wr, wc, fr, fq); S.done(cur); }
        if (!has_next) break;
#pragma unroll
        for (int a = 0; a < 2; ++a)
#pragma unroll
            for (int b = 0; b < 2; ++b)
#pragma unroll
                for (int m = 0; m < 4; ++m)
#pragma unroll
                    for (int n = 0; n < 2; ++n) acc[a][b][m][n] = (f32x4){0.f, 0.f, 0.f, 0.f};
        cur = nxt; cA = nA; cB = nB; ++ui;
        if constexpr (ALIGN_EPI) { if (wr == 1) PG8_BAR; }
    }
    PG8_WAIT_V(0);
    if constexpr (!ALIGN_EPI) { if (wr == 0) PG8_BAR; }
    PG8_BAR;
    if constexpr (Epi::AFTER_DRAIN) { E.fused(acc, cur, wr, wc, fr, fq, lds, wid, lane); S.done(cur); }
#undef PG8_SA
#undef PG8_SB
#undef PG8_STAGE
#undef PG8_LDA
#undef PG8_LDB
#undef PG8_MMA
#undef PG8_WAIT_V
#undef PG8_WAIT_L
#undef PG8_BAR
#undef PG8_SCHED
}
}
#include <hip/hip_bf16.h>
#include <cmath>
namespace attn_body {
using bf16=__hip_bfloat16;
using bf16x8=__attribute__((ext_vector_type(8)))short;
using s16x4=__attribute__((ext_vector_type(4)))short;
using f32x16=__attribute__((ext_vector_type(16)))float;
using u32x4=__attribute__((ext_vector_type(4)))unsigned;
constexpr int BATCH=2,NHEAD=16,SEQ=8192,D=64,DM=NHEAD*D;
constexpr int NW=8,QBLK=32,QB=QBLK*NW,KVBLK=64,NQB=SEQ/QB;
constexpr int ATTN_PITCH=DM, ATTN_UNIT_ROWS=QB;
__device__ __forceinline__ int crow(int r,int hi){return (r&3)+8*(r>>2)+4*hi;}
#define SBAR() __builtin_amdgcn_sched_barrier(0)
__device__ __forceinline__ void cmask(f32x16&p0,f32x16&p1,int jb,int qrel,int hi){
  const float NEG=-INFINITY; int kb=64*jb+4*hi;
  #pragma unroll
  for(int r=0;r<16;++r){int kv=kb+(r&3)+8*(r>>2); if(kv>qrel)p0[r]=NEG; if(kv+32>qrel)p1[r]=NEG;}
}

constexpr int NSLOT=3, SLOTB=9216;
constexpr int LDS_K=0, LDS_V=NSLOT*SLOTB, LDS_WS=2*NSLOT*SLOTB, LDS_OST=LDS_WS+NW*64*4, LDS_BYTES=LDS_OST+NW*4096;
constexpr float C2=0.125f*1.4426950408889634f;
__device__ __forceinline__ void glds16(const void*gsrc,unsigned lds_dst){unsigned keep;
  asm volatile("s_mov_b32 %0, m0\n\ts_mov_b32 m0, %2\n\ts_nop 0\n\tglobal_load_lds_dwordx4 %1, off\n\ts_mov_b32 m0, %0":"=&s"(keep):"v"(gsrc),"s"(lds_dst):"memory");}
__device__ __forceinline__ float max3f(float a,float b,float c){float r;asm("v_max3_f32 %0, %1, %2, %3":"=v"(r):"v"(a),"v"(b),"v"(c));return r;}
__device__ __forceinline__ float max2f(float a,float b){float r;asm("v_max_f32_e32 %0, %1, %2":"=v"(r):"v"(a),"v"(b));return r;}
__device__ __forceinline__ float fadd_s(float a,float b){float r;asm("v_add_f32_e32 %0, %1, %2":"=v"(r):"v"(a),"v"(b));return r;}
__device__ __forceinline__ float fsub_s(float a,float b){float r;asm("v_sub_f32_e32 %0, %1, %2":"=v"(r):"v"(a),"v"(b));return r;}
typedef float f32x2_t __attribute__((ext_vector_type(2))); typedef __bf16 bf16x2_t __attribute__((ext_vector_type(2)));
__device__ __forceinline__ unsigned cvtpk_s(float lo,float hi){f32x2_t v={lo,hi};bf16x2_t b=__builtin_convertvector(v,bf16x2_t);return __builtin_bit_cast(unsigned,b);}
#define WAIT_BAR(N) asm volatile("s_waitcnt vmcnt(" #N ") lgkmcnt(0)\n\ts_barrier":::"memory")
#define WAIT_BARW() do{ if(wid==0){WAIT_BAR(3);} else {WAIT_BAR(2);} }while(0)

__device__ __forceinline__ void qkt(f32x16&p0,f32x16&p1,const char*Kslot,const bf16x8*qr,const bf16x8 qe,const f32x16&negm,int r32,int hi){
  const char*kb=Kslot+hi*1024+r32*16;
  #pragma unroll
  for(int d0=0;d0<4;++d0){
    const bf16x8 b0=*reinterpret_cast<const bf16x8*>(kb+d0*2048);
    const bf16x8 b1=*reinterpret_cast<const bf16x8*>(kb+d0*2048+512);
    if(d0==0){p0=__builtin_amdgcn_mfma_f32_32x32x16_bf16(b0,qr[0],negm,0,0,0);p1=__builtin_amdgcn_mfma_f32_32x32x16_bf16(b1,qr[0],negm,0,0,0);}
    else{p0=__builtin_amdgcn_mfma_f32_32x32x16_bf16(b0,qr[d0],p0,0,0,0);p1=__builtin_amdgcn_mfma_f32_32x32x16_bf16(b1,qr[d0],p1,0,0,0);}}
  { const char*ke=Kslot+8192+r32*16; const bf16x8 e0=*reinterpret_cast<const bf16x8*>(ke),e1=*reinterpret_cast<const bf16x8*>(ke+512);
    p0=__builtin_amdgcn_mfma_f32_32x32x16_bf16(e0,qe,p0,0,0,0);p1=__builtin_amdgcn_mfma_f32_32x32x16_bf16(e1,qe,p1,0,0,0);}
}
typedef __attribute__((address_space(3))) const char* lds_cptr;
typedef short v4i16_t __attribute__((ext_vector_type(4)));
__device__ __forceinline__ void kload8(bf16x8*kf,lds_cptr kp){
  kf[0]=*(const __attribute__((address_space(3))) bf16x8*)(kp);      kf[1]=*(const __attribute__((address_space(3))) bf16x8*)(kp+512);
  kf[2]=*(const __attribute__((address_space(3))) bf16x8*)(kp+2048); kf[3]=*(const __attribute__((address_space(3))) bf16x8*)(kp+2560);
  kf[4]=*(const __attribute__((address_space(3))) bf16x8*)(kp+4096); kf[5]=*(const __attribute__((address_space(3))) bf16x8*)(kp+4608);
  kf[6]=*(const __attribute__((address_space(3))) bf16x8*)(kp+6144); kf[7]=*(const __attribute__((address_space(3))) bf16x8*)(kp+6656);
}
__device__ __forceinline__ void kload2(bf16x8*kf,lds_cptr kp,int j){ kf[2*j]=*(const __attribute__((address_space(3))) bf16x8*)(kp+j*2048); kf[2*j+1]=*(const __attribute__((address_space(3))) bf16x8*)(kp+j*2048+512); }
__device__ __forceinline__ s16x4 vtr(lds_cptr p){ return __builtin_bit_cast(s16x4,__builtin_amdgcn_ds_read_tr16_b64_v4i16((__attribute__((address_space(3))) v4i16_t*)p)); }
__device__ __forceinline__ float rowmax(const f32x16&p0,const f32x16&p1){
  float a=max3f(p0[0],p0[1],p1[0]),b=max3f(p0[2],p0[3],p1[1]);a=max3f(a,p1[2],p1[3]);
  #pragma unroll
  for(int r=4;r<16;r+=4){a=max3f(a,p0[r],p0[r+1]);b=max3f(b,p0[r+2],p0[r+3]);a=max3f(a,p1[r],p1[r+1]);b=max3f(b,p1[r+2],p1[r+3]);}
  const float m=max2f(a,b);
  auto rr=__builtin_amdgcn_permlane32_swap(__float_as_uint(m),__float_as_uint(m),false,false);
  return max2f(__uint_as_float(rr[0]),__uint_as_float(rr[1]));
}
__device__ __forceinline__ void pv(f32x16*o,int vb,bf16x8 pa0,bf16x8 pa1,bf16x8 pa2,bf16x8 pa3){
  #pragma unroll
  for(int d0=0;d0<2;++d0){s16x4 lo[4],hi[4];
    #pragma unroll
    for(int ks=0;ks<4;++ks){
      asm volatile("ds_read_b64_tr_b16 %0,%1 offset:%c2":"=&v"(lo[ks]):"v"(vb),"i"(d0*4096+ks*1024):"memory");
      asm volatile("ds_read_b64_tr_b16 %0,%1 offset:%c2":"=&v"(hi[ks]):"v"(vb),"i"(d0*4096+ks*1024+512):"memory");}
    asm volatile("s_waitcnt lgkmcnt(0)":::"memory");SBAR();
    #define PK(k) (bf16x8){lo[k][0],lo[k][1],lo[k][2],lo[k][3],hi[k][0],hi[k][1],hi[k][2],hi[k][3]}
    o[d0]=__builtin_amdgcn_mfma_f32_32x32x16_bf16(pa0,PK(0),o[d0],0,0,0);
    o[d0]=__builtin_amdgcn_mfma_f32_32x32x16_bf16(pa1,PK(1),o[d0],0,0,0);
    o[d0]=__builtin_amdgcn_mfma_f32_32x32x16_bf16(pa2,PK(2),o[d0],0,0,0);
    o[d0]=__builtin_amdgcn_mfma_f32_32x32x16_bf16(pa3,PK(3),o[d0],0,0,0);
    #undef PK
  }
}

#ifndef ATTN_STORE16
#define ATTN_STORE16(p,v) (*(u32x4*)(p)=(v))
#endif
template<int THRL> __device__ __forceinline__ void attn_unit(int b,int h,int qb,const bf16*Q,const bf16*__restrict__ K,const bf16*__restrict__ V,bf16*O,const bf16*__restrict__ GT,const unsigned char*__restrict__ G3,const float*__restrict__ qgain,const float kbound,char*shm,const int tid_in){
  int tid_l=tid_in; asm volatile("":"+v"(tid_l)); const int tid=tid_l,lane=tid&63,r32=lane&31,hi=lane>>5; const int wid=__builtin_amdgcn_readfirstlane(tid>>6);
  const long rowbase=(long)b*SEQ; const int q0=qb*QB;
  const bf16*Qw=Q+(rowbase+q0+wid*QBLK)*DM+h*D;
  const bf16*Kh=K+rowbase*DM+h*D,*Vh=V+rowbase*DM+h*D;
  const unsigned lds0=(unsigned)(uintptr_t)shm;
  float*wsf=(float*)(shm+LDS_WS)+wid*64;
  const bf16*ksrc=Kh+(long)lane*DM+wid*8;
  const bf16*vsrc=Vh+(long)(16*(wid&3)+(lane>>2))*DM+(wid>>2)*32+(lane&3)*8;
  const unsigned kdst=lds0+LDS_K+wid*1024, vdst=lds0+LDS_V+wid*1024, gdst=lds0+LDS_K+8192;
  const unsigned char*gsrc=G3+((long)(b*NHEAD+h)*SEQ+lane)*16;
  #define DMA_K(t,slot) do{ if(wid==0)glds16(gsrc+(long)(t)*KVBLK*16,(unsigned)__builtin_amdgcn_readfirstlane(gdst+(slot))); glds16(ksrc+(long)(t)*KVBLK*DM,(unsigned)__builtin_amdgcn_readfirstlane(kdst+(slot))); }while(0)
  #define DMA_V(t,slot) glds16(vsrc+(long)(t)*KVBLK*DM,(unsigned)__builtin_amdgcn_readfirstlane(vdst+(slot)))
  const int vb0=(int)(lds0+LDS_V)+((lane>>4)&1)*32+(lane&3)*8+(4*hi+((lane&15)>>2))*64;
  const char*Kbase=shm+LDS_K; bf16x8 kf[10];
  const lds_cptr shm3=(lds_cptr)shm; const lds_cptr kp0=shm3+LDS_K+hi*1024+r32*16; const lds_cptr kpe=shm3+LDS_K+8192+r32*16; const lds_cptr vp0=shm3+LDS_V+((lane>>4)&1)*32+(lane&3)*8+(4*hi+((lane&15)>>2))*64;
  const int NT=(q0+QB)/KVBLK;
  DMA_K(0,0);DMA_V(0,0);DMA_K(1,SLOTB);
  bf16x8 qr[4]; float fq2; bf16x8 qe; float ubound;
  { bf16x8 qraw[4];
    #pragma unroll
    for(int d0=0;d0<4;++d0)qraw[d0]=*reinterpret_cast<const bf16x8*>(&Qw[(long)r32*DM+d0*16+hi*8]);
    const u32x4 ge=*reinterpret_cast<const u32x4*>(G3+((long)(b*NHEAD+h)*SEQ+q0+wid*QBLK+r32)*16);
    fq2=-(__uint_as_float(ge[0]<<16)+__uint_as_float(ge[0]&0xffff0000u)+__uint_as_float(ge[1]<<16));
    float ss=0.f;
    #pragma unroll
    for(int d0=0;d0<4;++d0)
      #pragma unroll
      for(int j=0;j<8;++j){const float x=__uint_as_float(((unsigned)(unsigned short)qraw[d0][j])<<16);ss+=x*x;}
    {auto rr=__builtin_amdgcn_permlane32_swap(__float_as_uint(ss),__float_as_uint(ss),false,false);ss=__uint_as_float(rr[0])+__uint_as_float(rr[1]);}
    const float qs=C2/sqrtf(ss*(1.0f/64.0f)+1e-6f);
    float s2=0.f;
    #pragma unroll
    for(int d0=0;d0<4;++d0){ u32x4 w;
      #pragma unroll
      for(int j=0;j<8;j+=2){const float x0=__uint_as_float(((unsigned)(unsigned short)qraw[d0][j])<<16),x1=__uint_as_float(((unsigned)(unsigned short)qraw[d0][j+1])<<16);
        const float y0=x0*qs*qgain[d0*16+hi*8+j],y1=x1*qs*qgain[d0*16+hi*8+j+1]; s2+=y0*y0+y1*y1;
        w[j>>1]=cvtpk_s(y0,y1);}
      qr[d0]=__builtin_bit_cast(bf16x8,w);}
    {auto rr=__builtin_amdgcn_permlane32_swap(__float_as_uint(s2),__float_as_uint(s2),false,false);s2=__uint_as_float(rr[0])+__uint_as_float(rr[1]);}
    ubound=sqrtf(s2)*kbound;
    const unsigned one2=hi?0u:0x3f803f80u, one1=hi?0u:0x00003f80u; qe=__builtin_bit_cast(bf16x8,(u32x4){one2,one1,0u,0u}); }
  float mhat=ubound,l_reg=0.f;f32x16 o[2];o[0]=f32x16{};o[1]=f32x16{};f32x16 negm;
  #pragma unroll
  for(int r=0;r<16;++r)negm[r]=fq2-ubound;
  asm volatile("":"+v"(negm));
  const int qrel=wid*QBLK+r32;
  #define CMASK(P0,P1,t) do{int jb_=(t)-(NT-4); if(jb_>=0)cmask(P0,P1,jb_,qrel,hi);}while(0)
  bool resc=false;
  #define START(P0,P1) do{ const float rm=rowmax(P0,P1); resc=false; \
    { const float dl=fmaxf(rm,0.f); mhat=fadd_s(mhat,dl); \
      _Pragma("unroll") for(int r=0;r<16;++r){P0[r]=fsub_s(P0[r],dl);P1[r]=fsub_s(P1[r],dl);} \
      _Pragma("unroll") for(int r=0;r<16;++r)negm[r]=fq2-mhat; asm volatile("":"+v"(negm)); } \
    _Pragma("unroll") for(int r=0;r<16;++r)P0[r]=__builtin_amdgcn_exp2f(P0[r]); }while(0)
  #define RESC() do{ if(resc){ asm volatile("s_waitcnt lgkmcnt(0)":::"memory"); \
      _Pragma("unroll") for(int d_=0;d_<2;++d_) _Pragma("unroll") for(int r=0;r<16;++r)o[d_][r]*=wsf[crow(r,hi)]; } }while(0)
  f32x16 pA0,pA1,pB0,pB1;
  int sl_prev=0,sl_cur=0,sl_next=SLOTB;
  #define ROT() do{sl_prev=sl_cur;sl_cur=sl_next;sl_next=(sl_next==(NSLOT-1)*SLOTB)?0:sl_next+SLOTB;}while(0)
  DMA_K(2,2*SLOTB);
  WAIT_BAR(3);
  qkt(pA0,pA1,Kbase,qr,qe,negm,r32,hi);asm volatile("s_nop 15\n\ts_nop 7":"+v"(pA0),"+v"(pA1));CMASK(pA0,pA1,0);
  START(pA0,pA1);
  _Pragma("unroll") for(int r=0;r<16;++r)pA1[r]=__builtin_amdgcn_exp2f(pA1[r]);
  WAIT_BAR(0);
  DMA_K(3,0);DMA_V(1,SLOTB);
  ROT();
  kload8(kf,kp0+sl_cur);
  kf[8]=*(const __attribute__((address_space(3))) bf16x8*)(kpe+sl_cur); kf[9]=*(const __attribute__((address_space(3))) bf16x8*)(kpe+sl_cur+512);
  WAIT_BARW();
  s16x4 vlo[8],vhi[8]; u32x4 pw0,pw1,pw2,pw3;
  #define PKW(P,B) cvtpk_s(P[B],P[B+1])
  #define PAF(k) __builtin_bit_cast(bf16x8,pw##k)
  #define VFR(i) (bf16x8){vlo[i][0],vlo[i][1],vlo[i][2],vlo[i][3],vhi[i][0],vhi[i][1],vhi[i][2],vhi[i][3]}
  #define PIN(x) asm volatile("":"+v"(x))
  #define MX3(a,b,c) __builtin_fmaxf(__builtin_fmaxf((a),(b)),(c))
  #define GAPA(MF,A0,A1,A2,A3,W0,W1,PW) do{ MF; sacc+=A0; sacc+=A1; sacc+=A2; sacc+=A3; PIN(sacc); W0; W1; PIN(PW); SBAR(); }while(0)
  #define EX(v) __builtin_amdgcn_exp2f(v)
  #define GAPB(MF,X,B) do{ MF; X[B]=EX(X[B]); X[B+1]=EX(X[B+1]); X[B+2]=EX(X[B+2]); X[B+3]=EX(X[B+3]); PIN(X); SBAR(); }while(0)
  #define VRD(i) do{ vlo[i]=vtr(vp_+(((i)>>2)*4096+((i)&3)*1024)); vhi[i]=vtr(vp_+(((i)>>2)*4096+((i)&3)*1024+512)); }while(0)
  #define KRD(G,j) do{ if(G){ kload2(kf,kp0+sl_next,j); SBAR(); } }while(0)
  #define STEP(C0,C1,P0,P1,t,GK,GV,GL) do{ SBAR(); \
    const lds_cptr vp_=vp0+sl_prev; \
    VRD(0); SBAR(); float sacc=(P0[0]+P0[1]); \
    GAPA(C0=__builtin_amdgcn_mfma_f32_32x32x16_bf16(kf[0],qr[0],negm,0,0,0), P0[2],P0[3],P0[4],P0[5],     pw0[0]=PKW(P0,0), pw0[1]=PKW(P0,2), pw0); \
    VRD(4); SBAR(); GAPA(C1=__builtin_amdgcn_mfma_f32_32x32x16_bf16(kf[1],qr[0],negm,0,0,0), P0[6],P0[7],P0[8],P0[9],     pw0[2]=PKW(P0,4), pw0[3]=PKW(P0,6), pw0); \
    VRD(1); SBAR(); GAPA(C0=__builtin_amdgcn_mfma_f32_32x32x16_bf16(kf[2],qr[1],C0,0,0,0),   P0[10],P0[11],P0[12],P0[13], pw1[0]=PKW(P0,8), pw1[1]=PKW(P0,10), pw1); \
    VRD(5); SBAR(); GAPA(C1=__builtin_amdgcn_mfma_f32_32x32x16_bf16(kf[3],qr[1],C1,0,0,0),   P0[14],P0[15],P1[0],P1[1],   pw1[2]=PKW(P0,12),pw1[3]=PKW(P0,14), pw1); \
    VRD(2); SBAR(); GAPA(C0=__builtin_amdgcn_mfma_f32_32x32x16_bf16(kf[4],qr[2],C0,0,0,0),   P1[2],P1[3],P1[4],P1[5],     pw2[0]=PKW(P1,0), pw2[1]=PKW(P1,2), pw2); \
    VRD(6); SBAR(); GAPA(C1=__builtin_amdgcn_mfma_f32_32x32x16_bf16(kf[5],qr[2],C1,0,0,0),   P1[6],P1[7],P1[8],P1[9],     pw2[2]=PKW(P1,4), pw2[3]=PKW(P1,6), pw2); \
    VRD(3); SBAR(); GAPA(C0=__builtin_amdgcn_mfma_f32_32x32x16_bf16(kf[6],qr[3],C0,0,0,0),   P1[10],P1[11],P1[12],P1[13], pw3[0]=PKW(P1,8), pw3[1]=PKW(P1,10), pw3); \
    VRD(7); SBAR(); GAPA(C1=__builtin_amdgcn_mfma_f32_32x32x16_bf16(kf[7],qr[3],C1,0,0,0),   P1[14],P1[15],0.f,0.f,       pw3[2]=PKW(P1,12),pw3[3]=PKW(P1,14), pw3); \
    C0=__builtin_amdgcn_mfma_f32_32x32x16_bf16(kf[8],qe,C0,0,0,0); C1=__builtin_amdgcn_mfma_f32_32x32x16_bf16(kf[9],qe,C1,0,0,0); \
    l_reg+=sacc; \
    if(GK){DMA_K((t)+3,sl_cur);} if(GV){DMA_V((t)+1,sl_next);} \
    CMASK(C0,C1,t); \
    { float a=MX3(C0[0],C0[1],C1[0]),b=MX3(C0[2],C0[3],C1[1]); a=MX3(a,C1[2],C1[3]); \
      _Pragma("unroll") for(int r=4;r<16;r+=4){a=MX3(a,C0[r],C0[r+1]);b=MX3(b,C0[r+2],C0[r+3]);a=MX3(a,C1[r],C1[r+1]);b=MX3(b,C1[r+2],C1[r+3]);} \
      float rm=__builtin_fmaxf(a,b); { auto rr=__builtin_amdgcn_permlane32_swap(__float_as_uint(rm),__float_as_uint(rm),false,false); rm=__builtin_fmaxf(__uint_as_float(rr[0]),__uint_as_float(rr[1])); } \
      resc=false; \
      if(__builtin_expect(__any(rm>(float)THRL),0)){ const float dl=__builtin_fmaxf(rm,0.f); mhat+=dl; \
        _Pragma("unroll") for(int r=0;r<16;++r){C0[r]-=dl;C1[r]-=dl;} \
        _Pragma("unroll") for(int r=0;r<16;++r)negm[r]=fq2-mhat; asm volatile("":"+v"(negm)); \
        const float f=__builtin_amdgcn_exp2f(-dl); l_reg*=f; if(hi==0)wsf[r32]=f; resc=true; } } \
    SBAR(); \
    GAPB(o[0]=__builtin_amdgcn_mfma_f32_32x32x16_bf16(PAF(0),VFR(0),o[0],0,0,0), C0,0); \
    GAPB(o[1]=__builtin_amdgcn_mfma_f32_32x32x16_bf16(PAF(0),VFR(4),o[1],0,0,0), C0,4); \
    KRD(GL,0); GAPB(o[0]=__builtin_amdgcn_mfma_f32_32x32x16_bf16(PAF(1),VFR(1),o[0],0,0,0), C0,8); \
    KRD(GL,1); GAPB(o[1]=__builtin_amdgcn_mfma_f32_32x32x16_bf16(PAF(1),VFR(5),o[1],0,0,0), C0,12); \
    KRD(GL,2); GAPB(o[0]=__builtin_amdgcn_mfma_f32_32x32x16_bf16(PAF(2),VFR(2),o[0],0,0,0), C1,0); \
    KRD(GL,3); GAPB(o[1]=__builtin_amdgcn_mfma_f32_32x32x16_bf16(PAF(2),VFR(6),o[1],0,0,0), C1,4); \
    if(GL){ kf[8]=*(const __attribute__((address_space(3))) bf16x8*)(kpe+sl_next); kf[9]=*(const __attribute__((address_space(3))) bf16x8*)(kpe+sl_next+512); SBAR(); } \
    GAPB(o[0]=__builtin_amdgcn_mfma_f32_32x32x16_bf16(PAF(3),VFR(3),o[0],0,0,0), C1,8); \
    GAPB(o[1]=__builtin_amdgcn_mfma_f32_32x32x16_bf16(PAF(3),VFR(7),o[1],0,0,0), C1,12); \
    }while(0)
  int t=1;
  #undef CMASK
  #define CMASK(P0,P1,t) do{}while(0)
  for(;t+5<NT;t+=2){
    STEP(pB0,pB1,pA0,pA1,t,true,true,true);     WAIT_BARW(); RESC(); ROT();
    STEP(pA0,pA1,pB0,pB1,t+1,true,true,true);   WAIT_BARW(); RESC(); ROT();
  }
  #undef CMASK
  #define CMASK(P0,P1,t) do{int jb_=(t)-(NT-4); if(jb_>=0)cmask(P0,P1,jb_,qrel,hi);}while(0)
  #define ENDW(tt) do{ if((tt)+3<NT){WAIT_BARW();} else if((tt)+2<NT){WAIT_BAR(1);} else {WAIT_BAR(0);} }while(0)
  for(;t+1<NT;t+=2){
    STEP(pB0,pB1,pA0,pA1,t,(t+3<NT),(t+1<NT),(t+1<NT));       ENDW(t);   RESC(); ROT();
    STEP(pA0,pA1,pB0,pB1,t+1,(t+4<NT),(t+2<NT),(t+2<NT));     ENDW(t+1); RESC(); ROT();
  }
  STEP(pB0,pB1,pA0,pA1,NT-1,false,false,false); RESC();
  { float sacc=pB0[0]+pB0[1]; _Pragma("unroll") for(int r=2;r<16;++r)sacc+=pB0[r]; _Pragma("unroll") for(int r=0;r<16;++r)sacc+=pB1[r]; l_reg+=sacc;
    pw0=(u32x4){PKW(pB0,0),PKW(pB0,2),PKW(pB0,4),PKW(pB0,6)};pw1=(u32x4){PKW(pB0,8),PKW(pB0,10),PKW(pB0,12),PKW(pB0,14)};pw2=(u32x4){PKW(pB1,0),PKW(pB1,2),PKW(pB1,4),PKW(pB1,6)};pw3=(u32x4){PKW(pB1,8),PKW(pB1,10),PKW(pB1,12),PKW(pB1,14)};
    SBAR(); pv(o,vb0+sl_cur,PAF(0),PAF(1),PAF(2),PAF(3)); }
  #undef PKW
  #undef PAF
  #undef VFR
  #undef PIN
  #undef MX3
  #undef GAPA
  #undef GAPB
  #undef EX
  #undef VRD
  #undef KRD
  #undef STEP
  #undef ENDW
  {auto rr=__builtin_amdgcn_permlane32_swap(__float_as_uint(l_reg),__float_as_uint(l_reg),false,false);l_reg=__uint_as_float(rr[0])+__uint_as_float(rr[1]);}
  if(hi==0)wsf[32+r32]=l_reg;asm volatile("s_waitcnt lgkmcnt(0)":::"memory");
  float rli[16];
  #pragma unroll
  for(int r=0;r<16;++r)rli[r]=__builtin_amdgcn_rcpf(wsf[32+crow(r,hi)]);
  bf16*Ow=O+(rowbase+q0+wid*QBLK)*DM+h*D;
  { bf16*stg=(bf16*)(shm+LDS_OST)+wid*2048;
    #pragma unroll
    for(int r=0;r<16;++r){const int orow=crow(r,hi);
      #pragma unroll
      for(int d0=0;d0<2;++d0)stg[orow*64+d0*32+r32]=__float2bfloat16(o[d0][r]*rli[r]);}
    asm volatile("s_waitcnt lgkmcnt(0)":::"memory");
    const bf16*Gw=GT+(rowbase+q0+wid*QBLK)*DM+h*D;
    #pragma unroll
    for(int i=0;i<4;++i){const int row=i*8+(lane>>3),ch=lane&7; u32x4 v=*(const u32x4*)(stg+row*64+ch*8); const u32x4 gg=*(const u32x4*)(Gw+(long)row*DM+ch*8);
      #pragma unroll
      for(int j=0;j<4;++j){ v[j]=cvtpk_s(__uint_as_float(v[j]<<16)*__uint_as_float(gg[j]<<16),__uint_as_float(v[j]&0xffff0000u)*__uint_as_float(gg[j]&0xffff0000u)); }
      ATTN_STORE16(Ow+(long)row*DM+ch*8,v);} }
  asm volatile("s_waitcnt lgkmcnt(0)\n\ts_barrier":::"memory");
  #undef DMA_K
  #undef DMA_V
  #undef CMASK
  #undef START
  #undef RESC
  #undef ROT
}
constexpr int ATTN_LDS_BYTES=LDS_BYTES;
struct AttnTensors { const bf16* Q; const bf16* K; const bf16* V; bf16* O; const bf16* GT; const unsigned char* G3; const float* qgain; float kbound; };
struct AttnUnit { int bh; int qb; };
struct StaticOrder {
  int vcu;
  __device__ __forceinline__ explicit StaticOrder(int grid,int block):vcu((block%8)*(grid/8)+block/8){}
  __device__ __forceinline__ bool next(int i,AttnUnit&u)const{ if(i>=4)return false; const int s=vcu&7; u.bh=vcu>>3; u.qb=(i==0)?s:(i==1)?15-s:(i==2)?16+s:31-s; return true; }
  __device__ __forceinline__ void a_ready(const AttnUnit&)const{}
  __device__ __forceinline__ void done(const AttnUnit&)const{}
};
template<class Sched,int THRL=8> __device__ __forceinline__ void attn_phase(char*lds,const AttnTensors&T,const Sched&S,const int tid_in){
  AttnUnit u;
  for(int i=0;S.next(i,u);++i){ S.a_ready(u); attn_unit<THRL>(u.bh/NHEAD,u.bh%NHEAD,u.qb,T.Q,T.K,T.V,T.O,T.GT,T.G3,T.qgain,T.kbound,lds,tid_in); S.done(u); }
}
#undef SBAR
#undef WAIT_BAR
#undef WAIT_BARW
}
constexpr int NWAVES = 8;
constexpr int BATCH = 2, T = 8192, D = 1024, H = 16, HD = 64, FF = 4096, M = BATCH * T;
constexpr int N1 = 3584, K1 = 2048, NP2 = 3072;
constexpr size_t MiB = 1u << 20;
constexpr size_t WS_MOD = 0;
constexpr size_t WS_W1 = 1 * MiB;
constexpr size_t WS_W2A = 29 * MiB;
constexpr size_t WS_W2G = 32 * MiB;
constexpr size_t WS_WO = 33 * MiB;
constexpr size_t WS_WKV = 37 * MiB;
constexpr size_t WS_WQG = 42 * MiB;
constexpr size_t WS_WO2 = 50 * MiB;
constexpr size_t WS_WUP = 54 * MiB, WS_WDN = 62 * MiB;
constexpr size_t WS_G3 = 70 * MiB;
constexpr size_t WS_FL = 74 * MiB;
constexpr size_t WS_H2 = 76 * MiB;
constexpr size_t WS_P1 = 140 * MiB;
constexpr size_t WS_P2 = 252 * MiB;
constexpr size_t WS_VF = 348 * MiB;
constexpr size_t WS_HB = 140 * MiB;
constexpr size_t WS_KVRAW = 140 * MiB, WS_QB = 204 * MiB, WS_GT = 236 * MiB, WS_VS = 316 * MiB, WS_KS = 348 * MiB;
constexpr size_t WS_END = 380 * MiB;
constexpr int LDS_BYTES = 147456;

#define GAS __attribute__((address_space(1)))
#define LAS __attribute__((address_space(3)))
typedef unsigned short bf16;
typedef unsigned v4u __attribute__((ext_vector_type(4)));
typedef unsigned v2u __attribute__((ext_vector_type(2)));
typedef float f32x4 __attribute__((ext_vector_type(4)));
using pg8::pkbf; using pg8::bflo; using pg8::bfhi; using pg8::sigm;

struct Args { const float* in[39]; float* out; unsigned char* ws; int ph_lo, ph_hi; };

struct Frame { LAS unsigned char* lds; int tid, lane, wave, vcu, G, bx; unsigned char* ws; float* out; const float* const* in; };

__device__ __forceinline__ void tr_item(const float* W, int ldw, int Nvalid, bf16* WT, int ldt, int row_off, int col_off, const float* mu, LAS float* scr, int item, int lane) {
    const int nblk = (Nvalid + 31) / 32, kb = item / nblk, nb = item % nblk, k0 = 64 * kb, n0 = 32 * nb;
    { float t[32]; const int n = n0 + (lane & 31); const bool ok = n < Nvalid; const float* wp = W + (size_t)(k0 + (lane >> 5)) * ldw + n;
#pragma unroll
      for (int i = 0; i < 32; ++i) t[i] = ok ? wp[(size_t)(2 * i) * ldw] : 0.f;
#pragma unroll
      for (int i = 0; i < 32; ++i) scr[(2 * i + (lane >> 5)) * 33 + (lane & 31)] = t[i]; }
    asm volatile("s_waitcnt lgkmcnt(0)" ::: "memory");
    const int c = lane & 7;
    float s0[8], s1[8];
#pragma unroll
    for (int q = 0; q < 8; ++q) { const float m = mu ? mu[k0 + 8 * c + q] : 0.f; s0[q] = 1.f - m; s1[q] = m; }
#pragma unroll
    for (int j = 0; j < 4; ++j) { const int n = (lane >> 3) + 8 * j; const LAS float* s = scr + (8 * c) * 33 + n;
        float v[8];
#pragma unroll
        for (int q = 0; q < 8; ++q) v[q] = s[q * 33];
        v4u o; o.x = pkbf(v[0] * s0[0], v[1] * s0[1]); o.y = pkbf(v[2] * s0[2], v[3] * s0[3]); o.z = pkbf(v[4] * s0[4], v[5] * s0[5]); o.w = pkbf(v[6] * s0[6], v[7] * s0[7]);
        bf16* dst = WT + (size_t)(row_off + n0 + n) * ldt + col_off + k0 + 8 * c;
        *(v4u*)dst = o;
        if (mu) { v4u p; p.x = pkbf(v[0] * s1[0], v[1] * s1[1]); p.y = pkbf(v[2] * s1[2], v[3] * s1[3]); p.z = pkbf(v[4] * s1[4], v[5] * s1[5]); p.w = pkbf(v[6] * s1[6], v[7] * s1[7]); *(v4u*)(dst + 1024) = p; } }
    asm volatile("s_waitcnt lgkmcnt(0)" ::: "memory");
}
__device__ __forceinline__ float dpp_f(float x, const int ctrl_sel) {
    switch (ctrl_sel) {
        case 0: return __builtin_bit_cast(float, __builtin_amdgcn_update_dpp(0, __builtin_bit_cast(int, x), 0xB1, 0xf, 0xf, false));
        case 1: return __builtin_bit_cast(float, __builtin_amdgcn_update_dpp(0, __builtin_bit_cast(int, x), 0x4E, 0xf, 0xf, false));
        case 2: return __builtin_bit_cast(float, __builtin_amdgcn_update_dpp(0, __builtin_bit_cast(int, x), 0x141, 0xf, 0xf, false));
        default: return __builtin_bit_cast(float, __builtin_amdgcn_update_dpp(0, __builtin_bit_cast(int, x), 0x140, 0xf, 0xf, false));
    }
}
__device__ __forceinline__ float sum4(float x) { x += dpp_f(x, 0); x += dpp_f(x, 1); return x; }
__device__ __forceinline__ float sum8(float x) { x = sum4(x); x += dpp_f(x, 2); return x; }
__device__ __forceinline__ float sum16(float x) { x = sum8(x); x += dpp_f(x, 3); return x; }
__device__ __forceinline__ float wave_sum(float v) {
    v = sum16(v);
    { auto rr = __builtin_amdgcn_permlane16_swap(__float_as_uint(v), __float_as_uint(v), false, false); v = __uint_as_float(rr[0]) + __uint_as_float(rr[1]); }
    { auto rr = __builtin_amdgcn_permlane32_swap(__float_as_uint(v), __float_as_uint(v), false, false); v = __uint_as_float(rr[0]) + __uint_as_float(rr[1]); }
    return v;
}
__device__ __forceinline__ void norm_row(const float* xrow, const float* g, const float* sh, const float* sc, int lane, f32x4 (&v)[4]) {
    float s = 0.f;
#pragma unroll
    for (int j = 0; j < 4; ++j) { v[j] = *((const f32x4*)xrow + lane + 64 * j); s += (v[j].x * v[j].x + v[j].y * v[j].y) + (v[j].z * v[j].z + v[j].w * v[j].w); }
    const float rstd = 1.0f / sqrtf(wave_sum(s) * (1.f / D) + 1e-6f);
#pragma unroll
    for (int j = 0; j < 4; ++j) { const f32x4 gg = *((const f32x4*)g + lane + 64 * j);
        f32x4 a = {1.f, 1.f, 1.f, 1.f}, b = {0.f, 0.f, 0.f, 0.f}; if (sc) { a = *((const f32x4*)sc + lane + 64 * j) + 1.0f; b = *((const f32x4*)sh + lane + 64 * j); }
        v[j] = (v[j] * rstd * gg) * a + b; }
}
__device__ __forceinline__ void st_row_bf16(bf16* orow, int lane, const f32x4 (&v)[4]) {
#pragma unroll
    for (int j = 0; j < 4; ++j) { v2u w; w.x = pkbf(v[j].x, v[j].y); w.y = pkbf(v[j].z, v[j].w); *((v2u*)orow + lane + 64 * j) = w; }
}
__device__ __forceinline__ void p0_mod(Frame& F) {
    LAS float* ca = (LAS float*)F.lds; LAS float* red = (LAS float*)(F.lds + 8192);
    const float* cin = F.in[1];
    for (int i = F.tid; i < 2048; i += 512) { const float c = cin[i]; ca[i] = c / (1.0f + __expf(-c)); }
    __syncthreads();
    float* MOD = (float*)(F.ws + WS_MOD); float* MODKV = MOD + 4 * 2 * 6144;
    for (int item = F.bx; item < 208; item += F.G) {
        const int col = item * 128; const float* W; const float* bias; int ldw, cw; float* dst0; float* dst1;
        if (col < 24576) { const int l = col / 6144; cw = col % 6144; W = F.in[2] + (size_t)l * 1024 * 6144; ldw = 6144; bias = F.in[3] + l * 6144; dst0 = MOD + (l * 2 + 0) * 6144 + cw; dst1 = MOD + (l * 2 + 1) * 6144 + cw; }
        else { cw = col - 24576; W = F.in[30]; ldw = 2048; bias = F.in[31]; dst0 = MODKV + cw; dst1 = MODKV + 2048 + cw; }
        const int c4 = F.tid & 31, ks = F.tid >> 5;
        f32x4 a0 = {0.f, 0.f, 0.f, 0.f}, a1 = {0.f, 0.f, 0.f, 0.f};
#pragma unroll 8
        for (int k = ks * 64; k < ks * 64 + 64; ++k) { const f32x4 w = *(const f32x4*)(W + (size_t)k * ldw + cw + c4 * 4); a0 += w * ca[k]; a1 += w * ca[1024 + k]; }
        *(LAS f32x4*)(red + (ks * 32 + c4) * 8) = a0; *(LAS f32x4*)(red + (ks * 32 + c4) * 8 + 4) = a1;
        __syncthreads();
        if (F.tid < 256) { const int b = F.tid >> 7, c = F.tid & 127; float s = 0.f;
#pragma unroll
            for (int q = 0; q < 16; ++q) s += red[(q * 32 + (c >> 2)) * 8 + b * 4 + (c & 3)];
            (b ? dst1 : dst0)[c] = s + bias[cw + c]; }
        __syncthreads();
    }
}
__device__ __forceinline__ void p0_weights(Frame& F) {
    LAS float* scr = (LAS float*)(F.lds + 16384 + F.wave * 16384);
    const int gw = F.vcu * NWAVES + F.wave, NGW = F.G * NWAVES;
    bf16* W1 = (bf16*)(F.ws + WS_W1); bf16* WO = (bf16*)(F.ws + WS_WO); bf16* WKV = (bf16*)(F.ws + WS_WKV); bf16* WQG = (bf16*)(F.ws + WS_WQG); bf16* WO2 = (bf16*)(F.ws + WS_WO2);
    const float* mu = F.in[8];
    constexpr int PL = 512 * 3 + 32 + 32 + 16 + 80 + 512;
    constexpr int NIT = 2 * PL + 512 + 512 + 16 + 2 * (1024 + 512);
    for (int it = gw; it < NIT; it += NGW) {
        int r = it;
        if (r < 2 * PL) { const int i = r / PL; r -= i * PL; bf16* w1 = W1 + (size_t)i * N1 * K1; const float* m6 = mu + i * 6 * 1024;
            bf16* wl = w1 + (size_t)3072 * 1024;
            if (r < 512) { tr_item(F.in[9] + (size_t)i * D * D, D, D, w1, D, 0, 0, nullptr, scr, r, F.lane); continue; } r -= 512;
            if (r < 512) { tr_item(F.in[10] + (size_t)i * D * D, D, D, w1, D, 1024, 0, nullptr, scr, r, F.lane); continue; } r -= 512;
            if (r < 512) { tr_item(F.in[11] + (size_t)i * D * D, D, D, w1, D, 2048, 0, nullptr, scr, r, F.lane); continue; } r -= 512;
            if (r < 32) { tr_item(F.in[14] + (size_t)i * D * 64, 64, 64, wl, K1, 0, 0, m6 + 1 * 1024, scr, r, F.lane); continue; } r -= 32;
            if (r < 32) { tr_item(F.in[17] + (size_t)i * D * 64, 64, 64, wl, K1, 64, 0, m6 + 4 * 1024, scr, r, F.lane); continue; } r -= 32;
            if (r < 16) { if (i == 1) tr_item(F.in[27], 32, 32, wl, K1, 128, 0, m6 + 3 * 1024, scr, r, F.lane); continue; } r -= 16;
            if (r < 80) { tr_item(F.in[19] + (size_t)i * D * 160, 160, 160, wl, K1, 160, 0, m6 + 5 * 1024, scr, r, F.lane); continue; } r -= 80;
            tr_item(F.in[12] + (size_t)i * D * D, D, D, WO + (size_t)i * D * D, D, 0, 0, nullptr, scr, r, F.lane); continue; }
        r -= 2 * PL;
        if (r < 512) { tr_item(F.in[32], 2064, 1024, WKV, D, 0, 0, nullptr, scr, r, F.lane); continue; } r -= 512;
        if (r < 512) { tr_item(F.in[32] + 1024, 2064, 1024, WKV, D, 1024, 0, nullptr, scr, r, F.lane); continue; } r -= 512;
        if (r < 16) { tr_item(F.in[32] + 2048, 2064, 16, WKV, D, 2048, 0, nullptr, scr, r, F.lane); continue; } r -= 16;
        { const int j = r / 1536; r -= j * 1536;
          if (r < 1024) tr_item(F.in[35] + (size_t)j * D * 2048, 2048, 2048, WQG + (size_t)j * 2048 * D, D, 0, 0, nullptr, scr, r, F.lane);
          else tr_item(F.in[37] + (size_t)j * D * D, D, D, WO2 + (size_t)j * D * D, D, 0, 0, nullptr, scr, r - 1024, F.lane); }
    }
    const int gt = F.bx * 512 + F.tid, NT = F.G * 512; const v4u z = {0u, 0u, 0u, 0u};
    for (int e = gt; e < 135168; e += NT) {
        int r = e; bf16* p;
        if (r < 98304) { const int i = r / 49152; r -= i * 49152; p = W1 + (size_t)i * N1 * K1 + (size_t)3072 * 1024 + (size_t)320 * K1 + (size_t)r * 8; }
        else if (r < 98304 + 8192) { r -= 98304; p = W1 + (size_t)3072 * 1024 + (size_t)128 * K1 + (size_t)r * 8; }
        else { r -= 98304 + 8192; p = WKV + (size_t)2080 * D + (size_t)r * 8; }
        *(v4u*)p = z; }
    { float* B2 = (float*)(F.ws + WS_MOD) + 53248;
      for (int e = gt; e < 2 * 3072; e += NT) { const int i = e / 3072, n = e % 3072, grp = n >> 10, c = n & 1023;
          B2[e] = grp == 0 ? F.in[13][i * D + c] : (grp == 1 ? F.in[16][i * D + c] : (i == 1 ? F.in[26][c] : 0.f)); } }
    bf16* W2A = (bf16*)(F.ws + WS_W2A); bf16* W2G = (bf16*)(F.ws + WS_W2G);
    for (int e4 = gt; e4 < 2 * 262144; e4 += NT) {
        const int i = e4 >> 18; int r = (e4 & 262143) * 4;
        if (r < 786432) { const int k = r / 3072, n = r % 3072, grp = n >> 10, c = n & 1023; f32x4 v = {0.f, 0.f, 0.f, 0.f};
            if (grp == 0) { if (k < 64) v = *(const f32x4*)(F.in[15] + ((size_t)i * 64 + k) * 1024 + c); }
            else if (grp == 1) { if (k >= 64 && k < 128) v = *(const f32x4*)(F.in[18] + ((size_t)i * 64 + (k - 64)) * 1024 + c); }
            else { if (i == 1 && k >= 128 && k < 160) v = *(const f32x4*)(F.in[28] + (size_t)(k - 128) * 1024 + c); }
            bf16* o = W2A + (size_t)i * 3072 * 256 + (size_t)n * 256 + k; const unsigned p0 = pkbf(v.x, v.y), p1 = pkbf(v.z, v.w);
            o[0] = (bf16)(p0 & 0xffffu); o[256] = (bf16)(p0 >> 16); o[512] = (bf16)(p1 & 0xffffu); o[768] = (bf16)(p1 >> 16); }
        else { r -= 786432; const int k = r >> 10, n = r & 1023; f32x4 v = {0.f, 0.f, 0.f, 0.f}; if (k < 160) v = *(const f32x4*)(F.in[20] + ((size_t)i * 160 + k) * 1024 + n);
            bf16* o = W2G + (size_t)i * 1024 * 256 + (size_t)n * 256 + k; const unsigned p0 = pkbf(v.x, v.y), p1 = pkbf(v.z, v.w);
            o[0] = (bf16)(p0 & 0xffffu); o[256] = (bf16)(p0 >> 16); o[512] = (bf16)(p1 & 0xffffu); o[768] = (bf16)(p1 >> 16); }
    }
}
__device__ __forceinline__ void mlp_weights(Frame& F, int L) {
    LAS float* scr = (LAS float*)(F.lds + F.wave * 16384);
    const int gw = F.vcu * NWAVES + F.wave, NGW = F.G * NWAVES;
    bf16* WUP = (bf16*)(F.ws + WS_WUP); bf16* WDN = (bf16*)(F.ws + WS_WDN);
    for (int it = gw; it < 4096; it += NGW) {
        if (it < 2048) tr_item(F.in[6] + (size_t)L * D * FF, FF, FF, WUP, D, 0, 0, nullptr, scr, it, F.lane);
        else tr_item(F.in[7] + (size_t)L * FF * D, D, D, WDN, FF, 0, 0, nullptr, scr, it - 2048, F.lane);
    }
}
__device__ __forceinline__ void norm_phase(Frame& F, const float* xin, const float* g, const float* sh, const float* sc, int bstride, int mode, bf16* dst, float* outf = nullptr) {
    const int gw = F.vcu * NWAVES + F.wave, NGW = F.G * NWAVES, lane = F.lane; (void)mode;
    for (int base = gw * 8; base < M; base += NGW * 8) {
        const int b = base >> 13;
        f32x4 gg[4], aa[4], bb[4];
#pragma unroll
        for (int j = 0; j < 4; ++j) { gg[j] = *((const f32x4*)g + lane + 64 * j);
            aa[j] = sc ? *((const f32x4*)(sc + b * bstride) + lane + 64 * j) + 1.0f : (f32x4){1.f, 1.f, 1.f, 1.f}; bb[j] = sh ? *((const f32x4*)(sh + b * bstride) + lane + 64 * j) : (f32x4){0.f, 0.f, 0.f, 0.f}; }
        f32x4 xn[4];
#pragma unroll
        for (int j = 0; j < 4; ++j) xn[j] = *((const f32x4*)(xin + (size_t)base * D) + lane + 64 * j);
#pragma unroll 1
        for (int r = 0; r < 8; ++r) { const int m = base + r; f32x4 v[4]; float s = 0.f;
#pragma unroll
            for (int j = 0; j < 4; ++j) { v[j] = xn[j]; s += (v[j].x * v[j].x + v[j].y * v[j].y) + (v[j].z * v[j].z + v[j].w * v[j].w); }
            if (r + 1 < 8) {
#pragma unroll
                for (int j = 0; j < 4; ++j) xn[j] = *((const f32x4*)(xin + (size_t)(m + 1) * D) + lane + 64 * j); }
            const float rstd = 1.0f / sqrtf(wave_sum(s) * (1.f / D) + 1e-6f);
#pragma unroll
            for (int j = 0; j < 4; ++j) v[j] = (v[j] * rstd * gg[j]) * aa[j] + bb[j];
            if (outf) {
#pragma unroll
                for (int j = 0; j < 4; ++j) *((f32x4*)(outf + (size_t)m * D) + lane + 64 * j) = v[j]; }
            else st_row_bf16(dst + (size_t)m * 1024, lane, v);
        }
    }
}
__device__ __forceinline__ void norm_mix_phase(Frame& F, const float* xin, const float* g, const float* sh, const float* sc, const float* mu, bf16* H2p, bf16* XJ) {
    const int gw = F.vcu * NWAVES + F.wave, NGW = F.G * NWAVES, lane = F.lane;
    for (int base = gw * 8; base < M; base += NGW * 8) {
        const int b = base >> 13;
        f32x4 gg[4], aa[4], bb[4], m0[4], m1[4], m2[4];
#pragma unroll
        for (int j = 0; j < 4; ++j) { gg[j] = *((const f32x4*)g + lane + 64 * j); aa[j] = *((const f32x4*)(sc + b * 6144) + lane + 64 * j) + 1.0f; bb[j] = *((const f32x4*)(sh + b * 6144) + lane + 64 * j);
            m0[j] = *((const f32x4*)mu + lane + 64 * j); m1[j] = *((const f32x4*)(mu + 2048) + lane + 64 * j); m2[j] = *((const f32x4*)(mu + 3072) + lane + 64 * j); }
        const bool first = (base & 8191) == 0; const int r0 = first ? 0 : -1;
        f32x4 hp[4], xn[4];
#pragma unroll
        for (int j = 0; j < 4; ++j) { hp[j] = (f32x4){0.f, 0.f, 0.f, 0.f}; xn[j] = *((const f32x4*)(xin + (size_t)(base + r0) * D) + lane + 64 * j); }
#pragma unroll 1
        for (int r = r0; r < 8; ++r) { const int m = base + r; f32x4 v[4];
            float s = 0.f;
#pragma unroll
            for (int j = 0; j < 4; ++j) { v[j] = xn[j]; s += (v[j].x * v[j].x + v[j].y * v[j].y) + (v[j].z * v[j].z + v[j].w * v[j].w); }
            if (r + 1 < 8) {
#pragma unroll
                for (int j = 0; j < 4; ++j) xn[j] = *((const f32x4*)(xin + (size_t)(m + 1) * D) + lane + 64 * j); }
            const float rstd = 1.0f / sqrtf(wave_sum(s) * (1.f / D) + 1e-6f);
#pragma unroll
            for (int j = 0; j < 4; ++j) v[j] = (v[j] * rstd * gg[j]) * aa[j] + bb[j];
            if (r >= 0) {
                st_row_bf16(H2p + (size_t)m * 2048, lane, v); st_row_bf16(H2p + (size_t)m * 2048 + 1024, lane, hp);
                f32x4 x[4];
#pragma unroll
                for (int j = 0; j < 4; ++j) x[j] = v[j] + (hp[j] - v[j]) * m0[j];
                st_row_bf16(XJ + (size_t)m * D, lane, x);
#pragma unroll
                for (int j = 0; j < 4; ++j) x[j] = v[j] + (hp[j] - v[j]) * m1[j];
                st_row_bf16(XJ + (size_t)M * D + (size_t)m * D, lane, x);
#pragma unroll
                for (int j = 0; j < 4; ++j) x[j] = v[j] + (hp[j] - v[j]) * m2[j];
                st_row_bf16(XJ + (size_t)2 * M * D + (size_t)m * D, lane, x);
            }
#pragma unroll
            for (int j = 0; j < 4; ++j) hp[j] = v[j]; }
    }
}
__device__ __forceinline__ void final_norm_phase(Frame& F) { norm_phase(F, F.out, F.in[38], nullptr, nullptr, 0, 1, nullptr, F.out); }
#ifndef PROBE_SC
#define PROBE_SC 0
#endif
constexpr int SC_C = 32, SC_NC = T / SC_C;
constexpr int SC_VEC = 0, SC_SCAL = 36864, SC_V = 37120, SC_Y = 38144, SC_BUF = 54528;
typedef float f32x2s __attribute__((ext_vector_type(2)));
__device__ __forceinline__ float dot4(const f32x4 s, const f32x4 a) { f32x2s t = (f32x2s){s.x, s.y} * (f32x2s){a.x, a.y}; t = (f32x2s){s.z, s.w} * (f32x2s){a.z, a.w} + t; return t.x + t.y; }
__device__ __forceinline__ void scan_chunk(const LAS unsigned char* Bc, f32x4& S, const int kq, const int rowi) {
                const LAS f32x4* pvec = (const LAS f32x4*)(Bc + SC_VEC) + kq; const LAS f32x4* psc = (const LAS f32x4*)(Bc + SC_SCAL);
                const LAS float* pv = (const LAS float*)(Bc + SC_V) + rowi; LAS float* py = (LAS float*)(Bc + SC_Y) + rowi * 16 + kq;
                f32x4 cv[9], cs; float c0, c1;
#pragma unroll
                for (int j = 0; j < 9; ++j) cv[j] = pvec[j * 16];
                cs = psc[0]; c0 = pv[0]; c1 = pv[8];
#pragma unroll
                for (int p = 0; p < SC_C / 2; ++p) {
                    f32x4 nv[9], ns; float n0, n1;
                    if (p + 1 < SC_C / 2) {
#pragma unroll
                        for (int j = 0; j < 9; ++j) nv[j] = pvec[((p + 1) * 9 + j) * 16];
                        ns = psc[p + 1]; n0 = pv[(2 * p + 2) * 8]; n1 = pv[(2 * p + 3) * 8];
                    }
                    __builtin_amdgcn_sched_barrier(0);
                    float p1 = dot4(S, cv[0]), p2 = dot4(S, cv[1]); const float p3 = dot4(S, cv[2]);
                    p1 += dpp_f(p1, 0); p2 += dpp_f(p2, 0);
                    p1 += dpp_f(p1, 1); p2 += dpp_f(p2, 1);
                    p1 += dpp_f(p1, 2); p2 += dpp_f(p2, 2);
                    p1 += dpp_f(p1, 3); p2 += dpp_f(p2, 3);
                    const float sa1 = fmaf(c0, cs.w, p2);
                    const float y0 = p3 + ((kq == 0) ? c0 * cs.y : 0.f);
                    const f32x4 t0 = S * cv[3] + cv[4] * p1 + cv[5] * c0 + cv[7] * c1;
                    S = t0 + cv[6] * sa1;
                    const float y1 = dot4(S, cv[8]);
                    py[(2 * p) * 128] = y0; py[(2 * p + 1) * 128] = y1;
                    if (p + 1 < SC_C / 2) {
#pragma unroll
                        for (int j = 0; j < 9; ++j) cv[j] = nv[j];
                        cs = ns; c0 = n0; c1 = n1;
                    }
                }
}
__device__ __forceinline__ void scan_phase(Frame& F, int L) {
    const bf16* P1 = (const bf16*)(F.ws + WS_P1); const bf16* P2 = (const bf16*)(F.ws + WS_P2); const bf16* VF = (const bf16*)(F.ws + WS_VF); float* Y = (float*)(F.ws + WS_H2);
    const float* kkw = F.in[21] + L * D; const float* kaw = F.in[22] + L * D;
    const int lane = F.lane;
    int wave;
    { LAS unsigned* tb = (LAS unsigned*)(F.lds + LDS_BYTES - 2048);
      const unsigned simd = ((unsigned)__builtin_amdgcn_s_getreg((1 << 11) | (4 << 6) | 4)) & 3u;
      if (lane == 0) tb[F.wave] = simd;
      __syncthreads();
      unsigned sd[8];
#pragma unroll
      for (int w = 0; w < 8; ++w) sd[w] = tb[w];
      int B = 1;
#pragma unroll
      for (int w = 7; w >= 1; --w) if (sd[w] != sd[0]) B = w;
      int total_non = 0, non_before = 0, share_before = 0; bool my_share = false;
#pragma unroll
      for (int w = 1; w < 8; ++w) { const bool sh = (sd[w] == sd[0]) || (sd[w] == sd[B]); const bool other = (w != B);
          if (other && !sh) { ++total_non; if (w < F.wave) ++non_before; }
          if (other && sh && w < F.wave) ++share_before;
          if (w == F.wave) my_share = sh; }
      int role;
      if (F.wave == 0) role = 0; else if (F.wave == B) role = 1; else role = my_share ? (2 + total_non + share_before) : (2 + non_before);
      wave = __builtin_amdgcn_readfirstlane(role);
      __syncthreads(); }
    for (int item = F.bx; item < 256; item += F.G) {
        const int bh = (item & 7) + 8 * (item >> 6), rg = (item >> 3) & 7, b = bh >> 4, h = bh & 15;
        const size_t m0 = (size_t)b * T;
        const int hidx = (wave - 2) * 64 + lane, hp = (hidx >> 4) & 15, hc4 = hidx & 15;
        const int vtt = lane >> 1, vr4 = (lane & 1) * 4;
        float ckk[4], cka[4];
        v2u lr[2][2], lk[2][2], lw[2][2], la[2][2]; v2u lv[2], lvm[2], lvf[2];
#pragma unroll
        for (int q = 0; q < 2; ++q) { lv[q] = (v2u){0u,0u}; lvm[q] = (v2u){0u,0u}; lvf[q] = (v2u){0u,0u};
#pragma unroll
            for (int u = 0; u < 2; ++u) { lr[q][u] = (v2u){0u,0u}; lk[q][u] = (v2u){0u,0u}; lw[q][u] = (v2u){0u,0u}; la[q][u] = (v2u){0u,0u}; } }
        if (wave >= 2 && wave < 6) {
#pragma unroll
            for (int j = 0; j < 4; ++j) { ckk[j] = kkw[h * 64 + hc4 * 4 + j]; cka[j] = kaw[h * 64 + hc4 * 4 + j]; } }
#define SC_LOAD(c, Q) do { \
        if (wave >= 2 && wave < 6) { _Pragma("unroll") for (int u = 0; u < 2; ++u) { const size_t m = m0 + (size_t)(c) * SC_C + 2 * hp + u; const bf16* p1 = P1 + m * N1 + h * 64 + hc4 * 4; const bf16* p2 = P2 + m * NP2 + h * 64 + hc4 * 4; \
            lr[Q][u] = *(const v2u*)p1; lk[Q][u] = *(const v2u*)(p1 + 1024); lw[Q][u] = *(const v2u*)p2; la[Q][u] = *(const v2u*)(p2 + 1024); } } \
        else if (wave == 6) { const size_t m = m0 + (size_t)(c) * SC_C + vtt; const int cc = h * 64 + rg * 8 + vr4; \
            lv[Q] = *(const v2u*)(P1 + m * N1 + 2048 + cc); if (L == 1) { lvm[Q] = *(const v2u*)(P2 + m * NP2 + 2048 + cc); lvf[Q] = *(const v2u*)(VF + m * D + cc); } } } while (0)
#define SC_PREP(buf, Q) do { LAS unsigned char* B_ = F.lds + (buf) * SC_BUF; \
        if (wave >= 2 && wave < 6) { f32x4 an[2], bb[2], k2[2], ww[2], rr[2]; \
            _Pragma("unroll") for (int u = 0; u < 2; ++u) { \
                const float kr[4] = {bflo(lk[Q][u].x), bfhi(lk[Q][u].x), bflo(lk[Q][u].y), bfhi(lk[Q][u].y)}, av[4] = {bflo(la[Q][u].x), bfhi(la[Q][u].x), bflo(la[Q][u].y), bfhi(la[Q][u].y)}; \
                const float wn[4] = {bflo(lw[Q][u].x), bfhi(lw[Q][u].x), bflo(lw[Q][u].y), bfhi(lw[Q][u].y)}, rv[4] = {bflo(lr[Q][u].x), bfhi(lr[Q][u].x), bflo(lr[Q][u].y), bfhi(lr[Q][u].y)}; \
                float kv_[4], ss = 0.f; \
                _Pragma("unroll") for (int j = 0; j < 4; ++j) { kv_[j] = kr[j] * ckk[j]; ss += kv_[j] * kv_[j]; } \
                ss = sum16(ss); const float inv = 1.0f / fmaxf(sqrtf(ss), 1e-12f); \
                _Pragma("unroll") for (int j = 0; j < 4; ++j) { const float kk = kv_[j] * inv; an[u][j] = -kk; bb[u][j] = kk * av[j]; k2[u][j] = kr[j] * (1.0f + (av[j] - 1.0f) * cka[j]); ww[u][j] = __expf(wn[j]); rr[u][j] = rv[j]; } } \
            LAS f32x4* V_ = (LAS f32x4*)(B_ + SC_VEC) + (hp * 9) * 16 + hc4; \
            float s0 = dot4(bb[0], rr[0]), s1 = dot4(k2[0], rr[0]), s2 = dot4(bb[0], an[1]), s3 = dot4(k2[0], an[1]); \
            s0 = sum16(s0); s1 = sum16(s1); s2 = sum16(s2); s3 = sum16(s3); \
            V_[0 * 16] = an[0]; V_[1 * 16] = ww[0] * an[1] + an[0] * s2; V_[2 * 16] = ww[0] * rr[0] + an[0] * s0; V_[3 * 16] = ww[0] * ww[1]; V_[4 * 16] = bb[0] * ww[1]; V_[5 * 16] = k2[0] * ww[1]; V_[6 * 16] = bb[1]; V_[7 * 16] = k2[1]; V_[8 * 16] = rr[1]; \
            if (hc4 == 0) *(LAS f32x4*)(B_ + SC_SCAL + hp * 16) = (f32x4){s0, s1, s2, s3}; } \
        else if (wave == 6) { float v_[4] = {bflo(lv[Q].x), bfhi(lv[Q].x), bflo(lv[Q].y), bfhi(lv[Q].y)}; \
            if (L == 1) { const float f_[4] = {bflo(lvf[Q].x), bfhi(lvf[Q].x), bflo(lvf[Q].y), bfhi(lvf[Q].y)}, g_[4] = {bflo(lvm[Q].x), bfhi(lvm[Q].x), bflo(lvm[Q].y), bfhi(lvm[Q].y)}; \
                _Pragma("unroll") for (int j = 0; j < 4; ++j) v_[j] = v_[j] + (f_[j] - v_[j]) * g_[j]; } \
            *(LAS f32x4*)(B_ + SC_V + (vtt * 8 + vr4) * 4) = (f32x4){v_[0], v_[1], v_[2], v_[3]}; } } while (0)
#define SC_YRED(bufi) f32x4 yv; do { const LAS f32x4* q_ = (const LAS f32x4*)(F.lds + (bufi) * SC_BUF + SC_Y) + (vtt * 8 + vr4) * 4; \
            _Pragma("unroll") for (int r_ = 0; r_ < 4; ++r_) { const f32x4 t0 = q_[r_ * 4], t1 = q_[r_ * 4 + 1], t2 = q_[r_ * 4 + 2], t3 = q_[r_ * 4 + 3]; const f32x4 t = (t0 + t1) + (t2 + t3); yv[r_] = (t.x + t.y) + (t.z + t.w); } } while (0)
        SC_LOAD(0, 0); SC_PREP(0, 0); SC_LOAD(1, 1);
        __syncthreads();
        f32x4 S = {0.f, 0.f, 0.f, 0.f};
        const int rl = lane >> 4, kq = lane & 15, rowi = (wave & 1) * 4 + rl;
#define SC_ITER(c, QL, QP) do { const int buf = (c) & 1; \
            if (wave < 2) { if (PROBE_SC == 2) { f32x4 S2 = S; scan_chunk(F.lds + buf * SC_BUF, S2, kq, rowi); asm volatile("" :: "v"(S2) : "memory"); } scan_chunk(F.lds + buf * SC_BUF, S, kq, rowi); } \
            else { if ((c) + 2 < SC_NC) SC_LOAD((c) + 2, QL); \
                if ((c) + 1 < SC_NC) SC_PREP(buf ^ 1, QP); \
                if (PROBE_SC == 1 && (c) + 1 < SC_NC) { asm volatile("" ::: "memory"); SC_PREP(buf ^ 1, QP); } \
                if (wave == 7 && (c) > 0) { SC_YRED(buf ^ 1); *(f32x4*)(Y + (m0 + (size_t)((c) - 1) * SC_C + vtt) * D + h * 64 + rg * 8 + vr4) = yv; } } \
            asm volatile("s_waitcnt lgkmcnt(0)\n\ts_barrier" ::: "memory"); } while (0)
        for (int c = 0; c < SC_NC; c += 2) { SC_ITER(c, 0, 1); SC_ITER(c + 1, 1, 0); }
#undef SC_ITER
        if (wave == 7) { SC_YRED((SC_NC - 1) & 1);
            *(f32x4*)(Y + (m0 + (size_t)(SC_NC - 1) * SC_C + vtt) * D + h * 64 + rg * 8 + vr4) = yv; }
        __syncthreads();
#undef SC_LOAD
#undef SC_PREP
#undef SC_YRED
    }
}
__device__ __forceinline__ void post_phase(Frame& F, int L) {
    const bf16* P1 = (const bf16*)(F.ws + WS_P1); const bf16* P2 = (const bf16*)(F.ws + WS_P2); bf16* VF = (bf16*)(F.ws + WS_VF); float* Y = (float*)(F.ws + WS_H2);
    const int gw = F.vcu * NWAVES + F.wave, NGW = F.G * NWAVES, lane = F.lane, c0 = lane * 16;
    const float* kaw = F.in[22] + L * D + c0; const float* rkw = F.in[23] + L * D + c0; const float* lnw = F.in[24] + L * D + c0; const float* lnb = F.in[25] + L * D + c0;
    for (int m = gw; m < M; m += NGW) {
        float y[16], r[16], k[16], v[16], a[16];
        const float* yp = Y + (size_t)m * D + c0;
#pragma unroll
        for (int q = 0; q < 4; ++q) { const f32x4 t = *(const f32x4*)(yp + 4 * q); y[4 * q] = t.x; y[4 * q + 1] = t.y; y[4 * q + 2] = t.z; y[4 * q + 3] = t.w; }
        const bf16* p1 = P1 + (size_t)m * N1 + c0; const bf16* p2 = P2 + (size_t)m * NP2 + c0;
        v4u rv[2], kv[2], vv[2], av[2];
#pragma unroll
        for (int q = 0; q < 2; ++q) { rv[q] = *(const v4u*)(p1 + 8 * q); kv[q] = *(const v4u*)(p1 + 1024 + 8 * q); vv[q] = *(const v4u*)(p1 + 2048 + 8 * q); av[q] = *(const v4u*)(p2 + 1024 + 8 * q); }
#pragma unroll
        for (int q = 0; q < 2; ++q)
#pragma unroll
            for (int j = 0; j < 4; ++j) { r[8 * q + 2 * j] = bflo(rv[q][j]); r[8 * q + 2 * j + 1] = bfhi(rv[q][j]); k[8 * q + 2 * j] = bflo(kv[q][j]); k[8 * q + 2 * j + 1] = bfhi(kv[q][j]);
                v[8 * q + 2 * j] = bflo(vv[q][j]); v[8 * q + 2 * j + 1] = bfhi(vv[q][j]); a[8 * q + 2 * j] = bflo(av[q][j]); a[8 * q + 2 * j + 1] = bfhi(av[q][j]); }
        if (L == 0) { *(v4u*)(VF + (size_t)m * D + c0) = vv[0]; *(v4u*)(VF + (size_t)m * D + c0 + 8) = vv[1]; }
        else { v4u fv[2], gv[2];
#pragma unroll
            for (int q = 0; q < 2; ++q) { fv[q] = *(const v4u*)(VF + (size_t)m * D + c0 + 8 * q); gv[q] = *(const v4u*)(p2 + 2048 + 8 * q); }
#pragma unroll
            for (int q = 0; q < 2; ++q)
#pragma unroll
                for (int j = 0; j < 4; ++j) { const float f0 = bflo(fv[q][j]), f1 = bfhi(fv[q][j]), g0 = bflo(gv[q][j]), g1 = bfhi(gv[q][j]);
                    v[8 * q + 2 * j] += (f0 - v[8 * q + 2 * j]) * g0; v[8 * q + 2 * j + 1] += (f1 - v[8 * q + 2 * j + 1]) * g1; } }
        float s = 0.f, bd = 0.f;
#pragma unroll
        for (int j = 0; j < 16; ++j) { s += y[j]; const float k2 = k[j] * (1.0f + (a[j] - 1.0f) * kaw[j]); bd += r[j] * k2 * rkw[j]; }
        s = sum4(s); bd = sum4(bd);
        const float mean = s * (1.0f / 64.0f); float q2 = 0.f;
#pragma unroll
        for (int j = 0; j < 16; ++j) { const float d = y[j] - mean; q2 += d * d; }
        q2 = sum4(q2);
        const float rstd = 1.0f / sqrtf(q2 * (1.0f / 64.0f) + 64e-5f);
        float o[16];
#pragma unroll
        for (int j = 0; j < 16; ++j) o[j] = (y[j] - mean) * rstd * lnw[j] + lnb[j] + bd * v[j];
        bf16* yn = (bf16*)(Y + (size_t)m * D) + c0;
        v4u w0, w1; w0.x = pkbf(o[0], o[1]); w0.y = pkbf(o[2], o[3]); w0.z = pkbf(o[4], o[5]); w0.w = pkbf(o[6], o[7]); w1.x = pkbf(o[8], o[9]); w1.y = pkbf(o[10], o[11]); w1.z = pkbf(o[12], o[13]); w1.w = pkbf(o[14], o[15]);
        *(v4u*)yn = w0; *(v4u*)(yn + 8) = w1;
    }
}
__device__ __forceinline__ void kvpost_phase(Frame& F) {
    const bf16* KV = (const bf16*)(F.ws + WS_KVRAW); bf16* KS = (bf16*)(F.ws + WS_KS); bf16* VS = (bf16*)(F.ws + WS_VS);
    const int gw = F.vcu * NWAVES + F.wave, NGW = F.G * NWAVES, lane = F.lane, c0 = lane * 16;
    const float* kg = F.in[34] + (c0 & 63);
    for (int m = gw; m < M; m += NGW) {
        const bf16* p = KV + (size_t)m * 2048 + c0; v4u kv[2], vv[2];
#pragma unroll
        for (int q = 0; q < 2; ++q) { kv[q] = *(const v4u*)(p + 8 * q); vv[q] = *(const v4u*)(p + 1024 + 8 * q); }
        float k[16], ss = 0.f;
#pragma unroll
        for (int q = 0; q < 2; ++q)
#pragma unroll
            for (int j = 0; j < 4; ++j) { k[8 * q + 2 * j] = bflo(kv[q][j]); k[8 * q + 2 * j + 1] = bfhi(kv[q][j]); }
#pragma unroll
        for (int j = 0; j < 16; ++j) ss += k[j] * k[j];
        ss = sum4(ss); const float rs = 1.0f / sqrtf(ss * (1.0f / 64.0f) + 1e-6f);
        v4u w0, w1;
        w0.x = pkbf(k[0] * rs * kg[0], k[1] * rs * kg[1]); w0.y = pkbf(k[2] * rs * kg[2], k[3] * rs * kg[3]); w0.z = pkbf(k[4] * rs * kg[4], k[5] * rs * kg[5]); w0.w = pkbf(k[6] * rs * kg[6], k[7] * rs * kg[7]);
        w1.x = pkbf(k[8] * rs * kg[8], k[9] * rs * kg[9]); w1.y = pkbf(k[10] * rs * kg[10], k[11] * rs * kg[11]); w1.z = pkbf(k[12] * rs * kg[12], k[13] * rs * kg[13]); w1.w = pkbf(k[14] * rs * kg[14], k[15] * rs * kg[15]);
        *(v4u*)(KS + (size_t)m * D + c0) = w0; *(v4u*)(KS + (size_t)m * D + c0 + 8) = w1;
        *(v4u*)(VS + (size_t)m * D + c0) = vv[0]; *(v4u*)(VS + (size_t)m * D + c0 + 8) = vv[1];
    }
    if (gw < 32) {
        const int bh = gw, b = bh >> 4, h = bh & 15; const float* FL = (const float*)(F.ws + WS_FL) + ((size_t)b * T + (size_t)lane * 128) * 16 + h; const float fb = F.in[33][h];
        v4u* G3 = (v4u*)(F.ws + WS_G3) + (size_t)bh * T + (size_t)lane * 128;
        float tot = 0.f;
#pragma unroll 8
        for (int i = 0; i < 128; ++i) { const float x = FL[(size_t)i * 16] + fb; tot += -(fmaxf(-x, 0.f) + log1pf(__expf(-fabsf(x)))); }
        float inc = tot;
#pragma unroll
        for (int o = 1; o < 64; o <<= 1) { const float n = __int_as_float(__builtin_amdgcn_ds_bpermute((lane - o) << 2, __float_as_int(inc))); if (lane >= o) inc += n; }
        float run = inc - tot;
#pragma unroll 8
        for (int i = 0; i < 128; ++i) { const float x = FL[(size_t)i * 16] + fb; run += -(fmaxf(-x, 0.f) + log1pf(__expf(-fabsf(x))));
            const float gv = -run * 1.4426950408889634f;
            const unsigned hi = pkbf(gv, 0.f) & 0xffffu; const float r1 = gv - __uint_as_float(hi << 16);
            const unsigned mid = pkbf(r1, 0.f) & 0xffffu; const float r2 = r1 - __uint_as_float(mid << 16);
            const unsigned lo = pkbf(r2, 0.f) & 0xffffu;
            G3[i] = (v4u){hi | (mid << 16), lo, 0u, 0u}; }
    }
}
constexpr size_t WS_BAR = 512 * 1024, BAR_BYTES = 16384; constexpr int MISC_OFF = LDS_BYTES - 1024;
#define RLX_AGENT __ATOMIC_RELAXED, __HIP_MEMORY_SCOPE_AGENT
#define LDS_WAIT() asm volatile("s_waitcnt lgkmcnt(0)" ::: "memory")
#define VM_WAIT() asm volatile("s_waitcnt vmcnt(0)" ::: "memory")
__device__ __forceinline__ unsigned long long rt() { return __builtin_amdgcn_s_memrealtime(); }
__device__ __forceinline__ unsigned f2bf(float f) { unsigned u = __builtin_bit_cast(unsigned, f); return (u + 0x7fffu + ((u >> 16) & 1u)) >> 16; }
__device__ __forceinline__ unsigned pk2(float lo, float hi) { return f2bf(lo) | (f2bf(hi) << 16); }

#define XB_TMO      128
#define XB_XCNT(j)  (256  + 64 * (j))
#define XB_XSUB(j)  (1280 + 64 * (j))
#define XB_XGEN(j)  (2304 + 64 * (j))
#define XB_TOP      3328
#define XB_TOPGEN   3392
#define XCD_BAR_WORDS 3456
#define XB_SPIN_CAP (1u << 18)

__device__ __forceinline__ unsigned xb_ld(unsigned* p)              { return __hip_atomic_load(p, __ATOMIC_RELAXED, __HIP_MEMORY_SCOPE_AGENT); }
__device__ __forceinline__ unsigned xb_add(unsigned* p, unsigned v) { return __hip_atomic_fetch_add(p, v, __ATOMIC_RELAXED, __HIP_MEMORY_SCOPE_AGENT); }
__device__ __forceinline__ unsigned xb_xcc_id() { return (unsigned)__builtin_amdgcn_s_getreg((3 << 11) | 20) & 0xFu; }
#define XB_SPIN(cond, bar) do { unsigned _sp = 0; while (cond) { __builtin_amdgcn_s_sleep(1); \
    if ((++_sp & 255u) == 0u) { if (xb_ld(&(bar)[XB_TMO])) break; if (_sp > XB_SPIN_CAP) { atomicAdd(&(bar)[XB_TMO], 1u); break; } } } } while (0)

struct XcdBarrier {
    unsigned* bar; unsigned x;
    volatile LAS unsigned* st;
};

__device__ __forceinline__ XcdBarrier xcd_barrier_post(unsigned* bar, volatile LAS unsigned* st, const int tid) {
    XcdBarrier b; b.bar = bar; b.x = xb_xcc_id(); b.st = st;
    if (tid == 0) (void)xb_add(&bar[XB_XCNT(b.x)], 1u);
    return b;
}
__device__ __forceinline__ void xcd_barrier_complete(unsigned* bar, unsigned x, unsigned& nloc, unsigned& nx) {
    const unsigned G = gridDim.x * gridDim.y * gridDim.z;
    unsigned sum, cnt, mine, sp = 0u;
    for (;;) {
        sum = 0u; cnt = 0u; mine = 0u;
#pragma unroll
        for (unsigned j = 0; j < 16; ++j) { const unsigned c = xb_ld(&bar[XB_XCNT(j)]); sum += c; cnt += (c > 0u) ? 1u : 0u; mine = (j == x) ? c : mine; }
        if (sum == G) break;
        __builtin_amdgcn_s_sleep(1);
        if ((++sp & 255u) == 0u) { if (xb_ld(&bar[XB_TMO])) break; if (sp > XB_SPIN_CAP) { atomicAdd(&bar[XB_TMO], 1u); break; } }
    }
    nloc = mine > 0u ? mine : 1u; nx = cnt > 0u ? cnt : 1u;
}

__device__ __forceinline__ void xcd_barrier(const XcdBarrier& b, const int tid) {
    asm volatile("s_waitcnt vmcnt(0)" ::: "memory");
    __syncthreads();
    if (tid == 0) {
        unsigned* bar = b.bar;
        __builtin_amdgcn_s_waitcnt(0);
        unsigned nloc = b.st[0], nx = b.st[1];
        if (nloc == 0u) { xcd_barrier_complete(bar, b.x, nloc, nx); b.st[0] = nloc; b.st[1] = nx; }
        const unsigned old = xb_add(&bar[XB_XSUB(b.x)], 1u);
        const unsigned gen = old / nloc;
        if (old + 1u == (gen + 1u) * nloc) {
            __builtin_amdgcn_fence(__ATOMIC_RELEASE, "agent");
            asm volatile("s_waitcnt vmcnt(0)" ::: "memory");
            const unsigned og = xb_add(&bar[XB_TOP], 1u);
            const unsigned tg = og / nx;
            if (og + 1u == (tg + 1u) * nx) xb_add(&bar[XB_TOPGEN], 1u);
            else XB_SPIN(xb_ld(&bar[XB_TOPGEN]) == tg, bar);
            __builtin_amdgcn_fence(__ATOMIC_ACQUIRE, "agent");
            xb_add(&bar[XB_XGEN(b.x)], 1u);
            asm volatile("s_waitcnt vmcnt(0)" ::: "memory");
        } else {
            XB_SPIN(xb_ld(&bar[XB_XGEN(b.x)]) == gen, bar);
            __builtin_amdgcn_fence(__ATOMIC_ACQUIRE, "agent");
            asm volatile("s_waitcnt vmcnt(0)" ::: "memory");
        }
    }
    __syncthreads();
}
#define GEMM_CALL(FN, Aptr, Bptr, Nn, Kk, LDA, LDB, ...) GEMM_CALL_G(FN, Aptr, Bptr, Nn, Kk, LDA, LDB, 0, 0, __VA_ARGS__)
#define GEMM_CALL_G(FN, Aptr, Bptr, Nn, Kk, LDA, LDB, AGRP, ASTEP, ...) GEMM_CALL_S(StaticOrder, FN, Aptr, Bptr, Nn, Kk, LDA, LDB, AGRP, ASTEP, __VA_ARGS__)
#define GEMM_CALL_S(ORD, FN, Aptr, Bptr, Nn, Kk, LDA, LDB, AGRP, ASTEP, ...) do { pg8::Gemm g_{(const pg8::bf16_t*)(Aptr), (const pg8::bf16_t*)(Bptr), M, (Nn), (Kk), (LDA), (LDB), (AGRP), (size_t)(ASTEP)}; pg8::ORD S_; S_.init(M, (Nn), F.G, F.bx); \
    pg8::Epi8<pg8::FN> E_{{__VA_ARGS__}}; pg8::gemm_phase<pg8::Epi8<pg8::FN>, pg8::ORD, true, true>(F.lds, g_, S_, E_, F.tid); } while (0)
constexpr int N_PHASES = 42;
__global__ void __launch_bounds__(NWAVES * 64, 2) yoco_fwd(Args args) {
    extern __shared__ __attribute__((aligned(16))) unsigned char lds[];
    cg::grid_group grid = cg::this_grid();
    Frame F;
    const int wave_s = __builtin_amdgcn_readfirstlane((int)threadIdx.x >> 6);
    F.lds = (LAS unsigned char*)lds; F.tid = threadIdx.x; F.lane = F.tid & 63; F.wave = wave_s;
    F.G = gridDim.x; F.bx = blockIdx.x; F.vcu = F.bx;
    F.ws = args.ws; F.out = args.out; F.in = args.in;
    unsigned char* ws = args.ws;
    const int lo = args.ph_lo, hi = args.ph_hi; const bool one = (hi - lo) > 1;
#define LAUNDER() do { int t_ = wave_s * 64 + (int)__builtin_amdgcn_mbcnt_hi(~0u, __builtin_amdgcn_mbcnt_lo(~0u, 0u)); asm volatile("" : "+v"(t_)); F.tid = t_; F.lane = t_ & 63; F.wave = __builtin_amdgcn_readfirstlane(t_ >> 6); \
        int z_ = 0; asm volatile("" : "+v"(z_)); z_ = __builtin_amdgcn_readfirstlane(z_); ws = args.ws + z_; F.ws = ws; F.in = args.in + z_; F.out = args.out + z_; F.bx = (int)blockIdx.x + z_; F.G = (int)gridDim.x + z_; F.vcu = (F.G % 8 == 0) ? (F.bx % 8) * (F.G / 8) + F.bx / 8 : F.bx; } while (0)
#define IN(k) (lo <= (k) && (k) < hi)
#ifndef PROBE_BAR
#define PROBE_BAR 0
#endif
#ifndef PROBE_PH
#define PROBE_PH (-1)
#endif
#define PHASE(k) if (IN(k)) for (int rep_ = 0; rep_ < (((k) == PROBE_PH) ? 2 : 1); ++rep_)
#define SEAM() do { if (one) { unsigned zz_ = 0u; asm volatile("" : "+v"(zz_)); const int st_ = wave_s * 64 + (int)__builtin_amdgcn_mbcnt_hi(~0u, __builtin_amdgcn_mbcnt_lo(~0u, zz_)); xcd_barrier(xbar, st_); if (PROBE_BAR) xcd_barrier(xbar, st_); } } while (0)
#define MOD_ ((float*)(ws + WS_MOD))
#define MODKV_ (MOD_ + 4 * 2 * 6144)
#define H2_ ((bf16*)(ws + WS_H2))
#define XN_ ((bf16*)(ws + WS_H2))
#define XNKV_ ((bf16*)(ws + WS_H2 + 32 * MiB))
#define P1_ ((bf16*)(ws + WS_P1))
#define P2_ ((bf16*)(ws + WS_P2))
#define HB_ ((bf16*)(ws + WS_HB))
#define QB_ ((bf16*)(ws + WS_QB))
#define GT_ ((bf16*)(ws + WS_GT))
#define XIN1_ ((L == 0) ? F.in[0] : (const float*)F.out)
#define MODL_ (MOD_ + L * 2 * 6144)

    volatile LAS unsigned* MISC = (volatile LAS unsigned*)(F.lds + MISC_OFF);
    if (F.tid < 32) MISC[F.tid] = 0u;
    __syncthreads();
    XcdBarrier xbar; xbar.bar = (unsigned*)(args.ws + WS_BAR); xbar.x = 0; xbar.st = MISC + 8;
    if (one) xbar = xcd_barrier_post((unsigned*)(args.ws + WS_BAR), MISC + 8, F.tid);
    PHASE(0) { LAUNDER(); p0_mod(F); p0_weights(F); if (one) grid.sync(); }
    { constexpr int L = 0;
        const int pb = 1 + L * 10;
        if (L < 2) {
            PHASE(pb + 0) { LAUNDER(); norm_mix_phase(F, XIN1_, F.in[4] + L * D, MODL_, MODL_ + 1024, F.in[8] + L * 6 * 1024, H2_, P2_); SEAM(); }
            PHASE(pb + 1) { LAUNDER(); GEMM_CALL(FnP1, H2_, ws + WS_W1 + (size_t)L * N1 * K1 * 2 + (size_t)3072 * 1024 * 2, 512, K1, K1, K1, P1_, 3072);
                LAUNDER();
                if (F.G == 256) GEMM_CALL_S(SplitOrder, FnP1, P2_, ws + WS_W1 + (size_t)L * N1 * K1 * 2, 3072, D, D, D, 4, (size_t)M * D * 2, P1_, 0);
                else GEMM_CALL_G(FnP1, P2_, ws + WS_W1 + (size_t)L * N1 * K1 * 2, 3072, D, D, D, 4, (size_t)M * D * 2, P1_, 0);
                SEAM(); }
            PHASE(pb + 2) { LAUNDER(); GEMM_CALL(FnP2, P1_ + 3072, ws + WS_W2A + (size_t)L * 3072 * 256 * 2, NP2, 256, N1, 256, P2_, MOD_ + 53248 + L * 3072); SEAM(); }
            PHASE(pb + 3) { LAUNDER(); scan_phase(F, L); SEAM(); }
            PHASE(pb + 4) { LAUNDER(); post_phase(F, L); SEAM(); }
            PHASE(pb + 5) { LAUNDER(); GEMM_CALL(FnGate, P1_ + 3232, ws + WS_W2G + (size_t)L * 1024 * 256 * 2, D, 256, N1, 256, H2_, 2048); SEAM(); }
            PHASE(pb + 6) { LAUNDER(); GEMM_CALL(FnRes, H2_, ws + WS_WO + (size_t)L * D * D * 2, D, D, 2048, D, XIN1_, F.out, MODL_ + 2 * 1024); SEAM(); }
        } else {
            const int j = L - 2;
            PHASE(pb + 0) { LAUNDER(); norm_phase(F, F.out, F.in[4] + L * D, MODL_, MODL_ + 1024, 6144, 1, XN_);
                if (L == 2) norm_phase(F, F.out, F.in[29], MODKV_, MODKV_ + 1024, 2048, 1, XNKV_);
                SEAM(); }
            PHASE(pb + 1) { LAUNDER();
                if (L == 2) GEMM_CALL(FnKv, XNKV_, ws + WS_WKV, 2304, D, D, D, (bf16*)(ws + WS_KVRAW), (float*)(ws + WS_FL));
                LAUNDER();
                GEMM_CALL(FnQg, XN_, ws + WS_WQG + (size_t)j * 2048 * D * 2, 2048, D, D, D, QB_, GT_); SEAM(); }
            if (L == 2) PHASE(pb + 2) { LAUNDER(); kvpost_phase(F); SEAM(); }
            PHASE(pb + 3) { LAUNDER();
                float kb_; { float g_ = fabsf(F.in[34][F.lane]); g_ = fmaxf(g_, dpp_f(g_, 0)); g_ = fmaxf(g_, dpp_f(g_, 1)); g_ = fmaxf(g_, dpp_f(g_, 2)); g_ = fmaxf(g_, dpp_f(g_, 3));
                  { auto rr = __builtin_amdgcn_permlane16_swap(__float_as_uint(g_), __float_as_uint(g_), false, false); g_ = fmaxf(__uint_as_float(rr[0]), __uint_as_float(rr[1])); }
                  { auto rr = __builtin_amdgcn_permlane32_swap(__float_as_uint(g_), __float_as_uint(g_), false, false); g_ = fmaxf(__uint_as_float(rr[0]), __uint_as_float(rr[1])); }
                  kb_ = 8.0f * 1.02f * g_; }
                const attn_body::AttnTensors AT{(const attn_body::bf16*)QB_, (const attn_body::bf16*)(ws + WS_KS), (const attn_body::bf16*)(ws + WS_VS), (attn_body::bf16*)((PROBE_PH == pb + 3 && rep_ == 0) ? (bf16*)(ws + WS_KVRAW) : QB_), (const attn_body::bf16*)GT_, (const unsigned char*)(ws + WS_G3), F.in[36] + j * 64, kb_};
                const attn_body::StaticOrder S((int)F.G, F.bx);
                attn_body::attn_phase<attn_body::StaticOrder>((char*)lds, AT, S, F.tid);
                SEAM(); }
            PHASE(pb + 6) { LAUNDER(); GEMM_CALL(FnRes, QB_, ws + WS_WO2 + (size_t)j * D * D * 2, D, D, D, D, (const float*)F.out, F.out, MODL_ + 2 * 1024); SEAM(); }
        }
        PHASE(pb + 7) { LAUNDER(); mlp_weights(F, L); norm_phase(F, F.out, F.in[5] + L * D, MODL_ + 3 * 1024, MODL_ + 4 * 1024, 6144, 1, XN_); SEAM(); }
        PHASE(pb + 8) { LAUNDER(); GEMM_CALL(FnUp, XN_, ws + WS_WUP, FF, D, D, D, HB_); SEAM(); }
        PHASE(pb + 9) { LAUNDER(); GEMM_CALL(FnRes, HB_, ws + WS_WDN, D, FF, FF, FF, (const float*)F.out, F.out, MODL_ + 5 * 1024); SEAM(); }
        }
    { constexpr int L = 1;
        const int pb = 1 + L * 10;
        if (L < 2) {
            PHASE(pb + 0) { LAUNDER(); norm_mix_phase(F, XIN1_, F.in[4] + L * D, MODL_, MODL_ + 1024, F.in[8] + L * 6 * 1024, H2_, P2_); SEAM(); }
            PHASE(pb + 1) { LAUNDER(); GEMM_CALL(FnP1, H2_, ws + WS_W1 + (size_t)L * N1 * K1 * 2 + (size_t)3072 * 1024 * 2, 512, K1, K1, K1, P1_, 3072);
                LAUNDER();
                if (F.G == 256) GEMM_CALL_S(SplitOrder, FnP1, P2_, ws + WS_W1 + (size_t)L * N1 * K1 * 2, 3072, D, D, D, 4, (size_t)M * D * 2, P1_, 0);
                else GEMM_CALL_G(FnP1, P2_, ws + WS_W1 + (size_t)L * N1 * K1 * 2, 3072, D, D, D, 4, (size_t)M * D * 2, P1_, 0);
                SEAM(); }
            PHASE(pb + 2) { LAUNDER(); GEMM_CALL(FnP2, P1_ + 3072, ws + WS_W2A + (size_t)L * 3072 * 256 * 2, NP2, 256, N1, 256, P2_, MOD_ + 53248 + L * 3072); SEAM(); }
            PHASE(pb + 3) { LAUNDER(); scan_phase(F, L); SEAM(); }
            PHASE(pb + 4) { LAUNDER(); post_phase(F, L); SEAM(); }
            PHASE(pb + 5) { LAUNDER(); GEMM_CALL(FnGate, P1_ + 3232, ws + WS_W2G + (size_t)L * 1024 * 256 * 2, D, 256, N1, 256, H2_, 2048); SEAM(); }
            PHASE(pb + 6) { LAUNDER(); GEMM_CALL(FnRes, H2_, ws + WS_WO + (size_t)L * D * D * 2, D, D, 2048, D, XIN1_, F.out, MODL_ + 2 * 1024); SEAM(); }
        } else {
            const int j = L - 2;
            PHASE(pb + 0) { LAUNDER(); norm_phase(F, F.out, F.in[4] + L * D, MODL_, MODL_ + 1024, 6144, 1, XN_);
                if (L == 2) norm_phase(F, F.out, F.in[29], MODKV_, MODKV_ + 1024, 2048, 1, XNKV_);
                SEAM(); }
            PHASE(pb + 1) { LAUNDER();
                if (L == 2) GEMM_CALL(FnKv, XNKV_, ws + WS_WKV, 2304, D, D, D, (bf16*)(ws + WS_KVRAW), (float*)(ws + WS_FL));
                LAUNDER();
                GEMM_CALL(FnQg, XN_, ws + WS_WQG + (size_t)j * 2048 * D * 2, 2048, D, D, D, QB_, GT_); SEAM(); }
            if (L == 2) PHASE(pb + 2) { LAUNDER(); kvpost_phase(F); SEAM(); }
            PHASE(pb + 3) { LAUNDER();
                float kb_; { float g_ = fabsf(F.in[34][F.lane]); g_ = fmaxf(g_, dpp_f(g_, 0)); g_ = fmaxf(g_, dpp_f(g_, 1)); g_ = fmaxf(g_, dpp_f(g_, 2)); g_ = fmaxf(g_, dpp_f(g_, 3));
                  { auto rr = __builtin_amdgcn_permlane16_swap(__float_as_uint(g_), __float_as_uint(g_), false, false); g_ = fmaxf(__uint_as_float(rr[0]), __uint_as_float(rr[1])); }
                  { auto rr = __builtin_amdgcn_permlane32_swap(__float_as_uint(g_), __float_as_uint(g_), false, false); g_ = fmaxf(__uint_as_float(rr[0]), __uint_as_float(rr[1])); }
                  kb_ = 8.0f * 1.02f * g_; }
                const attn_body::AttnTensors AT{(const attn_body::bf16*)QB_, (const attn_body::bf16*)(ws + WS_KS), (const attn_body::bf16*)(ws + WS_VS), (attn_body::bf16*)((PROBE_PH == pb + 3 && rep_ == 0) ? (bf16*)(ws + WS_KVRAW) : QB_), (const attn_body::bf16*)GT_, (const unsigned char*)(ws + WS_G3), F.in[36] + j * 64, kb_};
                const attn_body::StaticOrder S((int)F.G, F.bx);
                attn_body::attn_phase<attn_body::StaticOrder>((char*)lds, AT, S, F.tid);
                SEAM(); }
            PHASE(pb + 6) { LAUNDER(); GEMM_CALL(FnRes, QB_, ws + WS_WO2 + (size_t)j * D * D * 2, D, D, D, D, (const float*)F.out, F.out, MODL_ + 2 * 1024); SEAM(); }
        }
        PHASE(pb + 7) { LAUNDER(); mlp_weights(F, L); norm_phase(F, F.out, F.in[5] + L * D, MODL_ + 3 * 1024, MODL_ + 4 * 1024, 6144, 1, XN_); SEAM(); }
        PHASE(pb + 8) { LAUNDER(); GEMM_CALL(FnUp, XN_, ws + WS_WUP, FF, D, D, D, HB_); SEAM(); }
        PHASE(pb + 9) { LAUNDER(); GEMM_CALL(FnRes, HB_, ws + WS_WDN, D, FF, FF, FF, (const float*)F.out, F.out, MODL_ + 5 * 1024); SEAM(); }
        }
    { constexpr int L = 2;
        const int pb = 1 + L * 10;
        if (L < 2) {
            PHASE(pb + 0) { LAUNDER(); norm_mix_phase(F, XIN1_, F.in[4] + L * D, MODL_, MODL_ + 1024, F.in[8] + L * 6 * 1024, H2_, P2_); SEAM(); }
            PHASE(pb + 1) { LAUNDER(); GEMM_CALL(FnP1, H2_, ws + WS_W1 + (size_t)L * N1 * K1 * 2 + (size_t)3072 * 1024 * 2, 512, K1, K1, K1, P1_, 3072);
                LAUNDER();
                if (F.G == 256) GEMM_CALL_S(SplitOrder, FnP1, P2_, ws + WS_W1 + (size_t)L * N1 * K1 * 2, 3072, D, D, D, 4, (size_t)M * D * 2, P1_, 0);
                else GEMM_CALL_G(FnP1, P2_, ws + WS_W1 + (size_t)L * N1 * K1 * 2, 3072, D, D, D, 4, (size_t)M * D * 2, P1_, 0);
                SEAM(); }
            PHASE(pb + 2) { LAUNDER(); GEMM_CALL(FnP2, P1_ + 3072, ws + WS_W2A + (size_t)L * 3072 * 256 * 2, NP2, 256, N1, 256, P2_, MOD_ + 53248 + L * 3072); SEAM(); }
            PHASE(pb + 3) { LAUNDER(); scan_phase(F, L); SEAM(); }
            PHASE(pb + 4) { LAUNDER(); post_phase(F, L); SEAM(); }
            PHASE(pb + 5) { LAUNDER(); GEMM_CALL(FnGate, P1_ + 3232, ws + WS_W2G + (size_t)L * 1024 * 256 * 2, D, 256, N1, 256, H2_, 2048); SEAM(); }
            PHASE(pb + 6) { LAUNDER(); GEMM_CALL(FnRes, H2_, ws + WS_WO + (size_t)L * D * D * 2, D, D, 2048, D, XIN1_, F.out, MODL_ + 2 * 1024); SEAM(); }
        } else {
            const int j = L - 2;
            PHASE(pb + 0) { LAUNDER(); norm_phase(F, F.out, F.in[4] + L * D, MODL_, MODL_ + 1024, 6144, 1, XN_);
                if (L == 2) norm_phase(F, F.out, F.in[29], MODKV_, MODKV_ + 1024, 2048, 1, XNKV_);
                SEAM(); }
            PHASE(pb + 1) { LAUNDER();
                if (L == 2) GEMM_CALL(FnKv, XNKV_, ws + WS_WKV, 2304, D, D, D, (bf16*)(ws + WS_KVRAW), (float*)(ws + WS_FL));
                LAUNDER();
                GEMM_CALL(FnQg, XN_, ws + WS_WQG + (size_t)j * 2048 * D * 2, 2048, D, D, D, QB_, GT_); SEAM(); }
            if (L == 2) PHASE(pb + 2) { LAUNDER(); kvpost_phase(F); SEAM(); }
            PHASE(pb + 3) { LAUNDER();
                float kb_; { float g_ = fabsf(F.in[34][F.lane]); g_ = fmaxf(g_, dpp_f(g_, 0)); g_ = fmaxf(g_, dpp_f(g_, 1)); g_ = fmaxf(g_, dpp_f(g_, 2)); g_ = fmaxf(g_, dpp_f(g_, 3));
                  { auto rr = __builtin_amdgcn_permlane16_swap(__float_as_uint(g_), __float_as_uint(g_), false, false); g_ = fmaxf(__uint_as_float(rr[0]), __uint_as_float(rr[1])); }
                  { auto rr = __builtin_amdgcn_permlane32_swap(__float_as_uint(g_), __float_as_uint(g_), false, false); g_ = fmaxf(__uint_as_float(rr[0]), __uint_as_float(rr[1])); }
                  kb_ = 8.0f * 1.02f * g_; }
                const attn_body::AttnTensors AT{(const attn_body::bf16*)QB_, (const attn_body::bf16*)(ws + WS_KS), (const attn_body::bf16*)(ws + WS_VS), (attn_body::bf16*)((PROBE_PH == pb + 3 && rep_ == 0) ? (bf16*)(ws + WS_KVRAW) : QB_), (const attn_body::bf16*)GT_, (const unsigned char*)(ws + WS_G3), F.in[36] + j * 64, kb_};
                const attn_body::StaticOrder S((int)F.G, F.bx);
                attn_body::attn_phase<attn_body::StaticOrder>((char*)lds, AT, S, F.tid);
                SEAM(); }
            PHASE(pb + 6) { LAUNDER(); GEMM_CALL(FnRes, QB_, ws + WS_WO2 + (size_t)j * D * D * 2, D, D, D, D, (const float*)F.out, F.out, MODL_ + 2 * 1024); SEAM(); }
        }
        PHASE(pb + 7) { LAUNDER(); mlp_weights(F, L); norm_phase(F, F.out, F.in[5] + L * D, MODL_ + 3 * 1024, MODL_ + 4 * 1024, 6144, 1, XN_); SEAM(); }
        PHASE(pb + 8) { LAUNDER(); GEMM_CALL(FnUp, XN_, ws + WS_WUP, FF, D, D, D, HB_); SEAM(); }
        PHASE(pb + 9) { LAUNDER(); GEMM_CALL(FnRes, HB_, ws + WS_WDN, D, FF, FF, FF, (const float*)F.out, F.out, MODL_ + 5 * 1024); SEAM(); }
        }
    { constexpr int L = 3;
        const int pb = 1 + L * 10;
        if (L < 2) {
            PHASE(pb + 0) { LAUNDER(); norm_mix_phase(F, XIN1_, F.in[4] + L * D, MODL_, MODL_ + 1024, F.in[8] + L * 6 * 1024, H2_, P2_); SEAM(); }
            PHASE(pb + 1) { LAUNDER(); GEMM_CALL(FnP1, H2_, ws + WS_W1 + (size_t)L * N1 * K1 * 2 + (size_t)3072 * 1024 * 2, 512, K1, K1, K1, P1_, 3072);
                LAUNDER();
                if (F.G == 256) GEMM_CALL_S(SplitOrder, FnP1, P2_, ws + WS_W1 + (size_t)L * N1 * K1 * 2, 3072, D, D, D, 4, (size_t)M * D * 2, P1_, 0);
                else GEMM_CALL_G(FnP1, P2_, ws + WS_W1 + (size_t)L * N1 * K1 * 2, 3072, D, D, D, 4, (size_t)M * D * 2, P1_, 0);
                SEAM(); }
            PHASE(pb + 2) { LAUNDER(); GEMM_CALL(FnP2, P1_ + 3072, ws + WS_W2A + (size_t)L * 3072 * 256 * 2, NP2, 256, N1, 256, P2_, MOD_ + 53248 + L * 3072); SEAM(); }
            PHASE(pb + 3) { LAUNDER(); scan_phase(F, L); SEAM(); }
            PHASE(pb + 4) { LAUNDER(); post_phase(F, L); SEAM(); }
            PHASE(pb + 5) { LAUNDER(); GEMM_CALL(FnGate, P1_ + 3232, ws + WS_W2G + (size_t)L * 1024 * 256 * 2, D, 256, N1, 256, H2_, 2048); SEAM(); }
            PHASE(pb + 6) { LAUNDER(); GEMM_CALL(FnRes, H2_, ws + WS_WO + (size_t)L * D * D * 2, D, D, 2048, D, XIN1_, F.out, MODL_ + 2 * 1024); SEAM(); }
        } else {
            const int j = L - 2;
            PHASE(pb + 0) { LAUNDER(); norm_phase(F, F.out, F.in[4] + L * D, MODL_, MODL_ + 1024, 6144, 1, XN_);
                if (L == 2) norm_phase(F, F.out, F.in[29], MODKV_, MODKV_ + 1024, 2048, 1, XNKV_);
                SEAM(); }
            PHASE(pb + 1) { LAUNDER();
                if (L == 2) GEMM_CALL(FnKv, XNKV_, ws + WS_WKV, 2304, D, D, D, (bf16*)(ws + WS_KVRAW), (float*)(ws + WS_FL));
                LAUNDER();
                GEMM_CALL(FnQg, XN_, ws + WS_WQG + (size_t)j * 2048 * D * 2, 2048, D, D, D, QB_, GT_); SEAM(); }
            if (L == 2) PHASE(pb + 2) { LAUNDER(); kvpost_phase(F); SEAM(); }
            PHASE(pb + 3) { LAUNDER();
                float kb_; { float g_ = fabsf(F.in[34][F.lane]); g_ = fmaxf(g_, dpp_f(g_, 0)); g_ = fmaxf(g_, dpp_f(g_, 1)); g_ = fmaxf(g_, dpp_f(g_, 2)); g_ = fmaxf(g_, dpp_f(g_, 3));
                  { auto rr = __builtin_amdgcn_permlane16_swap(__float_as_uint(g_), __float_as_uint(g_), false, false); g_ = fmaxf(__uint_as_float(rr[0]), __uint_as_float(rr[1])); }
                  { auto rr = __builtin_amdgcn_permlane32_swap(__float_as_uint(g_), __float_as_uint(g_), false, false); g_ = fmaxf(__uint_as_float(rr[0]), __uint_as_float(rr[1])); }
                  kb_ = 8.0f * 1.02f * g_; }
                const attn_body::AttnTensors AT{(const attn_body::bf16*)QB_, (const attn_body::bf16*)(ws + WS_KS), (const attn_body::bf16*)(ws + WS_VS), (attn_body::bf16*)((PROBE_PH == pb + 3 && rep_ == 0) ? (bf16*)(ws + WS_KVRAW) : QB_), (const attn_body::bf16*)GT_, (const unsigned char*)(ws + WS_G3), F.in[36] + j * 64, kb_};
                const attn_body::StaticOrder S((int)F.G, F.bx);
                attn_body::attn_phase<attn_body::StaticOrder>((char*)lds, AT, S, F.tid);
                SEAM(); }
            PHASE(pb + 6) { LAUNDER(); GEMM_CALL(FnRes, QB_, ws + WS_WO2 + (size_t)j * D * D * 2, D, D, D, D, (const float*)F.out, F.out, MODL_ + 2 * 1024); SEAM(); }
        }
        PHASE(pb + 7) { LAUNDER(); mlp_weights(F, L); norm_phase(F, F.out, F.in[5] + L * D, MODL_ + 3 * 1024, MODL_ + 4 * 1024, 6144, 1, XN_); SEAM(); }
        PHASE(pb + 8) { LAUNDER(); GEMM_CALL(FnUp, XN_, ws + WS_WUP, FF, D, D, D, HB_); SEAM(); }
        PHASE(pb + 9) { LAUNDER(); GEMM_CALL(FnRes, HB_, ws + WS_WDN, D, FF, FF, FF, (const float*)F.out, F.out, MODL_ + 5 * 1024); SEAM(); }
        }
    PHASE(41) { LAUNDER(); final_norm_phase(F); }
#undef IN
#undef SEAM
}
static bool phase_exists(int ph) {
    if (ph == 0 || ph == 41) return true;
    const int L = (ph - 1) / 10, s = (ph - 1) % 10;
    if (L < 2) return true;
    if (s == 4 || s == 5) return false;
    if (s == 2) return L == 2;
    return true;
}
extern "C" void kernel_launch(void* const* d_in, const int* in_sizes, int n_in, void* d_out, int out_size, void* d_ws, size_t ws_size, hipStream_t stream) {
    static int grid = 0;
    if (grid == 0) {
        if (n_in != 39 || in_sizes[0] != M * D || out_size != M * D || ws_size < WS_END) { fprintf(stderr, "kernel_launch: shape/workspace mismatch: n_in %d in0 %d out %d ws %zu (need %zu)\n", n_in, n_in > 0 ? in_sizes[0] : -1, out_size, ws_size, (size_t)WS_END); grid = -1; return; }
        int dev = 0, cus = 0, per_cu = 0;
        if (hipGetDevice(&dev) != hipSuccess || hipDeviceGetAttribute(&cus, hipDeviceAttributeMultiprocessorCount, dev) != hipSuccess) { fprintf(stderr, "kernel_launch: device query failed\n"); grid = -1; return; }
        if (hipFuncSetAttribute((const void*)yoco_fwd, hipFuncAttributeMaxDynamicSharedMemorySize, LDS_BYTES) != hipSuccess) { fprintf(stderr, "kernel_launch: hipFuncSetAttribute failed\n"); grid = -1; return; }
        if (hipOccupancyMaxActiveBlocksPerMultiprocessor(&per_cu, (const void*)yoco_fwd, NWAVES * 64, LDS_BYTES) != hipSuccess || per_cu < 1) { fprintf(stderr, "kernel_launch: occupancy query says %d blocks/CU\n", per_cu); per_cu = 1; }
        (void)hipGetLastError();
        grid = cus * per_cu;
        if (grid != 256) { fprintf(stderr, "kernel_launch: resident capacity %d workgroups; this kernel's static schedules want 256 (using 256)\n", grid); if (grid > 256) grid = 256; }
    }
    if (grid < 0) return;
    if (hipMemsetAsync((char*)d_ws + WS_BAR, 0, BAR_BYTES, stream) != hipSuccess) { fprintf(stderr, "kernel_launch: memset of barrier words failed\n"); return; }
    Args a{};
    for (int i = 0; i < 39; ++i) a.in[i] = (const float*)d_in[i];
    a.out = (float*)d_out; a.ws = (unsigned char*)d_ws;
#if MK_ONE_LAUNCH
    a.ph_lo = 0; a.ph_hi = N_PHASES;
    void* params[] = {&a};
    const hipError_t le = hipLaunchCooperativeKernel((const void*)yoco_fwd, dim3(grid), dim3(NWAVES * 64), params, LDS_BYTES, stream);
    if (le != hipSuccess) fprintf(stderr, "kernel_launch: cooperative launch failed: %s (grid %d)\n", hipGetErrorName(le), grid);
#else
    for (int ph = 0; ph < N_PHASES; ++ph) { if (!phase_exists(ph)) continue; a.ph_lo = ph; a.ph_hi = ph + 1;
        hipLaunchKernelGGL(yoco_fwd, dim3(grid), dim3(NWAVES * 64), LDS_BYTES, stream, a);
        const hipError_t le = hipPeekAtLastError(); if (le != hipSuccess) { fprintf(stderr, "kernel_launch: launch of phase %d failed: %s\n", ph, hipGetErrorName(le)); break; } }
#endif
}
```

```cpp
#include <hip/hip_runtime.h>
#include <hip/hip_cooperative_groups.h>
#include <hip/hip_bf16.h>
#include <cstdio>
#include <cstdint>
#include <cmath>
namespace cg = cooperative_groups;
#ifndef MK_ONE_LAUNCH
#define MK_ONE_LAUNCH 1
#endif
namespace pg8 {
#define PG8_LAS __attribute__((address_space(3)))
typedef unsigned short bf16_t;
typedef short bf16x8 __attribute__((ext_vector_type(8)));
typedef float f32x4 __attribute__((ext_vector_type(4)));
typedef unsigned u32x4 __attribute__((ext_vector_type(4)));
constexpr int BM = 256, BK = 64, HALF = 128, HTB = HALF * BK * 2  , STAGE_BYTES = 8 * HTB, NXCD = 8, WGM = 8;

__host__ __device__ __forceinline__ int lds_byte(int r, int c) { const int st = (r >> 4) * 2 + (c >> 5), rr = r & 15, cc = c & 31, ob = rr * 64 + cc * 2; return st * 1024 + (ob ^ (((ob >> 9) & 1) << 5)); }
__host__ __device__ __forceinline__ void stage_rc(int b, int& R, int& C) { const int st = b / 1024, sb = b % 1024, swz = sb ^ (((sb >> 9) & 1) << 5); R = (st >> 1) * 16 + swz / 64; C = (st & 1) * 32 + (swz % 64) / 2; }
__host__ __device__ __forceinline__ int perm32(int rho) { const int n = rho >> 4, i = rho & 15; return 8 * (i >> 2) + 4 * n + (i & 3); }

struct Unit { int pm, pn; };
struct Gemm { const bf16_t* A; const bf16_t* Bt; int M, N, K, lda, ldb; int agrp; size_t astep; };

struct SplitOrder {
    int c, nN;
    __host__ __device__ void init(int M, int N, int G_, int c_) { c = c_; nN = N / BM; (void)M; (void)G_; }
    __host__ __device__ bool next(int i, Unit& u) const { int idx; if (c < 128) { if (i >= 2) return false; idx = 2 * c + i; } else { if (i >= 4) return false; idx = 256 + 4 * (c - 128) + i; } u.pm = idx / nN; u.pn = idx % nN; return true; }
    __device__ __forceinline__ void a_ready(const Unit&) const {}
    __device__ __forceinline__ void done(const Unit&) const {}
};
struct StaticOrder {
    int nM, nN, nwg, G, c;
    __host__ __device__ void init(int M, int N, int G_, int c_) { nM = M / BM; nN = N / BM; nwg = nM * nN; G = G_; c = c_; }
    __host__ __device__ bool next(int i, Unit& u) const {
        const long L = (long)i * G + c; if (L >= nwg) return false;
        int wgid = (int)L; { const int q = nwg / NXCD, r = nwg % NXCD, xcd = wgid % NXCD, off = wgid / NXCD; wgid = (xcd < r ? xcd * (q + 1) : r * (q + 1) + (xcd - r) * q) + off; }
        const int nig = WGM * nN, gid = wgid / nig, fm = gid * WGM, gsz = (nM - fm) < WGM ? (nM - fm) : WGM;
        u.pm = fm + ((wgid % nig) % gsz); u.pn = (wgid % nig) / gsz; return true;
    }
    __device__ __forceinline__ void a_ready(const Unit&) const {}
    __device__ __forceinline__ void done(const Unit&) const {}
};

typedef float f32x2 __attribute__((ext_vector_type(2)));
typedef __bf16 bf16x2_t __attribute__((ext_vector_type(2)));
__device__ __forceinline__ unsigned pkbf(float lo, float hi) { f32x2 v = {lo, hi}; bf16x2_t b = __builtin_convertvector(v, bf16x2_t); return __builtin_bit_cast(unsigned, b); }
__device__ __forceinline__ float bflo(unsigned w) { return __uint_as_float(w << 16); }
__device__ __forceinline__ float bfhi(unsigned w) { return __uint_as_float(w & 0xffff0000u); }
__device__ __forceinline__ float sigm(float x) { return 1.0f / (1.0f + __expf(-x)); }
template <class Fn> struct Epi8 {
    static constexpr bool PERM = true, AFTER_DRAIN = false; Fn f;
    __device__ __forceinline__ void operator()(const f32x4 (&acc)[2][2][4][2], const Unit& u, int wr, int wc, int fr, int fq) const {
        const int row0 = u.pm * BM + wr * 64 + fr, col0 = u.pn * BM + wc * 32 + 8 * fq;
#pragma unroll
        for (int ai = 0; ai < 2; ++ai)
#pragma unroll
            for (int m = 0; m < 4; ++m)
#pragma unroll
                for (int bj = 0; bj < 2; ++bj) { f(row0 + ai * HALF + m * 16, col0 + bj * HALF, acc[ai][bj][m][0], acc[ai][bj][m][1]); }
    }
};
__device__ __forceinline__ void st8bf(bf16_t* p, f32x4 v0, f32x4 v1) { u32x4 w; w.x = pkbf(v0[0], v0[1]); w.y = pkbf(v0[2], v0[3]); w.z = pkbf(v1[0], v1[1]); w.w = pkbf(v1[2], v1[3]); *(u32x4*)p = w; }
struct FnP1 { bf16_t* O; int coff;
    __device__ __forceinline__ void operator()(int row, int col, f32x4 v0, f32x4 v1) const {
        col += coff;
        if (col >= 3072) {
            if (col < 3136) {
#pragma unroll
                for (int j = 0; j < 4; ++j) { v0[j] = 1.0f - 2.0f / (__expf(2.0f * v0[j]) + 1.0f); v1[j] = 1.0f - 2.0f / (__expf(2.0f * v1[j]) + 1.0f); } }
            else if (col >= 3232 && col < 3392) {
#pragma unroll
                for (int j = 0; j < 4; ++j) { v0[j] = sigm(v0[j]); v1[j] = sigm(v1[j]); } }
        }
        st8bf(O + (size_t)row * 3584 + col, v0, v1); } };
struct FnP2 { bf16_t* O; const float* bias;
    __device__ __forceinline__ void operator()(int row, int col, f32x4 v0, f32x4 v1) const {
        const f32x4 b0 = *(const f32x4*)(bias + col), b1 = *(const f32x4*)(bias + col + 4);
        const float sc = col < 1024 ? -0.60653065971f : 1.0f;
#pragma unroll
        for (int j = 0; j < 4; ++j) { v0[j] = sc * sigm(v0[j] + b0[j]); v1[j] = sc * sigm(v1[j] + b1[j]); }
        st8bf(O + (size_t)row * 3072 + col, v0, v1); } };
struct FnGate { bf16_t* Y; int ld;
    __device__ __forceinline__ void operator()(int row, int col, f32x4 v0, f32x4 v1) const {
        bf16_t* p = Y + (size_t)row * ld + col; const u32x4 y = *(const u32x4*)p;
        v0[0] *= bflo(y.x); v0[1] *= bfhi(y.x); v0[2] *= bflo(y.y); v0[3] *= bfhi(y.y); v1[0] *= bflo(y.z); v1[1] *= bfhi(y.z); v1[2] *= bflo(y.w); v1[3] *= bfhi(y.w);
        st8bf(p, v0, v1); } };
struct FnRes { const float* xin; float* xout; const float* gate;
    __device__ __forceinline__ void operator()(int row, int col, f32x4 v0, f32x4 v1) const {
        const float* gp = gate + (row >> 13) * 6144 + col; const f32x4 g0 = *(const f32x4*)gp, g1 = *(const f32x4*)(gp + 4);
        const size_t off = (size_t)row * 1024 + col; const f32x4 x0 = *(const f32x4*)(xin + off), x1 = *(const f32x4*)(xin + off + 4);
        *(f32x4*)(xout + off) = x0 + (g0 + 1.0f) * v0; *(f32x4*)(xout + off + 4) = x1 + (g1 + 1.0f) * v1; } };
struct FnUp { bf16_t* O;
    __device__ __forceinline__ void operator()(int row, int col, f32x4 v0, f32x4 v1) const {
#pragma unroll
        for (int j = 0; j < 4; ++j) { const float a = fmaxf(v0[j], 0.f), b = fmaxf(v1[j], 0.f); v0[j] = a * a; v1[j] = b * b; }
        st8bf(O + (size_t)row * 4096 + col, v0, v1); } };
struct FnKv { bf16_t* O; float* FL;
    __device__ __forceinline__ void operator()(int row, int col, f32x4 v0, f32x4 v1) const {
        if (col < 2048) st8bf(O + (size_t)row * 2048 + col, v0, v1);
        else if (col < 2064) { float* p = FL + (size_t)row * 16 + (col - 2048); *(f32x4*)p = v0; *(f32x4*)(p + 4) = v1; } } };
struct FnQg { bf16_t* Q; bf16_t* G;
    __device__ __forceinline__ void operator()(int row, int col, f32x4 v0, f32x4 v1) const {
        if (col < 1024) st8bf(Q + (size_t)row * 1024 + col, v0, v1);
        else {
#pragma unroll
            for (int j = 0; j < 4; ++j) { v0[j] = sigm(v0[j]); v1[j] = sigm(v1[j]); }
            st8bf(G + (size_t)row * 1024 + (col - 1024), v0, v1); } } };
template <class Epi, class Sched, bool ALIGN_EPI = false, bool SP2 = false>
__device__ __forceinline__ void gemm_phase(PG8_LAS unsigned char* lds, const Gemm g, const Sched& S, const Epi& E, const int tid_in) {
    int tid_l = tid_in; asm volatile("" : "+v"(tid_l));
    const int tid = tid_l, wid = __builtin_amdgcn_readfirstlane(tid >> 6), lane = tid & 63, wr = wid >> 2, wc = wid & 3, fr = lane & 15, fq = lane >> 4;
    const int K = g.K, nt = K / BK;
    unsigned voffA[2], voffB[2];
#pragma unroll
    for (int i = 0; i < 2; ++i) { int R, C; stage_rc(tid * 16 + i * 8192, R, C); const int Rb = Epi::PERM ? ((R & ~31) + perm32(R & 31)) : R;
        voffA[i] = (unsigned)(R * g.lda + C) * 2u; voffB[i] = (unsigned)(Rb * g.ldb + C) * 2u; }
    const size_t kstep = (size_t)(BK * 2);
    const size_t hstepA = (size_t)HALF * g.lda * 2, hstepB = (size_t)HALF * g.ldb * 2;
    const size_t tstepA = 2 * hstepA, tstepB = 2 * hstepB;
    const unsigned ldsw = (unsigned)wid * 1024u;
    const int aoff = lds_byte(wr * 64 + fr, fq * 8), boff = lds_byte(wc * 32 + fr, fq * 8);
#define PG8_SA(b, h) (((b) * 2 + (h)) * HTB)
#define PG8_SB(b, h) ((4 + (b) * 2 + (h)) * HTB)
#define PG8_STAGE(bufoff, gbase, voff) do { _Pragma("unroll") for (int _i = 0; _i < 2; ++_i) \
        __builtin_amdgcn_global_load_lds((const unsigned*)((const char*)(gbase) + (voff)[_i]), (PG8_LAS unsigned*)(lds + (bufoff) + ldsw + _i * 8192), 16, 0, 0); } while (0)
#define PG8_LDA(dst, b, h) do { _Pragma("unroll") for (int m = 0; m < 4; ++m) _Pragma("unroll") for (int k = 0; k < 2; ++k) dst[m][k] = *(const PG8_LAS bf16x8*)(lds + PG8_SA(b, h) + aoff + m * 2048 + k * 1024); } while (0)
#define PG8_LDB(dst, b, h) do { _Pragma("unroll") for (int n = 0; n < 2; ++n) _Pragma("unroll") for (int k = 0; k < 2; ++k) dst[n][k] = *(const PG8_LAS bf16x8*)(lds + PG8_SB(b, h) + boff + n * 2048 + k * 1024); } while (0)
#define PG8_MMA(ai, bj, At, Bt) do { __builtin_amdgcn_s_setprio(1); _Pragma("unroll") for (int m = 0; m < 4; ++m) _Pragma("unroll") for (int n = 0; n < 2; ++n) _Pragma("unroll") for (int k = 0; k < 2; ++k) \
        acc[ai][bj][m][n] = __builtin_amdgcn_mfma_f32_16x16x32_bf16(Bt[n][k], At[m][k], acc[ai][bj][m][n], 0, 0, 0); __builtin_amdgcn_s_setprio(0); } while (0)
#define PG8_WAIT_V(n) asm volatile("s_waitcnt vmcnt(" #n ")" ::: "memory")
#define PG8_WAIT_L(n) asm volatile("s_waitcnt lgkmcnt(" #n ")" ::: "memory")
#define PG8_BAR __builtin_amdgcn_s_barrier()
#define PG8_SCHED __builtin_amdgcn_sched_barrier(0)
    Unit cur, nxt; int ui = 0;
    if (!S.next(0, cur)) return;
    f32x4 acc[2][2][4][2];
#pragma unroll
    for (int a = 0; a < 2; ++a)
#pragma unroll
        for (int b = 0; b < 2; ++b)
#pragma unroll
            for (int m = 0; m < 4; ++m)
#pragma unroll
                for (int n = 0; n < 2; ++n) acc[a][b][m][n] = (f32x4){0.f, 0.f, 0.f, 0.f};
    bf16x8 At[4][2], B0[2][2], B1[2][2];
    const char* cA = (const char*)g.A + (size_t)cur.pm * tstepA + (g.agrp ? (size_t)(cur.pn / g.agrp) * g.astep : (size_t)0); const char* cB = (const char*)g.Bt + (size_t)cur.pn * tstepB;
    S.a_ready(cur);
    if constexpr (SP2) {
        PG8_STAGE(PG8_SB(0, 0), cB, voffB); PG8_STAGE(PG8_SB(0, 1), cB + hstepB, voffB); PG8_STAGE(PG8_SA(0, 0), cA, voffA); PG8_STAGE(PG8_SA(0, 1), cA + hstepA, voffA);
        if (wr == 1) PG8_BAR;
        PG8_WAIT_V(2); PG8_BAR;
        PG8_STAGE(PG8_SB(1, 0), cB + kstep, voffB); PG8_STAGE(PG8_SA(1, 0), cA + kstep, voffA); PG8_STAGE(PG8_SB(1, 1), cB + hstepB + kstep, voffB);
        PG8_WAIT_V(6); PG8_BAR;
    } else {
        PG8_STAGE(PG8_SB(0, 0), cB, voffB); PG8_STAGE(PG8_SA(0, 0), cA, voffA); PG8_STAGE(PG8_SB(0, 1), cB + hstepB, voffB); PG8_STAGE(PG8_SA(0, 1), cA + hstepA, voffA);
        if (wr == 1) PG8_BAR;
        PG8_WAIT_V(4); PG8_BAR;
        PG8_STAGE(PG8_SB(1, 0), cB + kstep, voffB); PG8_STAGE(PG8_SA(1, 0), cA + kstep, voffA); PG8_STAGE(PG8_SB(1, 1), cB + hstepB + kstep, voffB);
        PG8_WAIT_V(6); PG8_BAR;
    }
    for (;;) {
        const bool has_next = S.next(ui + 1, nxt);
        const char* nA = has_next ? (const char*)g.A + (size_t)nxt.pm * tstepA + (g.agrp ? (size_t)(nxt.pn / g.agrp) * g.astep : (size_t)0) : cA; const char* nB = has_next ? (const char*)g.Bt + (size_t)nxt.pn * tstepB : cB;
        for (int t = 0; t < nt; t += 2) {
            const bool last = (t == nt - 2);
            const char* a1 = cA + (size_t)(t + 1) * kstep;
            const char* a2 = last ? nA : cA + (size_t)(t + 2) * kstep; const char* b2 = last ? nB : cB + (size_t)(t + 2) * kstep;
            const char* a3 = a2 + kstep; const char* b3 = b2 + kstep;
            if (last && has_next) S.a_ready(nxt);
            if constexpr (SP2) {
            PG8_LDB(B0, 0, 0); PG8_LDB(B1, 0, 1); PG8_SCHED; PG8_LDA(At, 0, 0); PG8_STAGE(PG8_SA(1, 1), a1 + hstepA, voffA);
            PG8_WAIT_V(8); PG8_WAIT_L(0); PG8_BAR; PG8_MMA(0, 0, At, B0); PG8_MMA(0, 1, At, B1); PG8_BAR; PG8_SCHED;
            PG8_LDA(At, 0, 1); PG8_STAGE(PG8_SB(0, 0), b2, voffB); PG8_STAGE(PG8_SB(0, 1), b2 + hstepB, voffB); PG8_STAGE(PG8_SA(0, 0), a2, voffA);
            PG8_WAIT_V(8); PG8_WAIT_L(0); PG8_BAR; PG8_MMA(1, 0, At, B0); PG8_MMA(1, 1, At, B1); PG8_BAR; PG8_SCHED;
            PG8_LDB(B0, 1, 0); PG8_LDB(B1, 1, 1); PG8_SCHED; PG8_LDA(At, 1, 0); PG8_STAGE(PG8_SA(0, 1), a2 + hstepA, voffA);
            PG8_WAIT_V(8); PG8_WAIT_L(0); PG8_BAR; PG8_MMA(0, 0, At, B0); PG8_MMA(0, 1, At, B1); PG8_BAR; PG8_SCHED;
            PG8_LDA(At, 1, 1); PG8_STAGE(PG8_SB(1, 0), b3, voffB); PG8_STAGE(PG8_SB(1, 1), b3 + hstepB, voffB); PG8_STAGE(PG8_SA(1, 0), a3, voffA);
            PG8_WAIT_V(8); PG8_WAIT_L(0); PG8_BAR; PG8_MMA(1, 0, At, B0); PG8_MMA(1, 1, At, B1); PG8_BAR; PG8_SCHED;
            } else {
            PG8_LDB(B0, 0, 0); PG8_SCHED; PG8_LDA(At, 0, 0); PG8_STAGE(PG8_SA(1, 1), a1 + hstepA, voffA);
            PG8_WAIT_L(8); PG8_BAR; PG8_WAIT_L(0); PG8_MMA(0, 0, At, B0); PG8_BAR; PG8_SCHED;
            PG8_LDB(B1, 0, 1); PG8_STAGE(PG8_SB(0, 0), b2, voffB);
            PG8_BAR; PG8_WAIT_L(0); PG8_MMA(0, 1, At, B1); PG8_BAR;
            PG8_LDA(At, 0, 1); PG8_STAGE(PG8_SA(0, 0), a2, voffA);
            PG8_BAR; PG8_WAIT_L(0); PG8_MMA(1, 0, At, B0); PG8_BAR; PG8_SCHED;
            PG8_STAGE(PG8_SB(0, 1), b2 + hstepB, voffB);
            PG8_WAIT_V(6); PG8_BAR; PG8_MMA(1, 1, At, B1); PG8_BAR;
            PG8_LDB(B0, 1, 0); PG8_SCHED; PG8_LDA(At, 1, 0); PG8_STAGE(PG8_SA(0, 1), a2 + hstepA, voffA);
            PG8_WAIT_L(8); PG8_BAR; PG8_WAIT_L(0); PG8_MMA(0, 0, At, B0); PG8_BAR; PG8_SCHED;
            PG8_LDB(B1, 1, 1); PG8_STAGE(PG8_SB(1, 0), b3, voffB);
            PG8_BAR; PG8_WAIT_L(0); PG8_MMA(0, 1, At, B1); PG8_BAR;
            PG8_LDA(At, 1, 1); PG8_STAGE(PG8_SA(1, 0), a3, voffA);
            PG8_BAR; PG8_WAIT_L(0); PG8_MMA(1, 0, At, B0); PG8_BAR; PG8_SCHED;
            PG8_STAGE(PG8_SB(1, 1), b3 + hstepB, voffB);
            PG8_WAIT_V(6); PG8_BAR; PG8_MMA(1, 1, At, B1); PG8_BAR;
            }
        }
        if constexpr (ALIGN_EPI) { if (wr == 0) PG8_BAR; }
        if constexpr (!Epi::AFTER_DRAIN) { E(acc, cur, wr, wc, fr, fq); S.done(cur); }
        if (!has_next) break;
#pragma unroll
        for (int a = 0; a < 2; ++a)
#pragma unroll
            for (int b = 0; b < 2; ++b)
#pragma unroll
                for (int m = 0; m < 4; ++m)
#pragma unroll
                    for (int n = 0; n < 2; ++n) acc[a][b][m][n] = (f32x4){0.f, 0.f, 0.f, 0.f};
        cur = nxt; cA = nA; cB = nB; ++ui;
        if constexpr (ALIGN_EPI) { if (wr == 1) PG8_BAR; }
    }
    PG8_WAIT_V(0);
    if constexpr (!ALIGN_EPI) { if (wr == 0) PG8_BAR; }
    PG8_BAR;
    if constexpr (Epi::AFTER_DRAIN) { E.fused(acc, cur, wr, wc, fr, fq, lds, wid, lane); S.done(cur); }
#undef PG8_SA
#undef PG8_SB
#undef PG8_STAGE
#undef PG8_LDA
#undef PG8_LDB
#undef PG8_MMA
#undef PG8_WAIT_V
#undef PG8_WAIT_L
#undef PG8_BAR
#undef PG8_SCHED
}
}
#include <hip/hip_bf16.h>
#include <cmath>
namespace attn_body {
using bf16=__hip_bfloat16;
using bf16x8=__attribute__((ext_vector_type(8)))short;
using s16x4=__attribute__((ext_vector_type(4)))short;
using f32x16=__attribute__((ext_vector_type(16)))float;
using u32x4=__attribute__((ext_vector_type(4)))unsigned;
constexpr int BATCH=2,NHEAD=16,SEQ=8192,D=64,DM=NHEAD*D;
constexpr int NW=8,QBLK=32,QB=QBLK*NW,KVBLK=64,NQB=SEQ/QB;
constexpr int ATTN_PITCH=DM, ATTN_UNIT_ROWS=QB;
__device__ __forceinline__ int crow(int r,int hi){return (r&3)+8*(r>>2)+4*hi;}
#define SBAR() __builtin_amdgcn_sched_barrier(0)
__device__ __forceinline__ void cmask(f32x16&p0,f32x16&p1,int jb,int qrel,int hi){
  const float NEG=-INFINITY; int kb=64*jb+4*hi;
  #pragma unroll
  for(int r=0;r<16;++r){int kv=kb+(r&3)+8*(r>>2); if(kv>qrel)p0[r]=NEG; if(kv+32>qrel)p1[r]=NEG;}
}

constexpr int NSLOT=3, SLOTB=9216;
constexpr int LDS_K=0, LDS_V=NSLOT*SLOTB, LDS_WS=2*NSLOT*SLOTB, LDS_OST=LDS_WS+NW*64*4, LDS_BYTES=LDS_OST+NW*4096;
constexpr float C2=0.125f*1.4426950408889634f;
__device__ __forceinline__ void glds16(const void*gsrc,unsigned lds_dst){unsigned keep;
  asm volatile("s_mov_b32 %0, m0\n\ts_mov_b32 m0, %2\n\ts_nop 0\n\tglobal_load_lds_dwordx4 %1, off\n\ts_mov_b32 m0, %0":"=&s"(keep):"v"(gsrc),"s"(lds_dst):"memory");}
__device__ __forceinline__ float max3f(float a,float b,float c){float r;asm("v_max3_f32 %0, %1, %2, %3":"=v"(r):"v"(a),"v"(b),"v"(c));return r;}
__device__ __forceinline__ float max2f(float a,float b){float r;asm("v_max_f32_e32 %0, %1, %2":"=v"(r):"v"(a),"v"(b));return r;}
__device__ __forceinline__ float fadd_s(float a,float b){float r;asm("v_add_f32_e32 %0, %1, %2":"=v"(r):"v"(a),"v"(b));return r;}
__device__ __forceinline__ float fsub_s(float a,float b){float r;asm("v_sub_f32_e32 %0, %1, %2":"=v"(r):"v"(a),"v"(b));return r;}
typedef float f32x2_t __attribute__((ext_vector_type(2))); typedef __bf16 bf16x2_t __attribute__((ext_vector_type(2)));
__device__ __forceinline__ unsigned cvtpk_s(float lo,float hi){f32x2_t v={lo,hi};bf16x2_t b=__builtin_convertvector(v,bf16x2_t);return __builtin_bit_cast(unsigned,b);}
#define WAIT_BAR(N) asm volatile("s_waitcnt vmcnt(" #N ") lgkmcnt(0)\n\ts_barrier":::"memory")
#define WAIT_BARW() do{ if(wid==0){WAIT_BAR(3);} else {WAIT_BAR(2);} }while(0)

__device__ __forceinline__ void qkt(f32x16&p0,f32x16&p1,const char*Kslot,const bf16x8*qr,const bf16x8 qe,const f32x16&negm,int r32,int hi){
  const char*kb=Kslot+hi*1024+r32*16;
  #pragma unroll
  for(int d0=0;d0<4;++d0){
    const bf16x8 b0=*reinterpret_cast<const bf16x8*>(kb+d0*2048);
    const bf16x8 b1=*reinterpret_cast<const bf16x8*>(kb+d0*2048+512);
    if(d0==0){p0=__builtin_amdgcn_mfma_f32_32x32x16_bf16(b0,qr[0],negm,0,0,0);p1=__builtin_amdgcn_mfma_f32_32x32x16_bf16(b1,qr[0],negm,0,0,0);}
    else{p0=__builtin_amdgcn_mfma_f32_32x32x16_bf16(b0,qr[d0],p0,0,0,0);p1=__builtin_amdgcn_mfma_f32_32x32x16_bf16(b1,qr[d0],p1,0,0,0);}}
  { const char*ke=Kslot+8192+r32*16; const bf16x8 e0=*reinterpret_cast<const bf16x8*>(ke),e1=*reinterpret_cast<const bf16x8*>(ke+512);
    p0=__builtin_amdgcn_mfma_f32_32x32x16_bf16(e0,qe,p0,0,0,0);p1=__builtin_amdgcn_mfma_f32_32x32x16_bf16(e1,qe,p1,0,0,0);}
}
typedef __attribute__((address_space(3))) const char* lds_cptr;
typedef short v4i16_t __attribute__((ext_vector_type(4)));
__device__ __forceinline__ void kload8(bf16x8*kf,lds_cptr kp){
  kf[0]=*(const __attribute__((address_space(3))) bf16x8*)(kp);      kf[1]=*(const __attribute__((address_space(3))) bf16x8*)(kp+512);
  kf[2]=*(const __attribute__((address_space(3))) bf16x8*)(kp+2048); kf[3]=*(const __attribute__((address_space(3))) bf16x8*)(kp+2560);
  kf[4]=*(const __attribute__((address_space(3))) bf16x8*)(kp+4096); kf[5]=*(const __attribute__((address_space(3))) bf16x8*)(kp+4608);
  kf[6]=*(const __attribute__((address_space(3))) bf16x8*)(kp+6144); kf[7]=*(const __attribute__((address_space(3))) bf16x8*)(kp+6656);
}
__device__ __forceinline__ void kload2(bf16x8*kf,lds_cptr kp,int j){ kf[2*j]=*(const __attribute__((address_space(3))) bf16x8*)(kp+j*2048); kf[2*j+1]=*(const __attribute__((address_space(3))) bf16x8*)(kp+j*2048+512); }
__device__ __forceinline__ s16x4 vtr(lds_cptr p){ return __builtin_bit_cast(s16x4,__builtin_amdgcn_ds_read_tr16_b64_v4i16((__attribute__((address_space(3))) v4i16_t*)p)); }
__device__ __forceinline__ float rowmax(const f32x16&p0,const f32x16&p1){
  float a=max3f(p0[0],p0[1],p1[0]),b=max3f(p0[2],p0[3],p1[1]);a=max3f(a,p1[2],p1[3]);
  #pragma unroll
  for(int r=4;r<16;r+=4){a=max3f(a,p0[r],p0[r+1]);b=max3f(b,p0[r+2],p0[r+3]);a=max3f(a,p1[r],p1[r+1]);b=max3f(b,p1[r+2],p1[r+3]);}
  const float m=max2f(a,b);
  auto rr=__builtin_amdgcn_permlane32_swap(__float_as_uint(m),__float_as_uint(m),false,false);
  return max2f(__uint_as_float(rr[0]),__uint_as_float(rr[1]));
}
__device__ __forceinline__ void pv(f32x16*o,int vb,bf16x8 pa0,bf16x8 pa1,bf16x8 pa2,bf16x8 pa3){
  #pragma unroll
  for(int d0=0;d0<2;++d0){s16x4 lo[4],hi[4];
    #pragma unroll
    for(int ks=0;ks<4;++ks){
      asm volatile("ds_read_b64_tr_b16 %0,%1 offset:%c2":"=&v"(lo[ks]):"v"(vb),"i"(d0*4096+ks*1024):"memory");
      asm volatile("ds_read_b64_tr_b16 %0,%1 offset:%c2":"=&v"(hi[ks]):"v"(vb),"i"(d0*4096+ks*1024+512):"memory");}
    asm volatile("s_waitcnt lgkmcnt(0)":::"memory");SBAR();
    #define PK(k) (bf16x8){lo[k][0],lo[k][1],lo[k][2],lo[k][3],hi[k][0],hi[k][1],hi[k][2],hi[k][3]}
    o[d0]=__builtin_amdgcn_mfma_f32_32x32x16_bf16(pa0,PK(0),o[d0],0,0,0);
    o[d0]=__builtin_amdgcn_mfma_f32_32x32x16_bf16(pa1,PK(1),o[d0],0,0,0);
    o[d0]=__builtin_amdgcn_mfma_f32_32x32x16_bf16(pa2,PK(2),o[d0],0,0,0);
    o[d0]=__builtin_amdgcn_mfma_f32_32x32x16_bf16(pa3,PK(3),o[d0],0,0,0);
    #undef PK
  }
}

#ifndef ATTN_STORE16
#define ATTN_STORE16(p,v) (*(u32x4*)(p)=(v))
#endif
template<int THRL> __device__ __forceinline__ void attn_unit(int b,int h,int qb,const bf16*Q,const bf16*__restrict__ K,const bf16*__restrict__ V,bf16*O,const bf16*__restrict__ GT,const unsigned char*__restrict__ G3,const float*__restrict__ qgain,const float kbound,char*shm,const int tid_in){
  int tid_l=tid_in; asm volatile("":"+v"(tid_l)); const int tid=tid_l,lane=tid&63,r32=lane&31,hi=lane>>5; const int wid=__builtin_amdgcn_readfirstlane(tid>>6);
  const long rowbase=(long)b*SEQ; const int q0=qb*QB;
  const bf16*Qw=Q+(rowbase+q0+wid*QBLK)*DM+h*D;
  const bf16*Kh=K+rowbase*DM+h*D,*Vh=V+rowbase*DM+h*D;
  const unsigned lds0=(unsigned)(uintptr_t)shm;
  float*wsf=(float*)(shm+LDS_WS)+wid*64;
  const bf16*ksrc=Kh+(long)lane*DM+wid*8;
  const bf16*vsrc=Vh+(long)(16*(wid&3)+(lane>>2))*DM+(wid>>2)*32+(lane&3)*8;
  const unsigned kdst=lds0+LDS_K+wid*1024, vdst=lds0+LDS_V+wid*1024, gdst=lds0+LDS_K+8192;
  const unsigned char*gsrc=G3+((long)(b*NHEAD+h)*SEQ+lane)*16;
  #define DMA_K(t,slot) do{ if(wid==0)glds16(gsrc+(long)(t)*KVBLK*16,(unsigned)__builtin_amdgcn_readfirstlane(gdst+(slot))); glds16(ksrc+(long)(t)*KVBLK*DM,(unsigned)__builtin_amdgcn_readfirstlane(kdst+(slot))); }while(0)
  #define DMA_V(t,slot) glds16(vsrc+(long)(t)*KVBLK*DM,(unsigned)__builtin_amdgcn_readfirstlane(vdst+(slot)))
  const int vb0=(int)(lds0+LDS_V)+((lane>>4)&1)*32+(lane&3)*8+(4*hi+((lane&15)>>2))*64;
  const char*Kbase=shm+LDS_K; bf16x8 kf[10];
  const lds_cptr shm3=(lds_cptr)shm; const lds_cptr kp0=shm3+LDS_K+hi*1024+r32*16; const lds_cptr kpe=shm3+LDS_K+8192+r32*16; const lds_cptr vp0=shm3+LDS_V+((lane>>4)&1)*32+(lane&3)*8+(4*hi+((lane&15)>>2))*64;
  const int NT=(q0+QB)/KVBLK;
  DMA_K(0,0);DMA_V(0,0);DMA_K(1,SLOTB);
  bf16x8 qr[4]; float fq2; bf16x8 qe; float ubound;
  { bf16x8 qraw[4];
    #pragma unroll
    for(int d0=0;d0<4;++d0)qraw[d0]=*reinterpret_cast<const bf16x8*>(&Qw[(long)r32*DM+d0*16+hi*8]);
    const u32x4 ge=*reinterpret_cast<const u32x4*>(G3+((long)(b*NHEAD+h)*SEQ+q0+wid*QBLK+r32)*16);
    fq2=-(__uint_as_float(ge[0]<<16)+__uint_as_float(ge[0]&0xffff0000u)+__uint_as_float(ge[1]<<16));
    float ss=0.f;
    #pragma unroll
    for(int d0=0;d0<4;++d0)
      #pragma unroll
      for(int j=0;j<8;++j){const float x=__uint_as_float(((unsigned)(unsigned short)qraw[d0][j])<<16);ss+=x*x;}
    {auto rr=__builtin_amdgcn_permlane32_swap(__float_as_uint(ss),__float_as_uint(ss),false,false);ss=__uint_as_float(rr[0])+__uint_as_float(rr[1]);}
    const float qs=C2/sqrtf(ss*(1.0f/64.0f)+1e-6f);
    float s2=0.f;
    #pragma unroll
    for(int d0=0;d0<4;++d0){ u32x4 w;
      #pragma unroll
      for(int j=0;j<8;j+=2){const float x0=__uint_as_float(((unsigned)(unsigned short)qraw[d0][j])<<16),x1=__uint_as_float(((unsigned)(unsigned short)qraw[d0][j+1])<<16);
        const float y0=x0*qs*qgain[d0*16+hi*8+j],y1=x1*qs*qgain[d0*16+hi*8+j+1]; s2+=y0*y0+y1*y1;
        w[j>>1]=cvtpk_s(y0,y1);}
      qr[d0]=__builtin_bit_cast(bf16x8,w);}
    {auto rr=__builtin_amdgcn_permlane32_swap(__float_as_uint(s2),__float_as_uint(s2),false,false);s2=__uint_as_float(rr[0])+__uint_as_float(rr[1]);}
    ubound=sqrtf(s2)*kbound;
    const unsigned one2=hi?0u:0x3f803f80u, one1=hi?0u:0x00003f80u; qe=__builtin_bit_cast(bf16x8,(u32x4){one2,one1,0u,0u}); }
  float mhat=ubound,l_reg=0.f;f32x16 o[2];o[0]=f32x16{};o[1]=f32x16{};f32x16 negm;
  #pragma unroll
  for(int r=0;r<16;++r)negm[r]=fq2-ubound;
  asm volatile("":"+v"(negm));
  const int qrel=wid*QBLK+r32;
  #define CMASK(P0,P1,t) do{int jb_=(t)-(NT-4); if(jb_>=0)cmask(P0,P1,jb_,qrel,hi);}while(0)
  bool resc=false;
  #define START(P0,P1) do{ const float rm=rowmax(P0,P1); resc=false; \
    { const float dl=fmaxf(rm,0.f); mhat=fadd_s(mhat,dl); \
      _Pragma("unroll") for(int r=0;r<16;++r){P0[r]=fsub_s(P0[r],dl);P1[r]=fsub_s(P1[r],dl);} \
      _Pragma("unroll") for(int r=0;r<16;++r)negm[r]=fq2-mhat; asm volatile("":"+v"(negm)); } \
    _Pragma("unroll") for(int r=0;r<16;++r)P0[r]=__builtin_amdgcn_exp2f(P0[r]); }while(0)
  #define RESC() do{ if(resc){ asm volatile("s_waitcnt lgkmcnt(0)":::"memory"); \
      _Pragma("unroll") for(int d_=0;d_<2;++d_) _Pragma("unroll") for(int r=0;r<16;++r)o[d_][r]*=wsf[crow(r,hi)]; } }while(0)
  f32x16 pA0,pA1,pB0,pB1;
  int sl_prev=0,sl_cur=0,sl_next=SLOTB;
  #define ROT() do{sl_prev=sl_cur;sl_cur=sl_next;sl_next=(sl_next==(NSLOT-1)*SLOTB)?0:sl_next+SLOTB;}while(0)
  DMA_K(2,2*SLOTB);
  WAIT_BAR(3);
  qkt(pA0,pA1,Kbase,qr,qe,negm,r32,hi);asm volatile("s_nop 15\n\ts_nop 7":"+v"(pA0),"+v"(pA1));CMASK(pA0,pA1,0);
  START(pA0,pA1);
  _Pragma("unroll") for(int r=0;r<16;++r)pA1[r]=__builtin_amdgcn_exp2f(pA1[r]);
  WAIT_BAR(0);
  DMA_K(3,0);DMA_V(1,SLOTB);
  ROT();
  kload8(kf,kp0+sl_cur);
  kf[8]=*(const __attribute__((address_space(3))) bf16x8*)(kpe+sl_cur); kf[9]=*(const __attribute__((address_space(3))) bf16x8*)(kpe+sl_cur+512);
  WAIT_BARW();
  s16x4 vlo[8],vhi[8]; u32x4 pw0,pw1,pw2,pw3;
  #define PKW(P,B) cvtpk_s(P[B],P[B+1])
  #define PAF(k) __builtin_bit_cast(bf16x8,pw##k)
  #define VFR(i) (bf16x8){vlo[i][0],vlo[i][1],vlo[i][2],vlo[i][3],vhi[i][0],vhi[i][1],vhi[i][2],vhi[i][3]}
  #define PIN(x) asm volatile("":"+v"(x))
  #define MX3(a,b,c) __builtin_fmaxf(__builtin_fmaxf((a),(b)),(c))
  #define GAPA(MF,A0,A1,A2,A3,W0,W1,PW) do{ MF; sacc+=A0; sacc+=A1; sacc+=A2; sacc+=A3; PIN(sacc); W0; W1; PIN(PW); SBAR(); }while(0)
  #define EX(v) __builtin_amdgcn_exp2f(v)
  #define GAPB(MF,X,B) do{ MF; X[B]=EX(X[B]); X[B+1]=EX(X[B+1]); X[B+2]=EX(X[B+2]); X[B+3]=EX(X[B+3]); PIN(X); SBAR(); }while(0)
  #define VRD(i) do{ vlo[i]=vtr(vp_+(((i)>>2)*4096+((i)&3)*1024)); vhi[i]=vtr(vp_+(((i)>>2)*4096+((i)&3)*1024+512)); }while(0)
  #define KRD(G,j) do{ if(G){ kload2(kf,kp0+sl_next,j); SBAR(); } }while(0)
  #define STEP(C0,C1,P0,P1,t,GK,GV,GL) do{ SBAR(); \
    const lds_cptr vp_=vp0+sl_prev; \
    VRD(0); SBAR(); float sacc=(P0[0]+P0[1]); \
    GAPA(C0=__builtin_amdgcn_mfma_f32_32x32x16_bf16(kf[0],qr[0],negm,0,0,0), P0[2],P0[3],P0[4],P0[5],     pw0[0]=PKW(P0,0), pw0[1]=PKW(P0,2), pw0); \
    VRD(4); SBAR(); GAPA(C1=__builtin_amdgcn_mfma_f32_32x32x16_bf16(kf[1],qr[0],negm,0,0,0), P0[6],P0[7],P0[8],P0[9],     pw0[2]=PKW(P0,4), pw0[3]=PKW(P0,6), pw0); \
    VRD(1); SBAR(); GAPA(C0=__builtin_amdgcn_mfma_f32_32x32x16_bf16(kf[2],qr[1],C0,0,0,0),   P0[10],P0[11],P0[12],P0[13], pw1[0]=PKW(P0,8), pw1[1]=PKW(P0,10), pw1); \
    VRD(5); SBAR(); GAPA(C1=__builtin_amdgcn_mfma_f32_32x32x16_bf16(kf[3],qr[1],C1,0,0,0),   P0[14],P0[15],P1[0],P1[1],   pw1[2]=PKW(P0,12),pw1[3]=PKW(P0,14), pw1); \
    VRD(2); SBAR(); GAPA(C0=__builtin_amdgcn_mfma_f32_32x32x16_bf16(kf[4],qr[2],C0,0,0,0),   P1[2],P1[3],P1[4],P1[5],     pw2[0]=PKW(P1,0), pw2[1]=PKW(P1,2), pw2); \
    VRD(6); SBAR(); GAPA(C1=__builtin_amdgcn_mfma_f32_32x32x16_bf16(kf[5],qr[2],C1,0,0,0),   P1[6],P1[7],P1[8],P1[9],     pw2[2]=PKW(P1,4), pw2[3]=PKW(P1,6), pw2); \
    VRD(3); SBAR(); GAPA(C0=__builtin_amdgcn_mfma_f32_32x32x16_bf16(kf[6],qr[3],C0,0,0,0),   P1[10],P1[11],P1[12],P1[13], pw3[0]=PKW(P1,8), pw3[1]=PKW(P1,10), pw3); \
    VRD(7); SBAR(); GAPA(C1=__builtin_amdgcn_mfma_f32_32x32x16_bf16(kf[7],qr[3],C1,0,0,0),   P1[14],P1[15],0.f,0.f,       pw3[2]=PKW(P1,12),pw3[3]=PKW(P1,14), pw3); \
    C0=__builtin_amdgcn_mfma_f32_32x32x16_bf16(kf[8],qe,C0,0,0,0); C1=__builtin_amdgcn_mfma_f32_32x32x16_bf16(kf[9],qe,C1,0,0,0); \
    l_reg+=sacc; \
    if(GK){DMA_K((t)+3,sl_cur);} if(GV){DMA_V((t)+1,sl_next);} \
    CMASK(C0,C1,t); \
    { float a=MX3(C0[0],C0[1],C1[0]),b=MX3(C0[2],C0[3],C1[1]); a=MX3(a,C1[2],C1[3]); \
      _Pragma("unroll") for(int r=4;r<16;r+=4){a=MX3(a,C0[r],C0[r+1]);b=MX3(b,C0[r+2],C0[r+3]);a=MX3(a,C1[r],C1[r+1]);b=MX3(b,C1[r+2],C1[r+3]);} \
      float rm=__builtin_fmaxf(a,b); { auto rr=__builtin_amdgcn_permlane32_swap(__float_as_uint(rm),__float_as_uint(rm),false,false); rm=__builtin_fmaxf(__uint_as_float(rr[0]),__uint_as_float(rr[1])); } \
      resc=false; \
      if(__builtin_expect(__any(rm>(float)THRL),0)){ const float dl=__builtin_fmaxf(rm,0.f); mhat+=dl; \
        _Pragma("unroll") for(int r=0;r<16;++r){C0[r]-=dl;C1[r]-=dl;} \
        _Pragma("unroll") for(int r=0;r<16;++r)negm[r]=fq2-mhat; asm volatile("":"+v"(negm)); \
        const float f=__builtin_amdgcn_exp2f(-dl); l_reg*=f; if(hi==0)wsf[r32]=f; resc=true; } } \
    SBAR(); \
    GAPB(o[0]=__builtin_amdgcn_mfma_f32_32x32x16_bf16(PAF(0),VFR(0),o[0],0,0,0), C0,0); \
    GAPB(o[1]=__builtin_amdgcn_mfma_f32_32x32x16_bf16(PAF(0),VFR(4),o[1],0,0,0), C0,4); \
    KRD(GL,0); GAPB(o[0]=__builtin_amdgcn_mfma_f32_32x32x16_bf16(PAF(1),VFR(1),o[0],0,0,0), C0,8); \
    KRD(GL,1); GAPB(o[1]=__builtin_amdgcn_mfma_f32_32x32x16_bf16(PAF(1),VFR(5),o[1],0,0,0), C0,12); \
    KRD(GL,2); GAPB(o[0]=__builtin_amdgcn_mfma_f32_32x32x16_bf16(PAF(2),VFR(2),o[0],0,0,0), C1,0); \
    KRD(GL,3); GAPB(o[1]=__builtin_amdgcn_mfma_f32_32x32x16_bf16(PAF(2),VFR(6),o[1],0,0,0), C1,4); \
    if(GL){ kf[8]=*(const __attribute__((address_space(3))) bf16x8*)(kpe+sl_next); kf[9]=*(const __attribute__((address_space(3))) bf16x8*)(kpe+sl_next+512); SBAR(); } \
    GAPB(o[0]=__builtin_amdgcn_mfma_f32_32x32x16_bf16(PAF(3),VFR(3),o[0],0,0,0), C1,8); \
    GAPB(o[1]=__builtin_amdgcn_mfma_f32_32x32x16_bf16(PAF(3),VFR(7),o[1],0,0,0), C1,12); \
    }while(0)
  int t=1;
  #undef CMASK
  #define CMASK(P0,P1,t) do{}while(0)
  for(;t+5<NT;t+=2){
    STEP(pB0,pB1,pA0,pA1,t,true,true,true);     WAIT_BARW(); RESC(); ROT();
    STEP(pA0,pA1,pB0,pB1,t+1,true,true,true);   WAIT_BARW(); RESC(); ROT();
  }
  #undef CMASK
  #define CMASK(P0,P1,t) do{int jb_=(t)-(NT-4); if(jb_>=0)cmask(P0,P1,jb_,qrel,hi);}while(0)
  #define ENDW(tt) do{ if((tt)+3<NT){WAIT_BARW();} else if((tt)+2<NT){WAIT_BAR(1);} else {WAIT_BAR(0);} }while(0)
  for(;t+1<NT;t+=2){
    STEP(pB0,pB1,pA0,pA1,t,(t+3<NT),(t+1<NT),(t+1<NT));       ENDW(t);   RESC(); ROT();
    STEP(pA0,pA1,pB0,pB1,t+1,(t+4<NT),(t+2<NT),(t+2<NT));     ENDW(t+1); RESC(); ROT();
  }
  STEP(pB0,pB1,pA0,pA1,NT-1,false,false,false); RESC();
  { float sacc=pB0[0]+pB0[1]; _Pragma("unroll") for(int r=2;r<16;++r)sacc+=pB0[r]; _Pragma("unroll") for(int r=0;r<16;++r)sacc+=pB1[r]; l_reg+=sacc;
    pw0=(u32x4){PKW(pB0,0),PKW(pB0,2),PKW(pB0,4),PKW(pB0,6)};pw1=(u32x4){PKW(pB0,8),PKW(pB0,10),PKW(pB0,12),PKW(pB0,14)};pw2=(u32x4){PKW(pB1,0),PKW(pB1,2),PKW(pB1,4),PKW(pB1,6)};pw3=(u32x4){PKW(pB1,8),PKW(pB1,10),PKW(pB1,12),PKW(pB1,14)};
    SBAR(); pv(o,vb0+sl_cur,PAF(0),PAF(1),PAF(2),PAF(3)); }
  #undef PKW
  #undef PAF
  #undef VFR
  #undef PIN
  #undef MX3
  #undef GAPA
  #undef GAPB
  #undef EX
  #undef VRD
  #undef KRD
  #undef STEP
  #undef ENDW
  {auto rr=__builtin_amdgcn_permlane32_swap(__float_as_uint(l_reg),__float_as_uint(l_reg),false,false);l_reg=__uint_as_float(rr[0])+__uint_as_float(rr[1]);}
  if(hi==0)wsf[32+r32]=l_reg;asm volatile("s_waitcnt lgkmcnt(0)":::"memory");
  float rli[16];
  #pragma unroll
  for(int r=0;r<16;++r)rli[r]=__builtin_amdgcn_rcpf(wsf[32+crow(r,hi)]);
  bf16*Ow=O+(rowbase+q0+wid*QBLK)*DM+h*D;
  { bf16*stg=(bf16*)(shm+LDS_OST)+wid*2048;
    #pragma unroll
    for(int r=0;r<16;++r){const int orow=crow(r,hi);
      #pragma unroll
      for(int d0=0;d0<2;++d0)stg[orow*64+d0*32+r32]=__float2bfloat16(o[d0][r]*rli[r]);}
    asm volatile("s_waitcnt lgkmcnt(0)":::"memory");
    const bf16*Gw=GT+(rowbase+q0+wid*QBLK)*DM+h*D;
    #pragma unroll
    for(int i=0;i<4;++i){const int row=i*8+(lane>>3),ch=lane&7; u32x4 v=*(const u32x4*)(stg+row*64+ch*8); const u32x4 gg=*(const u32x4*)(Gw+(long)row*DM+ch*8);
      #pragma unroll
      for(int j=0;j<4;++j){ v[j]=cvtpk_s(__uint_as_float(v[j]<<16)*__uint_as_float(gg[j]<<16),__uint_as_float(v[j]&0xffff0000u)*__uint_as_float(gg[j]&0xffff0000u)); }
      ATTN_STORE16(Ow+(long)row*DM+ch*8,v);} }
  asm volatile("s_waitcnt lgkmcnt(0)\n\ts_barrier":::"memory");
  #undef DMA_K
  #undef DMA_V
  #undef CMASK
  #undef START
  #undef RESC
  #undef ROT
}
constexpr int ATTN_LDS_BYTES=LDS_BYTES;
struct AttnTensors { const bf16* Q; const bf16* K; const bf16* V; bf16* O; const bf16* GT; const unsigned char* G3; const float* qgain; float kbound; };
struct AttnUnit { int bh; int qb; };
struct StaticOrder {
  int vcu;
  __device__ __forceinline__ explicit StaticOrder(int grid,int block):vcu((block%8)*(grid/8)+block/8){}
  __device__ __forceinline__ bool next(int i,AttnUnit&u)const{ if(i>=4)return false; const int s=vcu&7; u.bh=vcu>>3; u.qb=(i==0)?s:(i==1)?15-s:(i==2)?16+s:31-s; return true; }
  __device__ __forceinline__ void a_ready(const AttnUnit&)const{}
  __device__ __forceinline__ void done(const AttnUnit&)const{}
};
template<class Sched,int THRL=8> __device__ __forceinline__ void attn_phase(char*lds,const AttnTensors&T,const Sched&S,const int tid_in){
  AttnUnit u;
  for(int i=0;S.next(i,u);++i){ S.a_ready(u); attn_unit<THRL>(u.bh/NHEAD,u.bh%NHEAD,u.qb,T.Q,T.K,T.V,T.O,T.GT,T.G3,T.qgain,T.kbound,lds,tid_in); S.done(u); }
}
#undef SBAR
#undef WAIT_BAR
#undef WAIT_BARW
}
constexpr int NWAVES = 8;
constexpr int BATCH = 2, T = 8192, D = 1024, H = 16, HD = 64, FF = 4096, M = BATCH * T;
constexpr int N1 = 3584, K1 = 2048, NP2 = 3072;
constexpr size_t MiB = 1u << 20;
constexpr size_t WS_MOD = 0;
constexpr size_t WS_W1 = 1 * MiB;
constexpr size_t WS_W2A = 29 * MiB;
constexpr size_t WS_W2G = 32 * MiB;
constexpr size_t WS_WO = 33 * MiB;
constexpr size_t WS_WKV = 37 * MiB;
constexpr size_t WS_WQG = 42 * MiB;
constexpr size_t WS_WO2 = 50 * MiB;
constexpr size_t WS_WUP = 54 * MiB, WS_WDN = 62 * MiB;
constexpr size_t WS_G3 = 70 * MiB;
constexpr size_t WS_FL = 74 * MiB;
constexpr size_t WS_H2 = 76 * MiB;
constexpr size_t WS_P1 = 140 * MiB;
constexpr size_t WS_P2 = 252 * MiB;
constexpr size_t WS_VF = 348 * MiB;
constexpr size_t WS_HB = 140 * MiB;
constexpr size_t WS_KVRAW = 140 * MiB, WS_QB = 204 * MiB, WS_GT = 236 * MiB, WS_VS = 316 * MiB, WS_KS = 348 * MiB;
constexpr size_t WS_END = 380 * MiB;
constexpr int LDS_BYTES = 147456;

#define GAS __attribute__((address_space(1)))
#define LAS __attribute__((address_space(3)))
typedef unsigned short bf16;
typedef unsigned v4u __attribute__((ext_vector_type(4)));
typedef unsigned v2u __attribute__((ext_vector_type(2)));
typedef float f32x4 __attribute__((ext_vector_type(4)));
using pg8::pkbf; using pg8::bflo; using pg8::bfhi; using pg8::sigm;

struct Args { const float* in[39]; float* out; unsigned char* ws; int ph_lo, ph_hi; };

struct Frame { LAS unsigned char* lds; int tid, lane, wave, vcu, G, bx; unsigned char* ws; float* out; const float* const* in; };

__device__ __forceinline__ void tr_item(const float* W, int ldw, int Nvalid, bf16* WT, int ldt, int row_off, int col_off, const float* mu, LAS float* scr, int item, int lane) {
    const int nblk = (Nvalid + 31) / 32, kb = item / nblk, nb = item % nblk, k0 = 64 * kb, n0 = 32 * nb;
    { float t[32]; const int n = n0 + (lane & 31); const bool ok = n < Nvalid; const float* wp = W + (size_t)(k0 + (lane >> 5)) * ldw + n;
#pragma unroll
      for (int i = 0; i < 32; ++i) t[i] = ok ? wp[(size_t)(2 * i) * ldw] : 0.f;
#pragma unroll
      for (int i = 0; i < 32; ++i) scr[(2 * i + (lane >> 5)) * 33 + (lane & 31)] = t[i]; }
    asm volatile("s_waitcnt lgkmcnt(0)" ::: "memory");
    const int c = lane & 7;
    float s0[8], s1[8];
#pragma unroll
    for (int q = 0; q < 8; ++q) { const float m = mu ? mu[k0 + 8 * c + q] : 0.f; s0[q] = 1.f - m; s1[q] = m; }
#pragma unroll
    for (int j = 0; j < 4; ++j) { const int n = (lane >> 3) + 8 * j; const LAS float* s = scr + (8 * c) * 33 + n;
        float v[8];
#pragma unroll
        for (int q = 0; q < 8; ++q) v[q] = s[q * 33];
        v4u o; o.x = pkbf(v[0] * s0[0], v[1] * s0[1]); o.y = pkbf(v[2] * s0[2], v[3] * s0[3]); o.z = pkbf(v[4] * s0[4], v[5] * s0[5]); o.w = pkbf(v[6] * s0[6], v[7] * s0[7]);
        bf16* dst = WT + (size_t)(row_off + n0 + n) * ldt + col_off + k0 + 8 * c;
        *(v4u*)dst = o;
        if (mu) { v4u p; p.x = pkbf(v[0] * s1[0], v[1] * s1[1]); p.y = pkbf(v[2] * s1[2], v[3] * s1[3]); p.z = pkbf(v[4] * s1[4], v[5] * s1[5]); p.w = pkbf(v[6] * s1[6], v[7] * s1[7]); *(v4u*)(dst + 1024) = p; } }
    asm volatile("s_waitcnt lgkmcnt(0)" ::: "memory");
}
__device__ __forceinline__ float dpp_f(float x, const int ctrl_sel) {
    switch (ctrl_sel) {
        case 0: return __builtin_bit_cast(float, __builtin_amdgcn_update_dpp(0, __builtin_bit_cast(int, x), 0xB1, 0xf, 0xf, false));
        case 1: return __builtin_bit_cast(float, __builtin_amdgcn_update_dpp(0, __builtin_bit_cast(int, x), 0x4E, 0xf, 0xf, false));
        case 2: return __builtin_bit_cast(float, __builtin_amdgcn_update_dpp(0, __builtin_bit_cast(int, x), 0x141, 0xf, 0xf, false));
        default: return __builtin_bit_cast(float, __builtin_amdgcn_update_dpp(0, __builtin_bit_cast(int, x), 0x140, 0xf, 0xf, false));
    }
}
__device__ __forceinline__ float sum4(float x) { x += dpp_f(x, 0); x += dpp_f(x, 1); return x; }
__device__ __forceinline__ float sum8(float x) { x = sum4(x); x += dpp_f(x, 2); return x; }
__device__ __forceinline__ float sum16(float x) { x = sum8(x); x += dpp_f(x, 3); return x; }
__device__ __forceinline__ float wave_sum(float v) {
    v = sum16(v);
    { auto rr = __builtin_amdgcn_permlane16_swap(__float_as_uint(v), __float_as_uint(v), false, false); v = __uint_as_float(rr[0]) + __uint_as_float(rr[1]); }
    { auto rr = __builtin_amdgcn_permlane32_swap(__float_as_uint(v), __float_as_uint(v), false, false); v = __uint_as_float(rr[0]) + __uint_as_float(rr[1]); }
    return v;
}
__device__ __forceinline__ void norm_row(const float* xrow, const float* g, const float* sh, const float* sc, int lane, f32x4 (&v)[4]) {
    float s = 0.f;
#pragma unroll
    for (int j = 0; j < 4; ++j) { v[j] = *((const f32x4*)xrow + lane + 64 * j); s += (v[j].x * v[j].x + v[j].y * v[j].y) + (v[j].z * v[j].z + v[j].w * v[j].w); }
    const float rstd = 1.0f / sqrtf(wave_sum(s) * (1.f / D) + 1e-6f);
#pragma unroll
    for (int j = 0; j < 4; ++j) { const f32x4 gg = *((const f32x4*)g + lane + 64 * j);
        f32x4 a = {1.f, 1.f, 1.f, 1.f}, b = {0.f, 0.f, 0.f, 0.f}; if (sc) { a = *((const f32x4*)sc + lane + 64 * j) + 1.0f; b = *((const f32x4*)sh + lane + 64 * j); }
        v[j] = (v[j] * rstd * gg) * a + b; }
}
__device__ __forceinline__ void st_row_bf16(bf16* orow, int lane, const f32x4 (&v)[4]) {
#pragma unroll
    for (int j = 0; j < 4; ++j) { v2u w; w.x = pkbf(v[j].x, v[j].y); w.y = pkbf(v[j].z, v[j].w); *((v2u*)orow + lane + 64 * j) = w; }
}
__device__ __forceinline__ void p0_mod(Frame& F) {
    LAS float* ca = (LAS float*)F.lds; LAS float* red = (LAS float*)(F.lds + 8192);
    const float* cin = F.in[1];
    for (int i = F.tid; i < 2048; i += 512) { const float c = cin[i]; ca[i] = c / (1.0f + __expf(-c)); }
    __syncthreads();
    float* MOD = (float*)(F.ws + WS_MOD); float* MODKV = MOD + 4 * 2 * 6144;
    for (int item = F.bx; item < 208; item += F.G) {
        const int col = item * 128; const float* W; const float* bias; int ldw, cw; float* dst0; float* dst1;
        if (col < 24576) { const int l = col / 6144; cw = col % 6144; W = F.in[2] + (size_t)l * 1024 * 6144; ldw = 6144; bias = F.in[3] + l * 6144; dst0 = MOD + (l * 2 + 0) * 6144 + cw; dst1 = MOD + (l * 2 + 1) * 6144 + cw; }
        else { cw = col - 24576; W = F.in[30]; ldw = 2048; bias = F.in[31]; dst0 = MODKV + cw; dst1 = MODKV + 2048 + cw; }
        const int c4 = F.tid & 31, ks = F.tid >> 5;
        f32x4 a0 = {0.f, 0.f, 0.f, 0.f}, a1 = {0.f, 0.f, 0.f, 0.f};
#pragma unroll 8
        for (int k = ks * 64; k < ks * 64 + 64; ++k) { const f32x4 w = *(const f32x4*)(W + (size_t)k * ldw + cw + c4 * 4); a0 += w * ca[k]; a1 += w * ca[1024 + k]; }
        *(LAS f32x4*)(red + (ks * 32 + c4) * 8) = a0; *(LAS f32x4*)(red + (ks * 32 + c4) * 8 + 4) = a1;
        __syncthreads();
        if (F.tid < 256) { const int b = F.tid >> 7, c = F.tid & 127; float s = 0.f;
#pragma unroll
            for (int q = 0; q < 16; ++q) s += red[(q * 32 + (c >> 2)) * 8 + b * 4 + (c & 3)];
            (b ? dst1 : dst0)[c] = s + bias[cw + c]; }
        __syncthreads();
    }
}
__device__ __forceinline__ void p0_weights(Frame& F) {
    LAS float* scr = (LAS float*)(F.lds + 16384 + F.wave * 16384);
    const int gw = F.vcu * NWAVES + F.wave, NGW = F.G * NWAVES;
    bf16* W1 = (bf16*)(F.ws + WS_W1); bf16* WO = (bf16*)(F.ws + WS_WO); bf16* WKV = (bf16*)(F.ws + WS_WKV); bf16* WQG = (bf16*)(F.ws + WS_WQG); bf16* WO2 = (bf16*)(F.ws + WS_WO2);
    const float* mu = F.in[8];
    constexpr int PL = 512 * 3 + 32 + 32 + 16 + 80 + 512;
    constexpr int NIT = 2 * PL + 512 + 512 + 16 + 2 * (1024 + 512);
    for (int it = gw; it < NIT; it += NGW) {
        int r = it;
        if (r < 2 * PL) { const int i = r / PL; r -= i * PL; bf16* w1 = W1 + (size_t)i * N1 * K1; const float* m6 = mu + i * 6 * 1024;
            bf16* wl = w1 + (size_t)3072 * 1024;
            if (r < 512) { tr_item(F.in[9] + (size_t)i * D * D, D, D, w1, D, 0, 0, nullptr, scr, r, F.lane); continue; } r -= 512;
            if (r < 512) { tr_item(F.in[10] + (size_t)i * D * D, D, D, w1, D, 1024, 0, nullptr, scr, r, F.lane); continue; } r -= 512;
            if (r < 512) { tr_item(F.in[11] + (size_t)i * D * D, D, D, w1, D, 2048, 0, nullptr, scr, r, F.lane); continue; } r -= 512;
            if (r < 32) { tr_item(F.in[14] + (size_t)i * D * 64, 64, 64, wl, K1, 0, 0, m6 + 1 * 1024, scr, r, F.lane); continue; } r -= 32;
            if (r < 32) { tr_item(F.in[17] + (size_t)i * D * 64, 64, 64, wl, K1, 64, 0, m6 + 4 * 1024, scr, r, F.lane); continue; } r -= 32;
            if (r < 16) { if (i == 1) tr_item(F.in[27], 32, 32, wl, K1, 128, 0, m6 + 3 * 1024, scr, r, F.lane); continue; } r -= 16;
            if (r < 80) { tr_item(F.in[19] + (size_t)i * D * 160, 160, 160, wl, K1, 160, 0, m6 + 5 * 1024, scr, r, F.lane); continue; } r -= 80;
            tr_item(F.in[12] + (size_t)i * D * D, D, D, WO + (size_t)i * D * D, D, 0, 0, nullptr, scr, r, F.lane); continue; }
        r -= 2 * PL;
        if (r < 512) { tr_item(F.in[32], 2064, 1024, WKV, D, 0, 0, nullptr, scr, r, F.lane); continue; } r -= 512;
        if (r < 512) { tr_item(F.in[32] + 1024, 2064, 1024, WKV, D, 1024, 0, nullptr, scr, r, F.lane); continue; } r -= 512;
        if (r < 16) { tr_item(F.in[32] + 2048, 2064, 16, WKV, D, 2048, 0, nullptr, scr, r, F.lane); continue; } r -= 16;
        { const int j = r / 1536; r -= j * 1536;
          if (r < 1024) tr_item(F.in[35] + (size_t)j * D * 2048, 2048, 2048, WQG + (size_t)j * 2048 * D, D, 0, 0, nullptr, scr, r, F.lane);
          else tr_item(F.in[37] + (size_t)j * D * D, D, D, WO2 + (size_t)j * D * D, D, 0, 0, nullptr, scr, r - 1024, F.lane); }
    }
    const int gt = F.bx * 512 + F.tid, NT = F.G * 512; const v4u z = {0u, 0u, 0u, 0u};
    for (int e = gt; e < 135168; e += NT) {
        int r = e; bf16* p;
        if (r < 98304) { const int i = r / 49152; r -= i * 49152; p = W1 + (size_t)i * N1 * K1 + (size_t)3072 * 1024 + (size_t)320 * K1 + (size_t)r * 8; }
        else if (r < 98304 + 8192) { r -= 98304; p = W1 + (size_t)3072 * 1024 + (size_t)128 * K1 + (size_t)r * 8; }
        else { r -= 98304 + 8192; p = WKV + (size_t)2080 * D + (size_t)r * 8; }
        *(v4u*)p = z; }
    { float* B2 = (float*)(F.ws + WS_MOD) + 53248;
      for (int e = gt; e < 2 * 3072; e += NT) { const int i = e / 3072, n = e % 3072, grp = n >> 10, c = n & 1023;
          B2[e] = grp == 0 ? F.in[13][i * D + c] : (grp == 1 ? F.in[16][i * D + c] : (i == 1 ? F.in[26][c] : 0.f)); } }
    bf16* W2A = (bf16*)(F.ws + WS_W2A); bf16* W2G = (bf16*)(F.ws + WS_W2G);
    for (int e4 = gt; e4 < 2 * 262144; e4 += NT) {
        const int i = e4 >> 18; int r = (e4 & 262143) * 4;
        if (r < 786432) { const int k = r / 3072, n = r % 3072, grp = n >> 10, c = n & 1023; f32x4 v = {0.f, 0.f, 0.f, 0.f};
            if (grp == 0) { if (k < 64) v = *(const f32x4*)(F.in[15] + ((size_t)i * 64 + k) * 1024 + c); }
            else if (grp == 1) { if (k >= 64 && k < 128) v = *(const f32x4*)(F.in[18] + ((size_t)i * 64 + (k - 64)) * 1024 + c); }
            else { if (i == 1 && k >= 128 && k < 160) v = *(const f32x4*)(F.in[28] + (size_t)(k - 128) * 1024 + c); }
            bf16* o = W2A + (size_t)i * 3072 * 256 + (size_t)n * 256 + k; const unsigned p0 = pkbf(v.x, v.y), p1 = pkbf(v.z, v.w);
            o[0] = (bf16)(p0 & 0xffffu); o[256] = (bf16)(p0 >> 16); o[512] = (bf16)(p1 & 0xffffu); o[768] = (bf16)(p1 >> 16); }
        else { r -= 786432; const int k = r >> 10, n = r & 1023; f32x4 v = {0.f, 0.f, 0.f, 0.f}; if (k < 160) v = *(const f32x4*)(F.in[20] + ((size_t)i * 160 + k) * 1024 + n);
            bf16* o = W2G + (size_t)i * 1024 * 256 + (size_t)n * 256 + k; const unsigned p0 = pkbf(v.x, v.y), p1 = pkbf(v.z, v.w);
            o[0] = (bf16)(p0 & 0xffffu); o[256] = (bf16)(p0 >> 16); o[512] = (bf16)(p1 & 0xffffu); o[768] = (bf16)(p1 >> 16); }
    }
}
__device__ __forceinline__ void mlp_weights(Frame& F, int L) {
    LAS float* scr = (LAS float*)(F.lds + F.wave * 16384);
    const int gw = F.vcu * NWAVES + F.wave, NGW = F.G * NWAVES;
    bf16* WUP = (bf16*)(F.ws + WS_WUP); bf16* WDN = (bf16*)(F.ws + WS_WDN);
    for (int it = gw; it < 4096; it += NGW) {
        if (it < 2048) tr_item(F.in[6] + (size_t)L * D * FF, FF, FF, WUP, D, 0, 0, nullptr, scr, it, F.lane);
        else tr_item(F.in[7] + (size_t)L * FF * D, D, D, WDN, FF, 0, 0, nullptr, scr, it - 2048, F.lane);
    }
}
__device__ __forceinline__ void norm_phase(Frame& F, const float* xin, const float* g, const float* sh, const float* sc, int bstride, int mode, bf16* dst, float* outf = nullptr) {
    const int gw = F.vcu * NWAVES + F.wave, NGW = F.G * NWAVES, lane = F.lane; (void)mode;
    for (int base = gw * 8; base < M; base += NGW * 8) {
        const int b = base >> 13;
        f32x4 gg[4], aa[4], bb[4];
#pragma unroll
        for (int j = 0; j < 4; ++j) { gg[j] = *((const f32x4*)g + lane + 64 * j);
            aa[j] = sc ? *((const f32x4*)(sc + b * bstride) + lane + 64 * j) + 1.0f : (f32x4){1.f, 1.f, 1.f, 1.f}; bb[j] = sh ? *((const f32x4*)(sh + b * bstride) + lane + 64 * j) : (f32x4){0.f, 0.f, 0.f, 0.f}; }
        f32x4 xn[4];
#pragma unroll
        for (int j = 0; j < 4; ++j) xn[j] = *((const f32x4*)(xin + (size_t)base * D) + lane + 64 * j);
#pragma unroll 1
        for (int r = 0; r < 8; ++r) { const int m = base + r; f32x4 v[4]; float s = 0.f;
#pragma unroll
            for (int j = 0; j < 4; ++j) { v[j] = xn[j]; s += (v[j].x * v[j].x + v[j].y * v[j].y) + (v[j].z * v[j].z + v[j].w * v[j].w); }
            if (r + 1 < 8) {
#pragma unroll
                for (int j = 0; j < 4; ++j) xn[j] = *((const f32x4*)(xin + (size_t)(m + 1) * D) + lane + 64 * j); }
            const float rstd = 1.0f / sqrtf(wave_sum(s) * (1.f / D) + 1e-6f);
#pragma unroll
            for (int j = 0; j < 4; ++j) v[j] = (v[j] * rstd * gg[j]) * aa[j] + bb[j];
            if (outf) {
#pragma unroll
                for (int j = 0; j < 4; ++j) *((f32x4*)(outf + (size_t)m * D) + lane + 64 * j) = v[j]; }
            else st_row_bf16(dst + (size_t)m * 1024, lane, v);
        }
    }
}
__device__ __forceinline__ void norm_mix_phase(Frame& F, const float* xin, const float* g, const float* sh, const float* sc, const float* mu, bf16* H2p, bf16* XJ) {
    const int gw = F.vcu * NWAVES + F.wave, NGW = F.G * NWAVES, lane = F.lane;
    for (int base = gw * 8; base < M; base += NGW * 8) {
        const int b = base >> 13;
        f32x4 gg[4], aa[4], bb[4], m0[4], m1[4], m2[4];
#pragma unroll
        for (int j = 0; j < 4; ++j) { gg[j] = *((const f32x4*)g + lane + 64 * j); aa[j] = *((const f32x4*)(sc + b * 6144) + lane + 64 * j) + 1.0f; bb[j] = *((const f32x4*)(sh + b * 6144) + lane + 64 * j);
            m0[j] = *((const f32x4*)mu + lane + 64 * j); m1[j] = *((const f32x4*)(mu + 2048) + lane + 64 * j); m2[j] = *((const f32x4*)(mu + 3072) + lane + 64 * j); }
        const bool first = (base & 8191) == 0; const int r0 = first ? 0 : -1;
        f32x4 hp[4], xn[4];
#pragma unroll
        for (int j = 0; j < 4; ++j) { hp[j] = (f32x4){0.f, 0.f, 0.f, 0.f}; xn[j] = *((const f32x4*)(xin + (size_t)(base + r0) * D) + lane + 64 * j); }
#pragma unroll 1
        for (int r = r0; r < 8; ++r) { const int m = base + r; f32x4 v[4];
            float s = 0.f;
#pragma unroll
            for (int j = 0; j < 4; ++j) { v[j] = xn[j]; s += (v[j].x * v[j].x + v[j].y * v[j].y) + (v[j].z * v[j].z + v[j].w * v[j].w); }
            if (r + 1 < 8) {
#pragma unroll
                for (int j = 0; j < 4; ++j) xn[j] = *((const f32x4*)(xin + (size_t)(m + 1) * D) + lane + 64 * j); }
            const float rstd = 1.0f / sqrtf(wave_sum(s) * (1.f / D) + 1e-6f);
#pragma unroll
            for (int j = 0; j < 4; ++j) v[j] = (v[j] * rstd * gg[j]) * aa[j] + bb[j];
            if (r >= 0) {
                st_row_bf16(H2p + (size_t)m * 2048, lane, v); st_row_bf16(H2p + (size_t)m * 2048 + 1024, lane, hp);
                f32x4 x[4];
#pragma unroll
                for (int j = 0; j < 4; ++j) x[j] = v[j] + (hp[j] - v[j]) * m0[j];
                st_row_bf16(XJ + (size_t)m * D, lane, x);
#pragma unroll
                for (int j = 0; j < 4; ++j) x[j] = v[j] + (hp[j] - v[j]) * m1[j];
                st_row_bf16(XJ + (size_t)M * D + (size_t)m * D, lane, x);
#pragma unroll
                for (int j = 0; j < 4; ++j) x[j] = v[j] + (hp[j] - v[j]) * m2[j];
                st_row_bf16(XJ + (size_t)2 * M * D + (size_t)m * D, lane, x);
            }
#pragma unroll
            for (int j = 0; j < 4; ++j) hp[j] = v[j]; }
    }
}
__device__ __forceinline__ void final_norm_phase(Frame& F) { norm_phase(F, F.out, F.in[38], nullptr, nullptr, 0, 1, nullptr, F.out); }
#ifndef PROBE_SC
#define PROBE_SC 0
#endif
constexpr int SC_C = 32, SC_NC = T / SC_C;
constexpr int SC_VEC = 0, SC_SCAL = 36864, SC_V = 37120, SC_Y = 38144, SC_BUF = 54528;
typedef float f32x2s __attribute__((ext_vector_type(2)));
__device__ __forceinline__ float dot4(const f32x4 s, const f32x4 a) { f32x2s t = (f32x2s){s.x, s.y} * (f32x2s){a.x, a.y}; t = (f32x2s){s.z, s.w} * (f32x2s){a.z, a.w} + t; return t.x + t.y; }
__device__ __forceinline__ void scan_chunk(const LAS unsigned char* Bc, f32x4& S, const int kq, const int rowi) {
                const LAS f32x4* pvec = (const LAS f32x4*)(Bc + SC_VEC) + kq; const LAS f32x4* psc = (const LAS f32x4*)(Bc + SC_SCAL);
                const LAS float* pv = (const LAS float*)(Bc + SC_V) + rowi; LAS float* py = (LAS float*)(Bc + SC_Y) + rowi * 16 + kq;
                f32x4 cv[9], cs; float c0, c1;
#pragma unroll
                for (int j = 0; j < 9; ++j) cv[j] = pvec[j * 16];
                cs = psc[0]; c0 = pv[0]; c1 = pv[8];
#pragma unroll
                for (int p = 0; p < SC_C / 2; ++p) {
                    f32x4 nv[9], ns; float n0, n1;
                    if (p + 1 < SC_C / 2) {
#pragma unroll
                        for (int j = 0; j < 9; ++j) nv[j] = pvec[((p + 1) * 9 + j) * 16];
                        ns = psc[p + 1]; n0 = pv[(2 * p + 2) * 8]; n1 = pv[(2 * p + 3) * 8];
                    }
                    __builtin_amdgcn_sched_barrier(0);
                    float p1 = dot4(S, cv[0]), p2 = dot4(S, cv[1]); const float p3 = dot4(S, cv[2]);
                    p1 += dpp_f(p1, 0); p2 += dpp_f(p2, 0);
                    p1 += dpp_f(p1, 1); p2 += dpp_f(p2, 1);
                    p1 += dpp_f(p1, 2); p2 += dpp_f(p2, 2);
                    p1 += dpp_f(p1, 3); p2 += dpp_f(p2, 3);
                    const float sa1 = fmaf(c0, cs.w, p2);
                    const float y0 = p3 + ((kq == 0) ? c0 * cs.y : 0.f);
                    const f32x4 t0 = S * cv[3] + cv[4] * p1 + cv[5] * c0 + cv[7] * c1;
                    S = t0 + cv[6] * sa1;
                    const float y1 = dot4(S, cv[8]);
                    py[(2 * p) * 128] = y0; py[(2 * p + 1) * 128] = y1;
                    if (p + 1 < SC_C / 2) {
#pragma unroll
                        for (int j = 0; j < 9; ++j) cv[j] = nv[j];
                        cs = ns; c0 = n0; c1 = n1;
                    }
                }
}
__device__ __forceinline__ void scan_phase(Frame& F, int L) {
    const bf16* P1 = (const bf16*)(F.ws + WS_P1); const bf16* P2 = (const bf16*)(F.ws + WS_P2); const bf16* VF = (const bf16*)(F.ws + WS_VF); float* Y = (float*)(F.ws + WS_H2);
    const float* kkw = F.in[21] + L * D; const float* kaw = F.in[22] + L * D;
    const int lane = F.lane;
    int wave;
    { LAS unsigned* tb = (LAS unsigned*)(F.lds + LDS_BYTES - 2048);
      const unsigned simd = ((unsigned)__builtin_amdgcn_s_getreg((1 << 11) | (4 << 6) | 4)) & 3u;
      if (lane == 0) tb[F.wave] = simd;
      __syncthreads();
      unsigned sd[8];
#pragma unroll
      for (int w = 0; w < 8; ++w) sd[w] = tb[w];
      int B = 1;
#pragma unroll
      for (int w = 7; w >= 1; --w) if (sd[w] != sd[0]) B = w;
      int total_non = 0, non_before = 0, share_before = 0; bool my_share = false;
#pragma unroll
      for (int w = 1; w < 8; ++w) { const bool sh = (sd[w] == sd[0]) || (sd[w] == sd[B]); const bool other = (w != B);
          if (other && !sh) { ++total_non; if (w < F.wave) ++non_before; }
          if (other && sh && w < F.wave) ++share_before;
          if (w == F.wave) my_share = sh; }
      int role;
      if (F.wave == 0) role = 0; else if (F.wave == B) role = 1; else role = my_share ? (2 + total_non + share_before) : (2 + non_before);
      wave = __builtin_amdgcn_readfirstlane(role);
      __syncthreads(); }
    for (int item = F.bx; item < 256; item += F.G) {
        const int bh = (item & 7) + 8 * (item >> 6), rg = (item >> 3) & 7, b = bh >> 4, h = bh & 15;
        const size_t m0 = (size_t)b * T;
        const int hidx = (wave - 2) * 64 + lane, hp = (hidx >> 4) & 15, hc4 = hidx & 15;
        const int vtt = lane >> 1, vr4 = (lane & 1) * 4;
        float ckk[4], cka[4];
        v2u lr[2][2], lk[2][2], lw[2][2], la[2][2]; v2u lv[2], lvm[2], lvf[2];
#pragma unroll
        for (int q = 0; q < 2; ++q) { lv[q] = (v2u){0u,0u}; lvm[q] = (v2u){0u,0u}; lvf[q] = (v2u){0u,0u};
#pragma unroll
            for (int u = 0; u < 2; ++u) { lr[q][u] = (v2u){0u,0u}; lk[q][u] = (v2u){0u,0u}; lw[q][u] = (v2u){0u,0u}; la[q][u] = (v2u){0u,0u}; } }
        if (wave >= 2 && wave < 6) {
#pragma unroll
            for (int j = 0; j < 4; ++j) { ckk[j] = kkw[h * 64 + hc4 * 4 + j]; cka[j] = kaw[h * 64 + hc4 * 4 + j]; } }
#define SC_LOAD(c, Q) do { \
        if (wave >= 2 && wave < 6) { _Pragma("unroll") for (int u = 0; u < 2; ++u) { const size_t m = m0 + (size_t)(c) * SC_C + 2 * hp + u; const bf16* p1 = P1 + m * N1 + h * 64 + hc4 * 4; const bf16* p2 = P2 + m * NP2 + h * 64 + hc4 * 4; \
            lr[Q][u] = *(const v2u*)p1; lk[Q][u] = *(const v2u*)(p1 + 1024); lw[Q][u] = *(const v2u*)p2; la[Q][u] = *(const v2u*)(p2 + 1024); } } \
        else if (wave == 6) { const size_t m = m0 + (size_t)(c) * SC_C + vtt; const int cc = h * 64 + rg * 8 + vr4; \
            lv[Q] = *(const v2u*)(P1 + m * N1 + 2048 + cc); if (L == 1) { lvm[Q] = *(const v2u*)(P2 + m * NP2 + 2048 + cc); lvf[Q] = *(const v2u*)(VF + m * D + cc); } } } while (0)
#define SC_PREP(buf, Q) do { LAS unsigned char* B_ = F.lds + (buf) * SC_BUF; \
        if (wave >= 2 && wave < 6) { f32x4 an[2], bb[2], k2[2], ww[2], rr[2]; \
            _Pragma("unroll") for (int u = 0; u < 2; ++u) { \
                const float kr[4] = {bflo(lk[Q][u].x), bfhi(lk[Q][u].x), bflo(lk[Q][u].y), bfhi(lk[Q][u].y)}, av[4] = {bflo(la[Q][u].x), bfhi(la[Q][u].x), bflo(la[Q][u].y), bfhi(la[Q][u].y)}; \
                const float wn[4] = {bflo(lw[Q][u].x), bfhi(lw[Q][u].x), bflo(lw[Q][u].y), bfhi(lw[Q][u].y)}, rv[4] = {bflo(lr[Q][u].x), bfhi(lr[Q][u].x), bflo(lr[Q][u].y), bfhi(lr[Q][u].y)}; \
                float kv_[4], ss = 0.f; \
                _Pragma("unroll") for (int j = 0; j < 4; ++j) { kv_[j] = kr[j] * ckk[j]; ss += kv_[j] * kv_[j]; } \
                ss = sum16(ss); const float inv = 1.0f / fmaxf(sqrtf(ss), 1e-12f); \
                _Pragma("unroll") for (int j = 0; j < 4; ++j) { const float kk = kv_[j] * inv; an[u][j] = -kk; bb[u][j] = kk * av[j]; k2[u][j] = kr[j] * (1.0f + (av[j] - 1.0f) * cka[j]); ww[u][j] = __expf(wn[j]); rr[u][j] = rv[j]; } } \
            LAS f32x4* V_ = (LAS f32x4*)(B_ + SC_VEC) + (hp * 9) * 16 + hc4; \
            float s0 = dot4(bb[0], rr[0]), s1 = dot4(k2[0], rr[0]), s2 = dot4(bb[0], an[1]), s3 = dot4(k2[0], an[1]); \
            s0 = sum16(s0); s1 = sum16(s1); s2 = sum16(s2); s3 = sum16(s3); \
            V_[0 * 16] = an[0]; V_[1 * 16] = ww[0] * an[1] + an[0] * s2; V_[2 * 16] = ww[0] * rr[0] + an[0] * s0; V_[3 * 16] = ww[0] * ww[1]; V_[4 * 16] = bb[0] * ww[1]; V_[5 * 16] = k2[0] * ww[1]; V_[6 * 16] = bb[1]; V_[7 * 16] = k2[1]; V_[8 * 16] = rr[1]; \
            if (hc4 == 0) *(LAS f32x4*)(B_ + SC_SCAL + hp * 16) = (f32x4){s0, s1, s2, s3}; } \
        else if (wave == 6) { float v_[4] = {bflo(lv[Q].x), bfhi(lv[Q].x), bflo(lv[Q].y), bfhi(lv[Q].y)}; \
            if (L == 1) { const float f_[4] = {bflo(lvf[Q].x), bfhi(lvf[Q].x), bflo(lvf[Q].y), bfhi(lvf[Q].y)}, g_[4] = {bflo(lvm[Q].x), bfhi(lvm[Q].x), bflo(lvm[Q].y), bfhi(lvm[Q].y)}; \
                _Pragma("unroll") for (int j = 0; j < 4; ++j) v_[j] = v_[j] + (f_[j] - v_[j]) * g_[j]; } \
            *(LAS f32x4*)(B_ + SC_V + (vtt * 8 + vr4) * 4) = (f32x4){v_[0], v_[1], v_[2], v_[3]}; } } while (0)
#define SC_YRED(bufi) f32x4 yv; do { const LAS f32x4* q_ = (const LAS f32x4*)(F.lds + (bufi) * SC_BUF + SC_Y) + (vtt * 8 + vr4) * 4; \
            _Pragma("unroll") for (int r_ = 0; r_ < 4; ++r_) { const f32x4 t0 = q_[r_ * 4], t1 = q_[r_ * 4 + 1], t2 = q_[r_ * 4 + 2], t3 = q_[r_ * 4 + 3]; const f32x4 t = (t0 + t1) + (t2 + t3); yv[r_] = (t.x + t.y) + (t.z + t.w); } } while (0)
        SC_LOAD(0, 0); SC_PREP(0, 0); SC_LOAD(1, 1);
        __syncthreads();
        f32x4 S = {0.f, 0.f, 0.f, 0.f};
        const int rl = lane >> 4, kq = lane & 15, rowi = (wave & 1) * 4 + rl;
#define SC_ITER(c, QL, QP) do { const int buf = (c) & 1; \
            if (wave < 2) { if (PROBE_SC == 2) { f32x4 S2 = S; scan_chunk(F.lds + buf * SC_BUF, S2, kq, rowi); asm volatile("" :: "v"(S2) : "memory"); } scan_chunk(F.lds + buf * SC_BUF, S, kq, rowi); } \
            else { if ((c) + 2 < SC_NC) SC_LOAD((c) + 2, QL); \
                if ((c) + 1 < SC_NC) SC_PREP(buf ^ 1, QP); \
                if (PROBE_SC == 1 && (c) + 1 < SC_NC) { asm volatile("" ::: "memory"); SC_PREP(buf ^ 1, QP); } \
                if (wave == 7 && (c) > 0) { SC_YRED(buf ^ 1); *(f32x4*)(Y + (m0 + (size_t)((c) - 1) * SC_C + vtt) * D + h * 64 + rg * 8 + vr4) = yv; } } \
            asm volatile("s_waitcnt lgkmcnt(0)\n\ts_barrier" ::: "memory"); } while (0)
        for (int c = 0; c < SC_NC; c += 2) { SC_ITER(c, 0, 1); SC_ITER(c + 1, 1, 0); }
#undef SC_ITER
        if (wave == 7) { SC_YRED((SC_NC - 1) & 1);
            *(f32x4*)(Y + (m0 + (size_t)(SC_NC - 1) * SC_C + vtt) * D + h * 64 + rg * 8 + vr4) = yv; }
        __syncthreads();
#undef SC_LOAD
#undef SC_PREP
#undef SC_YRED
    }
}
__device__ __forceinline__ void post_phase(Frame& F, int L) {
    const bf16* P1 = (const bf16*)(F.ws + WS_P1); const bf16* P2 = (const bf16*)(F.ws + WS_P2); bf16* VF = (bf16*)(F.ws + WS_VF); float* Y = (float*)(F.ws + WS_H2);
    const int gw = F.vcu * NWAVES + F.wave, NGW = F.G * NWAVES, lane = F.lane, c0 = lane * 16;
    const float* kaw = F.in[22] + L * D + c0; const float* rkw = F.in[23] + L * D + c0; const float* lnw = F.in[24] + L * D + c0; const float* lnb = F.in[25] + L * D + c0;
    for (int m = gw; m < M; m += NGW) {
        float y[16], r[16], k[16], v[16], a[16];
        const float* yp = Y + (size_t)m * D + c0;
#pragma unroll
        for (int q = 0; q < 4; ++q) { const f32x4 t = *(const f32x4*)(yp + 4 * q); y[4 * q] = t.x; y[4 * q + 1] = t.y; y[4 * q + 2] = t.z; y[4 * q + 3] = t.w; }
        const bf16* p1 = P1 + (size_t)m * N1 + c0; const bf16* p2 = P2 + (size_t)m * NP2 + c0;
        v4u rv[2], kv[2], vv[2], av[2];
#pragma unroll
        for (int q = 0; q < 2; ++q) { rv[q] = *(const v4u*)(p1 + 8 * q); kv[q] = *(const v4u*)(p1 + 1024 + 8 * q); vv[q] = *(const v4u*)(p1 + 2048 + 8 * q); av[q] = *(const v4u*)(p2 + 1024 + 8 * q); }
#pragma unroll
        for (int q = 0; q < 2; ++q)
#pragma unroll
            for (int j = 0; j < 4; ++j) { r[8 * q + 2 * j] = bflo(rv[q][j]); r[8 * q + 2 * j + 1] = bfhi(rv[q][j]); k[8 * q + 2 * j] = bflo(kv[q][j]); k[8 * q + 2 * j + 1] = bfhi(kv[q][j]);
                v[8 * q + 2 * j] = bflo(vv[q][j]); v[8 * q + 2 * j + 1] = bfhi(vv[q][j]); a[8 * q + 2 * j] = bflo(av[q][j]); a[8 * q + 2 * j + 1] = bfhi(av[q][j]); }
        if (L == 0) { *(v4u*)(VF + (size_t)m * D + c0) = vv[0]; *(v4u*)(VF + (size_t)m * D + c0 + 8) = vv[1]; }
        else { v4u fv[2], gv[2];
#pragma unroll
            for (int q = 0; q < 2; ++q) { fv[q] = *(const v4u*)(VF + (size_t)m * D + c0 + 8 * q); gv[q] = *(const v4u*)(p2 + 2048 + 8 * q); }
#pragma unroll
            for (int q = 0; q < 2; ++q)
#pragma unroll
                for (int j = 0; j < 4; ++j) { const float f0 = bflo(fv[q][j]), f1 = bfhi(fv[q][j]), g0 = bflo(gv[q][j]), g1 = bfhi(gv[q][j]);
                    v[8 * q + 2 * j] += (f0 - v[8 * q + 2 * j]) * g0; v[8 * q + 2 * j + 1] += (f1 - v[8 * q + 2 * j + 1]) * g1; } }
        float s = 0.f, bd = 0.f;
#pragma unroll
        for (int j = 0; j < 16; ++j) { s += y[j]; const float k2 = k[j] * (1.0f + (a[j] - 1.0f) * kaw[j]); bd += r[j] * k2 * rkw[j]; }
        s = sum4(s); bd = sum4(bd);
        const float mean = s * (1.0f / 64.0f); float q2 = 0.f;
#pragma unroll
        for (int j = 0; j < 16; ++j) { const float d = y[j] - mean; q2 += d * d; }
        q2 = sum4(q2);
        const float rstd = 1.0f / sqrtf(q2 * (1.0f / 64.0f) + 64e-5f);
        float o[16];
#pragma unroll
        for (int j = 0; j < 16; ++j) o[j] = (y[j] - mean) * rstd * lnw[j] + lnb[j] + bd * v[j];
        bf16* yn = (bf16*)(Y + (size_t)m * D) + c0;
        v4u w0, w1; w0.x = pkbf(o[0], o[1]); w0.y = pkbf(o[2], o[3]); w0.z = pkbf(o[4], o[5]); w0.w = pkbf(o[6], o[7]); w1.x = pkbf(o[8], o[9]); w1.y = pkbf(o[10], o[11]); w1.z = pkbf(o[12], o[13]); w1.w = pkbf(o[14], o[15]);
        *(v4u*)yn = w0; *(v4u*)(yn + 8) = w1;
    }
}
__device__ __forceinline__ void kvpost_phase(Frame& F) {
    const bf16* KV = (const bf16*)(F.ws + WS_KVRAW); bf16* KS = (bf16*)(F.ws + WS_KS); bf16* VS = (bf16*)(F.ws + WS_VS);
    const int gw = F.vcu * NWAVES + F.wave, NGW = F.G * NWAVES, lane = F.lane, c0 = lane * 16;
    const float* kg = F.in[34] + (c0 & 63);
    for (int m = gw; m < M; m += NGW) {
        const bf16* p = KV + (size_t)m * 2048 + c0; v4u kv[2], vv[2];
#pragma unroll
        for (int q = 0; q < 2; ++q) { kv[q] = *(const v4u*)(p + 8 * q); vv[q] = *(const v4u*)(p + 1024 + 8 * q); }
        float k[16], ss = 0.f;
#pragma unroll
        for (int q = 0; q < 2; ++q)
#pragma unroll
            for (int j = 0; j < 4; ++j) { k[8 * q + 2 * j] = bflo(kv[q][j]); k[8 * q + 2 * j + 1] = bfhi(kv[q][j]); }
#pragma unroll
        for (int j = 0; j < 16; ++j) ss += k[j] * k[j];
        ss = sum4(ss); const float rs = 1.0f / sqrtf(ss * (1.0f / 64.0f) + 1e-6f);
        v4u w0, w1;
        w0.x = pkbf(k[0] * rs * kg[0], k[1] * rs * kg[1]); w0.y = pkbf(k[2] * rs * kg[2], k[3] * rs * kg[3]); w0.z = pkbf(k[4] * rs * kg[4], k[5] * rs * kg[5]); w0.w = pkbf(k[6] * rs * kg[6], k[7] * rs * kg[7]);
        w1.x = pkbf(k[8] * rs * kg[8], k[9] * rs * kg[9]); w1.y = pkbf(k[10] * rs * kg[10], k[11] * rs * kg[11]); w1.z = pkbf(k[12] * rs * kg[12], k[13] * rs * kg[13]); w1.w = pkbf(k[14] * rs * kg[14], k[15] * rs * kg[15]);
        *(v4u*)(KS + (size_t)m * D + c0) = w0; *(v4u*)(KS + (size_t)m * D + c0 + 8) = w1;
        *(v4u*)(VS + (size_t)m * D + c0) = vv[0]; *(v4u*)(VS + (size_t)m * D + c0 + 8) = vv[1];
    }
    if (gw < 32) {
        const int bh = gw, b = bh >> 4, h = bh & 15; const float* FL = (const float*)(F.ws + WS_FL) + ((size_t)b * T + (size_t)lane * 128) * 16 + h; const float fb = F.in[33][h];
        v4u* G3 = (v4u*)(F.ws + WS_G3) + (size_t)bh * T + (size_t)lane * 128;
        float tot = 0.f;
#pragma unroll 8
        for (int i = 0; i < 128; ++i) { const float x = FL[(size_t)i * 16] + fb; tot += -(fmaxf(-x, 0.f) + log1pf(__expf(-fabsf(x)))); }
        float inc = tot;
#pragma unroll
        for (int o = 1; o < 64; o <<= 1) { const float n = __int_as_float(__builtin_amdgcn_ds_bpermute((lane - o) << 2, __float_as_int(inc))); if (lane >= o) inc += n; }
        float run = inc - tot;
#pragma unroll 8
        for (int i = 0; i < 128; ++i) { const float x = FL[(size_t)i * 16] + fb; run += -(fmaxf(-x, 0.f) + log1pf(__expf(-fabsf(x))));
            const float gv = -run * 1.4426950408889634f;
            const unsigned hi = pkbf(gv, 0.f) & 0xffffu; const float r1 = gv - __uint_as_float(hi << 16);
            const unsigned mid = pkbf(r1, 0.f) & 0xffffu; const float r2 = r1 - __uint_as_float(mid << 16);
            const unsigned lo = pkbf(r2, 0.f) & 0xffffu;
            G3[i] = (v4u){hi | (mid << 16), lo, 0u, 0u}; }
    }
}
constexpr size_t WS_BAR = 512 * 1024, BAR_BYTES = 16384; constexpr int MISC_OFF = LDS_BYTES - 1024;
#define RLX_AGENT __ATOMIC_RELAXED, __HIP_MEMORY_SCOPE_AGENT
#define LDS_WAIT() asm volatile("s_waitcnt lgkmcnt(0)" ::: "memory")
#define VM_WAIT() asm volatile("s_waitcnt vmcnt(0)" ::: "memory")
__device__ __forceinline__ unsigned long long rt() { return __builtin_amdgcn_s_memrealtime(); }
__device__ __forceinline__ unsigned f2bf(float f) { unsigned u = __builtin_bit_cast(unsigned, f); return (u + 0x7fffu + ((u >> 16) & 1u)) >> 16; }
__device__ __forceinline__ unsigned pk2(float lo, float hi) { return f2bf(lo) | (f2bf(hi) << 16); }

#define XB_TMO      128
#define XB_XCNT(j)  (256  + 64 * (j))
#define XB_XSUB(j)  (1280 + 64 * (j))
#define XB_XGEN(j)  (2304 + 64 * (j))
#define XB_TOP      3328
#define XB_TOPGEN   3392
#define XCD_BAR_WORDS 3456
#define XB_SPIN_CAP (1u << 18)

__device__ __forceinline__ unsigned xb_ld(unsigned* p)              { return __hip_atomic_load(p, __ATOMIC_RELAXED, __HIP_MEMORY_SCOPE_AGENT); }
__device__ __forceinline__ unsigned xb_add(unsigned* p, unsigned v) { return __hip_atomic_fetch_add(p, v, __ATOMIC_RELAXED, __HIP_MEMORY_SCOPE_AGENT); }
__device__ __forceinline__ unsigned xb_xcc_id() { return (unsigned)__builtin_amdgcn_s_getreg((3 << 11) | 20) & 0xFu; }
#define XB_SPIN(cond, bar) do { unsigned _sp = 0; while (cond) { __builtin_amdgcn_s_sleep(1); \
    if ((++_sp & 255u) == 0u) { if (xb_ld(&(bar)[XB_TMO])) break; if (_sp > XB_SPIN_CAP) { atomicAdd(&(bar)[XB_TMO], 1u); break; } } } } while (0)

struct XcdBarrier {
    unsigned* bar; unsigned x;
    volatile LAS unsigned* st;
};

__device__ __forceinline__ XcdBarrier xcd_barrier_post(unsigned* bar, volatile LAS unsigned* st, const int tid) {
    XcdBarrier b; b.bar = bar; b.x = xb_xcc_id(); b.st = st;
    if (tid == 0) (void)xb_add(&bar[XB_XCNT(b.x)], 1u);
    return b;
}
__device__ __forceinline__ void xcd_barrier_complete(unsigned* bar, unsigned x, unsigned& nloc, unsigned& nx) {
    const unsigned G = gridDim.x * gridDim.y * gridDim.z;
    unsigned sum, cnt, mine, sp = 0u;
    for (;;) {
        sum = 0u; cnt = 0u; mine = 0u;
#pragma unroll
        for (unsigned j = 0; j < 16; ++j) { const unsigned c = xb_ld(&bar[XB_XCNT(j)]); sum += c; cnt += (c > 0u) ? 1u : 0u; mine = (j == x) ? c : mine; }
        if (sum == G) break;
        __builtin_amdgcn_s_sleep(1);
        if ((++sp & 255u) == 0u) { if (xb_ld(&bar[XB_TMO])) break; if (sp > XB_SPIN_CAP) { atomicAdd(&bar[XB_TMO], 1u); break; } }
    }
    nloc = mine > 0u ? mine : 1u; nx = cnt > 0u ? cnt : 1u;
}

__device__ __forceinline__ void xcd_barrier(const XcdBarrier& b, const int tid) {
    asm volatile("s_waitcnt vmcnt(0)" ::: "memory");
    __syncthreads();
    if (tid == 0) {
        unsigned* bar = b.bar;
        __builtin_amdgcn_s_waitcnt(0);
        unsigned nloc = b.st[0], nx = b.st[1];
        if (nloc == 0u) { xcd_barrier_complete(bar, b.x, nloc, nx); b.st[0] = nloc; b.st[1] = nx; }
        const unsigned old = xb_add(&bar[XB_XSUB(b.x)], 1u);
        const unsigned gen = old / nloc;
        if (old + 1u == (gen + 1u) * nloc) {
            __builtin_amdgcn_fence(__ATOMIC_RELEASE, "agent");
            asm volatile("s_waitcnt vmcnt(0)" ::: "memory");
            const unsigned og = xb_add(&bar[XB_TOP], 1u);
            const unsigned tg = og / nx;
            if (og + 1u == (tg + 1u) * nx) xb_add(&bar[XB_TOPGEN], 1u);
            else XB_SPIN(xb_ld(&bar[XB_TOPGEN]) == tg, bar);
            __builtin_amdgcn_fence(__ATOMIC_ACQUIRE, "agent");
            xb_add(&bar[XB_XGEN(b.x)], 1u);
            asm volatile("s_waitcnt vmcnt(0)" ::: "memory");
        } else {
            XB_SPIN(xb_ld(&bar[XB_XGEN(b.x)]) == gen, bar);
            __builtin_amdgcn_fence(__ATOMIC_ACQUIRE, "agent");
            asm volatile("s_waitcnt vmcnt(0)" ::: "memory");
        }
    }
    __syncthreads();
}
#define GEMM_CALL(FN, Aptr, Bptr, Nn, Kk, LDA, LDB, ...) GEMM_CALL_G(FN, Aptr, Bptr, Nn, Kk, LDA, LDB, 0, 0, __VA_ARGS__)
#define GEMM_CALL_G(FN, Aptr, Bptr, Nn, Kk, LDA, LDB, AGRP, ASTEP, ...) GEMM_CALL_S(StaticOrder, FN, Aptr, Bptr, Nn, Kk, LDA, LDB, AGRP, ASTEP, __VA_ARGS__)
#define GEMM_CALL_S(ORD, FN, Aptr, Bptr, Nn, Kk, LDA, LDB, AGRP, ASTEP, ...) do { pg8::Gemm g_{(const pg8::bf16_t*)(Aptr), (const pg8::bf16_t*)(Bptr), M, (Nn), (Kk), (LDA), (LDB), (AGRP), (size_t)(ASTEP)}; pg8::ORD S_; S_.init(M, (Nn), F.G, F.bx); \
    pg8::Epi8<pg8::FN> E_{{__VA_ARGS__}}; pg8::gemm_phase<pg8::Epi8<pg8::FN>, pg8::ORD, true, true>(F.lds, g_, S_, E_, F.tid); } while (0)
constexpr int N_PHASES = 42;
__global__ void __launch_bounds__(NWAVES * 64, 2) yoco_fwd(Args args) {
    extern __shared__ __attribute__((aligned(16))) unsigned char lds[];
    cg::grid_group grid = cg::this_grid();
    Frame F;
    const int wave_s = __builtin_amdgcn_readfirstlane((int)threadIdx.x >> 6);
    F.lds = (LAS unsigned char*)lds; F.tid = threadIdx.x; F.lane = F.tid & 63; F.wave = wave_s;
    F.G = gridDim.x; F.bx = blockIdx.x; F.vcu = F.bx;
    F.ws = args.ws; F.out = args.out; F.in = args.in;
    unsigned char* ws = args.ws;
    const int lo = args.ph_lo, hi = args.ph_hi; const bool one = (hi - lo) > 1;
#define LAUNDER() do { int t_ = wave_s * 64 + (int)__builtin_amdgcn_mbcnt_hi(~0u, __builtin_amdgcn_mbcnt_lo(~0u, 0u)); asm volatile("" : "+v"(t_)); F.tid = t_; F.lane = t_ & 63; F.wave = __builtin_amdgcn_readfirstlane(t_ >> 6); \
        int z_ = 0; asm volatile("" : "+v"(z_)); z_ = __builtin_amdgcn_readfirstlane(z_); ws = args.ws + z_; F.ws = ws; F.in = args.in + z_; F.out = args.out + z_; F.bx = (int)blockIdx.x + z_; F.G = (int)gridDim.x + z_; F.vcu = (F.G % 8 == 0) ? (F.bx % 8) * (F.G / 8) + F.bx / 8 : F.bx; } while (0)
#define IN(k) (lo <= (k) && (k) < hi)
#ifndef PROBE_BAR
#define PROBE_BAR 0
#endif
#ifndef PROBE_PH
#define PROBE_PH (-1)
#endif
#define PHASE(k) if (IN(k)) for (int rep_ = 0; rep_ < (((k) == PROBE_PH) ? 2 : 1); ++rep_)
#define SEAM() do { if (one) { unsigned zz_ = 0u; asm volatile("" : "+v"(zz_)); const int st_ = wave_s * 64 + (int)__builtin_amdgcn_mbcnt_hi(~0u, __builtin_amdgcn_mbcnt_lo(~0u, zz_)); xcd_barrier(xbar, st_); if (PROBE_BAR) xcd_barrier(xbar, st_); } } while (0)
#define MOD_ ((float*)(ws + WS_MOD))
#define MODKV_ (MOD_ + 4 * 2 * 6144)
#define H2_ ((bf16*)(ws + WS_H2))
#define XN_ ((bf16*)(ws + WS_H2))
#define XNKV_ ((bf16*)(ws + WS_H2 + 32 * MiB))
#define P1_ ((bf16*)(ws + WS_P1))
#define P2_ ((bf16*)(ws + WS_P2))
#define HB_ ((bf16*)(ws + WS_HB))
#define QB_ ((bf16*)(ws + WS_QB))
#define GT_ ((bf16*)(ws + WS_GT))
#define XIN1_ ((L == 0) ? F.in[0] : (const float*)F.out)
#define MODL_ (MOD_ + L * 2 * 6144)

    volatile LAS unsigned* MISC = (volatile LAS unsigned*)(F.lds + MISC_OFF);
    if (F.tid < 32) MISC[F.tid] = 0u;
    __syncthreads();
    XcdBarrier xbar; xbar.bar = (unsigned*)(args.ws + WS_BAR); xbar.x = 0; xbar.st = MISC + 8;
    if (one) xbar = xcd_barrier_post((unsigned*)(args.ws + WS_BAR), MISC + 8, F.tid);
    PHASE(0) { LAUNDER(); p0_mod(F); p0_weights(F); if (one) grid.sync(); }
    { constexpr int L = 0;
        const int pb = 1 + L * 10;
        if (L < 2) {
            PHASE(pb + 0) { LAUNDER(); norm_mix_phase(F, XIN1_, F.in[4] + L * D, MODL_, MODL_ + 1024, F.in[8] + L * 6 * 1024, H2_, P2_); SEAM(); }
            PHASE(pb + 1) { LAUNDER(); GEMM_CALL(FnP1, H2_, ws + WS_W1 + (size_t)L * N1 * K1 * 2 + (size_t)3072 * 1024 * 2, 512, K1, K1, K1, P1_, 3072);
                LAUNDER();
                if (F.G == 256) GEMM_CALL_S(SplitOrder, FnP1, P2_, ws + WS_W1 + (size_t)L * N1 * K1 * 2, 3072, D, D, D, 4, (size_t)M * D * 2, P1_, 0);
                else GEMM_CALL_G(FnP1, P2_, ws + WS_W1 + (size_t)L * N1 * K1 * 2, 3072, D, D, D, 4, (size_t)M * D * 2, P1_, 0);
                SEAM(); }
            PHASE(pb + 2) { LAUNDER(); GEMM_CALL(FnP2, P1_ + 3072, ws + WS_W2A + (size_t)L * 3072 * 256 * 2, (L == 0 ? 2048 : NP2), 256, N1, 256, P2_, MOD_ + 53248 + L * 3072); SEAM(); }
            PHASE(pb + 3) { LAUNDER(); scan_phase(F, L); SEAM(); }
            PHASE(pb + 4) { LAUNDER(); post_phase(F, L); SEAM(); }
            PHASE(pb + 5) { LAUNDER(); GEMM_CALL(FnGate, P1_ + 3232, ws + WS_W2G + (size_t)L * 1024 * 256 * 2, D, 256, N1, 256, H2_, 2048); SEAM(); }
            PHASE(pb + 6) { LAUNDER(); GEMM_CALL(FnRes, H2_, ws + WS_WO + (size_t)L * D * D * 2, D, D, 2048, D, XIN1_, F.out, MODL_ + 2 * 1024); SEAM(); }
        } else {
            const int j = L - 2;
            PHASE(pb + 0) { LAUNDER(); norm_phase(F, F.out, F.in[4] + L * D, MODL_, MODL_ + 1024, 6144, 1, XN_);
                if (L == 2) norm_phase(F, F.out, F.in[29], MODKV_, MODKV_ + 1024, 2048, 1, XNKV_);
                SEAM(); }
            PHASE(pb + 1) { LAUNDER();
                if (L == 2) GEMM_CALL(FnKv, XNKV_, ws + WS_WKV, 2304, D, D, D, (bf16*)(ws + WS_KVRAW), (float*)(ws + WS_FL));
                LAUNDER();
                GEMM_CALL(FnQg, XN_, ws + WS_WQG + (size_t)j * 2048 * D * 2, 2048, D, D, D, QB_, GT_); SEAM(); }
            if (L == 2) PHASE(pb + 2) { LAUNDER(); kvpost_phase(F); SEAM(); }
            PHASE(pb + 3) { LAUNDER();
                float kb_; { float g_ = fabsf(F.in[34][F.lane]); g_ = fmaxf(g_, dpp_f(g_, 0)); g_ = fmaxf(g_, dpp_f(g_, 1)); g_ = fmaxf(g_, dpp_f(g_, 2)); g_ = fmaxf(g_, dpp_f(g_, 3));
                  { auto rr = __builtin_amdgcn_permlane16_swap(__float_as_uint(g_), __float_as_uint(g_), false, false); g_ = fmaxf(__uint_as_float(rr[0]), __uint_as_float(rr[1])); }
                  { auto rr = __builtin_amdgcn_permlane32_swap(__float_as_uint(g_), __float_as_uint(g_), false, false); g_ = fmaxf(__uint_as_float(rr[0]), __uint_as_float(rr[1])); }
                  kb_ = 8.0f * 1.02f * g_; }
                const attn_body::AttnTensors AT{(const attn_body::bf16*)QB_, (const attn_body::bf16*)(ws + WS_KS), (const attn_body::bf16*)(ws + WS_VS), (attn_body::bf16*)((PROBE_PH == pb + 3 && rep_ == 0) ? (bf16*)(ws + WS_KVRAW) : QB_), (const attn_body::bf16*)GT_, (const unsigned char*)(ws + WS_G3), F.in[36] + j * 64, kb_};
                const attn_body::StaticOrder S((int)F.G, F.bx);
                attn_body::attn_phase<attn_body::StaticOrder>((char*)lds, AT, S, F.tid);
                SEAM(); }
            PHASE(pb + 6) { LAUNDER(); GEMM_CALL(FnRes, QB_, ws + WS_WO2 + (size_t)j * D * D * 2, D, D, D, D, (const float*)F.out, F.out, MODL_ + 2 * 1024); SEAM(); }
        }
        PHASE(pb + 7) { LAUNDER(); mlp_weights(F, L); norm_phase(F, F.out, F.in[5] + L * D, MODL_ + 3 * 1024, MODL_ + 4 * 1024, 6144, 1, XN_); SEAM(); }
        PHASE(pb + 8) { LAUNDER(); GEMM_CALL(FnUp, XN_, ws + WS_WUP, FF, D, D, D, HB_); SEAM(); }
        PHASE(pb + 9) { LAUNDER(); GEMM_CALL(FnRes, HB_, ws + WS_WDN, D, FF, FF, FF, (const float*)F.out, F.out, MODL_ + 5 * 1024); SEAM(); }
        }
    { constexpr int L = 1;
        const int pb = 1 + L * 10;
        if (L < 2) {
            PHASE(pb + 0) { LAUNDER(); norm_mix_phase(F, XIN1_, F.in[4] + L * D, MODL_, MODL_ + 1024, F.in[8] + L * 6 * 1024, H2_, P2_); SEAM(); }
            PHASE(pb + 1) { LAUNDER(); GEMM_CALL(FnP1, H2_, ws + WS_W1 + (size_t)L * N1 * K1 * 2 + (size_t)3072 * 1024 * 2, 512, K1, K1, K1, P1_, 3072);
                LAUNDER();
                if (F.G == 256) GEMM_CALL_S(SplitOrder, FnP1, P2_, ws + WS_W1 + (size_t)L * N1 * K1 * 2, 3072, D, D, D, 4, (size_t)M * D * 2, P1_, 0);
                else GEMM_CALL_G(FnP1, P2_, ws + WS_W1 + (size_t)L * N1 * K1 * 2, 3072, D, D, D, 4, (size_t)M * D * 2, P1_, 0);
                SEAM(); }
            PHASE(pb + 2) { LAUNDER(); GEMM_CALL(FnP2, P1_ + 3072, ws + WS_W2A + (size_t)L * 3072 * 256 * 2, (L == 0 ? 2048 : NP2), 256, N1, 256, P2_, MOD_ + 53248 + L * 3072); SEAM(); }
            PHASE(pb + 3) { LAUNDER(); scan_phase(F, L); SEAM(); }
            PHASE(pb + 4) { LAUNDER(); post_phase(F, L); SEAM(); }
            PHASE(pb + 5) { LAUNDER(); GEMM_CALL(FnGate, P1_ + 3232, ws + WS_W2G + (size_t)L * 1024 * 256 * 2, D, 256, N1, 256, H2_, 2048); SEAM(); }
            PHASE(pb + 6) { LAUNDER(); GEMM_CALL(FnRes, H2_, ws + WS_WO + (size_t)L * D * D * 2, D, D, 2048, D, XIN1_, F.out, MODL_ + 2 * 1024); SEAM(); }
        } else {
            const int j = L - 2;
            PHASE(pb + 0) { LAUNDER(); norm_phase(F, F.out, F.in[4] + L * D, MODL_, MODL_ + 1024, 6144, 1, XN_);
                if (L == 2) norm_phase(F, F.out, F.in[29], MODKV_, MODKV_ + 1024, 2048, 1, XNKV_);
                SEAM(); }
            PHASE(pb + 1) { LAUNDER();
                if (L == 2) GEMM_CALL(FnKv, XNKV_, ws + WS_WKV, 2304, D, D, D, (bf16*)(ws + WS_KVRAW), (float*)(ws + WS_FL));
                LAUNDER();
                GEMM_CALL(FnQg, XN_, ws + WS_WQG + (size_t)j * 2048 * D * 2, 2048, D, D, D, QB_, GT_); SEAM(); }
            if (L == 2) PHASE(pb + 2) { LAUNDER(); kvpost_phase(F); SEAM(); }
            PHASE(pb + 3) { LAUNDER();
                float kb_; { float g_ = fabsf(F.in[34][F.lane]); g_ = fmaxf(g_, dpp_f(g_, 0)); g_ = fmaxf(g_, dpp_f(g_, 1)); g_ = fmaxf(g_, dpp_f(g_, 2)); g_ = fmaxf(g_, dpp_f(g_, 3));
                  { auto rr = __builtin_amdgcn_permlane16_swap(__float_as_uint(g_), __float_as_uint(g_), false, false); g_ = fmaxf(__uint_as_float(rr[0]), __uint_as_float(rr[1])); }
                  { auto rr = __builtin_amdgcn_permlane32_swap(__float_as_uint(g_), __float_as_uint(g_), false, false); g_ = fmaxf(__uint_as_float(rr[0]), __uint_as_float(rr[1])); }
                  kb_ = 8.0f * 1.02f * g_; }
                const attn_body::AttnTensors AT{(const attn_body::bf16*)QB_, (const attn_body::bf16*)(ws + WS_KS), (const attn_body::bf16*)(ws + WS_VS), (attn_body::bf16*)((PROBE_PH == pb + 3 && rep_ == 0) ? (bf16*)(ws + WS_KVRAW) : QB_), (const attn_body::bf16*)GT_, (const unsigned char*)(ws + WS_G3), F.in[36] + j * 64, kb_};
                const attn_body::StaticOrder S((int)F.G, F.bx);
                attn_body::attn_phase<attn_body::StaticOrder>((char*)lds, AT, S, F.tid);
                SEAM(); }
            PHASE(pb + 6) { LAUNDER(); GEMM_CALL(FnRes, QB_, ws + WS_WO2 + (size_t)j * D * D * 2, D, D, D, D, (const float*)F.out, F.out, MODL_ + 2 * 1024); SEAM(); }
        }
        PHASE(pb + 7) { LAUNDER(); mlp_weights(F, L); norm_phase(F, F.out, F.in[5] + L * D, MODL_ + 3 * 1024, MODL_ + 4 * 1024, 6144, 1, XN_); SEAM(); }
        PHASE(pb + 8) { LAUNDER(); GEMM_CALL(FnUp, XN_, ws + WS_WUP, FF, D, D, D, HB_); SEAM(); }
        PHASE(pb + 9) { LAUNDER(); GEMM_CALL(FnRes, HB_, ws + WS_WDN, D, FF, FF, FF, (const float*)F.out, F.out, MODL_ + 5 * 1024); SEAM(); }
        }
    { constexpr int L = 2;
        const int pb = 1 + L * 10;
        if (L < 2) {
            PHASE(pb + 0) { LAUNDER(); norm_mix_phase(F, XIN1_, F.in[4] + L * D, MODL_, MODL_ + 1024, F.in[8] + L * 6 * 1024, H2_, P2_); SEAM(); }
            PHASE(pb + 1) { LAUNDER(); GEMM_CALL(FnP1, H2_, ws + WS_W1 + (size_t)L * N1 * K1 * 2 + (size_t)3072 * 1024 * 2, 512, K1, K1, K1, P1_, 3072);
                LAUNDER();
                if (F.G == 256) GEMM_CALL_S(SplitOrder, FnP1, P2_, ws + WS_W1 + (size_t)L * N1 * K1 * 2, 3072, D, D, D, 4, (size_t)M * D * 2, P1_, 0);
                else GEMM_CALL_G(FnP1, P2_, ws + WS_W1 + (size_t)L * N1 * K1 * 2, 3072, D, D, D, 4, (size_t)M * D * 2, P1_, 0);
                SEAM(); }
            PHASE(pb + 2) { LAUNDER(); GEMM_CALL(FnP2, P1_ + 3072, ws + WS_W2A + (size_t)L * 3072 * 256 * 2, (L == 0 ? 2048 : NP2), 256, N1, 256, P2_, MOD_ + 53248 + L * 3072); SEAM(); }
            PHASE(pb + 3) { LAUNDER(); scan_phase(F, L); SEAM(); }
            PHASE(pb + 4) { LAUNDER(); post_phase(F, L); SEAM(); }
            PHASE(pb + 5) { LAUNDER(); GEMM_CALL(FnGate, P1_ + 3232, ws + WS_W2G + (size_t)L * 1024 * 256 * 2, D, 256, N1, 256, H2_, 2048); SEAM(); }
            PHASE(pb + 6) { LAUNDER(); GEMM_CALL(FnRes, H2_, ws + WS_WO + (size_t)L * D * D * 2, D, D, 2048, D, XIN1_, F.out, MODL_ + 2 * 1024); SEAM(); }
        } else {
            const int j = L - 2;
            PHASE(pb + 0) { LAUNDER(); norm_phase(F, F.out, F.in[4] + L * D, MODL_, MODL_ + 1024, 6144, 1, XN_);
                if (L == 2) norm_phase(F, F.out, F.in[29], MODKV_, MODKV_ + 1024, 2048, 1, XNKV_);
                SEAM(); }
            PHASE(pb + 1) { LAUNDER();
                if (L == 2) GEMM_CALL(FnKv, XNKV_, ws + WS_WKV, 2304, D, D, D, (bf16*)(ws + WS_KVRAW), (float*)(ws + WS_FL));
                LAUNDER();
                GEMM_CALL(FnQg, XN_, ws + WS_WQG + (size_t)j * 2048 * D * 2, 2048, D, D, D, QB_, GT_); SEAM(); }
            if (L == 2) PHASE(pb + 2) { LAUNDER(); kvpost_phase(F); SEAM(); }
            PHASE(pb + 3) { LAUNDER();
                float kb_; { float g_ = fabsf(F.in[34][F.lane]); g_ = fmaxf(g_, dpp_f(g_, 0)); g_ = fmaxf(g_, dpp_f(g_, 1)); g_ = fmaxf(g_, dpp_f(g_, 2)); g_ = fmaxf(g_, dpp_f(g_, 3));
                  { auto rr = __builtin_amdgcn_permlane16_swap(__float_as_uint(g_), __float_as_uint(g_), false, false); g_ = fmaxf(__uint_as_float(rr[0]), __uint_as_float(rr[1])); }
                  { auto rr = __builtin_amdgcn_permlane32_swap(__float_as_uint(g_), __float_as_uint(g_), false, false); g_ = fmaxf(__uint_as_float(rr[0]), __uint_as_float(rr[1])); }
                  kb_ = 8.0f * 1.02f * g_; }
                const attn_body::AttnTensors AT{(const attn_body::bf16*)QB_, (const attn_body::bf16*)(ws + WS_KS), (const attn_body::bf16*)(ws + WS_VS), (attn_body::bf16*)((PROBE_PH == pb + 3 && rep_ == 0) ? (bf16*)(ws + WS_KVRAW) : QB_), (const attn_body::bf16*)GT_, (const unsigned char*)(ws + WS_G3), F.in[36] + j * 64, kb_};
                const attn_body::StaticOrder S((int)F.G, F.bx);
                attn_body::attn_phase<attn_body::StaticOrder>((char*)lds, AT, S, F.tid);
                SEAM(); }
            PHASE(pb + 6) { LAUNDER(); GEMM_CALL(FnRes, QB_, ws + WS_WO2 + (size_t)j * D * D * 2, D, D, D, D, (const float*)F.out, F.out, MODL_ + 2 * 1024); SEAM(); }
        }
        PHASE(pb + 7) { LAUNDER(); mlp_weights(F, L); norm_phase(F, F.out, F.in[5] + L * D, MODL_ + 3 * 1024, MODL_ + 4 * 1024, 6144, 1, XN_); SEAM(); }
        PHASE(pb + 8) { LAUNDER(); GEMM_CALL(FnUp, XN_, ws + WS_WUP, FF, D, D, D, HB_); SEAM(); }
        PHASE(pb + 9) { LAUNDER(); GEMM_CALL(FnRes, HB_, ws + WS_WDN, D, FF, FF, FF, (const float*)F.out, F.out, MODL_ + 5 * 1024); SEAM(); }
        }
    { constexpr int L = 3;
        const int pb = 1 + L * 10;
        if (L < 2) {
            PHASE(pb + 0) { LAUNDER(); norm_mix_phase(F, XIN1_, F.in[4] + L * D, MODL_, MODL_ + 1024, F.in[8] + L * 6 * 1024, H2_, P2_); SEAM(); }
            PHASE(pb + 1) { LAUNDER(); GEMM_CALL(FnP1, H2_, ws + WS_W1 + (size_t)L * N1 * K1 * 2 + (size_t)3072 * 1024 * 2, 512, K1, K1, K1, P1_, 3072);
                LAUNDER();
                if (F.G == 256) GEMM_CALL_S(SplitOrder, FnP1, P2_, ws + WS_W1 + (size_t)L * N1 * K1 * 2, 3072, D, D, D, 4, (size_t)M * D * 2, P1_, 0);
                else GEMM_CALL_G(FnP1, P2_, ws + WS_W1 + (size_t)L * N1 * K1 * 2, 3072, D, D, D, 4, (size_t)M * D * 2, P1_, 0);
                SEAM(); }
            PHASE(pb + 2) { LAUNDER(); GEMM_CALL(FnP2, P1_ + 3072, ws + WS_W2A + (size_t)L * 3072 * 256 * 2, (L == 0 ? 2048 : NP2), 256, N1, 256, P2_, MOD_ + 53248 + L * 3072); SEAM(); }
            PHASE(pb + 3) { LAUNDER(); scan_phase(F, L); SEAM(); }
            PHASE(pb + 4) { LAUNDER(); post_phase(F, L); SEAM(); }
            PHASE(pb + 5) { LAUNDER(); GEMM_CALL(FnGate, P1_ + 3232, ws + WS_W2G + (size_t)L * 1024 * 256 * 2, D, 256, N1, 256, H2_, 2048); SEAM(); }
            PHASE(pb + 6) { LAUNDER(); GEMM_CALL(FnRes, H2_, ws + WS_WO + (size_t)L * D * D * 2, D, D, 2048, D, XIN1_, F.out, MODL_ + 2 * 1024); SEAM(); }
        } else {
            const int j = L - 2;
            PHASE(pb + 0) { LAUNDER(); norm_phase(F, F.out, F.in[4] + L * D, MODL_, MODL_ + 1024, 6144, 1, XN_);
                if (L == 2) norm_phase(F, F.out, F.in[29], MODKV_, MODKV_ + 1024, 2048, 1, XNKV_);
                SEAM(); }
            PHASE(pb + 1) { LAUNDER();
                if (L == 2) GEMM_CALL(FnKv, XNKV_, ws + WS_WKV, 2304, D, D, D, (bf16*)(ws + WS_KVRAW), (float*)(ws + WS_FL));
                LAUNDER();
                GEMM_CALL(FnQg, XN_, ws + WS_WQG + (size_t)j * 2048 * D * 2, 2048, D, D, D, QB_, GT_); SEAM(); }
            if (L == 2) PHASE(pb + 2) { LAUNDER(); kvpost_phase(F); SEAM(); }
            PHASE(pb + 3) { LAUNDER();
                float kb_; { float g_ = fabsf(F.in[34][F.lane]); g_ = fmaxf(g_, dpp_f(g_, 0)); g_ = fmaxf(g_, dpp_f(g_, 1)); g_ = fmaxf(g_, dpp_f(g_, 2)); g_ = fmaxf(g_, dpp_f(g_, 3));
                  { auto rr = __builtin_amdgcn_permlane16_swap(__float_as_uint(g_), __float_as_uint(g_), false, false); g_ = fmaxf(__uint_as_float(rr[0]), __uint_as_float(rr[1])); }
                  { auto rr = __builtin_amdgcn_permlane32_swap(__float_as_uint(g_), __float_as_uint(g_), false, false); g_ = fmaxf(__uint_as_float(rr[0]), __uint_as_float(rr[1])); }
                  kb_ = 8.0f * 1.02f * g_; }
                const attn_body::AttnTensors AT{(const attn_body::bf16*)QB_, (const attn_body::bf16*)(ws + WS_KS), (const attn_body::bf16*)(ws + WS_VS), (attn_body::bf16*)((PROBE_PH == pb + 3 && rep_ == 0) ? (bf16*)(ws + WS_KVRAW) : QB_), (const attn_body::bf16*)GT_, (const unsigned char*)(ws + WS_G3), F.in[36] + j * 64, kb_};
                const attn_body::StaticOrder S((int)F.G, F.bx);
                attn_body::attn_phase<attn_body::StaticOrder>((char*)lds, AT, S, F.tid);
                SEAM(); }
            PHASE(pb + 6) { LAUNDER(); GEMM_CALL(FnRes, QB_, ws + WS_WO2 + (size_t)j * D * D * 2, D, D, D, D, (const float*)F.out, F.out, MODL_ + 2 * 1024); SEAM(); }
        }
        PHASE(pb + 7) { LAUNDER(); mlp_weights(F, L); norm_phase(F, F.out, F.in[5] + L * D, MODL_ + 3 * 1024, MODL_ + 4 * 1024, 6144, 1, XN_); SEAM(); }
        PHASE(pb + 8) { LAUNDER(); GEMM_CALL(FnUp, XN_, ws + WS_WUP, FF, D, D, D, HB_); SEAM(); }
        PHASE(pb + 9) { LAUNDER(); GEMM_CALL(FnRes, HB_, ws + WS_WDN, D, FF, FF, FF, (const float*)F.out, F.out, MODL_ + 5 * 1024); SEAM(); }
        }
    PHASE(41) { LAUNDER(); final_norm_phase(F); }
#undef IN
#undef SEAM
}
static bool phase_exists(int ph) {
    if (ph == 0 || ph == 41) return true;
    const int L = (ph - 1) / 10, s = (ph - 1) % 10;
    if (L < 2) return true;
    if (s == 4 || s == 5) return false;
    if (s == 2) return L == 2;
    return true;
}
extern "C" void kernel_launch(void* const* d_in, const int* in_sizes, int n_in, void* d_out, int out_size, void* d_ws, size_t ws_size, hipStream_t stream) {
    static int grid = 0;
    if (grid == 0) {
        if (n_in != 39 || in_sizes[0] != M * D || out_size != M * D || ws_size < WS_END) { fprintf(stderr, "kernel_launch: shape/workspace mismatch: n_in %d in0 %d out %d ws %zu (need %zu)\n", n_in, n_in > 0 ? in_sizes[0] : -1, out_size, ws_size, (size_t)WS_END); grid = -1; return; }
        int dev = 0, cus = 0, per_cu = 0;
        if (hipGetDevice(&dev) != hipSuccess || hipDeviceGetAttribute(&cus, hipDeviceAttributeMultiprocessorCount, dev) != hipSuccess) { fprintf(stderr, "kernel_launch: device query failed\n"); grid = -1; return; }
        if (hipFuncSetAttribute((const void*)yoco_fwd, hipFuncAttributeMaxDynamicSharedMemorySize, LDS_BYTES) != hipSuccess) { fprintf(stderr, "kernel_launch: hipFuncSetAttribute failed\n"); grid = -1; return; }
        if (hipOccupancyMaxActiveBlocksPerMultiprocessor(&per_cu, (const void*)yoco_fwd, NWAVES * 64, LDS_BYTES) != hipSuccess || per_cu < 1) { fprintf(stderr, "kernel_launch: occupancy query says %d blocks/CU\n", per_cu); per_cu = 1; }
        (void)hipGetLastError();
        grid = cus * per_cu;
        if (grid != 256) { fprintf(stderr, "kernel_launch: resident capacity %d workgroups; this kernel's static schedules want 256 (using 256)\n", grid); if (grid > 256) grid = 256; }
    }
    if (grid < 0) return;
    if (hipMemsetAsync((char*)d_ws + WS_BAR, 0, BAR_BYTES, stream) != hipSuccess) { fprintf(stderr, "kernel_launch: memset of barrier words failed\n"); return; }
    Args a{};
    for (int i = 0; i < 39; ++i) a.in[i] = (const float*)d_in[i];
    a.out = (float*)d_out; a.ws = (unsigned char*)d_ws;
#if MK_ONE_LAUNCH
    a.ph_lo = 0; a.ph_hi = N_PHASES;
    void* params[] = {&a};
    const hipError_t le = hipLaunchCooperativeKernel((const void*)yoco_fwd, dim3(grid), dim3(NWAVES * 64), params, LDS_BYTES, stream);
    if (le != hipSuccess) fprintf(stderr, "kernel_launch: cooperative launch failed: %s (grid %d)\n", hipGetErrorName(le), grid);
#else
    for (int ph = 0; ph < N_PHASES; ++ph) { if (!phase_exists(ph)) continue; a.ph_lo = ph; a.ph_hi = ph + 1;
        hipLaunchKernelGGL(yoco_fwd, dim3(grid), dim3(NWAVES * 64), LDS_BYTES, stream, a);
        const hipError_t le = hipPeekAtLastError(); if (le != hipSuccess) { fprintf(stderr, "kernel_launch: launch of phase %d failed: %s\n", ph, hipGetErrorName(le)); break; } }
#endif
}
```

```cpp
#include <hip/hip_runtime.h>
#include <hip/hip_cooperative_groups.h>
#include <hip/hip_bf16.h>
#include <cstdio>
#include <cstdint>
#include <cmath>
namespace cg = cooperative_groups;
#ifndef MK_ONE_LAUNCH
#define MK_ONE_LAUNCH 1
#endif
namespace pg8 {
#define PG8_LAS __attribute__((address_space(3)))
typedef unsigned short bf16_t;
typedef short bf16x8 __attribute__((ext_vector_type(8)));
typedef float f32x4 __attribute__((ext_vector_type(4)));
typedef unsigned u32x4 __attribute__((ext_vector_type(4)));
constexpr int BM = 256, BK = 64, HALF = 128, HTB = HALF * BK * 2  , STAGE_BYTES = 8 * HTB, NXCD = 8, WGM = 8;

__host__ __device__ __forceinline__ int lds_byte(int r, int c) { const int st = (r >> 4) * 2 + (c >> 5), rr = r & 15, cc = c & 31, ob = rr * 64 + cc * 2; return st * 1024 + (ob ^ (((ob >> 9) & 1) << 5)); }
__host__ __device__ __forceinline__ void stage_rc(int b, int& R, int& C) { const int st = b / 1024, sb = b % 1024, swz = sb ^ (((sb >> 9) & 1) << 5); R = (st >> 1) * 16 + swz / 64; C = (st & 1) * 32 + (swz % 64) / 2; }
__host__ __device__ __forceinline__ int perm32(int rho) { const int n = rho >> 4, i = rho & 15; return 8 * (i >> 2) + 4 * n + (i & 3); }

struct Unit { int pm, pn; };
struct Gemm { const bf16_t* A; const bf16_t* Bt; int M, N, K, lda, ldb; int agrp; size_t astep; };

struct SplitOrder {
    int c, nN;
    __host__ __device__ void init(int M, int N, int G_, int c_) { c = c_; nN = N / BM; (void)M; (void)G_; }
    __host__ __device__ bool next(int i, Unit& u) const { int idx; if (c < 128) { if (i >= 2) return false; idx = 2 * c + i; } else { if (i >= 4) return false; idx = 256 + 4 * (c - 128) + i; } u.pm = idx / nN; u.pn = idx % nN; return true; }
    __device__ __forceinline__ void a_ready(const Unit&) const {}
    __device__ __forceinline__ void done(const Unit&) const {}
};
struct StaticOrder {
    int nM, nN, nwg, G, c;
    __host__ __device__ void init(int M, int N, int G_, int c_) { nM = M / BM; nN = N / BM; nwg = nM * nN; G = G_; c = c_; }
    __host__ __device__ bool next(int i, Unit& u) const {
        const long L = (long)i * G + c; if (L >= nwg) return false;
        int wgid = (int)L; { const int q = nwg / NXCD, r = nwg % NXCD, xcd = wgid % NXCD, off = wgid / NXCD; wgid = (xcd < r ? xcd * (q + 1) : r * (q + 1) + (xcd - r) * q) + off; }
        const int nig = WGM * nN, gid = wgid / nig, fm = gid * WGM, gsz = (nM - fm) < WGM ? (nM - fm) : WGM;
        u.pm = fm + ((wgid % nig) % gsz); u.pn = (wgid % nig) / gsz; return true;
    }
    __device__ __forceinline__ void a_ready(const Unit&) const {}
    __device__ __forceinline__ void done(const Unit&) const {}
};

typedef float f32x2 __attribute__((ext_vector_type(2)));
typedef __bf16 bf16x2_t __attribute__((ext_vector_type(2)));
__device__ __forceinline__ unsigned pkbf(float lo, float hi) { f32x2 v = {lo, hi}; bf16x2_t b = __builtin_convertvector(v, bf16x2_t); return __builtin_bit_cast(unsigned, b); }
__device__ __forceinline__ float bflo(unsigned w) { return __uint_as_float(w << 16); }
__device__ __forceinline__ float bfhi(unsigned w) { return __uint_as_float(w & 0xffff0000u); }
__device__ __forceinline__ float sigm(float x) { return __builtin_amdgcn_rcpf(1.0f + __builtin_amdgcn_exp2f(-1.4426950408889634f * x)); }
template <class Fn> struct Epi8 {
    static constexpr bool PERM = true, AFTER_DRAIN = false; Fn f;
    __device__ __forceinline__ void operator()(const f32x4 (&acc)[2][2][4][2], const Unit& u, int wr, int wc, int fr, int fq) const {
        const int row0 = u.pm * BM + wr * 64 + fr, col0 = u.pn * BM + wc * 32 + 8 * fq;
#pragma unroll
        for (int ai = 0; ai < 2; ++ai)
#pragma unroll
            for (int m = 0; m < 4; ++m)
#pragma unroll
                for (int bj = 0; bj < 2; ++bj) { f(row0 + ai * HALF + m * 16, col0 + bj * HALF, acc[ai][bj][m][0], acc[ai][bj][m][1]); }
    }
};
__device__ __forceinline__ void st8bf(bf16_t* p, f32x4 v0, f32x4 v1) { u32x4 w; w.x = pkbf(v0[0], v0[1]); w.y = pkbf(v0[2], v0[3]); w.z = pkbf(v1[0], v1[1]); w.w = pkbf(v1[2], v1[3]); *(u32x4*)p = w; }
struct FnP1 { bf16_t* O; int coff;
    __device__ __forceinline__ void operator()(int row, int col, f32x4 v0, f32x4 v1) const {
        col += coff;
        if (col >= 3072) {
            if (col < 3136) {
#pragma unroll
                for (int j = 0; j < 4; ++j) { v0[j] = 1.0f - 2.0f * __builtin_amdgcn_rcpf(__builtin_amdgcn_exp2f(2.8853900817779268f * v0[j]) + 1.0f); v1[j] = 1.0f - 2.0f * __builtin_amdgcn_rcpf(__builtin_amdgcn_exp2f(2.8853900817779268f * v1[j]) + 1.0f); } }
            else if (col >= 3232 && col < 3392) {
#pragma unroll
                for (int j = 0; j < 4; ++j) { v0[j] = sigm(v0[j]); v1[j] = sigm(v1[j]); } }
        }
        st8bf(O + (size_t)row * 3584 + col, v0, v1); } };
struct FnP2 { bf16_t* O; const float* bias;
    __device__ __forceinline__ void operator()(int row, int col, f32x4 v0, f32x4 v1) const {
        const f32x4 b0 = *(const f32x4*)(bias + col), b1 = *(const f32x4*)(bias + col + 4);
        const float sc = col < 1024 ? -0.60653065971f : 1.0f;
#pragma unroll
        for (int j = 0; j < 4; ++j) { v0[j] = sc * sigm(v0[j] + b0[j]); v1[j] = sc * sigm(v1[j] + b1[j]); }
        st8bf(O + (size_t)row * 3072 + col, v0, v1); } };
struct FnGate { bf16_t* Y; int ld;
    __device__ __forceinline__ void operator()(int row, int col, f32x4 v0, f32x4 v1) const {
        bf16_t* p = Y + (size_t)row * ld + col; const u32x4 y = *(const u32x4*)p;
        v0[0] *= bflo(y.x); v0[1] *= bfhi(y.x); v0[2] *= bflo(y.y); v0[3] *= bfhi(y.y); v1[0] *= bflo(y.z); v1[1] *= bfhi(y.z); v1[2] *= bflo(y.w); v1[3] *= bfhi(y.w);
        st8bf(p, v0, v1); } };
struct FnRes { const float* xin; float* xout; const float* gate;
    __device__ __forceinline__ void operator()(int row, int col, f32x4 v0, f32x4 v1) const {
        const float* gp = gate + (row >> 13) * 6144 + col; const f32x4 g0 = *(const f32x4*)gp, g1 = *(const f32x4*)(gp + 4);
        const size_t off = (size_t)row * 1024 + col; const f32x4 x0 = *(const f32x4*)(xin + off), x1 = *(const f32x4*)(xin + off + 4);
        *(f32x4*)(xout + off) = x0 + (g0 + 1.0f) * v0; *(f32x4*)(xout + off + 4) = x1 + (g1 + 1.0f) * v1; } };
struct FnUp { bf16_t* O;
    __device__ __forceinline__ void operator()(int row, int col, f32x4 v0, f32x4 v1) const {
#pragma unroll
        for (int j = 0; j < 4; ++j) { const float a = fmaxf(v0[j], 0.f), b = fmaxf(v1[j], 0.f); v0[j] = a * a; v1[j] = b * b; }
        st8bf(O + (size_t)row * 4096 + col, v0, v1); } };
struct FnKv { bf16_t* O; float* FL;
    __device__ __forceinline__ void operator()(int row, int col, f32x4 v0, f32x4 v1) const {
        if (col < 2048) st8bf(O + (size_t)row * 2048 + col, v0, v1);
        else if (col < 2064) { float* p = FL + (size_t)row * 16 + (col - 2048); *(f32x4*)p = v0; *(f32x4*)(p + 4) = v1; } } };
struct FnQg { bf16_t* Q; bf16_t* G;
    __device__ __forceinline__ void operator()(int row, int col, f32x4 v0, f32x4 v1) const {
        if (col < 1024) st8bf(Q + (size_t)row * 1024 + col, v0, v1);
        else {
#pragma unroll
            for (int j = 0; j < 4; ++j) { v0[j] = sigm(v0[j]); v1[j] = sigm(v1[j]); }
            st8bf(G + (size_t)row * 1024 + (col - 1024), v0, v1); } } };
template <class Epi, class Sched, bool ALIGN_EPI = false, bool SP2 = false>
__device__ __forceinline__ void gemm_phase(PG8_LAS unsigned char* lds, const Gemm g, const Sched& S, const Epi& E, const int tid_in) {
    int tid_l = tid_in; asm volatile("" : "+v"(tid_l));
    const int tid = tid_l, wid = __builtin_amdgcn_readfirstlane(tid >> 6), lane = tid & 63, wr = wid >> 2, wc = wid & 3, fr = lane & 15, fq = lane >> 4;
    const int K = g.K, nt = K / BK;
    unsigned voffA[2], voffB[2];
#pragma unroll
    for (int i = 0; i < 2; ++i) { int R, C; stage_rc(tid * 16 + i * 8192, R, C); const int Rb = Epi::PERM ? ((R & ~31) + perm32(R & 31)) : R;
        voffA[i] = (unsigned)(R * g.lda + C) * 2u; voffB[i] = (unsigned)(Rb * g.ldb + C) * 2u; }
    const size_t kstep = (size_t)(BK * 2);
    const size_t hstepA = (size_t)HALF * g.lda * 2, hstepB = (size_t)HALF * g.ldb * 2;
    const size_t tstepA = 2 * hstepA, tstepB = 2 * hstepB;
    const unsigned ldsw = (unsigned)wid * 1024u;
    const int aoff = lds_byte(wr * 64 + fr, fq * 8), boff = lds_byte(wc * 32 + fr, fq * 8);
#define PG8_SA(b, h) (((b) * 2 + (h)) * HTB)
#define PG8_SB(b, h) ((4 + (b) * 2 + (h)) * HTB)
#define PG8_STAGE(bufoff, gbase, voff) do { _Pragma("unroll") for (int _i = 0; _i < 2; ++_i) \
        __builtin_amdgcn_global_load_lds((const unsigned*)((const char*)(gbase) + (voff)[_i]), (PG8_LAS unsigned*)(lds + (bufoff) + ldsw + _i * 8192), 16, 0, 0); } while (0)
#define PG8_LDA(dst, b, h) do { _Pragma("unroll") for (int m = 0; m < 4; ++m) _Pragma("unroll") for (int k = 0; k < 2; ++k) dst[m][k] = *(const PG8_LAS bf16x8*)(lds + PG8_SA(b, h) + aoff + m * 2048 + k * 1024); } while (0)
#define PG8_LDB(dst, b, h) do { _Pragma("unroll") for (int n = 0; n < 2; ++n) _Pragma("unroll") for (int k = 0; k < 2; ++k) dst[n][k] = *(const PG8_LAS bf16x8*)(lds + PG8_SB(b, h) + boff + n * 2048 + k * 1024); } while (0)
#define PG8_MMA(ai, bj, At, Bt) do { __builtin_amdgcn_s_setprio(1); _Pragma("unroll") for (int m = 0; m < 4; ++m) _Pragma("unroll") for (int n = 0; n < 2; ++n) _Pragma("unroll") for (int k = 0; k < 2; ++k) \
        acc[ai][bj][m][n] = __builtin_amdgcn_mfma_f32_16x16x32_bf16(Bt[n][k], At[m][k], acc[ai][bj][m][n], 0, 0, 0); __builtin_amdgcn_s_setprio(0); } while (0)
#define PG8_WAIT_V(n) asm volatile("s_waitcnt vmcnt(" #n ")" ::: "memory")
#define PG8_WAIT_L(n) asm volatile("s_waitcnt lgkmcnt(" #n ")" ::: "memory")
#define PG8_BAR __builtin_amdgcn_s_barrier()
#define PG8_SCHED __builtin_amdgcn_sched_barrier(0)
    Unit cur, nxt; int ui = 0;
    if (!S.next(0, cur)) return;
    f32x4 acc[2][2][4][2];
#pragma unroll
    for (int a = 0; a < 2; ++a)
#pragma unroll
        for (int b = 0; b < 2; ++b)
#pragma unroll
            for (int m = 0; m < 4; ++m)
#pragma unroll
                for (int n = 0; n < 2; ++n) acc[a][b][m][n] = (f32x4){0.f, 0.f, 0.f, 0.f};
    bf16x8 At[4][2], B0[2][2], B1[2][2];
    const char* cA = (const char*)g.A + (size_t)cur.pm * tstepA + (g.agrp ? (size_t)(cur.pn / g.agrp) * g.astep : (size_t)0); const char* cB = (const char*)g.Bt + (size_t)cur.pn * tstepB;
    S.a_ready(cur);
    if constexpr (SP2) {
        PG8_STAGE(PG8_SB(0, 0), cB, voffB); PG8_STAGE(PG8_SB(0, 1), cB + hstepB, voffB); PG8_STAGE(PG8_SA(0, 0), cA, voffA); PG8_STAGE(PG8_SA(0, 1), cA + hstepA, voffA);
        if (wr == 1) PG8_BAR;
        PG8_WAIT_V(2); PG8_BAR;
        PG8_STAGE(PG8_SB(1, 0), cB + kstep, voffB); PG8_STAGE(PG8_SA(1, 0), cA + kstep, voffA); PG8_STAGE(PG8_SB(1, 1), cB + hstepB + kstep, voffB);
        PG8_WAIT_V(6); PG8_BAR;
    } else {
        PG8_STAGE(PG8_SB(0, 0), cB, voffB); PG8_STAGE(PG8_SA(0, 0), cA, voffA); PG8_STAGE(PG8_SB(0, 1), cB + hstepB, voffB); PG8_STAGE(PG8_SA(0, 1), cA + hstepA, voffA);
        if (wr == 1) PG8_BAR;
        PG8_WAIT_V(4); PG8_BAR;
        PG8_STAGE(PG8_SB(1, 0), cB + kstep, voffB); PG8_STAGE(PG8_SA(1, 0), cA + kstep, voffA); PG8_STAGE(PG8_SB(1, 1), cB + hstepB + kstep, voffB);
        PG8_WAIT_V(6); PG8_BAR;
    }
    for (;;) {
        const bool has_next = S.next(ui + 1, nxt);
        const char* nA = has_next ? (const char*)g.A + (size_t)nxt.pm * tstepA + (g.agrp ? (size_t)(nxt.pn / g.agrp) * g.astep : (size_t)0) : cA; const char* nB = has_next ? (const char*)g.Bt + (size_t)nxt.pn * tstepB : cB;
        for (int t = 0; t < nt; t += 2) {
            const bool last = (t == nt - 2);
            const char* a1 = cA + (size_t)(t + 1) * kstep;
            const char* a2 = last ? nA : cA + (size_t)(t + 2) * kstep; const char* b2 = last ? nB : cB + (size_t)(t + 2) * kstep;
            const char* a3 = a2 + kstep; const char* b3 = b2 + kstep;
            if (last && has_next) S.a_ready(nxt);
            if constexpr (SP2) {
            PG8_LDB(B0, 0, 0); PG8_LDB(B1, 0, 1); PG8_SCHED; PG8_LDA(At, 0, 0); PG8_STAGE(PG8_SA(1, 1), a1 + hstepA, voffA);
            PG8_WAIT_V(8); PG8_WAIT_L(0); PG8_BAR; PG8_MMA(0, 0, At, B0); PG8_MMA(0, 1, At, B1); PG8_BAR; PG8_SCHED;
            PG8_LDA(At, 0, 1); PG8_STAGE(PG8_SB(0, 0), b2, voffB); PG8_STAGE(PG8_SB(0, 1), b2 + hstepB, voffB); PG8_STAGE(PG8_SA(0, 0), a2, voffA);
            PG8_WAIT_V(8); PG8_WAIT_L(0); PG8_BAR; PG8_MMA(1, 0, At, B0); PG8_MMA(1, 1, At, B1); PG8_BAR; PG8_SCHED;
            PG8_LDB(B0, 1, 0); PG8_LDB(B1, 1, 1); PG8_SCHED; PG8_LDA(At, 1, 0); PG8_STAGE(PG8_SA(0, 1), a2 + hstepA, voffA);
            PG8_WAIT_V(8); PG8_WAIT_L(0); PG8_BAR; PG8_MMA(0, 0, At, B0); PG8_MMA(0, 1, At, B1); PG8_BAR; PG8_SCHED;
            PG8_LDA(At, 1, 1); PG8_STAGE(PG8_SB(1, 0), b3, voffB); PG8_STAGE(PG8_SB(1, 1), b3 + hstepB, voffB); PG8_STAGE(PG8_SA(1, 0), a3, voffA);
            PG8_WAIT_V(8); PG8_WAIT_L(0); PG8_BAR; PG8_MMA(1, 0, At, B0); PG8_MMA(1, 1, At, B1); PG8_BAR; PG8_SCHED;
            } else {
            PG8_LDB(B0, 0, 0); PG8_SCHED; PG8_LDA(At, 0, 0); PG8_STAGE(PG8_SA(1, 1), a1 + hstepA, voffA);
            PG8_WAIT_L(8); PG8_BAR; PG8_WAIT_L(0); PG8_MMA(0, 0, At, B0); PG8_BAR; PG8_SCHED;
            PG8_LDB(B1, 0, 1); PG8_STAGE(PG8_SB(0, 0), b2, voffB);
            PG8_BAR; PG8_WAIT_L(0); PG8_MMA(0, 1, At, B1); PG8_BAR;
            PG8_LDA(At, 0, 1); PG8_STAGE(PG8_SA(0, 0), a2, voffA);
            PG8_BAR; PG8_WAIT_L(0); PG8_MMA(1, 0, At, B0); PG8_BAR; PG8_SCHED;
            PG8_STAGE(PG8_SB(0, 1), b2 + hstepB, voffB);
            PG8_WAIT_V(6); PG8_BAR; PG8_MMA(1, 1, At, B1); PG8_BAR;
            PG8_LDB(B0, 1, 0); PG8_SCHED; PG8_LDA(At, 1, 0); PG8_STAGE(PG8_SA(0, 1), a2 + hstepA, voffA);
            PG8_WAIT_L(8); PG8_BAR; PG8_WAIT_L(0); PG8_MMA(0, 0, At, B0); PG8_BAR; PG8_SCHED;
            PG8_LDB(B1, 1, 1); PG8_STAGE(PG8_SB(1, 0), b3, voffB);
            PG8_BAR; PG8_WAIT_L(0); PG8_MMA(0, 1, At, B1); PG8_BAR;
            PG8_LDA(At, 1, 1); PG8_STAGE(PG8_SA(1, 0), a3, voffA);
            PG8_BAR; PG8_WAIT_L(0); PG8_MMA(1, 0, At, B0); PG8_BAR; PG8_SCHED;
            PG8_STAGE(PG8_SB(1, 1), b3 + hstepB, voffB);
            PG8_WAIT_V(6); PG8_BAR; PG8_MMA(1, 1, At, B1); PG8_BAR;
            }
        }
        if constexpr (ALIGN_EPI) { if (wr == 0) PG8_BAR; }
        if constexpr (!Epi::AFTER_DRAIN) { E(acc, cur, wr, wc, fr, fq); S.done(cur); }
        if (!has_next) break;
#pragma unroll
        for (int a = 0; a < 2; ++a)
#pragma unroll
            for (int b = 0; b < 2; ++b)
#pragma unroll
                for (int m = 0; m < 4; ++m)
#pragma unroll
                    for (int n = 0; n < 2; ++n) acc[a][b][m][n] = (f32x4){0.f, 0.f, 0.f, 0.f};
        cur = nxt; cA = nA; cB = nB; ++ui;
        if constexpr (ALIGN_EPI) { if (wr == 1) PG8_BAR; }
    }
    PG8_WAIT_V(0);
    if constexpr (!ALIGN_EPI) { if (wr == 0) PG8_BAR; }
    PG8_BAR;
    if constexpr (Epi::AFTER_DRAIN) { E.fused(acc, cur, wr, wc, fr, fq, lds, wid, lane); S.done(cur); }
#undef PG8_SA
#undef PG8_SB
#undef PG8_STAGE
#undef PG8_LDA
#undef PG8_LDB
#undef PG8_MMA
#undef PG8_WAIT_V
#undef PG8_WAIT_L
#undef PG8_BAR
#undef PG8_SCHED
}
}
#include <hip/hip_bf16.h>
#include <cmath>
namespace attn_body {
using bf16=__hip_bfloat16;
using bf16x8=__attribute__((ext_vector_type(8)))short;
using s16x4=__attribute__((ext_vector_type(4)))short;
using f32x16=__attribute__((ext_vector_type(16)))float;
using u32x4=__attribute__((ext_vector_type(4)))unsigned;
constexpr int BATCH=2,NHEAD=16,SEQ=8192,D=64,DM=NHEAD*D;
constexpr int NW=8,QBLK=32,QB=QBLK*NW,KVBLK=64,NQB=SEQ/QB;
constexpr int ATTN_PITCH=DM, ATTN_UNIT_ROWS=QB;
__device__ __forceinline__ int crow(int r,int hi){return (r&3)+8*(r>>2)+4*hi;}
#define SBAR() __builtin_amdgcn_sched_barrier(0)
__device__ __forceinline__ void cmask(f32x16&p0,f32x16&p1,int jb,int qrel,int hi){
  const float NEG=-INFINITY; int kb=64*jb+4*hi;
  #pragma unroll
  for(int r=0;r<16;++r){int kv=kb+(r&3)+8*(r>>2); if(kv>qrel)p0[r]=NEG; if(kv+32>qrel)p1[r]=NEG;}
}

constexpr int NSLOT=3, SLOTB=9216;
constexpr int LDS_K=0, LDS_V=NSLOT*SLOTB, LDS_WS=2*NSLOT*SLOTB, LDS_OST=LDS_WS+NW*64*4, LDS_BYTES=LDS_OST+NW*4096;
constexpr float C2=0.125f*1.4426950408889634f;
__device__ __forceinline__ void glds16(const void*gsrc,unsigned lds_dst){unsigned keep;
  asm volatile("s_mov_b32 %0, m0\n\ts_mov_b32 m0, %2\n\ts_nop 0\n\tglobal_load_lds_dwordx4 %1, off\n\ts_mov_b32 m0, %0":"=&s"(keep):"v"(gsrc),"s"(lds_dst):"memory");}
__device__ __forceinline__ float max3f(float a,float b,float c){float r;asm("v_max3_f32 %0, %1, %2, %3":"=v"(r):"v"(a),"v"(b),"v"(c));return r;}
__device__ __forceinline__ float max2f(float a,float b){float r;asm("v_max_f32_e32 %0, %1, %2":"=v"(r):"v"(a),"v"(b));return r;}
__device__ __forceinline__ float fadd_s(float a,float b){float r;asm("v_add_f32_e32 %0, %1, %2":"=v"(r):"v"(a),"v"(b));return r;}
__device__ __forceinline__ float fsub_s(float a,float b){float r;asm("v_sub_f32_e32 %0, %1, %2":"=v"(r):"v"(a),"v"(b));return r;}
typedef float f32x2_t __attribute__((ext_vector_type(2))); typedef __bf16 bf16x2_t __attribute__((ext_vector_type(2)));
__device__ __forceinline__ unsigned cvtpk_s(float lo,float hi){f32x2_t v={lo,hi};bf16x2_t b=__builtin_convertvector(v,bf16x2_t);return __builtin_bit_cast(unsigned,b);}
#define WAIT_BAR(N) asm volatile("s_waitcnt vmcnt(" #N ") lgkmcnt(0)\n\ts_barrier":::"memory")
#define WAIT_BARW() do{ if(wid==0){WAIT_BAR(3);} else {WAIT_BAR(2);} }while(0)

__device__ __forceinline__ void qkt(f32x16&p0,f32x16&p1,const char*Kslot,const bf16x8*qr,const bf16x8 qe,const f32x16&negm,int r32,int hi){
  const char*kb=Kslot+hi*1024+r32*16;
  #pragma unroll
  for(int d0=0;d0<4;++d0){
    const bf16x8 b0=*reinterpret_cast<const bf16x8*>(kb+d0*2048);
    const bf16x8 b1=*reinterpret_cast<const bf16x8*>(kb+d0*2048+512);
    if(d0==0){p0=__builtin_amdgcn_mfma_f32_32x32x16_bf16(b0,qr[0],negm,0,0,0);p1=__builtin_amdgcn_mfma_f32_32x32x16_bf16(b1,qr[0],negm,0,0,0);}
    else{p0=__builtin_amdgcn_mfma_f32_32x32x16_bf16(b0,qr[d0],p0,0,0,0);p1=__builtin_amdgcn_mfma_f32_32x32x16_bf16(b1,qr[d0],p1,0,0,0);}}
  { const char*ke=Kslot+8192+r32*16; const bf16x8 e0=*reinterpret_cast<const bf16x8*>(ke),e1=*reinterpret_cast<const bf16x8*>(ke+512);
    p0=__builtin_amdgcn_mfma_f32_32x32x16_bf16(e0,qe,p0,0,0,0);p1=__builtin_amdgcn_mfma_f32_32x32x16_bf16(e1,qe,p1,0,0,0);}
}
typedef __attribute__((address_space(3))) const char* lds_cptr;
typedef short v4i16_t __attribute__((ext_vector_type(4)));
__device__ __forceinline__ void kload8(bf16x8*kf,lds_cptr kp){
  kf[0]=*(const __attribute__((address_space(3))) bf16x8*)(kp);      kf[1]=*(const __attribute__((address_space(3))) bf16x8*)(kp+512);
  kf[2]=*(const __attribute__((address_space(3))) bf16x8*)(kp+2048); kf[3]=*(const __attribute__((address_space(3))) bf16x8*)(kp+2560);
  kf[4]=*(const __attribute__((address_space(3))) bf16x8*)(kp+4096); kf[5]=*(const __attribute__((address_space(3))) bf16x8*)(kp+4608);
  kf[6]=*(const __attribute__((address_space(3))) bf16x8*)(kp+6144); kf[7]=*(const __attribute__((address_space(3))) bf16x8*)(kp+6656);
}
__device__ __forceinline__ void kload2(bf16x8*kf,lds_cptr kp,int j){ kf[2*j]=*(const __attribute__((address_space(3))) bf16x8*)(kp+j*2048); kf[2*j+1]=*(const __attribute__((address_space(3))) bf16x8*)(kp+j*2048+512); }
__device__ __forceinline__ s16x4 vtr(lds_cptr p){ return __builtin_bit_cast(s16x4,__builtin_amdgcn_ds_read_tr16_b64_v4i16((__attribute__((address_space(3))) v4i16_t*)p)); }
__device__ __forceinline__ float rowmax(const f32x16&p0,const f32x16&p1){
  float a=max3f(p0[0],p0[1],p1[0]),b=max3f(p0[2],p0[3],p1[1]);a=max3f(a,p1[2],p1[3]);
  #pragma unroll
  for(int r=4;r<16;r+=4){a=max3f(a,p0[r],p0[r+1]);b=max3f(b,p0[r+2],p0[r+3]);a=max3f(a,p1[r],p1[r+1]);b=max3f(b,p1[r+2],p1[r+3]);}
  const float m=max2f(a,b);
  auto rr=__builtin_amdgcn_permlane32_swap(__float_as_uint(m),__float_as_uint(m),false,false);
  return max2f(__uint_as_float(rr[0]),__uint_as_float(rr[1]));
}
__device__ __forceinline__ void pv(f32x16*o,int vb,bf16x8 pa0,bf16x8 pa1,bf16x8 pa2,bf16x8 pa3){
  #pragma unroll
  for(int d0=0;d0<2;++d0){s16x4 lo[4],hi[4];
    #pragma unroll
    for(int ks=0;ks<4;++ks){
      asm volatile("ds_read_b64_tr_b16 %0,%1 offset:%c2":"=&v"(lo[ks]):"v"(vb),"i"(d0*4096+ks*1024):"memory");
      asm volatile("ds_read_b64_tr_b16 %0,%1 offset:%c2":"=&v"(hi[ks]):"v"(vb),"i"(d0*4096+ks*1024+512):"memory");}
    asm volatile("s_waitcnt lgkmcnt(0)":::"memory");SBAR();
    #define PK(k) (bf16x8){lo[k][0],lo[k][1],lo[k][2],lo[k][3],hi[k][0],hi[k][1],hi[k][2],hi[k][3]}
    o[d0]=__builtin_amdgcn_mfma_f32_32x32x16_bf16(pa0,PK(0),o[d0],0,0,0);
    o[d0]=__builtin_amdgcn_mfma_f32_32x32x16_bf16(pa1,PK(1),o[d0],0,0,0);
    o[d0]=__builtin_amdgcn_mfma_f32_32x32x16_bf16(pa2,PK(2),o[d0],0,0,0);
    o[d0]=__builtin_amdgcn_mfma_f32_32x32x16_bf16(pa3,PK(3),o[d0],0,0,0);
    #undef PK
  }
}

#ifndef ATTN_STORE16
#define ATTN_STORE16(p,v) (*(u32x4*)(p)=(v))
#endif
template<int THRL> __device__ __forceinline__ void attn_unit(int b,int h,int qb,const bf16*Q,const bf16*__restrict__ K,const bf16*__restrict__ V,bf16*O,const bf16*__restrict__ GT,const unsigned char*__restrict__ G3,const float*__restrict__ qgain,const float kbound,char*shm,const int tid_in){
  int tid_l=tid_in; asm volatile("":"+v"(tid_l)); const int tid=tid_l,lane=tid&63,r32=lane&31,hi=lane>>5; const int wid=__builtin_amdgcn_readfirstlane(tid>>6);
  const long rowbase=(long)b*SEQ; const int q0=qb*QB;
  const bf16*Qw=Q+(rowbase+q0+wid*QBLK)*DM+h*D;
  const bf16*Kh=K+rowbase*DM+h*D,*Vh=V+rowbase*DM+h*D;
  const unsigned lds0=(unsigned)(uintptr_t)shm;
  float*wsf=(float*)(shm+LDS_WS)+wid*64;
  const bf16*ksrc=Kh+(long)lane*DM+wid*8;
  const bf16*vsrc=Vh+(long)(16*(wid&3)+(lane>>2))*DM+(wid>>2)*32+(lane&3)*8;
  const unsigned kdst=lds0+LDS_K+wid*1024, vdst=lds0+LDS_V+wid*1024, gdst=lds0+LDS_K+8192;
  const unsigned char*gsrc=G3+((long)(b*NHEAD+h)*SEQ+lane)*16;
  #define DMA_K(t,slot) do{ if(wid==0)glds16(gsrc+(long)(t)*KVBLK*16,(unsigned)__builtin_amdgcn_readfirstlane(gdst+(slot))); glds16(ksrc+(long)(t)*KVBLK*DM,(unsigned)__builtin_amdgcn_readfirstlane(kdst+(slot))); }while(0)
  #define DMA_V(t,slot) glds16(vsrc+(long)(t)*KVBLK*DM,(unsigned)__builtin_amdgcn_readfirstlane(vdst+(slot)))
  const int vb0=(int)(lds0+LDS_V)+((lane>>4)&1)*32+(lane&3)*8+(4*hi+((lane&15)>>2))*64;
  const char*Kbase=shm+LDS_K; bf16x8 kf[10];
  const lds_cptr shm3=(lds_cptr)shm; const lds_cptr kp0=shm3+LDS_K+hi*1024+r32*16; const lds_cptr kpe=shm3+LDS_K+8192+r32*16; const lds_cptr vp0=shm3+LDS_V+((lane>>4)&1)*32+(lane&3)*8+(4*hi+((lane&15)>>2))*64;
  const int NT=(q0+QB)/KVBLK;
  DMA_K(0,0);DMA_V(0,0);DMA_K(1,SLOTB);
  bf16x8 qr[4]; float fq2; bf16x8 qe; float ubound;
  { bf16x8 qraw[4];
    #pragma unroll
    for(int d0=0;d0<4;++d0)qraw[d0]=*reinterpret_cast<const bf16x8*>(&Qw[(long)r32*DM+d0*16+hi*8]);
    const u32x4 ge=*reinterpret_cast<const u32x4*>(G3+((long)(b*NHEAD+h)*SEQ+q0+wid*QBLK+r32)*16);
    fq2=-(__uint_as_float(ge[0]<<16)+__uint_as_float(ge[0]&0xffff0000u)+__uint_as_float(ge[1]<<16));
    float ss=0.f;
    #pragma unroll
    for(int d0=0;d0<4;++d0)
      #pragma unroll
      for(int j=0;j<8;++j){const float x=__uint_as_float(((unsigned)(unsigned short)qraw[d0][j])<<16);ss+=x*x;}
    {auto rr=__builtin_amdgcn_permlane32_swap(__float_as_uint(ss),__float_as_uint(ss),false,false);ss=__uint_as_float(rr[0])+__uint_as_float(rr[1]);}
    const float qs=C2/sqrtf(ss*(1.0f/64.0f)+1e-6f);
    float s2=0.f;
    #pragma unroll
    for(int d0=0;d0<4;++d0){ u32x4 w;
      #pragma unroll
      for(int j=0;j<8;j+=2){const float x0=__uint_as_float(((unsigned)(unsigned short)qraw[d0][j])<<16),x1=__uint_as_float(((unsigned)(unsigned short)qraw[d0][j+1])<<16);
        const float y0=x0*qs*qgain[d0*16+hi*8+j],y1=x1*qs*qgain[d0*16+hi*8+j+1]; s2+=y0*y0+y1*y1;
        w[j>>1]=cvtpk_s(y0,y1);}
      qr[d0]=__builtin_bit_cast(bf16x8,w);}
    {auto rr=__builtin_amdgcn_permlane32_swap(__float_as_uint(s2),__float_as_uint(s2),false,false);s2=__uint_as_float(rr[0])+__uint_as_float(rr[1]);}
    ubound=sqrtf(s2)*kbound;
    const unsigned one2=hi?0u:0x3f803f80u, one1=hi?0u:0x00003f80u; qe=__builtin_bit_cast(bf16x8,(u32x4){one2,one1,0u,0u}); }
  float mhat=ubound,l_reg=0.f;f32x16 o[2];o[0]=f32x16{};o[1]=f32x16{};f32x16 negm;
  #pragma unroll
  for(int r=0;r<16;++r)negm[r]=fq2-ubound;
  asm volatile("":"+v"(negm));
  const int qrel=wid*QBLK+r32;
  #define CMASK(P0,P1,t) do{int jb_=(t)-(NT-4); if(jb_>=0)cmask(P0,P1,jb_,qrel,hi);}while(0)
  bool resc=false;
  #define START(P0,P1) do{ const float rm=rowmax(P0,P1); resc=false; \
    { const float dl=fmaxf(rm,0.f); mhat=fadd_s(mhat,dl); \
      _Pragma("unroll") for(int r=0;r<16;++r){P0[r]=fsub_s(P0[r],dl);P1[r]=fsub_s(P1[r],dl);} \
      _Pragma("unroll") for(int r=0;r<16;++r)negm[r]=fq2-mhat; asm volatile("":"+v"(negm)); } \
    _Pragma("unroll") for(int r=0;r<16;++r)P0[r]=__builtin_amdgcn_exp2f(P0[r]); }while(0)
  #define RESC() do{ if(resc){ asm volatile("s_waitcnt lgkmcnt(0)":::"memory"); \
      _Pragma("unroll") for(int d_=0;d_<2;++d_) _Pragma("unroll") for(int r=0;r<16;++r)o[d_][r]*=wsf[crow(r,hi)]; } }while(0)
  f32x16 pA0,pA1,pB0,pB1;
  int sl_prev=0,sl_cur=0,sl_next=SLOTB;
  #define ROT() do{sl_prev=sl_cur;sl_cur=sl_next;sl_next=(sl_next==(NSLOT-1)*SLOTB)?0:sl_next+SLOTB;}while(0)
  DMA_K(2,2*SLOTB);
  WAIT_BAR(3);
  qkt(pA0,pA1,Kbase,qr,qe,negm,r32,hi);asm volatile("s_nop 15\n\ts_nop 7":"+v"(pA0),"+v"(pA1));CMASK(pA0,pA1,0);
  START(pA0,pA1);
  _Pragma("unroll") for(int r=0;r<16;++r)pA1[r]=__builtin_amdgcn_exp2f(pA1[r]);
  WAIT_BAR(0);
  DMA_K(3,0);DMA_V(1,SLOTB);
  ROT();
  kload8(kf,kp0+sl_cur);
  kf[8]=*(const __attribute__((address_space(3))) bf16x8*)(kpe+sl_cur); kf[9]=*(const __attribute__((address_space(3))) bf16x8*)(kpe+sl_cur+512);
  WAIT_BARW();
  s16x4 vlo[8],vhi[8]; u32x4 pw0,pw1,pw2,pw3;
  #define PKW(P,B) cvtpk_s(P[B],P[B+1])
  #define PAF(k) __builtin_bit_cast(bf16x8,pw##k)
  #define VFR(i) (bf16x8){vlo[i][0],vlo[i][1],vlo[i][2],vlo[i][3],vhi[i][0],vhi[i][1],vhi[i][2],vhi[i][3]}
  #define PIN(x) asm volatile("":"+v"(x))
  #define MX3(a,b,c) __builtin_fmaxf(__builtin_fmaxf((a),(b)),(c))
  #define GAPA(MF,A0,A1,A2,A3,W0,W1,PW) do{ MF; sacc+=A0; sacc+=A1; sacc+=A2; sacc+=A3; PIN(sacc); W0; W1; PIN(PW); SBAR(); }while(0)
  #define EX(v) __builtin_amdgcn_exp2f(v)
  #define GAPB(MF,X,B) do{ MF; X[B]=EX(X[B]); X[B+1]=EX(X[B+1]); X[B+2]=EX(X[B+2]); X[B+3]=EX(X[B+3]); PIN(X); SBAR(); }while(0)
  #define VRD(i) do{ vlo[i]=vtr(vp_+(((i)>>2)*4096+((i)&3)*1024)); vhi[i]=vtr(vp_+(((i)>>2)*4096+((i)&3)*1024+512)); }while(0)
  #define KRD(G,j) do{ if(G){ kload2(kf,kp0+sl_next,j); SBAR(); } }while(0)
  #define STEP(C0,C1,P0,P1,t,GK,GV,GL) do{ SBAR(); \
    const lds_cptr vp_=vp0+sl_prev; \
    VRD(0); SBAR(); float sacc=(P0[0]+P0[1]); \
    GAPA(C0=__builtin_amdgcn_mfma_f32_32x32x16_bf16(kf[0],qr[0],negm,0,0,0), P0[2],P0[3],P0[4],P0[5],     pw0[0]=PKW(P0,0), pw0[1]=PKW(P0,2), pw0); \
    VRD(4); SBAR(); GAPA(C1=__builtin_amdgcn_mfma_f32_32x32x16_bf16(kf[1],qr[0],negm,0,0,0), P0[6],P0[7],P0[8],P0[9],     pw0[2]=PKW(P0,4), pw0[3]=PKW(P0,6), pw0); \
    VRD(1); SBAR(); GAPA(C0=__builtin_amdgcn_mfma_f32_32x32x16_bf16(kf[2],qr[1],C0,0,0,0),   P0[10],P0[11],P0[12],P0[13], pw1[0]=PKW(P0,8), pw1[1]=PKW(P0,10), pw1); \
    VRD(5); SBAR(); GAPA(C1=__builtin_amdgcn_mfma_f32_32x32x16_bf16(kf[3],qr[1],C1,0,0,0),   P0[14],P0[15],P1[0],P1[1],   pw1[2]=PKW(P0,12),pw1[3]=PKW(P0,14), pw1); \
    VRD(2); SBAR(); GAPA(C0=__builtin_amdgcn_mfma_f32_32x32x16_bf16(kf[4],qr[2],C0,0,0,0),   P1[2],P1[3],P1[4],P1[5],     pw2[0]=PKW(P1,0), pw2[1]=PKW(P1,2), pw2); \
    VRD(6); SBAR(); GAPA(C1=__builtin_amdgcn_mfma_f32_32x32x16_bf16(kf[5],qr[2],C1,0,0,0),   P1[6],P1[7],P1[8],P1[9],     pw2[2]=PKW(P1,4), pw2[3]=PKW(P1,6), pw2); \
    VRD(3); SBAR(); GAPA(C0=__builtin_amdgcn_mfma_f32_32x32x16_bf16(kf[6],qr[3],C0,0,0,0),   P1[10],P1[11],P1[12],P1[13], pw3[0]=PKW(P1,8), pw3[1]=PKW(P1,10), pw3); \
    VRD(7); SBAR(); GAPA(C1=__builtin_amdgcn_mfma_f32_32x32x16_bf16(kf[7],qr[3],C1,0,0,0),   P1[14],P1[15],0.f,0.f,       pw3[2]=PKW(P1,12),pw3[3]=PKW(P1,14), pw3); \
    C0=__builtin_amdgcn_mfma_f32_32x32x16_bf16(kf[8],qe,C0,0,0,0); C1=__builtin_amdgcn_mfma_f32_32x32x16_bf16(kf[9],qe,C1,0,0,0); \
    l_reg+=sacc; \
    if(GK){DMA_K((t)+3,sl_cur);} if(GV){DMA_V((t)+1,sl_next);} \
    CMASK(C0,C1,t); \
    { float a=MX3(C0[0],C0[1],C1[0]),b=MX3(C0[2],C0[3],C1[1]); a=MX3(a,C1[2],C1[3]); \
      _Pragma("unroll") for(int r=4;r<16;r+=4){a=MX3(a,C0[r],C0[r+1]);b=MX3(b,C0[r+2],C0[r+3]);a=MX3(a,C1[r],C1[r+1]);b=MX3(b,C1[r+2],C1[r+3]);} \
      float rm=__builtin_fmaxf(a,b); { auto rr=__builtin_amdgcn_permlane32_swap(__float_as_uint(rm),__float_as_uint(rm),false,false); rm=__builtin_fmaxf(__uint_as_float(rr[0]),__uint_as_float(rr[1])); } \
      resc=false; \
      if(__builtin_expect(__any(rm>(float)THRL),0)){ const float dl=__builtin_fmaxf(rm,0.f); mhat+=dl; \
        _Pragma("unroll") for(int r=0;r<16;++r){C0[r]-=dl;C1[r]-=dl;} \
        _Pragma("unroll") for(int r=0;r<16;++r)negm[r]=fq2-mhat; asm volatile("":"+v"(negm)); \
        const float f=__builtin_amdgcn_exp2f(-dl); l_reg*=f; if(hi==0)wsf[r32]=f; resc=true; } } \
    SBAR(); \
    GAPB(o[0]=__builtin_amdgcn_mfma_f32_32x32x16_bf16(PAF(0),VFR(0),o[0],0,0,0), C0,0); \
    GAPB(o[1]=__builtin_amdgcn_mfma_f32_32x32x16_bf16(PAF(0),VFR(4),o[1],0,0,0), C0,4); \
    KRD(GL,0); GAPB(o[0]=__builtin_amdgcn_mfma_f32_32x32x16_bf16(PAF(1),VFR(1),o[0],0,0,0), C0,8); \
    KRD(GL,1); GAPB(o[1]=__builtin_amdgcn_mfma_f32_32x32x16_bf16(PAF(1),VFR(5),o[1],0,0,0), C0,12); \
    KRD(GL,2); GAPB(o[0]=__builtin_amdgcn_mfma_f32_32x32x16_bf16(PAF(2),VFR(2),o[0],0,0,0), C1,0); \
    KRD(GL,3); GAPB(o[1]=__builtin_amdgcn_mfma_f32_32x32x16_bf16(PAF(2),VFR(6),o[1],0,0,0), C1,4); \
    if(GL){ kf[8]=*(const __attribute__((address_space(3))) bf16x8*)(kpe+sl_next); kf[9]=*(const __attribute__((address_space(3))) bf16x8*)(kpe+sl_next+512); SBAR(); } \
    GAPB(o[0]=__builtin_amdgcn_mfma_f32_32x32x16_bf16(PAF(3),VFR(3),o[0],0,0,0), C1,8); \
    GAPB(o[1]=__builtin_amdgcn_mfma_f32_32x32x16_bf16(PAF(3),VFR(7),o[1],0,0,0), C1,12); \
    }while(0)
  int t=1;
  #undef CMASK
  #define CMASK(P0,P1,t) do{}while(0)
  for(;t+5<NT;t+=2){
    STEP(pB0,pB1,pA0,pA1,t,true,true,true);     WAIT_BARW(); RESC(); ROT();
    STEP(pA0,pA1,pB0,pB1,t+1,true,true,true);   WAIT_BARW(); RESC(); ROT();
  }
  #undef CMASK
  #define CMASK(P0,P1,t) do{int jb_=(t)-(NT-4); if(jb_>=0)cmask(P0,P1,jb_,qrel,hi);}while(0)
  #define ENDW(tt) do{ if((tt)+3<NT){WAIT_BARW();} else if((tt)+2<NT){WAIT_BAR(1);} else {WAIT_BAR(0);} }while(0)
  for(;t+1<NT;t+=2){
    STEP(pB0,pB1,pA0,pA1,t,(t+3<NT),(t+1<NT),(t+1<NT));       ENDW(t);   RESC(); ROT();
    STEP(pA0,pA1,pB0,pB1,t+1,(t+4<NT),(t+2<NT),(t+2<NT));     ENDW(t+1); RESC(); ROT();
  }
  STEP(pB0,pB1,pA0,pA1,NT-1,false,false,false); RESC();
  { float sacc=pB0[0]+pB0[1]; _Pragma("unroll") for(int r=2;r<16;++r)sacc+=pB0[r]; _Pragma("unroll") for(int r=0;r<16;++r)sacc+=pB1[r]; l_reg+=sacc;
    pw0=(u32x4){PKW(pB0,0),PKW(pB0,2),PKW(pB0,4),PKW(pB0,6)};pw1=(u32x4){PKW(pB0,8),PKW(pB0,10),PKW(pB0,12),PKW(pB0,14)};pw2=(u32x4){PKW(pB1,0),PKW(pB1,2),PKW(pB1,4),PKW(pB1,6)};pw3=(u32x4){PKW(pB1,8),PKW(pB1,10),PKW(pB1,12),PKW(pB1,14)};
    SBAR(); pv(o,vb0+sl_cur,PAF(0),PAF(1),PAF(2),PAF(3)); }
  #undef PKW
  #undef PAF
  #undef VFR
  #undef PIN
  #undef MX3
  #undef GAPA
  #undef GAPB
  #undef EX
  #undef VRD
  #undef KRD
  #undef STEP
  #undef ENDW
  {auto rr=__builtin_amdgcn_permlane32_swap(__float_as_uint(l_reg),__float_as_uint(l_reg),false,false);l_reg=__uint_as_float(rr[0])+__uint_as_float(rr[1]);}
  if(hi==0)wsf[32+r32]=l_reg;asm volatile("s_waitcnt lgkmcnt(0)":::"memory");
  float rli[16];
  #pragma unroll
  for(int r=0;r<16;++r)rli[r]=__builtin_amdgcn_rcpf(wsf[32+crow(r,hi)]);
  bf16*Ow=O+(rowbase+q0+wid*QBLK)*DM+h*D;
  { bf16*stg=(bf16*)(shm+LDS_OST)+wid*2048;
    #pragma unroll
    for(int r=0;r<16;++r){const int orow=crow(r,hi);
      #pragma unroll
      for(int d0=0;d0<2;++d0)stg[orow*64+d0*32+r32]=__float2bfloat16(o[d0][r]*rli[r]);}
    asm volatile("s_waitcnt lgkmcnt(0)":::"memory");
    const bf16*Gw=GT+(rowbase+q0+wid*QBLK)*DM+h*D;
    #pragma unroll
    for(int i=0;i<4;++i){const int row=i*8+(lane>>3),ch=lane&7; u32x4 v=*(const u32x4*)(stg+row*64+ch*8); const u32x4 gg=*(const u32x4*)(Gw+(long)row*DM+ch*8);
      #pragma unroll
      for(int j=0;j<4;++j){ v[j]=cvtpk_s(__uint_as_float(v[j]<<16)*__uint_as_float(gg[j]<<16),__uint_as_float(v[j]&0xffff0000u)*__uint_as_float(gg[j]&0xffff0000u)); }
      ATTN_STORE16(Ow+(long)row*DM+ch*8,v);} }
  asm volatile("s_waitcnt lgkmcnt(0)\n\ts_barrier":::"memory");
  #undef DMA_K
  #undef DMA_V
  #undef CMASK
  #undef START
  #undef RESC
  #undef ROT
}
constexpr int ATTN_LDS_BYTES=LDS_BYTES;
struct AttnTensors { const bf16* Q; const bf16* K; const bf16* V; bf16* O; const bf16* GT; const unsigned char* G3; const float* qgain; float kbound; };
struct AttnUnit { int bh; int qb; };
struct StaticOrder {
  int vcu;
  __device__ __forceinline__ explicit StaticOrder(int grid,int block):vcu((block%8)*(grid/8)+block/8){}
  __device__ __forceinline__ bool next(int i,AttnUnit&u)const{ if(i>=4)return false; const int s=vcu&7; u.bh=vcu>>3; u.qb=(i==0)?s:(i==1)?15-s:(i==2)?16+s:31-s; return true; }
  __device__ __forceinline__ void a_ready(const AttnUnit&)const{}
  __device__ __forceinline__ void done(const AttnUnit&)const{}
};
template<class Sched,int THRL=8> __device__ __forceinline__ void attn_phase(char*lds,const AttnTensors&T,const Sched&S,const int tid_in){
  AttnUnit u;
  for(int i=0;S.next(i,u);++i){ S.a_ready(u); attn_unit<THRL>(u.bh/NHEAD,u.bh%NHEAD,u.qb,T.Q,T.K,T.V,T.O,T.GT,T.G3,T.qgain,T.kbound,lds,tid_in); S.done(u); }
}
#undef SBAR
#undef WAIT_BAR
#undef WAIT_BARW
}
constexpr int NWAVES = 8;
constexpr int BATCH = 2, T = 8192, D = 1024, H = 16, HD = 64, FF = 4096, M = BATCH * T;
constexpr int N1 = 3584, K1 = 2048, NP2 = 3072;
constexpr size_t MiB = 1u << 20;
constexpr size_t WS_MOD = 0;
constexpr size_t WS_W1 = 1 * MiB;
constexpr size_t WS_W2A = 29 * MiB;
constexpr size_t WS_W2G = 32 * MiB;
constexpr size_t WS_WO = 33 * MiB;
constexpr size_t WS_WKV = 37 * MiB;
constexpr size_t WS_WQG = 42 * MiB;
constexpr size_t WS_WO2 = 50 * MiB;
constexpr size_t WS_WUP = 54 * MiB, WS_WDN = 62 * MiB;
constexpr size_t WS_G3 = 70 * MiB;
constexpr size_t WS_FL = 74 * MiB;
constexpr size_t WS_H2 = 76 * MiB;
constexpr size_t WS_P1 = 140 * MiB;
constexpr size_t WS_P2 = 252 * MiB;
constexpr size_t WS_VF = 348 * MiB;
constexpr size_t WS_HB = 140 * MiB;
constexpr size_t WS_KVRAW = 140 * MiB, WS_QB = 204 * MiB, WS_GT = 236 * MiB, WS_VS = 316 * MiB, WS_KS = 348 * MiB;
constexpr size_t WS_END = 380 * MiB;
constexpr int LDS_BYTES = 147456;

#define GAS __attribute__((address_space(1)))
#define LAS __attribute__((address_space(3)))
typedef unsigned short bf16;
typedef unsigned v4u __attribute__((ext_vector_type(4)));
typedef unsigned v2u __attribute__((ext_vector_type(2)));
typedef float f32x4 __attribute__((ext_vector_type(4)));
using pg8::pkbf; using pg8::bflo; using pg8::bfhi; using pg8::sigm;

struct Args { const float* in[39]; float* out; unsigned char* ws; int ph_lo, ph_hi; };

struct Frame { LAS unsigned char* lds; int tid, lane, wave, vcu, G, bx; unsigned char* ws; float* out; const float* const* in; };

__device__ __forceinline__ void tr_item(const float* W, int ldw, int Nvalid, bf16* WT, int ldt, int row_off, int col_off, const float* mu, LAS float* scr, int item, int lane) {
    const int nblk = (Nvalid + 31) / 32, kb = item / nblk, nb = item % nblk, k0 = 64 * kb, n0 = 32 * nb;
    { float t[32]; const int n = n0 + (lane & 31); const bool ok = n < Nvalid; const float* wp = W + (size_t)(k0 + (lane >> 5)) * ldw + n;
#pragma unroll
      for (int i = 0; i < 32; ++i) t[i] = ok ? wp[(size_t)(2 * i) * ldw] : 0.f;
#pragma unroll
      for (int i = 0; i < 32; ++i) scr[(2 * i + (lane >> 5)) * 33 + (lane & 31)] = t[i]; }
    asm volatile("s_waitcnt lgkmcnt(0)" ::: "memory");
    const int c = lane & 7;
    float s0[8], s1[8];
#pragma unroll
    for (int q = 0; q < 8; ++q) { const float m = mu ? mu[k0 + 8 * c + q] : 0.f; s0[q] = 1.f - m; s1[q] = m; }
#pragma unroll
    for (int j = 0; j < 4; ++j) { const int n = (lane >> 3) + 8 * j; const LAS float* s = scr + (8 * c) * 33 + n;
        float v[8];
#pragma unroll
        for (int q = 0; q < 8; ++q) v[q] = s[q * 33];
        v4u o; o.x = pkbf(v[0] * s0[0], v[1] * s0[1]); o.y = pkbf(v[2] * s0[2], v[3] * s0[3]); o.z = pkbf(v[4] * s0[4], v[5] * s0[5]); o.w = pkbf(v[6] * s0[6], v[7] * s0[7]);
        bf16* dst = WT + (size_t)(row_off + n0 + n) * ldt + col_off + k0 + 8 * c;
        *(v4u*)dst = o;
        if (mu) { v4u p; p.x = pkbf(v[0] * s1[0], v[1] * s1[1]); p.y = pkbf(v[2] * s1[2], v[3] * s1[3]); p.z = pkbf(v[4] * s1[4], v[5] * s1[5]); p.w = pkbf(v[6] * s1[6], v[7] * s1[7]); *(v4u*)(dst + 1024) = p; } }
    asm volatile("s_waitcnt lgkmcnt(0)" ::: "memory");
}
__device__ __forceinline__ float dpp_f(float x, const int ctrl_sel) {
    switch (ctrl_sel) {
        case 0: return __builtin_bit_cast(float, __builtin_amdgcn_update_dpp(0, __builtin_bit_cast(int, x), 0xB1, 0xf, 0xf, false));
        case 1: return __builtin_bit_cast(float, __builtin_amdgcn_update_dpp(0, __builtin_bit_cast(int, x), 0x4E, 0xf, 0xf, false));
        case 2: return __builtin_bit_cast(float, __builtin_amdgcn_update_dpp(0, __builtin_bit_cast(int, x), 0x141, 0xf, 0xf, false));
        default: return __builtin_bit_cast(float, __builtin_amdgcn_update_dpp(0, __builtin_bit_cast(int, x), 0x140, 0xf, 0xf, false));
    }
}
__device__ __forceinline__ float sum4(float x) { x += dpp_f(x, 0); x += dpp_f(x, 1); return x; }
__device__ __forceinline__ float sum8(float x) { x = sum4(x); x += dpp_f(x, 2); return x; }
__device__ __forceinline__ float sum16(float x) { x = sum8(x); x += dpp_f(x, 3); return x; }
__device__ __forceinline__ float wave_sum(float v) {
    v = sum16(v);
    { auto rr = __builtin_amdgcn_permlane16_swap(__float_as_uint(v), __float_as_uint(v), false, false); v = __uint_as_float(rr[0]) + __uint_as_float(rr[1]); }
    { auto rr = __builtin_amdgcn_permlane32_swap(__float_as_uint(v), __float_as_uint(v), false, false); v = __uint_as_float(rr[0]) + __uint_as_float(rr[1]); }
    return v;
}
__device__ __forceinline__ void norm_row(const float* xrow, const float* g, const float* sh, const float* sc, int lane, f32x4 (&v)[4]) {
    float s = 0.f;
#pragma unroll
    for (int j = 0; j < 4; ++j) { v[j] = *((const f32x4*)xrow + lane + 64 * j); s += (v[j].x * v[j].x + v[j].y * v[j].y) + (v[j].z * v[j].z + v[j].w * v[j].w); }
    const float rstd = 1.0f / sqrtf(wave_sum(s) * (1.f / D) + 1e-6f);
#pragma unroll
    for (int j = 0; j < 4; ++j) { const f32x4 gg = *((const f32x4*)g + lane + 64 * j);
        f32x4 a = {1.f, 1.f, 1.f, 1.f}, b = {0.f, 0.f, 0.f, 0.f}; if (sc) { a = *((const f32x4*)sc + lane + 64 * j) + 1.0f; b = *((const f32x4*)sh + lane + 64 * j); }
        v[j] = (v[j] * rstd * gg) * a + b; }
}
__device__ __forceinline__ void st_row_bf16(bf16* orow, int lane, const f32x4 (&v)[4]) {
#pragma unroll
    for (int j = 0; j < 4; ++j) { v2u w; w.x = pkbf(v[j].x, v[j].y); w.y = pkbf(v[j].z, v[j].w); *((v2u*)orow + lane + 64 * j) = w; }
}
__device__ __forceinline__ void p0_mod(Frame& F) {
    LAS float* ca = (LAS float*)F.lds; LAS float* red = (LAS float*)(F.lds + 8192);
    const float* cin = F.in[1];
    for (int i = F.tid; i < 2048; i += 512) { const float c = cin[i]; ca[i] = c / (1.0f + __expf(-c)); }
    __syncthreads();
    float* MOD = (float*)(F.ws + WS_MOD); float* MODKV = MOD + 4 * 2 * 6144;
    for (int item = F.bx; item < 208; item += F.G) {
        const int col = item * 128; const float* W; const float* bias; int ldw, cw; float* dst0; float* dst1;
        if (col < 24576) { const int l = col / 6144; cw = col % 6144; W = F.in[2] + (size_t)l * 1024 * 6144; ldw = 6144; bias = F.in[3] + l * 6144; dst0 = MOD + (l * 2 + 0) * 6144 + cw; dst1 = MOD + (l * 2 + 1) * 6144 + cw; }
        else { cw = col - 24576; W = F.in[30]; ldw = 2048; bias = F.in[31]; dst0 = MODKV + cw; dst1 = MODKV + 2048 + cw; }
        const int c4 = F.tid & 31, ks = F.tid >> 5;
        f32x4 a0 = {0.f, 0.f, 0.f, 0.f}, a1 = {0.f, 0.f, 0.f, 0.f};
#pragma unroll 8
        for (int k = ks * 64; k < ks * 64 + 64; ++k) { const f32x4 w = *(const f32x4*)(W + (size_t)k * ldw + cw + c4 * 4); a0 += w * ca[k]; a1 += w * ca[1024 + k]; }
        *(LAS f32x4*)(red + (ks * 32 + c4) * 8) = a0; *(LAS f32x4*)(red + (ks * 32 + c4) * 8 + 4) = a1;
        __syncthreads();
        if (F.tid < 256) { const int b = F.tid >> 7, c = F.tid & 127; float s = 0.f;
#pragma unroll
            for (int q = 0; q < 16; ++q) s += red[(q * 32 + (c >> 2)) * 8 + b * 4 + (c & 3)];
            (b ? dst1 : dst0)[c] = s + bias[cw + c]; }
        __syncthreads();
    }
}
__device__ __forceinline__ void p0_weights(Frame& F) {
    LAS float* scr = (LAS float*)(F.lds + 16384 + F.wave * 16384);
    const int gw = F.vcu * NWAVES + F.wave, NGW = F.G * NWAVES;
    bf16* W1 = (bf16*)(F.ws + WS_W1); bf16* WO = (bf16*)(F.ws + WS_WO); bf16* WKV = (bf16*)(F.ws + WS_WKV); bf16* WQG = (bf16*)(F.ws + WS_WQG); bf16* WO2 = (bf16*)(F.ws + WS_WO2);
    const float* mu = F.in[8];
    constexpr int PL = 512 * 3 + 32 + 32 + 16 + 80 + 512;
    constexpr int NIT = 2 * PL + 512 + 512 + 16 + 2 * (1024 + 512);
    for (int it = gw; it < NIT; it += NGW) {
        int r = it;
        if (r < 2 * PL) { const int i = r / PL; r -= i * PL; bf16* w1 = W1 + (size_t)i * N1 * K1; const float* m6 = mu + i * 6 * 1024;
            bf16* wl = w1 + (size_t)3072 * 1024;
            if (r < 512) { tr_item(F.in[9] + (size_t)i * D * D, D, D, w1, D, 0, 0, nullptr, scr, r, F.lane); continue; } r -= 512;
            if (r < 512) { tr_item(F.in[10] + (size_t)i * D * D, D, D, w1, D, 1024, 0, nullptr, scr, r, F.lane); continue; } r -= 512;
            if (r < 512) { tr_item(F.in[11] + (size_t)i * D * D, D, D, w1, D, 2048, 0, nullptr, scr, r, F.lane); continue; } r -= 512;
            if (r < 32) { tr_item(F.in[14] + (size_t)i * D * 64, 64, 64, wl, K1, 0, 0, m6 + 1 * 1024, scr, r, F.lane); continue; } r -= 32;
            if (r < 32) { tr_item(F.in[17] + (size_t)i * D * 64, 64, 64, wl, K1, 64, 0, m6 + 4 * 1024, scr, r, F.lane); continue; } r -= 32;
            if (r < 16) { if (i == 1) tr_item(F.in[27], 32, 32, wl, K1, 128, 0, m6 + 3 * 1024, scr, r, F.lane); continue; } r -= 16;
            if (r < 80) { tr_item(F.in[19] + (size_t)i * D * 160, 160, 160, wl, K1, 160, 0, m6 + 5 * 1024, scr, r, F.lane); continue; } r -= 80;
            tr_item(F.in[12] + (size_t)i * D * D, D, D, WO + (size_t)i * D * D, D, 0, 0, nullptr, scr, r, F.lane); continue; }
        r -= 2 * PL;
        if (r < 512) { tr_item(F.in[32], 2064, 1024, WKV, D, 0, 0, nullptr, scr, r, F.lane); continue; } r -= 512;
        if (r < 512) { tr_item(F.in[32] + 1024, 2064, 1024, WKV, D, 1024, 0, nullptr, scr, r, F.lane); continue; } r -= 512;
        if (r < 16) { tr_item(F.in[32] + 2048, 2064, 16, WKV, D, 2048, 0, nullptr, scr, r, F.lane); continue; } r -= 16;
        { const int j = r / 1536; r -= j * 1536;
          if (r < 1024) tr_item(F.in[35] + (size_t)j * D * 2048, 2048, 2048, WQG + (size_t)j * 2048 * D, D, 0, 0, nullptr, scr, r, F.lane);
          else tr_item(F.in[37] + (size_t)j * D * D, D, D, WO2 + (size_t)j * D * D, D, 0, 0, nullptr, scr, r - 1024, F.lane); }
    }
    const int gt = F.bx * 512 + F.tid, NT = F.G * 512; const v4u z = {0u, 0u, 0u, 0u};
    for (int e = gt; e < 135168; e += NT) {
        int r = e; bf16* p;
        if (r < 98304) { const int i = r / 49152; r -= i * 49152; p = W1 + (size_t)i * N1 * K1 + (size_t)3072 * 1024 + (size_t)320 * K1 + (size_t)r * 8; }
        else if (r < 98304 + 8192) { r -= 98304; p = W1 + (size_t)3072 * 1024 + (size_t)128 * K1 + (size_t)r * 8; }
        else { r -= 98304 + 8192; p = WKV + (size_t)2080 * D + (size_t)r * 8; }
        *(v4u*)p = z; }
    { float* B2 = (float*)(F.ws + WS_MOD) + 53248;
      for (int e = gt; e < 2 * 3072; e += NT) { const int i = e / 3072, n = e % 3072, grp = n >> 10, c = n & 1023;
          B2[e] = grp == 0 ? F.in[13][i * D + c] : (grp == 1 ? F.in[16][i * D + c] : (i == 1 ? F.in[26][c] : 0.f)); } }
    bf16* W2A = (bf16*)(F.ws + WS_W2A); bf16* W2G = (bf16*)(F.ws + WS_W2G);
    for (int e4 = gt; e4 < 2 * 262144; e4 += NT) {
        const int i = e4 >> 18; int r = (e4 & 262143) * 4;
        if (r < 786432) { const int k = r / 3072, n = r % 3072, grp = n >> 10, c = n & 1023; f32x4 v = {0.f, 0.f, 0.f, 0.f};
            if (grp == 0) { if (k < 64) v = *(const f32x4*)(F.in[15] + ((size_t)i * 64 + k) * 1024 + c); }
            else if (grp == 1) { if (k >= 64 && k < 128) v = *(const f32x4*)(F.in[18] + ((size_t)i * 64 + (k - 64)) * 1024 + c); }
            else { if (i == 1 && k >= 128 && k < 160) v = *(const f32x4*)(F.in[28] + (size_t)(k - 128) * 1024 + c); }
            bf16* o = W2A + (size_t)i * 3072 * 256 + (size_t)n * 256 + k; const unsigned p0 = pkbf(v.x, v.y), p1 = pkbf(v.z, v.w);
            o[0] = (bf16)(p0 & 0xffffu); o[256] = (bf16)(p0 >> 16); o[512] = (bf16)(p1 & 0xffffu); o[768] = (bf16)(p1 >> 16); }
        else { r -= 786432; const int k = r >> 10, n = r & 1023; f32x4 v = {0.f, 0.f, 0.f, 0.f}; if (k < 160) v = *(const f32x4*)(F.in[20] + ((size_t)i * 160 + k) * 1024 + n);
            bf16* o = W2G + (size_t)i * 1024 * 256 + (size_t)n * 256 + k; const unsigned p0 = pkbf(v.x, v.y), p1 = pkbf(v.z, v.w);
            o[0] = (bf16)(p0 & 0xffffu); o[256] = (bf16)(p0 >> 16); o[512] = (bf16)(p1 & 0xffffu); o[768] = (bf16)(p1 >> 16); }
    }
}
__device__ __forceinline__ void mlp_weights(Frame& F, int L) {
    LAS float* scr = (LAS float*)(F.lds + F.wave * 16384);
    const int gw = F.vcu * NWAVES + F.wave, NGW = F.G * NWAVES;
    bf16* WUP = (bf16*)(F.ws + WS_WUP); bf16* WDN = (bf16*)(F.ws + WS_WDN);
    for (int it = gw; it < 4096; it += NGW) {
        if (it < 2048) tr_item(F.in[6] + (size_t)L * D * FF, FF, FF, WUP, D, 0, 0, nullptr, scr, it, F.lane);
        else tr_item(F.in[7] + (size_t)L * FF * D, D, D, WDN, FF, 0, 0, nullptr, scr, it - 2048, F.lane);
    }
}
__device__ __forceinline__ void norm_phase(Frame& F, const float* xin, const float* g, const float* sh, const float* sc, int bstride, int mode, bf16* dst, float* outf = nullptr) {
    const int gw = F.vcu * NWAVES + F.wave, NGW = F.G * NWAVES, lane = F.lane; (void)mode;
    for (int base = gw * 8; base < M; base += NGW * 8) {
        const int b = base >> 13;
        f32x4 gg[4], aa[4], bb[4];
#pragma unroll
        for (int j = 0; j < 4; ++j) { gg[j] = *((const f32x4*)g + lane + 64 * j);
            aa[j] = sc ? *((const f32x4*)(sc + b * bstride) + lane + 64 * j) + 1.0f : (f32x4){1.f, 1.f, 1.f, 1.f}; bb[j] = sh ? *((const f32x4*)(sh + b * bstride) + lane + 64 * j) : (f32x4){0.f, 0.f, 0.f, 0.f}; }
        f32x4 xn[4];
#pragma unroll
        for (int j = 0; j < 4; ++j) xn[j] = *((const f32x4*)(xin + (size_t)base * D) + lane + 64 * j);
#pragma unroll 1
        for (int r = 0; r < 8; ++r) { const int m = base + r; f32x4 v[4]; float s = 0.f;
#pragma unroll
            for (int j = 0; j < 4; ++j) { v[j] = xn[j]; s += (v[j].x * v[j].x + v[j].y * v[j].y) + (v[j].z * v[j].z + v[j].w * v[j].w); }
            if (r + 1 < 8) {
#pragma unroll
                for (int j = 0; j < 4; ++j) xn[j] = *((const f32x4*)(xin + (size_t)(m + 1) * D) + lane + 64 * j); }
            const float rstd = 1.0f / sqrtf(wave_sum(s) * (1.f / D) + 1e-6f);
#pragma unroll
            for (int j = 0; j < 4; ++j) v[j] = (v[j] * rstd * gg[j]) * aa[j] + bb[j];
            if (outf) {
#pragma unroll
                for (int j = 0; j < 4; ++j) *((f32x4*)(outf + (size_t)m * D) + lane + 64 * j) = v[j]; }
            else st_row_bf16(dst + (size_t)m * 1024, lane, v);
        }
    }
}
__device__ __forceinline__ void norm_mix_phase(Frame& F, const float* xin, const float* g, const float* sh, const float* sc, const float* mu, bf16* H2p, bf16* XJ) {
    const int gw = F.vcu * NWAVES + F.wave, NGW = F.G * NWAVES, lane = F.lane;
    for (int base = gw * 8; base < M; base += NGW * 8) {
        const int b = base >> 13;
        f32x4 gg[4], aa[4], bb[4], m0[4], m1[4], m2[4];
#pragma unroll
        for (int j = 0; j < 4; ++j) { gg[j] = *((const f32x4*)g + lane + 64 * j); aa[j] = *((const f32x4*)(sc + b * 6144) + lane + 64 * j) + 1.0f; bb[j] = *((const f32x4*)(sh + b * 6144) + lane + 64 * j);
            m0[j] = *((const f32x4*)mu + lane + 64 * j); m1[j] = *((const f32x4*)(mu + 2048) + lane + 64 * j); m2[j] = *((const f32x4*)(mu + 3072) + lane + 64 * j); }
        const bool first = (base & 8191) == 0; const int r0 = first ? 0 : -1;
        f32x4 hp[4], xn[4];
#pragma unroll
        for (int j = 0; j < 4; ++j) { hp[j] = (f32x4){0.f, 0.f, 0.f, 0.f}; xn[j] = *((const f32x4*)(xin + (size_t)(base + r0) * D) + lane + 64 * j); }
#pragma unroll 1
        for (int r = r0; r < 8; ++r) { const int m = base + r; f32x4 v[4];
            float s = 0.f;
#pragma unroll
            for (int j = 0; j < 4; ++j) { v[j] = xn[j]; s += (v[j].x * v[j].x + v[j].y * v[j].y) + (v[j].z * v[j].z + v[j].w * v[j].w); }
            if (r + 1 < 8) {
#pragma unroll
                for (int j = 0; j < 4; ++j) xn[j] = *((const f32x4*)(xin + (size_t)(m + 1) * D) + lane + 64 * j); }
            const float rstd = 1.0f / sqrtf(wave_sum(s) * (1.f / D) + 1e-6f);
#pragma unroll
            for (int j = 0; j < 4; ++j) v[j] = (v[j] * rstd * gg[j]) * aa[j] + bb[j];
            if (r >= 0) {
                st_row_bf16(H2p + (size_t)m * 2048, lane, v); st_row_bf16(H2p + (size_t)m * 2048 + 1024, lane, hp);
                f32x4 x[4];
#pragma unroll
                for (int j = 0; j < 4; ++j) x[j] = v[j] + (hp[j] - v[j]) * m0[j];
                st_row_bf16(XJ + (size_t)m * D, lane, x);
#pragma unroll
                for (int j = 0; j < 4; ++j) x[j] = v[j] + (hp[j] - v[j]) * m1[j];
                st_row_bf16(XJ + (size_t)M * D + (size_t)m * D, lane, x);
#pragma unroll
                for (int j = 0; j < 4; ++j) x[j] = v[j] + (hp[j] - v[j]) * m2[j];
                st_row_bf16(XJ + (size_t)2 * M * D + (size_t)m * D, lane, x);
            }
#pragma unroll
            for (int j = 0; j < 4; ++j) hp[j] = v[j]; }
    }
}
__device__ __forceinline__ void final_norm_phase(Frame& F) { norm_phase(F, F.out, F.in[38], nullptr, nullptr, 0, 1, nullptr, F.out); }
#ifndef PROBE_SC
#define PROBE_SC 0
#endif
constexpr int SC_C = 32, SC_NC = T / SC_C;
constexpr int SC_VEC = 0, SC_SCAL = 36864, SC_V = 37120, SC_Y = 38144, SC_BUF = 54528;
typedef float f32x2s __attribute__((ext_vector_type(2)));
__device__ __forceinline__ float dot4(const f32x4 s, const f32x4 a) { f32x2s t = (f32x2s){s.x, s.y} * (f32x2s){a.x, a.y}; t = (f32x2s){s.z, s.w} * (f32x2s){a.z, a.w} + t; return t.x + t.y; }
__device__ __forceinline__ void scan_chunk(const LAS unsigned char* Bc, f32x4& S, const int kq, const int rowi) {
                const LAS f32x4* pvec = (const LAS f32x4*)(Bc + SC_VEC) + kq; const LAS f32x4* psc = (const LAS f32x4*)(Bc + SC_SCAL);
                const LAS float* pv = (const LAS float*)(Bc + SC_V) + rowi; LAS float* py = (LAS float*)(Bc + SC_Y) + rowi * 16 + kq;
                f32x4 cv[9], cs; float c0, c1;
#pragma unroll
                for (int j = 0; j < 9; ++j) cv[j] = pvec[j * 16];
                cs = psc[0]; c0 = pv[0]; c1 = pv[8];
#pragma unroll
                for (int p = 0; p < SC_C / 2; ++p) {
                    f32x4 nv[9], ns; float n0, n1;
                    if (p + 1 < SC_C / 2) {
#pragma unroll
                        for (int j = 0; j < 9; ++j) nv[j] = pvec[((p + 1) * 9 + j) * 16];
                        ns = psc[p + 1]; n0 = pv[(2 * p + 2) * 8]; n1 = pv[(2 * p + 3) * 8];
                    }
                    __builtin_amdgcn_sched_barrier(0);
                    float p1 = dot4(S, cv[0]), p2 = dot4(S, cv[1]); const float p3 = dot4(S, cv[2]);
                    p1 += dpp_f(p1, 0); p2 += dpp_f(p2, 0);
                    p1 += dpp_f(p1, 1); p2 += dpp_f(p2, 1);
                    p1 += dpp_f(p1, 2); p2 += dpp_f(p2, 2);
                    p1 += dpp_f(p1, 3); p2 += dpp_f(p2, 3);
                    const float sa1 = fmaf(c0, cs.w, p2);
                    const float y0 = p3 + ((kq == 0) ? c0 * cs.y : 0.f);
                    const f32x4 t0 = S * cv[3] + cv[4] * p1 + cv[5] * c0 + cv[7] * c1;
                    S = t0 + cv[6] * sa1;
                    const float y1 = dot4(S, cv[8]);
                    py[(2 * p) * 128] = y0; py[(2 * p + 1) * 128] = y1;
                    if (p + 1 < SC_C / 2) {
#pragma unroll
                        for (int j = 0; j < 9; ++j) cv[j] = nv[j];
                        cs = ns; c0 = n0; c1 = n1;
                    }
                }
}
__device__ __forceinline__ void scan_phase(Frame& F, int L) {
    const bf16* P1 = (const bf16*)(F.ws + WS_P1); const bf16* P2 = (const bf16*)(F.ws + WS_P2); const bf16* VF = (const bf16*)(F.ws + WS_VF); float* Y = (float*)(F.ws + WS_H2);
    const float* kkw = F.in[21] + L * D; const float* kaw = F.in[22] + L * D;
    const int lane = F.lane;
    int wave;
    { LAS unsigned* tb = (LAS unsigned*)(F.lds + LDS_BYTES - 2048);
      const unsigned simd = ((unsigned)__builtin_amdgcn_s_getreg((1 << 11) | (4 << 6) | 4)) & 3u;
      if (lane == 0) tb[F.wave] = simd;
      __syncthreads();
      unsigned sd[8];
#pragma unroll
      for (int w = 0; w < 8; ++w) sd[w] = tb[w];
      int B = 1;
#pragma unroll
      for (int w = 7; w >= 1; --w) if (sd[w] != sd[0]) B = w;
      int total_non = 0, non_before = 0, share_before = 0; bool my_share = false;
#pragma unroll
      for (int w = 1; w < 8; ++w) { const bool sh = (sd[w] == sd[0]) || (sd[w] == sd[B]); const bool other = (w != B);
          if (other && !sh) { ++total_non; if (w < F.wave) ++non_before; }
          if (other && sh && w < F.wave) ++share_before;
          if (w == F.wave) my_share = sh; }
      int role;
      if (F.wave == 0) role = 0; else if (F.wave == B) role = 1; else role = my_share ? (2 + total_non + share_before) : (2 + non_before);
      wave = __builtin_amdgcn_readfirstlane(role);
      __syncthreads(); }
    for (int item = F.bx; item < 256; item += F.G) {
        const int bh = (item & 7) + 8 * (item >> 6), rg = (item >> 3) & 7, b = bh >> 4, h = bh & 15;
        const size_t m0 = (size_t)b * T;
        const int hidx = (wave - 2) * 64 + lane, hp = (hidx >> 4) & 15, hc4 = hidx & 15;
        const int vtt = lane >> 1, vr4 = (lane & 1) * 4;
        float ckk[4], cka[4];
        v2u lr[2][2], lk[2][2], lw[2][2], la[2][2]; v2u lv[2], lvm[2], lvf[2];
#pragma unroll
        for (int q = 0; q < 2; ++q) { lv[q] = (v2u){0u,0u}; lvm[q] = (v2u){0u,0u}; lvf[q] = (v2u){0u,0u};
#pragma unroll
            for (int u = 0; u < 2; ++u) { lr[q][u] = (v2u){0u,0u}; lk[q][u] = (v2u){0u,0u}; lw[q][u] = (v2u){0u,0u}; la[q][u] = (v2u){0u,0u}; } }
        if (wave >= 2 && wave < 6) {
#pragma unroll
            for (int j = 0; j < 4; ++j) { ckk[j] = kkw[h * 64 + hc4 * 4 + j]; cka[j] = kaw[h * 64 + hc4 * 4 + j]; } }
#define SC_LOAD(c, Q) do { \
        if (wave >= 2 && wave < 6) { _Pragma("unroll") for (int u = 0; u < 2; ++u) { const size_t m = m0 + (size_t)(c) * SC_C + 2 * hp + u; const bf16* p1 = P1 + m * N1 + h * 64 + hc4 * 4; const bf16* p2 = P2 + m * NP2 + h * 64 + hc4 * 4; \
            lr[Q][u] = *(const v2u*)p1; lk[Q][u] = *(const v2u*)(p1 + 1024); lw[Q][u] = *(const v2u*)p2; la[Q][u] = *(const v2u*)(p2 + 1024); } } \
        else if (wave == 6) { const size_t m = m0 + (size_t)(c) * SC_C + vtt; const int cc = h * 64 + rg * 8 + vr4; \
            lv[Q] = *(const v2u*)(P1 + m * N1 + 2048 + cc); if (L == 1) { lvm[Q] = *(const v2u*)(P2 + m * NP2 + 2048 + cc); lvf[Q] = *(const v2u*)(VF + m * D + cc); } } } while (0)
#define SC_PREP(buf, Q) do { LAS unsigned char* B_ = F.lds + (buf) * SC_BUF; \
        if (wave >= 2 && wave < 6) { f32x4 an[2], bb[2], k2[2], ww[2], rr[2]; \
            _Pragma("unroll") for (int u = 0; u < 2; ++u) { \
                const float kr[4] = {bflo(lk[Q][u].x), bfhi(lk[Q][u].x), bflo(lk[Q][u].y), bfhi(lk[Q][u].y)}, av[4] = {bflo(la[Q][u].x), bfhi(la[Q][u].x), bflo(la[Q][u].y), bfhi(la[Q][u].y)}; \
                const float wn[4] = {bflo(lw[Q][u].x), bfhi(lw[Q][u].x), bflo(lw[Q][u].y), bfhi(lw[Q][u].y)}, rv[4] = {bflo(lr[Q][u].x), bfhi(lr[Q][u].x), bflo(lr[Q][u].y), bfhi(lr[Q][u].y)}; \
                float kv_[4], ss = 0.f; \
                _Pragma("unroll") for (int j = 0; j < 4; ++j) { kv_[j] = kr[j] * ckk[j]; ss += kv_[j] * kv_[j]; } \
                ss = sum16(ss); const float inv = 1.0f / fmaxf(sqrtf(ss), 1e-12f); \
                _Pragma("unroll") for (int j = 0; j < 4; ++j) { const float kk = kv_[j] * inv; an[u][j] = -kk; bb[u][j] = kk * av[j]; k2[u][j] = kr[j] * (1.0f + (av[j] - 1.0f) * cka[j]); ww[u][j] = __expf(wn[j]); rr[u][j] = rv[j]; } } \
            LAS f32x4* V_ = (LAS f32x4*)(B_ + SC_VEC) + (hp * 9) * 16 + hc4; \
            float s0 = dot4(bb[0], rr[0]), s1 = dot4(k2[0], rr[0]), s2 = dot4(bb[0], an[1]), s3 = dot4(k2[0], an[1]); \
            s0 = sum16(s0); s1 = sum16(s1); s2 = sum16(s2); s3 = sum16(s3); \
            V_[0 * 16] = an[0]; V_[1 * 16] = ww[0] * an[1] + an[0] * s2; V_[2 * 16] = ww[0] * rr[0] + an[0] * s0; V_[3 * 16] = ww[0] * ww[1]; V_[4 * 16] = bb[0] * ww[1]; V_[5 * 16] = k2[0] * ww[1]; V_[6 * 16] = bb[1]; V_[7 * 16] = k2[1]; V_[8 * 16] = rr[1]; \
            if (hc4 == 0) *(LAS f32x4*)(B_ + SC_SCAL + hp * 16) = (f32x4){s0, s1, s2, s3}; } \
        else if (wave == 6) { float v_[4] = {bflo(lv[Q].x), bfhi(lv[Q].x), bflo(lv[Q].y), bfhi(lv[Q].y)}; \
            if (L == 1) { const float f_[4] = {bflo(lvf[Q].x), bfhi(lvf[Q].x), bflo(lvf[Q].y), bfhi(lvf[Q].y)}, g_[4] = {bflo(lvm[Q].x), bfhi(lvm[Q].x), bflo(lvm[Q].y), bfhi(lvm[Q].y)}; \
                _Pragma("unroll") for (int j = 0; j < 4; ++j) v_[j] = v_[j] + (f_[j] - v_[j]) * g_[j]; } \
            *(LAS f32x4*)(B_ + SC_V + (vtt * 8 + vr4) * 4) = (f32x4){v_[0], v_[1], v_[2], v_[3]}; } } while (0)
#define SC_YRED(bufi) f32x4 yv; do { const LAS f32x4* q_ = (const LAS f32x4*)(F.lds + (bufi) * SC_BUF + SC_Y) + (vtt * 8 + vr4) * 4; \
            _Pragma("unroll") for (int r_ = 0; r_ < 4; ++r_) { const f32x4 t0 = q_[r_ * 4], t1 = q_[r_ * 4 + 1], t2 = q_[r_ * 4 + 2], t3 = q_[r_ * 4 + 3]; const f32x4 t = (t0 + t1) + (t2 + t3); yv[r_] = (t.x + t.y) + (t.z + t.w); } } while (0)
        SC_LOAD(0, 0); SC_PREP(0, 0); SC_LOAD(1, 1);
        __syncthreads();
        f32x4 S = {0.f, 0.f, 0.f, 0.f};
        const int rl = lane >> 4, kq = lane & 15, rowi = (wave & 1) * 4 + rl;
#define SC_ITER(c, QL, QP) do { const int buf = (c) & 1; \
            if (wave < 2) { if (PROBE_SC == 2) { f32x4 S2 = S; scan_chunk(F.lds + buf * SC_BUF, S2, kq, rowi); asm volatile("" :: "v"(S2) : "memory"); } scan_chunk(F.lds + buf * SC_BUF, S, kq, rowi); } \
            else { if ((c) + 2 < SC_NC) SC_LOAD((c) + 2, QL); \
                if ((c) + 1 < SC_NC) SC_PREP(buf ^ 1, QP); \
                if (PROBE_SC == 1 && (c) + 1 < SC_NC) { asm volatile("" ::: "memory"); SC_PREP(buf ^ 1, QP); } \
                if (wave == 7 && (c) > 0) { SC_YRED(buf ^ 1); *(f32x4*)(Y + (m0 + (size_t)((c) - 1) * SC_C + vtt) * D + h * 64 + rg * 8 + vr4) = yv; } } \
            asm volatile("s_waitcnt lgkmcnt(0)\n\ts_barrier" ::: "memory"); } while (0)
        for (int c = 0; c < SC_NC; c += 2) { SC_ITER(c, 0, 1); SC_ITER(c + 1, 1, 0); }
#undef SC_ITER
        if (wave == 7) { SC_YRED((SC_NC - 1) & 1);
            *(f32x4*)(Y + (m0 + (size_t)(SC_NC - 1) * SC_C + vtt) * D + h * 64 + rg * 8 + vr4) = yv; }
        __syncthreads();
#undef SC_LOAD
#undef SC_PREP
#undef SC_YRED
    }
}
__device__ __forceinline__ void post_phase(Frame& F, int L) {
    const bf16* P1 = (const bf16*)(F.ws + WS_P1); const bf16* P2 = (const bf16*)(F.ws + WS_P2); bf16* VF = (bf16*)(F.ws + WS_VF); float* Y = (float*)(F.ws + WS_H2);
    const int gw = F.vcu * NWAVES + F.wave, NGW = F.G * NWAVES, lane = F.lane, c0 = lane * 16;
    const float* kaw = F.in[22] + L * D + c0; const float* rkw = F.in[23] + L * D + c0; const float* lnw = F.in[24] + L * D + c0; const float* lnb = F.in[25] + L * D + c0;
    for (int m = gw; m < M; m += NGW) {
        float y[16], r[16], k[16], v[16], a[16];
        const float* yp = Y + (size_t)m * D + c0;
#pragma unroll
        for (int q = 0; q < 4; ++q) { const f32x4 t = *(const f32x4*)(yp + 4 * q); y[4 * q] = t.x; y[4 * q + 1] = t.y; y[4 * q + 2] = t.z; y[4 * q + 3] = t.w; }
        const bf16* p1 = P1 + (size_t)m * N1 + c0; const bf16* p2 = P2 + (size_t)m * NP2 + c0;
        v4u rv[2], kv[2], vv[2], av[2];
#pragma unroll
        for (int q = 0; q < 2; ++q) { rv[q] = *(const v4u*)(p1 + 8 * q); kv[q] = *(const v4u*)(p1 + 1024 + 8 * q); vv[q] = *(const v4u*)(p1 + 2048 + 8 * q); av[q] = *(const v4u*)(p2 + 1024 + 8 * q); }
#pragma unroll
        for (int q = 0; q < 2; ++q)
#pragma unroll
            for (int j = 0; j < 4; ++j) { r[8 * q + 2 * j] = bflo(rv[q][j]); r[8 * q + 2 * j + 1] = bfhi(rv[q][j]); k[8 * q + 2 * j] = bflo(kv[q][j]); k[8 * q + 2 * j + 1] = bfhi(kv[q][j]);
                v[8 * q + 2 * j] = bflo(vv[q][j]); v[8 * q + 2 * j + 1] = bfhi(vv[q][j]); a[8 * q + 2 * j] = bflo(av[q][j]); a[8 * q + 2 * j + 1] = bfhi(av[q][j]); }
        if (L == 0) { *(v4u*)(VF + (size_t)m * D + c0) = vv[0]; *(v4u*)(VF + (size_t)m * D + c0 + 8) = vv[1]; }
        else { v4u fv[2], gv[2];
#pragma unroll
            for (int q = 0; q < 2; ++q) { fv[q] = *(const v4u*)(VF + (size_t)m * D + c0 + 8 * q); gv[q] = *(const v4u*)(p2 + 2048 + 8 * q); }
#pragma unroll
            for (int q = 0; q < 2; ++q)
#pragma unroll
                for (int j = 0; j < 4; ++j) { const float f0 = bflo(fv[q][j]), f1 = bfhi(fv[q][j]), g0 = bflo(gv[q][j]), g1 = bfhi(gv[q][j]);
                    v[8 * q + 2 * j] += (f0 - v[8 * q + 2 * j]) * g0; v[8 * q + 2 * j + 1] += (f1 - v[8 * q + 2 * j + 1]) * g1; } }
        float s = 0.f, bd = 0.f;
#pragma unroll
        for (int j = 0; j < 16; ++j) { s += y[j]; const float k2 = k[j] * (1.0f + (a[j] - 1.0f) * kaw[j]); bd += r[j] * k2 * rkw[j]; }
        s = sum4(s); bd = sum4(bd);
        const float mean = s * (1.0f / 64.0f); float q2 = 0.f;
#pragma unroll
        for (int j = 0; j < 16; ++j) { const float d = y[j] - mean; q2 += d * d; }
        q2 = sum4(q2);
        const float rstd = 1.0f / sqrtf(q2 * (1.0f / 64.0f) + 64e-5f);
        float o[16];
#pragma unroll
        for (int j = 0; j < 16; ++j) o[j] = (y[j] - mean) * rstd * lnw[j] + lnb[j] + bd * v[j];
        bf16* yn = (bf16*)(Y + (size_t)m * D) + c0;
        v4u w0, w1; w0.x = pkbf(o[0], o[1]); w0.y = pkbf(o[2], o[3]); w0.z = pkbf(o[4], o[5]); w0.w = pkbf(o[6], o[7]); w1.x = pkbf(o[8], o[9]); w1.y = pkbf(o[10], o[11]); w1.z = pkbf(o[12], o[13]); w1.w = pkbf(o[14], o[15]);
        *(v4u*)yn = w0; *(v4u*)(yn + 8) = w1;
    }
}
__device__ __forceinline__ void kvpost_phase(Frame& F) {
    const bf16* KV = (const bf16*)(F.ws + WS_KVRAW); bf16* KS = (bf16*)(F.ws + WS_KS); bf16* VS = (bf16*)(F.ws + WS_VS);
    const int gw = F.vcu * NWAVES + F.wave, NGW = F.G * NWAVES, lane = F.lane, c0 = lane * 16;
    const float* kg = F.in[34] + (c0 & 63);
    for (int m = gw; m < M; m += NGW) {
        const bf16* p = KV + (size_t)m * 2048 + c0; v4u kv[2], vv[2];
#pragma unroll
        for (int q = 0; q < 2; ++q) { kv[q] = *(const v4u*)(p + 8 * q); vv[q] = *(const v4u*)(p + 1024 + 8 * q); }
        float k[16], ss = 0.f;
#pragma unroll
        for (int q = 0; q < 2; ++q)
#pragma unroll
            for (int j = 0; j < 4; ++j) { k[8 * q + 2 * j] = bflo(kv[q][j]); k[8 * q + 2 * j + 1] = bfhi(kv[q][j]); }
#pragma unroll
        for (int j = 0; j < 16; ++j) ss += k[j] * k[j];
        ss = sum4(ss); const float rs = 1.0f / sqrtf(ss * (1.0f / 64.0f) + 1e-6f);
        v4u w0, w1;
        w0.x = pkbf(k[0] * rs * kg[0], k[1] * rs * kg[1]); w0.y = pkbf(k[2] * rs * kg[2], k[3] * rs * kg[3]); w0.z = pkbf(k[4] * rs * kg[4], k[5] * rs * kg[5]); w0.w = pkbf(k[6] * rs * kg[6], k[7] * rs * kg[7]);
        w1.x = pkbf(k[8] * rs * kg[8], k[9] * rs * kg[9]); w1.y = pkbf(k[10] * rs * kg[10], k[11] * rs * kg[11]); w1.z = pkbf(k[12] * rs * kg[12], k[13] * rs * kg[13]); w1.w = pkbf(k[14] * rs * kg[14], k[15] * rs * kg[15]);
        *(v4u*)(KS + (size_t)m * D + c0) = w0; *(v4u*)(KS + (size_t)m * D + c0 + 8) = w1;
        *(v4u*)(VS + (size_t)m * D + c0) = vv[0]; *(v4u*)(VS + (size_t)m * D + c0 + 8) = vv[1];
    }
    if (gw < 32) {
        const int bh = gw, b = bh >> 4, h = bh & 15; const float* FL = (const float*)(F.ws + WS_FL) + ((size_t)b * T + (size_t)lane * 128) * 16 + h; const float fb = F.in[33][h];
        v4u* G3 = (v4u*)(F.ws + WS_G3) + (size_t)bh * T + (size_t)lane * 128;
        float tot = 0.f;
#pragma unroll 8
        for (int i = 0; i < 128; ++i) { const float x = FL[(size_t)i * 16] + fb; tot += -(fmaxf(-x, 0.f) + log1pf(__expf(-fabsf(x)))); }
        float inc = tot;
#pragma unroll
        for (int o = 1; o < 64; o <<= 1) { const float n = __int_as_float(__builtin_amdgcn_ds_bpermute((lane - o) << 2, __float_as_int(inc))); if (lane >= o) inc += n; }
        float run = inc - tot;
#pragma unroll 8
        for (int i = 0; i < 128; ++i) { const float x = FL[(size_t)i * 16] + fb; run += -(fmaxf(-x, 0.f) + log1pf(__expf(-fabsf(x))));
            const float gv = -run * 1.4426950408889634f;
            const unsigned hi = pkbf(gv, 0.f) & 0xffffu; const float r1 = gv - __uint_as_float(hi << 16);
            const unsigned mid = pkbf(r1, 0.f) & 0xffffu; const float r2 = r1 - __uint_as_float(mid << 16);
            const unsigned lo = pkbf(r2, 0.f) & 0xffffu;
            G3[i] = (v4u){hi | (mid << 16), lo, 0u, 0u}; }
    }
}
constexpr size_t WS_BAR = 512 * 1024, BAR_BYTES = 16384; constexpr int MISC_OFF = LDS_BYTES - 1024;
#define RLX_AGENT __ATOMIC_RELAXED, __HIP_MEMORY_SCOPE_AGENT
#define LDS_WAIT() asm volatile("s_waitcnt lgkmcnt(0)" ::: "memory")
#define VM_WAIT() asm volatile("s_waitcnt vmcnt(0)" ::: "memory")
__device__ __forceinline__ unsigned long long rt() { return __builtin_amdgcn_s_memrealtime(); }
__device__ __forceinline__ unsigned f2bf(float f) { unsigned u = __builtin_bit_cast(unsigned, f); return (u + 0x7fffu + ((u >> 16) & 1u)) >> 16; }
__device__ __forceinline__ unsigned pk2(float lo, float hi) { return f2bf(lo) | (f2bf(hi) << 16); }

#define XB_TMO      128
#define XB_XCNT(j)  (256  + 64 * (j))
#define XB_XSUB(j)  (1280 + 64 * (j))
#define XB_XGEN(j)  (2304 + 64 * (j))
#define XB_TOP      3328
#define XB_TOPGEN   3392
#define XCD_BAR_WORDS 3456
#define XB_SPIN_CAP (1u << 18)

__device__ __forceinline__ unsigned xb_ld(unsigned* p)              { return __hip_atomic_load(p, __ATOMIC_RELAXED, __HIP_MEMORY_SCOPE_AGENT); }
__device__ __forceinline__ unsigned xb_add(unsigned* p, unsigned v) { return __hip_atomic_fetch_add(p, v, __ATOMIC_RELAXED, __HIP_MEMORY_SCOPE_AGENT); }
__device__ __forceinline__ unsigned xb_xcc_id() { return (unsigned)__builtin_amdgcn_s_getreg((3 << 11) | 20) & 0xFu; }
#define XB_SPIN(cond, bar) do { unsigned _sp = 0; while (cond) { __builtin_amdgcn_s_sleep(1); \
    if ((++_sp & 255u) == 0u) { if (xb_ld(&(bar)[XB_TMO])) break; if (_sp > XB_SPIN_CAP) { atomicAdd(&(bar)[XB_TMO], 1u); break; } } } } while (0)

struct XcdBarrier {
    unsigned* bar; unsigned x;
    volatile LAS unsigned* st;
};

__device__ __forceinline__ XcdBarrier xcd_barrier_post(unsigned* bar, volatile LAS unsigned* st, const int tid) {
    XcdBarrier b; b.bar = bar; b.x = xb_xcc_id(); b.st = st;
    if (tid == 0) (void)xb_add(&bar[XB_XCNT(b.x)], 1u);
    return b;
}
__device__ __forceinline__ void xcd_barrier_complete(unsigned* bar, unsigned x, unsigned& nloc, unsigned& nx) {
    const unsigned G = gridDim.x * gridDim.y * gridDim.z;
    unsigned sum, cnt, mine, sp = 0u;
    for (;;) {
        sum = 0u; cnt = 0u; mine = 0u;
#pragma unroll
        for (unsigned j = 0; j < 16; ++j) { const unsigned c = xb_ld(&bar[XB_XCNT(j)]); sum += c; cnt += (c > 0u) ? 1u : 0u; mine = (j == x) ? c : mine; }
        if (sum == G) break;
        __builtin_amdgcn_s_sleep(1);
        if ((++sp & 255u) == 0u) { if (xb_ld(&bar[XB_TMO])) break; if (sp > XB_SPIN_CAP) { atomicAdd(&bar[XB_TMO], 1u); break; } }
    }
    nloc = mine > 0u ? mine : 1u; nx = cnt > 0u ? cnt : 1u;
}

__device__ __forceinline__ void xcd_barrier(const XcdBarrier& b, const int tid) {
    asm volatile("s_waitcnt vmcnt(0)" ::: "memory");
    __syncthreads();
    if (tid == 0) {
        unsigned* bar = b.bar;
        __builtin_amdgcn_s_waitcnt(0);
        unsigned nloc = b.st[0], nx = b.st[1];
        if (nloc == 0u) { xcd_barrier_complete(bar, b.x, nloc, nx); b.st[0] = nloc; b.st[1] = nx; }
        const unsigned old = xb_add(&bar[XB_XSUB(b.x)], 1u);
        const unsigned gen = old / nloc;
        if (old + 1u == (gen + 1u) * nloc) {
            __builtin_amdgcn_fence(__ATOMIC_RELEASE, "agent");
            asm volatile("s_waitcnt vmcnt(0)" ::: "memory");
            const unsigned og = xb_add(&bar[XB_TOP], 1u);
            const unsigned tg = og / nx;
            if (og + 1u == (tg + 1u) * nx) xb_add(&bar[XB_TOPGEN], 1u);
            else XB_SPIN(xb_ld(&bar[XB_TOPGEN]) == tg, bar);
            __builtin_amdgcn_fence(__ATOMIC_ACQUIRE, "agent");
            xb_add(&bar[XB_XGEN(b.x)], 1u);
            asm volatile("s_waitcnt vmcnt(0)" ::: "memory");
        } else {
            XB_SPIN(xb_ld(&bar[XB_XGEN(b.x)]) == gen, bar);
            __builtin_amdgcn_fence(__ATOMIC_ACQUIRE, "agent");
            asm volatile("s_waitcnt vmcnt(0)" ::: "memory");
        }
    }
    __syncthreads();
}
#define GEMM_CALL(FN, Aptr, Bptr, Nn, Kk, LDA, LDB, ...) GEMM_CALL_G(FN, Aptr, Bptr, Nn, Kk, LDA, LDB, 0, 0, __VA_ARGS__)
#define GEMM_CALL_G(FN, Aptr, Bptr, Nn, Kk, LDA, LDB, AGRP, ASTEP, ...) GEMM_CALL_S(StaticOrder, FN, Aptr, Bptr, Nn, Kk, LDA, LDB, AGRP, ASTEP, __VA_ARGS__)
#define GEMM_CALL_S(ORD, FN, Aptr, Bptr, Nn, Kk, LDA, LDB, AGRP, ASTEP, ...) do { pg8::Gemm g_{(const pg8::bf16_t*)(Aptr), (const pg8::bf16_t*)(Bptr), M, (Nn), (Kk), (LDA), (LDB), (AGRP), (size_t)(ASTEP)}; pg8::ORD S_; S_.init(M, (Nn), F.G, F.bx); \
    pg8::Epi8<pg8::FN> E_{{__VA_ARGS__}}; pg8::gemm_phase<pg8::Epi8<pg8::FN>, pg8::ORD, true, true>(F.lds, g_, S_, E_, F.tid); } while (0)
constexpr int N_PHASES = 42;
__global__ void __launch_bounds__(NWAVES * 64, 2) yoco_fwd(Args args) {
    extern __shared__ __attribute__((aligned(16))) unsigned char lds[];
    cg::grid_group grid = cg::this_grid();
    Frame F;
    const int wave_s = __builtin_amdgcn_readfirstlane((int)threadIdx.x >> 6);
    F.lds = (LAS unsigned char*)lds; F.tid = threadIdx.x; F.lane = F.tid & 63; F.wave = wave_s;
    F.G = gridDim.x; F.bx = blockIdx.x; F.vcu = F.bx;
    F.ws = args.ws; F.out = args.out; F.in = args.in;
    unsigned char* ws = args.ws;
    const int lo = args.ph_lo, hi = args.ph_hi; const bool one = (hi - lo) > 1;
#define LAUNDER() do { int t_ = wave_s * 64 + (int)__builtin_amdgcn_mbcnt_hi(~0u, __builtin_amdgcn_mbcnt_lo(~0u, 0u)); asm volatile("" : "+v"(t_)); F.tid = t_; F.lane = t_ & 63; F.wave = __builtin_amdgcn_readfirstlane(t_ >> 6); \
        int z_ = 0; asm volatile("" : "+v"(z_)); z_ = __builtin_amdgcn_readfirstlane(z_); ws = args.ws + z_; F.ws = ws; F.in = args.in + z_; F.out = args.out + z_; F.bx = (int)blockIdx.x + z_; F.G = (int)gridDim.x + z_; F.vcu = (F.G % 8 == 0) ? (F.bx % 8) * (F.G / 8) + F.bx / 8 : F.bx; } while (0)
#define IN(k) (lo <= (k) && (k) < hi)
#ifndef PROBE_BAR
#define PROBE_BAR 0
#endif
#ifndef PROBE_PH
#define PROBE_PH (-1)
#endif
#define PHASE(k) if (IN(k)) for (int rep_ = 0; rep_ < (((k) == PROBE_PH) ? 2 : 1); ++rep_)
#define SEAM() do { if (one) { unsigned zz_ = 0u; asm volatile("" : "+v"(zz_)); const int st_ = wave_s * 64 + (int)__builtin_amdgcn_mbcnt_hi(~0u, __builtin_amdgcn_mbcnt_lo(~0u, zz_)); xcd_barrier(xbar, st_); if (PROBE_BAR) xcd_barrier(xbar, st_); } } while (0)
#define MOD_ ((float*)(ws + WS_MOD))
#define MODKV_ (MOD_ + 4 * 2 * 6144)
#define H2_ ((bf16*)(ws + WS_H2))
#define XN_ ((bf16*)(ws + WS_H2))
#define XNKV_ ((bf16*)(ws + WS_H2 + 32 * MiB))
#define P1_ ((bf16*)(ws + WS_P1))
#define P2_ ((bf16*)(ws + WS_P2))
#define HB_ ((bf16*)(ws + WS_HB))
#define QB_ ((bf16*)(ws + WS_QB))
#define GT_ ((bf16*)(ws + WS_GT))
#define XIN1_ ((L == 0) ? F.in[0] : (const float*)F.out)
#define MODL_ (MOD_ + L * 2 * 6144)

    volatile LAS unsigned* MISC = (volatile LAS unsigned*)(F.lds + MISC_OFF);
    if (F.tid < 32) MISC[F.tid] = 0u;
    __syncthreads();
    XcdBarrier xbar; xbar.bar = (unsigned*)(args.ws + WS_BAR); xbar.x = 0; xbar.st = MISC + 8;
    if (one) xbar = xcd_barrier_post((unsigned*)(args.ws + WS_BAR), MISC + 8, F.tid);
    PHASE(0) { LAUNDER(); p0_mod(F); p0_weights(F); if (one) grid.sync(); }
    { constexpr int L = 0;
        const int pb = 1 + L * 10;
        if (L < 2) {
            PHASE(pb + 0) { LAUNDER(); norm_mix_phase(F, XIN1_, F.in[4] + L * D, MODL_, MODL_ + 1024, F.in[8] + L * 6 * 1024, H2_, P2_); SEAM(); }
            PHASE(pb + 1) { LAUNDER(); GEMM_CALL(FnP1, H2_, ws + WS_W1 + (size_t)L * N1 * K1 * 2 + (size_t)3072 * 1024 * 2, 512, K1, K1, K1, P1_, 3072);
                LAUNDER();
                if (F.G == 256) GEMM_CALL_S(SplitOrder, FnP1, P2_, ws + WS_W1 + (size_t)L * N1 * K1 * 2, 3072, D, D, D, 4, (size_t)M * D * 2, P1_, 0);
                else GEMM_CALL_G(FnP1, P2_, ws + WS_W1 + (size_t)L * N1 * K1 * 2, 3072, D, D, D, 4, (size_t)M * D * 2, P1_, 0);
                SEAM(); }
            PHASE(pb + 2) { LAUNDER(); GEMM_CALL(FnP2, P1_ + 3072, ws + WS_W2A + (size_t)L * 3072 * 256 * 2, (L == 0 ? 2048 : NP2), 256, N1, 256, P2_, MOD_ + 53248 + L * 3072); SEAM(); }
            PHASE(pb + 3) { LAUNDER(); scan_phase(F, L); SEAM(); }
            PHASE(pb + 4) { LAUNDER(); post_phase(F, L); SEAM(); }
            PHASE(pb + 5) { LAUNDER(); GEMM_CALL(FnGate, P1_ + 3232, ws + WS_W2G + (size_t)L * 1024 * 256 * 2, D, 256, N1, 256, H2_, 2048); SEAM(); }
            PHASE(pb + 6) { LAUNDER(); GEMM_CALL(FnRes, H2_, ws + WS_WO + (size_t)L * D * D * 2, D, D, 2048, D, XIN1_, F.out, MODL_ + 2 * 1024); SEAM(); }
        } else {
            const int j = L - 2;
            PHASE(pb + 0) { LAUNDER(); norm_phase(F, F.out, F.in[4] + L * D, MODL_, MODL_ + 1024, 6144, 1, XN_);
                if (L == 2) norm_phase(F, F.out, F.in[29], MODKV_, MODKV_ + 1024, 2048, 1, XNKV_);
                SEAM(); }
            PHASE(pb + 1) { LAUNDER();
                if (L == 2) GEMM_CALL(FnKv, XNKV_, ws + WS_WKV, 2304, D, D, D, (bf16*)(ws + WS_KVRAW), (float*)(ws + WS_FL));
                LAUNDER();
                GEMM_CALL(FnQg, XN_, ws + WS_WQG + (size_t)j * 2048 * D * 2, 2048, D, D, D, QB_, GT_); SEAM(); }
            if (L == 2) PHASE(pb + 2) { LAUNDER(); kvpost_phase(F); SEAM(); }
            PHASE(pb + 3) { LAUNDER();
                float kb_; { float g_ = fabsf(F.in[34][F.lane]); g_ = fmaxf(g_, dpp_f(g_, 0)); g_ = fmaxf(g_, dpp_f(g_, 1)); g_ = fmaxf(g_, dpp_f(g_, 2)); g_ = fmaxf(g_, dpp_f(g_, 3));
                  { auto rr = __builtin_amdgcn_permlane16_swap(__float_as_uint(g_), __float_as_uint(g_), false, false); g_ = fmaxf(__uint_as_float(rr[0]), __uint_as_float(rr[1])); }
                  { auto rr = __builtin_amdgcn_permlane32_swap(__float_as_uint(g_), __float_as_uint(g_), false, false); g_ = fmaxf(__uint_as_float(rr[0]), __uint_as_float(rr[1])); }
                  kb_ = 8.0f * 1.02f * g_; }
                const attn_body::AttnTensors AT{(const attn_body::bf16*)QB_, (const attn_body::bf16*)(ws + WS_KS), (const attn_body::bf16*)(ws + WS_VS), (attn_body::bf16*)((PROBE_PH == pb + 3 && rep_ == 0) ? (bf16*)(ws + WS_KVRAW) : QB_), (const attn_body::bf16*)GT_, (const unsigned char*)(ws + WS_G3), F.in[36] + j * 64, kb_};
                const attn_body::StaticOrder S((int)F.G, F.bx);
                attn_body::attn_phase<attn_body::StaticOrder>((char*)lds, AT, S, F.tid);
                SEAM(); }
            PHASE(pb + 6) { LAUNDER(); GEMM_CALL(FnRes, QB_, ws + WS_WO2 + (size_t)j * D * D * 2, D, D, D, D, (const float*)F.out, F.out, MODL_ + 2 * 1024); SEAM(); }
        }
        PHASE(pb + 7) { LAUNDER(); mlp_weights(F, L); norm_phase(F, F.out, F.in[5] + L * D, MODL_ + 3 * 1024, MODL_ + 4 * 1024, 6144, 1, XN_); SEAM(); }
        PHASE(pb + 8) { LAUNDER(); GEMM_CALL(FnUp, XN_, ws + WS_WUP, FF, D, D, D, HB_); SEAM(); }
        PHASE(pb + 9) { LAUNDER(); GEMM_CALL(FnRes, HB_, ws + WS_WDN, D, FF, FF, FF, (const float*)F.out, F.out, MODL_ + 5 * 1024); SEAM(); }
        }
    { constexpr int L = 1;
        const int pb = 1 + L * 10;
        if (L < 2) {
            PHASE(pb + 0) { LAUNDER(); norm_mix_phase(F, XIN1_, F.in[4] + L * D, MODL_, MODL_ + 1024, F.in[8] + L * 6 * 1024, H2_, P2_); SEAM(); }
            PHASE(pb + 1) { LAUNDER(); GEMM_CALL(FnP1, H2_, ws + WS_W1 + (size_t)L * N1 * K1 * 2 + (size_t)3072 * 1024 * 2, 512, K1, K1, K1, P1_, 3072);
                LAUNDER();
                if (F.G == 256) GEMM_CALL_S(SplitOrder, FnP1, P2_, ws + WS_W1 + (size_t)L * N1 * K1 * 2, 3072, D, D, D, 4, (size_t)M * D * 2, P1_, 0);
                else GEMM_CALL_G(FnP1, P2_, ws + WS_W1 + (size_t)L * N1 * K1 * 2, 3072, D, D, D, 4, (size_t)M * D * 2, P1_, 0);
                SEAM(); }
            PHASE(pb + 2) { LAUNDER(); GEMM_CALL(FnP2, P1_ + 3072, ws + WS_W2A + (size_t)L * 3072 * 256 * 2, (L == 0 ? 2048 : NP2), 256, N1, 256, P2_, MOD_ + 53248 + L * 3072); SEAM(); }
            PHASE(pb + 3) { LAUNDER(); scan_phase(F, L); SEAM(); }
            PHASE(pb + 4) { LAUNDER(); post_phase(F, L); SEAM(); }
            PHASE(pb + 5) { LAUNDER(); GEMM_CALL(FnGate, P1_ + 3232, ws + WS_W2G + (size_t)L * 1024 * 256 * 2, D, 256, N1, 256, H2_, 2048); SEAM(); }
            PHASE(pb + 6) { LAUNDER(); GEMM_CALL(FnRes, H2_, ws + WS_WO + (size_t)L * D * D * 2, D, D, 2048, D, XIN1_, F.out, MODL_ + 2 * 1024); SEAM(); }
        } else {
            const int j = L - 2;
            PHASE(pb + 0) { LAUNDER(); norm_phase(F, F.out, F.in[4] + L * D, MODL_, MODL_ + 1024, 6144, 1, XN_);
                if (L == 2) norm_phase(F, F.out, F.in[29], MODKV_, MODKV_ + 1024, 2048, 1, XNKV_);
                SEAM(); }
            PHASE(pb + 1) { LAUNDER();
                if (L == 2) GEMM_CALL(FnKv, XNKV_, ws + WS_WKV, 2304, D, D, D, (bf16*)(ws + WS_KVRAW), (float*)(ws + WS_FL));
                LAUNDER();
                GEMM_CALL(FnQg, XN_, ws + WS_WQG + (size_t)j * 2048 * D * 2, 2048, D, D, D, QB_, GT_); SEAM(); }
            if (L == 2) PHASE(pb + 2) { LAUNDER(); kvpost_phase(F); SEAM(); }
            PHASE(pb + 3) { LAUNDER();
                float kb_; { float g_ = fabsf(F.in[34][F.lane]); g_ = fmaxf(g_, dpp_f(g_, 0)); g_ = fmaxf(g_, dpp_f(g_, 1)); g_ = fmaxf(g_, dpp_f(g_, 2)); g_ = fmaxf(g_, dpp_f(g_, 3));
                  { auto rr = __builtin_amdgcn_permlane16_swap(__float_as_uint(g_), __float_as_uint(g_), false, false); g_ = fmaxf(__uint_as_float(rr[0]), __uint_as_float(rr[1])); }
                  { auto rr = __builtin_amdgcn_permlane32_swap(__float_as_uint(g_), __float_as_uint(g_), false, false); g_ = fmaxf(__uint_as_float(rr[0]), __uint_as_float(rr[1])); }
                  kb_ = 8.0f * 1.02f * g_; }
                const attn_body::AttnTensors AT{(const attn_body::bf16*)QB_, (const attn_body::bf16*)(ws + WS_KS), (const attn_body::bf16*)(ws + WS_VS), (attn_body::bf16*)((PROBE_PH == pb + 3 && rep_ == 0) ? (bf16*)(ws + WS_KVRAW) : QB_), (const attn_body::bf16*)GT_, (const unsigned char*)(ws + WS_G3), F.in[36] + j * 64, kb_};
                const attn_body::StaticOrder S((int)F.G, F.bx);
                attn_body::attn_phase<attn_body::StaticOrder>((char*)lds, AT, S, F.tid);
                SEAM(); }
            PHASE(pb + 6) { LAUNDER(); GEMM_CALL(FnRes, QB_, ws + WS_WO2 + (size_t)j * D * D * 2, D, D, D, D, (const float*)F.out, F.out, MODL_ + 2 * 1024); SEAM(); }
        }
        PHASE(pb + 7) { LAUNDER(); mlp_weights(F, L); norm_phase(F, F.out, F.in[5] + L * D, MODL_ + 3 * 1024, MODL_ + 4 * 1024, 6144, 1, XN_); SEAM(); }
        PHASE(pb + 8) { LAUNDER(); GEMM_CALL(FnUp, XN_, ws + WS_WUP, FF, D, D, D, HB_); SEAM(); }
        PHASE(pb + 9) { LAUNDER(); GEMM_CALL(FnRes, HB_, ws + WS_WDN, D, FF, FF, FF, (const float*)F.out, F.out, MODL_ + 5 * 1024); SEAM(); }
        }
    { constexpr int L = 2;
        const int pb = 1 + L * 10;
        if (L < 2) {
            PHASE(pb + 0) { LAUNDER(); norm_mix_phase(F, XIN1_, F.in[4] + L * D, MODL_, MODL_ + 1024, F.in[8] + L * 6 * 1024, H2_, P2_); SEAM(); }
            PHASE(pb + 1) { LAUNDER(); GEMM_CALL(FnP1, H2_, ws + WS_W1 + (size_t)L * N1 * K1 * 2 + (size_t)3072 * 1024 * 2, 512, K1, K1, K1, P1_, 3072);
                LAUNDER();
                if (F.G == 256) GEMM_CALL_S(SplitOrder, FnP1, P2_, ws + WS_W1 + (size_t)L * N1 * K1 * 2, 3072, D, D, D, 4, (size_t)M * D * 2, P1_, 0);
                else GEMM_CALL_G(FnP1, P2_, ws + WS_W1 + (size_t)L * N1 * K1 * 2, 3072, D, D, D, 4, (size_t)M * D * 2, P1_, 0);
                SEAM(); }
            PHASE(pb + 2) { LAUNDER(); GEMM_CALL(FnP2, P1_ + 3072, ws + WS_W2A + (size_t)L * 3072 * 256 * 2, (L == 0 ? 2048 : NP2), 256, N1, 256, P2_, MOD_ + 53248 + L * 3072); SEAM(); }
            PHASE(pb + 3) { LAUNDER(); scan_phase(F, L); SEAM(); }
            PHASE(pb + 4) { LAUNDER(); post_phase(F, L); SEAM(); }
            PHASE(pb + 5) { LAUNDER(); GEMM_CALL(FnGate, P1_ + 3232, ws + WS_W2G + (size_t)L * 1024 * 256 * 2, D, 256, N1, 256, H2_, 2048); SEAM(); }
            PHASE(pb + 6) { LAUNDER(); GEMM_CALL(FnRes, H2_, ws + WS_WO + (size_t)L * D * D * 2, D, D, 2048, D, XIN1_, F.out, MODL_ + 2 * 1024); SEAM(); }
        } else {
            const int j = L - 2;
            PHASE(pb + 0) { LAUNDER(); norm_phase(F, F.out, F.in[4] + L * D, MODL_, MODL_ + 1024, 6144, 1, XN_);
                if (L == 2) norm_phase(F, F.out, F.in[29], MODKV_, MODKV_ + 1024, 2048, 1, XNKV_);
                SEAM(); }
            PHASE(pb + 1) { LAUNDER();
                if (L == 2) GEMM_CALL(FnKv, XNKV_, ws + WS_WKV, 2304, D, D, D, (bf16*)(ws + WS_KVRAW), (float*)(ws + WS_FL));
                LAUNDER();
                GEMM_CALL(FnQg, XN_, ws + WS_WQG + (size_t)j * 2048 * D * 2, 2048, D, D, D, QB_, GT_); SEAM(); }
            if (L == 2) PHASE(pb + 2) { LAUNDER(); kvpost_phase(F); SEAM(); }
            PHASE(pb + 3) { LAUNDER();
                float kb_; { float g_ = fabsf(F.in[34][F.lane]); g_ = fmaxf(g_, dpp_f(g_, 0)); g_ = fmaxf(g_, dpp_f(g_, 1)); g_ = fmaxf(g_, dpp_f(g_, 2)); g_ = fmaxf(g_, dpp_f(g_, 3));
                  { auto rr = __builtin_amdgcn_permlane16_swap(__float_as_uint(g_), __float_as_uint(g_), false, false); g_ = fmaxf(__uint_as_float(rr[0]), __uint_as_float(rr[1])); }
                  { auto rr = __builtin_amdgcn_permlane32_swap(__float_as_uint(g_), __float_as_uint(g_), false, false); g_ = fmaxf(__uint_as_float(rr[0]), __uint_as_float(rr[1])); }
                  kb_ = 8.0f * 1.02f * g_; }
                const attn_body::AttnTensors AT{(const attn_body::bf16*)QB_, (const attn_body::bf16*)(ws + WS_KS), (const attn_body::bf16*)(ws + WS_VS), (attn_body::bf16*)((PROBE_PH == pb + 3 && rep_ == 0) ? (bf16*)(ws + WS_KVRAW) : QB_), (const attn_body::bf16*)GT_, (const unsigned char*)(ws + WS_G3), F.in[36] + j * 64, kb_};
                const attn_body::StaticOrder S((int)F.G, F.bx);
                attn_body::attn_phase<attn_body::StaticOrder>((char*)lds, AT, S, F.tid);
                SEAM(); }
            PHASE(pb + 6) { LAUNDER(); GEMM_CALL(FnRes, QB_, ws + WS_WO2 + (size_t)j * D * D * 2, D, D, D, D, (const float*)F.out, F.out, MODL_ + 2 * 1024); SEAM(); }
        }
        PHASE(pb + 7) { LAUNDER(); mlp_weights(F, L); norm_phase(F, F.out, F.in[5] + L * D, MODL_ + 3 * 1024, MODL_ + 4 * 1024, 6144, 1, XN_); SEAM(); }
        PHASE(pb + 8) { LAUNDER(); GEMM_CALL(FnUp, XN_, ws + WS_WUP, FF, D, D, D, HB_); SEAM(); }
        PHASE(pb + 9) { LAUNDER(); GEMM_CALL(FnRes, HB_, ws + WS_WDN, D, FF, FF, FF, (const float*)F.out, F.out, MODL_ + 5 * 1024); SEAM(); }
        }
    { constexpr int L = 3;
        const int pb = 1 + L * 10;
        if (L < 2) {
            PHASE(pb + 0) { LAUNDER(); norm_mix_phase(F, XIN1_, F.in[4] + L * D, MODL_, MODL_ + 1024, F.in[8] + L * 6 * 1024, H2_, P2_); SEAM(); }
            PHASE(pb + 1) { LAUNDER(); GEMM_CALL(FnP1, H2_, ws + WS_W1 + (size_t)L * N1 * K1 * 2 + (size_t)3072 * 1024 * 2, 512, K1, K1, K1, P1_, 3072);
                LAUNDER();
                if (F.G == 256) GEMM_CALL_S(SplitOrder, FnP1, P2_, ws + WS_W1 + (size_t)L * N1 * K1 * 2, 3072, D, D, D, 4, (size_t)M * D * 2, P1_, 0);
                else GEMM_CALL_G(FnP1, P2_, ws + WS_W1 + (size_t)L * N1 * K1 * 2, 3072, D, D, D, 4, (size_t)M * D * 2, P1_, 0);
                SEAM(); }
            PHASE(pb + 2) { LAUNDER(); GEMM_CALL(FnP2, P1_ + 3072, ws + WS_W2A + (size_t)L * 3072 * 256 * 2, (L == 0 ? 2048 : NP2), 256, N1, 256, P2_, MOD_ + 53248 + L * 3072); SEAM(); }
            PHASE(pb + 3) { LAUNDER(); scan_phase(F, L); SEAM(); }
            PHASE(pb + 4) { LAUNDER(); post_phase(F, L); SEAM(); }
            PHASE(pb + 5) { LAUNDER(); GEMM_CALL(FnGate, P1_ + 3232, ws + WS_W2G + (size_t)L * 1024 * 256 * 2, D, 256, N1, 256, H2_, 2048); SEAM(); }
            PHASE(pb + 6) { LAUNDER(); GEMM_CALL(FnRes, H2_, ws + WS_WO + (size_t)L * D * D * 2, D, D, 2048, D, XIN1_, F.out, MODL_ + 2 * 1024); SEAM(); }
        } else {
            const int j = L - 2;
            PHASE(pb + 0) { LAUNDER(); norm_phase(F, F.out, F.in[4] + L * D, MODL_, MODL_ + 1024, 6144, 1, XN_);
                if (L == 2) norm_phase(F, F.out, F.in[29], MODKV_, MODKV_ + 1024, 2048, 1, XNKV_);
                SEAM(); }
            PHASE(pb + 1) { LAUNDER();
                if (L == 2) GEMM_CALL(FnKv, XNKV_, ws + WS_WKV, 2304, D, D, D, (bf16*)(ws + WS_KVRAW), (float*)(ws + WS_FL));
                LAUNDER();
                GEMM_CALL(FnQg, XN_, ws + WS_WQG + (size_t)j * 2048 * D * 2, 2048, D, D, D, QB_, GT_); SEAM(); }
            if (L == 2) PHASE(pb + 2) { LAUNDER(); kvpost_phase(F); SEAM(); }
            PHASE(pb + 3) { LAUNDER();
                float kb_; { float g_ = fabsf(F.in[34][F.lane]); g_ = fmaxf(g_, dpp_f(g_, 0)); g_ = fmaxf(g_, dpp_f(g_, 1)); g_ = fmaxf(g_, dpp_f(g_, 2)); g_ = fmaxf(g_, dpp_f(g_, 3));
                  { auto rr = __builtin_amdgcn_permlane16_swap(__float_as_uint(g_), __float_as_uint(g_), false, false); g_ = fmaxf(__uint_as_float(rr[0]), __uint_as_float(rr[1])); }
                  { auto rr = __builtin_amdgcn_permlane32_swap(__float_as_uint(g_), __float_as_uint(g_), false, false); g_ = fmaxf(__uint_as_float(rr[0]), __uint_as_float(rr[1])); }
                  kb_ = 8.0f * 1.02f * g_; }
                const attn_body::AttnTensors AT{(const attn_body::bf16*)QB_, (const attn_body::bf16*)(ws + WS_KS), (const attn_body::bf16*)(ws + WS_VS), (attn_body::bf16*)((PROBE_PH == pb + 3 && rep_ == 0) ? (bf16*)(ws + WS_KVRAW) : QB_), (const attn_body::bf16*)GT_, (const unsigned char*)(ws + WS_G3), F.in[36] + j * 64, kb_};
                const attn_body::StaticOrder S((int)F.G, F.bx);
                attn_body::attn_phase<attn_body::StaticOrder>((char*)lds, AT, S, F.tid);
                SEAM(); }
            PHASE(pb + 6) { LAUNDER(); GEMM_CALL(FnRes, QB_, ws + WS_WO2 + (size_t)j * D * D * 2, D, D, D, D, (const float*)F.out, F.out, MODL_ + 2 * 1024); SEAM(); }
        }
        PHASE(pb + 7) { LAUNDER(); mlp_weights(F, L); norm_phase(F, F.out, F.in[5] + L * D, MODL_ + 3 * 1024, MODL_ + 4 * 1024, 6144, 1, XN_); SEAM(); }
        PHASE(pb + 8) { LAUNDER(); GEMM_CALL(FnUp, XN_, ws + WS_WUP, FF, D, D, D, HB_); SEAM(); }
        PHASE(pb + 9) { LAUNDER(); GEMM_CALL(FnRes, HB_, ws + WS_WDN, D, FF, FF, FF, (const float*)F.out, F.out, MODL_ + 5 * 1024); SEAM(); }
        }
    PHASE(41) { LAUNDER(); final_norm_phase(F); }
#undef IN
#undef SEAM
}
static bool phase_exists(int ph) {
    if (ph == 0 || ph == 41) return true;
    const int L = (ph - 1) / 10, s = (ph - 1) % 10;
    if (L < 2) return true;
    if (s == 4 || s == 5) return false;
    if (s == 2) return L == 2;
    return true;
}
extern "C" void kernel_launch(void* const* d_in, const int* in_sizes, int n_in, void* d_out, int out_size, void* d_ws, size_t ws_size, hipStream_t stream) {
    static int grid = 0;
    if (grid == 0) {
        if (n_in != 39 || in_sizes[0] != M * D || out_size != M * D || ws_size < WS_END) { fprintf(stderr, "kernel_launch: shape/workspace mismatch: n_in %d in0 %d out %d ws %zu (need %zu)\n", n_in, n_in > 0 ? in_sizes[0] : -1, out_size, ws_size, (size_t)WS_END); grid = -1; return; }
        int dev = 0, cus = 0, per_cu = 0;
        if (hipGetDevice(&dev) != hipSuccess || hipDeviceGetAttribute(&cus, hipDeviceAttributeMultiprocessorCount, dev) != hipSuccess) { fprintf(stderr, "kernel_launch: device query failed\n"); grid = -1; return; }
        if (hipFuncSetAttribute((const void*)yoco_fwd, hipFuncAttributeMaxDynamicSharedMemorySize, LDS_BYTES) != hipSuccess) { fprintf(stderr, "kernel_launch: hipFuncSetAttribute failed\n"); grid = -1; return; }
        if (hipOccupancyMaxActiveBlocksPerMultiprocessor(&per_cu, (const void*)yoco_fwd, NWAVES * 64, LDS_BYTES) != hipSuccess || per_cu < 1) { fprintf(stderr, "kernel_launch: occupancy query says %d blocks/CU\n", per_cu); per_cu = 1; }
        (void)hipGetLastError();
        grid = cus * per_cu;
        if (grid != 256) { fprintf(stderr, "kernel_launch: resident capacity %d workgroups; this kernel's static schedules want 256 (using 256)\n", grid); if (grid > 256) grid = 256; }
    }
    if (grid < 0) return;
    if (hipMemsetAsync((char*)d_ws + WS_BAR, 0, BAR_BYTES, stream) != hipSuccess) { fprintf(stderr, "kernel_launch: memset of barrier words failed\n"); return; }
    Args a{};
    for (int i = 0; i < 39; ++i) a.in[i] = (const float*)d_in[i];
    a.out = (float*)d_out; a.ws = (unsigned char*)d_ws;
#if MK_ONE_LAUNCH
    a.ph_lo = 0; a.ph_hi = N_PHASES;
    void* params[] = {&a};
    const hipError_t le = hipLaunchCooperativeKernel((const void*)yoco_fwd, dim3(grid), dim3(NWAVES * 64), params, LDS_BYTES, stream);
    if (le != hipSuccess) fprintf(stderr, "kernel_launch: cooperative launch failed: %s (grid %d)\n", hipGetErrorName(le), grid);
#else
    for (int ph = 0; ph < N_PHASES; ++ph) { if (!phase_exists(ph)) continue; a.ph_lo = ph; a.ph_hi = ph + 1;
        hipLaunchKernelGGL(yoco_fwd, dim3(grid), dim3(NWAVES * 64), LDS_BYTES, stream, a);
        const hipError_t le = hipPeekAtLastError(); if (le != hipSuccess) { fprintf(stderr, "kernel_launch: launch of phase %d failed: %s\n", ph, hipGetErrorName(le)); break; } }
#endif
}
```

```cpp
#include <hip/hip_runtime.h>
#include <hip/hip_cooperative_groups.h>
#include <hip/hip_bf16.h>
#include <cstdio>
#include <cstdint>
#include <cmath>
namespace cg = cooperative_groups;
#ifndef MK_ONE_LAUNCH
#define MK_ONE_LAUNCH 1
#endif
namespace pg8 {
#define PG8_LAS __attribute__((address_space(3)))
typedef unsigned short bf16_t;
typedef short bf16x8 __attribute__((ext_vector_type(8)));
typedef float f32x4 __attribute__((ext_vector_type(4)));
typedef unsigned u32x4 __attribute__((ext_vector_type(4)));
constexpr int BM = 256, BK = 64, HALF = 128, HTB = HALF * BK * 2  , STAGE_BYTES = 8 * HTB, NXCD = 8, WGM = 8;

__host__ __device__ __forceinline__ int lds_byte(int r, int c) { const int st = (r >> 4) * 2 + (c >> 5), rr = r & 15, cc = c & 31, ob = rr * 64 + cc * 2; return st * 1024 + (ob ^ (((ob >> 9) & 1) << 5)); }
__host__ __device__ __forceinline__ void stage_rc(int b, int& R, int& C) { const int st = b / 1024, sb = b % 1024, swz = sb ^ (((sb >> 9) & 1) << 5); R = (st >> 1) * 16 + swz / 64; C = (st & 1) * 32 + (swz % 64) / 2; }
__host__ __device__ __forceinline__ int perm32(int rho) { const int n = rho >> 4, i = rho & 15; return 8 * (i >> 2) + 4 * n + (i & 3); }

struct Unit { int pm, pn; };
struct Gemm { const bf16_t* A; const bf16_t* Bt; int M, N, K, lda, ldb; int agrp; size_t astep; };

struct SplitOrder {
    int c, nN;
    __host__ __device__ void init(int M, int N, int G_, int c_) { c = c_; nN = N / BM; (void)M; (void)G_; }
    __host__ __device__ bool next(int i, Unit& u) const { int idx; if (c < 128) { if (i >= 2) return false; idx = 2 * c + i; } else { if (i >= 4) return false; idx = 256 + 4 * (c - 128) + i; } u.pm = idx / nN; u.pn = idx % nN; return true; }
    __device__ __forceinline__ void a_ready(const Unit&) const {}
    __device__ __forceinline__ void done(const Unit&) const {}
};
struct StaticOrder {
    int nM, nN, nwg, G, c;
    __host__ __device__ void init(int M, int N, int G_, int c_) { nM = M / BM; nN = N / BM; nwg = nM * nN; G = G_; c = c_; }
    __host__ __device__ bool next(int i, Unit& u) const {
        const long L = (long)i * G + c; if (L >= nwg) return false;
        int wgid = (int)L; { const int q = nwg / NXCD, r = nwg % NXCD, xcd = wgid % NXCD, off = wgid / NXCD; wgid = (xcd < r ? xcd * (q + 1) : r * (q + 1) + (xcd - r) * q) + off; }
        const int nig = WGM * nN, gid = wgid / nig, fm = gid * WGM, gsz = (nM - fm) < WGM ? (nM - fm) : WGM;
        u.pm = fm + ((wgid % nig) % gsz); u.pn = (wgid % nig) / gsz; return true;
    }
    __device__ __forceinline__ void a_ready(const Unit&) const {}
    __device__ __forceinline__ void done(const Unit&) const {}
};

typedef float f32x2 __attribute__((ext_vector_type(2)));
typedef __bf16 bf16x2_t __attribute__((ext_vector_type(2)));
__device__ __forceinline__ unsigned pkbf(float lo, float hi) { f32x2 v = {lo, hi}; bf16x2_t b = __builtin_convertvector(v, bf16x2_t); return __builtin_bit_cast(unsigned, b); }
__device__ __forceinline__ float bflo(unsigned w) { return __uint_as_float(w << 16); }
__device__ __forceinline__ float bfhi(unsigned w) { return __uint_as_float(w & 0xffff0000u); }
__device__ __forceinline__ float sigm(float x) { return __builtin_amdgcn_rcpf(1.0f + __builtin_amdgcn_exp2f(-1.4426950408889634f * x)); }
template <class Fn> struct Epi8 {
    static constexpr bool PERM = true, AFTER_DRAIN = false; Fn f;
    __device__ __forceinline__ void operator()(const f32x4 (&acc)[2][2][4][2], const Unit& u, int wr, int wc, int fr, int fq) const {
        const int row0 = u.pm * BM + wr * 64 + fr, col0 = u.pn * BM + wc * 32 + 8 * fq;
#pragma unroll
        for (int ai = 0; ai < 2; ++ai)
#pragma unroll
            for (int m = 0; m < 4; ++m)
#pragma unroll
                for (int bj = 0; bj < 2; ++bj) { f(row0 + ai * HALF + m * 16, col0 + bj * HALF, acc[ai][bj][m][0], acc[ai][bj][m][1]); }
    }
};
__device__ __forceinline__ void st8bf(bf16_t* p, f32x4 v0, f32x4 v1) { u32x4 w; w.x = pkbf(v0[0], v0[1]); w.y = pkbf(v0[2], v0[3]); w.z = pkbf(v1[0], v1[1]); w.w = pkbf(v1[2], v1[3]); *(u32x4*)p = w; }
struct FnP1 { bf16_t* O; int coff;
    __device__ __forceinline__ void operator()(int row, int col, f32x4 v0, f32x4 v1) const {
        col += coff;
        if (col >= 3072) {
            if (col < 3136) {
#pragma unroll
                for (int j = 0; j < 4; ++j) { v0[j] = 1.0f - 2.0f * __builtin_amdgcn_rcpf(__builtin_amdgcn_exp2f(2.8853900817779268f * v0[j]) + 1.0f); v1[j] = 1.0f - 2.0f * __builtin_amdgcn_rcpf(__builtin_amdgcn_exp2f(2.8853900817779268f * v1[j]) + 1.0f); } }
            else if (col >= 3232 && col < 3392) {
#pragma unroll
                for (int j = 0; j < 4; ++j) { v0[j] = sigm(v0[j]); v1[j] = sigm(v1[j]); } }
        }
        st8bf(O + (size_t)row * 3584 + col, v0, v1); } };
struct FnP2 { bf16_t* O; const float* bias;
    __device__ __forceinline__ void operator()(int row, int col, f32x4 v0, f32x4 v1) const {
        const f32x4 b0 = *(const f32x4*)(bias + col), b1 = *(const f32x4*)(bias + col + 4);
        const float sc = col < 1024 ? -0.60653065971f : 1.0f;
#pragma unroll
        for (int j = 0; j < 4; ++j) { v0[j] = sc * sigm(v0[j] + b0[j]); v1[j] = sc * sigm(v1[j] + b1[j]); }
        st8bf(O + (size_t)row * 3072 + col, v0, v1); } };
struct FnGate { bf16_t* Y; int ld;
    __device__ __forceinline__ void operator()(int row, int col, f32x4 v0, f32x4 v1) const {
        bf16_t* p = Y + (size_t)row * ld + col; const u32x4 y = *(const u32x4*)p;
        v0[0] *= bflo(y.x); v0[1] *= bfhi(y.x); v0[2] *= bflo(y.y); v0[3] *= bfhi(y.y); v1[0] *= bflo(y.z); v1[1] *= bfhi(y.z); v1[2] *= bflo(y.w); v1[3] *= bfhi(y.w);
        st8bf(p, v0, v1); } };
struct FnRes { const float* xin; float* xout; const float* gate;
    __device__ __forceinline__ void operator()(int row, int col, f32x4 v0, f32x4 v1) const {
        const float* gp = gate + (row >> 13) * 6144 + col; const f32x4 g0 = *(const f32x4*)gp, g1 = *(const f32x4*)(gp + 4);
        const size_t off = (size_t)row * 1024 + col; const f32x4 x0 = *(const f32x4*)(xin + off), x1 = *(const f32x4*)(xin + off + 4);
        *(f32x4*)(xout + off) = x0 + (g0 + 1.0f) * v0; *(f32x4*)(xout + off + 4) = x1 + (g1 + 1.0f) * v1; } };
struct FnUp { bf16_t* O;
    __device__ __forceinline__ void operator()(int row, int col, f32x4 v0, f32x4 v1) const {
#pragma unroll
        for (int j = 0; j < 4; ++j) { const float a = fmaxf(v0[j], 0.f), b = fmaxf(v1[j], 0.f); v0[j] = a * a; v1[j] = b * b; }
        st8bf(O + (size_t)row * 4096 + col, v0, v1); } };
struct FnKv { bf16_t* O; float* FL;
    __device__ __forceinline__ void operator()(int row, int col, f32x4 v0, f32x4 v1) const {
        if (col < 2048) st8bf(O + (size_t)row * 2048 + col, v0, v1);
        else if (col < 2064) { float* p = FL + (size_t)row * 16 + (col - 2048); *(f32x4*)p = v0; *(f32x4*)(p + 4) = v1; } } };
struct FnQg { bf16_t* Q; bf16_t* G;
    __device__ __forceinline__ void operator()(int row, int col, f32x4 v0, f32x4 v1) const {
        if (col < 1024) st8bf(Q + (size_t)row * 1024 + col, v0, v1);
        else {
#pragma unroll
            for (int j = 0; j < 4; ++j) { v0[j] = sigm(v0[j]); v1[j] = sigm(v1[j]); }
            st8bf(G + (size_t)row * 1024 + (col - 1024), v0, v1); } } };
template <class Epi, class Sched, bool ALIGN_EPI = false, bool SP2 = false>
__device__ __forceinline__ void gemm_phase(PG8_LAS unsigned char* lds, const Gemm g, const Sched& S, const Epi& E, const int tid_in) {
    int tid_l = tid_in; asm volatile("" : "+v"(tid_l));
    const int tid = tid_l, wid = __builtin_amdgcn_readfirstlane(tid >> 6), lane = tid & 63, wr = wid >> 2, wc = wid & 3, fr = lane & 15, fq = lane >> 4;
    const int K = g.K, nt = K / BK;
    unsigned voffA[2], voffB[2];
#pragma unroll
    for (int i = 0; i < 2; ++i) { int R, C; stage_rc(tid * 16 + i * 8192, R, C); const int Rb = Epi::PERM ? ((R & ~31) + perm32(R & 31)) : R;
        voffA[i] = (unsigned)(R * g.lda + C) * 2u; voffB[i] = (unsigned)(Rb * g.ldb + C) * 2u; }
    const size_t kstep = (size_t)(BK * 2);
    const size_t hstepA = (size_t)HALF * g.lda * 2, hstepB = (size_t)HALF * g.ldb * 2;
    const size_t tstepA = 2 * hstepA, tstepB = 2 * hstepB;
    const unsigned ldsw = (unsigned)wid * 1024u;
    const int aoff = lds_byte(wr * 64 + fr, fq * 8), boff = lds_byte(wc * 32 + fr, fq * 8);
#define PG8_SA(b, h) (((b) * 2 + (h)) * HTB)
#define PG8_SB(b, h) ((4 + (b) * 2 + (h)) * HTB)
#define PG8_STAGE(bufoff, gbase, voff) do { _Pragma("unroll") for (int _i = 0; _i < 2; ++_i) \
        __builtin_amdgcn_global_load_lds((const unsigned*)((const char*)(gbase) + (voff)[_i]), (PG8_LAS unsigned*)(lds + (bufoff) + ldsw + _i * 8192), 16, 0, 0); } while (0)
#define PG8_LDA(dst, b, h) do { _Pragma("unroll") for (int m = 0; m < 4; ++m) _Pragma("unroll") for (int k = 0; k < 2; ++k) dst[m][k] = *(const PG8_LAS bf16x8*)(lds + PG8_SA(b, h) + aoff + m * 2048 + k * 1024); } while (0)
#define PG8_LDB(dst, b, h) do { _Pragma("unroll") for (int n = 0; n < 2; ++n) _Pragma("unroll") for (int k = 0; k < 2; ++k) dst[n][k] = *(const PG8_LAS bf16x8*)(lds + PG8_SB(b, h) + boff + n * 2048 + k * 1024); } while (0)
#define PG8_MMA(ai, bj, At, Bt) do { __builtin_amdgcn_s_setprio(1); _Pragma("unroll") for (int m = 0; m < 4; ++m) _Pragma("unroll") for (int n = 0; n < 2; ++n) _Pragma("unroll") for (int k = 0; k < 2; ++k) \
        acc[ai][bj][m][n] = __builtin_amdgcn_mfma_f32_16x16x32_bf16(Bt[n][k], At[m][k], acc[ai][bj][m][n], 0, 0, 0); __builtin_amdgcn_s_setprio(0); } while (0)
#define PG8_WAIT_V(n) asm volatile("s_waitcnt vmcnt(" #n ")" ::: "memory")
#define PG8_WAIT_L(n) asm volatile("s_waitcnt lgkmcnt(" #n ")" ::: "memory")
#define PG8_BAR __builtin_amdgcn_s_barrier()
#define PG8_SCHED __builtin_amdgcn_sched_barrier(0)
    Unit cur, nxt; int ui = 0;
    if (!S.next(0, cur)) return;
    f32x4 acc[2][2][4][2];
#pragma unroll
    for (int a = 0; a < 2; ++a)
#pragma unroll
        for (int b = 0; b < 2; ++b)
#pragma unroll
            for (int m = 0; m < 4; ++m)
#pragma unroll
                for (int n = 0; n < 2; ++n) acc[a][b][m][n] = (f32x4){0.f, 0.f, 0.f, 0.f};
    bf16x8 At[4][2], B0[2][2], B1[2][2];
    const char* cA = (const char*)g.A + (size_t)cur.pm * tstepA + (g.agrp ? (size_t)(cur.pn / g.agrp) * g.astep : (size_t)0); const char* cB = (const char*)g.Bt + (size_t)cur.pn * tstepB;
    S.a_ready(cur);
    if constexpr (SP2) {
        PG8_STAGE(PG8_SB(0, 0), cB, voffB); PG8_STAGE(PG8_SB(0, 1), cB + hstepB, voffB); PG8_STAGE(PG8_SA(0, 0), cA, voffA); PG8_STAGE(PG8_SA(0, 1), cA + hstepA, voffA);
        if (wr == 1) PG8_BAR;
        PG8_WAIT_V(2); PG8_BAR;
        PG8_STAGE(PG8_SB(1, 0), cB + kstep, voffB); PG8_STAGE(PG8_SA(1, 0), cA + kstep, voffA); PG8_STAGE(PG8_SB(1, 1), cB + hstepB + kstep, voffB);
        PG8_WAIT_V(6); PG8_BAR;
    } else {
        PG8_STAGE(PG8_SB(0, 0), cB, voffB); PG8_STAGE(PG8_SA(0, 0), cA, voffA); PG8_STAGE(PG8_SB(0, 1), cB + hstepB, voffB); PG8_STAGE(PG8_SA(0, 1), cA + hstepA, voffA);
        if (wr == 1) PG8_BAR;
        PG8_WAIT_V(4); PG8_BAR;
        PG8_STAGE(PG8_SB(1, 0), cB + kstep, voffB); PG8_STAGE(PG8_SA(1, 0), cA + kstep, voffA); PG8_STAGE(PG8_SB(1, 1), cB + hstepB + kstep, voffB);
        PG8_WAIT_V(6); PG8_BAR;
    }
    for (;;) {
        const bool has_next = S.next(ui + 1, nxt);
        const char* nA = has_next ? (const char*)g.A + (size_t)nxt.pm * tstepA + (g.agrp ? (size_t)(nxt.pn / g.agrp) * g.astep : (size_t)0) : cA; const char* nB = has_next ? (const char*)g.Bt + (size_t)nxt.pn * tstepB : cB;
        for (int t = 0; t < nt; t += 2) {
            const bool last = (t == nt - 2);
            const char* a1 = cA + (size_t)(t + 1) * kstep;
            const char* a2 = last ? nA : cA + (size_t)(t + 2) * kstep; const char* b2 = last ? nB : cB + (size_t)(t + 2) * kstep;
            const char* a3 = a2 + kstep; const char* b3 = b2 + kstep;
            if (last && has_next) S.a_ready(nxt);
            if constexpr (SP2) {
            PG8_LDB(B0, 0, 0); PG8_LDB(B1, 0, 1); PG8_SCHED; PG8_LDA(At, 0, 0); PG8_STAGE(PG8_SA(1, 1), a1 + hstepA, voffA);
            PG8_WAIT_V(8); PG8_WAIT_L(0); PG8_BAR; PG8_MMA(0, 0, At, B0); PG8_MMA(0, 1, At, B1); PG8_BAR; PG8_SCHED;
            PG8_LDA(At, 0, 1); PG8_STAGE(PG8_SB(0, 0), b2, voffB); PG8_STAGE(PG8_SB(0, 1), b2 + hstepB, voffB); PG8_STAGE(PG8_SA(0, 0), a2, voffA);
            PG8_WAIT_V(8); PG8_WAIT_L(0); PG8_BAR; PG8_MMA(1, 0, At, B0); PG8_MMA(1, 1, At, B1); PG8_BAR; PG8_SCHED;
            PG8_LDB(B0, 1, 0); PG8_LDB(B1, 1, 1); PG8_SCHED; PG8_LDA(At, 1, 0); PG8_STAGE(PG8_SA(0, 1), a2 + hstepA, voffA);
            PG8_WAIT_V(8); PG8_WAIT_L(0); PG8_BAR; PG8_MMA(0, 0, At, B0); PG8_MMA(0, 1, At, B1); PG8_BAR; PG8_SCHED;
            PG8_LDA(At, 1, 1); PG8_STAGE(PG8_SB(1, 0), b3, voffB); PG8_STAGE(PG8_SB(1, 1), b3 + hstepB, voffB); PG8_STAGE(PG8_SA(1, 0), a3, voffA);
            PG8_WAIT_V(8); PG8_WAIT_L(0); PG8_BAR; PG8_MMA(1, 0, At, B0); PG8_MMA(1, 1, At, B1); PG8_BAR; PG8_SCHED;
            } else {
            PG8_LDB(B0, 0, 0); PG8_SCHED; PG8_LDA(At, 0, 0); PG8_STAGE(PG8_SA(1, 1), a1 + hstepA, voffA);
            PG8_WAIT_L(8); PG8_BAR; PG8_WAIT_L(0); PG8_MMA(0, 0, At, B0); PG8_BAR; PG8_SCHED;
            PG8_LDB(B1, 0, 1); PG8_STAGE(PG8_SB(0, 0), b2, voffB);
            PG8_BAR; PG8_WAIT_L(0); PG8_MMA(0, 1, At, B1); PG8_BAR;
            PG8_LDA(At, 0, 1); PG8_STAGE(PG8_SA(0, 0), a2, voffA);
            PG8_BAR; PG8_WAIT_L(0); PG8_MMA(1, 0, At, B0); PG8_BAR; PG8_SCHED;
            PG8_STAGE(PG8_SB(0, 1), b2 + hstepB, voffB);
            PG8_WAIT_V(6); PG8_BAR; PG8_MMA(1, 1, At, B1); PG8_BAR;
            PG8_LDB(B0, 1, 0); PG8_SCHED; PG8_LDA(At, 1, 0); PG8_STAGE(PG8_SA(0, 1), a2 + hstepA, voffA);
            PG8_WAIT_L(8); PG8_BAR; PG8_WAIT_L(0); PG8_MMA(0, 0, At, B0); PG8_BAR; PG8_SCHED;
            PG8_LDB(B1, 1, 1); PG8_STAGE(PG8_SB(1, 0), b3, voffB);
            PG8_BAR; PG8_WAIT_L(0); PG8_MMA(0, 1, At, B1); PG8_BAR;
            PG8_LDA(At, 1, 1); PG8_STAGE(PG8_SA(1, 0), a3, voffA);
            PG8_BAR; PG8_WAIT_L(0); PG8_MMA(1, 0, At, B0); PG8_BAR; PG8_SCHED;
            PG8_STAGE(PG8_SB(1, 1), b3 + hstepB, voffB);
            PG8_WAIT_V(6); PG8_BAR; PG8_MMA(1, 1, At, B1); PG8_BAR;
            }
        }
        if constexpr (ALIGN_EPI) { if (wr == 0) PG8_BAR; }
        if constexpr (!Epi::AFTER_DRAIN) { E(acc, cur, wr, wc, fr, fq); S.done(cur); }
        if (!has_next) break;
#pragma unroll
        for (int a = 0; a < 2; ++a)
#pragma unroll
            for (int b = 0; b < 2; ++b)
#pragma unroll
                for (int m = 0; m < 4; ++m)
#pragma unroll
                    for (int n = 0; n < 2; ++n) acc[a][b][m][n] = (f32x4){0.f, 0.f, 0.f, 0.f};
        cur = nxt; cA = nA; cB = nB; ++ui;
        if constexpr (ALIGN_EPI) { if (wr == 1) PG8_BAR; }
    }
    PG8_WAIT_V(0);
    if constexpr (!ALIGN_EPI) { if (wr == 0) PG8_BAR; }
    PG8_BAR;
    if constexpr (Epi::AFTER_DRAIN) { E.fused(acc, cur, wr, wc, fr, fq, lds, wid, lane); S.done(cur); }
#undef PG8_SA
#undef PG8_SB
#undef PG8_STAGE
#undef PG8_LDA
#undef PG8_LDB
#undef PG8_MMA
#undef PG8_WAIT_V
#undef PG8_WAIT_L
#undef PG8_BAR
#undef PG8_SCHED
}
}
#include <hip/hip_bf16.h>
#include <cmath>
namespace attn_body {
using bf16=__hip_bfloat16;
using bf16x8=__attribute__((ext_vector_type(8)))short;
using s16x4=__attribute__((ext_vector_type(4)))short;
using f32x16=__attribute__((ext_vector_type(16)))float;
using u32x4=__attribute__((ext_vector_type(4)))unsigned;
constexpr int BATCH=2,NHEAD=16,SEQ=8192,D=64,DM=NHEAD*D;
constexpr int NW=8,QBLK=32,QB=QBLK*NW,KVBLK=64,NQB=SEQ/QB;
constexpr int ATTN_PITCH=DM, ATTN_UNIT_ROWS=QB;
__device__ __forceinline__ int crow(int r,int hi){return (r&3)+8*(r>>2)+4*hi;}
#define SBAR() __builtin_amdgcn_sched_barrier(0)
__device__ __forceinline__ void cmask(f32x16&p0,f32x16&p1,int jb,int qrel,int hi){
  const float NEG=-INFINITY; int kb=64*jb+4*hi;
  #pragma unroll
  for(int r=0;r<16;++r){int kv=kb+(r&3)+8*(r>>2); if(kv>qrel)p0[r]=NEG; if(kv+32>qrel)p1[r]=NEG;}
}

constexpr int NSLOT=3, SLOTB=9216;
constexpr int LDS_K=0, LDS_V=NSLOT*SLOTB, LDS_WS=2*NSLOT*SLOTB, LDS_OST=LDS_WS+NW*64*4, LDS_BYTES=LDS_OST+NW*4096;
constexpr float C2=0.125f*1.4426950408889634f;
__device__ __forceinline__ void glds16(const void*gsrc,unsigned lds_dst){unsigned keep;
  asm volatile("s_mov_b32 %0, m0\n\ts_mov_b32 m0, %2\n\ts_nop 0\n\tglobal_load_lds_dwordx4 %1, off\n\ts_mov_b32 m0, %0":"=&s"(keep):"v"(gsrc),"s"(lds_dst):"memory");}
__device__ __forceinline__ float max3f(float a,float b,float c){float r;asm("v_max3_f32 %0, %1, %2, %3":"=v"(r):"v"(a),"v"(b),"v"(c));return r;}
__device__ __forceinline__ float max2f(float a,float b){float r;asm("v_max_f32_e32 %0, %1, %2":"=v"(r):"v"(a),"v"(b));return r;}
__device__ __forceinline__ float fadd_s(float a,float b){float r;asm("v_add_f32_e32 %0, %1, %2":"=v"(r):"v"(a),"v"(b));return r;}
__device__ __forceinline__ float fsub_s(float a,float b){float r;asm("v_sub_f32_e32 %0, %1, %2":"=v"(r):"v"(a),"v"(b));return r;}
typedef float f32x2_t __attribute__((ext_vector_type(2))); typedef __bf16 bf16x2_t __attribute__((ext_vector_type(2)));
__device__ __forceinline__ unsigned cvtpk_s(float lo,float hi){f32x2_t v={lo,hi};bf16x2_t b=__builtin_convertvector(v,bf16x2_t);return __builtin_bit_cast(unsigned,b);}
#define WAIT_BAR(N) asm volatile("s_waitcnt vmcnt(" #N ") lgkmcnt(0)\n\ts_barrier":::"memory")
#define WAIT_BARW() do{ if(wid==0){WAIT_BAR(3);} else {WAIT_BAR(2);} }while(0)

__device__ __forceinline__ void qkt(f32x16&p0,f32x16&p1,const char*Kslot,const bf16x8*qr,const bf16x8 qe,const f32x16&negm,int r32,int hi){
  const char*kb=Kslot+hi*1024+r32*16;
  #pragma unroll
  for(int d0=0;d0<4;++d0){
    const bf16x8 b0=*reinterpret_cast<const bf16x8*>(kb+d0*2048);
    const bf16x8 b1=*reinterpret_cast<const bf16x8*>(kb+d0*2048+512);
    if(d0==0){p0=__builtin_amdgcn_mfma_f32_32x32x16_bf16(b0,qr[0],negm,0,0,0);p1=__builtin_amdgcn_mfma_f32_32x32x16_bf16(b1,qr[0],negm,0,0,0);}
    else{p0=__builtin_amdgcn_mfma_f32_32x32x16_bf16(b0,qr[d0],p0,0,0,0);p1=__builtin_amdgcn_mfma_f32_32x32x16_bf16(b1,qr[d0],p1,0,0,0);}}
  { const char*ke=Kslot+8192+r32*16; const bf16x8 e0=*reinterpret_cast<const bf16x8*>(ke),e1=*reinterpret_cast<const bf16x8*>(ke+512);
    p0=__builtin_amdgcn_mfma_f32_32x32x16_bf16(e0,qe,p0,0,0,0);p1=__builtin_amdgcn_mfma_f32_32x32x16_bf16(e1,qe,p1,0,0,0);}
}
typedef __attribute__((address_space(3))) const char* lds_cptr;
typedef short v4i16_t __attribute__((ext_vector_type(4)));
__device__ __forceinline__ void kload8(bf16x8*kf,lds_cptr kp){
  kf[0]=*(const __attribute__((address_space(3))) bf16x8*)(kp);      kf[1]=*(const __attribute__((address_space(3))) bf16x8*)(kp+512);
  kf[2]=*(const __attribute__((address_space(3))) bf16x8*)(kp+2048); kf[3]=*(const __attribute__((address_space(3))) bf16x8*)(kp+2560);
  kf[4]=*(const __attribute__((address_space(3))) bf16x8*)(kp+4096); kf[5]=*(const __attribute__((address_space(3))) bf16x8*)(kp+4608);
  kf[6]=*(const __attribute__((address_space(3))) bf16x8*)(kp+6144); kf[7]=*(const __attribute__((address_space(3))) bf16x8*)(kp+6656);
}
__device__ __forceinline__ void kload2(bf16x8*kf,lds_cptr kp,int j){ kf[2*j]=*(const __attribute__((address_space(3))) bf16x8*)(kp+j*2048); kf[2*j+1]=*(const __attribute__((address_space(3))) bf16x8*)(kp+j*2048+512); }
__device__ __forceinline__ s16x4 vtr(lds_cptr p){ return __builtin_bit_cast(s16x4,__builtin_amdgcn_ds_read_tr16_b64_v4i16((__attribute__((address_space(3))) v4i16_t*)p)); }
__device__ __forceinline__ float rowmax(const f32x16&p0,const f32x16&p1){
  float a=max3f(p0[0],p0[1],p1[0]),b=max3f(p0[2],p0[3],p1[1]);a=max3f(a,p1[2],p1[3]);
  #pragma unroll
  for(int r=4;r<16;r+=4){a=max3f(a,p0[r],p0[r+1]);b=max3f(b,p0[r+2],p0[r+3]);a=max3f(a,p1[r],p1[r+1]);b=max3f(b,p1[r+2],p1[r+3]);}
  const float m=max2f(a,b);
  auto rr=__builtin_amdgcn_permlane32_swap(__float_as_uint(m),__float_as_uint(m),false,false);
  return max2f(__uint_as_float(rr[0]),__uint_as_float(rr[1]));
}
__device__ __forceinline__ void pv(f32x16*o,int vb,bf16x8 pa0,bf16x8 pa1,bf16x8 pa2,bf16x8 pa3){
  #pragma unroll
  for(int d0=0;d0<2;++d0){s16x4 lo[4],hi[4];
    #pragma unroll
    for(int ks=0;ks<4;++ks){
      asm volatile("ds_read_b64_tr_b16 %0,%1 offset:%c2":"=&v"(lo[ks]):"v"(vb),"i"(d0*4096+ks*1024):"memory");
      asm volatile("ds_read_b64_tr_b16 %0,%1 offset:%c2":"=&v"(hi[ks]):"v"(vb),"i"(d0*4096+ks*1024+512):"memory");}
    asm volatile("s_waitcnt lgkmcnt(0)":::"memory");SBAR();
    #define PK(k) (bf16x8){lo[k][0],lo[k][1],lo[k][2],lo[k][3],hi[k][0],hi[k][1],hi[k][2],hi[k][3]}
    o[d0]=__builtin_amdgcn_mfma_f32_32x32x16_bf16(pa0,PK(0),o[d0],0,0,0);
    o[d0]=__builtin_amdgcn_mfma_f32_32x32x16_bf16(pa1,PK(1),o[d0],0,0,0);
    o[d0]=__builtin_amdgcn_mfma_f32_32x32x16_bf16(pa2,PK(2),o[d0],0,0,0);
    o[d0]=__builtin_amdgcn_mfma_f32_32x32x16_bf16(pa3,PK(3),o[d0],0,0,0);
    #undef PK
  }
}

#ifndef ATTN_STORE16
#define ATTN_STORE16(p,v) (*(u32x4*)(p)=(v))
#endif
template<int THRL> __device__ __forceinline__ void attn_unit(int b,int h,int qb,const bf16*Q,const bf16*__restrict__ K,const bf16*__restrict__ V,bf16*O,const bf16*__restrict__ GT,const unsigned char*__restrict__ G3,const float*__restrict__ qgain,const float kbound,char*shm,const int tid_in){
  int tid_l=tid_in; asm volatile("":"+v"(tid_l)); const int tid=tid_l,lane=tid&63,r32=lane&31,hi=lane>>5; const int wid=__builtin_amdgcn_readfirstlane(tid>>6);
  const long rowbase=(long)b*SEQ; const int q0=qb*QB;
  const bf16*Qw=Q+(rowbase+q0+wid*QBLK)*DM+h*D;
  const bf16*Kh=K+rowbase*DM+h*D,*Vh=V+rowbase*DM+h*D;
  const unsigned lds0=(unsigned)(uintptr_t)shm;
  float*wsf=(float*)(shm+LDS_WS)+wid*64;
  const bf16*ksrc=Kh+(long)lane*DM+wid*8;
  const bf16*vsrc=Vh+(long)(16*(wid&3)+(lane>>2))*DM+(wid>>2)*32+(lane&3)*8;
  const unsigned kdst=lds0+LDS_K+wid*1024, vdst=lds0+LDS_V+wid*1024, gdst=lds0+LDS_K+8192;
  const unsigned char*gsrc=G3+((long)(b*NHEAD+h)*SEQ+lane)*16;
  #define DMA_K(t,slot) do{ if(wid==0)glds16(gsrc+(long)(t)*KVBLK*16,(unsigned)__builtin_amdgcn_readfirstlane(gdst+(slot))); glds16(ksrc+(long)(t)*KVBLK*DM,(unsigned)__builtin_amdgcn_readfirstlane(kdst+(slot))); }while(0)
  #define DMA_V(t,slot) glds16(vsrc+(long)(t)*KVBLK*DM,(unsigned)__builtin_amdgcn_readfirstlane(vdst+(slot)))
  const int vb0=(int)(lds0+LDS_V)+((lane>>4)&1)*32+(lane&3)*8+(4*hi+((lane&15)>>2))*64;
  const char*Kbase=shm+LDS_K; bf16x8 kf[10];
  const lds_cptr shm3=(lds_cptr)shm; const lds_cptr kp0=shm3+LDS_K+hi*1024+r32*16; const lds_cptr kpe=shm3+LDS_K+8192+r32*16; const lds_cptr vp0=shm3+LDS_V+((lane>>4)&1)*32+(lane&3)*8+(4*hi+((lane&15)>>2))*64;
  const int NT=(q0+QB)/KVBLK;
  DMA_K(0,0);DMA_V(0,0);DMA_K(1,SLOTB);
  bf16x8 qr[4]; float fq2; bf16x8 qe; float ubound;
  { bf16x8 qraw[4];
    #pragma unroll
    for(int d0=0;d0<4;++d0)qraw[d0]=*reinterpret_cast<const bf16x8*>(&Qw[(long)r32*DM+d0*16+hi*8]);
    const u32x4 ge=*reinterpret_cast<const u32x4*>(G3+((long)(b*NHEAD+h)*SEQ+q0+wid*QBLK+r32)*16);
    fq2=-(__uint_as_float(ge[0]<<16)+__uint_as_float(ge[0]&0xffff0000u)+__uint_as_float(ge[1]<<16));
    float ss=0.f;
    #pragma unroll
    for(int d0=0;d0<4;++d0)
      #pragma unroll
      for(int j=0;j<8;++j){const float x=__uint_as_float(((unsigned)(unsigned short)qraw[d0][j])<<16);ss+=x*x;}
    {auto rr=__builtin_amdgcn_permlane32_swap(__float_as_uint(ss),__float_as_uint(ss),false,false);ss=__uint_as_float(rr[0])+__uint_as_float(rr[1]);}
    const float qs=C2/sqrtf(ss*(1.0f/64.0f)+1e-6f);
    float s2=0.f;
    #pragma unroll
    for(int d0=0;d0<4;++d0){ u32x4 w;
      #pragma unroll
      for(int j=0;j<8;j+=2){const float x0=__uint_as_float(((unsigned)(unsigned short)qraw[d0][j])<<16),x1=__uint_as_float(((unsigned)(unsigned short)qraw[d0][j+1])<<16);
        const float y0=x0*qs*qgain[d0*16+hi*8+j],y1=x1*qs*qgain[d0*16+hi*8+j+1]; s2+=y0*y0+y1*y1;
        w[j>>1]=cvtpk_s(y0,y1);}
      qr[d0]=__builtin_bit_cast(bf16x8,w);}
    {auto rr=__builtin_amdgcn_permlane32_swap(__float_as_uint(s2),__float_as_uint(s2),false,false);s2=__uint_as_float(rr[0])+__uint_as_float(rr[1]);}
    ubound=sqrtf(s2)*kbound;
    const unsigned one2=hi?0u:0x3f803f80u, one1=hi?0u:0x00003f80u; qe=__builtin_bit_cast(bf16x8,(u32x4){one2,one1,0u,0u}); }
  float mhat=ubound,l_reg=0.f;f32x16 o[2];o[0]=f32x16{};o[1]=f32x16{};f32x16 negm;
  #pragma unroll
  for(int r=0;r<16;++r)negm[r]=fq2-ubound;
  asm volatile("":"+v"(negm));
  const int qrel=wid*QBLK+r32;
  #define CMASK(P0,P1,t) do{int jb_=(t)-(NT-4); if(jb_>=0)cmask(P0,P1,jb_,qrel,hi);}while(0)
  bool resc=false;
  #define START(P0,P1) do{ const float rm=rowmax(P0,P1); resc=false; \
    { const float dl=fmaxf(rm,0.f); mhat=fadd_s(mhat,dl); \
      _Pragma("unroll") for(int r=0;r<16;++r){P0[r]=fsub_s(P0[r],dl);P1[r]=fsub_s(P1[r],dl);} \
      _Pragma("unroll") for(int r=0;r<16;++r)negm[r]=fq2-mhat; asm volatile("":"+v"(negm)); } \
    _Pragma("unroll") for(int r=0;r<16;++r)P0[r]=__builtin_amdgcn_exp2f(P0[r]); }while(0)
  #define RESC() do{ if(resc){ asm volatile("s_waitcnt lgkmcnt(0)":::"memory"); \
      _Pragma("unroll") for(int d_=0;d_<2;++d_) _Pragma("unroll") for(int r=0;r<16;++r)o[d_][r]*=wsf[crow(r,hi)]; } }while(0)
  f32x16 pA0,pA1,pB0,pB1;
  int sl_prev=0,sl_cur=0,sl_next=SLOTB;
  #define ROT() do{sl_prev=sl_cur;sl_cur=sl_next;sl_next=(sl_next==(NSLOT-1)*SLOTB)?0:sl_next+SLOTB;}while(0)
  DMA_K(2,2*SLOTB);
  WAIT_BAR(3);
  qkt(pA0,pA1,Kbase,qr,qe,negm,r32,hi);asm volatile("s_nop 15\n\ts_nop 7":"+v"(pA0),"+v"(pA1));CMASK(pA0,pA1,0);
  START(pA0,pA1);
  _Pragma("unroll") for(int r=0;r<16;++r)pA1[r]=__builtin_amdgcn_exp2f(pA1[r]);
  WAIT_BAR(0);
  DMA_K(3,0);DMA_V(1,SLOTB);
  ROT();
  kload8(kf,kp0+sl_cur);
  kf[8]=*(const __attribute__((address_space(3))) bf16x8*)(kpe+sl_cur); kf[9]=*(const __attribute__((address_space(3))) bf16x8*)(kpe+sl_cur+512);
  WAIT_BARW();
  s16x4 vlo[8],vhi[8]; u32x4 pw0,pw1,pw2,pw3;
  #define PKW(P,B) cvtpk_s(P[B],P[B+1])
  #define PAF(k) __builtin_bit_cast(bf16x8,pw##k)
  #define VFR(i) (bf16x8){vlo[i][0],vlo[i][1],vlo[i][2],vlo[i][3],vhi[i][0],vhi[i][1],vhi[i][2],vhi[i][3]}
  #define PIN(x) asm volatile("":"+v"(x))
  #define MX3(a,b,c) __builtin_fmaxf(__builtin_fmaxf((a),(b)),(c))
  #define GAPA(MF,A0,A1,A2,A3,W0,W1,PW) do{ MF; sacc+=A0; sacc+=A1; sacc+=A2; sacc+=A3; PIN(sacc); W0; W1; PIN(PW); SBAR(); }while(0)
  #define EX(v) __builtin_amdgcn_exp2f(v)
  #define GAPB(MF,X,B) do{ MF; X[B]=EX(X[B]); X[B+1]=EX(X[B+1]); X[B+2]=EX(X[B+2]); X[B+3]=EX(X[B+3]); PIN(X); SBAR(); }while(0)
  #define VRD(i) do{ vlo[i]=vtr(vp_+(((i)>>2)*4096+((i)&3)*1024)); vhi[i]=vtr(vp_+(((i)>>2)*4096+((i)&3)*1024+512)); }while(0)
  #define KRD(G,j) do{ if(G){ kload2(kf,kp0+sl_next,j); SBAR(); } }while(0)
  #define STEP(C0,C1,P0,P1,t,GK,GV,GL) do{ SBAR(); \
    const lds_cptr vp_=vp0+sl_prev; \
    VRD(0); SBAR(); float sacc=(P0[0]+P0[1]); \
    GAPA(C0=__builtin_amdgcn_mfma_f32_32x32x16_bf16(kf[0],qr[0],negm,0,0,0), P0[2],P0[3],P0[4],P0[5],     pw0[0]=PKW(P0,0), pw0[1]=PKW(P0,2), pw0); \
    VRD(4); SBAR(); GAPA(C1=__builtin_amdgcn_mfma_f32_32x32x16_bf16(kf[1],qr[0],negm,0,0,0), P0[6],P0[7],P0[8],P0[9],     pw0[2]=PKW(P0,4), pw0[3]=PKW(P0,6), pw0); \
    VRD(1); SBAR(); GAPA(C0=__builtin_amdgcn_mfma_f32_32x32x16_bf16(kf[2],qr[1],C0,0,0,0),   P0[10],P0[11],P0[12],P0[13], pw1[0]=PKW(P0,8), pw1[1]=PKW(P0,10), pw1); \
    VRD(5); SBAR(); GAPA(C1=__builtin_amdgcn_mfma_f32_32x32x16_bf16(kf[3],qr[1],C1,0,0,0),   P0[14],P0[15],P1[0],P1[1],   pw1[2]=PKW(P0,12),pw1[3]=PKW(P0,14), pw1); \
    VRD(2); SBAR(); GAPA(C0=__builtin_amdgcn_mfma_f32_32x32x16_bf16(kf[4],qr[2],C0,0,0,0),   P1[2],P1[3],P1[4],P1[5],     pw2[0]=PKW(P1,0), pw2[1]=PKW(P1,2), pw2); \
    VRD(6); SBAR(); GAPA(C1=__builtin_amdgcn_mfma_f32_32x32x16_bf16(kf[5],qr[2],C1,0,0,0),   P1[6],P1[7],P1[8],P1[9],     pw2[2]=PKW(P1,4), pw2[3]=PKW(P1,6), pw2); \
    VRD(3); SBAR(); GAPA(C0=__builtin_amdgcn_mfma_f32_32x32x16_bf16(kf[6],qr[3],C0,0,0,0),   P1[10],P1[11],P1[12],P1[13], pw3[0]=PKW(P1,8), pw3[1]=PKW(P1,10), pw3); \
    VRD(7); SBAR(); GAPA(C1=__builtin_amdgcn_mfma_f32_32x32x16_bf16(kf[7],qr[3],C1,0,0,0),   P1[14],P1[15],0.f,0.f,       pw3[2]=PKW(P1,12),pw3[3]=PKW(P1,14), pw3); \
    C0=__builtin_amdgcn_mfma_f32_32x32x16_bf16(kf[8],qe,C0,0,0,0); C1=__builtin_amdgcn_mfma_f32_32x32x16_bf16(kf[9],qe,C1,0,0,0); \
    l_reg+=sacc; \
    if(GK){DMA_K((t)+3,sl_cur);} if(GV){DMA_V((t)+1,sl_next);} \
    CMASK(C0,C1,t); \
    resc=false;     \
    SBAR(); \
    GAPB(o[0]=__builtin_amdgcn_mfma_f32_32x32x16_bf16(PAF(0),VFR(0),o[0],0,0,0), C0,0); \
    GAPB(o[1]=__builtin_amdgcn_mfma_f32_32x32x16_bf16(PAF(0),VFR(4),o[1],0,0,0), C0,4); \
    KRD(GL,0); GAPB(o[0]=__builtin_amdgcn_mfma_f32_32x32x16_bf16(PAF(1),VFR(1),o[0],0,0,0), C0,8); \
    KRD(GL,1); GAPB(o[1]=__builtin_amdgcn_mfma_f32_32x32x16_bf16(PAF(1),VFR(5),o[1],0,0,0), C0,12); \
    KRD(GL,2); GAPB(o[0]=__builtin_amdgcn_mfma_f32_32x32x16_bf16(PAF(2),VFR(2),o[0],0,0,0), C1,0); \
    KRD(GL,3); GAPB(o[1]=__builtin_amdgcn_mfma_f32_32x32x16_bf16(PAF(2),VFR(6),o[1],0,0,0), C1,4); \
    if(GL){ kf[8]=*(const __attribute__((address_space(3))) bf16x8*)(kpe+sl_next); kf[9]=*(const __attribute__((address_space(3))) bf16x8*)(kpe+sl_next+512); SBAR(); } \
    GAPB(o[0]=__builtin_amdgcn_mfma_f32_32x32x16_bf16(PAF(3),VFR(3),o[0],0,0,0), C1,8); \
    GAPB(o[1]=__builtin_amdgcn_mfma_f32_32x32x16_bf16(PAF(3),VFR(7),o[1],0,0,0), C1,12); \
    }while(0)
  int t=1;
  #undef CMASK
  #define CMASK(P0,P1,t) do{}while(0)
  for(;t+5<NT;t+=2){
    STEP(pB0,pB1,pA0,pA1,t,true,true,true);     WAIT_BARW(); RESC(); ROT();
    STEP(pA0,pA1,pB0,pB1,t+1,true,true,true);   WAIT_BARW(); RESC(); ROT();
  }
  #undef CMASK
  #define CMASK(P0,P1,t) do{int jb_=(t)-(NT-4); if(jb_>=0)cmask(P0,P1,jb_,qrel,hi);}while(0)
  #define ENDW(tt) do{ if((tt)+3<NT){WAIT_BARW();} else if((tt)+2<NT){WAIT_BAR(1);} else {WAIT_BAR(0);} }while(0)
  for(;t+1<NT;t+=2){
    STEP(pB0,pB1,pA0,pA1,t,(t+3<NT),(t+1<NT),(t+1<NT));       ENDW(t);   RESC(); ROT();
    STEP(pA0,pA1,pB0,pB1,t+1,(t+4<NT),(t+2<NT),(t+2<NT));     ENDW(t+1); RESC(); ROT();
  }
  STEP(pB0,pB1,pA0,pA1,NT-1,false,false,false); RESC();
  { float sacc=pB0[0]+pB0[1]; _Pragma("unroll") for(int r=2;r<16;++r)sacc+=pB0[r]; _Pragma("unroll") for(int r=0;r<16;++r)sacc+=pB1[r]; l_reg+=sacc;
    pw0=(u32x4){PKW(pB0,0),PKW(pB0,2),PKW(pB0,4),PKW(pB0,6)};pw1=(u32x4){PKW(pB0,8),PKW(pB0,10),PKW(pB0,12),PKW(pB0,14)};pw2=(u32x4){PKW(pB1,0),PKW(pB1,2),PKW(pB1,4),PKW(pB1,6)};pw3=(u32x4){PKW(pB1,8),PKW(pB1,10),PKW(pB1,12),PKW(pB1,14)};
    SBAR(); pv(o,vb0+sl_cur,PAF(0),PAF(1),PAF(2),PAF(3)); }
  #undef PKW
  #undef PAF
  #undef VFR
  #undef PIN
  #undef MX3
  #undef GAPA
  #undef GAPB
  #undef EX
  #undef VRD
  #undef KRD
  #undef STEP
  #undef ENDW
  {auto rr=__builtin_amdgcn_permlane32_swap(__float_as_uint(l_reg),__float_as_uint(l_reg),false,false);l_reg=__uint_as_float(rr[0])+__uint_as_float(rr[1]);}
  if(hi==0)wsf[32+r32]=l_reg;asm volatile("s_waitcnt lgkmcnt(0)":::"memory");
  float rli[16];
  #pragma unroll
  for(int r=0;r<16;++r)rli[r]=__builtin_amdgcn_rcpf(wsf[32+crow(r,hi)]);
  bf16*Ow=O+(rowbase+q0+wid*QBLK)*DM+h*D;
  { bf16*stg=(bf16*)(shm+LDS_OST)+wid*2048;
    #pragma unroll
    for(int r=0;r<16;++r){const int orow=crow(r,hi);
      #pragma unroll
      for(int d0=0;d0<2;++d0)stg[orow*64+d0*32+r32]=__float2bfloat16(o[d0][r]*rli[r]);}
    asm volatile("s_waitcnt lgkmcnt(0)":::"memory");
    const bf16*Gw=GT+(rowbase+q0+wid*QBLK)*DM+h*D;
    #pragma unroll
    for(int i=0;i<4;++i){const int row=i*8+(lane>>3),ch=lane&7; u32x4 v=*(const u32x4*)(stg+row*64+ch*8); const u32x4 gg=*(const u32x4*)(Gw+(long)row*DM+ch*8);
      #pragma unroll
      for(int j=0;j<4;++j){ v[j]=cvtpk_s(__uint_as_float(v[j]<<16)*__uint_as_float(gg[j]<<16),__uint_as_float(v[j]&0xffff0000u)*__uint_as_float(gg[j]&0xffff0000u)); }
      ATTN_STORE16(Ow+(long)row*DM+ch*8,v);} }
  asm volatile("s_waitcnt lgkmcnt(0)\n\ts_barrier":::"memory");
  #undef DMA_K
  #undef DMA_V
  #undef CMASK
  #undef START
  #undef RESC
  #undef ROT
}
constexpr int ATTN_LDS_BYTES=LDS_BYTES;
struct AttnTensors { const bf16* Q; const bf16* K; const bf16* V; bf16* O; const bf16* GT; const unsigned char* G3; const float* qgain; float kbound; };
struct AttnUnit { int bh; int qb; };
struct StaticOrder {
  int vcu;
  __device__ __forceinline__ explicit StaticOrder(int grid,int block):vcu((block%8)*(grid/8)+block/8){}
  __device__ __forceinline__ bool next(int i,AttnUnit&u)const{ if(i>=4)return false; const int s=vcu&7; u.bh=vcu>>3; u.qb=(i==0)?s:(i==1)?15-s:(i==2)?16+s:31-s; return true; }
  __device__ __forceinline__ void a_ready(const AttnUnit&)const{}
  __device__ __forceinline__ void done(const AttnUnit&)const{}
};
template<class Sched,int THRL=8> __device__ __forceinline__ void attn_phase(char*lds,const AttnTensors&T,const Sched&S,const int tid_in){
  AttnUnit u;
  for(int i=0;S.next(i,u);++i){ S.a_ready(u); attn_unit<THRL>(u.bh/NHEAD,u.bh%NHEAD,u.qb,T.Q,T.K,T.V,T.O,T.GT,T.G3,T.qgain,T.kbound,lds,tid_in); S.done(u); }
}
#undef SBAR
#undef WAIT_BAR
#undef WAIT_BARW
}
constexpr int NWAVES = 8;
constexpr int BATCH = 2, T = 8192, D = 1024, H = 16, HD = 64, FF = 4096, M = BATCH * T;
constexpr int N1 = 3584, K1 = 2048, NP2 = 3072;
constexpr size_t MiB = 1u << 20;
constexpr size_t WS_MOD = 0;
constexpr size_t WS_W1 = 1 * MiB;
constexpr size_t WS_W2A = 29 * MiB;
constexpr size_t WS_W2G = 32 * MiB;
constexpr size_t WS_WO = 33 * MiB;
constexpr size_t WS_WKV = 37 * MiB;
constexpr size_t WS_WQG = 42 * MiB;
constexpr size_t WS_WO2 = 50 * MiB;
constexpr size_t WS_WUP = 54 * MiB, WS_WDN = 62 * MiB;
constexpr size_t WS_G3 = 70 * MiB;
constexpr size_t WS_FL = 74 * MiB;
constexpr size_t WS_H2 = 76 * MiB;
constexpr size_t WS_P1 = 140 * MiB;
constexpr size_t WS_P2 = 252 * MiB;
constexpr size_t WS_VF = 348 * MiB;
constexpr size_t WS_HB = 140 * MiB;
constexpr size_t WS_KVRAW = 140 * MiB, WS_QB = 204 * MiB, WS_GT = 236 * MiB, WS_VS = 316 * MiB, WS_KS = 348 * MiB;
constexpr size_t WS_END = 380 * MiB;
constexpr int LDS_BYTES = 147456;

#define GAS __attribute__((address_space(1)))
#define LAS __attribute__((address_space(3)))
typedef unsigned short bf16;
typedef unsigned v4u __attribute__((ext_vector_type(4)));
typedef unsigned v2u __attribute__((ext_vector_type(2)));
typedef float f32x4 __attribute__((ext_vector_type(4)));
using pg8::pkbf; using pg8::bflo; using pg8::bfhi; using pg8::sigm;

struct Args { const float* in[39]; float* out; unsigned char* ws; int ph_lo, ph_hi; };

struct Frame { LAS unsigned char* lds; int tid, lane, wave, vcu, G, bx; unsigned char* ws; float* out; const float* const* in; };

__device__ __forceinline__ void tr_item(const float* W, int ldw, int Nvalid, bf16* WT, int ldt, int row_off, int col_off, const float* mu, LAS float* scr, int item, int lane) {
    const int nblk = (Nvalid + 31) / 32, kb = item / nblk, nb = item % nblk, k0 = 64 * kb, n0 = 32 * nb;
    { float t[32]; const int n = n0 + (lane & 31); const bool ok = n < Nvalid; const float* wp = W + (size_t)(k0 + (lane >> 5)) * ldw + n;
#pragma unroll
      for (int i = 0; i < 32; ++i) t[i] = ok ? wp[(size_t)(2 * i) * ldw] : 0.f;
#pragma unroll
      for (int i = 0; i < 32; ++i) scr[(2 * i + (lane >> 5)) * 33 + (lane & 31)] = t[i]; }
    asm volatile("s_waitcnt lgkmcnt(0)" ::: "memory");
    const int c = lane & 7;
    float s0[8], s1[8];
#pragma unroll
    for (int q = 0; q < 8; ++q) { const float m = mu ? mu[k0 + 8 * c + q] : 0.f; s0[q] = 1.f - m; s1[q] = m; }
#pragma unroll
    for (int j = 0; j < 4; ++j) { const int n = (lane >> 3) + 8 * j; const LAS float* s = scr + (8 * c) * 33 + n;
        float v[8];
#pragma unroll
        for (int q = 0; q < 8; ++q) v[q] = s[q * 33];
        v4u o; o.x = pkbf(v[0] * s0[0], v[1] * s0[1]); o.y = pkbf(v[2] * s0[2], v[3] * s0[3]); o.z = pkbf(v[4] * s0[4], v[5] * s0[5]); o.w = pkbf(v[6] * s0[6], v[7] * s0[7]);
        bf16* dst = WT + (size_t)(row_off + n0 + n) * ldt + col_off + k0 + 8 * c;
        *(v4u*)dst = o;
        if (mu) { v4u p; p.x = pkbf(v[0] * s1[0], v[1] * s1[1]); p.y = pkbf(v[2] * s1[2], v[3] * s1[3]); p.z = pkbf(v[4] * s1[4], v[5] * s1[5]); p.w = pkbf(v[6] * s1[6], v[7] * s1[7]); *(v4u*)(dst + 1024) = p; } }
    asm volatile("s_waitcnt lgkmcnt(0)" ::: "memory");
}
__device__ __forceinline__ float dpp_f(float x, const int ctrl_sel) {
    switch (ctrl_sel) {
        case 0: return __builtin_bit_cast(float, __builtin_amdgcn_update_dpp(0, __builtin_bit_cast(int, x), 0xB1, 0xf, 0xf, false));
        case 1: return __builtin_bit_cast(float, __builtin_amdgcn_update_dpp(0, __builtin_bit_cast(int, x), 0x4E, 0xf, 0xf, false));
        case 2: return __builtin_bit_cast(float, __builtin_amdgcn_update_dpp(0, __builtin_bit_cast(int, x), 0x141, 0xf, 0xf, false));
        default: return __builtin_bit_cast(float, __builtin_amdgcn_update_dpp(0, __builtin_bit_cast(int, x), 0x140, 0xf, 0xf, false));
    }
}
__device__ __forceinline__ float sum4(float x) { x += dpp_f(x, 0); x += dpp_f(x, 1); return x; }
__device__ __forceinline__ float sum8(float x) { x = sum4(x); x += dpp_f(x, 2); return x; }
__device__ __forceinline__ float sum16(float x) { x = sum8(x); x += dpp_f(x, 3); return x; }
__device__ __forceinline__ float wave_sum(float v) {
    v = sum16(v);
    { auto rr = __builtin_amdgcn_permlane16_swap(__float_as_uint(v), __float_as_uint(v), false, false); v = __uint_as_float(rr[0]) + __uint_as_float(rr[1]); }
    { auto rr = __builtin_amdgcn_permlane32_swap(__float_as_uint(v), __float_as_uint(v), false, false); v = __uint_as_float(rr[0]) + __uint_as_float(rr[1]); }
    return v;
}
__device__ __forceinline__ void norm_row(const float* xrow, const float* g, const float* sh, const float* sc, int lane, f32x4 (&v)[4]) {
    float s = 0.f;
#pragma unroll
    for (int j = 0; j < 4; ++j) { v[j] = *((const f32x4*)xrow + lane + 64 * j); s += (v[j].x * v[j].x + v[j].y * v[j].y) + (v[j].z * v[j].z + v[j].w * v[j].w); }
    const float rstd = 1.0f / sqrtf(wave_sum(s) * (1.f / D) + 1e-6f);
#pragma unroll
    for (int j = 0; j < 4; ++j) { const f32x4 gg = *((const f32x4*)g + lane + 64 * j);
        f32x4 a = {1.f, 1.f, 1.f, 1.f}, b = {0.f, 0.f, 0.f, 0.f}; if (sc) { a = *((const f32x4*)sc + lane + 64 * j) + 1.0f; b = *((const f32x4*)sh + lane + 64 * j); }
        v[j] = (v[j] * rstd * gg) * a + b; }
}
__device__ __forceinline__ void st_row_bf16(bf16* orow, int lane, const f32x4 (&v)[4]) {
#pragma unroll
    for (int j = 0; j < 4; ++j) { v2u w; w.x = pkbf(v[j].x, v[j].y); w.y = pkbf(v[j].z, v[j].w); *((v2u*)orow + lane + 64 * j) = w; }
}
__device__ __forceinline__ void p0_mod(Frame& F) {
    LAS float* ca = (LAS float*)F.lds; LAS float* red = (LAS float*)(F.lds + 8192);
    const float* cin = F.in[1];
    for (int i = F.tid; i < 2048; i += 512) { const float c = cin[i]; ca[i] = c / (1.0f + __expf(-c)); }
    __syncthreads();
    float* MOD = (float*)(F.ws + WS_MOD); float* MODKV = MOD + 4 * 2 * 6144;
    for (int item = F.bx; item < 208; item += F.G) {
        const int col = item * 128; const float* W; const float* bias; int ldw, cw; float* dst0; float* dst1;
        if (col < 24576) { const int l = col / 6144; cw = col % 6144; W = F.in[2] + (size_t)l * 1024 * 6144; ldw = 6144; bias = F.in[3] + l * 6144; dst0 = MOD + (l * 2 + 0) * 6144 + cw; dst1 = MOD + (l * 2 + 1) * 6144 + cw; }
        else { cw = col - 24576; W = F.in[30]; ldw = 2048; bias = F.in[31]; dst0 = MODKV + cw; dst1 = MODKV + 2048 + cw; }
        const int c4 = F.tid & 31, ks = F.tid >> 5;
        f32x4 a0 = {0.f, 0.f, 0.f, 0.f}, a1 = {0.f, 0.f, 0.f, 0.f};
#pragma unroll 8
        for (int k = ks * 64; k < ks * 64 + 64; ++k) { const f32x4 w = *(const f32x4*)(W + (size_t)k * ldw + cw + c4 * 4); a0 += w * ca[k]; a1 += w * ca[1024 + k]; }
        *(LAS f32x4*)(red + (ks * 32 + c4) * 8) = a0; *(LAS f32x4*)(red + (ks * 32 + c4) * 8 + 4) = a1;
        __syncthreads();
        if (F.tid < 256) { const int b = F.tid >> 7, c = F.tid & 127; float s = 0.f;
#pragma unroll
            for (int q = 0; q < 16; ++q) s += red[(q * 32 + (c >> 2)) * 8 + b * 4 + (c & 3)];
            (b ? dst1 : dst0)[c] = s + bias[cw + c]; }
        __syncthreads();
    }
}
__device__ __forceinline__ void p0_weights(Frame& F) {
    LAS float* scr = (LAS float*)(F.lds + 16384 + F.wave * 16384);
    const int gw = F.vcu * NWAVES + F.wave, NGW = F.G * NWAVES;
    bf16* W1 = (bf16*)(F.ws + WS_W1); bf16* WO = (bf16*)(F.ws + WS_WO); bf16* WKV = (bf16*)(F.ws + WS_WKV); bf16* WQG = (bf16*)(F.ws + WS_WQG); bf16* WO2 = (bf16*)(F.ws + WS_WO2);
    const float* mu = F.in[8];
    constexpr int PL = 512 * 3 + 32 + 32 + 16 + 80 + 512;
    constexpr int NIT = 2 * PL + 512 + 512 + 16 + 2 * (1024 + 512);
    for (int it = gw; it < NIT; it += NGW) {
        int r = it;
        if (r < 2 * PL) { const int i = r / PL; r -= i * PL; bf16* w1 = W1 + (size_t)i * N1 * K1; const float* m6 = mu + i * 6 * 1024;
            bf16* wl = w1 + (size_t)3072 * 1024;
            if (r < 512) { tr_item(F.in[9] + (size_t)i * D * D, D, D, w1, D, 0, 0, nullptr, scr, r, F.lane); continue; } r -= 512;
            if (r < 512) { tr_item(F.in[10] + (size_t)i * D * D, D, D, w1, D, 1024, 0, nullptr, scr, r, F.lane); continue; } r -= 512;
            if (r < 512) { tr_item(F.in[11] + (size_t)i * D * D, D, D, w1, D, 2048, 0, nullptr, scr, r, F.lane); continue; } r -= 512;
            if (r < 32) { tr_item(F.in[14] + (size_t)i * D * 64, 64, 64, wl, K1, 0, 0, m6 + 1 * 1024, scr, r, F.lane); continue; } r -= 32;
            if (r < 32) { tr_item(F.in[17] + (size_t)i * D * 64, 64, 64, wl, K1, 64, 0, m6 + 4 * 1024, scr, r, F.lane); continue; } r -= 32;
            if (r < 16) { if (i == 1) tr_item(F.in[27], 32, 32, wl, K1, 128, 0, m6 + 3 * 1024, scr, r, F.lane); continue; } r -= 16;
            if (r < 80) { tr_item(F.in[19] + (size_t)i * D * 160, 160, 160, wl, K1, 160, 0, m6 + 5 * 1024, scr, r, F.lane); continue; } r -= 80;
            tr_item(F.in[12] + (size_t)i * D * D, D, D, WO + (size_t)i * D * D, D, 0, 0, nullptr, scr, r, F.lane); continue; }
        r -= 2 * PL;
        if (r < 512) { tr_item(F.in[32], 2064, 1024, WKV, D, 0, 0, nullptr, scr, r, F.lane); continue; } r -= 512;
        if (r < 512) { tr_item(F.in[32] + 1024, 2064, 1024, WKV, D, 1024, 0, nullptr, scr, r, F.lane); continue; } r -= 512;
        if (r < 16) { tr_item(F.in[32] + 2048, 2064, 16, WKV, D, 2048, 0, nullptr, scr, r, F.lane); continue; } r -= 16;
        { const int j = r / 1536; r -= j * 1536;
          if (r < 1024) tr_item(F.in[35] + (size_t)j * D * 2048, 2048, 2048, WQG + (size_t)j * 2048 * D, D, 0, 0, nullptr, scr, r, F.lane);
          else tr_item(F.in[37] + (size_t)j * D * D, D, D, WO2 + (size_t)j * D * D, D, 0, 0, nullptr, scr, r - 1024, F.lane); }
    }
    const int gt = F.bx * 512 + F.tid, NT = F.G * 512; const v4u z = {0u, 0u, 0u, 0u};
    for (int e = gt; e < 135168; e += NT) {
        int r = e; bf16* p;
        if (r < 98304) { const int i = r / 49152; r -= i * 49152; p = W1 + (size_t)i * N1 * K1 + (size_t)3072 * 1024 + (size_t)320 * K1 + (size_t)r * 8; }
        else if (r < 98304 + 8192) { r -= 98304; p = W1 + (size_t)3072 * 1024 + (size_t)128 * K1 + (size_t)r * 8; }
        else { r -= 98304 + 8192; p = WKV + (size_t)2080 * D + (size_t)r * 8; }
        *(v4u*)p = z; }
    { float* B2 = (float*)(F.ws + WS_MOD) + 53248;
      for (int e = gt; e < 2 * 3072; e += NT) { const int i = e / 3072, n = e % 3072, grp = n >> 10, c = n & 1023;
          B2[e] = grp == 0 ? F.in[13][i * D + c] : (grp == 1 ? F.in[16][i * D + c] : (i == 1 ? F.in[26][c] : 0.f)); } }
    bf16* W2A = (bf16*)(F.ws + WS_W2A); bf16* W2G = (bf16*)(F.ws + WS_W2G);
    for (int e4 = gt; e4 < 2 * 262144; e4 += NT) {
        const int i = e4 >> 18; int r = (e4 & 262143) * 4;
        if (r < 786432) { const int k = r / 3072, n = r % 3072, grp = n >> 10, c = n & 1023; f32x4 v = {0.f, 0.f, 0.f, 0.f};
            if (grp == 0) { if (k < 64) v = *(const f32x4*)(F.in[15] + ((size_t)i * 64 + k) * 1024 + c); }
            else if (grp == 1) { if (k >= 64 && k < 128) v = *(const f32x4*)(F.in[18] + ((size_t)i * 64 + (k - 64)) * 1024 + c); }
            else { if (i == 1 && k >= 128 && k < 160) v = *(const f32x4*)(F.in[28] + (size_t)(k - 128) * 1024 + c); }
            bf16* o = W2A + (size_t)i * 3072 * 256 + (size_t)n * 256 + k; const unsigned p0 = pkbf(v.x, v.y), p1 = pkbf(v.z, v.w);
            o[0] = (bf16)(p0 & 0xffffu); o[256] = (bf16)(p0 >> 16); o[512] = (bf16)(p1 & 0xffffu); o[768] = (bf16)(p1 >> 16); }
        else { r -= 786432; const int k = r >> 10, n = r & 1023; f32x4 v = {0.f, 0.f, 0.f, 0.f}; if (k < 160) v = *(const f32x4*)(F.in[20] + ((size_t)i * 160 + k) * 1024 + n);
            bf16* o = W2G + (size_t)i * 1024 * 256 + (size_t)n * 256 + k; const unsigned p0 = pkbf(v.x, v.y), p1 = pkbf(v.z, v.w);
            o[0] = (bf16)(p0 & 0xffffu); o[256] = (bf16)(p0 >> 16); o[512] = (bf16)(p1 & 0xffffu); o[768] = (bf16)(p1 >> 16); }
    }
}
__device__ __forceinline__ void mlp_weights(Frame& F, int L) {
    LAS float* scr = (LAS float*)(F.lds + F.wave * 16384);
    const int gw = F.vcu * NWAVES + F.wave, NGW = F.G * NWAVES;
    bf16* WUP = (bf16*)(F.ws + WS_WUP); bf16* WDN = (bf16*)(F.ws + WS_WDN);
    for (int it = gw; it < 4096; it += NGW) {
        if (it < 2048) tr_item(F.in[6] + (size_t)L * D * FF, FF, FF, WUP, D, 0, 0, nullptr, scr, it, F.lane);
        else tr_item(F.in[7] + (size_t)L * FF * D, D, D, WDN, FF, 0, 0, nullptr, scr, it - 2048, F.lane);
    }
}
__device__ __forceinline__ void norm_phase(Frame& F, const float* xin, const float* g, const float* sh, const float* sc, int bstride, int mode, bf16* dst, float* outf = nullptr) {
    const int gw = F.vcu * NWAVES + F.wave, NGW = F.G * NWAVES, lane = F.lane; (void)mode;
    for (int base = gw * 8; base < M; base += NGW * 8) {
        const int b = base >> 13;
        f32x4 gg[4], aa[4], bb[4];
#pragma unroll
        for (int j = 0; j < 4; ++j) { gg[j] = *((const f32x4*)g + lane + 64 * j);
            aa[j] = sc ? *((const f32x4*)(sc + b * bstride) + lane + 64 * j) + 1.0f : (f32x4){1.f, 1.f, 1.f, 1.f}; bb[j] = sh ? *((const f32x4*)(sh + b * bstride) + lane + 64 * j) : (f32x4){0.f, 0.f, 0.f, 0.f}; }
        f32x4 xn[4];
#pragma unroll
        for (int j = 0; j < 4; ++j) xn[j] = *((const f32x4*)(xin + (size_t)base * D) + lane + 64 * j);
#pragma unroll 1
        for (int r = 0; r < 8; ++r) { const int m = base + r; f32x4 v[4]; float s = 0.f;
#pragma unroll
            for (int j = 0; j < 4; ++j) { v[j] = xn[j]; s += (v[j].x * v[j].x + v[j].y * v[j].y) + (v[j].z * v[j].z + v[j].w * v[j].w); }
            if (r + 1 < 8) {
#pragma unroll
                for (int j = 0; j < 4; ++j) xn[j] = *((const f32x4*)(xin + (size_t)(m + 1) * D) + lane + 64 * j); }
            const float rstd = 1.0f / sqrtf(wave_sum(s) * (1.f / D) + 1e-6f);
#pragma unroll
            for (int j = 0; j < 4; ++j) v[j] = (v[j] * rstd * gg[j]) * aa[j] + bb[j];
            if (outf) {
#pragma unroll
                for (int j = 0; j < 4; ++j) *((f32x4*)(outf + (size_t)m * D) + lane + 64 * j) = v[j]; }
            else st_row_bf16(dst + (size_t)m * 1024, lane, v);
        }
    }
}
__device__ __forceinline__ void norm_mix_phase(Frame& F, const float* xin, const float* g, const float* sh, const float* sc, const float* mu, bf16* H2p, bf16* XJ) {
    const int gw = F.vcu * NWAVES + F.wave, NGW = F.G * NWAVES, lane = F.lane;
    for (int base = gw * 8; base < M; base += NGW * 8) {
        const int b = base >> 13;
        f32x4 gg[4], aa[4], bb[4], m0[4], m1[4], m2[4];
#pragma unroll
        for (int j = 0; j < 4; ++j) { gg[j] = *((const f32x4*)g + lane + 64 * j); aa[j] = *((const f32x4*)(sc + b * 6144) + lane + 64 * j) + 1.0f; bb[j] = *((const f32x4*)(sh + b * 6144) + lane + 64 * j);
            m0[j] = *((const f32x4*)mu + lane + 64 * j); m1[j] = *((const f32x4*)(mu + 2048) + lane + 64 * j); m2[j] = *((const f32x4*)(mu + 3072) + lane + 64 * j); }
        const bool first = (base & 8191) == 0; const int r0 = first ? 0 : -1;
        f32x4 hp[4], xn[4];
#pragma unroll
        for (int j = 0; j < 4; ++j) { hp[j] = (f32x4){0.f, 0.f, 0.f, 0.f}; xn[j] = *((const f32x4*)(xin + (size_t)(base + r0) * D) + lane + 64 * j); }
#pragma unroll 1
        for (int r = r0; r < 8; ++r) { const int m = base + r; f32x4 v[4];
            float s = 0.f;
#pragma unroll
            for (int j = 0; j < 4; ++j) { v[j] = xn[j]; s += (v[j].x * v[j].x + v[j].y * v[j].y) + (v[j].z * v[j].z + v[j].w * v[j].w); }
            if (r + 1 < 8) {
#pragma unroll
                for (int j = 0; j < 4; ++j) xn[j] = *((const f32x4*)(xin + (size_t)(m + 1) * D) + lane + 64 * j); }
            const float rstd = 1.0f / sqrtf(wave_sum(s) * (1.f / D) + 1e-6f);
#pragma unroll
            for (int j = 0; j < 4; ++j) v[j] = (v[j] * rstd * gg[j]) * aa[j] + bb[j];
            if (r >= 0) {
                st_row_bf16(H2p + (size_t)m * 2048, lane, v); st_row_bf16(H2p + (size_t)m * 2048 + 1024, lane, hp);
                f32x4 x[4];
#pragma unroll
                for (int j = 0; j < 4; ++j) x[j] = v[j] + (hp[j] - v[j]) * m0[j];
                st_row_bf16(XJ + (size_t)m * D, lane, x);
#pragma unroll
                for (int j = 0; j < 4; ++j) x[j] = v[j] + (hp[j] - v[j]) * m1[j];
                st_row_bf16(XJ + (size_t)M * D + (size_t)m * D, lane, x);
#pragma unroll
                for (int j = 0; j < 4; ++j) x[j] = v[j] + (hp[j] - v[j]) * m2[j];
                st_row_bf16(XJ + (size_t)2 * M * D + (size_t)m * D, lane, x);
            }
#pragma unroll
            for (int j = 0; j < 4; ++j) hp[j] = v[j]; }
    }
}
__device__ __forceinline__ void final_norm_phase(Frame& F) { norm_phase(F, F.out, F.in[38], nullptr, nullptr, 0, 1, nullptr, F.out); }
#ifndef PROBE_SC
#define PROBE_SC 0
#endif
constexpr int SC_C = 32, SC_NC = T / SC_C;
constexpr int SC_VEC = 0, SC_SCAL = 36864, SC_V = 37120, SC_Y = 38144, SC_BUF = 54528;
typedef float f32x2s __attribute__((ext_vector_type(2)));
__device__ __forceinline__ float dot4(const f32x4 s, const f32x4 a) { f32x2s t = (f32x2s){s.x, s.y} * (f32x2s){a.x, a.y}; t = (f32x2s){s.z, s.w} * (f32x2s){a.z, a.w} + t; return t.x + t.y; }
__device__ __forceinline__ void scan_chunk(const LAS unsigned char* Bc, f32x4& S, const int kq, const int rowi) {
                const LAS f32x4* pvec = (const LAS f32x4*)(Bc + SC_VEC) + kq; const LAS f32x4* psc = (const LAS f32x4*)(Bc + SC_SCAL);
                const LAS float* pv = (const LAS float*)(Bc + SC_V) + rowi; LAS float* py = (LAS float*)(Bc + SC_Y) + rowi * 16 + kq;
                f32x4 cv[9], cs; float c0, c1;
#pragma unroll
                for (int j = 0; j < 9; ++j) cv[j] = pvec[j * 16];
                cs = psc[0]; c0 = pv[0]; c1 = pv[8];
#pragma unroll
                for (int p = 0; p < SC_C / 2; ++p) {
                    f32x4 nv[9], ns; float n0, n1;
                    if (p + 1 < SC_C / 2) {
#pragma unroll
                        for (int j = 0; j < 9; ++j) nv[j] = pvec[((p + 1) * 9 + j) * 16];
                        ns = psc[p + 1]; n0 = pv[(2 * p + 2) * 8]; n1 = pv[(2 * p + 3) * 8];
                    }
                    __builtin_amdgcn_sched_barrier(0);
                    float p1 = dot4(S, cv[0]), p2 = dot4(S, cv[1]); const float p3 = dot4(S, cv[2]);
                    p1 += dpp_f(p1, 0); p2 += dpp_f(p2, 0);
                    p1 += dpp_f(p1, 1); p2 += dpp_f(p2, 1);
                    p1 += dpp_f(p1, 2); p2 += dpp_f(p2, 2);
                    p1 += dpp_f(p1, 3); p2 += dpp_f(p2, 3);
                    const float sa1 = fmaf(c0, cs.w, p2);
                    const float y0 = p3 + ((kq == 0) ? c0 * cs.y : 0.f);
                    const f32x4 t0 = S * cv[3] + cv[4] * p1 + cv[5] * c0 + cv[7] * c1;
                    S = t0 + cv[6] * sa1;
                    const float y1 = dot4(S, cv[8]);
                    py[(2 * p) * 128] = y0; py[(2 * p + 1) * 128] = y1;
                    if (p + 1 < SC_C / 2) {
#pragma unroll
                        for (int j = 0; j < 9; ++j) cv[j] = nv[j];
                        cs = ns; c0 = n0; c1 = n1;
                    }
                }
}
__device__ __forceinline__ void scan_phase(Frame& F, int L) {
    const bf16* P1 = (const bf16*)(F.ws + WS_P1); const bf16* P2 = (const bf16*)(F.ws + WS_P2); const bf16* VF = (const bf16*)(F.ws + WS_VF); float* Y = (float*)(F.ws + WS_H2);
    const float* kkw = F.in[21] + L * D; const float* kaw = F.in[22] + L * D;
    const int lane = F.lane;
    int wave;
    { LAS unsigned* tb = (LAS unsigned*)(F.lds + LDS_BYTES - 2048);
      const unsigned simd = ((unsigned)__builtin_amdgcn_s_getreg((1 << 11) | (4 << 6) | 4)) & 3u;
      if (lane == 0) tb[F.wave] = simd;
      __syncthreads();
      unsigned sd[8];
#pragma unroll
      for (int w = 0; w < 8; ++w) sd[w] = tb[w];
      int B = 1;
#pragma unroll
      for (int w = 7; w >= 1; --w) if (sd[w] != sd[0]) B = w;
      int total_non = 0, non_before = 0, share_before = 0; bool my_share = false;
#pragma unroll
      for (int w = 1; w < 8; ++w) { const bool sh = (sd[w] == sd[0]) || (sd[w] == sd[B]); const bool other = (w != B);
          if (other && !sh) { ++total_non; if (w < F.wave) ++non_before; }
          if (other && sh && w < F.wave) ++share_before;
          if (w == F.wave) my_share = sh; }
      int role;
      if (F.wave == 0) role = 0; else if (F.wave == B) role = 1; else role = my_share ? (2 + total_non + share_before) : (2 + non_before);
      wave = __builtin_amdgcn_readfirstlane(role);
      __syncthreads(); }
    for (int item = F.bx; item < 256; item += F.G) {
        const int bh = (item & 7) + 8 * (item >> 6), rg = (item >> 3) & 7, b = bh >> 4, h = bh & 15;
        const size_t m0 = (size_t)b * T;
        const int hidx = (wave - 2) * 64 + lane, hp = (hidx >> 4) & 15, hc4 = hidx & 15;
        const int vtt = lane >> 1, vr4 = (lane & 1) * 4;
        float ckk[4], cka[4];
        v2u lr[2][2], lk[2][2], lw[2][2], la[2][2]; v2u lv[2], lvm[2], lvf[2];
#pragma unroll
        for (int q = 0; q < 2; ++q) { lv[q] = (v2u){0u,0u}; lvm[q] = (v2u){0u,0u}; lvf[q] = (v2u){0u,0u};
#pragma unroll
            for (int u = 0; u < 2; ++u) { lr[q][u] = (v2u){0u,0u}; lk[q][u] = (v2u){0u,0u}; lw[q][u] = (v2u){0u,0u}; la[q][u] = (v2u){0u,0u}; } }
        if (wave >= 2 && wave < 6) {
#pragma unroll
            for (int j = 0; j < 4; ++j) { ckk[j] = kkw[h * 64 + hc4 * 4 + j]; cka[j] = kaw[h * 64 + hc4 * 4 + j]; } }
#define SC_LOAD(c, Q) do { \
        if (wave >= 2 && wave < 6) { _Pragma("unroll") for (int u = 0; u < 2; ++u) { const size_t m = m0 + (size_t)(c) * SC_C + 2 * hp + u; const bf16* p1 = P1 + m * N1 + h * 64 + hc4 * 4; const bf16* p2 = P2 + m * NP2 + h * 64 + hc4 * 4; \
            lr[Q][u] = *(const v2u*)p1; lk[Q][u] = *(const v2u*)(p1 + 1024); lw[Q][u] = *(const v2u*)p2; la[Q][u] = *(const v2u*)(p2 + 1024); } } \
        else if (wave == 6) { const size_t m = m0 + (size_t)(c) * SC_C + vtt; const int cc = h * 64 + rg * 8 + vr4; \
            lv[Q] = *(const v2u*)(P1 + m * N1 + 2048 + cc); if (L == 1) { lvm[Q] = *(const v2u*)(P2 + m * NP2 + 2048 + cc); lvf[Q] = *(const v2u*)(VF + m * D + cc); } } } while (0)
#define SC_PREP(buf, Q) do { LAS unsigned char* B_ = F.lds + (buf) * SC_BUF; \
        if (wave >= 2 && wave < 6) { f32x4 an[2], bb[2], k2[2], ww[2], rr[2]; \
            _Pragma("unroll") for (int u = 0; u < 2; ++u) { \
                const float kr[4] = {bflo(lk[Q][u].x), bfhi(lk[Q][u].x), bflo(lk[Q][u].y), bfhi(lk[Q][u].y)}, av[4] = {bflo(la[Q][u].x), bfhi(la[Q][u].x), bflo(la[Q][u].y), bfhi(la[Q][u].y)}; \
                const float wn[4] = {bflo(lw[Q][u].x), bfhi(lw[Q][u].x), bflo(lw[Q][u].y), bfhi(lw[Q][u].y)}, rv[4] = {bflo(lr[Q][u].x), bfhi(lr[Q][u].x), bflo(lr[Q][u].y), bfhi(lr[Q][u].y)}; \
                float kv_[4], ss = 0.f; \
                _Pragma("unroll") for (int j = 0; j < 4; ++j) { kv_[j] = kr[j] * ckk[j]; ss += kv_[j] * kv_[j]; } \
                ss = sum16(ss); const float inv = 1.0f / fmaxf(sqrtf(ss), 1e-12f); \
                _Pragma("unroll") for (int j = 0; j < 4; ++j) { const float kk = kv_[j] * inv; an[u][j] = -kk; bb[u][j] = kk * av[j]; k2[u][j] = kr[j] * (1.0f + (av[j] - 1.0f) * cka[j]); ww[u][j] = __expf(wn[j]); rr[u][j] = rv[j]; } } \
            LAS f32x4* V_ = (LAS f32x4*)(B_ + SC_VEC) + (hp * 9) * 16 + hc4; \
            float s0 = dot4(bb[0], rr[0]), s1 = dot4(k2[0], rr[0]), s2 = dot4(bb[0], an[1]), s3 = dot4(k2[0], an[1]); \
            s0 = sum16(s0); s1 = sum16(s1); s2 = sum16(s2); s3 = sum16(s3); \
            V_[0 * 16] = an[0]; V_[1 * 16] = ww[0] * an[1] + an[0] * s2; V_[2 * 16] = ww[0] * rr[0] + an[0] * s0; V_[3 * 16] = ww[0] * ww[1]; V_[4 * 16] = bb[0] * ww[1]; V_[5 * 16] = k2[0] * ww[1]; V_[6 * 16] = bb[1]; V_[7 * 16] = k2[1]; V_[8 * 16] = rr[1]; \
            if (hc4 == 0) *(LAS f32x4*)(B_ + SC_SCAL + hp * 16) = (f32x4){s0, s1, s2, s3}; } \
        else if (wave == 6) { float v_[4] = {bflo(lv[Q].x), bfhi(lv[Q].x), bflo(lv[Q].y), bfhi(lv[Q].y)}; \
            if (L == 1) { const float f_[4] = {bflo(lvf[Q].x), bfhi(lvf[Q].x), bflo(lvf[Q].y), bfhi(lvf[Q].y)}, g_[4] = {bflo(lvm[Q].x), bfhi(lvm[Q].x), bflo(lvm[Q].y), bfhi(lvm[Q].y)}; \
                _Pragma("unroll") for (int j = 0; j < 4; ++j) v_[j] = v_[j] + (f_[j] - v_[j]) * g_[j]; } \
            *(LAS f32x4*)(B_ + SC_V + (vtt * 8 + vr4) * 4) = (f32x4){v_[0], v_[1], v_[2], v_[3]}; } } while (0)
#define SC_YRED(bufi) f32x4 yv; do { const LAS f32x4* q_ = (const LAS f32x4*)(F.lds + (bufi) * SC_BUF + SC_Y) + (vtt * 8 + vr4) * 4; \
            _Pragma("unroll") for (int r_ = 0; r_ < 4; ++r_) { const f32x4 t0 = q_[r_ * 4], t1 = q_[r_ * 4 + 1], t2 = q_[r_ * 4 + 2], t3 = q_[r_ * 4 + 3]; const f32x4 t = (t0 + t1) + (t2 + t3); yv[r_] = (t.x + t.y) + (t.z + t.w); } } while (0)
        SC_LOAD(0, 0); SC_PREP(0, 0); SC_LOAD(1, 1);
        __syncthreads();
        f32x4 S = {0.f, 0.f, 0.f, 0.f};
        const int rl = lane >> 4, kq = lane & 15, rowi = (wave & 1) * 4 + rl;
#define SC_ITER(c, QL, QP) do { const int buf = (c) & 1; \
            if (wave < 2) { if (PROBE_SC == 2) { f32x4 S2 = S; scan_chunk(F.lds + buf * SC_BUF, S2, kq, rowi); asm volatile("" :: "v"(S2) : "memory"); } scan_chunk(F.lds + buf * SC_BUF, S, kq, rowi); } \
            else { if ((c) + 2 < SC_NC) SC_LOAD((c) + 2, QL); \
                if ((c) + 1 < SC_NC) SC_PREP(buf ^ 1, QP); \
                if (PROBE_SC == 1 && (c) + 1 < SC_NC) { asm volatile("" ::: "memory"); SC_PREP(buf ^ 1, QP); } \
                if (wave == 7 && (c) > 0) { SC_YRED(buf ^ 1); *(f32x4*)(Y + (m0 + (size_t)((c) - 1) * SC_C + vtt) * D + h * 64 + rg * 8 + vr4) = yv; } } \
            asm volatile("s_waitcnt lgkmcnt(0)\n\ts_barrier" ::: "memory"); } while (0)
        for (int c = 0; c < SC_NC; c += 2) { SC_ITER(c, 0, 1); SC_ITER(c + 1, 1, 0); }
#undef SC_ITER
        if (wave == 7) { SC_YRED((SC_NC - 1) & 1);
            *(f32x4*)(Y + (m0 + (size_t)(SC_NC - 1) * SC_C + vtt) * D + h * 64 + rg * 8 + vr4) = yv; }
        __syncthreads();
#undef SC_LOAD
#undef SC_PREP
#undef SC_YRED
    }
}
__device__ __forceinline__ void post_phase(Frame& F, int L) {
    const bf16* P1 = (const bf16*)(F.ws + WS_P1); const bf16* P2 = (const bf16*)(F.ws + WS_P2); bf16* VF = (bf16*)(F.ws + WS_VF); float* Y = (float*)(F.ws + WS_H2);
    const int gw = F.vcu * NWAVES + F.wave, NGW = F.G * NWAVES, lane = F.lane, c0 = lane * 16;
    const float* kaw = F.in[22] + L * D + c0; const float* rkw = F.in[23] + L * D + c0; const float* lnw = F.in[24] + L * D + c0; const float* lnb = F.in[25] + L * D + c0;
    for (int m = gw; m < M; m += NGW) {
        float y[16], r[16], k[16], v[16], a[16];
        const float* yp = Y + (size_t)m * D + c0;
#pragma unroll
        for (int q = 0; q < 4; ++q) { const f32x4 t = *(const f32x4*)(yp + 4 * q); y[4 * q] = t.x; y[4 * q + 1] = t.y; y[4 * q + 2] = t.z; y[4 * q + 3] = t.w; }
        const bf16* p1 = P1 + (size_t)m * N1 + c0; const bf16* p2 = P2 + (size_t)m * NP2 + c0;
        v4u rv[2], kv[2], vv[2], av[2];
#pragma unroll
        for (int q = 0; q < 2; ++q) { rv[q] = *(const v4u*)(p1 + 8 * q); kv[q] = *(const v4u*)(p1 + 1024 + 8 * q); vv[q] = *(const v4u*)(p1 + 2048 + 8 * q); av[q] = *(const v4u*)(p2 + 1024 + 8 * q); }
#pragma unroll
        for (int q = 0; q < 2; ++q)
#pragma unroll
            for (int j = 0; j < 4; ++j) { r[8 * q + 2 * j] = bflo(rv[q][j]); r[8 * q + 2 * j + 1] = bfhi(rv[q][j]); k[8 * q + 2 * j] = bflo(kv[q][j]); k[8 * q + 2 * j + 1] = bfhi(kv[q][j]);
                v[8 * q + 2 * j] = bflo(vv[q][j]); v[8 * q + 2 * j + 1] = bfhi(vv[q][j]); a[8 * q + 2 * j] = bflo(av[q][j]); a[8 * q + 2 * j + 1] = bfhi(av[q][j]); }
        if (L == 0) { *(v4u*)(VF + (size_t)m * D + c0) = vv[0]; *(v4u*)(VF + (size_t)m * D + c0 + 8) = vv[1]; }
        else { v4u fv[2], gv[2];
#pragma unroll
            for (int q = 0; q < 2; ++q) { fv[q] = *(const v4u*)(VF + (size_t)m * D + c0 + 8 * q); gv[q] = *(const v4u*)(p2 + 2048 + 8 * q); }
#pragma unroll
            for (int q = 0; q < 2; ++q)
#pragma unroll
                for (int j = 0; j < 4; ++j) { const float f0 = bflo(fv[q][j]), f1 = bfhi(fv[q][j]), g0 = bflo(gv[q][j]), g1 = bfhi(gv[q][j]);
                    v[8 * q + 2 * j] += (f0 - v[8 * q + 2 * j]) * g0; v[8 * q + 2 * j + 1] += (f1 - v[8 * q + 2 * j + 1]) * g1; } }
        float s = 0.f, bd = 0.f;
#pragma unroll
        for (int j = 0; j < 16; ++j) { s += y[j]; const float k2 = k[j] * (1.0f + (a[j] - 1.0f) * kaw[j]); bd += r[j] * k2 * rkw[j]; }
        s = sum4(s); bd = sum4(bd);
        const float mean = s * (1.0f / 64.0f); float q2 = 0.f;
#pragma unroll
        for (int j = 0; j < 16; ++j) { const float d = y[j] - mean; q2 += d * d; }
        q2 = sum4(q2);
        const float rstd = 1.0f / sqrtf(q2 * (1.0f / 64.0f) + 64e-5f);
        float o[16];
#pragma unroll
        for (int j = 0; j < 16; ++j) o[j] = (y[j] - mean) * rstd * lnw[j] + lnb[j] + bd * v[j];
        bf16* yn = (bf16*)(Y + (size_t)m * D) + c0;
        v4u w0, w1; w0.x = pkbf(o[0], o[1]); w0.y = pkbf(o[2], o[3]); w0.z = pkbf(o[4], o[5]); w0.w = pkbf(o[6], o[7]); w1.x = pkbf(o[8], o[9]); w1.y = pkbf(o[10], o[11]); w1.z = pkbf(o[12], o[13]); w1.w = pkbf(o[14], o[15]);
        *(v4u*)yn = w0; *(v4u*)(yn + 8) = w1;
    }
}
__device__ __forceinline__ void kvpost_phase(Frame& F) {
    const bf16* KV = (const bf16*)(F.ws + WS_KVRAW); bf16* KS = (bf16*)(F.ws + WS_KS); bf16* VS = (bf16*)(F.ws + WS_VS);
    const int gw = F.vcu * NWAVES + F.wave, NGW = F.G * NWAVES, lane = F.lane, c0 = lane * 16;
    const float* kg = F.in[34] + (c0 & 63);
    for (int m = gw; m < M; m += NGW) {
        const bf16* p = KV + (size_t)m * 2048 + c0; v4u kv[2], vv[2];
#pragma unroll
        for (int q = 0; q < 2; ++q) { kv[q] = *(const v4u*)(p + 8 * q); vv[q] = *(const v4u*)(p + 1024 + 8 * q); }
        float k[16], ss = 0.f;
#pragma unroll
        for (int q = 0; q < 2; ++q)
#pragma unroll
            for (int j = 0; j < 4; ++j) { k[8 * q + 2 * j] = bflo(kv[q][j]); k[8 * q + 2 * j + 1] = bfhi(kv[q][j]); }
#pragma unroll
        for (int j = 0; j < 16; ++j) ss += k[j] * k[j];
        ss = sum4(ss); const float rs = 1.0f / sqrtf(ss * (1.0f / 64.0f) + 1e-6f);
        v4u w0, w1;
        w0.x = pkbf(k[0] * rs * kg[0], k[1] * rs * kg[1]); w0.y = pkbf(k[2] * rs * kg[2], k[3] * rs * kg[3]); w0.z = pkbf(k[4] * rs * kg[4], k[5] * rs * kg[5]); w0.w = pkbf(k[6] * rs * kg[6], k[7] * rs * kg[7]);
        w1.x = pkbf(k[8] * rs * kg[8], k[9] * rs * kg[9]); w1.y = pkbf(k[10] * rs * kg[10], k[11] * rs * kg[11]); w1.z = pkbf(k[12] * rs * kg[12], k[13] * rs * kg[13]); w1.w = pkbf(k[14] * rs * kg[14], k[15] * rs * kg[15]);
        *(v4u*)(KS + (size_t)m * D + c0) = w0; *(v4u*)(KS + (size_t)m * D + c0 + 8) = w1;
        *(v4u*)(VS + (size_t)m * D + c0) = vv[0]; *(v4u*)(VS + (size_t)m * D + c0 + 8) = vv[1];
    }
    if (gw < 32) {
        const int bh = gw, b = bh >> 4, h = bh & 15; const float* FL = (const float*)(F.ws + WS_FL) + ((size_t)b * T + (size_t)lane * 128) * 16 + h; const float fb = F.in[33][h];
        v4u* G3 = (v4u*)(F.ws + WS_G3) + (size_t)bh * T + (size_t)lane * 128;
        float tot = 0.f;
#pragma unroll 8
        for (int i = 0; i < 128; ++i) { const float x = FL[(size_t)i * 16] + fb; tot += -(fmaxf(-x, 0.f) + log1pf(__expf(-fabsf(x)))); }
        float inc = tot;
#pragma unroll
        for (int o = 1; o < 64; o <<= 1) { const float n = __int_as_float(__builtin_amdgcn_ds_bpermute((lane - o) << 2, __float_as_int(inc))); if (lane >= o) inc += n; }
        float run = inc - tot;
#pragma unroll 8
        for (int i = 0; i < 128; ++i) { const float x = FL[(size_t)i * 16] + fb; run += -(fmaxf(-x, 0.f) + log1pf(__expf(-fabsf(x))));
            const float gv = -run * 1.4426950408889634f;
            const unsigned hi = pkbf(gv, 0.f) & 0xffffu; const float r1 = gv - __uint_as_float(hi << 16);
            const unsigned mid = pkbf(r1, 0.f) & 0xffffu; const float r2 = r1 - __uint_as_float(mid << 16);
            const unsigned lo = pkbf(r2, 0.f) & 0xffffu;
            G3[i] = (v4u){hi | (mid << 16), lo, 0u, 0u}; }
    }
}
constexpr size_t WS_BAR = 512 * 1024, BAR_BYTES = 16384; constexpr int MISC_OFF = LDS_BYTES - 1024;
#define RLX_AGENT __ATOMIC_RELAXED, __HIP_MEMORY_SCOPE_AGENT
#define LDS_WAIT() asm volatile("s_waitcnt lgkmcnt(0)" ::: "memory")
#define VM_WAIT() asm volatile("s_waitcnt vmcnt(0)" ::: "memory")
__device__ __forceinline__ unsigned long long rt() { return __builtin_amdgcn_s_memrealtime(); }
__device__ __forceinline__ unsigned f2bf(float f) { unsigned u = __builtin_bit_cast(unsigned, f); return (u + 0x7fffu + ((u >> 16) & 1u)) >> 16; }
__device__ __forceinline__ unsigned pk2(float lo, float hi) { return f2bf(lo) | (f2bf(hi) << 16); }

#define XB_TMO      128
#define XB_XCNT(j)  (256  + 64 * (j))
#define XB_XSUB(j)  (1280 + 64 * (j))
#define XB_XGEN(j)  (2304 + 64 * (j))
#define XB_TOP      3328
#define XB_TOPGEN   3392
#define XCD_BAR_WORDS 3456
#define XB_SPIN_CAP (1u << 18)

__device__ __forceinline__ unsigned xb_ld(unsigned* p)              { return __hip_atomic_load(p, __ATOMIC_RELAXED, __HIP_MEMORY_SCOPE_AGENT); }
__device__ __forceinline__ unsigned xb_add(unsigned* p, unsigned v) { return __hip_atomic_fetch_add(p, v, __ATOMIC_RELAXED, __HIP_MEMORY_SCOPE_AGENT); }
__device__ __forceinline__ unsigned xb_xcc_id() { return (unsigned)__builtin_amdgcn_s_getreg((3 << 11) | 20) & 0xFu; }
#define XB_SPIN(cond, bar) do { unsigned _sp = 0; while (cond) { __builtin_amdgcn_s_sleep(1); \
    if ((++_sp & 255u) == 0u) { if (xb_ld(&(bar)[XB_TMO])) break; if (_sp > XB_SPIN_CAP) { atomicAdd(&(bar)[XB_TMO], 1u); break; } } } } while (0)

struct XcdBarrier {
    unsigned* bar; unsigned x;
    volatile LAS unsigned* st;
};

__device__ __forceinline__ XcdBarrier xcd_barrier_post(unsigned* bar, volatile LAS unsigned* st, const int tid) {
    XcdBarrier b; b.bar = bar; b.x = xb_xcc_id(); b.st = st;
    if (tid == 0) (void)xb_add(&bar[XB_XCNT(b.x)], 1u);
    return b;
}
__device__ __forceinline__ void xcd_barrier_complete(unsigned* bar, unsigned x, unsigned& nloc, unsigned& nx) {
    const unsigned G = gridDim.x * gridDim.y * gridDim.z;
    unsigned sum, cnt, mine, sp = 0u;
    for (;;) {
        sum = 0u; cnt = 0u; mine = 0u;
#pragma unroll
        for (unsigned j = 0; j < 16; ++j) { const unsigned c = xb_ld(&bar[XB_XCNT(j)]); sum += c; cnt += (c > 0u) ? 1u : 0u; mine = (j == x) ? c : mine; }
        if (sum == G) break;
        __builtin_amdgcn_s_sleep(1);
        if ((++sp & 255u) == 0u) { if (xb_ld(&bar[XB_TMO])) break; if (sp > XB_SPIN_CAP) { atomicAdd(&bar[XB_TMO], 1u); break; } }
    }
    nloc = mine > 0u ? mine : 1u; nx = cnt > 0u ? cnt : 1u;
}

__device__ __forceinline__ void xcd_barrier(const XcdBarrier& b, const int tid) {
    asm volatile("s_waitcnt vmcnt(0)" ::: "memory");
    __syncthreads();
    if (tid == 0) {
        unsigned* bar = b.bar;
        __builtin_amdgcn_s_waitcnt(0);
        unsigned nloc = b.st[0], nx = b.st[1];
        if (nloc == 0u) { xcd_barrier_complete(bar, b.x, nloc, nx); b.st[0] = nloc; b.st[1] = nx; }
        const unsigned old = xb_add(&bar[XB_XSUB(b.x)], 1u);
        const unsigned gen = old / nloc;
        if (old + 1u == (gen + 1u) * nloc) {
            __builtin_amdgcn_fence(__ATOMIC_RELEASE, "agent");
            asm volatile("s_waitcnt vmcnt(0)" ::: "memory");
            const unsigned og = xb_add(&bar[XB_TOP], 1u);
            const unsigned tg = og / nx;
            if (og + 1u == (tg + 1u) * nx) xb_add(&bar[XB_TOPGEN], 1u);
            else XB_SPIN(xb_ld(&bar[XB_TOPGEN]) == tg, bar);
            __builtin_amdgcn_fence(__ATOMIC_ACQUIRE, "agent");
            xb_add(&bar[XB_XGEN(b.x)], 1u);
            asm volatile("s_waitcnt vmcnt(0)" ::: "memory");
        } else {
            XB_SPIN(xb_ld(&bar[XB_XGEN(b.x)]) == gen, bar);
            __builtin_amdgcn_fence(__ATOMIC_ACQUIRE, "agent");
            asm volatile("s_waitcnt vmcnt(0)" ::: "memory");
        }
    }
    __syncthreads();
}
#define GEMM_CALL(FN, Aptr, Bptr, Nn, Kk, LDA, LDB, ...) GEMM_CALL_G(FN, Aptr, Bptr, Nn, Kk, LDA, LDB, 0, 0, __VA_ARGS__)
#define GEMM_CALL_G(FN, Aptr, Bptr, Nn, Kk, LDA, LDB, AGRP, ASTEP, ...) GEMM_CALL_S(StaticOrder, FN, Aptr, Bptr, Nn, Kk, LDA, LDB, AGRP, ASTEP, __VA_ARGS__)
#define GEMM_CALL_S(ORD, FN, Aptr, Bptr, Nn, Kk, LDA, LDB, AGRP, ASTEP, ...) do { pg8::Gemm g_{(const pg8::bf16_t*)(Aptr), (const pg8::bf16_t*)(Bptr), M, (Nn), (Kk), (LDA), (LDB), (AGRP), (size_t)(ASTEP)}; pg8::ORD S_; S_.init(M, (Nn), F.G, F.bx); \
    pg8::Epi8<pg8::FN> E_{{__VA_ARGS__}}; pg8::gemm_phase<pg8::Epi8<pg8::FN>, pg8::ORD, true, true>(F.lds, g_, S_, E_, F.tid); } while (0)
constexpr int N_PHASES = 42;
__global__ void __launch_bounds__(NWAVES * 64, 2) yoco_fwd(Args args) {
    extern __shared__ __attribute__((aligned(16))) unsigned char lds[];
    cg::grid_group grid = cg::this_grid();
    Frame F;
    const int wave_s = __builtin_amdgcn_readfirstlane((int)threadIdx.x >> 6);
    F.lds = (LAS unsigned char*)lds; F.tid = threadIdx.x; F.lane = F.tid & 63; F.wave = wave_s;
    F.G = gridDim.x; F.bx = blockIdx.x; F.vcu = F.bx;
    F.ws = args.ws; F.out = args.out; F.in = args.in;
    unsigned char* ws = args.ws;
    const int lo = args.ph_lo, hi = args.ph_hi; const bool one = (hi - lo) > 1;
#define LAUNDER() do { int t_ = wave_s * 64 + (int)__builtin_amdgcn_mbcnt_hi(~0u, __builtin_amdgcn_mbcnt_lo(~0u, 0u)); asm volatile("" : "+v"(t_)); F.tid = t_; F.lane = t_ & 63; F.wave = __builtin_amdgcn_readfirstlane(t_ >> 6); \
        int z_ = 0; asm volatile("" : "+v"(z_)); z_ = __builtin_amdgcn_readfirstlane(z_); ws = args.ws + z_; F.ws = ws; F.in = args.in + z_; F.out = args.out + z_; F.bx = (int)blockIdx.x + z_; F.G = (int)gridDim.x + z_; F.vcu = (F.G % 8 == 0) ? (F.bx % 8) * (F.G / 8) + F.bx / 8 : F.bx; } while (0)
#define IN(k) (lo <= (k) && (k) < hi)
#ifndef PROBE_BAR
#define PROBE_BAR 0
#endif
#ifndef PROBE_PH
#define PROBE_PH (-1)
#endif
#define PHASE(k) if (IN(k)) for (int rep_ = 0; rep_ < (((k) == PROBE_PH) ? 2 : 1); ++rep_)
#define SEAM() do { if (one) { unsigned zz_ = 0u; asm volatile("" : "+v"(zz_)); const int st_ = wave_s * 64 + (int)__builtin_amdgcn_mbcnt_hi(~0u, __builtin_amdgcn_mbcnt_lo(~0u, zz_)); xcd_barrier(xbar, st_); if (PROBE_BAR) xcd_barrier(xbar, st_); } } while (0)
#define MOD_ ((float*)(ws + WS_MOD))
#define MODKV_ (MOD_ + 4 * 2 * 6144)
#define H2_ ((bf16*)(ws + WS_H2))
#define XN_ ((bf16*)(ws + WS_H2))
#define XNKV_ ((bf16*)(ws + WS_H2 + 32 * MiB))
#define P1_ ((bf16*)(ws + WS_P1))
#define P2_ ((bf16*)(ws + WS_P2))
#define HB_ ((bf16*)(ws + WS_HB))
#define QB_ ((bf16*)(ws + WS_QB))
#define GT_ ((bf16*)(ws + WS_GT))
#define XIN1_ ((L == 0) ? F.in[0] : (const float*)F.out)
#define MODL_ (MOD_ + L * 2 * 6144)

    volatile LAS unsigned* MISC = (volatile LAS unsigned*)(F.lds + MISC_OFF);
    if (F.tid < 32) MISC[F.tid] = 0u;
    __syncthreads();
    XcdBarrier xbar; xbar.bar = (unsigned*)(args.ws + WS_BAR); xbar.x = 0; xbar.st = MISC + 8;
    if (one) xbar = xcd_barrier_post((unsigned*)(args.ws + WS_BAR), MISC + 8, F.tid);
    PHASE(0) { LAUNDER(); p0_mod(F); p0_weights(F); if (one) grid.sync(); }
    { constexpr int L = 0;
        const int pb = 1 + L * 10;
        if (L < 2) {
            PHASE(pb + 0) { LAUNDER(); norm_mix_phase(F, XIN1_, F.in[4] + L * D, MODL_, MODL_ + 1024, F.in[8] + L * 6 * 1024, H2_, P2_); SEAM(); }
            PHASE(pb + 1) { LAUNDER(); GEMM_CALL(FnP1, H2_, ws + WS_W1 + (size_t)L * N1 * K1 * 2 + (size_t)3072 * 1024 * 2, 512, K1, K1, K1, P1_, 3072);
                LAUNDER();
                if (F.G == 256) GEMM_CALL_S(SplitOrder, FnP1, P2_, ws + WS_W1 + (size_t)L * N1 * K1 * 2, 3072, D, D, D, 4, (size_t)M * D * 2, P1_, 0);
                else GEMM_CALL_G(FnP1, P2_, ws + WS_W1 + (size_t)L * N1 * K1 * 2, 3072, D, D, D, 4, (size_t)M * D * 2, P1_, 0);
                SEAM(); }
            PHASE(pb + 2) { LAUNDER(); GEMM_CALL(FnP2, P1_ + 3072, ws + WS_W2A + (size_t)L * 3072 * 256 * 2, (L == 0 ? 2048 : NP2), 256, N1, 256, P2_, MOD_ + 53248 + L * 3072); SEAM(); }
            PHASE(pb + 3) { LAUNDER(); scan_phase(F, L); SEAM(); }
            PHASE(pb + 4) { LAUNDER(); post_phase(F, L); SEAM(); }
            PHASE(pb + 5) { LAUNDER(); GEMM_CALL(FnGate, P1_ + 3232, ws + WS_W2G + (size_t)L * 1024 * 256 * 2, D, 256, N1, 256, H2_, 2048); SEAM(); }
            PHASE(pb + 6) { LAUNDER(); GEMM_CALL(FnRes, H2_, ws + WS_WO + (size_t)L * D * D * 2, D, D, 2048, D, XIN1_, F.out, MODL_ + 2 * 1024); SEAM(); }
        } else {
            const int j = L - 2;
            PHASE(pb + 0) { LAUNDER(); norm_phase(F, F.out, F.in[4] + L * D, MODL_, MODL_ + 1024, 6144, 1, XN_);
                if (L == 2) norm_phase(F, F.out, F.in[29], MODKV_, MODKV_ + 1024, 2048, 1, XNKV_);
                SEAM(); }
            PHASE(pb + 1) { LAUNDER();
                if (L == 2) GEMM_CALL(FnKv, XNKV_, ws + WS_WKV, 2304, D, D, D, (bf16*)(ws + WS_KVRAW), (float*)(ws + WS_FL));
                LAUNDER();
                GEMM_CALL(FnQg, XN_, ws + WS_WQG + (size_t)j * 2048 * D * 2, 2048, D, D, D, QB_, GT_); SEAM(); }
            if (L == 2) PHASE(pb + 2) { LAUNDER(); kvpost_phase(F); SEAM(); }
            PHASE(pb + 3) { LAUNDER();
                float kb_; { float g_ = fabsf(F.in[34][F.lane]); g_ = fmaxf(g_, dpp_f(g_, 0)); g_ = fmaxf(g_, dpp_f(g_, 1)); g_ = fmaxf(g_, dpp_f(g_, 2)); g_ = fmaxf(g_, dpp_f(g_, 3));
                  { auto rr = __builtin_amdgcn_permlane16_swap(__float_as_uint(g_), __float_as_uint(g_), false, false); g_ = fmaxf(__uint_as_float(rr[0]), __uint_as_float(rr[1])); }
                  { auto rr = __builtin_amdgcn_permlane32_swap(__float_as_uint(g_), __float_as_uint(g_), false, false); g_ = fmaxf(__uint_as_float(rr[0]), __uint_as_float(rr[1])); }
                  kb_ = 8.0f * 1.02f * g_; }
                const attn_body::AttnTensors AT{(const attn_body::bf16*)QB_, (const attn_body::bf16*)(ws + WS_KS), (const attn_body::bf16*)(ws + WS_VS), (attn_body::bf16*)((PROBE_PH == pb + 3 && rep_ == 0) ? (bf16*)(ws + WS_KVRAW) : QB_), (const attn_body::bf16*)GT_, (const unsigned char*)(ws + WS_G3), F.in[36] + j * 64, kb_};
                const attn_body::StaticOrder S((int)F.G, F.bx);
                attn_body::attn_phase<attn_body::StaticOrder>((char*)lds, AT, S, F.tid);
                SEAM(); }
            PHASE(pb + 6) { LAUNDER(); GEMM_CALL(FnRes, QB_, ws + WS_WO2 + (size_t)j * D * D * 2, D, D, D, D, (const float*)F.out, F.out, MODL_ + 2 * 1024); SEAM(); }
        }
        PHASE(pb + 7) { LAUNDER(); mlp_weights(F, L); norm_phase(F, F.out, F.in[5] + L * D, MODL_ + 3 * 1024, MODL_ + 4 * 1024, 6144, 1, XN_); SEAM(); }
        PHASE(pb + 8) { LAUNDER(); GEMM_CALL(FnUp, XN_, ws + WS_WUP, FF, D, D, D, HB_); SEAM(); }
        PHASE(pb + 9) { LAUNDER(); GEMM_CALL(FnRes, HB_, ws + WS_WDN, D, FF, FF, FF, (const float*)F.out, F.out, MODL_ + 5 * 1024); SEAM(); }
        }
    { constexpr int L = 1;
        const int pb = 1 + L * 10;
        if (L < 2) {
            PHASE(pb + 0) { LAUNDER(); norm_mix_phase(F, XIN1_, F.in[4] + L * D, MODL_, MODL_ + 1024, F.in[8] + L * 6 * 1024, H2_, P2_); SEAM(); }
            PHASE(pb + 1) { LAUNDER(); GEMM_CALL(FnP1, H2_, ws + WS_W1 + (size_t)L * N1 * K1 * 2 + (size_t)3072 * 1024 * 2, 512, K1, K1, K1, P1_, 3072);
                LAUNDER();
                if (F.G == 256) GEMM_CALL_S(SplitOrder, FnP1, P2_, ws + WS_W1 + (size_t)L * N1 * K1 * 2, 3072, D, D, D, 4, (size_t)M * D * 2, P1_, 0);
                else GEMM_CALL_G(FnP1, P2_, ws + WS_W1 + (size_t)L * N1 * K1 * 2, 3072, D, D, D, 4, (size_t)M * D * 2, P1_, 0);
                SEAM(); }
            PHASE(pb + 2) { LAUNDER(); GEMM_CALL(FnP2, P1_ + 3072, ws + WS_W2A + (size_t)L * 3072 * 256 * 2, (L == 0 ? 2048 : NP2), 256, N1, 256, P2_, MOD_ + 53248 + L * 3072); SEAM(); }
            PHASE(pb + 3) { LAUNDER(); scan_phase(F, L); SEAM(); }
            PHASE(pb + 4) { LAUNDER(); post_phase(F, L); SEAM(); }
            PHASE(pb + 5) { LAUNDER(); GEMM_CALL(FnGate, P1_ + 3232, ws + WS_W2G + (size_t)L * 1024 * 256 * 2, D, 256, N1, 256, H2_, 2048); SEAM(); }
            PHASE(pb + 6) { LAUNDER(); GEMM_CALL(FnRes, H2_, ws + WS_WO + (size_t)L * D * D * 2, D, D, 2048, D, XIN1_, F.out, MODL_ + 2 * 1024); SEAM(); }
        } else {
            const int j = L - 2;
            PHASE(pb + 0) { LAUNDER(); norm_phase(F, F.out, F.in[4] + L * D, MODL_, MODL_ + 1024, 6144, 1, XN_);
                if (L == 2) norm_phase(F, F.out, F.in[29], MODKV_, MODKV_ + 1024, 2048, 1, XNKV_);
                SEAM(); }
            PHASE(pb + 1) { LAUNDER();
                if (L == 2) GEMM_CALL(FnKv, XNKV_, ws + WS_WKV, 2304, D, D, D, (bf16*)(ws + WS_KVRAW), (float*)(ws + WS_FL));
                LAUNDER();
                GEMM_CALL(FnQg, XN_, ws + WS_WQG + (size_t)j * 2048 * D * 2, 2048, D, D, D, QB_, GT_); SEAM(); }
            if (L == 2) PHASE(pb + 2) { LAUNDER(); kvpost_phase(F); SEAM(); }
            PHASE(pb + 3) { LAUNDER();
                float kb_; { float g_ = fabsf(F.in[34][F.lane]); g_ = fmaxf(g_, dpp_f(g_, 0)); g_ = fmaxf(g_, dpp_f(g_, 1)); g_ = fmaxf(g_, dpp_f(g_, 2)); g_ = fmaxf(g_, dpp_f(g_, 3));
                  { auto rr = __builtin_amdgcn_permlane16_swap(__float_as_uint(g_), __float_as_uint(g_), false, false); g_ = fmaxf(__uint_as_float(rr[0]), __uint_as_float(rr[1])); }
                  { auto rr = __builtin_amdgcn_permlane32_swap(__float_as_uint(g_), __float_as_uint(g_), false, false); g_ = fmaxf(__uint_as_float(rr[0]), __uint_as_float(rr[1])); }
                  kb_ = 8.0f * 1.02f * g_; }
                const attn_body::AttnTensors AT{(const attn_body::bf16*)QB_, (const attn_body::bf16*)(ws + WS_KS), (const attn_body::bf16*)(ws + WS_VS), (attn_body::bf16*)((PROBE_PH == pb + 3 && rep_ == 0) ? (bf16*)(ws + WS_KVRAW) : QB_), (const attn_body::bf16*)GT_, (const unsigned char*)(ws + WS_G3), F.in[36] + j * 64, kb_};
                const attn_body::StaticOrder S((int)F.G, F.bx);
                attn_body::attn_phase<attn_body::StaticOrder>((char*)lds, AT, S, F.tid);
                SEAM(); }
            PHASE(pb + 6) { LAUNDER(); GEMM_CALL(FnRes, QB_, ws + WS_WO2 + (size_t)j * D * D * 2, D, D, D, D, (const float*)F.out, F.out, MODL_ + 2 * 1024); SEAM(); }
        }
        PHASE(pb + 7) { LAUNDER(); mlp_weights(F, L); norm_phase(F, F.out, F.in[5] + L * D, MODL_ + 3 * 1024, MODL_ + 4 * 1024, 6144, 1, XN_); SEAM(); }
        PHASE(pb + 8) { LAUNDER(); GEMM_CALL(FnUp, XN_, ws + WS_WUP, FF, D, D, D, HB_); SEAM(); }
        PHASE(pb + 9) { LAUNDER(); GEMM_CALL(FnRes, HB_, ws + WS_WDN, D, FF, FF, FF, (const float*)F.out, F.out, MODL_ + 5 * 1024); SEAM(); }
        }
    { constexpr int L = 2;
        const int pb = 1 + L * 10;
        if (L < 2) {
            PHASE(pb + 0) { LAUNDER(); norm_mix_phase(F, XIN1_, F.in[4] + L * D, MODL_, MODL_ + 1024, F.in[8] + L * 6 * 1024, H2_, P2_); SEAM(); }
            PHASE(pb + 1) { LAUNDER(); GEMM_CALL(FnP1, H2_, ws + WS_W1 + (size_t)L * N1 * K1 * 2 + (size_t)3072 * 1024 * 2, 512, K1, K1, K1, P1_, 3072);
                LAUNDER();
                if (F.G == 256) GEMM_CALL_S(SplitOrder, FnP1, P2_, ws + WS_W1 + (size_t)L * N1 * K1 * 2, 3072, D, D, D, 4, (size_t)M * D * 2, P1_, 0);
                else GEMM_CALL_G(FnP1, P2_, ws + WS_W1 + (size_t)L * N1 * K1 * 2, 3072, D, D, D, 4, (size_t)M * D * 2, P1_, 0);
                SEAM(); }
            PHASE(pb + 2) { LAUNDER(); GEMM_CALL(FnP2, P1_ + 3072, ws + WS_W2A + (size_t)L * 3072 * 256 * 2, (L == 0 ? 2048 : NP2), 256, N1, 256, P2_, MOD_ + 53248 + L * 3072); SEAM(); }
            PHASE(pb + 3) { LAUNDER(); scan_phase(F, L); SEAM(); }
            PHASE(pb + 4) { LAUNDER(); post_phase(F, L); SEAM(); }
            PHASE(pb + 5) { LAUNDER(); GEMM_CALL(FnGate, P1_ + 3232, ws + WS_W2G + (size_t)L * 1024 * 256 * 2, D, 256, N1, 256, H2_, 2048); SEAM(); }
            PHASE(pb + 6) { LAUNDER(); GEMM_CALL(FnRes, H2_, ws + WS_WO + (size_t)L * D * D * 2, D, D, 2048, D, XIN1_, F.out, MODL_ + 2 * 1024); SEAM(); }
        } else {
            const int j = L - 2;
            PHASE(pb + 0) { LAUNDER(); norm_phase(F, F.out, F.in[4] + L * D, MODL_, MODL_ + 1024, 6144, 1, XN_);
                if (L == 2) norm_phase(F, F.out, F.in[29], MODKV_, MODKV_ + 1024, 2048, 1, XNKV_);
                SEAM(); }
            PHASE(pb + 1) { LAUNDER();
                if (L == 2) GEMM_CALL(FnKv, XNKV_, ws + WS_WKV, 2304, D, D, D, (bf16*)(ws + WS_KVRAW), (float*)(ws + WS_FL));
                LAUNDER();
                GEMM_CALL(FnQg, XN_, ws + WS_WQG + (size_t)j * 2048 * D * 2, 2048, D, D, D, QB_, GT_); SEAM(); }
            if (L == 2) PHASE(pb + 2) { LAUNDER(); kvpost_phase(F); SEAM(); }
            PHASE(pb + 3) { LAUNDER();
                float kb_; { float g_ = fabsf(F.in[34][F.lane]); g_ = fmaxf(g_, dpp_f(g_, 0)); g_ = fmaxf(g_, dpp_f(g_, 1)); g_ = fmaxf(g_, dpp_f(g_, 2)); g_ = fmaxf(g_, dpp_f(g_, 3));
                  { auto rr = __builtin_amdgcn_permlane16_swap(__float_as_uint(g_), __float_as_uint(g_), false, false); g_ = fmaxf(__uint_as_float(rr[0]), __uint_as_float(rr[1])); }
                  { auto rr = __builtin_amdgcn_permlane32_swap(__float_as_uint(g_), __float_as_uint(g_), false, false); g_ = fmaxf(__uint_as_float(rr[0]), __uint_as_float(rr[1])); }
                  kb_ = 8.0f * 1.02f * g_; }
                const attn_body::AttnTensors AT{(const attn_body::bf16*)QB_, (const attn_body::bf16*)(ws + WS_KS), (const attn_body::bf16*)(ws + WS_VS), (attn_body::bf16*)((PROBE_PH == pb + 3 && rep_ == 0) ? (bf16*)(ws + WS_KVRAW) : QB_), (const attn_body::bf16*)GT_, (const unsigned char*)(ws + WS_G3), F.in[36] + j * 64, kb_};
                const attn_body::StaticOrder S((int)F.G, F.bx);
                attn_body::attn_phase<attn_body::StaticOrder>((char*)lds, AT, S, F.tid);
                SEAM(); }
            PHASE(pb + 6) { LAUNDER(); GEMM_CALL(FnRes, QB_, ws + WS_WO2 + (size_t)j * D * D * 2, D, D, D, D, (const float*)F.out, F.out, MODL_ + 2 * 1024); SEAM(); }
        }
        PHASE(pb + 7) { LAUNDER(); mlp_weights(F, L); norm_phase(F, F.out, F.in[5] + L * D, MODL_ + 3 * 1024, MODL_ + 4 * 1024, 6144, 1, XN_); SEAM(); }
        PHASE(pb + 8) { LAUNDER(); GEMM_CALL(FnUp, XN_, ws + WS_WUP, FF, D, D, D, HB_); SEAM(); }
        PHASE(pb + 9) { LAUNDER(); GEMM_CALL(FnRes, HB_, ws + WS_WDN, D, FF, FF, FF, (const float*)F.out, F.out, MODL_ + 5 * 1024); SEAM(); }
        }
    { constexpr int L = 3;
        const int pb = 1 + L * 10;
        if (L < 2) {
            PHASE(pb + 0) { LAUNDER(); norm_mix_phase(F, XIN1_, F.in[4] + L * D, MODL_, MODL_ + 1024, F.in[8] + L * 6 * 1024, H2_, P2_); SEAM(); }
            PHASE(pb + 1) { LAUNDER(); GEMM_CALL(FnP1, H2_, ws + WS_W1 + (size_t)L * N1 * K1 * 2 + (size_t)3072 * 1024 * 2, 512, K1, K1, K1, P1_, 3072);
                LAUNDER();
                if (F.G == 256) GEMM_CALL_S(SplitOrder, FnP1, P2_, ws + WS_W1 + (size_t)L * N1 * K1 * 2, 3072, D, D, D, 4, (size_t)M * D * 2, P1_, 0);
                else GEMM_CALL_G(FnP1, P2_, ws + WS_W1 + (size_t)L * N1 * K1 * 2, 3072, D, D, D, 4, (size_t)M * D * 2, P1_, 0);
                SEAM(); }
            PHASE(pb + 2) { LAUNDER(); GEMM_CALL(FnP2, P1_ + 3072, ws + WS_W2A + (size_t)L * 3072 * 256 * 2, (L == 0 ? 2048 : NP2), 256, N1, 256, P2_, MOD_ + 53248 + L * 3072); SEAM(); }
            PHASE(pb + 3) { LAUNDER(); scan_phase(F, L); SEAM(); }
            PHASE(pb + 4) { LAUNDER(); post_phase(F, L); SEAM(); }
            PHASE(pb + 5) { LAUNDER(); GEMM_CALL(FnGate, P1_ + 3232, ws + WS_W2G + (size_t)L * 1024 * 256 * 2, D, 256, N1, 256, H2_, 2048); SEAM(); }
            PHASE(pb + 6) { LAUNDER(); GEMM_CALL(FnRes, H2_, ws + WS_WO + (size_t)L * D * D * 2, D, D, 2048, D, XIN1_, F.out, MODL_ + 2 * 1024); SEAM(); }
        } else {
            const int j = L - 2;
            PHASE(pb + 0) { LAUNDER(); norm_phase(F, F.out, F.in[4] + L * D, MODL_, MODL_ + 1024, 6144, 1, XN_);
                if (L == 2) norm_phase(F, F.out, F.in[29], MODKV_, MODKV_ + 1024, 2048, 1, XNKV_);
                SEAM(); }
            PHASE(pb + 1) { LAUNDER();
                if (L == 2) GEMM_CALL(FnKv, XNKV_, ws + WS_WKV, 2304, D, D, D, (bf16*)(ws + WS_KVRAW), (float*)(ws + WS_FL));
                LAUNDER();
                GEMM_CALL(FnQg, XN_, ws + WS_WQG + (size_t)j * 2048 * D * 2, 2048, D, D, D, QB_, GT_); SEAM(); }
            if (L == 2) PHASE(pb + 2) { LAUNDER(); kvpost_phase(F); SEAM(); }
            PHASE(pb + 3) { LAUNDER();
                float kb_; { float g_ = fabsf(F.in[34][F.lane]); g_ = fmaxf(g_, dpp_f(g_, 0)); g_ = fmaxf(g_, dpp_f(g_, 1)); g_ = fmaxf(g_, dpp_f(g_, 2)); g_ = fmaxf(g_, dpp_f(g_, 3));
                  { auto rr = __builtin_amdgcn_permlane16_swap(__float_as_uint(g_), __float_as_uint(g_), false, false); g_ = fmaxf(__uint_as_float(rr[0]), __uint_as_float(rr[1])); }
                  { auto rr = __builtin_amdgcn_permlane32_swap(__float_as_uint(g_), __float_as_uint(g_), false, false); g_ = fmaxf(__uint_as_float(rr[0]), __uint_as_float(rr[1])); }
                  kb_ = 8.0f * 1.02f * g_; }
                const attn_body::AttnTensors AT{(const attn_body::bf16*)QB_, (const attn_body::bf16*)(ws + WS_KS), (const attn_body::bf16*)(ws + WS_VS), (attn_body::bf16*)((PROBE_PH == pb + 3 && rep_ == 0) ? (bf16*)(ws + WS_KVRAW) : QB_), (const attn_body::bf16*)GT_, (const unsigned char*)(ws + WS_G3), F.in[36] + j * 64, kb_};
                const attn_body::StaticOrder S((int)F.G, F.bx);
                attn_body::attn_phase<attn_body::StaticOrder>((char*)lds, AT, S, F.tid);
                SEAM(); }
            PHASE(pb + 6) { LAUNDER(); GEMM_CALL(FnRes, QB_, ws + WS_WO2 + (size_t)j * D * D * 2, D, D, D, D, (const float*)F.out, F.out, MODL_ + 2 * 1024); SEAM(); }
        }
        PHASE(pb + 7) { LAUNDER(); mlp_weights(F, L); norm_phase(F, F.out, F.in[5] + L * D, MODL_ + 3 * 1024, MODL_ + 4 * 1024, 6144, 1, XN_); SEAM(); }
        PHASE(pb + 8) { LAUNDER(); GEMM_CALL(FnUp, XN_, ws + WS_WUP, FF, D, D, D, HB_); SEAM(); }
        PHASE(pb + 9) { LAUNDER(); GEMM_CALL(FnRes, HB_, ws + WS_WDN, D, FF, FF, FF, (const float*)F.out, F.out, MODL_ + 5 * 1024); SEAM(); }
        }
    PHASE(41) { LAUNDER(); final_norm_phase(F); }
#undef IN
#undef SEAM
}
static bool phase_exists(int ph) {
    if (ph == 0 || ph == 41) return true;
    const int L = (ph - 1) / 10, s = (ph - 1) % 10;
    if (L < 2) return true;
    if (s == 4 || s == 5) return false;
    if (s == 2) return L == 2;
    return true;
}
extern "C" void kernel_launch(void* const* d_in, const int* in_sizes, int n_in, void* d_out, int out_size, void* d_ws, size_t ws_size, hipStream_t stream) {
    static int grid = 0;
    if (grid == 0) {
        if (n_in != 39 || in_sizes[0] != M * D || out_size != M * D || ws_size < WS_END) { fprintf(stderr, "kernel_launch: shape/workspace mismatch: n_in %d in0 %d out %d ws %zu (need %zu)\n", n_in, n_in > 0 ? in_sizes[0] : -1, out_size, ws_size, (size_t)WS_END); grid = -1; return; }
        int dev = 0, cus = 0, per_cu = 0;
        if (hipGetDevice(&dev) != hipSuccess || hipDeviceGetAttribute(&cus, hipDeviceAttributeMultiprocessorCount, dev) != hipSuccess) { fprintf(stderr, "kernel_launch: device query failed\n"); grid = -1; return; }
        if (hipFuncSetAttribute((const void*)yoco_fwd, hipFuncAttributeMaxDynamicSharedMemorySize, LDS_BYTES) != hipSuccess) { fprintf(stderr, "kernel_launch: hipFuncSetAttribute failed\n"); grid = -1; return; }
        if (hipOccupancyMaxActiveBlocksPerMultiprocessor(&per_cu, (const void*)yoco_fwd, NWAVES * 64, LDS_BYTES) != hipSuccess || per_cu < 1) { fprintf(stderr, "kernel_launch: occupancy query says %d blocks/CU\n", per_cu); per_cu = 1; }
        (void)hipGetLastError();
        grid = cus * per_cu;
        if (grid != 256) { fprintf(stderr, "kernel_launch: resident capacity %d workgroups; this kernel's static schedules want 256 (using 256)\n", grid); if (grid > 256) grid = 256; }
    }
    if (grid < 0) return;
    if (hipMemsetAsync((char*)d_ws + WS_BAR, 0, BAR_BYTES, stream) != hipSuccess) { fprintf(stderr, "kernel_launch: memset of barrier words failed\n"); return; }
    Args a{};
    for (int i = 0; i < 39; ++i) a.in[i] = (const float*)d_in[i];
    a.out = (float*)d_out; a.ws = (unsigned char*)d_ws;
#if MK_ONE_LAUNCH
    a.ph_lo = 0; a.ph_hi = N_PHASES;
    void* params[] = {&a};
    const hipError_t le = hipLaunchCooperativeKernel((const void*)yoco_fwd, dim3(grid), dim3(NWAVES * 64), params, LDS_BYTES, stream);
    if (le != hipSuccess) fprintf(stderr, "kernel_launch: cooperative launch failed: %s (grid %d)\n", hipGetErrorName(le), grid);
#else
    for (int ph = 0; ph < N_PHASES; ++ph) { if (!phase_exists(ph)) continue; a.ph_lo = ph; a.ph_hi = ph + 1;
        hipLaunchKernelGGL(yoco_fwd, dim3(grid), dim3(NWAVES * 64), LDS_BYTES, stream, a);
        const hipError_t le = hipPeekAtLastError(); if (le != hipSuccess) { fprintf(stderr, "kernel_launch: launch of phase %d failed: %s\n", ph, hipGetErrorName(le)); break; } }
#endif
}
```

```cpp
#include <hip/hip_runtime.h>
#include <hip/hip_cooperative_groups.h>
#include <hip/hip_bf16.h>
#include <cstdio>
#include <cstdint>
#include <cmath>
namespace cg = cooperative_groups;
#ifndef MK_ONE_LAUNCH
#define MK_ONE_LAUNCH 1
#endif
namespace pg8 {
#define PG8_LAS __attribute__((address_space(3)))
typedef unsigned short bf16_t;
typedef short bf16x8 __attribute__((ext_vector_type(8)));
typedef float f32x4 __attribute__((ext_vector_type(4)));
typedef unsigned u32x4 __attribute__((ext_vector_type(4)));
constexpr int BM = 256, BK = 64, HALF = 128, HTB = HALF * BK * 2  , STAGE_BYTES = 8 * HTB, NXCD = 8, WGM = 8;

__host__ __device__ __forceinline__ int lds_byte(int r, int c) { const int st = (r >> 4) * 2 + (c >> 5), rr = r & 15, cc = c & 31, ob = rr * 64 + cc * 2; return st * 1024 + (ob ^ (((ob >> 9) & 1) << 5)); }
__host__ __device__ __forceinline__ void stage_rc(int b, int& R, int& C) { const int st = b / 1024, sb = b % 1024, swz = sb ^ (((sb >> 9) & 1) << 5); R = (st >> 1) * 16 + swz / 64; C = (st & 1) * 32 + (swz % 64) / 2; }
__host__ __device__ __forceinline__ int perm32(int rho) { const int n = rho >> 4, i = rho & 15; return 8 * (i >> 2) + 4 * n + (i & 3); }

struct Unit { int pm, pn; };
struct Gemm { const bf16_t* A; const bf16_t* Bt; int M, N, K, lda, ldb; int agrp; size_t astep; };

struct SplitOrder {
    int c, nN;
    __host__ __device__ void init(int M, int N, int G_, int c_) { c = c_; nN = N / BM; (void)M; (void)G_; }
    __host__ __device__ bool next(int i, Unit& u) const { int idx; if (c < 128) { if (i >= 2) return false; idx = 2 * c + i; } else { if (i >= 4) return false; idx = 256 + 4 * (c - 128) + i; } u.pm = idx / nN; u.pn = idx % nN; return true; }
    __device__ __forceinline__ void a_ready(const Unit&) const {}
    __device__ __forceinline__ void done(const Unit&) const {}
};
struct StaticOrder {
    int nM, nN, nwg, G, c;
    __host__ __device__ void init(int M, int N, int G_, int c_) { nM = M / BM; nN = N / BM; nwg = nM * nN; G = G_; c = c_; }
    __host__ __device__ bool next(int i, Unit& u) const {
        const long L = (long)i * G + c; if (L >= nwg) return false;
        int wgid = (int)L; { const int q = nwg / NXCD, r = nwg % NXCD, xcd = wgid % NXCD, off = wgid / NXCD; wgid = (xcd < r ? xcd * (q + 1) : r * (q + 1) + (xcd - r) * q) + off; }
        const int nig = WGM * nN, gid = wgid / nig, fm = gid * WGM, gsz = (nM - fm) < WGM ? (nM - fm) : WGM;
        u.pm = fm + ((wgid % nig) % gsz); u.pn = (wgid % nig) / gsz; return true;
    }
    __device__ __forceinline__ void a_ready(const Unit&) const {}
    __device__ __forceinline__ void done(const Unit&) const {}
};

typedef float f32x2 __attribute__((ext_vector_type(2)));
typedef __bf16 bf16x2_t __attribute__((ext_vector_type(2)));
__device__ __forceinline__ unsigned pkbf(float lo, float hi) { f32x2 v = {lo, hi}; bf16x2_t b = __builtin_convertvector(v, bf16x2_t); return __builtin_bit_cast(unsigned, b); }
__device__ __forceinline__ float bflo(unsigned w) { return __uint_as_float(w << 16); }
__device__ __forceinline__ float bfhi(unsigned w) { return __uint_as_float(w & 0xffff0000u); }
__device__ __forceinline__ float sigm(float x) { return __builtin_amdgcn_rcpf(1.0f + __builtin_amdgcn_exp2f(-1.4426950408889634f * x)); }
template <class Fn> struct Epi8 {
    static constexpr bool PERM = true, AFTER_DRAIN = false; Fn f;
    __device__ __forceinline__ void operator()(const f32x4 (&acc)[2][2][4][2], const Unit& u, int wr, int wc, int fr, int fq) const {
        const int row0 = u.pm * BM + wr * 64 + fr, col0 = u.pn * BM + wc * 32 + 8 * fq;
#pragma unroll
        for (int ai = 0; ai < 2; ++ai)
#pragma unroll
            for (int m = 0; m < 4; ++m)
#pragma unroll
                for (int bj = 0; bj < 2; ++bj) { f(row0 + ai * HALF + m * 16, col0 + bj * HALF, acc[ai][bj][m][0], acc[ai][bj][m][1]); }
    }
};
__device__ __forceinline__ void st8bf(bf16_t* p, f32x4 v0, f32x4 v1) { u32x4 w; w.x = pkbf(v0[0], v0[1]); w.y = pkbf(v0[2], v0[3]); w.z = pkbf(v1[0], v1[1]); w.w = pkbf(v1[2], v1[3]); *(u32x4*)p = w; }
struct FnP1 { bf16_t* O; int coff;
    __device__ __forceinline__ void operator()(int row, int col, f32x4 v0, f32x4 v1) const {
        col += coff;
        if (col >= 3072) {
            if (col < 3136) {
#pragma unroll
                for (int j = 0; j < 4; ++j) { v0[j] = 1.0f - 2.0f * __builtin_amdgcn_rcpf(__builtin_amdgcn_exp2f(2.8853900817779268f * v0[j]) + 1.0f); v1[j] = 1.0f - 2.0f * __builtin_amdgcn_rcpf(__builtin_amdgcn_exp2f(2.8853900817779268f * v1[j]) + 1.0f); } }
            else if (col >= 3232 && col < 3392) {
#pragma unroll
                for (int j = 0; j < 4; ++j) { v0[j] = sigm(v0[j]); v1[j] = sigm(v1[j]); } }
        }
        st8bf(O + (size_t)row * 3584 + col, v0, v1); } };
struct FnP2 { bf16_t* O; const float* bias;
    __device__ __forceinline__ void operator()(int row, int col, f32x4 v0, f32x4 v1) const {
        const f32x4 b0 = *(const f32x4*)(bias + col), b1 = *(const f32x4*)(bias + col + 4);
        const float sc = col < 1024 ? -0.60653065971f : 1.0f;
#pragma unroll
        for (int j = 0; j < 4; ++j) { v0[j] = sc * sigm(v0[j] + b0[j]); v1[j] = sc * sigm(v1[j] + b1[j]); }
        st8bf(O + (size_t)row * 3072 + col, v0, v1); } };
struct FnGate { bf16_t* Y; int ld;
    __device__ __forceinline__ void operator()(int row, int col, f32x4 v0, f32x4 v1) const {
        bf16_t* p = Y + (size_t)row * ld + col; const u32x4 y = *(const u32x4*)p;
        v0[0] *= bflo(y.x); v0[1] *= bfhi(y.x); v0[2] *= bflo(y.y); v0[3] *= bfhi(y.y); v1[0] *= bflo(y.z); v1[1] *= bfhi(y.z); v1[2] *= bflo(y.w); v1[3] *= bfhi(y.w);
        st8bf(p, v0, v1); } };
struct FnRes { const float* xin; float* xout; const float* gate;
    __device__ __forceinline__ void operator()(int row, int col, f32x4 v0, f32x4 v1) const {
        const float* gp = gate + (row >> 13) * 6144 + col; const f32x4 g0 = *(const f32x4*)gp, g1 = *(const f32x4*)(gp + 4);
        const size_t off = (size_t)row * 1024 + col; const f32x4 x0 = *(const f32x4*)(xin + off), x1 = *(const f32x4*)(xin + off + 4);
        *(f32x4*)(xout + off) = x0 + (g0 + 1.0f) * v0; *(f32x4*)(xout + off + 4) = x1 + (g1 + 1.0f) * v1; } };
struct FnUp { bf16_t* O;
    __device__ __forceinline__ void operator()(int row, int col, f32x4 v0, f32x4 v1) const {
#pragma unroll
        for (int j = 0; j < 4; ++j) { const float a = fmaxf(v0[j], 0.f), b = fmaxf(v1[j], 0.f); v0[j] = a * a; v1[j] = b * b; }
        st8bf(O + (size_t)row * 4096 + col, v0, v1); } };
struct FnKv { bf16_t* O; float* FL;
    __device__ __forceinline__ void operator()(int row, int col, f32x4 v0, f32x4 v1) const {
        if (col < 2048) st8bf(O + (size_t)row * 2048 + col, v0, v1);
        else if (col < 2064) { float* p = FL + (size_t)row * 16 + (col - 2048); *(f32x4*)p = v0; *(f32x4*)(p + 4) = v1; } } };
struct FnQg { bf16_t* Q; bf16_t* G;
    __device__ __forceinline__ void operator()(int row, int col, f32x4 v0, f32x4 v1) const {
        if (col < 1024) st8bf(Q + (size_t)row * 1024 + col, v0, v1);
        else {
#pragma unroll
            for (int j = 0; j < 4; ++j) { v0[j] = sigm(v0[j]); v1[j] = sigm(v1[j]); }
            st8bf(G + (size_t)row * 1024 + (col - 1024), v0, v1); } } };
template <class Epi, class Sched, bool ALIGN_EPI = false, bool SP2 = false>
__device__ __forceinline__ void gemm_phase(PG8_LAS unsigned char* lds, const Gemm g, const Sched& S, const Epi& E, const int tid_in) {
    int tid_l = tid_in; asm volatile("" : "+v"(tid_l));
    const int tid = tid_l, wid = __builtin_amdgcn_readfirstlane(tid >> 6), lane = tid & 63, wr = wid >> 2, wc = wid & 3, fr = lane & 15, fq = lane >> 4;
    const int K = g.K, nt = K / BK;
    unsigned voffA[2], voffB[2];
#pragma unroll
    for (int i = 0; i < 2; ++i) { int R, C; stage_rc(tid * 16 + i * 8192, R, C); const int Rb = Epi::PERM ? ((R & ~31) + perm32(R & 31)) : R;
        voffA[i] = (unsigned)(R * g.lda + C) * 2u; voffB[i] = (unsigned)(Rb * g.ldb + C) * 2u; }
    const size_t kstep = (size_t)(BK * 2);
    const size_t hstepA = (size_t)HALF * g.lda * 2, hstepB = (size_t)HALF * g.ldb * 2;
    const size_t tstepA = 2 * hstepA, tstepB = 2 * hstepB;
    const unsigned ldsw = (unsigned)wid * 1024u;
    const int aoff = lds_byte(wr * 64 + fr, fq * 8), boff = lds_byte(wc * 32 + fr, fq * 8);
#define PG8_SA(b, h) (((b) * 2 + (h)) * HTB)
#define PG8_SB(b, h) ((4 + (b) * 2 + (h)) * HTB)
#define PG8_STAGE(bufoff, gbase, voff) do { _Pragma("unroll") for (int _i = 0; _i < 2; ++_i) \
        __builtin_amdgcn_global_load_lds((const unsigned*)((const char*)(gbase) + (voff)[_i]), (PG8_LAS unsigned*)(lds + (bufoff) + ldsw + _i * 8192), 16, 0, 0); } while (0)
#define PG8_LDA(dst, b, h) do { _Pragma("unroll") for (int m = 0; m < 4; ++m) _Pragma("unroll") for (int k = 0; k < 2; ++k) dst[m][k] = *(const PG8_LAS bf16x8*)(lds + PG8_SA(b, h) + aoff + m * 2048 + k * 1024); } while (0)
#define PG8_LDB(dst, b, h) do { _Pragma("unroll") for (int n = 0; n < 2; ++n) _Pragma("unroll") for (int k = 0; k < 2; ++k) dst[n][k] = *(const PG8_LAS bf16x8*)(lds + PG8_SB(b, h) + boff + n * 2048 + k * 1024); } while (0)
#define PG8_MMA(ai, bj, At, Bt) do { __builtin_amdgcn_s_setprio(1); _Pragma("unroll") for (int m = 0; m < 4; ++m) _Pragma("unroll") for (int n = 0; n < 2; ++n) _Pragma("unroll") for (int k = 0; k < 2; ++k) \
        acc[ai][bj][m][n] = __builtin_amdgcn_mfma_f32_16x16x32_bf16(Bt[n][k], At[m][k], acc[ai][bj][m][n], 0, 0, 0); __builtin_amdgcn_s_setprio(0); } while (0)
#define PG8_WAIT_V(n) asm volatile("s_waitcnt vmcnt(" #n ")" ::: "memory")
#define PG8_WAIT_L(n) asm volatile("s_waitcnt lgkmcnt(" #n ")" ::: "memory")
#define PG8_BAR __builtin_amdgcn_s_barrier()
#define PG8_SCHED __builtin_amdgcn_sched_barrier(0)
    Unit cur, nxt; int ui = 0;
    if (!S.next(0, cur)) return;
    f32x4 acc[2][2][4][2];
#pragma unroll
    for (int a = 0; a < 2; ++a)
#pragma unroll
        for (int b = 0; b < 2; ++b)
#pragma unroll
            for (int m = 0; m < 4; ++m)
#pragma unroll
                for (int n = 0; n < 2; ++n) acc[a][b][m][n] = (f32x4){0.f, 0.f, 0.f, 0.f};
    bf16x8 At[4][2], B0[2][2], B1[2][2];
    const char* cA = (const char*)g.A + (size_t)cur.pm * tstepA + (g.agrp ? (size_t)(cur.pn / g.agrp) * g.astep : (size_t)0); const char* cB = (const char*)g.Bt + (size_t)cur.pn * tstepB;
    S.a_ready(cur);
    if constexpr (SP2) {
        PG8_STAGE(PG8_SB(0, 0), cB, voffB); PG8_STAGE(PG8_SB(0, 1), cB + hstepB, voffB); PG8_STAGE(PG8_SA(0, 0), cA, voffA); PG8_STAGE(PG8_SA(0, 1), cA + hstepA, voffA);
        if (wr == 1) PG8_BAR;
        PG8_WAIT_V(2); PG8_BAR;
        PG8_STAGE(PG8_SB(1, 0), cB + kstep, voffB); PG8_STAGE(PG8_SA(1, 0), cA + kstep, voffA); PG8_STAGE(PG8_SB(1, 1), cB + hstepB + kstep, voffB);
        PG8_WAIT_V(6); PG8_BAR;
    } else {
        PG8_STAGE(PG8_SB(0, 0), cB, voffB); PG8_STAGE(PG8_SA(0, 0), cA, voffA); PG8_STAGE(PG8_SB(0, 1), cB + hstepB, voffB); PG8_STAGE(PG8_SA(0, 1), cA + hstepA, voffA);
        if (wr == 1) PG8_BAR;
        PG8_WAIT_V(4); PG8_BAR;
        PG8_STAGE(PG8_SB(1, 0), cB + kstep, voffB); PG8_STAGE(PG8_SA(1, 0), cA + kstep, voffA); PG8_STAGE(PG8_SB(1, 1), cB + hstepB + kstep, voffB);
        PG8_WAIT_V(6); PG8_BAR;
    }
    for (;;) {
        const bool has_next = S.next(ui + 1, nxt);
        const char* nA = has_next ? (const char*)g.A + (size_t)nxt.pm * tstepA + (g.agrp ? (size_t)(nxt.pn / g.agrp) * g.astep : (size_t)0) : cA; const char* nB = has_next ? (const char*)g.Bt + (size_t)nxt.pn * tstepB : cB;
        for (int t = 0; t < nt; t += 2) {
            const bool last = (t == nt - 2);
            const char* a1 = cA + (size_t)(t + 1) * kstep;
            const char* a2 = last ? nA : cA + (size_t)(t + 2) * kstep; const char* b2 = last ? nB : cB + (size_t)(t + 2) * kstep;
            const char* a3 = a2 + kstep; const char* b3 = b2 + kstep;
            if (last && has_next) S.a_ready(nxt);
            if constexpr (SP2) {
            PG8_LDB(B0, 0, 0); PG8_LDB(B1, 0, 1); PG8_SCHED; PG8_LDA(At, 0, 0); PG8_STAGE(PG8_SA(1, 1), a1 + hstepA, voffA);
            PG8_WAIT_V(8); PG8_WAIT_L(0); PG8_BAR; PG8_MMA(0, 0, At, B0); PG8_MMA(0, 1, At, B1); PG8_BAR; PG8_SCHED;
            PG8_LDA(At, 0, 1); PG8_STAGE(PG8_SB(0, 0), b2, voffB); PG8_STAGE(PG8_SB(0, 1), b2 + hstepB, voffB); PG8_STAGE(PG8_SA(0, 0), a2, voffA);
            PG8_WAIT_V(8); PG8_WAIT_L(0); PG8_BAR; PG8_MMA(1, 0, At, B0); PG8_MMA(1, 1, At, B1); PG8_BAR; PG8_SCHED;
            PG8_LDB(B0, 1, 0); PG8_LDB(B1, 1, 1); PG8_SCHED; PG8_LDA(At, 1, 0); PG8_STAGE(PG8_SA(0, 1), a2 + hstepA, voffA);
            PG8_WAIT_V(8); PG8_WAIT_L(0); PG8_BAR; PG8_MMA(0, 0, At, B0); PG8_MMA(0, 1, At, B1); PG8_BAR; PG8_SCHED;
            PG8_LDA(At, 1, 1); PG8_STAGE(PG8_SB(1, 0), b3, voffB); PG8_STAGE(PG8_SB(1, 1), b3 + hstepB, voffB); PG8_STAGE(PG8_SA(1, 0), a3, voffA);
            PG8_WAIT_V(8); PG8_WAIT_L(0); PG8_BAR; PG8_MMA(1, 0, At, B0); PG8_MMA(1, 1, At, B1); PG8_BAR; PG8_SCHED;
            } else {
            PG8_LDB(B0, 0, 0); PG8_SCHED; PG8_LDA(At, 0, 0); PG8_STAGE(PG8_SA(1, 1), a1 + hstepA, voffA);
            PG8_WAIT_L(8); PG8_BAR; PG8_WAIT_L(0); PG8_MMA(0, 0, At, B0); PG8_BAR; PG8_SCHED;
            PG8_LDB(B1, 0, 1); PG8_STAGE(PG8_SB(0, 0), b2, voffB);
            PG8_BAR; PG8_WAIT_L(0); PG8_MMA(0, 1, At, B1); PG8_BAR;
            PG8_LDA(At, 0, 1); PG8_STAGE(PG8_SA(0, 0), a2, voffA);
            PG8_BAR; PG8_WAIT_L(0); PG8_MMA(1, 0, At, B0); PG8_BAR; PG8_SCHED;
            PG8_STAGE(PG8_SB(0, 1), b2 + hstepB, voffB);
            PG8_WAIT_V(6); PG8_BAR; PG8_MMA(1, 1, At, B1); PG8_BAR;
            PG8_LDB(B0, 1, 0); PG8_SCHED; PG8_LDA(At, 1, 0); PG8_STAGE(PG8_SA(0, 1), a2 + hstepA, voffA);
            PG8_WAIT_L(8); PG8_BAR; PG8_WAIT_L(0); PG8_MMA(0, 0, At, B0); PG8_BAR; PG8_SCHED;
            PG8_LDB(B1, 1, 1); PG8_STAGE(PG8_SB(1, 0), b3, voffB);
            PG8_BAR; PG8_WAIT_L(0); PG8_MMA(0, 1, At, B1); PG8_BAR;
            PG8_LDA(At, 1, 1); PG8_STAGE(PG8_SA(1, 0), a3, voffA);
            PG8_BAR; PG8_WAIT_L(0); PG8_MMA(1, 0, At, B0); PG8_BAR; PG8_SCHED;
            PG8_STAGE(PG8_SB(1, 1), b3 + hstepB, voffB);
            PG8_WAIT_V(6); PG8_BAR; PG8_MMA(1, 1, At, B1); PG8_BAR;
            }
        }
        if constexpr (ALIGN_EPI) { if (wr == 0) PG8_BAR; }
        if constexpr (!Epi::AFTER_DRAIN) { E(acc, cur, wr, wc, fr, fq); S.done(cur); }
        if (!has_next) break;
#pragma unroll
        for (int a = 0; a < 2; ++a)
#pragma unroll
            for (int b = 0; b < 2; ++b)
#pragma unroll
                for (int m = 0; m < 4; ++m)
#pragma unroll
                    for (int n = 0; n < 2; ++n) acc[a][b][m][n] = (f32x4){0.f, 0.f, 0.f, 0.f};
        cur = nxt; cA = nA; cB = nB; ++ui;
        if constexpr (ALIGN_EPI) { if (wr == 1) PG8_BAR; }
    }
    PG8_WAIT_V(0);
    if constexpr (!ALIGN_EPI) { if (wr == 0) PG8_BAR; }
    PG8_BAR;
    if constexpr (Epi::AFTER_DRAIN) { E.fused(acc, cur, wr, wc, fr, fq, lds, wid, lane); S.done(cur); }
#undef PG8_SA
#undef PG8_SB
#undef PG8_STAGE
#undef PG8_LDA
#undef PG8_LDB
#undef PG8_MMA
#undef PG8_WAIT_V
#undef PG8_WAIT_L
#undef PG8_BAR
#undef PG8_SCHED
}
}
#include <hip/hip_bf16.h>
#include <cmath>
namespace attn_body {
using bf16=__hip_bfloat16;
using bf16x8=__attribute__((ext_vector_type(8)))short;
using s16x4=__attribute__((ext_vector_type(4)))short;
using f32x16=__attribute__((ext_vector_type(16)))float;
using u32x4=__attribute__((ext_vector_type(4)))unsigned;
constexpr int BATCH=2,NHEAD=16,SEQ=8192,D=64,DM=NHEAD*D;
constexpr int NW=8,QBLK=32,QB=QBLK*NW,KVBLK=64,NQB=SEQ/QB;
constexpr int ATTN_PITCH=DM, ATTN_UNIT_ROWS=QB;
__device__ __forceinline__ int crow(int r,int hi){return (r&3)+8*(r>>2)+4*hi;}
#define SBAR() __builtin_amdgcn_sched_barrier(0)
__device__ __forceinline__ void cmask(f32x16&p0,f32x16&p1,int jb,int qrel,int hi){
  const float NEG=-INFINITY; int kb=64*jb+4*hi;
  #pragma unroll
  for(int r=0;r<16;++r){int kv=kb+(r&3)+8*(r>>2); if(kv>qrel)p0[r]=NEG; if(kv+32>qrel)p1[r]=NEG;}
}

constexpr int NSLOT=3, SLOTB=9216;
constexpr int LDS_K=0, LDS_V=NSLOT*SLOTB, LDS_WS=2*NSLOT*SLOTB, LDS_OST=LDS_WS+NW*64*4, LDS_BYTES=LDS_OST+NW*4096;
constexpr float C2=0.125f*1.4426950408889634f;
__device__ __forceinline__ void glds16(const void*gsrc,unsigned lds_dst){unsigned keep;
  asm volatile("s_mov_b32 %0, m0\n\ts_mov_b32 m0, %2\n\ts_nop 0\n\tglobal_load_lds_dwordx4 %1, off\n\ts_mov_b32 m0, %0":"=&s"(keep):"v"(gsrc),"s"(lds_dst):"memory");}
__device__ __forceinline__ float max3f(float a,float b,float c){float r;asm("v_max3_f32 %0, %1, %2, %3":"=v"(r):"v"(a),"v"(b),"v"(c));return r;}
__device__ __forceinline__ float max2f(float a,float b){float r;asm("v_max_f32_e32 %0, %1, %2":"=v"(r):"v"(a),"v"(b));return r;}
__device__ __forceinline__ float fadd_s(float a,float b){float r;asm("v_add_f32_e32 %0, %1, %2":"=v"(r):"v"(a),"v"(b));return r;}
__device__ __forceinline__ float fsub_s(float a,float b){float r;asm("v_sub_f32_e32 %0, %1, %2":"=v"(r):"v"(a),"v"(b));return r;}
typedef float f32x2_t __attribute__((ext_vector_type(2))); typedef __bf16 bf16x2_t __attribute__((ext_vector_type(2)));
__device__ __forceinline__ unsigned cvtpk_s(float lo,float hi){f32x2_t v={lo,hi};bf16x2_t b=__builtin_convertvector(v,bf16x2_t);return __builtin_bit_cast(unsigned,b);}
#define WAIT_BAR(N) asm volatile("s_waitcnt vmcnt(" #N ") lgkmcnt(0)\n\ts_barrier":::"memory")
#define WAIT_BARW() do{ if(wid==0){WAIT_BAR(3);} else {WAIT_BAR(2);} }while(0)

__device__ __forceinline__ void qkt(f32x16&p0,f32x16&p1,const char*Kslot,const bf16x8*qr,const bf16x8 qe,const f32x16&negm,int r32,int hi){
  const char*kb=Kslot+hi*1024+r32*16;
  #pragma unroll
  for(int d0=0;d0<4;++d0){
    const bf16x8 b0=*reinterpret_cast<const bf16x8*>(kb+d0*2048);
    const bf16x8 b1=*reinterpret_cast<const bf16x8*>(kb+d0*2048+512);
    if(d0==0){p0=__builtin_amdgcn_mfma_f32_32x32x16_bf16(b0,qr[0],negm,0,0,0);p1=__builtin_amdgcn_mfma_f32_32x32x16_bf16(b1,qr[0],negm,0,0,0);}
    else{p0=__builtin_amdgcn_mfma_f32_32x32x16_bf16(b0,qr[d0],p0,0,0,0);p1=__builtin_amdgcn_mfma_f32_32x32x16_bf16(b1,qr[d0],p1,0,0,0);}}
  { const char*ke=Kslot+8192+r32*16; const bf16x8 e0=*reinterpret_cast<const bf16x8*>(ke),e1=*reinterpret_cast<const bf16x8*>(ke+512);
    p0=__builtin_amdgcn_mfma_f32_32x32x16_bf16(e0,qe,p0,0,0,0);p1=__builtin_amdgcn_mfma_f32_32x32x16_bf16(e1,qe,p1,0,0,0);}
}
typedef __attribute__((address_space(3))) const char* lds_cptr;
typedef short v4i16_t __attribute__((ext_vector_type(4)));
__device__ __forceinline__ void kload8(bf16x8*kf,lds_cptr kp){
  kf[0]=*(const __attribute__((address_space(3))) bf16x8*)(kp);      kf[1]=*(const __attribute__((address_space(3))) bf16x8*)(kp+512);
  kf[2]=*(const __attribute__((address_space(3))) bf16x8*)(kp+2048); kf[3]=*(const __attribute__((address_space(3))) bf16x8*)(kp+2560);
  kf[4]=*(const __attribute__((address_space(3))) bf16x8*)(kp+4096); kf[5]=*(const __attribute__((address_space(3))) bf16x8*)(kp+4608);
  kf[6]=*(const __attribute__((address_space(3))) bf16x8*)(kp+6144); kf[7]=*(const __attribute__((address_space(3))) bf16x8*)(kp+6656);
}
__device__ __forceinline__ void kload2(bf16x8*kf,lds_cptr kp,int j){ kf[2*j]=*(const __attribute__((address_space(3))) bf16x8*)(kp+j*2048); kf[2*j+1]=*(const __attribute__((address_space(3))) bf16x8*)(kp+j*2048+512); }
__device__ __forceinline__ s16x4 vtr(lds_cptr p){ return __builtin_bit_cast(s16x4,__builtin_amdgcn_ds_read_tr16_b64_v4i16((__attribute__((address_space(3))) v4i16_t*)p)); }
__device__ __forceinline__ float rowmax(const f32x16&p0,const f32x16&p1){
  float a=max3f(p0[0],p0[1],p1[0]),b=max3f(p0[2],p0[3],p1[1]);a=max3f(a,p1[2],p1[3]);
  #pragma unroll
  for(int r=4;r<16;r+=4){a=max3f(a,p0[r],p0[r+1]);b=max3f(b,p0[r+2],p0[r+3]);a=max3f(a,p1[r],p1[r+1]);b=max3f(b,p1[r+2],p1[r+3]);}
  const float m=max2f(a,b);
  auto rr=__builtin_amdgcn_permlane32_swap(__float_as_uint(m),__float_as_uint(m),false,false);
  return max2f(__uint_as_float(rr[0]),__uint_as_float(rr[1]));
}
__device__ __forceinline__ void pv(f32x16*o,int vb,bf16x8 pa0,bf16x8 pa1,bf16x8 pa2,bf16x8 pa3){
  #pragma unroll
  for(int d0=0;d0<2;++d0){s16x4 lo[4],hi[4];
    #pragma unroll
    for(int ks=0;ks<4;++ks){
      asm volatile("ds_read_b64_tr_b16 %0,%1 offset:%c2":"=&v"(lo[ks]):"v"(vb),"i"(d0*4096+ks*1024):"memory");
      asm volatile("ds_read_b64_tr_b16 %0,%1 offset:%c2":"=&v"(hi[ks]):"v"(vb),"i"(d0*4096+ks*1024+512):"memory");}
    asm volatile("s_waitcnt lgkmcnt(0)":::"memory");SBAR();
    #define PK(k) (bf16x8){lo[k][0],lo[k][1],lo[k][2],lo[k][3],hi[k][0],hi[k][1],hi[k][2],hi[k][3]}
    o[d0]=__builtin_amdgcn_mfma_f32_32x32x16_bf16(pa0,PK(0),o[d0],0,0,0);
    o[d0]=__builtin_amdgcn_mfma_f32_32x32x16_bf16(pa1,PK(1),o[d0],0,0,0);
    o[d0]=__builtin_amdgcn_mfma_f32_32x32x16_bf16(pa2,PK(2),o[d0],0,0,0);
    o[d0]=__builtin_amdgcn_mfma_f32_32x32x16_bf16(pa3,PK(3),o[d0],0,0,0);
    #undef PK
  }
}

#ifndef ATTN_STORE16
#define ATTN_STORE16(p,v) (*(u32x4*)(p)=(v))
#endif
template<int THRL> __device__ __forceinline__ void attn_unit(int b,int h,int qb,const bf16*Q,const bf16*__restrict__ K,const bf16*__restrict__ V,bf16*O,const bf16*__restrict__ GT,const unsigned char*__restrict__ G3,const float*__restrict__ qgain,const float kbound,char*shm,const int tid_in,const int j0){
  int tid_l=tid_in; asm volatile("":"+v"(tid_l)); const int tid=tid_l,lane=tid&63,r32=lane&31,hi=lane>>5; const int wid=__builtin_amdgcn_readfirstlane(tid>>6);
  const long rowbase=(long)b*SEQ; const int q0=qb*QB;
  const bf16*Qw=Q+(rowbase+q0+wid*QBLK)*DM+h*D;
  const bf16*Kh=K+rowbase*DM+h*D,*Vh=V+rowbase*DM+h*D;
  const unsigned lds0=(unsigned)(uintptr_t)shm;
  float*wsf=(float*)(shm+LDS_WS)+wid*64;
  const bf16*ksrc=Kh+(long)lane*DM+wid*8;
  const bf16*vsrc=Vh+(long)(16*(wid&3)+(lane>>2))*DM+(wid>>2)*32+(lane&3)*8;
  const unsigned kdst=lds0+LDS_K+wid*1024, vdst=lds0+LDS_V+wid*1024, gdst=lds0+LDS_K+8192;
  const unsigned char*gsrc=G3+((long)(b*NHEAD+h)*SEQ+lane)*16;
  #define DMA_K(t,slot) do{ if(wid==0)glds16(gsrc+(long)(t)*KVBLK*16,(unsigned)__builtin_amdgcn_readfirstlane(gdst+(slot))); glds16(ksrc+(long)(t)*KVBLK*DM,(unsigned)__builtin_amdgcn_readfirstlane(kdst+(slot))); }while(0)
  #define DMA_V(t,slot) glds16(vsrc+(long)(t)*KVBLK*DM,(unsigned)__builtin_amdgcn_readfirstlane(vdst+(slot)))
  const int vb0=(int)(lds0+LDS_V)+((lane>>4)&1)*32+(lane&3)*8+(4*hi+((lane&15)>>2))*64;
  const char*Kbase=shm+LDS_K; bf16x8 kf[10];
  const lds_cptr shm3=(lds_cptr)shm; const lds_cptr kp0=shm3+LDS_K+hi*1024+r32*16; const lds_cptr kpe=shm3+LDS_K+8192+r32*16; const lds_cptr vp0=shm3+LDS_V+((lane>>4)&1)*32+(lane&3)*8+(4*hi+((lane&15)>>2))*64;
  ksrc+=(long)j0*KVBLK*DM; vsrc+=(long)j0*KVBLK*DM; gsrc+=(long)j0*KVBLK*16;
  const int NT=(q0+QB)/KVBLK-j0;
  DMA_K(0,0);DMA_V(0,0);DMA_K(1,SLOTB);
  bf16x8 qr[4]; float fq2; bf16x8 qe; float ubound;
  { bf16x8 qraw[4];
    #pragma unroll
    for(int d0=0;d0<4;++d0)qraw[d0]=*reinterpret_cast<const bf16x8*>(&Qw[(long)r32*DM+d0*16+hi*8]);
    const u32x4 ge=*reinterpret_cast<const u32x4*>(G3+((long)(b*NHEAD+h)*SEQ+q0+wid*QBLK+r32)*16);
    fq2=-(__uint_as_float(ge[0]<<16)+__uint_as_float(ge[0]&0xffff0000u)+__uint_as_float(ge[1]<<16));
    float ss=0.f;
    #pragma unroll
    for(int d0=0;d0<4;++d0)
      #pragma unroll
      for(int j=0;j<8;++j){const float x=__uint_as_float(((unsigned)(unsigned short)qraw[d0][j])<<16);ss+=x*x;}
    {auto rr=__builtin_amdgcn_permlane32_swap(__float_as_uint(ss),__float_as_uint(ss),false,false);ss=__uint_as_float(rr[0])+__uint_as_float(rr[1]);}
    const float qs=C2/sqrtf(ss*(1.0f/64.0f)+1e-6f);
    float s2=0.f;
    #pragma unroll
    for(int d0=0;d0<4;++d0){ u32x4 w;
      #pragma unroll
      for(int j=0;j<8;j+=2){const float x0=__uint_as_float(((unsigned)(unsigned short)qraw[d0][j])<<16),x1=__uint_as_float(((unsigned)(unsigned short)qraw[d0][j+1])<<16);
        const float y0=x0*qs*qgain[d0*16+hi*8+j],y1=x1*qs*qgain[d0*16+hi*8+j+1]; s2+=y0*y0+y1*y1;
        w[j>>1]=cvtpk_s(y0,y1);}
      qr[d0]=__builtin_bit_cast(bf16x8,w);}
    {auto rr=__builtin_amdgcn_permlane32_swap(__float_as_uint(s2),__float_as_uint(s2),false,false);s2=__uint_as_float(rr[0])+__uint_as_float(rr[1]);}
    ubound=sqrtf(s2)*kbound;
    const unsigned one2=hi?0u:0x3f803f80u, one1=hi?0u:0x00003f80u; qe=__builtin_bit_cast(bf16x8,(u32x4){one2,one1,0u,0u}); }
  float mhat=ubound,l_reg=0.f;f32x16 o[2];o[0]=f32x16{};o[1]=f32x16{};f32x16 negm;
  #pragma unroll
  for(int r=0;r<16;++r)negm[r]=fq2-ubound;
  asm volatile("":"+v"(negm));
  const int qrel=wid*QBLK+r32;
  #define CMASK(P0,P1,t) do{int jb_=(t)-(NT-4); if(jb_>=0)cmask(P0,P1,jb_,qrel,hi);}while(0)
  bool resc=false;
  #define START(P0,P1) do{ const float rm=rowmax(P0,P1); resc=false; \
    { const float dl=fmaxf(rm,0.f); mhat=fadd_s(mhat,dl); \
      _Pragma("unroll") for(int r=0;r<16;++r){P0[r]=fsub_s(P0[r],dl);P1[r]=fsub_s(P1[r],dl);} \
      _Pragma("unroll") for(int r=0;r<16;++r)negm[r]=fq2-mhat; asm volatile("":"+v"(negm)); } \
    _Pragma("unroll") for(int r=0;r<16;++r)P0[r]=__builtin_amdgcn_exp2f(P0[r]); }while(0)
  #define RESC() do{ if(resc){ asm volatile("s_waitcnt lgkmcnt(0)":::"memory"); \
      _Pragma("unroll") for(int d_=0;d_<2;++d_) _Pragma("unroll") for(int r=0;r<16;++r)o[d_][r]*=wsf[crow(r,hi)]; } }while(0)
  f32x16 pA0,pA1,pB0,pB1;
  int sl_prev=0,sl_cur=0,sl_next=SLOTB;
  #define ROT() do{sl_prev=sl_cur;sl_cur=sl_next;sl_next=(sl_next==(NSLOT-1)*SLOTB)?0:sl_next+SLOTB;}while(0)
  DMA_K(2,2*SLOTB);
  WAIT_BAR(3);
  qkt(pA0,pA1,Kbase,qr,qe,negm,r32,hi);asm volatile("s_nop 15\n\ts_nop 7":"+v"(pA0),"+v"(pA1));CMASK(pA0,pA1,0);
  START(pA0,pA1);
  _Pragma("unroll") for(int r=0;r<16;++r)pA1[r]=__builtin_amdgcn_exp2f(pA1[r]);
  WAIT_BAR(0);
  DMA_K(3,0);DMA_V(1,SLOTB);
  ROT();
  kload8(kf,kp0+sl_cur);
  kf[8]=*(const __attribute__((address_space(3))) bf16x8*)(kpe+sl_cur); kf[9]=*(const __attribute__((address_space(3))) bf16x8*)(kpe+sl_cur+512);
  WAIT_BARW();
  s16x4 vlo[8],vhi[8]; u32x4 pw0,pw1,pw2,pw3;
  #define PKW(P,B) cvtpk_s(P[B],P[B+1])
  #define PAF(k) __builtin_bit_cast(bf16x8,pw##k)
  #define VFR(i) (bf16x8){vlo[i][0],vlo[i][1],vlo[i][2],vlo[i][3],vhi[i][0],vhi[i][1],vhi[i][2],vhi[i][3]}
  #define PIN(x) asm volatile("":"+v"(x))
  #define MX3(a,b,c) __builtin_fmaxf(__builtin_fmaxf((a),(b)),(c))
  #define GAPA(MF,A0,A1,A2,A3,W0,W1,PW) do{ MF; sacc+=A0; sacc+=A1; sacc+=A2; sacc+=A3; PIN(sacc); W0; W1; PIN(PW); SBAR(); }while(0)
  #define EX(v) __builtin_amdgcn_exp2f(v)
  #define GAPB(MF,X,B) do{ MF; X[B]=EX(X[B]); X[B+1]=EX(X[B+1]); X[B+2]=EX(X[B+2]); X[B+3]=EX(X[B+3]); PIN(X); SBAR(); }while(0)
  #define VRD(i) do{ vlo[i]=vtr(vp_+(((i)>>2)*4096+((i)&3)*1024)); vhi[i]=vtr(vp_+(((i)>>2)*4096+((i)&3)*1024+512)); }while(0)
  #define KRD(G,j) do{ if(G){ kload2(kf,kp0+sl_next,j); SBAR(); } }while(0)
  #define STEP(C0,C1,P0,P1,t,GK,GV,GL) do{ SBAR(); \
    const lds_cptr vp_=vp0+sl_prev; \
    VRD(0); SBAR(); float sacc=(P0[0]+P0[1]); \
    GAPA(C0=__builtin_amdgcn_mfma_f32_32x32x16_bf16(kf[0],qr[0],negm,0,0,0), P0[2],P0[3],P0[4],P0[5],     pw0[0]=PKW(P0,0), pw0[1]=PKW(P0,2), pw0); \
    VRD(4); SBAR(); GAPA(C1=__builtin_amdgcn_mfma_f32_32x32x16_bf16(kf[1],qr[0],negm,0,0,0), P0[6],P0[7],P0[8],P0[9],     pw0[2]=PKW(P0,4), pw0[3]=PKW(P0,6), pw0); \
    VRD(1); SBAR(); GAPA(C0=__builtin_amdgcn_mfma_f32_32x32x16_bf16(kf[2],qr[1],C0,0,0,0),   P0[10],P0[11],P0[12],P0[13], pw1[0]=PKW(P0,8), pw1[1]=PKW(P0,10), pw1); \
    VRD(5); SBAR(); GAPA(C1=__builtin_amdgcn_mfma_f32_32x32x16_bf16(kf[3],qr[1],C1,0,0,0),   P0[14],P0[15],P1[0],P1[1],   pw1[2]=PKW(P0,12),pw1[3]=PKW(P0,14), pw1); \
    VRD(2); SBAR(); GAPA(C0=__builtin_amdgcn_mfma_f32_32x32x16_bf16(kf[4],qr[2],C0,0,0,0),   P1[2],P1[3],P1[4],P1[5],     pw2[0]=PKW(P1,0), pw2[1]=PKW(P1,2), pw2); \
    VRD(6); SBAR(); GAPA(C1=__builtin_amdgcn_mfma_f32_32x32x16_bf16(kf[5],qr[2],C1,0,0,0),   P1[6],P1[7],P1[8],P1[9],     pw2[2]=PKW(P1,4), pw2[3]=PKW(P1,6), pw2); \
    VRD(3); SBAR(); GAPA(C0=__builtin_amdgcn_mfma_f32_32x32x16_bf16(kf[6],qr[3],C0,0,0,0),   P1[10],P1[11],P1[12],P1[13], pw3[0]=PKW(P1,8), pw3[1]=PKW(P1,10), pw3); \
    VRD(7); SBAR(); GAPA(C1=__builtin_amdgcn_mfma_f32_32x32x16_bf16(kf[7],qr[3],C1,0,0,0),   P1[14],P1[15],0.f,0.f,       pw3[2]=PKW(P1,12),pw3[3]=PKW(P1,14), pw3); \
    C0=__builtin_amdgcn_mfma_f32_32x32x16_bf16(kf[8],qe,C0,0,0,0); C1=__builtin_amdgcn_mfma_f32_32x32x16_bf16(kf[9],qe,C1,0,0,0); \
    l_reg+=sacc; \
    if(GK){DMA_K((t)+3,sl_cur);} if(GV){DMA_V((t)+1,sl_next);} \
    CMASK(C0,C1,t); \
    resc=false;     \
    SBAR(); \
    GAPB(o[0]=__builtin_amdgcn_mfma_f32_32x32x16_bf16(PAF(0),VFR(0),o[0],0,0,0), C0,0); \
    GAPB(o[1]=__builtin_amdgcn_mfma_f32_32x32x16_bf16(PAF(0),VFR(4),o[1],0,0,0), C0,4); \
    KRD(GL,0); GAPB(o[0]=__builtin_amdgcn_mfma_f32_32x32x16_bf16(PAF(1),VFR(1),o[0],0,0,0), C0,8); \
    KRD(GL,1); GAPB(o[1]=__builtin_amdgcn_mfma_f32_32x32x16_bf16(PAF(1),VFR(5),o[1],0,0,0), C0,12); \
    KRD(GL,2); GAPB(o[0]=__builtin_amdgcn_mfma_f32_32x32x16_bf16(PAF(2),VFR(2),o[0],0,0,0), C1,0); \
    KRD(GL,3); GAPB(o[1]=__builtin_amdgcn_mfma_f32_32x32x16_bf16(PAF(2),VFR(6),o[1],0,0,0), C1,4); \
    if(GL){ kf[8]=*(const __attribute__((address_space(3))) bf16x8*)(kpe+sl_next); kf[9]=*(const __attribute__((address_space(3))) bf16x8*)(kpe+sl_next+512); SBAR(); } \
    GAPB(o[0]=__builtin_amdgcn_mfma_f32_32x32x16_bf16(PAF(3),VFR(3),o[0],0,0,0), C1,8); \
    GAPB(o[1]=__builtin_amdgcn_mfma_f32_32x32x16_bf16(PAF(3),VFR(7),o[1],0,0,0), C1,12); \
    }while(0)
  int t=1;
  #undef CMASK
  #define CMASK(P0,P1,t) do{}while(0)
  for(;t+5<NT;t+=2){
    STEP(pB0,pB1,pA0,pA1,t,true,true,true);     WAIT_BARW(); RESC(); ROT();
    STEP(pA0,pA1,pB0,pB1,t+1,true,true,true);   WAIT_BARW(); RESC(); ROT();
  }
  #undef CMASK
  #define CMASK(P0,P1,t) do{int jb_=(t)-(NT-4); if(jb_>=0)cmask(P0,P1,jb_,qrel,hi);}while(0)
  #define ENDW(tt) do{ if((tt)+3<NT){WAIT_BARW();} else if((tt)+2<NT){WAIT_BAR(1);} else {WAIT_BAR(0);} }while(0)
  for(;t+1<NT;t+=2){
    STEP(pB0,pB1,pA0,pA1,t,(t+3<NT),(t+1<NT),(t+1<NT));       ENDW(t);   RESC(); ROT();
    STEP(pA0,pA1,pB0,pB1,t+1,(t+4<NT),(t+2<NT),(t+2<NT));     ENDW(t+1); RESC(); ROT();
  }
  STEP(pB0,pB1,pA0,pA1,NT-1,false,false,false); RESC();
  { float sacc=pB0[0]+pB0[1]; _Pragma("unroll") for(int r=2;r<16;++r)sacc+=pB0[r]; _Pragma("unroll") for(int r=0;r<16;++r)sacc+=pB1[r]; l_reg+=sacc;
    pw0=(u32x4){PKW(pB0,0),PKW(pB0,2),PKW(pB0,4),PKW(pB0,6)};pw1=(u32x4){PKW(pB0,8),PKW(pB0,10),PKW(pB0,12),PKW(pB0,14)};pw2=(u32x4){PKW(pB1,0),PKW(pB1,2),PKW(pB1,4),PKW(pB1,6)};pw3=(u32x4){PKW(pB1,8),PKW(pB1,10),PKW(pB1,12),PKW(pB1,14)};
    SBAR(); pv(o,vb0+sl_cur,PAF(0),PAF(1),PAF(2),PAF(3)); }
  #undef PKW
  #undef PAF
  #undef VFR
  #undef PIN
  #undef MX3
  #undef GAPA
  #undef GAPB
  #undef EX
  #undef VRD
  #undef KRD
  #undef STEP
  #undef ENDW
  {auto rr=__builtin_amdgcn_permlane32_swap(__float_as_uint(l_reg),__float_as_uint(l_reg),false,false);l_reg=__uint_as_float(rr[0])+__uint_as_float(rr[1]);}
  if(hi==0)wsf[32+r32]=l_reg;asm volatile("s_waitcnt lgkmcnt(0)":::"memory");
  float rli[16];
  #pragma unroll
  for(int r=0;r<16;++r)rli[r]=__builtin_amdgcn_rcpf(wsf[32+crow(r,hi)]);
  bf16*Ow=O+(rowbase+q0+wid*QBLK)*DM+h*D;
  { bf16*stg=(bf16*)(shm+LDS_OST)+wid*2048;
    #pragma unroll
    for(int r=0;r<16;++r){const int orow=crow(r,hi);
      #pragma unroll
      for(int d0=0;d0<2;++d0)stg[orow*64+d0*32+r32]=__float2bfloat16(o[d0][r]*rli[r]);}
    asm volatile("s_waitcnt lgkmcnt(0)":::"memory");
    const bf16*Gw=GT+(rowbase+q0+wid*QBLK)*DM+h*D;
    #pragma unroll
    for(int i=0;i<4;++i){const int row=i*8+(lane>>3),ch=lane&7; u32x4 v=*(const u32x4*)(stg+row*64+ch*8); const u32x4 gg=*(const u32x4*)(Gw+(long)row*DM+ch*8);
      #pragma unroll
      for(int j=0;j<4;++j){ v[j]=cvtpk_s(__uint_as_float(v[j]<<16)*__uint_as_float(gg[j]<<16),__uint_as_float(v[j]&0xffff0000u)*__uint_as_float(gg[j]&0xffff0000u)); }
      ATTN_STORE16(Ow+(long)row*DM+ch*8,v);} }
  asm volatile("s_waitcnt lgkmcnt(0)\n\ts_barrier":::"memory");
  #undef DMA_K
  #undef DMA_V
  #undef CMASK
  #undef START
  #undef RESC
  #undef ROT
}
constexpr int ATTN_LDS_BYTES=LDS_BYTES;
struct AttnTensors { const bf16* Q; const bf16* K; const bf16* V; bf16* O; const bf16* GT; const unsigned char* G3; const float* qgain; float kbound; };
struct AttnUnit { int bh; int qb; };
struct StaticOrder {
  int vcu;
  __device__ __forceinline__ explicit StaticOrder(int grid,int block):vcu((block%8)*(grid/8)+block/8){}
  __device__ __forceinline__ bool next(int i,AttnUnit&u)const{ if(i>=4)return false; const int s=vcu&7; u.bh=vcu>>3; u.qb=(i==0)?s:(i==1)?15-s:(i==2)?16+s:31-s; return true; }
  __device__ __forceinline__ void a_ready(const AttnUnit&)const{}
  __device__ __forceinline__ void done(const AttnUnit&)const{}
};
template<class Sched,int THRL=8> __device__ __forceinline__ void attn_phase(char*lds,const AttnTensors&T,const Sched&S,const int tid_in){
  AttnUnit u;
  for(int i=0;S.next(i,u);++i){ S.a_ready(u); attn_unit<THRL>(u.bh/NHEAD,u.bh%NHEAD,u.qb,T.Q,T.K,T.V,T.O,T.GT,T.G3,T.qgain,T.kbound,lds,tid_in,0); S.done(u); }
}
__device__ __forceinline__ float g3val(const unsigned char*G3,long key){ const u32x4 ge=*reinterpret_cast<const u32x4*>(G3+key*16); return __uint_as_float(ge[0]<<16)+__uint_as_float(ge[0]&0xffff0000u)+__uint_as_float(ge[1]<<16); }
template<int THRL=8> __device__ __forceinline__ void attn_phase_dyn(char*lds,const AttnTensors&T,unsigned*counter,const float thr2,const int tid_in){
  int tid_l=tid_in; asm volatile("":"+v"(tid_l)); const int tid=tid_l,lane=tid&63;
  volatile unsigned*uw=(volatile unsigned*)(lds+LDS_BYTES);
  for(;;){
    if(tid==0){ const unsigned got=__hip_atomic_fetch_add(counter,1u,__ATOMIC_RELAXED,__HIP_MEMORY_SCOPE_AGENT); *uw=got; }
    __syncthreads();
    const unsigned u=(unsigned)__builtin_amdgcn_readfirstlane((int)*uw);
    if(u>=(unsigned)(BATCH*NHEAD*NQB))break;
    const int qb=NQB-1-(int)(u>>5), bh=(int)(u&31), ntf=4*qb+4;
    const long kb=(long)bh*SEQ; const float gt0=g3val(T.G3,kb+(long)qb*QB);
    bool skip0=false,skip1=false;
    if(lane<ntf) skip0=g3val(T.G3,kb+64*lane+63)<gt0-thr2;
    if(lane+64<ntf) skip1=g3val(T.G3,kb+64*(lane+64)+63)<gt0-thr2;
    int j0=__builtin_popcountll(__ballot(skip0))+__builtin_popcountll(__ballot(skip1));
    j0=__builtin_amdgcn_readfirstlane(j0); j0&=~1; if(j0>ntf-4)j0=ntf-4;
    attn_unit<THRL>(bh/NHEAD,bh%NHEAD,qb,T.Q,T.K,T.V,T.O,T.GT,T.G3,T.qgain,T.kbound,lds,tid_in,j0);
  }
}
#undef SBAR
#undef WAIT_BAR
#undef WAIT_BARW
}
constexpr int NWAVES = 8;
constexpr int BATCH = 2, T = 8192, D = 1024, H = 16, HD = 64, FF = 4096, M = BATCH * T;
constexpr int N1 = 3584, K1 = 2048, NP2 = 3072;
constexpr size_t MiB = 1u << 20;
constexpr size_t WS_MOD = 0;
constexpr size_t WS_W1 = 1 * MiB;
constexpr size_t WS_W2A = 29 * MiB;
constexpr size_t WS_W2G = 32 * MiB;
constexpr size_t WS_WO = 33 * MiB;
constexpr size_t WS_WKV = 37 * MiB;
constexpr size_t WS_WQG = 42 * MiB;
constexpr size_t WS_WO2 = 50 * MiB;
constexpr size_t WS_WUP = 54 * MiB, WS_WDN = 62 * MiB;
constexpr size_t WS_G3 = 70 * MiB;
constexpr size_t WS_FL = 74 * MiB;
constexpr size_t WS_H2 = 76 * MiB;
constexpr size_t WS_P1 = 140 * MiB;
constexpr size_t WS_P2 = 252 * MiB;
constexpr size_t WS_VF = 348 * MiB;
constexpr size_t WS_HB = 140 * MiB;
constexpr size_t WS_KVRAW = 140 * MiB, WS_QB = 204 * MiB, WS_GT = 236 * MiB, WS_VS = 316 * MiB, WS_KS = 348 * MiB;
constexpr size_t WS_END = 380 * MiB;
constexpr int LDS_BYTES = 147456;

#define GAS __attribute__((address_space(1)))
#define LAS __attribute__((address_space(3)))
typedef unsigned short bf16;
typedef unsigned v4u __attribute__((ext_vector_type(4)));
typedef unsigned v2u __attribute__((ext_vector_type(2)));
typedef float f32x4 __attribute__((ext_vector_type(4)));
using pg8::pkbf; using pg8::bflo; using pg8::bfhi; using pg8::sigm;

struct Args { const float* in[39]; float* out; unsigned char* ws; int ph_lo, ph_hi; };

struct Frame { LAS unsigned char* lds; int tid, lane, wave, vcu, G, bx; unsigned char* ws; float* out; const float* const* in; };

__device__ __forceinline__ void tr_item(const float* W, int ldw, int Nvalid, bf16* WT, int ldt, int row_off, int col_off, const float* mu, LAS float* scr, int item, int lane) {
    const int nblk = (Nvalid + 31) / 32, kb = item / nblk, nb = item % nblk, k0 = 64 * kb, n0 = 32 * nb;
    { float t[32]; const int n = n0 + (lane & 31); const bool ok = n < Nvalid; const float* wp = W + (size_t)(k0 + (lane >> 5)) * ldw + n;
#pragma unroll
      for (int i = 0; i < 32; ++i) t[i] = ok ? wp[(size_t)(2 * i) * ldw] : 0.f;
#pragma unroll
      for (int i = 0; i < 32; ++i) scr[(2 * i + (lane >> 5)) * 33 + (lane & 31)] = t[i]; }
    asm volatile("s_waitcnt lgkmcnt(0)" ::: "memory");
    const int c = lane & 7;
    float s0[8], s1[8];
#pragma unroll
    for (int q = 0; q < 8; ++q) { const float m = mu ? mu[k0 + 8 * c + q] : 0.f; s0[q] = 1.f - m; s1[q] = m; }
#pragma unroll
    for (int j = 0; j < 4; ++j) { const int n = (lane >> 3) + 8 * j; const LAS float* s = scr + (8 * c) * 33 + n;
        float v[8];
#pragma unroll
        for (int q = 0; q < 8; ++q) v[q] = s[q * 33];
        v4u o; o.x = pkbf(v[0] * s0[0], v[1] * s0[1]); o.y = pkbf(v[2] * s0[2], v[3] * s0[3]); o.z = pkbf(v[4] * s0[4], v[5] * s0[5]); o.w = pkbf(v[6] * s0[6], v[7] * s0[7]);
        bf16* dst = WT + (size_t)(row_off + n0 + n) * ldt + col_off + k0 + 8 * c;
        *(v4u*)dst = o;
        if (mu) { v4u p; p.x = pkbf(v[0] * s1[0], v[1] * s1[1]); p.y = pkbf(v[2] * s1[2], v[3] * s1[3]); p.z = pkbf(v[4] * s1[4], v[5] * s1[5]); p.w = pkbf(v[6] * s1[6], v[7] * s1[7]); *(v4u*)(dst + 1024) = p; } }
    asm volatile("s_waitcnt lgkmcnt(0)" ::: "memory");
}
__device__ __forceinline__ float dpp_f(float x, const int ctrl_sel) {
    switch (ctrl_sel) {
        case 0: return __builtin_bit_cast(float, __builtin_amdgcn_update_dpp(0, __builtin_bit_cast(int, x), 0xB1, 0xf, 0xf, false));
        case 1: return __builtin_bit_cast(float, __builtin_amdgcn_update_dpp(0, __builtin_bit_cast(int, x), 0x4E, 0xf, 0xf, false));
        case 2: return __builtin_bit_cast(float, __builtin_amdgcn_update_dpp(0, __builtin_bit_cast(int, x), 0x141, 0xf, 0xf, false));
        default: return __builtin_bit_cast(float, __builtin_amdgcn_update_dpp(0, __builtin_bit_cast(int, x), 0x140, 0xf, 0xf, false));
    }
}
__device__ __forceinline__ float sum4(float x) { x += dpp_f(x, 0); x += dpp_f(x, 1); return x; }
__device__ __forceinline__ float sum8(float x) { x = sum4(x); x += dpp_f(x, 2); return x; }
__device__ __forceinline__ float sum16(float x) { x = sum8(x); x += dpp_f(x, 3); return x; }
__device__ __forceinline__ float wave_sum(float v) {
    v = sum16(v);
    { auto rr = __builtin_amdgcn_permlane16_swap(__float_as_uint(v), __float_as_uint(v), false, false); v = __uint_as_float(rr[0]) + __uint_as_float(rr[1]); }
    { auto rr = __builtin_amdgcn_permlane32_swap(__float_as_uint(v), __float_as_uint(v), false, false); v = __uint_as_float(rr[0]) + __uint_as_float(rr[1]); }
    return v;
}
__device__ __forceinline__ void norm_row(const float* xrow, const float* g, const float* sh, const float* sc, int lane, f32x4 (&v)[4]) {
    float s = 0.f;
#pragma unroll
    for (int j = 0; j < 4; ++j) { v[j] = *((const f32x4*)xrow + lane + 64 * j); s += (v[j].x * v[j].x + v[j].y * v[j].y) + (v[j].z * v[j].z + v[j].w * v[j].w); }
    const float rstd = 1.0f / sqrtf(wave_sum(s) * (1.f / D) + 1e-6f);
#pragma unroll
    for (int j = 0; j < 4; ++j) { const f32x4 gg = *((const f32x4*)g + lane + 64 * j);
        f32x4 a = {1.f, 1.f, 1.f, 1.f}, b = {0.f, 0.f, 0.f, 0.f}; if (sc) { a = *((const f32x4*)sc + lane + 64 * j) + 1.0f; b = *((const f32x4*)sh + lane + 64 * j); }
        v[j] = (v[j] * rstd * gg) * a + b; }
}
__device__ __forceinline__ void st_row_bf16(bf16* orow, int lane, const f32x4 (&v)[4]) {
#pragma unroll
    for (int j = 0; j < 4; ++j) { v2u w; w.x = pkbf(v[j].x, v[j].y); w.y = pkbf(v[j].z, v[j].w); *((v2u*)orow + lane + 64 * j) = w; }
}
__device__ __forceinline__ void p0_mod(Frame& F) {
    LAS float* ca = (LAS float*)F.lds; LAS float* red = (LAS float*)(F.lds + 8192);
    const float* cin = F.in[1];
    for (int i = F.tid; i < 2048; i += 512) { const float c = cin[i]; ca[i] = c / (1.0f + __expf(-c)); }
    __syncthreads();
    float* MOD = (float*)(F.ws + WS_MOD); float* MODKV = MOD + 4 * 2 * 6144;
    for (int item = F.bx; item < 208; item += F.G) {
        const int col = item * 128; const float* W; const float* bias; int ldw, cw; float* dst0; float* dst1;
        if (col < 24576) { const int l = col / 6144; cw = col % 6144; W = F.in[2] + (size_t)l * 1024 * 6144; ldw = 6144; bias = F.in[3] + l * 6144; dst0 = MOD + (l * 2 + 0) * 6144 + cw; dst1 = MOD + (l * 2 + 1) * 6144 + cw; }
        else { cw = col - 24576; W = F.in[30]; ldw = 2048; bias = F.in[31]; dst0 = MODKV + cw; dst1 = MODKV + 2048 + cw; }
        const int c4 = F.tid & 31, ks = F.tid >> 5;
        f32x4 a0 = {0.f, 0.f, 0.f, 0.f}, a1 = {0.f, 0.f, 0.f, 0.f};
#pragma unroll 8
        for (int k = ks * 64; k < ks * 64 + 64; ++k) { const f32x4 w = *(const f32x4*)(W + (size_t)k * ldw + cw + c4 * 4); a0 += w * ca[k]; a1 += w * ca[1024 + k]; }
        *(LAS f32x4*)(red + (ks * 32 + c4) * 8) = a0; *(LAS f32x4*)(red + (ks * 32 + c4) * 8 + 4) = a1;
        __syncthreads();
        if (F.tid < 256) { const int b = F.tid >> 7, c = F.tid & 127; float s = 0.f;
#pragma unroll
            for (int q = 0; q < 16; ++q) s += red[(q * 32 + (c >> 2)) * 8 + b * 4 + (c & 3)];
            (b ? dst1 : dst0)[c] = s + bias[cw + c]; }
        __syncthreads();
    }
}
__device__ __forceinline__ void p0_weights(Frame& F) {
    LAS float* scr = (LAS float*)(F.lds + 16384 + F.wave * 16384);
    const int gw = F.vcu * NWAVES + F.wave, NGW = F.G * NWAVES;
    bf16* W1 = (bf16*)(F.ws + WS_W1); bf16* WO = (bf16*)(F.ws + WS_WO); bf16* WKV = (bf16*)(F.ws + WS_WKV); bf16* WQG = (bf16*)(F.ws + WS_WQG); bf16* WO2 = (bf16*)(F.ws + WS_WO2);
    const float* mu = F.in[8];
    constexpr int PL = 512 * 3 + 32 + 32 + 16 + 80 + 512;
    constexpr int NIT = 2 * PL + 512 + 512 + 16 + 2 * (1024 + 512);
    for (int it = gw; it < NIT; it += NGW) {
        int r = it;
        if (r < 2 * PL) { const int i = r / PL; r -= i * PL; bf16* w1 = W1 + (size_t)i * N1 * K1; const float* m6 = mu + i * 6 * 1024;
            bf16* wl = w1 + (size_t)3072 * 1024;
            if (r < 512) { tr_item(F.in[9] + (size_t)i * D * D, D, D, w1, D, 0, 0, nullptr, scr, r, F.lane); continue; } r -= 512;
            if (r < 512) { tr_item(F.in[10] + (size_t)i * D * D, D, D, w1, D, 1024, 0, nullptr, scr, r, F.lane); continue; } r -= 512;
            if (r < 512) { tr_item(F.in[11] + (size_t)i * D * D, D, D, w1, D, 2048, 0, nullptr, scr, r, F.lane); continue; } r -= 512;
            if (r < 32) { tr_item(F.in[14] + (size_t)i * D * 64, 64, 64, wl, K1, 0, 0, m6 + 1 * 1024, scr, r, F.lane); continue; } r -= 32;
            if (r < 32) { tr_item(F.in[17] + (size_t)i * D * 64, 64, 64, wl, K1, 64, 0, m6 + 4 * 1024, scr, r, F.lane); continue; } r -= 32;
            if (r < 16) { if (i == 1) tr_item(F.in[27], 32, 32, wl, K1, 128, 0, m6 + 3 * 1024, scr, r, F.lane); continue; } r -= 16;
            if (r < 80) { tr_item(F.in[19] + (size_t)i * D * 160, 160, 160, wl, K1, 160, 0, m6 + 5 * 1024, scr, r, F.lane); continue; } r -= 80;
            tr_item(F.in[12] + (size_t)i * D * D, D, D, WO + (size_t)i * D * D, D, 0, 0, nullptr, scr, r, F.lane); continue; }
        r -= 2 * PL;
        if (r < 512) { tr_item(F.in[32], 2064, 1024, WKV, D, 0, 0, nullptr, scr, r, F.lane); continue; } r -= 512;
        if (r < 512) { tr_item(F.in[32] + 1024, 2064, 1024, WKV, D, 1024, 0, nullptr, scr, r, F.lane); continue; } r -= 512;
        if (r < 16) { tr_item(F.in[32] + 2048, 2064, 16, WKV, D, 2048, 0, nullptr, scr, r, F.lane); continue; } r -= 16;
        { const int j = r / 1536; r -= j * 1536;
          if (r < 1024) tr_item(F.in[35] + (size_t)j * D * 2048, 2048, 2048, WQG + (size_t)j * 2048 * D, D, 0, 0, nullptr, scr, r, F.lane);
          else tr_item(F.in[37] + (size_t)j * D * D, D, D, WO2 + (size_t)j * D * D, D, 0, 0, nullptr, scr, r - 1024, F.lane); }
    }
    const int gt = F.bx * 512 + F.tid, NT = F.G * 512; const v4u z = {0u, 0u, 0u, 0u};
    for (int e = gt; e < 135168; e += NT) {
        int r = e; bf16* p;
        if (r < 98304) { const int i = r / 49152; r -= i * 49152; p = W1 + (size_t)i * N1 * K1 + (size_t)3072 * 1024 + (size_t)320 * K1 + (size_t)r * 8; }
        else if (r < 98304 + 8192) { r -= 98304; p = W1 + (size_t)3072 * 1024 + (size_t)128 * K1 + (size_t)r * 8; }
        else { r -= 98304 + 8192; p = WKV + (size_t)2080 * D + (size_t)r * 8; }
        *(v4u*)p = z; }
    { float* B2 = (float*)(F.ws + WS_MOD) + 53248;
      for (int e = gt; e < 2 * 3072; e += NT) { const int i = e / 3072, n = e % 3072, grp = n >> 10, c = n & 1023;
          B2[e] = grp == 0 ? F.in[13][i * D + c] : (grp == 1 ? F.in[16][i * D + c] : (i == 1 ? F.in[26][c] : 0.f)); } }
    bf16* W2A = (bf16*)(F.ws + WS_W2A); bf16* W2G = (bf16*)(F.ws + WS_W2G);
    for (int e4 = gt; e4 < 2 * 262144; e4 += NT) {
        const int i = e4 >> 18; int r = (e4 & 262143) * 4;
        if (r < 786432) { const int k = r / 3072, n = r % 3072, grp = n >> 10, c = n & 1023; f32x4 v = {0.f, 0.f, 0.f, 0.f};
            if (grp == 0) { if (k < 64) v = *(const f32x4*)(F.in[15] + ((size_t)i * 64 + k) * 1024 + c); }
            else if (grp == 1) { if (k >= 64 && k < 128) v = *(const f32x4*)(F.in[18] + ((size_t)i * 64 + (k - 64)) * 1024 + c); }
            else { if (i == 1 && k >= 128 && k < 160) v = *(const f32x4*)(F.in[28] + (size_t)(k - 128) * 1024 + c); }
            bf16* o = W2A + (size_t)i * 3072 * 256 + (size_t)n * 256 + k; const unsigned p0 = pkbf(v.x, v.y), p1 = pkbf(v.z, v.w);
            o[0] = (bf16)(p0 & 0xffffu); o[256] = (bf16)(p0 >> 16); o[512] = (bf16)(p1 & 0xffffu); o[768] = (bf16)(p1 >> 16); }
        else { r -= 786432; const int k = r >> 10, n = r & 1023; f32x4 v = {0.f, 0.f, 0.f, 0.f}; if (k < 160) v = *(const f32x4*)(F.in[20] + ((size_t)i * 160 + k) * 1024 + n);
            bf16* o = W2G + (size_t)i * 1024 * 256 + (size_t)n * 256 + k; const unsigned p0 = pkbf(v.x, v.y), p1 = pkbf(v.z, v.w);
            o[0] = (bf16)(p0 & 0xffffu); o[256] = (bf16)(p0 >> 16); o[512] = (bf16)(p1 & 0xffffu); o[768] = (bf16)(p1 >> 16); }
    }
}
__device__ __forceinline__ void mlp_weights(Frame& F, int L) {
    LAS float* scr = (LAS float*)(F.lds + F.wave * 16384);
    const int gw = F.vcu * NWAVES + F.wave, NGW = F.G * NWAVES;
    bf16* WUP = (bf16*)(F.ws + WS_WUP); bf16* WDN = (bf16*)(F.ws + WS_WDN);
    for (int it = gw; it < 4096; it += NGW) {
        if (it < 2048) tr_item(F.in[6] + (size_t)L * D * FF, FF, FF, WUP, D, 0, 0, nullptr, scr, it, F.lane);
        else tr_item(F.in[7] + (size_t)L * FF * D, D, D, WDN, FF, 0, 0, nullptr, scr, it - 2048, F.lane);
    }
}
__device__ __forceinline__ void norm_phase(Frame& F, const float* xin, const float* g, const float* sh, const float* sc, int bstride, int mode, bf16* dst, float* outf = nullptr) {
    const int gw = F.vcu * NWAVES + F.wave, NGW = F.G * NWAVES, lane = F.lane; (void)mode;
    for (int base = gw * 8; base < M; base += NGW * 8) {
        const int b = base >> 13;
        f32x4 gg[4], aa[4], bb[4];
#pragma unroll
        for (int j = 0; j < 4; ++j) { gg[j] = *((const f32x4*)g + lane + 64 * j);
            aa[j] = sc ? *((const f32x4*)(sc + b * bstride) + lane + 64 * j) + 1.0f : (f32x4){1.f, 1.f, 1.f, 1.f}; bb[j] = sh ? *((const f32x4*)(sh + b * bstride) + lane + 64 * j) : (f32x4){0.f, 0.f, 0.f, 0.f}; }
        f32x4 xn[4];
#pragma unroll
        for (int j = 0; j < 4; ++j) xn[j] = *((const f32x4*)(xin + (size_t)base * D) + lane + 64 * j);
#pragma unroll 1
        for (int r = 0; r < 8; ++r) { const int m = base + r; f32x4 v[4]; float s = 0.f;
#pragma unroll
            for (int j = 0; j < 4; ++j) { v[j] = xn[j]; s += (v[j].x * v[j].x + v[j].y * v[j].y) + (v[j].z * v[j].z + v[j].w * v[j].w); }
            if (r + 1 < 8) {
#pragma unroll
                for (int j = 0; j < 4; ++j) xn[j] = *((const f32x4*)(xin + (size_t)(m + 1) * D) + lane + 64 * j); }
            const float rstd = 1.0f / sqrtf(wave_sum(s) * (1.f / D) + 1e-6f);
#pragma unroll
            for (int j = 0; j < 4; ++j) v[j] = (v[j] * rstd * gg[j]) * aa[j] + bb[j];
            if (outf) {
#pragma unroll
                for (int j = 0; j < 4; ++j) *((f32x4*)(outf + (size_t)m * D) + lane + 64 * j) = v[j]; }
            else st_row_bf16(dst + (size_t)m * 1024, lane, v);
        }
    }
}
__device__ __forceinline__ void norm_mix_phase(Frame& F, const float* xin, const float* g, const float* sh, const float* sc, const float* mu, bf16* H2p, bf16* XJ) {
    const int gw = F.vcu * NWAVES + F.wave, NGW = F.G * NWAVES, lane = F.lane;
    for (int base = gw * 8; base < M; base += NGW * 8) {
        const int b = base >> 13;
        f32x4 gg[4], aa[4], bb[4], m0[4], m1[4], m2[4];
#pragma unroll
        for (int j = 0; j < 4; ++j) { gg[j] = *((const f32x4*)g + lane + 64 * j); aa[j] = *((const f32x4*)(sc + b * 6144) + lane + 64 * j) + 1.0f; bb[j] = *((const f32x4*)(sh + b * 6144) + lane + 64 * j);
            m0[j] = *((const f32x4*)mu + lane + 64 * j); m1[j] = *((const f32x4*)(mu + 2048) + lane + 64 * j); m2[j] = *((const f32x4*)(mu + 3072) + lane + 64 * j); }
        const bool first = (base & 8191) == 0; const int r0 = first ? 0 : -1;
        f32x4 hp[4], xn[4];
#pragma unroll
        for (int j = 0; j < 4; ++j) { hp[j] = (f32x4){0.f, 0.f, 0.f, 0.f}; xn[j] = *((const f32x4*)(xin + (size_t)(base + r0) * D) + lane + 64 * j); }
#pragma unroll 1
        for (int r = r0; r < 8; ++r) { const int m = base + r; f32x4 v[4];
            float s = 0.f;
#pragma unroll
            for (int j = 0; j < 4; ++j) { v[j] = xn[j]; s += (v[j].x * v[j].x + v[j].y * v[j].y) + (v[j].z * v[j].z + v[j].w * v[j].w); }
            if (r + 1 < 8) {
#pragma unroll
                for (int j = 0; j < 4; ++j) xn[j] = *((const f32x4*)(xin + (size_t)(m + 1) * D) + lane + 64 * j); }
            const float rstd = 1.0f / sqrtf(wave_sum(s) * (1.f / D) + 1e-6f);
#pragma unroll
            for (int j = 0; j < 4; ++j) v[j] = (v[j] * rstd * gg[j]) * aa[j] + bb[j];
            if (r >= 0) {
                st_row_bf16(H2p + (size_t)m * 2048, lane, v); st_row_bf16(H2p + (size_t)m * 2048 + 1024, lane, hp);
                f32x4 x[4];
#pragma unroll
                for (int j = 0; j < 4; ++j) x[j] = v[j] + (hp[j] - v[j]) * m0[j];
                st_row_bf16(XJ + (size_t)m * D, lane, x);
#pragma unroll
                for (int j = 0; j < 4; ++j) x[j] = v[j] + (hp[j] - v[j]) * m1[j];
                st_row_bf16(XJ + (size_t)M * D + (size_t)m * D, lane, x);
#pragma unroll
                for (int j = 0; j < 4; ++j) x[j] = v[j] + (hp[j] - v[j]) * m2[j];
                st_row_bf16(XJ + (size_t)2 * M * D + (size_t)m * D, lane, x);
            }
#pragma unroll
            for (int j = 0; j < 4; ++j) hp[j] = v[j]; }
    }
}
__device__ __forceinline__ void final_norm_phase(Frame& F) { norm_phase(F, F.out, F.in[38], nullptr, nullptr, 0, 1, nullptr, F.out); }
#ifndef PROBE_SC
#define PROBE_SC 0
#endif
constexpr int SC_C = 32, SC_NC = T / SC_C;
constexpr int SC_VEC = 0, SC_SCAL = 36864, SC_V = 37120, SC_Y = 38144, SC_BUF = 54528;
typedef float f32x2s __attribute__((ext_vector_type(2)));
__device__ __forceinline__ float dot4(const f32x4 s, const f32x4 a) { f32x2s t = (f32x2s){s.x, s.y} * (f32x2s){a.x, a.y}; t = (f32x2s){s.z, s.w} * (f32x2s){a.z, a.w} + t; return t.x + t.y; }
__device__ __forceinline__ void scan_chunk(const LAS unsigned char* Bc, f32x4& S, const int kq, const int rowi) {
                const LAS f32x4* pvec = (const LAS f32x4*)(Bc + SC_VEC) + kq; const LAS f32x4* psc = (const LAS f32x4*)(Bc + SC_SCAL);
                const LAS float* pv = (const LAS float*)(Bc + SC_V) + rowi; LAS float* py = (LAS float*)(Bc + SC_Y) + rowi * 16 + kq;
                f32x4 cv[9], cs; float c0, c1;
#pragma unroll
                for (int j = 0; j < 9; ++j) cv[j] = pvec[j * 16];
                cs = psc[0]; c0 = pv[0]; c1 = pv[8];
#pragma unroll
                for (int p = 0; p < SC_C / 2; ++p) {
                    f32x4 nv[9], ns; float n0, n1;
                    if (p + 1 < SC_C / 2) {
#pragma unroll
                        for (int j = 0; j < 9; ++j) nv[j] = pvec[((p + 1) * 9 + j) * 16];
                        ns = psc[p + 1]; n0 = pv[(2 * p + 2) * 8]; n1 = pv[(2 * p + 3) * 8];
                    }
                    __builtin_amdgcn_sched_barrier(0);
                    float p1 = dot4(S, cv[0]), p2 = dot4(S, cv[1]); const float p3 = dot4(S, cv[2]);
                    p1 += dpp_f(p1, 0); p2 += dpp_f(p2, 0);
                    p1 += dpp_f(p1, 1); p2 += dpp_f(p2, 1);
                    p1 += dpp_f(p1, 2); p2 += dpp_f(p2, 2);
                    p1 += dpp_f(p1, 3); p2 += dpp_f(p2, 3);
                    const float sa1 = fmaf(c0, cs.w, p2);
                    const float y0 = p3 + ((kq == 0) ? c0 * cs.y : 0.f);
                    const f32x4 t0 = S * cv[3] + cv[4] * p1 + cv[5] * c0 + cv[7] * c1;
                    S = t0 + cv[6] * sa1;
                    const float y1 = dot4(S, cv[8]);
                    py[(2 * p) * 128] = y0; py[(2 * p + 1) * 128] = y1;
                    if (p + 1 < SC_C / 2) {
#pragma unroll
                        for (int j = 0; j < 9; ++j) cv[j] = nv[j];
                        cs = ns; c0 = n0; c1 = n1;
                    }
                }
}
__device__ __forceinline__ void scan_phase(Frame& F, int L) {
    const bf16* P1 = (const bf16*)(F.ws + WS_P1); const bf16* P2 = (const bf16*)(F.ws + WS_P2); const bf16* VF = (const bf16*)(F.ws + WS_VF); float* Y = (float*)(F.ws + WS_H2);
    const float* kkw = F.in[21] + L * D; const float* kaw = F.in[22] + L * D;
    const int lane = F.lane;
    int wave;
    { LAS unsigned* tb = (LAS unsigned*)(F.lds + LDS_BYTES - 2048);
      const unsigned simd = ((unsigned)__builtin_amdgcn_s_getreg((1 << 11) | (4 << 6) | 4)) & 3u;
      if (lane == 0) tb[F.wave] = simd;
      __syncthreads();
      unsigned sd[8];
#pragma unroll
      for (int w = 0; w < 8; ++w) sd[w] = tb[w];
      int B = 1;
#pragma unroll
      for (int w = 7; w >= 1; --w) if (sd[w] != sd[0]) B = w;
      int total_non = 0, non_before = 0, share_before = 0; bool my_share = false;
#pragma unroll
      for (int w = 1; w < 8; ++w) { const bool sh = (sd[w] == sd[0]) || (sd[w] == sd[B]); const bool other = (w != B);
          if (other && !sh) { ++total_non; if (w < F.wave) ++non_before; }
          if (other && sh && w < F.wave) ++share_before;
          if (w == F.wave) my_share = sh; }
      int role;
      if (F.wave == 0) role = 0; else if (F.wave == B) role = 1; else role = my_share ? (2 + total_non + share_before) : (2 + non_before);
      wave = __builtin_amdgcn_readfirstlane(role);
      __syncthreads(); }
    for (int item = F.bx; item < 256; item += F.G) {
        const int bh = (item & 7) + 8 * (item >> 6), rg = (item >> 3) & 7, b = bh >> 4, h = bh & 15;
        const size_t m0 = (size_t)b * T;
        const int hidx = (wave - 2) * 64 + lane, hp = (hidx >> 4) & 15, hc4 = hidx & 15;
        const int vtt = lane >> 1, vr4 = (lane & 1) * 4;
        float ckk[4], cka[4];
        v2u lr[2][2], lk[2][2], lw[2][2], la[2][2]; v2u lv[2], lvm[2], lvf[2];
#pragma unroll
        for (int q = 0; q < 2; ++q) { lv[q] = (v2u){0u,0u}; lvm[q] = (v2u){0u,0u}; lvf[q] = (v2u){0u,0u};
#pragma unroll
            for (int u = 0; u < 2; ++u) { lr[q][u] = (v2u){0u,0u}; lk[q][u] = (v2u){0u,0u}; lw[q][u] = (v2u){0u,0u}; la[q][u] = (v2u){0u,0u}; } }
        if (wave >= 2 && wave < 6) {
#pragma unroll
            for (int j = 0; j < 4; ++j) { ckk[j] = kkw[h * 64 + hc4 * 4 + j]; cka[j] = kaw[h * 64 + hc4 * 4 + j]; } }
#define SC_LOAD(c, Q) do { \
        if (wave >= 2 && wave < 6) { _Pragma("unroll") for (int u = 0; u < 2; ++u) { const size_t m = m0 + (size_t)(c) * SC_C + 2 * hp + u; const bf16* p1 = P1 + m * N1 + h * 64 + hc4 * 4; const bf16* p2 = P2 + m * NP2 + h * 64 + hc4 * 4; \
            lr[Q][u] = *(const v2u*)p1; lk[Q][u] = *(const v2u*)(p1 + 1024); lw[Q][u] = *(const v2u*)p2; la[Q][u] = *(const v2u*)(p2 + 1024); } } \
        else if (wave == 6) { const size_t m = m0 + (size_t)(c) * SC_C + vtt; const int cc = h * 64 + rg * 8 + vr4; \
            lv[Q] = *(const v2u*)(P1 + m * N1 + 2048 + cc); if (L == 1) { lvm[Q] = *(const v2u*)(P2 + m * NP2 + 2048 + cc); lvf[Q] = *(const v2u*)(VF + m * D + cc); } } } while (0)
#define SC_PREP(buf, Q) do { LAS unsigned char* B_ = F.lds + (buf) * SC_BUF; \
        if (wave >= 2 && wave < 6) { f32x4 an[2], bb[2], k2[2], ww[2], rr[2]; \
            _Pragma("unroll") for (int u = 0; u < 2; ++u) { \
                const float kr[4] = {bflo(lk[Q][u].x), bfhi(lk[Q][u].x), bflo(lk[Q][u].y), bfhi(lk[Q][u].y)}, av[4] = {bflo(la[Q][u].x), bfhi(la[Q][u].x), bflo(la[Q][u].y), bfhi(la[Q][u].y)}; \
                const float wn[4] = {bflo(lw[Q][u].x), bfhi(lw[Q][u].x), bflo(lw[Q][u].y), bfhi(lw[Q][u].y)}, rv[4] = {bflo(lr[Q][u].x), bfhi(lr[Q][u].x), bflo(lr[Q][u].y), bfhi(lr[Q][u].y)}; \
                float kv_[4], ss = 0.f; \
                _Pragma("unroll") for (int j = 0; j < 4; ++j) { kv_[j] = kr[j] * ckk[j]; ss += kv_[j] * kv_[j]; } \
                ss = sum16(ss); const float inv = 1.0f / fmaxf(sqrtf(ss), 1e-12f); \
                _Pragma("unroll") for (int j = 0; j < 4; ++j) { const float kk = kv_[j] * inv; an[u][j] = -kk; bb[u][j] = kk * av[j]; k2[u][j] = kr[j] * (1.0f + (av[j] - 1.0f) * cka[j]); ww[u][j] = __expf(wn[j]); rr[u][j] = rv[j]; } } \
            LAS f32x4* V_ = (LAS f32x4*)(B_ + SC_VEC) + (hp * 9) * 16 + hc4; \
            float s0 = dot4(bb[0], rr[0]), s1 = dot4(k2[0], rr[0]), s2 = dot4(bb[0], an[1]), s3 = dot4(k2[0], an[1]); \
            s0 = sum16(s0); s1 = sum16(s1); s2 = sum16(s2); s3 = sum16(s3); \
            V_[0 * 16] = an[0]; V_[1 * 16] = ww[0] * an[1] + an[0] * s2; V_[2 * 16] = ww[0] * rr[0] + an[0] * s0; V_[3 * 16] = ww[0] * ww[1]; V_[4 * 16] = bb[0] * ww[1]; V_[5 * 16] = k2[0] * ww[1]; V_[6 * 16] = bb[1]; V_[7 * 16] = k2[1]; V_[8 * 16] = rr[1]; \
            if (hc4 == 0) *(LAS f32x4*)(B_ + SC_SCAL + hp * 16) = (f32x4){s0, s1, s2, s3}; } \
        else if (wave == 6) { float v_[4] = {bflo(lv[Q].x), bfhi(lv[Q].x), bflo(lv[Q].y), bfhi(lv[Q].y)}; \
            if (L == 1) { const float f_[4] = {bflo(lvf[Q].x), bfhi(lvf[Q].x), bflo(lvf[Q].y), bfhi(lvf[Q].y)}, g_[4] = {bflo(lvm[Q].x), bfhi(lvm[Q].x), bflo(lvm[Q].y), bfhi(lvm[Q].y)}; \
                _Pragma("unroll") for (int j = 0; j < 4; ++j) v_[j] = v_[j] + (f_[j] - v_[j]) * g_[j]; } \
            *(LAS f32x4*)(B_ + SC_V + (vtt * 8 + vr4) * 4) = (f32x4){v_[0], v_[1], v_[2], v_[3]}; } } while (0)
#define SC_YRED(bufi) f32x4 yv; do { const LAS f32x4* q_ = (const LAS f32x4*)(F.lds + (bufi) * SC_BUF + SC_Y) + (vtt * 8 + vr4) * 4; \
            _Pragma("unroll") for (int r_ = 0; r_ < 4; ++r_) { const f32x4 t0 = q_[r_ * 4], t1 = q_[r_ * 4 + 1], t2 = q_[r_ * 4 + 2], t3 = q_[r_ * 4 + 3]; const f32x4 t = (t0 + t1) + (t2 + t3); yv[r_] = (t.x + t.y) + (t.z + t.w); } } while (0)
        SC_LOAD(0, 0); SC_PREP(0, 0); SC_LOAD(1, 1);
        __syncthreads();
        f32x4 S = {0.f, 0.f, 0.f, 0.f};
        const int rl = lane >> 4, kq = lane & 15, rowi = (wave & 1) * 4 + rl;
#define SC_ITER(c, QL, QP) do { const int buf = (c) & 1; \
            if (wave < 2) { if (PROBE_SC == 2) { f32x4 S2 = S; scan_chunk(F.lds + buf * SC_BUF, S2, kq, rowi); asm volatile("" :: "v"(S2) : "memory"); } scan_chunk(F.lds + buf * SC_BUF, S, kq, rowi); } \
            else { if ((c) + 2 < SC_NC) SC_LOAD((c) + 2, QL); \
                if ((c) + 1 < SC_NC) SC_PREP(buf ^ 1, QP); \
                if (PROBE_SC == 1 && (c) + 1 < SC_NC) { asm volatile("" ::: "memory"); SC_PREP(buf ^ 1, QP); } \
                if (wave == 7 && (c) > 0) { SC_YRED(buf ^ 1); *(f32x4*)(Y + (m0 + (size_t)((c) - 1) * SC_C + vtt) * D + h * 64 + rg * 8 + vr4) = yv; } } \
            asm volatile("s_waitcnt lgkmcnt(0)\n\ts_barrier" ::: "memory"); } while (0)
        for (int c = 0; c < SC_NC; c += 2) { SC_ITER(c, 0, 1); SC_ITER(c + 1, 1, 0); }
#undef SC_ITER
        if (wave == 7) { SC_YRED((SC_NC - 1) & 1);
            *(f32x4*)(Y + (m0 + (size_t)(SC_NC - 1) * SC_C + vtt) * D + h * 64 + rg * 8 + vr4) = yv; }
        __syncthreads();
#undef SC_LOAD
#undef SC_PREP
#undef SC_YRED
    }
}
__device__ __forceinline__ void post_phase(Frame& F, int L) {
    const bf16* P1 = (const bf16*)(F.ws + WS_P1); const bf16* P2 = (const bf16*)(F.ws + WS_P2); bf16* VF = (bf16*)(F.ws + WS_VF); float* Y = (float*)(F.ws + WS_H2);
    const int gw = F.vcu * NWAVES + F.wave, NGW = F.G * NWAVES, lane = F.lane, c0 = lane * 16;
    const float* kaw = F.in[22] + L * D + c0; const float* rkw = F.in[23] + L * D + c0; const float* lnw = F.in[24] + L * D + c0; const float* lnb = F.in[25] + L * D + c0;
    for (int m = gw; m < M; m += NGW) {
        float y[16], r[16], k[16], v[16], a[16];
        const float* yp = Y + (size_t)m * D + c0;
#pragma unroll
        for (int q = 0; q < 4; ++q) { const f32x4 t = *(const f32x4*)(yp + 4 * q); y[4 * q] = t.x; y[4 * q + 1] = t.y; y[4 * q + 2] = t.z; y[4 * q + 3] = t.w; }
        const bf16* p1 = P1 + (size_t)m * N1 + c0; const bf16* p2 = P2 + (size_t)m * NP2 + c0;
        v4u rv[2], kv[2], vv[2], av[2];
#pragma unroll
        for (int q = 0; q < 2; ++q) { rv[q] = *(const v4u*)(p1 + 8 * q); kv[q] = *(const v4u*)(p1 + 1024 + 8 * q); vv[q] = *(const v4u*)(p1 + 2048 + 8 * q); av[q] = *(const v4u*)(p2 + 1024 + 8 * q); }
#pragma unroll
        for (int q = 0; q < 2; ++q)
#pragma unroll
            for (int j = 0; j < 4; ++j) { r[8 * q + 2 * j] = bflo(rv[q][j]); r[8 * q + 2 * j + 1] = bfhi(rv[q][j]); k[8 * q + 2 * j] = bflo(kv[q][j]); k[8 * q + 2 * j + 1] = bfhi(kv[q][j]);
                v[8 * q + 2 * j] = bflo(vv[q][j]); v[8 * q + 2 * j + 1] = bfhi(vv[q][j]); a[8 * q + 2 * j] = bflo(av[q][j]); a[8 * q + 2 * j + 1] = bfhi(av[q][j]); }
        if (L == 0) { *(v4u*)(VF + (size_t)m * D + c0) = vv[0]; *(v4u*)(VF + (size_t)m * D + c0 + 8) = vv[1]; }
        else { v4u fv[2], gv[2];
#pragma unroll
            for (int q = 0; q < 2; ++q) { fv[q] = *(const v4u*)(VF + (size_t)m * D + c0 + 8 * q); gv[q] = *(const v4u*)(p2 + 2048 + 8 * q); }
#pragma unroll
            for (int q = 0; q < 2; ++q)
#pragma unroll
                for (int j = 0; j < 4; ++j) { const float f0 = bflo(fv[q][j]), f1 = bfhi(fv[q][j]), g0 = bflo(gv[q][j]), g1 = bfhi(gv[q][j]);
                    v[8 * q + 2 * j] += (f0 - v[8 * q + 2 * j]) * g0; v[8 * q + 2 * j + 1] += (f1 - v[8 * q + 2 * j + 1]) * g1; } }
        float s = 0.f, bd = 0.f;
#pragma unroll
        for (int j = 0; j < 16; ++j) { s += y[j]; const float k2 = k[j] * (1.0f + (a[j] - 1.0f) * kaw[j]); bd += r[j] * k2 * rkw[j]; }
        s = sum4(s); bd = sum4(bd);
        const float mean = s * (1.0f / 64.0f); float q2 = 0.f;
#pragma unroll
        for (int j = 0; j < 16; ++j) { const float d = y[j] - mean; q2 += d * d; }
        q2 = sum4(q2);
        const float rstd = 1.0f / sqrtf(q2 * (1.0f / 64.0f) + 64e-5f);
        float o[16];
#pragma unroll
        for (int j = 0; j < 16; ++j) o[j] = (y[j] - mean) * rstd * lnw[j] + lnb[j] + bd * v[j];
        bf16* yn = (bf16*)(Y + (size_t)m * D) + c0;
        v4u w0, w1; w0.x = pkbf(o[0], o[1]); w0.y = pkbf(o[2], o[3]); w0.z = pkbf(o[4], o[5]); w0.w = pkbf(o[6], o[7]); w1.x = pkbf(o[8], o[9]); w1.y = pkbf(o[10], o[11]); w1.z = pkbf(o[12], o[13]); w1.w = pkbf(o[14], o[15]);
        *(v4u*)yn = w0; *(v4u*)(yn + 8) = w1;
    }
}
__device__ __forceinline__ void kvpost_phase(Frame& F) {
    const bf16* KV = (const bf16*)(F.ws + WS_KVRAW); bf16* KS = (bf16*)(F.ws + WS_KS); bf16* VS = (bf16*)(F.ws + WS_VS);
    const int gw = F.vcu * NWAVES + F.wave, NGW = F.G * NWAVES, lane = F.lane, c0 = lane * 16;
    const float* kg = F.in[34] + (c0 & 63);
    for (int m = gw; m < M; m += NGW) {
        const bf16* p = KV + (size_t)m * 2048 + c0; v4u kv[2], vv[2];
#pragma unroll
        for (int q = 0; q < 2; ++q) { kv[q] = *(const v4u*)(p + 8 * q); vv[q] = *(const v4u*)(p + 1024 + 8 * q); }
        float k[16], ss = 0.f;
#pragma unroll
        for (int q = 0; q < 2; ++q)
#pragma unroll
            for (int j = 0; j < 4; ++j) { k[8 * q + 2 * j] = bflo(kv[q][j]); k[8 * q + 2 * j + 1] = bfhi(kv[q][j]); }
#pragma unroll
        for (int j = 0; j < 16; ++j) ss += k[j] * k[j];
        ss = sum4(ss); const float rs = 1.0f / sqrtf(ss * (1.0f / 64.0f) + 1e-6f);
        v4u w0, w1;
        w0.x = pkbf(k[0] * rs * kg[0], k[1] * rs * kg[1]); w0.y = pkbf(k[2] * rs * kg[2], k[3] * rs * kg[3]); w0.z = pkbf(k[4] * rs * kg[4], k[5] * rs * kg[5]); w0.w = pkbf(k[6] * rs * kg[6], k[7] * rs * kg[7]);
        w1.x = pkbf(k[8] * rs * kg[8], k[9] * rs * kg[9]); w1.y = pkbf(k[10] * rs * kg[10], k[11] * rs * kg[11]); w1.z = pkbf(k[12] * rs * kg[12], k[13] * rs * kg[13]); w1.w = pkbf(k[14] * rs * kg[14], k[15] * rs * kg[15]);
        *(v4u*)(KS + (size_t)m * D + c0) = w0; *(v4u*)(KS + (size_t)m * D + c0 + 8) = w1;
        *(v4u*)(VS + (size_t)m * D + c0) = vv[0]; *(v4u*)(VS + (size_t)m * D + c0 + 8) = vv[1];
    }
    if (gw < 32) {
        const int bh = gw, b = bh >> 4, h = bh & 15; const float* FL = (const float*)(F.ws + WS_FL) + ((size_t)b * T + (size_t)lane * 128) * 16 + h; const float fb = F.in[33][h];
        v4u* G3 = (v4u*)(F.ws + WS_G3) + (size_t)bh * T + (size_t)lane * 128;
        float tot = 0.f;
#pragma unroll 8
        for (int i = 0; i < 128; ++i) { const float x = FL[(size_t)i * 16] + fb; tot += -(fmaxf(-x, 0.f) + log1pf(__expf(-fabsf(x)))); }
        float inc = tot;
#pragma unroll
        for (int o = 1; o < 64; o <<= 1) { const float n = __int_as_float(__builtin_amdgcn_ds_bpermute((lane - o) << 2, __float_as_int(inc))); if (lane >= o) inc += n; }
        float run = inc - tot;
#pragma unroll 8
        for (int i = 0; i < 128; ++i) { const float x = FL[(size_t)i * 16] + fb; run += -(fmaxf(-x, 0.f) + log1pf(__expf(-fabsf(x))));
            const float gv = -run * 1.4426950408889634f;
            const unsigned hi = pkbf(gv, 0.f) & 0xffffu; const float r1 = gv - __uint_as_float(hi << 16);
            const unsigned mid = pkbf(r1, 0.f) & 0xffffu; const float r2 = r1 - __uint_as_float(mid << 16);
            const unsigned lo = pkbf(r2, 0.f) & 0xffffu;
            G3[i] = (v4u){hi | (mid << 16), lo, 0u, 0u}; }
    }
}
constexpr size_t WS_BAR = 512 * 1024, BAR_BYTES = 16384; constexpr int MISC_OFF = LDS_BYTES - 1024;
#define RLX_AGENT __ATOMIC_RELAXED, __HIP_MEMORY_SCOPE_AGENT
#define LDS_WAIT() asm volatile("s_waitcnt lgkmcnt(0)" ::: "memory")
#define VM_WAIT() asm volatile("s_waitcnt vmcnt(0)" ::: "memory")
__device__ __forceinline__ unsigned long long rt() { return __builtin_amdgcn_s_memrealtime(); }
__device__ __forceinline__ unsigned f2bf(float f) { unsigned u = __builtin_bit_cast(unsigned, f); return (u + 0x7fffu + ((u >> 16) & 1u)) >> 16; }
__device__ __forceinline__ unsigned pk2(float lo, float hi) { return f2bf(lo) | (f2bf(hi) << 16); }

#define XB_TMO      128
#define XB_XCNT(j)  (256  + 64 * (j))
#define XB_XSUB(j)  (1280 + 64 * (j))
#define XB_XGEN(j)  (2304 + 64 * (j))
#define XB_TOP      3328
#define XB_TOPGEN   3392
#define XCD_BAR_WORDS 3456
#define XB_SPIN_CAP (1u << 18)

__device__ __forceinline__ unsigned xb_ld(unsigned* p)              { return __hip_atomic_load(p, __ATOMIC_RELAXED, __HIP_MEMORY_SCOPE_AGENT); }
__device__ __forceinline__ unsigned xb_add(unsigned* p, unsigned v) { return __hip_atomic_fetch_add(p, v, __ATOMIC_RELAXED, __HIP_MEMORY_SCOPE_AGENT); }
__device__ __forceinline__ unsigned xb_xcc_id() { return (unsigned)__builtin_amdgcn_s_getreg((3 << 11) | 20) & 0xFu; }
#define XB_SPIN(cond, bar) do { unsigned _sp = 0; while (cond) { __builtin_amdgcn_s_sleep(1); \
    if ((++_sp & 255u) == 0u) { if (xb_ld(&(bar)[XB_TMO])) break; if (_sp > XB_SPIN_CAP) { atomicAdd(&(bar)[XB_TMO], 1u); break; } } } } while (0)

struct XcdBarrier {
    unsigned* bar; unsigned x;
    volatile LAS unsigned* st;
};

__device__ __forceinline__ XcdBarrier xcd_barrier_post(unsigned* bar, volatile LAS unsigned* st, const int tid) {
    XcdBarrier b; b.bar = bar; b.x = xb_xcc_id(); b.st = st;
    if (tid == 0) (void)xb_add(&bar[XB_XCNT(b.x)], 1u);
    return b;
}
__device__ __forceinline__ void xcd_barrier_complete(unsigned* bar, unsigned x, unsigned& nloc, unsigned& nx) {
    const unsigned G = gridDim.x * gridDim.y * gridDim.z;
    unsigned sum, cnt, mine, sp = 0u;
    for (;;) {
        sum = 0u; cnt = 0u; mine = 0u;
#pragma unroll
        for (unsigned j = 0; j < 16; ++j) { const unsigned c = xb_ld(&bar[XB_XCNT(j)]); sum += c; cnt += (c > 0u) ? 1u : 0u; mine = (j == x) ? c : mine; }
        if (sum == G) break;
        __builtin_amdgcn_s_sleep(1);
        if ((++sp & 255u) == 0u) { if (xb_ld(&bar[XB_TMO])) break; if (sp > XB_SPIN_CAP) { atomicAdd(&bar[XB_TMO], 1u); break; } }
    }
    nloc = mine > 0u ? mine : 1u; nx = cnt > 0u ? cnt : 1u;
}

__device__ __forceinline__ void xcd_barrier(const XcdBarrier& b, const int tid) {
    asm volatile("s_waitcnt vmcnt(0)" ::: "memory");
    __syncthreads();
    if (tid == 0) {
        unsigned* bar = b.bar;
        __builtin_amdgcn_s_waitcnt(0);
        unsigned nloc = b.st[0], nx = b.st[1];
        if (nloc == 0u) { xcd_barrier_complete(bar, b.x, nloc, nx); b.st[0] = nloc; b.st[1] = nx; }
        const unsigned old = xb_add(&bar[XB_XSUB(b.x)], 1u);
        const unsigned gen = old / nloc;
        if (old + 1u == (gen + 1u) * nloc) {
            __builtin_amdgcn_fence(__ATOMIC_RELEASE, "agent");
            asm volatile("s_waitcnt vmcnt(0)" ::: "memory");
            const unsigned og = xb_add(&bar[XB_TOP], 1u);
            const unsigned tg = og / nx;
            if (og + 1u == (tg + 1u) * nx) xb_add(&bar[XB_TOPGEN], 1u);
            else XB_SPIN(xb_ld(&bar[XB_TOPGEN]) == tg, bar);
            __builtin_amdgcn_fence(__ATOMIC_ACQUIRE, "agent");
            xb_add(&bar[XB_XGEN(b.x)], 1u);
            asm volatile("s_waitcnt vmcnt(0)" ::: "memory");
        } else {
            XB_SPIN(xb_ld(&bar[XB_XGEN(b.x)]) == gen, bar);
            __builtin_amdgcn_fence(__ATOMIC_ACQUIRE, "agent");
            asm volatile("s_waitcnt vmcnt(0)" ::: "memory");
        }
    }
    __syncthreads();
}
#define GEMM_CALL(FN, Aptr, Bptr, Nn, Kk, LDA, LDB, ...) GEMM_CALL_G(FN, Aptr, Bptr, Nn, Kk, LDA, LDB, 0, 0, __VA_ARGS__)
#define GEMM_CALL_G(FN, Aptr, Bptr, Nn, Kk, LDA, LDB, AGRP, ASTEP, ...) GEMM_CALL_S(StaticOrder, FN, Aptr, Bptr, Nn, Kk, LDA, LDB, AGRP, ASTEP, __VA_ARGS__)
#define GEMM_CALL_S(ORD, FN, Aptr, Bptr, Nn, Kk, LDA, LDB, AGRP, ASTEP, ...) do { pg8::Gemm g_{(const pg8::bf16_t*)(Aptr), (const pg8::bf16_t*)(Bptr), M, (Nn), (Kk), (LDA), (LDB), (AGRP), (size_t)(ASTEP)}; pg8::ORD S_; S_.init(M, (Nn), F.G, F.bx); \
    pg8::Epi8<pg8::FN> E_{{__VA_ARGS__}}; pg8::gemm_phase<pg8::Epi8<pg8::FN>, pg8::ORD, true, true>(F.lds, g_, S_, E_, F.tid); } while (0)
constexpr int N_PHASES = 42;
__global__ void __launch_bounds__(NWAVES * 64, 2) yoco_fwd(Args args) {
    extern __shared__ __attribute__((aligned(16))) unsigned char lds[];
    cg::grid_group grid = cg::this_grid();
    Frame F;
    const int wave_s = __builtin_amdgcn_readfirstlane((int)threadIdx.x >> 6);
    F.lds = (LAS unsigned char*)lds; F.tid = threadIdx.x; F.lane = F.tid & 63; F.wave = wave_s;
    F.G = gridDim.x; F.bx = blockIdx.x; F.vcu = F.bx;
    F.ws = args.ws; F.out = args.out; F.in = args.in;
    unsigned char* ws = args.ws;
    const int lo = args.ph_lo, hi = args.ph_hi; const bool one = (hi - lo) > 1;
#define LAUNDER() do { int t_ = wave_s * 64 + (int)__builtin_amdgcn_mbcnt_hi(~0u, __builtin_amdgcn_mbcnt_lo(~0u, 0u)); asm volatile("" : "+v"(t_)); F.tid = t_; F.lane = t_ & 63; F.wave = __builtin_amdgcn_readfirstlane(t_ >> 6); \
        int z_ = 0; asm volatile("" : "+v"(z_)); z_ = __builtin_amdgcn_readfirstlane(z_); ws = args.ws + z_; F.ws = ws; F.in = args.in + z_; F.out = args.out + z_; F.bx = (int)blockIdx.x + z_; F.G = (int)gridDim.x + z_; F.vcu = (F.G % 8 == 0) ? (F.bx % 8) * (F.G / 8) + F.bx / 8 : F.bx; } while (0)
#define IN(k) (lo <= (k) && (k) < hi)
#ifndef PROBE_BAR
#define PROBE_BAR 0
#endif
#ifndef PROBE_PH
#define PROBE_PH (-1)
#endif
#define PHASE(k) if (IN(k)) for (int rep_ = 0; rep_ < (((k) == PROBE_PH) ? 2 : 1); ++rep_)
#define SEAM() do { if (one) { unsigned zz_ = 0u; asm volatile("" : "+v"(zz_)); const int st_ = wave_s * 64 + (int)__builtin_amdgcn_mbcnt_hi(~0u, __builtin_amdgcn_mbcnt_lo(~0u, zz_)); xcd_barrier(xbar, st_); if (PROBE_BAR) xcd_barrier(xbar, st_); } } while (0)
#define MOD_ ((float*)(ws + WS_MOD))
#define MODKV_ (MOD_ + 4 * 2 * 6144)
#define H2_ ((bf16*)(ws + WS_H2))
#define XN_ ((bf16*)(ws + WS_H2))
#define XNKV_ ((bf16*)(ws + WS_H2 + 32 * MiB))
#define P1_ ((bf16*)(ws + WS_P1))
#define P2_ ((bf16*)(ws + WS_P2))
#define HB_ ((bf16*)(ws + WS_HB))
#define QB_ ((bf16*)(ws + WS_QB))
#define GT_ ((bf16*)(ws + WS_GT))
#define XIN1_ ((L == 0) ? F.in[0] : (const float*)F.out)
#define MODL_ (MOD_ + L * 2 * 6144)

    volatile LAS unsigned* MISC = (volatile LAS unsigned*)(F.lds + MISC_OFF);
    if (F.tid < 32) MISC[F.tid] = 0u;
    __syncthreads();
    XcdBarrier xbar; xbar.bar = (unsigned*)(args.ws + WS_BAR); xbar.x = 0; xbar.st = MISC + 8;
    if (one) xbar = xcd_barrier_post((unsigned*)(args.ws + WS_BAR), MISC + 8, F.tid);
    PHASE(0) { LAUNDER(); p0_mod(F); p0_weights(F); if (one) grid.sync(); }
    { constexpr int L = 0;
        const int pb = 1 + L * 10;
        if (L < 2) {
            PHASE(pb + 0) { LAUNDER(); norm_mix_phase(F, XIN1_, F.in[4] + L * D, MODL_, MODL_ + 1024, F.in[8] + L * 6 * 1024, H2_, P2_); SEAM(); }
            PHASE(pb + 1) { LAUNDER(); GEMM_CALL(FnP1, H2_, ws + WS_W1 + (size_t)L * N1 * K1 * 2 + (size_t)3072 * 1024 * 2, 512, K1, K1, K1, P1_, 3072);
                LAUNDER();
                if (F.G == 256) GEMM_CALL_S(SplitOrder, FnP1, P2_, ws + WS_W1 + (size_t)L * N1 * K1 * 2, 3072, D, D, D, 4, (size_t)M * D * 2, P1_, 0);
                else GEMM_CALL_G(FnP1, P2_, ws + WS_W1 + (size_t)L * N1 * K1 * 2, 3072, D, D, D, 4, (size_t)M * D * 2, P1_, 0);
                SEAM(); }
            PHASE(pb + 2) { LAUNDER(); GEMM_CALL(FnP2, P1_ + 3072, ws + WS_W2A + (size_t)L * 3072 * 256 * 2, (L == 0 ? 2048 : NP2), 256, N1, 256, P2_, MOD_ + 53248 + L * 3072); SEAM(); }
            PHASE(pb + 3) { LAUNDER(); scan_phase(F, L); SEAM(); }
            PHASE(pb + 4) { LAUNDER(); post_phase(F, L); SEAM(); }
            PHASE(pb + 5) { LAUNDER(); GEMM_CALL(FnGate, P1_ + 3232, ws + WS_W2G + (size_t)L * 1024 * 256 * 2, D, 256, N1, 256, H2_, 2048); SEAM(); }
            PHASE(pb + 6) { LAUNDER(); GEMM_CALL(FnRes, H2_, ws + WS_WO + (size_t)L * D * D * 2, D, D, 2048, D, XIN1_, F.out, MODL_ + 2 * 1024); SEAM(); }
        } else {
            const int j = L - 2;
            PHASE(pb + 0) { LAUNDER(); norm_phase(F, F.out, F.in[4] + L * D, MODL_, MODL_ + 1024, 6144, 1, XN_);
                if (L == 2) norm_phase(F, F.out, F.in[29], MODKV_, MODKV_ + 1024, 2048, 1, XNKV_);
                SEAM(); }
            PHASE(pb + 1) { LAUNDER();
                if (L == 2) GEMM_CALL(FnKv, XNKV_, ws + WS_WKV, 2304, D, D, D, (bf16*)(ws + WS_KVRAW), (float*)(ws + WS_FL));
                LAUNDER();
                GEMM_CALL(FnQg, XN_, ws + WS_WQG + (size_t)j * 2048 * D * 2, 2048, D, D, D, QB_, GT_); SEAM(); }
            if (L == 2) PHASE(pb + 2) { LAUNDER(); kvpost_phase(F); SEAM(); }
            PHASE(pb + 3) { LAUNDER();
                float kb_; { float g_ = fabsf(F.in[34][F.lane]); g_ = fmaxf(g_, dpp_f(g_, 0)); g_ = fmaxf(g_, dpp_f(g_, 1)); g_ = fmaxf(g_, dpp_f(g_, 2)); g_ = fmaxf(g_, dpp_f(g_, 3));
                  { auto rr = __builtin_amdgcn_permlane16_swap(__float_as_uint(g_), __float_as_uint(g_), false, false); g_ = fmaxf(__uint_as_float(rr[0]), __uint_as_float(rr[1])); }
                  { auto rr = __builtin_amdgcn_permlane32_swap(__float_as_uint(g_), __float_as_uint(g_), false, false); g_ = fmaxf(__uint_as_float(rr[0]), __uint_as_float(rr[1])); }
                  kb_ = 8.0f * 1.02f * g_; }
                const attn_body::AttnTensors AT{(const attn_body::bf16*)QB_, (const attn_body::bf16*)(ws + WS_KS), (const attn_body::bf16*)(ws + WS_VS), (attn_body::bf16*)((PROBE_PH == pb + 3 && rep_ == 0) ? (bf16*)(ws + WS_KVRAW) : QB_), (const attn_body::bf16*)GT_, (const unsigned char*)(ws + WS_G3), F.in[36] + j * 64, kb_};
                float thr2_; { float g_ = fabsf(F.in[36][j * 64 + F.lane]); g_ = fmaxf(g_, dpp_f(g_, 0)); g_ = fmaxf(g_, dpp_f(g_, 1)); g_ = fmaxf(g_, dpp_f(g_, 2)); g_ = fmaxf(g_, dpp_f(g_, 3));
                  { auto rr = __builtin_amdgcn_permlane16_swap(__float_as_uint(g_), __float_as_uint(g_), false, false); g_ = fmaxf(__uint_as_float(rr[0]), __uint_as_float(rr[1])); }
                  { auto rr = __builtin_amdgcn_permlane32_swap(__float_as_uint(g_), __float_as_uint(g_), false, false); g_ = fmaxf(__uint_as_float(rr[0]), __uint_as_float(rr[1])); }
                  thr2_ = 64.0f + 2.0f * kb_ * attn_body::C2 * 8.16f * g_; }
                attn_body::attn_phase_dyn<8>((char*)lds, AT, (unsigned*)(ws + WS_BAR) + 3600 + j * 64, thr2_, F.tid);
                SEAM(); }
            PHASE(pb + 6) { LAUNDER(); GEMM_CALL(FnRes, QB_, ws + WS_WO2 + (size_t)j * D * D * 2, D, D, D, D, (const float*)F.out, F.out, MODL_ + 2 * 1024); SEAM(); }
        }
        PHASE(pb + 7) { LAUNDER(); mlp_weights(F, L); norm_phase(F, F.out, F.in[5] + L * D, MODL_ + 3 * 1024, MODL_ + 4 * 1024, 6144, 1, XN_); SEAM(); }
        PHASE(pb + 8) { LAUNDER(); GEMM_CALL(FnUp, XN_, ws + WS_WUP, FF, D, D, D, HB_); SEAM(); }
        PHASE(pb + 9) { LAUNDER(); GEMM_CALL(FnRes, HB_, ws + WS_WDN, D, FF, FF, FF, (const float*)F.out, F.out, MODL_ + 5 * 1024); SEAM(); }
        }
    { constexpr int L = 1;
        const int pb = 1 + L * 10;
        if (L < 2) {
            PHASE(pb + 0) { LAUNDER(); norm_mix_phase(F, XIN1_, F.in[4] + L * D, MODL_, MODL_ + 1024, F.in[8] + L * 6 * 1024, H2_, P2_); SEAM(); }
            PHASE(pb + 1) { LAUNDER(); GEMM_CALL(FnP1, H2_, ws + WS_W1 + (size_t)L * N1 * K1 * 2 + (size_t)3072 * 1024 * 2, 512, K1, K1, K1, P1_, 3072);
                LAUNDER();
                if (F.G == 256) GEMM_CALL_S(SplitOrder, FnP1, P2_, ws + WS_W1 + (size_t)L * N1 * K1 * 2, 3072, D, D, D, 4, (size_t)M * D * 2, P1_, 0);
                else GEMM_CALL_G(FnP1, P2_, ws + WS_W1 + (size_t)L * N1 * K1 * 2, 3072, D, D, D, 4, (size_t)M * D * 2, P1_, 0);
                SEAM(); }
            PHASE(pb + 2) { LAUNDER(); GEMM_CALL(FnP2, P1_ + 3072, ws + WS_W2A + (size_t)L * 3072 * 256 * 2, (L == 0 ? 2048 : NP2), 256, N1, 256, P2_, MOD_ + 53248 + L * 3072); SEAM(); }
            PHASE(pb + 3) { LAUNDER(); scan_phase(F, L); SEAM(); }
            PHASE(pb + 4) { LAUNDER(); post_phase(F, L); SEAM(); }
            PHASE(pb + 5) { LAUNDER(); GEMM_CALL(FnGate, P1_ + 3232, ws + WS_W2G + (size_t)L * 1024 * 256 * 2, D, 256, N1, 256, H2_, 2048); SEAM(); }
            PHASE(pb + 6) { LAUNDER(); GEMM_CALL(FnRes, H2_, ws + WS_WO + (size_t)L * D * D * 2, D, D, 2048, D, XIN1_, F.out, MODL_ + 2 * 1024); SEAM(); }
        } else {
            const int j = L - 2;
            PHASE(pb + 0) { LAUNDER(); norm_phase(F, F.out, F.in[4] + L * D, MODL_, MODL_ + 1024, 6144, 1, XN_);
                if (L == 2) norm_phase(F, F.out, F.in[29], MODKV_, MODKV_ + 1024, 2048, 1, XNKV_);
                SEAM(); }
            PHASE(pb + 1) { LAUNDER();
                if (L == 2) GEMM_CALL(FnKv, XNKV_, ws + WS_WKV, 2304, D, D, D, (bf16*)(ws + WS_KVRAW), (float*)(ws + WS_FL));
                LAUNDER();
                GEMM_CALL(FnQg, XN_, ws + WS_WQG + (size_t)j * 2048 * D * 2, 2048, D, D, D, QB_, GT_); SEAM(); }
            if (L == 2) PHASE(pb + 2) { LAUNDER(); kvpost_phase(F); SEAM(); }
            PHASE(pb + 3) { LAUNDER();
                float kb_; { float g_ = fabsf(F.in[34][F.lane]); g_ = fmaxf(g_, dpp_f(g_, 0)); g_ = fmaxf(g_, dpp_f(g_, 1)); g_ = fmaxf(g_, dpp_f(g_, 2)); g_ = fmaxf(g_, dpp_f(g_, 3));
                  { auto rr = __builtin_amdgcn_permlane16_swap(__float_as_uint(g_), __float_as_uint(g_), false, false); g_ = fmaxf(__uint_as_float(rr[0]), __uint_as_float(rr[1])); }
                  { auto rr = __builtin_amdgcn_permlane32_swap(__float_as_uint(g_), __float_as_uint(g_), false, false); g_ = fmaxf(__uint_as_float(rr[0]), __uint_as_float(rr[1])); }
                  kb_ = 8.0f * 1.02f * g_; }
                const attn_body::AttnTensors AT{(const attn_body::bf16*)QB_, (const attn_body::bf16*)(ws + WS_KS), (const attn_body::bf16*)(ws + WS_VS), (attn_body::bf16*)((PROBE_PH == pb + 3 && rep_ == 0) ? (bf16*)(ws + WS_KVRAW) : QB_), (const attn_body::bf16*)GT_, (const unsigned char*)(ws + WS_G3), F.in[36] + j * 64, kb_};
                float thr2_; { float g_ = fabsf(F.in[36][j * 64 + F.lane]); g_ = fmaxf(g_, dpp_f(g_, 0)); g_ = fmaxf(g_, dpp_f(g_, 1)); g_ = fmaxf(g_, dpp_f(g_, 2)); g_ = fmaxf(g_, dpp_f(g_, 3));
                  { auto rr = __builtin_amdgcn_permlane16_swap(__float_as_uint(g_), __float_as_uint(g_), false, false); g_ = fmaxf(__uint_as_float(rr[0]), __uint_as_float(rr[1])); }
                  { auto rr = __builtin_amdgcn_permlane32_swap(__float_as_uint(g_), __float_as_uint(g_), false, false); g_ = fmaxf(__uint_as_float(rr[0]), __uint_as_float(rr[1])); }
                  thr2_ = 64.0f + 2.0f * kb_ * attn_body::C2 * 8.16f * g_; }
                attn_body::attn_phase_dyn<8>((char*)lds, AT, (unsigned*)(ws + WS_BAR) + 3600 + j * 64, thr2_, F.tid);
                SEAM(); }
            PHASE(pb + 6) { LAUNDER(); GEMM_CALL(FnRes, QB_, ws + WS_WO2 + (size_t)j * D * D * 2, D, D, D, D, (const float*)F.out, F.out, MODL_ + 2 * 1024); SEAM(); }
        }
        PHASE(pb + 7) { LAUNDER(); mlp_weights(F, L); norm_phase(F, F.out, F.in[5] + L * D, MODL_ + 3 * 1024, MODL_ + 4 * 1024, 6144, 1, XN_); SEAM(); }
        PHASE(pb + 8) { LAUNDER(); GEMM_CALL(FnUp, XN_, ws + WS_WUP, FF, D, D, D, HB_); SEAM(); }
        PHASE(pb + 9) { LAUNDER(); GEMM_CALL(FnRes, HB_, ws + WS_WDN, D, FF, FF, FF, (const float*)F.out, F.out, MODL_ + 5 * 1024); SEAM(); }
        }
    { constexpr int L = 2;
        const int pb = 1 + L * 10;
        if (L < 2) {
            PHASE(pb + 0) { LAUNDER(); norm_mix_phase(F, XIN1_, F.in[4] + L * D, MODL_, MODL_ + 1024, F.in[8] + L * 6 * 1024, H2_, P2_); SEAM(); }
            PHASE(pb + 1) { LAUNDER(); GEMM_CALL(FnP1, H2_, ws + WS_W1 + (size_t)L * N1 * K1 * 2 + (size_t)3072 * 1024 * 2, 512, K1, K1, K1, P1_, 3072);
                LAUNDER();
                if (F.G == 256) GEMM_CALL_S(SplitOrder, FnP1, P2_, ws + WS_W1 + (size_t)L * N1 * K1 * 2, 3072, D, D, D, 4, (size_t)M * D * 2, P1_, 0);
                else GEMM_CALL_G(FnP1, P2_, ws + WS_W1 + (size_t)L * N1 * K1 * 2, 3072, D, D, D, 4, (size_t)M * D * 2, P1_, 0);
                SEAM(); }
            PHASE(pb + 2) { LAUNDER(); GEMM_CALL(FnP2, P1_ + 3072, ws + WS_W2A + (size_t)L * 3072 * 256 * 2, (L == 0 ? 2048 : NP2), 256, N1, 256, P2_, MOD_ + 53248 + L * 3072); SEAM(); }
            PHASE(pb + 3) { LAUNDER(); scan_phase(F, L); SEAM(); }
            PHASE(pb + 4) { LAUNDER(); post_phase(F, L); SEAM(); }
            PHASE(pb + 5) { LAUNDER(); GEMM_CALL(FnGate, P1_ + 3232, ws + WS_W2G + (size_t)L * 1024 * 256 * 2, D, 256, N1, 256, H2_, 2048); SEAM(); }
            PHASE(pb + 6) { LAUNDER(); GEMM_CALL(FnRes, H2_, ws + WS_WO + (size_t)L * D * D * 2, D, D, 2048, D, XIN1_, F.out, MODL_ + 2 * 1024); SEAM(); }
        } else {
            const int j = L - 2;
            PHASE(pb + 0) { LAUNDER(); norm_phase(F, F.out, F.in[4] + L * D, MODL_, MODL_ + 1024, 6144, 1, XN_);
                if (L == 2) norm_phase(F, F.out, F.in[29], MODKV_, MODKV_ + 1024, 2048, 1, XNKV_);
                SEAM(); }
            PHASE(pb + 1) { LAUNDER();
                if (L == 2) GEMM_CALL(FnKv, XNKV_, ws + WS_WKV, 2304, D, D, D, (bf16*)(ws + WS_KVRAW), (float*)(ws + WS_FL));
                LAUNDER();
                GEMM_CALL(FnQg, XN_, ws + WS_WQG + (size_t)j * 2048 * D * 2, 2048, D, D, D, QB_, GT_); SEAM(); }
            if (L == 2) PHASE(pb + 2) { LAUNDER(); kvpost_phase(F); SEAM(); }
            PHASE(pb + 3) { LAUNDER();
                float kb_; { float g_ = fabsf(F.in[34][F.lane]); g_ = fmaxf(g_, dpp_f(g_, 0)); g_ = fmaxf(g_, dpp_f(g_, 1)); g_ = fmaxf(g_, dpp_f(g_, 2)); g_ = fmaxf(g_, dpp_f(g_, 3));
                  { auto rr = __builtin_amdgcn_permlane16_swap(__float_as_uint(g_), __float_as_uint(g_), false, false); g_ = fmaxf(__uint_as_float(rr[0]), __uint_as_float(rr[1])); }
                  { auto rr = __builtin_amdgcn_permlane32_swap(__float_as_uint(g_), __float_as_uint(g_), false, false); g_ = fmaxf(__uint_as_float(rr[0]), __uint_as_float(rr[1])); }
                  kb_ = 8.0f * 1.02f * g_; }
                const attn_body::AttnTensors AT{(const attn_body::bf16*)QB_, (const attn_body::bf16*)(ws + WS_KS), (const attn_body::bf16*)(ws + WS_VS), (attn_body::bf16*)((PROBE_PH == pb + 3 && rep_ == 0) ? (bf16*)(ws + WS_KVRAW) : QB_), (const attn_body::bf16*)GT_, (const unsigned char*)(ws + WS_G3), F.in[36] + j * 64, kb_};
                float thr2_; { float g_ = fabsf(F.in[36][j * 64 + F.lane]); g_ = fmaxf(g_, dpp_f(g_, 0)); g_ = fmaxf(g_, dpp_f(g_, 1)); g_ = fmaxf(g_, dpp_f(g_, 2)); g_ = fmaxf(g_, dpp_f(g_, 3));
                  { auto rr = __builtin_amdgcn_permlane16_swap(__float_as_uint(g_), __float_as_uint(g_), false, false); g_ = fmaxf(__uint_as_float(rr[0]), __uint_as_float(rr[1])); }
                  { auto rr = __builtin_amdgcn_permlane32_swap(__float_as_uint(g_), __float_as_uint(g_), false, false); g_ = fmaxf(__uint_as_float(rr[0]), __uint_as_float(rr[1])); }
                  thr2_ = 64.0f + 2.0f * kb_ * attn_body::C2 * 8.16f * g_; }
                attn_body::attn_phase_dyn<8>((char*)lds, AT, (unsigned*)(ws + WS_BAR) + 3600 + j * 64, thr2_, F.tid);
                SEAM(); }
            PHASE(pb + 6) { LAUNDER(); GEMM_CALL(FnRes, QB_, ws + WS_WO2 + (size_t)j * D * D * 2, D, D, D, D, (const float*)F.out, F.out, MODL_ + 2 * 1024); SEAM(); }
        }
        PHASE(pb + 7) { LAUNDER(); mlp_weights(F, L); norm_phase(F, F.out, F.in[5] + L * D, MODL_ + 3 * 1024, MODL_ + 4 * 1024, 6144, 1, XN_); SEAM(); }
        PHASE(pb + 8) { LAUNDER(); GEMM_CALL(FnUp, XN_, ws + WS_WUP, FF, D, D, D, HB_); SEAM(); }
        PHASE(pb + 9) { LAUNDER(); GEMM_CALL(FnRes, HB_, ws + WS_WDN, D, FF, FF, FF, (const float*)F.out, F.out, MODL_ + 5 * 1024); SEAM(); }
        }
    { constexpr int L = 3;
        const int pb = 1 + L * 10;
        if (L < 2) {
            PHASE(pb + 0) { LAUNDER(); norm_mix_phase(F, XIN1_, F.in[4] + L * D, MODL_, MODL_ + 1024, F.in[8] + L * 6 * 1024, H2_, P2_); SEAM(); }
            PHASE(pb + 1) { LAUNDER(); GEMM_CALL(FnP1, H2_, ws + WS_W1 + (size_t)L * N1 * K1 * 2 + (size_t)3072 * 1024 * 2, 512, K1, K1, K1, P1_, 3072);
                LAUNDER();
                if (F.G == 256) GEMM_CALL_S(SplitOrder, FnP1, P2_, ws + WS_W1 + (size_t)L * N1 * K1 * 2, 3072, D, D, D, 4, (size_t)M * D * 2, P1_, 0);
                else GEMM_CALL_G(FnP1, P2_, ws + WS_W1 + (size_t)L * N1 * K1 * 2, 3072, D, D, D, 4, (size_t)M * D * 2, P1_, 0);
                SEAM(); }
            PHASE(pb + 2) { LAUNDER(); GEMM_CALL(FnP2, P1_ + 3072, ws + WS_W2A + (size_t)L * 3072 * 256 * 2, (L == 0 ? 2048 : NP2), 256, N1, 256, P2_, MOD_ + 53248 + L * 3072); SEAM(); }
            PHASE(pb + 3) { LAUNDER(); scan_phase(F, L); SEAM(); }
            PHASE(pb + 4) { LAUNDER(); post_phase(F, L); SEAM(); }
            PHASE(pb + 5) { LAUNDER(); GEMM_CALL(FnGate, P1_ + 3232, ws + WS_W2G + (size_t)L * 1024 * 256 * 2, D, 256, N1, 256, H2_, 2048); SEAM(); }
            PHASE(pb + 6) { LAUNDER(); GEMM_CALL(FnRes, H2_, ws + WS_WO + (size_t)L * D * D * 2, D, D, 2048, D, XIN1_, F.out, MODL_ + 2 * 1024); SEAM(); }
        } else {
            const int j = L - 2;
            PHASE(pb + 0) { LAUNDER(); norm_phase(F, F.out, F.in[4] + L * D, MODL_, MODL_ + 1024, 6144, 1, XN_);
                if (L == 2) norm_phase(F, F.out, F.in[29], MODKV_, MODKV_ + 1024, 2048, 1, XNKV_);
                SEAM(); }
            PHASE(pb + 1) { LAUNDER();
                if (L == 2) GEMM_CALL(FnKv, XNKV_, ws + WS_WKV, 2304, D, D, D, (bf16*)(ws + WS_KVRAW), (float*)(ws + WS_FL));
                LAUNDER();
                GEMM_CALL(FnQg, XN_, ws + WS_WQG + (size_t)j * 2048 * D * 2, 2048, D, D, D, QB_, GT_); SEAM(); }
            if (L == 2) PHASE(pb + 2) { LAUNDER(); kvpost_phase(F); SEAM(); }
            PHASE(pb + 3) { LAUNDER();
                float kb_; { float g_ = fabsf(F.in[34][F.lane]); g_ = fmaxf(g_, dpp_f(g_, 0)); g_ = fmaxf(g_, dpp_f(g_, 1)); g_ = fmaxf(g_, dpp_f(g_, 2)); g_ = fmaxf(g_, dpp_f(g_, 3));
                  { auto rr = __builtin_amdgcn_permlane16_swap(__float_as_uint(g_), __float_as_uint(g_), false, false); g_ = fmaxf(__uint_as_float(rr[0]), __uint_as_float(rr[1])); }
                  { auto rr = __builtin_amdgcn_permlane32_swap(__float_as_uint(g_), __float_as_uint(g_), false, false); g_ = fmaxf(__uint_as_float(rr[0]), __uint_as_float(rr[1])); }
                  kb_ = 8.0f * 1.02f * g_; }
                const attn_body::AttnTensors AT{(const attn_body::bf16*)QB_, (const attn_body::bf16*)(ws + WS_KS), (const attn_body::bf16*)(ws + WS_VS), (attn_body::bf16*)((PROBE_PH == pb + 3 && rep_ == 0) ? (bf16*)(ws + WS_KVRAW) : QB_), (const attn_body::bf16*)GT_, (const unsigned char*)(ws + WS_G3), F.in[36] + j * 64, kb_};
                float thr2_; { float g_ = fabsf(F.in[36][j * 64 + F.lane]); g_ = fmaxf(g_, dpp_f(g_, 0)); g_ = fmaxf(g_, dpp_f(g_, 1)); g_ = fmaxf(g_, dpp_f(g_, 2)); g_ = fmaxf(g_, dpp_f(g_, 3));
                  { auto rr = __builtin_amdgcn_permlane16_swap(__float_as_uint(g_), __float_as_uint(g_), false, false); g_ = fmaxf(__uint_as_float(rr[0]), __uint_as_float(rr[1])); }
                  { auto rr = __builtin_amdgcn_permlane32_swap(__float_as_uint(g_), __float_as_uint(g_), false, false); g_ = fmaxf(__uint_as_float(rr[0]), __uint_as_float(rr[1])); }
                  thr2_ = 64.0f + 2.0f * kb_ * attn_body::C2 * 8.16f * g_; }
                attn_body::attn_phase_dyn<8>((char*)lds, AT, (unsigned*)(ws + WS_BAR) + 3600 + j * 64, thr2_, F.tid);
                SEAM(); }
            PHASE(pb + 6) { LAUNDER(); GEMM_CALL(FnRes, QB_, ws + WS_WO2 + (size_t)j * D * D * 2, D, D, D, D, (const float*)F.out, F.out, MODL_ + 2 * 1024); SEAM(); }
        }
        PHASE(pb + 7) { LAUNDER(); mlp_weights(F, L); norm_phase(F, F.out, F.in[5] + L * D, MODL_ + 3 * 1024, MODL_ + 4 * 1024, 6144, 1, XN_); SEAM(); }
        PHASE(pb + 8) { LAUNDER(); GEMM_CALL(FnUp, XN_, ws + WS_WUP, FF, D, D, D, HB_); SEAM(); }
        PHASE(pb + 9) { LAUNDER(); GEMM_CALL(FnRes, HB_, ws + WS_WDN, D, FF, FF, FF, (const float*)F.out, F.out, MODL_ + 5 * 1024); SEAM(); }
        }
    PHASE(41) { LAUNDER(); final_norm_phase(F); }
#undef IN
#undef SEAM
}
static bool phase_exists(int ph) {
    if (ph == 0 || ph == 41) return true;
    const int L = (ph - 1) / 10, s = (ph - 1) % 10;
    if (L < 2) return true;
    if (s == 4 || s == 5) return false;
    if (s == 2) return L == 2;
    return true;
}
extern "C" void kernel_launch(void* const* d_in, const int* in_sizes, int n_in, void* d_out, int out_size, void* d_ws, size_t ws_size, hipStream_t stream) {
    static int grid = 0;
    if (grid == 0) {
        if (n_in != 39 || in_sizes[0] != M * D || out_size != M * D || ws_size < WS_END) { fprintf(stderr, "kernel_launch: shape/workspace mismatch: n_in %d in0 %d out %d ws %zu (need %zu)\n", n_in, n_in > 0 ? in_sizes[0] : -1, out_size, ws_size, (size_t)WS_END); grid = -1; return; }
        int dev = 0, cus = 0, per_cu = 0;
        if (hipGetDevice(&dev) != hipSuccess || hipDeviceGetAttribute(&cus, hipDeviceAttributeMultiprocessorCount, dev) != hipSuccess) { fprintf(stderr, "kernel_launch: device query failed\n"); grid = -1; return; }
        if (hipFuncSetAttribute((const void*)yoco_fwd, hipFuncAttributeMaxDynamicSharedMemorySize, LDS_BYTES) != hipSuccess) { fprintf(stderr, "kernel_launch: hipFuncSetAttribute failed\n"); grid = -1; return; }
        if (hipOccupancyMaxActiveBlocksPerMultiprocessor(&per_cu, (const void*)yoco_fwd, NWAVES * 64, LDS_BYTES) != hipSuccess || per_cu < 1) { fprintf(stderr, "kernel_launch: occupancy query says %d blocks/CU\n", per_cu); per_cu = 1; }
        (void)hipGetLastError();
        grid = cus * per_cu;
        if (grid != 256) { fprintf(stderr, "kernel_launch: resident capacity %d workgroups; this kernel's static schedules want 256 (using 256)\n", grid); if (grid > 256) grid = 256; }
    }
    if (grid < 0) return;
    if (hipMemsetAsync((char*)d_ws + WS_BAR, 0, BAR_BYTES, stream) != hipSuccess) { fprintf(stderr, "kernel_launch: memset of barrier words failed\n"); return; }
    Args a{};
    for (int i = 0; i < 39; ++i) a.in[i] = (const float*)d_in[i];
    a.out = (float*)d_out; a.ws = (unsigned char*)d_ws;
#if MK_ONE_LAUNCH
    a.ph_lo = 0; a.ph_hi = N_PHASES;
    void* params[] = {&a};
    const hipError_t le = hipLaunchCooperativeKernel((const void*)yoco_fwd, dim3(grid), dim3(NWAVES * 64), params, LDS_BYTES, stream);
    if (le != hipSuccess) fprintf(stderr, "kernel_launch: cooperative launch failed: %s (grid %d)\n", hipGetErrorName(le), grid);
#else
    for (int ph = 0; ph < N_PHASES; ++ph) { if (!phase_exists(ph)) continue; a.ph_lo = ph; a.ph_hi = ph + 1;
        hipLaunchKernelGGL(yoco_fwd, dim3(grid), dim3(NWAVES * 64), LDS_BYTES, stream, a);
        const hipError_t le = hipPeekAtLastError(); if (le != hipSuccess) { fprintf(stderr, "kernel_launch: launch of phase %d failed: %s\n", ph, hipGetErrorName(le)); break; } }
#endif
}
```

```cpp
#include <hip/hip_runtime.h>
#include <hip/hip_cooperative_groups.h>
#include <hip/hip_bf16.h>
#include <cstdio>
#include <cstdint>
#include <cmath>
namespace cg = cooperative_groups;
#ifndef MK_ONE_LAUNCH
#define MK_ONE_LAUNCH 1
#endif
namespace pg8 {
#define PG8_LAS __attribute__((address_space(3)))
typedef unsigned short bf16_t;
typedef short bf16x8 __attribute__((ext_vector_type(8)));
typedef float f32x4 __attribute__((ext_vector_type(4)));
typedef unsigned u32x4 __attribute__((ext_vector_type(4)));
constexpr int BM = 256, BK = 64, HALF = 128, HTB = HALF * BK * 2  , STAGE_BYTES = 8 * HTB, NXCD = 8, WGM = 8;

__host__ __device__ __forceinline__ int lds_byte(int r, int c) { const int st = (r >> 4) * 2 + (c >> 5), rr = r & 15, cc = c & 31, ob = rr * 64 + cc * 2; return st * 1024 + (ob ^ (((ob >> 9) & 1) << 5)); }
__host__ __device__ __forceinline__ void stage_rc(int b, int& R, int& C) { const int st = b / 1024, sb = b % 1024, swz = sb ^ (((sb >> 9) & 1) << 5); R = (st >> 1) * 16 + swz / 64; C = (st & 1) * 32 + (swz % 64) / 2; }
__host__ __device__ __forceinline__ int perm32(int rho) { const int n = rho >> 4, i = rho & 15; return 8 * (i >> 2) + 4 * n + (i & 3); }

struct Unit { int pm, pn; };
struct Gemm { const bf16_t* A; const bf16_t* Bt; int M, N, K, lda, ldb; int agrp; size_t astep; };

struct SplitOrder {
    int c, nN;
    __host__ __device__ void init(int M, int N, int G_, int c_) { c = c_; nN = N / BM; (void)M; (void)G_; }
    __host__ __device__ bool next(int i, Unit& u) const { int idx; if (c < 128) { if (i >= 2) return false; idx = 2 * c + i; } else { if (i >= 4) return false; idx = 256 + 4 * (c - 128) + i; } u.pm = idx / nN; u.pn = idx % nN; return true; }
    __device__ __forceinline__ void a_ready(const Unit&) const {}
    __device__ __forceinline__ void done(const Unit&) const {}
};
struct StaticOrder {
    int nM, nN, nwg, G, c;
    __host__ __device__ void init(int M, int N, int G_, int c_) { nM = M / BM; nN = N / BM; nwg = nM * nN; G = G_; c = c_; }
    __host__ __device__ bool next(int i, Unit& u) const {
        const long L = (long)i * G + c; if (L >= nwg) return false;
        int wgid = (int)L; { const int q = nwg / NXCD, r = nwg % NXCD, xcd = wgid % NXCD, off = wgid / NXCD; wgid = (xcd < r ? xcd * (q + 1) : r * (q + 1) + (xcd - r) * q) + off; }
        const int nig = WGM * nN, gid = wgid / nig, fm = gid * WGM, gsz = (nM - fm) < WGM ? (nM - fm) : WGM;
        u.pm = fm + ((wgid % nig) % gsz); u.pn = (wgid % nig) / gsz; return true;
    }
    __device__ __forceinline__ void a_ready(const Unit&) const {}
    __device__ __forceinline__ void done(const Unit&) const {}
};

typedef float f32x2 __attribute__((ext_vector_type(2)));
typedef __bf16 bf16x2_t __attribute__((ext_vector_type(2)));
__device__ __forceinline__ unsigned pkbf(float lo, float hi) { f32x2 v = {lo, hi}; bf16x2_t b = __builtin_convertvector(v, bf16x2_t); return __builtin_bit_cast(unsigned, b); }
__device__ __forceinline__ float bflo(unsigned w) { return __uint_as_float(w << 16); }
__device__ __forceinline__ float bfhi(unsigned w) { return __uint_as_float(w & 0xffff0000u); }
__device__ __forceinline__ float sigm(float x) { return __builtin_amdgcn_rcpf(1.0f + __builtin_amdgcn_exp2f(-1.4426950408889634f * x)); }
template <class Fn> struct Epi8 {
    static constexpr bool PERM = true, AFTER_DRAIN = false; Fn f;
    __device__ __forceinline__ void operator()(const f32x4 (&acc)[2][2][4][2], const Unit& u, int wr, int wc, int fr, int fq) const {
        const int row0 = u.pm * BM + wr * 64 + fr, col0 = u.pn * BM + wc * 32 + 8 * fq;
#pragma unroll
        for (int ai = 0; ai < 2; ++ai)
#pragma unroll
            for (int m = 0; m < 4; ++m)
#pragma unroll
                for (int bj = 0; bj < 2; ++bj) { f(row0 + ai * HALF + m * 16, col0 + bj * HALF, acc[ai][bj][m][0], acc[ai][bj][m][1]); }
    }
};
__device__ __forceinline__ void st8bf(bf16_t* p, f32x4 v0, f32x4 v1) { u32x4 w; w.x = pkbf(v0[0], v0[1]); w.y = pkbf(v0[2], v0[3]); w.z = pkbf(v1[0], v1[1]); w.w = pkbf(v1[2], v1[3]); *(u32x4*)p = w; }
struct FnP1 { bf16_t* O; int coff;
    __device__ __forceinline__ void operator()(int row, int col, f32x4 v0, f32x4 v1) const {
        col += coff;
        if (col >= 3072) {
            if (col < 3136) {
#pragma unroll
                for (int j = 0; j < 4; ++j) { v0[j] = 1.0f - 2.0f * __builtin_amdgcn_rcpf(__builtin_amdgcn_exp2f(2.8853900817779268f * v0[j]) + 1.0f); v1[j] = 1.0f - 2.0f * __builtin_amdgcn_rcpf(__builtin_amdgcn_exp2f(2.8853900817779268f * v1[j]) + 1.0f); } }
            else if (col >= 3232 && col < 3392) {
#pragma unroll
                for (int j = 0; j < 4; ++j) { v0[j] = sigm(v0[j]); v1[j] = sigm(v1[j]); } }
        }
        st8bf(O + (size_t)row * 3584 + col, v0, v1); } };
struct FnP2 { bf16_t* O; const float* bias;
    __device__ __forceinline__ void operator()(int row, int col, f32x4 v0, f32x4 v1) const {
        const f32x4 b0 = *(const f32x4*)(bias + col), b1 = *(const f32x4*)(bias + col + 4);
        const float sc = col < 1024 ? -0.60653065971f : 1.0f;
#pragma unroll
        for (int j = 0; j < 4; ++j) { v0[j] = sc * sigm(v0[j] + b0[j]); v1[j] = sc * sigm(v1[j] + b1[j]); }
        st8bf(O + (size_t)row * 3072 + col, v0, v1); } };
struct FnGate { bf16_t* Y; int ld;
    __device__ __forceinline__ void operator()(int row, int col, f32x4 v0, f32x4 v1) const {
        bf16_t* p = Y + (size_t)row * ld + col; const u32x4 y = *(const u32x4*)p;
        v0[0] *= bflo(y.x); v0[1] *= bfhi(y.x); v0[2] *= bflo(y.y); v0[3] *= bfhi(y.y); v1[0] *= bflo(y.z); v1[1] *= bfhi(y.z); v1[2] *= bflo(y.w); v1[3] *= bfhi(y.w);
        st8bf(p, v0, v1); } };
struct FnRes { const float* xin; float* xout; const float* gate;
    __device__ __forceinline__ void operator()(int row, int col, f32x4 v0, f32x4 v1) const {
        const float* gp = gate + (row >> 13) * 6144 + col; const f32x4 g0 = *(const f32x4*)gp, g1 = *(const f32x4*)(gp + 4);
        const size_t off = (size_t)row * 1024 + col; const f32x4 x0 = *(const f32x4*)(xin + off), x1 = *(const f32x4*)(xin + off + 4);
        *(f32x4*)(xout + off) = x0 + (g0 + 1.0f) * v0; *(f32x4*)(xout + off + 4) = x1 + (g1 + 1.0f) * v1; } };
struct FnUp { bf16_t* O;
    __device__ __forceinline__ void operator()(int row, int col, f32x4 v0, f32x4 v1) const {
#pragma unroll
        for (int j = 0; j < 4; ++j) { const float a = fmaxf(v0[j], 0.f), b = fmaxf(v1[j], 0.f); v0[j] = a * a; v1[j] = b * b; }
        st8bf(O + (size_t)row * 4096 + col, v0, v1); } };
struct FnKv { bf16_t* O; float* FL;
    __device__ __forceinline__ void operator()(int row, int col, f32x4 v0, f32x4 v1) const {
        if (col < 2048) st8bf(O + (size_t)row * 2048 + col, v0, v1);
        else if (col < 2064) { float* p = FL + (size_t)row * 16 + (col - 2048); *(f32x4*)p = v0; *(f32x4*)(p + 4) = v1; } } };
struct FnQg { bf16_t* Q; bf16_t* G;
    __device__ __forceinline__ void operator()(int row, int col, f32x4 v0, f32x4 v1) const {
        if (col < 1024) st8bf(Q + (size_t)row * 1024 + col, v0, v1);
        else {
#pragma unroll
            for (int j = 0; j < 4; ++j) { v0[j] = sigm(v0[j]); v1[j] = sigm(v1[j]); }
            st8bf(G + (size_t)row * 1024 + (col - 1024), v0, v1); } } };
template <class Epi, class Sched, bool ALIGN_EPI = false, bool SP2 = false>
__device__ __forceinline__ void gemm_phase(PG8_LAS unsigned char* lds, const Gemm g, const Sched& S, const Epi& E, const int tid_in) {
    int tid_l = tid_in; asm volatile("" : "+v"(tid_l));
    const int tid = tid_l, wid = __builtin_amdgcn_readfirstlane(tid >> 6), lane = tid & 63, wr = wid >> 2, wc = wid & 3, fr = lane & 15, fq = lane >> 4;
    const int K = g.K, nt = K / BK;
    unsigned voffA[2], voffB[2];
#pragma unroll
    for (int i = 0; i < 2; ++i) { int R, C; stage_rc(tid * 16 + i * 8192, R, C); const int Rb = Epi::PERM ? ((R & ~31) + perm32(R & 31)) : R;
        voffA[i] = (unsigned)(R * g.lda + C) * 2u; voffB[i] = (unsigned)(Rb * g.ldb + C) * 2u; }
    const size_t kstep = (size_t)(BK * 2);
    const size_t hstepA = (size_t)HALF * g.lda * 2, hstepB = (size_t)HALF * g.ldb * 2;
    const size_t tstepA = 2 * hstepA, tstepB = 2 * hstepB;
    const unsigned ldsw = (unsigned)wid * 1024u;
    const int aoff = lds_byte(wr * 64 + fr, fq * 8), boff = lds_byte(wc * 32 + fr, fq * 8);
#define PG8_SA(b, h) (((b) * 2 + (h)) * HTB)
#define PG8_SB(b, h) ((4 + (b) * 2 + (h)) * HTB)
#define PG8_STAGE(bufoff, gbase, voff) do { _Pragma("unroll") for (int _i = 0; _i < 2; ++_i) \
        __builtin_amdgcn_global_load_lds((const unsigned*)((const char*)(gbase) + (voff)[_i]), (PG8_LAS unsigned*)(lds + (bufoff) + ldsw + _i * 8192), 16, 0, 0); } while (0)
#define PG8_LDA(dst, b, h) do { _Pragma("unroll") for (int m = 0; m < 4; ++m) _Pragma("unroll") for (int k = 0; k < 2; ++k) dst[m][k] = *(const PG8_LAS bf16x8*)(lds + PG8_SA(b, h) + aoff + m * 2048 + k * 1024); } while (0)
#define PG8_LDB(dst, b, h) do { _Pragma("unroll") for (int n = 0; n < 2; ++n) _Pragma("unroll") for (int k = 0; k < 2; ++k) dst[n][k] = *(const PG8_LAS bf16x8*)(lds + PG8_SB(b, h) + boff + n * 2048 + k * 1024); } while (0)
#define PG8_MMA(ai, bj, At, Bt) do { __builtin_amdgcn_s_setprio(1); _Pragma("unroll") for (int m = 0; m < 4; ++m) _Pragma("unroll") for (int n = 0; n < 2; ++n) _Pragma("unroll") for (int k = 0; k < 2; ++k) \
        acc[ai][bj][m][n] = __builtin_amdgcn_mfma_f32_16x16x32_bf16(Bt[n][k], At[m][k], acc[ai][bj][m][n], 0, 0, 0); __builtin_amdgcn_s_setprio(0); } while (0)
#define PG8_WAIT_V(n) asm volatile("s_waitcnt vmcnt(" #n ")" ::: "memory")
#define PG8_WAIT_L(n) asm volatile("s_waitcnt lgkmcnt(" #n ")" ::: "memory")
#define PG8_BAR __builtin_amdgcn_s_barrier()
#define PG8_SCHED __builtin_amdgcn_sched_barrier(0)
    Unit cur, nxt; int ui = 0;
    if (!S.next(0, cur)) return;
    f32x4 acc[2][2][4][2];
#pragma unroll
    for (int a = 0; a < 2; ++a)
#pragma unroll
        for (int b = 0; b < 2; ++b)
#pragma unroll
            for (int m = 0; m < 4; ++m)
#pragma unroll
                for (int n = 0; n < 2; ++n) acc[a][b][m][n] = (f32x4){0.f, 0.f, 0.f, 0.f};
    bf16x8 At[4][2], B0[2][2], B1[2][2];
    const char* cA = (const char*)g.A + (size_t)cur.pm * tstepA + (g.agrp ? (size_t)(cur.pn / g.agrp) * g.astep : (size_t)0); const char* cB = (const char*)g.Bt + (size_t)cur.pn * tstepB;
    S.a_ready(cur);
    if constexpr (SP2) {
        PG8_STAGE(PG8_SB(0, 0), cB, voffB); PG8_STAGE(PG8_SB(0, 1), cB + hstepB, voffB); PG8_STAGE(PG8_SA(0, 0), cA, voffA); PG8_STAGE(PG8_SA(0, 1), cA + hstepA, voffA);
        if (wr == 1) PG8_BAR;
        PG8_WAIT_V(2); PG8_BAR;
        PG8_STAGE(PG8_SB(1, 0), cB + kstep, voffB); PG8_STAGE(PG8_SA(1, 0), cA + kstep, voffA); PG8_STAGE(PG8_SB(1, 1), cB + hstepB + kstep, voffB);
        PG8_WAIT_V(6); PG8_BAR;
    } else {
        PG8_STAGE(PG8_SB(0, 0), cB, voffB); PG8_STAGE(PG8_SA(0, 0), cA, voffA); PG8_STAGE(PG8_SB(0, 1), cB + hstepB, voffB); PG8_STAGE(PG8_SA(0, 1), cA + hstepA, voffA);
        if (wr == 1) PG8_BAR;
        PG8_WAIT_V(4); PG8_BAR;
        PG8_STAGE(PG8_SB(1, 0), cB + kstep, voffB); PG8_STAGE(PG8_SA(1, 0), cA + kstep, voffA); PG8_STAGE(PG8_SB(1, 1), cB + hstepB + kstep, voffB);
        PG8_WAIT_V(6); PG8_BAR;
    }
    for (;;) {
        const bool has_next = S.next(ui + 1, nxt);
        const char* nA = has_next ? (const char*)g.A + (size_t)nxt.pm * tstepA + (g.agrp ? (size_t)(nxt.pn / g.agrp) * g.astep : (size_t)0) : cA; const char* nB = has_next ? (const char*)g.Bt + (size_t)nxt.pn * tstepB : cB;
        for (int t = 0; t < nt; t += 2) {
            const bool last = (t == nt - 2);
            const char* a1 = cA + (size_t)(t + 1) * kstep;
            const char* a2 = last ? nA : cA + (size_t)(t + 2) * kstep; const char* b2 = last ? nB : cB + (size_t)(t + 2) * kstep;
            const char* a3 = a2 + kstep; const char* b3 = b2 + kstep;
            if (last && has_next) S.a_ready(nxt);
            if constexpr (SP2) {
            PG8_LDB(B0, 0, 0); PG8_LDB(B1, 0, 1); PG8_SCHED; PG8_LDA(At, 0, 0); PG8_STAGE(PG8_SA(1, 1), a1 + hstepA, voffA);
            PG8_WAIT_V(8); PG8_WAIT_L(0); PG8_BAR; PG8_MMA(0, 0, At, B0); PG8_MMA(0, 1, At, B1); PG8_BAR; PG8_SCHED;
            PG8_LDA(At, 0, 1); PG8_STAGE(PG8_SB(0, 0), b2, voffB); PG8_STAGE(PG8_SB(0, 1), b2 + hstepB, voffB); PG8_STAGE(PG8_SA(0, 0), a2, voffA);
            PG8_WAIT_V(8); PG8_WAIT_L(0); PG8_BAR; PG8_MMA(1, 0, At, B0); PG8_MMA(1, 1, At, B1); PG8_BAR; PG8_SCHED;
            PG8_LDB(B0, 1, 0); PG8_LDB(B1, 1, 1); PG8_SCHED; PG8_LDA(At, 1, 0); PG8_STAGE(PG8_SA(0, 1), a2 + hstepA, voffA);
            PG8_WAIT_V(8); PG8_WAIT_L(0); PG8_BAR; PG8_MMA(0, 0, At, B0); PG8_MMA(0, 1, At, B1); PG8_BAR; PG8_SCHED;
            PG8_LDA(At, 1, 1); PG8_STAGE(PG8_SB(1, 0), b3, voffB); PG8_STAGE(PG8_SB(1, 1), b3 + hstepB, voffB); PG8_STAGE(PG8_SA(1, 0), a3, voffA);
            PG8_WAIT_V(8); PG8_WAIT_L(0); PG8_BAR; PG8_MMA(1, 0, At, B0); PG8_MMA(1, 1, At, B1); PG8_BAR; PG8_SCHED;
            } else {
            PG8_LDB(B0, 0, 0); PG8_SCHED; PG8_LDA(At, 0, 0); PG8_STAGE(PG8_SA(1, 1), a1 + hstepA, voffA);
            PG8_WAIT_L(8); PG8_BAR; PG8_WAIT_L(0); PG8_MMA(0, 0, At, B0); PG8_BAR; PG8_SCHED;
            PG8_LDB(B1, 0, 1); PG8_STAGE(PG8_SB(0, 0), b2, voffB);
            PG8_BAR; PG8_WAIT_L(0); PG8_MMA(0, 1, At, B1); PG8_BAR;
            PG8_LDA(At, 0, 1); PG8_STAGE(PG8_SA(0, 0), a2, voffA);
            PG8_BAR; PG8_WAIT_L(0); PG8_MMA(1, 0, At, B0); PG8_BAR; PG8_SCHED;
            PG8_STAGE(PG8_SB(0, 1), b2 + hstepB, voffB);
            PG8_WAIT_V(6); PG8_BAR; PG8_MMA(1, 1, At, B1); PG8_BAR;
            PG8_LDB(B0, 1, 0); PG8_SCHED; PG8_LDA(At, 1, 0); PG8_STAGE(PG8_SA(0, 1), a2 + hstepA, voffA);
            PG8_WAIT_L(8); PG8_BAR; PG8_WAIT_L(0); PG8_MMA(0, 0, At, B0); PG8_BAR; PG8_SCHED;
            PG8_LDB(B1, 1, 1); PG8_STAGE(PG8_SB(1, 0), b3, voffB);
            PG8_BAR; PG8_WAIT_L(0); PG8_MMA(0, 1, At, B1); PG8_BAR;
            PG8_LDA(At, 1, 1); PG8_STAGE(PG8_SA(1, 0), a3, voffA);
            PG8_BAR; PG8_WAIT_L(0); PG8_MMA(1, 0, At, B0); PG8_BAR; PG8_SCHED;
            PG8_STAGE(PG8_SB(1, 1), b3 + hstepB, voffB);
            PG8_WAIT_V(6); PG8_BAR; PG8_MMA(1, 1, At, B1); PG8_BAR;
            }
        }
        if constexpr (ALIGN_EPI) { if (wr == 0) PG8_BAR; }
        if constexpr (!Epi::AFTER_DRAIN) { E(acc, cur, wr, wc, fr, fq); S.done(cur); }
        if (!has_next) break;
#pragma unroll
        for (int a = 0; a < 2; ++a)
#pragma unroll
            for (int b = 0; b < 2; ++b)
#pragma unroll
                for (int m = 0; m < 4; ++m)
#pragma unroll
                    for (int n = 0; n < 2; ++n) acc[a][b][m][n] = (f32x4){0.f, 0.f, 0.f, 0.f};
        cur = nxt; cA = nA; cB = nB; ++ui;
        if constexpr (ALIGN_EPI) { if (wr == 1) PG8_BAR; }
    }
    PG8_WAIT_V(0);
    if constexpr (!ALIGN_EPI) { if (wr == 0) PG8_BAR; }
    PG8_BAR;
    if constexpr (Epi::AFTER_DRAIN) { E.fused(acc, cur, wr, wc, fr, fq, lds, wid, lane); S.done(cur); }
#undef PG8_SA
#undef PG8_SB
#undef PG8_STAGE
#undef PG8_LDA
#undef PG8_LDB
#undef PG8_MMA
#undef PG8_WAIT_V
#undef PG8_WAIT_L
#undef PG8_BAR
#undef PG8_SCHED
}
}
#include <hip/hip_bf16.h>
#include <cmath>
namespace attn_body {
using bf16=__hip_bfloat16;
using bf16x8=__attribute__((ext_vector_type(8)))short;
using s16x4=__attribute__((ext_vector_type(4)))short;
using f32x16=__attribute__((ext_vector_type(16)))float;
using u32x4=__attribute__((ext_vector_type(4)))unsigned;
constexpr int BATCH=2,NHEAD=16,SEQ=8192,D=64,DM=NHEAD*D;
constexpr int NW=8,QBLK=32,QB=QBLK*NW,KVBLK=64,NQB=SEQ/QB;
constexpr int ATTN_PITCH=DM, ATTN_UNIT_ROWS=QB;
__device__ __forceinline__ int crow(int r,int hi){return (r&3)+8*(r>>2)+4*hi;}
#define SBAR() __builtin_amdgcn_sched_barrier(0)
__device__ __forceinline__ void cmask(f32x16&p0,f32x16&p1,int jb,int qrel,int hi){
  const float NEG=-INFINITY; int kb=64*jb+4*hi;
  #pragma unroll
  for(int r=0;r<16;++r){int kv=kb+(r&3)+8*(r>>2); if(kv>qrel)p0[r]=NEG; if(kv+32>qrel)p1[r]=NEG;}
}

constexpr int NSLOT=3, SLOTB=9216;
constexpr int LDS_K=0, LDS_V=NSLOT*SLOTB, LDS_WS=2*NSLOT*SLOTB, LDS_OST=LDS_WS+NW*64*4, LDS_BYTES=LDS_OST+NW*4096;
constexpr float C2=0.125f*1.4426950408889634f;
__device__ __forceinline__ void glds16(const void*gsrc,unsigned lds_dst){unsigned keep;
  asm volatile("s_mov_b32 %0, m0\n\ts_mov_b32 m0, %2\n\ts_nop 0\n\tglobal_load_lds_dwordx4 %1, off\n\ts_mov_b32 m0, %0":"=&s"(keep):"v"(gsrc),"s"(lds_dst):"memory");}
__device__ __forceinline__ float max3f(float a,float b,float c){float r;asm("v_max3_f32 %0, %1, %2, %3":"=v"(r):"v"(a),"v"(b),"v"(c));return r;}
__device__ __forceinline__ float max2f(float a,float b){float r;asm("v_max_f32_e32 %0, %1, %2":"=v"(r):"v"(a),"v"(b));return r;}
__device__ __forceinline__ float fadd_s(float a,float b){float r;asm("v_add_f32_e32 %0, %1, %2":"=v"(r):"v"(a),"v"(b));return r;}
__device__ __forceinline__ float fsub_s(float a,float b){float r;asm("v_sub_f32_e32 %0, %1, %2":"=v"(r):"v"(a),"v"(b));return r;}
typedef float f32x2_t __attribute__((ext_vector_type(2))); typedef __bf16 bf16x2_t __attribute__((ext_vector_type(2)));
__device__ __forceinline__ unsigned cvtpk_s(float lo,float hi){f32x2_t v={lo,hi};bf16x2_t b=__builtin_convertvector(v,bf16x2_t);return __builtin_bit_cast(unsigned,b);}
#define WAIT_BAR(N) asm volatile("s_waitcnt vmcnt(" #N ") lgkmcnt(0)\n\ts_barrier":::"memory")
#define WAIT_BARW() do{ if(wid==0){WAIT_BAR(3);} else {WAIT_BAR(2);} }while(0)

__device__ __forceinline__ void qkt(f32x16&p0,f32x16&p1,const char*Kslot,const bf16x8*qr,const bf16x8 qe,const f32x16&negm,int r32,int hi){
  const char*kb=Kslot+hi*1024+r32*16;
  #pragma unroll
  for(int d0=0;d0<4;++d0){
    const bf16x8 b0=*reinterpret_cast<const bf16x8*>(kb+d0*2048);
    const bf16x8 b1=*reinterpret_cast<const bf16x8*>(kb+d0*2048+512);
    if(d0==0){p0=__builtin_amdgcn_mfma_f32_32x32x16_bf16(b0,qr[0],negm,0,0,0);p1=__builtin_amdgcn_mfma_f32_32x32x16_bf16(b1,qr[0],negm,0,0,0);}
    else{p0=__builtin_amdgcn_mfma_f32_32x32x16_bf16(b0,qr[d0],p0,0,0,0);p1=__builtin_amdgcn_mfma_f32_32x32x16_bf16(b1,qr[d0],p1,0,0,0);}}
  { const char*ke=Kslot+8192+r32*16; const bf16x8 e0=*reinterpret_cast<const bf16x8*>(ke),e1=*reinterpret_cast<const bf16x8*>(ke+512);
    p0=__builtin_amdgcn_mfma_f32_32x32x16_bf16(e0,qe,p0,0,0,0);p1=__builtin_amdgcn_mfma_f32_32x32x16_bf16(e1,qe,p1,0,0,0);}
}
typedef __attribute__((address_space(3))) const char* lds_cptr;
typedef short v4i16_t __attribute__((ext_vector_type(4)));
__device__ __forceinline__ void kload8(bf16x8*kf,lds_cptr kp){
  kf[0]=*(const __attribute__((address_space(3))) bf16x8*)(kp);      kf[1]=*(const __attribute__((address_space(3))) bf16x8*)(kp+512);
  kf[2]=*(const __attribute__((address_space(3))) bf16x8*)(kp+2048); kf[3]=*(const __attribute__((address_space(3))) bf16x8*)(kp+2560);
  kf[4]=*(const __attribute__((address_space(3))) bf16x8*)(kp+4096); kf[5]=*(const __attribute__((address_space(3))) bf16x8*)(kp+4608);
  kf[6]=*(const __attribute__((address_space(3))) bf16x8*)(kp+6144); kf[7]=*(const __attribute__((address_space(3))) bf16x8*)(kp+6656);
}
__device__ __forceinline__ void kload2(bf16x8*kf,lds_cptr kp,int j){ kf[2*j]=*(const __attribute__((address_space(3))) bf16x8*)(kp+j*2048); kf[2*j+1]=*(const __attribute__((address_space(3))) bf16x8*)(kp+j*2048+512); }
__device__ __forceinline__ s16x4 vtr(lds_cptr p){ return __builtin_bit_cast(s16x4,__builtin_amdgcn_ds_read_tr16_b64_v4i16((__attribute__((address_space(3))) v4i16_t*)p)); }
__device__ __forceinline__ float rowmax(const f32x16&p0,const f32x16&p1){
  float a=max3f(p0[0],p0[1],p1[0]),b=max3f(p0[2],p0[3],p1[1]);a=max3f(a,p1[2],p1[3]);
  #pragma unroll
  for(int r=4;r<16;r+=4){a=max3f(a,p0[r],p0[r+1]);b=max3f(b,p0[r+2],p0[r+3]);a=max3f(a,p1[r],p1[r+1]);b=max3f(b,p1[r+2],p1[r+3]);}
  const float m=max2f(a,b);
  auto rr=__builtin_amdgcn_permlane32_swap(__float_as_uint(m),__float_as_uint(m),false,false);
  return max2f(__uint_as_float(rr[0]),__uint_as_float(rr[1]));
}
__device__ __forceinline__ void pv(f32x16*o,int vb,bf16x8 pa0,bf16x8 pa1,bf16x8 pa2,bf16x8 pa3){
  #pragma unroll
  for(int d0=0;d0<2;++d0){s16x4 lo[4],hi[4];
    #pragma unroll
    for(int ks=0;ks<4;++ks){
      asm volatile("ds_read_b64_tr_b16 %0,%1 offset:%c2":"=&v"(lo[ks]):"v"(vb),"i"(d0*4096+ks*1024):"memory");
      asm volatile("ds_read_b64_tr_b16 %0,%1 offset:%c2":"=&v"(hi[ks]):"v"(vb),"i"(d0*4096+ks*1024+512):"memory");}
    asm volatile("s_waitcnt lgkmcnt(0)":::"memory");SBAR();
    #define PK(k) (bf16x8){lo[k][0],lo[k][1],lo[k][2],lo[k][3],hi[k][0],hi[k][1],hi[k][2],hi[k][3]}
    o[d0]=__builtin_amdgcn_mfma_f32_32x32x16_bf16(pa0,PK(0),o[d0],0,0,0);
    o[d0]=__builtin_amdgcn_mfma_f32_32x32x16_bf16(pa1,PK(1),o[d0],0,0,0);
    o[d0]=__builtin_amdgcn_mfma_f32_32x32x16_bf16(pa2,PK(2),o[d0],0,0,0);
    o[d0]=__builtin_amdgcn_mfma_f32_32x32x16_bf16(pa3,PK(3),o[d0],0,0,0);
    #undef PK
  }
}

#ifndef ATTN_STORE16
#define ATTN_STORE16(p,v) (*(u32x4*)(p)=(v))
#endif
template<int THRL> __device__ __forceinline__ void attn_unit(int b,int h,int qb,const bf16*Q,const bf16*__restrict__ K,const bf16*__restrict__ V,bf16*O,const bf16*__restrict__ GT,const unsigned char*__restrict__ G3,const float*__restrict__ qgain,const float kbound,char*shm,const int tid_in,const int j0){
  int tid_l=tid_in; asm volatile("":"+v"(tid_l)); const int tid=tid_l,lane=tid&63,r32=lane&31,hi=lane>>5; const int wid=__builtin_amdgcn_readfirstlane(tid>>6);
  const long rowbase=(long)b*SEQ; const int q0=qb*QB;
  const bf16*Qw=Q+(rowbase+q0+wid*QBLK)*DM+h*D;
  const bf16*Kh=K+rowbase*DM+h*D,*Vh=V+rowbase*DM+h*D;
  const unsigned lds0=(unsigned)(uintptr_t)shm;
  float*wsf=(float*)(shm+LDS_WS)+wid*64;
  const bf16*ksrc=Kh+(long)lane*DM+wid*8;
  const bf16*vsrc=Vh+(long)(16*(wid&3)+(lane>>2))*DM+(wid>>2)*32+(lane&3)*8;
  const unsigned kdst=lds0+LDS_K+wid*1024, vdst=lds0+LDS_V+wid*1024, gdst=lds0+LDS_K+8192;
  const unsigned char*gsrc=G3+((long)(b*NHEAD+h)*SEQ+lane)*16;
  #define DMA_K(t,slot) do{ if(wid==0)glds16(gsrc+(long)(t)*KVBLK*16,(unsigned)__builtin_amdgcn_readfirstlane(gdst+(slot))); glds16(ksrc+(long)(t)*KVBLK*DM,(unsigned)__builtin_amdgcn_readfirstlane(kdst+(slot))); }while(0)
  #define DMA_V(t,slot) glds16(vsrc+(long)(t)*KVBLK*DM,(unsigned)__builtin_amdgcn_readfirstlane(vdst+(slot)))
  const int vb0=(int)(lds0+LDS_V)+((lane>>4)&1)*32+(lane&3)*8+(4*hi+((lane&15)>>2))*64;
  const char*Kbase=shm+LDS_K; bf16x8 kf[10];
  const lds_cptr shm3=(lds_cptr)shm; const lds_cptr kp0=shm3+LDS_K+hi*1024+r32*16; const lds_cptr kpe=shm3+LDS_K+8192+r32*16; const lds_cptr vp0=shm3+LDS_V+((lane>>4)&1)*32+(lane&3)*8+(4*hi+((lane&15)>>2))*64;
  ksrc+=(long)j0*KVBLK*DM; vsrc+=(long)j0*KVBLK*DM; gsrc+=(long)j0*KVBLK*16;
  const int NT=(q0+QB)/KVBLK-j0;
  DMA_K(0,0);DMA_V(0,0);DMA_K(1,SLOTB);
  bf16x8 qr[4]; float fq2; bf16x8 qe; float ubound;
  { bf16x8 qraw[4];
    #pragma unroll
    for(int d0=0;d0<4;++d0)qraw[d0]=*reinterpret_cast<const bf16x8*>(&Qw[(long)r32*DM+d0*16+hi*8]);
    const u32x4 ge=*reinterpret_cast<const u32x4*>(G3+((long)(b*NHEAD+h)*SEQ+q0+wid*QBLK+r32)*16);
    fq2=-(__uint_as_float(ge[0]<<16)+__uint_as_float(ge[0]&0xffff0000u)+__uint_as_float(ge[1]<<16));
    float ss=0.f;
    #pragma unroll
    for(int d0=0;d0<4;++d0)
      #pragma unroll
      for(int j=0;j<8;++j){const float x=__uint_as_float(((unsigned)(unsigned short)qraw[d0][j])<<16);ss+=x*x;}
    {auto rr=__builtin_amdgcn_permlane32_swap(__float_as_uint(ss),__float_as_uint(ss),false,false);ss=__uint_as_float(rr[0])+__uint_as_float(rr[1]);}
    const float qs=C2/sqrtf(ss*(1.0f/64.0f)+1e-6f);
    float s2=0.f;
    #pragma unroll
    for(int d0=0;d0<4;++d0){ u32x4 w;
      #pragma unroll
      for(int j=0;j<8;j+=2){const float x0=__uint_as_float(((unsigned)(unsigned short)qraw[d0][j])<<16),x1=__uint_as_float(((unsigned)(unsigned short)qraw[d0][j+1])<<16);
        const float y0=x0*qs*qgain[d0*16+hi*8+j],y1=x1*qs*qgain[d0*16+hi*8+j+1]; s2+=y0*y0+y1*y1;
        w[j>>1]=cvtpk_s(y0,y1);}
      qr[d0]=__builtin_bit_cast(bf16x8,w);}
    {auto rr=__builtin_amdgcn_permlane32_swap(__float_as_uint(s2),__float_as_uint(s2),false,false);s2=__uint_as_float(rr[0])+__uint_as_float(rr[1]);}
    ubound=sqrtf(s2)*kbound;
    const unsigned one2=hi?0u:0x3f803f80u, one1=hi?0u:0x00003f80u; qe=__builtin_bit_cast(bf16x8,(u32x4){one2,one1,0u,0u}); }
  float mhat=ubound,l_reg=0.f;f32x16 o[2];o[0]=f32x16{};o[1]=f32x16{};f32x16 negm;
  #pragma unroll
  for(int r=0;r<16;++r)negm[r]=fq2-ubound;
  asm volatile("":"+v"(negm));
  const int qrel=wid*QBLK+r32;
  #define CMASK(P0,P1,t) do{int jb_=(t)-(NT-4); if(jb_>=0)cmask(P0,P1,jb_,qrel,hi);}while(0)
  bool resc=false;
  #define START(P0,P1) do{ const float rm=rowmax(P0,P1); resc=false; \
    { const float dl=fmaxf(rm,0.f); mhat=fadd_s(mhat,dl); \
      _Pragma("unroll") for(int r=0;r<16;++r){P0[r]=fsub_s(P0[r],dl);P1[r]=fsub_s(P1[r],dl);} \
      _Pragma("unroll") for(int r=0;r<16;++r)negm[r]=fq2-mhat; asm volatile("":"+v"(negm)); } \
    _Pragma("unroll") for(int r=0;r<16;++r)P0[r]=__builtin_amdgcn_exp2f(P0[r]); }while(0)
  #define RESC() do{ if(resc){ asm volatile("s_waitcnt lgkmcnt(0)":::"memory"); \
      _Pragma("unroll") for(int d_=0;d_<2;++d_) _Pragma("unroll") for(int r=0;r<16;++r)o[d_][r]*=wsf[crow(r,hi)]; } }while(0)
  f32x16 pA0,pA1,pB0,pB1;
  int sl_prev=0,sl_cur=0,sl_next=SLOTB;
  #define ROT() do{sl_prev=sl_cur;sl_cur=sl_next;sl_next=(sl_next==(NSLOT-1)*SLOTB)?0:sl_next+SLOTB;}while(0)
  DMA_K(2,2*SLOTB);
  WAIT_BAR(3);
  qkt(pA0,pA1,Kbase,qr,qe,negm,r32,hi);asm volatile("s_nop 15\n\ts_nop 7":"+v"(pA0),"+v"(pA1));CMASK(pA0,pA1,0);
  START(pA0,pA1);
  _Pragma("unroll") for(int r=0;r<16;++r)pA1[r]=__builtin_amdgcn_exp2f(pA1[r]);
  WAIT_BAR(0);
  DMA_K(3,0);DMA_V(1,SLOTB);
  ROT();
  kload8(kf,kp0+sl_cur);
  kf[8]=*(const __attribute__((address_space(3))) bf16x8*)(kpe+sl_cur); kf[9]=*(const __attribute__((address_space(3))) bf16x8*)(kpe+sl_cur+512);
  WAIT_BARW();
  s16x4 vlo[8],vhi[8]; u32x4 pw0,pw1,pw2,pw3;
  #define PKW(P,B) cvtpk_s(P[B],P[B+1])
  #define PAF(k) __builtin_bit_cast(bf16x8,pw##k)
  #define VFR(i) (bf16x8){vlo[i][0],vlo[i][1],vlo[i][2],vlo[i][3],vhi[i][0],vhi[i][1],vhi[i][2],vhi[i][3]}
  #define PIN(x) asm volatile("":"+v"(x))
  #define MX3(a,b,c) __builtin_fmaxf(__builtin_fmaxf((a),(b)),(c))
  #define GAPA(MF,A0,A1,A2,A3,W0,W1,PW) do{ MF; sacc+=A0; sacc+=A1; sacc+=A2; sacc+=A3; PIN(sacc); W0; W1; PIN(PW); SBAR(); }while(0)
  #define EX(v) __builtin_amdgcn_exp2f(v)
  #define GAPB(MF,X,B) do{ MF; X[B]=EX(X[B]); X[B+1]=EX(X[B+1]); X[B+2]=EX(X[B+2]); X[B+3]=EX(X[B+3]); PIN(X); SBAR(); }while(0)
  #define VRD(i) do{ vlo[i]=vtr(vp_+(((i)>>2)*4096+((i)&3)*1024)); vhi[i]=vtr(vp_+(((i)>>2)*4096+((i)&3)*1024+512)); }while(0)
  #define KRD(G,j) do{ if(G){ kload2(kf,kp0+sl_next,j); SBAR(); } }while(0)
  #define STEP(C0,C1,P0,P1,t,GK,GV,GL) do{ SBAR(); \
    const lds_cptr vp_=vp0+sl_prev; \
    VRD(0); SBAR(); float sacc=(P0[0]+P0[1]); \
    GAPA(C0=__builtin_amdgcn_mfma_f32_32x32x16_bf16(kf[0],qr[0],negm,0,0,0), P0[2],P0[3],P0[4],P0[5],     pw0[0]=PKW(P0,0), pw0[1]=PKW(P0,2), pw0); \
    VRD(4); SBAR(); GAPA(C1=__builtin_amdgcn_mfma_f32_32x32x16_bf16(kf[1],qr[0],negm,0,0,0), P0[6],P0[7],P0[8],P0[9],     pw0[2]=PKW(P0,4), pw0[3]=PKW(P0,6), pw0); \
    VRD(1); SBAR(); GAPA(C0=__builtin_amdgcn_mfma_f32_32x32x16_bf16(kf[2],qr[1],C0,0,0,0),   P0[10],P0[11],P0[12],P0[13], pw1[0]=PKW(P0,8), pw1[1]=PKW(P0,10), pw1); \
    VRD(5); SBAR(); GAPA(C1=__builtin_amdgcn_mfma_f32_32x32x16_bf16(kf[3],qr[1],C1,0,0,0),   P0[14],P0[15],P1[0],P1[1],   pw1[2]=PKW(P0,12),pw1[3]=PKW(P0,14), pw1); \
    VRD(2); SBAR(); GAPA(C0=__builtin_amdgcn_mfma_f32_32x32x16_bf16(kf[4],qr[2],C0,0,0,0),   P1[2],P1[3],P1[4],P1[5],     pw2[0]=PKW(P1,0), pw2[1]=PKW(P1,2), pw2); \
    VRD(6); SBAR(); GAPA(C1=__builtin_amdgcn_mfma_f32_32x32x16_bf16(kf[5],qr[2],C1,0,0,0),   P1[6],P1[7],P1[8],P1[9],     pw2[2]=PKW(P1,4), pw2[3]=PKW(P1,6), pw2); \
    VRD(3); SBAR(); GAPA(C0=__builtin_amdgcn_mfma_f32_32x32x16_bf16(kf[6],qr[3],C0,0,0,0),   P1[10],P1[11],P1[12],P1[13], pw3[0]=PKW(P1,8), pw3[1]=PKW(P1,10), pw3); \
    VRD(7); SBAR(); GAPA(C1=__builtin_amdgcn_mfma_f32_32x32x16_bf16(kf[7],qr[3],C1,0,0,0),   P1[14],P1[15],0.f,0.f,       pw3[2]=PKW(P1,12),pw3[3]=PKW(P1,14), pw3); \
    C0=__builtin_amdgcn_mfma_f32_32x32x16_bf16(kf[8],qe,C0,0,0,0); C1=__builtin_amdgcn_mfma_f32_32x32x16_bf16(kf[9],qe,C1,0,0,0); \
    l_reg+=sacc; \
    if(GK){DMA_K((t)+3,sl_cur);} if(GV){DMA_V((t)+1,sl_next);} \
    CMASK(C0,C1,t); \
    resc=false;     \
    SBAR(); \
    GAPB(o[0]=__builtin_amdgcn_mfma_f32_32x32x16_bf16(PAF(0),VFR(0),o[0],0,0,0), C0,0); \
    GAPB(o[1]=__builtin_amdgcn_mfma_f32_32x32x16_bf16(PAF(0),VFR(4),o[1],0,0,0), C0,4); \
    KRD(GL,0); GAPB(o[0]=__builtin_amdgcn_mfma_f32_32x32x16_bf16(PAF(1),VFR(1),o[0],0,0,0), C0,8); \
    KRD(GL,1); GAPB(o[1]=__builtin_amdgcn_mfma_f32_32x32x16_bf16(PAF(1),VFR(5),o[1],0,0,0), C0,12); \
    KRD(GL,2); GAPB(o[0]=__builtin_amdgcn_mfma_f32_32x32x16_bf16(PAF(2),VFR(2),o[0],0,0,0), C1,0); \
    KRD(GL,3); GAPB(o[1]=__builtin_amdgcn_mfma_f32_32x32x16_bf16(PAF(2),VFR(6),o[1],0,0,0), C1,4); \
    if(GL){ kf[8]=*(const __attribute__((address_space(3))) bf16x8*)(kpe+sl_next); kf[9]=*(const __attribute__((address_space(3))) bf16x8*)(kpe+sl_next+512); SBAR(); } \
    GAPB(o[0]=__builtin_amdgcn_mfma_f32_32x32x16_bf16(PAF(3),VFR(3),o[0],0,0,0), C1,8); \
    GAPB(o[1]=__builtin_amdgcn_mfma_f32_32x32x16_bf16(PAF(3),VFR(7),o[1],0,0,0), C1,12); \
    }while(0)
  int t=1;
  #undef CMASK
  #define CMASK(P0,P1,t) do{}while(0)
  for(;t+5<NT;t+=2){
    STEP(pB0,pB1,pA0,pA1,t,true,true,true);     WAIT_BARW(); RESC(); ROT();
    STEP(pA0,pA1,pB0,pB1,t+1,true,true,true);   WAIT_BARW(); RESC(); ROT();
  }
  #undef CMASK
  #define CMASK(P0,P1,t) do{int jb_=(t)-(NT-4); if(jb_>=0)cmask(P0,P1,jb_,qrel,hi);}while(0)
  #define ENDW(tt) do{ if((tt)+3<NT){WAIT_BARW();} else if((tt)+2<NT){WAIT_BAR(1);} else {WAIT_BAR(0);} }while(0)
  for(;t+1<NT;t+=2){
    STEP(pB0,pB1,pA0,pA1,t,(t+3<NT),(t+1<NT),(t+1<NT));       ENDW(t);   RESC(); ROT();
    STEP(pA0,pA1,pB0,pB1,t+1,(t+4<NT),(t+2<NT),(t+2<NT));     ENDW(t+1); RESC(); ROT();
  }
  STEP(pB0,pB1,pA0,pA1,NT-1,false,false,false); RESC();
  { float sacc=pB0[0]+pB0[1]; _Pragma("unroll") for(int r=2;r<16;++r)sacc+=pB0[r]; _Pragma("unroll") for(int r=0;r<16;++r)sacc+=pB1[r]; l_reg+=sacc;
    pw0=(u32x4){PKW(pB0,0),PKW(pB0,2),PKW(pB0,4),PKW(pB0,6)};pw1=(u32x4){PKW(pB0,8),PKW(pB0,10),PKW(pB0,12),PKW(pB0,14)};pw2=(u32x4){PKW(pB1,0),PKW(pB1,2),PKW(pB1,4),PKW(pB1,6)};pw3=(u32x4){PKW(pB1,8),PKW(pB1,10),PKW(pB1,12),PKW(pB1,14)};
    SBAR(); pv(o,vb0+sl_cur,PAF(0),PAF(1),PAF(2),PAF(3)); }
  #undef PKW
  #undef PAF
  #undef VFR
  #undef PIN
  #undef MX3
  #undef GAPA
  #undef GAPB
  #undef EX
  #undef VRD
  #undef KRD
  #undef STEP
  #undef ENDW
  {auto rr=__builtin_amdgcn_permlane32_swap(__float_as_uint(l_reg),__float_as_uint(l_reg),false,false);l_reg=__uint_as_float(rr[0])+__uint_as_float(rr[1]);}
  if(hi==0)wsf[32+r32]=l_reg;asm volatile("s_waitcnt lgkmcnt(0)":::"memory");
  float rli[16];
  #pragma unroll
  for(int r=0;r<16;++r)rli[r]=__builtin_amdgcn_rcpf(wsf[32+crow(r,hi)]);
  bf16*Ow=O+(rowbase+q0+wid*QBLK)*DM+h*D;
  { bf16*stg=(bf16*)(shm+LDS_OST)+wid*2048;
    #pragma unroll
    for(int r=0;r<16;++r){const int orow=crow(r,hi);
      #pragma unroll
      for(int d0=0;d0<2;++d0)stg[orow*64+d0*32+r32]=__float2bfloat16(o[d0][r]*rli[r]);}
    asm volatile("s_waitcnt lgkmcnt(0)":::"memory");
    const bf16*Gw=GT+(rowbase+q0+wid*QBLK)*DM+h*D;
    #pragma unroll
    for(int i=0;i<4;++i){const int row=i*8+(lane>>3),ch=lane&7; u32x4 v=*(const u32x4*)(stg+row*64+ch*8); const u32x4 gg=*(const u32x4*)(Gw+(long)row*DM+ch*8);
      #pragma unroll
      for(int j=0;j<4;++j){ v[j]=cvtpk_s(__uint_as_float(v[j]<<16)*__uint_as_float(gg[j]<<16),__uint_as_float(v[j]&0xffff0000u)*__uint_as_float(gg[j]&0xffff0000u)); }
      ATTN_STORE16(Ow+(long)row*DM+ch*8,v);} }
  asm volatile("s_waitcnt lgkmcnt(0)\n\ts_barrier":::"memory");
  #undef DMA_K
  #undef DMA_V
  #undef CMASK
  #undef START
  #undef RESC
  #undef ROT
}
constexpr int ATTN_LDS_BYTES=LDS_BYTES;
struct AttnTensors { const bf16* Q; const bf16* K; const bf16* V; bf16* O; const bf16* GT; const unsigned char* G3; const float* qgain; float kbound; };
struct AttnUnit { int bh; int qb; };
struct StaticOrder {
  int vcu;
  __device__ __forceinline__ explicit StaticOrder(int grid,int block):vcu((block%8)*(grid/8)+block/8){}
  __device__ __forceinline__ bool next(int i,AttnUnit&u)const{ if(i>=4)return false; const int s=vcu&7; u.bh=vcu>>3; u.qb=(i==0)?s:(i==1)?15-s:(i==2)?16+s:31-s; return true; }
  __device__ __forceinline__ void a_ready(const AttnUnit&)const{}
  __device__ __forceinline__ void done(const AttnUnit&)const{}
};
template<class Sched,int THRL=8> __device__ __forceinline__ void attn_phase(char*lds,const AttnTensors&T,const Sched&S,const int tid_in){
  AttnUnit u;
  for(int i=0;S.next(i,u);++i){ S.a_ready(u); attn_unit<THRL>(u.bh/NHEAD,u.bh%NHEAD,u.qb,T.Q,T.K,T.V,T.O,T.GT,T.G3,T.qgain,T.kbound,lds,tid_in,0); S.done(u); }
}
__device__ __forceinline__ float g3val(const unsigned char*G3,long key){ const u32x4 ge=*reinterpret_cast<const u32x4*>(G3+key*16); return __uint_as_float(ge[0]<<16)+__uint_as_float(ge[0]&0xffff0000u)+__uint_as_float(ge[1]<<16); }
template<int THRL=8> __device__ __forceinline__ void attn_phase_dyn(char*lds,const AttnTensors&T,unsigned*counter,const float thr2,const int tid_in){
  int tid_l=tid_in; asm volatile("":"+v"(tid_l)); const int tid=tid_l,lane=tid&63;
  volatile unsigned*uw=(volatile unsigned*)(lds+LDS_BYTES);
  for(;;){
    if(tid==0){ const unsigned got=__hip_atomic_fetch_add(counter,1u,__ATOMIC_RELAXED,__HIP_MEMORY_SCOPE_AGENT); *uw=got; }
    __syncthreads();
    const unsigned u=(unsigned)__builtin_amdgcn_readfirstlane((int)*uw);
    if(u>=(unsigned)(BATCH*NHEAD*NQB))break;
    const int qb=NQB-1-(int)(u>>5), bh=(int)(u&31), ntf=4*qb+4;
    const long kb=(long)bh*SEQ; const float gt0=g3val(T.G3,kb+(long)qb*QB);
    bool skip0=false,skip1=false;
    if(lane<ntf) skip0=g3val(T.G3,kb+64*lane+63)<gt0-thr2;
    if(lane+64<ntf) skip1=g3val(T.G3,kb+64*(lane+64)+63)<gt0-thr2;
    int j0=__builtin_popcountll(__ballot(skip0))+__builtin_popcountll(__ballot(skip1));
    j0=__builtin_amdgcn_readfirstlane(j0); j0&=~1; if(j0>ntf-4)j0=ntf-4;
    attn_unit<THRL>(bh/NHEAD,bh%NHEAD,qb,T.Q,T.K,T.V,T.O,T.GT,T.G3,T.qgain,T.kbound,lds,tid_in,j0);
  }
}
#undef SBAR
#undef WAIT_BAR
#undef WAIT_BARW
}
constexpr int NWAVES = 8;
constexpr int BATCH = 2, T = 8192, D = 1024, H = 16, HD = 64, FF = 4096, M = BATCH * T;
constexpr int N1 = 3584, K1 = 2048, NP2 = 3072;
constexpr size_t MiB = 1u << 20;
constexpr size_t WS_MOD = 0;
constexpr size_t WS_W1 = 1 * MiB;
constexpr size_t WS_W2A = 29 * MiB;
constexpr size_t WS_W2G = 32 * MiB;
constexpr size_t WS_WO = 33 * MiB;
constexpr size_t WS_WKV = 37 * MiB;
constexpr size_t WS_WQG = 42 * MiB;
constexpr size_t WS_WO2 = 50 * MiB;
constexpr size_t WS_WUP = 54 * MiB, WS_WDN = 62 * MiB;
constexpr size_t WS_G3 = 70 * MiB;
constexpr size_t WS_FL = 74 * MiB;
constexpr size_t WS_H2 = 76 * MiB;
constexpr size_t WS_P1 = 140 * MiB;
constexpr size_t WS_P2 = 252 * MiB;
constexpr size_t WS_VF = 348 * MiB;
constexpr size_t WS_HB = 140 * MiB;
constexpr size_t WS_KVRAW = 140 * MiB, WS_QB = 204 * MiB, WS_GT = 236 * MiB, WS_VS = 316 * MiB, WS_KS = 348 * MiB;
constexpr size_t WS_END = 380 * MiB;
constexpr int LDS_BYTES = 147456;

#define GAS __attribute__((address_space(1)))
#define LAS __attribute__((address_space(3)))
typedef unsigned short bf16;
typedef unsigned v4u __attribute__((ext_vector_type(4)));
typedef unsigned v2u __attribute__((ext_vector_type(2)));
typedef float f32x4 __attribute__((ext_vector_type(4)));
using pg8::pkbf; using pg8::bflo; using pg8::bfhi; using pg8::sigm;

struct Args { const float* in[39]; float* out; unsigned char* ws; int ph_lo, ph_hi; };

struct Frame { LAS unsigned char* lds; int tid, lane, wave, vcu, G, bx; unsigned char* ws; float* out; const float* const* in; };

__device__ __forceinline__ void tr_item(const float* W, int ldw, int Nvalid, bf16* WT, int ldt, int row_off, int col_off, const float* mu, LAS float* scr, int item, int lane) {
    const int nblk = (Nvalid + 31) / 32, kb = item / nblk, nb = item % nblk, k0 = 64 * kb, n0 = 32 * nb;
    { float t[32]; const int n = n0 + (lane & 31); const bool ok = n < Nvalid; const float* wp = W + (size_t)(k0 + (lane >> 5)) * ldw + n;
#pragma unroll
      for (int i = 0; i < 32; ++i) t[i] = ok ? wp[(size_t)(2 * i) * ldw] : 0.f;
#pragma unroll
      for (int i = 0; i < 32; ++i) scr[(2 * i + (lane >> 5)) * 33 + (lane & 31)] = t[i]; }
    asm volatile("s_waitcnt lgkmcnt(0)" ::: "memory");
    const int c = lane & 7;
    float s0[8], s1[8];
#pragma unroll
    for (int q = 0; q < 8; ++q) { const float m = mu ? mu[k0 + 8 * c + q] : 0.f; s0[q] = 1.f - m; s1[q] = m; }
#pragma unroll
    for (int j = 0; j < 4; ++j) { const int n = (lane >> 3) + 8 * j; const LAS float* s = scr + (8 * c) * 33 + n;
        float v[8];
#pragma unroll
        for (int q = 0; q < 8; ++q) v[q] = s[q * 33];
        v4u o; o.x = pkbf(v[0] * s0[0], v[1] * s0[1]); o.y = pkbf(v[2] * s0[2], v[3] * s0[3]); o.z = pkbf(v[4] * s0[4], v[5] * s0[5]); o.w = pkbf(v[6] * s0[6], v[7] * s0[7]);
        bf16* dst = WT + (size_t)(row_off + n0 + n) * ldt + col_off + k0 + 8 * c;
        *(v4u*)dst = o;
        if (mu) { v4u p; p.x = pkbf(v[0] * s1[0], v[1] * s1[1]); p.y = pkbf(v[2] * s1[2], v[3] * s1[3]); p.z = pkbf(v[4] * s1[4], v[5] * s1[5]); p.w = pkbf(v[6] * s1[6], v[7] * s1[7]); *(v4u*)(dst + 1024) = p; } }
    asm volatile("s_waitcnt lgkmcnt(0)" ::: "memory");
}
__device__ __forceinline__ float dpp_f(float x, const int ctrl_sel) {
    switch (ctrl_sel) {
        case 0: return __builtin_bit_cast(float, __builtin_amdgcn_update_dpp(0, __builtin_bit_cast(int, x), 0xB1, 0xf, 0xf, false));
        case 1: return __builtin_bit_cast(float, __builtin_amdgcn_update_dpp(0, __builtin_bit_cast(int, x), 0x4E, 0xf, 0xf, false));
        case 2: return __builtin_bit_cast(float, __builtin_amdgcn_update_dpp(0, __builtin_bit_cast(int, x), 0x141, 0xf, 0xf, false));
        default: return __builtin_bit_cast(float, __builtin_amdgcn_update_dpp(0, __builtin_bit_cast(int, x), 0x140, 0xf, 0xf, false));
    }
}
__device__ __forceinline__ float sum4(float x) { x += dpp_f(x, 0); x += dpp_f(x, 1); return x; }
__device__ __forceinline__ float sum8(float x) { x = sum4(x); x += dpp_f(x, 2); return x; }
__device__ __forceinline__ float sum16(float x) { x = sum8(x); x += dpp_f(x, 3); return x; }
__device__ __forceinline__ float wave_sum(float v) {
    v = sum16(v);
    { auto rr = __builtin_amdgcn_permlane16_swap(__float_as_uint(v), __float_as_uint(v), false, false); v = __uint_as_float(rr[0]) + __uint_as_float(rr[1]); }
    { auto rr = __builtin_amdgcn_permlane32_swap(__float_as_uint(v), __float_as_uint(v), false, false); v = __uint_as_float(rr[0]) + __uint_as_float(rr[1]); }
    return v;
}
__device__ __forceinline__ void norm_row(const float* xrow, const float* g, const float* sh, const float* sc, int lane, f32x4 (&v)[4]) {
    float s = 0.f;
#pragma unroll
    for (int j = 0; j < 4; ++j) { v[j] = *((const f32x4*)xrow + lane + 64 * j); s += (v[j].x * v[j].x + v[j].y * v[j].y) + (v[j].z * v[j].z + v[j].w * v[j].w); }
    const float rstd = 1.0f / sqrtf(wave_sum(s) * (1.f / D) + 1e-6f);
#pragma unroll
    for (int j = 0; j < 4; ++j) { const f32x4 gg = *((const f32x4*)g + lane + 64 * j);
        f32x4 a = {1.f, 1.f, 1.f, 1.f}, b = {0.f, 0.f, 0.f, 0.f}; if (sc) { a = *((const f32x4*)sc + lane + 64 * j) + 1.0f; b = *((const f32x4*)sh + lane + 64 * j); }
        v[j] = (v[j] * rstd * gg) * a + b; }
}
__device__ __forceinline__ void st_row_bf16(bf16* orow, int lane, const f32x4 (&v)[4]) {
#pragma unroll
    for (int j = 0; j < 4; ++j) { v2u w; w.x = pkbf(v[j].x, v[j].y); w.y = pkbf(v[j].z, v[j].w); *((v2u*)orow + lane + 64 * j) = w; }
}
__device__ __forceinline__ void p0_mod(Frame& F) {
    LAS float* ca = (LAS float*)F.lds; LAS float* red = (LAS float*)(F.lds + 8192);
    const float* cin = F.in[1];
    for (int i = F.tid; i < 2048; i += 512) { const float c = cin[i]; ca[i] = c / (1.0f + __expf(-c)); }
    __syncthreads();
    float* MOD = (float*)(F.ws + WS_MOD); float* MODKV = MOD + 4 * 2 * 6144;
    for (int item = F.bx; item < 208; item += F.G) {
        const int col = item * 128; const float* W; const float* bias; int ldw, cw; float* dst0; float* dst1;
        if (col < 24576) { const int l = col / 6144; cw = col % 6144; W = F.in[2] + (size_t)l * 1024 * 6144; ldw = 6144; bias = F.in[3] + l * 6144; dst0 = MOD + (l * 2 + 0) * 6144 + cw; dst1 = MOD + (l * 2 + 1) * 6144 + cw; }
        else { cw = col - 24576; W = F.in[30]; ldw = 2048; bias = F.in[31]; dst0 = MODKV + cw; dst1 = MODKV + 2048 + cw; }
        const int c4 = F.tid & 31, ks = F.tid >> 5;
        f32x4 a0 = {0.f, 0.f, 0.f, 0.f}, a1 = {0.f, 0.f, 0.f, 0.f};
#pragma unroll 8
        for (int k = ks * 64; k < ks * 64 + 64; ++k) { const f32x4 w = *(const f32x4*)(W + (size_t)k * ldw + cw + c4 * 4); a0 += w * ca[k]; a1 += w * ca[1024 + k]; }
        *(LAS f32x4*)(red + (ks * 32 + c4) * 8) = a0; *(LAS f32x4*)(red + (ks * 32 + c4) * 8 + 4) = a1;
        __syncthreads();
        if (F.tid < 256) { const int b = F.tid >> 7, c = F.tid & 127; float s = 0.f;
#pragma unroll
            for (int q = 0; q < 16; ++q) s += red[(q * 32 + (c >> 2)) * 8 + b * 4 + (c & 3)];
            (b ? dst1 : dst0)[c] = s + bias[cw + c]; }
        __syncthreads();
    }
}
__device__ __forceinline__ void p0_weights(Frame& F) {
    LAS float* scr = (LAS float*)(F.lds + 16384 + F.wave * 16384);
    const int gw = F.vcu * NWAVES + F.wave, NGW = F.G * NWAVES;
    bf16* W1 = (bf16*)(F.ws + WS_W1); bf16* WO = (bf16*)(F.ws + WS_WO); bf16* WKV = (bf16*)(F.ws + WS_WKV); bf16* WQG = (bf16*)(F.ws + WS_WQG); bf16* WO2 = (bf16*)(F.ws + WS_WO2);
    const float* mu = F.in[8];
    constexpr int PL = 512 * 3 + 32 + 32 + 16 + 80 + 512;
    constexpr int NIT = 2 * PL + 512 + 512 + 16 + 2 * (1024 + 512);
    for (int it = gw; it < NIT; it += NGW) {
        int r = it;
        if (r < 2 * PL) { const int i = r / PL; r -= i * PL; bf16* w1 = W1 + (size_t)i * N1 * K1; const float* m6 = mu + i * 6 * 1024;
            bf16* wl = w1 + (size_t)3072 * 1024;
            if (r < 512) { tr_item(F.in[9] + (size_t)i * D * D, D, D, w1, D, 0, 0, nullptr, scr, r, F.lane); continue; } r -= 512;
            if (r < 512) { tr_item(F.in[10] + (size_t)i * D * D, D, D, w1, D, 1024, 0, nullptr, scr, r, F.lane); continue; } r -= 512;
            if (r < 512) { tr_item(F.in[11] + (size_t)i * D * D, D, D, w1, D, 2048, 0, nullptr, scr, r, F.lane); continue; } r -= 512;
            if (r < 32) { tr_item(F.in[14] + (size_t)i * D * 64, 64, 64, wl, K1, 0, 0, m6 + 1 * 1024, scr, r, F.lane); continue; } r -= 32;
            if (r < 32) { tr_item(F.in[17] + (size_t)i * D * 64, 64, 64, wl, K1, 64, 0, m6 + 4 * 1024, scr, r, F.lane); continue; } r -= 32;
            if (r < 16) { if (i == 1) tr_item(F.in[27], 32, 32, wl, K1, 128, 0, m6 + 3 * 1024, scr, r, F.lane); continue; } r -= 16;
            if (r < 80) { tr_item(F.in[19] + (size_t)i * D * 160, 160, 160, wl, K1, 160, 0, m6 + 5 * 1024, scr, r, F.lane); continue; } r -= 80;
            tr_item(F.in[12] + (size_t)i * D * D, D, D, WO + (size_t)i * D * D, D, 0, 0, nullptr, scr, r, F.lane); continue; }
        r -= 2 * PL;
        if (r < 512) { tr_item(F.in[32], 2064, 1024, WKV, D, 0, 0, nullptr, scr, r, F.lane); continue; } r -= 512;
        if (r < 512) { tr_item(F.in[32] + 1024, 2064, 1024, WKV, D, 1024, 0, nullptr, scr, r, F.lane); continue; } r -= 512;
        if (r < 16) { tr_item(F.in[32] + 2048, 2064, 16, WKV, D, 2048, 0, nullptr, scr, r, F.lane); continue; } r -= 16;
        { const int j = r / 1536; r -= j * 1536;
          if (r < 1024) tr_item(F.in[35] + (size_t)j * D * 2048, 2048, 2048, WQG + (size_t)j * 2048 * D, D, 0, 0, nullptr, scr, r, F.lane);
          else tr_item(F.in[37] + (size_t)j * D * D, D, D, WO2 + (size_t)j * D * D, D, 0, 0, nullptr, scr, r - 1024, F.lane); }
    }
    const int gt = F.bx * 512 + F.tid, NT = F.G * 512; const v4u z = {0u, 0u, 0u, 0u};
    for (int e = gt; e < 135168; e += NT) {
        int r = e; bf16* p;
        if (r < 98304) { const int i = r / 49152; r -= i * 49152; p = W1 + (size_t)i * N1 * K1 + (size_t)3072 * 1024 + (size_t)320 * K1 + (size_t)r * 8; }
        else if (r < 98304 + 8192) { r -= 98304; p = W1 + (size_t)3072 * 1024 + (size_t)128 * K1 + (size_t)r * 8; }
        else { r -= 98304 + 8192; p = WKV + (size_t)2080 * D + (size_t)r * 8; }
        *(v4u*)p = z; }
    { float* B2 = (float*)(F.ws + WS_MOD) + 53248;
      for (int e = gt; e < 2 * 3072; e += NT) { const int i = e / 3072, n = e % 3072, grp = n >> 10, c = n & 1023;
          B2[e] = grp == 0 ? F.in[13][i * D + c] : (grp == 1 ? F.in[16][i * D + c] : (i == 1 ? F.in[26][c] : 0.f)); } }
    bf16* W2A = (bf16*)(F.ws + WS_W2A); bf16* W2G = (bf16*)(F.ws + WS_W2G);
    for (int e4 = gt; e4 < 2 * 262144; e4 += NT) {
        const int i = e4 >> 18; int r = (e4 & 262143) * 4;
        if (r < 786432) { const int k = r / 3072, n = r % 3072, grp = n >> 10, c = n & 1023; f32x4 v = {0.f, 0.f, 0.f, 0.f};
            if (grp == 0) { if (k < 64) v = *(const f32x4*)(F.in[15] + ((size_t)i * 64 + k) * 1024 + c); }
            else if (grp == 1) { if (k >= 64 && k < 128) v = *(const f32x4*)(F.in[18] + ((size_t)i * 64 + (k - 64)) * 1024 + c); }
            else { if (i == 1 && k >= 128 && k < 160) v = *(const f32x4*)(F.in[28] + (size_t)(k - 128) * 1024 + c); }
            bf16* o = W2A + (size_t)i * 3072 * 256 + (size_t)n * 256 + k; const unsigned p0 = pkbf(v.x, v.y), p1 = pkbf(v.z, v.w);
            o[0] = (bf16)(p0 & 0xffffu); o[256] = (bf16)(p0 >> 16); o[512] = (bf16)(p1 & 0xffffu); o[768] = (bf16)(p1 >> 16); }
        else { r -= 786432; const int k = r >> 10, n = r & 1023; f32x4 v = {0.f, 0.f, 0.f, 0.f}; if (k < 160) v = *(const f32x4*)(F.in[20] + ((size_t)i * 160 + k) * 1024 + n);
            bf16* o = W2G + (size_t)i * 1024 * 256 + (size_t)n * 256 + k; const unsigned p0 = pkbf(v.x, v.y), p1 = pkbf(v.z, v.w);
            o[0] = (bf16)(p0 & 0xffffu); o[256] = (bf16)(p0 >> 16); o[512] = (bf16)(p1 & 0xffffu); o[768] = (bf16)(p1 >> 16); }
    }
}
__device__ __forceinline__ void mlp_weights(Frame& F, int L) {
    LAS float* scr = (LAS float*)(F.lds + F.wave * 16384);
    const int gw = F.vcu * NWAVES + F.wave, NGW = F.G * NWAVES;
    bf16* WUP = (bf16*)(F.ws + WS_WUP); bf16* WDN = (bf16*)(F.ws + WS_WDN);
    for (int it = gw; it < 4096; it += NGW) {
        if (it < 2048) tr_item(F.in[6] + (size_t)L * D * FF, FF, FF, WUP, D, 0, 0, nullptr, scr, it, F.lane);
        else tr_item(F.in[7] + (size_t)L * FF * D, D, D, WDN, FF, 0, 0, nullptr, scr, it - 2048, F.lane);
    }
}
__device__ __forceinline__ void norm_phase(Frame& F, const float* xin, const float* g, const float* sh, const float* sc, int bstride, int mode, bf16* dst, float* outf = nullptr) {
    const int gw = F.vcu * NWAVES + F.wave, NGW = F.G * NWAVES, lane = F.lane; (void)mode;
    for (int base = gw * 8; base < M; base += NGW * 8) {
        const int b = base >> 13;
        f32x4 gg[4], aa[4], bb[4];
#pragma unroll
        for (int j = 0; j < 4; ++j) { gg[j] = *((const f32x4*)g + lane + 64 * j);
            aa[j] = sc ? *((const f32x4*)(sc + b * bstride) + lane + 64 * j) + 1.0f : (f32x4){1.f, 1.f, 1.f, 1.f}; bb[j] = sh ? *((const f32x4*)(sh + b * bstride) + lane + 64 * j) : (f32x4){0.f, 0.f, 0.f, 0.f}; }
        f32x4 xn[4];
#pragma unroll
        for (int j = 0; j < 4; ++j) xn[j] = *((const f32x4*)(xin + (size_t)base * D) + lane + 64 * j);
#pragma unroll 1
        for (int r = 0; r < 8; ++r) { const int m = base + r; f32x4 v[4]; float s = 0.f;
#pragma unroll
            for (int j = 0; j < 4; ++j) { v[j] = xn[j]; s += (v[j].x * v[j].x + v[j].y * v[j].y) + (v[j].z * v[j].z + v[j].w * v[j].w); }
            if (r + 1 < 8) {
#pragma unroll
                for (int j = 0; j < 4; ++j) xn[j] = *((const f32x4*)(xin + (size_t)(m + 1) * D) + lane + 64 * j); }
            const float rstd = 1.0f / sqrtf(wave_sum(s) * (1.f / D) + 1e-6f);
#pragma unroll
            for (int j = 0; j < 4; ++j) v[j] = (v[j] * rstd * gg[j]) * aa[j] + bb[j];
            if (outf) {
#pragma unroll
                for (int j = 0; j < 4; ++j) *((f32x4*)(outf + (size_t)m * D) + lane + 64 * j) = v[j]; }
            else st_row_bf16(dst + (size_t)m * 1024, lane, v);
        }
    }
}
__device__ __forceinline__ void norm_mix_phase(Frame& F, const float* xin, const float* g, const float* sh, const float* sc, const float* mu, bf16* H2p, bf16* XJ) {
    const int gw = F.vcu * NWAVES + F.wave, NGW = F.G * NWAVES, lane = F.lane;
    for (int base = gw * 8; base < M; base += NGW * 8) {
        const int b = base >> 13;
        f32x4 gg[4], aa[4], bb[4], m0[4], m1[4], m2[4];
#pragma unroll
        for (int j = 0; j < 4; ++j) { gg[j] = *((const f32x4*)g + lane + 64 * j); aa[j] = *((const f32x4*)(sc + b * 6144) + lane + 64 * j) + 1.0f; bb[j] = *((const f32x4*)(sh + b * 6144) + lane + 64 * j);
            m0[j] = *((const f32x4*)mu + lane + 64 * j); m1[j] = *((const f32x4*)(mu + 2048) + lane + 64 * j); m2[j] = *((const f32x4*)(mu + 3072) + lane + 64 * j); }
        const bool first = (base & 8191) == 0; const int r0 = first ? 0 : -1;
        f32x4 hp[4], xn[4];
#pragma unroll
        for (int j = 0; j < 4; ++j) { hp[j] = (f32x4){0.f, 0.f, 0.f, 0.f}; xn[j] = *((const f32x4*)(xin + (size_t)(base + r0) * D) + lane + 64 * j); }
#pragma unroll 1
        for (int r = r0; r < 8; ++r) { const int m = base + r; f32x4 v[4];
            float s = 0.f;
#pragma unroll
            for (int j = 0; j < 4; ++j) { v[j] = xn[j]; s += (v[j].x * v[j].x + v[j].y * v[j].y) + (v[j].z * v[j].z + v[j].w * v[j].w); }
            if (r + 1 < 8) {
#pragma unroll
                for (int j = 0; j < 4; ++j) xn[j] = *((const f32x4*)(xin + (size_t)(m + 1) * D) + lane + 64 * j); }
            const float rstd = 1.0f / sqrtf(wave_sum(s) * (1.f / D) + 1e-6f);
#pragma unroll
            for (int j = 0; j < 4; ++j) v[j] = (v[j] * rstd * gg[j]) * aa[j] + bb[j];
            if (r >= 0) {
                st_row_bf16(H2p + (size_t)m * 2048, lane, v); st_row_bf16(H2p + (size_t)m * 2048 + 1024, lane, hp);
                f32x4 x[4];
#pragma unroll
                for (int j = 0; j < 4; ++j) x[j] = v[j] + (hp[j] - v[j]) * m0[j];
                st_row_bf16(XJ + (size_t)m * D, lane, x);
#pragma unroll
                for (int j = 0; j < 4; ++j) x[j] = v[j] + (hp[j] - v[j]) * m1[j];
                st_row_bf16(XJ + (size_t)M * D + (size_t)m * D, lane, x);
#pragma unroll
                for (int j = 0; j < 4; ++j) x[j] = v[j] + (hp[j] - v[j]) * m2[j];
                st_row_bf16(XJ + (size_t)2 * M * D + (size_t)m * D, lane, x);
            }
#pragma unroll
            for (int j = 0; j < 4; ++j) hp[j] = v[j]; }
    }
}
__device__ __forceinline__ void final_norm_phase(Frame& F) { norm_phase(F, F.out, F.in[38], nullptr, nullptr, 0, 1, nullptr, F.out); }
#ifndef PROBE_SC
#define PROBE_SC 0
#endif
constexpr int SC_C = 32, SC_NC = T / SC_C;
constexpr int SC_VEC = 0, SC_REC = 36864, SC_Y = 38912, SC_BUF = 55296;
typedef float f32x2s __attribute__((ext_vector_type(2)));
__device__ __forceinline__ float dot4(const f32x4 s, const f32x4 a) { f32x2s t = (f32x2s){s.x, s.y} * (f32x2s){a.x, a.y}; t = (f32x2s){s.z, s.w} * (f32x2s){a.z, a.w} + t; return t.x + t.y; }
__device__ __forceinline__ void scan_chunk(const LAS unsigned char* Bc, f32x4& S, const int kq, const int rowi) {
                const LAS f32x4* pvec = (const LAS f32x4*)(Bc + SC_VEC) + kq; const LAS f32x4* prec = (const LAS f32x4*)(Bc + SC_REC) + rowi;
                LAS float* py = (LAS float*)(Bc + SC_Y) + rowi * 16 + kq;
                f32x4 cv[9], cs;
#pragma unroll
                for (int j = 0; j < 9; ++j) cv[j] = pvec[j * 16];
                cs = prec[0];
#pragma unroll
                for (int p = 0; p < SC_C / 2; ++p) {
                    f32x4 nv[9], ns;
                    if (p + 1 < SC_C / 2) {
#pragma unroll
                        for (int j = 0; j < 9; ++j) nv[j] = pvec[((p + 1) * 9 + j) * 16];
                        ns = prec[(p + 1) * 8];
                    }
                    __builtin_amdgcn_sched_barrier(0);
                    float p1 = dot4(S, cv[0]), p2 = dot4(S, cv[1]); const float p3 = dot4(S, cv[2]);
                    p1 += dpp_f(p1, 0); p2 += dpp_f(p2, 0);
                    p1 += dpp_f(p1, 1); p2 += dpp_f(p2, 1);
                    p1 += dpp_f(p1, 2); p2 += dpp_f(p2, 2);
                    p1 += dpp_f(p1, 3); p2 += dpp_f(p2, 3);
                    const float sa1 = fmaf(cs.x, cs.z, p2);
                    const float y0 = p3 + ((kq == 0) ? cs.x * cs.w : 0.f);
                    const f32x4 t0 = S * cv[3] + cv[4] * p1 + cv[5] * cs.x + cv[7] * cs.y;
                    S = t0 + cv[6] * sa1;
                    const float y1 = dot4(S, cv[8]);
                    py[(2 * p) * 128] = y0; py[(2 * p + 1) * 128] = y1;
                    if (p + 1 < SC_C / 2) {
#pragma unroll
                        for (int j = 0; j < 9; ++j) cv[j] = nv[j];
                        cs = ns;
                    }
                }
}
__device__ __forceinline__ void scan_phase(Frame& F, int L) {
    const bf16* P1 = (const bf16*)(F.ws + WS_P1); const bf16* P2 = (const bf16*)(F.ws + WS_P2); const bf16* VF = (const bf16*)(F.ws + WS_VF); float* Y = (float*)(F.ws + WS_H2);
    const float* kkw = F.in[21] + L * D; const float* kaw = F.in[22] + L * D;
    const int lane = F.lane;
    int wave;
    { LAS unsigned* tb = (LAS unsigned*)(F.lds + LDS_BYTES - 2048);
      const unsigned simd = ((unsigned)__builtin_amdgcn_s_getreg((1 << 11) | (4 << 6) | 4)) & 3u;
      if (lane == 0) tb[F.wave] = simd;
      __syncthreads();
      unsigned sd[8];
#pragma unroll
      for (int w = 0; w < 8; ++w) sd[w] = tb[w];
      int B = 1;
#pragma unroll
      for (int w = 7; w >= 1; --w) if (sd[w] != sd[0]) B = w;
      int total_non = 0, non_before = 0, share_before = 0; bool my_share = false;
#pragma unroll
      for (int w = 1; w < 8; ++w) { const bool sh = (sd[w] == sd[0]) || (sd[w] == sd[B]); const bool other = (w != B);
          if (other && !sh) { ++total_non; if (w < F.wave) ++non_before; }
          if (other && sh && w < F.wave) ++share_before;
          if (w == F.wave) my_share = sh; }
      int role;
      if (F.wave == 0) role = 0; else if (F.wave == B) role = 1; else role = my_share ? (2 + total_non + share_before) : (2 + non_before);
      wave = __builtin_amdgcn_readfirstlane(role);
      __syncthreads(); }
    for (int item = F.bx; item < 256; item += F.G) {
        const int bh = (item & 7) + 8 * (item >> 6), rg = (item >> 3) & 7, b = bh >> 4, h = bh & 15;
        const size_t m0 = (size_t)b * T;
        const int hidx = (wave - 2) * 64 + lane, hp = (hidx >> 4) & 15, hc4 = hidx & 15;
        const int vtt = lane >> 1, vr4 = (lane & 1) * 4;
        float ckk[4], cka[4];
        v2u lr[2][2], lk[2][2], lw[2][2], la[2][2]; v2u lv[2], lvm[2], lvf[2];
#pragma unroll
        for (int q = 0; q < 2; ++q) { lv[q] = (v2u){0u,0u}; lvm[q] = (v2u){0u,0u}; lvf[q] = (v2u){0u,0u};
#pragma unroll
            for (int u = 0; u < 2; ++u) { lr[q][u] = (v2u){0u,0u}; lk[q][u] = (v2u){0u,0u}; lw[q][u] = (v2u){0u,0u}; la[q][u] = (v2u){0u,0u}; } }
        if (wave >= 2 && wave < 6) {
#pragma unroll
            for (int j = 0; j < 4; ++j) { ckk[j] = kkw[h * 64 + hc4 * 4 + j]; cka[j] = kaw[h * 64 + hc4 * 4 + j]; } }
#define SC_LOAD(c, Q) do { \
        if (wave >= 2 && wave < 6) { _Pragma("unroll") for (int u = 0; u < 2; ++u) { const size_t m = m0 + (size_t)(c) * SC_C + 2 * hp + u; const bf16* p1 = P1 + m * N1 + h * 64 + hc4 * 4; const bf16* p2 = P2 + m * NP2 + h * 64 + hc4 * 4; \
            lr[Q][u] = *(const v2u*)p1; lk[Q][u] = *(const v2u*)(p1 + 1024); lw[Q][u] = *(const v2u*)p2; la[Q][u] = *(const v2u*)(p2 + 1024); } } \
        else if (wave == 6) { const size_t m = m0 + (size_t)(c) * SC_C + vtt; const int cc = h * 64 + rg * 8 + vr4; \
            lv[Q] = *(const v2u*)(P1 + m * N1 + 2048 + cc); if (L == 1) { lvm[Q] = *(const v2u*)(P2 + m * NP2 + 2048 + cc); lvf[Q] = *(const v2u*)(VF + m * D + cc); } } } while (0)
#define SC_PREP(buf, Q) do { LAS unsigned char* B_ = F.lds + (buf) * SC_BUF; \
        if (wave >= 2 && wave < 6) { f32x4 an[2], bb[2], k2[2], ww[2], rr[2]; \
            _Pragma("unroll") for (int u = 0; u < 2; ++u) { \
                const float kr[4] = {bflo(lk[Q][u].x), bfhi(lk[Q][u].x), bflo(lk[Q][u].y), bfhi(lk[Q][u].y)}, av[4] = {bflo(la[Q][u].x), bfhi(la[Q][u].x), bflo(la[Q][u].y), bfhi(la[Q][u].y)}; \
                const float wn[4] = {bflo(lw[Q][u].x), bfhi(lw[Q][u].x), bflo(lw[Q][u].y), bfhi(lw[Q][u].y)}, rv[4] = {bflo(lr[Q][u].x), bfhi(lr[Q][u].x), bflo(lr[Q][u].y), bfhi(lr[Q][u].y)}; \
                float kv_[4], ss = 0.f; \
                _Pragma("unroll") for (int j = 0; j < 4; ++j) { kv_[j] = kr[j] * ckk[j]; ss += kv_[j] * kv_[j]; } \
                ss = sum16(ss); const float inv = 1.0f / fmaxf(sqrtf(ss), 1e-12f); \
                _Pragma("unroll") for (int j = 0; j < 4; ++j) { const float kk = kv_[j] * inv; an[u][j] = -kk; bb[u][j] = kk * av[j]; k2[u][j] = kr[j] * (1.0f + (av[j] - 1.0f) * cka[j]); ww[u][j] = __expf(wn[j]); rr[u][j] = rv[j]; } } \
            LAS f32x4* V_ = (LAS f32x4*)(B_ + SC_VEC) + (hp * 9) * 16 + hc4; \
            float s0 = dot4(bb[0], rr[0]), s1 = dot4(k2[0], rr[0]), s2 = dot4(bb[0], an[1]), s3 = dot4(k2[0], an[1]); \
            s0 = sum16(s0); s1 = sum16(s1); s2 = sum16(s2); s3 = sum16(s3); \
            V_[0 * 16] = an[0]; V_[1 * 16] = ww[0] * an[1] + an[0] * s2; V_[2 * 16] = ww[0] * rr[0] + an[0] * s0; V_[3 * 16] = ww[0] * ww[1]; V_[4 * 16] = bb[0] * ww[1]; V_[5 * 16] = k2[0] * ww[1]; V_[6 * 16] = bb[1]; V_[7 * 16] = k2[1]; V_[8 * 16] = rr[1]; \
            if (hc4 == 0) { _Pragma("unroll") for (int row_ = 0; row_ < 8; ++row_) *(LAS f32x2s*)(B_ + SC_REC + (hp * 8 + row_) * 16 + 8) = (f32x2s){s3, s1}; } } \
        else if (wave == 6) { float v_[4] = {bflo(lv[Q].x), bfhi(lv[Q].x), bflo(lv[Q].y), bfhi(lv[Q].y)}; \
            if (L == 1) { const float f_[4] = {bflo(lvf[Q].x), bfhi(lvf[Q].x), bflo(lvf[Q].y), bfhi(lvf[Q].y)}, g_[4] = {bflo(lvm[Q].x), bfhi(lvm[Q].x), bflo(lvm[Q].y), bfhi(lvm[Q].y)}; \
                _Pragma("unroll") for (int j = 0; j < 4; ++j) v_[j] = v_[j] + (f_[j] - v_[j]) * g_[j]; } \
            _Pragma("unroll") for (int j = 0; j < 4; ++j) *(LAS float*)(B_ + SC_REC + ((vtt >> 1) * 8 + vr4 + j) * 16 + (vtt & 1) * 4) = v_[j]; } } while (0)
#define SC_YRED(bufi) f32x4 yv; do { const LAS f32x4* q_ = (const LAS f32x4*)(F.lds + (bufi) * SC_BUF + SC_Y) + (vtt * 8 + vr4) * 4; \
            _Pragma("unroll") for (int r_ = 0; r_ < 4; ++r_) { const f32x4 t0 = q_[r_ * 4], t1 = q_[r_ * 4 + 1], t2 = q_[r_ * 4 + 2], t3 = q_[r_ * 4 + 3]; const f32x4 t = (t0 + t1) + (t2 + t3); yv[r_] = (t.x + t.y) + (t.z + t.w); } } while (0)
        SC_LOAD(0, 0); SC_PREP(0, 0); SC_LOAD(1, 1);
        __syncthreads();
        f32x4 S = {0.f, 0.f, 0.f, 0.f};
        const int rl = lane >> 4, kq = lane & 15, rowi = (wave & 1) * 4 + rl;
#define SC_ITER(c, QL, QP) do { const int buf = (c) & 1; \
            if (wave < 2) { if (PROBE_SC == 2) { f32x4 S2 = S; scan_chunk(F.lds + buf * SC_BUF, S2, kq, rowi); asm volatile("" :: "v"(S2) : "memory"); } scan_chunk(F.lds + buf * SC_BUF, S, kq, rowi); } \
            else { if ((c) + 2 < SC_NC) SC_LOAD((c) + 2, QL); \
                if ((c) + 1 < SC_NC) SC_PREP(buf ^ 1, QP); \
                if (PROBE_SC == 1 && (c) + 1 < SC_NC) { asm volatile("" ::: "memory"); SC_PREP(buf ^ 1, QP); } \
                if (wave == 7 && (c) > 0) { SC_YRED(buf ^ 1); *(f32x4*)(Y + (m0 + (size_t)((c) - 1) * SC_C + vtt) * D + h * 64 + rg * 8 + vr4) = yv; } } \
            asm volatile("s_waitcnt lgkmcnt(0)\n\ts_barrier" ::: "memory"); } while (0)
        for (int c = 0; c < SC_NC; c += 2) { SC_ITER(c, 0, 1); SC_ITER(c + 1, 1, 0); }
#undef SC_ITER
        if (wave == 7) { SC_YRED((SC_NC - 1) & 1);
            *(f32x4*)(Y + (m0 + (size_t)(SC_NC - 1) * SC_C + vtt) * D + h * 64 + rg * 8 + vr4) = yv; }
        __syncthreads();
#undef SC_LOAD
#undef SC_PREP
#undef SC_YRED
    }
}
__device__ __forceinline__ void post_phase(Frame& F, int L) {
    const bf16* P1 = (const bf16*)(F.ws + WS_P1); const bf16* P2 = (const bf16*)(F.ws + WS_P2); bf16* VF = (bf16*)(F.ws + WS_VF); float* Y = (float*)(F.ws + WS_H2);
    const int gw = F.vcu * NWAVES + F.wave, NGW = F.G * NWAVES, lane = F.lane, c0 = lane * 16;
    const float* kaw = F.in[22] + L * D + c0; const float* rkw = F.in[23] + L * D + c0; const float* lnw = F.in[24] + L * D + c0; const float* lnb = F.in[25] + L * D + c0;
    for (int m = gw; m < M; m += NGW) {
        float y[16], r[16], k[16], v[16], a[16];
        const float* yp = Y + (size_t)m * D + c0;
#pragma unroll
        for (int q = 0; q < 4; ++q) { const f32x4 t = *(const f32x4*)(yp + 4 * q); y[4 * q] = t.x; y[4 * q + 1] = t.y; y[4 * q + 2] = t.z; y[4 * q + 3] = t.w; }
        const bf16* p1 = P1 + (size_t)m * N1 + c0; const bf16* p2 = P2 + (size_t)m * NP2 + c0;
        v4u rv[2], kv[2], vv[2], av[2];
#pragma unroll
        for (int q = 0; q < 2; ++q) { rv[q] = *(const v4u*)(p1 + 8 * q); kv[q] = *(const v4u*)(p1 + 1024 + 8 * q); vv[q] = *(const v4u*)(p1 + 2048 + 8 * q); av[q] = *(const v4u*)(p2 + 1024 + 8 * q); }
#pragma unroll
        for (int q = 0; q < 2; ++q)
#pragma unroll
            for (int j = 0; j < 4; ++j) { r[8 * q + 2 * j] = bflo(rv[q][j]); r[8 * q + 2 * j + 1] = bfhi(rv[q][j]); k[8 * q + 2 * j] = bflo(kv[q][j]); k[8 * q + 2 * j + 1] = bfhi(kv[q][j]);
                v[8 * q + 2 * j] = bflo(vv[q][j]); v[8 * q + 2 * j + 1] = bfhi(vv[q][j]); a[8 * q + 2 * j] = bflo(av[q][j]); a[8 * q + 2 * j + 1] = bfhi(av[q][j]); }
        if (L == 0) { *(v4u*)(VF + (size_t)m * D + c0) = vv[0]; *(v4u*)(VF + (size_t)m * D + c0 + 8) = vv[1]; }
        else { v4u fv[2], gv[2];
#pragma unroll
            for (int q = 0; q < 2; ++q) { fv[q] = *(const v4u*)(VF + (size_t)m * D + c0 + 8 * q); gv[q] = *(const v4u*)(p2 + 2048 + 8 * q); }
#pragma unroll
            for (int q = 0; q < 2; ++q)
#pragma unroll
                for (int j = 0; j < 4; ++j) { const float f0 = bflo(fv[q][j]), f1 = bfhi(fv[q][j]), g0 = bflo(gv[q][j]), g1 = bfhi(gv[q][j]);
                    v[8 * q + 2 * j] += (f0 - v[8 * q + 2 * j]) * g0; v[8 * q + 2 * j + 1] += (f1 - v[8 * q + 2 * j + 1]) * g1; } }
        float s = 0.f, bd = 0.f;
#pragma unroll
        for (int j = 0; j < 16; ++j) { s += y[j]; const float k2 = k[j] * (1.0f + (a[j] - 1.0f) * kaw[j]); bd += r[j] * k2 * rkw[j]; }
        s = sum4(s); bd = sum4(bd);
        const float mean = s * (1.0f / 64.0f); float q2 = 0.f;
#pragma unroll
        for (int j = 0; j < 16; ++j) { const float d = y[j] - mean; q2 += d * d; }
        q2 = sum4(q2);
        const float rstd = 1.0f / sqrtf(q2 * (1.0f / 64.0f) + 64e-5f);
        float o[16];
#pragma unroll
        for (int j = 0; j < 16; ++j) o[j] = (y[j] - mean) * rstd * lnw[j] + lnb[j] + bd * v[j];
        bf16* yn = (bf16*)(Y + (size_t)m * D) + c0;
        v4u w0, w1; w0.x = pkbf(o[0], o[1]); w0.y = pkbf(o[2], o[3]); w0.z = pkbf(o[4], o[5]); w0.w = pkbf(o[6], o[7]); w1.x = pkbf(o[8], o[9]); w1.y = pkbf(o[10], o[11]); w1.z = pkbf(o[12], o[13]); w1.w = pkbf(o[14], o[15]);
        *(v4u*)yn = w0; *(v4u*)(yn + 8) = w1;
    }
}
__device__ __forceinline__ void kvpost_phase(Frame& F) {
    const bf16* KV = (const bf16*)(F.ws + WS_KVRAW); bf16* KS = (bf16*)(F.ws + WS_KS); bf16* VS = (bf16*)(F.ws + WS_VS);
    const int gw = F.vcu * NWAVES + F.wave, NGW = F.G * NWAVES, lane = F.lane, c0 = lane * 16;
    const float* kg = F.in[34] + (c0 & 63);
    for (int m = gw; m < M; m += NGW) {
        const bf16* p = KV + (size_t)m * 2048 + c0; v4u kv[2], vv[2];
#pragma unroll
        for (int q = 0; q < 2; ++q) { kv[q] = *(const v4u*)(p + 8 * q); vv[q] = *(const v4u*)(p + 1024 + 8 * q); }
        float k[16], ss = 0.f;
#pragma unroll
        for (int q = 0; q < 2; ++q)
#pragma unroll
            for (int j = 0; j < 4; ++j) { k[8 * q + 2 * j] = bflo(kv[q][j]); k[8 * q + 2 * j + 1] = bfhi(kv[q][j]); }
#pragma unroll
        for (int j = 0; j < 16; ++j) ss += k[j] * k[j];
        ss = sum4(ss); const float rs = 1.0f / sqrtf(ss * (1.0f / 64.0f) + 1e-6f);
        v4u w0, w1;
        w0.x = pkbf(k[0] * rs * kg[0], k[1] * rs * kg[1]); w0.y = pkbf(k[2] * rs * kg[2], k[3] * rs * kg[3]); w0.z = pkbf(k[4] * rs * kg[4], k[5] * rs * kg[5]); w0.w = pkbf(k[6] * rs * kg[6], k[7] * rs * kg[7]);
        w1.x = pkbf(k[8] * rs * kg[8], k[9] * rs * kg[9]); w1.y = pkbf(k[10] * rs * kg[10], k[11] * rs * kg[11]); w1.z = pkbf(k[12] * rs * kg[12], k[13] * rs * kg[13]); w1.w = pkbf(k[14] * rs * kg[14], k[15] * rs * kg[15]);
        *(v4u*)(KS + (size_t)m * D + c0) = w0; *(v4u*)(KS + (size_t)m * D + c0 + 8) = w1;
        *(v4u*)(VS + (size_t)m * D + c0) = vv[0]; *(v4u*)(VS + (size_t)m * D + c0 + 8) = vv[1];
    }
    if (gw < 32) {
        const int bh = gw, b = bh >> 4, h = bh & 15; const float* FL = (const float*)(F.ws + WS_FL) + ((size_t)b * T + (size_t)lane * 128) * 16 + h; const float fb = F.in[33][h];
        v4u* G3 = (v4u*)(F.ws + WS_G3) + (size_t)bh * T + (size_t)lane * 128;
        float tot = 0.f;
#pragma unroll 8
        for (int i = 0; i < 128; ++i) { const float x = FL[(size_t)i * 16] + fb; tot += -(fmaxf(-x, 0.f) + log1pf(__expf(-fabsf(x)))); }
        float inc = tot;
#pragma unroll
        for (int o = 1; o < 64; o <<= 1) { const float n = __int_as_float(__builtin_amdgcn_ds_bpermute((lane - o) << 2, __float_as_int(inc))); if (lane >= o) inc += n; }
        float run = inc - tot;
#pragma unroll 8
        for (int i = 0; i < 128; ++i) { const float x = FL[(size_t)i * 16] + fb; run += -(fmaxf(-x, 0.f) + log1pf(__expf(-fabsf(x))));
            const float gv = -run * 1.4426950408889634f;
            const unsigned hi = pkbf(gv, 0.f) & 0xffffu; const float r1 = gv - __uint_as_float(hi << 16);
            const unsigned mid = pkbf(r1, 0.f) & 0xffffu; const float r2 = r1 - __uint_as_float(mid << 16);
            const unsigned lo = pkbf(r2, 0.f) & 0xffffu;
            G3[i] = (v4u){hi | (mid << 16), lo, 0u, 0u}; }
    }
}
constexpr size_t WS_BAR = 512 * 1024, BAR_BYTES = 16384; constexpr int MISC_OFF = LDS_BYTES - 1024;
#define RLX_AGENT __ATOMIC_RELAXED, __HIP_MEMORY_SCOPE_AGENT
#define LDS_WAIT() asm volatile("s_waitcnt lgkmcnt(0)" ::: "memory")
#define VM_WAIT() asm volatile("s_waitcnt vmcnt(0)" ::: "memory")
__device__ __forceinline__ unsigned long long rt() { return __builtin_amdgcn_s_memrealtime(); }
__device__ __forceinline__ unsigned f2bf(float f) { unsigned u = __builtin_bit_cast(unsigned, f); return (u + 0x7fffu + ((u >> 16) & 1u)) >> 16; }
__device__ __forceinline__ unsigned pk2(float lo, float hi) { return f2bf(lo) | (f2bf(hi) << 16); }

#define XB_TMO      128
#define XB_XCNT(j)  (256  + 64 * (j))
#define XB_XSUB(j)  (1280 + 64 * (j))
#define XB_XGEN(j)  (2304 + 64 * (j))
#define XB_TOP      3328
#define XB_TOPGEN   3392
#define XCD_BAR_WORDS 3456
#define XB_SPIN_CAP (1u << 18)

__device__ __forceinline__ unsigned xb_ld(unsigned* p)              { return __hip_atomic_load(p, __ATOMIC_RELAXED, __HIP_MEMORY_SCOPE_AGENT); }
__device__ __forceinline__ unsigned xb_add(unsigned* p, unsigned v) { return __hip_atomic_fetch_add(p, v, __ATOMIC_RELAXED, __HIP_MEMORY_SCOPE_AGENT); }
__device__ __forceinline__ unsigned xb_xcc_id() { return (unsigned)__builtin_amdgcn_s_getreg((3 << 11) | 20) & 0xFu; }
#define XB_SPIN(cond, bar) do { unsigned _sp = 0; while (cond) { __builtin_amdgcn_s_sleep(1); \
    if ((++_sp & 255u) == 0u) { if (xb_ld(&(bar)[XB_TMO])) break; if (_sp > XB_SPIN_CAP) { atomicAdd(&(bar)[XB_TMO], 1u); break; } } } } while (0)

struct XcdBarrier {
    unsigned* bar; unsigned x;
    volatile LAS unsigned* st;
};

__device__ __forceinline__ XcdBarrier xcd_barrier_post(unsigned* bar, volatile LAS unsigned* st, const int tid) {
    XcdBarrier b; b.bar = bar; b.x = xb_xcc_id(); b.st = st;
    if (tid == 0) (void)xb_add(&bar[XB_XCNT(b.x)], 1u);
    return b;
}
__device__ __forceinline__ void xcd_barrier_complete(unsigned* bar, unsigned x, unsigned& nloc, unsigned& nx) {
    const unsigned G = gridDim.x * gridDim.y * gridDim.z;
    unsigned sum, cnt, mine, sp = 0u;
    for (;;) {
        sum = 0u; cnt = 0u; mine = 0u;
#pragma unroll
        for (unsigned j = 0; j < 16; ++j) { const unsigned c = xb_ld(&bar[XB_XCNT(j)]); sum += c; cnt += (c > 0u) ? 1u : 0u; mine = (j == x) ? c : mine; }
        if (sum == G) break;
        __builtin_amdgcn_s_sleep(1);
        if ((++sp & 255u) == 0u) { if (xb_ld(&bar[XB_TMO])) break; if (sp > XB_SPIN_CAP) { atomicAdd(&bar[XB_TMO], 1u); break; } }
    }
    nloc = mine > 0u ? mine : 1u; nx = cnt > 0u ? cnt : 1u;
}

__device__ __forceinline__ void xcd_barrier(const XcdBarrier& b, const int tid) {
    asm volatile("s_waitcnt vmcnt(0)" ::: "memory");
    __syncthreads();
    if (tid == 0) {
        unsigned* bar = b.bar;
        __builtin_amdgcn_s_waitcnt(0);
        unsigned nloc = b.st[0], nx = b.st[1];
        if (nloc == 0u) { xcd_barrier_complete(bar, b.x, nloc, nx); b.st[0] = nloc; b.st[1] = nx; }
        const unsigned old = xb_add(&bar[XB_XSUB(b.x)], 1u);
        const unsigned gen = old / nloc;
        if (old + 1u == (gen + 1u) * nloc) {
            __builtin_amdgcn_fence(__ATOMIC_RELEASE, "agent");
            asm volatile("s_waitcnt vmcnt(0)" ::: "memory");
            const unsigned og = xb_add(&bar[XB_TOP], 1u);
            const unsigned tg = og / nx;
            if (og + 1u == (tg + 1u) * nx) xb_add(&bar[XB_TOPGEN], 1u);
            else XB_SPIN(xb_ld(&bar[XB_TOPGEN]) == tg, bar);
            __builtin_amdgcn_fence(__ATOMIC_ACQUIRE, "agent");
            xb_add(&bar[XB_XGEN(b.x)], 1u);
            asm volatile("s_waitcnt vmcnt(0)" ::: "memory");
        } else {
            XB_SPIN(xb_ld(&bar[XB_XGEN(b.x)]) == gen, bar);
            __builtin_amdgcn_fence(__ATOMIC_ACQUIRE, "agent");
            asm volatile("s_waitcnt vmcnt(0)" ::: "memory");
        }
    }
    __syncthreads();
}
#define GEMM_CALL(FN, Aptr, Bptr, Nn, Kk, LDA, LDB, ...) GEMM_CALL_G(FN, Aptr, Bptr, Nn, Kk, LDA, LDB, 0, 0, __VA_ARGS__)
#define GEMM_CALL_G(FN, Aptr, Bptr, Nn, Kk, LDA, LDB, AGRP, ASTEP, ...) GEMM_CALL_S(StaticOrder, FN, Aptr, Bptr, Nn, Kk, LDA, LDB, AGRP, ASTEP, __VA_ARGS__)
#define GEMM_CALL_S(ORD, FN, Aptr, Bptr, Nn, Kk, LDA, LDB, AGRP, ASTEP, ...) do { pg8::Gemm g_{(const pg8::bf16_t*)(Aptr), (const pg8::bf16_t*)(Bptr), M, (Nn), (Kk), (LDA), (LDB), (AGRP), (size_t)(ASTEP)}; pg8::ORD S_; S_.init(M, (Nn), F.G, F.bx); \
    pg8::Epi8<pg8::FN> E_{{__VA_ARGS__}}; pg8::gemm_phase<pg8::Epi8<pg8::FN>, pg8::ORD, true, true>(F.lds, g_, S_, E_, F.tid); } while (0)
constexpr int N_PHASES = 42;
__global__ void __launch_bounds__(NWAVES * 64, 2) yoco_fwd(Args args) {
    extern __shared__ __attribute__((aligned(16))) unsigned char lds[];
    cg::grid_group grid = cg::this_grid();
    Frame F;
    const int wave_s = __builtin_amdgcn_readfirstlane((int)threadIdx.x >> 6);
    F.lds = (LAS unsigned char*)lds; F.tid = threadIdx.x; F.lane = F.tid & 63; F.wave = wave_s;
    F.G = gridDim.x; F.bx = blockIdx.x; F.vcu = F.bx;
    F.ws = args.ws; F.out = args.out; F.in = args.in;
    unsigned char* ws = args.ws;
    const int lo = args.ph_lo, hi = args.ph_hi; const bool one = (hi - lo) > 1;
#define LAUNDER() do { int t_ = wave_s * 64 + (int)__builtin_amdgcn_mbcnt_hi(~0u, __builtin_amdgcn_mbcnt_lo(~0u, 0u)); asm volatile("" : "+v"(t_)); F.tid = t_; F.lane = t_ & 63; F.wave = __builtin_amdgcn_readfirstlane(t_ >> 6); \
        int z_ = 0; asm volatile("" : "+v"(z_)); z_ = __builtin_amdgcn_readfirstlane(z_); ws = args.ws + z_; F.ws = ws; F.in = args.in + z_; F.out = args.out + z_; F.bx = (int)blockIdx.x + z_; F.G = (int)gridDim.x + z_; F.vcu = (F.G % 8 == 0) ? (F.bx % 8) * (F.G / 8) + F.bx / 8 : F.bx; } while (0)
#define IN(k) (lo <= (k) && (k) < hi)
#ifndef PROBE_BAR
#define PROBE_BAR 0
#endif
#ifndef PROBE_PH
#define PROBE_PH (-1)
#endif
#define PHASE(k) if (IN(k)) for (int rep_ = 0; rep_ < (((k) == PROBE_PH) ? 2 : 1); ++rep_)
#define SEAM() do { if (one) { unsigned zz_ = 0u; asm volatile("" : "+v"(zz_)); const int st_ = wave_s * 64 + (int)__builtin_amdgcn_mbcnt_hi(~0u, __builtin_amdgcn_mbcnt_lo(~0u, zz_)); xcd_barrier(xbar, st_); if (PROBE_BAR) xcd_barrier(xbar, st_); } } while (0)
#define MOD_ ((float*)(ws + WS_MOD))
#define MODKV_ (MOD_ + 4 * 2 * 6144)
#define H2_ ((bf16*)(ws + WS_H2))
#define XN_ ((bf16*)(ws + WS_H2))
#define XNKV_ ((bf16*)(ws + WS_H2 + 32 * MiB))
#define P1_ ((bf16*)(ws + WS_P1))
#define P2_ ((bf16*)(ws + WS_P2))
#define HB_ ((bf16*)(ws + WS_HB))
#define QB_ ((bf16*)(ws + WS_QB))
#define GT_ ((bf16*)(ws + WS_GT))
#define XIN1_ ((L == 0) ? F.in[0] : (const float*)F.out)
#define MODL_ (MOD_ + L * 2 * 6144)

    volatile LAS unsigned* MISC = (volatile LAS unsigned*)(F.lds + MISC_OFF);
    if (F.tid < 32) MISC[F.tid] = 0u;
    __syncthreads();
    XcdBarrier xbar; xbar.bar = (unsigned*)(args.ws + WS_BAR); xbar.x = 0; xbar.st = MISC + 8;
    if (one) xbar = xcd_barrier_post((unsigned*)(args.ws + WS_BAR), MISC + 8, F.tid);
    PHASE(0) { LAUNDER(); p0_mod(F); p0_weights(F); if (one) grid.sync(); }
    { constexpr int L = 0;
        const int pb = 1 + L * 10;
        if (L < 2) {
            PHASE(pb + 0) { LAUNDER(); norm_mix_phase(F, XIN1_, F.in[4] + L * D, MODL_, MODL_ + 1024, F.in[8] + L * 6 * 1024, H2_, P2_); SEAM(); }
            PHASE(pb + 1) { LAUNDER(); GEMM_CALL(FnP1, H2_, ws + WS_W1 + (size_t)L * N1 * K1 * 2 + (size_t)3072 * 1024 * 2, 512, K1, K1, K1, P1_, 3072);
                LAUNDER();
                if (F.G == 256) GEMM_CALL_S(SplitOrder, FnP1, P2_, ws + WS_W1 + (size_t)L * N1 * K1 * 2, 3072, D, D, D, 4, (size_t)M * D * 2, P1_, 0);
                else GEMM_CALL_G(FnP1, P2_, ws + WS_W1 + (size_t)L * N1 * K1 * 2, 3072, D, D, D, 4, (size_t)M * D * 2, P1_, 0);
                SEAM(); }
            PHASE(pb + 2) { LAUNDER(); GEMM_CALL(FnP2, P1_ + 3072, ws + WS_W2A + (size_t)L * 3072 * 256 * 2, (L == 0 ? 2048 : NP2), 256, N1, 256, P2_, MOD_ + 53248 + L * 3072); SEAM(); }
            PHASE(pb + 3) { LAUNDER(); scan_phase(F, L); SEAM(); }
            PHASE(pb + 4) { LAUNDER(); post_phase(F, L); SEAM(); }
            PHASE(pb + 5) { LAUNDER(); GEMM_CALL(FnGate, P1_ + 3232, ws + WS_W2G + (size_t)L * 1024 * 256 * 2, D, 256, N1, 256, H2_, 2048); SEAM(); }
            PHASE(pb + 6) { LAUNDER(); GEMM_CALL(FnRes, H2_, ws + WS_WO + (size_t)L * D * D * 2, D, D, 2048, D, XIN1_, F.out, MODL_ + 2 * 1024); SEAM(); }
        } else {
            const int j = L - 2;
            PHASE(pb + 0) { LAUNDER(); norm_phase(F, F.out, F.in[4] + L * D, MODL_, MODL_ + 1024, 6144, 1, XN_);
                if (L == 2) norm_phase(F, F.out, F.in[29], MODKV_, MODKV_ + 1024, 2048, 1, XNKV_);
                SEAM(); }
            PHASE(pb + 1) { LAUNDER();
                if (L == 2) GEMM_CALL(FnKv, XNKV_, ws + WS_WKV, 2304, D, D, D, (bf16*)(ws + WS_KVRAW), (float*)(ws + WS_FL));
                LAUNDER();
                GEMM_CALL(FnQg, XN_, ws + WS_WQG + (size_t)j * 2048 * D * 2, 2048, D, D, D, QB_, GT_); SEAM(); }
            if (L == 2) PHASE(pb + 2) { LAUNDER(); kvpost_phase(F); SEAM(); }
            PHASE(pb + 3) { LAUNDER();
                float kb_; { float g_ = fabsf(F.in[34][F.lane]); g_ = fmaxf(g_, dpp_f(g_, 0)); g_ = fmaxf(g_, dpp_f(g_, 1)); g_ = fmaxf(g_, dpp_f(g_, 2)); g_ = fmaxf(g_, dpp_f(g_, 3));
                  { auto rr = __builtin_amdgcn_permlane16_swap(__float_as_uint(g_), __float_as_uint(g_), false, false); g_ = fmaxf(__uint_as_float(rr[0]), __uint_as_float(rr[1])); }
                  { auto rr = __builtin_amdgcn_permlane32_swap(__float_as_uint(g_), __float_as_uint(g_), false, false); g_ = fmaxf(__uint_as_float(rr[0]), __uint_as_float(rr[1])); }
                  kb_ = 8.0f * 1.02f * g_; }
                const attn_body::AttnTensors AT{(const attn_body::bf16*)QB_, (const attn_body::bf16*)(ws + WS_KS), (const attn_body::bf16*)(ws + WS_VS), (attn_body::bf16*)((PROBE_PH == pb + 3 && rep_ == 0) ? (bf16*)(ws + WS_KVRAW) : QB_), (const attn_body::bf16*)GT_, (const unsigned char*)(ws + WS_G3), F.in[36] + j * 64, kb_};
                float thr2_; { float g_ = fabsf(F.in[36][j * 64 + F.lane]); g_ = fmaxf(g_, dpp_f(g_, 0)); g_ = fmaxf(g_, dpp_f(g_, 1)); g_ = fmaxf(g_, dpp_f(g_, 2)); g_ = fmaxf(g_, dpp_f(g_, 3));
                  { auto rr = __builtin_amdgcn_permlane16_swap(__float_as_uint(g_), __float_as_uint(g_), false, false); g_ = fmaxf(__uint_as_float(rr[0]), __uint_as_float(rr[1])); }
                  { auto rr = __builtin_amdgcn_permlane32_swap(__float_as_uint(g_), __float_as_uint(g_), false, false); g_ = fmaxf(__uint_as_float(rr[0]), __uint_as_float(rr[1])); }
                  thr2_ = 64.0f + 2.0f * kb_ * attn_body::C2 * 8.16f * g_; }
                attn_body::attn_phase_dyn<8>((char*)lds, AT, (unsigned*)(ws + WS_BAR) + 3600 + j * 64, thr2_, F.tid);
                SEAM(); }
            PHASE(pb + 6) { LAUNDER(); GEMM_CALL(FnRes, QB_, ws + WS_WO2 + (size_t)j * D * D * 2, D, D, D, D, (const float*)F.out, F.out, MODL_ + 2 * 1024); SEAM(); }
        }
        PHASE(pb + 7) { LAUNDER(); mlp_weights(F, L); norm_phase(F, F.out, F.in[5] + L * D, MODL_ + 3 * 1024, MODL_ + 4 * 1024, 6144, 1, XN_); SEAM(); }
        PHASE(pb + 8) { LAUNDER(); GEMM_CALL(FnUp, XN_, ws + WS_WUP, FF, D, D, D, HB_); SEAM(); }
        PHASE(pb + 9) { LAUNDER(); GEMM_CALL(FnRes, HB_, ws + WS_WDN, D, FF, FF, FF, (const float*)F.out, F.out, MODL_ + 5 * 1024); SEAM(); }
        }
    { constexpr int L = 1;
        const int pb = 1 + L * 10;
        if (L < 2) {
            PHASE(pb + 0) { LAUNDER(); norm_mix_phase(F, XIN1_, F.in[4] + L * D, MODL_, MODL_ + 1024, F.in[8] + L * 6 * 1024, H2_, P2_); SEAM(); }
            PHASE(pb + 1) { LAUNDER(); GEMM_CALL(FnP1, H2_, ws + WS_W1 + (size_t)L * N1 * K1 * 2 + (size_t)3072 * 1024 * 2, 512, K1, K1, K1, P1_, 3072);
                LAUNDER();
                if (F.G == 256) GEMM_CALL_S(SplitOrder, FnP1, P2_, ws + WS_W1 + (size_t)L * N1 * K1 * 2, 3072, D, D, D, 4, (size_t)M * D * 2, P1_, 0);
                else GEMM_CALL_G(FnP1, P2_, ws + WS_W1 + (size_t)L * N1 * K1 * 2, 3072, D, D, D, 4, (size_t)M * D * 2, P1_, 0);
                SEAM(); }
            PHASE(pb + 2) { LAUNDER(); GEMM_CALL(FnP2, P1_ + 3072, ws + WS_W2A + (size_t)L * 3072 * 256 * 2, (L == 0 ? 2048 : NP2), 256, N1, 256, P2_, MOD_ + 53248 + L * 3072); SEAM(); }
            PHASE(pb + 3) { LAUNDER(); scan_phase(F, L); SEAM(); }
            PHASE(pb + 4) { LAUNDER(); post_phase(F, L); SEAM(); }
            PHASE(pb + 5) { LAUNDER(); GEMM_CALL(FnGate, P1_ + 3232, ws + WS_W2G + (size_t)L * 1024 * 256 * 2, D, 256, N1, 256, H2_, 2048); SEAM(); }
            PHASE(pb + 6) { LAUNDER(); GEMM_CALL(FnRes, H2_, ws + WS_WO + (size_t)L * D * D * 2, D, D, 2048, D, XIN1_, F.out, MODL_ + 2 * 1024); SEAM(); }
        } else {
            const int j = L - 2;
            PHASE(pb + 0) { LAUNDER(); norm_phase(F, F.out, F.in[4] + L * D, MODL_, MODL_ + 1024, 6144, 1, XN_);
                if (L == 2) norm_phase(F, F.out, F.in[29], MODKV_, MODKV_ + 1024, 2048, 1, XNKV_);
                SEAM(); }
            PHASE(pb + 1) { LAUNDER();
                if (L == 2) GEMM_CALL(FnKv, XNKV_, ws + WS_WKV, 2304, D, D, D, (bf16*)(ws + WS_KVRAW), (float*)(ws + WS_FL));
                LAUNDER();
                GEMM_CALL(FnQg, XN_, ws + WS_WQG + (size_t)j * 2048 * D * 2, 2048, D, D, D, QB_, GT_); SEAM(); }
            if (L == 2) PHASE(pb + 2) { LAUNDER(); kvpost_phase(F); SEAM(); }
            PHASE(pb + 3) { LAUNDER();
                float kb_; { float g_ = fabsf(F.in[34][F.lane]); g_ = fmaxf(g_, dpp_f(g_, 0)); g_ = fmaxf(g_, dpp_f(g_, 1)); g_ = fmaxf(g_, dpp_f(g_, 2)); g_ = fmaxf(g_, dpp_f(g_, 3));
                  { auto rr = __builtin_amdgcn_permlane16_swap(__float_as_uint(g_), __float_as_uint(g_), false, false); g_ = fmaxf(__uint_as_float(rr[0]), __uint_as_float(rr[1])); }
                  { auto rr = __builtin_amdgcn_permlane32_swap(__float_as_uint(g_), __float_as_uint(g_), false, false); g_ = fmaxf(__uint_as_float(rr[0]), __uint_as_float(rr[1])); }
                  kb_ = 8.0f * 1.02f * g_; }
                const attn_body::AttnTensors AT{(const attn_body::bf16*)QB_, (const attn_body::bf16*)(ws + WS_KS), (const attn_body::bf16*)(ws + WS_VS), (attn_body::bf16*)((PROBE_PH == pb + 3 && rep_ == 0) ? (bf16*)(ws + WS_KVRAW) : QB_), (const attn_body::bf16*)GT_, (const unsigned char*)(ws + WS_G3), F.in[36] + j * 64, kb_};
                float thr2_; { float g_ = fabsf(F.in[36][j * 64 + F.lane]); g_ = fmaxf(g_, dpp_f(g_, 0)); g_ = fmaxf(g_, dpp_f(g_, 1)); g_ = fmaxf(g_, dpp_f(g_, 2)); g_ = fmaxf(g_, dpp_f(g_, 3));
                  { auto rr = __builtin_amdgcn_permlane16_swap(__float_as_uint(g_), __float_as_uint(g_), false, false); g_ = fmaxf(__uint_as_float(rr[0]), __uint_as_float(rr[1])); }
                  { auto rr = __builtin_amdgcn_permlane32_swap(__float_as_uint(g_), __float_as_uint(g_), false, false); g_ = fmaxf(__uint_as_float(rr[0]), __uint_as_float(rr[1])); }
                  thr2_ = 64.0f + 2.0f * kb_ * attn_body::C2 * 8.16f * g_; }
                attn_body::attn_phase_dyn<8>((char*)lds, AT, (unsigned*)(ws + WS_BAR) + 3600 + j * 64, thr2_, F.tid);
                SEAM(); }
            PHASE(pb + 6) { LAUNDER(); GEMM_CALL(FnRes, QB_, ws + WS_WO2 + (size_t)j * D * D * 2, D, D, D, D, (const float*)F.out, F.out, MODL_ + 2 * 1024); SEAM(); }
        }
        PHASE(pb + 7) { LAUNDER(); mlp_weights(F, L); norm_phase(F, F.out, F.in[5] + L * D, MODL_ + 3 * 1024, MODL_ + 4 * 1024, 6144, 1, XN_); SEAM(); }
        PHASE(pb + 8) { LAUNDER(); GEMM_CALL(FnUp, XN_, ws + WS_WUP, FF, D, D, D, HB_); SEAM(); }
        PHASE(pb + 9) { LAUNDER(); GEMM_CALL(FnRes, HB_, ws + WS_WDN, D, FF, FF, FF, (const float*)F.out, F.out, MODL_ + 5 * 1024); SEAM(); }
        }
    { constexpr int L = 2;
        const int pb = 1 + L * 10;
        if (L < 2) {
            PHASE(pb + 0) { LAUNDER(); norm_mix_phase(F, XIN1_, F.in[4] + L * D, MODL_, MODL_ + 1024, F.in[8] + L * 6 * 1024, H2_, P2_); SEAM(); }
            PHASE(pb + 1) { LAUNDER(); GEMM_CALL(FnP1, H2_, ws + WS_W1 + (size_t)L * N1 * K1 * 2 + (size_t)3072 * 1024 * 2, 512, K1, K1, K1, P1_, 3072);
                LAUNDER();
                if (F.G == 256) GEMM_CALL_S(SplitOrder, FnP1, P2_, ws + WS_W1 + (size_t)L * N1 * K1 * 2, 3072, D, D, D, 4, (size_t)M * D * 2, P1_, 0);
                else GEMM_CALL_G(FnP1, P2_, ws + WS_W1 + (size_t)L * N1 * K1 * 2, 3072, D, D, D, 4, (size_t)M * D * 2, P1_, 0);
                SEAM(); }
            PHASE(pb + 2) { LAUNDER(); GEMM_CALL(FnP2, P1_ + 3072, ws + WS_W2A + (size_t)L * 3072 * 256 * 2, (L == 0 ? 2048 : NP2), 256, N1, 256, P2_, MOD_ + 53248 + L * 3072); SEAM(); }
            PHASE(pb + 3) { LAUNDER(); scan_phase(F, L); SEAM(); }
            PHASE(pb + 4) { LAUNDER(); post_phase(F, L); SEAM(); }
            PHASE(pb + 5) { LAUNDER(); GEMM_CALL(FnGate, P1_ + 3232, ws + WS_W2G + (size_t)L * 1024 * 256 * 2, D, 256, N1, 256, H2_, 2048); SEAM(); }
            PHASE(pb + 6) { LAUNDER(); GEMM_CALL(FnRes, H2_, ws + WS_WO + (size_t)L * D * D * 2, D, D, 2048, D, XIN1_, F.out, MODL_ + 2 * 1024); SEAM(); }
        } else {
            const int j = L - 2;
            PHASE(pb + 0) { LAUNDER(); norm_phase(F, F.out, F.in[4] + L * D, MODL_, MODL_ + 1024, 6144, 1, XN_);
                if (L == 2) norm_phase(F, F.out, F.in[29], MODKV_, MODKV_ + 1024, 2048, 1, XNKV_);
                SEAM(); }
            PHASE(pb + 1) { LAUNDER();
                if (L == 2) GEMM_CALL(FnKv, XNKV_, ws + WS_WKV, 2304, D, D, D, (bf16*)(ws + WS_KVRAW), (float*)(ws + WS_FL));
                LAUNDER();
                GEMM_CALL(FnQg, XN_, ws + WS_WQG + (size_t)j * 2048 * D * 2, 2048, D, D, D, QB_, GT_); SEAM(); }
            if (L == 2) PHASE(pb + 2) { LAUNDER(); kvpost_phase(F); SEAM(); }
            PHASE(pb + 3) { LAUNDER();
                float kb_; { float g_ = fabsf(F.in[34][F.lane]); g_ = fmaxf(g_, dpp_f(g_, 0)); g_ = fmaxf(g_, dpp_f(g_, 1)); g_ = fmaxf(g_, dpp_f(g_, 2)); g_ = fmaxf(g_, dpp_f(g_, 3));
                  { auto rr = __builtin_amdgcn_permlane16_swap(__float_as_uint(g_), __float_as_uint(g_), false, false); g_ = fmaxf(__uint_as_float(rr[0]), __uint_as_float(rr[1])); }
                  { auto rr = __builtin_amdgcn_permlane32_swap(__float_as_uint(g_), __float_as_uint(g_), false, false); g_ = fmaxf(__uint_as_float(rr[0]), __uint_as_float(rr[1])); }
                  kb_ = 8.0f * 1.02f * g_; }
                const attn_body::AttnTensors AT{(const attn_body::bf16*)QB_, (const attn_body::bf16*)(ws + WS_KS), (const attn_body::bf16*)(ws + WS_VS), (attn_body::bf16*)((PROBE_PH == pb + 3 && rep_ == 0) ? (bf16*)(ws + WS_KVRAW) : QB_), (const attn_body::bf16*)GT_, (const unsigned char*)(ws + WS_G3), F.in[36] + j * 64, kb_};
                float thr2_; { float g_ = fabsf(F.in[36][j * 64 + F.lane]); g_ = fmaxf(g_, dpp_f(g_, 0)); g_ = fmaxf(g_, dpp_f(g_, 1)); g_ = fmaxf(g_, dpp_f(g_, 2)); g_ = fmaxf(g_, dpp_f(g_, 3));
                  { auto rr = __builtin_amdgcn_permlane16_swap(__float_as_uint(g_), __float_as_uint(g_), false, false); g_ = fmaxf(__uint_as_float(rr[0]), __uint_as_float(rr[1])); }
                  { auto rr = __builtin_amdgcn_permlane32_swap(__float_as_uint(g_), __float_as_uint(g_), false, false); g_ = fmaxf(__uint_as_float(rr[0]), __uint_as_float(rr[1])); }
                  thr2_ = 64.0f + 2.0f * kb_ * attn_body::C2 * 8.16f * g_; }
                attn_body::attn_phase_dyn<8>((char*)lds, AT, (unsigned*)(ws + WS_BAR) + 3600 + j * 64, thr2_, F.tid);
                SEAM(); }
            PHASE(pb + 6) { LAUNDER(); GEMM_CALL(FnRes, QB_, ws + WS_WO2 + (size_t)j * D * D * 2, D, D, D, D, (const float*)F.out, F.out, MODL_ + 2 * 1024); SEAM(); }
        }
        PHASE(pb + 7) { LAUNDER(); mlp_weights(F, L); norm_phase(F, F.out, F.in[5] + L * D, MODL_ + 3 * 1024, MODL_ + 4 * 1024, 6144, 1, XN_); SEAM(); }
        PHASE(pb + 8) { LAUNDER(); GEMM_CALL(FnUp, XN_, ws + WS_WUP, FF, D, D, D, HB_); SEAM(); }
        PHASE(pb + 9) { LAUNDER(); GEMM_CALL(FnRes, HB_, ws + WS_WDN, D, FF, FF, FF, (const float*)F.out, F.out, MODL_ + 5 * 1024); SEAM(); }
        }
    { constexpr int L = 3;
        const int pb = 1 + L * 10;
        if (L < 2) {
            PHASE(pb + 0) { LAUNDER(); norm_mix_phase(F, XIN1_, F.in[4] + L * D, MODL_, MODL_ + 1024, F.in[8] + L * 6 * 1024, H2_, P2_); SEAM(); }
            PHASE(pb + 1) { LAUNDER(); GEMM_CALL(FnP1, H2_, ws + WS_W1 + (size_t)L * N1 * K1 * 2 + (size_t)3072 * 1024 * 2, 512, K1, K1, K1, P1_, 3072);
                LAUNDER();
                if (F.G == 256) GEMM_CALL_S(SplitOrder, FnP1, P2_, ws + WS_W1 + (size_t)L * N1 * K1 * 2, 3072, D, D, D, 4, (size_t)M * D * 2, P1_, 0);
                else GEMM_CALL_G(FnP1, P2_, ws + WS_W1 + (size_t)L * N1 * K1 * 2, 3072, D, D, D, 4, (size_t)M * D * 2, P1_, 0);
                SEAM(); }
            PHASE(pb + 2) { LAUNDER(); GEMM_CALL(FnP2, P1_ + 3072, ws + WS_W2A + (size_t)L * 3072 * 256 * 2, (L == 0 ? 2048 : NP2), 256, N1, 256, P2_, MOD_ + 53248 + L * 3072); SEAM(); }
            PHASE(pb + 3) { LAUNDER(); scan_phase(F, L); SEAM(); }
            PHASE(pb + 4) { LAUNDER(); post_phase(F, L); SEAM(); }
            PHASE(pb + 5) { LAUNDER(); GEMM_CALL(FnGate, P1_ + 3232, ws + WS_W2G + (size_t)L * 1024 * 256 * 2, D, 256, N1, 256, H2_, 2048); SEAM(); }
            PHASE(pb + 6) { LAUNDER(); GEMM_CALL(FnRes, H2_, ws + WS_WO + (size_t)L * D * D * 2, D, D, 2048, D, XIN1_, F.out, MODL_ + 2 * 1024); SEAM(); }
        } else {
            const int j = L - 2;
            PHASE(pb + 0) { LAUNDER(); norm_phase(F, F.out, F.in[4] + L * D, MODL_, MODL_ + 1024, 6144, 1, XN_);
                if (L == 2) norm_phase(F, F.out, F.in[29], MODKV_, MODKV_ + 1024, 2048, 1, XNKV_);
                SEAM(); }
            PHASE(pb + 1) { LAUNDER();
                if (L == 2) GEMM_CALL(FnKv, XNKV_, ws + WS_WKV, 2304, D, D, D, (bf16*)(ws + WS_KVRAW), (float*)(ws + WS_FL));
                LAUNDER();
                GEMM_CALL(FnQg, XN_, ws + WS_WQG + (size_t)j * 2048 * D * 2, 2048, D, D, D, QB_, GT_); SEAM(); }
            if (L == 2) PHASE(pb + 2) { LAUNDER(); kvpost_phase(F); SEAM(); }
            PHASE(pb + 3) { LAUNDER();
                float kb_; { float g_ = fabsf(F.in[34][F.lane]); g_ = fmaxf(g_, dpp_f(g_, 0)); g_ = fmaxf(g_, dpp_f(g_, 1)); g_ = fmaxf(g_, dpp_f(g_, 2)); g_ = fmaxf(g_, dpp_f(g_, 3));
                  { auto rr = __builtin_amdgcn_permlane16_swap(__float_as_uint(g_), __float_as_uint(g_), false, false); g_ = fmaxf(__uint_as_float(rr[0]), __uint_as_float(rr[1])); }
                  { auto rr = __builtin_amdgcn_permlane32_swap(__float_as_uint(g_), __float_as_uint(g_), false, false); g_ = fmaxf(__uint_as_float(rr[0]), __uint_as_float(rr[1])); }
                  kb_ = 8.0f * 1.02f * g_; }
                const attn_body::AttnTensors AT{(const attn_body::bf16*)QB_, (const attn_body::bf16*)(ws + WS_KS), (const attn_body::bf16*)(ws + WS_VS), (attn_body::bf16*)((PROBE_PH == pb + 3 && rep_ == 0) ? (bf16*)(ws + WS_KVRAW) : QB_), (const attn_body::bf16*)GT_, (const unsigned char*)(ws + WS_G3), F.in[36] + j * 64, kb_};
                float thr2_; { float g_ = fabsf(F.in[36][j * 64 + F.lane]); g_ = fmaxf(g_, dpp_f(g_, 0)); g_ = fmaxf(g_, dpp_f(g_, 1)); g_ = fmaxf(g_, dpp_f(g_, 2)); g_ = fmaxf(g_, dpp_f(g_, 3));
                  { auto rr = __builtin_amdgcn_permlane16_swap(__float_as_uint(g_), __float_as_uint(g_), false, false); g_ = fmaxf(__uint_as_float(rr[0]), __uint_as_float(rr[1])); }
                  { auto rr = __builtin_amdgcn_permlane32_swap(__float_as_uint(g_), __float_as_uint(g_), false, false); g_ = fmaxf(__uint_as_float(rr[0]), __uint_as_float(rr[1])); }
                  thr2_ = 64.0f + 2.0f * kb_ * attn_body::C2 * 8.16f * g_; }
                attn_body::attn_phase_dyn<8>((char*)lds, AT, (unsigned*)(ws + WS_BAR) + 3600 + j * 64, thr2_, F.tid);
                SEAM(); }
            PHASE(pb + 6) { LAUNDER(); GEMM_CALL(FnRes, QB_, ws + WS_WO2 + (size_t)j * D * D * 2, D, D, D, D, (const float*)F.out, F.out, MODL_ + 2 * 1024); SEAM(); }
        }
        PHASE(pb + 7) { LAUNDER(); mlp_weights(F, L); norm_phase(F, F.out, F.in[5] + L * D, MODL_ + 3 * 1024, MODL_ + 4 * 1024, 6144, 1, XN_); SEAM(); }
        PHASE(pb + 8) { LAUNDER(); GEMM_CALL(FnUp, XN_, ws + WS_WUP, FF, D, D, D, HB_); SEAM(); }
        PHASE(pb + 9) { LAUNDER(); GEMM_CALL(FnRes, HB_, ws + WS_WDN, D, FF, FF, FF, (const float*)F.out, F.out, MODL_ + 5 * 1024); SEAM(); }
        }
    PHASE(41) { LAUNDER(); final_norm_phase(F); }
#undef IN
#undef SEAM
}
static bool phase_exists(int ph) {
    if (ph == 0 || ph == 41) return true;
    const int L = (ph - 1) / 10, s = (ph - 1) % 10;
    if (L < 2) return true;
    if (s == 4 || s == 5) return false;
    if (s == 2) return L == 2;
    return true;
}
extern "C" void kernel_launch(void* const* d_in, const int* in_sizes, int n_in, void* d_out, int out_size, void* d_ws, size_t ws_size, hipStream_t stream) {
    static int grid = 0;
    if (grid == 0) {
        if (n_in != 39 || in_sizes[0] != M * D || out_size != M * D || ws_size < WS_END) { fprintf(stderr, "kernel_launch: shape/workspace mismatch: n_in %d in0 %d out %d ws %zu (need %zu)\n", n_in, n_in > 0 ? in_sizes[0] : -1, out_size, ws_size, (size_t)WS_END); grid = -1; return; }
        int dev = 0, cus = 0, per_cu = 0;
        if (hipGetDevice(&dev) != hipSuccess || hipDeviceGetAttribute(&cus, hipDeviceAttributeMultiprocessorCount, dev) != hipSuccess) { fprintf(stderr, "kernel_launch: device query failed\n"); grid = -1; return; }
        if (hipFuncSetAttribute((const void*)yoco_fwd, hipFuncAttributeMaxDynamicSharedMemorySize, LDS_BYTES) != hipSuccess) { fprintf(stderr, "kernel_launch: hipFuncSetAttribute failed\n"); grid = -1; return; }
        if (hipOccupancyMaxActiveBlocksPerMultiprocessor(&per_cu, (const void*)yoco_fwd, NWAVES * 64, LDS_BYTES) != hipSuccess || per_cu < 1) { fprintf(stderr, "kernel_launch: occupancy query says %d blocks/CU\n", per_cu); per_cu = 1; }
        (void)hipGetLastError();
        grid = cus * per_cu;
        if (grid != 256) { fprintf(stderr, "kernel_launch: resident capacity %d workgroups; this kernel's static schedules want 256 (using 256)\n", grid); if (grid > 256) grid = 256; }
    }
    if (grid < 0) return;
    if (hipMemsetAsync((char*)d_ws + WS_BAR, 0, BAR_BYTES, stream) != hipSuccess) { fprintf(stderr, "kernel_launch: memset of barrier words failed\n"); return; }
    Args a{};
    for (int i = 0; i < 39; ++i) a.in[i] = (const float*)d_in[i];
    a.out = (float*)d_out; a.ws = (unsigned char*)d_ws;
#if MK_ONE_LAUNCH
    a.ph_lo = 0; a.ph_hi = N_PHASES;
    void* params[] = {&a};
    const hipError_t le = hipLaunchCooperativeKernel((const void*)yoco_fwd, dim3(grid), dim3(NWAVES * 64), params, LDS_BYTES, stream);
    if (le != hipSuccess) fprintf(stderr, "kernel_launch: cooperative launch failed: %s (grid %d)\n", hipGetErrorName(le), grid);
#else
    for (int ph = 0; ph < N_PHASES; ++ph) { if (!phase_exists(ph)) continue; a.ph_lo = ph; a.ph_hi = ph + 1;
        hipLaunchKernelGGL(yoco_fwd, dim3(grid), dim3(NWAVES * 64), LDS_BYTES, stream, a);
        const hipError_t le = hipPeekAtLastError(); if (le != hipSuccess) { fprintf(stderr, "kernel_launch: launch of phase %d failed: %s\n", ph, hipGetErrorName(le)); break; } }
#endif
}
```

```cpp
#include <hip/hip_runtime.h>
#include <hip/hip_cooperative_groups.h>
#include <hip/hip_bf16.h>
#include <cstdio>
#include <cstdint>
#include <cmath>
namespace cg = cooperative_groups;
#ifndef MK_ONE_LAUNCH
#define MK_ONE_LAUNCH 1
#endif
namespace pg8 {
#define PG8_LAS __attribute__((address_space(3)))
typedef unsigned short bf16_t;
typedef short bf16x8 __attribute__((ext_vector_type(8)));
typedef float f32x4 __attribute__((ext_vector_type(4)));
typedef unsigned u32x4 __attribute__((ext_vector_type(4)));
constexpr int BM = 256, BK = 64, HALF = 128, HTB = HALF * BK * 2  , STAGE_BYTES = 8 * HTB, NXCD = 8, WGM = 8;

__host__ __device__ __forceinline__ int lds_byte(int r, int c) { const int st = (r >> 4) * 2 + (c >> 5), rr = r & 15, cc = c & 31, ob = rr * 64 + cc * 2; return st * 1024 + (ob ^ (((ob >> 9) & 1) << 5)); }
__host__ __device__ __forceinline__ void stage_rc(int b, int& R, int& C) { const int st = b / 1024, sb = b % 1024, swz = sb ^ (((sb >> 9) & 1) << 5); R = (st >> 1) * 16 + swz / 64; C = (st & 1) * 32 + (swz % 64) / 2; }
__host__ __device__ __forceinline__ int perm32(int rho) { const int n = rho >> 4, i = rho & 15; return 8 * (i >> 2) + 4 * n + (i & 3); }

struct Unit { int pm, pn; };
struct Gemm { const bf16_t* A; const bf16_t* Bt; int M, N, K, lda, ldb; int agrp; size_t astep; };

struct SplitOrder {
    int c, nN;
    __host__ __device__ void init(int M, int N, int G_, int c_) { c = c_; nN = N / BM; (void)M; (void)G_; }
    __host__ __device__ bool next(int i, Unit& u) const { int idx; if (c < 128) { if (i >= 2) return false; idx = 2 * c + i; } else { if (i >= 4) return false; idx = 256 + 4 * (c - 128) + i; } u.pm = idx / nN; u.pn = idx % nN; return true; }
    __device__ __forceinline__ void a_ready(const Unit&) const {}
    __device__ __forceinline__ void done(const Unit&) const {}
};
struct StaticOrder {
    int nM, nN, nwg, G, c;
    __host__ __device__ void init(int M, int N, int G_, int c_) { nM = M / BM; nN = N / BM; nwg = nM * nN; G = G_; c = c_; }
    __host__ __device__ bool next(int i, Unit& u) const {
        const long L = (long)i * G + c; if (L >= nwg) return false;
        int wgid = (int)L; { const int q = nwg / NXCD, r = nwg % NXCD, xcd = wgid % NXCD, off = wgid / NXCD; wgid = (xcd < r ? xcd * (q + 1) : r * (q + 1) + (xcd - r) * q) + off; }
        const int nig = WGM * nN, gid = wgid / nig, fm = gid * WGM, gsz = (nM - fm) < WGM ? (nM - fm) : WGM;
        u.pm = fm + ((wgid % nig) % gsz); u.pn = (wgid % nig) / gsz; return true;
    }
    __device__ __forceinline__ void a_ready(const Unit&) const {}
    __device__ __forceinline__ void done(const Unit&) const {}
};

typedef float f32x2 __attribute__((ext_vector_type(2)));
typedef __bf16 bf16x2_t __attribute__((ext_vector_type(2)));
__device__ __forceinline__ unsigned pkbf(float lo, float hi) { f32x2 v = {lo, hi}; bf16x2_t b = __builtin_convertvector(v, bf16x2_t); return __builtin_bit_cast(unsigned, b); }
__device__ __forceinline__ float bflo(unsigned w) { return __uint_as_float(w << 16); }
__device__ __forceinline__ float bfhi(unsigned w) { return __uint_as_float(w & 0xffff0000u); }
__device__ __forceinline__ float sigm(float x) { return __builtin_amdgcn_rcpf(1.0f + __builtin_amdgcn_exp2f(-1.4426950408889634f * x)); }
template <class Fn> struct Epi8 {
    static constexpr bool PERM = true, AFTER_DRAIN = false; Fn f;
    __device__ __forceinline__ void operator()(const f32x4 (&acc)[2][2][4][2], const Unit& u, int wr, int wc, int fr, int fq) const {
        const int row0 = u.pm * BM + wr * 64 + fr, col0 = u.pn * BM + wc * 32 + 8 * fq;
#pragma unroll
        for (int ai = 0; ai < 2; ++ai)
#pragma unroll
            for (int m = 0; m < 4; ++m)
#pragma unroll
                for (int bj = 0; bj < 2; ++bj) { f(row0 + ai * HALF + m * 16, col0 + bj * HALF, acc[ai][bj][m][0], acc[ai][bj][m][1]); }
    }
};
__device__ __forceinline__ void st8bf(bf16_t* p, f32x4 v0, f32x4 v1) { u32x4 w; w.x = pkbf(v0[0], v0[1]); w.y = pkbf(v0[2], v0[3]); w.z = pkbf(v1[0], v1[1]); w.w = pkbf(v1[2], v1[3]); *(u32x4*)p = w; }
struct FnP1 { bf16_t* O; int coff;
    __device__ __forceinline__ void operator()(int row, int col, f32x4 v0, f32x4 v1) const {
        col += coff;
        if (col >= 3072) {
            if (col < 3136) {
#pragma unroll
                for (int j = 0; j < 4; ++j) { v0[j] = 1.0f - 2.0f * __builtin_amdgcn_rcpf(__builtin_amdgcn_exp2f(2.8853900817779268f * v0[j]) + 1.0f); v1[j] = 1.0f - 2.0f * __builtin_amdgcn_rcpf(__builtin_amdgcn_exp2f(2.8853900817779268f * v1[j]) + 1.0f); } }
            else if (col >= 3232 && col < 3392) {
#pragma unroll
                for (int j = 0; j < 4; ++j) { v0[j] = sigm(v0[j]); v1[j] = sigm(v1[j]); } }
        }
        st8bf(O + (size_t)row * 3584 + col, v0, v1); } };
struct FnP2 { bf16_t* O; const float* bias;
    __device__ __forceinline__ void operator()(int row, int col, f32x4 v0, f32x4 v1) const {
        const f32x4 b0 = *(const f32x4*)(bias + col), b1 = *(const f32x4*)(bias + col + 4);
        const float sc = col < 1024 ? -0.60653065971f : 1.0f;
#pragma unroll
        for (int j = 0; j < 4; ++j) { v0[j] = sc * sigm(v0[j] + b0[j]); v1[j] = sc * sigm(v1[j] + b1[j]); }
        st8bf(O + (size_t)row * 3072 + col, v0, v1); } };
struct FnGate { bf16_t* Y; int ld;
    __device__ __forceinline__ void operator()(int row, int col, f32x4 v0, f32x4 v1) const {
        bf16_t* p = Y + (size_t)row * ld + col; const u32x4 y = *(const u32x4*)p;
        v0[0] *= bflo(y.x); v0[1] *= bfhi(y.x); v0[2] *= bflo(y.y); v0[3] *= bfhi(y.y); v1[0] *= bflo(y.z); v1[1] *= bfhi(y.z); v1[2] *= bflo(y.w); v1[3] *= bfhi(y.w);
        st8bf(p, v0, v1); } };
struct FnRes { const float* xin; float* xout; const float* gate;
    __device__ __forceinline__ void operator()(int row, int col, f32x4 v0, f32x4 v1) const {
        const float* gp = gate + (row >> 13) * 6144 + col; const f32x4 g0 = *(const f32x4*)gp, g1 = *(const f32x4*)(gp + 4);
        const size_t off = (size_t)row * 1024 + col; const f32x4 x0 = *(const f32x4*)(xin + off), x1 = *(const f32x4*)(xin + off + 4);
        *(f32x4*)(xout + off) = x0 + (g0 + 1.0f) * v0; *(f32x4*)(xout + off + 4) = x1 + (g1 + 1.0f) * v1; } };
struct FnUp { bf16_t* O;
    __device__ __forceinline__ void operator()(int row, int col, f32x4 v0, f32x4 v1) const {
#pragma unroll
        for (int j = 0; j < 4; ++j) { const float a = fmaxf(v0[j], 0.f), b = fmaxf(v1[j], 0.f); v0[j] = a * a; v1[j] = b * b; }
        st8bf(O + (size_t)row * 4096 + col, v0, v1); } };
struct FnKv { bf16_t* O; float* FL; bf16_t* VS;
    __device__ __forceinline__ void operator()(int row, int col, f32x4 v0, f32x4 v1) const {
        if (col < 1024) st8bf(O + (size_t)row * 2048 + col, v0, v1);
        else if (col < 2048) st8bf(VS + (size_t)row * 1024 + (col - 1024), v0, v1);
        else if (col < 2064) { float* p = FL + (size_t)row * 16 + (col - 2048); *(f32x4*)p = v0; *(f32x4*)(p + 4) = v1; } } };
struct FnQg { bf16_t* Q; bf16_t* G;
    __device__ __forceinline__ void operator()(int row, int col, f32x4 v0, f32x4 v1) const {
        if (col < 1024) st8bf(Q + (size_t)row * 1024 + col, v0, v1);
        else {
#pragma unroll
            for (int j = 0; j < 4; ++j) { v0[j] = sigm(v0[j]); v1[j] = sigm(v1[j]); }
            st8bf(G + (size_t)row * 1024 + (col - 1024), v0, v1); } } };
template <class Epi, class Sched, bool ALIGN_EPI = false, bool SP2 = false>
__device__ __forceinline__ void gemm_phase(PG8_LAS unsigned char* lds, const Gemm g, const Sched& S, const Epi& E, const int tid_in) {
    int tid_l = tid_in; asm volatile("" : "+v"(tid_l));
    const int tid = tid_l, wid = __builtin_amdgcn_readfirstlane(tid >> 6), lane = tid & 63, wr = wid >> 2, wc = wid & 3, fr = lane & 15, fq = lane >> 4;
    const int K = g.K, nt = K / BK;
    unsigned voffA[2], voffB[2];
#pragma unroll
    for (int i = 0; i < 2; ++i) { int R, C; stage_rc(tid * 16 + i * 8192, R, C); const int Rb = Epi::PERM ? ((R & ~31) + perm32(R & 31)) : R;
        voffA[i] = (unsigned)(R * g.lda + C) * 2u; voffB[i] = (unsigned)(Rb * g.ldb + C) * 2u; }
    const size_t kstep = (size_t)(BK * 2);
    const size_t hstepA = (size_t)HALF * g.lda * 2, hstepB = (size_t)HALF * g.ldb * 2;
    const size_t tstepA = 2 * hstepA, tstepB = 2 * hstepB;
    const unsigned ldsw = (unsigned)wid * 1024u;
    const int aoff = lds_byte(wr * 64 + fr, fq * 8), boff = lds_byte(wc * 32 + fr, fq * 8);
#define PG8_SA(b, h) (((b) * 2 + (h)) * HTB)
#define PG8_SB(b, h) ((4 + (b) * 2 + (h)) * HTB)
#define PG8_STAGE(bufoff, gbase, voff) do { _Pragma("unroll") for (int _i = 0; _i < 2; ++_i) \
        __builtin_amdgcn_global_load_lds((const unsigned*)((const char*)(gbase) + (voff)[_i]), (PG8_LAS unsigned*)(lds + (bufoff) + ldsw + _i * 8192), 16, 0, 0); } while (0)
#define PG8_LDA(dst, b, h) do { _Pragma("unroll") for (int m = 0; m < 4; ++m) _Pragma("unroll") for (int k = 0; k < 2; ++k) dst[m][k] = *(const PG8_LAS bf16x8*)(lds + PG8_SA(b, h) + aoff + m * 2048 + k * 1024); } while (0)
#define PG8_LDB(dst, b, h) do { _Pragma("unroll") for (int n = 0; n < 2; ++n) _Pragma("unroll") for (int k = 0; k < 2; ++k) dst[n][k] = *(const PG8_LAS bf16x8*)(lds + PG8_SB(b, h) + boff + n * 2048 + k * 1024); } while (0)
#define PG8_MMA(ai, bj, At, Bt) do { __builtin_amdgcn_s_setprio(1); _Pragma("unroll") for (int m = 0; m < 4; ++m) _Pragma("unroll") for (int n = 0; n < 2; ++n) _Pragma("unroll") for (int k = 0; k < 2; ++k) \
        acc[ai][bj][m][n] = __builtin_amdgcn_mfma_f32_16x16x32_bf16(Bt[n][k], At[m][k], acc[ai][bj][m][n], 0, 0, 0); __builtin_amdgcn_s_setprio(0); } while (0)
#define PG8_WAIT_V(n) asm volatile("s_waitcnt vmcnt(" #n ")" ::: "memory")
#define PG8_WAIT_L(n) asm volatile("s_waitcnt lgkmcnt(" #n ")" ::: "memory")
#define PG8_BAR __builtin_amdgcn_s_barrier()
#define PG8_SCHED __builtin_amdgcn_sched_barrier(0)
    Unit cur, nxt; int ui = 0;
    if (!S.next(0, cur)) return;
    f32x4 acc[2][2][4][2];
#pragma unroll
    for (int a = 0; a < 2; ++a)
#pragma unroll
        for (int b = 0; b < 2; ++b)
#pragma unroll
            for (int m = 0; m < 4; ++m)
#pragma unroll
                for (int n = 0; n < 2; ++n) acc[a][b][m][n] = (f32x4){0.f, 0.f, 0.f, 0.f};
    bf16x8 At[4][2], B0[2][2], B1[2][2];
    const char* cA = (const char*)g.A + (size_t)cur.pm * tstepA + (g.agrp ? (size_t)(cur.pn / g.agrp) * g.astep : (size_t)0); const char* cB = (const char*)g.Bt + (size_t)cur.pn * tstepB;
    S.a_ready(cur);
    if constexpr (SP2) {
        PG8_STAGE(PG8_SB(0, 0), cB, voffB); PG8_STAGE(PG8_SB(0, 1), cB + hstepB, voffB); PG8_STAGE(PG8_SA(0, 0), cA, voffA); PG8_STAGE(PG8_SA(0, 1), cA + hstepA, voffA);
        if (wr == 1) PG8_BAR;
        PG8_WAIT_V(2); PG8_BAR;
        PG8_STAGE(PG8_SB(1, 0), cB + kstep, voffB); PG8_STAGE(PG8_SA(1, 0), cA + kstep, voffA); PG8_STAGE(PG8_SB(1, 1), cB + hstepB + kstep, voffB);
        PG8_WAIT_V(6); PG8_BAR;
    } else {
        PG8_STAGE(PG8_SB(0, 0), cB, voffB); PG8_STAGE(PG8_SA(0, 0), cA, voffA); PG8_STAGE(PG8_SB(0, 1), cB + hstepB, voffB); PG8_STAGE(PG8_SA(0, 1), cA + hstepA, voffA);
        if (wr == 1) PG8_BAR;
        PG8_WAIT_V(4); PG8_BAR;
        PG8_STAGE(PG8_SB(1, 0), cB + kstep, voffB); PG8_STAGE(PG8_SA(1, 0), cA + kstep, voffA); PG8_STAGE(PG8_SB(1, 1), cB + hstepB + kstep, voffB);
        PG8_WAIT_V(6); PG8_BAR;
    }
    for (;;) {
        const bool has_next = S.next(ui + 1, nxt);
        const char* nA = has_next ? (const char*)g.A + (size_t)nxt.pm * tstepA + (g.agrp ? (size_t)(nxt.pn / g.agrp) * g.astep : (size_t)0) : cA; const char* nB = has_next ? (const char*)g.Bt + (size_t)nxt.pn * tstepB : cB;
        for (int t = 0; t < nt; t += 2) {
            const bool last = (t == nt - 2);
            const char* a1 = cA + (size_t)(t + 1) * kstep;
            const char* a2 = last ? nA : cA + (size_t)(t + 2) * kstep; const char* b2 = last ? nB : cB + (size_t)(t + 2) * kstep;
            const char* a3 = a2 + kstep; const char* b3 = b2 + kstep;
            if (last && has_next) S.a_ready(nxt);
            if constexpr (SP2) {
            PG8_LDB(B0, 0, 0); PG8_LDB(B1, 0, 1); PG8_SCHED; PG8_LDA(At, 0, 0); PG8_STAGE(PG8_SA(1, 1), a1 + hstepA, voffA);
            PG8_WAIT_V(8); PG8_WAIT_L(0); PG8_BAR; PG8_MMA(0, 0, At, B0); PG8_MMA(0, 1, At, B1); PG8_BAR; PG8_SCHED;
            PG8_LDA(At, 0, 1); PG8_STAGE(PG8_SB(0, 0), b2, voffB); PG8_STAGE(PG8_SB(0, 1), b2 + hstepB, voffB); PG8_STAGE(PG8_SA(0, 0), a2, voffA);
            PG8_WAIT_V(8); PG8_WAIT_L(0); PG8_BAR; PG8_MMA(1, 0, At, B0); PG8_MMA(1, 1, At, B1); PG8_BAR; PG8_SCHED;
            PG8_LDB(B0, 1, 0); PG8_LDB(B1, 1, 1); PG8_SCHED; PG8_LDA(At, 1, 0); PG8_STAGE(PG8_SA(0, 1), a2 + hstepA, voffA);
            PG8_WAIT_V(8); PG8_WAIT_L(0); PG8_BAR; PG8_MMA(0, 0, At, B0); PG8_MMA(0, 1, At, B1); PG8_BAR; PG8_SCHED;
            PG8_LDA(At, 1, 1); PG8_STAGE(PG8_SB(1, 0), b3, voffB); PG8_STAGE(PG8_SB(1, 1), b3 + hstepB, voffB); PG8_STAGE(PG8_SA(1, 0), a3, voffA);
            PG8_WAIT_V(8); PG8_WAIT_L(0); PG8_BAR; PG8_MMA(1, 0, At, B0); PG8_MMA(1, 1, At, B1); PG8_BAR; PG8_SCHED;
            } else {
            PG8_LDB(B0, 0, 0); PG8_SCHED; PG8_LDA(At, 0, 0); PG8_STAGE(PG8_SA(1, 1), a1 + hstepA, voffA);
            PG8_WAIT_L(8); PG8_BAR; PG8_WAIT_L(0); PG8_MMA(0, 0, At, B0); PG8_BAR; PG8_SCHED;
            PG8_LDB(B1, 0, 1); PG8_STAGE(PG8_SB(0, 0), b2, voffB);
            PG8_BAR; PG8_WAIT_L(0); PG8_MMA(0, 1, At, B1); PG8_BAR;
            PG8_LDA(At, 0, 1); PG8_STAGE(PG8_SA(0, 0), a2, voffA);
            PG8_BAR; PG8_WAIT_L(0); PG8_MMA(1, 0, At, B0); PG8_BAR; PG8_SCHED;
            PG8_STAGE(PG8_SB(0, 1), b2 + hstepB, voffB);
            PG8_WAIT_V(6); PG8_BAR; PG8_MMA(1, 1, At, B1); PG8_BAR;
            PG8_LDB(B0, 1, 0); PG8_SCHED; PG8_LDA(At, 1, 0); PG8_STAGE(PG8_SA(0, 1), a2 + hstepA, voffA);
            PG8_WAIT_L(8); PG8_BAR; PG8_WAIT_L(0); PG8_MMA(0, 0, At, B0); PG8_BAR; PG8_SCHED;
            PG8_LDB(B1, 1, 1); PG8_STAGE(PG8_SB(1, 0), b3, voffB);
            PG8_BAR; PG8_WAIT_L(0); PG8_MMA(0, 1, At, B1); PG8_BAR;
            PG8_LDA(At, 1, 1); PG8_STAGE(PG8_SA(1, 0), a3, voffA);
            PG8_BAR; PG8_WAIT_L(0); PG8_MMA(1, 0, At, B0); PG8_BAR; PG8_SCHED;
            PG8_STAGE(PG8_SB(1, 1), b3 + hstepB, voffB);
            PG8_WAIT_V(6); PG8_BAR; PG8_MMA(1, 1, At, B1); PG8_BAR;
            }
        }
        if constexpr (ALIGN_EPI) { if (wr == 0) PG8_BAR; }
        if constexpr (!Epi::AFTER_DRAIN) { E(acc, cur, wr, wc, fr, fq); S.done(cur); }
        if (!has_next) break;
#pragma unroll
        for (int a = 0; a < 2; ++a)
#pragma unroll
            for (int b = 0; b < 2; ++b)
#pragma unroll
                for (int m = 0; m < 4; ++m)
#pragma unroll
                    for (int n = 0; n < 2; ++n) acc[a][b][m][n] = (f32x4){0.f, 0.f, 0.f, 0.f};
        cur = nxt; cA = nA; cB = nB; ++ui;
        if constexpr (ALIGN_EPI) { if (wr == 1) PG8_BAR; }
    }
    PG8_WAIT_V(0);
    if constexpr (!ALIGN_EPI) { if (wr == 0) PG8_BAR; }
    PG8_BAR;
    if constexpr (Epi::AFTER_DRAIN) { E.fused(acc, cur, wr, wc, fr, fq, lds, wid, lane); S.done(cur); }
#undef PG8_SA
#undef PG8_SB
#undef PG8_STAGE
#undef PG8_LDA
#undef PG8_LDB
#undef PG8_MMA
#undef PG8_WAIT_V
#undef PG8_WAIT_L
#undef PG8_BAR
#undef PG8_SCHED
}
}
#include <hip/hip_bf16.h>
#include <cmath>
namespace attn_body {
using bf16=__hip_bfloat16;
using bf16x8=__attribute__((ext_vector_type(8)))short;
using s16x4=__attribute__((ext_vector_type(4)))short;
using f32x16=__attribute__((ext_vector_type(16)))float;
using u32x4=__attribute__((ext_vector_type(4)))unsigned;
constexpr int BATCH=2,NHEAD=16,SEQ=8192,D=64,DM=NHEAD*D;
constexpr int NW=8,QBLK=32,QB=QBLK*NW,KVBLK=64,NQB=SEQ/QB;
constexpr int ATTN_PITCH=DM, ATTN_UNIT_ROWS=QB;
__device__ __forceinline__ int crow(int r,int hi){return (r&3)+8*(r>>2)+4*hi;}
#define SBAR() __builtin_amdgcn_sched_barrier(0)
__device__ __forceinline__ void cmask(f32x16&p0,f32x16&p1,int jb,int qrel,int hi){
  const float NEG=-INFINITY; int kb=64*jb+4*hi;
  #pragma unroll
  for(int r=0;r<16;++r){int kv=kb+(r&3)+8*(r>>2); if(kv>qrel)p0[r]=NEG; if(kv+32>qrel)p1[r]=NEG;}
}

constexpr int NSLOT=3, SLOTB=9216;
constexpr int LDS_K=0, LDS_V=NSLOT*SLOTB, LDS_WS=2*NSLOT*SLOTB, LDS_OST=LDS_WS+NW*64*4, LDS_BYTES=LDS_OST+NW*4096;
constexpr float C2=0.125f*1.4426950408889634f;
__device__ __forceinline__ void glds16(const void*gsrc,unsigned lds_dst){unsigned keep;
  asm volatile("s_mov_b32 %0, m0\n\ts_mov_b32 m0, %2\n\ts_nop 0\n\tglobal_load_lds_dwordx4 %1, off\n\ts_mov_b32 m0, %0":"=&s"(keep):"v"(gsrc),"s"(lds_dst):"memory");}
__device__ __forceinline__ float max3f(float a,float b,float c){float r;asm("v_max3_f32 %0, %1, %2, %3":"=v"(r):"v"(a),"v"(b),"v"(c));return r;}
__device__ __forceinline__ float max2f(float a,float b){float r;asm("v_max_f32_e32 %0, %1, %2":"=v"(r):"v"(a),"v"(b));return r;}
__device__ __forceinline__ float fadd_s(float a,float b){float r;asm("v_add_f32_e32 %0, %1, %2":"=v"(r):"v"(a),"v"(b));return r;}
__device__ __forceinline__ float fsub_s(float a,float b){float r;asm("v_sub_f32_e32 %0, %1, %2":"=v"(r):"v"(a),"v"(b));return r;}
typedef float f32x2_t __attribute__((ext_vector_type(2))); typedef __bf16 bf16x2_t __attribute__((ext_vector_type(2)));
__device__ __forceinline__ unsigned cvtpk_s(float lo,float hi){f32x2_t v={lo,hi};bf16x2_t b=__builtin_convertvector(v,bf16x2_t);return __builtin_bit_cast(unsigned,b);}
#define WAIT_BAR(N) asm volatile("s_waitcnt vmcnt(" #N ") lgkmcnt(0)\n\ts_barrier":::"memory")
#define WAIT_BARW() do{ if(wid==0){WAIT_BAR(3);} else {WAIT_BAR(2);} }while(0)

__device__ __forceinline__ void qkt(f32x16&p0,f32x16&p1,const char*Kslot,const bf16x8*qr,const bf16x8 qe,const f32x16&negm,int r32,int hi){
  const char*kb=Kslot+hi*1024+r32*16;
  #pragma unroll
  for(int d0=0;d0<4;++d0){
    const bf16x8 b0=*reinterpret_cast<const bf16x8*>(kb+d0*2048);
    const bf16x8 b1=*reinterpret_cast<const bf16x8*>(kb+d0*2048+512);
    if(d0==0){p0=__builtin_amdgcn_mfma_f32_32x32x16_bf16(b0,qr[0],negm,0,0,0);p1=__builtin_amdgcn_mfma_f32_32x32x16_bf16(b1,qr[0],negm,0,0,0);}
    else{p0=__builtin_amdgcn_mfma_f32_32x32x16_bf16(b0,qr[d0],p0,0,0,0);p1=__builtin_amdgcn_mfma_f32_32x32x16_bf16(b1,qr[d0],p1,0,0,0);}}
  { const char*ke=Kslot+8192+r32*16; const bf16x8 e0=*reinterpret_cast<const bf16x8*>(ke),e1=*reinterpret_cast<const bf16x8*>(ke+512);
    p0=__builtin_amdgcn_mfma_f32_32x32x16_bf16(e0,qe,p0,0,0,0);p1=__builtin_amdgcn_mfma_f32_32x32x16_bf16(e1,qe,p1,0,0,0);}
}
typedef __attribute__((address_space(3))) const char* lds_cptr;
typedef short v4i16_t __attribute__((ext_vector_type(4)));
__device__ __forceinline__ void kload8(bf16x8*kf,lds_cptr kp){
  kf[0]=*(const __attribute__((address_space(3))) bf16x8*)(kp);      kf[1]=*(const __attribute__((address_space(3))) bf16x8*)(kp+512);
  kf[2]=*(const __attribute__((address_space(3))) bf16x8*)(kp+2048); kf[3]=*(const __attribute__((address_space(3))) bf16x8*)(kp+2560);
  kf[4]=*(const __attribute__((address_space(3))) bf16x8*)(kp+4096); kf[5]=*(const __attribute__((address_space(3))) bf16x8*)(kp+4608);
  kf[6]=*(const __attribute__((address_space(3))) bf16x8*)(kp+6144); kf[7]=*(const __attribute__((address_space(3))) bf16x8*)(kp+6656);
}
__device__ __forceinline__ void kload2(bf16x8*kf,lds_cptr kp,int j){ kf[2*j]=*(const __attribute__((address_space(3))) bf16x8*)(kp+j*2048); kf[2*j+1]=*(const __attribute__((address_space(3))) bf16x8*)(kp+j*2048+512); }
__device__ __forceinline__ s16x4 vtr(lds_cptr p){ return __builtin_bit_cast(s16x4,__builtin_amdgcn_ds_read_tr16_b64_v4i16((__attribute__((address_space(3))) v4i16_t*)p)); }
__device__ __forceinline__ float rowmax(const f32x16&p0,const f32x16&p1){
  float a=max3f(p0[0],p0[1],p1[0]),b=max3f(p0[2],p0[3],p1[1]);a=max3f(a,p1[2],p1[3]);
  #pragma unroll
  for(int r=4;r<16;r+=4){a=max3f(a,p0[r],p0[r+1]);b=max3f(b,p0[r+2],p0[r+3]);a=max3f(a,p1[r],p1[r+1]);b=max3f(b,p1[r+2],p1[r+3]);}
  const float m=max2f(a,b);
  auto rr=__builtin_amdgcn_permlane32_swap(__float_as_uint(m),__float_as_uint(m),false,false);
  return max2f(__uint_as_float(rr[0]),__uint_as_float(rr[1]));
}
__device__ __forceinline__ void pv(f32x16*o,int vb,bf16x8 pa0,bf16x8 pa1,bf16x8 pa2,bf16x8 pa3){
  #pragma unroll
  for(int d0=0;d0<2;++d0){s16x4 lo[4],hi[4];
    #pragma unroll
    for(int ks=0;ks<4;++ks){
      asm volatile("ds_read_b64_tr_b16 %0,%1 offset:%c2":"=&v"(lo[ks]):"v"(vb),"i"(d0*4096+ks*1024):"memory");
      asm volatile("ds_read_b64_tr_b16 %0,%1 offset:%c2":"=&v"(hi[ks]):"v"(vb),"i"(d0*4096+ks*1024+512):"memory");}
    asm volatile("s_waitcnt lgkmcnt(0)":::"memory");SBAR();
    #define PK(k) (bf16x8){lo[k][0],lo[k][1],lo[k][2],lo[k][3],hi[k][0],hi[k][1],hi[k][2],hi[k][3]}
    o[d0]=__builtin_amdgcn_mfma_f32_32x32x16_bf16(pa0,PK(0),o[d0],0,0,0);
    o[d0]=__builtin_amdgcn_mfma_f32_32x32x16_bf16(pa1,PK(1),o[d0],0,0,0);
    o[d0]=__builtin_amdgcn_mfma_f32_32x32x16_bf16(pa2,PK(2),o[d0],0,0,0);
    o[d0]=__builtin_amdgcn_mfma_f32_32x32x16_bf16(pa3,PK(3),o[d0],0,0,0);
    #undef PK
  }
}

#ifndef ATTN_STORE16
#define ATTN_STORE16(p,v) (*(u32x4*)(p)=(v))
#endif
template<int THRL> __device__ __forceinline__ void attn_unit(int b,int h,int qb,const bf16*Q,const bf16*__restrict__ K,const bf16*__restrict__ V,bf16*O,const bf16*__restrict__ GT,const unsigned char*__restrict__ G3,const float*__restrict__ qgain,const float kbound,char*shm,const int tid_in,const int j0){
  int tid_l=tid_in; asm volatile("":"+v"(tid_l)); const int tid=tid_l,lane=tid&63,r32=lane&31,hi=lane>>5; const int wid=__builtin_amdgcn_readfirstlane(tid>>6);
  const long rowbase=(long)b*SEQ; const int q0=qb*QB;
  const bf16*Qw=Q+(rowbase+q0+wid*QBLK)*DM+h*D;
  const bf16*Kh=K+rowbase*DM+h*D,*Vh=V+rowbase*DM+h*D;
  const unsigned lds0=(unsigned)(uintptr_t)shm;
  float*wsf=(float*)(shm+LDS_WS)+wid*64;
  const bf16*ksrc=Kh+(long)lane*DM+wid*8;
  const bf16*vsrc=Vh+(long)(16*(wid&3)+(lane>>2))*DM+(wid>>2)*32+(lane&3)*8;
  const unsigned kdst=lds0+LDS_K+wid*1024, vdst=lds0+LDS_V+wid*1024, gdst=lds0+LDS_K+8192;
  const unsigned char*gsrc=G3+((long)(b*NHEAD+h)*SEQ+lane)*16;
  #define DMA_K(t,slot) do{ if(wid==0)glds16(gsrc+(long)(t)*KVBLK*16,(unsigned)__builtin_amdgcn_readfirstlane(gdst+(slot))); glds16(ksrc+(long)(t)*KVBLK*DM,(unsigned)__builtin_amdgcn_readfirstlane(kdst+(slot))); }while(0)
  #define DMA_V(t,slot) glds16(vsrc+(long)(t)*KVBLK*DM,(unsigned)__builtin_amdgcn_readfirstlane(vdst+(slot)))
  const int vb0=(int)(lds0+LDS_V)+((lane>>4)&1)*32+(lane&3)*8+(4*hi+((lane&15)>>2))*64;
  const char*Kbase=shm+LDS_K; bf16x8 kf[10];
  const lds_cptr shm3=(lds_cptr)shm; const lds_cptr kp0=shm3+LDS_K+hi*1024+r32*16; const lds_cptr kpe=shm3+LDS_K+8192+r32*16; const lds_cptr vp0=shm3+LDS_V+((lane>>4)&1)*32+(lane&3)*8+(4*hi+((lane&15)>>2))*64;
  ksrc+=(long)j0*KVBLK*DM; vsrc+=(long)j0*KVBLK*DM; gsrc+=(long)j0*KVBLK*16;
  const int NT=(q0+QB)/KVBLK-j0;
  DMA_K(0,0);DMA_V(0,0);DMA_K(1,SLOTB);
  bf16x8 qr[4]; float fq2; bf16x8 qe; float ubound;
  { bf16x8 qraw[4];
    #pragma unroll
    for(int d0=0;d0<4;++d0)qraw[d0]=*reinterpret_cast<const bf16x8*>(&Qw[(long)r32*DM+d0*16+hi*8]);
    const u32x4 ge=*reinterpret_cast<const u32x4*>(G3+((long)(b*NHEAD+h)*SEQ+q0+wid*QBLK+r32)*16);
    fq2=-(__uint_as_float(ge[0]<<16)+__uint_as_float(ge[0]&0xffff0000u)+__uint_as_float(ge[1]<<16));
    float ss=0.f;
    #pragma unroll
    for(int d0=0;d0<4;++d0)
      #pragma unroll
      for(int j=0;j<8;++j){const float x=__uint_as_float(((unsigned)(unsigned short)qraw[d0][j])<<16);ss+=x*x;}
    {auto rr=__builtin_amdgcn_permlane32_swap(__float_as_uint(ss),__float_as_uint(ss),false,false);ss=__uint_as_float(rr[0])+__uint_as_float(rr[1]);}
    const float qs=C2/sqrtf(ss*(1.0f/64.0f)+1e-6f);
    float s2=0.f;
    #pragma unroll
    for(int d0=0;d0<4;++d0){ u32x4 w;
      #pragma unroll
      for(int j=0;j<8;j+=2){const float x0=__uint_as_float(((unsigned)(unsigned short)qraw[d0][j])<<16),x1=__uint_as_float(((unsigned)(unsigned short)qraw[d0][j+1])<<16);
        const float y0=x0*qs*qgain[d0*16+hi*8+j],y1=x1*qs*qgain[d0*16+hi*8+j+1]; s2+=y0*y0+y1*y1;
        w[j>>1]=cvtpk_s(y0,y1);}
      qr[d0]=__builtin_bit_cast(bf16x8,w);}
    {auto rr=__builtin_amdgcn_permlane32_swap(__float_as_uint(s2),__float_as_uint(s2),false,false);s2=__uint_as_float(rr[0])+__uint_as_float(rr[1]);}
    ubound=sqrtf(s2)*kbound;
    const unsigned one2=hi?0u:0x3f803f80u, one1=hi?0u:0x00003f80u; qe=__builtin_bit_cast(bf16x8,(u32x4){one2,one1,0u,0u}); }
  float mhat=ubound,l_reg=0.f;f32x16 o[2];o[0]=f32x16{};o[1]=f32x16{};f32x16 negm;
  #pragma unroll
  for(int r=0;r<16;++r)negm[r]=fq2-ubound;
  asm volatile("":"+v"(negm));
  const int qrel=wid*QBLK+r32;
  #define CMASK(P0,P1,t) do{int jb_=(t)-(NT-4); if(jb_>=0)cmask(P0,P1,jb_,qrel,hi);}while(0)
  bool resc=false;
  #define START(P0,P1) do{ const float rm=rowmax(P0,P1); resc=false; \
    { const float dl=fmaxf(rm,0.f); mhat=fadd_s(mhat,dl); \
      _Pragma("unroll") for(int r=0;r<16;++r){P0[r]=fsub_s(P0[r],dl);P1[r]=fsub_s(P1[r],dl);} \
      _Pragma("unroll") for(int r=0;r<16;++r)negm[r]=fq2-mhat; asm volatile("":"+v"(negm)); } \
    _Pragma("unroll") for(int r=0;r<16;++r)P0[r]=__builtin_amdgcn_exp2f(P0[r]); }while(0)
  #define RESC() do{ if(resc){ asm volatile("s_waitcnt lgkmcnt(0)":::"memory"); \
      _Pragma("unroll") for(int d_=0;d_<2;++d_) _Pragma("unroll") for(int r=0;r<16;++r)o[d_][r]*=wsf[crow(r,hi)]; } }while(0)
  f32x16 pA0,pA1,pB0,pB1;
  int sl_prev=0,sl_cur=0,sl_next=SLOTB;
  #define ROT() do{sl_prev=sl_cur;sl_cur=sl_next;sl_next=(sl_next==(NSLOT-1)*SLOTB)?0:sl_next+SLOTB;}while(0)
  DMA_K(2,2*SLOTB);
  WAIT_BAR(3);
  qkt(pA0,pA1,Kbase,qr,qe,negm,r32,hi);asm volatile("s_nop 15\n\ts_nop 7":"+v"(pA0),"+v"(pA1));CMASK(pA0,pA1,0);
  START(pA0,pA1);
  _Pragma("unroll") for(int r=0;r<16;++r)pA1[r]=__builtin_amdgcn_exp2f(pA1[r]);
  WAIT_BAR(0);
  DMA_K(3,0);DMA_V(1,SLOTB);
  ROT();
  kload8(kf,kp0+sl_cur);
  kf[8]=*(const __attribute__((address_space(3))) bf16x8*)(kpe+sl_cur); kf[9]=*(const __attribute__((address_space(3))) bf16x8*)(kpe+sl_cur+512);
  WAIT_BARW();
  s16x4 vlo[8],vhi[8]; u32x4 pw0,pw1,pw2,pw3;
  #define PKW(P,B) cvtpk_s(P[B],P[B+1])
  #define PAF(k) __builtin_bit_cast(bf16x8,pw##k)
  #define VFR(i) (bf16x8){vlo[i][0],vlo[i][1],vlo[i][2],vlo[i][3],vhi[i][0],vhi[i][1],vhi[i][2],vhi[i][3]}
  #define PIN(x) asm volatile("":"+v"(x))
  #define MX3(a,b,c) __builtin_fmaxf(__builtin_fmaxf((a),(b)),(c))
  #define GAPA(MF,A0,A1,A2,A3,W0,W1,PW) do{ MF; sacc+=A0; sacc+=A1; sacc+=A2; sacc+=A3; PIN(sacc); W0; W1; PIN(PW); SBAR(); }while(0)
  #define EX(v) __builtin_amdgcn_exp2f(v)
  #define GAPB(MF,X,B) do{ MF; X[B]=EX(X[B]); X[B+1]=EX(X[B+1]); X[B+2]=EX(X[B+2]); X[B+3]=EX(X[B+3]); PIN(X); SBAR(); }while(0)
  #define VRD(i) do{ vlo[i]=vtr(vp_+(((i)>>2)*4096+((i)&3)*1024)); vhi[i]=vtr(vp_+(((i)>>2)*4096+((i)&3)*1024+512)); }while(0)
  #define KRD(G,j) do{ if(G){ kload2(kf,kp0+sl_next,j); SBAR(); } }while(0)
  #define STEP(C0,C1,P0,P1,t,GK,GV,GL) do{ SBAR(); \
    const lds_cptr vp_=vp0+sl_prev; \
    VRD(0); SBAR(); float sacc=(P0[0]+P0[1]); \
    GAPA(C0=__builtin_amdgcn_mfma_f32_32x32x16_bf16(kf[0],qr[0],negm,0,0,0), P0[2],P0[3],P0[4],P0[5],     pw0[0]=PKW(P0,0), pw0[1]=PKW(P0,2), pw0); \
    VRD(4); SBAR(); GAPA(C1=__builtin_amdgcn_mfma_f32_32x32x16_bf16(kf[1],qr[0],negm,0,0,0), P0[6],P0[7],P0[8],P0[9],     pw0[2]=PKW(P0,4), pw0[3]=PKW(P0,6), pw0); \
    VRD(1); SBAR(); GAPA(C0=__builtin_amdgcn_mfma_f32_32x32x16_bf16(kf[2],qr[1],C0,0,0,0),   P0[10],P0[11],P0[12],P0[13], pw1[0]=PKW(P0,8), pw1[1]=PKW(P0,10), pw1); \
    VRD(5); SBAR(); GAPA(C1=__builtin_amdgcn_mfma_f32_32x32x16_bf16(kf[3],qr[1],C1,0,0,0),   P0[14],P0[15],P1[0],P1[1],   pw1[2]=PKW(P0,12),pw1[3]=PKW(P0,14), pw1); \
    VRD(2); SBAR(); GAPA(C0=__builtin_amdgcn_mfma_f32_32x32x16_bf16(kf[4],qr[2],C0,0,0,0),   P1[2],P1[3],P1[4],P1[5],     pw2[0]=PKW(P1,0), pw2[1]=PKW(P1,2), pw2); \
    VRD(6); SBAR(); GAPA(C1=__builtin_amdgcn_mfma_f32_32x32x16_bf16(kf[5],qr[2],C1,0,0,0),   P1[6],P1[7],P1[8],P1[9],     pw2[2]=PKW(P1,4), pw2[3]=PKW(P1,6), pw2); \
    VRD(3); SBAR(); GAPA(C0=__builtin_amdgcn_mfma_f32_32x32x16_bf16(kf[6],qr[3],C0,0,0,0),   P1[10],P1[11],P1[12],P1[13], pw3[0]=PKW(P1,8), pw3[1]=PKW(P1,10), pw3); \
    VRD(7); SBAR(); GAPA(C1=__builtin_amdgcn_mfma_f32_32x32x16_bf16(kf[7],qr[3],C1,0,0,0),   P1[14],P1[15],0.f,0.f,       pw3[2]=PKW(P1,12),pw3[3]=PKW(P1,14), pw3); \
    C0=__builtin_amdgcn_mfma_f32_32x32x16_bf16(kf[8],qe,C0,0,0,0); C1=__builtin_amdgcn_mfma_f32_32x32x16_bf16(kf[9],qe,C1,0,0,0); \
    l_reg+=sacc; \
    if(GK){DMA_K((t)+3,sl_cur);} if(GV){DMA_V((t)+1,sl_next);} \
    CMASK(C0,C1,t); \
    resc=false;     \
    SBAR(); \
    GAPB(o[0]=__builtin_amdgcn_mfma_f32_32x32x16_bf16(PAF(0),VFR(0),o[0],0,0,0), C0,0); \
    GAPB(o[1]=__builtin_amdgcn_mfma_f32_32x32x16_bf16(PAF(0),VFR(4),o[1],0,0,0), C0,4); \
    KRD(GL,0); GAPB(o[0]=__builtin_amdgcn_mfma_f32_32x32x16_bf16(PAF(1),VFR(1),o[0],0,0,0), C0,8); \
    KRD(GL,1); GAPB(o[1]=__builtin_amdgcn_mfma_f32_32x32x16_bf16(PAF(1),VFR(5),o[1],0,0,0), C0,12); \
    KRD(GL,2); GAPB(o[0]=__builtin_amdgcn_mfma_f32_32x32x16_bf16(PAF(2),VFR(2),o[0],0,0,0), C1,0); \
    KRD(GL,3); GAPB(o[1]=__builtin_amdgcn_mfma_f32_32x32x16_bf16(PAF(2),VFR(6),o[1],0,0,0), C1,4); \
    if(GL){ kf[8]=*(const __attribute__((address_space(3))) bf16x8*)(kpe+sl_next); kf[9]=*(const __attribute__((address_space(3))) bf16x8*)(kpe+sl_next+512); SBAR(); } \
    GAPB(o[0]=__builtin_amdgcn_mfma_f32_32x32x16_bf16(PAF(3),VFR(3),o[0],0,0,0), C1,8); \
    GAPB(o[1]=__builtin_amdgcn_mfma_f32_32x32x16_bf16(PAF(3),VFR(7),o[1],0,0,0), C1,12); \
    }while(0)
  int t=1;
  #undef CMASK
  #define CMASK(P0,P1,t) do{}while(0)
  for(;t+5<NT;t+=2){
    STEP(pB0,pB1,pA0,pA1,t,true,true,true);     WAIT_BARW(); RESC(); ROT();
    STEP(pA0,pA1,pB0,pB1,t+1,true,true,true);   WAIT_BARW(); RESC(); ROT();
  }
  #undef CMASK
  #define CMASK(P0,P1,t) do{int jb_=(t)-(NT-4); if(jb_>=0)cmask(P0,P1,jb_,qrel,hi);}while(0)
  #define ENDW(tt) do{ if((tt)+3<NT){WAIT_BARW();} else if((tt)+2<NT){WAIT_BAR(1);} else {WAIT_BAR(0);} }while(0)
  for(;t+1<NT;t+=2){
    STEP(pB0,pB1,pA0,pA1,t,(t+3<NT),(t+1<NT),(t+1<NT));       ENDW(t);   RESC(); ROT();
    STEP(pA0,pA1,pB0,pB1,t+1,(t+4<NT),(t+2<NT),(t+2<NT));     ENDW(t+1); RESC(); ROT();
  }
  STEP(pB0,pB1,pA0,pA1,NT-1,false,false,false); RESC();
  { float sacc=pB0[0]+pB0[1]; _Pragma("unroll") for(int r=2;r<16;++r)sacc+=pB0[r]; _Pragma("unroll") for(int r=0;r<16;++r)sacc+=pB1[r]; l_reg+=sacc;
    pw0=(u32x4){PKW(pB0,0),PKW(pB0,2),PKW(pB0,4),PKW(pB0,6)};pw1=(u32x4){PKW(pB0,8),PKW(pB0,10),PKW(pB0,12),PKW(pB0,14)};pw2=(u32x4){PKW(pB1,0),PKW(pB1,2),PKW(pB1,4),PKW(pB1,6)};pw3=(u32x4){PKW(pB1,8),PKW(pB1,10),PKW(pB1,12),PKW(pB1,14)};
    SBAR(); pv(o,vb0+sl_cur,PAF(0),PAF(1),PAF(2),PAF(3)); }
  #undef PKW
  #undef PAF
  #undef VFR
  #undef PIN
  #undef MX3
  #undef GAPA
  #undef GAPB
  #undef EX
  #undef VRD
  #undef KRD
  #undef STEP
  #undef ENDW
  {auto rr=__builtin_amdgcn_permlane32_swap(__float_as_uint(l_reg),__float_as_uint(l_reg),false,false);l_reg=__uint_as_float(rr[0])+__uint_as_float(rr[1]);}
  if(hi==0)wsf[32+r32]=l_reg;asm volatile("s_waitcnt lgkmcnt(0)":::"memory");
  float rli[16];
  #pragma unroll
  for(int r=0;r<16;++r)rli[r]=__builtin_amdgcn_rcpf(wsf[32+crow(r,hi)]);
  bf16*Ow=O+(rowbase+q0+wid*QBLK)*DM+h*D;
  { bf16*stg=(bf16*)(shm+LDS_OST)+wid*2048;
    #pragma unroll
    for(int r=0;r<16;++r){const int orow=crow(r,hi);
      #pragma unroll
      for(int d0=0;d0<2;++d0)stg[orow*64+d0*32+r32]=__float2bfloat16(o[d0][r]*rli[r]);}
    asm volatile("s_waitcnt lgkmcnt(0)":::"memory");
    const bf16*Gw=GT+(rowbase+q0+wid*QBLK)*DM+h*D;
    #pragma unroll
    for(int i=0;i<4;++i){const int row=i*8+(lane>>3),ch=lane&7; u32x4 v=*(const u32x4*)(stg+row*64+ch*8); const u32x4 gg=*(const u32x4*)(Gw+(long)row*DM+ch*8);
      #pragma unroll
      for(int j=0;j<4;++j){ v[j]=cvtpk_s(__uint_as_float(v[j]<<16)*__uint_as_float(gg[j]<<16),__uint_as_float(v[j]&0xffff0000u)*__uint_as_float(gg[j]&0xffff0000u)); }
      ATTN_STORE16(Ow+(long)row*DM+ch*8,v);} }
  asm volatile("s_waitcnt lgkmcnt(0)\n\ts_barrier":::"memory");
  #undef DMA_K
  #undef DMA_V
  #undef CMASK
  #undef START
  #undef RESC
  #undef ROT
}
constexpr int ATTN_LDS_BYTES=LDS_BYTES;
struct AttnTensors { const bf16* Q; const bf16* K; const bf16* V; bf16* O; const bf16* GT; const unsigned char* G3; const float* qgain; float kbound; };
struct AttnUnit { int bh; int qb; };
struct StaticOrder {
  int vcu;
  __device__ __forceinline__ explicit StaticOrder(int grid,int block):vcu((block%8)*(grid/8)+block/8){}
  __device__ __forceinline__ bool next(int i,AttnUnit&u)const{ if(i>=4)return false; const int s=vcu&7; u.bh=vcu>>3; u.qb=(i==0)?s:(i==1)?15-s:(i==2)?16+s:31-s; return true; }
  __device__ __forceinline__ void a_ready(const AttnUnit&)const{}
  __device__ __forceinline__ void done(const AttnUnit&)const{}
};
template<class Sched,int THRL=8> __device__ __forceinline__ void attn_phase(char*lds,const AttnTensors&T,const Sched&S,const int tid_in){
  AttnUnit u;
  for(int i=0;S.next(i,u);++i){ S.a_ready(u); attn_unit<THRL>(u.bh/NHEAD,u.bh%NHEAD,u.qb,T.Q,T.K,T.V,T.O,T.GT,T.G3,T.qgain,T.kbound,lds,tid_in,0); S.done(u); }
}
__device__ __forceinline__ float g3val(const unsigned char*G3,long key){ const u32x4 ge=*reinterpret_cast<const u32x4*>(G3+key*16); return __uint_as_float(ge[0]<<16)+__uint_as_float(ge[0]&0xffff0000u)+__uint_as_float(ge[1]<<16); }
template<int THRL=8> __device__ __forceinline__ void attn_phase_dyn(char*lds,const AttnTensors&T,unsigned*counter,const float thr2,const int tid_in){
  int tid_l=tid_in; asm volatile("":"+v"(tid_l)); const int tid=tid_l,lane=tid&63;
  volatile unsigned*uw=(volatile unsigned*)(lds+LDS_BYTES);
  for(;;){
    if(tid==0){ const unsigned got=__hip_atomic_fetch_add(counter,1u,__ATOMIC_RELAXED,__HIP_MEMORY_SCOPE_AGENT); *uw=got; }
    __syncthreads();
    const unsigned u=(unsigned)__builtin_amdgcn_readfirstlane((int)*uw);
    if(u>=(unsigned)(BATCH*NHEAD*NQB))break;
    const int qb=NQB-1-(int)(u>>5), bh=(int)(u&31), ntf=4*qb+4;
    const long kb=(long)bh*SEQ; const float gt0=g3val(T.G3,kb+(long)qb*QB);
    bool skip0=false,skip1=false;
    if(lane<ntf) skip0=g3val(T.G3,kb+64*lane+63)<gt0-thr2;
    if(lane+64<ntf) skip1=g3val(T.G3,kb+64*(lane+64)+63)<gt0-thr2;
    int j0=__builtin_popcountll(__ballot(skip0))+__builtin_popcountll(__ballot(skip1));
    j0=__builtin_amdgcn_readfirstlane(j0); j0&=~1; if(j0>ntf-4)j0=ntf-4;
    attn_unit<THRL>(bh/NHEAD,bh%NHEAD,qb,T.Q,T.K,T.V,T.O,T.GT,T.G3,T.qgain,T.kbound,lds,tid_in,j0);
  }
}
#undef SBAR
#undef WAIT_BAR
#undef WAIT_BARW
}
constexpr int NWAVES = 8;
constexpr int BATCH = 2, T = 8192, D = 1024, H = 16, HD = 64, FF = 4096, M = BATCH * T;
constexpr int N1 = 3584, K1 = 2048, NP2 = 3072;
constexpr size_t MiB = 1u << 20;
constexpr size_t WS_MOD = 0;
constexpr size_t WS_W1 = 1 * MiB;
constexpr size_t WS_W2A = 29 * MiB;
constexpr size_t WS_W2G = 32 * MiB;
constexpr size_t WS_WO = 33 * MiB;
constexpr size_t WS_WKV = 37 * MiB;
constexpr size_t WS_WQG = 42 * MiB;
constexpr size_t WS_WO2 = 50 * MiB;
constexpr size_t WS_WUP = 54 * MiB, WS_WDN = 62 * MiB;
constexpr size_t WS_G3 = 70 * MiB;
constexpr size_t WS_FL = 74 * MiB;
constexpr size_t WS_H2 = 76 * MiB;
constexpr size_t WS_P1 = 140 * MiB;
constexpr size_t WS_P2 = 252 * MiB;
constexpr size_t WS_VF = 348 * MiB;
constexpr size_t WS_HB = 140 * MiB;
constexpr size_t WS_KVRAW = 140 * MiB, WS_QB = 204 * MiB, WS_GT = 236 * MiB, WS_VS = 316 * MiB, WS_KS = 348 * MiB;
constexpr size_t WS_END = 380 * MiB;
constexpr int LDS_BYTES = 147456;

#define GAS __attribute__((address_space(1)))
#define LAS __attribute__((address_space(3)))
typedef unsigned short bf16;
typedef unsigned v4u __attribute__((ext_vector_type(4)));
typedef unsigned v2u __attribute__((ext_vector_type(2)));
typedef float f32x4 __attribute__((ext_vector_type(4)));
using pg8::pkbf; using pg8::bflo; using pg8::bfhi; using pg8::sigm;

struct Args { const float* in[39]; float* out; unsigned char* ws; int ph_lo, ph_hi; };

struct Frame { LAS unsigned char* lds; int tid, lane, wave, vcu, G, bx; unsigned char* ws; float* out; const float* const* in; };

__device__ __forceinline__ void tr_item(const float* W, int ldw, int Nvalid, bf16* WT, int ldt, int row_off, int col_off, const float* mu, LAS float* scr, int item, int lane) {
    const int nblk = (Nvalid + 31) / 32, kb = item / nblk, nb = item % nblk, k0 = 64 * kb, n0 = 32 * nb;
    { float t[32]; const int n = n0 + (lane & 31); const bool ok = n < Nvalid; const float* wp = W + (size_t)(k0 + (lane >> 5)) * ldw + n;
#pragma unroll
      for (int i = 0; i < 32; ++i) t[i] = ok ? wp[(size_t)(2 * i) * ldw] : 0.f;
#pragma unroll
      for (int i = 0; i < 32; ++i) scr[(2 * i + (lane >> 5)) * 33 + (lane & 31)] = t[i]; }
    asm volatile("s_waitcnt lgkmcnt(0)" ::: "memory");
    const int c = lane & 7;
    float s0[8], s1[8];
#pragma unroll
    for (int q = 0; q < 8; ++q) { const float m = mu ? mu[k0 + 8 * c + q] : 0.f; s0[q] = 1.f - m; s1[q] = m; }
#pragma unroll
    for (int j = 0; j < 4; ++j) { const int n = (lane >> 3) + 8 * j; const LAS float* s = scr + (8 * c) * 33 + n;
        float v[8];
#pragma unroll
        for (int q = 0; q < 8; ++q) v[q] = s[q * 33];
        v4u o; o.x = pkbf(v[0] * s0[0], v[1] * s0[1]); o.y = pkbf(v[2] * s0[2], v[3] * s0[3]); o.z = pkbf(v[4] * s0[4], v[5] * s0[5]); o.w = pkbf(v[6] * s0[6], v[7] * s0[7]);
        bf16* dst = WT + (size_t)(row_off + n0 + n) * ldt + col_off + k0 + 8 * c;
        *(v4u*)dst = o;
        if (mu) { v4u p; p.x = pkbf(v[0] * s1[0], v[1] * s1[1]); p.y = pkbf(v[2] * s1[2], v[3] * s1[3]); p.z = pkbf(v[4] * s1[4], v[5] * s1[5]); p.w = pkbf(v[6] * s1[6], v[7] * s1[7]); *(v4u*)(dst + 1024) = p; } }
    asm volatile("s_waitcnt lgkmcnt(0)" ::: "memory");
}
__device__ __forceinline__ float dpp_f(float x, const int ctrl_sel) {
    switch (ctrl_sel) {
        case 0: return __builtin_bit_cast(float, __builtin_amdgcn_update_dpp(0, __builtin_bit_cast(int, x), 0xB1, 0xf, 0xf, false));
        case 1: return __builtin_bit_cast(float, __builtin_amdgcn_update_dpp(0, __builtin_bit_cast(int, x), 0x4E, 0xf, 0xf, false));
        case 2: return __builtin_bit_cast(float, __builtin_amdgcn_update_dpp(0, __builtin_bit_cast(int, x), 0x141, 0xf, 0xf, false));
        default: return __builtin_bit_cast(float, __builtin_amdgcn_update_dpp(0, __builtin_bit_cast(int, x), 0x140, 0xf, 0xf, false));
    }
}
__device__ __forceinline__ float sum4(float x) { x += dpp_f(x, 0); x += dpp_f(x, 1); return x; }
__device__ __forceinline__ float sum8(float x) { x = sum4(x); x += dpp_f(x, 2); return x; }
__device__ __forceinline__ float sum16(float x) { x = sum8(x); x += dpp_f(x, 3); return x; }
__device__ __forceinline__ float wave_sum(float v) {
    v = sum16(v);
    { auto rr = __builtin_amdgcn_permlane16_swap(__float_as_uint(v), __float_as_uint(v), false, false); v = __uint_as_float(rr[0]) + __uint_as_float(rr[1]); }
    { auto rr = __builtin_amdgcn_permlane32_swap(__float_as_uint(v), __float_as_uint(v), false, false); v = __uint_as_float(rr[0]) + __uint_as_float(rr[1]); }
    return v;
}
__device__ __forceinline__ void norm_row(const float* xrow, const float* g, const float* sh, const float* sc, int lane, f32x4 (&v)[4]) {
    float s = 0.f;
#pragma unroll
    for (int j = 0; j < 4; ++j) { v[j] = *((const f32x4*)xrow + lane + 64 * j); s += (v[j].x * v[j].x + v[j].y * v[j].y) + (v[j].z * v[j].z + v[j].w * v[j].w); }
    const float rstd = 1.0f / sqrtf(wave_sum(s) * (1.f / D) + 1e-6f);
#pragma unroll
    for (int j = 0; j < 4; ++j) { const f32x4 gg = *((const f32x4*)g + lane + 64 * j);
        f32x4 a = {1.f, 1.f, 1.f, 1.f}, b = {0.f, 0.f, 0.f, 0.f}; if (sc) { a = *((const f32x4*)sc + lane + 64 * j) + 1.0f; b = *((const f32x4*)sh + lane + 64 * j); }
        v[j] = (v[j] * rstd * gg) * a + b; }
}
__device__ __forceinline__ void st_row_bf16(bf16* orow, int lane, const f32x4 (&v)[4]) {
#pragma unroll
    for (int j = 0; j < 4; ++j) { v2u w; w.x = pkbf(v[j].x, v[j].y); w.y = pkbf(v[j].z, v[j].w); *((v2u*)orow + lane + 64 * j) = w; }
}
__device__ __forceinline__ void p0_mod(Frame& F) {
    LAS float* ca = (LAS float*)F.lds; LAS float* red = (LAS float*)(F.lds + 8192);
    const float* cin = F.in[1];
    for (int i = F.tid; i < 2048; i += 512) { const float c = cin[i]; ca[i] = c / (1.0f + __expf(-c)); }
    __syncthreads();
    float* MOD = (float*)(F.ws + WS_MOD); float* MODKV = MOD + 4 * 2 * 6144;
    for (int item = F.bx; item < 208; item += F.G) {
        const int col = item * 128; const float* W; const float* bias; int ldw, cw; float* dst0; float* dst1;
        if (col < 24576) { const int l = col / 6144; cw = col % 6144; W = F.in[2] + (size_t)l * 1024 * 6144; ldw = 6144; bias = F.in[3] + l * 6144; dst0 = MOD + (l * 2 + 0) * 6144 + cw; dst1 = MOD + (l * 2 + 1) * 6144 + cw; }
        else { cw = col - 24576; W = F.in[30]; ldw = 2048; bias = F.in[31]; dst0 = MODKV + cw; dst1 = MODKV + 2048 + cw; }
        const int c4 = F.tid & 31, ks = F.tid >> 5;
        f32x4 a0 = {0.f, 0.f, 0.f, 0.f}, a1 = {0.f, 0.f, 0.f, 0.f};
#pragma unroll 8
        for (int k = ks * 64; k < ks * 64 + 64; ++k) { const f32x4 w = *(const f32x4*)(W + (size_t)k * ldw + cw + c4 * 4); a0 += w * ca[k]; a1 += w * ca[1024 + k]; }
        *(LAS f32x4*)(red + (ks * 32 + c4) * 8) = a0; *(LAS f32x4*)(red + (ks * 32 + c4) * 8 + 4) = a1;
        __syncthreads();
        if (F.tid < 256) { const int b = F.tid >> 7, c = F.tid & 127; float s = 0.f;
#pragma unroll
            for (int q = 0; q < 16; ++q) s += red[(q * 32 + (c >> 2)) * 8 + b * 4 + (c & 3)];
            (b ? dst1 : dst0)[c] = s + bias[cw + c]; }
        __syncthreads();
    }
}
__device__ __forceinline__ void p0_weights(Frame& F) {
    LAS float* scr = (LAS float*)(F.lds + 16384 + F.wave * 16384);
    const int gw = F.vcu * NWAVES + F.wave, NGW = F.G * NWAVES;
    bf16* W1 = (bf16*)(F.ws + WS_W1); bf16* WO = (bf16*)(F.ws + WS_WO); bf16* WKV = (bf16*)(F.ws + WS_WKV); bf16* WQG = (bf16*)(F.ws + WS_WQG); bf16* WO2 = (bf16*)(F.ws + WS_WO2);
    const float* mu = F.in[8];
    constexpr int PL = 512 * 3 + 32 + 32 + 16 + 80 + 512;
    constexpr int NIT = 2 * PL + 512 + 512 + 16 + 2 * (1024 + 512);
    for (int it = gw; it < NIT; it += NGW) {
        int r = it;
        if (r < 2 * PL) { const int i = r / PL; r -= i * PL; bf16* w1 = W1 + (size_t)i * N1 * K1; const float* m6 = mu + i * 6 * 1024;
            bf16* wl = w1 + (size_t)3072 * 1024;
            if (r < 512) { tr_item(F.in[9] + (size_t)i * D * D, D, D, w1, D, 0, 0, nullptr, scr, r, F.lane); continue; } r -= 512;
            if (r < 512) { tr_item(F.in[10] + (size_t)i * D * D, D, D, w1, D, 1024, 0, nullptr, scr, r, F.lane); continue; } r -= 512;
            if (r < 512) { tr_item(F.in[11] + (size_t)i * D * D, D, D, w1, D, 2048, 0, nullptr, scr, r, F.lane); continue; } r -= 512;
            if (r < 32) { tr_item(F.in[14] + (size_t)i * D * 64, 64, 64, wl, K1, 0, 0, m6 + 1 * 1024, scr, r, F.lane); continue; } r -= 32;
            if (r < 32) { tr_item(F.in[17] + (size_t)i * D * 64, 64, 64, wl, K1, 64, 0, m6 + 4 * 1024, scr, r, F.lane); continue; } r -= 32;
            if (r < 16) { if (i == 1) tr_item(F.in[27], 32, 32, wl, K1, 128, 0, m6 + 3 * 1024, scr, r, F.lane); continue; } r -= 16;
            if (r < 80) { tr_item(F.in[19] + (size_t)i * D * 160, 160, 160, wl, K1, 160, 0, m6 + 5 * 1024, scr, r, F.lane); continue; } r -= 80;
            tr_item(F.in[12] + (size_t)i * D * D, D, D, WO + (size_t)i * D * D, D, 0, 0, nullptr, scr, r, F.lane); continue; }
        r -= 2 * PL;
        if (r < 512) { tr_item(F.in[32], 2064, 1024, WKV, D, 0, 0, nullptr, scr, r, F.lane); continue; } r -= 512;
        if (r < 512) { tr_item(F.in[32] + 1024, 2064, 1024, WKV, D, 1024, 0, nullptr, scr, r, F.lane); continue; } r -= 512;
        if (r < 16) { tr_item(F.in[32] + 2048, 2064, 16, WKV, D, 2048, 0, nullptr, scr, r, F.lane); continue; } r -= 16;
        { const int j = r / 1536; r -= j * 1536;
          if (r < 1024) tr_item(F.in[35] + (size_t)j * D * 2048, 2048, 2048, WQG + (size_t)j * 2048 * D, D, 0, 0, nullptr, scr, r, F.lane);
          else tr_item(F.in[37] + (size_t)j * D * D, D, D, WO2 + (size_t)j * D * D, D, 0, 0, nullptr, scr, r - 1024, F.lane); }
    }
    const int gt = F.bx * 512 + F.tid, NT = F.G * 512; const v4u z = {0u, 0u, 0u, 0u};
    for (int e = gt; e < 135168; e += NT) {
        int r = e; bf16* p;
        if (r < 98304) { const int i = r / 49152; r -= i * 49152; p = W1 + (size_t)i * N1 * K1 + (size_t)3072 * 1024 + (size_t)320 * K1 + (size_t)r * 8; }
        else if (r < 98304 + 8192) { r -= 98304; p = W1 + (size_t)3072 * 1024 + (size_t)128 * K1 + (size_t)r * 8; }
        else { r -= 98304 + 8192; p = WKV + (size_t)2080 * D + (size_t)r * 8; }
        *(v4u*)p = z; }
    { float* B2 = (float*)(F.ws + WS_MOD) + 53248;
      for (int e = gt; e < 2 * 3072; e += NT) { const int i = e / 3072, n = e % 3072, grp = n >> 10, c = n & 1023;
          B2[e] = grp == 0 ? F.in[13][i * D + c] : (grp == 1 ? F.in[16][i * D + c] : (i == 1 ? F.in[26][c] : 0.f)); } }
    bf16* W2A = (bf16*)(F.ws + WS_W2A); bf16* W2G = (bf16*)(F.ws + WS_W2G);
    for (int e4 = gt; e4 < 2 * 262144; e4 += NT) {
        const int i = e4 >> 18; int r = (e4 & 262143) * 4;
        if (r < 786432) { const int k = r / 3072, n = r % 3072, grp = n >> 10, c = n & 1023; f32x4 v = {0.f, 0.f, 0.f, 0.f};
            if (grp == 0) { if (k < 64) v = *(const f32x4*)(F.in[15] + ((size_t)i * 64 + k) * 1024 + c); }
            else if (grp == 1) { if (k >= 64 && k < 128) v = *(const f32x4*)(F.in[18] + ((size_t)i * 64 + (k - 64)) * 1024 + c); }
            else { if (i == 1 && k >= 128 && k < 160) v = *(const f32x4*)(F.in[28] + (size_t)(k - 128) * 1024 + c); }
            bf16* o = W2A + (size_t)i * 3072 * 256 + (size_t)n * 256 + k; const unsigned p0 = pkbf(v.x, v.y), p1 = pkbf(v.z, v.w);
            o[0] = (bf16)(p0 & 0xffffu); o[256] = (bf16)(p0 >> 16); o[512] = (bf16)(p1 & 0xffffu); o[768] = (bf16)(p1 >> 16); }
        else { r -= 786432; const int k = r >> 10, n = r & 1023; f32x4 v = {0.f, 0.f, 0.f, 0.f}; if (k < 160) v = *(const f32x4*)(F.in[20] + ((size_t)i * 160 + k) * 1024 + n);
            bf16* o = W2G + (size_t)i * 1024 * 256 + (size_t)n * 256 + k; const unsigned p0 = pkbf(v.x, v.y), p1 = pkbf(v.z, v.w);
            o[0] = (bf16)(p0 & 0xffffu); o[256] = (bf16)(p0 >> 16); o[512] = (bf16)(p1 & 0xffffu); o[768] = (bf16)(p1 >> 16); }
    }
}
__device__ __forceinline__ void mlp_weights(Frame& F, int L) {
    LAS float* scr = (LAS float*)(F.lds + F.wave * 16384);
    const int gw = F.vcu * NWAVES + F.wave, NGW = F.G * NWAVES;
    bf16* WUP = (bf16*)(F.ws + WS_WUP); bf16* WDN = (bf16*)(F.ws + WS_WDN);
    for (int it = gw; it < 4096; it += NGW) {
        if (it < 2048) tr_item(F.in[6] + (size_t)L * D * FF, FF, FF, WUP, D, 0, 0, nullptr, scr, it, F.lane);
        else tr_item(F.in[7] + (size_t)L * FF * D, D, D, WDN, FF, 0, 0, nullptr, scr, it - 2048, F.lane);
    }
}
__device__ __forceinline__ void norm_phase(Frame& F, const float* xin, const float* g, const float* sh, const float* sc, int bstride, int mode, bf16* dst, float* outf = nullptr) {
    const int gw = F.vcu * NWAVES + F.wave, NGW = F.G * NWAVES, lane = F.lane; (void)mode;
    for (int base = gw * 8; base < M; base += NGW * 8) {
        const int b = base >> 13;
        f32x4 gg[4], aa[4], bb[4];
#pragma unroll
        for (int j = 0; j < 4; ++j) { gg[j] = *((const f32x4*)g + lane + 64 * j);
            aa[j] = sc ? *((const f32x4*)(sc + b * bstride) + lane + 64 * j) + 1.0f : (f32x4){1.f, 1.f, 1.f, 1.f}; bb[j] = sh ? *((const f32x4*)(sh + b * bstride) + lane + 64 * j) : (f32x4){0.f, 0.f, 0.f, 0.f}; }
        f32x4 xn[4];
#pragma unroll
        for (int j = 0; j < 4; ++j) xn[j] = *((const f32x4*)(xin + (size_t)base * D) + lane + 64 * j);
#pragma unroll 1
        for (int r = 0; r < 8; ++r) { const int m = base + r; f32x4 v[4]; float s = 0.f;
#pragma unroll
            for (int j = 0; j < 4; ++j) { v[j] = xn[j]; s += (v[j].x * v[j].x + v[j].y * v[j].y) + (v[j].z * v[j].z + v[j].w * v[j].w); }
            if (r + 1 < 8) {
#pragma unroll
                for (int j = 0; j < 4; ++j) xn[j] = *((const f32x4*)(xin + (size_t)(m + 1) * D) + lane + 64 * j); }
            const float rstd = 1.0f / sqrtf(wave_sum(s) * (1.f / D) + 1e-6f);
#pragma unroll
            for (int j = 0; j < 4; ++j) v[j] = (v[j] * rstd * gg[j]) * aa[j] + bb[j];
            if (outf) {
#pragma unroll
                for (int j = 0; j < 4; ++j) *((f32x4*)(outf + (size_t)m * D) + lane + 64 * j) = v[j]; }
            else st_row_bf16(dst + (size_t)m * 1024, lane, v);
        }
    }
}
__device__ __forceinline__ void norm_mix_phase(Frame& F, const float* xin, const float* g, const float* sh, const float* sc, const float* mu, bf16* H2p, bf16* XJ) {
    const int gw = F.vcu * NWAVES + F.wave, NGW = F.G * NWAVES, lane = F.lane;
    for (int base = gw * 8; base < M; base += NGW * 8) {
        const int b = base >> 13;
        f32x4 gg[4], aa[4], bb[4], m0[4], m1[4], m2[4];
#pragma unroll
        for (int j = 0; j < 4; ++j) { gg[j] = *((const f32x4*)g + lane + 64 * j); aa[j] = *((const f32x4*)(sc + b * 6144) + lane + 64 * j) + 1.0f; bb[j] = *((const f32x4*)(sh + b * 6144) + lane + 64 * j);
            m0[j] = *((const f32x4*)mu + lane + 64 * j); m1[j] = *((const f32x4*)(mu + 2048) + lane + 64 * j); m2[j] = *((const f32x4*)(mu + 3072) + lane + 64 * j); }
        const bool first = (base & 8191) == 0; const int r0 = first ? 0 : -1;
        f32x4 hp[4], xn[4];
#pragma unroll
        for (int j = 0; j < 4; ++j) { hp[j] = (f32x4){0.f, 0.f, 0.f, 0.f}; xn[j] = *((const f32x4*)(xin + (size_t)(base + r0) * D) + lane + 64 * j); }
#pragma unroll 1
        for (int r = r0; r < 8; ++r) { const int m = base + r; f32x4 v[4];
            float s = 0.f;
#pragma unroll
            for (int j = 0; j < 4; ++j) { v[j] = xn[j]; s += (v[j].x * v[j].x + v[j].y * v[j].y) + (v[j].z * v[j].z + v[j].w * v[j].w); }
            if (r + 1 < 8) {
#pragma unroll
                for (int j = 0; j < 4; ++j) xn[j] = *((const f32x4*)(xin + (size_t)(m + 1) * D) + lane + 64 * j); }
            const float rstd = 1.0f / sqrtf(wave_sum(s) * (1.f / D) + 1e-6f);
#pragma unroll
            for (int j = 0; j < 4; ++j) v[j] = (v[j] * rstd * gg[j]) * aa[j] + bb[j];
            if (r >= 0) {
                st_row_bf16(H2p + (size_t)m * 2048, lane, v); st_row_bf16(H2p + (size_t)m * 2048 + 1024, lane, hp);
                f32x4 x[4];
#pragma unroll
                for (int j = 0; j < 4; ++j) x[j] = v[j] + (hp[j] - v[j]) * m0[j];
                st_row_bf16(XJ + (size_t)m * D, lane, x);
#pragma unroll
                for (int j = 0; j < 4; ++j) x[j] = v[j] + (hp[j] - v[j]) * m1[j];
                st_row_bf16(XJ + (size_t)M * D + (size_t)m * D, lane, x);
#pragma unroll
                for (int j = 0; j < 4; ++j) x[j] = v[j] + (hp[j] - v[j]) * m2[j];
                st_row_bf16(XJ + (size_t)2 * M * D + (size_t)m * D, lane, x);
            }
#pragma unroll
            for (int j = 0; j < 4; ++j) hp[j] = v[j]; }
    }
}
__device__ __forceinline__ void final_norm_phase(Frame& F) { norm_phase(F, F.out, F.in[38], nullptr, nullptr, 0, 1, nullptr, F.out); }
#ifndef PROBE_SC
#define PROBE_SC 0
#endif
constexpr int SC_C = 32, SC_NC = T / SC_C;
constexpr int SC_VEC = 0, SC_REC = 36864, SC_Y = 38912, SC_BUF = 55296;
typedef float f32x2s __attribute__((ext_vector_type(2)));
__device__ __forceinline__ float dot4(const f32x4 s, const f32x4 a) { f32x2s t = (f32x2s){s.x, s.y} * (f32x2s){a.x, a.y}; t = (f32x2s){s.z, s.w} * (f32x2s){a.z, a.w} + t; return t.x + t.y; }
__device__ __forceinline__ void scan_chunk(const LAS unsigned char* Bc, f32x4& S, const int kq, const int rowi) {
                const LAS f32x4* pvec = (const LAS f32x4*)(Bc + SC_VEC) + kq; const LAS f32x4* prec = (const LAS f32x4*)(Bc + SC_REC) + rowi;
                LAS float* py = (LAS float*)(Bc + SC_Y) + rowi * 16 + kq;
                f32x4 cv[9], cs;
#pragma unroll
                for (int j = 0; j < 9; ++j) cv[j] = pvec[j * 16];
                cs = prec[0];
#pragma unroll
                for (int p = 0; p < SC_C / 2; ++p) {
                    f32x4 nv[9], ns;
                    if (p + 1 < SC_C / 2) {
#pragma unroll
                        for (int j = 0; j < 9; ++j) nv[j] = pvec[((p + 1) * 9 + j) * 16];
                        ns = prec[(p + 1) * 8];
                    }
                    __builtin_amdgcn_sched_barrier(0);
                    float p1 = dot4(S, cv[0]), p2 = dot4(S, cv[1]); const float p3 = dot4(S, cv[2]);
                    p1 += dpp_f(p1, 0); p2 += dpp_f(p2, 0);
                    p1 += dpp_f(p1, 1); p2 += dpp_f(p2, 1);
                    p1 += dpp_f(p1, 2); p2 += dpp_f(p2, 2);
                    p1 += dpp_f(p1, 3); p2 += dpp_f(p2, 3);
                    const float sa1 = fmaf(cs.x, cs.z, p2);
                    const float y0 = p3 + ((kq == 0) ? cs.x * cs.w : 0.f);
                    const f32x4 t0 = S * cv[3] + cv[4] * p1 + cv[5] * cs.x + cv[7] * cs.y;
                    S = t0 + cv[6] * sa1;
                    const float y1 = dot4(S, cv[8]);
                    py[(2 * p) * 128] = y0; py[(2 * p + 1) * 128] = y1;
                    if (p + 1 < SC_C / 2) {
#pragma unroll
                        for (int j = 0; j < 9; ++j) cv[j] = nv[j];
                        cs = ns;
                    }
                }
}
__device__ __forceinline__ void scan_phase(Frame& F, int L) {
    const bf16* P1 = (const bf16*)(F.ws + WS_P1); const bf16* P2 = (const bf16*)(F.ws + WS_P2); const bf16* VF = (const bf16*)(F.ws + WS_VF); float* Y = (float*)(F.ws + WS_H2);
    const float* kkw = F.in[21] + L * D; const float* kaw = F.in[22] + L * D;
    const int lane = F.lane;
    int wave;
    { LAS unsigned* tb = (LAS unsigned*)(F.lds + LDS_BYTES - 2048);
      const unsigned simd = ((unsigned)__builtin_amdgcn_s_getreg((1 << 11) | (4 << 6) | 4)) & 3u;
      if (lane == 0) tb[F.wave] = simd;
      __syncthreads();
      unsigned sd[8];
#pragma unroll
      for (int w = 0; w < 8; ++w) sd[w] = tb[w];
      int B = 1;
#pragma unroll
      for (int w = 7; w >= 1; --w) if (sd[w] != sd[0]) B = w;
      int total_non = 0, non_before = 0, share_before = 0; bool my_share = false;
#pragma unroll
      for (int w = 1; w < 8; ++w) { const bool sh = (sd[w] == sd[0]) || (sd[w] == sd[B]); const bool other = (w != B);
          if (other && !sh) { ++total_non; if (w < F.wave) ++non_before; }
          if (other && sh && w < F.wave) ++share_before;
          if (w == F.wave) my_share = sh; }
      int role;
      if (F.wave == 0) role = 0; else if (F.wave == B) role = 1; else role = my_share ? (2 + total_non + share_before) : (2 + non_before);
      wave = __builtin_amdgcn_readfirstlane(role);
      __syncthreads(); }
    for (int item = F.bx; item < 256; item += F.G) {
        const int bh = (item & 7) + 8 * (item >> 6), rg = (item >> 3) & 7, b = bh >> 4, h = bh & 15;
        const size_t m0 = (size_t)b * T;
        const int hidx = (wave - 2) * 64 + lane, hp = (hidx >> 4) & 15, hc4 = hidx & 15;
        const int vtt = lane >> 1, vr4 = (lane & 1) * 4;
        float ckk[4], cka[4];
        v2u lr[2][2], lk[2][2], lw[2][2], la[2][2]; v2u lv[2], lvm[2], lvf[2];
#pragma unroll
        for (int q = 0; q < 2; ++q) { lv[q] = (v2u){0u,0u}; lvm[q] = (v2u){0u,0u}; lvf[q] = (v2u){0u,0u};
#pragma unroll
            for (int u = 0; u < 2; ++u) { lr[q][u] = (v2u){0u,0u}; lk[q][u] = (v2u){0u,0u}; lw[q][u] = (v2u){0u,0u}; la[q][u] = (v2u){0u,0u}; } }
        if (wave >= 2 && wave < 6) {
#pragma unroll
            for (int j = 0; j < 4; ++j) { ckk[j] = kkw[h * 64 + hc4 * 4 + j]; cka[j] = kaw[h * 64 + hc4 * 4 + j]; } }
#define SC_LOAD(c, Q) do { \
        if (wave >= 2 && wave < 6) { _Pragma("unroll") for (int u = 0; u < 2; ++u) { const size_t m = m0 + (size_t)(c) * SC_C + 2 * hp + u; const bf16* p1 = P1 + m * N1 + h * 64 + hc4 * 4; const bf16* p2 = P2 + m * NP2 + h * 64 + hc4 * 4; \
            lr[Q][u] = *(const v2u*)p1; lk[Q][u] = *(const v2u*)(p1 + 1024); lw[Q][u] = *(const v2u*)p2; la[Q][u] = *(const v2u*)(p2 + 1024); } } \
        else if (wave == 6) { const size_t m = m0 + (size_t)(c) * SC_C + vtt; const int cc = h * 64 + rg * 8 + vr4; \
            lv[Q] = *(const v2u*)(P1 + m * N1 + 2048 + cc); if (L == 1) { lvm[Q] = *(const v2u*)(P2 + m * NP2 + 2048 + cc); lvf[Q] = *(const v2u*)(VF + m * D + cc); } } } while (0)
#define SC_PREP(buf, Q) do { LAS unsigned char* B_ = F.lds + (buf) * SC_BUF; \
        if (wave >= 2 && wave < 6) { f32x4 an[2], bb[2], k2[2], ww[2], rr[2]; \
            _Pragma("unroll") for (int u = 0; u < 2; ++u) { \
                const float kr[4] = {bflo(lk[Q][u].x), bfhi(lk[Q][u].x), bflo(lk[Q][u].y), bfhi(lk[Q][u].y)}, av[4] = {bflo(la[Q][u].x), bfhi(la[Q][u].x), bflo(la[Q][u].y), bfhi(la[Q][u].y)}; \
                const float wn[4] = {bflo(lw[Q][u].x), bfhi(lw[Q][u].x), bflo(lw[Q][u].y), bfhi(lw[Q][u].y)}, rv[4] = {bflo(lr[Q][u].x), bfhi(lr[Q][u].x), bflo(lr[Q][u].y), bfhi(lr[Q][u].y)}; \
                float kv_[4], ss = 0.f; \
                _Pragma("unroll") for (int j = 0; j < 4; ++j) { kv_[j] = kr[j] * ckk[j]; ss += kv_[j] * kv_[j]; } \
                ss = sum16(ss); const float inv = 1.0f / fmaxf(sqrtf(ss), 1e-12f); \
                _Pragma("unroll") for (int j = 0; j < 4; ++j) { const float kk = kv_[j] * inv; an[u][j] = -kk; bb[u][j] = kk * av[j]; k2[u][j] = kr[j] * (1.0f + (av[j] - 1.0f) * cka[j]); ww[u][j] = __expf(wn[j]); rr[u][j] = rv[j]; } } \
            LAS f32x4* V_ = (LAS f32x4*)(B_ + SC_VEC) + (hp * 9) * 16 + hc4; \
            float s0 = dot4(bb[0], rr[0]), s1 = dot4(k2[0], rr[0]), s2 = dot4(bb[0], an[1]), s3 = dot4(k2[0], an[1]); \
            s0 = sum16(s0); s1 = sum16(s1); s2 = sum16(s2); s3 = sum16(s3); \
            V_[0 * 16] = an[0]; V_[1 * 16] = ww[0] * an[1] + an[0] * s2; V_[2 * 16] = ww[0] * rr[0] + an[0] * s0; V_[3 * 16] = ww[0] * ww[1]; V_[4 * 16] = bb[0] * ww[1]; V_[5 * 16] = k2[0] * ww[1]; V_[6 * 16] = bb[1]; V_[7 * 16] = k2[1]; V_[8 * 16] = rr[1]; \
            if (hc4 == 0) { _Pragma("unroll") for (int row_ = 0; row_ < 8; ++row_) *(LAS f32x2s*)(B_ + SC_REC + (hp * 8 + row_) * 16 + 8) = (f32x2s){s3, s1}; } } \
        else if (wave == 6) { float v_[4] = {bflo(lv[Q].x), bfhi(lv[Q].x), bflo(lv[Q].y), bfhi(lv[Q].y)}; \
            if (L == 1) { const float f_[4] = {bflo(lvf[Q].x), bfhi(lvf[Q].x), bflo(lvf[Q].y), bfhi(lvf[Q].y)}, g_[4] = {bflo(lvm[Q].x), bfhi(lvm[Q].x), bflo(lvm[Q].y), bfhi(lvm[Q].y)}; \
                _Pragma("unroll") for (int j = 0; j < 4; ++j) v_[j] = v_[j] + (f_[j] - v_[j]) * g_[j]; } \
            _Pragma("unroll") for (int j = 0; j < 4; ++j) *(LAS float*)(B_ + SC_REC + ((vtt >> 1) * 8 + vr4 + j) * 16 + (vtt & 1) * 4) = v_[j]; } } while (0)
#define SC_YRED(bufi) f32x4 yv; do { const LAS f32x4* q_ = (const LAS f32x4*)(F.lds + (bufi) * SC_BUF + SC_Y) + (vtt * 8 + vr4) * 4; \
            _Pragma("unroll") for (int r_ = 0; r_ < 4; ++r_) { const f32x4 t0 = q_[r_ * 4], t1 = q_[r_ * 4 + 1], t2 = q_[r_ * 4 + 2], t3 = q_[r_ * 4 + 3]; const f32x4 t = (t0 + t1) + (t2 + t3); yv[r_] = (t.x + t.y) + (t.z + t.w); } } while (0)
        SC_LOAD(0, 0); SC_PREP(0, 0); SC_LOAD(1, 1);
        __syncthreads();
        f32x4 S = {0.f, 0.f, 0.f, 0.f};
        const int rl = lane >> 4, kq = lane & 15, rowi = (wave & 1) * 4 + rl;
#define SC_ITER(c, QL, QP) do { const int buf = (c) & 1; \
            if (wave < 2) { if (PROBE_SC == 2) { f32x4 S2 = S; scan_chunk(F.lds + buf * SC_BUF, S2, kq, rowi); asm volatile("" :: "v"(S2) : "memory"); } scan_chunk(F.lds + buf * SC_BUF, S, kq, rowi); } \
            else { if ((c) + 2 < SC_NC) SC_LOAD((c) + 2, QL); \
                if ((c) + 1 < SC_NC) SC_PREP(buf ^ 1, QP); \
                if (PROBE_SC == 1 && (c) + 1 < SC_NC) { asm volatile("" ::: "memory"); SC_PREP(buf ^ 1, QP); } \
                if (wave == 7 && (c) > 0) { SC_YRED(buf ^ 1); *(f32x4*)(Y + (m0 + (size_t)((c) - 1) * SC_C + vtt) * D + h * 64 + rg * 8 + vr4) = yv; } } \
            asm volatile("s_waitcnt lgkmcnt(0)\n\ts_barrier" ::: "memory"); } while (0)
        for (int c = 0; c < SC_NC; c += 2) { SC_ITER(c, 0, 1); SC_ITER(c + 1, 1, 0); }
#undef SC_ITER
        if (wave == 7) { SC_YRED((SC_NC - 1) & 1);
            *(f32x4*)(Y + (m0 + (size_t)(SC_NC - 1) * SC_C + vtt) * D + h * 64 + rg * 8 + vr4) = yv; }
        __syncthreads();
#undef SC_LOAD
#undef SC_PREP
#undef SC_YRED
    }
}
__device__ __forceinline__ void post_phase(Frame& F, int L) {
    const bf16* P1 = (const bf16*)(F.ws + WS_P1); const bf16* P2 = (const bf16*)(F.ws + WS_P2); bf16* VF = (bf16*)(F.ws + WS_VF); float* Y = (float*)(F.ws + WS_H2);
    const int gw = F.vcu * NWAVES + F.wave, NGW = F.G * NWAVES, lane = F.lane, c0 = lane * 16;
    const float* kaw = F.in[22] + L * D + c0; const float* rkw = F.in[23] + L * D + c0; const float* lnw = F.in[24] + L * D + c0; const float* lnb = F.in[25] + L * D + c0;
    for (int m = gw; m < M; m += NGW) {
        float y[16], r[16], k[16], v[16], a[16];
        const float* yp = Y + (size_t)m * D + c0;
#pragma unroll
        for (int q = 0; q < 4; ++q) { const f32x4 t = *(const f32x4*)(yp + 4 * q); y[4 * q] = t.x; y[4 * q + 1] = t.y; y[4 * q + 2] = t.z; y[4 * q + 3] = t.w; }
        const bf16* p1 = P1 + (size_t)m * N1 + c0; const bf16* p2 = P2 + (size_t)m * NP2 + c0;
        v4u rv[2], kv[2], vv[2], av[2];
#pragma unroll
        for (int q = 0; q < 2; ++q) { rv[q] = *(const v4u*)(p1 + 8 * q); kv[q] = *(const v4u*)(p1 + 1024 + 8 * q); vv[q] = *(const v4u*)(p1 + 2048 + 8 * q); av[q] = *(const v4u*)(p2 + 1024 + 8 * q); }
#pragma unroll
        for (int q = 0; q < 2; ++q)
#pragma unroll
            for (int j = 0; j < 4; ++j) { r[8 * q + 2 * j] = bflo(rv[q][j]); r[8 * q + 2 * j + 1] = bfhi(rv[q][j]); k[8 * q + 2 * j] = bflo(kv[q][j]); k[8 * q + 2 * j + 1] = bfhi(kv[q][j]);
                v[8 * q + 2 * j] = bflo(vv[q][j]); v[8 * q + 2 * j + 1] = bfhi(vv[q][j]); a[8 * q + 2 * j] = bflo(av[q][j]); a[8 * q + 2 * j + 1] = bfhi(av[q][j]); }
        if (L == 0) { *(v4u*)(VF + (size_t)m * D + c0) = vv[0]; *(v4u*)(VF + (size_t)m * D + c0 + 8) = vv[1]; }
        else { v4u fv[2], gv[2];
#pragma unroll
            for (int q = 0; q < 2; ++q) { fv[q] = *(const v4u*)(VF + (size_t)m * D + c0 + 8 * q); gv[q] = *(const v4u*)(p2 + 2048 + 8 * q); }
#pragma unroll
            for (int q = 0; q < 2; ++q)
#pragma unroll
                for (int j = 0; j < 4; ++j) { const float f0 = bflo(fv[q][j]), f1 = bfhi(fv[q][j]), g0 = bflo(gv[q][j]), g1 = bfhi(gv[q][j]);
                    v[8 * q + 2 * j] += (f0 - v[8 * q + 2 * j]) * g0; v[8 * q + 2 * j + 1] += (f1 - v[8 * q + 2 * j + 1]) * g1; } }
        float s = 0.f, bd = 0.f;
#pragma unroll
        for (int j = 0; j < 16; ++j) { s += y[j]; const float k2 = k[j] * (1.0f + (a[j] - 1.0f) * kaw[j]); bd += r[j] * k2 * rkw[j]; }
        s = sum4(s); bd = sum4(bd);
        const float mean = s * (1.0f / 64.0f); float q2 = 0.f;
#pragma unroll
        for (int j = 0; j < 16; ++j) { const float d = y[j] - mean; q2 += d * d; }
        q2 = sum4(q2);
        const float rstd = 1.0f / sqrtf(q2 * (1.0f / 64.0f) + 64e-5f);
        float o[16];
#pragma unroll
        for (int j = 0; j < 16; ++j) o[j] = (y[j] - mean) * rstd * lnw[j] + lnb[j] + bd * v[j];
        bf16* yn = (bf16*)(Y + (size_t)m * D) + c0;
        v4u w0, w1; w0.x = pkbf(o[0], o[1]); w0.y = pkbf(o[2], o[3]); w0.z = pkbf(o[4], o[5]); w0.w = pkbf(o[6], o[7]); w1.x = pkbf(o[8], o[9]); w1.y = pkbf(o[10], o[11]); w1.z = pkbf(o[12], o[13]); w1.w = pkbf(o[14], o[15]);
        *(v4u*)yn = w0; *(v4u*)(yn + 8) = w1;
    }
}
__device__ __forceinline__ void kvpost_phase(Frame& F) {
    const bf16* KV = (const bf16*)(F.ws + WS_KVRAW); bf16* KS = (bf16*)(F.ws + WS_KS);
    const int gw = F.vcu * NWAVES + F.wave, NGW = F.G * NWAVES, lane = F.lane, c0 = lane * 16;
    const float* kg = F.in[34] + (c0 & 63);
    for (int m = gw; m < M; m += NGW) {
        const bf16* p = KV + (size_t)m * 2048 + c0; v4u kv[2];
#pragma unroll
        for (int q = 0; q < 2; ++q) kv[q] = *(const v4u*)(p + 8 * q);
        float k[16], ss = 0.f;
#pragma unroll
        for (int q = 0; q < 2; ++q)
#pragma unroll
            for (int j = 0; j < 4; ++j) { k[8 * q + 2 * j] = bflo(kv[q][j]); k[8 * q + 2 * j + 1] = bfhi(kv[q][j]); }
#pragma unroll
        for (int j = 0; j < 16; ++j) ss += k[j] * k[j];
        ss = sum4(ss); const float rs = 1.0f / sqrtf(ss * (1.0f / 64.0f) + 1e-6f);
        v4u w0, w1;
        w0.x = pkbf(k[0] * rs * kg[0], k[1] * rs * kg[1]); w0.y = pkbf(k[2] * rs * kg[2], k[3] * rs * kg[3]); w0.z = pkbf(k[4] * rs * kg[4], k[5] * rs * kg[5]); w0.w = pkbf(k[6] * rs * kg[6], k[7] * rs * kg[7]);
        w1.x = pkbf(k[8] * rs * kg[8], k[9] * rs * kg[9]); w1.y = pkbf(k[10] * rs * kg[10], k[11] * rs * kg[11]); w1.z = pkbf(k[12] * rs * kg[12], k[13] * rs * kg[13]); w1.w = pkbf(k[14] * rs * kg[14], k[15] * rs * kg[15]);
        *(v4u*)(KS + (size_t)m * D + c0) = w0; *(v4u*)(KS + (size_t)m * D + c0 + 8) = w1;
    }
    if (gw < 32) {
        const int bh = gw, b = bh >> 4, h = bh & 15; const float* FL = (const float*)(F.ws + WS_FL) + ((size_t)b * T + (size_t)lane * 128) * 16 + h; const float fb = F.in[33][h];
        v4u* G3 = (v4u*)(F.ws + WS_G3) + (size_t)bh * T + (size_t)lane * 128;
        float tot = 0.f;
#pragma unroll 8
        for (int i = 0; i < 128; ++i) { const float x = FL[(size_t)i * 16] + fb; tot += -(fmaxf(-x, 0.f) + log1pf(__expf(-fabsf(x)))); }
        float inc = tot;
#pragma unroll
        for (int o = 1; o < 64; o <<= 1) { const float n = __int_as_float(__builtin_amdgcn_ds_bpermute((lane - o) << 2, __float_as_int(inc))); if (lane >= o) inc += n; }
        float run = inc - tot;
#pragma unroll 8
        for (int i = 0; i < 128; ++i) { const float x = FL[(size_t)i * 16] + fb; run += -(fmaxf(-x, 0.f) + log1pf(__expf(-fabsf(x))));
            const float gv = -run * 1.4426950408889634f;
            const unsigned hi = pkbf(gv, 0.f) & 0xffffu; const float r1 = gv - __uint_as_float(hi << 16);
            const unsigned mid = pkbf(r1, 0.f) & 0xffffu; const float r2 = r1 - __uint_as_float(mid << 16);
            const unsigned lo = pkbf(r2, 0.f) & 0xffffu;
            G3[i] = (v4u){hi | (mid << 16), lo, 0u, 0u}; }
    }
}
constexpr size_t WS_BAR = 512 * 1024, BAR_BYTES = 16384; constexpr int MISC_OFF = LDS_BYTES - 1024;
#define RLX_AGENT __ATOMIC_RELAXED, __HIP_MEMORY_SCOPE_AGENT
#define LDS_WAIT() asm volatile("s_waitcnt lgkmcnt(0)" ::: "memory")
#define VM_WAIT() asm volatile("s_waitcnt vmcnt(0)" ::: "memory")
__device__ __forceinline__ unsigned long long rt() { return __builtin_amdgcn_s_memrealtime(); }
__device__ __forceinline__ unsigned f2bf(float f) { unsigned u = __builtin_bit_cast(unsigned, f); return (u + 0x7fffu + ((u >> 16) & 1u)) >> 16; }
__device__ __forceinline__ unsigned pk2(float lo, float hi) { return f2bf(lo) | (f2bf(hi) << 16); }

#define XB_TMO      128
#define XB_XCNT(j)  (256  + 64 * (j))
#define XB_XSUB(j)  (1280 + 64 * (j))
#define XB_XGEN(j)  (2304 + 64 * (j))
#define XB_TOP      3328
#define XB_TOPGEN   3392
#define XCD_BAR_WORDS 3456
#define XB_SPIN_CAP (1u << 18)

__device__ __forceinline__ unsigned xb_ld(unsigned* p)              { return __hip_atomic_load(p, __ATOMIC_RELAXED, __HIP_MEMORY_SCOPE_AGENT); }
__device__ __forceinline__ unsigned xb_add(unsigned* p, unsigned v) { return __hip_atomic_fetch_add(p, v, __ATOMIC_RELAXED, __HIP_MEMORY_SCOPE_AGENT); }
__device__ __forceinline__ unsigned xb_xcc_id() { return (unsigned)__builtin_amdgcn_s_getreg((3 << 11) | 20) & 0xFu; }
#define XB_SPIN(cond, bar) do { unsigned _sp = 0; while (cond) { __builtin_amdgcn_s_sleep(1); \
    if ((++_sp & 255u) == 0u) { if (xb_ld(&(bar)[XB_TMO])) break; if (_sp > XB_SPIN_CAP) { atomicAdd(&(bar)[XB_TMO], 1u); break; } } } } while (0)

struct XcdBarrier {
    unsigned* bar; unsigned x;
    volatile LAS unsigned* st;
};

__device__ __forceinline__ XcdBarrier xcd_barrier_post(unsigned* bar, volatile LAS unsigned* st, const int tid) {
    XcdBarrier b; b.bar = bar; b.x = xb_xcc_id(); b.st = st;
    if (tid == 0) (void)xb_add(&bar[XB_XCNT(b.x)], 1u);
    return b;
}
__device__ __forceinline__ void xcd_barrier_complete(unsigned* bar, unsigned x, unsigned& nloc, unsigned& nx) {
    const unsigned G = gridDim.x * gridDim.y * gridDim.z;
    unsigned sum, cnt, mine, sp = 0u;
    for (;;) {
        sum = 0u; cnt = 0u; mine = 0u;
#pragma unroll
        for (unsigned j = 0; j < 16; ++j) { const unsigned c = xb_ld(&bar[XB_XCNT(j)]); sum += c; cnt += (c > 0u) ? 1u : 0u; mine = (j == x) ? c : mine; }
        if (sum == G) break;
        __builtin_amdgcn_s_sleep(1);
        if ((++sp & 255u) == 0u) { if (xb_ld(&bar[XB_TMO])) break; if (sp > XB_SPIN_CAP) { atomicAdd(&bar[XB_TMO], 1u); break; } }
    }
    nloc = mine > 0u ? mine : 1u; nx = cnt > 0u ? cnt : 1u;
}

__device__ __forceinline__ void xcd_barrier(const XcdBarrier& b, const int tid) {
    asm volatile("s_waitcnt vmcnt(0)" ::: "memory");
    __syncthreads();
    if (tid == 0) {
        unsigned* bar = b.bar;
        __builtin_amdgcn_s_waitcnt(0);
        unsigned nloc = b.st[0], nx = b.st[1];
        if (nloc == 0u) { xcd_barrier_complete(bar, b.x, nloc, nx); b.st[0] = nloc; b.st[1] = nx; }
        const unsigned old = xb_add(&bar[XB_XSUB(b.x)], 1u);
        const unsigned gen = old / nloc;
        if (old + 1u == (gen + 1u) * nloc) {
            __builtin_amdgcn_fence(__ATOMIC_RELEASE, "agent");
            asm volatile("s_waitcnt vmcnt(0)" ::: "memory");
            const unsigned og = xb_add(&bar[XB_TOP], 1u);
            const unsigned tg = og / nx;
            if (og + 1u == (tg + 1u) * nx) xb_add(&bar[XB_TOPGEN], 1u);
            else XB_SPIN(xb_ld(&bar[XB_TOPGEN]) == tg, bar);
            __builtin_amdgcn_fence(__ATOMIC_ACQUIRE, "agent");
            xb_add(&bar[XB_XGEN(b.x)], 1u);
            asm volatile("s_waitcnt vmcnt(0)" ::: "memory");
        } else {
            XB_SPIN(xb_ld(&bar[XB_XGEN(b.x)]) == gen, bar);
            __builtin_amdgcn_fence(__ATOMIC_ACQUIRE, "agent");
            asm volatile("s_waitcnt vmcnt(0)" ::: "memory");
        }
    }
    __syncthreads();
}
#define GEMM_CALL(FN, Aptr, Bptr, Nn, Kk, LDA, LDB, ...) GEMM_CALL_G(FN, Aptr, Bptr, Nn, Kk, LDA, LDB, 0, 0, __VA_ARGS__)
#define GEMM_CALL_G(FN, Aptr, Bptr, Nn, Kk, LDA, LDB, AGRP, ASTEP, ...) GEMM_CALL_S(StaticOrder, FN, Aptr, Bptr, Nn, Kk, LDA, LDB, AGRP, ASTEP, __VA_ARGS__)
#define GEMM_CALL_S(ORD, FN, Aptr, Bptr, Nn, Kk, LDA, LDB, AGRP, ASTEP, ...) do { pg8::Gemm g_{(const pg8::bf16_t*)(Aptr), (const pg8::bf16_t*)(Bptr), M, (Nn), (Kk), (LDA), (LDB), (AGRP), (size_t)(ASTEP)}; pg8::ORD S_; S_.init(M, (Nn), F.G, F.bx); \
    pg8::Epi8<pg8::FN> E_{{__VA_ARGS__}}; pg8::gemm_phase<pg8::Epi8<pg8::FN>, pg8::ORD, true, true>(F.lds, g_, S_, E_, F.tid); } while (0)
constexpr int N_PHASES = 42;
__global__ void __launch_bounds__(NWAVES * 64, 2) yoco_fwd(Args args) {
    extern __shared__ __attribute__((aligned(16))) unsigned char lds[];
    cg::grid_group grid = cg::this_grid();
    Frame F;
    const int wave_s = __builtin_amdgcn_readfirstlane((int)threadIdx.x >> 6);
    F.lds = (LAS unsigned char*)lds; F.tid = threadIdx.x; F.lane = F.tid & 63; F.wave = wave_s;
    F.G = gridDim.x; F.bx = blockIdx.x; F.vcu = F.bx;
    F.ws = args.ws; F.out = args.out; F.in = args.in;
    unsigned char* ws = args.ws;
    const int lo = args.ph_lo, hi = args.ph_hi; const bool one = (hi - lo) > 1;
#define LAUNDER() do { int t_ = wave_s * 64 + (int)__builtin_amdgcn_mbcnt_hi(~0u, __builtin_amdgcn_mbcnt_lo(~0u, 0u)); asm volatile("" : "+v"(t_)); F.tid = t_; F.lane = t_ & 63; F.wave = __builtin_amdgcn_readfirstlane(t_ >> 6); \
        int z_ = 0; asm volatile("" : "+v"(z_)); z_ = __builtin_amdgcn_readfirstlane(z_); ws = args.ws + z_; F.ws = ws; F.in = args.in + z_; F.out = args.out + z_; F.bx = (int)blockIdx.x + z_; F.G = (int)gridDim.x + z_; F.vcu = (F.G % 8 == 0) ? (F.bx % 8) * (F.G / 8) + F.bx / 8 : F.bx; } while (0)
#define IN(k) (lo <= (k) && (k) < hi)
#ifndef PROBE_BAR
#define PROBE_BAR 0
#endif
#ifndef PROBE_PH
#define PROBE_PH (-1)
#endif
#define PHASE(k) if (IN(k)) for (int rep_ = 0; rep_ < (((k) == PROBE_PH) ? 2 : 1); ++rep_)
#define SEAM() do { if (one) { unsigned zz_ = 0u; asm volatile("" : "+v"(zz_)); const int st_ = wave_s * 64 + (int)__builtin_amdgcn_mbcnt_hi(~0u, __builtin_amdgcn_mbcnt_lo(~0u, zz_)); xcd_barrier(xbar, st_); if (PROBE_BAR) xcd_barrier(xbar, st_); } } while (0)
#define MOD_ ((float*)(ws + WS_MOD))
#define MODKV_ (MOD_ + 4 * 2 * 6144)
#define H2_ ((bf16*)(ws + WS_H2))
#define XN_ ((bf16*)(ws + WS_H2))
#define XNKV_ ((bf16*)(ws + WS_H2 + 32 * MiB))
#define P1_ ((bf16*)(ws + WS_P1))
#define P2_ ((bf16*)(ws + WS_P2))
#define HB_ ((bf16*)(ws + WS_HB))
#define QB_ ((bf16*)(ws + WS_QB))
#define GT_ ((bf16*)(ws + WS_GT))
#define XIN1_ ((L == 0) ? F.in[0] : (const float*)F.out)
#define MODL_ (MOD_ + L * 2 * 6144)

    volatile LAS unsigned* MISC = (volatile LAS unsigned*)(F.lds + MISC_OFF);
    if (F.tid < 32) MISC[F.tid] = 0u;
    __syncthreads();
    XcdBarrier xbar; xbar.bar = (unsigned*)(args.ws + WS_BAR); xbar.x = 0; xbar.st = MISC + 8;
    if (one) xbar = xcd_barrier_post((unsigned*)(args.ws + WS_BAR), MISC + 8, F.tid);
    PHASE(0) { LAUNDER(); p0_mod(F); p0_weights(F); if (one) grid.sync(); }
    { constexpr int L = 0;
        const int pb = 1 + L * 10;
        if (L < 2) {
            PHASE(pb + 0) { LAUNDER(); norm_mix_phase(F, XIN1_, F.in[4] + L * D, MODL_, MODL_ + 1024, F.in[8] + L * 6 * 1024, H2_, P2_); SEAM(); }
            PHASE(pb + 1) { LAUNDER(); GEMM_CALL(FnP1, H2_, ws + WS_W1 + (size_t)L * N1 * K1 * 2 + (size_t)3072 * 1024 * 2, 512, K1, K1, K1, P1_, 3072);
                LAUNDER();
                if (F.G == 256) GEMM_CALL_S(SplitOrder, FnP1, P2_, ws + WS_W1 + (size_t)L * N1 * K1 * 2, 3072, D, D, D, 4, (size_t)M * D * 2, P1_, 0);
                else GEMM_CALL_G(FnP1, P2_, ws + WS_W1 + (size_t)L * N1 * K1 * 2, 3072, D, D, D, 4, (size_t)M * D * 2, P1_, 0);
                SEAM(); }
            PHASE(pb + 2) { LAUNDER(); GEMM_CALL(FnP2, P1_ + 3072, ws + WS_W2A + (size_t)L * 3072 * 256 * 2, (L == 0 ? 2048 : NP2), 256, N1, 256, P2_, MOD_ + 53248 + L * 3072); SEAM(); }
            PHASE(pb + 3) { LAUNDER(); scan_phase(F, L); SEAM(); }
            PHASE(pb + 4) { LAUNDER(); post_phase(F, L); SEAM(); }
            PHASE(pb + 5) { LAUNDER(); GEMM_CALL(FnGate, P1_ + 3232, ws + WS_W2G + (size_t)L * 1024 * 256 * 2, D, 256, N1, 256, H2_, 2048); SEAM(); }
            PHASE(pb + 6) { LAUNDER(); GEMM_CALL(FnRes, H2_, ws + WS_WO + (size_t)L * D * D * 2, D, D, 2048, D, XIN1_, F.out, MODL_ + 2 * 1024); SEAM(); }
        } else {
            const int j = L - 2;
            PHASE(pb + 0) { LAUNDER(); norm_phase(F, F.out, F.in[4] + L * D, MODL_, MODL_ + 1024, 6144, 1, XN_);
                if (L == 2) norm_phase(F, F.out, F.in[29], MODKV_, MODKV_ + 1024, 2048, 1, XNKV_);
                SEAM(); }
            PHASE(pb + 1) { LAUNDER();
                if (L == 2) GEMM_CALL(FnKv, XNKV_, ws + WS_WKV, 2304, D, D, D, (bf16*)(ws + WS_KVRAW), (float*)(ws + WS_FL), (bf16*)(ws + WS_VS));
                LAUNDER();
                GEMM_CALL(FnQg, XN_, ws + WS_WQG + (size_t)j * 2048 * D * 2, 2048, D, D, D, QB_, GT_); SEAM(); }
            if (L == 2) PHASE(pb + 2) { LAUNDER(); kvpost_phase(F); SEAM(); }
            PHASE(pb + 3) { LAUNDER();
                float kb_; { float g_ = fabsf(F.in[34][F.lane]); g_ = fmaxf(g_, dpp_f(g_, 0)); g_ = fmaxf(g_, dpp_f(g_, 1)); g_ = fmaxf(g_, dpp_f(g_, 2)); g_ = fmaxf(g_, dpp_f(g_, 3));
                  { auto rr = __builtin_amdgcn_permlane16_swap(__float_as_uint(g_), __float_as_uint(g_), false, false); g_ = fmaxf(__uint_as_float(rr[0]), __uint_as_float(rr[1])); }
                  { auto rr = __builtin_amdgcn_permlane32_swap(__float_as_uint(g_), __float_as_uint(g_), false, false); g_ = fmaxf(__uint_as_float(rr[0]), __uint_as_float(rr[1])); }
                  kb_ = 8.0f * 1.02f * g_; }
                const attn_body::AttnTensors AT{(const attn_body::bf16*)QB_, (const attn_body::bf16*)(ws + WS_KS), (const attn_body::bf16*)(ws + WS_VS), (attn_body::bf16*)((PROBE_PH == pb + 3 && rep_ == 0) ? (bf16*)(ws + WS_KVRAW) : QB_), (const attn_body::bf16*)GT_, (const unsigned char*)(ws + WS_G3), F.in[36] + j * 64, kb_};
                float thr2_; { float g_ = fabsf(F.in[36][j * 64 + F.lane]); g_ = fmaxf(g_, dpp_f(g_, 0)); g_ = fmaxf(g_, dpp_f(g_, 1)); g_ = fmaxf(g_, dpp_f(g_, 2)); g_ = fmaxf(g_, dpp_f(g_, 3));
                  { auto rr = __builtin_amdgcn_permlane16_swap(__float_as_uint(g_), __float_as_uint(g_), false, false); g_ = fmaxf(__uint_as_float(rr[0]), __uint_as_float(rr[1])); }
                  { auto rr = __builtin_amdgcn_permlane32_swap(__float_as_uint(g_), __float_as_uint(g_), false, false); g_ = fmaxf(__uint_as_float(rr[0]), __uint_as_float(rr[1])); }
                  thr2_ = 64.0f + 2.0f * kb_ * attn_body::C2 * 8.16f * g_; }
                attn_body::attn_phase_dyn<8>((char*)lds, AT, (unsigned*)(ws + WS_BAR) + 3600 + j * 64, thr2_, F.tid);
                SEAM(); }
            PHASE(pb + 6) { LAUNDER(); GEMM_CALL(FnRes, QB_, ws + WS_WO2 + (size_t)j * D * D * 2, D, D, D, D, (const float*)F.out, F.out, MODL_ + 2 * 1024); SEAM(); }
        }
        PHASE(pb + 7) { LAUNDER(); mlp_weights(F, L); norm_phase(F, F.out, F.in[5] + L * D, MODL_ + 3 * 1024, MODL_ + 4 * 1024, 6144, 1, XN_); SEAM(); }
        PHASE(pb + 8) { LAUNDER(); GEMM_CALL(FnUp, XN_, ws + WS_WUP, FF, D, D, D, HB_); SEAM(); }
        PHASE(pb + 9) { LAUNDER(); GEMM_CALL(FnRes, HB_, ws + WS_WDN, D, FF, FF, FF, (const float*)F.out, F.out, MODL_ + 5 * 1024); SEAM(); }
        }
    { constexpr int L = 1;
        const int pb = 1 + L * 10;
        if (L < 2) {
            PHASE(pb + 0) { LAUNDER(); norm_mix_phase(F, XIN1_, F.in[4] + L * D, MODL_, MODL_ + 1024, F.in[8] + L * 6 * 1024, H2_, P2_); SEAM(); }
            PHASE(pb + 1) { LAUNDER(); GEMM_CALL(FnP1, H2_, ws + WS_W1 + (size_t)L * N1 * K1 * 2 + (size_t)3072 * 1024 * 2, 512, K1, K1, K1, P1_, 3072);
                LAUNDER();
                if (F.G == 256) GEMM_CALL_S(SplitOrder, FnP1, P2_, ws + WS_W1 + (size_t)L * N1 * K1 * 2, 3072, D, D, D, 4, (size_t)M * D * 2, P1_, 0);
                else GEMM_CALL_G(FnP1, P2_, ws + WS_W1 + (size_t)L * N1 * K1 * 2, 3072, D, D, D, 4, (size_t)M * D * 2, P1_, 0);
                SEAM(); }
            PHASE(pb + 2) { LAUNDER(); GEMM_CALL(FnP2, P1_ + 3072, ws + WS_W2A + (size_t)L * 3072 * 256 * 2, (L == 0 ? 2048 : NP2), 256, N1, 256, P2_, MOD_ + 53248 + L * 3072); SEAM(); }
            PHASE(pb + 3) { LAUNDER(); scan_phase(F, L); SEAM(); }
            PHASE(pb + 4) { LAUNDER(); post_phase(F, L); SEAM(); }
            PHASE(pb + 5) { LAUNDER(); GEMM_CALL(FnGate, P1_ + 3232, ws + WS_W2G + (size_t)L * 1024 * 256 * 2, D, 256, N1, 256, H2_, 2048); SEAM(); }
            PHASE(pb + 6) { LAUNDER(); GEMM_CALL(FnRes, H2_, ws + WS_WO + (size_t)L * D * D * 2, D, D, 2048, D, XIN1_, F.out, MODL_ + 2 * 1024); SEAM(); }
        } else {
            const int j = L - 2;
            PHASE(pb + 0) { LAUNDER(); norm_phase(F, F.out, F.in[4] + L * D, MODL_, MODL_ + 1024, 6144, 1, XN_);
                if (L == 2) norm_phase(F, F.out, F.in[29], MODKV_, MODKV_ + 1024, 2048, 1, XNKV_);
                SEAM(); }
            PHASE(pb + 1) { LAUNDER();
                if (L == 2) GEMM_CALL(FnKv, XNKV_, ws + WS_WKV, 2304, D, D, D, (bf16*)(ws + WS_KVRAW), (float*)(ws + WS_FL), (bf16*)(ws + WS_VS));
                LAUNDER();
                GEMM_CALL(FnQg, XN_, ws + WS_WQG + (size_t)j * 2048 * D * 2, 2048, D, D, D, QB_, GT_); SEAM(); }
            if (L == 2) PHASE(pb + 2) { LAUNDER(); kvpost_phase(F); SEAM(); }
            PHASE(pb + 3) { LAUNDER();
                float kb_; { float g_ = fabsf(F.in[34][F.lane]); g_ = fmaxf(g_, dpp_f(g_, 0)); g_ = fmaxf(g_, dpp_f(g_, 1)); g_ = fmaxf(g_, dpp_f(g_, 2)); g_ = fmaxf(g_, dpp_f(g_, 3));
                  { auto rr = __builtin_amdgcn_permlane16_swap(__float_as_uint(g_), __float_as_uint(g_), false, false); g_ = fmaxf(__uint_as_float(rr[0]), __uint_as_float(rr[1])); }
                  { auto rr = __builtin_amdgcn_permlane32_swap(__float_as_uint(g_), __float_as_uint(g_), false, false); g_ = fmaxf(__uint_as_float(rr[0]), __uint_as_float(rr[1])); }
                  kb_ = 8.0f * 1.02f * g_; }
                const attn_body::AttnTensors AT{(const attn_body::bf16*)QB_, (const attn_body::bf16*)(ws + WS_KS), (const attn_body::bf16*)(ws + WS_VS), (attn_body::bf16*)((PROBE_PH == pb + 3 && rep_ == 0) ? (bf16*)(ws + WS_KVRAW) : QB_), (const attn_body::bf16*)GT_, (const unsigned char*)(ws + WS_G3), F.in[36] + j * 64, kb_};
                float thr2_; { float g_ = fabsf(F.in[36][j * 64 + F.lane]); g_ = fmaxf(g_, dpp_f(g_, 0)); g_ = fmaxf(g_, dpp_f(g_, 1)); g_ = fmaxf(g_, dpp_f(g_, 2)); g_ = fmaxf(g_, dpp_f(g_, 3));
                  { auto rr = __builtin_amdgcn_permlane16_swap(__float_as_uint(g_), __float_as_uint(g_), false, false); g_ = fmaxf(__uint_as_float(rr[0]), __uint_as_float(rr[1])); }
                  { auto rr = __builtin_amdgcn_permlane32_swap(__float_as_uint(g_), __float_as_uint(g_), false, false); g_ = fmaxf(__uint_as_float(rr[0]), __uint_as_float(rr[1])); }
                  thr2_ = 64.0f + 2.0f * kb_ * attn_body::C2 * 8.16f * g_; }
                attn_body::attn_phase_dyn<8>((char*)lds, AT, (unsigned*)(ws + WS_BAR) + 3600 + j * 64, thr2_, F.tid);
                SEAM(); }
            PHASE(pb + 6) { LAUNDER(); GEMM_CALL(FnRes, QB_, ws + WS_WO2 + (size_t)j * D * D * 2, D, D, D, D, (const float*)F.out, F.out, MODL_ + 2 * 1024); SEAM(); }
        }
        PHASE(pb + 7) { LAUNDER(); mlp_weights(F, L); norm_phase(F, F.out, F.in[5] + L * D, MODL_ + 3 * 1024, MODL_ + 4 * 1024, 6144, 1, XN_); SEAM(); }
        PHASE(pb + 8) { LAUNDER(); GEMM_CALL(FnUp, XN_, ws + WS_WUP, FF, D, D, D, HB_); SEAM(); }
        PHASE(pb + 9) { LAUNDER(); GEMM_CALL(FnRes, HB_, ws + WS_WDN, D, FF, FF, FF, (const float*)F.out, F.out, MODL_ + 5 * 1024); SEAM(); }
        }
    { constexpr int L = 2;
        const int pb = 1 + L * 10;
        if (L < 2) {
            PHASE(pb + 0) { LAUNDER(); norm_mix_phase(F, XIN1_, F.in[4] + L * D, MODL_, MODL_ + 1024, F.in[8] + L * 6 * 1024, H2_, P2_); SEAM(); }
            PHASE(pb + 1) { LAUNDER(); GEMM_CALL(FnP1, H2_, ws + WS_W1 + (size_t)L * N1 * K1 * 2 + (size_t)3072 * 1024 * 2, 512, K1, K1, K1, P1_, 3072);
                LAUNDER();
                if (F.G == 256) GEMM_CALL_S(SplitOrder, FnP1, P2_, ws + WS_W1 + (size_t)L * N1 * K1 * 2, 3072, D, D, D, 4, (size_t)M * D * 2, P1_, 0);
                else GEMM_CALL_G(FnP1, P2_, ws + WS_W1 + (size_t)L * N1 * K1 * 2, 3072, D, D, D, 4, (size_t)M * D * 2, P1_, 0);
                SEAM(); }
            PHASE(pb + 2) { LAUNDER(); GEMM_CALL(FnP2, P1_ + 3072, ws + WS_W2A + (size_t)L * 3072 * 256 * 2, (L == 0 ? 2048 : NP2), 256, N1, 256, P2_, MOD_ + 53248 + L * 3072); SEAM(); }
            PHASE(pb + 3) { LAUNDER(); scan_phase(F, L); SEAM(); }
            PHASE(pb + 4) { LAUNDER(); post_phase(F, L); SEAM(); }
            PHASE(pb + 5) { LAUNDER(); GEMM_CALL(FnGate, P1_ + 3232, ws + WS_W2G + (size_t)L * 1024 * 256 * 2, D, 256, N1, 256, H2_, 2048); SEAM(); }
            PHASE(pb + 6) { LAUNDER(); GEMM_CALL(FnRes, H2_, ws + WS_WO + (size_t)L * D * D * 2, D, D, 2048, D, XIN1_, F.out, MODL_ + 2 * 1024); SEAM(); }
        } else {
            const int j = L - 2;
            PHASE(pb + 0) { LAUNDER(); norm_phase(F, F.out, F.in[4] + L * D, MODL_, MODL_ + 1024, 6144, 1, XN_);
                if (L == 2) norm_phase(F, F.out, F.in[29], MODKV_, MODKV_ + 1024, 2048, 1, XNKV_);
                SEAM(); }
            PHASE(pb + 1) { LAUNDER();
                if (L == 2) GEMM_CALL(FnKv, XNKV_, ws + WS_WKV, 2304, D, D, D, (bf16*)(ws + WS_KVRAW), (float*)(ws + WS_FL), (bf16*)(ws + WS_VS));
                LAUNDER();
                GEMM_CALL(FnQg, XN_, ws + WS_WQG + (size_t)j * 2048 * D * 2, 2048, D, D, D, QB_, GT_); SEAM(); }
            if (L == 2) PHASE(pb + 2) { LAUNDER(); kvpost_phase(F); SEAM(); }
            PHASE(pb + 3) { LAUNDER();
                float kb_; { float g_ = fabsf(F.in[34][F.lane]); g_ = fmaxf(g_, dpp_f(g_, 0)); g_ = fmaxf(g_, dpp_f(g_, 1)); g_ = fmaxf(g_, dpp_f(g_, 2)); g_ = fmaxf(g_, dpp_f(g_, 3));
                  { auto rr = __builtin_amdgcn_permlane16_swap(__float_as_uint(g_), __float_as_uint(g_), false, false); g_ = fmaxf(__uint_as_float(rr[0]), __uint_as_float(rr[1])); }
                  { auto rr = __builtin_amdgcn_permlane32_swap(__float_as_uint(g_), __float_as_uint(g_), false, false); g_ = fmaxf(__uint_as_float(rr[0]), __uint_as_float(rr[1])); }
                  kb_ = 8.0f * 1.02f * g_; }
                const attn_body::AttnTensors AT{(const attn_body::bf16*)QB_, (const attn_body::bf16*)(ws + WS_KS), (const attn_body::bf16*)(ws + WS_VS), (attn_body::bf16*)((PROBE_PH == pb + 3 && rep_ == 0) ? (bf16*)(ws + WS_KVRAW) : QB_), (const attn_body::bf16*)GT_, (const unsigned char*)(ws + WS_G3), F.in[36] + j * 64, kb_};
                float thr2_; { float g_ = fabsf(F.in[36][j * 64 + F.lane]); g_ = fmaxf(g_, dpp_f(g_, 0)); g_ = fmaxf(g_, dpp_f(g_, 1)); g_ = fmaxf(g_, dpp_f(g_, 2)); g_ = fmaxf(g_, dpp_f(g_, 3));
                  { auto rr = __builtin_amdgcn_permlane16_swap(__float_as_uint(g_), __float_as_uint(g_), false, false); g_ = fmaxf(__uint_as_float(rr[0]), __uint_as_float(rr[1])); }
                  { auto rr = __builtin_amdgcn_permlane32_swap(__float_as_uint(g_), __float_as_uint(g_), false, false); g_ = fmaxf(__uint_as_float(rr[0]), __uint_as_float(rr[1])); }
                  thr2_ = 64.0f + 2.0f * kb_ * attn_body::C2 * 8.16f * g_; }
                attn_body::attn_phase_dyn<8>((char*)lds, AT, (unsigned*)(ws + WS_BAR) + 3600 + j * 64, thr2_, F.tid);
                SEAM(); }
            PHASE(pb + 6) { LAUNDER(); GEMM_CALL(FnRes, QB_, ws + WS_WO2 + (size_t)j * D * D * 2, D, D, D, D, (const float*)F.out, F.out, MODL_ + 2 * 1024); SEAM(); }
        }
        PHASE(pb + 7) { LAUNDER(); mlp_weights(F, L); norm_phase(F, F.out, F.in[5] + L * D, MODL_ + 3 * 1024, MODL_ + 4 * 1024, 6144, 1, XN_); SEAM(); }
        PHASE(pb + 8) { LAUNDER(); GEMM_CALL(FnUp, XN_, ws + WS_WUP, FF, D, D, D, HB_); SEAM(); }
        PHASE(pb + 9) { LAUNDER(); GEMM_CALL(FnRes, HB_, ws + WS_WDN, D, FF, FF, FF, (const float*)F.out, F.out, MODL_ + 5 * 1024); SEAM(); }
        }
    { constexpr int L = 3;
        const int pb = 1 + L * 10;
        if (L < 2) {
            PHASE(pb + 0) { LAUNDER(); norm_mix_phase(F, XIN1_, F.in[4] + L * D, MODL_, MODL_ + 1024, F.in[8] + L * 6 * 1024, H2_, P2_); SEAM(); }
            PHASE(pb + 1) { LAUNDER(); GEMM_CALL(FnP1, H2_, ws + WS_W1 + (size_t)L * N1 * K1 * 2 + (size_t)3072 * 1024 * 2, 512, K1, K1, K1, P1_, 3072);
                LAUNDER();
                if (F.G == 256) GEMM_CALL_S(SplitOrder, FnP1, P2_, ws + WS_W1 + (size_t)L * N1 * K1 * 2, 3072, D, D, D, 4, (size_t)M * D * 2, P1_, 0);
                else GEMM_CALL_G(FnP1, P2_, ws + WS_W1 + (size_t)L * N1 * K1 * 2, 3072, D, D, D, 4, (size_t)M * D * 2, P1_, 0);
                SEAM(); }
            PHASE(pb + 2) { LAUNDER(); GEMM_CALL(FnP2, P1_ + 3072, ws + WS_W2A + (size_t)L * 3072 * 256 * 2, (L == 0 ? 2048 : NP2), 256, N1, 256, P2_, MOD_ + 53248 + L * 3072); SEAM(); }
            PHASE(pb + 3) { LAUNDER(); scan_phase(F, L); SEAM(); }
            PHASE(pb + 4) { LAUNDER(); post_phase(F, L); SEAM(); }
            PHASE(pb + 5) { LAUNDER(); GEMM_CALL(FnGate, P1_ + 3232, ws + WS_W2G + (size_t)L * 1024 * 256 * 2, D, 256, N1, 256, H2_, 2048); SEAM(); }
            PHASE(pb + 6) { LAUNDER(); GEMM_CALL(FnRes, H2_, ws + WS_WO + (size_t)L * D * D * 2, D, D, 2048, D, XIN1_, F.out, MODL_ + 2 * 1024); SEAM(); }
        } else {
            const int j = L - 2;
            PHASE(pb + 0) { LAUNDER(); norm_phase(F, F.out, F.in[4] + L * D, MODL_, MODL_ + 1024, 6144, 1, XN_);
                if (L == 2) norm_phase(F, F.out, F.in[29], MODKV_, MODKV_ + 1024, 2048, 1, XNKV_);
                SEAM(); }
            PHASE(pb + 1) { LAUNDER();
                if (L == 2) GEMM_CALL(FnKv, XNKV_, ws + WS_WKV, 2304, D, D, D, (bf16*)(ws + WS_KVRAW), (float*)(ws + WS_FL), (bf16*)(ws + WS_VS));
                LAUNDER();
                GEMM_CALL(FnQg, XN_, ws + WS_WQG + (size_t)j * 2048 * D * 2, 2048, D, D, D, QB_, GT_); SEAM(); }
            if (L == 2) PHASE(pb + 2) { LAUNDER(); kvpost_phase(F); SEAM(); }
            PHASE(pb + 3) { LAUNDER();
                float kb_; { float g_ = fabsf(F.in[34][F.lane]); g_ = fmaxf(g_, dpp_f(g_, 0)); g_ = fmaxf(g_, dpp_f(g_, 1)); g_ = fmaxf(g_, dpp_f(g_, 2)); g_ = fmaxf(g_, dpp_f(g_, 3));
                  { auto rr = __builtin_amdgcn_permlane16_swap(__float_as_uint(g_), __float_as_uint(g_), false, false); g_ = fmaxf(__uint_as_float(rr[0]), __uint_as_float(rr[1])); }
                  { auto rr = __builtin_amdgcn_permlane32_swap(__float_as_uint(g_), __float_as_uint(g_), false, false); g_ = fmaxf(__uint_as_float(rr[0]), __uint_as_float(rr[1])); }
                  kb_ = 8.0f * 1.02f * g_; }
                const attn_body::AttnTensors AT{(const attn_body::bf16*)QB_, (const attn_body::bf16*)(ws + WS_KS), (const attn_body::bf16*)(ws + WS_VS), (attn_body::bf16*)((PROBE_PH == pb + 3 && rep_ == 0) ? (bf16*)(ws + WS_KVRAW) : QB_), (const attn_body::bf16*)GT_, (const unsigned char*)(ws + WS_G3), F.in[36] + j * 64, kb_};
                float thr2_; { float g_ = fabsf(F.in[36][j * 64 + F.lane]); g_ = fmaxf(g_, dpp_f(g_, 0)); g_ = fmaxf(g_, dpp_f(g_, 1)); g_ = fmaxf(g_, dpp_f(g_, 2)); g_ = fmaxf(g_, dpp_f(g_, 3));
                  { auto rr = __builtin_amdgcn_permlane16_swap(__float_as_uint(g_), __float_as_uint(g_), false, false); g_ = fmaxf(__uint_as_float(rr[0]), __uint_as_float(rr[1])); }
                  { auto rr = __builtin_amdgcn_permlane32_swap(__float_as_uint(g_), __float_as_uint(g_), false, false); g_ = fmaxf(__uint_as_float(rr[0]), __uint_as_float(rr[1])); }
                  thr2_ = 64.0f + 2.0f * kb_ * attn_body::C2 * 8.16f * g_; }
                attn_body::attn_phase_dyn<8>((char*)lds, AT, (unsigned*)(ws + WS_BAR) + 3600 + j * 64, thr2_, F.tid);
                SEAM(); }
            PHASE(pb + 6) { LAUNDER(); GEMM_CALL(FnRes, QB_, ws + WS_WO2 + (size_t)j * D * D * 2, D, D, D, D, (const float*)F.out, F.out, MODL_ + 2 * 1024); SEAM(); }
        }
        PHASE(pb + 7) { LAUNDER(); mlp_weights(F, L); norm_phase(F, F.out, F.in[5] + L * D, MODL_ + 3 * 1024, MODL_ + 4 * 1024, 6144, 1, XN_); SEAM(); }
        PHASE(pb + 8) { LAUNDER(); GEMM_CALL(FnUp, XN_, ws + WS_WUP, FF, D, D, D, HB_); SEAM(); }
        PHASE(pb + 9) { LAUNDER(); GEMM_CALL(FnRes, HB_, ws + WS_WDN, D, FF, FF, FF, (const float*)F.out, F.out, MODL_ + 5 * 1024); SEAM(); }
        }
    PHASE(41) { LAUNDER(); final_norm_phase(F); }
#undef IN
#undef SEAM
}
static bool phase_exists(int ph) {
    if (ph == 0 || ph == 41) return true;
    const int L = (ph - 1) / 10, s = (ph - 1) % 10;
    if (L < 2) return true;
    if (s == 4 || s == 5) return false;
    if (s == 2) return L == 2;
    return true;
}
extern "C" void kernel_launch(void* const* d_in, const int* in_sizes, int n_in, void* d_out, int out_size, void* d_ws, size_t ws_size, hipStream_t stream) {
    static int grid = 0;
    if (grid == 0) {
        if (n_in != 39 || in_sizes[0] != M * D || out_size != M * D || ws_size < WS_END) { fprintf(stderr, "kernel_launch: shape/workspace mismatch: n_in %d in0 %d out %d ws %zu (need %zu)\n", n_in, n_in > 0 ? in_sizes[0] : -1, out_size, ws_size, (size_t)WS_END); grid = -1; return; }
        int dev = 0, cus = 0, per_cu = 0;
        if (hipGetDevice(&dev) != hipSuccess || hipDeviceGetAttribute(&cus, hipDeviceAttributeMultiprocessorCount, dev) != hipSuccess) { fprintf(stderr, "kernel_launch: device query failed\n"); grid = -1; return; }
        if (hipFuncSetAttribute((const void*)yoco_fwd, hipFuncAttributeMaxDynamicSharedMemorySize, LDS_BYTES) != hipSuccess) { fprintf(stderr, "kernel_launch: hipFuncSetAttribute failed\n"); grid = -1; return; }
        if (hipOccupancyMaxActiveBlocksPerMultiprocessor(&per_cu, (const void*)yoco_fwd, NWAVES * 64, LDS_BYTES) != hipSuccess || per_cu < 1) { fprintf(stderr, "kernel_launch: occupancy query says %d blocks/CU\n", per_cu); per_cu = 1; }
        (void)hipGetLastError();
        grid = cus * per_cu;
        if (grid != 256) { fprintf(stderr, "kernel_launch: resident capacity %d workgroups; this kernel's static schedules want 256 (using 256)\n", grid); if (grid > 256) grid = 256; }
    }
    if (grid < 0) return;
    if (hipMemsetAsync((char*)d_ws + WS_BAR, 0, BAR_BYTES, stream) != hipSuccess) { fprintf(stderr, "kernel_launch: memset of barrier words failed\n"); return; }
    Args a{};
    for (int i = 0; i < 39; ++i) a.in[i] = (const float*)d_in[i];
    a.out = (float*)d_out; a.ws = (unsigned char*)d_ws;
#if MK_ONE_LAUNCH
    a.ph_lo = 0; a.ph_hi = N_PHASES;
    void* params[] = {&a};
    const hipError_t le = hipLaunchCooperativeKernel((const void*)yoco_fwd, dim3(grid), dim3(NWAVES * 64), params, LDS_BYTES, stream);
    if (le != hipSuccess) fprintf(stderr, "kernel_launch: cooperative launch failed: %s (grid %d)\n", hipGetErrorName(le), grid);
#else
    for (int ph = 0; ph < N_PHASES; ++ph) { if (!phase_exists(ph)) continue; a.ph_lo = ph; a.ph_hi = ph + 1;
        hipLaunchKernelGGL(yoco_fwd, dim3(grid), dim3(NWAVES * 64), LDS_BYTES, stream, a);
        const hipError_t le = hipPeekAtLastError(); if (le != hipSuccess) { fprintf(stderr, "kernel_launch: launch of phase %d failed: %s\n", ph, hipGetErrorName(le)); break; } }
#endif
}
```

```cpp
#include <hip/hip_runtime.h>
#include <hip/hip_cooperative_groups.h>
#include <hip/hip_bf16.h>
#include <cstdio>
#include <cstdint>
#include <cmath>
namespace cg = cooperative_groups;
#ifndef MK_ONE_LAUNCH
#define MK_ONE_LAUNCH 1
#endif
namespace pg8 {
#define PG8_LAS __attribute__((address_space(3)))
typedef unsigned short bf16_t;
typedef short bf16x8 __attribute__((ext_vector_type(8)));
typedef float f32x4 __attribute__((ext_vector_type(4)));
typedef unsigned u32x4 __attribute__((ext_vector_type(4)));
constexpr int BM = 256, BK = 64, HALF = 128, HTB = HALF * BK * 2  , STAGE_BYTES = 8 * HTB, NXCD = 8, WGM = 8;

__host__ __device__ __forceinline__ int lds_byte(int r, int c) { const int st = (r >> 4) * 2 + (c >> 5), rr = r & 15, cc = c & 31, ob = rr * 64 + cc * 2; return st * 1024 + (ob ^ (((ob >> 9) & 1) << 5)); }
__host__ __device__ __forceinline__ void stage_rc(int b, int& R, int& C) { const int st = b / 1024, sb = b % 1024, swz = sb ^ (((sb >> 9) & 1) << 5); R = (st >> 1) * 16 + swz / 64; C = (st & 1) * 32 + (swz % 64) / 2; }
__host__ __device__ __forceinline__ int perm32(int rho) { const int n = rho >> 4, i = rho & 15; return 8 * (i >> 2) + 4 * n + (i & 3); }

struct Unit { int pm, pn; };
struct Gemm { const bf16_t* A; const bf16_t* Bt; int M, N, K, lda, ldb; int agrp; size_t astep; };

struct SplitOrder {
    int c, nN;
    __host__ __device__ void init(int M, int N, int G_, int c_) { c = c_; nN = N / BM; (void)M; (void)G_; }
    __host__ __device__ bool next(int i, Unit& u) const { int idx; if (c < 128) { if (i >= 2) return false; idx = 2 * c + i; } else { if (i >= 4) return false; idx = 256 + 4 * (c - 128) + i; } u.pm = idx / nN; u.pn = idx % nN; return true; }
    __device__ __forceinline__ void a_ready(const Unit&) const {}
    __device__ __forceinline__ void done(const Unit&) const {}
};
struct StaticOrder {
    int nM, nN, nwg, G, c;
    __host__ __device__ void init(int M, int N, int G_, int c_) { nM = M / BM; nN = N / BM; nwg = nM * nN; G = G_; c = c_; }
    __host__ __device__ bool next(int i, Unit& u) const {
        const long L = (long)i * G + c; if (L >= nwg) return false;
        int wgid = (int)L; { const int q = nwg / NXCD, r = nwg % NXCD, xcd = wgid % NXCD, off = wgid / NXCD; wgid = (xcd < r ? xcd * (q + 1) : r * (q + 1) + (xcd - r) * q) + off; }
        const int nig = WGM * nN, gid = wgid / nig, fm = gid * WGM, gsz = (nM - fm) < WGM ? (nM - fm) : WGM;
        u.pm = fm + ((wgid % nig) % gsz); u.pn = (wgid % nig) / gsz; return true;
    }
    __device__ __forceinline__ void a_ready(const Unit&) const {}
    __device__ __forceinline__ void done(const Unit&) const {}
};

typedef float f32x2 __attribute__((ext_vector_type(2)));
typedef __bf16 bf16x2_t __attribute__((ext_vector_type(2)));
__device__ __forceinline__ unsigned pkbf(float lo, float hi) { f32x2 v = {lo, hi}; bf16x2_t b = __builtin_convertvector(v, bf16x2_t); return __builtin_bit_cast(unsigned, b); }
__device__ __forceinline__ float bflo(unsigned w) { return __uint_as_float(w << 16); }
__device__ __forceinline__ float bfhi(unsigned w) { return __uint_as_float(w & 0xffff0000u); }
__device__ __forceinline__ float sigm(float x) { return __builtin_amdgcn_rcpf(1.0f + __builtin_amdgcn_exp2f(-1.4426950408889634f * x)); }
template <class Fn> struct Epi8 {
    static constexpr bool PERM = true, AFTER_DRAIN = false; Fn f;
    __device__ __forceinline__ void operator()(const f32x4 (&acc)[2][2][4][2], const Unit& u, int wr, int wc, int fr, int fq) const {
        const int row0 = u.pm * BM + wr * 64 + fr, col0 = u.pn * BM + wc * 32 + 8 * fq;
#pragma unroll
        for (int ai = 0; ai < 2; ++ai)
#pragma unroll
            for (int m = 0; m < 4; ++m)
#pragma unroll
                for (int bj = 0; bj < 2; ++bj) { f(row0 + ai * HALF + m * 16, col0 + bj * HALF, acc[ai][bj][m][0], acc[ai][bj][m][1]); }
    }
};
__device__ __forceinline__ void st8bf(bf16_t* p, f32x4 v0, f32x4 v1) { u32x4 w; w.x = pkbf(v0[0], v0[1]); w.y = pkbf(v0[2], v0[3]); w.z = pkbf(v1[0], v1[1]); w.w = pkbf(v1[2], v1[3]); *(u32x4*)p = w; }
struct FnP1 { bf16_t* O; int coff;
    __device__ __forceinline__ void operator()(int row, int col, f32x4 v0, f32x4 v1) const {
        col += coff;
        if (col >= 3072) {
            if (col < 3136) {
#pragma unroll
                for (int j = 0; j < 4; ++j) { v0[j] = 1.0f - 2.0f * __builtin_amdgcn_rcpf(__builtin_amdgcn_exp2f(2.8853900817779268f * v0[j]) + 1.0f); v1[j] = 1.0f - 2.0f * __builtin_amdgcn_rcpf(__builtin_amdgcn_exp2f(2.8853900817779268f * v1[j]) + 1.0f); } }
            else if (col >= 3232 && col < 3392) {
#pragma unroll
                for (int j = 0; j < 4; ++j) { v0[j] = sigm(v0[j]); v1[j] = sigm(v1[j]); } }
        }
        st8bf(O + (size_t)row * 3584 + col, v0, v1); } };
struct FnP2 { bf16_t* O; const float* bias;
    __device__ __forceinline__ void operator()(int row, int col, f32x4 v0, f32x4 v1) const {
        const f32x4 b0 = *(const f32x4*)(bias + col), b1 = *(const f32x4*)(bias + col + 4);
        const float sc = col < 1024 ? -0.60653065971f : 1.0f;
#pragma unroll
        for (int j = 0; j < 4; ++j) { v0[j] = sc * sigm(v0[j] + b0[j]); v1[j] = sc * sigm(v1[j] + b1[j]); }
        st8bf(O + (size_t)row * 3072 + col, v0, v1); } };
struct FnGate { bf16_t* Y; int ld;
    __device__ __forceinline__ void operator()(int row, int col, f32x4 v0, f32x4 v1) const {
        bf16_t* p = Y + (size_t)row * ld + col; const u32x4 y = *(const u32x4*)p;
        v0[0] *= bflo(y.x); v0[1] *= bfhi(y.x); v0[2] *= bflo(y.y); v0[3] *= bfhi(y.y); v1[0] *= bflo(y.z); v1[1] *= bfhi(y.z); v1[2] *= bflo(y.w); v1[3] *= bfhi(y.w);
        st8bf(p, v0, v1); } };
struct FnRes { const float* xin; float* xout; const float* gate;
    __device__ __forceinline__ void operator()(int row, int col, f32x4 v0, f32x4 v1) const {
        const float* gp = gate + (row >> 13) * 6144 + col; const f32x4 g0 = *(const f32x4*)gp, g1 = *(const f32x4*)(gp + 4);
        const size_t off = (size_t)row * 1024 + col; const f32x4 x0 = *(const f32x4*)(xin + off), x1 = *(const f32x4*)(xin + off + 4);
        *(f32x4*)(xout + off) = x0 + (g0 + 1.0f) * v0; *(f32x4*)(xout + off + 4) = x1 + (g1 + 1.0f) * v1; } };
struct FnUp { bf16_t* O;
    __device__ __forceinline__ void operator()(int row, int col, f32x4 v0, f32x4 v1) const {
#pragma unroll
        for (int j = 0; j < 4; ++j) { const float a = fmaxf(v0[j], 0.f), b = fmaxf(v1[j], 0.f); v0[j] = a * a; v1[j] = b * b; }
        st8bf(O + (size_t)row * 4096 + col, v0, v1); } };
struct FnKv { bf16_t* O; float* FL; bf16_t* VS;
    __device__ __forceinline__ void operator()(int row, int col, f32x4 v0, f32x4 v1) const {
        if (col < 1024) st8bf(O + (size_t)row * 2048 + col, v0, v1);
        else if (col < 2048) st8bf(VS + (size_t)row * 1024 + (col - 1024), v0, v1);
        else if (col < 2064) { float* p = FL + (size_t)row * 16 + (col - 2048); *(f32x4*)p = v0; *(f32x4*)(p + 4) = v1; } } };
struct FnQg { bf16_t* Q; bf16_t* G;
    __device__ __forceinline__ void operator()(int row, int col, f32x4 v0, f32x4 v1) const {
        if (col < 1024) st8bf(Q + (size_t)row * 1024 + col, v0, v1);
        else {
#pragma unroll
            for (int j = 0; j < 4; ++j) { v0[j] = sigm(v0[j]); v1[j] = sigm(v1[j]); }
            st8bf(G + (size_t)row * 1024 + (col - 1024), v0, v1); } } };
template <class Epi, class Sched, bool ALIGN_EPI = false, bool SP2 = false>
__device__ __forceinline__ void gemm_phase(PG8_LAS unsigned char* lds, const Gemm g, const Sched& S, const Epi& E, const int tid_in) {
    int tid_l = tid_in; asm volatile("" : "+v"(tid_l));
    const int tid = tid_l, wid = __builtin_amdgcn_readfirstlane(tid >> 6), lane = tid & 63, wr = wid >> 2, wc = wid & 3, fr = lane & 15, fq = lane >> 4;
    const int K = g.K, nt = K / BK;
    unsigned voffA[2], voffB[2];
#pragma unroll
    for (int i = 0; i < 2; ++i) { int R, C; stage_rc(tid * 16 + i * 8192, R, C); const int Rb = Epi::PERM ? ((R & ~31) + perm32(R & 31)) : R;
        voffA[i] = (unsigned)(R * g.lda + C) * 2u; voffB[i] = (unsigned)(Rb * g.ldb + C) * 2u; }
    const size_t kstep = (size_t)(BK * 2);
    const size_t hstepA = (size_t)HALF * g.lda * 2, hstepB = (size_t)HALF * g.ldb * 2;
    const size_t tstepA = 2 * hstepA, tstepB = 2 * hstepB;
    const unsigned ldsw = (unsigned)wid * 1024u;
    const int aoff = lds_byte(wr * 64 + fr, fq * 8), boff = lds_byte(wc * 32 + fr, fq * 8);
#define PG8_SA(b, h) (((b) * 2 + (h)) * HTB)
#define PG8_SB(b, h) ((4 + (b) * 2 + (h)) * HTB)
#define PG8_STAGE(bufoff, gbase, voff) do { _Pragma("unroll") for (int _i = 0; _i < 2; ++_i) \
        __builtin_amdgcn_global_load_lds((const unsigned*)((const char*)(gbase) + (voff)[_i]), (PG8_LAS unsigned*)(lds + (bufoff) + ldsw + _i * 8192), 16, 0, 0); } while (0)
#define PG8_LDA(dst, b, h) do { _Pragma("unroll") for (int m = 0; m < 4; ++m) _Pragma("unroll") for (int k = 0; k < 2; ++k) dst[m][k] = *(const PG8_LAS bf16x8*)(lds + PG8_SA(b, h) + aoff + m * 2048 + k * 1024); } while (0)
#define PG8_LDB(dst, b, h) do { _Pragma("unroll") for (int n = 0; n < 2; ++n) _Pragma("unroll") for (int k = 0; k < 2; ++k) dst[n][k] = *(const PG8_LAS bf16x8*)(lds + PG8_SB(b, h) + boff + n * 2048 + k * 1024); } while (0)
#define PG8_MMA(ai, bj, At, Bt) do { __builtin_amdgcn_s_setprio(1); _Pragma("unroll") for (int m = 0; m < 4; ++m) _Pragma("unroll") for (int n = 0; n < 2; ++n) _Pragma("unroll") for (int k = 0; k < 2; ++k) \
        acc[ai][bj][m][n] = __builtin_amdgcn_mfma_f32_16x16x32_bf16(Bt[n][k], At[m][k], acc[ai][bj][m][n], 0, 0, 0); __builtin_amdgcn_s_setprio(0); } while (0)
#define PG8_WAIT_V(n) asm volatile("s_waitcnt vmcnt(" #n ")" ::: "memory")
#define PG8_WAIT_L(n) asm volatile("s_waitcnt lgkmcnt(" #n ")" ::: "memory")
#define PG8_BAR __builtin_amdgcn_s_barrier()
#define PG8_SCHED __builtin_amdgcn_sched_barrier(0)
    Unit cur, nxt; int ui = 0;
    if (!S.next(0, cur)) return;
    f32x4 acc[2][2][4][2];
#pragma unroll
    for (int a = 0; a < 2; ++a)
#pragma unroll
        for (int b = 0; b < 2; ++b)
#pragma unroll
            for (int m = 0; m < 4; ++m)
#pragma unroll
                for (int n = 0; n < 2; ++n) acc[a][b][m][n] = (f32x4){0.f, 0.f, 0.f, 0.f};
    bf16x8 At[4][2], B0[2][2], B1[2][2];
    const char* cA = (const char*)g.A + (size_t)cur.pm * tstepA + (g.agrp ? (size_t)(cur.pn / g.agrp) * g.astep : (size_t)0); const char* cB = (const char*)g.Bt + (size_t)cur.pn * tstepB;
    S.a_ready(cur);
    if constexpr (SP2) {
        PG8_STAGE(PG8_SB(0, 0), cB, voffB); PG8_STAGE(PG8_SB(0, 1), cB + hstepB, voffB); PG8_STAGE(PG8_SA(0, 0), cA, voffA); PG8_STAGE(PG8_SA(0, 1), cA + hstepA, voffA);
        if (wr == 1) PG8_BAR;
        PG8_WAIT_V(2); PG8_BAR;
        PG8_STAGE(PG8_SB(1, 0), cB + kstep, voffB); PG8_STAGE(PG8_SA(1, 0), cA + kstep, voffA); PG8_STAGE(PG8_SB(1, 1), cB + hstepB + kstep, voffB);
        PG8_WAIT_V(6); PG8_BAR;
    } else {
        PG8_STAGE(PG8_SB(0, 0), cB, voffB); PG8_STAGE(PG8_SA(0, 0), cA, voffA); PG8_STAGE(PG8_SB(0, 1), cB + hstepB, voffB); PG8_STAGE(PG8_SA(0, 1), cA + hstepA, voffA);
        if (wr == 1) PG8_BAR;
        PG8_WAIT_V(4); PG8_BAR;
        PG8_STAGE(PG8_SB(1, 0), cB + kstep, voffB); PG8_STAGE(PG8_SA(1, 0), cA + kstep, voffA); PG8_STAGE(PG8_SB(1, 1), cB + hstepB + kstep, voffB);
        PG8_WAIT_V(6); PG8_BAR;
    }
    for (;;) {
        const bool has_next = S.next(ui + 1, nxt);
        const char* nA = has_next ? (const char*)g.A + (size_t)nxt.pm * tstepA + (g.agrp ? (size_t)(nxt.pn / g.agrp) * g.astep : (size_t)0) : cA; const char* nB = has_next ? (const char*)g.Bt + (size_t)nxt.pn * tstepB : cB;
        for (int t = 0; t < nt; t += 2) {
            const bool last = (t == nt - 2);
            const char* a1 = cA + (size_t)(t + 1) * kstep;
            const char* a2 = last ? nA : cA + (size_t)(t + 2) * kstep; const char* b2 = last ? nB : cB + (size_t)(t + 2) * kstep;
            const char* a3 = a2 + kstep; const char* b3 = b2 + kstep;
            if (last && has_next) S.a_ready(nxt);
            if constexpr (SP2) {
            PG8_LDB(B0, 0, 0); PG8_LDB(B1, 0, 1); PG8_SCHED; PG8_LDA(At, 0, 0); PG8_STAGE(PG8_SA(1, 1), a1 + hstepA, voffA);
            PG8_WAIT_V(8); PG8_WAIT_L(0); PG8_BAR; PG8_MMA(0, 0, At, B0); PG8_MMA(0, 1, At, B1); PG8_BAR; PG8_SCHED;
            PG8_LDA(At, 0, 1); PG8_STAGE(PG8_SB(0, 0), b2, voffB); PG8_STAGE(PG8_SB(0, 1), b2 + hstepB, voffB); PG8_STAGE(PG8_SA(0, 0), a2, voffA);
            PG8_WAIT_V(8); PG8_WAIT_L(0); PG8_BAR; PG8_MMA(1, 0, At, B0); PG8_MMA(1, 1, At, B1); PG8_BAR; PG8_SCHED;
            PG8_LDB(B0, 1, 0); PG8_LDB(B1, 1, 1); PG8_SCHED; PG8_LDA(At, 1, 0); PG8_STAGE(PG8_SA(0, 1), a2 + hstepA, voffA);
            PG8_WAIT_V(8); PG8_WAIT_L(0); PG8_BAR; PG8_MMA(0, 0, At, B0); PG8_MMA(0, 1, At, B1); PG8_BAR; PG8_SCHED;
            PG8_LDA(At, 1, 1); PG8_STAGE(PG8_SB(1, 0), b3, voffB); PG8_STAGE(PG8_SB(1, 1), b3 + hstepB, voffB); PG8_STAGE(PG8_SA(1, 0), a3, voffA);
            PG8_WAIT_V(8); PG8_WAIT_L(0); PG8_BAR; PG8_MMA(1, 0, At, B0); PG8_MMA(1, 1, At, B1); PG8_BAR; PG8_SCHED;
            } else {
            PG8_LDB(B0, 0, 0); PG8_SCHED; PG8_LDA(At, 0, 0); PG8_STAGE(PG8_SA(1, 1), a1 + hstepA, voffA);
            PG8_WAIT_L(8); PG8_BAR; PG8_WAIT_L(0); PG8_MMA(0, 0, At, B0); PG8_BAR; PG8_SCHED;
            PG8_LDB(B1, 0, 1); PG8_STAGE(PG8_SB(0, 0), b2, voffB);
            PG8_BAR; PG8_WAIT_L(0); PG8_MMA(0, 1, At, B1); PG8_BAR;
            PG8_LDA(At, 0, 1); PG8_STAGE(PG8_SA(0, 0), a2, voffA);
            PG8_BAR; PG8_WAIT_L(0); PG8_MMA(1, 0, At, B0); PG8_BAR; PG8_SCHED;
            PG8_STAGE(PG8_SB(0, 1), b2 + hstepB, voffB);
            PG8_WAIT_V(6); PG8_BAR; PG8_MMA(1, 1, At, B1); PG8_BAR;
            PG8_LDB(B0, 1, 0); PG8_SCHED; PG8_LDA(At, 1, 0); PG8_STAGE(PG8_SA(0, 1), a2 + hstepA, voffA);
            PG8_WAIT_L(8); PG8_BAR; PG8_WAIT_L(0); PG8_MMA(0, 0, At, B0); PG8_BAR; PG8_SCHED;
            PG8_LDB(B1, 1, 1); PG8_STAGE(PG8_SB(1, 0), b3, voffB);
            PG8_BAR; PG8_WAIT_L(0); PG8_MMA(0, 1, At, B1); PG8_BAR;
            PG8_LDA(At, 1, 1); PG8_STAGE(PG8_SA(1, 0), a3, voffA);
            PG8_BAR; PG8_WAIT_L(0); PG8_MMA(1, 0, At, B0); PG8_BAR; PG8_SCHED;
            PG8_STAGE(PG8_SB(1, 1), b3 + hstepB, voffB);
            PG8_WAIT_V(6); PG8_BAR; PG8_MMA(1, 1, At, B1); PG8_BAR;
            }
        }
        if constexpr (ALIGN_EPI) { if (wr == 0) PG8_BAR; }
        if constexpr (!Epi::AFTER_DRAIN) { E(acc, cur, wr, wc, fr, fq); S.done(cur); }
        if (!has_next) break;
#pragma unroll
        for (int a = 0; a < 2; ++a)
#pragma unroll
            for (int b = 0; b < 2; ++b)
#pragma unroll
                for (int m = 0; m < 4; ++m)
#pragma unroll
                    for (int n = 0; n < 2; ++n) acc[a][b][m][n] = (f32x4){0.f, 0.f, 0.f, 0.f};
        cur = nxt; cA = nA; cB = nB; ++ui;
        if constexpr (ALIGN_EPI) { if (wr == 1) PG8_BAR; }
    }
    PG8_WAIT_V(0);
    if constexpr (!ALIGN_EPI) { if (wr == 0) PG8_BAR; }
    PG8_BAR;
    if constexpr (Epi::AFTER_DRAIN) { E.fused(acc, cur, wr, wc, fr, fq, lds, wid, lane); S.done(cur); }
#undef PG8_SA
#undef PG8_SB
#undef PG8_STAGE
#undef PG8_LDA
#undef PG8_LDB
#undef PG8_MMA
#undef PG8_WAIT_V
#undef PG8_WAIT_L
#undef PG8_BAR
#undef PG8_SCHED
}
}
#include <hip/hip_bf16.h>
#include <cmath>
namespace attn_body {
using bf16=__hip_bfloat16;
using bf16x8=__attribute__((ext_vector_type(8)))short;
using s16x4=__attribute__((ext_vector_type(4)))short;
using f32x16=__attribute__((ext_vector_type(16)))float;
using u32x4=__attribute__((ext_vector_type(4)))unsigned;
constexpr int BATCH=2,NHEAD=16,SEQ=8192,D=64,DM=NHEAD*D;
constexpr int NW=8,QBLK=32,QB=QBLK*NW,KVBLK=64,NQB=SEQ/QB;
constexpr int ATTN_PITCH=DM, ATTN_UNIT_ROWS=QB;
__device__ __forceinline__ int crow(int r,int hi){return (r&3)+8*(r>>2)+4*hi;}
#define SBAR() __builtin_amdgcn_sched_barrier(0)
__device__ __forceinline__ void cmask(f32x16&p0,f32x16&p1,int jb,int qrel,int hi){
  const float NEG=-INFINITY; int kb=64*jb+4*hi;
  #pragma unroll
  for(int r=0;r<16;++r){int kv=kb+(r&3)+8*(r>>2); if(kv>qrel)p0[r]=NEG; if(kv+32>qrel)p1[r]=NEG;}
}

constexpr int NSLOT=3, SLOTB=9216;
constexpr int LDS_K=0, LDS_V=NSLOT*SLOTB, LDS_WS=2*NSLOT*SLOTB, LDS_OST=LDS_WS+NW*64*4, LDS_BYTES=LDS_OST+NW*4096;
constexpr float C2=0.125f*1.4426950408889634f;
__device__ __forceinline__ void glds16(const void*gsrc,unsigned lds_dst){unsigned keep;
  asm volatile("s_mov_b32 %0, m0\n\ts_mov_b32 m0, %2\n\ts_nop 0\n\tglobal_load_lds_dwordx4 %1, off\n\ts_mov_b32 m0, %0":"=&s"(keep):"v"(gsrc),"s"(lds_dst):"memory");}
__device__ __forceinline__ float max3f(float a,float b,float c){float r;asm("v_max3_f32 %0, %1, %2, %3":"=v"(r):"v"(a),"v"(b),"v"(c));return r;}
__device__ __forceinline__ float max2f(float a,float b){float r;asm("v_max_f32_e32 %0, %1, %2":"=v"(r):"v"(a),"v"(b));return r;}
__device__ __forceinline__ float fadd_s(float a,float b){float r;asm("v_add_f32_e32 %0, %1, %2":"=v"(r):"v"(a),"v"(b));return r;}
__device__ __forceinline__ float fsub_s(float a,float b){float r;asm("v_sub_f32_e32 %0, %1, %2":"=v"(r):"v"(a),"v"(b));return r;}
typedef float f32x2_t __attribute__((ext_vector_type(2))); typedef __bf16 bf16x2_t __attribute__((ext_vector_type(2)));
__device__ __forceinline__ unsigned cvtpk_s(float lo,float hi){f32x2_t v={lo,hi};bf16x2_t b=__builtin_convertvector(v,bf16x2_t);return __builtin_bit_cast(unsigned,b);}
#define WAIT_BAR(N) asm volatile("s_waitcnt vmcnt(" #N ") lgkmcnt(0)\n\ts_barrier":::"memory")
#define WAIT_BARW() do{ if(wid==0){WAIT_BAR(3);} else {WAIT_BAR(2);} }while(0)

__device__ __forceinline__ void qkt(f32x16&p0,f32x16&p1,const char*Kslot,const bf16x8*qr,const bf16x8 qe,const f32x16&negm,int r32,int hi){
  const char*kb=Kslot+hi*1024+r32*16;
  #pragma unroll
  for(int d0=0;d0<4;++d0){
    const bf16x8 b0=*reinterpret_cast<const bf16x8*>(kb+d0*2048);
    const bf16x8 b1=*reinterpret_cast<const bf16x8*>(kb+d0*2048+512);
    if(d0==0){p0=__builtin_amdgcn_mfma_f32_32x32x16_bf16(b0,qr[0],negm,0,0,0);p1=__builtin_amdgcn_mfma_f32_32x32x16_bf16(b1,qr[0],negm,0,0,0);}
    else{p0=__builtin_amdgcn_mfma_f32_32x32x16_bf16(b0,qr[d0],p0,0,0,0);p1=__builtin_amdgcn_mfma_f32_32x32x16_bf16(b1,qr[d0],p1,0,0,0);}}
  { const char*ke=Kslot+8192+r32*16; const bf16x8 e0=*reinterpret_cast<const bf16x8*>(ke),e1=*reinterpret_cast<const bf16x8*>(ke+512);
    p0=__builtin_amdgcn_mfma_f32_32x32x16_bf16(e0,qe,p0,0,0,0);p1=__builtin_amdgcn_mfma_f32_32x32x16_bf16(e1,qe,p1,0,0,0);}
}
typedef __attribute__((address_space(3))) const char* lds_cptr;
typedef short v4i16_t __attribute__((ext_vector_type(4)));
__device__ __forceinline__ void kload8(bf16x8*kf,lds_cptr kp){
  kf[0]=*(const __attribute__((address_space(3))) bf16x8*)(kp);      kf[1]=*(const __attribute__((address_space(3))) bf16x8*)(kp+512);
  kf[2]=*(const __attribute__((address_space(3))) bf16x8*)(kp+2048); kf[3]=*(const __attribute__((address_space(3))) bf16x8*)(kp+2560);
  kf[4]=*(const __attribute__((address_space(3))) bf16x8*)(kp+4096); kf[5]=*(const __attribute__((address_space(3))) bf16x8*)(kp+4608);
  kf[6]=*(const __attribute__((address_space(3))) bf16x8*)(kp+6144); kf[7]=*(const __attribute__((address_space(3))) bf16x8*)(kp+6656);
}
__device__ __forceinline__ void kload2(bf16x8*kf,lds_cptr kp,int j){ kf[2*j]=*(const __attribute__((address_space(3))) bf16x8*)(kp+j*2048); kf[2*j+1]=*(const __attribute__((address_space(3))) bf16x8*)(kp+j*2048+512); }
__device__ __forceinline__ s16x4 vtr(lds_cptr p){ return __builtin_bit_cast(s16x4,__builtin_amdgcn_ds_read_tr16_b64_v4i16((__attribute__((address_space(3))) v4i16_t*)p)); }
__device__ __forceinline__ float rowmax(const f32x16&p0,const f32x16&p1){
  float a=max3f(p0[0],p0[1],p1[0]),b=max3f(p0[2],p0[3],p1[1]);a=max3f(a,p1[2],p1[3]);
  #pragma unroll
  for(int r=4;r<16;r+=4){a=max3f(a,p0[r],p0[r+1]);b=max3f(b,p0[r+2],p0[r+3]);a=max3f(a,p1[r],p1[r+1]);b=max3f(b,p1[r+2],p1[r+3]);}
  const float m=max2f(a,b);
  auto rr=__builtin_amdgcn_permlane32_swap(__float_as_uint(m),__float_as_uint(m),false,false);
  return max2f(__uint_as_float(rr[0]),__uint_as_float(rr[1]));
}
__device__ __forceinline__ void pv(f32x16*o,int vb,bf16x8 pa0,bf16x8 pa1,bf16x8 pa2,bf16x8 pa3){
  #pragma unroll
  for(int d0=0;d0<2;++d0){s16x4 lo[4],hi[4];
    #pragma unroll
    for(int ks=0;ks<4;++ks){
      asm volatile("ds_read_b64_tr_b16 %0,%1 offset:%c2":"=&v"(lo[ks]):"v"(vb),"i"(d0*4096+ks*1024):"memory");
      asm volatile("ds_read_b64_tr_b16 %0,%1 offset:%c2":"=&v"(hi[ks]):"v"(vb),"i"(d0*4096+ks*1024+512):"memory");}
    asm volatile("s_waitcnt lgkmcnt(0)":::"memory");SBAR();
    #define PK(k) (bf16x8){lo[k][0],lo[k][1],lo[k][2],lo[k][3],hi[k][0],hi[k][1],hi[k][2],hi[k][3]}
    o[d0]=__builtin_amdgcn_mfma_f32_32x32x16_bf16(pa0,PK(0),o[d0],0,0,0);
    o[d0]=__builtin_amdgcn_mfma_f32_32x32x16_bf16(pa1,PK(1),o[d0],0,0,0);
    o[d0]=__builtin_amdgcn_mfma_f32_32x32x16_bf16(pa2,PK(2),o[d0],0,0,0);
    o[d0]=__builtin_amdgcn_mfma_f32_32x32x16_bf16(pa3,PK(3),o[d0],0,0,0);
    #undef PK
  }
}

#ifndef ATTN_STORE16
#define ATTN_STORE16(p,v) (*(u32x4*)(p)=(v))
#endif
template<int THRL> __device__ __forceinline__ void attn_unit(int b,int h,int qb,const bf16*Q,const bf16*__restrict__ K,const bf16*__restrict__ V,bf16*O,const bf16*__restrict__ GT,const unsigned char*__restrict__ G3,const float*__restrict__ qgain,const float kbound,char*shm,const int tid_in,const int j0){
  int tid_l=tid_in; asm volatile("":"+v"(tid_l)); const int tid=tid_l,lane=tid&63,r32=lane&31,hi=lane>>5; const int wid=__builtin_amdgcn_readfirstlane(tid>>6);
  const long rowbase=(long)b*SEQ; const int q0=qb*QB;
  const bf16*Qw=Q+(rowbase+q0+wid*QBLK)*DM+h*D;
  const bf16*Kh=K+rowbase*DM+h*D,*Vh=V+rowbase*DM+h*D;
  const unsigned lds0=(unsigned)(uintptr_t)shm;
  float*wsf=(float*)(shm+LDS_WS)+wid*64;
  const bf16*ksrc=Kh+(long)lane*DM+wid*8;
  const bf16*vsrc=Vh+(long)(16*(wid&3)+(lane>>2))*DM+(wid>>2)*32+(lane&3)*8;
  const unsigned kdst=lds0+LDS_K+wid*1024, vdst=lds0+LDS_V+wid*1024, gdst=lds0+LDS_K+8192;
  const unsigned char*gsrc=G3+((long)(b*NHEAD+h)*SEQ+lane)*16;
  #define DMA_K(t,slot) do{ if(wid==0)glds16(gsrc+(long)(t)*KVBLK*16,(unsigned)__builtin_amdgcn_readfirstlane(gdst+(slot))); glds16(ksrc+(long)(t)*KVBLK*DM,(unsigned)__builtin_amdgcn_readfirstlane(kdst+(slot))); }while(0)
  #define DMA_V(t,slot) glds16(vsrc+(long)(t)*KVBLK*DM,(unsigned)__builtin_amdgcn_readfirstlane(vdst+(slot)))
  const int vb0=(int)(lds0+LDS_V)+((lane>>4)&1)*32+(lane&3)*8+(4*hi+((lane&15)>>2))*64;
  const char*Kbase=shm+LDS_K; bf16x8 kf[10];
  const lds_cptr shm3=(lds_cptr)shm; const lds_cptr kp0=shm3+LDS_K+hi*1024+r32*16; const lds_cptr kpe=shm3+LDS_K+8192+r32*16; const lds_cptr vp0=shm3+LDS_V+((lane>>4)&1)*32+(lane&3)*8+(4*hi+((lane&15)>>2))*64;
  ksrc+=(long)j0*KVBLK*DM; vsrc+=(long)j0*KVBLK*DM; gsrc+=(long)j0*KVBLK*16;
  const int NT=(q0+QB)/KVBLK-j0;
  DMA_K(0,0);DMA_V(0,0);DMA_K(1,SLOTB);
  bf16x8 qr[4]; float fq2; bf16x8 qe; float ubound;
  { bf16x8 qraw[4];
    #pragma unroll
    for(int d0=0;d0<4;++d0)qraw[d0]=*reinterpret_cast<const bf16x8*>(&Qw[(long)r32*DM+d0*16+hi*8]);
    const u32x4 ge=*reinterpret_cast<const u32x4*>(G3+((long)(b*NHEAD+h)*SEQ+q0+wid*QBLK+r32)*16);
    fq2=-(__uint_as_float(ge[0]<<16)+__uint_as_float(ge[0]&0xffff0000u)+__uint_as_float(ge[1]<<16));
    float ss=0.f;
    #pragma unroll
    for(int d0=0;d0<4;++d0)
      #pragma unroll
      for(int j=0;j<8;++j){const float x=__uint_as_float(((unsigned)(unsigned short)qraw[d0][j])<<16);ss+=x*x;}
    {auto rr=__builtin_amdgcn_permlane32_swap(__float_as_uint(ss),__float_as_uint(ss),false,false);ss=__uint_as_float(rr[0])+__uint_as_float(rr[1]);}
    const float qs=C2/sqrtf(ss*(1.0f/64.0f)+1e-6f);
    float s2=0.f;
    #pragma unroll
    for(int d0=0;d0<4;++d0){ u32x4 w;
      #pragma unroll
      for(int j=0;j<8;j+=2){const float x0=__uint_as_float(((unsigned)(unsigned short)qraw[d0][j])<<16),x1=__uint_as_float(((unsigned)(unsigned short)qraw[d0][j+1])<<16);
        const float y0=x0*qs*qgain[d0*16+hi*8+j],y1=x1*qs*qgain[d0*16+hi*8+j+1]; s2+=y0*y0+y1*y1;
        w[j>>1]=cvtpk_s(y0,y1);}
      qr[d0]=__builtin_bit_cast(bf16x8,w);}
    {auto rr=__builtin_amdgcn_permlane32_swap(__float_as_uint(s2),__float_as_uint(s2),false,false);s2=__uint_as_float(rr[0])+__uint_as_float(rr[1]);}
    ubound=sqrtf(s2)*kbound;
    const unsigned one2=hi?0u:0x3f803f80u, one1=hi?0u:0x00003f80u; qe=__builtin_bit_cast(bf16x8,(u32x4){one2,one1,0u,0u}); }
  float mhat=ubound,l_reg=0.f;f32x16 o[2];o[0]=f32x16{};o[1]=f32x16{};f32x16 negm;
  #pragma unroll
  for(int r=0;r<16;++r)negm[r]=fq2-ubound;
  asm volatile("":"+v"(negm));
  const int qrel=wid*QBLK+r32;
  #define CMASK(P0,P1,t) do{int jb_=(t)-(NT-4); if(jb_>=0)cmask(P0,P1,jb_,qrel,hi);}while(0)
  bool resc=false;
  #define START(P0,P1) do{ const float rm=rowmax(P0,P1); resc=false; \
    { const float dl=fmaxf(rm,0.f); mhat=fadd_s(mhat,dl); \
      _Pragma("unroll") for(int r=0;r<16;++r){P0[r]=fsub_s(P0[r],dl);P1[r]=fsub_s(P1[r],dl);} \
      _Pragma("unroll") for(int r=0;r<16;++r)negm[r]=fq2-mhat; asm volatile("":"+v"(negm)); } \
    _Pragma("unroll") for(int r=0;r<16;++r)P0[r]=__builtin_amdgcn_exp2f(P0[r]); }while(0)
  #define RESC() do{ if(resc){ asm volatile("s_waitcnt lgkmcnt(0)":::"memory"); \
      _Pragma("unroll") for(int d_=0;d_<2;++d_) _Pragma("unroll") for(int r=0;r<16;++r)o[d_][r]*=wsf[crow(r,hi)]; } }while(0)
  f32x16 pA0,pA1,pB0,pB1;
  int sl_prev=0,sl_cur=0,sl_next=SLOTB;
  #define ROT() do{sl_prev=sl_cur;sl_cur=sl_next;sl_next=(sl_next==(NSLOT-1)*SLOTB)?0:sl_next+SLOTB;}while(0)
  DMA_K(2,2*SLOTB);
  WAIT_BAR(3);
  qkt(pA0,pA1,Kbase,qr,qe,negm,r32,hi);asm volatile("s_nop 15\n\ts_nop 7":"+v"(pA0),"+v"(pA1));CMASK(pA0,pA1,0);
  START(pA0,pA1);
  _Pragma("unroll") for(int r=0;r<16;++r)pA1[r]=__builtin_amdgcn_exp2f(pA1[r]);
  WAIT_BAR(0);
  DMA_K(3,0);DMA_V(1,SLOTB);
  ROT();
  kload8(kf,kp0+sl_cur);
  kf[8]=*(const __attribute__((address_space(3))) bf16x8*)(kpe+sl_cur); kf[9]=*(const __attribute__((address_space(3))) bf16x8*)(kpe+sl_cur+512);
  WAIT_BARW();
  s16x4 vlo[8],vhi[8]; u32x4 pw0,pw1,pw2,pw3;
  #define PKW(P,B) cvtpk_s(P[B],P[B+1])
  #define PAF(k) __builtin_bit_cast(bf16x8,pw##k)
  #define VFR(i) (bf16x8){vlo[i][0],vlo[i][1],vlo[i][2],vlo[i][3],vhi[i][0],vhi[i][1],vhi[i][2],vhi[i][3]}
  #define PIN(x) asm volatile("":"+v"(x))
  #define MX3(a,b,c) __builtin_fmaxf(__builtin_fmaxf((a),(b)),(c))
  #define GAPA(MF,A0,A1,A2,A3,W0,W1,PW) do{ MF; sacc+=A0; sacc+=A1; sacc+=A2; sacc+=A3; PIN(sacc); W0; W1; PIN(PW); SBAR(); }while(0)
  #define EX(v) __builtin_amdgcn_exp2f(v)
  #define GAPB(MF,X,B) do{ MF; X[B]=EX(X[B]); X[B+1]=EX(X[B+1]); X[B+2]=EX(X[B+2]); X[B+3]=EX(X[B+3]); PIN(X); SBAR(); }while(0)
  #define VRD(i) do{ vlo[i]=vtr(vp_+(((i)>>2)*4096+((i)&3)*1024)); vhi[i]=vtr(vp_+(((i)>>2)*4096+((i)&3)*1024+512)); }while(0)
  #define KRD(G,j) do{ if(G){ kload2(kf,kp0+sl_next,j); SBAR(); } }while(0)
  #define STEP(C0,C1,P0,P1,t,GK,GV,GL) do{ SBAR(); \
    const lds_cptr vp_=vp0+sl_prev; \
    VRD(0); SBAR(); float sacc=(P0[0]+P0[1]); \
    GAPA(C0=__builtin_amdgcn_mfma_f32_32x32x16_bf16(kf[0],qr[0],negm,0,0,0), P0[2],P0[3],P0[4],P0[5],     pw0[0]=PKW(P0,0), pw0[1]=PKW(P0,2), pw0); \
    VRD(4); SBAR(); GAPA(C1=__builtin_amdgcn_mfma_f32_32x32x16_bf16(kf[1],qr[0],negm,0,0,0), P0[6],P0[7],P0[8],P0[9],     pw0[2]=PKW(P0,4), pw0[3]=PKW(P0,6), pw0); \
    VRD(1); SBAR(); GAPA(C0=__builtin_amdgcn_mfma_f32_32x32x16_bf16(kf[2],qr[1],C0,0,0,0),   P0[10],P0[11],P0[12],P0[13], pw1[0]=PKW(P0,8), pw1[1]=PKW(P0,10), pw1); \
    VRD(5); SBAR(); GAPA(C1=__builtin_amdgcn_mfma_f32_32x32x16_bf16(kf[3],qr[1],C1,0,0,0),   P0[14],P0[15],P1[0],P1[1],   pw1[2]=PKW(P0,12),pw1[3]=PKW(P0,14), pw1); \
    VRD(2); SBAR(); GAPA(C0=__builtin_amdgcn_mfma_f32_32x32x16_bf16(kf[4],qr[2],C0,0,0,0),   P1[2],P1[3],P1[4],P1[5],     pw2[0]=PKW(P1,0), pw2[1]=PKW(P1,2), pw2); \
    VRD(6); SBAR(); GAPA(C1=__builtin_amdgcn_mfma_f32_32x32x16_bf16(kf[5],qr[2],C1,0,0,0),   P1[6],P1[7],P1[8],P1[9],     pw2[2]=PKW(P1,4), pw2[3]=PKW(P1,6), pw2); \
    VRD(3); SBAR(); GAPA(C0=__builtin_amdgcn_mfma_f32_32x32x16_bf16(kf[6],qr[3],C0,0,0,0),   P1[10],P1[11],P1[12],P1[13], pw3[0]=PKW(P1,8), pw3[1]=PKW(P1,10), pw3); \
    VRD(7); SBAR(); GAPA(C1=__builtin_amdgcn_mfma_f32_32x32x16_bf16(kf[7],qr[3],C1,0,0,0),   P1[14],P1[15],0.f,0.f,       pw3[2]=PKW(P1,12),pw3[3]=PKW(P1,14), pw3); \
    C0=__builtin_amdgcn_mfma_f32_32x32x16_bf16(kf[8],qe,C0,0,0,0); C1=__builtin_amdgcn_mfma_f32_32x32x16_bf16(kf[9],qe,C1,0,0,0); \
    l_reg+=sacc; \
    if(GK){DMA_K((t)+3,sl_cur);} if(GV){DMA_V((t)+1,sl_next);} \
    CMASK(C0,C1,t); \
    resc=false;     \
    SBAR(); \
    GAPB(o[0]=__builtin_amdgcn_mfma_f32_32x32x16_bf16(PAF(0),VFR(0),o[0],0,0,0), C0,0); \
    GAPB(o[1]=__builtin_amdgcn_mfma_f32_32x32x16_bf16(PAF(0),VFR(4),o[1],0,0,0), C0,4); \
    KRD(GL,0); GAPB(o[0]=__builtin_amdgcn_mfma_f32_32x32x16_bf16(PAF(1),VFR(1),o[0],0,0,0), C0,8); \
    KRD(GL,1); GAPB(o[1]=__builtin_amdgcn_mfma_f32_32x32x16_bf16(PAF(1),VFR(5),o[1],0,0,0), C0,12); \
    KRD(GL,2); GAPB(o[0]=__builtin_amdgcn_mfma_f32_32x32x16_bf16(PAF(2),VFR(2),o[0],0,0,0), C1,0); \
    KRD(GL,3); GAPB(o[1]=__builtin_amdgcn_mfma_f32_32x32x16_bf16(PAF(2),VFR(6),o[1],0,0,0), C1,4); \
    if(GL){ kf[8]=*(const __attribute__((address_space(3))) bf16x8*)(kpe+sl_next); kf[9]=*(const __attribute__((address_space(3))) bf16x8*)(kpe+sl_next+512); SBAR(); } \
    GAPB(o[0]=__builtin_amdgcn_mfma_f32_32x32x16_bf16(PAF(3),VFR(3),o[0],0,0,0), C1,8); \
    GAPB(o[1]=__builtin_amdgcn_mfma_f32_32x32x16_bf16(PAF(3),VFR(7),o[1],0,0,0), C1,12); \
    }while(0)
  int t=1;
  #undef CMASK
  #define CMASK(P0,P1,t) do{}while(0)
  for(;t+5<NT;t+=2){
    STEP(pB0,pB1,pA0,pA1,t,true,true,true);     WAIT_BARW(); RESC(); ROT();
    STEP(pA0,pA1,pB0,pB1,t+1,true,true,true);   WAIT_BARW(); RESC(); ROT();
  }
  #undef CMASK
  #define CMASK(P0,P1,t) do{int jb_=(t)-(NT-4); if(jb_>=0)cmask(P0,P1,jb_,qrel,hi);}while(0)
  #define ENDW(tt) do{ if((tt)+3<NT){WAIT_BARW();} else if((tt)+2<NT){WAIT_BAR(1);} else {WAIT_BAR(0);} }while(0)
  for(;t+1<NT;t+=2){
    STEP(pB0,pB1,pA0,pA1,t,(t+3<NT),(t+1<NT),(t+1<NT));       ENDW(t);   RESC(); ROT();
    STEP(pA0,pA1,pB0,pB1,t+1,(t+4<NT),(t+2<NT),(t+2<NT));     ENDW(t+1); RESC(); ROT();
  }
  STEP(pB0,pB1,pA0,pA1,NT-1,false,false,false); RESC();
  { float sacc=pB0[0]+pB0[1]; _Pragma("unroll") for(int r=2;r<16;++r)sacc+=pB0[r]; _Pragma("unroll") for(int r=0;r<16;++r)sacc+=pB1[r]; l_reg+=sacc;
    pw0=(u32x4){PKW(pB0,0),PKW(pB0,2),PKW(pB0,4),PKW(pB0,6)};pw1=(u32x4){PKW(pB0,8),PKW(pB0,10),PKW(pB0,12),PKW(pB0,14)};pw2=(u32x4){PKW(pB1,0),PKW(pB1,2),PKW(pB1,4),PKW(pB1,6)};pw3=(u32x4){PKW(pB1,8),PKW(pB1,10),PKW(pB1,12),PKW(pB1,14)};
    SBAR(); pv(o,vb0+sl_cur,PAF(0),PAF(1),PAF(2),PAF(3)); }
  #undef PKW
  #undef PAF
  #undef VFR
  #undef PIN
  #undef MX3
  #undef GAPA
  #undef GAPB
  #undef EX
  #undef VRD
  #undef KRD
  #undef STEP
  #undef ENDW
  {auto rr=__builtin_amdgcn_permlane32_swap(__float_as_uint(l_reg),__float_as_uint(l_reg),false,false);l_reg=__uint_as_float(rr[0])+__uint_as_float(rr[1]);}
  if(hi==0)wsf[32+r32]=l_reg;asm volatile("s_waitcnt lgkmcnt(0)":::"memory");
  float rli[16];
  #pragma unroll
  for(int r=0;r<16;++r)rli[r]=__builtin_amdgcn_rcpf(wsf[32+crow(r,hi)]);
  bf16*Ow=O+(rowbase+q0+wid*QBLK)*DM+h*D;
  { bf16*stg=(bf16*)(shm+LDS_OST)+wid*2048;
    #pragma unroll
    for(int r=0;r<16;++r){const int orow=crow(r,hi);
      #pragma unroll
      for(int d0=0;d0<2;++d0)stg[orow*64+d0*32+r32]=__float2bfloat16(o[d0][r]*rli[r]);}
    asm volatile("s_waitcnt lgkmcnt(0)":::"memory");
    const bf16*Gw=GT+(rowbase+q0+wid*QBLK)*DM+h*D;
    #pragma unroll
    for(int i=0;i<4;++i){const int row=i*8+(lane>>3),ch=lane&7; u32x4 v=*(const u32x4*)(stg+row*64+ch*8); const u32x4 gg=*(const u32x4*)(Gw+(long)row*DM+ch*8);
      #pragma unroll
      for(int j=0;j<4;++j){ v[j]=cvtpk_s(__uint_as_float(v[j]<<16)*__uint_as_float(gg[j]<<16),__uint_as_float(v[j]&0xffff0000u)*__uint_as_float(gg[j]&0xffff0000u)); }
      ATTN_STORE16(Ow+(long)row*DM+ch*8,v);} }
  asm volatile("s_waitcnt lgkmcnt(0)\n\ts_barrier":::"memory");
  #undef DMA_K
  #undef DMA_V
  #undef CMASK
  #undef START
  #undef RESC
  #undef ROT
}
constexpr int ATTN_LDS_BYTES=LDS_BYTES;
struct AttnTensors { const bf16* Q; const bf16* K; const bf16* V; bf16* O; const bf16* GT; const unsigned char* G3; const float* qgain; float kbound; };
struct AttnUnit { int bh; int qb; };
struct StaticOrder {
  int vcu;
  __device__ __forceinline__ explicit StaticOrder(int grid,int block):vcu((block%8)*(grid/8)+block/8){}
  __device__ __forceinline__ bool next(int i,AttnUnit&u)const{ if(i>=4)return false; const int s=vcu&7; u.bh=vcu>>3; u.qb=(i==0)?s:(i==1)?15-s:(i==2)?16+s:31-s; return true; }
  __device__ __forceinline__ void a_ready(const AttnUnit&)const{}
  __device__ __forceinline__ void done(const AttnUnit&)const{}
};
template<class Sched,int THRL=8> __device__ __forceinline__ void attn_phase(char*lds,const AttnTensors&T,const Sched&S,const int tid_in){
  AttnUnit u;
  for(int i=0;S.next(i,u);++i){ S.a_ready(u); attn_unit<THRL>(u.bh/NHEAD,u.bh%NHEAD,u.qb,T.Q,T.K,T.V,T.O,T.GT,T.G3,T.qgain,T.kbound,lds,tid_in,0); S.done(u); }
}
__device__ __forceinline__ float g3val(const unsigned char*G3,long key){ const u32x4 ge=*reinterpret_cast<const u32x4*>(G3+key*16); return __uint_as_float(ge[0]<<16)+__uint_as_float(ge[0]&0xffff0000u)+__uint_as_float(ge[1]<<16); }
template<int THRL=8> __device__ __forceinline__ void attn_phase_dyn(char*lds,const AttnTensors&T,unsigned*counter,const float thr2,const int tid_in){
  int tid_l=tid_in; asm volatile("":"+v"(tid_l)); const int tid=tid_l,lane=tid&63;
  volatile unsigned*uw=(volatile unsigned*)(lds+LDS_BYTES);
  for(;;){
    if(tid==0){ const unsigned got=__hip_atomic_fetch_add(counter,1u,__ATOMIC_RELAXED,__HIP_MEMORY_SCOPE_AGENT); *uw=got; }
    __syncthreads();
    const unsigned u=(unsigned)__builtin_amdgcn_readfirstlane((int)*uw);
    if(u>=(unsigned)(BATCH*NHEAD*NQB))break;
    const int qb=NQB-1-(int)(u>>5), bh=(int)(u&31), ntf=4*qb+4;
    const long kb=(long)bh*SEQ; const float gt0=g3val(T.G3,kb+(long)qb*QB);
    bool skip0=false,skip1=false;
    if(lane<ntf) skip0=g3val(T.G3,kb+64*lane+63)<gt0-thr2;
    if(lane+64<ntf) skip1=g3val(T.G3,kb+64*(lane+64)+63)<gt0-thr2;
    int j0=__builtin_popcountll(__ballot(skip0))+__builtin_popcountll(__ballot(skip1));
    j0=__builtin_amdgcn_readfirstlane(j0); j0&=~1; if(j0>ntf-4)j0=ntf-4;
    attn_unit<THRL>(bh/NHEAD,bh%NHEAD,qb,T.Q,T.K,T.V,T.O,T.GT,T.G3,T.qgain,T.kbound,lds,tid_in,j0);
  }
}
#undef SBAR
#undef WAIT_BAR
#undef WAIT_BARW
}
constexpr int NWAVES = 8;
constexpr int BATCH = 2, T = 8192, D = 1024, H = 16, HD = 64, FF = 4096, M = BATCH * T;
constexpr int N1 = 3584, K1 = 2048, NP2 = 3072;
constexpr size_t MiB = 1u << 20;
constexpr size_t WS_MOD = 0;
constexpr size_t WS_W1 = 1 * MiB;
constexpr size_t WS_W2A = 29 * MiB;
constexpr size_t WS_W2G = 32 * MiB;
constexpr size_t WS_WO = 33 * MiB;
constexpr size_t WS_WKV = 37 * MiB;
constexpr size_t WS_WQG = 42 * MiB;
constexpr size_t WS_WO2 = 50 * MiB;
constexpr size_t WS_WUP = 54 * MiB, WS_WDN = 62 * MiB;
constexpr size_t WS_G3 = 70 * MiB;
constexpr size_t WS_FL = 74 * MiB;
constexpr size_t WS_H2 = 76 * MiB;
constexpr size_t WS_P1 = 140 * MiB;
constexpr size_t WS_P2 = 252 * MiB;
constexpr size_t WS_VF = 348 * MiB;
constexpr size_t WS_HB = 140 * MiB;
constexpr size_t WS_KVRAW = 140 * MiB, WS_QB = 204 * MiB, WS_GT = 236 * MiB, WS_VS = 316 * MiB, WS_KS = 348 * MiB;
constexpr size_t WS_END = 380 * MiB;
constexpr int LDS_BYTES = 147456;

#define GAS __attribute__((address_space(1)))
#define LAS __attribute__((address_space(3)))
typedef unsigned short bf16;
typedef unsigned v4u __attribute__((ext_vector_type(4)));
typedef unsigned v2u __attribute__((ext_vector_type(2)));
typedef float f32x4 __attribute__((ext_vector_type(4)));
using pg8::pkbf; using pg8::bflo; using pg8::bfhi; using pg8::sigm;

struct Args { const float* in[39]; float* out; unsigned char* ws; int ph_lo, ph_hi; };

struct Frame { LAS unsigned char* lds; int tid, lane, wave, vcu, G, bx; unsigned char* ws; float* out; const float* const* in; };

__device__ __forceinline__ void tr_item(const float* W, int ldw, int Nvalid, bf16* WT, int ldt, int row_off, int col_off, const float* mu, LAS float* scr, int item, int lane) {
    const int nblk = (Nvalid + 31) / 32, kb = item / nblk, nb = item % nblk, k0 = 64 * kb, n0 = 32 * nb;
    { float t[32]; const int n = n0 + (lane & 31); const bool ok = n < Nvalid; const float* wp = W + (size_t)(k0 + (lane >> 5)) * ldw + n;
#pragma unroll
      for (int i = 0; i < 32; ++i) t[i] = ok ? wp[(size_t)(2 * i) * ldw] : 0.f;
#pragma unroll
      for (int i = 0; i < 32; ++i) scr[(2 * i + (lane >> 5)) * 33 + (lane & 31)] = t[i]; }
    asm volatile("s_waitcnt lgkmcnt(0)" ::: "memory");
    const int c = lane & 7;
    float s0[8], s1[8];
#pragma unroll
    for (int q = 0; q < 8; ++q) { const float m = mu ? mu[k0 + 8 * c + q] : 0.f; s0[q] = 1.f - m; s1[q] = m; }
#pragma unroll
    for (int j = 0; j < 4; ++j) { const int n = (lane >> 3) + 8 * j; const LAS float* s = scr + (8 * c) * 33 + n;
        float v[8];
#pragma unroll
        for (int q = 0; q < 8; ++q) v[q] = s[q * 33];
        v4u o; o.x = pkbf(v[0] * s0[0], v[1] * s0[1]); o.y = pkbf(v[2] * s0[2], v[3] * s0[3]); o.z = pkbf(v[4] * s0[4], v[5] * s0[5]); o.w = pkbf(v[6] * s0[6], v[7] * s0[7]);
        bf16* dst = WT + (size_t)(row_off + n0 + n) * ldt + col_off + k0 + 8 * c;
        *(v4u*)dst = o;
        if (mu) { v4u p; p.x = pkbf(v[0] * s1[0], v[1] * s1[1]); p.y = pkbf(v[2] * s1[2], v[3] * s1[3]); p.z = pkbf(v[4] * s1[4], v[5] * s1[5]); p.w = pkbf(v[6] * s1[6], v[7] * s1[7]); *(v4u*)(dst + 1024) = p; } }
    asm volatile("s_waitcnt lgkmcnt(0)" ::: "memory");
}
__device__ __forceinline__ float dpp_f(float x, const int ctrl_sel) {
    switch (ctrl_sel) {
        case 0: return __builtin_bit_cast(float, __builtin_amdgcn_update_dpp(0, __builtin_bit_cast(int, x), 0xB1, 0xf, 0xf, false));
        case 1: return __builtin_bit_cast(float, __builtin_amdgcn_update_dpp(0, __builtin_bit_cast(int, x), 0x4E, 0xf, 0xf, false));
        case 2: return __builtin_bit_cast(float, __builtin_amdgcn_update_dpp(0, __builtin_bit_cast(int, x), 0x141, 0xf, 0xf, false));
        default: return __builtin_bit_cast(float, __builtin_amdgcn_update_dpp(0, __builtin_bit_cast(int, x), 0x140, 0xf, 0xf, false));
    }
}
__device__ __forceinline__ float sum4(float x) { x += dpp_f(x, 0); x += dpp_f(x, 1); return x; }
__device__ __forceinline__ float sum8(float x) { x = sum4(x); x += dpp_f(x, 2); return x; }
__device__ __forceinline__ float sum16(float x) { x = sum8(x); x += dpp_f(x, 3); return x; }
__device__ __forceinline__ float wave_sum(float v) {
    v = sum16(v);
    { auto rr = __builtin_amdgcn_permlane16_swap(__float_as_uint(v), __float_as_uint(v), false, false); v = __uint_as_float(rr[0]) + __uint_as_float(rr[1]); }
    { auto rr = __builtin_amdgcn_permlane32_swap(__float_as_uint(v), __float_as_uint(v), false, false); v = __uint_as_float(rr[0]) + __uint_as_float(rr[1]); }
    return v;
}
__device__ __forceinline__ void norm_row(const float* xrow, const float* g, const float* sh, const float* sc, int lane, f32x4 (&v)[4]) {
    float s = 0.f;
#pragma unroll
    for (int j = 0; j < 4; ++j) { v[j] = *((const f32x4*)xrow + lane + 64 * j); s += (v[j].x * v[j].x + v[j].y * v[j].y) + (v[j].z * v[j].z + v[j].w * v[j].w); }
    const float rstd = 1.0f / sqrtf(wave_sum(s) * (1.f / D) + 1e-6f);
#pragma unroll
    for (int j = 0; j < 4; ++j) { const f32x4 gg = *((const f32x4*)g + lane + 64 * j);
        f32x4 a = {1.f, 1.f, 1.f, 1.f}, b = {0.f, 0.f, 0.f, 0.f}; if (sc) { a = *((const f32x4*)sc + lane + 64 * j) + 1.0f; b = *((const f32x4*)sh + lane + 64 * j); }
        v[j] = (v[j] * rstd * gg) * a + b; }
}
__device__ __forceinline__ void st_row_bf16(bf16* orow, int lane, const f32x4 (&v)[4]) {
#pragma unroll
    for (int j = 0; j < 4; ++j) { v2u w; w.x = pkbf(v[j].x, v[j].y); w.y = pkbf(v[j].z, v[j].w); *((v2u*)orow + lane + 64 * j) = w; }
}
__device__ __forceinline__ void p0_mod(Frame& F) {
    LAS float* ca = (LAS float*)F.lds; LAS float* red = (LAS float*)(F.lds + 8192);
    const float* cin = F.in[1];
    for (int i = F.tid; i < 2048; i += 512) { const float c = cin[i]; ca[i] = c / (1.0f + __expf(-c)); }
    __syncthreads();
    float* MOD = (float*)(F.ws + WS_MOD); float* MODKV = MOD + 4 * 2 * 6144;
    for (int item = F.bx; item < 208; item += F.G) {
        const int col = item * 128; const float* W; const float* bias; int ldw, cw; float* dst0; float* dst1;
        if (col < 24576) { const int l = col / 6144; cw = col % 6144; W = F.in[2] + (size_t)l * 1024 * 6144; ldw = 6144; bias = F.in[3] + l * 6144; dst0 = MOD + (l * 2 + 0) * 6144 + cw; dst1 = MOD + (l * 2 + 1) * 6144 + cw; }
        else { cw = col - 24576; W = F.in[30]; ldw = 2048; bias = F.in[31]; dst0 = MODKV + cw; dst1 = MODKV + 2048 + cw; }
        const int c4 = F.tid & 31, ks = F.tid >> 5;
        f32x4 a0 = {0.f, 0.f, 0.f, 0.f}, a1 = {0.f, 0.f, 0.f, 0.f};
#pragma unroll 8
        for (int k = ks * 64; k < ks * 64 + 64; ++k) { const f32x4 w = *(const f32x4*)(W + (size_t)k * ldw + cw + c4 * 4); a0 += w * ca[k]; a1 += w * ca[1024 + k]; }
        *(LAS f32x4*)(red + (ks * 32 + c4) * 8) = a0; *(LAS f32x4*)(red + (ks * 32 + c4) * 8 + 4) = a1;
        __syncthreads();
        if (F.tid < 256) { const int b = F.tid >> 7, c = F.tid & 127; float s = 0.f;
#pragma unroll
            for (int q = 0; q < 16; ++q) s += red[(q * 32 + (c >> 2)) * 8 + b * 4 + (c & 3)];
            (b ? dst1 : dst0)[c] = s + bias[cw + c]; }
        __syncthreads();
    }
}
__device__ __forceinline__ void p0_weights(Frame& F) {
    LAS float* scr = (LAS float*)(F.lds + 16384 + F.wave * 16384);
    const int gw = F.vcu * NWAVES + F.wave, NGW = F.G * NWAVES;
    bf16* W1 = (bf16*)(F.ws + WS_W1); bf16* WO = (bf16*)(F.ws + WS_WO); bf16* WKV = (bf16*)(F.ws + WS_WKV); bf16* WQG = (bf16*)(F.ws + WS_WQG); bf16* WO2 = (bf16*)(F.ws + WS_WO2);
    const float* mu = F.in[8];
    constexpr int PL = 512 * 3 + 32 + 32 + 16 + 80 + 512;
    constexpr int NIT = 2 * PL + 512 + 512 + 16 + 2 * (1024 + 512);
    for (int it = gw; it < NIT; it += NGW) {
        int r = it;
        if (r < 2 * PL) { const int i = r / PL; r -= i * PL; bf16* w1 = W1 + (size_t)i * N1 * K1; const float* m6 = mu + i * 6 * 1024;
            bf16* wl = w1 + (size_t)3072 * 1024;
            if (r < 512) { tr_item(F.in[9] + (size_t)i * D * D, D, D, w1, D, 0, 0, nullptr, scr, r, F.lane); continue; } r -= 512;
            if (r < 512) { tr_item(F.in[10] + (size_t)i * D * D, D, D, w1, D, 1024, 0, nullptr, scr, r, F.lane); continue; } r -= 512;
            if (r < 512) { tr_item(F.in[11] + (size_t)i * D * D, D, D, w1, D, 2048, 0, nullptr, scr, r, F.lane); continue; } r -= 512;
            if (r < 32) { tr_item(F.in[14] + (size_t)i * D * 64, 64, 64, wl, K1, 0, 0, m6 + 1 * 1024, scr, r, F.lane); continue; } r -= 32;
            if (r < 32) { tr_item(F.in[17] + (size_t)i * D * 64, 64, 64, wl, K1, 64, 0, m6 + 4 * 1024, scr, r, F.lane); continue; } r -= 32;
            if (r < 16) { if (i == 1) tr_item(F.in[27], 32, 32, wl, K1, 128, 0, m6 + 3 * 1024, scr, r, F.lane); continue; } r -= 16;
            if (r < 80) { tr_item(F.in[19] + (size_t)i * D * 160, 160, 160, wl, K1, 160, 0, m6 + 5 * 1024, scr, r, F.lane); continue; } r -= 80;
            tr_item(F.in[12] + (size_t)i * D * D, D, D, WO + (size_t)i * D * D, D, 0, 0, nullptr, scr, r, F.lane); continue; }
        r -= 2 * PL;
        if (r < 512) { tr_item(F.in[32], 2064, 1024, WKV, D, 0, 0, nullptr, scr, r, F.lane); continue; } r -= 512;
        if (r < 512) { tr_item(F.in[32] + 1024, 2064, 1024, WKV, D, 1024, 0, nullptr, scr, r, F.lane); continue; } r -= 512;
        if (r < 16) { tr_item(F.in[32] + 2048, 2064, 16, WKV, D, 2048, 0, nullptr, scr, r, F.lane); continue; } r -= 16;
        { const int j = r / 1536; r -= j * 1536;
          if (r < 1024) tr_item(F.in[35] + (size_t)j * D * 2048, 2048, 2048, WQG + (size_t)j * 2048 * D, D, 0, 0, nullptr, scr, r, F.lane);
          else tr_item(F.in[37] + (size_t)j * D * D, D, D, WO2 + (size_t)j * D * D, D, 0, 0, nullptr, scr, r - 1024, F.lane); }
    }
    const int gt = F.bx * 512 + F.tid, NT = F.G * 512; const v4u z = {0u, 0u, 0u, 0u};
    for (int e = gt; e < 135168; e += NT) {
        int r = e; bf16* p;
        if (r < 98304) { const int i = r / 49152; r -= i * 49152; p = W1 + (size_t)i * N1 * K1 + (size_t)3072 * 1024 + (size_t)320 * K1 + (size_t)r * 8; }
        else if (r < 98304 + 8192) { r -= 98304; p = W1 + (size_t)3072 * 1024 + (size_t)128 * K1 + (size_t)r * 8; }
        else { r -= 98304 + 8192; p = WKV + (size_t)2080 * D + (size_t)r * 8; }
        *(v4u*)p = z; }
    { float* B2 = (float*)(F.ws + WS_MOD) + 53248;
      for (int e = gt; e < 2 * 3072; e += NT) { const int i = e / 3072, n = e % 3072, grp = n >> 10, c = n & 1023;
          B2[e] = grp == 0 ? F.in[13][i * D + c] : (grp == 1 ? F.in[16][i * D + c] : (i == 1 ? F.in[26][c] : 0.f)); } }
    bf16* W2A = (bf16*)(F.ws + WS_W2A); bf16* W2G = (bf16*)(F.ws + WS_W2G);
    for (int e4 = gt; e4 < 2 * 262144; e4 += NT) {
        const int i = e4 >> 18; int r = (e4 & 262143) * 4;
        if (r < 786432) { const int k = r / 3072, n = r % 3072, grp = n >> 10, c = n & 1023; f32x4 v = {0.f, 0.f, 0.f, 0.f};
            if (grp == 0) { if (k < 64) v = *(const f32x4*)(F.in[15] + ((size_t)i * 64 + k) * 1024 + c); }
            else if (grp == 1) { if (k >= 64 && k < 128) v = *(const f32x4*)(F.in[18] + ((size_t)i * 64 + (k - 64)) * 1024 + c); }
            else { if (i == 1 && k >= 128 && k < 160) v = *(const f32x4*)(F.in[28] + (size_t)(k - 128) * 1024 + c); }
            bf16* o = W2A + (size_t)i * 3072 * 256 + (size_t)n * 256 + k; const unsigned p0 = pkbf(v.x, v.y), p1 = pkbf(v.z, v.w);
            o[0] = (bf16)(p0 & 0xffffu); o[256] = (bf16)(p0 >> 16); o[512] = (bf16)(p1 & 0xffffu); o[768] = (bf16)(p1 >> 16); }
        else { r -= 786432; const int k = r >> 10, n = r & 1023; f32x4 v = {0.f, 0.f, 0.f, 0.f}; if (k < 160) v = *(const f32x4*)(F.in[20] + ((size_t)i * 160 + k) * 1024 + n);
            bf16* o = W2G + (size_t)i * 1024 * 256 + (size_t)n * 256 + k; const unsigned p0 = pkbf(v.x, v.y), p1 = pkbf(v.z, v.w);
            o[0] = (bf16)(p0 & 0xffffu); o[256] = (bf16)(p0 >> 16); o[512] = (bf16)(p1 & 0xffffu); o[768] = (bf16)(p1 >> 16); }
    }
}
__device__ __forceinline__ void mlp_weights(Frame& F, int L) {
    LAS float* scr = (LAS float*)(F.lds + F.wave * 16384);
    const int gw = F.vcu * NWAVES + F.wave, NGW = F.G * NWAVES;
    bf16* WUP = (bf16*)(F.ws + WS_WUP); bf16* WDN = (bf16*)(F.ws + WS_WDN);
    for (int it = gw; it < 4096; it += NGW) {
        if (it < 2048) tr_item(F.in[6] + (size_t)L * D * FF, FF, FF, WUP, D, 0, 0, nullptr, scr, it, F.lane);
        else tr_item(F.in[7] + (size_t)L * FF * D, D, D, WDN, FF, 0, 0, nullptr, scr, it - 2048, F.lane);
    }
}
__device__ __forceinline__ void norm_phase(Frame& F, const float* xin, const float* g, const float* sh, const float* sc, int bstride, int mode, bf16* dst, float* outf = nullptr) {
    const int gw = F.vcu * NWAVES + F.wave, NGW = F.G * NWAVES, lane = F.lane; (void)mode;
    for (int base = gw * 8; base < M; base += NGW * 8) {
        const int b = base >> 13;
        f32x4 gg[4], aa[4], bb[4];
#pragma unroll
        for (int j = 0; j < 4; ++j) { gg[j] = *((const f32x4*)g + lane + 64 * j);
            aa[j] = sc ? *((const f32x4*)(sc + b * bstride) + lane + 64 * j) + 1.0f : (f32x4){1.f, 1.f, 1.f, 1.f}; bb[j] = sh ? *((const f32x4*)(sh + b * bstride) + lane + 64 * j) : (f32x4){0.f, 0.f, 0.f, 0.f}; }
        f32x4 xn[4];
#pragma unroll
        for (int j = 0; j < 4; ++j) xn[j] = *((const f32x4*)(xin + (size_t)base * D) + lane + 64 * j);
#pragma unroll 1
        for (int r = 0; r < 8; ++r) { const int m = base + r; f32x4 v[4]; float s = 0.f;
#pragma unroll
            for (int j = 0; j < 4; ++j) { v[j] = xn[j]; s += (v[j].x * v[j].x + v[j].y * v[j].y) + (v[j].z * v[j].z + v[j].w * v[j].w); }
            if (r + 1 < 8) {
#pragma unroll
                for (int j = 0; j < 4; ++j) xn[j] = *((const f32x4*)(xin + (size_t)(m + 1) * D) + lane + 64 * j); }
            const float rstd = 1.0f / sqrtf(wave_sum(s) * (1.f / D) + 1e-6f);
#pragma unroll
            for (int j = 0; j < 4; ++j) v[j] = (v[j] * rstd * gg[j]) * aa[j] + bb[j];
            if (outf) {
#pragma unroll
                for (int j = 0; j < 4; ++j) *((f32x4*)(outf + (size_t)m * D) + lane + 64 * j) = v[j]; }
            else st_row_bf16(dst + (size_t)m * 1024, lane, v);
        }
    }
}
__device__ __forceinline__ void norm_mix_phase(Frame& F, const float* xin, const float* g, const float* sh, const float* sc, const float* mu, bf16* H2p, bf16* XJ) {
    const int gw = F.vcu * NWAVES + F.wave, NGW = F.G * NWAVES, lane = F.lane;
    for (int base = gw * 8; base < M; base += NGW * 8) {
        const int b = base >> 13;
        f32x4 gg[4], aa[4], bb[4], m0[4], m1[4], m2[4];
#pragma unroll
        for (int j = 0; j < 4; ++j) { gg[j] = *((const f32x4*)g + lane + 64 * j); aa[j] = *((const f32x4*)(sc + b * 6144) + lane + 64 * j) + 1.0f; bb[j] = *((const f32x4*)(sh + b * 6144) + lane + 64 * j);
            m0[j] = *((const f32x4*)mu + lane + 64 * j); m1[j] = *((const f32x4*)(mu + 2048) + lane + 64 * j); m2[j] = *((const f32x4*)(mu + 3072) + lane + 64 * j); }
        const bool first = (base & 8191) == 0; const int r0 = first ? 0 : -1;
        f32x4 hp[4], xn[4];
#pragma unroll
        for (int j = 0; j < 4; ++j) { hp[j] = (f32x4){0.f, 0.f, 0.f, 0.f}; xn[j] = *((const f32x4*)(xin + (size_t)(base + r0) * D) + lane + 64 * j); }
#pragma unroll 1
        for (int r = r0; r < 8; ++r) { const int m = base + r; f32x4 v[4];
            float s = 0.f;
#pragma unroll
            for (int j = 0; j < 4; ++j) { v[j] = xn[j]; s += (v[j].x * v[j].x + v[j].y * v[j].y) + (v[j].z * v[j].z + v[j].w * v[j].w); }
            if (r + 1 < 8) {
#pragma unroll
                for (int j = 0; j < 4; ++j) xn[j] = *((const f32x4*)(xin + (size_t)(m + 1) * D) + lane + 64 * j); }
            const float rstd = 1.0f / sqrtf(wave_sum(s) * (1.f / D) + 1e-6f);
#pragma unroll
            for (int j = 0; j < 4; ++j) v[j] = (v[j] * rstd * gg[j]) * aa[j] + bb[j];
            if (r >= 0) {
                st_row_bf16(H2p + (size_t)m * 2048, lane, v); st_row_bf16(H2p + (size_t)m * 2048 + 1024, lane, hp);
                f32x4 x[4];
#pragma unroll
                for (int j = 0; j < 4; ++j) x[j] = v[j] + (hp[j] - v[j]) * m0[j];
                st_row_bf16(XJ + (size_t)m * D, lane, x);
#pragma unroll
                for (int j = 0; j < 4; ++j) x[j] = v[j] + (hp[j] - v[j]) * m1[j];
                st_row_bf16(XJ + (size_t)M * D + (size_t)m * D, lane, x);
#pragma unroll
                for (int j = 0; j < 4; ++j) x[j] = v[j] + (hp[j] - v[j]) * m2[j];
                st_row_bf16(XJ + (size_t)2 * M * D + (size_t)m * D, lane, x);
            }
#pragma unroll
            for (int j = 0; j < 4; ++j) hp[j] = v[j]; }
    }
}
__device__ __forceinline__ void final_norm_phase(Frame& F) { norm_phase(F, F.out, F.in[38], nullptr, nullptr, 0, 1, nullptr, F.out); }
#ifndef PROBE_SC
#define PROBE_SC 0
#endif
constexpr int SC_C = 32, SC_NC = T / SC_C;
constexpr int SC_VEC = 0, SC_REC = 36864, SC_Y = 38912, SC_BUF = 55296;
typedef float f32x2s __attribute__((ext_vector_type(2)));
__device__ __forceinline__ float dot4(const f32x4 s, const f32x4 a) { f32x2s t = (f32x2s){s.x, s.y} * (f32x2s){a.x, a.y}; t = (f32x2s){s.z, s.w} * (f32x2s){a.z, a.w} + t; return t.x + t.y; }
__device__ __forceinline__ void scan_chunk(const LAS unsigned char* Bc, f32x4& S, const int kq, const int rowi) {
                const LAS f32x4* pvec = (const LAS f32x4*)(Bc + SC_VEC) + kq; const LAS f32x4* prec = (const LAS f32x4*)(Bc + SC_REC) + rowi;
                LAS float* py = (LAS float*)(Bc + SC_Y) + rowi * 16 + kq;
                f32x4 cv[9], cs;
#pragma unroll
                for (int j = 0; j < 9; ++j) cv[j] = pvec[j * 16];
                cs = prec[0];
#pragma unroll
                for (int p = 0; p < SC_C / 2; ++p) {
                    f32x4 nv[9], ns;
                    if (p + 1 < SC_C / 2) {
#pragma unroll
                        for (int j = 0; j < 9; ++j) nv[j] = pvec[((p + 1) * 9 + j) * 16];
                        ns = prec[(p + 1) * 8];
                    }
                    __builtin_amdgcn_sched_barrier(0);
                    float p1 = dot4(S, cv[0]), p2 = dot4(S, cv[1]); const float p3 = dot4(S, cv[2]);
                    p1 += dpp_f(p1, 0); p2 += dpp_f(p2, 0);
                    p1 += dpp_f(p1, 1); p2 += dpp_f(p2, 1);
                    p1 += dpp_f(p1, 2); p2 += dpp_f(p2, 2);
                    p1 += dpp_f(p1, 3); p2 += dpp_f(p2, 3);
                    const float sa1 = fmaf(cs.x, cs.z, p2);
                    const float y0 = p3 + ((kq == 0) ? cs.x * cs.w : 0.f);
                    const f32x4 t0 = S * cv[3] + cv[4] * p1 + cv[5] * cs.x + cv[7] * cs.y;
                    S = t0 + cv[6] * sa1;
                    const float y1 = dot4(S, cv[8]);
                    py[(2 * p) * 128] = y0; py[(2 * p + 1) * 128] = y1;
                    if (p + 1 < SC_C / 2) {
#pragma unroll
                        for (int j = 0; j < 9; ++j) cv[j] = nv[j];
                        cs = ns;
                    }
                }
}
__device__ __forceinline__ void scan_phase(Frame& F, int L) {
    const bf16* P1 = (const bf16*)(F.ws + WS_P1); const bf16* P2 = (const bf16*)(F.ws + WS_P2); const bf16* VF = (const bf16*)(F.ws + WS_VF); float* Y = (float*)(F.ws + WS_H2);
    const float* kkw = F.in[21] + L * D; const float* kaw = F.in[22] + L * D; const float* rkw_ = F.in[23] + L * D; float* BD = (float*)(F.ws + WS_FL);
    const int lane = F.lane;
    int wave;
    { LAS unsigned* tb = (LAS unsigned*)(F.lds + LDS_BYTES - 2048);
      const unsigned simd = ((unsigned)__builtin_amdgcn_s_getreg((1 << 11) | (4 << 6) | 4)) & 3u;
      if (lane == 0) tb[F.wave] = simd;
      __syncthreads();
      unsigned sd[8];
#pragma unroll
      for (int w = 0; w < 8; ++w) sd[w] = tb[w];
      int B = 1;
#pragma unroll
      for (int w = 7; w >= 1; --w) if (sd[w] != sd[0]) B = w;
      int total_non = 0, non_before = 0, share_before = 0; bool my_share = false;
#pragma unroll
      for (int w = 1; w < 8; ++w) { const bool sh = (sd[w] == sd[0]) || (sd[w] == sd[B]); const bool other = (w != B);
          if (other && !sh) { ++total_non; if (w < F.wave) ++non_before; }
          if (other && sh && w < F.wave) ++share_before;
          if (w == F.wave) my_share = sh; }
      int role;
      if (F.wave == 0) role = 0; else if (F.wave == B) role = 1; else role = my_share ? (2 + total_non + share_before) : (2 + non_before);
      wave = __builtin_amdgcn_readfirstlane(role);
      __syncthreads(); }
    for (int item = F.bx; item < 256; item += F.G) {
        const int bh = (item & 7) + 8 * (item >> 6), rg = (item >> 3) & 7, b = bh >> 4, h = bh & 15;
        const size_t m0 = (size_t)b * T;
        const int hidx = (wave - 2) * 64 + lane, hp = (hidx >> 4) & 15, hc4 = hidx & 15;
        const int vtt = lane >> 1, vr4 = (lane & 1) * 4;
        float ckk[4], cka[4], crk[4];
        v2u lr[2][2], lk[2][2], lw[2][2], la[2][2]; v2u lv[2], lvm[2], lvf[2];
#pragma unroll
        for (int q = 0; q < 2; ++q) { lv[q] = (v2u){0u,0u}; lvm[q] = (v2u){0u,0u}; lvf[q] = (v2u){0u,0u};
#pragma unroll
            for (int u = 0; u < 2; ++u) { lr[q][u] = (v2u){0u,0u}; lk[q][u] = (v2u){0u,0u}; lw[q][u] = (v2u){0u,0u}; la[q][u] = (v2u){0u,0u}; } }
        if (wave >= 2 && wave < 6) {
#pragma unroll
            for (int j = 0; j < 4; ++j) { ckk[j] = kkw[h * 64 + hc4 * 4 + j]; cka[j] = kaw[h * 64 + hc4 * 4 + j]; crk[j] = rkw_[h * 64 + hc4 * 4 + j]; } }
#define SC_LOAD(c, Q) do { \
        if (wave >= 2 && wave < 6) { _Pragma("unroll") for (int u = 0; u < 2; ++u) { const size_t m = m0 + (size_t)(c) * SC_C + 2 * hp + u; const bf16* p1 = P1 + m * N1 + h * 64 + hc4 * 4; const bf16* p2 = P2 + m * NP2 + h * 64 + hc4 * 4; \
            lr[Q][u] = *(const v2u*)p1; lk[Q][u] = *(const v2u*)(p1 + 1024); lw[Q][u] = *(const v2u*)p2; la[Q][u] = *(const v2u*)(p2 + 1024); } } \
        else if (wave == 6) { const size_t m = m0 + (size_t)(c) * SC_C + vtt; const int cc = h * 64 + rg * 8 + vr4; \
            lv[Q] = *(const v2u*)(P1 + m * N1 + 2048 + cc); if (L == 1) { lvm[Q] = *(const v2u*)(P2 + m * NP2 + 2048 + cc); lvf[Q] = *(const v2u*)(VF + m * D + cc); } } } while (0)
#define SC_PREP(buf, Q, CC) do { LAS unsigned char* B_ = F.lds + (buf) * SC_BUF; \
        if (wave >= 2 && wave < 6) { f32x4 an[2], bb[2], k2[2], ww[2], rr[2]; \
            _Pragma("unroll") for (int u = 0; u < 2; ++u) { \
                const float kr[4] = {bflo(lk[Q][u].x), bfhi(lk[Q][u].x), bflo(lk[Q][u].y), bfhi(lk[Q][u].y)}, av[4] = {bflo(la[Q][u].x), bfhi(la[Q][u].x), bflo(la[Q][u].y), bfhi(la[Q][u].y)}; \
                const float wn[4] = {bflo(lw[Q][u].x), bfhi(lw[Q][u].x), bflo(lw[Q][u].y), bfhi(lw[Q][u].y)}, rv[4] = {bflo(lr[Q][u].x), bfhi(lr[Q][u].x), bflo(lr[Q][u].y), bfhi(lr[Q][u].y)}; \
                float kv_[4], ss = 0.f; \
                _Pragma("unroll") for (int j = 0; j < 4; ++j) { kv_[j] = kr[j] * ckk[j]; ss += kv_[j] * kv_[j]; } \
                ss = sum16(ss); const float inv = 1.0f / fmaxf(sqrtf(ss), 1e-12f); \
                _Pragma("unroll") for (int j = 0; j < 4; ++j) { const float kk = kv_[j] * inv; an[u][j] = -kk; bb[u][j] = kk * av[j]; k2[u][j] = kr[j] * (1.0f + (av[j] - 1.0f) * cka[j]); ww[u][j] = __expf(wn[j]); rr[u][j] = rv[j]; } } \
            LAS f32x4* V_ = (LAS f32x4*)(B_ + SC_VEC) + (hp * 9) * 16 + hc4; \
            float s0 = dot4(bb[0], rr[0]), s1 = dot4(k2[0], rr[0]), s2 = dot4(bb[0], an[1]), s3 = dot4(k2[0], an[1]); \
            s0 = sum16(s0); s1 = sum16(s1); s2 = sum16(s2); s3 = sum16(s3); \
            if (rg == 0) { float b0_ = 0.f, b1_ = 0.f; _Pragma("unroll") for (int j = 0; j < 4; ++j) { b0_ += rr[0][j] * k2[0][j] * crk[j]; b1_ += rr[1][j] * k2[1][j] * crk[j]; } b0_ = sum16(b0_); b1_ = sum16(b1_); \
                if (hc4 == 0) { float* bp_ = BD + (m0 + (size_t)(CC) * SC_C + 2 * hp) * 16 + h; bp_[0] = b0_; bp_[16] = b1_; } } \
            V_[0 * 16] = an[0]; V_[1 * 16] = ww[0] * an[1] + an[0] * s2; V_[2 * 16] = ww[0] * rr[0] + an[0] * s0; V_[3 * 16] = ww[0] * ww[1]; V_[4 * 16] = bb[0] * ww[1]; V_[5 * 16] = k2[0] * ww[1]; V_[6 * 16] = bb[1]; V_[7 * 16] = k2[1]; V_[8 * 16] = rr[1]; \
            if (hc4 == 0) { _Pragma("unroll") for (int row_ = 0; row_ < 8; ++row_) *(LAS f32x2s*)(B_ + SC_REC + (hp * 8 + row_) * 16 + 8) = (f32x2s){s3, s1}; } } \
        else if (wave == 6) { float v_[4] = {bflo(lv[Q].x), bfhi(lv[Q].x), bflo(lv[Q].y), bfhi(lv[Q].y)}; \
            if (L == 1) { const float f_[4] = {bflo(lvf[Q].x), bfhi(lvf[Q].x), bflo(lvf[Q].y), bfhi(lvf[Q].y)}, g_[4] = {bflo(lvm[Q].x), bfhi(lvm[Q].x), bflo(lvm[Q].y), bfhi(lvm[Q].y)}; \
                _Pragma("unroll") for (int j = 0; j < 4; ++j) v_[j] = v_[j] + (f_[j] - v_[j]) * g_[j]; } \
            _Pragma("unroll") for (int j = 0; j < 4; ++j) *(LAS float*)(B_ + SC_REC + ((vtt >> 1) * 8 + vr4 + j) * 16 + (vtt & 1) * 4) = v_[j]; } } while (0)
#define SC_YRED(bufi) f32x4 yv; do { const LAS f32x4* q_ = (const LAS f32x4*)(F.lds + (bufi) * SC_BUF + SC_Y) + (vtt * 8 + vr4) * 4; \
            _Pragma("unroll") for (int r_ = 0; r_ < 4; ++r_) { const f32x4 t0 = q_[r_ * 4], t1 = q_[r_ * 4 + 1], t2 = q_[r_ * 4 + 2], t3 = q_[r_ * 4 + 3]; const f32x4 t = (t0 + t1) + (t2 + t3); yv[r_] = (t.x + t.y) + (t.z + t.w); } } while (0)
        SC_LOAD(0, 0); SC_PREP(0, 0, 0); SC_LOAD(1, 1);
        __syncthreads();
        f32x4 S = {0.f, 0.f, 0.f, 0.f};
        const int rl = lane >> 4, kq = lane & 15, rowi = (wave & 1) * 4 + rl;
#define SC_ITER(c, QL, QP) do { const int buf = (c) & 1; \
            if (wave < 2) { if (PROBE_SC == 2) { f32x4 S2 = S; scan_chunk(F.lds + buf * SC_BUF, S2, kq, rowi); asm volatile("" :: "v"(S2) : "memory"); } scan_chunk(F.lds + buf * SC_BUF, S, kq, rowi); } \
            else { if ((c) + 2 < SC_NC) SC_LOAD((c) + 2, QL); \
                if ((c) + 1 < SC_NC) SC_PREP(buf ^ 1, QP, (c) + 1); \
                if (PROBE_SC == 1 && (c) + 1 < SC_NC) { asm volatile("" ::: "memory"); SC_PREP(buf ^ 1, QP, (c) + 1); } \
                if (wave == 7 && (c) > 0) { SC_YRED(buf ^ 1); *(f32x4*)(Y + (m0 + (size_t)((c) - 1) * SC_C + vtt) * D + h * 64 + rg * 8 + vr4) = yv; } } \
            asm volatile("s_waitcnt lgkmcnt(0)\n\ts_barrier" ::: "memory"); } while (0)
        for (int c = 0; c < SC_NC; c += 2) { SC_ITER(c, 0, 1); SC_ITER(c + 1, 1, 0); }
#undef SC_ITER
        if (wave == 7) { SC_YRED((SC_NC - 1) & 1);
            *(f32x4*)(Y + (m0 + (size_t)(SC_NC - 1) * SC_C + vtt) * D + h * 64 + rg * 8 + vr4) = yv; }
        __syncthreads();
#undef SC_LOAD
#undef SC_PREP
#undef SC_YRED
    }
}
__device__ __forceinline__ void post_phase(Frame& F, int L) {
    const bf16* P1 = (const bf16*)(F.ws + WS_P1); const bf16* P2 = (const bf16*)(F.ws + WS_P2); bf16* VF = (bf16*)(F.ws + WS_VF); float* Y = (float*)(F.ws + WS_H2);
    const int gw = F.vcu * NWAVES + F.wave, NGW = F.G * NWAVES, lane = F.lane, c0 = lane * 16;
    const float* lnw = F.in[24] + L * D + c0; const float* lnb = F.in[25] + L * D + c0;
    for (int m = gw; m < M; m += NGW) {
        float y[16], v[16];
        const float* yp = Y + (size_t)m * D + c0;
#pragma unroll
        for (int q = 0; q < 4; ++q) { const f32x4 t = *(const f32x4*)(yp + 4 * q); y[4 * q] = t.x; y[4 * q + 1] = t.y; y[4 * q + 2] = t.z; y[4 * q + 3] = t.w; }
        const bf16* p1 = P1 + (size_t)m * N1 + c0; const bf16* p2 = P2 + (size_t)m * NP2 + c0;
        const float bd = ((const float*)(F.ws + WS_FL))[(size_t)m * 16 + (lane >> 2)];
        v4u vv[2];
#pragma unroll
        for (int q = 0; q < 2; ++q) vv[q] = *(const v4u*)(p1 + 2048 + 8 * q);
#pragma unroll
        for (int q = 0; q < 2; ++q)
#pragma unroll
            for (int j = 0; j < 4; ++j) { v[8 * q + 2 * j] = bflo(vv[q][j]); v[8 * q + 2 * j + 1] = bfhi(vv[q][j]); }
        if (L == 0) { *(v4u*)(VF + (size_t)m * D + c0) = vv[0]; *(v4u*)(VF + (size_t)m * D + c0 + 8) = vv[1]; }
        else { v4u fv[2], gv[2];
#pragma unroll
            for (int q = 0; q < 2; ++q) { fv[q] = *(const v4u*)(VF + (size_t)m * D + c0 + 8 * q); gv[q] = *(const v4u*)(p2 + 2048 + 8 * q); }
#pragma unroll
            for (int q = 0; q < 2; ++q)
#pragma unroll
                for (int j = 0; j < 4; ++j) { const float f0 = bflo(fv[q][j]), f1 = bfhi(fv[q][j]), g0 = bflo(gv[q][j]), g1 = bfhi(gv[q][j]);
                    v[8 * q + 2 * j] += (f0 - v[8 * q + 2 * j]) * g0; v[8 * q + 2 * j + 1] += (f1 - v[8 * q + 2 * j + 1]) * g1; } }
        float s = 0.f;
#pragma unroll
        for (int j = 0; j < 16; ++j) s += y[j];
        s = sum4(s);
        const float mean = s * (1.0f / 64.0f); float q2 = 0.f;
#pragma unroll
        for (int j = 0; j < 16; ++j) { const float d = y[j] - mean; q2 += d * d; }
        q2 = sum4(q2);
        const float rstd = 1.0f / sqrtf(q2 * (1.0f / 64.0f) + 64e-5f);
        float o[16];
#pragma unroll
        for (int j = 0; j < 16; ++j) o[j] = (y[j] - mean) * rstd * lnw[j] + lnb[j] + bd * v[j];
        bf16* yn = (bf16*)(Y + (size_t)m * D) + c0;
        v4u w0, w1; w0.x = pkbf(o[0], o[1]); w0.y = pkbf(o[2], o[3]); w0.z = pkbf(o[4], o[5]); w0.w = pkbf(o[6], o[7]); w1.x = pkbf(o[8], o[9]); w1.y = pkbf(o[10], o[11]); w1.z = pkbf(o[12], o[13]); w1.w = pkbf(o[14], o[15]);
        *(v4u*)yn = w0; *(v4u*)(yn + 8) = w1;
    }
}
__device__ __forceinline__ void kvpost_phase(Frame& F) {
    const bf16* KV = (const bf16*)(F.ws + WS_KVRAW); bf16* KS = (bf16*)(F.ws + WS_KS);
    const int gw = F.vcu * NWAVES + F.wave, NGW = F.G * NWAVES, lane = F.lane, c0 = lane * 16;
    const float* kg = F.in[34] + (c0 & 63);
    for (int m = gw; m < M; m += NGW) {
        const bf16* p = KV + (size_t)m * 2048 + c0; v4u kv[2];
#pragma unroll
        for (int q = 0; q < 2; ++q) kv[q] = *(const v4u*)(p + 8 * q);
        float k[16], ss = 0.f;
#pragma unroll
        for (int q = 0; q < 2; ++q)
#pragma unroll
            for (int j = 0; j < 4; ++j) { k[8 * q + 2 * j] = bflo(kv[q][j]); k[8 * q + 2 * j + 1] = bfhi(kv[q][j]); }
#pragma unroll
        for (int j = 0; j < 16; ++j) ss += k[j] * k[j];
        ss = sum4(ss); const float rs = 1.0f / sqrtf(ss * (1.0f / 64.0f) + 1e-6f);
        v4u w0, w1;
        w0.x = pkbf(k[0] * rs * kg[0], k[1] * rs * kg[1]); w0.y = pkbf(k[2] * rs * kg[2], k[3] * rs * kg[3]); w0.z = pkbf(k[4] * rs * kg[4], k[5] * rs * kg[5]); w0.w = pkbf(k[6] * rs * kg[6], k[7] * rs * kg[7]);
        w1.x = pkbf(k[8] * rs * kg[8], k[9] * rs * kg[9]); w1.y = pkbf(k[10] * rs * kg[10], k[11] * rs * kg[11]); w1.z = pkbf(k[12] * rs * kg[12], k[13] * rs * kg[13]); w1.w = pkbf(k[14] * rs * kg[14], k[15] * rs * kg[15]);
        *(v4u*)(KS + (size_t)m * D + c0) = w0; *(v4u*)(KS + (size_t)m * D + c0 + 8) = w1;
    }
    if (gw < 32) {
        const int bh = gw, b = bh >> 4, h = bh & 15; const float* FL = (const float*)(F.ws + WS_FL) + ((size_t)b * T + (size_t)lane * 128) * 16 + h; const float fb = F.in[33][h];
        v4u* G3 = (v4u*)(F.ws + WS_G3) + (size_t)bh * T + (size_t)lane * 128;
        float tot = 0.f;
#pragma unroll 8
        for (int i = 0; i < 128; ++i) { const float x = FL[(size_t)i * 16] + fb; tot += -(fmaxf(-x, 0.f) + log1pf(__expf(-fabsf(x)))); }
        float inc = tot;
#pragma unroll
        for (int o = 1; o < 64; o <<= 1) { const float n = __int_as_float(__builtin_amdgcn_ds_bpermute((lane - o) << 2, __float_as_int(inc))); if (lane >= o) inc += n; }
        float run = inc - tot;
#pragma unroll 8
        for (int i = 0; i < 128; ++i) { const float x = FL[(size_t)i * 16] + fb; run += -(fmaxf(-x, 0.f) + log1pf(__expf(-fabsf(x))));
            const float gv = -run * 1.4426950408889634f;
            const unsigned hi = pkbf(gv, 0.f) & 0xffffu; const float r1 = gv - __uint_as_float(hi << 16);
            const unsigned mid = pkbf(r1, 0.f) & 0xffffu; const float r2 = r1 - __uint_as_float(mid << 16);
            const unsigned lo = pkbf(r2, 0.f) & 0xffffu;
            G3[i] = (v4u){hi | (mid << 16), lo, 0u, 0u}; }
    }
}
constexpr size_t WS_BAR = 512 * 1024, BAR_BYTES = 16384; constexpr int MISC_OFF = LDS_BYTES - 1024;
#define RLX_AGENT __ATOMIC_RELAXED, __HIP_MEMORY_SCOPE_AGENT
#define LDS_WAIT() asm volatile("s_waitcnt lgkmcnt(0)" ::: "memory")
#define VM_WAIT() asm volatile("s_waitcnt vmcnt(0)" ::: "memory")
__device__ __forceinline__ unsigned long long rt() { return __builtin_amdgcn_s_memrealtime(); }
__device__ __forceinline__ unsigned f2bf(float f) { unsigned u = __builtin_bit_cast(unsigned, f); return (u + 0x7fffu + ((u >> 16) & 1u)) >> 16; }
__device__ __forceinline__ unsigned pk2(float lo, float hi) { return f2bf(lo) | (f2bf(hi) << 16); }

#define XB_TMO      128
#define XB_XCNT(j)  (256  + 64 * (j))
#define XB_XSUB(j)  (1280 + 64 * (j))
#define XB_XGEN(j)  (2304 + 64 * (j))
#define XB_TOP      3328
#define XB_TOPGEN   3392
#define XCD_BAR_WORDS 3456
#define XB_SPIN_CAP (1u << 18)

__device__ __forceinline__ unsigned xb_ld(unsigned* p)              { return __hip_atomic_load(p, __ATOMIC_RELAXED, __HIP_MEMORY_SCOPE_AGENT); }
__device__ __forceinline__ unsigned xb_add(unsigned* p, unsigned v) { return __hip_atomic_fetch_add(p, v, __ATOMIC_RELAXED, __HIP_MEMORY_SCOPE_AGENT); }
__device__ __forceinline__ unsigned xb_xcc_id() { return (unsigned)__builtin_amdgcn_s_getreg((3 << 11) | 20) & 0xFu; }
#define XB_SPIN(cond, bar) do { unsigned _sp = 0; while (cond) { __builtin_amdgcn_s_sleep(1); \
    if ((++_sp & 255u) == 0u) { if (xb_ld(&(bar)[XB_TMO])) break; if (_sp > XB_SPIN_CAP) { atomicAdd(&(bar)[XB_TMO], 1u); break; } } } } while (0)

struct XcdBarrier {
    unsigned* bar; unsigned x;
    volatile LAS unsigned* st;
};

__device__ __forceinline__ XcdBarrier xcd_barrier_post(unsigned* bar, volatile LAS unsigned* st, const int tid) {
    XcdBarrier b; b.bar = bar; b.x = xb_xcc_id(); b.st = st;
    if (tid == 0) (void)xb_add(&bar[XB_XCNT(b.x)], 1u);
    return b;
}
__device__ __forceinline__ void xcd_barrier_complete(unsigned* bar, unsigned x, unsigned& nloc, unsigned& nx) {
    const unsigned G = gridDim.x * gridDim.y * gridDim.z;
    unsigned sum, cnt, mine, sp = 0u;
    for (;;) {
        sum = 0u; cnt = 0u; mine = 0u;
#pragma unroll
        for (unsigned j = 0; j < 16; ++j) { const unsigned c = xb_ld(&bar[XB_XCNT(j)]); sum += c; cnt += (c > 0u) ? 1u : 0u; mine = (j == x) ? c : mine; }
        if (sum == G) break;
        __builtin_amdgcn_s_sleep(1);
        if ((++sp & 255u) == 0u) { if (xb_ld(&bar[XB_TMO])) break; if (sp > XB_SPIN_CAP) { atomicAdd(&bar[XB_TMO], 1u); break; } }
    }
    nloc = mine > 0u ? mine : 1u; nx = cnt > 0u ? cnt : 1u;
}

__device__ __forceinline__ void xcd_barrier(const XcdBarrier& b, const int tid) {
    asm volatile("s_waitcnt vmcnt(0)" ::: "memory");
    __syncthreads();
    if (tid == 0) {
        unsigned* bar = b.bar;
        __builtin_amdgcn_s_waitcnt(0);
        unsigned nloc = b.st[0], nx = b.st[1];
        if (nloc == 0u) { xcd_barrier_complete(bar, b.x, nloc, nx); b.st[0] = nloc; b.st[1] = nx; }
        const unsigned old = xb_add(&bar[XB_XSUB(b.x)], 1u);
        const unsigned gen = old / nloc;
        if (old + 1u == (gen + 1u) * nloc) {
            __builtin_amdgcn_fence(__ATOMIC_RELEASE, "agent");
            asm volatile("s_waitcnt vmcnt(0)" ::: "memory");
            const unsigned og = xb_add(&bar[XB_TOP], 1u);
            const unsigned tg = og / nx;
            if (og + 1u == (tg + 1u) * nx) xb_add(&bar[XB_TOPGEN], 1u);
            else XB_SPIN(xb_ld(&bar[XB_TOPGEN]) == tg, bar);
            __builtin_amdgcn_fence(__ATOMIC_ACQUIRE, "agent");
            xb_add(&bar[XB_XGEN(b.x)], 1u);
            asm volatile("s_waitcnt vmcnt(0)" ::: "memory");
        } else {
            XB_SPIN(xb_ld(&bar[XB_XGEN(b.x)]) == gen, bar);
            __builtin_amdgcn_fence(__ATOMIC_ACQUIRE, "agent");
            asm volatile("s_waitcnt vmcnt(0)" ::: "memory");
        }
    }
    __syncthreads();
}
#define GEMM_CALL(FN, Aptr, Bptr, Nn, Kk, LDA, LDB, ...) GEMM_CALL_G(FN, Aptr, Bptr, Nn, Kk, LDA, LDB, 0, 0, __VA_ARGS__)
#define GEMM_CALL_G(FN, Aptr, Bptr, Nn, Kk, LDA, LDB, AGRP, ASTEP, ...) GEMM_CALL_S(StaticOrder, FN, Aptr, Bptr, Nn, Kk, LDA, LDB, AGRP, ASTEP, __VA_ARGS__)
#define GEMM_CALL_S(ORD, FN, Aptr, Bptr, Nn, Kk, LDA, LDB, AGRP, ASTEP, ...) do { pg8::Gemm g_{(const pg8::bf16_t*)(Aptr), (const pg8::bf16_t*)(Bptr), M, (Nn), (Kk), (LDA), (LDB), (AGRP), (size_t)(ASTEP)}; pg8::ORD S_; S_.init(M, (Nn), F.G, F.bx); \
    pg8::Epi8<pg8::FN> E_{{__VA_ARGS__}}; pg8::gemm_phase<pg8::Epi8<pg8::FN>, pg8::ORD, true, true>(F.lds, g_, S_, E_, F.tid); } while (0)
constexpr int N_PHASES = 42;
__global__ void __launch_bounds__(NWAVES * 64, 2) yoco_fwd(Args args) {
    extern __shared__ __attribute__((aligned(16))) unsigned char lds[];
    cg::grid_group grid = cg::this_grid();
    Frame F;
    const int wave_s = __builtin_amdgcn_readfirstlane((int)threadIdx.x >> 6);
    F.lds = (LAS unsigned char*)lds; F.tid = threadIdx.x; F.lane = F.tid & 63; F.wave = wave_s;
    F.G = gridDim.x; F.bx = blockIdx.x; F.vcu = F.bx;
    F.ws = args.ws; F.out = args.out; F.in = args.in;
    unsigned char* ws = args.ws;
    const int lo = args.ph_lo, hi = args.ph_hi; const bool one = (hi - lo) > 1;
#define LAUNDER() do { int t_ = wave_s * 64 + (int)__builtin_amdgcn_mbcnt_hi(~0u, __builtin_amdgcn_mbcnt_lo(~0u, 0u)); asm volatile("" : "+v"(t_)); F.tid = t_; F.lane = t_ & 63; F.wave = __builtin_amdgcn_readfirstlane(t_ >> 6); \
        int z_ = 0; asm volatile("" : "+v"(z_)); z_ = __builtin_amdgcn_readfirstlane(z_); ws = args.ws + z_; F.ws = ws; F.in = args.in + z_; F.out = args.out + z_; F.bx = (int)blockIdx.x + z_; F.G = (int)gridDim.x + z_; F.vcu = (F.G % 8 == 0) ? (F.bx % 8) * (F.G / 8) + F.bx / 8 : F.bx; } while (0)
#define IN(k) (lo <= (k) && (k) < hi)
#ifndef PROBE_BAR
#define PROBE_BAR 0
#endif
#ifndef PROBE_PH
#define PROBE_PH (-1)
#endif
#define PHASE(k) if (IN(k)) for (int rep_ = 0; rep_ < (((k) == PROBE_PH) ? 2 : 1); ++rep_)
#define SEAM() do { if (one) { unsigned zz_ = 0u; asm volatile("" : "+v"(zz_)); const int st_ = wave_s * 64 + (int)__builtin_amdgcn_mbcnt_hi(~0u, __builtin_amdgcn_mbcnt_lo(~0u, zz_)); xcd_barrier(xbar, st_); if (PROBE_BAR) xcd_barrier(xbar, st_); } } while (0)
#define MOD_ ((float*)(ws + WS_MOD))
#define MODKV_ (MOD_ + 4 * 2 * 6144)
#define H2_ ((bf16*)(ws + WS_H2))
#define XN_ ((bf16*)(ws + WS_H2))
#define XNKV_ ((bf16*)(ws + WS_H2 + 32 * MiB))
#define P1_ ((bf16*)(ws + WS_P1))
#define P2_ ((bf16*)(ws + WS_P2))
#define HB_ ((bf16*)(ws + WS_HB))
#define QB_ ((bf16*)(ws + WS_QB))
#define GT_ ((bf16*)(ws + WS_GT))
#define XIN1_ ((L == 0) ? F.in[0] : (const float*)F.out)
#define MODL_ (MOD_ + L * 2 * 6144)

    volatile LAS unsigned* MISC = (volatile LAS unsigned*)(F.lds + MISC_OFF);
    if (F.tid < 32) MISC[F.tid] = 0u;
    __syncthreads();
    XcdBarrier xbar; xbar.bar = (unsigned*)(args.ws + WS_BAR); xbar.x = 0; xbar.st = MISC + 8;
    if (one) xbar = xcd_barrier_post((unsigned*)(args.ws + WS_BAR), MISC + 8, F.tid);
    PHASE(0) { LAUNDER(); p0_mod(F); p0_weights(F); if (one) grid.sync(); }
    { constexpr int L = 0;
        const int pb = 1 + L * 10;
        if (L < 2) {
            PHASE(pb + 0) { LAUNDER(); norm_mix_phase(F, XIN1_, F.in[4] + L * D, MODL_, MODL_ + 1024, F.in[8] + L * 6 * 1024, H2_, P2_); SEAM(); }
            PHASE(pb + 1) { LAUNDER(); GEMM_CALL(FnP1, H2_, ws + WS_W1 + (size_t)L * N1 * K1 * 2 + (size_t)3072 * 1024 * 2, 512, K1, K1, K1, P1_, 3072);
                LAUNDER();
                if (F.G == 256) GEMM_CALL_S(SplitOrder, FnP1, P2_, ws + WS_W1 + (size_t)L * N1 * K1 * 2, 3072, D, D, D, 4, (size_t)M * D * 2, P1_, 0);
                else GEMM_CALL_G(FnP1, P2_, ws + WS_W1 + (size_t)L * N1 * K1 * 2, 3072, D, D, D, 4, (size_t)M * D * 2, P1_, 0);
                SEAM(); }
            PHASE(pb + 2) { LAUNDER(); GEMM_CALL(FnP2, P1_ + 3072, ws + WS_W2A + (size_t)L * 3072 * 256 * 2, (L == 0 ? 2048 : NP2), 256, N1, 256, P2_, MOD_ + 53248 + L * 3072); SEAM(); }
            PHASE(pb + 3) { LAUNDER(); scan_phase(F, L); SEAM(); }
            PHASE(pb + 4) { LAUNDER(); post_phase(F, L); SEAM(); }
            PHASE(pb + 5) { LAUNDER(); GEMM_CALL(FnGate, P1_ + 3232, ws + WS_W2G + (size_t)L * 1024 * 256 * 2, D, 256, N1, 256, H2_, 2048); SEAM(); }
            PHASE(pb + 6) { LAUNDER(); GEMM_CALL(FnRes, H2_, ws + WS_WO + (size_t)L * D * D * 2, D, D, 2048, D, XIN1_, F.out, MODL_ + 2 * 1024); SEAM(); }
        } else {
            const int j = L - 2;
            PHASE(pb + 0) { LAUNDER(); norm_phase(F, F.out, F.in[4] + L * D, MODL_, MODL_ + 1024, 6144, 1, XN_);
                if (L == 2) norm_phase(F, F.out, F.in[29], MODKV_, MODKV_ + 1024, 2048, 1, XNKV_);
                SEAM(); }
            PHASE(pb + 1) { LAUNDER();
                if (L == 2) GEMM_CALL(FnKv, XNKV_, ws + WS_WKV, 2304, D, D, D, (bf16*)(ws + WS_KVRAW), (float*)(ws + WS_FL), (bf16*)(ws + WS_VS));
                LAUNDER();
                GEMM_CALL(FnQg, XN_, ws + WS_WQG + (size_t)j * 2048 * D * 2, 2048, D, D, D, QB_, GT_); SEAM(); }
            if (L == 2) PHASE(pb + 2) { LAUNDER(); kvpost_phase(F); SEAM(); }
            PHASE(pb + 3) { LAUNDER();
                float kb_; { float g_ = fabsf(F.in[34][F.lane]); g_ = fmaxf(g_, dpp_f(g_, 0)); g_ = fmaxf(g_, dpp_f(g_, 1)); g_ = fmaxf(g_, dpp_f(g_, 2)); g_ = fmaxf(g_, dpp_f(g_, 3));
                  { auto rr = __builtin_amdgcn_permlane16_swap(__float_as_uint(g_), __float_as_uint(g_), false, false); g_ = fmaxf(__uint_as_float(rr[0]), __uint_as_float(rr[1])); }
                  { auto rr = __builtin_amdgcn_permlane32_swap(__float_as_uint(g_), __float_as_uint(g_), false, false); g_ = fmaxf(__uint_as_float(rr[0]), __uint_as_float(rr[1])); }
                  kb_ = 8.0f * 1.02f * g_; }
                const attn_body::AttnTensors AT{(const attn_body::bf16*)QB_, (const attn_body::bf16*)(ws + WS_KS), (const attn_body::bf16*)(ws + WS_VS), (attn_body::bf16*)((PROBE_PH == pb + 3 && rep_ == 0) ? (bf16*)(ws + WS_KVRAW) : QB_), (const attn_body::bf16*)GT_, (const unsigned char*)(ws + WS_G3), F.in[36] + j * 64, kb_};
                float thr2_; { float g_ = fabsf(F.in[36][j * 64 + F.lane]); g_ = fmaxf(g_, dpp_f(g_, 0)); g_ = fmaxf(g_, dpp_f(g_, 1)); g_ = fmaxf(g_, dpp_f(g_, 2)); g_ = fmaxf(g_, dpp_f(g_, 3));
                  { auto rr = __builtin_amdgcn_permlane16_swap(__float_as_uint(g_), __float_as_uint(g_), false, false); g_ = fmaxf(__uint_as_float(rr[0]), __uint_as_float(rr[1])); }
                  { auto rr = __builtin_amdgcn_permlane32_swap(__float_as_uint(g_), __float_as_uint(g_), false, false); g_ = fmaxf(__uint_as_float(rr[0]), __uint_as_float(rr[1])); }
                  thr2_ = 64.0f + 2.0f * kb_ * attn_body::C2 * 8.16f * g_; }
                attn_body::attn_phase_dyn<8>((char*)lds, AT, (unsigned*)(ws + WS_BAR) + 3600 + j * 64, thr2_, F.tid);
                SEAM(); }
            PHASE(pb + 6) { LAUNDER(); GEMM_CALL(FnRes, QB_, ws + WS_WO2 + (size_t)j * D * D * 2, D, D, D, D, (const float*)F.out, F.out, MODL_ + 2 * 1024); SEAM(); }
        }
        PHASE(pb + 7) { LAUNDER(); mlp_weights(F, L); norm_phase(F, F.out, F.in[5] + L * D, MODL_ + 3 * 1024, MODL_ + 4 * 1024, 6144, 1, XN_); SEAM(); }
        PHASE(pb + 8) { LAUNDER(); GEMM_CALL(FnUp, XN_, ws + WS_WUP, FF, D, D, D, HB_); SEAM(); }
        PHASE(pb + 9) { LAUNDER(); GEMM_CALL(FnRes, HB_, ws + WS_WDN, D, FF, FF, FF, (const float*)F.out, F.out, MODL_ + 5 * 1024); SEAM(); }
        }
    { constexpr int L = 1;
        const int pb = 1 + L * 10;
        if (L < 2) {
            PHASE(pb + 0) { LAUNDER(); norm_mix_phase(F, XIN1_, F.in[4] + L * D, MODL_, MODL_ + 1024, F.in[8] + L * 6 * 1024, H2_, P2_); SEAM(); }
            PHASE(pb + 1) { LAUNDER(); GEMM_CALL(FnP1, H2_, ws + WS_W1 + (size_t)L * N1 * K1 * 2 + (size_t)3072 * 1024 * 2, 512, K1, K1, K1, P1_, 3072);
                LAUNDER();
                if (F.G == 256) GEMM_CALL_S(SplitOrder, FnP1, P2_, ws + WS_W1 + (size_t)L * N1 * K1 * 2, 3072, D, D, D, 4, (size_t)M * D * 2, P1_, 0);
                else GEMM_CALL_G(FnP1, P2_, ws + WS_W1 + (size_t)L * N1 * K1 * 2, 3072, D, D, D, 4, (size_t)M * D * 2, P1_, 0);
                SEAM(); }
            PHASE(pb + 2) { LAUNDER(); GEMM_CALL(FnP2, P1_ + 3072, ws + WS_W2A + (size_t)L * 3072 * 256 * 2, (L == 0 ? 2048 : NP2), 256, N1, 256, P2_, MOD_ + 53248 + L * 3072); SEAM(); }
            PHASE(pb + 3) { LAUNDER(); scan_phase(F, L); SEAM(); }
            PHASE(pb + 4) { LAUNDER(); post_phase(F, L); SEAM(); }
            PHASE(pb + 5) { LAUNDER(); GEMM_CALL(FnGate, P1_ + 3232, ws + WS_W2G + (size_t)L * 1024 * 256 * 2, D, 256, N1, 256, H2_, 2048); SEAM(); }
            PHASE(pb + 6) { LAUNDER(); GEMM_CALL(FnRes, H2_, ws + WS_WO + (size_t)L * D * D * 2, D, D, 2048, D, XIN1_, F.out, MODL_ + 2 * 1024); SEAM(); }
        } else {
            const int j = L - 2;
            PHASE(pb + 0) { LAUNDER(); norm_phase(F, F.out, F.in[4] + L * D, MODL_, MODL_ + 1024, 6144, 1, XN_);
                if (L == 2) norm_phase(F, F.out, F.in[29], MODKV_, MODKV_ + 1024, 2048, 1, XNKV_);
                SEAM(); }
            PHASE(pb + 1) { LAUNDER();
                if (L == 2) GEMM_CALL(FnKv, XNKV_, ws + WS_WKV, 2304, D, D, D, (bf16*)(ws + WS_KVRAW), (float*)(ws + WS_FL), (bf16*)(ws + WS_VS));
                LAUNDER();
                GEMM_CALL(FnQg, XN_, ws + WS_WQG + (size_t)j * 2048 * D * 2, 2048, D, D, D, QB_, GT_); SEAM(); }
            if (L == 2) PHASE(pb + 2) { LAUNDER(); kvpost_phase(F); SEAM(); }
            PHASE(pb + 3) { LAUNDER();
                float kb_; { float g_ = fabsf(F.in[34][F.lane]); g_ = fmaxf(g_, dpp_f(g_, 0)); g_ = fmaxf(g_, dpp_f(g_, 1)); g_ = fmaxf(g_, dpp_f(g_, 2)); g_ = fmaxf(g_, dpp_f(g_, 3));
                  { auto rr = __builtin_amdgcn_permlane16_swap(__float_as_uint(g_), __float_as_uint(g_), false, false); g_ = fmaxf(__uint_as_float(rr[0]), __uint_as_float(rr[1])); }
                  { auto rr = __builtin_amdgcn_permlane32_swap(__float_as_uint(g_), __float_as_uint(g_), false, false); g_ = fmaxf(__uint_as_float(rr[0]), __uint_as_float(rr[1])); }
                  kb_ = 8.0f * 1.02f * g_; }
                const attn_body::AttnTensors AT{(const attn_body::bf16*)QB_, (const attn_body::bf16*)(ws + WS_KS), (const attn_body::bf16*)(ws + WS_VS), (attn_body::bf16*)((PROBE_PH == pb + 3 && rep_ == 0) ? (bf16*)(ws + WS_KVRAW) : QB_), (const attn_body::bf16*)GT_, (const unsigned char*)(ws + WS_G3), F.in[36] + j * 64, kb_};
                float thr2_; { float g_ = fabsf(F.in[36][j * 64 + F.lane]); g_ = fmaxf(g_, dpp_f(g_, 0)); g_ = fmaxf(g_, dpp_f(g_, 1)); g_ = fmaxf(g_, dpp_f(g_, 2)); g_ = fmaxf(g_, dpp_f(g_, 3));
                  { auto rr = __builtin_amdgcn_permlane16_swap(__float_as_uint(g_), __float_as_uint(g_), false, false); g_ = fmaxf(__uint_as_float(rr[0]), __uint_as_float(rr[1])); }
                  { auto rr = __builtin_amdgcn_permlane32_swap(__float_as_uint(g_), __float_as_uint(g_), false, false); g_ = fmaxf(__uint_as_float(rr[0]), __uint_as_float(rr[1])); }
                  thr2_ = 64.0f + 2.0f * kb_ * attn_body::C2 * 8.16f * g_; }
                attn_body::attn_phase_dyn<8>((char*)lds, AT, (unsigned*)(ws + WS_BAR) + 3600 + j * 64, thr2_, F.tid);
                SEAM(); }
            PHASE(pb + 6) { LAUNDER(); GEMM_CALL(FnRes, QB_, ws + WS_WO2 + (size_t)j * D * D * 2, D, D, D, D, (const float*)F.out, F.out, MODL_ + 2 * 1024); SEAM(); }
        }
        PHASE(pb + 7) { LAUNDER(); mlp_weights(F, L); norm_phase(F, F.out, F.in[5] + L * D, MODL_ + 3 * 1024, MODL_ + 4 * 1024, 6144, 1, XN_); SEAM(); }
        PHASE(pb + 8) { LAUNDER(); GEMM_CALL(FnUp, XN_, ws + WS_WUP, FF, D, D, D, HB_); SEAM(); }
        PHASE(pb + 9) { LAUNDER(); GEMM_CALL(FnRes, HB_, ws + WS_WDN, D, FF, FF, FF, (const float*)F.out, F.out, MODL_ + 5 * 1024); SEAM(); }
        }
    { constexpr int L = 2;
        const int pb = 1 + L * 10;
        if (L < 2) {
            PHASE(pb + 0) { LAUNDER(); norm_mix_phase(F, XIN1_, F.in[4] + L * D, MODL_, MODL_ + 1024, F.in[8] + L * 6 * 1024, H2_, P2_); SEAM(); }
            PHASE(pb + 1) { LAUNDER(); GEMM_CALL(FnP1, H2_, ws + WS_W1 + (size_t)L * N1 * K1 * 2 + (size_t)3072 * 1024 * 2, 512, K1, K1, K1, P1_, 3072);
                LAUNDER();
                if (F.G == 256) GEMM_CALL_S(SplitOrder, FnP1, P2_, ws + WS_W1 + (size_t)L * N1 * K1 * 2, 3072, D, D, D, 4, (size_t)M * D * 2, P1_, 0);
                else GEMM_CALL_G(FnP1, P2_, ws + WS_W1 + (size_t)L * N1 * K1 * 2, 3072, D, D, D, 4, (size_t)M * D * 2, P1_, 0);
                SEAM(); }
            PHASE(pb + 2) { LAUNDER(); GEMM_CALL(FnP2, P1_ + 3072, ws + WS_W2A + (size_t)L * 3072 * 256 * 2, (L == 0 ? 2048 : NP2), 256, N1, 256, P2_, MOD_ + 53248 + L * 3072); SEAM(); }
            PHASE(pb + 3) { LAUNDER(); scan_phase(F, L); SEAM(); }
            PHASE(pb + 4) { LAUNDER(); post_phase(F, L); SEAM(); }
            PHASE(pb + 5) { LAUNDER(); GEMM_CALL(FnGate, P1_ + 3232, ws + WS_W2G + (size_t)L * 1024 * 256 * 2, D, 256, N1, 256, H2_, 2048); SEAM(); }
            PHASE(pb + 6) { LAUNDER(); GEMM_CALL(FnRes, H2_, ws + WS_WO + (size_t)L * D * D * 2, D, D, 2048, D, XIN1_, F.out, MODL_ + 2 * 1024); SEAM(); }
        } else {
            const int j = L - 2;
            PHASE(pb + 0) { LAUNDER(); norm_phase(F, F.out, F.in[4] + L * D, MODL_, MODL_ + 1024, 6144, 1, XN_);
                if (L == 2) norm_phase(F, F.out, F.in[29], MODKV_, MODKV_ + 1024, 2048, 1, XNKV_);
                SEAM(); }
            PHASE(pb + 1) { LAUNDER();
                if (L == 2) GEMM_CALL(FnKv, XNKV_, ws + WS_WKV, 2304, D, D, D, (bf16*)(ws + WS_KVRAW), (float*)(ws + WS_FL), (bf16*)(ws + WS_VS));
                LAUNDER();
                GEMM_CALL(FnQg, XN_, ws + WS_WQG + (size_t)j * 2048 * D * 2, 2048, D, D, D, QB_, GT_); SEAM(); }
            if (L == 2) PHASE(pb + 2) { LAUNDER(); kvpost_phase(F); SEAM(); }
            PHASE(pb + 3) { LAUNDER();
                float kb_; { float g_ = fabsf(F.in[34][F.lane]); g_ = fmaxf(g_, dpp_f(g_, 0)); g_ = fmaxf(g_, dpp_f(g_, 1)); g_ = fmaxf(g_, dpp_f(g_, 2)); g_ = fmaxf(g_, dpp_f(g_, 3));
                  { auto rr = __builtin_amdgcn_permlane16_swap(__float_as_uint(g_), __float_as_uint(g_), false, false); g_ = fmaxf(__uint_as_float(rr[0]), __uint_as_float(rr[1])); }
                  { auto rr = __builtin_amdgcn_permlane32_swap(__float_as_uint(g_), __float_as_uint(g_), false, false); g_ = fmaxf(__uint_as_float(rr[0]), __uint_as_float(rr[1])); }
                  kb_ = 8.0f * 1.02f * g_; }
                const attn_body::AttnTensors AT{(const attn_body::bf16*)QB_, (const attn_body::bf16*)(ws + WS_KS), (const attn_body::bf16*)(ws + WS_VS), (attn_body::bf16*)((PROBE_PH == pb + 3 && rep_ == 0) ? (bf16*)(ws + WS_KVRAW) : QB_), (const attn_body::bf16*)GT_, (const unsigned char*)(ws + WS_G3), F.in[36] + j * 64, kb_};
                float thr2_; { float g_ = fabsf(F.in[36][j * 64 + F.lane]); g_ = fmaxf(g_, dpp_f(g_, 0)); g_ = fmaxf(g_, dpp_f(g_, 1)); g_ = fmaxf(g_, dpp_f(g_, 2)); g_ = fmaxf(g_, dpp_f(g_, 3));
                  { auto rr = __builtin_amdgcn_permlane16_swap(__float_as_uint(g_), __float_as_uint(g_), false, false); g_ = fmaxf(__uint_as_float(rr[0]), __uint_as_float(rr[1])); }
                  { auto rr = __builtin_amdgcn_permlane32_swap(__float_as_uint(g_), __float_as_uint(g_), false, false); g_ = fmaxf(__uint_as_float(rr[0]), __uint_as_float(rr[1])); }
                  thr2_ = 64.0f + 2.0f * kb_ * attn_body::C2 * 8.16f * g_; }
                attn_body::attn_phase_dyn<8>((char*)lds, AT, (unsigned*)(ws + WS_BAR) + 3600 + j * 64, thr2_, F.tid);
                SEAM(); }
            PHASE(pb + 6) { LAUNDER(); GEMM_CALL(FnRes, QB_, ws + WS_WO2 + (size_t)j * D * D * 2, D, D, D, D, (const float*)F.out, F.out, MODL_ + 2 * 1024); SEAM(); }
        }
        PHASE(pb + 7) { LAUNDER(); mlp_weights(F, L); norm_phase(F, F.out, F.in[5] + L * D, MODL_ + 3 * 1024, MODL_ + 4 * 1024, 6144, 1, XN_); SEAM(); }
        PHASE(pb + 8) { LAUNDER(); GEMM_CALL(FnUp, XN_, ws + WS_WUP, FF, D, D, D, HB_); SEAM(); }
        PHASE(pb + 9) { LAUNDER(); GEMM_CALL(FnRes, HB_, ws + WS_WDN, D, FF, FF, FF, (const float*)F.out, F.out, MODL_ + 5 * 1024); SEAM(); }
        }
    { constexpr int L = 3;
        const int pb = 1 + L * 10;
        if (L < 2) {
            PHASE(pb + 0) { LAUNDER(); norm_mix_phase(F, XIN1_, F.in[4] + L * D, MODL_, MODL_ + 1024, F.in[8] + L * 6 * 1024, H2_, P2_); SEAM(); }
            PHASE(pb + 1) { LAUNDER(); GEMM_CALL(FnP1, H2_, ws + WS_W1 + (size_t)L * N1 * K1 * 2 + (size_t)3072 * 1024 * 2, 512, K1, K1, K1, P1_, 3072);
                LAUNDER();
                if (F.G == 256) GEMM_CALL_S(SplitOrder, FnP1, P2_, ws + WS_W1 + (size_t)L * N1 * K1 * 2, 3072, D, D, D, 4, (size_t)M * D * 2, P1_, 0);
                else GEMM_CALL_G(FnP1, P2_, ws + WS_W1 + (size_t)L * N1 * K1 * 2, 3072, D, D, D, 4, (size_t)M * D * 2, P1_, 0);
                SEAM(); }
            PHASE(pb + 2) { LAUNDER(); GEMM_CALL(FnP2, P1_ + 3072, ws + WS_W2A + (size_t)L * 3072 * 256 * 2, (L == 0 ? 2048 : NP2), 256, N1, 256, P2_, MOD_ + 53248 + L * 3072); SEAM(); }
            PHASE(pb + 3) { LAUNDER(); scan_phase(F, L); SEAM(); }
            PHASE(pb + 4) { LAUNDER(); post_phase(F, L); SEAM(); }
            PHASE(pb + 5) { LAUNDER(); GEMM_CALL(FnGate, P1_ + 3232, ws + WS_W2G + (size_t)L * 1024 * 256 * 2, D, 256, N1, 256, H2_, 2048); SEAM(); }
            PHASE(pb + 6) { LAUNDER(); GEMM_CALL(FnRes, H2_, ws + WS_WO + (size_t)L * D * D * 2, D, D, 2048, D, XIN1_, F.out, MODL_ + 2 * 1024); SEAM(); }
        } else {
            const int j = L - 2;
            PHASE(pb + 0) { LAUNDER(); norm_phase(F, F.out, F.in[4] + L * D, MODL_, MODL_ + 1024, 6144, 1, XN_);
                if (L == 2) norm_phase(F, F.out, F.in[29], MODKV_, MODKV_ + 1024, 2048, 1, XNKV_);
                SEAM(); }
            PHASE(pb + 1) { LAUNDER();
                if (L == 2) GEMM_CALL(FnKv, XNKV_, ws + WS_WKV, 2304, D, D, D, (bf16*)(ws + WS_KVRAW), (float*)(ws + WS_FL), (bf16*)(ws + WS_VS));
                LAUNDER();
                GEMM_CALL(FnQg, XN_, ws + WS_WQG + (size_t)j * 2048 * D * 2, 2048, D, D, D, QB_, GT_); SEAM(); }
            if (L == 2) PHASE(pb + 2) { LAUNDER(); kvpost_phase(F); SEAM(); }
            PHASE(pb + 3) { LAUNDER();
                float kb_; { float g_ = fabsf(F.in[34][F.lane]); g_ = fmaxf(g_, dpp_f(g_, 0)); g_ = fmaxf(g_, dpp_f(g_, 1)); g_ = fmaxf(g_, dpp_f(g_, 2)); g_ = fmaxf(g_, dpp_f(g_, 3));
                  { auto rr = __builtin_amdgcn_permlane16_swap(__float_as_uint(g_), __float_as_uint(g_), false, false); g_ = fmaxf(__uint_as_float(rr[0]), __uint_as_float(rr[1])); }
                  { auto rr = __builtin_amdgcn_permlane32_swap(__float_as_uint(g_), __float_as_uint(g_), false, false); g_ = fmaxf(__uint_as_float(rr[0]), __uint_as_float(rr[1])); }
                  kb_ = 8.0f * 1.02f * g_; }
                const attn_body::AttnTensors AT{(const attn_body::bf16*)QB_, (const attn_body::bf16*)(ws + WS_KS), (const attn_body::bf16*)(ws + WS_VS), (attn_body::bf16*)((PROBE_PH == pb + 3 && rep_ == 0) ? (bf16*)(ws + WS_KVRAW) : QB_), (const attn_body::bf16*)GT_, (const unsigned char*)(ws + WS_G3), F.in[36] + j * 64, kb_};
                float thr2_; { float g_ = fabsf(F.in[36][j * 64 + F.lane]); g_ = fmaxf(g_, dpp_f(g_, 0)); g_ = fmaxf(g_, dpp_f(g_, 1)); g_ = fmaxf(g_, dpp_f(g_, 2)); g_ = fmaxf(g_, dpp_f(g_, 3));
                  { auto rr = __builtin_amdgcn_permlane16_swap(__float_as_uint(g_), __float_as_uint(g_), false, false); g_ = fmaxf(__uint_as_float(rr[0]), __uint_as_float(rr[1])); }
                  { auto rr = __builtin_amdgcn_permlane32_swap(__float_as_uint(g_), __float_as_uint(g_), false, false); g_ = fmaxf(__uint_as_float(rr[0]), __uint_as_float(rr[1])); }
                  thr2_ = 64.0f + 2.0f * kb_ * attn_body::C2 * 8.16f * g_; }
                attn_body::attn_phase_dyn<8>((char*)lds, AT, (unsigned*)(ws + WS_BAR) + 3600 + j * 64, thr2_, F.tid);
                SEAM(); }
            PHASE(pb + 6) { LAUNDER(); GEMM_CALL(FnRes, QB_, ws + WS_WO2 + (size_t)j * D * D * 2, D, D, D, D, (const float*)F.out, F.out, MODL_ + 2 * 1024); SEAM(); }
        }
        PHASE(pb + 7) { LAUNDER(); mlp_weights(F, L); norm_phase(F, F.out, F.in[5] + L * D, MODL_ + 3 * 1024, MODL_ + 4 * 1024, 6144, 1, XN_); SEAM(); }
        PHASE(pb + 8) { LAUNDER(); GEMM_CALL(FnUp, XN_, ws + WS_WUP, FF, D, D, D, HB_); SEAM(); }
        PHASE(pb + 9) { LAUNDER(); GEMM_CALL(FnRes, HB_, ws + WS_WDN, D, FF, FF, FF, (const float*)F.out, F.out, MODL_ + 5 * 1024); SEAM(); }
        }
    PHASE(41) { LAUNDER(); final_norm_phase(F); }
#undef IN
#undef SEAM
}
static bool phase_exists(int ph) {
    if (ph == 0 || ph == 41) return true;
    const int L = (ph - 1) / 10, s = (ph - 1) % 10;
    if (L < 2) return true;
    if (s == 4 || s == 5) return false;
    if (s == 2) return L == 2;
    return true;
}
extern "C" void kernel_launch(void* const* d_in, const int* in_sizes, int n_in, void* d_out, int out_size, void* d_ws, size_t ws_size, hipStream_t stream) {
    static int grid = 0;
    if (grid == 0) {
        if (n_in != 39 || in_sizes[0] != M * D || out_size != M * D || ws_size < WS_END) { fprintf(stderr, "kernel_launch: shape/workspace mismatch: n_in %d in0 %d out %d ws %zu (need %zu)\n", n_in, n_in > 0 ? in_sizes[0] : -1, out_size, ws_size, (size_t)WS_END); grid = -1; return; }
        int dev = 0, cus = 0, per_cu = 0;
        if (hipGetDevice(&dev) != hipSuccess || hipDeviceGetAttribute(&cus, hipDeviceAttributeMultiprocessorCount, dev) != hipSuccess) { fprintf(stderr, "kernel_launch: device query failed\n"); grid = -1; return; }
        if (hipFuncSetAttribute((const void*)yoco_fwd, hipFuncAttributeMaxDynamicSharedMemorySize, LDS_BYTES) != hipSuccess) { fprintf(stderr, "kernel_launch: hipFuncSetAttribute failed\n"); grid = -1; return; }
        if (hipOccupancyMaxActiveBlocksPerMultiprocessor(&per_cu, (const void*)yoco_fwd, NWAVES * 64, LDS_BYTES) != hipSuccess || per_cu < 1) { fprintf(stderr, "kernel_launch: occupancy query says %d blocks/CU\n", per_cu); per_cu = 1; }
        (void)hipGetLastError();
        grid = cus * per_cu;
        if (grid != 256) { fprintf(stderr, "kernel_launch: resident capacity %d workgroups; this kernel's static schedules want 256 (using 256)\n", grid); if (grid > 256) grid = 256; }
    }
    if (grid < 0) return;
    if (hipMemsetAsync((char*)d_ws + WS_BAR, 0, BAR_BYTES, stream) != hipSuccess) { fprintf(stderr, "kernel_launch: memset of barrier words failed\n"); return; }
    Args a{};
    for (int i = 0; i < 39; ++i) a.in[i] = (const float*)d_in[i];
    a.out = (float*)d_out; a.ws = (unsigned char*)d_ws;
#if MK_ONE_LAUNCH
    a.ph_lo = 0; a.ph_hi = N_PHASES;
    void* params[] = {&a};
    const hipError_t le = hipLaunchCooperativeKernel((const void*)yoco_fwd, dim3(grid), dim3(NWAVES * 64), params, LDS_BYTES, stream);
    if (le != hipSuccess) fprintf(stderr, "kernel_launch: cooperative launch failed: %s (grid %d)\n", hipGetErrorName(le), grid);
#else
    for (int ph = 0; ph < N_PHASES; ++ph) { if (!phase_exists(ph)) continue; a.ph_lo = ph; a.ph_hi = ph + 1;
        hipLaunchKernelGGL(yoco_fwd, dim3(grid), dim3(NWAVES * 64), LDS_BYTES, stream, a);
        const hipError_t le = hipPeekAtLastError(); if (le != hipSuccess) { fprintf(stderr, "kernel_launch: launch of phase %d failed: %s\n", ph, hipGetErrorName(le)); break; } }
#endif
}
```

```cpp
#include <hip/hip_runtime.h>
#include <hip/hip_cooperative_groups.h>
#include <hip/hip_bf16.h>
#include <cstdio>
#include <cstdint>
#include <cmath>
namespace cg = cooperative_groups;
#ifndef MK_ONE_LAUNCH
#define MK_ONE_LAUNCH 1
#endif
namespace pg8 {
#define PG8_LAS __attribute__((address_space(3)))
typedef unsigned short bf16_t;
typedef short bf16x8 __attribute__((ext_vector_type(8)));
typedef float f32x4 __attribute__((ext_vector_type(4)));
typedef unsigned u32x4 __attribute__((ext_vector_type(4)));
constexpr int BM = 256, BK = 64, HALF = 128, HTB = HALF * BK * 2  , STAGE_BYTES = 8 * HTB, NXCD = 8, WGM = 8;

__host__ __device__ __forceinline__ int lds_byte(int r, int c) { const int st = (r >> 4) * 2 + (c >> 5), rr = r & 15, cc = c & 31, ob = rr * 64 + cc * 2; return st * 1024 + (ob ^ (((ob >> 9) & 1) << 5)); }
__host__ __device__ __forceinline__ void stage_rc(int b, int& R, int& C) { const int st = b / 1024, sb = b % 1024, swz = sb ^ (((sb >> 9) & 1) << 5); R = (st >> 1) * 16 + swz / 64; C = (st & 1) * 32 + (swz % 64) / 2; }
__host__ __device__ __forceinline__ int perm32(int rho) { const int n = rho >> 4, i = rho & 15; return 8 * (i >> 2) + 4 * n + (i & 3); }

struct Unit { int pm, pn; };
struct Gemm { const bf16_t* A; const bf16_t* Bt; int M, N, K, lda, ldb; int agrp; size_t astep; };

struct SplitOrder {
    int c, nN;
    __host__ __device__ void init(int M, int N, int G_, int c_) { c = c_; nN = N / BM; (void)M; (void)G_; }
    __host__ __device__ bool next(int i, Unit& u) const { int idx; if (c < 128) { if (i >= 2) return false; idx = 2 * c + i; } else { if (i >= 4) return false; idx = 256 + 4 * (c - 128) + i; } u.pm = idx / nN; u.pn = idx % nN; return true; }
    __device__ __forceinline__ void a_ready(const Unit&) const {}
    __device__ __forceinline__ void done(const Unit&) const {}
};
struct StaticOrder {
    int nM, nN, nwg, G, c;
    __host__ __device__ void init(int M, int N, int G_, int c_) { nM = M / BM; nN = N / BM; nwg = nM * nN; G = G_; c = c_; }
    __host__ __device__ bool next(int i, Unit& u) const {
        const long L = (long)i * G + c; if (L >= nwg) return false;
        int wgid = (int)L; { const int q = nwg / NXCD, r = nwg % NXCD, xcd = wgid % NXCD, off = wgid / NXCD; wgid = (xcd < r ? xcd * (q + 1) : r * (q + 1) + (xcd - r) * q) + off; }
        const int nig = WGM * nN, gid = wgid / nig, fm = gid * WGM, gsz = (nM - fm) < WGM ? (nM - fm) : WGM;
        u.pm = fm + ((wgid % nig) % gsz); u.pn = (wgid % nig) / gsz; return true;
    }
    __device__ __forceinline__ void a_ready(const Unit&) const {}
    __device__ __forceinline__ void done(const Unit&) const {}
};

typedef float f32x2 __attribute__((ext_vector_type(2)));
typedef __bf16 bf16x2_t __attribute__((ext_vector_type(2)));
__device__ __forceinline__ unsigned pkbf(float lo, float hi) { f32x2 v = {lo, hi}; bf16x2_t b = __builtin_convertvector(v, bf16x2_t); return __builtin_bit_cast(unsigned, b); }
__device__ __forceinline__ float bflo(unsigned w) { return __uint_as_float(w << 16); }
__device__ __forceinline__ float bfhi(unsigned w) { return __uint_as_float(w & 0xffff0000u); }
__device__ __forceinline__ float sigm(float x) { return __builtin_amdgcn_rcpf(1.0f + __builtin_amdgcn_exp2f(-1.4426950408889634f * x)); }
template <class Fn> struct Epi8 {
    static constexpr bool PERM = true, AFTER_DRAIN = false; Fn f;
    __device__ __forceinline__ void operator()(const f32x4 (&acc)[2][2][4][2], const Unit& u, int wr, int wc, int fr, int fq) const {
        const int row0 = u.pm * BM + wr * 64 + fr, col0 = u.pn * BM + wc * 32 + 8 * fq;
#pragma unroll
        for (int ai = 0; ai < 2; ++ai)
#pragma unroll
            for (int m = 0; m < 4; ++m)
#pragma unroll
                for (int bj = 0; bj < 2; ++bj) { f(row0 + ai * HALF + m * 16, col0 + bj * HALF, acc[ai][bj][m][0], acc[ai][bj][m][1]); }
    }
};
__device__ __forceinline__ void st8bf(bf16_t* p, f32x4 v0, f32x4 v1) { u32x4 w; w.x = pkbf(v0[0], v0[1]); w.y = pkbf(v0[2], v0[3]); w.z = pkbf(v1[0], v1[1]); w.w = pkbf(v1[2], v1[3]); *(u32x4*)p = w; }
struct FnP1 { bf16_t* O; int coff;
    __device__ __forceinline__ void operator()(int row, int col, f32x4 v0, f32x4 v1) const {
        col += coff;
        if (col >= 3072) {
            if (col < 3136) {
#pragma unroll
                for (int j = 0; j < 4; ++j) { v0[j] = 1.0f - 2.0f * __builtin_amdgcn_rcpf(__builtin_amdgcn_exp2f(2.8853900817779268f * v0[j]) + 1.0f); v1[j] = 1.0f - 2.0f * __builtin_amdgcn_rcpf(__builtin_amdgcn_exp2f(2.8853900817779268f * v1[j]) + 1.0f); } }
            else if (col >= 3232 && col < 3392) {
#pragma unroll
                for (int j = 0; j < 4; ++j) { v0[j] = sigm(v0[j]); v1[j] = sigm(v1[j]); } }
        }
        st8bf(O + (size_t)row * 3584 + col, v0, v1); } };
struct FnP2 { bf16_t* O; const float* bias;
    __device__ __forceinline__ void operator()(int row, int col, f32x4 v0, f32x4 v1) const {
        const f32x4 b0 = *(const f32x4*)(bias + col), b1 = *(const f32x4*)(bias + col + 4);
        const float sc = col < 1024 ? -0.60653065971f : 1.0f;
#pragma unroll
        for (int j = 0; j < 4; ++j) { v0[j] = sc * sigm(v0[j] + b0[j]); v1[j] = sc * sigm(v1[j] + b1[j]); }
        st8bf(O + (size_t)row * 3072 + col, v0, v1); } };
struct FnGate { bf16_t* Y; int ld;
    __device__ __forceinline__ void operator()(int row, int col, f32x4 v0, f32x4 v1) const {
        bf16_t* p = Y + (size_t)row * ld + col; const u32x4 y = *(const u32x4*)p;
        v0[0] *= bflo(y.x); v0[1] *= bfhi(y.x); v0[2] *= bflo(y.y); v0[3] *= bfhi(y.y); v1[0] *= bflo(y.z); v1[1] *= bfhi(y.z); v1[2] *= bflo(y.w); v1[3] *= bfhi(y.w);
        st8bf(p, v0, v1); } };
struct FnRes { const float* xin; float* xout; const float* gate;
    __device__ __forceinline__ void operator()(int row, int col, f32x4 v0, f32x4 v1) const {
        const float* gp = gate + (row >> 13) * 6144 + col; const f32x4 g0 = *(const f32x4*)gp, g1 = *(const f32x4*)(gp + 4);
        const size_t off = (size_t)row * 1024 + col; const f32x4 x0 = *(const f32x4*)(xin + off), x1 = *(const f32x4*)(xin + off + 4);
        *(f32x4*)(xout + off) = x0 + (g0 + 1.0f) * v0; *(f32x4*)(xout + off + 4) = x1 + (g1 + 1.0f) * v1; } };
struct FnUp { bf16_t* O;
    __device__ __forceinline__ void operator()(int row, int col, f32x4 v0, f32x4 v1) const {
#pragma unroll
        for (int j = 0; j < 4; ++j) { const float a = fmaxf(v0[j], 0.f), b = fmaxf(v1[j], 0.f); v0[j] = a * a; v1[j] = b * b; }
        st8bf(O + (size_t)row * 4096 + col, v0, v1); } };
struct FnKv { bf16_t* O; float* FL; bf16_t* VS;
    __device__ __forceinline__ void operator()(int row, int col, f32x4 v0, f32x4 v1) const {
        if (col < 1024) st8bf(O + (size_t)row * 2048 + col, v0, v1);
        else if (col < 2048) st8bf(VS + (size_t)row * 1024 + (col - 1024), v0, v1);
        else if (col < 2064) { float* p = FL + (size_t)row * 16 + (col - 2048); *(f32x4*)p = v0; *(f32x4*)(p + 4) = v1; } } };
struct FnQg { bf16_t* Q; bf16_t* G;
    __device__ __forceinline__ void operator()(int row, int col, f32x4 v0, f32x4 v1) const {
        if (col < 1024) st8bf(Q + (size_t)row * 1024 + col, v0, v1);
        else {
#pragma unroll
            for (int j = 0; j < 4; ++j) { v0[j] = sigm(v0[j]); v1[j] = sigm(v1[j]); }
            st8bf(G + (size_t)row * 1024 + (col - 1024), v0, v1); } } };
template <class Epi, class Sched, bool ALIGN_EPI = false, bool SP2 = false>
__device__ __forceinline__ void gemm_phase(PG8_LAS unsigned char* lds, const Gemm g, const Sched& S, const Epi& E, const int tid_in) {
    int tid_l = tid_in; asm volatile("" : "+v"(tid_l));
    const int tid = tid_l, wid = __builtin_amdgcn_readfirstlane(tid >> 6), lane = tid & 63, wr = wid >> 2, wc = wid & 3, fr = lane & 15, fq = lane >> 4;
    const int K = g.K, nt = K / BK;
    unsigned voffA[2], voffB[2];
#pragma unroll
    for (int i = 0; i < 2; ++i) { int R, C; stage_rc(tid * 16 + i * 8192, R, C); const int Rb = Epi::PERM ? ((R & ~31) + perm32(R & 31)) : R;
        voffA[i] = (unsigned)(R * g.lda + C) * 2u; voffB[i] = (unsigned)(Rb * g.ldb + C) * 2u; }
    const size_t kstep = (size_t)(BK * 2);
    const size_t hstepA = (size_t)HALF * g.lda * 2, hstepB = (size_t)HALF * g.ldb * 2;
    const size_t tstepA = 2 * hstepA, tstepB = 2 * hstepB;
    const unsigned ldsw = (unsigned)wid * 1024u;
    const int aoff = lds_byte(wr * 64 + fr, fq * 8), boff = lds_byte(wc * 32 + fr, fq * 8);
#define PG8_SA(b, h) (((b) * 2 + (h)) * HTB)
#define PG8_SB(b, h) ((4 + (b) * 2 + (h)) * HTB)
#define PG8_STAGE(bufoff, gbase, voff) do { _Pragma("unroll") for (int _i = 0; _i < 2; ++_i) \
        __builtin_amdgcn_global_load_lds((const unsigned*)((const char*)(gbase) + (voff)[_i]), (PG8_LAS unsigned*)(lds + (bufoff) + ldsw + _i * 8192), 16, 0, 0); } while (0)
#define PG8_LDA(dst, b, h) do { _Pragma("unroll") for (int m = 0; m < 4; ++m) _Pragma("unroll") for (int k = 0; k < 2; ++k) dst[m][k] = *(const PG8_LAS bf16x8*)(lds + PG8_SA(b, h) + aoff + m * 2048 + k * 1024); } while (0)
#define PG8_LDB(dst, b, h) do { _Pragma("unroll") for (int n = 0; n < 2; ++n) _Pragma("unroll") for (int k = 0; k < 2; ++k) dst[n][k] = *(const PG8_LAS bf16x8*)(lds + PG8_SB(b, h) + boff + n * 2048 + k * 1024); } while (0)
#define PG8_MMA(ai, bj, At, Bt) do { __builtin_amdgcn_s_setprio(1); _Pragma("unroll") for (int m = 0; m < 4; ++m) _Pragma("unroll") for (int n = 0; n < 2; ++n) _Pragma("unroll") for (int k = 0; k < 2; ++k) \
        acc[ai][bj][m][n] = __builtin_amdgcn_mfma_f32_16x16x32_bf16(Bt[n][k], At[m][k], acc[ai][bj][m][n], 0, 0, 0); __builtin_amdgcn_s_setprio(0); } while (0)
#define PG8_WAIT_V(n) asm volatile("s_waitcnt vmcnt(" #n ")" ::: "memory")
#define PG8_WAIT_L(n) asm volatile("s_waitcnt lgkmcnt(" #n ")" ::: "memory")
#define PG8_BAR __builtin_amdgcn_s_barrier()
#define PG8_SCHED __builtin_amdgcn_sched_barrier(0)
    Unit cur, nxt; int ui = 0;
    if (!S.next(0, cur)) return;
    f32x4 acc[2][2][4][2];
#pragma unroll
    for (int a = 0; a < 2; ++a)
#pragma unroll
        for (int b = 0; b < 2; ++b)
#pragma unroll
            for (int m = 0; m < 4; ++m)
#pragma unroll
                for (int n = 0; n < 2; ++n) acc[a][b][m][n] = (f32x4){0.f, 0.f, 0.f, 0.f};
    bf16x8 At[4][2], B0[2][2], B1[2][2];
    const char* cA = (const char*)g.A + (size_t)cur.pm * tstepA + (g.agrp ? (size_t)(cur.pn / g.agrp) * g.astep : (size_t)0); const char* cB = (const char*)g.Bt + (size_t)cur.pn * tstepB;
    S.a_ready(cur);
    if constexpr (SP2) {
        PG8_STAGE(PG8_SB(0, 0), cB, voffB); PG8_STAGE(PG8_SB(0, 1), cB + hstepB, voffB); PG8_STAGE(PG8_SA(0, 0), cA, voffA); PG8_STAGE(PG8_SA(0, 1), cA + hstepA, voffA);
        if (wr == 1) PG8_BAR;
        PG8_WAIT_V(2); PG8_BAR;
        PG8_STAGE(PG8_SB(1, 0), cB + kstep, voffB); PG8_STAGE(PG8_SA(1, 0), cA + kstep, voffA); PG8_STAGE(PG8_SB(1, 1), cB + hstepB + kstep, voffB);
        PG8_WAIT_V(6); PG8_BAR;
    } else {
        PG8_STAGE(PG8_SB(0, 0), cB, voffB); PG8_STAGE(PG8_SA(0, 0), cA, voffA); PG8_STAGE(PG8_SB(0, 1), cB + hstepB, voffB); PG8_STAGE(PG8_SA(0, 1), cA + hstepA, voffA);
        if (wr == 1) PG8_BAR;
        PG8_WAIT_V(4); PG8_BAR;
        PG8_STAGE(PG8_SB(1, 0), cB + kstep, voffB); PG8_STAGE(PG8_SA(1, 0), cA + kstep, voffA); PG8_STAGE(PG8_SB(1, 1), cB + hstepB + kstep, voffB);
        PG8_WAIT_V(6); PG8_BAR;
    }
    for (;;) {
        const bool has_next = S.next(ui + 1, nxt);
        const char* nA = has_next ? (const char*)g.A + (size_t)nxt.pm * tstepA + (g.agrp ? (size_t)(nxt.pn / g.agrp) * g.astep : (size_t)0) : cA; const char* nB = has_next ? (const char*)g.Bt + (size_t)nxt.pn * tstepB : cB;
        for (int t = 0; t < nt; t += 2) {
            const bool last = (t == nt - 2);
            const char* a1 = cA + (size_t)(t + 1) * kstep;
            const char* a2 = last ? nA : cA + (size_t)(t + 2) * kstep; const char* b2 = last ? nB : cB + (size_t)(t + 2) * kstep;
            const char* a3 = a2 + kstep; const char* b3 = b2 + kstep;
            if (last && has_next) S.a_ready(nxt);
            if constexpr (SP2) {
            PG8_LDB(B0, 0, 0); PG8_LDB(B1, 0, 1); PG8_SCHED; PG8_LDA(At, 0, 0); PG8_STAGE(PG8_SA(1, 1), a1 + hstepA, voffA);
            PG8_WAIT_V(8); PG8_WAIT_L(0); PG8_BAR; PG8_MMA(0, 0, At, B0); PG8_MMA(0, 1, At, B1); PG8_BAR; PG8_SCHED;
            PG8_LDA(At, 0, 1); PG8_STAGE(PG8_SB(0, 0), b2, voffB); PG8_STAGE(PG8_SB(0, 1), b2 + hstepB, voffB); PG8_STAGE(PG8_SA(0, 0), a2, voffA);
            PG8_WAIT_V(8); PG8_WAIT_L(0); PG8_BAR; PG8_MMA(1, 0, At, B0); PG8_MMA(1, 1, At, B1); PG8_BAR; PG8_SCHED;
            PG8_LDB(B0, 1, 0); PG8_LDB(B1, 1, 1); PG8_SCHED; PG8_LDA(At, 1, 0); PG8_STAGE(PG8_SA(0, 1), a2 + hstepA, voffA);
            PG8_WAIT_V(8); PG8_WAIT_L(0); PG8_BAR; PG8_MMA(0, 0, At, B0); PG8_MMA(0, 1, At, B1); PG8_BAR; PG8_SCHED;
            PG8_LDA(At, 1, 1); PG8_STAGE(PG8_SB(1, 0), b3, voffB); PG8_STAGE(PG8_SB(1, 1), b3 + hstepB, voffB); PG8_STAGE(PG8_SA(1, 0), a3, voffA);
            PG8_WAIT_V(8); PG8_WAIT_L(0); PG8_BAR; PG8_MMA(1, 0, At, B0); PG8_MMA(1, 1, At, B1); PG8_BAR; PG8_SCHED;
            } else {
            PG8_LDB(B0, 0, 0); PG8_SCHED; PG8_LDA(At, 0, 0); PG8_STAGE(PG8_SA(1, 1), a1 + hstepA, voffA);
            PG8_WAIT_L(8); PG8_BAR; PG8_WAIT_L(0); PG8_MMA(0, 0, At, B0); PG8_BAR; PG8_SCHED;
            PG8_LDB(B1, 0, 1); PG8_STAGE(PG8_SB(0, 0), b2, voffB);
            PG8_BAR; PG8_WAIT_L(0); PG8_MMA(0, 1, At, B1); PG8_BAR;
            PG8_LDA(At, 0, 1); PG8_STAGE(PG8_SA(0, 0), a2, voffA);
            PG8_BAR; PG8_WAIT_L(0); PG8_MMA(1, 0, At, B0); PG8_BAR; PG8_SCHED;
            PG8_STAGE(PG8_SB(0, 1), b2 + hstepB, voffB);
            PG8_WAIT_V(6); PG8_BAR; PG8_MMA(1, 1, At, B1); PG8_BAR;
            PG8_LDB(B0, 1, 0); PG8_SCHED; PG8_LDA(At, 1, 0); PG8_STAGE(PG8_SA(0, 1), a2 + hstepA, voffA);
            PG8_WAIT_L(8); PG8_BAR; PG8_WAIT_L(0); PG8_MMA(0, 0, At, B0); PG8_BAR; PG8_SCHED;
            PG8_LDB(B1, 1, 1); PG8_STAGE(PG8_SB(1, 0), b3, voffB);
            PG8_BAR; PG8_WAIT_L(0); PG8_MMA(0, 1, At, B1); PG8_BAR;
            PG8_LDA(At, 1, 1); PG8_STAGE(PG8_SA(1, 0), a3, voffA);
            PG8_BAR; PG8_WAIT_L(0); PG8_MMA(1, 0, At, B0); PG8_BAR; PG8_SCHED;
            PG8_STAGE(PG8_SB(1, 1), b3 + hstepB, voffB);
            PG8_WAIT_V(6); PG8_BAR; PG8_MMA(1, 1, At, B1); PG8_BAR;
            }
        }
        if constexpr (ALIGN_EPI) { if (wr == 0) PG8_BAR; }
        if constexpr (!Epi::AFTER_DRAIN) { E(acc, cur, wr, wc, fr, fq); S.done(cur); }
        if (!has_next) break;
#pragma unroll
        for (int a = 0; a < 2; ++a)
#pragma unroll
            for (int b = 0; b < 2; ++b)
#pragma unroll
                for (int m = 0; m < 4; ++m)
#pragma unroll
                    for (int n = 0; n < 2; ++n) acc[a][b][m][n] = (f32x4){0.f, 0.f, 0.f, 0.f};
        cur = nxt; cA = nA; cB = nB; ++ui;
        if constexpr (ALIGN_EPI) { if (wr == 1) PG8_BAR; }
    }
    PG8_WAIT_V(0);
    if constexpr (!ALIGN_EPI) { if (wr == 0) PG8_BAR; }
    PG8_BAR;
    if constexpr (Epi::AFTER_DRAIN) { E.fused(acc, cur, wr, wc, fr, fq, lds, wid, lane); S.done(cur); }
#undef PG8_SA
#undef PG8_SB
#undef PG8_STAGE
#undef PG8_LDA
#undef PG8_LDB
#undef PG8_MMA
#undef PG8_WAIT_V
#undef PG8_WAIT_L
#undef PG8_BAR
#undef PG8_SCHED
}
}
#include <hip/hip_bf16.h>
#include <cmath>
namespace attn_body {
using bf16=__hip_bfloat16;
using bf16x8=__attribute__((ext_vector_type(8)))short;
using s16x4=__attribute__((ext_vector_type(4)))short;
using f32x16=__attribute__((ext_vector_type(16)))float;
using u32x4=__attribute__((ext_vector_type(4)))unsigned;
constexpr int BATCH=2,NHEAD=16,SEQ=8192,D=64,DM=NHEAD*D;
constexpr int NW=8,QBLK=32,QB=QBLK*NW,KVBLK=64,NQB=SEQ/QB;
constexpr int ATTN_PITCH=DM, ATTN_UNIT_ROWS=QB;
__device__ __forceinline__ int crow(int r,int hi){return (r&3)+8*(r>>2)+4*hi;}
#define SBAR() __builtin_amdgcn_sched_barrier(0)
__device__ __forceinline__ void cmask(f32x16&p0,f32x16&p1,int jb,int qrel,int hi){
  const float NEG=-INFINITY; int kb=64*jb+4*hi;
  #pragma unroll
  for(int r=0;r<16;++r){int kv=kb+(r&3)+8*(r>>2); if(kv>qrel)p0[r]=NEG; if(kv+32>qrel)p1[r]=NEG;}
}

constexpr int NSLOT=3, SLOTB=9216;
constexpr int LDS_K=0, LDS_V=NSLOT*SLOTB, LDS_WS=2*NSLOT*SLOTB, LDS_OST=LDS_WS+NW*64*4, LDS_BYTES=LDS_OST+NW*4096;
constexpr float C2=0.125f*1.4426950408889634f;
__device__ __forceinline__ void glds16(const void*gsrc,unsigned lds_dst){unsigned keep;
  asm volatile("s_mov_b32 %0, m0\n\ts_mov_b32 m0, %2\n\ts_nop 0\n\tglobal_load_lds_dwordx4 %1, off\n\ts_mov_b32 m0, %0":"=&s"(keep):"v"(gsrc),"s"(lds_dst):"memory");}
__device__ __forceinline__ float max3f(float a,float b,float c){float r;asm("v_max3_f32 %0, %1, %2, %3":"=v"(r):"v"(a),"v"(b),"v"(c));return r;}
__device__ __forceinline__ float max2f(float a,float b){float r;asm("v_max_f32_e32 %0, %1, %2":"=v"(r):"v"(a),"v"(b));return r;}
__device__ __forceinline__ float fadd_s(float a,float b){float r;asm("v_add_f32_e32 %0, %1, %2":"=v"(r):"v"(a),"v"(b));return r;}
__device__ __forceinline__ float fsub_s(float a,float b){float r;asm("v_sub_f32_e32 %0, %1, %2":"=v"(r):"v"(a),"v"(b));return r;}
typedef float f32x2_t __attribute__((ext_vector_type(2))); typedef __bf16 bf16x2_t __attribute__((ext_vector_type(2)));
__device__ __forceinline__ unsigned cvtpk_s(float lo,float hi){f32x2_t v={lo,hi};bf16x2_t b=__builtin_convertvector(v,bf16x2_t);return __builtin_bit_cast(unsigned,b);}
#define WAIT_BAR(N) asm volatile("s_waitcnt vmcnt(" #N ") lgkmcnt(0)\n\ts_barrier":::"memory")
#define WAIT_BARW() do{ if(wid==0){WAIT_BAR(3);} else {WAIT_BAR(2);} }while(0)

__device__ __forceinline__ void qkt(f32x16&p0,f32x16&p1,const char*Kslot,const bf16x8*qr,const bf16x8 qe,const f32x16&negm,int r32,int hi){
  const char*kb=Kslot+hi*1024+r32*16;
  #pragma unroll
  for(int d0=0;d0<4;++d0){
    const bf16x8 b0=*reinterpret_cast<const bf16x8*>(kb+d0*2048);
    const bf16x8 b1=*reinterpret_cast<const bf16x8*>(kb+d0*2048+512);
    if(d0==0){p0=__builtin_amdgcn_mfma_f32_32x32x16_bf16(b0,qr[0],negm,0,0,0);p1=__builtin_amdgcn_mfma_f32_32x32x16_bf16(b1,qr[0],negm,0,0,0);}
    else{p0=__builtin_amdgcn_mfma_f32_32x32x16_bf16(b0,qr[d0],p0,0,0,0);p1=__builtin_amdgcn_mfma_f32_32x32x16_bf16(b1,qr[d0],p1,0,0,0);}}
  { const char*ke=Kslot+8192+r32*16; const bf16x8 e0=*reinterpret_cast<const bf16x8*>(ke),e1=*reinterpret_cast<const bf16x8*>(ke+512);
    p0=__builtin_amdgcn_mfma_f32_32x32x16_bf16(e0,qe,p0,0,0,0);p1=__builtin_amdgcn_mfma_f32_32x32x16_bf16(e1,qe,p1,0,0,0);}
}
typedef __attribute__((address_space(3))) const char* lds_cptr;
typedef short v4i16_t __attribute__((ext_vector_type(4)));
__device__ __forceinline__ void kload8(bf16x8*kf,lds_cptr kp){
  kf[0]=*(const __attribute__((address_space(3))) bf16x8*)(kp);      kf[1]=*(const __attribute__((address_space(3))) bf16x8*)(kp+512);
  kf[2]=*(const __attribute__((address_space(3))) bf16x8*)(kp+2048); kf[3]=*(const __attribute__((address_space(3))) bf16x8*)(kp+2560);
  kf[4]=*(const __attribute__((address_space(3))) bf16x8*)(kp+4096); kf[5]=*(const __attribute__((address_space(3))) bf16x8*)(kp+4608);
  kf[6]=*(const __attribute__((address_space(3))) bf16x8*)(kp+6144); kf[7]=*(const __attribute__((address_space(3))) bf16x8*)(kp+6656);
}
__device__ __forceinline__ void kload2(bf16x8*kf,lds_cptr kp,int j){ kf[2*j]=*(const __attribute__((address_space(3))) bf16x8*)(kp+j*2048); kf[2*j+1]=*(const __attribute__((address_space(3))) bf16x8*)(kp+j*2048+512); }
__device__ __forceinline__ s16x4 vtr(lds_cptr p){ return __builtin_bit_cast(s16x4,__builtin_amdgcn_ds_read_tr16_b64_v4i16((__attribute__((address_space(3))) v4i16_t*)p)); }
__device__ __forceinline__ float rowmax(const f32x16&p0,const f32x16&p1){
  float a=max3f(p0[0],p0[1],p1[0]),b=max3f(p0[2],p0[3],p1[1]);a=max3f(a,p1[2],p1[3]);
  #pragma unroll
  for(int r=4;r<16;r+=4){a=max3f(a,p0[r],p0[r+1]);b=max3f(b,p0[r+2],p0[r+3]);a=max3f(a,p1[r],p1[r+1]);b=max3f(b,p1[r+2],p1[r+3]);}
  const float m=max2f(a,b);
  auto rr=__builtin_amdgcn_permlane32_swap(__float_as_uint(m),__float_as_uint(m),false,false);
  return max2f(__uint_as_float(rr[0]),__uint_as_float(rr[1]));
}
__device__ __forceinline__ void pv(f32x16*o,int vb,bf16x8 pa0,bf16x8 pa1,bf16x8 pa2,bf16x8 pa3){
  #pragma unroll
  for(int d0=0;d0<2;++d0){s16x4 lo[4],hi[4];
    #pragma unroll
    for(int ks=0;ks<4;++ks){
      asm volatile("ds_read_b64_tr_b16 %0,%1 offset:%c2":"=&v"(lo[ks]):"v"(vb),"i"(d0*4096+ks*1024):"memory");
      asm volatile("ds_read_b64_tr_b16 %0,%1 offset:%c2":"=&v"(hi[ks]):"v"(vb),"i"(d0*4096+ks*1024+512):"memory");}
    asm volatile("s_waitcnt lgkmcnt(0)":::"memory");SBAR();
    #define PK(k) (bf16x8){lo[k][0],lo[k][1],lo[k][2],lo[k][3],hi[k][0],hi[k][1],hi[k][2],hi[k][3]}
    o[d0]=__builtin_amdgcn_mfma_f32_32x32x16_bf16(pa0,PK(0),o[d0],0,0,0);
    o[d0]=__builtin_amdgcn_mfma_f32_32x32x16_bf16(pa1,PK(1),o[d0],0,0,0);
    o[d0]=__builtin_amdgcn_mfma_f32_32x32x16_bf16(pa2,PK(2),o[d0],0,0,0);
    o[d0]=__builtin_amdgcn_mfma_f32_32x32x16_bf16(pa3,PK(3),o[d0],0,0,0);
    #undef PK
  }
}

#ifndef ATTN_STORE16
#define ATTN_STORE16(p,v) (*(u32x4*)(p)=(v))
#endif
template<int THRL> __device__ __forceinline__ void attn_unit(int b,int h,int qb,const bf16*Q,const bf16*__restrict__ K,const bf16*__restrict__ V,bf16*O,const bf16*__restrict__ GT,const unsigned char*__restrict__ G3,const float*__restrict__ qgain,const float kbound,char*shm,const int tid_in,const int j0){
  int tid_l=tid_in; asm volatile("":"+v"(tid_l)); const int tid=tid_l,lane=tid&63,r32=lane&31,hi=lane>>5; const int wid=__builtin_amdgcn_readfirstlane(tid>>6);
  const long rowbase=(long)b*SEQ; const int q0=qb*QB;
  const bf16*Qw=Q+(rowbase+q0+wid*QBLK)*DM+h*D;
  const bf16*Kh=K+rowbase*DM+h*D,*Vh=V+rowbase*DM+h*D;
  const unsigned lds0=(unsigned)(uintptr_t)shm;
  float*wsf=(float*)(shm+LDS_WS)+wid*64;
  const bf16*ksrc=Kh+(long)lane*DM+wid*8;
  const bf16*vsrc=Vh+(long)(16*(wid&3)+(lane>>2))*DM+(wid>>2)*32+(lane&3)*8;
  const unsigned kdst=lds0+LDS_K+wid*1024, vdst=lds0+LDS_V+wid*1024, gdst=lds0+LDS_K+8192;
  const unsigned char*gsrc=G3+((long)(b*NHEAD+h)*SEQ+lane)*16;
  #define DMA_K(t,slot) do{ if(wid==0)glds16(gsrc+(long)(t)*KVBLK*16,(unsigned)__builtin_amdgcn_readfirstlane(gdst+(slot))); glds16(ksrc+(long)(t)*KVBLK*DM,(unsigned)__builtin_amdgcn_readfirstlane(kdst+(slot))); }while(0)
  #define DMA_V(t,slot) glds16(vsrc+(long)(t)*KVBLK*DM,(unsigned)__builtin_amdgcn_readfirstlane(vdst+(slot)))
  const int vb0=(int)(lds0+LDS_V)+((lane>>4)&1)*32+(lane&3)*8+(4*hi+((lane&15)>>2))*64;
  const char*Kbase=shm+LDS_K; bf16x8 kf[10];
  const lds_cptr shm3=(lds_cptr)shm; const lds_cptr kp0=shm3+LDS_K+hi*1024+r32*16; const lds_cptr kpe=shm3+LDS_K+8192+r32*16; const lds_cptr vp0=shm3+LDS_V+((lane>>4)&1)*32+(lane&3)*8+(4*hi+((lane&15)>>2))*64;
  ksrc+=(long)j0*KVBLK*DM; vsrc+=(long)j0*KVBLK*DM; gsrc+=(long)j0*KVBLK*16;
  const int NT=(q0+QB)/KVBLK-j0;
  DMA_K(0,0);DMA_V(0,0);DMA_K(1,SLOTB);
  bf16x8 qr[4]; float fq2; bf16x8 qe; float ubound;
  { bf16x8 qraw[4];
    #pragma unroll
    for(int d0=0;d0<4;++d0)qraw[d0]=*reinterpret_cast<const bf16x8*>(&Qw[(long)r32*DM+d0*16+hi*8]);
    const u32x4 ge=*reinterpret_cast<const u32x4*>(G3+((long)(b*NHEAD+h)*SEQ+q0+wid*QBLK+r32)*16);
    fq2=-(__uint_as_float(ge[0]<<16)+__uint_as_float(ge[0]&0xffff0000u)+__uint_as_float(ge[1]<<16));
    float ss=0.f;
    #pragma unroll
    for(int d0=0;d0<4;++d0)
      #pragma unroll
      for(int j=0;j<8;++j){const float x=__uint_as_float(((unsigned)(unsigned short)qraw[d0][j])<<16);ss+=x*x;}
    {auto rr=__builtin_amdgcn_permlane32_swap(__float_as_uint(ss),__float_as_uint(ss),false,false);ss=__uint_as_float(rr[0])+__uint_as_float(rr[1]);}
    const float qs=C2/sqrtf(ss*(1.0f/64.0f)+1e-6f);
    float s2=0.f;
    #pragma unroll
    for(int d0=0;d0<4;++d0){ u32x4 w;
      #pragma unroll
      for(int j=0;j<8;j+=2){const float x0=__uint_as_float(((unsigned)(unsigned short)qraw[d0][j])<<16),x1=__uint_as_float(((unsigned)(unsigned short)qraw[d0][j+1])<<16);
        const float y0=x0*qs*qgain[d0*16+hi*8+j],y1=x1*qs*qgain[d0*16+hi*8+j+1]; s2+=y0*y0+y1*y1;
        w[j>>1]=cvtpk_s(y0,y1);}
      qr[d0]=__builtin_bit_cast(bf16x8,w);}
    {auto rr=__builtin_amdgcn_permlane32_swap(__float_as_uint(s2),__float_as_uint(s2),false,false);s2=__uint_as_float(rr[0])+__uint_as_float(rr[1]);}
    ubound=sqrtf(s2)*kbound;
    const unsigned one2=hi?0u:0x3f803f80u, one1=hi?0u:0x00003f80u; qe=__builtin_bit_cast(bf16x8,(u32x4){one2,one1,0u,0u}); }
  float mhat=ubound,l_reg=0.f;f32x16 o[2];o[0]=f32x16{};o[1]=f32x16{};f32x16 negm;
  #pragma unroll
  for(int r=0;r<16;++r)negm[r]=fq2-ubound;
  asm volatile("":"+v"(negm));
  const int qrel=wid*QBLK+r32;
  #define CMASK(P0,P1,t) do{int jb_=(t)-(NT-4); if(jb_>=0)cmask(P0,P1,jb_,qrel,hi);}while(0)
  bool resc=false;
  #define START(P0,P1) do{ const float rm=rowmax(P0,P1); resc=false; \
    { const float dl=fmaxf(rm,0.f); mhat=fadd_s(mhat,dl); \
      _Pragma("unroll") for(int r=0;r<16;++r){P0[r]=fsub_s(P0[r],dl);P1[r]=fsub_s(P1[r],dl);} \
      _Pragma("unroll") for(int r=0;r<16;++r)negm[r]=fq2-mhat; asm volatile("":"+v"(negm)); } \
    _Pragma("unroll") for(int r=0;r<16;++r)P0[r]=__builtin_amdgcn_exp2f(P0[r]); }while(0)
  #define RESC() do{ if(resc){ asm volatile("s_waitcnt lgkmcnt(0)":::"memory"); \
      _Pragma("unroll") for(int d_=0;d_<2;++d_) _Pragma("unroll") for(int r=0;r<16;++r)o[d_][r]*=wsf[crow(r,hi)]; } }while(0)
  f32x16 pA0,pA1,pB0,pB1;
  int sl_prev=0,sl_cur=0,sl_next=SLOTB;
  #define ROT() do{sl_prev=sl_cur;sl_cur=sl_next;sl_next=(sl_next==(NSLOT-1)*SLOTB)?0:sl_next+SLOTB;}while(0)
  DMA_K(2,2*SLOTB);
  WAIT_BAR(3);
  qkt(pA0,pA1,Kbase,qr,qe,negm,r32,hi);asm volatile("s_nop 15\n\ts_nop 7":"+v"(pA0),"+v"(pA1));CMASK(pA0,pA1,0);
  START(pA0,pA1);
  _Pragma("unroll") for(int r=0;r<16;++r)pA1[r]=__builtin_amdgcn_exp2f(pA1[r]);
  WAIT_BAR(0);
  DMA_K(3,0);DMA_V(1,SLOTB);
  ROT();
  kload8(kf,kp0+sl_cur);
  kf[8]=*(const __attribute__((address_space(3))) bf16x8*)(kpe+sl_cur); kf[9]=*(const __attribute__((address_space(3))) bf16x8*)(kpe+sl_cur+512);
  WAIT_BARW();
  s16x4 vlo[8],vhi[8]; u32x4 pw0,pw1,pw2,pw3;
  #define PKW(P,B) cvtpk_s(P[B],P[B+1])
  #define PAF(k) __builtin_bit_cast(bf16x8,pw##k)
  #define VFR(i) (bf16x8){vlo[i][0],vlo[i][1],vlo[i][2],vlo[i][3],vhi[i][0],vhi[i][1],vhi[i][2],vhi[i][3]}
  #define PIN(x) asm volatile("":"+v"(x))
  #define MX3(a,b,c) __builtin_fmaxf(__builtin_fmaxf((a),(b)),(c))
  #define GAPA(MF,A0,A1,A2,A3,W0,W1,PW) do{ MF; sacc+=A0; sacc+=A1; sacc+=A2; sacc+=A3; PIN(sacc); W0; W1; PIN(PW); SBAR(); }while(0)
  #define EX(v) __builtin_amdgcn_exp2f(v)
  #define GAPB(MF,X,B) do{ MF; X[B]=EX(X[B]); X[B+1]=EX(X[B+1]); X[B+2]=EX(X[B+2]); X[B+3]=EX(X[B+3]); PIN(X); SBAR(); }while(0)
  #define VRD(i) do{ vlo[i]=vtr(vp_+(((i)>>2)*4096+((i)&3)*1024)); vhi[i]=vtr(vp_+(((i)>>2)*4096+((i)&3)*1024+512)); }while(0)
  #define KRD(G,j) do{ if(G){ kload2(kf,kp0+sl_next,j); SBAR(); } }while(0)
  #define STEP(C0,C1,P0,P1,t,GK,GV,GL) do{ SBAR(); \
    const lds_cptr vp_=vp0+sl_prev; \
    VRD(0); SBAR(); float sacc=(P0[0]+P0[1]); \
    GAPA(C0=__builtin_amdgcn_mfma_f32_32x32x16_bf16(kf[0],qr[0],negm,0,0,0), P0[2],P0[3],P0[4],P0[5],     pw0[0]=PKW(P0,0), pw0[1]=PKW(P0,2), pw0); \
    VRD(4); SBAR(); GAPA(C1=__builtin_amdgcn_mfma_f32_32x32x16_bf16(kf[1],qr[0],negm,0,0,0), P0[6],P0[7],P0[8],P0[9],     pw0[2]=PKW(P0,4), pw0[3]=PKW(P0,6), pw0); \
    VRD(1); SBAR(); GAPA(C0=__builtin_amdgcn_mfma_f32_32x32x16_bf16(kf[2],qr[1],C0,0,0,0),   P0[10],P0[11],P0[12],P0[13], pw1[0]=PKW(P0,8), pw1[1]=PKW(P0,10), pw1); \
    VRD(5); SBAR(); GAPA(C1=__builtin_amdgcn_mfma_f32_32x32x16_bf16(kf[3],qr[1],C1,0,0,0),   P0[14],P0[15],P1[0],P1[1],   pw1[2]=PKW(P0,12),pw1[3]=PKW(P0,14), pw1); \
    VRD(2); SBAR(); GAPA(C0=__builtin_amdgcn_mfma_f32_32x32x16_bf16(kf[4],qr[2],C0,0,0,0),   P1[2],P1[3],P1[4],P1[5],     pw2[0]=PKW(P1,0), pw2[1]=PKW(P1,2), pw2); \
    VRD(6); SBAR(); GAPA(C1=__builtin_amdgcn_mfma_f32_32x32x16_bf16(kf[5],qr[2],C1,0,0,0),   P1[6],P1[7],P1[8],P1[9],     pw2[2]=PKW(P1,4), pw2[3]=PKW(P1,6), pw2); \
    VRD(3); SBAR(); GAPA(C0=__builtin_amdgcn_mfma_f32_32x32x16_bf16(kf[6],qr[3],C0,0,0,0),   P1[10],P1[11],P1[12],P1[13], pw3[0]=PKW(P1,8), pw3[1]=PKW(P1,10), pw3); \
    VRD(7); SBAR(); GAPA(C1=__builtin_amdgcn_mfma_f32_32x32x16_bf16(kf[7],qr[3],C1,0,0,0),   P1[14],P1[15],0.f,0.f,       pw3[2]=PKW(P1,12),pw3[3]=PKW(P1,14), pw3); \
    C0=__builtin_amdgcn_mfma_f32_32x32x16_bf16(kf[8],qe,C0,0,0,0); C1=__builtin_amdgcn_mfma_f32_32x32x16_bf16(kf[9],qe,C1,0,0,0); \
    l_reg+=sacc; \
    if(GK){DMA_K((t)+3,sl_cur);} if(GV){DMA_V((t)+1,sl_next);} \
    CMASK(C0,C1,t); \
    resc=false;     \
    SBAR(); \
    GAPB(o[0]=__builtin_amdgcn_mfma_f32_32x32x16_bf16(PAF(0),VFR(0),o[0],0,0,0), C0,0); \
    GAPB(o[1]=__builtin_amdgcn_mfma_f32_32x32x16_bf16(PAF(0),VFR(4),o[1],0,0,0), C0,4); \
    KRD(GL,0); GAPB(o[0]=__builtin_amdgcn_mfma_f32_32x32x16_bf16(PAF(1),VFR(1),o[0],0,0,0), C0,8); \
    KRD(GL,1); GAPB(o[1]=__builtin_amdgcn_mfma_f32_32x32x16_bf16(PAF(1),VFR(5),o[1],0,0,0), C0,12); \
    KRD(GL,2); GAPB(o[0]=__builtin_amdgcn_mfma_f32_32x32x16_bf16(PAF(2),VFR(2),o[0],0,0,0), C1,0); \
    KRD(GL,3); GAPB(o[1]=__builtin_amdgcn_mfma_f32_32x32x16_bf16(PAF(2),VFR(6),o[1],0,0,0), C1,4); \
    if(GL){ kf[8]=*(const __attribute__((address_space(3))) bf16x8*)(kpe+sl_next); kf[9]=*(const __attribute__((address_space(3))) bf16x8*)(kpe+sl_next+512); SBAR(); } \
    GAPB(o[0]=__builtin_amdgcn_mfma_f32_32x32x16_bf16(PAF(3),VFR(3),o[0],0,0,0), C1,8); \
    GAPB(o[1]=__builtin_amdgcn_mfma_f32_32x32x16_bf16(PAF(3),VFR(7),o[1],0,0,0), C1,12); \
    }while(0)
  int t=1;
  #undef CMASK
  #define CMASK(P0,P1,t) do{}while(0)
  for(;t+5<NT;t+=2){
    STEP(pB0,pB1,pA0,pA1,t,true,true,true);     WAIT_BARW(); RESC(); ROT();
    STEP(pA0,pA1,pB0,pB1,t+1,true,true,true);   WAIT_BARW(); RESC(); ROT();
  }
  #undef CMASK
  #define CMASK(P0,P1,t) do{int jb_=(t)-(NT-4); if(jb_>=0)cmask(P0,P1,jb_,qrel,hi);}while(0)
  #define ENDW(tt) do{ if((tt)+3<NT){WAIT_BARW();} else if((tt)+2<NT){WAIT_BAR(1);} else {WAIT_BAR(0);} }while(0)
  for(;t+1<NT;t+=2){
    STEP(pB0,pB1,pA0,pA1,t,(t+3<NT),(t+1<NT),(t+1<NT));       ENDW(t);   RESC(); ROT();
    STEP(pA0,pA1,pB0,pB1,t+1,(t+4<NT),(t+2<NT),(t+2<NT));     ENDW(t+1); RESC(); ROT();
  }
  STEP(pB0,pB1,pA0,pA1,NT-1,false,false,false); RESC();
  { float sacc=pB0[0]+pB0[1]; _Pragma("unroll") for(int r=2;r<16;++r)sacc+=pB0[r]; _Pragma("unroll") for(int r=0;r<16;++r)sacc+=pB1[r]; l_reg+=sacc;
    pw0=(u32x4){PKW(pB0,0),PKW(pB0,2),PKW(pB0,4),PKW(pB0,6)};pw1=(u32x4){PKW(pB0,8),PKW(pB0,10),PKW(pB0,12),PKW(pB0,14)};pw2=(u32x4){PKW(pB1,0),PKW(pB1,2),PKW(pB1,4),PKW(pB1,6)};pw3=(u32x4){PKW(pB1,8),PKW(pB1,10),PKW(pB1,12),PKW(pB1,14)};
    SBAR(); pv(o,vb0+sl_cur,PAF(0),PAF(1),PAF(2),PAF(3)); }
  #undef PKW
  #undef PAF
  #undef VFR
  #undef PIN
  #undef MX3
  #undef GAPA
  #undef GAPB
  #undef EX
  #undef VRD
  #undef KRD
  #undef STEP
  #undef ENDW
  {auto rr=__builtin_amdgcn_permlane32_swap(__float_as_uint(l_reg),__float_as_uint(l_reg),false,false);l_reg=__uint_as_float(rr[0])+__uint_as_float(rr[1]);}
  if(hi==0)wsf[32+r32]=l_reg;asm volatile("s_waitcnt lgkmcnt(0)":::"memory");
  float rli[16];
  #pragma unroll
  for(int r=0;r<16;++r)rli[r]=__builtin_amdgcn_rcpf(wsf[32+crow(r,hi)]);
  bf16*Ow=O+(rowbase+q0+wid*QBLK)*DM+h*D;
  { bf16*stg=(bf16*)(shm+LDS_OST)+wid*2048;
    #pragma unroll
    for(int r=0;r<16;++r){const int orow=crow(r,hi);
      #pragma unroll
      for(int d0=0;d0<2;++d0)stg[orow*64+d0*32+r32]=__float2bfloat16(o[d0][r]*rli[r]);}
    asm volatile("s_waitcnt lgkmcnt(0)":::"memory");
    const bf16*Gw=GT+(rowbase+q0+wid*QBLK)*DM+h*D;
    #pragma unroll
    for(int i=0;i<4;++i){const int row=i*8+(lane>>3),ch=lane&7; u32x4 v=*(const u32x4*)(stg+row*64+ch*8); const u32x4 gg=*(const u32x4*)(Gw+(long)row*DM+ch*8);
      #pragma unroll
      for(int j=0;j<4;++j){ v[j]=cvtpk_s(__uint_as_float(v[j]<<16)*__uint_as_float(gg[j]<<16),__uint_as_float(v[j]&0xffff0000u)*__uint_as_float(gg[j]&0xffff0000u)); }
      ATTN_STORE16(Ow+(long)row*DM+ch*8,v);} }
  asm volatile("s_waitcnt lgkmcnt(0)\n\ts_barrier":::"memory");
  #undef DMA_K
  #undef DMA_V
  #undef CMASK
  #undef START
  #undef RESC
  #undef ROT
}
constexpr int ATTN_LDS_BYTES=LDS_BYTES;
struct AttnTensors { const bf16* Q; const bf16* K; const bf16* V; bf16* O; const bf16* GT; const unsigned char* G3; const float* qgain; float kbound; };
struct AttnUnit { int bh; int qb; };
struct StaticOrder {
  int vcu;
  __device__ __forceinline__ explicit StaticOrder(int grid,int block):vcu((block%8)*(grid/8)+block/8){}
  __device__ __forceinline__ bool next(int i,AttnUnit&u)const{ if(i>=4)return false; const int s=vcu&7; u.bh=vcu>>3; u.qb=(i==0)?s:(i==1)?15-s:(i==2)?16+s:31-s; return true; }
  __device__ __forceinline__ void a_ready(const AttnUnit&)const{}
  __device__ __forceinline__ void done(const AttnUnit&)const{}
};
template<class Sched,int THRL=8> __device__ __forceinline__ void attn_phase(char*lds,const AttnTensors&T,const Sched&S,const int tid_in){
  AttnUnit u;
  for(int i=0;S.next(i,u);++i){ S.a_ready(u); attn_unit<THRL>(u.bh/NHEAD,u.bh%NHEAD,u.qb,T.Q,T.K,T.V,T.O,T.GT,T.G3,T.qgain,T.kbound,lds,tid_in,0); S.done(u); }
}
__device__ __forceinline__ float g3val(const unsigned char*G3,long key){ const u32x4 ge=*reinterpret_cast<const u32x4*>(G3+key*16); return __uint_as_float(ge[0]<<16)+__uint_as_float(ge[0]&0xffff0000u)+__uint_as_float(ge[1]<<16); }
template<int THRL=8> __device__ __forceinline__ void attn_phase_dyn(char*lds,const AttnTensors&T,unsigned*counter,const float thr2,const int tid_in){
  int tid_l=tid_in; asm volatile("":"+v"(tid_l)); const int tid=tid_l,lane=tid&63;
  volatile unsigned*uw=(volatile unsigned*)(lds+LDS_BYTES);
  for(;;){
    if(tid==0){ const unsigned got=__hip_atomic_fetch_add(counter,1u,__ATOMIC_RELAXED,__HIP_MEMORY_SCOPE_AGENT); *uw=got; }
    __syncthreads();
    const unsigned u=(unsigned)__builtin_amdgcn_readfirstlane((int)*uw);
    if(u>=(unsigned)(BATCH*NHEAD*NQB))break;
    const int qb=NQB-1-(int)(u>>5), bh=(int)(u&31), ntf=4*qb+4;
    const long kb=(long)bh*SEQ; const float gt0=g3val(T.G3,kb+(long)qb*QB);
    bool skip0=false,skip1=false;
    if(lane<ntf) skip0=g3val(T.G3,kb+64*lane+63)<gt0-thr2;
    if(lane+64<ntf) skip1=g3val(T.G3,kb+64*(lane+64)+63)<gt0-thr2;
    int j0=__builtin_popcountll(__ballot(skip0))+__builtin_popcountll(__ballot(skip1));
    j0=__builtin_amdgcn_readfirstlane(j0); j0&=~1; if(j0>ntf-4)j0=ntf-4;
    attn_unit<THRL>(bh/NHEAD,bh%NHEAD,qb,T.Q,T.K,T.V,T.O,T.GT,T.G3,T.qgain,T.kbound,lds,tid_in,j0);
  }
}
#undef SBAR
#undef WAIT_BAR
#undef WAIT_BARW
}
constexpr int NWAVES = 8;
constexpr int BATCH = 2, T = 8192, D = 1024, H = 16, HD = 64, FF = 4096, M = BATCH * T;
constexpr int N1 = 3584, K1 = 2048, NP2 = 3072;
constexpr size_t MiB = 1u << 20;
constexpr size_t WS_MOD = 0;
constexpr size_t WS_W1 = 1 * MiB;
constexpr size_t WS_W2A = 29 * MiB;
constexpr size_t WS_W2G = 32 * MiB;
constexpr size_t WS_WO = 33 * MiB;
constexpr size_t WS_WKV = 37 * MiB;
constexpr size_t WS_WQG = 42 * MiB;
constexpr size_t WS_WO2 = 50 * MiB;
constexpr size_t WS_WUP = 54 * MiB, WS_WDN = 62 * MiB;
constexpr size_t WS_G3 = 70 * MiB;
constexpr size_t WS_FL = 74 * MiB;
constexpr size_t WS_H2 = 76 * MiB;
constexpr size_t WS_P1 = 140 * MiB;
constexpr size_t WS_P2 = 252 * MiB;
constexpr size_t WS_VF = 348 * MiB;
constexpr size_t WS_HB = 140 * MiB;
constexpr size_t WS_KVRAW = 140 * MiB, WS_QB = 204 * MiB, WS_GT = 236 * MiB, WS_VS = 316 * MiB, WS_KS = 348 * MiB;
constexpr size_t WS_END = 380 * MiB;
constexpr int LDS_BYTES = 147456;

#define GAS __attribute__((address_space(1)))
#define LAS __attribute__((address_space(3)))
typedef unsigned short bf16;
typedef unsigned v4u __attribute__((ext_vector_type(4)));
typedef unsigned v2u __attribute__((ext_vector_type(2)));
typedef float f32x4 __attribute__((ext_vector_type(4)));
using pg8::pkbf; using pg8::bflo; using pg8::bfhi; using pg8::sigm;

struct Args { const float* in[39]; float* out; unsigned char* ws; int ph_lo, ph_hi; };

struct Frame { LAS unsigned char* lds; int tid, lane, wave, vcu, G, bx; unsigned char* ws; float* out; const float* const* in; };

__device__ __forceinline__ void tr_item(const float* W, int ldw, int Nvalid, bf16* WT, int ldt, int row_off, int col_off, const float* mu, LAS float* scr, int item, int lane) {
    const int nblk = (Nvalid + 31) / 32, kb = item / nblk, nb = item % nblk, k0 = 64 * kb, n0 = 32 * nb;
    { float t[32]; const int n = n0 + (lane & 31); const bool ok = n < Nvalid; const float* wp = W + (size_t)(k0 + (lane >> 5)) * ldw + n;
#pragma unroll
      for (int i = 0; i < 32; ++i) t[i] = ok ? wp[(size_t)(2 * i) * ldw] : 0.f;
#pragma unroll
      for (int i = 0; i < 32; ++i) scr[(2 * i + (lane >> 5)) * 33 + (lane & 31)] = t[i]; }
    asm volatile("s_waitcnt lgkmcnt(0)" ::: "memory");
    const int c = lane & 7;
    float s0[8], s1[8];
#pragma unroll
    for (int q = 0; q < 8; ++q) { const float m = mu ? mu[k0 + 8 * c + q] : 0.f; s0[q] = 1.f - m; s1[q] = m; }
#pragma unroll
    for (int j = 0; j < 4; ++j) { const int n = (lane >> 3) + 8 * j; const LAS float* s = scr + (8 * c) * 33 + n;
        float v[8];
#pragma unroll
        for (int q = 0; q < 8; ++q) v[q] = s[q * 33];
        v4u o; o.x = pkbf(v[0] * s0[0], v[1] * s0[1]); o.y = pkbf(v[2] * s0[2], v[3] * s0[3]); o.z = pkbf(v[4] * s0[4], v[5] * s0[5]); o.w = pkbf(v[6] * s0[6], v[7] * s0[7]);
        bf16* dst = WT + (size_t)(row_off + n0 + n) * ldt + col_off + k0 + 8 * c;
        *(v4u*)dst = o;
        if (mu) { v4u p; p.x = pkbf(v[0] * s1[0], v[1] * s1[1]); p.y = pkbf(v[2] * s1[2], v[3] * s1[3]); p.z = pkbf(v[4] * s1[4], v[5] * s1[5]); p.w = pkbf(v[6] * s1[6], v[7] * s1[7]); *(v4u*)(dst + 1024) = p; } }
    asm volatile("s_waitcnt lgkmcnt(0)" ::: "memory");
}
__device__ __forceinline__ float dpp_f(float x, const int ctrl_sel) {
    switch (ctrl_sel) {
        case 0: return __builtin_bit_cast(float, __builtin_amdgcn_update_dpp(0, __builtin_bit_cast(int, x), 0xB1, 0xf, 0xf, false));
        case 1: return __builtin_bit_cast(float, __builtin_amdgcn_update_dpp(0, __builtin_bit_cast(int, x), 0x4E, 0xf, 0xf, false));
        case 2: return __builtin_bit_cast(float, __builtin_amdgcn_update_dpp(0, __builtin_bit_cast(int, x), 0x141, 0xf, 0xf, false));
        default: return __builtin_bit_cast(float, __builtin_amdgcn_update_dpp(0, __builtin_bit_cast(int, x), 0x140, 0xf, 0xf, false));
    }
}
__device__ __forceinline__ float sum4(float x) { x += dpp_f(x, 0); x += dpp_f(x, 1); return x; }
__device__ __forceinline__ float sum8(float x) { x = sum4(x); x += dpp_f(x, 2); return x; }
__device__ __forceinline__ float sum16(float x) { x = sum8(x); x += dpp_f(x, 3); return x; }
__device__ __forceinline__ float wave_sum(float v) {
    v = sum16(v);
    { auto rr = __builtin_amdgcn_permlane16_swap(__float_as_uint(v), __float_as_uint(v), false, false); v = __uint_as_float(rr[0]) + __uint_as_float(rr[1]); }
    { auto rr = __builtin_amdgcn_permlane32_swap(__float_as_uint(v), __float_as_uint(v), false, false); v = __uint_as_float(rr[0]) + __uint_as_float(rr[1]); }
    return v;
}
__device__ __forceinline__ void norm_row(const float* xrow, const float* g, const float* sh, const float* sc, int lane, f32x4 (&v)[4]) {
    float s = 0.f;
#pragma unroll
    for (int j = 0; j < 4; ++j) { v[j] = *((const f32x4*)xrow + lane + 64 * j); s += (v[j].x * v[j].x + v[j].y * v[j].y) + (v[j].z * v[j].z + v[j].w * v[j].w); }
    const float rstd = 1.0f / sqrtf(wave_sum(s) * (1.f / D) + 1e-6f);
#pragma unroll
    for (int j = 0; j < 4; ++j) { const f32x4 gg = *((const f32x4*)g + lane + 64 * j);
        f32x4 a = {1.f, 1.f, 1.f, 1.f}, b = {0.f, 0.f, 0.f, 0.f}; if (sc) { a = *((const f32x4*)sc + lane + 64 * j) + 1.0f; b = *((const f32x4*)sh + lane + 64 * j); }
        v[j] = (v[j] * rstd * gg) * a + b; }
}
__device__ __forceinline__ void st_row_bf16(bf16* orow, int lane, const f32x4 (&v)[4]) {
#pragma unroll
    for (int j = 0; j < 4; ++j) { v2u w; w.x = pkbf(v[j].x, v[j].y); w.y = pkbf(v[j].z, v[j].w); *((v2u*)orow + lane + 64 * j) = w; }
}
__device__ __forceinline__ void p0_mod(Frame& F) {
    LAS float* ca = (LAS float*)F.lds; LAS float* red = (LAS float*)(F.lds + 8192);
    const float* cin = F.in[1];
    for (int i = F.tid; i < 2048; i += 512) { const float c = cin[i]; ca[i] = c / (1.0f + __expf(-c)); }
    __syncthreads();
    float* MOD = (float*)(F.ws + WS_MOD); float* MODKV = MOD + 4 * 2 * 6144;
    for (int item = F.bx; item < 208; item += F.G) {
        const int col = item * 128; const float* W; const float* bias; int ldw, cw; float* dst0; float* dst1;
        if (col < 24576) { const int l = col / 6144; cw = col % 6144; W = F.in[2] + (size_t)l * 1024 * 6144; ldw = 6144; bias = F.in[3] + l * 6144; dst0 = MOD + (l * 2 + 0) * 6144 + cw; dst1 = MOD + (l * 2 + 1) * 6144 + cw; }
        else { cw = col - 24576; W = F.in[30]; ldw = 2048; bias = F.in[31]; dst0 = MODKV + cw; dst1 = MODKV + 2048 + cw; }
        const int c4 = F.tid & 31, ks = F.tid >> 5;
        f32x4 a0 = {0.f, 0.f, 0.f, 0.f}, a1 = {0.f, 0.f, 0.f, 0.f};
#pragma unroll 8
        for (int k = ks * 64; k < ks * 64 + 64; ++k) { const f32x4 w = *(const f32x4*)(W + (size_t)k * ldw + cw + c4 * 4); a0 += w * ca[k]; a1 += w * ca[1024 + k]; }
        *(LAS f32x4*)(red + (ks * 32 + c4) * 8) = a0; *(LAS f32x4*)(red + (ks * 32 + c4) * 8 + 4) = a1;
        __syncthreads();
        if (F.tid < 256) { const int b = F.tid >> 7, c = F.tid & 127; float s = 0.f;
#pragma unroll
            for (int q = 0; q < 16; ++q) s += red[(q * 32 + (c >> 2)) * 8 + b * 4 + (c & 3)];
            (b ? dst1 : dst0)[c] = s + bias[cw + c]; }
        __syncthreads();
    }
}
__device__ __forceinline__ void p0_weights(Frame& F) {
    LAS float* scr = (LAS float*)(F.lds + 16384 + F.wave * 16384);
    const int gw = F.vcu * NWAVES + F.wave, NGW = F.G * NWAVES;
    bf16* W1 = (bf16*)(F.ws + WS_W1); bf16* WO = (bf16*)(F.ws + WS_WO); bf16* WKV = (bf16*)(F.ws + WS_WKV); bf16* WQG = (bf16*)(F.ws + WS_WQG); bf16* WO2 = (bf16*)(F.ws + WS_WO2);
    const float* mu = F.in[8];
    constexpr int PL = 512 * 3 + 32 + 32 + 16 + 80 + 512;
    constexpr int NIT = 2 * PL + 512 + 512 + 16 + 2 * (1024 + 512);
    for (int it = gw; it < NIT; it += NGW) {
        int r = it;
        if (r < 2 * PL) { const int i = r / PL; r -= i * PL; bf16* w1 = W1 + (size_t)i * N1 * K1; const float* m6 = mu + i * 6 * 1024;
            bf16* wl = w1 + (size_t)3072 * 1024;
            if (r < 512) { tr_item(F.in[9] + (size_t)i * D * D, D, D, w1, D, 0, 0, nullptr, scr, r, F.lane); continue; } r -= 512;
            if (r < 512) { tr_item(F.in[10] + (size_t)i * D * D, D, D, w1, D, 1024, 0, nullptr, scr, r, F.lane); continue; } r -= 512;
            if (r < 512) { tr_item(F.in[11] + (size_t)i * D * D, D, D, w1, D, 2048, 0, nullptr, scr, r, F.lane); continue; } r -= 512;
            if (r < 32) { tr_item(F.in[14] + (size_t)i * D * 64, 64, 64, wl, K1, 0, 0, m6 + 1 * 1024, scr, r, F.lane); continue; } r -= 32;
            if (r < 32) { tr_item(F.in[17] + (size_t)i * D * 64, 64, 64, wl, K1, 64, 0, m6 + 4 * 1024, scr, r, F.lane); continue; } r -= 32;
            if (r < 16) { if (i == 1) tr_item(F.in[27], 32, 32, wl, K1, 128, 0, m6 + 3 * 1024, scr, r, F.lane); continue; } r -= 16;
            if (r < 80) { tr_item(F.in[19] + (size_t)i * D * 160, 160, 160, wl, K1, 160, 0, m6 + 5 * 1024, scr, r, F.lane); continue; } r -= 80;
            tr_item(F.in[12] + (size_t)i * D * D, D, D, WO + (size_t)i * D * D, D, 0, 0, nullptr, scr, r, F.lane); continue; }
        r -= 2 * PL;
        if (r < 512) { tr_item(F.in[32], 2064, 1024, WKV, D, 0, 0, nullptr, scr, r, F.lane); continue; } r -= 512;
        if (r < 512) { tr_item(F.in[32] + 1024, 2064, 1024, WKV, D, 1024, 0, nullptr, scr, r, F.lane); continue; } r -= 512;
        if (r < 16) { tr_item(F.in[32] + 2048, 2064, 16, WKV, D, 2048, 0, nullptr, scr, r, F.lane); continue; } r -= 16;
        { const int j = r / 1536; r -= j * 1536;
          if (r < 1024) tr_item(F.in[35] + (size_t)j * D * 2048, 2048, 2048, WQG + (size_t)j * 2048 * D, D, 0, 0, nullptr, scr, r, F.lane);
          else tr_item(F.in[37] + (size_t)j * D * D, D, D, WO2 + (size_t)j * D * D, D, 0, 0, nullptr, scr, r - 1024, F.lane); }
    }
    const int gt = F.bx * 512 + F.tid, NT = F.G * 512; const v4u z = {0u, 0u, 0u, 0u};
    for (int e = gt; e < 135168; e += NT) {
        int r = e; bf16* p;
        if (r < 98304) { const int i = r / 49152; r -= i * 49152; p = W1 + (size_t)i * N1 * K1 + (size_t)3072 * 1024 + (size_t)320 * K1 + (size_t)r * 8; }
        else if (r < 98304 + 8192) { r -= 98304; p = W1 + (size_t)3072 * 1024 + (size_t)128 * K1 + (size_t)r * 8; }
        else { r -= 98304 + 8192; p = WKV + (size_t)2080 * D + (size_t)r * 8; }
        *(v4u*)p = z; }
    { float* B2 = (float*)(F.ws + WS_MOD) + 53248;
      for (int e = gt; e < 2 * 3072; e += NT) { const int i = e / 3072, n = e % 3072, grp = n >> 10, c = n & 1023;
          B2[e] = grp == 0 ? F.in[13][i * D + c] : (grp == 1 ? F.in[16][i * D + c] : (i == 1 ? F.in[26][c] : 0.f)); } }
    bf16* W2A = (bf16*)(F.ws + WS_W2A); bf16* W2G = (bf16*)(F.ws + WS_W2G);
    for (int e4 = gt; e4 < 2 * 262144; e4 += NT) {
        const int i = e4 >> 18; int r = (e4 & 262143) * 4;
        if (r < 786432) { const int k = r / 3072, n = r % 3072, grp = n >> 10, c = n & 1023; f32x4 v = {0.f, 0.f, 0.f, 0.f};
            if (grp == 0) { if (k < 64) v = *(const f32x4*)(F.in[15] + ((size_t)i * 64 + k) * 1024 + c); }
            else if (grp == 1) { if (k >= 64 && k < 128) v = *(const f32x4*)(F.in[18] + ((size_t)i * 64 + (k - 64)) * 1024 + c); }
            else { if (i == 1 && k >= 128 && k < 160) v = *(const f32x4*)(F.in[28] + (size_t)(k - 128) * 1024 + c); }
            bf16* o = W2A + (size_t)i * 3072 * 256 + (size_t)n * 256 + k; const unsigned p0 = pkbf(v.x, v.y), p1 = pkbf(v.z, v.w);
            o[0] = (bf16)(p0 & 0xffffu); o[256] = (bf16)(p0 >> 16); o[512] = (bf16)(p1 & 0xffffu); o[768] = (bf16)(p1 >> 16); }
        else { r -= 786432; const int k = r >> 10, n = r & 1023; f32x4 v = {0.f, 0.f, 0.f, 0.f}; if (k < 160) v = *(const f32x4*)(F.in[20] + ((size_t)i * 160 + k) * 1024 + n);
            bf16* o = W2G + (size_t)i * 1024 * 256 + (size_t)n * 256 + k; const unsigned p0 = pkbf(v.x, v.y), p1 = pkbf(v.z, v.w);
            o[0] = (bf16)(p0 & 0xffffu); o[256] = (bf16)(p0 >> 16); o[512] = (bf16)(p1 & 0xffffu); o[768] = (bf16)(p1 >> 16); }
    }
}
__device__ __forceinline__ void mlp_weights(Frame& F, int L) {
    LAS float* scr = (LAS float*)(F.lds + F.wave * 16384);
    const int gw = F.vcu * NWAVES + F.wave, NGW = F.G * NWAVES;
    bf16* WUP = (bf16*)(F.ws + WS_WUP); bf16* WDN = (bf16*)(F.ws + WS_WDN);
    for (int it = gw; it < 4096; it += NGW) {
        if (it < 2048) tr_item(F.in[6] + (size_t)L * D * FF, FF, FF, WUP, D, 0, 0, nullptr, scr, it, F.lane);
        else tr_item(F.in[7] + (size_t)L * FF * D, D, D, WDN, FF, 0, 0, nullptr, scr, it - 2048, F.lane);
    }
}
__device__ __forceinline__ void norm_phase(Frame& F, const float* xin, const float* g, const float* sh, const float* sc, int bstride, int mode, bf16* dst, float* outf = nullptr) {
    const int gw = F.vcu * NWAVES + F.wave, NGW = F.G * NWAVES, lane = F.lane; (void)mode;
    for (int base = gw * 8; base < M; base += NGW * 8) {
        const int b = base >> 13;
        f32x4 gg[4], aa[4], bb[4];
#pragma unroll
        for (int j = 0; j < 4; ++j) { gg[j] = *((const f32x4*)g + lane + 64 * j);
            aa[j] = sc ? *((const f32x4*)(sc + b * bstride) + lane + 64 * j) + 1.0f : (f32x4){1.f, 1.f, 1.f, 1.f}; bb[j] = sh ? *((const f32x4*)(sh + b * bstride) + lane + 64 * j) : (f32x4){0.f, 0.f, 0.f, 0.f}; }
        f32x4 xn[4];
#pragma unroll
        for (int j = 0; j < 4; ++j) xn[j] = *((const f32x4*)(xin + (size_t)base * D) + lane + 64 * j);
#pragma unroll 1
        for (int r = 0; r < 8; ++r) { const int m = base + r; f32x4 v[4]; float s = 0.f;
#pragma unroll
            for (int j = 0; j < 4; ++j) { v[j] = xn[j]; s += (v[j].x * v[j].x + v[j].y * v[j].y) + (v[j].z * v[j].z + v[j].w * v[j].w); }
            if (r + 1 < 8) {
#pragma unroll
                for (int j = 0; j < 4; ++j) xn[j] = *((const f32x4*)(xin + (size_t)(m + 1) * D) + lane + 64 * j); }
            const float rstd = 1.0f / sqrtf(wave_sum(s) * (1.f / D) + 1e-6f);
#pragma unroll
            for (int j = 0; j < 4; ++j) v[j] = (v[j] * rstd * gg[j]) * aa[j] + bb[j];
            if (outf) {
#pragma unroll
                for (int j = 0; j < 4; ++j) *((f32x4*)(outf + (size_t)m * D) + lane + 64 * j) = v[j]; }
            else st_row_bf16(dst + (size_t)m * 1024, lane, v);
        }
    }
}
__device__ __forceinline__ void norm_mix_phase(Frame& F, const float* xin, const float* g, const float* sh, const float* sc, const float* mu, bf16* H2p, bf16* XJ) {
    const int gw = F.vcu * NWAVES + F.wave, NGW = F.G * NWAVES, lane = F.lane;
    for (int base = gw * 8; base < M; base += NGW * 8) {
        const int b = base >> 13;
        f32x4 gg[4], aa[4], bb[4], m0[4], m1[4], m2[4];
#pragma unroll
        for (int j = 0; j < 4; ++j) { gg[j] = *((const f32x4*)g + lane + 64 * j); aa[j] = *((const f32x4*)(sc + b * 6144) + lane + 64 * j) + 1.0f; bb[j] = *((const f32x4*)(sh + b * 6144) + lane + 64 * j);
            m0[j] = *((const f32x4*)mu + lane + 64 * j); m1[j] = *((const f32x4*)(mu + 2048) + lane + 64 * j); m2[j] = *((const f32x4*)(mu + 3072) + lane + 64 * j); }
        const bool first = (base & 8191) == 0; const int r0 = first ? 0 : -1;
        f32x4 hp[4], xn[4];
#pragma unroll
        for (int j = 0; j < 4; ++j) { hp[j] = (f32x4){0.f, 0.f, 0.f, 0.f}; xn[j] = *((const f32x4*)(xin + (size_t)(base + r0) * D) + lane + 64 * j); }
#pragma unroll 1
        for (int r = r0; r < 8; ++r) { const int m = base + r; f32x4 v[4];
            float s = 0.f;
#pragma unroll
            for (int j = 0; j < 4; ++j) { v[j] = xn[j]; s += (v[j].x * v[j].x + v[j].y * v[j].y) + (v[j].z * v[j].z + v[j].w * v[j].w); }
            if (r + 1 < 8) {
#pragma unroll
                for (int j = 0; j < 4; ++j) xn[j] = *((const f32x4*)(xin + (size_t)(m + 1) * D) + lane + 64 * j); }
            const float rstd = 1.0f / sqrtf(wave_sum(s) * (1.f / D) + 1e-6f);
#pragma unroll
            for (int j = 0; j < 4; ++j) v[j] = (v[j] * rstd * gg[j]) * aa[j] + bb[j];
            if (r >= 0) {
                st_row_bf16(H2p + (size_t)m * 2048, lane, v); st_row_bf16(H2p + (size_t)m * 2048 + 1024, lane, hp);
                f32x4 x[4];
#pragma unroll
                for (int j = 0; j < 4; ++j) x[j] = v[j] + (hp[j] - v[j]) * m0[j];
                st_row_bf16(XJ + (size_t)m * D, lane, x);
#pragma unroll
                for (int j = 0; j < 4; ++j) x[j] = v[j] + (hp[j] - v[j]) * m1[j];
                st_row_bf16(XJ + (size_t)M * D + (size_t)m * D, lane, x);
#pragma unroll
                for (int j = 0; j < 4; ++j) x[j] = v[j] + (hp[j] - v[j]) * m2[j];
                st_row_bf16(XJ + (size_t)2 * M * D + (size_t)m * D, lane, x);
            }
#pragma unroll
            for (int j = 0; j < 4; ++j) hp[j] = v[j]; }
    }
}
__device__ __forceinline__ void final_norm_phase(Frame& F) { norm_phase(F, F.out, F.in[38], nullptr, nullptr, 0, 1, nullptr, F.out); }
#ifndef PROBE_SC
#define PROBE_SC 0
#endif
constexpr int SC_C = 32, SC_NC = T / SC_C;
constexpr int SC_VEC = 0, SC_REC = 36864, SC_Y = 38912, SC_BUF = 55296;
typedef float f32x2s __attribute__((ext_vector_type(2)));
__device__ __forceinline__ float dot4(const f32x4 s, const f32x4 a) { f32x2s t = (f32x2s){s.x, s.y} * (f32x2s){a.x, a.y}; t = (f32x2s){s.z, s.w} * (f32x2s){a.z, a.w} + t; return t.x + t.y; }
__device__ __forceinline__ void scan_chunk(const LAS unsigned char* Bc, f32x4& S, const int kq, const int rowi) {
                const LAS f32x4* pvec = (const LAS f32x4*)(Bc + SC_VEC) + kq; const LAS f32x4* prec = (const LAS f32x4*)(Bc + SC_REC) + rowi;
                LAS float* py = (LAS float*)(Bc + SC_Y) + rowi * 16 + kq;
                f32x4 cv[9], cs;
#pragma unroll
                for (int j = 0; j < 9; ++j) cv[j] = pvec[j * 16];
                cs = prec[0];
#pragma unroll
                for (int p = 0; p < SC_C / 2; ++p) {
                    f32x4 nv[9], ns;
                    if (p + 1 < SC_C / 2) {
#pragma unroll
                        for (int j = 0; j < 9; ++j) nv[j] = pvec[((p + 1) * 9 + j) * 16];
                        ns = prec[(p + 1) * 8];
                    }
                    __builtin_amdgcn_sched_barrier(0);
                    float p1 = dot4(S, cv[0]), p2 = dot4(S, cv[1]); const float p3 = dot4(S, cv[2]);
                    p1 += dpp_f(p1, 0); p2 += dpp_f(p2, 0);
                    p1 += dpp_f(p1, 1); p2 += dpp_f(p2, 1);
                    p1 += dpp_f(p1, 2); p2 += dpp_f(p2, 2);
                    p1 += dpp_f(p1, 3); p2 += dpp_f(p2, 3);
                    const float sa1 = fmaf(cs.x, cs.z, p2);
                    const float y0 = p3 + ((kq == 0) ? cs.x * cs.w : 0.f);
                    const f32x4 t0 = S * cv[3] + cv[4] * p1 + cv[5] * cs.x + cv[7] * cs.y;
                    S = t0 + cv[6] * sa1;
                    const float y1 = dot4(S, cv[8]);
                    py[(2 * p) * 128] = y0; py[(2 * p + 1) * 128] = y1;
                    if (p + 1 < SC_C / 2) {
#pragma unroll
                        for (int j = 0; j < 9; ++j) cv[j] = nv[j];
                        cs = ns;
                    }
                }
}
__device__ __forceinline__ void scan_phase(Frame& F, int L) {
    const bf16* P1 = (const bf16*)(F.ws + WS_P1); const bf16* P2 = (const bf16*)(F.ws + WS_P2); const bf16* VF = (const bf16*)(F.ws + WS_VF); float* Y = (float*)(F.ws + WS_H2);
    const float* kkw = F.in[21] + L * D; const float* kaw = F.in[22] + L * D; const float* rkw_ = F.in[23] + L * D; float* BD = (float*)(F.ws + WS_FL);
    const int lane = F.lane;
    int wave;
    { LAS unsigned* tb = (LAS unsigned*)(F.lds + LDS_BYTES - 2048);
      const unsigned simd = ((unsigned)__builtin_amdgcn_s_getreg((1 << 11) | (4 << 6) | 4)) & 3u;
      if (lane == 0) tb[F.wave] = simd;
      __syncthreads();
      unsigned sd[8];
#pragma unroll
      for (int w = 0; w < 8; ++w) sd[w] = tb[w];
      int B = 1;
#pragma unroll
      for (int w = 7; w >= 1; --w) if (sd[w] != sd[0]) B = w;
      int total_non = 0, non_before = 0, share_before = 0; bool my_share = false;
#pragma unroll
      for (int w = 1; w < 8; ++w) { const bool sh = (sd[w] == sd[0]) || (sd[w] == sd[B]); const bool other = (w != B);
          if (other && !sh) { ++total_non; if (w < F.wave) ++non_before; }
          if (other && sh && w < F.wave) ++share_before;
          if (w == F.wave) my_share = sh; }
      int role;
      if (F.wave == 0) role = 0; else if (F.wave == B) role = 1; else role = my_share ? (2 + total_non + share_before) : (2 + non_before);
      wave = __builtin_amdgcn_readfirstlane(role);
      __syncthreads(); }
    for (int item = F.bx; item < 256; item += F.G) {
        const int bh = (item & 7) + 8 * (item >> 6), rg = (item >> 3) & 7, b = bh >> 4, h = bh & 15;
        const size_t m0 = (size_t)b * T;
        const int hidx = (wave - 2) * 64 + lane, hp = (hidx >> 4) & 15, hc4 = hidx & 15;
        const int vtt = lane >> 1, vr4 = (lane & 1) * 4;
        float ckk[4], cka[4], crk[4];
        v2u lr[2][2], lk[2][2], lw[2][2], la[2][2]; v2u lv[2], lvm[2], lvf[2];
#pragma unroll
        for (int q = 0; q < 2; ++q) { lv[q] = (v2u){0u,0u}; lvm[q] = (v2u){0u,0u}; lvf[q] = (v2u){0u,0u};
#pragma unroll
            for (int u = 0; u < 2; ++u) { lr[q][u] = (v2u){0u,0u}; lk[q][u] = (v2u){0u,0u}; lw[q][u] = (v2u){0u,0u}; la[q][u] = (v2u){0u,0u}; } }
        if (wave >= 2 && wave < 6) {
#pragma unroll
            for (int j = 0; j < 4; ++j) { ckk[j] = kkw[h * 64 + hc4 * 4 + j]; cka[j] = kaw[h * 64 + hc4 * 4 + j]; crk[j] = rkw_[h * 64 + hc4 * 4 + j]; } }
#define SC_LOAD(c, Q) do { \
        if (wave >= 2 && wave < 6) { _Pragma("unroll") for (int u = 0; u < 2; ++u) { const size_t m = m0 + (size_t)(c) * SC_C + 2 * hp + u; const bf16* p1 = P1 + m * N1 + h * 64 + hc4 * 4; const bf16* p2 = P2 + m * NP2 + h * 64 + hc4 * 4; \
            lr[Q][u] = *(const v2u*)p1; lk[Q][u] = *(const v2u*)(p1 + 1024); lw[Q][u] = *(const v2u*)p2; la[Q][u] = *(const v2u*)(p2 + 1024); } } \
        else if (wave == 6) { const size_t m = m0 + (size_t)(c) * SC_C + vtt; const int cc = h * 64 + rg * 8 + vr4; \
            lv[Q] = *(const v2u*)(P1 + m * N1 + 2048 + cc); if (L == 1) { lvm[Q] = *(const v2u*)(P2 + m * NP2 + 2048 + cc); lvf[Q] = *(const v2u*)(VF + m * D + cc); } } } while (0)
#define SC_PREP(buf, Q, CC) do { LAS unsigned char* B_ = F.lds + (buf) * SC_BUF; \
        if (wave >= 2 && wave < 6) { f32x4 an[2], bb[2], k2[2], ww[2], rr[2]; \
            _Pragma("unroll") for (int u = 0; u < 2; ++u) { \
                const float kr[4] = {bflo(lk[Q][u].x), bfhi(lk[Q][u].x), bflo(lk[Q][u].y), bfhi(lk[Q][u].y)}, av[4] = {bflo(la[Q][u].x), bfhi(la[Q][u].x), bflo(la[Q][u].y), bfhi(la[Q][u].y)}; \
                const float wn[4] = {bflo(lw[Q][u].x), bfhi(lw[Q][u].x), bflo(lw[Q][u].y), bfhi(lw[Q][u].y)}, rv[4] = {bflo(lr[Q][u].x), bfhi(lr[Q][u].x), bflo(lr[Q][u].y), bfhi(lr[Q][u].y)}; \
                float kv_[4], ss = 0.f; \
                _Pragma("unroll") for (int j = 0; j < 4; ++j) { kv_[j] = kr[j] * ckk[j]; ss += kv_[j] * kv_[j]; } \
                ss = sum16(ss); const float inv = 1.0f / fmaxf(sqrtf(ss), 1e-12f); \
                _Pragma("unroll") for (int j = 0; j < 4; ++j) { const float kk = kv_[j] * inv; an[u][j] = -kk; bb[u][j] = kk * av[j]; k2[u][j] = kr[j] * (1.0f + (av[j] - 1.0f) * cka[j]); ww[u][j] = __expf(wn[j]); rr[u][j] = rv[j]; } } \
            LAS f32x4* V_ = (LAS f32x4*)(B_ + SC_VEC) + (hp * 9) * 16 + hc4; \
            float s0 = dot4(bb[0], rr[0]), s1 = dot4(k2[0], rr[0]), s2 = dot4(bb[0], an[1]), s3 = dot4(k2[0], an[1]); \
            s0 = sum16(s0); s1 = sum16(s1); s2 = sum16(s2); s3 = sum16(s3); \
            if (rg == 0) { float b0_ = 0.f, b1_ = 0.f; _Pragma("unroll") for (int j = 0; j < 4; ++j) { b0_ += rr[0][j] * k2[0][j] * crk[j]; b1_ += rr[1][j] * k2[1][j] * crk[j]; } b0_ = sum16(b0_); b1_ = sum16(b1_); \
                if (hc4 == 0) { float* bp_ = BD + (m0 + (size_t)(CC) * SC_C + 2 * hp) * 16 + h; bp_[0] = b0_; bp_[16] = b1_; } } \
            V_[0 * 16] = an[0]; V_[1 * 16] = ww[0] * an[1] + an[0] * s2; V_[2 * 16] = ww[0] * rr[0] + an[0] * s0; V_[3 * 16] = ww[0] * ww[1]; V_[4 * 16] = bb[0] * ww[1]; V_[5 * 16] = k2[0] * ww[1]; V_[6 * 16] = bb[1]; V_[7 * 16] = k2[1]; V_[8 * 16] = rr[1]; \
            if (hc4 == 0) { _Pragma("unroll") for (int row_ = 0; row_ < 8; ++row_) *(LAS f32x2s*)(B_ + SC_REC + (hp * 8 + row_) * 16 + 8) = (f32x2s){s3, s1}; } } \
        else if (wave == 6) { float v_[4] = {bflo(lv[Q].x), bfhi(lv[Q].x), bflo(lv[Q].y), bfhi(lv[Q].y)}; \
            if (L == 1) { const float f_[4] = {bflo(lvf[Q].x), bfhi(lvf[Q].x), bflo(lvf[Q].y), bfhi(lvf[Q].y)}, g_[4] = {bflo(lvm[Q].x), bfhi(lvm[Q].x), bflo(lvm[Q].y), bfhi(lvm[Q].y)}; \
                _Pragma("unroll") for (int j = 0; j < 4; ++j) v_[j] = v_[j] + (f_[j] - v_[j]) * g_[j]; } \
            _Pragma("unroll") for (int j = 0; j < 4; ++j) *(LAS float*)(B_ + SC_REC + ((vtt >> 1) * 8 + vr4 + j) * 16 + (vtt & 1) * 4) = v_[j]; } } while (0)
#define SC_YRED(bufi) f32x4 yv; do { const LAS f32x4* q_ = (const LAS f32x4*)(F.lds + (bufi) * SC_BUF + SC_Y) + (vtt * 8 + vr4) * 4; \
            _Pragma("unroll") for (int r_ = 0; r_ < 4; ++r_) { const f32x4 t0 = q_[r_ * 4], t1 = q_[r_ * 4 + 1], t2 = q_[r_ * 4 + 2], t3 = q_[r_ * 4 + 3]; const f32x4 t = (t0 + t1) + (t2 + t3); yv[r_] = (t.x + t.y) + (t.z + t.w); } } while (0)
        SC_LOAD(0, 0); SC_PREP(0, 0, 0); SC_LOAD(1, 1);
        __syncthreads();
        f32x4 S = {0.f, 0.f, 0.f, 0.f};
        const int rl = lane >> 4, kq = lane & 15, rowi = (wave & 1) * 4 + rl;
#define SC_ITER(c, QL, QP) do { const int buf = (c) & 1; \
            if (wave < 2) { if (PROBE_SC == 2) { f32x4 S2 = S; scan_chunk(F.lds + buf * SC_BUF, S2, kq, rowi); asm volatile("" :: "v"(S2) : "memory"); } scan_chunk(F.lds + buf * SC_BUF, S, kq, rowi); } \
            else { if ((c) + 2 < SC_NC) SC_LOAD((c) + 2, QL); \
                if ((c) + 1 < SC_NC) SC_PREP(buf ^ 1, QP, (c) + 1); \
                if (PROBE_SC == 1 && (c) + 1 < SC_NC) { asm volatile("" ::: "memory"); SC_PREP(buf ^ 1, QP, (c) + 1); } \
                if (wave == 7 && (c) > 0) { SC_YRED(buf ^ 1); *(f32x4*)(Y + (m0 + (size_t)((c) - 1) * SC_C + vtt) * D + h * 64 + rg * 8 + vr4) = yv; } } \
            asm volatile("s_waitcnt lgkmcnt(0)\n\ts_barrier" ::: "memory"); } while (0)
        for (int c = 0; c < SC_NC; c += 2) { SC_ITER(c, 0, 1); SC_ITER(c + 1, 1, 0); }
#undef SC_ITER
        if (wave == 7) { SC_YRED((SC_NC - 1) & 1);
            *(f32x4*)(Y + (m0 + (size_t)(SC_NC - 1) * SC_C + vtt) * D + h * 64 + rg * 8 + vr4) = yv; }
        __syncthreads();
#undef SC_LOAD
#undef SC_PREP
#undef SC_YRED
    }
}
__device__ __forceinline__ void post_phase(Frame& F, int L) {
    const bf16* P1 = (const bf16*)(F.ws + WS_P1); const bf16* P2 = (const bf16*)(F.ws + WS_P2); bf16* VF = (bf16*)(F.ws + WS_VF); float* Y = (float*)(F.ws + WS_H2);
    const int gw = F.vcu * NWAVES + F.wave, NGW = F.G * NWAVES, lane = F.lane, c0 = lane * 16;
    const float* lnw = F.in[24] + L * D + c0; const float* lnb = F.in[25] + L * D + c0;
    for (int m = gw; m < M; m += NGW) {
        float y[16], v[16];
        const float* yp = Y + (size_t)m * D + c0;
#pragma unroll
        for (int q = 0; q < 4; ++q) { const f32x4 t = *(const f32x4*)(yp + 4 * q); y[4 * q] = t.x; y[4 * q + 1] = t.y; y[4 * q + 2] = t.z; y[4 * q + 3] = t.w; }
        const bf16* p1 = P1 + (size_t)m * N1 + c0; const bf16* p2 = P2 + (size_t)m * NP2 + c0;
        const float bd = ((const float*)(F.ws + WS_FL))[(size_t)m * 16 + (lane >> 2)];
        v4u vv[2];
#pragma unroll
        for (int q = 0; q < 2; ++q) vv[q] = *(const v4u*)(p1 + 2048 + 8 * q);
#pragma unroll
        for (int q = 0; q < 2; ++q)
#pragma unroll
            for (int j = 0; j < 4; ++j) { v[8 * q + 2 * j] = bflo(vv[q][j]); v[8 * q + 2 * j + 1] = bfhi(vv[q][j]); }
        if (L == 0) { *(v4u*)(VF + (size_t)m * D + c0) = vv[0]; *(v4u*)(VF + (size_t)m * D + c0 + 8) = vv[1]; }
        else { v4u fv[2], gv[2];
#pragma unroll
            for (int q = 0; q < 2; ++q) { fv[q] = *(const v4u*)(VF + (size_t)m * D + c0 + 8 * q); gv[q] = *(const v4u*)(p2 + 2048 + 8 * q); }
#pragma unroll
            for (int q = 0; q < 2; ++q)
#pragma unroll
                for (int j = 0; j < 4; ++j) { const float f0 = bflo(fv[q][j]), f1 = bfhi(fv[q][j]), g0 = bflo(gv[q][j]), g1 = bfhi(gv[q][j]);
                    v[8 * q + 2 * j] += (f0 - v[8 * q + 2 * j]) * g0; v[8 * q + 2 * j + 1] += (f1 - v[8 * q + 2 * j + 1]) * g1; } }
        float s = 0.f;
#pragma unroll
        for (int j = 0; j < 16; ++j) s += y[j];
        s = sum4(s);
        const float mean = s * (1.0f / 64.0f); float q2 = 0.f;
#pragma unroll
        for (int j = 0; j < 16; ++j) { const float d = y[j] - mean; q2 += d * d; }
        q2 = sum4(q2);
        const float rstd = 1.0f / sqrtf(q2 * (1.0f / 64.0f) + 64e-5f);
        float o[16];
#pragma unroll
        for (int j = 0; j < 16; ++j) o[j] = (y[j] - mean) * rstd * lnw[j] + lnb[j] + bd * v[j];
        bf16* yn = (bf16*)(Y + (size_t)m * D) + c0;
        v4u w0, w1; w0.x = pkbf(o[0], o[1]); w0.y = pkbf(o[2], o[3]); w0.z = pkbf(o[4], o[5]); w0.w = pkbf(o[6], o[7]); w1.x = pkbf(o[8], o[9]); w1.y = pkbf(o[10], o[11]); w1.z = pkbf(o[12], o[13]); w1.w = pkbf(o[14], o[15]);
        *(v4u*)yn = w0; *(v4u*)(yn + 8) = w1;
    }
}
__device__ __forceinline__ void kvpost_phase(Frame& F) {
    const bf16* KV = (const bf16*)(F.ws + WS_KVRAW); bf16* KS = (bf16*)(F.ws + WS_KS);
    const int gw = F.vcu * NWAVES + F.wave, NGW = F.G * NWAVES, lane = F.lane, c0 = lane * 16;
    const float* kg = F.in[34] + (c0 & 63);
    for (int m = gw; m < M; m += NGW) {
        const bf16* p = KV + (size_t)m * 2048 + c0; v4u kv[2];
#pragma unroll
        for (int q = 0; q < 2; ++q) kv[q] = *(const v4u*)(p + 8 * q);
        float k[16], ss = 0.f;
#pragma unroll
        for (int q = 0; q < 2; ++q)
#pragma unroll
            for (int j = 0; j < 4; ++j) { k[8 * q + 2 * j] = bflo(kv[q][j]); k[8 * q + 2 * j + 1] = bfhi(kv[q][j]); }
#pragma unroll
        for (int j = 0; j < 16; ++j) ss += k[j] * k[j];
        ss = sum4(ss); const float rs = 1.0f / sqrtf(ss * (1.0f / 64.0f) + 1e-6f);
        v4u w0, w1;
        w0.x = pkbf(k[0] * rs * kg[0], k[1] * rs * kg[1]); w0.y = pkbf(k[2] * rs * kg[2], k[3] * rs * kg[3]); w0.z = pkbf(k[4] * rs * kg[4], k[5] * rs * kg[5]); w0.w = pkbf(k[6] * rs * kg[6], k[7] * rs * kg[7]);
        w1.x = pkbf(k[8] * rs * kg[8], k[9] * rs * kg[9]); w1.y = pkbf(k[10] * rs * kg[10], k[11] * rs * kg[11]); w1.z = pkbf(k[12] * rs * kg[12], k[13] * rs * kg[13]); w1.w = pkbf(k[14] * rs * kg[14], k[15] * rs * kg[15]);
        *(v4u*)(KS + (size_t)m * D + c0) = w0; *(v4u*)(KS + (size_t)m * D + c0 + 8) = w1;
    }
    if (gw < 32) {
        const int bh = gw, b = bh >> 4, h = bh & 15; const float* FL = (const float*)(F.ws + WS_FL) + ((size_t)b * T + (size_t)lane * 128) * 16 + h; const float fb = F.in[33][h];
        v4u* G3 = (v4u*)(F.ws + WS_G3) + (size_t)bh * T + (size_t)lane * 128;
        float tot = 0.f;
#pragma unroll 8
        for (int i = 0; i < 128; ++i) { const float x = FL[(size_t)i * 16] + fb; tot += -(fmaxf(-x, 0.f) + log1pf(__expf(-fabsf(x)))); }
        float inc = tot;
#pragma unroll
        for (int o = 1; o < 64; o <<= 1) { const float n = __int_as_float(__builtin_amdgcn_ds_bpermute((lane - o) << 2, __float_as_int(inc))); if (lane >= o) inc += n; }
        float run = inc - tot;
#pragma unroll 8
        for (int i = 0; i < 128; ++i) { const float x = FL[(size_t)i * 16] + fb; run += -(fmaxf(-x, 0.f) + log1pf(__expf(-fabsf(x))));
            const float gv = -run * 1.4426950408889634f;
            const unsigned hi = pkbf(gv, 0.f) & 0xffffu; const float r1 = gv - __uint_as_float(hi << 16);
            const unsigned mid = pkbf(r1, 0.f) & 0xffffu; const float r2 = r1 - __uint_as_float(mid << 16);
            const unsigned lo = pkbf(r2, 0.f) & 0xffffu;
            G3[i] = (v4u){hi | (mid << 16), lo, 0u, 0u}; }
    }
}
constexpr size_t WS_BAR = 512 * 1024, BAR_BYTES = 16384; constexpr int MISC_OFF = LDS_BYTES - 1024;
#define RLX_AGENT __ATOMIC_RELAXED, __HIP_MEMORY_SCOPE_AGENT
#define LDS_WAIT() asm volatile("s_waitcnt lgkmcnt(0)" ::: "memory")
#define VM_WAIT() asm volatile("s_waitcnt vmcnt(0)" ::: "memory")
__device__ __forceinline__ unsigned long long rt() { return __builtin_amdgcn_s_memrealtime(); }
__device__ __forceinline__ unsigned f2bf(float f) { unsigned u = __builtin_bit_cast(unsigned, f); return (u + 0x7fffu + ((u >> 16) & 1u)) >> 16; }
__device__ __forceinline__ unsigned pk2(float lo, float hi) { return f2bf(lo) | (f2bf(hi) << 16); }

#define XB_TMO      128
#define XB_XCNT(j)  (256  + 64 * (j))
#define XB_XSUB(j)  (1280 + 64 * (j))
#define XB_XGEN(j)  (2304 + 64 * (j))
#define XB_TOP      3328
#define XB_TOPGEN   3392
#define XCD_BAR_WORDS 3456
#define XB_SPIN_CAP (1u << 18)

__device__ __forceinline__ unsigned xb_ld(unsigned* p)              { return __hip_atomic_load(p, __ATOMIC_RELAXED, __HIP_MEMORY_SCOPE_AGENT); }
__device__ __forceinline__ unsigned xb_add(unsigned* p, unsigned v) { return __hip_atomic_fetch_add(p, v, __ATOMIC_RELAXED, __HIP_MEMORY_SCOPE_AGENT); }
__device__ __forceinline__ unsigned xb_xcc_id() { return (unsigned)__builtin_amdgcn_s_getreg((3 << 11) | 20) & 0xFu; }
#define XB_SPIN(cond, bar) do { unsigned _sp = 0; while (cond) { __builtin_amdgcn_s_sleep(1); \
    if ((++_sp & 255u) == 0u) { if (xb_ld(&(bar)[XB_TMO])) break; if (_sp > XB_SPIN_CAP) { atomicAdd(&(bar)[XB_TMO], 1u); break; } } } } while (0)

struct XcdBarrier {
    unsigned* bar; unsigned x;
    volatile LAS unsigned* st;
};

__device__ __forceinline__ XcdBarrier xcd_barrier_post(unsigned* bar, volatile LAS unsigned* st, const int tid) {
    XcdBarrier b; b.bar = bar; b.x = xb_xcc_id(); b.st = st;
    if (tid == 0) (void)xb_add(&bar[XB_XCNT(b.x)], 1u);
    return b;
}
__device__ __forceinline__ void xcd_barrier_complete(unsigned* bar, unsigned x, unsigned& nloc, unsigned& nx) {
    const unsigned G = gridDim.x * gridDim.y * gridDim.z;
    unsigned sum, cnt, mine, sp = 0u;
    for (;;) {
        sum = 0u; cnt = 0u; mine = 0u;
#pragma unroll
        for (unsigned j = 0; j < 16; ++j) { const unsigned c = xb_ld(&bar[XB_XCNT(j)]); sum += c; cnt += (c > 0u) ? 1u : 0u; mine = (j == x) ? c : mine; }
        if (sum == G) break;
        __builtin_amdgcn_s_sleep(1);
        if ((++sp & 255u) == 0u) { if (xb_ld(&bar[XB_TMO])) break; if (sp > XB_SPIN_CAP) { atomicAdd(&bar[XB_TMO], 1u); break; } }
    }
    nloc = mine > 0u ? mine : 1u; nx = cnt > 0u ? cnt : 1u;
}

__device__ __forceinline__ void xcd_barrier(const XcdBarrier& b, const int tid) {
    asm volatile("s_waitcnt vmcnt(0)" ::: "memory");
    __syncthreads();
    if (tid == 0) {
        unsigned* bar = b.bar;
        __builtin_amdgcn_s_waitcnt(0);
        unsigned nloc = b.st[0], nx = b.st[1];
        if (nloc == 0u) { xcd_barrier_complete(bar, b.x, nloc, nx); b.st[0] = nloc; b.st[1] = nx; }
        const unsigned old = xb_add(&bar[XB_XSUB(b.x)], 1u);
        const unsigned gen = old / nloc;
        if (old + 1u == (gen + 1u) * nloc) {
            __builtin_amdgcn_fence(__ATOMIC_RELEASE, "agent");
            asm volatile("s_waitcnt vmcnt(0)" ::: "memory");
            const unsigned og = xb_add(&bar[XB_TOP], 1u);
            const unsigned tg = og / nx;
            if (og + 1u == (tg + 1u) * nx) xb_add(&bar[XB_TOPGEN], 1u);
            else XB_SPIN(xb_ld(&bar[XB_TOPGEN]) == tg, bar);
            __builtin_amdgcn_fence(__ATOMIC_ACQUIRE, "agent");
            xb_add(&bar[XB_XGEN(b.x)], 1u);
            asm volatile("s_waitcnt vmcnt(0)" ::: "memory");
        } else {
            XB_SPIN(xb_ld(&bar[XB_XGEN(b.x)]) == gen, bar);
            __builtin_amdgcn_fence(__ATOMIC_ACQUIRE, "agent");
            asm volatile("s_waitcnt vmcnt(0)" ::: "memory");
        }
    }
    __syncthreads();
}
#define GEMM_CALL_K256(FN, Aptr, Bptr, Nn, Kk, LDA, LDB, ...) do { pg8::Gemm g_{(const pg8::bf16_t*)(Aptr), (const pg8::bf16_t*)(Bptr), M, (Nn), (Kk), (LDA), (LDB), 0, (size_t)0}; pg8::StaticOrder S_; S_.init(M, (Nn), F.G, F.bx); \
    pg8::Epi8<pg8::FN> E_{{__VA_ARGS__}}; pg8::gemm_phase<pg8::Epi8<pg8::FN>, pg8::StaticOrder, true, false>(F.lds, g_, S_, E_, F.tid); } while (0)
#define GEMM_CALL(FN, Aptr, Bptr, Nn, Kk, LDA, LDB, ...) GEMM_CALL_G(FN, Aptr, Bptr, Nn, Kk, LDA, LDB, 0, 0, __VA_ARGS__)
#define GEMM_CALL_G(FN, Aptr, Bptr, Nn, Kk, LDA, LDB, AGRP, ASTEP, ...) GEMM_CALL_S(StaticOrder, FN, Aptr, Bptr, Nn, Kk, LDA, LDB, AGRP, ASTEP, __VA_ARGS__)
#define GEMM_CALL_S(ORD, FN, Aptr, Bptr, Nn, Kk, LDA, LDB, AGRP, ASTEP, ...) do { pg8::Gemm g_{(const pg8::bf16_t*)(Aptr), (const pg8::bf16_t*)(Bptr), M, (Nn), (Kk), (LDA), (LDB), (AGRP), (size_t)(ASTEP)}; pg8::ORD S_; S_.init(M, (Nn), F.G, F.bx); \
    pg8::Epi8<pg8::FN> E_{{__VA_ARGS__}}; pg8::gemm_phase<pg8::Epi8<pg8::FN>, pg8::ORD, true, true>(F.lds, g_, S_, E_, F.tid); } while (0)
constexpr int N_PHASES = 42;
__global__ void __launch_bounds__(NWAVES * 64, 2) yoco_fwd(Args args) {
    extern __shared__ __attribute__((aligned(16))) unsigned char lds[];
    cg::grid_group grid = cg::this_grid();
    Frame F;
    const int wave_s = __builtin_amdgcn_readfirstlane((int)threadIdx.x >> 6);
    F.lds = (LAS unsigned char*)lds; F.tid = threadIdx.x; F.lane = F.tid & 63; F.wave = wave_s;
    F.G = gridDim.x; F.bx = blockIdx.x; F.vcu = F.bx;
    F.ws = args.ws; F.out = args.out; F.in = args.in;
    unsigned char* ws = args.ws;
    const int lo = args.ph_lo, hi = args.ph_hi; const bool one = (hi - lo) > 1;
#define LAUNDER() do { int t_ = wave_s * 64 + (int)__builtin_amdgcn_mbcnt_hi(~0u, __builtin_amdgcn_mbcnt_lo(~0u, 0u)); asm volatile("" : "+v"(t_)); F.tid = t_; F.lane = t_ & 63; F.wave = __builtin_amdgcn_readfirstlane(t_ >> 6); \
        int z_ = 0; asm volatile("" : "+v"(z_)); z_ = __builtin_amdgcn_readfirstlane(z_); ws = args.ws + z_; F.ws = ws; F.in = args.in + z_; F.out = args.out + z_; F.bx = (int)blockIdx.x + z_; F.G = (int)gridDim.x + z_; F.vcu = (F.G % 8 == 0) ? (F.bx % 8) * (F.G / 8) + F.bx / 8 : F.bx; } while (0)
#define IN(k) (lo <= (k) && (k) < hi)
#ifndef PROBE_BAR
#define PROBE_BAR 0
#endif
#ifndef PROBE_PH
#define PROBE_PH (-1)
#endif
#define PHASE(k) if (IN(k)) for (int rep_ = 0; rep_ < (((k) == PROBE_PH) ? 2 : 1); ++rep_)
#define SEAM() do { if (one) { unsigned zz_ = 0u; asm volatile("" : "+v"(zz_)); const int st_ = wave_s * 64 + (int)__builtin_amdgcn_mbcnt_hi(~0u, __builtin_amdgcn_mbcnt_lo(~0u, zz_)); xcd_barrier(xbar, st_); if (PROBE_BAR) xcd_barrier(xbar, st_); } } while (0)
#define MOD_ ((float*)(ws + WS_MOD))
#define MODKV_ (MOD_ + 4 * 2 * 6144)
#define H2_ ((bf16*)(ws + WS_H2))
#define XN_ ((bf16*)(ws + WS_H2))
#define XNKV_ ((bf16*)(ws + WS_H2 + 32 * MiB))
#define P1_ ((bf16*)(ws + WS_P1))
#define P2_ ((bf16*)(ws + WS_P2))
#define HB_ ((bf16*)(ws + WS_HB))
#define QB_ ((bf16*)(ws + WS_QB))
#define GT_ ((bf16*)(ws + WS_GT))
#define XIN1_ ((L == 0) ? F.in[0] : (const float*)F.out)
#define MODL_ (MOD_ + L * 2 * 6144)

    volatile LAS unsigned* MISC = (volatile LAS unsigned*)(F.lds + MISC_OFF);
    if (F.tid < 32) MISC[F.tid] = 0u;
    __syncthreads();
    XcdBarrier xbar; xbar.bar = (unsigned*)(args.ws + WS_BAR); xbar.x = 0; xbar.st = MISC + 8;
    if (one) xbar = xcd_barrier_post((unsigned*)(args.ws + WS_BAR), MISC + 8, F.tid);
    PHASE(0) { LAUNDER(); p0_mod(F); p0_weights(F); if (one) grid.sync(); }
    { constexpr int L = 0;
        const int pb = 1 + L * 10;
        if (L < 2) {
            PHASE(pb + 0) { LAUNDER(); norm_mix_phase(F, XIN1_, F.in[4] + L * D, MODL_, MODL_ + 1024, F.in[8] + L * 6 * 1024, H2_, P2_); SEAM(); }
            PHASE(pb + 1) { LAUNDER(); GEMM_CALL(FnP1, H2_, ws + WS_W1 + (size_t)L * N1 * K1 * 2 + (size_t)3072 * 1024 * 2, 512, K1, K1, K1, P1_, 3072);
                LAUNDER();
                if (F.G == 256) GEMM_CALL_S(SplitOrder, FnP1, P2_, ws + WS_W1 + (size_t)L * N1 * K1 * 2, 3072, D, D, D, 4, (size_t)M * D * 2, P1_, 0);
                else GEMM_CALL_G(FnP1, P2_, ws + WS_W1 + (size_t)L * N1 * K1 * 2, 3072, D, D, D, 4, (size_t)M * D * 2, P1_, 0);
                SEAM(); }
            PHASE(pb + 2) { LAUNDER(); GEMM_CALL_K256(FnP2, P1_ + 3072, ws + WS_W2A + (size_t)L * 3072 * 256 * 2, (L == 0 ? 2048 : NP2), 256, N1, 256, P2_, MOD_ + 53248 + L * 3072); SEAM(); }
            PHASE(pb + 3) { LAUNDER(); scan_phase(F, L); SEAM(); }
            PHASE(pb + 4) { LAUNDER(); post_phase(F, L); SEAM(); }
            PHASE(pb + 5) { LAUNDER(); GEMM_CALL_K256(FnGate, P1_ + 3232, ws + WS_W2G + (size_t)L * 1024 * 256 * 2, D, 256, N1, 256, H2_, 2048); SEAM(); }
            PHASE(pb + 6) { LAUNDER(); GEMM_CALL(FnRes, H2_, ws + WS_WO + (size_t)L * D * D * 2, D, D, 2048, D, XIN1_, F.out, MODL_ + 2 * 1024); SEAM(); }
        } else {
            const int j = L - 2;
            PHASE(pb + 0) { LAUNDER(); norm_phase(F, F.out, F.in[4] + L * D, MODL_, MODL_ + 1024, 6144, 1, XN_);
                if (L == 2) norm_phase(F, F.out, F.in[29], MODKV_, MODKV_ + 1024, 2048, 1, XNKV_);
                SEAM(); }
            PHASE(pb + 1) { LAUNDER();
                if (L == 2) GEMM_CALL(FnKv, XNKV_, ws + WS_WKV, 2304, D, D, D, (bf16*)(ws + WS_KVRAW), (float*)(ws + WS_FL), (bf16*)(ws + WS_VS));
                LAUNDER();
                GEMM_CALL(FnQg, XN_, ws + WS_WQG + (size_t)j * 2048 * D * 2, 2048, D, D, D, QB_, GT_); SEAM(); }
            if (L == 2) PHASE(pb + 2) { LAUNDER(); kvpost_phase(F); SEAM(); }
            PHASE(pb + 3) { LAUNDER();
                float kb_; { float g_ = fabsf(F.in[34][F.lane]); g_ = fmaxf(g_, dpp_f(g_, 0)); g_ = fmaxf(g_, dpp_f(g_, 1)); g_ = fmaxf(g_, dpp_f(g_, 2)); g_ = fmaxf(g_, dpp_f(g_, 3));
                  { auto rr = __builtin_amdgcn_permlane16_swap(__float_as_uint(g_), __float_as_uint(g_), false, false); g_ = fmaxf(__uint_as_float(rr[0]), __uint_as_float(rr[1])); }
                  { auto rr = __builtin_amdgcn_permlane32_swap(__float_as_uint(g_), __float_as_uint(g_), false, false); g_ = fmaxf(__uint_as_float(rr[0]), __uint_as_float(rr[1])); }
                  kb_ = 8.0f * 1.02f * g_; }
                const attn_body::AttnTensors AT{(const attn_body::bf16*)QB_, (const attn_body::bf16*)(ws + WS_KS), (const attn_body::bf16*)(ws + WS_VS), (attn_body::bf16*)((PROBE_PH == pb + 3 && rep_ == 0) ? (bf16*)(ws + WS_KVRAW) : QB_), (const attn_body::bf16*)GT_, (const unsigned char*)(ws + WS_G3), F.in[36] + j * 64, kb_};
                float thr2_; { float g_ = fabsf(F.in[36][j * 64 + F.lane]); g_ = fmaxf(g_, dpp_f(g_, 0)); g_ = fmaxf(g_, dpp_f(g_, 1)); g_ = fmaxf(g_, dpp_f(g_, 2)); g_ = fmaxf(g_, dpp_f(g_, 3));
                  { auto rr = __builtin_amdgcn_permlane16_swap(__float_as_uint(g_), __float_as_uint(g_), false, false); g_ = fmaxf(__uint_as_float(rr[0]), __uint_as_float(rr[1])); }
                  { auto rr = __builtin_amdgcn_permlane32_swap(__float_as_uint(g_), __float_as_uint(g_), false, false); g_ = fmaxf(__uint_as_float(rr[0]), __uint_as_float(rr[1])); }
                  thr2_ = 64.0f + 2.0f * kb_ * attn_body::C2 * 8.16f * g_; }
                attn_body::attn_phase_dyn<8>((char*)lds, AT, (unsigned*)(ws + WS_BAR) + 3600 + j * 64, thr2_, F.tid);
                SEAM(); }
            PHASE(pb + 6) { LAUNDER(); GEMM_CALL(FnRes, QB_, ws + WS_WO2 + (size_t)j * D * D * 2, D, D, D, D, (const float*)F.out, F.out, MODL_ + 2 * 1024); SEAM(); }
        }
        PHASE(pb + 7) { LAUNDER(); mlp_weights(F, L); norm_phase(F, F.out, F.in[5] + L * D, MODL_ + 3 * 1024, MODL_ + 4 * 1024, 6144, 1, XN_); SEAM(); }
        PHASE(pb + 8) { LAUNDER(); GEMM_CALL(FnUp, XN_, ws + WS_WUP, FF, D, D, D, HB_); SEAM(); }
        PHASE(pb + 9) { LAUNDER(); GEMM_CALL(FnRes, HB_, ws + WS_WDN, D, FF, FF, FF, (const float*)F.out, F.out, MODL_ + 5 * 1024); SEAM(); }
        }
    { constexpr int L = 1;
        const int pb = 1 + L * 10;
        if (L < 2) {
            PHASE(pb + 0) { LAUNDER(); norm_mix_phase(F, XIN1_, F.in[4] + L * D, MODL_, MODL_ + 1024, F.in[8] + L * 6 * 1024, H2_, P2_); SEAM(); }
            PHASE(pb + 1) { LAUNDER(); GEMM_CALL(FnP1, H2_, ws + WS_W1 + (size_t)L * N1 * K1 * 2 + (size_t)3072 * 1024 * 2, 512, K1, K1, K1, P1_, 3072);
                LAUNDER();
                if (F.G == 256) GEMM_CALL_S(SplitOrder, FnP1, P2_, ws + WS_W1 + (size_t)L * N1 * K1 * 2, 3072, D, D, D, 4, (size_t)M * D * 2, P1_, 0);
                else GEMM_CALL_G(FnP1, P2_, ws + WS_W1 + (size_t)L * N1 * K1 * 2, 3072, D, D, D, 4, (size_t)M * D * 2, P1_, 0);
                SEAM(); }
            PHASE(pb + 2) { LAUNDER(); GEMM_CALL_K256(FnP2, P1_ + 3072, ws + WS_W2A + (size_t)L * 3072 * 256 * 2, (L == 0 ? 2048 : NP2), 256, N1, 256, P2_, MOD_ + 53248 + L * 3072); SEAM(); }
            PHASE(pb + 3) { LAUNDER(); scan_phase(F, L); SEAM(); }
            PHASE(pb + 4) { LAUNDER(); post_phase(F, L); SEAM(); }
            PHASE(pb + 5) { LAUNDER(); GEMM_CALL_K256(FnGate, P1_ + 3232, ws + WS_W2G + (size_t)L * 1024 * 256 * 2, D, 256, N1, 256, H2_, 2048); SEAM(); }
            PHASE(pb + 6) { LAUNDER(); GEMM_CALL(FnRes, H2_, ws + WS_WO + (size_t)L * D * D * 2, D, D, 2048, D, XIN1_, F.out, MODL_ + 2 * 1024); SEAM(); }
        } else {
            const int j = L - 2;
            PHASE(pb + 0) { LAUNDER(); norm_phase(F, F.out, F.in[4] + L * D, MODL_, MODL_ + 1024, 6144, 1, XN_);
                if (L == 2) norm_phase(F, F.out, F.in[29], MODKV_, MODKV_ + 1024, 2048, 1, XNKV_);
                SEAM(); }
            PHASE(pb + 1) { LAUNDER();
                if (L == 2) GEMM_CALL(FnKv, XNKV_, ws + WS_WKV, 2304, D, D, D, (bf16*)(ws + WS_KVRAW), (float*)(ws + WS_FL), (bf16*)(ws + WS_VS));
                LAUNDER();
                GEMM_CALL(FnQg, XN_, ws + WS_WQG + (size_t)j * 2048 * D * 2, 2048, D, D, D, QB_, GT_); SEAM(); }
            if (L == 2) PHASE(pb + 2) { LAUNDER(); kvpost_phase(F); SEAM(); }
            PHASE(pb + 3) { LAUNDER();
                float kb_; { float g_ = fabsf(F.in[34][F.lane]); g_ = fmaxf(g_, dpp_f(g_, 0)); g_ = fmaxf(g_, dpp_f(g_, 1)); g_ = fmaxf(g_, dpp_f(g_, 2)); g_ = fmaxf(g_, dpp_f(g_, 3));
                  { auto rr = __builtin_amdgcn_permlane16_swap(__float_as_uint(g_), __float_as_uint(g_), false, false); g_ = fmaxf(__uint_as_float(rr[0]), __uint_as_float(rr[1])); }
                  { auto rr = __builtin_amdgcn_permlane32_swap(__float_as_uint(g_), __float_as_uint(g_), false, false); g_ = fmaxf(__uint_as_float(rr[0]), __uint_as_float(rr[1])); }
                  kb_ = 8.0f * 1.02f * g_; }
                const attn_body::AttnTensors AT{(const attn_body::bf16*)QB_, (const attn_body::bf16*)(ws + WS_KS), (const attn_body::bf16*)(ws + WS_VS), (attn_body::bf16*)((PROBE_PH == pb + 3 && rep_ == 0) ? (bf16*)(ws + WS_KVRAW) : QB_), (const attn_body::bf16*)GT_, (const unsigned char*)(ws + WS_G3), F.in[36] + j * 64, kb_};
                float thr2_; { float g_ = fabsf(F.in[36][j * 64 + F.lane]); g_ = fmaxf(g_, dpp_f(g_, 0)); g_ = fmaxf(g_, dpp_f(g_, 1)); g_ = fmaxf(g_, dpp_f(g_, 2)); g_ = fmaxf(g_, dpp_f(g_, 3));
                  { auto rr = __builtin_amdgcn_permlane16_swap(__float_as_uint(g_), __float_as_uint(g_), false, false); g_ = fmaxf(__uint_as_float(rr[0]), __uint_as_float(rr[1])); }
                  { auto rr = __builtin_amdgcn_permlane32_swap(__float_as_uint(g_), __float_as_uint(g_), false, false); g_ = fmaxf(__uint_as_float(rr[0]), __uint_as_float(rr[1])); }
                  thr2_ = 64.0f + 2.0f * kb_ * attn_body::C2 * 8.16f * g_; }
                attn_body::attn_phase_dyn<8>((char*)lds, AT, (unsigned*)(ws + WS_BAR) + 3600 + j * 64, thr2_, F.tid);
                SEAM(); }
            PHASE(pb + 6) { LAUNDER(); GEMM_CALL(FnRes, QB_, ws + WS_WO2 + (size_t)j * D * D * 2, D, D, D, D, (const float*)F.out, F.out, MODL_ + 2 * 1024); SEAM(); }
        }
        PHASE(pb + 7) { LAUNDER(); mlp_weights(F, L); norm_phase(F, F.out, F.in[5] + L * D, MODL_ + 3 * 1024, MODL_ + 4 * 1024, 6144, 1, XN_); SEAM(); }
        PHASE(pb + 8) { LAUNDER(); GEMM_CALL(FnUp, XN_, ws + WS_WUP, FF, D, D, D, HB_); SEAM(); }
        PHASE(pb + 9) { LAUNDER(); GEMM_CALL(FnRes, HB_, ws + WS_WDN, D, FF, FF, FF, (const float*)F.out, F.out, MODL_ + 5 * 1024); SEAM(); }
        }
    { constexpr int L = 2;
        const int pb = 1 + L * 10;
        if (L < 2) {
            PHASE(pb + 0) { LAUNDER(); norm_mix_phase(F, XIN1_, F.in[4] + L * D, MODL_, MODL_ + 1024, F.in[8] + L * 6 * 1024, H2_, P2_); SEAM(); }
            PHASE(pb + 1) { LAUNDER(); GEMM_CALL(FnP1, H2_, ws + WS_W1 + (size_t)L * N1 * K1 * 2 + (size_t)3072 * 1024 * 2, 512, K1, K1, K1, P1_, 3072);
                LAUNDER();
                if (F.G == 256) GEMM_CALL_S(SplitOrder, FnP1, P2_, ws + WS_W1 + (size_t)L * N1 * K1 * 2, 3072, D, D, D, 4, (size_t)M * D * 2, P1_, 0);
                else GEMM_CALL_G(FnP1, P2_, ws + WS_W1 + (size_t)L * N1 * K1 * 2, 3072, D, D, D, 4, (size_t)M * D * 2, P1_, 0);
                SEAM(); }
            PHASE(pb + 2) { LAUNDER(); GEMM_CALL_K256(FnP2, P1_ + 3072, ws + WS_W2A + (size_t)L * 3072 * 256 * 2, (L == 0 ? 2048 : NP2), 256, N1, 256, P2_, MOD_ + 53248 + L * 3072); SEAM(); }
            PHASE(pb + 3) { LAUNDER(); scan_phase(F, L); SEAM(); }
            PHASE(pb + 4) { LAUNDER(); post_phase(F, L); SEAM(); }
            PHASE(pb + 5) { LAUNDER(); GEMM_CALL_K256(FnGate, P1_ + 3232, ws + WS_W2G + (size_t)L * 1024 * 256 * 2, D, 256, N1, 256, H2_, 2048); SEAM(); }
            PHASE(pb + 6) { LAUNDER(); GEMM_CALL(FnRes, H2_, ws + WS_WO + (size_t)L * D * D * 2, D, D, 2048, D, XIN1_, F.out, MODL_ + 2 * 1024); SEAM(); }
        } else {
            const int j = L - 2;
            PHASE(pb + 0) { LAUNDER(); norm_phase(F, F.out, F.in[4] + L * D, MODL_, MODL_ + 1024, 6144, 1, XN_);
                if (L == 2) norm_phase(F, F.out, F.in[29], MODKV_, MODKV_ + 1024, 2048, 1, XNKV_);
                SEAM(); }
            PHASE(pb + 1) { LAUNDER();
                if (L == 2) GEMM_CALL(FnKv, XNKV_, ws + WS_WKV, 2304, D, D, D, (bf16*)(ws + WS_KVRAW), (float*)(ws + WS_FL), (bf16*)(ws + WS_VS));
                LAUNDER();
                GEMM_CALL(FnQg, XN_, ws + WS_WQG + (size_t)j * 2048 * D * 2, 2048, D, D, D, QB_, GT_); SEAM(); }
            if (L == 2) PHASE(pb + 2) { LAUNDER(); kvpost_phase(F); SEAM(); }
            PHASE(pb + 3) { LAUNDER();
                float kb_; { float g_ = fabsf(F.in[34][F.lane]); g_ = fmaxf(g_, dpp_f(g_, 0)); g_ = fmaxf(g_, dpp_f(g_, 1)); g_ = fmaxf(g_, dpp_f(g_, 2)); g_ = fmaxf(g_, dpp_f(g_, 3));
                  { auto rr = __builtin_amdgcn_permlane16_swap(__float_as_uint(g_), __float_as_uint(g_), false, false); g_ = fmaxf(__uint_as_float(rr[0]), __uint_as_float(rr[1])); }
                  { auto rr = __builtin_amdgcn_permlane32_swap(__float_as_uint(g_), __float_as_uint(g_), false, false); g_ = fmaxf(__uint_as_float(rr[0]), __uint_as_float(rr[1])); }
                  kb_ = 8.0f * 1.02f * g_; }
                const attn_body::AttnTensors AT{(const attn_body::bf16*)QB_, (const attn_body::bf16*)(ws + WS_KS), (const attn_body::bf16*)(ws + WS_VS), (attn_body::bf16*)((PROBE_PH == pb + 3 && rep_ == 0) ? (bf16*)(ws + WS_KVRAW) : QB_), (const attn_body::bf16*)GT_, (const unsigned char*)(ws + WS_G3), F.in[36] + j * 64, kb_};
                float thr2_; { float g_ = fabsf(F.in[36][j * 64 + F.lane]); g_ = fmaxf(g_, dpp_f(g_, 0)); g_ = fmaxf(g_, dpp_f(g_, 1)); g_ = fmaxf(g_, dpp_f(g_, 2)); g_ = fmaxf(g_, dpp_f(g_, 3));
                  { auto rr = __builtin_amdgcn_permlane16_swap(__float_as_uint(g_), __float_as_uint(g_), false, false); g_ = fmaxf(__uint_as_float(rr[0]), __uint_as_float(rr[1])); }
                  { auto rr = __builtin_amdgcn_permlane32_swap(__float_as_uint(g_), __float_as_uint(g_), false, false); g_ = fmaxf(__uint_as_float(rr[0]), __uint_as_float(rr[1])); }
                  thr2_ = 64.0f + 2.0f * kb_ * attn_body::C2 * 8.16f * g_; }
                attn_body::attn_phase_dyn<8>((char*)lds, AT, (unsigned*)(ws + WS_BAR) + 3600 + j * 64, thr2_, F.tid);
                SEAM(); }
            PHASE(pb + 6) { LAUNDER(); GEMM_CALL(FnRes, QB_, ws + WS_WO2 + (size_t)j * D * D * 2, D, D, D, D, (const float*)F.out, F.out, MODL_ + 2 * 1024); SEAM(); }
        }
        PHASE(pb + 7) { LAUNDER(); mlp_weights(F, L); norm_phase(F, F.out, F.in[5] + L * D, MODL_ + 3 * 1024, MODL_ + 4 * 1024, 6144, 1, XN_); SEAM(); }
        PHASE(pb + 8) { LAUNDER(); GEMM_CALL(FnUp, XN_, ws + WS_WUP, FF, D, D, D, HB_); SEAM(); }
        PHASE(pb + 9) { LAUNDER(); GEMM_CALL(FnRes, HB_, ws + WS_WDN, D, FF, FF, FF, (const float*)F.out, F.out, MODL_ + 5 * 1024); SEAM(); }
        }
    { constexpr int L = 3;
        const int pb = 1 + L * 10;
        if (L < 2) {
            PHASE(pb + 0) { LAUNDER(); norm_mix_phase(F, XIN1_, F.in[4] + L * D, MODL_, MODL_ + 1024, F.in[8] + L * 6 * 1024, H2_, P2_); SEAM(); }
            PHASE(pb + 1) { LAUNDER(); GEMM_CALL(FnP1, H2_, ws + WS_W1 + (size_t)L * N1 * K1 * 2 + (size_t)3072 * 1024 * 2, 512, K1, K1, K1, P1_, 3072);
                LAUNDER();
                if (F.G == 256) GEMM_CALL_S(SplitOrder, FnP1, P2_, ws + WS_W1 + (size_t)L * N1 * K1 * 2, 3072, D, D, D, 4, (size_t)M * D * 2, P1_, 0);
                else GEMM_CALL_G(FnP1, P2_, ws + WS_W1 + (size_t)L * N1 * K1 * 2, 3072, D, D, D, 4, (size_t)M * D * 2, P1_, 0);
                SEAM(); }
            PHASE(pb + 2) { LAUNDER(); GEMM_CALL_K256(FnP2, P1_ + 3072, ws + WS_W2A + (size_t)L * 3072 * 256 * 2, (L == 0 ? 2048 : NP2), 256, N1, 256, P2_, MOD_ + 53248 + L * 3072); SEAM(); }
            PHASE(pb + 3) { LAUNDER(); scan_phase(F, L); SEAM(); }
            PHASE(pb + 4) { LAUNDER(); post_phase(F, L); SEAM(); }
            PHASE(pb + 5) { LAUNDER(); GEMM_CALL_K256(FnGate, P1_ + 3232, ws + WS_W2G + (size_t)L * 1024 * 256 * 2, D, 256, N1, 256, H2_, 2048); SEAM(); }
            PHASE(pb + 6) { LAUNDER(); GEMM_CALL(FnRes, H2_, ws + WS_WO + (size_t)L * D * D * 2, D, D, 2048, D, XIN1_, F.out, MODL_ + 2 * 1024); SEAM(); }
        } else {
            const int j = L - 2;
            PHASE(pb + 0) { LAUNDER(); norm_phase(F, F.out, F.in[4] + L * D, MODL_, MODL_ + 1024, 6144, 1, XN_);
                if (L == 2) norm_phase(F, F.out, F.in[29], MODKV_, MODKV_ + 1024, 2048, 1, XNKV_);
                SEAM(); }
            PHASE(pb + 1) { LAUNDER();
                if (L == 2) GEMM_CALL(FnKv, XNKV_, ws + WS_WKV, 2304, D, D, D, (bf16*)(ws + WS_KVRAW), (float*)(ws + WS_FL), (bf16*)(ws + WS_VS));
                LAUNDER();
                GEMM_CALL(FnQg, XN_, ws + WS_WQG + (size_t)j * 2048 * D * 2, 2048, D, D, D, QB_, GT_); SEAM(); }
            if (L == 2) PHASE(pb + 2) { LAUNDER(); kvpost_phase(F); SEAM(); }
            PHASE(pb + 3) { LAUNDER();
                float kb_; { float g_ = fabsf(F.in[34][F.lane]); g_ = fmaxf(g_, dpp_f(g_, 0)); g_ = fmaxf(g_, dpp_f(g_, 1)); g_ = fmaxf(g_, dpp_f(g_, 2)); g_ = fmaxf(g_, dpp_f(g_, 3));
                  { auto rr = __builtin_amdgcn_permlane16_swap(__float_as_uint(g_), __float_as_uint(g_), false, false); g_ = fmaxf(__uint_as_float(rr[0]), __uint_as_float(rr[1])); }
                  { auto rr = __builtin_amdgcn_permlane32_swap(__float_as_uint(g_), __float_as_uint(g_), false, false); g_ = fmaxf(__uint_as_float(rr[0]), __uint_as_float(rr[1])); }
                  kb_ = 8.0f * 1.02f * g_; }
                const attn_body::AttnTensors AT{(const attn_body::bf16*)QB_, (const attn_body::bf16*)(ws + WS_KS), (const attn_body::bf16*)(ws + WS_VS), (attn_body::bf16*)((PROBE_PH == pb + 3 && rep_ == 0) ? (bf16*)(ws + WS_KVRAW) : QB_), (const attn_body::bf16*)GT_, (const unsigned char*)(ws + WS_G3), F.in[36] + j * 64, kb_};
                float thr2_; { float g_ = fabsf(F.in[36][j * 64 + F.lane]); g_ = fmaxf(g_, dpp_f(g_, 0)); g_ = fmaxf(g_, dpp_f(g_, 1)); g_ = fmaxf(g_, dpp_f(g_, 2)); g_ = fmaxf(g_, dpp_f(g_, 3));
                  { auto rr = __builtin_amdgcn_permlane16_swap(__float_as_uint(g_), __float_as_uint(g_), false, false); g_ = fmaxf(__uint_as_float(rr[0]), __uint_as_float(rr[1])); }
                  { auto rr = __builtin_amdgcn_permlane32_swap(__float_as_uint(g_), __float_as_uint(g_), false, false); g_ = fmaxf(__uint_as_float(rr[0]), __uint_as_float(rr[1])); }
                  thr2_ = 64.0f + 2.0f * kb_ * attn_body::C2 * 8.16f * g_; }
                attn_body::attn_phase_dyn<8>((char*)lds, AT, (unsigned*)(ws + WS_BAR) + 3600 + j * 64, thr2_, F.tid);
                SEAM(); }
            PHASE(pb + 6) { LAUNDER(); GEMM_CALL(FnRes, QB_, ws + WS_WO2 + (size_t)j * D * D * 2, D, D, D, D, (const float*)F.out, F.out, MODL_ + 2 * 1024); SEAM(); }
        }
        PHASE(pb + 7) { LAUNDER(); mlp_weights(F, L); norm_phase(F, F.out, F.in[5] + L * D, MODL_ + 3 * 1024, MODL_ + 4 * 1024, 6144, 1, XN_); SEAM(); }
        PHASE(pb + 8) { LAUNDER(); GEMM_CALL(FnUp, XN_, ws + WS_WUP, FF, D, D, D, HB_); SEAM(); }
        PHASE(pb + 9) { LAUNDER(); GEMM_CALL(FnRes, HB_, ws + WS_WDN, D, FF, FF, FF, (const float*)F.out, F.out, MODL_ + 5 * 1024); SEAM(); }
        }
    PHASE(41) { LAUNDER(); final_norm_phase(F); }
#undef IN
#undef SEAM
}
static bool phase_exists(int ph) {
    if (ph == 0 || ph == 41) return true;
    const int L = (ph - 1) / 10, s = (ph - 1) % 10;
    if (L < 2) return true;
    if (s == 4 || s == 5) return false;
    if (s == 2) return L == 2;
    return true;
}
extern "C" void kernel_launch(void* const* d_in, const int* in_sizes, int n_in, void* d_out, int out_size, void* d_ws, size_t ws_size, hipStream_t stream) {
    static int grid = 0;
    if (grid == 0) {
        if (n_in != 39 || in_sizes[0] != M * D || out_size != M * D || ws_size < WS_END) { fprintf(stderr, "kernel_launch: shape/workspace mismatch: n_in %d in0 %d out %d ws %zu (need %zu)\n", n_in, n_in > 0 ? in_sizes[0] : -1, out_size, ws_size, (size_t)WS_END); grid = -1; return; }
        int dev = 0, cus = 0, per_cu = 0;
        if (hipGetDevice(&dev) != hipSuccess || hipDeviceGetAttribute(&cus, hipDeviceAttributeMultiprocessorCount, dev) != hipSuccess) { fprintf(stderr, "kernel_launch: device query failed\n"); grid = -1; return; }
        if (hipFuncSetAttribute((const void*)yoco_fwd, hipFuncAttributeMaxDynamicSharedMemorySize, LDS_BYTES) != hipSuccess) { fprintf(stderr, "kernel_launch: hipFuncSetAttribute failed\n"); grid = -1; return; }
        if (hipOccupancyMaxActiveBlocksPerMultiprocessor(&per_cu, (const void*)yoco_fwd, NWAVES * 64, LDS_BYTES) != hipSuccess || per_cu < 1) { fprintf(stderr, "kernel_launch: occupancy query says %d blocks/CU\n", per_cu); per_cu = 1; }
        (void)hipGetLastError();
        grid = cus * per_cu;
        if (grid != 256) { fprintf(stderr, "kernel_launch: resident capacity %d workgroups; this kernel's static schedules want 256 (using 256)\n", grid); if (grid > 256) grid = 256; }
    }
    if (grid < 0) return;
    if (hipMemsetAsync((char*)d_ws + WS_BAR, 0, BAR_BYTES, stream) != hipSuccess) { fprintf(stderr, "kernel_launch: memset of barrier words failed\n"); return; }
    Args a{};
    for (int i = 0; i < 39; ++i) a.in[i] = (const float*)d_in[i];
    a.out = (float*)d_out; a.ws = (unsigned char*)d_ws;
#if MK_ONE_LAUNCH
    a.ph_lo = 0; a.ph_hi = N_PHASES;
    void* params[] = {&a};
    const hipError_t le = hipLaunchCooperativeKernel((const void*)yoco_fwd, dim3(grid), dim3(NWAVES * 64), params, LDS_BYTES, stream);
    if (le != hipSuccess) fprintf(stderr, "kernel_launch: cooperative launch failed: %s (grid %d)\n", hipGetErrorName(le), grid);
#else
    for (int ph = 0; ph < N_PHASES; ++ph) { if (!phase_exists(ph)) continue; a.ph_lo = ph; a.ph_hi = ph + 1;
        hipLaunchKernelGGL(yoco_fwd, dim3(grid), dim3(NWAVES * 64), LDS_BYTES, stream, a);
        const hipError_t le = hipPeekAtLastError(); if (le != hipSuccess) { fprintf(stderr, "kernel_launch: launch of phase %d failed: %s\n", ph, hipGetErrorName(le)); break; } }
#endif
}
```
